# Optimizing an MI355X kernel written in HIP

```python
import math
import jax, jax.numpy as jnp
from jax import lax
import numpy as np

D_MODEL = 1024
BATCH = 4
SEQ = 8192
DEPTH = 2

N_A_LAYERS = DEPTH // 2
N_B_LAYERS = DEPTH - N_A_LAYERS

N_HEADS = 8
Q_BLOCK = 128

DIFF_HEAD_DIM = 64
DIFF_V_DIM = 2 * DIFF_HEAD_DIM
DIFF_QK_WIDTH = N_HEADS * 2 * DIFF_HEAD_DIM
DIFF_V_WIDTH = N_HEADS * DIFF_V_DIM

NSA_HEAD_DIM = 128
NSA_KV_GROUPS = 2
NSA_HEADS_PER_GROUP = N_HEADS // NSA_KV_GROUPS
N_BRANCH = 3
CMP_LEN = 32
CMP_STRIDE = 16
CMP_HIDDEN = 256
SEL_BLOCK = 64
SEL_TOPN = 16
SEL_N_LOCAL = 2
WINDOW = 512
NSA_Q_BLOCK = 64
NSA_Q_WIDTH = N_HEADS * NSA_HEAD_DIM
NSA_GATE_WIDTH = N_HEADS * N_BRANCH
NSA_KV_WIDTH = N_BRANCH * 2 * NSA_KV_GROUPS * NSA_HEAD_DIM

REL_BUCKETS = 32
REL_MAX_DIST = 1024

PEER_HEADS = 8
PEER_N_KEYS = 128
PEER_N_EXPERTS = PEER_N_KEYS ** 2
PEER_QUERY_DIM = 256
PEER_TOPK = 16
PEER_TOKEN_BLOCK = 128

N_ADA = 6
NEG_INF = -1e30
FORCE = 1e9
EPS = 1e-6

kernel_name = 'yoco_diffattn_nsa_peer_hybrid'


def rms_norm(x, gain):
    xf = x.astype(jnp.float32)
    y = xf * lax.rsqrt(jnp.mean(xf * xf, axis=-1, keepdims=True) + EPS)
    return (y * gain.astype(jnp.float32)).astype(x.dtype)


def modulate(h, shift, scale):
    return h * (1 + scale[:, None, :]) + shift[:, None, :]


def rel_bucket(dist):
    max_exact = REL_BUCKETS // 2
    n = jnp.maximum(dist, 0)
    nf = jnp.maximum(n, 1).astype(jnp.float32)
    large = max_exact + (jnp.log(nf / max_exact) / math.log(REL_MAX_DIST / max_exact)
                         * (REL_BUCKETS - max_exact)).astype(jnp.int32)
    large = jnp.minimum(large, REL_BUCKETS - 1)
    return jnp.where(n < max_exact, n, large)


def masked_softmax(logits, mask):
    lf = jnp.where(mask, logits.astype(jnp.float32), NEG_INF)
    p = jax.nn.softmax(lf, axis=-1)
    return jnp.where(mask, p, 0.0)


def diff_attention(h, w_in, w_out, lam, q_gain, k_gain, subln_gain, rel_bias, layer_idx):
    B, S, _ = h.shape
    proj = h @ w_in
    q, k, v = jnp.split(proj, [DIFF_QK_WIDTH, 2 * DIFF_QK_WIDTH], axis=-1)
    q = rms_norm(q.reshape(B, S, N_HEADS, 2, DIFF_HEAD_DIM), q_gain)
    k = rms_norm(k.reshape(B, S, N_HEADS, 2, DIFF_HEAD_DIM), k_gain)
    v = v.reshape(B, S, N_HEADS, DIFF_V_DIM)
    lam_init = 0.8 - 0.6 * math.exp(-0.3 * layer_idx)
    lamf = lam.astype(jnp.float32)
    lam_full = jnp.exp(jnp.sum(lamf[0] * lamf[1])) - jnp.exp(jnp.sum(lamf[2] * lamf[3])) + lam_init
    nb = S // Q_BLOCK
    qb = q.reshape(B, nb, Q_BLOCK, N_HEADS, 2, DIFF_HEAD_DIM).transpose(1, 0, 2, 3, 4, 5)
    k_pos = jnp.arange(S)
    scale = DIFF_HEAD_DIM ** -0.5

    def block(args):
        qi, i = args
        q_pos = i * Q_BLOCK + jnp.arange(Q_BLOCK)
        dist = q_pos[:, None] - k_pos[None, :]
        mask = dist >= 0
        bias = rel_bias[rel_bucket(dist)].transpose(2, 0, 1)[None, :, None]
        logits = jnp.einsum('bthjd,bshjd->bhjts', qi, k) * scale + bias
        p = masked_softmax(logits, mask)
        attn = p[:, :, 0] - lam_full * p[:, :, 1]
        return jnp.einsum('bhts,bshe->bthe', attn.astype(v.dtype), v)

    o = lax.map(block, (qb, jnp.arange(nb)))
    o = o.transpose(1, 0, 2, 3, 4).reshape(B, S, N_HEADS, DIFF_V_DIM)
    o = rms_norm(o, subln_gain) * (1 - lam_init)
    return o.reshape(B, S, DIFF_V_WIDTH) @ w_out


def nsa_shared_kv(x, c_act, kv_norm, kv_ada_w, kv_ada_b, kv_w, cmp_pos, cmp_w1, cmp_b1, cmp_w2, k_gain):
    B, S, _ = x.shape
    G, HD = NSA_KV_GROUPS, NSA_HEAD_DIM
    shift, scale = jnp.split(c_act @ kv_ada_w + kv_ada_b, 2, axis=-1)
    h = modulate(rms_norm(x, kv_norm), shift, scale)
    kv = (h @ kv_w).reshape(B, S, N_BRANCH, 2, G, HD)
    kv = kv.transpose(2, 3, 0, 4, 1, 5)
    n_cmp = (S - CMP_LEN) // CMP_STRIDE + 1
    idx = np.arange(n_cmp)[:, None] * CMP_STRIDE + np.arange(CMP_LEN)[None, :]
    blocks = kv[0][:, :, :, idx]
    blocks = blocks + cmp_pos[:, None, None, None]
    flat = blocks.reshape(2, B, G, n_cmp, CMP_LEN * HD)
    hid = jax.nn.gelu(jnp.einsum('kbgnf,kfh->kbgnh', flat, cmp_w1) + cmp_b1[:, None, None, None])
    cmp = jnp.einsum('kbgnh,khd->kbgnd', hid, cmp_w2)
    k_cmp = rms_norm(cmp[0], k_gain[0])
    v_cmp = cmp[1]
    k_slc = rms_norm(kv[1, 0], k_gain[1])
    v_slc = kv[1, 1]
    k_win = rms_norm(kv[2, 0], k_gain[2])
    v_win = kv[2, 1]
    return (k_cmp, v_cmp, k_slc, v_slc, k_win, v_win)


def nsa_attention(h, w_in, b_gate, w_out, q_gain, rel_bias, k_cmp, v_cmp, k_slc, v_slc, k_win, v_win):
    B, S, _ = h.shape
    G, HG, HD, T = NSA_KV_GROUPS, NSA_HEADS_PER_GROUP, NSA_HEAD_DIM, NSA_Q_BLOCK
    proj = h @ w_in
    q = rms_norm(proj[..., :NSA_Q_WIDTH].reshape(B, S, G, HG, HD), q_gain)
    gates = jax.nn.sigmoid((proj[..., NSA_Q_WIDTH:] + b_gate).astype(jnp.float32))
    nb = S // T
    n_cmp = k_cmp.shape[2]
    n_sel = S // SEL_BLOCK
    top_n = min(SEL_TOPN, n_sel)
    cmp_start = np.arange(n_cmp) * CMP_STRIDE
    sel_start = np.arange(n_sel) * SEL_BLOCK
    overlap = np.clip(np.minimum(cmp_start[:, None] + CMP_LEN, sel_start[None, :] + SEL_BLOCK)
                      - np.maximum(cmp_start[:, None], sel_start[None, :]), 0, None) / CMP_LEN
    overlap = jnp.asarray(overlap, jnp.float32)
    cmp_end = jnp.asarray(cmp_start + CMP_LEN - 1, jnp.int32)
    k_blocks = k_slc.reshape(B, G, n_sel, SEL_BLOCK, HD)
    v_blocks = v_slc.reshape(B, G, n_sel, SEL_BLOCK, HD)
    pad = ((0, 0), (0, 0), (WINDOW, 0), (0, 0))
    k_win_p = jnp.pad(k_win, pad)
    v_win_p = jnp.pad(v_win, pad)
    tab = rel_bias.reshape(REL_BUCKETS, G, HG)
    qb = q.reshape(B, nb, T, G, HG, HD).transpose(1, 0, 3, 4, 2, 5)
    gb = gates.reshape(B, nb, T, G, HG, N_BRANCH).transpose(1, 0, 3, 4, 2, 5)
    scale = HD ** -0.5
    b_idx = jnp.arange(B)[:, None, None, None]
    g_idx = jnp.arange(G)[None, :, None, None]
    g_idx5 = jnp.arange(G)[None, :, None, None, None]
    blk = jnp.arange(n_sel)

    def block(args):
        qi, gi, i = args
        q_pos = i * T + jnp.arange(T)
        dist_c = q_pos[:, None] - cmp_end[None, :]
        mask_c = dist_c >= 0
        bias_c = tab[rel_bucket(dist_c)].transpose(2, 3, 0, 1)
        logit_c = jnp.einsum('bghtd,bgnd->bghtn', qi, k_cmp) * scale + bias_c
        p_c = masked_softmax(logit_c, mask_c)
        o_c = jnp.einsum('bghtn,bgnd->bghtd', p_c.astype(v_cmp.dtype), v_cmp)
        imp = jnp.einsum('bghtn,nj->bgtj', p_c, overlap)
        cur = q_pos // SEL_BLOCK
        back = cur[:, None] - blk[None, :]
        forced = (blk[None, :] == 0) | ((back >= 0) & (back < SEL_N_LOCAL))
        imp = jnp.where(forced, FORCE, imp)
        imp = jnp.where(back >= 0, imp, NEG_INF)
        top_score, sel = lax.top_k(imp, top_n)
        sel_valid = top_score >= 0
        ks = k_blocks[b_idx, g_idx, sel]
        vs = v_blocks[b_idx, g_idx, sel]
        key_pos = sel[..., None] * SEL_BLOCK + jnp.arange(SEL_BLOCK)
        dist_s = q_pos[:, None, None] - key_pos
        mask_s = ((dist_s >= 0) & sel_valid[..., None]).reshape(B, G, 1, T, top_n * SEL_BLOCK)
        bias_s = tab[rel_bucket(dist_s), g_idx5].transpose(0, 1, 5, 2, 3, 4)
        logit_s = jnp.einsum('bghtd,bgtnrd->bghtnr', qi, ks) * scale + bias_s
        p_s = masked_softmax(logit_s.reshape(B, G, HG, T, top_n * SEL_BLOCK), mask_s)
        o_s = jnp.einsum('bghtk,bgtkd->bghtd', p_s.astype(vs.dtype),
                         vs.reshape(B, G, T, top_n * SEL_BLOCK, HD))
        kw = lax.dynamic_slice_in_dim(k_win_p, i * T, WINDOW + T, axis=2)
        vw = lax.dynamic_slice_in_dim(v_win_p, i * T, WINDOW + T, axis=2)
        key_pos_w = i * T - WINDOW + jnp.arange(WINDOW + T)
        dist_w = q_pos[:, None] - key_pos_w[None, :]
        mask_w = (dist_w >= 0) & (dist_w < WINDOW) & (key_pos_w[None, :] >= 0)
        bias_w = tab[rel_bucket(dist_w)].transpose(2, 3, 0, 1)
        logit_w = jnp.einsum('bghtd,bgkd->bghtk', qi, kw) * scale + bias_w
        p_w = masked_softmax(logit_w, mask_w)
        o_w = jnp.einsum('bghtk,bgkd->bghtd', p_w.astype(vw.dtype), vw)
        gi = gi.astype(o_c.dtype)
        return (gi[..., 0:1] * o_c + gi[..., 1:2] * o_s + gi[..., 2:3] * o_w)

    o = lax.map(block, (qb, gb, jnp.arange(nb)))
    o = o.transpose(1, 0, 4, 2, 3, 5).reshape(B, S, NSA_Q_WIDTH)
    return o @ w_out


def peer_ffn(h, w_q, subkeys, u, v):
    B, S, D = h.shape
    T = PEER_TOKEN_BLOCK
    tokens = h.reshape((B * S) // T, T, D)
    half = PEER_QUERY_DIM // 2

    def block(xt):
        q = (xt @ w_q).reshape(T, PEER_HEADS, 2, half)
        s = jnp.einsum('thpd,pkd->thpk', q, subkeys).astype(jnp.float32)
        s1, i1 = lax.top_k(s[:, :, 0], PEER_TOPK)
        s2, i2 = lax.top_k(s[:, :, 1], PEER_TOPK)
        cand = (s1[..., :, None] + s2[..., None, :]).reshape(T, PEER_HEADS, PEER_TOPK * PEER_TOPK)
        cand_idx = (i1[..., :, None] * PEER_N_KEYS + i2[..., None, :]).reshape(T, PEER_HEADS, PEER_TOPK * PEER_TOPK)
        top_s, pos = lax.top_k(cand, PEER_TOPK)
        expert = jnp.take_along_axis(cand_idx, pos, axis=-1)
        gate = jax.nn.softmax(top_s, axis=-1)
        ue = u[expert]
        ve = v[expert]
        act = jax.nn.gelu(jnp.einsum('td,thkd->thk', xt, ue)).astype(jnp.float32)
        return jnp.einsum('thk,thkd->td', (gate * act).astype(ve.dtype), ve)

    return lax.map(block, tokens).reshape(B, S, D)


def setup_inputs(seed: int = 0) -> dict:
    key = jax.random.key(seed)
    ks = jax.random.split(key, 32)
    f32 = jnp.float32
    D = D_MODEL

    def nrm(k, shape, s):
        return jax.random.normal(k, shape, f32) * s

    def gain(k, shape):
        return 1.0 + 0.05 * jax.random.normal(k, shape, f32)

    return {
        'x': nrm(ks[0], (BATCH, SEQ, D), 1.0),
        'c': nrm(ks[1], (BATCH, D), 1.0),
        'rel_bias': nrm(ks[2], (REL_BUCKETS, N_HEADS), 0.5),
        'ada_w': nrm(ks[3], (DEPTH, D, N_ADA * D), 0.5 * D ** -0.5),
        'ada_b': nrm(ks[4], (DEPTH, N_ADA * D), 0.02),
        'norm_mix': gain(ks[5], (DEPTH, D)),
        'norm_ffn': gain(ks[6], (DEPTH, D)),
        'diff_w_in': nrm(ks[7], (N_A_LAYERS, D, 2 * DIFF_QK_WIDTH + DIFF_V_WIDTH), D ** -0.5),
        'diff_w_out': nrm(ks[8], (N_A_LAYERS, DIFF_V_WIDTH, D), DIFF_V_WIDTH ** -0.5),
        'diff_lambda': nrm(ks[9], (N_A_LAYERS, 4, DIFF_HEAD_DIM), 0.1),
        'diff_q_gain': gain(ks[10], (N_A_LAYERS, DIFF_HEAD_DIM)),
        'diff_k_gain': gain(ks[11], (N_A_LAYERS, DIFF_HEAD_DIM)),
        'diff_subln': gain(ks[12], (N_A_LAYERS, DIFF_V_DIM)),
        'kv_norm': gain(ks[13], (D,)),
        'kv_ada_w': nrm(ks[14], (D, 2 * D), 0.5 * D ** -0.5),
        'kv_ada_b': nrm(ks[15], (2 * D,), 0.02),
        'kv_w': nrm(ks[16], (D, NSA_KV_WIDTH), D ** -0.5),
        'cmp_pos': nrm(ks[17], (2, CMP_LEN, NSA_HEAD_DIM), 0.1),
        'cmp_w1': nrm(ks[18], (2, CMP_LEN * NSA_HEAD_DIM, CMP_HIDDEN), (CMP_LEN * NSA_HEAD_DIM) ** -0.5),
        'cmp_b1': nrm(ks[19], (2, CMP_HIDDEN), 0.02),
        'cmp_w2': nrm(ks[20], (2, CMP_HIDDEN, NSA_HEAD_DIM), CMP_HIDDEN ** -0.5),
        'nsa_k_gain': gain(ks[21], (N_BRANCH, NSA_HEAD_DIM)),
        'nsa_w_in': nrm(ks[22], (N_B_LAYERS, D, NSA_Q_WIDTH + NSA_GATE_WIDTH), D ** -0.5),
        'nsa_b_gate': nrm(ks[23], (N_B_LAYERS, NSA_GATE_WIDTH), 0.1),
        'nsa_w_out': nrm(ks[24], (N_B_LAYERS, NSA_Q_WIDTH, D), NSA_Q_WIDTH ** -0.5),
        'nsa_q_gain': gain(ks[25], (N_B_LAYERS, NSA_HEAD_DIM)),
        'peer_w_q': nrm(ks[26], (DEPTH, D, PEER_HEADS * PEER_QUERY_DIM), D ** -0.5),
        'peer_subkeys': nrm(ks[27], (DEPTH, 2, PEER_N_KEYS, PEER_QUERY_DIM // 2), (PEER_QUERY_DIM // 2) ** -0.5),
        'peer_u': nrm(ks[28], (DEPTH, PEER_N_EXPERTS, D), D ** -0.5),
        'peer_v': nrm(ks[29], (DEPTH, PEER_N_EXPERTS, D), 1.0),
    }


def reference(x, c, rel_bias, ada_w, ada_b, norm_mix, norm_ffn, diff_w_in, diff_w_out, diff_lambda,
              diff_q_gain, diff_k_gain, diff_subln, kv_norm, kv_ada_w, kv_ada_b, kv_w, cmp_pos, cmp_w1,
              cmp_b1, cmp_w2, nsa_k_gain, nsa_w_in, nsa_b_gate, nsa_w_out, nsa_q_gain, peer_w_q,
              peer_subkeys, peer_u, peer_v):
    c_act = jax.nn.silu(c)
    kv_shared = None
    for layer in range(DEPTH):
        if layer == N_A_LAYERS:
            kv_shared = nsa_shared_kv(x, c_act, kv_norm, kv_ada_w, kv_ada_b, kv_w, cmp_pos,
                                      cmp_w1, cmp_b1, cmp_w2, nsa_k_gain)
        sh_m, sc_m, g_m, sh_f, sc_f, g_f = jnp.split(c_act @ ada_w[layer] + ada_b[layer], N_ADA, axis=-1)
        h = modulate(rms_norm(x, norm_mix[layer]), sh_m, sc_m)
        if layer < N_A_LAYERS:
            y = diff_attention(h, diff_w_in[layer], diff_w_out[layer], diff_lambda[layer],
                               diff_q_gain[layer], diff_k_gain[layer], diff_subln[layer], rel_bias, layer)
        else:
            j = layer - N_A_LAYERS
            y = nsa_attention(h, nsa_w_in[j], nsa_b_gate[j], nsa_w_out[j], nsa_q_gain[j], rel_bias, *kv_shared)
        x = x + g_m[:, None, :] * y
        h = modulate(rms_norm(x, norm_ffn[layer]), sh_f, sc_f)
        x = x + g_f[:, None, :] * peer_ffn(h, peer_w_q[layer], peer_subkeys[layer], peer_u[layer], peer_v[layer])
    return x
```

```cpp
#include <hip/hip_runtime.h>
#include <hip/hip_cooperative_groups.h>
#include <cstdio>
#include <cstdint>
namespace cg = cooperative_groups;

#define DI __device__ __forceinline__
#ifndef STOP_AFTER
#define STOP_AFTER 99
#endif
#ifndef ONLY_PHASE
#define ONLY_PHASE -1
#endif
#define RUN(n) if (ONLY_PHASE < 0 || ONLY_PHASE == (n))

typedef unsigned short bf16_t;
typedef short bf16x8 __attribute__((ext_vector_type(8)));
typedef float f32x16 __attribute__((ext_vector_type(16)));
typedef float f32x4 __attribute__((ext_vector_type(4)));
typedef float f32x2 __attribute__((ext_vector_type(2)));
typedef unsigned u32x4 __attribute__((ext_vector_type(4)));
typedef unsigned u32x2 __attribute__((ext_vector_type(2)));
typedef __bf16 bf16x2v __attribute__((ext_vector_type(2)));

#define MFMA32(a, b, c) __builtin_amdgcn_mfma_f32_32x32x16_bf16((a), (b), (c), 0, 0, 0)

constexpr int NB = 4, SEQ = 8192, DM = 1024, NTOK = NB * SEQ;
constexpr int NTHREADS = 512, NWAVES = 8;
constexpr float EPS = 1e-6f;
constexpr float LOG2E = 1.4426950408889634f;
constexpr int ADA_STRIDE = 14336;

constexpr size_t MB = 1u << 20;
constexpr size_t OFF_ADA = 0;
constexpr size_t OFF_POSB = 256 * 1024;
constexpr size_t OFF_WT_DIN = 1 * MB;
constexpr size_t OFF_WT_DOUT = 7 * MB;
constexpr size_t OFF_WT_KV = 9 * MB;
constexpr size_t OFF_WT_NIN = 12 * MB;
constexpr size_t OFF_WT_NOUT = 15 * MB;
constexpr size_t OFF_WT_PEER = 17 * MB;
constexpr size_t OFF_WT_C1 = 25 * MB;
constexpr size_t OFF_WT_C2 = 29 * MB;
constexpr size_t OFF_GATES = 30 * MB;
constexpr size_t OFF_KCMP = 34 * MB;
constexpr size_t OFF_VCMPT = 35 * MB;
constexpr size_t OFF_HID = 36 * MB;
constexpr size_t OFF_RIDX = 40 * MB;
constexpr size_t OFF_RGATE = 56 * MB;
constexpr size_t OFF_PU = 72 * MB;
constexpr size_t OFF_PV = 136 * MB;
constexpr size_t OFF_H = 200 * MB;
constexpr size_t OFF_R = 264 * MB;
constexpr size_t WS_END = 456 * MB;
constexpr size_t OFF_Q0 = OFF_R, OFF_K0 = OFF_R + 64 * MB, OFF_VT0 = OFF_R + 128 * MB;
constexpr size_t OFF_QN = OFF_R, OFF_H2 = OFF_R, OFF_KC = OFF_R + 64 * MB, OFF_KS = OFF_R + 96 * MB, OFF_VST = OFF_R + 112 * MB,
                 OFF_KW = OFF_R + 128 * MB, OFF_VWT = OFF_R + 144 * MB;

constexpr int LDS_BYTES = 136 * 1024;

struct Params {
    const float* in[30];
    float* out;
    unsigned char* ws;
};

DI unsigned pk2(float lo, float hi) { f32x2 v = {lo, hi}; return __builtin_bit_cast(unsigned, __builtin_convertvector(v, bf16x2v)); }
DI bf16_t f2bf(float x) { return (bf16_t)(pk2(x, 0.f) & 0xffffu); }
DI float bflo(unsigned u) { return __uint_as_float(u << 16); }
DI float bfhi(unsigned u) { return __uint_as_float(u & 0xffff0000u); }
DI float fexp2(float x) { return __builtin_amdgcn_exp2f(x); }
DI float frcp(float x) { return __builtin_amdgcn_rcpf(x); }
DI int crow(int reg, int h) { return (reg & 3) + 8 * (reg >> 2) + 4 * h; }
DI float wave_sum(float v) {
#pragma unroll
    for (int o = 1; o < 64; o <<= 1) v += __shfl_xor(v, o);
    return v;
}
DI float gelu_tanh(float x) {
    const float u = 0.7978845608028654f * (x + 0.044715f * x * x * x);
    return x * frcp(1.f + fexp2(-2.f * LOG2E * u));
}
DI float dot2bf(unsigned a, unsigned b, float c) {
    return __builtin_amdgcn_fdot2_f32_bf16(__builtin_bit_cast(bf16x2v, a), __builtin_bit_cast(bf16x2v, b), c, false);
}
DI int rel_bucket_i(int d) {
    if (d < 16) return d < 0 ? 0 : d;
    int b = 16;
    b += d >= 21; b += d >= 27; b += d >= 35; b += d >= 46; b += d >= 59; b += d >= 77; b += d >= 99; b += d >= 128;
    b += d >= 166; b += d >= 216; b += d >= 280; b += d >= 363; b += d >= 470; b += d >= 609; b += d >= 790;
    return b;
}
DI unsigned f2key(float f) { unsigned u = __float_as_uint(f); return u ^ ((unsigned)((int)u >> 31) | 0x80000000u); }
DI float key2f(unsigned k) { unsigned u = (k & 0x80000000u) ? (k ^ 0x80000000u) : ~k; return __uint_as_float(u); }

constexpr int G_XS = 128 * 128, G_WS = 256 * 128, G_STAGE = G_XS + G_WS;
constexpr int EPI_LDS = 2 * G_STAGE;

DI int swz128(int row, int chunk) { return row * 128 + ((chunk ^ (row & 7)) << 4); }

template <class Epi>
DI void gemm_tile(const bf16_t* __restrict__ A, long lda, int M, const bf16_t* __restrict__ Bt, long ldb, int N, int K,
                  int m0, int n0, const Epi& epi, unsigned char* lds, int tid) {
    const int lane = tid & 63, w = tid >> 6, tg = w & 3, fh = w >> 2, r = lane & 31, h = lane >> 5;
    const int sc = tid & 7, sr = tid >> 3;
    const bf16_t* xa[2];
    const bf16_t* wa[4];
#pragma unroll
    for (int i = 0; i < 2; ++i) { int m = m0 + sr + 64 * i; m = m < M ? m : M - 1; xa[i] = A + (long)m * lda + sc * 8; }
#pragma unroll
    for (int i = 0; i < 4; ++i) { int n = n0 + sr + 64 * i; n = n < N ? n : N - 1; wa[i] = Bt + (long)n * ldb + sc * 8; }
    f32x16 acc[4];
#pragma unroll
    for (int i = 0; i < 4; ++i)
#pragma unroll
        for (int j = 0; j < 16; ++j) acc[i][j] = 0.f;
    u32x4 xr[2], wr[4];
    const int nk = K >> 6;
#pragma unroll
    for (int i = 0; i < 2; ++i) xr[i] = *(const u32x4*)(xa[i]);
#pragma unroll
    for (int i = 0; i < 4; ++i) wr[i] = *(const u32x4*)(wa[i]);
#pragma unroll
    for (int i = 0; i < 2; ++i) *(u32x4*)(lds + swz128(sr + 64 * i, sc)) = xr[i];
#pragma unroll
    for (int i = 0; i < 4; ++i) *(u32x4*)(lds + G_XS + swz128(sr + 64 * i, sc)) = wr[i];
    __syncthreads();
    for (int kt = 0; kt < nk; ++kt) {
        unsigned char* cur = lds + (kt & 1) * G_STAGE;
        const bool more = kt + 1 < nk;
        if (more) {
            const int ko = (kt + 1) * 64;
#pragma unroll
            for (int i = 0; i < 2; ++i) xr[i] = *(const u32x4*)(xa[i] + ko);
#pragma unroll
            for (int i = 0; i < 4; ++i) wr[i] = *(const u32x4*)(wa[i] + ko);
        }
#pragma unroll
        for (int ks = 0; ks < 4; ++ks) {
            const bf16x8 xf = *(const bf16x8*)(cur + swz128(32 * tg + r, 2 * ks + h));
#pragma unroll
            for (int mt = 0; mt < 4; ++mt) {
                const bf16x8 wf = *(const bf16x8*)(cur + G_XS + swz128(128 * fh + 32 * mt + r, 2 * ks + h));
                acc[mt] = MFMA32(wf, xf, acc[mt]);
            }
        }
        if (more) {
            unsigned char* nxt = lds + ((kt + 1) & 1) * G_STAGE;
#pragma unroll
            for (int i = 0; i < 2; ++i) *(u32x4*)(nxt + swz128(sr + 64 * i, sc)) = xr[i];
#pragma unroll
            for (int i = 0; i < 4; ++i) *(u32x4*)(nxt + G_XS + swz128(sr + 64 * i, sc)) = wr[i];
        }
        __syncthreads();
    }
    epi(acc, m0 + 32 * tg + r, n0 + 128 * fh, h, lds, tid);
}

struct EpiQKV0 {
    bf16_t *Q, *Kk, *VT;
    const float *qg, *kg;
    DI void operator()(const f32x16 (&acc)[4], int tok, int fbase, int h, unsigned char*, int) const {
        const int sec = fbase >> 10, hd = (fbase & 1023) >> 7, b = tok >> 13, s = tok & (SEQ - 1);
        if (sec < 2) {
            const float* gn = sec == 0 ? qg : kg;
            const float sc = sec == 0 ? 0.125f * LOG2E : 1.f;
            bf16_t* dst = sec == 0 ? Q : Kk;
#pragma unroll
            for (int j = 0; j < 2; ++j) {
                float ss = 0.f;
#pragma unroll
                for (int mt = 0; mt < 2; ++mt)
#pragma unroll
                    for (int rg = 0; rg < 16; ++rg) { const float v = acc[2 * j + mt][rg]; ss += v * v; }
                ss += __shfl_xor(ss, 32);
                const float rstd = rsqrtf(ss * (1.f / 64.f) + EPS) * sc;
                bf16_t* row = dst + ((long)((b * 8 + hd) * 2 + j) * SEQ + s) * 64;
#pragma unroll
                for (int mt = 0; mt < 2; ++mt)
#pragma unroll
                    for (int g4 = 0; g4 < 4; ++g4) {
                        const int d0 = 32 * mt + 8 * g4 + 4 * h;
                        const f32x4 gv = *(const f32x4*)(gn + d0);
                        u32x2 o;
                        o.x = pk2(acc[2 * j + mt][4 * g4 + 0] * rstd * gv.x, acc[2 * j + mt][4 * g4 + 1] * rstd * gv.y);
                        o.y = pk2(acc[2 * j + mt][4 * g4 + 2] * rstd * gv.z, acc[2 * j + mt][4 * g4 + 3] * rstd * gv.w);
                        *(u32x2*)(row + d0) = o;
                    }
            }
        } else {
            bf16_t* base = VT + (long)(b * 8 + hd) * 128 * SEQ + s;
#pragma unroll
            for (int mt = 0; mt < 4; ++mt)
#pragma unroll
                for (int rg = 0; rg < 16; ++rg) base[(long)(32 * mt + crow(rg, h)) * SEQ] = f2bf(acc[mt][rg]);
        }
    }
};

struct EpiResid {
    const float* xin; float* xout; const float* gate;
    DI void operator()(const f32x16 (&acc)[4], int tok, int fbase, int h, unsigned char*, int) const {
        const int b = tok >> 13;
        const float* gp = gate + b * ADA_STRIDE;
#pragma unroll
        for (int mt = 0; mt < 4; ++mt)
#pragma unroll
            for (int g4 = 0; g4 < 4; ++g4) {
                const int f = fbase + 32 * mt + 8 * g4 + 4 * h;
                const f32x4 xv = *(const f32x4*)(xin + (long)tok * DM + f);
                const f32x4 gv = *(const f32x4*)(gp + f);
                f32x4 o;
                o.x = xv.x + gv.x * acc[mt][4 * g4 + 0]; o.y = xv.y + gv.y * acc[mt][4 * g4 + 1];
                o.z = xv.z + gv.z * acc[mt][4 * g4 + 2]; o.w = xv.w + gv.w * acc[mt][4 * g4 + 3];
                *(f32x4*)(xout + (long)tok * DM + f) = o;
            }
    }
};

struct EpiKV {
    bf16_t *KC, *KS, *VST, *KW, *VWT;
    const float* kgain;
    DI void operator()(const f32x16 (&acc)[4], int tok, int fbase, int h, unsigned char*, int) const {
        const int c = fbase >> 7, br = c >> 2, kv = (c >> 1) & 1, g = c & 1, b = tok >> 13, s = tok & (SEQ - 1);
        if (br == 0 || kv == 0) {
            float rstd = 1.f;
            bf16_t* row;
            if (br == 0) row = KC + ((long)((kv * 4 + b) * 2 + g) * SEQ + s) * 128;
            else {
                float ss = 0.f;
#pragma unroll
                for (int mt = 0; mt < 4; ++mt)
#pragma unroll
                    for (int rg = 0; rg < 16; ++rg) ss += acc[mt][rg] * acc[mt][rg];
                ss += __shfl_xor(ss, 32);
                rstd = rsqrtf(ss * (1.f / 128.f) + EPS);
                row = (br == 1 ? KS : KW) + ((long)(b * 2 + g) * SEQ + s) * 128;
            }
#pragma unroll
            for (int mt = 0; mt < 4; ++mt)
#pragma unroll
                for (int g4 = 0; g4 < 4; ++g4) {
                    const int d0 = 32 * mt + 8 * g4 + 4 * h;
                    f32x4 gv = {1.f, 1.f, 1.f, 1.f};
                    if (br != 0) gv = *(const f32x4*)(kgain + br * 128 + d0);
                    u32x2 o;
                    o.x = pk2(acc[mt][4 * g4 + 0] * rstd * gv.x, acc[mt][4 * g4 + 1] * rstd * gv.y);
                    o.y = pk2(acc[mt][4 * g4 + 2] * rstd * gv.z, acc[mt][4 * g4 + 3] * rstd * gv.w);
                    *(u32x2*)(row + d0) = o;
                }
        } else {
            bf16_t* base = (br == 1 ? VST : VWT) + (long)(b * 2 + g) * 128 * SEQ + s;
#pragma unroll
            for (int mt = 0; mt < 4; ++mt)
#pragma unroll
                for (int rg = 0; rg < 16; ++rg) base[(long)(32 * mt + crow(rg, h)) * SEQ] = f2bf(acc[mt][rg]);
        }
    }
};

struct EpiCmp1 {
    bf16_t* hid; const float* posb_part; const float* b1;
    DI void operator()(const f32x16 (&acc)[4], int tok, int fbase, int h, unsigned char*, int) const {
        if (tok >= 512) return;
#pragma unroll
        for (int mt = 0; mt < 4; ++mt)
#pragma unroll
            for (int g4 = 0; g4 < 4; ++g4) {
                const int f = fbase + 32 * mt + 8 * g4 + 4 * h;
                f32x4 pb = *(const f32x4*)(b1 + f);
                for (int c = 0; c < 16; ++c) { const f32x4 t = *(const f32x4*)(posb_part + c * 256 + f); pb.x += t.x; pb.y += t.y; pb.z += t.z; pb.w += t.w; }
                u32x2 o;
                o.x = pk2(gelu_tanh(acc[mt][4 * g4 + 0] + pb.x), gelu_tanh(acc[mt][4 * g4 + 1] + pb.y));
                o.y = pk2(gelu_tanh(acc[mt][4 * g4 + 2] + pb.z), gelu_tanh(acc[mt][4 * g4 + 3] + pb.w));
                *(u32x2*)(hid + (long)tok * 256 + f) = o;
            }
    }
};

struct EpiCmp2 {
    bf16_t* dst; const float* kgain0; int kv;
    DI void operator()(const f32x16 (&acc)[4], int tok, int fbase, int h, unsigned char*, int) const {
        if (fbase != 0 || tok >= 512) return;
        const float valid = tok < 511 ? 1.f : 0.f;
        if (kv == 0) {
            float ss = 0.f;
#pragma unroll
            for (int mt = 0; mt < 4; ++mt)
#pragma unroll
                for (int rg = 0; rg < 16; ++rg) ss += acc[mt][rg] * acc[mt][rg];
            ss += __shfl_xor(ss, 32);
            const float rstd = rsqrtf(ss * (1.f / 128.f) + EPS) * valid;
#pragma unroll
            for (int mt = 0; mt < 4; ++mt)
#pragma unroll
                for (int g4 = 0; g4 < 4; ++g4) {
                    const int d0 = 32 * mt + 8 * g4 + 4 * h;
                    const f32x4 gv = *(const f32x4*)(kgain0 + d0);
                    u32x2 o;
                    o.x = pk2(acc[mt][4 * g4 + 0] * rstd * gv.x, acc[mt][4 * g4 + 1] * rstd * gv.y);
                    o.y = pk2(acc[mt][4 * g4 + 2] * rstd * gv.z, acc[mt][4 * g4 + 3] * rstd * gv.w);
                    *(u32x2*)(dst + (long)tok * 128 + d0) = o;
                }
        } else {
#pragma unroll
            for (int mt = 0; mt < 4; ++mt)
#pragma unroll
                for (int rg = 0; rg < 16; ++rg) dst[(long)(32 * mt + crow(rg, h)) * 512 + tok] = f2bf(acc[mt][rg] * valid);
        }
    }
};

struct EpiNsaQ {
    bf16_t* QN; float* gates; const float* qgain; const float* bgate;
    DI void operator()(const f32x16 (&acc)[4], int tok, int fbase, int h, unsigned char*, int) const {
        const int b = tok >> 13, s = tok & (SEQ - 1);
        if (fbase < 1024) {
            const int head = fbase >> 7;
            float ss = 0.f;
#pragma unroll
            for (int mt = 0; mt < 4; ++mt)
#pragma unroll
                for (int rg = 0; rg < 16; ++rg) ss += acc[mt][rg] * acc[mt][rg];
            ss += __shfl_xor(ss, 32);
            const float rstd = rsqrtf(ss * (1.f / 128.f) + EPS) * (0.08838834764831845f * LOG2E);
            bf16_t* row = QN + ((long)(b * 8 + head) * SEQ + s) * 128;
#pragma unroll
            for (int mt = 0; mt < 4; ++mt)
#pragma unroll
                for (int g4 = 0; g4 < 4; ++g4) {
                    const int d0 = 32 * mt + 8 * g4 + 4 * h;
                    const f32x4 gv = *(const f32x4*)(qgain + d0);
                    u32x2 o;
                    o.x = pk2(acc[mt][4 * g4 + 0] * rstd * gv.x, acc[mt][4 * g4 + 1] * rstd * gv.y);
                    o.y = pk2(acc[mt][4 * g4 + 2] * rstd * gv.z, acc[mt][4 * g4 + 3] * rstd * gv.w);
                    *(u32x2*)(row + d0) = o;
                }
        } else if (fbase == 1024) {
#pragma unroll
            for (int rg = 0; rg < 16; ++rg) {
                const int f = crow(rg, h);
                if (f < 24) { const float z = acc[0][rg] + bgate[f]; gates[(long)tok * 24 + f] = frcp(1.f + fexp2(-LOG2E * z)); }
            }
        }
    }
};

struct EpiPeer {
    int* ridx; float* rgate;
    DI void operator()(const f32x16 (&acc)[4], int tok, int fbase, int h, unsigned char* lds, int tid) const {
        const int lane = tid & 63, w = tid >> 6, tg = w & 3, fh = w >> 2, r = lane & 31;
        const int hd = fbase >> 8;
        unsigned* EX = (unsigned*)(lds + EPI_LDS);
        unsigned L[16];
#pragma unroll
        for (int i = 0; i < 16; ++i) L[i] = 0u;
#pragma unroll
        for (int mt = 0; mt < 4; ++mt)
#pragma unroll
            for (int rg = 0; rg < 16; ++rg) {
                const int kidx = 32 * mt + crow(rg, h);
                unsigned x = (f2key(acc[mt][rg]) & ~127u) | (unsigned)(127 - kidx);
#pragma unroll
                for (int i = 0; i < 16; ++i) { const unsigned t = L[i] > x ? L[i] : x; x = L[i] > x ? x : L[i]; L[i] = t; }
            }
        {
            unsigned P[16];
#pragma unroll
            for (int i = 0; i < 16; ++i) P[i] = (unsigned)__shfl_xor((int)L[i], 32);
#pragma unroll
            for (int i = 0; i < 16; ++i) L[i] = L[i] > P[15 - i] ? L[i] : P[15 - i];
#pragma unroll
            for (int st = 8; st >= 1; st >>= 1)
#pragma unroll
                for (int i = 0; i < 16; ++i)
                    if ((i & st) == 0) { const unsigned a = L[i], b2 = L[i + st]; L[i] = a > b2 ? a : b2; L[i + st] = a > b2 ? b2 : a; }
        }
        if (h == 0) {
#pragma unroll
            for (int i = 0; i < 16; i += 4) *(u32x4*)(EX + ((fh * 4 + tg) * 32 + r) * 16 + i) = (u32x4){L[i], L[i + 1], L[i + 2], L[i + 3]};
        }
        __syncthreads();
        unsigned X[16], Y[16];
        {
            const unsigned* l0 = EX + ((0 * 4 + tg) * 32 + r) * 16;
            const unsigned* l1 = EX + ((1 * 4 + tg) * 32 + r) * 16;
            const unsigned* px = h ? l1 : l0;
            const unsigned* py = h ? l0 : l1;
#pragma unroll
            for (int i = 0; i < 16; i += 4) {
                const u32x4 a = *(const u32x4*)(px + i), b2 = *(const u32x4*)(py + i);
                X[i] = a.x; X[i + 1] = a.y; X[i + 2] = a.z; X[i + 3] = a.w;
                Y[i] = b2.x; Y[i + 1] = b2.y; Y[i + 2] = b2.z; Y[i + 3] = b2.w;
            }
        }
        unsigned T[16];
#pragma unroll
        for (int i = 0; i < 16; ++i) T[i] = 0u;
#pragma unroll
        for (int i = 0; i < 16; ++i)
#pragma unroll
            for (int j = i; j < 16; ++j) {
                if ((i + 1) * (j + 1) > 16) continue;
                const float fs = key2f(X[i] & ~127u) + key2f(Y[j] & ~127u);
                const unsigned code = h ? (unsigned)((j << 4) | i) : (unsigned)((i << 4) | j);
                unsigned x = (f2key(fs) & ~255u) | (255u - code);
                if (i == j) x = h ? 0u : x;
#pragma unroll
                for (int k = 0; k < 16; ++k) { const unsigned t = T[k] > x ? T[k] : x; x = T[k] > x ? x : T[k]; T[k] = t; }
            }
        {
            unsigned P[16];
#pragma unroll
            for (int i = 0; i < 16; ++i) P[i] = (unsigned)__shfl_xor((int)T[i], 32);
#pragma unroll
            for (int i = 0; i < 16; ++i) T[i] = T[i] > P[15 - i] ? T[i] : P[15 - i];
#pragma unroll
            for (int st = 8; st >= 1; st >>= 1)
#pragma unroll
                for (int i = 0; i < 16; ++i)
                    if ((i & st) == 0) { const unsigned a = T[i], b2 = T[i + st]; T[i] = a > b2 ? a : b2; T[i + st] = a > b2 ? b2 : a; }
        }
        float sc[16], sum = 0.f;
        const float mx = key2f(T[0] & ~255u);
#pragma unroll
        for (int k = 0; k < 16; ++k) { sc[k] = fexp2((key2f(T[k] & ~255u) - mx) * LOG2E); sum += sc[k]; }
        const float inv = frcp(sum);
        if (h == 0) {
            const unsigned* l0 = EX + ((0 * 4 + tg) * 32 + r) * 16;
            const unsigned* l1 = EX + ((1 * 4 + tg) * 32 + r) * 16;
#pragma unroll
            for (int k = 0; k < 16; ++k) {
                if ((k >> 3) != fh) continue;
                const unsigned code = 255u - (T[k] & 255u);
                const int i1 = 127 - (int)(l0[code >> 4] & 127u), i2 = 127 - (int)(l1[code & 15u] & 127u);
                ridx[(long)tok * 128 + hd * 16 + k] = i1 * 128 + i2;
                rgate[(long)tok * 128 + hd * 16 + k] = sc[k] * inv;
            }
        }
        __syncthreads();
    }
};

DI void p0_transpose_item(const float* __restrict__ W, int K, int N, bf16_t* __restrict__ WT, int item, int ntn, unsigned char* lds, int tid) {
    float* tile = (float*)lds;
    const int kb = item / ntn, nb = item % ntn, k0 = kb * 64, n0 = nb * 64;
    {
        const int nn = tid & 63, kk0 = tid >> 6;
#pragma unroll
        for (int i = 0; i < 8; ++i) { const int kk = kk0 + 8 * i; const int n = n0 + nn; tile[kk * 65 + nn] = n < N ? W[(long)(k0 + kk) * N + n] : 0.f; }
    }
    __syncthreads();
    {
        const int n = tid >> 3, c = tid & 7;
        const float* s = tile + (8 * c) * 65 + n;
        u32x4 o;
        o.x = pk2(s[0], s[65]); o.y = pk2(s[2 * 65], s[3 * 65]); o.z = pk2(s[4 * 65], s[5 * 65]); o.w = pk2(s[6 * 65], s[7 * 65]);
        *(u32x4*)(WT + (long)(n0 + n) * K + k0 + 8 * c) = o;
    }
    __syncthreads();
}

DI void p0_convert_item(const float* __restrict__ src, bf16_t* __restrict__ dst, int item, int tid) {
    const long base = (long)item * 16384;
#pragma unroll
    for (int i = 0; i < 4; ++i) {
        const long e = base + (long)(i * 512 + tid) * 8;
        const f32x4 a = *(const f32x4*)(src + e), b = *(const f32x4*)(src + e + 4);
        u32x4 o; o.x = pk2(a.x, a.y); o.y = pk2(a.z, a.w); o.z = pk2(b.x, b.y); o.w = pk2(b.z, b.w);
        *(u32x4*)(dst + e) = o;
    }
}

DI void p0_weff_item(const float* __restrict__ wq, const float* __restrict__ subk, bf16_t* __restrict__ WT, int item, unsigned char* lds, int tid) {
    const int layer = item >> 8, g = (item >> 4) & 15, ct = item & 15, p = g & 1, c0 = ct * 64;
    float* As = (float*)lds;
    float* Bs = As + 64 * 129;
    const float* wql = wq + (long)layer * 1024 * 2048;
    const float* sk = subk + ((long)layer * 2 + p) * 128 * 128;
    for (int e = tid; e < 64 * 128; e += NTHREADS) { const int c = e >> 7, d = e & 127; As[c * 129 + d] = wql[(long)(c0 + c) * 2048 + g * 128 + d]; }
    for (int e = tid; e < 128 * 128; e += NTHREADS) { const int k = e >> 7, d = e & 127; Bs[k * 129 + d] = sk[k * 128 + d]; }
    __syncthreads();
    const int k = tid & 127, cg4 = tid >> 7;
    float acc[16];
#pragma unroll
    for (int i = 0; i < 16; ++i) acc[i] = 0.f;
    for (int d = 0; d < 128; ++d) {
        const float bv = Bs[k * 129 + d];
#pragma unroll
        for (int i = 0; i < 16; ++i) acc[i] += As[(cg4 * 16 + i) * 129 + d] * bv;
    }
    bf16_t* o = WT + ((long)layer * 2048 + g * 128 + k) * 1024 + c0 + cg4 * 16;
    u32x4 o0, o1;
    o0.x = pk2(acc[0], acc[1]); o0.y = pk2(acc[2], acc[3]); o0.z = pk2(acc[4], acc[5]); o0.w = pk2(acc[6], acc[7]);
    o1.x = pk2(acc[8], acc[9]); o1.y = pk2(acc[10], acc[11]); o1.z = pk2(acc[12], acc[13]); o1.w = pk2(acc[14], acc[15]);
    *(u32x4*)o = o0; *(u32x4*)(o + 8) = o1;
    __syncthreads();
}

DI void p0_posb_item(const float* __restrict__ pos, const float* __restrict__ w1, float* __restrict__ part, int item, unsigned char* lds, int tid) {
    const int kv = item >> 4, ch = item & 15;
    float* red = (float*)lds;
    const int j = tid & 255, half = tid >> 8;
    const float* pp = pos + (long)kv * 4096 + ch * 256 + half * 128;
    const float* ww = w1 + ((long)kv * 4096 + ch * 256 + half * 128) * 256 + j;
    float a = 0.f;
    for (int f = 0; f < 128; ++f) a += pp[f] * ww[(long)f * 256];
    red[half * 256 + j] = a;
    __syncthreads();
    if (tid < 256) part[(kv * 16 + ch) * 256 + tid] = red[tid] + red[256 + tid];
    __syncthreads();
}

DI void p0_ada_item(const Params& p, float* __restrict__ ada, int item, unsigned char* lds, int tid) {
    float* cact = (float*)lds;
    float* red = cact + 4096;
    const float* c = p.in[1];
    for (int e = tid; e < 4096; e += NTHREADS) { const float v = c[e]; cact[e] = v * frcp(1.f + fexp2(-LOG2E * v)); }
    __syncthreads();
    const int colg = item * 64;
    const float* W; const float* bias; int N, n0;
    if (colg < 6144) { W = p.in[3]; bias = p.in[4]; N = 6144; n0 = colg; }
    else if (colg < 12288) { W = p.in[3] + (long)1024 * 6144; bias = p.in[4] + 6144; N = 6144; n0 = colg - 6144; }
    else { W = p.in[14]; bias = p.in[15]; N = 2048; n0 = colg - 12288; }
    const int col = tid & 63, kg = tid >> 6;
    float a0 = 0.f, a1 = 0.f, a2 = 0.f, a3 = 0.f;
    const float* wp = W + (long)(kg * 128) * N + n0 + col;
#pragma unroll 8
    for (int k = 0; k < 128; ++k) {
        const float wv = wp[(long)k * N];
        const int kk = kg * 128 + k;
        a0 += cact[kk] * wv; a1 += cact[1024 + kk] * wv; a2 += cact[2048 + kk] * wv; a3 += cact[3072 + kk] * wv;
    }
    red[(kg * 4 + 0) * 64 + col] = a0; red[(kg * 4 + 1) * 64 + col] = a1; red[(kg * 4 + 2) * 64 + col] = a2; red[(kg * 4 + 3) * 64 + col] = a3;
    __syncthreads();
    if (tid < 256) {
        const int b = tid >> 6, cc = tid & 63;
        float s = bias[n0 + cc];
#pragma unroll
        for (int q = 0; q < 8; ++q) s += red[(q * 4 + b) * 64 + cc];
        ada[b * ADA_STRIDE + colg + cc] = s;
    }
    __syncthreads();
}

constexpr int P0_CONV = 4096, P0_TR_DIN = 768, P0_TR_DOUT = 256, P0_TR_KV = 384, P0_TR_NIN = 288, P0_TR_NOUT = 256, P0_TR_C1 = 512, P0_TR_C2 = 16,
              P0_WEFF = 512, P0_POSB = 32, P0_ADA = 224;
constexpr int P0_TOTAL = P0_CONV + P0_TR_DIN + P0_TR_DOUT + P0_TR_KV + P0_TR_NIN + P0_TR_NOUT + P0_TR_C1 + P0_TR_C2 + P0_WEFF + P0_POSB + P0_ADA;

DI void phase_prep(const Params& p, unsigned char* lds, int tid) {
    unsigned char* ws = p.ws;
    for (int it = blockIdx.x; it < P0_TOTAL; it += gridDim.x) {
        int r = it;
        if (r < P0_ADA) { p0_ada_item(p, (float*)(ws + OFF_ADA), r, lds, tid); continue; } r -= P0_ADA;
        if (r < P0_WEFF) { p0_weff_item(p.in[26], p.in[27], (bf16_t*)(ws + OFF_WT_PEER), r, lds, tid); continue; } r -= P0_WEFF;
        if (r < P0_POSB) { p0_posb_item(p.in[17], p.in[18], (float*)(ws + OFF_POSB), r, lds, tid); continue; } r -= P0_POSB;
        if (r < P0_TR_DIN) { p0_transpose_item(p.in[7], 1024, 3072, (bf16_t*)(ws + OFF_WT_DIN), r, 48, lds, tid); continue; } r -= P0_TR_DIN;
        if (r < P0_TR_DOUT) { p0_transpose_item(p.in[8], 1024, 1024, (bf16_t*)(ws + OFF_WT_DOUT), r, 16, lds, tid); continue; } r -= P0_TR_DOUT;
        if (r < P0_TR_KV) { p0_transpose_item(p.in[16], 1024, 1536, (bf16_t*)(ws + OFF_WT_KV), r, 24, lds, tid); continue; } r -= P0_TR_KV;
        if (r < P0_TR_NIN) { p0_transpose_item(p.in[22], 1024, 1048, (bf16_t*)(ws + OFF_WT_NIN), r, 18, lds, tid); continue; } r -= P0_TR_NIN;
        if (r < P0_TR_NOUT) { p0_transpose_item(p.in[24], 1024, 1024, (bf16_t*)(ws + OFF_WT_NOUT), r, 16, lds, tid); continue; } r -= P0_TR_NOUT;
        if (r < P0_TR_C1) { const int kv = r >> 8; p0_transpose_item(p.in[18] + (long)kv * 4096 * 256, 4096, 256, (bf16_t*)(ws + OFF_WT_C1) + (long)kv * 256 * 4096, r & 255, 4, lds, tid); continue; } r -= P0_TR_C1;
        if (r < P0_TR_C2) { const int kv = r >> 3; p0_transpose_item(p.in[20] + (long)kv * 256 * 128, 256, 128, (bf16_t*)(ws + OFF_WT_C2) + (long)kv * 128 * 256, r & 7, 2, lds, tid); continue; } r -= P0_TR_C2;
        {
            const int tbl = r >> 10, sub = r & 1023;
            const float* src = (tbl < 2 ? p.in[28] : p.in[29]) + (long)(tbl & 1) * 16384 * 1024;
            bf16_t* dst = (bf16_t*)(ws + (tbl < 2 ? OFF_PU : OFF_PV)) + (long)(tbl & 1) * 16384 * 1024;
            p0_convert_item(src, dst, sub, tid);
        }
    }
}

DI void norm_row_write(const f32x4 (&v)[4], float rstd, const float* gain, const float* shift, const float* scale, bf16_t* orow, int lane) {
#pragma unroll
    for (int j = 0; j < 4; ++j) {
        const int c = 4 * lane + 256 * j;
        const f32x4 g = *(const f32x4*)(gain + c), sh = *(const f32x4*)(shift + c), sc = *(const f32x4*)(scale + c);
        u32x2 o;
        o.x = pk2(v[j].x * rstd * g.x * (1.f + sc.x) + sh.x, v[j].y * rstd * g.y * (1.f + sc.y) + sh.y);
        o.y = pk2(v[j].z * rstd * g.z * (1.f + sc.z) + sh.z, v[j].w * rstd * g.w * (1.f + sc.w) + sh.w);
        *(u32x2*)(orow + c) = o;
    }
}
DI void phase_norm(const float* __restrict__ x, bf16_t* __restrict__ out, const float* gain, const float* ada, int shift_off, int scale_off, int tid) {
    const int lane = tid & 63, gw = blockIdx.x * NWAVES + (tid >> 6), nw = gridDim.x * NWAVES;
    for (int tok = gw; tok < NTOK; tok += nw) {
        const int b = tok >> 13;
        f32x4 v[4]; float ss = 0.f;
#pragma unroll
        for (int j = 0; j < 4; ++j) { v[j] = *(const f32x4*)(x + (long)tok * DM + 4 * lane + 256 * j); ss += v[j].x * v[j].x + v[j].y * v[j].y + v[j].z * v[j].z + v[j].w * v[j].w; }
        const float rstd = rsqrtf(wave_sum(ss) * (1.f / DM) + EPS);
        norm_row_write(v, rstd, gain, ada + b * ADA_STRIDE + shift_off, ada + b * ADA_STRIDE + scale_off, out + (long)tok * DM, lane);
    }
}

DI int kidx(int mt, int i) { return 32 * mt + 16 * (i >> 3) + (i & 7); }
template <int DQK>
DI void attn_qk32(const unsigned char* Ks, const bf16x8 (&qf)[DQK / 16], f32x16& st, int mt, int r, int h) {
    constexpr int RB = DQK * 2, MSK = DQK == 64 ? 7 : 15;
    const int row = 32 * mt + ((r & 0x13) | ((r & 4) << 1) | ((r & 8) >> 1));
    const unsigned char* kr = Ks + row * RB;
#pragma unroll
    for (int i = 0; i < 16; ++i) st[i] = 0.f;
#pragma unroll
    for (int ks = 0; ks < DQK / 16; ++ks) {
        const bf16x8 kf = *(const bf16x8*)(kr + (((2 * ks + h) ^ (row & MSK)) << 4));
        st = MFMA32(kf, qf[ks], st);
    }
}
DI void attn_pack32(const f32x16& st, bf16x8 (&pf)[2]) {
#pragma unroll
    for (int s = 0; s < 2; ++s) {
        u32x4 t;
        t.x = pk2(st[8 * s + 0], st[8 * s + 1]); t.y = pk2(st[8 * s + 2], st[8 * s + 3]);
        t.z = pk2(st[8 * s + 4], st[8 * s + 5]); t.w = pk2(st[8 * s + 6], st[8 * s + 7]);
        pf[s] = __builtin_bit_cast(bf16x8, t);
    }
}
DI void attn_softmax32(f32x16& st, float& m, float& l, f32x16 (&o)[4]) {
    float mx = st[0];
#pragma unroll
    for (int i = 1; i < 16; ++i) mx = fmaxf(mx, st[i]);
    mx = fmaxf(mx, __shfl_xor(mx, 32));
    const float mn = fmaxf(m, mx);
    if (!__all(mn == m)) {
        const float alpha = fexp2(m - mn);
        l *= alpha;
#pragma unroll
        for (int dt = 0; dt < 4; ++dt)
#pragma unroll
            for (int i = 0; i < 16; ++i) o[dt][i] *= alpha;
        m = mn;
    }
    float sum = 0.f;
#pragma unroll
    for (int i = 0; i < 16; ++i) { const float pv = fexp2(st[i] - m); st[i] = pv; sum += pv; }
    l += sum;
}
DI void attn_pv32(const unsigned char* Vs, const bf16x8 (&pf)[2], f32x16 (&o)[4], int mt, int r, int h) {
#pragma unroll
    for (int dt = 0; dt < 4; ++dt)
#pragma unroll
        for (int s2 = 0; s2 < 2; ++s2) {
            const int row = 32 * dt + r;
            const bf16x8 vf = *(const bf16x8*)(Vs + row * 128 + (((2 * (2 * mt + s2) + h) ^ (row & 7)) << 4));
            o[dt] = MFMA32(vf, pf[s2], o[dt]);
        }
}
template <int RB, int NROWS>
DI void dma_offsets(unsigned (&off)[NROWS * RB / 16 / 512], unsigned gstride, int tid) {
    constexpr int CPR = RB / 16;
#pragma unroll
    for (int i = 0; i < NROWS * CPR / 512; ++i) {
        const int idx = tid + 512 * i, row = idx / CPR, cp = idx % CPR;
        off[i] = (unsigned)row * gstride + ((cp ^ (row & (CPR - 1))) << 4);
    }
}
template <int N>
DI void dma_issue(unsigned char* dst, const unsigned char* gbase, const unsigned (&off)[N], int tid) {
    const int wbase = tid & ~63;
#pragma unroll
    for (int i = 0; i < N; ++i)
        __builtin_amdgcn_global_load_lds((const unsigned*)(gbase + off[i]), (unsigned*)(dst + (wbase + 512 * i) * 16), 16, 0, 0);
}

constexpr int AT_STAGE = 32 * 1024;
constexpr int AT_LUT = 2 * AT_STAGE;
constexpr int LUT_N = 1280, LUT_OFF = 1100;
constexpr int LUTC_W = 52;
constexpr int AT_LUTC = AT_LUT + 20 * 1024;
constexpr int AT_IMP = AT_LUTC + 13 * 1024;
constexpr int AT_SEL = AT_IMP + 34 * 1024;

DI void phase_diff_attn(const Params& p, unsigned char* lds, int tid) {
    unsigned char* ws = p.ws;
    const bf16_t* Q = (const bf16_t*)(ws + OFF_Q0);
    const bf16_t* Kk = (const bf16_t*)(ws + OFF_K0);
    const bf16_t* VT = (const bf16_t*)(ws + OFF_VT0);
    bf16_t* O = (bf16_t*)(ws + OFF_H);
    const float* relb = p.in[2];
    const float* lam = p.in[9];
    const float* subln = p.in[12];
    const int lane = tid & 63, w = tid >> 6, comp = w & 1, qg = w >> 1, r = lane & 31, h = lane >> 5;
    float* lut = (float*)(lds + AT_LUT);
    float lam_full;
    {
        float s01 = 0.f, s23 = 0.f;
        for (int i = 0; i < 64; ++i) { s01 += lam[i] * lam[64 + i]; s23 += lam[128 + i] * lam[192 + i]; }
        lam_full = __expf(s01) - __expf(s23) + 0.2f;
    }
    const int G = gridDim.x, rows_per_it = G >> 5;
    unsigned koff[1], voff[2];
    dma_offsets<128, 64>(koff, 128, tid);
    dma_offsets<128, 128>(voff, SEQ * 2, tid);
    for (int it = 0;; ++it) {
        int u;
        if ((G & 31) == 0) {
            const int rr = blockIdx.x >> 5, cc = blockIdx.x & 31;
            const int rowi = it * rows_per_it + ((it & 1) ? rows_per_it - 1 - rr : rr);
            u = rowi * 32 + cc;
        } else u = it * G + blockIdx.x;
        if (u >= 2048) break;
        const int qb = 63 - (u >> 5), b = (u & 31) >> 3, hd = u & 7;
        const int q0 = qb * 128, ntiles = 2 * qb + 2;
        const int qpos = q0 + 32 * qg + r, qlo = q0 + 32 * qg, qhi = qlo + 31;
        for (int e = tid; e < LUT_N; e += NTHREADS) { const int d = LUT_OFF - e; lut[e] = d < 0 ? -INFINITY : (d >= 790 ? 0.f : (relb[rel_bucket_i(d) * 8 + hd] - relb[31 * 8 + hd]) * LOG2E); }
        bf16x8 qf[4];
        {
            const bf16_t* qrow = Q + ((long)((b * 8 + hd) * 2 + comp) * SEQ + qpos) * 64;
#pragma unroll
            for (int ks = 0; ks < 4; ++ks) qf[ks] = *(const bf16x8*)(qrow + 16 * ks + 8 * h);
        }
        const unsigned char* k0g = (const unsigned char*)(Kk + (long)((b * 8 + hd) * 2 + 0) * SEQ * 64);
        const unsigned char* k1g = (const unsigned char*)(Kk + (long)((b * 8 + hd) * 2 + 1) * SEQ * 64);
        const unsigned char* vtg = (const unsigned char*)(VT + (long)(b * 8 + hd) * 128 * SEQ);
        f32x16 o[4];
#pragma unroll
        for (int dt = 0; dt < 4; ++dt)
#pragma unroll
            for (int i = 0; i < 16; ++i) o[dt][i] = 0.f;
        float m = -1e30f, l = 0.f;
        auto stage = [&](int kt, unsigned char* st) {
            dma_issue(st, k0g + (long)kt * 8192, koff, tid);
            dma_issue(st + 8192, k1g + (long)kt * 8192, koff, tid);
            dma_issue(st + 16384, vtg + (long)kt * 128, voff, tid);
        };
        stage(0, lds);
        __syncthreads();
        for (int kt = 0; kt < ntiles; ++kt) {
            unsigned char* cur = lds + (kt & 1) * AT_STAGE;
            if (kt + 1 < ntiles) stage(kt + 1, lds + ((kt + 1) & 1) * AT_STAGE);
            const int k0 = kt * 64;
            const bool nearb = qlo - (k0 + 63) < 790;
            const int dbase = qpos - k0 - 8 * h;
            const float* lp = lut + (LUT_OFF - dbase);
#pragma unroll
            for (int mt = 0; mt < 2; ++mt) {
                if (k0 + 32 * mt <= qhi) {
                    f32x16 st;
                    attn_qk32<64>(cur + comp * 8192, qf, st, mt, r, h);
                    if (nearb) {
#pragma unroll
                        for (int i = 0; i < 16; ++i) st[i] += lp[kidx(mt, i)];
                    }
                    attn_softmax32(st, m, l, o);
                    bf16x8 pf[2];
                    attn_pack32(st, pf);
                    attn_pv32(cur + 16384, pf, o, mt, r, h);
                }
            }
            __syncthreads();
        }
        l += __shfl_xor(l, 32);
        const float inv = l > 0.f ? frcp(l) : 0.f;
        float* xch = (float*)lds + qg * 4096;
        if (comp == 1) {
            const float sc = inv * lam_full;
#pragma unroll
            for (int dt = 0; dt < 4; ++dt)
#pragma unroll
                for (int i = 0; i < 16; ++i) xch[(dt * 16 + i) * 64 + lane] = o[dt][i] * sc;
        }
        __syncthreads();
        if (comp == 0) {
            float ss = 0.f;
#pragma unroll
            for (int dt = 0; dt < 4; ++dt)
#pragma unroll
                for (int i = 0; i < 16; ++i) { const float v = o[dt][i] * inv - xch[(dt * 16 + i) * 64 + lane]; o[dt][i] = v; ss += v * v; }
            ss += __shfl_xor(ss, 32);
            const float rstd = rsqrtf(ss * (1.f / 128.f) + EPS) * 0.8f;
            bf16_t* orow = O + (long)(b * SEQ + qpos) * DM + hd * 128;
#pragma unroll
            for (int dt = 0; dt < 4; ++dt)
#pragma unroll
                for (int g4 = 0; g4 < 4; ++g4) {
                    const int d0 = 32 * dt + 8 * g4 + 4 * h;
                    const f32x4 gv = *(const f32x4*)(subln + d0);
                    u32x2 ov;
                    ov.x = pk2(o[dt][4 * g4 + 0] * rstd * gv.x, o[dt][4 * g4 + 1] * rstd * gv.y);
                    ov.y = pk2(o[dt][4 * g4 + 2] * rstd * gv.z, o[dt][4 * g4 + 3] * rstd * gv.w);
                    *(u32x2*)(orow + d0) = ov;
                }
        }
        __syncthreads();
    }
}

DI void phase_nsa_attn(const Params& p, unsigned char* lds, int tid) {
    unsigned char* ws = p.ws;
    const bf16_t* QN = (const bf16_t*)(ws + OFF_QN);
    const bf16_t* KS = (const bf16_t*)(ws + OFF_KS);
    const bf16_t* VST = (const bf16_t*)(ws + OFF_VST);
    const bf16_t* KW = (const bf16_t*)(ws + OFF_KW);
    const bf16_t* VWT = (const bf16_t*)(ws + OFF_VWT);
    const bf16_t* KCMP = (const bf16_t*)(ws + OFF_KCMP);
    const bf16_t* VCMPT = (const bf16_t*)(ws + OFF_VCMPT);
    const float* gates = (const float*)(ws + OFF_GATES);
    bf16_t* O = (bf16_t*)(ws + OFF_H);
    const float* relb = p.in[2];
    const int lane = tid & 63, w = tid >> 6, hg = w >> 1, th = w & 1, r = lane & 31, h = lane >> 5;
    float* lut = (float*)(lds + AT_LUT);
    float* lutc = (float*)(lds + AT_LUTC);
    float* imp = (float*)(lds + AT_IMP);
    unsigned* selw = (unsigned*)(lds + AT_SEL);
    unsigned short* sel16 = (unsigned short*)selw;
    const int G = gridDim.x, rows_per_it = G >> 3;
    unsigned koff[2], voffc[2], voffs[2];
    dma_offsets<256, 64>(koff, 256, tid);
    dma_offsets<128, 128>(voffc, 1024, tid);
    dma_offsets<128, 128>(voffs, SEQ * 2, tid);
    for (int it = 0;; ++it) {
        int u;
        if ((G & 7) == 0) {
            const int rr = blockIdx.x >> 3, cc = blockIdx.x & 7;
            const int rowi = it * rows_per_it + ((it & 1) ? rows_per_it - 1 - rr : rr);
            u = rowi * 8 + cc;
        } else u = it * G + blockIdx.x;
        if (u >= 1024) break;
        const int bi = 127 - (u >> 3), b = (u & 7) >> 1, g = u & 1, head = 4 * g + hg;
        const int tq = 64 * bi + 32 * th + r;
        const int tl = 32 * th + r;
        const long tok = (long)b * SEQ + tq;
        for (int e = tid; e < 4 * LUT_N; e += NTHREADS) { const int hh = e / LUT_N, d = LUT_OFF - (e % LUT_N); lut[e] = d < 0 ? -INFINITY : (d >= 790 ? 0.f : (relb[rel_bucket_i(d) * 8 + 4 * g + hh] - relb[31 * 8 + 4 * g + hh]) * LOG2E); }
        for (int e = tid; e < 4 * 16 * LUTC_W; e += NTHREADS) {
            const int hh = e / (16 * LUTC_W), ph = (e / LUTC_W) & 15, ci = e % LUTC_W, d = 16 * (ci - 1) + ph;
            lutc[e] = ci == 0 ? -INFINITY : (d >= 790 ? 0.f : (relb[rel_bucket_i(d) * 8 + 4 * g + hh] - relb[31 * 8 + 4 * g + hh]) * LOG2E);
        }
        for (int e = tid; e < 64 * 129; e += NTHREADS) imp[e] = 0.f;
        if (tid < 4) selw[256 + tid] = 0u;
        const float* mylut = lut + hg * LUT_N;
        bf16x8 qf[8];
        const bf16_t* qrow = QN + ((long)(b * 8 + head) * SEQ + tq) * 128 + 8 * h;
        auto load_q = [&]() {
#pragma unroll
            for (int ks = 0; ks < 8; ++ks) qf[ks] = *(const bf16x8*)(qrow + 16 * ks);
        };
        load_q();
        const float g_c = gates[tok * 24 + head * 3 + 0], g_s = gates[tok * 24 + head * 3 + 1], g_w = gates[tok * 24 + head * 3 + 2];
        bf16_t* orow = O + tok * DM + head * 128;
        auto stage = [&](const unsigned char* kg, const unsigned char* vg, const unsigned (&vo)[2], int kt, unsigned char* st) {
            dma_issue(st, kg + (long)kt * 16384, koff, tid);
            dma_issue(st + 16384, vg + (long)kt * 128, vo, tid);
        };
        f32x16 o[4];
        float m, l;
        auto reset = [&]() {
#pragma unroll
            for (int dt = 0; dt < 4; ++dt)
#pragma unroll
                for (int i = 0; i < 16; ++i) o[dt][i] = 0.f;
            m = -1e30f; l = 0.f;
        };
        const unsigned char* kcg = (const unsigned char*)(KCMP + (long)(b * 2 + g) * 512 * 128);
        const unsigned char* vcg = (const unsigned char*)(VCMPT + (long)(b * 2 + g) * 128 * 512);
        const int nct = ((4 * bi + 2) >> 6) + 1;
        m = -1e30f; l = 0.f;
        __syncthreads();
        {
            const int cb = (tq - 31) >> 4;
            const float* lc = lutc + (hg * 16 + ((tq - 31) & 15)) * LUTC_W + 1;
            stage(kcg, vcg, voffc, 0, lds);
            __syncthreads();
            for (int kt = 0; kt < nct; ++kt) {
                unsigned char* cur = lds + (kt & 1) * AT_STAGE;
                if (kt + 1 < nct) stage(kcg, vcg, voffc, kt + 1, lds + ((kt + 1) & 1) * AT_STAGE);
                const int cbase = cb - kt * 64 - 8 * h;
#pragma unroll
                for (int mt = 0; mt < 2; ++mt) {
                    f32x16 st;
                    attn_qk32<128>(cur, qf, st, mt, r, h);
#pragma unroll
                    for (int i = 0; i < 16; ++i) {
                        const int c = cbase - kidx(mt, i);
                        st[i] += lc[c < -1 ? -1 : (c > 50 ? 50 : c)];
                    }
                    float mx = st[0];
#pragma unroll
                    for (int i = 1; i < 16; ++i) mx = fmaxf(mx, st[i]);
                    mx = fmaxf(mx, __shfl_xor(mx, 32));
                    const float mn = fmaxf(m, mx);
                    l *= fexp2(m - mn); m = mn;
                    float sum = 0.f;
#pragma unroll
                    for (int i = 0; i < 16; ++i) sum += fexp2(st[i] - m);
                    l += sum;
                }
                __syncthreads();
            }
            const float lt = l + __shfl_xor(l, 32);
            const float invl = lt > 0.f ? frcp(lt) : 0.f;
#pragma unroll
            for (int dt = 0; dt < 4; ++dt)
#pragma unroll
                for (int i = 0; i < 16; ++i) o[dt][i] = 0.f;
            stage(kcg, vcg, voffc, 0, lds);
            __syncthreads();
            for (int kt = 0; kt < nct; ++kt) {
                unsigned char* cur = lds + (kt & 1) * AT_STAGE;
                if (kt + 1 < nct) stage(kcg, vcg, voffc, kt + 1, lds + ((kt + 1) & 1) * AT_STAGE);
                const int cbase = cb - kt * 64 - 8 * h;
                float* irow = imp + tl * 129 + kt * 16 + 2 * h;
#pragma unroll
                for (int mt = 0; mt < 2; ++mt) {
                    f32x16 st;
                    attn_qk32<128>(cur, qf, st, mt, r, h);
#pragma unroll
                    for (int i = 0; i < 16; ++i) {
                        const int c = cbase - kidx(mt, i);
                        st[i] = fexp2(st[i] + lc[c < -1 ? -1 : (c > 50 ? 50 : c)] - m) * invl;
                    }
#pragma unroll
                    for (int q4 = 0; q4 < 4; ++q4) {
                        const int jo = 8 * mt + 4 * (q4 >> 1) + (q4 & 1);
                        const float a = st[4 * q4] + st[4 * q4 + 1] + st[4 * q4 + 2] + 0.5f * st[4 * q4 + 3];
                        const float c2 = 0.5f * st[4 * q4 + 3];
                        atomicAdd(irow + jo, a);
                        if (kt * 16 + 2 * h + jo + 1 < 128) atomicAdd(irow + jo + 1, c2);
                    }
                    bf16x8 pf[2];
                    attn_pack32(st, pf);
                    attn_pv32(cur + 16384, pf, o, mt, r, h);
                }
                __syncthreads();
            }
        }
#pragma unroll
        for (int dt = 0; dt < 4; ++dt)
#pragma unroll
            for (int g4 = 0; g4 < 4; ++g4) {
                const int d0 = 32 * dt + 8 * g4 + 4 * h;
                u32x2 ov;
                ov.x = pk2(o[dt][4 * g4 + 0] * g_c, o[dt][4 * g4 + 1] * g_c);
                ov.y = pk2(o[dt][4 * g4 + 2] * g_c, o[dt][4 * g4 + 3] * g_c);
                *(u32x2*)(orow + d0) = ov;
            }
        {
            const int tkn = tid >> 3, part = tid & 7;
            float mine[16];
#pragma unroll
            for (int q = 0; q < 16; ++q) {
                const int j = part * 16 + q;
                float v = imp[tkn * 129 + j];
                const int back = bi - j;
                if (j == 0 || (back >= 0 && back < 2)) v = 1e9f;
                if (back < 0) v = -1e30f;
                mine[q] = v;
            }
            int rank[16];
#pragma unroll
            for (int q = 0; q < 16; ++q) rank[q] = 0;
#pragma unroll 2
            for (int jj = 0; jj < 128; ++jj) {
                float v = imp[tkn * 129 + jj];
                const int back = bi - jj;
                if (jj == 0 || (back >= 0 && back < 2)) v = 1e9f;
                if (back < 0) v = -1e30f;
#pragma unroll
                for (int q = 0; q < 16; ++q) {
                    const int j = part * 16 + q;
                    rank[q] += (v > mine[q] || (v == mine[q] && jj < j)) ? 1 : 0;
                }
            }
            unsigned bits = 0;
#pragma unroll
            for (int q = 0; q < 16; ++q) bits |= (rank[q] < 16 && mine[q] >= 0.f) ? (1u << q) : 0u;
            sel16[tkn * 8 + part] = (unsigned short)bits;
            atomicOr(&selw[256 + (part >> 1)], bits << ((part & 1) * 16));
        }
        __syncthreads();
        const unsigned sw0 = selw[tl * 4 + 0], sw1 = selw[tl * 4 + 1], sw2 = selw[tl * 4 + 2], sw3 = selw[tl * 4 + 3];
        const unsigned un0 = selw[256], un1 = selw[257], un2 = selw[258], un3 = selw[259];
        const unsigned char* ksg = (const unsigned char*)(KS + (long)(b * 2 + g) * SEQ * 128);
        const unsigned char* vsg = (const unsigned char*)(VST + (long)(b * 2 + g) * 128 * SEQ);
        reset(); load_q();
        {
            const unsigned long long ulo = ((unsigned long long)(unsigned)__builtin_amdgcn_readfirstlane((int)un1) << 32) | (unsigned)__builtin_amdgcn_readfirstlane((int)un0);
            const unsigned long long uhi = ((unsigned long long)(unsigned)__builtin_amdgcn_readfirstlane((int)un3) << 32) | (unsigned)__builtin_amdgcn_readfirstlane((int)un2);
            auto next_tile = [&](int from) -> int {
                if (from < 64) { const unsigned long long mk = ulo >> from; if (mk) return from + __builtin_ctzll(mk); from = 64; }
                if (from < 128) { const unsigned long long mk = uhi >> (from - 64); if (mk) return from + __builtin_ctzll(mk); }
                return 128;
            };
            int jt = next_tile(0);
            int buf = 0;
            if (jt < 128) stage(ksg, vsg, voffs, jt, lds);
            __syncthreads();
            while (jt < 128) {
                unsigned char* cur = lds + buf * AT_STAGE;
                const int jn = next_tile(jt + 1);
                if (jn < 128) stage(ksg, vsg, voffs, jn, lds + (buf ^ 1) * AT_STAGE);
                const unsigned wd = jt < 32 ? sw0 : (jt < 64 ? sw1 : (jt < 96 ? sw2 : sw3));
                const bool mysel = (wd >> (jt & 31)) & 1u;
                if (__any(mysel)) {
                    const int k0 = jt * 64;
                    const bool nearb = (64 * bi + 32 * th) - (k0 + 63) < 790;
                    const int dbase = tq - k0 - 8 * h;
                    const float* lp = mylut + (LUT_OFF - dbase);
#pragma unroll
                    for (int mt = 0; mt < 2; ++mt) {
                        f32x16 st;
                        attn_qk32<128>(cur, qf, st, mt, r, h);
                        if (nearb) {
#pragma unroll
                            for (int i = 0; i < 16; ++i) st[i] += lp[kidx(mt, i)];
                        }
                        if (!mysel) {
#pragma unroll
                            for (int i = 0; i < 16; ++i) st[i] = -INFINITY;
                        }
                        attn_softmax32(st, m, l, o);
                        bf16x8 pf[2];
                        attn_pack32(st, pf);
                        attn_pv32(cur + 16384, pf, o, mt, r, h);
                    }
                }
                __syncthreads();
                buf ^= 1; jt = jn;
            }
        }
        {
            const float lt = l + __shfl_xor(l, 32);
            const float sc = (lt > 0.f ? frcp(lt) : 0.f) * g_s;
#pragma unroll
            for (int dt = 0; dt < 4; ++dt)
#pragma unroll
                for (int g4 = 0; g4 < 4; ++g4) {
                    const int d0 = 32 * dt + 8 * g4 + 4 * h;
                    const u32x2 pv = *(const u32x2*)(orow + d0);
                    u32x2 ov;
                    ov.x = pk2(bflo(pv.x) + o[dt][4 * g4 + 0] * sc, bfhi(pv.x) + o[dt][4 * g4 + 1] * sc);
                    ov.y = pk2(bflo(pv.y) + o[dt][4 * g4 + 2] * sc, bfhi(pv.y) + o[dt][4 * g4 + 3] * sc);
                    *(u32x2*)(orow + d0) = ov;
                }
        }
        const unsigned char* kwg = (const unsigned char*)(KW + (long)(b * 2 + g) * SEQ * 128);
        const unsigned char* vwg = (const unsigned char*)(VWT + (long)(b * 2 + g) * 128 * SEQ);
        reset(); load_q();
        {
            const int j0 = bi >= 8 ? bi - 8 : 0, nt = bi - j0 + 1;
            stage(kwg, vwg, voffs, j0, lds);
            __syncthreads();
            for (int kt = 0; kt < nt; ++kt) {
                unsigned char* cur = lds + (kt & 1) * AT_STAGE;
                if (kt + 1 < nt) stage(kwg, vwg, voffs, j0 + kt + 1, lds + ((kt + 1) & 1) * AT_STAGE);
                const int k0 = (j0 + kt) * 64;
                const int dbase = tq - k0 - 8 * h;
                const float* lp = mylut + (LUT_OFF - dbase);
#pragma unroll
                for (int mt = 0; mt < 2; ++mt) {
                    f32x16 st;
                    attn_qk32<128>(cur, qf, st, mt, r, h);
#pragma unroll
                    for (int i = 0; i < 16; ++i) st[i] = kidx(mt, i) <= dbase - 512 ? -INFINITY : st[i] + lp[kidx(mt, i)];
                    attn_softmax32(st, m, l, o);
                    bf16x8 pf[2];
                    attn_pack32(st, pf);
                    attn_pv32(cur + 16384, pf, o, mt, r, h);
                }
                __syncthreads();
            }
        }
        {
            const float lt = l + __shfl_xor(l, 32);
            const float sc = (lt > 0.f ? frcp(lt) : 0.f) * g_w;
#pragma unroll
            for (int dt = 0; dt < 4; ++dt)
#pragma unroll
                for (int g4 = 0; g4 < 4; ++g4) {
                    const int d0 = 32 * dt + 8 * g4 + 4 * h;
                    const u32x2 pv = *(const u32x2*)(orow + d0);
                    u32x2 ov;
                    ov.x = pk2(bflo(pv.x) + o[dt][4 * g4 + 0] * sc, bfhi(pv.x) + o[dt][4 * g4 + 1] * sc);
                    ov.y = pk2(bflo(pv.y) + o[dt][4 * g4 + 2] * sc, bfhi(pv.y) + o[dt][4 * g4 + 3] * sc);
                    *(u32x2*)(orow + d0) = ov;
                }
        }
        __syncthreads();
    }
}

template <bool FUSE_NORM>
DI void phase_peer_experts(const Params& p, int layer, int tid) {
    unsigned char* ws = p.ws;
    const bf16_t* H = (const bf16_t*)(ws + OFF_H);
    const int* ridx = (const int*)(ws + OFF_RIDX);
    const float* rgate = (const float*)(ws + OFF_RGATE);
    const bf16_t* U = (const bf16_t*)(ws + OFF_PU) + (long)layer * 16384 * 1024;
    const bf16_t* V = (const bf16_t*)(ws + OFF_PV) + (long)layer * 16384 * 1024;
    const float* ada = (const float*)(ws + OFF_ADA);
    float* x = p.out;
    const int lane = tid & 63, gw = blockIdx.x * NWAVES + (tid >> 6), nw = gridDim.x * NWAVES;
    const int sub = lane & 15, grp = lane >> 4;
    for (int tok = gw; tok < NTOK; tok += nw) {
        const int b = tok >> 13;
        const int i0 = ridx[(long)tok * 128 + lane], i1 = ridx[(long)tok * 128 + 64 + lane];
        const float g0 = rgate[(long)tok * 128 + lane], g1 = rgate[(long)tok * 128 + 64 + lane];
        u32x4 hr[8];
#pragma unroll
        for (int t = 0; t < 8; ++t) hr[t] = *(const u32x4*)(H + (long)tok * DM + t * 128 + sub * 8);
        float w0 = 0.f, w1 = 0.f;
        auto uhalf = [&](int ireg, float& wreg) {
#pragma unroll 2
            for (int e4 = 0; e4 < 16; ++e4) {
                const int id = __shfl(ireg, 4 * e4 + grp);
                const bf16_t* urow = U + (long)id * 1024 + sub * 8;
                float a0 = 0.f, a1 = 0.f, a2 = 0.f, a3 = 0.f;
#pragma unroll
                for (int t = 0; t < 8; ++t) {
                    const u32x4 uv = *(const u32x4*)(urow + t * 128);
                    a0 = dot2bf(uv.x, hr[t].x, a0); a1 = dot2bf(uv.y, hr[t].y, a1); a2 = dot2bf(uv.z, hr[t].z, a2); a3 = dot2bf(uv.w, hr[t].w, a3);
                }
                float d = (a0 + a1) + (a2 + a3);
                d += __shfl_xor(d, 1); d += __shfl_xor(d, 2); d += __shfl_xor(d, 4); d += __shfl_xor(d, 8);
                const float act = gelu_tanh(d);
                const float bc = __shfl(act, 16 * (lane & 3));
                if ((lane >> 2) == e4) wreg = bc;
            }
        };
        uhalf(i0, w0); uhalf(i1, w1);
        w0 *= g0; w1 *= g1;
        float acc[16];
#pragma unroll
        for (int i = 0; i < 16; ++i) acc[i] = 0.f;
        auto vhalf = [&](int ireg, float wreg) {
#pragma unroll 4
            for (int e = 0; e < 64; ++e) {
                const int id = __builtin_amdgcn_readlane(ireg, e);
                const float wv = __builtin_bit_cast(float, __builtin_amdgcn_readlane(__builtin_bit_cast(int, wreg), e));
                const bf16_t* vrow = V + (long)id * 1024 + lane * 8;
                const u32x4 v0 = *(const u32x4*)(vrow), v1 = *(const u32x4*)(vrow + 512);
                acc[0] += wv * bflo(v0.x); acc[1] += wv * bfhi(v0.x); acc[2] += wv * bflo(v0.y); acc[3] += wv * bfhi(v0.y);
                acc[4] += wv * bflo(v0.z); acc[5] += wv * bfhi(v0.z); acc[6] += wv * bflo(v0.w); acc[7] += wv * bfhi(v0.w);
                acc[8] += wv * bflo(v1.x); acc[9] += wv * bfhi(v1.x); acc[10] += wv * bflo(v1.y); acc[11] += wv * bfhi(v1.y);
                acc[12] += wv * bflo(v1.z); acc[13] += wv * bfhi(v1.z); acc[14] += wv * bflo(v1.w); acc[15] += wv * bfhi(v1.w);
            }
        };
        vhalf(i0, w0); vhalf(i1, w1);
        const float* gf = ada + b * ADA_STRIDE + layer * 6144 + 5 * 1024;
        float* xr = x + (long)tok * DM;
        float nv[16]; float ss = 0.f;
#pragma unroll
        for (int hh = 0; hh < 2; ++hh)
#pragma unroll
            for (int q = 0; q < 2; ++q) {
                const int c = hh * 512 + lane * 8 + q * 4;
                const f32x4 xv = *(const f32x4*)(xr + c), gv = *(const f32x4*)(gf + c);
                f32x4 o;
                o.x = xv.x + gv.x * acc[hh * 8 + q * 4 + 0]; o.y = xv.y + gv.y * acc[hh * 8 + q * 4 + 1];
                o.z = xv.z + gv.z * acc[hh * 8 + q * 4 + 2]; o.w = xv.w + gv.w * acc[hh * 8 + q * 4 + 3];
                *(f32x4*)(xr + c) = o;
                nv[hh * 8 + q * 4 + 0] = o.x; nv[hh * 8 + q * 4 + 1] = o.y; nv[hh * 8 + q * 4 + 2] = o.z; nv[hh * 8 + q * 4 + 3] = o.w;
                ss += o.x * o.x + o.y * o.y + o.z * o.z + o.w * o.w;
            }
        if (FUSE_NORM) {
            const float rstd = rsqrtf(wave_sum(ss) * (1.f / DM) + EPS);
            bf16_t* h2 = (bf16_t*)(ws + OFF_H2) + (long)tok * DM;
            bf16_t* h1 = (bf16_t*)(ws + OFF_H) + (long)tok * DM;
            const float* kvn = p.in[13]; const float* nm1 = p.in[5] + 1024;
            const float* kvsh = ada + b * ADA_STRIDE + 12288; const float* kvsc = kvsh + 1024;
            const float* m1sh = ada + b * ADA_STRIDE + 6144; const float* m1sc = m1sh + 1024;
#pragma unroll
            for (int hh = 0; hh < 2; ++hh) {
                const int c = hh * 512 + lane * 8;
                u32x4 oa, ob;
                float ta[8], tb[8];
#pragma unroll
                for (int q = 0; q < 8; ++q) {
                    const float xn = nv[hh * 8 + q] * rstd;
                    ta[q] = xn * kvn[c + q] * (1.f + kvsc[c + q]) + kvsh[c + q];
                    tb[q] = xn * nm1[c + q] * (1.f + m1sc[c + q]) + m1sh[c + q];
                }
                oa.x = pk2(ta[0], ta[1]); oa.y = pk2(ta[2], ta[3]); oa.z = pk2(ta[4], ta[5]); oa.w = pk2(ta[6], ta[7]);
                ob.x = pk2(tb[0], tb[1]); ob.y = pk2(tb[2], tb[3]); ob.z = pk2(tb[4], tb[5]); ob.w = pk2(tb[6], tb[7]);
                *(u32x4*)(h2 + c) = oa; *(u32x4*)(h1 + c) = ob;
            }
        }
    }
}

template <class Epi>
DI void gemm_phase(const bf16_t* A, long lda, int M, const bf16_t* Bt, long ldb, int N, int K, const Epi& epi, unsigned char* lds, int tid) {
    const int ntm = (M + 127) / 128, ntn = (N + 255) / 256, nt = ntm * ntn;
    for (int t = blockIdx.x; t < nt; t += gridDim.x) {
        const int tn = t / ntm, tm = t % ntm;
        gemm_tile(A, lda, M, Bt, ldb, N, K, tm * 128, tn * 256, epi, lds, tid);
    }
}

DI int ftid() { int t = threadIdx.x; asm volatile("" : "+v"(t)); return t; }

__global__ void __launch_bounds__(NTHREADS) yoco_fwd(Params p) {
    extern __shared__ __attribute__((aligned(16))) unsigned char lds[];
    cg::grid_group grid = cg::this_grid();
    unsigned char* ws = p.ws;
    const float* ada = (const float*)(ws + OFF_ADA);
    bf16_t* Hb = (bf16_t*)(ws + OFF_H);

    RUN(0) phase_prep(p, lds, ftid());
    grid.sync();
    RUN(1) phase_norm(p.in[0], Hb, p.in[5], ada, 0, 1024, ftid());
    grid.sync();
    RUN(2) {
        EpiQKV0 e{(bf16_t*)(ws + OFF_Q0), (bf16_t*)(ws + OFF_K0), (bf16_t*)(ws + OFF_VT0), p.in[10], p.in[11]};
        gemm_phase(Hb, DM, NTOK, (const bf16_t*)(ws + OFF_WT_DIN), DM, 3072, DM, e, lds, ftid());
    }
    grid.sync();
    RUN(3) phase_diff_attn(p, lds, ftid());
    grid.sync();
    RUN(4) {
        EpiResid e{p.in[0], p.out, ada + 2 * 1024};
        gemm_phase(Hb, DM, NTOK, (const bf16_t*)(ws + OFF_WT_DOUT), DM, 1024, DM, e, lds, ftid());
    }
    grid.sync();
    if (STOP_AFTER <= 1) return;
    RUN(1) phase_norm(p.out, Hb, p.in[6], ada, 3 * 1024, 4 * 1024, ftid());
    grid.sync();
    RUN(5) {
        EpiPeer e{(int*)(ws + OFF_RIDX), (float*)(ws + OFF_RGATE)};
        gemm_phase(Hb, DM, NTOK, (const bf16_t*)(ws + OFF_WT_PEER), DM, 2048, DM, e, lds, ftid());
    }
    grid.sync();
    RUN(6) phase_peer_experts<true>(p, 0, ftid());
    grid.sync();
    if (STOP_AFTER <= 2) return;
    RUN(7) {
        EpiKV e{(bf16_t*)(ws + OFF_KC), (bf16_t*)(ws + OFF_KS), (bf16_t*)(ws + OFF_VST), (bf16_t*)(ws + OFF_KW), (bf16_t*)(ws + OFF_VWT), p.in[21]};
        gemm_phase((const bf16_t*)(ws + OFF_H2), DM, NTOK, (const bf16_t*)(ws + OFF_WT_KV), DM, 1536, DM, e, lds, ftid());
    }
    grid.sync();
    RUN(8) {
        EpiNsaQ e{(bf16_t*)(ws + OFF_QN), (float*)(ws + OFF_GATES), p.in[25], p.in[23]};
        gemm_phase(Hb, DM, NTOK, (const bf16_t*)(ws + OFF_WT_NIN), DM, 1048, DM, e, lds, ftid());
        for (int t = blockIdx.x; t < 64; t += gridDim.x) {
            const int pr = t >> 2, tm = t & 3, kv = pr >> 3, bg = pr & 7;
            const bf16_t* Ap = (const bf16_t*)(ws + OFF_KC) + (long)(kv * 8 + bg) * SEQ * 128;
            bf16_t* hid = (bf16_t*)(ws + OFF_HID) + (long)pr * 512 * 256;
            EpiCmp1 e1{hid, (const float*)(ws + OFF_POSB) + kv * 16 * 256, p.in[19] + kv * 256};
            gemm_tile(Ap, 2048, 511, (const bf16_t*)(ws + OFF_WT_C1) + (long)kv * 256 * 4096, 4096, 256, 4096, tm * 128, 0, e1, lds, ftid());
            __syncthreads();
            bf16_t* dst = kv == 0 ? (bf16_t*)(ws + OFF_KCMP) + (long)bg * 512 * 128 : (bf16_t*)(ws + OFF_VCMPT) + (long)bg * 128 * 512;
            EpiCmp2 e2{dst, p.in[21], kv};
            gemm_tile(hid, 256, 512, (const bf16_t*)(ws + OFF_WT_C2) + (long)kv * 128 * 256, 256, 128, 256, tm * 128, 0, e2, lds, ftid());
        }
    }
    grid.sync();
    RUN(9) phase_nsa_attn(p, lds, ftid());
    grid.sync();
    RUN(4) {
        EpiResid e{p.out, p.out, ada + 6144 + 2 * 1024};
        gemm_phase(Hb, DM, NTOK, (const bf16_t*)(ws + OFF_WT_NOUT), DM, 1024, DM, e, lds, ftid());
    }
    grid.sync();
    if (STOP_AFTER <= 3) return;
    RUN(1) phase_norm(p.out, Hb, p.in[6] + 1024, ada, 6144 + 3 * 1024, 6144 + 4 * 1024, ftid());
    grid.sync();
    RUN(5) {
        EpiPeer e{(int*)(ws + OFF_RIDX), (float*)(ws + OFF_RGATE)};
        gemm_phase(Hb, DM, NTOK, (const bf16_t*)(ws + OFF_WT_PEER) + (long)2048 * 1024, DM, 2048, DM, e, lds, ftid());
    }
    grid.sync();
    RUN(6) phase_peer_experts<false>(p, 1, ftid());
}

extern "C" void kernel_launch(void* const* d_in, const int* in_sizes, int n_in, void* d_out, int out_size, void* d_ws, size_t ws_size,
                              hipStream_t stream) {
    static int grid_blocks = 0;
    if (grid_blocks == 0) {
        if (n_in != 30 || out_size != NTOK * DM || ws_size < WS_END) {
            fprintf(stderr, "kernel_launch: unexpected shapes (n_in %d out %d ws %zu)\n", n_in, out_size, ws_size);
            grid_blocks = -1; return;
        }
        int dev = 0, cus = 0, per_cu = 0;
        hipGetDevice(&dev);
        hipDeviceGetAttribute(&cus, hipDeviceAttributeMultiprocessorCount, dev);
        hipFuncSetAttribute((const void*)yoco_fwd, hipFuncAttributeMaxDynamicSharedMemorySize, LDS_BYTES);
        hipOccupancyMaxActiveBlocksPerMultiprocessor(&per_cu, (const void*)yoco_fwd, NTHREADS, LDS_BYTES);
        if (per_cu < 1) { fprintf(stderr, "kernel_launch: occupancy query says %d blocks per CU\n", per_cu); grid_blocks = -1; return; }
        grid_blocks = cus;
    }
    if (grid_blocks < 0) return;
    Params p{};
    for (int i = 0; i < 30; ++i) p.in[i] = (const float*)d_in[i];
    p.out = (float*)d_out;
    p.ws = (unsigned char*)d_ws;
    void* args[] = {&p};
    hipError_t e = hipLaunchCooperativeKernel((const void*)yoco_fwd, dim3(grid_blocks), dim3(NTHREADS), args, LDS_BYTES, stream);
    if (e != hipSuccess) fprintf(stderr, "cooperative launch failed: %s (grid %d)\n", hipGetErrorString(e), grid_blocks);
}
```

```cpp
#include <hip/hip_runtime.h>
#include <hip/hip_cooperative_groups.h>
#include <cstdio>
#include <cstdint>
namespace cg = cooperative_groups;

#define DI __device__ __forceinline__
#ifndef STOP_AFTER
#define STOP_AFTER 99
#endif
#ifndef ONLY_PHASE
#define ONLY_PHASE -1
#endif
#define RUN(n) if (ONLY_PHASE < 0 || ONLY_PHASE == (n))
#ifndef REPEAT_MASK
#define REPEAT_MASK 0
#endif
#define REP(n) for (int rep_ = 0; rep_ < (((REPEAT_MASK) >> (n)) & 1) + 1; ++rep_)

typedef unsigned short bf16_t;
typedef short bf16x8 __attribute__((ext_vector_type(8)));
typedef float f32x16 __attribute__((ext_vector_type(16)));
typedef float f32x4 __attribute__((ext_vector_type(4)));
typedef float f32x2 __attribute__((ext_vector_type(2)));
typedef unsigned u32x4 __attribute__((ext_vector_type(4)));
typedef unsigned u32x2 __attribute__((ext_vector_type(2)));
typedef __bf16 bf16x2v __attribute__((ext_vector_type(2)));

#define MFMA32(a, b, c) __builtin_amdgcn_mfma_f32_32x32x16_bf16((a), (b), (c), 0, 0, 0)

constexpr int NB = 4, SEQ = 8192, DM = 1024, NTOK = NB * SEQ;
constexpr int NTHREADS = 512, NWAVES = 8;
constexpr float EPS = 1e-6f;
constexpr float LOG2E = 1.4426950408889634f;
constexpr int ADA_STRIDE = 14336;

constexpr size_t MB = 1u << 20;
constexpr size_t OFF_ADA = 0;
constexpr size_t OFF_POSB = 256 * 1024;
constexpr size_t OFF_BAR = 320 * 1024;
constexpr size_t OFF_WT_DIN = 1 * MB;
constexpr size_t OFF_WT_DOUT = 7 * MB;
constexpr size_t OFF_WT_KV = 9 * MB;
constexpr size_t OFF_WT_NIN = 12 * MB;
constexpr size_t OFF_WT_NOUT = 15 * MB;
constexpr size_t OFF_WT_PEER = 17 * MB;
constexpr size_t OFF_WT_C1 = 25 * MB;
constexpr size_t OFF_WT_C2 = 29 * MB;
constexpr size_t OFF_GATES = 30 * MB;
constexpr size_t OFF_KCMP = 34 * MB;
constexpr size_t OFF_VCMPT = 35 * MB;
constexpr size_t OFF_HID = 36 * MB;
constexpr size_t OFF_RIDX = 40 * MB;
constexpr size_t OFF_RGATE = 56 * MB;
constexpr size_t OFF_PU = 72 * MB;
constexpr size_t OFF_PV = 136 * MB;
constexpr size_t OFF_H = 200 * MB;
constexpr size_t OFF_R = 264 * MB;
constexpr size_t WS_END = 456 * MB;
constexpr size_t OFF_Q0 = OFF_R, OFF_K0 = OFF_R + 64 * MB, OFF_VT0 = OFF_R + 128 * MB;
constexpr size_t OFF_QN = OFF_R, OFF_H2 = OFF_R, OFF_KC = OFF_R + 64 * MB, OFF_KS = OFF_R + 96 * MB, OFF_VST = OFF_R + 112 * MB,
                 OFF_KW = OFF_R + 128 * MB, OFF_VWT = OFF_R + 144 * MB;

constexpr int LDS_BYTES = 144 * 1024 + 256;

struct Params {
    const float* in[30];
    float* out;
    unsigned char* ws;
};

DI unsigned pk2(float lo, float hi) { f32x2 v = {lo, hi}; return __builtin_bit_cast(unsigned, __builtin_convertvector(v, bf16x2v)); }
DI bf16_t f2bf(float x) { return (bf16_t)(pk2(x, 0.f) & 0xffffu); }
DI float bflo(unsigned u) { return __uint_as_float(u << 16); }
DI float bfhi(unsigned u) { return __uint_as_float(u & 0xffff0000u); }
DI float fexp2(float x) { return __builtin_amdgcn_exp2f(x); }
DI float frcp(float x) { return __builtin_amdgcn_rcpf(x); }
DI int crow(int reg, int h) { return (reg & 3) + 8 * (reg >> 2) + 4 * h; }
DI float wave_sum(float v) {
#pragma unroll
    for (int o = 1; o < 64; o <<= 1) v += __shfl_xor(v, o);
    return v;
}
DI float gelu_tanh(float x) {
    const float u = 0.7978845608028654f * (x + 0.044715f * x * x * x);
    return x * frcp(1.f + fexp2(-2.f * LOG2E * u));
}
DI float dot2bf(unsigned a, unsigned b, float c) {
    return __builtin_amdgcn_fdot2_f32_bf16(__builtin_bit_cast(bf16x2v, a), __builtin_bit_cast(bf16x2v, b), c, false);
}
DI int rel_bucket_i(int d) {
    if (d < 16) return d < 0 ? 0 : d;
    int b = 16;
    b += d >= 21; b += d >= 27; b += d >= 35; b += d >= 46; b += d >= 59; b += d >= 77; b += d >= 99; b += d >= 128;
    b += d >= 166; b += d >= 216; b += d >= 280; b += d >= 363; b += d >= 470; b += d >= 609; b += d >= 790;
    return b;
}
DI unsigned f2key(float f) { unsigned u = __float_as_uint(f); return u ^ ((unsigned)((int)u >> 31) | 0x80000000u); }
DI float key2f(unsigned k) { unsigned u = (k & 0x80000000u) ? (k ^ 0x80000000u) : ~k; return __uint_as_float(u); }

constexpr int EPI_LDS = 96 * 1024;

DI int sw2(int row, int chunk) { return (row >> 1) * 256 + (((((row & 1) << 3) | chunk) ^ ((row >> 1) & 15)) << 4); }
DI void sw2_src(int P, int& row, int& chunk) { const int R2 = P >> 4, lc = (P & 15) ^ (R2 & 15); row = 2 * R2 + (lc >> 3); chunk = lc & 7; }

template <class T, class = void> struct epi_stash { static constexpr bool value = false, present = false; };
template <class T> struct epi_stash<T, decltype((void)T::STASH)> { static constexpr bool value = T::STASH, present = true; };

template <int MT, class Epi>
DI void gemm_tile(const bf16_t* __restrict__ A, long lda, int M, const bf16_t* __restrict__ Bt, long ldb, int N, int K,
                  int m0, int n0, const Epi& epi, unsigned char* lds, int tid) {
    constexpr int XS = MT * 128 * 128, WS = 256 * 128, STAGE = XS + WS;
    const int lane = tid & 63, w = tid >> 6, tg = w & 3, fh = w >> 2, r = lane & 31, h = lane >> 5;
    const int wbase = tid & ~63;
    unsigned xo[2 * MT], wo[4];
#pragma unroll
    for (int i = 0; i < 2 * MT; ++i) { int row, c; sw2_src(tid + 512 * i, row, c); int m = m0 + row; m = m < M ? m : M - 1; xo[i] = (unsigned)m * (unsigned)(lda * 2) + c * 16; }
#pragma unroll
    for (int i = 0; i < 4; ++i) { int row, c; sw2_src(tid + 512 * i, row, c); int n = n0 + row; n = n < N ? n : N - 1; wo[i] = (unsigned)n * (unsigned)(ldb * 2) + c * 16; }
    const unsigned char* Ab = (const unsigned char*)A;
    const unsigned char* Bb = (const unsigned char*)Bt;
    auto stage = [&](int kt, unsigned char* st) {
#pragma unroll
        for (int i = 0; i < 2 * MT; ++i)
            __builtin_amdgcn_global_load_lds((const unsigned*)(Ab + kt * 128 + xo[i]), (unsigned*)(st + (wbase + 512 * i) * 16), 16, 0, 0);
#pragma unroll
        for (int i = 0; i < 4; ++i)
            __builtin_amdgcn_global_load_lds((const unsigned*)(Bb + kt * 128 + wo[i]), (unsigned*)(st + XS + (wbase + 512 * i) * 16), 16, 0, 0);
    };
    f32x16 acc[MT][4];
#pragma unroll
    for (int s2 = 0; s2 < MT; ++s2)
#pragma unroll
        for (int i = 0; i < 4; ++i)
#pragma unroll
            for (int j = 0; j < 16; ++j) acc[s2][i][j] = 0.f;
    const int nk = K >> 6;
    stage(0, lds);
    __syncthreads();
    for (int kt = 0; kt < nk; ++kt) {
        unsigned char* cur = lds + (kt & 1) * STAGE;
        if (kt + 1 < nk) stage(kt + 1, lds + ((kt + 1) & 1) * STAGE);
#pragma unroll
        for (int ks = 0; ks < 4; ++ks) {
            bf16x8 xf[MT];
#pragma unroll
            for (int s2 = 0; s2 < MT; ++s2) xf[s2] = *(const bf16x8*)(cur + sw2(32 * MT * tg + 32 * s2 + r, 2 * ks + h));
#pragma unroll
            for (int mt = 0; mt < 4; ++mt) {
                const bf16x8 wf = *(const bf16x8*)(cur + XS + sw2(128 * fh + 32 * mt + r, 2 * ks + h));
#pragma unroll
                for (int s2 = 0; s2 < MT; ++s2) acc[s2][mt] = MFMA32(wf, xf[s2], acc[s2][mt]);
            }
        }
        __syncthreads();
    }
    if constexpr (MT == 2 && epi_stash<Epi>::value) {
        float* sp = (float*)lds + w * 4096 + lane;
#pragma unroll
        for (int mt = 0; mt < 4; ++mt)
#pragma unroll
            for (int j = 0; j < 16; ++j) sp[(mt * 16 + j) * 64] = acc[1][mt][j];
        epi(acc[0], m0 + 64 * tg + r, n0 + 128 * fh, h, lds, tid);
        f32x16 a2[4];
        const float* sp2 = sp; asm volatile("" : "+v"(sp2));
#pragma unroll
        for (int mt = 0; mt < 4; ++mt)
#pragma unroll
            for (int j = 0; j < 16; ++j) a2[mt][j] = sp2[(mt * 16 + j) * 64];
        epi(a2, m0 + 64 * tg + 32 + r, n0 + 128 * fh, h, lds, tid);
        __syncthreads();
    } else {
        int ho = h, ro = r, to = tid;
        if constexpr (epi_stash<Epi>::present) asm volatile("" : "+v"(ho), "+v"(ro), "+v"(to));
#pragma unroll
        for (int s2 = 0; s2 < MT; ++s2) epi(acc[s2], m0 + 32 * MT * tg + 32 * s2 + ro, n0 + 128 * fh, ho, lds, to);
    }
}

struct EpiQKV0 {
    bf16_t *Q, *Kk, *VT;
    const float *qg, *kg;
    DI void operator()(const f32x16 (&acc)[4], int tok, int fbase, int h, unsigned char*, int) const {
        const int sec = fbase >> 10, hd = (fbase & 1023) >> 7, b = tok >> 13, s = tok & (SEQ - 1);
        if (sec < 2) {
            const float* gn = sec == 0 ? qg : kg;
            const float sc = sec == 0 ? 0.125f * LOG2E : 1.f;
            bf16_t* dst = sec == 0 ? Q : Kk;
#pragma unroll
            for (int j = 0; j < 2; ++j) {
                float ss = 0.f;
#pragma unroll
                for (int mt = 0; mt < 2; ++mt)
#pragma unroll
                    for (int rg = 0; rg < 16; ++rg) { const float v = acc[2 * j + mt][rg]; ss += v * v; }
                ss += __shfl_xor(ss, 32);
                const float rstd = rsqrtf(ss * (1.f / 64.f) + EPS) * sc;
                bf16_t* row = dst + ((long)((b * 8 + hd) * 2 + j) * SEQ + s) * 64;
#pragma unroll
                for (int mt = 0; mt < 2; ++mt)
#pragma unroll
                    for (int g4 = 0; g4 < 4; ++g4) {
                        const int d0 = 32 * mt + 8 * g4 + 4 * h;
                        const f32x4 gv = *(const f32x4*)(gn + d0);
                        u32x2 o;
                        o.x = pk2(acc[2 * j + mt][4 * g4 + 0] * rstd * gv.x, acc[2 * j + mt][4 * g4 + 1] * rstd * gv.y);
                        o.y = pk2(acc[2 * j + mt][4 * g4 + 2] * rstd * gv.z, acc[2 * j + mt][4 * g4 + 3] * rstd * gv.w);
                        *(u32x2*)(row + d0) = o;
                    }
            }
        } else {
            bf16_t* base = VT + (long)(b * 8 + hd) * 128 * SEQ + s;
#pragma unroll
            for (int mt = 0; mt < 4; ++mt)
#pragma unroll
                for (int rg = 0; rg < 16; ++rg) base[(long)(32 * mt + crow(rg, h)) * SEQ] = f2bf(acc[mt][rg]);
        }
    }
};

struct EpiResid {
    const float* xin; float* xout; const float* gate;
    DI void operator()(const f32x16 (&acc)[4], int tok, int fbase, int h, unsigned char*, int) const {
        const int b = tok >> 13;
        const float* gp = gate + b * ADA_STRIDE;
#pragma unroll
        for (int mt = 0; mt < 4; ++mt)
#pragma unroll
            for (int g4 = 0; g4 < 4; ++g4) {
                const int f = fbase + 32 * mt + 8 * g4 + 4 * h;
                const f32x4 xv = *(const f32x4*)(xin + (long)tok * DM + f);
                const f32x4 gv = *(const f32x4*)(gp + f);
                f32x4 o;
                o.x = xv.x + gv.x * acc[mt][4 * g4 + 0]; o.y = xv.y + gv.y * acc[mt][4 * g4 + 1];
                o.z = xv.z + gv.z * acc[mt][4 * g4 + 2]; o.w = xv.w + gv.w * acc[mt][4 * g4 + 3];
                *(f32x4*)(xout + (long)tok * DM + f) = o;
                if (g4 == 3) __builtin_amdgcn_sched_barrier(0);
            }
    }
};

struct EpiKV {
    bf16_t *KC, *KS, *VST, *KW, *VWT;
    const float* kgain;
    DI void operator()(const f32x16 (&acc)[4], int tok, int fbase, int h, unsigned char*, int) const {
        const int c = fbase >> 7, br = c >> 2, kv = (c >> 1) & 1, g = c & 1, b = tok >> 13, s = tok & (SEQ - 1);
        if (br == 0 || kv == 0) {
            float rstd = 1.f;
            bf16_t* row;
            if (br == 0) row = KC + ((long)((kv * 4 + b) * 2 + g) * SEQ + s) * 128;
            else {
                float ss = 0.f;
#pragma unroll
                for (int mt = 0; mt < 4; ++mt)
#pragma unroll
                    for (int rg = 0; rg < 16; ++rg) ss += acc[mt][rg] * acc[mt][rg];
                ss += __shfl_xor(ss, 32);
                rstd = rsqrtf(ss * (1.f / 128.f) + EPS);
                row = (br == 1 ? KS : KW) + ((long)(b * 2 + g) * SEQ + s) * 128;
            }
#pragma unroll
            for (int mt = 0; mt < 4; ++mt)
#pragma unroll
                for (int g4 = 0; g4 < 4; ++g4) {
                    const int d0 = 32 * mt + 8 * g4 + 4 * h;
                    f32x4 gv = {1.f, 1.f, 1.f, 1.f};
                    if (br != 0) gv = *(const f32x4*)(kgain + br * 128 + d0);
                    u32x2 o;
                    o.x = pk2(acc[mt][4 * g4 + 0] * rstd * gv.x, acc[mt][4 * g4 + 1] * rstd * gv.y);
                    o.y = pk2(acc[mt][4 * g4 + 2] * rstd * gv.z, acc[mt][4 * g4 + 3] * rstd * gv.w);
                    *(u32x2*)(row + d0) = o;
                }
        } else {
            bf16_t* base = (br == 1 ? VST : VWT) + (long)(b * 2 + g) * 128 * SEQ + s;
#pragma unroll
            for (int mt = 0; mt < 4; ++mt)
#pragma unroll
                for (int rg = 0; rg < 16; ++rg) base[(long)(32 * mt + crow(rg, h)) * SEQ] = f2bf(acc[mt][rg]);
        }
    }
};

struct EpiCmp1 {
    bf16_t* hid; const float* posb_part; const float* b1;
    DI void operator()(const f32x16 (&acc)[4], int tok, int fbase, int h, unsigned char*, int) const {
        if (tok >= 512) return;
#pragma unroll
        for (int mt = 0; mt < 4; ++mt)
#pragma unroll
            for (int g4 = 0; g4 < 4; ++g4) {
                const int f = fbase + 32 * mt + 8 * g4 + 4 * h;
                f32x4 pb = *(const f32x4*)(b1 + f);
                for (int c = 0; c < 16; ++c) { const f32x4 t = *(const f32x4*)(posb_part + c * 256 + f); pb.x += t.x; pb.y += t.y; pb.z += t.z; pb.w += t.w; }
                u32x2 o;
                o.x = pk2(gelu_tanh(acc[mt][4 * g4 + 0] + pb.x), gelu_tanh(acc[mt][4 * g4 + 1] + pb.y));
                o.y = pk2(gelu_tanh(acc[mt][4 * g4 + 2] + pb.z), gelu_tanh(acc[mt][4 * g4 + 3] + pb.w));
                *(u32x2*)(hid + (long)tok * 256 + f) = o;
            }
    }
};

struct EpiCmp2 {
    bf16_t* dst; const float* kgain0; int kv;
    DI void operator()(const f32x16 (&acc)[4], int tok, int fbase, int h, unsigned char*, int) const {
        if (fbase != 0 || tok >= 512) return;
        const float valid = tok < 511 ? 1.f : 0.f;
        if (kv == 0) {
            float ss = 0.f;
#pragma unroll
            for (int mt = 0; mt < 4; ++mt)
#pragma unroll
                for (int rg = 0; rg < 16; ++rg) ss += acc[mt][rg] * acc[mt][rg];
            ss += __shfl_xor(ss, 32);
            const float rstd = rsqrtf(ss * (1.f / 128.f) + EPS) * valid;
#pragma unroll
            for (int mt = 0; mt < 4; ++mt)
#pragma unroll
                for (int g4 = 0; g4 < 4; ++g4) {
                    const int d0 = 32 * mt + 8 * g4 + 4 * h;
                    const f32x4 gv = *(const f32x4*)(kgain0 + d0);
                    u32x2 o;
                    o.x = pk2(acc[mt][4 * g4 + 0] * rstd * gv.x, acc[mt][4 * g4 + 1] * rstd * gv.y);
                    o.y = pk2(acc[mt][4 * g4 + 2] * rstd * gv.z, acc[mt][4 * g4 + 3] * rstd * gv.w);
                    *(u32x2*)(dst + (long)tok * 128 + d0) = o;
                }
        } else {
#pragma unroll
            for (int mt = 0; mt < 4; ++mt)
#pragma unroll
                for (int rg = 0; rg < 16; ++rg) dst[(long)(32 * mt + crow(rg, h)) * 512 + tok] = f2bf(acc[mt][rg] * valid);
        }
    }
};

struct EpiNsaQ {
    bf16_t* QN; float* gates; const float* qgain; const float* bgate;
    DI void operator()(const f32x16 (&acc)[4], int tok, int fbase, int h, unsigned char*, int) const {
        const int b = tok >> 13, s = tok & (SEQ - 1);
        if (fbase < 1024) {
            const int head = fbase >> 7;
            float ss = 0.f;
#pragma unroll
            for (int mt = 0; mt < 4; ++mt)
#pragma unroll
                for (int rg = 0; rg < 16; ++rg) ss += acc[mt][rg] * acc[mt][rg];
            ss += __shfl_xor(ss, 32);
            const float rstd = rsqrtf(ss * (1.f / 128.f) + EPS) * (0.08838834764831845f * LOG2E);
            bf16_t* row = QN + ((long)(b * 8 + head) * SEQ + s) * 128;
#pragma unroll
            for (int mt = 0; mt < 4; ++mt)
#pragma unroll
                for (int g4 = 0; g4 < 4; ++g4) {
                    const int d0 = 32 * mt + 8 * g4 + 4 * h;
                    const f32x4 gv = *(const f32x4*)(qgain + d0);
                    u32x2 o;
                    o.x = pk2(acc[mt][4 * g4 + 0] * rstd * gv.x, acc[mt][4 * g4 + 1] * rstd * gv.y);
                    o.y = pk2(acc[mt][4 * g4 + 2] * rstd * gv.z, acc[mt][4 * g4 + 3] * rstd * gv.w);
                    *(u32x2*)(row + d0) = o;
                }
        } else if (fbase == 1024) {
#pragma unroll
            for (int rg = 0; rg < 16; ++rg) {
                const int f = crow(rg, h);
                if (f < 24) { const float z = acc[0][rg] + bgate[f]; gates[(long)tok * 24 + f] = frcp(1.f + fexp2(-LOG2E * z)); }
            }
        }
    }
};

struct EpiPeer {
    static constexpr bool STASH = false;
    int* ridx; float* rgate; int ex_off;
    DI void operator()(const f32x16 (&acc)[4], int tok, int fbase, int h, unsigned char* lds, int tid) const {
        const int lane = tid & 63, w = tid >> 6, tg = w & 3, fh = w >> 2, r = lane & 31;
        const int hd = fbase >> 8;
        unsigned* EX = (unsigned*)(lds + ex_off);
        unsigned L[16];
#pragma unroll
        for (int i = 0; i < 16; ++i) L[i] = 0u;
#pragma unroll
        for (int mt = 0; mt < 4; ++mt)
#pragma unroll
            for (int rg = 0; rg < 16; ++rg) {
                const int kidx = 32 * mt + crow(rg, h);
                unsigned x = (f2key(acc[mt][rg]) & ~127u) | (unsigned)(127 - kidx);
#pragma unroll
                for (int i = 0; i < 16; ++i) { const unsigned t = L[i] > x ? L[i] : x; x = L[i] > x ? x : L[i]; L[i] = t; }
            }
        {
            unsigned P[16];
#pragma unroll
            for (int i = 0; i < 16; ++i) P[i] = (unsigned)__shfl_xor((int)L[i], 32);
#pragma unroll
            for (int i = 0; i < 16; ++i) L[i] = L[i] > P[15 - i] ? L[i] : P[15 - i];
#pragma unroll
            for (int st = 8; st >= 1; st >>= 1)
#pragma unroll
                for (int i = 0; i < 16; ++i)
                    if ((i & st) == 0) { const unsigned a = L[i], b2 = L[i + st]; L[i] = a > b2 ? a : b2; L[i + st] = a > b2 ? b2 : a; }
        }
        if (h == 0) {
#pragma unroll
            for (int i = 0; i < 16; i += 4) *(u32x4*)(EX + ((fh * 4 + tg) * 32 + r) * 16 + i) = (u32x4){L[i], L[i + 1], L[i + 2], L[i + 3]};
        }
        __syncthreads();
        unsigned X[16], Y[16];
        {
            const unsigned* l0 = EX + ((0 * 4 + tg) * 32 + r) * 16;
            const unsigned* l1 = EX + ((1 * 4 + tg) * 32 + r) * 16;
            const unsigned* px = h ? l1 : l0;
            const unsigned* py = h ? l0 : l1;
#pragma unroll
            for (int i = 0; i < 16; i += 4) {
                const u32x4 a = *(const u32x4*)(px + i), b2 = *(const u32x4*)(py + i);
                X[i] = a.x; X[i + 1] = a.y; X[i + 2] = a.z; X[i + 3] = a.w;
                Y[i] = b2.x; Y[i + 1] = b2.y; Y[i + 2] = b2.z; Y[i + 3] = b2.w;
            }
        }
        unsigned T[16];
#pragma unroll
        for (int i = 0; i < 16; ++i) T[i] = 0u;
#pragma unroll
        for (int i = 0; i < 16; ++i)
#pragma unroll
            for (int j = i; j < 16; ++j) {
                if ((i + 1) * (j + 1) > 16) continue;
                const float fs = key2f(X[i] & ~127u) + key2f(Y[j] & ~127u);
                const unsigned code = h ? (unsigned)((j << 4) | i) : (unsigned)((i << 4) | j);
                unsigned x = (f2key(fs) & ~255u) | (255u - code);
                if (i == j) x = h ? 0u : x;
#pragma unroll
                for (int k = 0; k < 16; ++k) { const unsigned t = T[k] > x ? T[k] : x; x = T[k] > x ? x : T[k]; T[k] = t; }
            }
        {
            unsigned P[16];
#pragma unroll
            for (int i = 0; i < 16; ++i) P[i] = (unsigned)__shfl_xor((int)T[i], 32);
#pragma unroll
            for (int i = 0; i < 16; ++i) T[i] = T[i] > P[15 - i] ? T[i] : P[15 - i];
#pragma unroll
            for (int st = 8; st >= 1; st >>= 1)
#pragma unroll
                for (int i = 0; i < 16; ++i)
                    if ((i & st) == 0) { const unsigned a = T[i], b2 = T[i + st]; T[i] = a > b2 ? a : b2; T[i + st] = a > b2 ? b2 : a; }
        }
        float sc[16], sum = 0.f;
        const float mx = key2f(T[0] & ~255u);
#pragma unroll
        for (int k = 0; k < 16; ++k) { sc[k] = fexp2((key2f(T[k] & ~255u) - mx) * LOG2E); sum += sc[k]; }
        const float inv = frcp(sum);
        if (h == 0) {
            const unsigned* l0 = EX + ((0 * 4 + tg) * 32 + r) * 16;
            const unsigned* l1 = EX + ((1 * 4 + tg) * 32 + r) * 16;
#pragma unroll
            for (int k = 0; k < 16; ++k) {
                if ((k >> 3) != fh) continue;
                const unsigned code = 255u - (T[k] & 255u);
                const int i1 = 127 - (int)(l0[code >> 4] & 127u), i2 = 127 - (int)(l1[code & 15u] & 127u);
                ridx[(long)tok * 128 + hd * 16 + k] = i1 * 128 + i2;
                rgate[(long)tok * 128 + hd * 16 + k] = sc[k] * inv;
            }
        }
        __syncthreads();
    }
};

DI void p0_transpose_item(const float* __restrict__ W, int K, int N, bf16_t* __restrict__ WT, int item, int ntn, unsigned char* lds, int tid) {
    float* tile = (float*)lds;
    const int kb = item / ntn, nb = item % ntn, k0 = kb * 64, n0 = nb * 64;
    {
        const int nn = tid & 63, kk0 = tid >> 6;
#pragma unroll
        for (int i = 0; i < 8; ++i) { const int kk = kk0 + 8 * i; const int n = n0 + nn; tile[kk * 65 + nn] = n < N ? W[(long)(k0 + kk) * N + n] : 0.f; }
    }
    __syncthreads();
    {
        const int n = tid >> 3, c = tid & 7;
        const float* s = tile + (8 * c) * 65 + n;
        u32x4 o;
        o.x = pk2(s[0], s[65]); o.y = pk2(s[2 * 65], s[3 * 65]); o.z = pk2(s[4 * 65], s[5 * 65]); o.w = pk2(s[6 * 65], s[7 * 65]);
        *(u32x4*)(WT + (long)(n0 + n) * K + k0 + 8 * c) = o;
    }
    __syncthreads();
}

DI void p0_convert_item(const float* __restrict__ src, bf16_t* __restrict__ dst, int item, int tid) {
    const long base = (long)item * 16384;
#pragma unroll
    for (int i = 0; i < 4; ++i) {
        const long e = base + (long)(i * 512 + tid) * 8;
        const f32x4 a = *(const f32x4*)(src + e), b = *(const f32x4*)(src + e + 4);
        u32x4 o; o.x = pk2(a.x, a.y); o.y = pk2(a.z, a.w); o.z = pk2(b.x, b.y); o.w = pk2(b.z, b.w);
        *(u32x4*)(dst + e) = o;
    }
}

DI void p0_weff_item(const float* __restrict__ wq, const float* __restrict__ subk, bf16_t* __restrict__ WT, int item, unsigned char* lds, int tid) {
    const int layer = item >> 8, g = (item >> 4) & 15, ct = item & 15, p = g & 1, c0 = ct * 64;
    float* As = (float*)lds;
    float* Bs = As + 64 * 129;
    const float* wql = wq + (long)layer * 1024 * 2048;
    const float* sk = subk + ((long)layer * 2 + p) * 128 * 128;
    for (int e = tid; e < 64 * 128; e += NTHREADS) { const int c = e >> 7, d = e & 127; As[c * 129 + d] = wql[(long)(c0 + c) * 2048 + g * 128 + d]; }
    for (int e = tid; e < 128 * 128; e += NTHREADS) { const int k = e >> 7, d = e & 127; Bs[k * 129 + d] = sk[k * 128 + d]; }
    __syncthreads();
    const int k = tid & 127, cg4 = tid >> 7;
    float acc[16];
#pragma unroll
    for (int i = 0; i < 16; ++i) acc[i] = 0.f;
    for (int d = 0; d < 128; ++d) {
        const float bv = Bs[k * 129 + d];
#pragma unroll
        for (int i = 0; i < 16; ++i) acc[i] += As[(cg4 * 16 + i) * 129 + d] * bv;
    }
    bf16_t* o = WT + ((long)layer * 2048 + g * 128 + k) * 1024 + c0 + cg4 * 16;
    u32x4 o0, o1;
    o0.x = pk2(acc[0], acc[1]); o0.y = pk2(acc[2], acc[3]); o0.z = pk2(acc[4], acc[5]); o0.w = pk2(acc[6], acc[7]);
    o1.x = pk2(acc[8], acc[9]); o1.y = pk2(acc[10], acc[11]); o1.z = pk2(acc[12], acc[13]); o1.w = pk2(acc[14], acc[15]);
    *(u32x4*)o = o0; *(u32x4*)(o + 8) = o1;
    __syncthreads();
}

DI void p0_posb_item(const float* __restrict__ pos, const float* __restrict__ w1, float* __restrict__ part, int item, unsigned char* lds, int tid) {
    const int kv = item >> 4, ch = item & 15;
    float* red = (float*)lds;
    const int j = tid & 255, half = tid >> 8;
    const float* pp = pos + (long)kv * 4096 + ch * 256 + half * 128;
    const float* ww = w1 + ((long)kv * 4096 + ch * 256 + half * 128) * 256 + j;
    float a = 0.f;
    for (int f = 0; f < 128; ++f) a += pp[f] * ww[(long)f * 256];
    red[half * 256 + j] = a;
    __syncthreads();
    if (tid < 256) part[(kv * 16 + ch) * 256 + tid] = red[tid] + red[256 + tid];
    __syncthreads();
}

DI void p0_ada_item(const Params& p, float* __restrict__ ada, int item, unsigned char* lds, int tid) {
    float* cact = (float*)lds;
    float* red = cact + 4096;
    const float* c = p.in[1];
    for (int e = tid; e < 4096; e += NTHREADS) { const float v = c[e]; cact[e] = v * frcp(1.f + fexp2(-LOG2E * v)); }
    __syncthreads();
    const int colg = item * 64;
    const float* W; const float* bias; int N, n0;
    if (colg < 6144) { W = p.in[3]; bias = p.in[4]; N = 6144; n0 = colg; }
    else if (colg < 12288) { W = p.in[3] + (long)1024 * 6144; bias = p.in[4] + 6144; N = 6144; n0 = colg - 6144; }
    else { W = p.in[14]; bias = p.in[15]; N = 2048; n0 = colg - 12288; }
    const int col = tid & 63, kg = tid >> 6;
    float a0 = 0.f, a1 = 0.f, a2 = 0.f, a3 = 0.f;
    const float* wp = W + (long)(kg * 128) * N + n0 + col;
#pragma unroll 8
    for (int k = 0; k < 128; ++k) {
        const float wv = wp[(long)k * N];
        const int kk = kg * 128 + k;
        a0 += cact[kk] * wv; a1 += cact[1024 + kk] * wv; a2 += cact[2048 + kk] * wv; a3 += cact[3072 + kk] * wv;
    }
    red[(kg * 4 + 0) * 64 + col] = a0; red[(kg * 4 + 1) * 64 + col] = a1; red[(kg * 4 + 2) * 64 + col] = a2; red[(kg * 4 + 3) * 64 + col] = a3;
    __syncthreads();
    if (tid < 256) {
        const int b = tid >> 6, cc = tid & 63;
        float s = bias[n0 + cc];
#pragma unroll
        for (int q = 0; q < 8; ++q) s += red[(q * 4 + b) * 64 + cc];
        ada[b * ADA_STRIDE + colg + cc] = s;
    }
    __syncthreads();
}

constexpr int P0_CONV = 4096, P0_TR_DIN = 768, P0_TR_DOUT = 256, P0_TR_KV = 384, P0_TR_NIN = 288, P0_TR_NOUT = 256, P0_TR_C1 = 512, P0_TR_C2 = 16,
              P0_WEFF = 512, P0_POSB = 32, P0_ADA = 224;
constexpr int P0_TOTAL = P0_CONV + P0_TR_DIN + P0_TR_DOUT + P0_TR_KV + P0_TR_NIN + P0_TR_NOUT + P0_TR_C1 + P0_TR_C2 + P0_WEFF + P0_POSB + P0_ADA;

DI void phase_prep(const Params& p, unsigned char* lds, int tid) {
    unsigned char* ws = p.ws;
    for (int it = blockIdx.x; it < P0_TOTAL; it += gridDim.x) {
        int r = it;
        if (r < P0_ADA) { p0_ada_item(p, (float*)(ws + OFF_ADA), r, lds, tid); continue; } r -= P0_ADA;
        if (r < P0_WEFF) { p0_weff_item(p.in[26], p.in[27], (bf16_t*)(ws + OFF_WT_PEER), r, lds, tid); continue; } r -= P0_WEFF;
        if (r < P0_POSB) { p0_posb_item(p.in[17], p.in[18], (float*)(ws + OFF_POSB), r, lds, tid); continue; } r -= P0_POSB;
        if (r < P0_TR_DIN) { p0_transpose_item(p.in[7], 1024, 3072, (bf16_t*)(ws + OFF_WT_DIN), r, 48, lds, tid); continue; } r -= P0_TR_DIN;
        if (r < P0_TR_DOUT) { p0_transpose_item(p.in[8], 1024, 1024, (bf16_t*)(ws + OFF_WT_DOUT), r, 16, lds, tid); continue; } r -= P0_TR_DOUT;
        if (r < P0_TR_KV) { p0_transpose_item(p.in[16], 1024, 1536, (bf16_t*)(ws + OFF_WT_KV), r, 24, lds, tid); continue; } r -= P0_TR_KV;
        if (r < P0_TR_NIN) { p0_transpose_item(p.in[22], 1024, 1048, (bf16_t*)(ws + OFF_WT_NIN), r, 18, lds, tid); continue; } r -= P0_TR_NIN;
        if (r < P0_TR_NOUT) { p0_transpose_item(p.in[24], 1024, 1024, (bf16_t*)(ws + OFF_WT_NOUT), r, 16, lds, tid); continue; } r -= P0_TR_NOUT;
        if (r < P0_TR_C1) { const int kv = r >> 8; p0_transpose_item(p.in[18] + (long)kv * 4096 * 256, 4096, 256, (bf16_t*)(ws + OFF_WT_C1) + (long)kv * 256 * 4096, r & 255, 4, lds, tid); continue; } r -= P0_TR_C1;
        if (r < P0_TR_C2) { const int kv = r >> 3; p0_transpose_item(p.in[20] + (long)kv * 256 * 128, 256, 128, (bf16_t*)(ws + OFF_WT_C2) + (long)kv * 128 * 256, r & 7, 2, lds, tid); continue; } r -= P0_TR_C2;
        {
            const int tbl = r >> 10, sub = r & 1023;
            const float* src = (tbl < 2 ? p.in[28] : p.in[29]) + (long)(tbl & 1) * 16384 * 1024;
            bf16_t* dst = (bf16_t*)(ws + (tbl < 2 ? OFF_PU : OFF_PV)) + (long)(tbl & 1) * 16384 * 1024;
            p0_convert_item(src, dst, sub, tid);
        }
    }
}

DI void norm_row_write(const f32x4 (&v)[4], float rstd, const float* gain, const float* shift, const float* scale, bf16_t* orow, int lane) {
#pragma unroll
    for (int j = 0; j < 4; ++j) {
        const int c = 4 * lane + 256 * j;
        const f32x4 g = *(const f32x4*)(gain + c), sh = *(const f32x4*)(shift + c), sc = *(const f32x4*)(scale + c);
        u32x2 o;
        o.x = pk2(v[j].x * rstd * g.x * (1.f + sc.x) + sh.x, v[j].y * rstd * g.y * (1.f + sc.y) + sh.y);
        o.y = pk2(v[j].z * rstd * g.z * (1.f + sc.z) + sh.z, v[j].w * rstd * g.w * (1.f + sc.w) + sh.w);
        *(u32x2*)(orow + c) = o;
    }
}
DI void phase_norm(const float* __restrict__ x, bf16_t* __restrict__ out, const float* gain, const float* ada, int shift_off, int scale_off, int tid) {
    const int lane = tid & 63, gw = blockIdx.x * NWAVES + (tid >> 6), nw = gridDim.x * NWAVES;
    for (int tok = gw; tok < NTOK; tok += nw) {
        const int b = tok >> 13;
        f32x4 v[4]; float ss = 0.f;
#pragma unroll
        for (int j = 0; j < 4; ++j) { v[j] = *(const f32x4*)(x + (long)tok * DM + 4 * lane + 256 * j); ss += v[j].x * v[j].x + v[j].y * v[j].y + v[j].z * v[j].z + v[j].w * v[j].w; }
        const float rstd = rsqrtf(wave_sum(ss) * (1.f / DM) + EPS);
        norm_row_write(v, rstd, gain, ada + b * ADA_STRIDE + shift_off, ada + b * ADA_STRIDE + scale_off, out + (long)tok * DM, lane);
    }
}

DI int kidx(int mt, int i) { return 32 * mt + 16 * (i >> 3) + (i & 7); }
template <int DQK>
DI void attn_qk32(const unsigned char* Ks, const bf16x8 (&qf)[DQK / 16], f32x16& st, int mt, int r, int h) {
    constexpr int RB = DQK * 2, MSK = DQK == 64 ? 7 : 15;
    const int row = 32 * mt + ((r & 0x13) | ((r & 4) << 1) | ((r & 8) >> 1));
    const unsigned char* kr = Ks + row * RB;
#pragma unroll
    for (int i = 0; i < 16; ++i) st[i] = 0.f;
#pragma unroll
    for (int ks = 0; ks < DQK / 16; ++ks) {
        const bf16x8 kf = *(const bf16x8*)(kr + (((2 * ks + h) ^ (row & MSK)) << 4));
        st = MFMA32(kf, qf[ks], st);
    }
}
DI void attn_pack32(const f32x16& st, bf16x8 (&pf)[2]) {
#pragma unroll
    for (int s = 0; s < 2; ++s) {
        u32x4 t;
        t.x = pk2(st[8 * s + 0], st[8 * s + 1]); t.y = pk2(st[8 * s + 2], st[8 * s + 3]);
        t.z = pk2(st[8 * s + 4], st[8 * s + 5]); t.w = pk2(st[8 * s + 6], st[8 * s + 7]);
        pf[s] = __builtin_bit_cast(bf16x8, t);
    }
}
DI void attn_softmax32(f32x16& st, float& m, float& l, f32x16 (&o)[4]) {
    float mx = st[0];
#pragma unroll
    for (int i = 1; i < 16; ++i) mx = fmaxf(mx, st[i]);
    mx = fmaxf(mx, __shfl_xor(mx, 32));
    const float mn = fmaxf(m, mx);
    if (!__all(mn == m)) {
        const float alpha = fexp2(m - mn);
        l *= alpha;
#pragma unroll
        for (int dt = 0; dt < 4; ++dt)
#pragma unroll
            for (int i = 0; i < 16; ++i) o[dt][i] *= alpha;
        m = mn;
    }
    float sum = 0.f;
#pragma unroll
    for (int i = 0; i < 16; ++i) { const float pv = fexp2(st[i] - m); st[i] = pv; sum += pv; }
    l += sum;
}
DI void attn_pv32(const unsigned char* Vs, const bf16x8 (&pf)[2], f32x16 (&o)[4], int mt, int r, int h) {
#pragma unroll
    for (int dt = 0; dt < 4; ++dt)
#pragma unroll
        for (int s2 = 0; s2 < 2; ++s2) {
            const int row = 32 * dt + r;
            const bf16x8 vf = *(const bf16x8*)(Vs + row * 128 + (((2 * (2 * mt + s2) + h) ^ (row & 7)) << 4));
            o[dt] = MFMA32(vf, pf[s2], o[dt]);
        }
}
template <int RB, int NROWS>
DI void dma_offsets(unsigned (&off)[NROWS * RB / 16 / 512], unsigned gstride, int tid) {
    constexpr int CPR = RB / 16;
#pragma unroll
    for (int i = 0; i < NROWS * CPR / 512; ++i) {
        const int idx = tid + 512 * i, row = idx / CPR, cp = idx % CPR;
        off[i] = (unsigned)row * gstride + ((cp ^ (row & (CPR - 1))) << 4);
    }
}
template <int N>
DI void dma_issue(unsigned char* dst, const unsigned char* gbase, const unsigned (&off)[N], int tid) {
    const int wbase = tid & ~63;
#pragma unroll
    for (int i = 0; i < N; ++i)
        __builtin_amdgcn_global_load_lds((const unsigned*)(gbase + off[i]), (unsigned*)(dst + (wbase + 512 * i) * 16), 16, 0, 0);
}

constexpr int AT_STAGE = 32 * 1024;
constexpr int AT_LUT = 2 * AT_STAGE;
constexpr int LUT_N = 1280, LUT_OFF = 1100;
constexpr int LUTC_W = 52;
constexpr int AT_LUTC = AT_LUT + 20 * 1024;
constexpr int AT_IMP = AT_LUTC + 13 * 1024;
constexpr int AT_SEL = AT_IMP + 34 * 1024;

DI void phase_diff_attn(const Params& p, unsigned char* lds, int tid) {
    unsigned char* ws = p.ws;
    const bf16_t* Q = (const bf16_t*)(ws + OFF_Q0);
    const bf16_t* Kk = (const bf16_t*)(ws + OFF_K0);
    const bf16_t* VT = (const bf16_t*)(ws + OFF_VT0);
    bf16_t* O = (bf16_t*)(ws + OFF_H);
    const float* relb = p.in[2];
    const float* lam = p.in[9];
    const float* subln = p.in[12];
    const int lane = tid & 63, w = tid >> 6, comp = w & 1, qg = w >> 1, r = lane & 31, h = lane >> 5;
    float* lut = (float*)(lds + AT_LUT);
    float lam_full;
    {
        float s01 = 0.f, s23 = 0.f;
        for (int i = 0; i < 64; ++i) { s01 += lam[i] * lam[64 + i]; s23 += lam[128 + i] * lam[192 + i]; }
        lam_full = __expf(s01) - __expf(s23) + 0.2f;
    }
    const int G = gridDim.x, rows_per_it = G >> 5;
    unsigned koff[1], voff[2];
    dma_offsets<128, 64>(koff, 128, tid);
    dma_offsets<128, 128>(voff, SEQ * 2, tid);
    for (int it = 0;; ++it) {
        int u;
        if ((G & 31) == 0) {
            const int rr = blockIdx.x >> 5, cc = blockIdx.x & 31;
            const int rowi = it * rows_per_it + ((it & 1) ? rows_per_it - 1 - rr : rr);
            u = rowi * 32 + cc;
        } else u = it * G + blockIdx.x;
        if (u >= 2048) break;
        const int qb = 63 - (u >> 5), b = (u & 31) >> 3, hd = u & 7;
        const int q0 = qb * 128, ntiles = 2 * qb + 2;
        const int qpos = q0 + 32 * qg + r, qlo = q0 + 32 * qg, qhi = qlo + 31;
        for (int e = tid; e < LUT_N; e += NTHREADS) { const int d = LUT_OFF - e; lut[e] = d < 0 ? -INFINITY : (d >= 790 ? 0.f : (relb[rel_bucket_i(d) * 8 + hd] - relb[31 * 8 + hd]) * LOG2E); }
        bf16x8 qf[4];
        {
            const bf16_t* qrow = Q + ((long)((b * 8 + hd) * 2 + comp) * SEQ + qpos) * 64;
#pragma unroll
            for (int ks = 0; ks < 4; ++ks) qf[ks] = *(const bf16x8*)(qrow + 16 * ks + 8 * h);
        }
        const unsigned char* k0g = (const unsigned char*)(Kk + (long)((b * 8 + hd) * 2 + 0) * SEQ * 64);
        const unsigned char* k1g = (const unsigned char*)(Kk + (long)((b * 8 + hd) * 2 + 1) * SEQ * 64);
        const unsigned char* vtg = (const unsigned char*)(VT + (long)(b * 8 + hd) * 128 * SEQ);
        f32x16 o[4];
#pragma unroll
        for (int dt = 0; dt < 4; ++dt)
#pragma unroll
            for (int i = 0; i < 16; ++i) o[dt][i] = 0.f;
        float m = -1e30f, l = 0.f;
        auto stage = [&](int kt, unsigned char* st) {
            dma_issue(st, k0g + (long)kt * 8192, koff, tid);
            dma_issue(st + 8192, k1g + (long)kt * 8192, koff, tid);
            dma_issue(st + 16384, vtg + (long)kt * 128, voff, tid);
        };
        stage(0, lds);
        __syncthreads();
        for (int kt = 0; kt < ntiles; ++kt) {
            unsigned char* cur = lds + (kt & 1) * AT_STAGE;
            if (kt + 1 < ntiles) stage(kt + 1, lds + ((kt + 1) & 1) * AT_STAGE);
            const int k0 = kt * 64;
            const bool nearb = qlo - (k0 + 63) < 790;
            const int dbase = qpos - k0 - 8 * h;
            const float* lp = lut + (LUT_OFF - dbase);
#pragma unroll
            for (int mt = 0; mt < 2; ++mt) {
                if (k0 + 32 * mt <= qhi) {
                    f32x16 st;
                    attn_qk32<64>(cur + comp * 8192, qf, st, mt, r, h);
                    if (nearb) {
#pragma unroll
                        for (int i = 0; i < 16; ++i) st[i] += lp[kidx(mt, i)];
                    }
                    attn_softmax32(st, m, l, o);
                    bf16x8 pf[2];
                    attn_pack32(st, pf);
                    attn_pv32(cur + 16384, pf, o, mt, r, h);
                }
            }
            __syncthreads();
        }
        l += __shfl_xor(l, 32);
        const float inv = l > 0.f ? frcp(l) : 0.f;
        float* xch = (float*)lds + qg * 4096;
        if (comp == 1) {
            const float sc = inv * lam_full;
#pragma unroll
            for (int dt = 0; dt < 4; ++dt)
#pragma unroll
                for (int i = 0; i < 16; ++i) xch[(dt * 16 + i) * 64 + lane] = o[dt][i] * sc;
        }
        __syncthreads();
        if (comp == 0) {
            float ss = 0.f;
#pragma unroll
            for (int dt = 0; dt < 4; ++dt)
#pragma unroll
                for (int i = 0; i < 16; ++i) { const float v = o[dt][i] * inv - xch[(dt * 16 + i) * 64 + lane]; o[dt][i] = v; ss += v * v; }
            ss += __shfl_xor(ss, 32);
            const float rstd = rsqrtf(ss * (1.f / 128.f) + EPS) * 0.8f;
            bf16_t* orow = O + (long)(b * SEQ + qpos) * DM + hd * 128;
#pragma unroll
            for (int dt = 0; dt < 4; ++dt)
#pragma unroll
                for (int g4 = 0; g4 < 4; ++g4) {
                    const int d0 = 32 * dt + 8 * g4 + 4 * h;
                    const f32x4 gv = *(const f32x4*)(subln + d0);
                    u32x2 ov;
                    ov.x = pk2(o[dt][4 * g4 + 0] * rstd * gv.x, o[dt][4 * g4 + 1] * rstd * gv.y);
                    ov.y = pk2(o[dt][4 * g4 + 2] * rstd * gv.z, o[dt][4 * g4 + 3] * rstd * gv.w);
                    *(u32x2*)(orow + d0) = ov;
                }
        }
        __syncthreads();
    }
}

DI void phase_nsa_attn(const Params& p, unsigned char* lds, int tid) {
    unsigned char* ws = p.ws;
    const bf16_t* QN = (const bf16_t*)(ws + OFF_QN);
    const bf16_t* KS = (const bf16_t*)(ws + OFF_KS);
    const bf16_t* VST = (const bf16_t*)(ws + OFF_VST);
    const bf16_t* KW = (const bf16_t*)(ws + OFF_KW);
    const bf16_t* VWT = (const bf16_t*)(ws + OFF_VWT);
    const bf16_t* KCMP = (const bf16_t*)(ws + OFF_KCMP);
    const bf16_t* VCMPT = (const bf16_t*)(ws + OFF_VCMPT);
    const float* gates = (const float*)(ws + OFF_GATES);
    bf16_t* O = (bf16_t*)(ws + OFF_H);
    const float* relb = p.in[2];
    const int lane = tid & 63, w = tid >> 6, hg = w >> 1, th = w & 1, r = lane & 31, h = lane >> 5;
    float* lut = (float*)(lds + AT_LUT);
    float* lutc = (float*)(lds + AT_LUTC);
    float* imp = (float*)(lds + AT_IMP);
    unsigned* selw = (unsigned*)(lds + AT_SEL);
    unsigned short* sel16 = (unsigned short*)selw;
    const int G = gridDim.x, rows_per_it = G >> 3;
    for (int it = 0;; ++it) {
        int u;
        if ((G & 7) == 0) {
            const int rr = blockIdx.x >> 3, cc = blockIdx.x & 7;
            const int rowi = it * rows_per_it + ((it & 1) ? rows_per_it - 1 - rr : rr);
            u = rowi * 8 + cc;
        } else u = it * G + blockIdx.x;
        if (u >= 1024) break;
        const int bi = 127 - (u >> 3), b = (u & 7) >> 1, g = u & 1, head = 4 * g + hg;
        const int tq = 64 * bi + 32 * th + r;
        const int tl = 32 * th + r;
        const long tok = (long)b * SEQ + tq;
        for (int e = tid; e < 4 * LUT_N; e += NTHREADS) { const int hh = e / LUT_N, d = LUT_OFF - (e % LUT_N); lut[e] = d < 0 ? -INFINITY : (d >= 790 ? 0.f : (relb[rel_bucket_i(d) * 8 + 4 * g + hh] - relb[31 * 8 + 4 * g + hh]) * LOG2E); }
        for (int e = tid; e < 4 * 16 * LUTC_W; e += NTHREADS) {
            const int hh = e / (16 * LUTC_W), ph = (e / LUTC_W) & 15, ci = e % LUTC_W, d = 16 * (ci - 1) + ph;
            lutc[e] = ci == 0 ? -INFINITY : (d >= 790 ? 0.f : (relb[rel_bucket_i(d) * 8 + 4 * g + hh] - relb[31 * 8 + 4 * g + hh]) * LOG2E);
        }
        for (int e = tid; e < 64 * 129; e += NTHREADS) imp[e] = 0.f;
        if (tid < 4) selw[256 + tid] = 0u;
        const float* mylut = lut + hg * LUT_N;
        bf16x8 qf[8];
        const bf16_t* qrow = QN + ((long)(b * 8 + head) * SEQ + tq) * 128 + 8 * h;
        auto load_q = [&]() {
#pragma unroll
            for (int ks = 0; ks < 8; ++ks) qf[ks] = *(const bf16x8*)(qrow + 16 * ks);
        };
        load_q();
        const float* gp = gates + tok * 24 + head * 3;
        bf16_t* orow = O + tok * DM + head * 128;
        auto stage = [&](const unsigned char* kg, const unsigned char* vg, unsigned vstride, int kt, unsigned char* st) {
            int t2 = tid; asm volatile("" : "+v"(t2));
            unsigned koff[2], vo[2];
            dma_offsets<256, 64>(koff, 256, t2);
            dma_offsets<128, 128>(vo, vstride, t2);
            dma_issue(st, kg + (long)kt * 16384, koff, t2);
            dma_issue(st + 16384, vg + (long)kt * 128, vo, t2);
        };
        f32x16 o[4];
        float m, l;
        auto reset = [&]() {
#pragma unroll
            for (int dt = 0; dt < 4; ++dt)
#pragma unroll
                for (int i = 0; i < 16; ++i) o[dt][i] = 0.f;
            m = -1e30f; l = 0.f;
        };
        const unsigned char* kcg = (const unsigned char*)(KCMP + (long)(b * 2 + g) * 512 * 128);
        const unsigned char* vcg = (const unsigned char*)(VCMPT + (long)(b * 2 + g) * 128 * 512);
        const int nct = ((4 * bi + 2) >> 6) + 1;
        m = -1e30f; l = 0.f;
        __syncthreads();
        {
            const int cb = (tq - 31) >> 4;
            const float* lc = lutc + (hg * 16 + ((tq - 31) & 15)) * LUTC_W + 1;
            stage(kcg, vcg, 1024u, 0, lds);
            __syncthreads();
            for (int kt = 0; kt < nct; ++kt) {
                unsigned char* cur = lds + (kt & 1) * AT_STAGE;
                if (kt + 1 < nct) stage(kcg, vcg, 1024u, kt + 1, lds + ((kt + 1) & 1) * AT_STAGE);
                const int cbase = cb - kt * 64 - 8 * h;
#pragma unroll
                for (int mt = 0; mt < 2; ++mt) {
                    f32x16 st;
                    attn_qk32<128>(cur, qf, st, mt, r, h);
#pragma unroll
                    for (int i = 0; i < 16; ++i) {
                        const int c = cbase - kidx(mt, i);
                        st[i] += lc[c < -1 ? -1 : (c > 50 ? 50 : c)];
                    }
                    float mx = st[0];
#pragma unroll
                    for (int i = 1; i < 16; ++i) mx = fmaxf(mx, st[i]);
                    mx = fmaxf(mx, __shfl_xor(mx, 32));
                    const float mn = fmaxf(m, mx);
                    l *= fexp2(m - mn); m = mn;
                    float sum = 0.f;
#pragma unroll
                    for (int i = 0; i < 16; ++i) sum += fexp2(st[i] - m);
                    l += sum;
                }
                __syncthreads();
            }
            const float lt = l + __shfl_xor(l, 32);
            const float invl = lt > 0.f ? frcp(lt) : 0.f;
#pragma unroll
            for (int dt = 0; dt < 4; ++dt)
#pragma unroll
                for (int i = 0; i < 16; ++i) o[dt][i] = 0.f;
            stage(kcg, vcg, 1024u, 0, lds);
            __syncthreads();
            for (int kt = 0; kt < nct; ++kt) {
                unsigned char* cur = lds + (kt & 1) * AT_STAGE;
                if (kt + 1 < nct) stage(kcg, vcg, 1024u, kt + 1, lds + ((kt + 1) & 1) * AT_STAGE);
                const int cbase = cb - kt * 64 - 8 * h;
                float* irow = imp + tl * 129 + kt * 16 + 2 * h;
#pragma unroll
                for (int mt = 0; mt < 2; ++mt) {
                    f32x16 st;
                    attn_qk32<128>(cur, qf, st, mt, r, h);
#pragma unroll
                    for (int i = 0; i < 16; ++i) {
                        const int c = cbase - kidx(mt, i);
                        st[i] = fexp2(st[i] + lc[c < -1 ? -1 : (c > 50 ? 50 : c)] - m) * invl;
                    }
#pragma unroll
                    for (int q4 = 0; q4 < 4; ++q4) {
                        const int jo = 8 * mt + 4 * (q4 >> 1) + (q4 & 1);
                        const float a = st[4 * q4] + st[4 * q4 + 1] + st[4 * q4 + 2] + 0.5f * st[4 * q4 + 3];
                        const float c2 = 0.5f * st[4 * q4 + 3];
                        atomicAdd(irow + jo, a);
                        if (kt * 16 + 2 * h + jo + 1 < 128) atomicAdd(irow + jo + 1, c2);
                    }
                    bf16x8 pf[2];
                    attn_pack32(st, pf);
                    attn_pv32(cur + 16384, pf, o, mt, r, h);
                }
                __syncthreads();
            }
        }
        const float g_c = gp[0];
#pragma unroll
        for (int dt = 0; dt < 4; ++dt)
#pragma unroll
            for (int g4 = 0; g4 < 4; ++g4) {
                const int d0 = 32 * dt + 8 * g4 + 4 * h;
                u32x2 ov;
                ov.x = pk2(o[dt][4 * g4 + 0] * g_c, o[dt][4 * g4 + 1] * g_c);
                ov.y = pk2(o[dt][4 * g4 + 2] * g_c, o[dt][4 * g4 + 3] * g_c);
                *(u32x2*)(orow + d0) = ov;
            }
        {
            const int tkn = tid >> 3, part = tid & 7;
            float mine[16];
#pragma unroll
            for (int q = 0; q < 16; ++q) {
                const int j = part * 16 + q;
                float v = imp[tkn * 129 + j];
                const int back = bi - j;
                if (j == 0 || (back >= 0 && back < 2)) v = 1e9f;
                if (back < 0) v = -1e30f;
                mine[q] = v;
            }
            int rank[16];
#pragma unroll
            for (int q = 0; q < 16; ++q) rank[q] = 0;
#pragma unroll 2
            for (int jj = 0; jj < 128; ++jj) {
                float v = imp[tkn * 129 + jj];
                const int back = bi - jj;
                if (jj == 0 || (back >= 0 && back < 2)) v = 1e9f;
                if (back < 0) v = -1e30f;
#pragma unroll
                for (int q = 0; q < 16; ++q) {
                    const int j = part * 16 + q;
                    rank[q] += (v > mine[q] || (v == mine[q] && jj < j)) ? 1 : 0;
                }
            }
            unsigned bits = 0;
#pragma unroll
            for (int q = 0; q < 16; ++q) bits |= (rank[q] < 16 && mine[q] >= 0.f) ? (1u << q) : 0u;
            sel16[tkn * 8 + part] = (unsigned short)bits;
            atomicOr(&selw[256 + (part >> 1)], bits << ((part & 1) * 16));
        }
        __syncthreads();
        const unsigned un0 = selw[256], un1 = selw[257], un2 = selw[258], un3 = selw[259];
        const unsigned char* ksg = (const unsigned char*)(KS + (long)(b * 2 + g) * SEQ * 128);
        const unsigned char* vsg = (const unsigned char*)(VST + (long)(b * 2 + g) * 128 * SEQ);
        reset(); load_q();
        {
            const unsigned long long ulo = ((unsigned long long)(unsigned)__builtin_amdgcn_readfirstlane((int)un1) << 32) | (unsigned)__builtin_amdgcn_readfirstlane((int)un0);
            const unsigned long long uhi = ((unsigned long long)(unsigned)__builtin_amdgcn_readfirstlane((int)un3) << 32) | (unsigned)__builtin_amdgcn_readfirstlane((int)un2);
            auto next_tile = [&](int from) -> int {
                if (from < 64) { const unsigned long long mk = ulo >> from; if (mk) return from + __builtin_ctzll(mk); from = 64; }
                if (from < 128) { const unsigned long long mk = uhi >> (from - 64); if (mk) return from + __builtin_ctzll(mk); }
                return 128;
            };
            int jt = next_tile(0);
            int buf = 0;
            if (jt < 128) stage(ksg, vsg, SEQ * 2u, jt, lds);
            __syncthreads();
            while (jt < 128) {
                unsigned char* cur = lds + buf * AT_STAGE;
                const int jn = next_tile(jt + 1);
                if (jn < 128) stage(ksg, vsg, SEQ * 2u, jn, lds + (buf ^ 1) * AT_STAGE);
                const unsigned wd = selw[tl * 4 + (jt >> 5)];
                const bool mysel = (wd >> (jt & 31)) & 1u;
                if (__any(mysel)) {
                    const int k0 = jt * 64;
                    const bool nearb = (64 * bi + 32 * th) - (k0 + 63) < 790;
                    const int dbase = tq - k0 - 8 * h;
                    const float* lp = mylut + (LUT_OFF - dbase);
#pragma unroll
                    for (int mt = 0; mt < 2; ++mt) {
                        f32x16 st;
                        attn_qk32<128>(cur, qf, st, mt, r, h);
                        if (nearb) {
#pragma unroll
                            for (int i = 0; i < 16; ++i) st[i] += lp[kidx(mt, i)];
                        }
                        if (!mysel) {
#pragma unroll
                            for (int i = 0; i < 16; ++i) st[i] = -INFINITY;
                        }
                        attn_softmax32(st, m, l, o);
                        bf16x8 pf[2];
                        attn_pack32(st, pf);
                        attn_pv32(cur + 16384, pf, o, mt, r, h);
                    }
                }
                __syncthreads();
                buf ^= 1; jt = jn;
            }
        }
        {
            const float lt = l + __shfl_xor(l, 32);
            const float sc = (lt > 0.f ? frcp(lt) : 0.f) * gp[1];
#pragma unroll
            for (int dt = 0; dt < 4; ++dt)
#pragma unroll
                for (int g4 = 0; g4 < 4; ++g4) {
                    const int d0 = 32 * dt + 8 * g4 + 4 * h;
                    const u32x2 pv = *(const u32x2*)(orow + d0);
                    u32x2 ov;
                    ov.x = pk2(bflo(pv.x) + o[dt][4 * g4 + 0] * sc, bfhi(pv.x) + o[dt][4 * g4 + 1] * sc);
                    ov.y = pk2(bflo(pv.y) + o[dt][4 * g4 + 2] * sc, bfhi(pv.y) + o[dt][4 * g4 + 3] * sc);
                    *(u32x2*)(orow + d0) = ov;
                }
        }
        const unsigned char* kwg = (const unsigned char*)(KW + (long)(b * 2 + g) * SEQ * 128);
        const unsigned char* vwg = (const unsigned char*)(VWT + (long)(b * 2 + g) * 128 * SEQ);
        reset(); load_q();
        {
            const int j0 = bi >= 8 ? bi - 8 : 0, nt = bi - j0 + 1;
            stage(kwg, vwg, SEQ * 2u, j0, lds);
            __syncthreads();
            for (int kt = 0; kt < nt; ++kt) {
                unsigned char* cur = lds + (kt & 1) * AT_STAGE;
                if (kt + 1 < nt) stage(kwg, vwg, SEQ * 2u, j0 + kt + 1, lds + ((kt + 1) & 1) * AT_STAGE);
                const int k0 = (j0 + kt) * 64;
                const int dbase = tq - k0 - 8 * h;
                const float* lp = mylut + (LUT_OFF - dbase);
#pragma unroll
                for (int mt = 0; mt < 2; ++mt) {
                    f32x16 st;
                    attn_qk32<128>(cur, qf, st, mt, r, h);
#pragma unroll
                    for (int i = 0; i < 16; ++i) st[i] = kidx(mt, i) <= dbase - 512 ? -INFINITY : st[i] + lp[kidx(mt, i)];
                    attn_softmax32(st, m, l, o);
                    bf16x8 pf[2];
                    attn_pack32(st, pf);
                    attn_pv32(cur + 16384, pf, o, mt, r, h);
                }
                __syncthreads();
            }
        }
        {
            const float lt = l + __shfl_xor(l, 32);
            const float sc = (lt > 0.f ? frcp(lt) : 0.f) * gp[2];
#pragma unroll
            for (int dt = 0; dt < 4; ++dt)
#pragma unroll
                for (int g4 = 0; g4 < 4; ++g4) {
                    const int d0 = 32 * dt + 8 * g4 + 4 * h;
                    const u32x2 pv = *(const u32x2*)(orow + d0);
                    u32x2 ov;
                    ov.x = pk2(bflo(pv.x) + o[dt][4 * g4 + 0] * sc, bfhi(pv.x) + o[dt][4 * g4 + 1] * sc);
                    ov.y = pk2(bflo(pv.y) + o[dt][4 * g4 + 2] * sc, bfhi(pv.y) + o[dt][4 * g4 + 3] * sc);
                    *(u32x2*)(orow + d0) = ov;
                }
        }
        __syncthreads();
    }
}

template <bool FUSE_NORM, bool DRY>
DI void phase_peer_experts(const Params& p, int layer, int tid) {
    unsigned char* ws = p.ws;
    const bf16_t* H = (const bf16_t*)(ws + OFF_H);
    const int* ridx = (const int*)(ws + OFF_RIDX);
    const float* rgate = (const float*)(ws + OFF_RGATE);
    const bf16_t* U = (const bf16_t*)(ws + OFF_PU) + (long)layer * 16384 * 1024;
    const bf16_t* V = (const bf16_t*)(ws + OFF_PV) + (long)layer * 16384 * 1024;
    const float* ada = (const float*)(ws + OFF_ADA);
    float* x = p.out;
    const int lane = tid & 63, gw = blockIdx.x * NWAVES + (tid >> 6), nw = gridDim.x * NWAVES;
    const int sub = lane & 15, grp = lane >> 4;
    for (int tok = gw; tok < NTOK; tok += nw) {
        const int b = tok >> 13;
        const int i0 = ridx[(long)tok * 128 + lane], i1 = ridx[(long)tok * 128 + 64 + lane];
        const float g0 = rgate[(long)tok * 128 + lane], g1 = rgate[(long)tok * 128 + 64 + lane];
        u32x4 hr[8];
#pragma unroll
        for (int t = 0; t < 8; ++t) hr[t] = *(const u32x4*)(H + (long)tok * DM + t * 128 + sub * 8);
        float w0 = 0.f, w1 = 0.f;
        auto uhalf = [&](int ireg, float& wreg) {
#pragma unroll 2
            for (int e4 = 0; e4 < 16; ++e4) {
                const int id = __shfl(ireg, 4 * e4 + grp);
                const bf16_t* urow = U + (long)id * 1024 + sub * 8;
                float a0 = 0.f, a1 = 0.f, a2 = 0.f, a3 = 0.f;
#pragma unroll
                for (int t = 0; t < 8; ++t) {
                    const u32x4 uv = *(const u32x4*)(urow + t * 128);
                    a0 = dot2bf(uv.x, hr[t].x, a0); a1 = dot2bf(uv.y, hr[t].y, a1); a2 = dot2bf(uv.z, hr[t].z, a2); a3 = dot2bf(uv.w, hr[t].w, a3);
                }
                float d = (a0 + a1) + (a2 + a3);
                d += __shfl_xor(d, 1); d += __shfl_xor(d, 2); d += __shfl_xor(d, 4); d += __shfl_xor(d, 8);
                const float act = gelu_tanh(d);
                const float bc = __shfl(act, 16 * (lane & 3));
                if ((lane >> 2) == e4) wreg = bc;
            }
        };
        uhalf(i0, w0); uhalf(i1, w1);
        w0 *= g0; w1 *= g1;
        float acc[16];
#pragma unroll
        for (int i = 0; i < 16; ++i) acc[i] = 0.f;
        auto vhalf = [&](int ireg, float wreg) {
#pragma unroll 4
            for (int e = 0; e < 64; ++e) {
                const int id = __builtin_amdgcn_readlane(ireg, e);
                const float wv = __builtin_bit_cast(float, __builtin_amdgcn_readlane(__builtin_bit_cast(int, wreg), e));
                const bf16_t* vrow = V + (long)id * 1024 + lane * 8;
                const u32x4 v0 = *(const u32x4*)(vrow), v1 = *(const u32x4*)(vrow + 512);
                acc[0] += wv * bflo(v0.x); acc[1] += wv * bfhi(v0.x); acc[2] += wv * bflo(v0.y); acc[3] += wv * bfhi(v0.y);
                acc[4] += wv * bflo(v0.z); acc[5] += wv * bfhi(v0.z); acc[6] += wv * bflo(v0.w); acc[7] += wv * bfhi(v0.w);
                acc[8] += wv * bflo(v1.x); acc[9] += wv * bfhi(v1.x); acc[10] += wv * bflo(v1.y); acc[11] += wv * bfhi(v1.y);
                acc[12] += wv * bflo(v1.z); acc[13] += wv * bfhi(v1.z); acc[14] += wv * bflo(v1.w); acc[15] += wv * bfhi(v1.w);
            }
        };
        vhalf(i0, w0); vhalf(i1, w1);
        const float* gf = ada + b * ADA_STRIDE + layer * 6144 + 5 * 1024;
        float* xr = x + (long)tok * DM;
        float* xw = DRY ? (float*)(ws + OFF_R + 64 * MB) + (long)(tok & 16383) * DM : xr;
        float nv[16]; float ss = 0.f;
#pragma unroll
        for (int hh = 0; hh < 2; ++hh)
#pragma unroll
            for (int q = 0; q < 2; ++q) {
                const int c = hh * 512 + lane * 8 + q * 4;
                const f32x4 xv = *(const f32x4*)(xr + c), gv = *(const f32x4*)(gf + c);
                f32x4 o;
                o.x = xv.x + gv.x * acc[hh * 8 + q * 4 + 0]; o.y = xv.y + gv.y * acc[hh * 8 + q * 4 + 1];
                o.z = xv.z + gv.z * acc[hh * 8 + q * 4 + 2]; o.w = xv.w + gv.w * acc[hh * 8 + q * 4 + 3];
                *(f32x4*)(xw + c) = o;
                nv[hh * 8 + q * 4 + 0] = o.x; nv[hh * 8 + q * 4 + 1] = o.y; nv[hh * 8 + q * 4 + 2] = o.z; nv[hh * 8 + q * 4 + 3] = o.w;
                ss += o.x * o.x + o.y * o.y + o.z * o.z + o.w * o.w;
            }
        if (FUSE_NORM && !DRY) {
            const float rstd = rsqrtf(wave_sum(ss) * (1.f / DM) + EPS);
            bf16_t* h2 = (bf16_t*)(ws + OFF_H2) + (long)tok * DM;
            bf16_t* h1 = (bf16_t*)(ws + OFF_H) + (long)tok * DM;
            const float* kvn = p.in[13]; const float* nm1 = p.in[5] + 1024;
            const float* kvsh = ada + b * ADA_STRIDE + 12288; const float* kvsc = kvsh + 1024;
            const float* m1sh = ada + b * ADA_STRIDE + 6144; const float* m1sc = m1sh + 1024;
#pragma unroll
            for (int hh = 0; hh < 2; ++hh) {
                const int c = hh * 512 + lane * 8;
                u32x4 oa, ob;
                float ta[8], tb[8];
#pragma unroll
                for (int q = 0; q < 8; ++q) {
                    const float xn = nv[hh * 8 + q] * rstd;
                    ta[q] = xn * kvn[c + q] * (1.f + kvsc[c + q]) + kvsh[c + q];
                    tb[q] = xn * nm1[c + q] * (1.f + m1sc[c + q]) + m1sh[c + q];
                }
                oa.x = pk2(ta[0], ta[1]); oa.y = pk2(ta[2], ta[3]); oa.z = pk2(ta[4], ta[5]); oa.w = pk2(ta[6], ta[7]);
                ob.x = pk2(tb[0], tb[1]); ob.y = pk2(tb[2], tb[3]); ob.z = pk2(tb[4], tb[5]); ob.w = pk2(tb[6], tb[7]);
                *(u32x4*)(h2 + c) = oa; *(u32x4*)(h1 + c) = ob;
            }
        }
    }
}

template <bool DRY>
DI void phase_peer_u(const Params& p, int layer, unsigned char* lds, int tid) {
    unsigned char* ws = p.ws;
    const bf16_t* H = (const bf16_t*)(ws + OFF_H);
    const int* ridx = (const int*)(ws + OFF_RIDX);
    float* rgate = (float*)(ws + OFF_RGATE);
    const bf16_t* U = (const bf16_t*)(ws + OFF_PU) + (long)layer * 16384 * 1024;
    const int lane = tid & 63, w = tid >> 6, sub = lane & 3, grp = lane >> 2;
    const int xg = blockIdx.x & 7, lb = blockIdx.x >> 3, nwv = (gridDim.x >> 3) * NWAVES, wv = lb * NWAVES + w;
    unsigned* cl = (unsigned*)(lds + w * 4096);
    unsigned char* hb = lds + w * 4096 + 1024;
    const unsigned long long lt = (1ull << lane) - 1ull;
    if (lb >= (int)(gridDim.x >> 3)) return;
    for (int pass = 0; pass < 2; ++pass) {
        const int sl = xg + 8 * pass;
        int i0 = ridx[(long)wv * 128 + lane], i1 = ridx[(long)wv * 128 + 64 + lane];
        u32x4 h0 = *(const u32x4*)(H + (long)wv * DM + lane * 16), h1 = *(const u32x4*)(H + (long)wv * DM + lane * 16 + 8);
        for (int tok = wv; tok < NTOK; tok += nwv) {
            const bool b0 = (i0 >> 10) == sl, b1 = (i1 >> 10) == sl;
            const unsigned long long m0 = __ballot(b0), m1 = __ballot(b1);
            const int n0 = __popcll(m0), n = n0 + __popcll(m1);
            if (b0) { const int k = __popcll(m0 & lt); cl[2 * k] = lane; cl[2 * k + 1] = i0; }
            if (b1) { const int k = n0 + __popcll(m1 & lt); cl[2 * k] = 64 + lane; cl[2 * k + 1] = i1; }
            *(u32x4*)(hb + lane * 32) = h0; *(u32x4*)(hb + lane * 32 + 16) = h1;
            {
                const int tn = tok + nwv < NTOK ? tok + nwv : tok;
                i0 = ridx[(long)tn * 128 + lane]; i1 = ridx[(long)tn * 128 + 64 + lane];
                h0 = *(const u32x4*)(H + (long)tn * DM + lane * 16); h1 = *(const u32x4*)(H + (long)tn * DM + lane * 16 + 8);
            }
            for (int k0 = 0; k0 < n; k0 += 16) {
                const int k = k0 + grp;
                const bool valid = k < n;
                const int kk = valid ? k : 0;
                const int slot = cl[2 * kk], id = cl[2 * kk + 1];
                const bf16_t* urow = U + (long)id * 1024 + sub * 8;
                float a0 = 0.f, a1 = 0.f, a2 = 0.f, a3 = 0.f;
#pragma unroll
                for (int hf = 0; hf < 2; ++hf) {
                    u32x4 uv[16];
#pragma unroll
                    for (int t = 0; t < 16; ++t) uv[t] = *(const u32x4*)(urow + (16 * hf + t) * 32);
#pragma unroll
                    for (int t = 0; t < 16; ++t) {
                        const u32x4 hv = *(const u32x4*)(hb + (sub + 4 * (16 * hf + t)) * 16);
                        a0 = dot2bf(uv[t].x, hv.x, a0); a1 = dot2bf(uv[t].y, hv.y, a1); a2 = dot2bf(uv[t].z, hv.z, a2); a3 = dot2bf(uv[t].w, hv.w, a3);
                    }
                }
                float d = (a0 + a1) + (a2 + a3);
                d += __shfl_xor(d, 1); d += __shfl_xor(d, 2);
                if (valid && sub == 0) { float* gp = rgate + (long)tok * 128 + slot; float* gw = DRY ? (float*)(ws + OFF_R) + (long)tok * 128 + slot : gp; *gw = *gp * gelu_tanh(d); }
            }
        }
    }
}

template <bool DRY>
DI void phase_peer_v(const Params& p, int layer, int tid) {
    unsigned char* ws = p.ws;
    const int* ridx = (const int*)(ws + OFF_RIDX);
    const float* wact = (const float*)(ws + OFF_RGATE);
    const bf16_t* V = (const bf16_t*)(ws + OFF_PV) + (long)layer * 16384 * 1024;
    const float* ada = (const float*)(ws + OFF_ADA);
    float* x = p.out;
    const int lane = tid & 63, w = tid >> 6, sub = lane & 7, eg = lane >> 3;
    const int xg = blockIdx.x & 7, lb = blockIdx.x >> 3, nwv = (gridDim.x >> 3) * NWAVES, wv = lb * NWAVES + w;
    if (lb >= (int)(gridDim.x >> 3)) return;
    for (int pass = 0; pass < 2; ++pass) {
        const int col0 = 64 * (xg + 8 * pass) + sub * 8;
        const bf16_t* Vc = V + col0;
        int ia[2][2]; float wa[2][2];
#pragma unroll
        for (int q = 0; q < 2; ++q) {
            const long tk = wv + q * nwv;
            ia[q][0] = ridx[tk * 128 + lane]; ia[q][1] = ridx[tk * 128 + 64 + lane];
            wa[q][0] = wact[tk * 128 + lane]; wa[q][1] = wact[tk * 128 + 64 + lane];
        }
        for (int tok = wv; tok < NTOK; tok += 2 * nwv) {
            u32x4 vv[2][16];
            float wc[2][2];
#pragma unroll
            for (int q = 0; q < 2; ++q) {
                wc[q][0] = wa[q][0]; wc[q][1] = wa[q][1];
#pragma unroll
                for (int j = 0; j < 16; ++j) {
                    const int id = __shfl(ia[q][j >> 3], (8 * j + eg) & 63);
                    vv[q][j] = *(const u32x4*)(Vc + (long)id * 1024);
                }
            }
            f32x4 xv[2][2];
#pragma unroll
            for (int q = 0; q < 2; ++q) {
                const float* xr = x + (long)(tok + q * nwv) * DM + col0;
                xv[q][0] = *(const f32x4*)(xr); xv[q][1] = *(const f32x4*)(xr + 4);
            }
#pragma unroll
            for (int q = 0; q < 2; ++q) {
                long tk = tok + (2 + q) * nwv; tk = tk < NTOK ? tk : tok;
                ia[q][0] = ridx[tk * 128 + lane]; ia[q][1] = ridx[tk * 128 + 64 + lane];
                wa[q][0] = wact[tk * 128 + lane]; wa[q][1] = wact[tk * 128 + 64 + lane];
            }
#pragma unroll
            for (int q = 0; q < 2; ++q) {
                float acc[8];
#pragma unroll
                for (int i = 0; i < 8; ++i) acc[i] = 0.f;
#pragma unroll
                for (int j = 0; j < 16; ++j) {
                    const float ww = __shfl(wc[q][j >> 3], (8 * j + eg) & 63); const u32x4 v = vv[q][j];
                    acc[0] += ww * bflo(v.x); acc[1] += ww * bfhi(v.x); acc[2] += ww * bflo(v.y); acc[3] += ww * bfhi(v.y);
                    acc[4] += ww * bflo(v.z); acc[5] += ww * bfhi(v.z); acc[6] += ww * bflo(v.w); acc[7] += ww * bfhi(v.w);
                }
#pragma unroll
                for (int i = 0; i < 8; ++i) { acc[i] += __shfl_xor(acc[i], 8); acc[i] += __shfl_xor(acc[i], 16); acc[i] += __shfl_xor(acc[i], 32); }
                if (eg == 0) {
                    const int tk = tok + q * nwv, b = tk >> 13;
                    const float* gf = ada + b * ADA_STRIDE + layer * 6144 + 5 * 1024 + col0;
                    float* xr = DRY ? (float*)(ws + OFF_R + 16 * MB) + (long)tk * DM + col0 : x + (long)tk * DM + col0;
#pragma unroll
                    for (int c = 0; c < 2; ++c) {
                        const f32x4 gv = *(const f32x4*)(gf + 4 * c);
                        f32x4 o;
                        o.x = xv[q][c].x + gv.x * acc[4 * c + 0]; o.y = xv[q][c].y + gv.y * acc[4 * c + 1];
                        o.z = xv[q][c].z + gv.z * acc[4 * c + 2]; o.w = xv[q][c].w + gv.w * acc[4 * c + 3];
                        *(f32x4*)(xr + 4 * c) = o;
                    }
                }
            }
        }
    }
}

DI void phase_norm2(const float* __restrict__ x, bf16_t* __restrict__ out1, const float* gain1, int sh1, int sc1,
                    bf16_t* __restrict__ out2, const float* gain2, int sh2, int sc2, const float* ada, int tid) {
    const int lane = tid & 63, gw = blockIdx.x * NWAVES + (tid >> 6), nw = gridDim.x * NWAVES;
    for (int tok = gw; tok < NTOK; tok += nw) {
        const int b = tok >> 13;
        f32x4 v[4]; float ss = 0.f;
#pragma unroll
        for (int j = 0; j < 4; ++j) { v[j] = *(const f32x4*)(x + (long)tok * DM + 4 * lane + 256 * j); ss += v[j].x * v[j].x + v[j].y * v[j].y + v[j].z * v[j].z + v[j].w * v[j].w; }
        const float rstd = rsqrtf(wave_sum(ss) * (1.f / DM) + EPS);
        norm_row_write(v, rstd, gain1, ada + b * ADA_STRIDE + sh1, ada + b * ADA_STRIDE + sc1, out1 + (long)tok * DM, lane);
        norm_row_write(v, rstd, gain2, ada + b * ADA_STRIDE + sh2, ada + b * ADA_STRIDE + sc2, out2 + (long)tok * DM, lane);
    }
}

template <int MT, class Epi>
DI void gemm_phase(const bf16_t* A, long lda, int M, const bf16_t* Bt, long ldb, int N, int K, const Epi& epi, unsigned char* lds, int tid) {
    const int ntm = (M + 128 * MT - 1) / (128 * MT), ntn = (N + 255) / 256, nt = ntm * ntn;
    for (int t = blockIdx.x; t < nt; t += gridDim.x) {
        const int tn = t / ntm, tm = t % ntm;
        gemm_tile<MT>(A, lda, M, Bt, ldb, N, K, tm * 128 * MT, tn * 256, epi, lds, tid);
    }
}

#define XB_TMO      128
#define XB_XCNT(j)  (256  + 64 * (j))
#define XB_XSUB(j)  (1280 + 64 * (j))
#define XB_XGEN(j)  (2304 + 64 * (j))
#define XB_TOP      3328
#define XB_TOPGEN   3392
#define XCD_BAR_WORDS 3456
#define XB_SPIN_CAP (1u << 22)
#define LAS __attribute__((address_space(3)))
DI unsigned xb_ld(unsigned* p) { return __hip_atomic_load(p, __ATOMIC_RELAXED, __HIP_MEMORY_SCOPE_AGENT); }
DI unsigned xb_add(unsigned* p, unsigned v) { return __hip_atomic_fetch_add(p, v, __ATOMIC_RELAXED, __HIP_MEMORY_SCOPE_AGENT); }
DI unsigned xb_xcc_id() { return (unsigned)__builtin_amdgcn_s_getreg((3 << 11) | 20) & 0xFu; }
#define XB_SPIN(cond, bar) do { unsigned _sp = 0; while (cond) { __builtin_amdgcn_s_sleep(1); \
    if ((++_sp & 255u) == 0u) { if (xb_ld(&(bar)[XB_TMO])) break; if (_sp > XB_SPIN_CAP) { atomicAdd(&(bar)[XB_TMO], 1u); break; } } } } while (0)
DI void xcd_barrier_complete(unsigned* bar, unsigned x, unsigned& nloc, unsigned& nx) {
    const unsigned G = gridDim.x;
    unsigned sum, cnt, mine, sp = 0u;
    for (;;) {
        sum = 0u; cnt = 0u; mine = 0u;
#pragma unroll
        for (unsigned j = 0; j < 16; ++j) { const unsigned c = xb_ld(&bar[XB_XCNT(j)]); sum += c; cnt += (c > 0u) ? 1u : 0u; mine = (j == x) ? c : mine; }
        if (sum == G) break;
        __builtin_amdgcn_s_sleep(1);
        if ((++sp & 255u) == 0u) { if (xb_ld(&bar[XB_TMO])) break; if (sp > XB_SPIN_CAP) { atomicAdd(&bar[XB_TMO], 1u); break; } }
    }
    nloc = mine > 0u ? mine : 1u; nx = cnt > 0u ? cnt : 1u;
}
DI void xcd_barrier(unsigned* bar, volatile LAS unsigned* st) {
    asm volatile("s_waitcnt vmcnt(0)" ::: "memory");
    __syncthreads();
    if (threadIdx.x == 0) {
        const unsigned x = xb_xcc_id();
        __builtin_amdgcn_s_waitcnt(0);
        unsigned nloc = st[0], nx = st[1];
        if (nloc == 0u) { xcd_barrier_complete(bar, x, nloc, nx); st[0] = nloc; st[1] = nx; }
        const unsigned old = xb_add(&bar[XB_XSUB(x)], 1u);
        const unsigned gen = old / nloc;
        if (old + 1u == (gen + 1u) * nloc) {
            __builtin_amdgcn_fence(__ATOMIC_RELEASE, "agent");
            asm volatile("s_waitcnt vmcnt(0)" ::: "memory");
            const unsigned og = xb_add(&bar[XB_TOP], 1u);
            const unsigned tg = og / nx;
            if (og + 1u == (tg + 1u) * nx) xb_add(&bar[XB_TOPGEN], 1u);
            else XB_SPIN(xb_ld(&bar[XB_TOPGEN]) == tg, bar);
            __builtin_amdgcn_fence(__ATOMIC_ACQUIRE, "agent");
            xb_add(&bar[XB_XGEN(x)], 1u);
            asm volatile("s_waitcnt vmcnt(0)" ::: "memory");
        } else {
            XB_SPIN(xb_ld(&bar[XB_XGEN(x)]) == gen, bar);
            __builtin_amdgcn_fence(__ATOMIC_ACQUIRE, "agent");
            asm volatile("s_waitcnt vmcnt(0)" ::: "memory");
        }
    }
    __syncthreads();
}

DI int ftid() { int t = threadIdx.x; asm volatile("" : "+v"(t)); return t; }

__global__ void __launch_bounds__(NTHREADS) yoco_fwd(Params p) {
    extern __shared__ __attribute__((aligned(16))) unsigned char lds[];
    cg::grid_group grid = cg::this_grid();
    unsigned char* ws = p.ws;
    const float* ada = (const float*)(ws + OFF_ADA);
    bf16_t* Hb = (bf16_t*)(ws + OFF_H);

    unsigned* bar = (unsigned*)(ws + OFF_BAR);
    volatile LAS unsigned* bst = (volatile LAS unsigned*)(lds + 144 * 1024);
    if (threadIdx.x == 0) { bst[0] = 0u; bst[1] = 0u; }
    if (blockIdx.x == 0) for (int i = threadIdx.x; i < XCD_BAR_WORDS; i += NTHREADS) bar[i] = 0u;
    __syncthreads();
    RUN(0) REP(0) phase_prep(p, lds, ftid());
    grid.sync();
    if (threadIdx.x == 0) (void)xb_add(&bar[XB_XCNT(xb_xcc_id())], 1u);
    RUN(1) REP(1) phase_norm(p.in[0], Hb, p.in[5], ada, 0, 1024, ftid());
    xcd_barrier(bar, bst);
    RUN(2) REP(2) {
        EpiQKV0 e{(bf16_t*)(ws + OFF_Q0), (bf16_t*)(ws + OFF_K0), (bf16_t*)(ws + OFF_VT0), p.in[10], p.in[11]};
        gemm_phase<2>(Hb, DM, NTOK, (const bf16_t*)(ws + OFF_WT_DIN), DM, 3072, DM, e, lds, ftid());
    }
    xcd_barrier(bar, bst);
    RUN(3) REP(3) phase_diff_attn(p, lds, ftid());
    xcd_barrier(bar, bst);
    RUN(4) REP(4) {
        EpiResid e{p.in[0], p.out, ada + 2 * 1024};
        gemm_phase<2>(Hb, DM, NTOK, (const bf16_t*)(ws + OFF_WT_DOUT), DM, 1024, DM, e, lds, ftid());
    }
    xcd_barrier(bar, bst);
    if (STOP_AFTER <= 1) return;
    RUN(1) phase_norm(p.out, Hb, p.in[6], ada, 3 * 1024, 4 * 1024, ftid());
    xcd_barrier(bar, bst);
    RUN(5) REP(5) {
        EpiPeer e{(int*)(ws + OFF_RIDX), (float*)(ws + OFF_RGATE), 128 * 1024};
        gemm_phase<2>(Hb, DM, NTOK, (const bf16_t*)(ws + OFF_WT_PEER), DM, 2048, DM, e, lds, ftid());
    }
    xcd_barrier(bar, bst);
    if ((REPEAT_MASK >> 6) & 1) phase_peer_u<true>(p, 0, lds, ftid());
    RUN(6) phase_peer_u<false>(p, 0, lds, ftid());
    xcd_barrier(bar, bst);
    if ((REPEAT_MASK >> 10) & 1) phase_peer_v<true>(p, 0, ftid());
    RUN(6) phase_peer_v<false>(p, 0, ftid());
    xcd_barrier(bar, bst);
    RUN(1) phase_norm2(p.out, (bf16_t*)(ws + OFF_H2), p.in[13], 12288, 12288 + 1024, Hb, p.in[5] + 1024, 6144, 6144 + 1024, ada, ftid());
    xcd_barrier(bar, bst);
    if (STOP_AFTER <= 2) return;
    RUN(7) REP(7) {
        EpiKV e{(bf16_t*)(ws + OFF_KC), (bf16_t*)(ws + OFF_KS), (bf16_t*)(ws + OFF_VST), (bf16_t*)(ws + OFF_KW), (bf16_t*)(ws + OFF_VWT), p.in[21]};
        gemm_phase<2>((const bf16_t*)(ws + OFF_H2), DM, NTOK, (const bf16_t*)(ws + OFF_WT_KV), DM, 1536, DM, e, lds, ftid());
    }
    xcd_barrier(bar, bst);
    RUN(8) REP(8) {
        EpiNsaQ e{(bf16_t*)(ws + OFF_QN), (float*)(ws + OFF_GATES), p.in[25], p.in[23]};
        gemm_phase<2>(Hb, DM, NTOK, (const bf16_t*)(ws + OFF_WT_NIN), DM, 1048, DM, e, lds, ftid());
        for (int t = blockIdx.x; t < 64; t += gridDim.x) {
            const int pr = t >> 2, tm = t & 3, kv = pr >> 3, bg = pr & 7;
            const bf16_t* Ap = (const bf16_t*)(ws + OFF_KC) + (long)(kv * 8 + bg) * SEQ * 128;
            bf16_t* hid = (bf16_t*)(ws + OFF_HID) + (long)pr * 512 * 256;
            EpiCmp1 e1{hid, (const float*)(ws + OFF_POSB) + kv * 16 * 256, p.in[19] + kv * 256};
            gemm_tile<1>(Ap, 2048, 511, (const bf16_t*)(ws + OFF_WT_C1) + (long)kv * 256 * 4096, 4096, 256, 4096, tm * 128, 0, e1, lds, ftid());
            __syncthreads();
            bf16_t* dst = kv == 0 ? (bf16_t*)(ws + OFF_KCMP) + (long)bg * 512 * 128 : (bf16_t*)(ws + OFF_VCMPT) + (long)bg * 128 * 512;
            EpiCmp2 e2{dst, p.in[21], kv};
            gemm_tile<1>(hid, 256, 512, (const bf16_t*)(ws + OFF_WT_C2) + (long)kv * 128 * 256, 256, 128, 256, tm * 128, 0, e2, lds, ftid());
        }
    }
    xcd_barrier(bar, bst);
    RUN(9) REP(9) phase_nsa_attn(p, lds, ftid());
    xcd_barrier(bar, bst);
    RUN(4) {
        EpiResid e{p.out, p.out, ada + 6144 + 2 * 1024};
        gemm_phase<2>(Hb, DM, NTOK, (const bf16_t*)(ws + OFF_WT_NOUT), DM, 1024, DM, e, lds, ftid());
    }
    xcd_barrier(bar, bst);
    if (STOP_AFTER <= 3) return;
    RUN(1) phase_norm(p.out, Hb, p.in[6] + 1024, ada, 6144 + 3 * 1024, 6144 + 4 * 1024, ftid());
    xcd_barrier(bar, bst);
    RUN(5) REP(5) {
        EpiPeer e{(int*)(ws + OFF_RIDX), (float*)(ws + OFF_RGATE), 128 * 1024};
        gemm_phase<2>(Hb, DM, NTOK, (const bf16_t*)(ws + OFF_WT_PEER) + (long)2048 * 1024, DM, 2048, DM, e, lds, ftid());
    }
    xcd_barrier(bar, bst);
    if ((REPEAT_MASK >> 6) & 1) phase_peer_u<true>(p, 1, lds, ftid());
    RUN(6) phase_peer_u<false>(p, 1, lds, ftid());
    xcd_barrier(bar, bst);
    if ((REPEAT_MASK >> 10) & 1) phase_peer_v<true>(p, 1, ftid());
    RUN(6) phase_peer_v<false>(p, 1, ftid());
}

extern "C" void kernel_launch(void* const* d_in, const int* in_sizes, int n_in, void* d_out, int out_size, void* d_ws, size_t ws_size,
                              hipStream_t stream) {
    static int grid_blocks = 0;
    if (grid_blocks == 0) {
        if (n_in != 30 || out_size != NTOK * DM || ws_size < WS_END) {
            fprintf(stderr, "kernel_launch: unexpected shapes (n_in %d out %d ws %zu)\n", n_in, out_size, ws_size);
            grid_blocks = -1; return;
        }
        int dev = 0, cus = 0, per_cu = 0;
        hipGetDevice(&dev);
        hipDeviceGetAttribute(&cus, hipDeviceAttributeMultiprocessorCount, dev);
        hipFuncSetAttribute((const void*)yoco_fwd, hipFuncAttributeMaxDynamicSharedMemorySize, LDS_BYTES);
        hipOccupancyMaxActiveBlocksPerMultiprocessor(&per_cu, (const void*)yoco_fwd, NTHREADS, LDS_BYTES);
        if (per_cu < 1) { fprintf(stderr, "kernel_launch: occupancy query says %d blocks per CU\n", per_cu); grid_blocks = -1; return; }
        grid_blocks = cus;
    }
    if (grid_blocks < 0) return;
    Params p{};
    for (int i = 0; i < 30; ++i) p.in[i] = (const float*)d_in[i];
    p.out = (float*)d_out;
    p.ws = (unsigned char*)d_ws;
    void* args[] = {&p};
    hipError_t e = hipLaunchCooperativeKernel((const void*)yoco_fwd, dim3(grid_blocks), dim3(NTHREADS), args, LDS_BYTES, stream);
    if (e != hipSuccess) fprintf(stderr, "cooperative launch failed: %s (grid %d)\n", hipGetErrorString(e), grid_blocks);
}
```

```cpp
#include <hip/hip_runtime.h>
#include <hip/hip_cooperative_groups.h>
#include <cstdio>
#include <cstdint>
namespace cg = cooperative_groups;

#define DI __device__ __forceinline__
#ifndef STOP_AFTER
#define STOP_AFTER 99
#endif
#ifndef ONLY_PHASE
#define ONLY_PHASE -1
#endif
#define RUN(n) if (ONLY_PHASE < 0 || ONLY_PHASE == (n))
#ifndef REPEAT_MASK
#define REPEAT_MASK 0
#endif
#define REP(n) for (int rep_ = 0; rep_ < (((REPEAT_MASK) >> (n)) & 1) + 1; ++rep_)

typedef unsigned short bf16_t;
typedef short bf16x8 __attribute__((ext_vector_type(8)));
typedef float f32x16 __attribute__((ext_vector_type(16)));
typedef float f32x4 __attribute__((ext_vector_type(4)));
typedef float f32x2 __attribute__((ext_vector_type(2)));
typedef unsigned u32x4 __attribute__((ext_vector_type(4)));
typedef unsigned u32x2 __attribute__((ext_vector_type(2)));
typedef __bf16 bf16x2v __attribute__((ext_vector_type(2)));

#define MFMA32(a, b, c) __builtin_amdgcn_mfma_f32_32x32x16_bf16((a), (b), (c), 0, 0, 0)

constexpr int NB = 4, SEQ = 8192, DM = 1024, NTOK = NB * SEQ;
constexpr int NTHREADS = 512, NWAVES = 8;
constexpr float EPS = 1e-6f;
constexpr float LOG2E = 1.4426950408889634f;
constexpr int ADA_STRIDE = 14336;

constexpr size_t MB = 1u << 20;
constexpr size_t OFF_ADA = 0;
constexpr size_t OFF_POSB = 256 * 1024;
constexpr size_t OFF_BAR = 320 * 1024;
constexpr size_t OFF_USI = 384 * 1024;
constexpr size_t OFF_VSI = 512 * 1024;
constexpr size_t OFF_WT_DIN = 1 * MB;
constexpr size_t OFF_WT_DOUT = 7 * MB;
constexpr size_t OFF_WT_KV = 9 * MB;
constexpr size_t OFF_WT_NIN = 12 * MB;
constexpr size_t OFF_WT_NOUT = 15 * MB;
constexpr size_t OFF_WT_PEER = 17 * MB;
constexpr size_t OFF_WT_C1 = 25 * MB;
constexpr size_t OFF_WT_C2 = 29 * MB;
constexpr size_t OFF_GATES = 30 * MB;
constexpr size_t OFF_KCMP = 34 * MB;
constexpr size_t OFF_VCMPT = 35 * MB;
constexpr size_t OFF_HID = 36 * MB;
constexpr size_t OFF_RIDX = 40 * MB;
constexpr size_t OFF_RGATE = 56 * MB;
constexpr size_t OFF_PU = 72 * MB;
constexpr size_t OFF_PV = 136 * MB;
constexpr size_t OFF_H = 200 * MB;
constexpr size_t OFF_R = 264 * MB;
constexpr size_t WS_END = 456 * MB;
constexpr size_t OFF_Q0 = OFF_R, OFF_K0 = OFF_R + 64 * MB, OFF_VT0 = OFF_R + 128 * MB;
constexpr size_t OFF_QN = OFF_R, OFF_H2 = OFF_R, OFF_KC = OFF_R + 64 * MB, OFF_KS = OFF_R + 96 * MB, OFF_VST = OFF_R + 112 * MB,
                 OFF_KW = OFF_R + 128 * MB, OFF_VWT = OFF_R + 144 * MB;

constexpr int LDS_BYTES = 144 * 1024 + 256;

struct Params {
    const float* in[30];
    float* out;
    unsigned char* ws;
};

template <class T> DI T* opq(T* q) { asm volatile("" : "+s"(q)); return (T*)(__attribute__((address_space(1))) T*)q; }
DI unsigned pk2(float lo, float hi) { f32x2 v = {lo, hi}; return __builtin_bit_cast(unsigned, __builtin_convertvector(v, bf16x2v)); }
DI bf16_t f2bf(float x) { return (bf16_t)(pk2(x, 0.f) & 0xffffu); }
DI float bflo(unsigned u) { return __uint_as_float(u << 16); }
DI float bfhi(unsigned u) { return __uint_as_float(u & 0xffff0000u); }
DI float fexp2(float x) { return __builtin_amdgcn_exp2f(x); }
DI float frcp(float x) { return __builtin_amdgcn_rcpf(x); }
DI int crow(int reg, int h) { return (reg & 3) + 8 * (reg >> 2) + 4 * h; }
template <int CTRL> DI float dpp_f(float v) { return __builtin_bit_cast(float, __builtin_amdgcn_update_dpp(0, __builtin_bit_cast(int, v), CTRL, 0xF, 0xF, true)); }
DI float lx1(float v) { return dpp_f<0xB1>(v); }
DI float lx2(float v) { return dpp_f<0x4E>(v); }
DI float lhm(float v) { return dpp_f<0x141>(v); }
DI float lr8(float v) { return dpp_f<0x128>(v); }
DI float sum_x16(float v) { auto s = __builtin_amdgcn_permlane16_swap(__float_as_uint(v), __float_as_uint(v), false, false); return __uint_as_float(s[0]) + __uint_as_float(s[1]); }
DI float sum_x32(float v) { auto s = __builtin_amdgcn_permlane32_swap(__float_as_uint(v), __float_as_uint(v), false, false); return __uint_as_float(s[0]) + __uint_as_float(s[1]); }
DI float max_x16(float v) { auto s = __builtin_amdgcn_permlane16_swap(__float_as_uint(v), __float_as_uint(v), false, false); return fmaxf(__uint_as_float(s[0]), __uint_as_float(s[1])); }
DI float max_x32(float v) { auto s = __builtin_amdgcn_permlane32_swap(__float_as_uint(v), __float_as_uint(v), false, false); return fmaxf(__uint_as_float(s[0]), __uint_as_float(s[1])); }
DI unsigned get_x32(unsigned v, int h) { auto s = __builtin_amdgcn_permlane32_swap(v, v, false, false); return h ? s[0] : s[1]; }
DI float wave_sum(float v) { v += lx1(v); v += lx2(v); v += lhm(v); v += lr8(v); v = sum_x16(v); return sum_x32(v); }
DI float wave_max(float v) { v = fmaxf(v, lx1(v)); v = fmaxf(v, lx2(v)); v = fmaxf(v, lhm(v)); v = fmaxf(v, lr8(v)); v = max_x16(v); return max_x32(v); }
DI int bperm(int v, int srclane) { return __builtin_amdgcn_ds_bpermute(srclane << 2, v); }
DI float bpermf(float v, int srclane) { return __builtin_bit_cast(float, __builtin_amdgcn_ds_bpermute(srclane << 2, __builtin_bit_cast(int, v))); }
DI float gelu_tanh(float x) {
    const float u = 0.7978845608028654f * (x + 0.044715f * x * x * x);
    return x * frcp(1.f + fexp2(-2.f * LOG2E * u));
}
DI float dot2bf(unsigned a, unsigned b, float c) {
    return __builtin_amdgcn_fdot2_f32_bf16(__builtin_bit_cast(bf16x2v, a), __builtin_bit_cast(bf16x2v, b), c, false);
}
DI int rel_bucket_i(int d) {
    if (d < 16) return d < 0 ? 0 : d;
    int b = 16;
    b += d >= 21; b += d >= 27; b += d >= 35; b += d >= 46; b += d >= 59; b += d >= 77; b += d >= 99; b += d >= 128;
    b += d >= 166; b += d >= 216; b += d >= 280; b += d >= 363; b += d >= 470; b += d >= 609; b += d >= 790;
    return b;
}
DI unsigned f2key(float f) { unsigned u = __float_as_uint(f); return u ^ ((unsigned)((int)u >> 31) | 0x80000000u); }
DI float key2f(unsigned k) { unsigned u = (k & 0x80000000u) ? (k ^ 0x80000000u) : ~k; return __uint_as_float(u); }

constexpr int EPI_LDS = 96 * 1024;

DI int sw2(int row, int chunk) { return (row >> 1) * 256 + (((((row & 1) << 3) | chunk) ^ ((row >> 1) & 15)) << 4); }
DI void sw2_src(int P, int& row, int& chunk) { const int R2 = P >> 4, lc = (P & 15) ^ (R2 & 15); row = 2 * R2 + (lc >> 3); chunk = lc & 7; }

template <class T, class = void> struct epi_stash { static constexpr bool value = false, present = false; };
template <class T> struct epi_stash<T, decltype((void)T::STASH)> { static constexpr bool value = T::STASH, present = true; };

template <int MT, class Epi>
DI void gemm_tile(const bf16_t* __restrict__ A, long lda, int M, const bf16_t* __restrict__ Bt, long ldb, int N, int K,
                  int m0, int n0, const Epi& epi, unsigned char* lds, int tid) {
    constexpr int XS = MT * 128 * 128, WS = 256 * 128, STAGE = XS + WS;
    const int lane = tid & 63, w = tid >> 6, tg = w & 3, fh = w >> 2, r = lane & 31, h = lane >> 5;
    const int wbase = tid & ~63;
    unsigned xo[2 * MT], wo[4];
#pragma unroll
    for (int i = 0; i < 2 * MT; ++i) { int row, c; sw2_src(tid + 512 * i, row, c); int m = m0 + row; m = m < M ? m : M - 1; xo[i] = (unsigned)m * (unsigned)(lda * 2) + c * 16; }
#pragma unroll
    for (int i = 0; i < 4; ++i) { int row, c; sw2_src(tid + 512 * i, row, c); int n = n0 + row; n = n < N ? n : N - 1; wo[i] = (unsigned)n * (unsigned)(ldb * 2) + c * 16; }
    const unsigned char* Ab = (const unsigned char*)A;
    const unsigned char* Bb = (const unsigned char*)Bt;
    auto stage = [&](int kt, unsigned char* st) {
#pragma unroll
        for (int i = 0; i < 2 * MT; ++i)
            __builtin_amdgcn_global_load_lds((const unsigned*)(Ab + kt * 128 + xo[i]), (unsigned*)(st + (wbase + 512 * i) * 16), 16, 0, 0);
#pragma unroll
        for (int i = 0; i < 4; ++i)
            __builtin_amdgcn_global_load_lds((const unsigned*)(Bb + kt * 128 + wo[i]), (unsigned*)(st + XS + (wbase + 512 * i) * 16), 16, 0, 0);
    };
    f32x16 acc[MT][4];
#pragma unroll
    for (int s2 = 0; s2 < MT; ++s2)
#pragma unroll
        for (int i = 0; i < 4; ++i)
#pragma unroll
            for (int j = 0; j < 16; ++j) acc[s2][i][j] = 0.f;
    const int nk = K >> 6;
    stage(0, lds);
    __syncthreads();
    for (int kt = 0; kt < nk; ++kt) {
        unsigned char* cur = lds + (kt & 1) * STAGE;
        if (kt + 1 < nk) stage(kt + 1, lds + ((kt + 1) & 1) * STAGE);
#pragma unroll
        for (int ks = 0; ks < 4; ++ks) {
            bf16x8 xf[MT];
#pragma unroll
            for (int s2 = 0; s2 < MT; ++s2) xf[s2] = *(const bf16x8*)(cur + sw2(32 * MT * tg + 32 * s2 + r, 2 * ks + h));
#pragma unroll
            for (int mt = 0; mt < 4; ++mt) {
                const bf16x8 wf = *(const bf16x8*)(cur + XS + sw2(128 * fh + 32 * mt + r, 2 * ks + h));
#pragma unroll
                for (int s2 = 0; s2 < MT; ++s2) acc[s2][mt] = MFMA32(wf, xf[s2], acc[s2][mt]);
            }
        }
        __syncthreads();
    }
    if constexpr (MT == 2 && epi_stash<Epi>::value) {
        float* sp = (float*)lds + w * 4096 + lane;
#pragma unroll
        for (int mt = 0; mt < 4; ++mt)
#pragma unroll
            for (int j = 0; j < 16; ++j) sp[(mt * 16 + j) * 64] = acc[1][mt][j];
        epi(acc[0], m0 + 64 * tg + r, n0 + 128 * fh, h, lds, tid);
        f32x16 a2[4];
        const float* sp2 = sp; asm volatile("" : "+v"(sp2));
#pragma unroll
        for (int mt = 0; mt < 4; ++mt)
#pragma unroll
            for (int j = 0; j < 16; ++j) a2[mt][j] = sp2[(mt * 16 + j) * 64];
        epi(a2, m0 + 64 * tg + 32 + r, n0 + 128 * fh, h, lds, tid);
        __syncthreads();
    } else {
        int ho = h, ro = r, to = tid;
        if constexpr (epi_stash<Epi>::present) asm volatile("" : "+v"(ho), "+v"(ro), "+v"(to));
#pragma unroll
        for (int s2 = 0; s2 < MT; ++s2) epi(acc[s2], m0 + 32 * MT * tg + 32 * s2 + ro, n0 + 128 * fh, ho, lds, to);
    }
}

struct EpiQKV0 {
    bf16_t *Q, *Kk, *VT;
    const float *qg, *kg;
    DI void operator()(const f32x16 (&acc)[4], int tok, int fbase, int h, unsigned char*, int) const {
        const int sec = fbase >> 10, hd = (fbase & 1023) >> 7, b = tok >> 13, s = tok & (SEQ - 1);
        if (sec < 2) {
            const float* gn = sec == 0 ? qg : kg;
            const float sc = sec == 0 ? 0.125f * LOG2E : 1.f;
            bf16_t* dst = sec == 0 ? Q : Kk;
#pragma unroll
            for (int j = 0; j < 2; ++j) {
                float ss = 0.f;
#pragma unroll
                for (int mt = 0; mt < 2; ++mt)
#pragma unroll
                    for (int rg = 0; rg < 16; ++rg) { const float v = acc[2 * j + mt][rg]; ss += v * v; }
                ss = sum_x32(ss);
                const float rstd = rsqrtf(ss * (1.f / 64.f) + EPS) * sc;
                bf16_t* row = dst + ((long)((b * 8 + hd) * 2 + j) * SEQ + s) * 64;
#pragma unroll
                for (int mt = 0; mt < 2; ++mt)
#pragma unroll
                    for (int g4 = 0; g4 < 4; ++g4) {
                        const int d0 = 32 * mt + 8 * g4 + 4 * h;
                        const f32x4 gv = *(const f32x4*)(gn + d0);
                        u32x2 o;
                        o.x = pk2(acc[2 * j + mt][4 * g4 + 0] * rstd * gv.x, acc[2 * j + mt][4 * g4 + 1] * rstd * gv.y);
                        o.y = pk2(acc[2 * j + mt][4 * g4 + 2] * rstd * gv.z, acc[2 * j + mt][4 * g4 + 3] * rstd * gv.w);
                        *(u32x2*)(row + d0) = o;
                    }
            }
        } else {
            bf16_t* base = VT + (long)(b * 8 + hd) * 128 * SEQ + s;
#pragma unroll
            for (int mt = 0; mt < 4; ++mt)
#pragma unroll
                for (int rg = 0; rg < 16; ++rg) base[(long)(32 * mt + crow(rg, h)) * SEQ] = f2bf(acc[mt][rg]);
        }
    }
};

struct EpiResid {
    const float* xin; float* xout; const float* gate;
    DI void operator()(const f32x16 (&acc)[4], int tok, int fbase, int h, unsigned char*, int) const {
        const int b = tok >> 13;
        const float* gp = gate + b * ADA_STRIDE;
#pragma unroll
        for (int mt = 0; mt < 4; ++mt)
#pragma unroll
            for (int g4 = 0; g4 < 4; ++g4) {
                const int f = fbase + 32 * mt + 8 * g4 + 4 * h;
                const f32x4 xv = *(const f32x4*)(xin + (long)tok * DM + f);
                const f32x4 gv = *(const f32x4*)(gp + f);
                f32x4 o;
                o.x = xv.x + gv.x * acc[mt][4 * g4 + 0]; o.y = xv.y + gv.y * acc[mt][4 * g4 + 1];
                o.z = xv.z + gv.z * acc[mt][4 * g4 + 2]; o.w = xv.w + gv.w * acc[mt][4 * g4 + 3];
                *(f32x4*)(xout + (long)tok * DM + f) = o;
                if (g4 == 3) __builtin_amdgcn_sched_barrier(0);
            }
    }
};

struct EpiKV {
    bf16_t *KC, *KS, *VST, *KW, *VWT;
    const float* kgain;
    DI void operator()(const f32x16 (&acc)[4], int tok, int fbase, int h, unsigned char*, int) const {
        const int c = fbase >> 7, br = c >> 2, kv = (c >> 1) & 1, g = c & 1, b = tok >> 13, s = tok & (SEQ - 1);
        if (br == 0 || kv == 0) {
            float rstd = 1.f;
            bf16_t* row;
            if (br == 0) row = KC + ((long)((kv * 4 + b) * 2 + g) * SEQ + s) * 128;
            else {
                float ss = 0.f;
#pragma unroll
                for (int mt = 0; mt < 4; ++mt)
#pragma unroll
                    for (int rg = 0; rg < 16; ++rg) ss += acc[mt][rg] * acc[mt][rg];
                ss = sum_x32(ss);
                rstd = rsqrtf(ss * (1.f / 128.f) + EPS);
                row = (br == 1 ? KS : KW) + ((long)(b * 2 + g) * SEQ + s) * 128;
            }
#pragma unroll
            for (int mt = 0; mt < 4; ++mt)
#pragma unroll
                for (int g4 = 0; g4 < 4; ++g4) {
                    const int d0 = 32 * mt + 8 * g4 + 4 * h;
                    f32x4 gv = {1.f, 1.f, 1.f, 1.f};
                    if (br != 0) gv = *(const f32x4*)(kgain + br * 128 + d0);
                    u32x2 o;
                    o.x = pk2(acc[mt][4 * g4 + 0] * rstd * gv.x, acc[mt][4 * g4 + 1] * rstd * gv.y);
                    o.y = pk2(acc[mt][4 * g4 + 2] * rstd * gv.z, acc[mt][4 * g4 + 3] * rstd * gv.w);
                    *(u32x2*)(row + d0) = o;
                }
        } else {
            bf16_t* base = (br == 1 ? VST : VWT) + (long)(b * 2 + g) * 128 * SEQ + s;
#pragma unroll
            for (int mt = 0; mt < 4; ++mt)
#pragma unroll
                for (int rg = 0; rg < 16; ++rg) base[(long)(32 * mt + crow(rg, h)) * SEQ] = f2bf(acc[mt][rg]);
        }
    }
};

struct EpiCmp1 {
    bf16_t* hid; const float* posb_part; const float* b1;
    DI void operator()(const f32x16 (&acc)[4], int tok, int fbase, int h, unsigned char*, int) const {
        if (tok >= 512) return;
#pragma unroll
        for (int mt = 0; mt < 4; ++mt)
#pragma unroll
            for (int g4 = 0; g4 < 4; ++g4) {
                const int f = fbase + 32 * mt + 8 * g4 + 4 * h;
                f32x4 pb = *(const f32x4*)(b1 + f);
                for (int c = 0; c < 16; ++c) { const f32x4 t = *(const f32x4*)(posb_part + c * 256 + f); pb.x += t.x; pb.y += t.y; pb.z += t.z; pb.w += t.w; }
                u32x2 o;
                o.x = pk2(gelu_tanh(acc[mt][4 * g4 + 0] + pb.x), gelu_tanh(acc[mt][4 * g4 + 1] + pb.y));
                o.y = pk2(gelu_tanh(acc[mt][4 * g4 + 2] + pb.z), gelu_tanh(acc[mt][4 * g4 + 3] + pb.w));
                *(u32x2*)(hid + (long)tok * 256 + f) = o;
            }
    }
};

struct EpiCmp2 {
    bf16_t* dst; const float* kgain0; int kv;
    DI void operator()(const f32x16 (&acc)[4], int tok, int fbase, int h, unsigned char*, int) const {
        if (fbase != 0 || tok >= 512) return;
        const float valid = tok < 511 ? 1.f : 0.f;
        if (kv == 0) {
            float ss = 0.f;
#pragma unroll
            for (int mt = 0; mt < 4; ++mt)
#pragma unroll
                for (int rg = 0; rg < 16; ++rg) ss += acc[mt][rg] * acc[mt][rg];
            ss = sum_x32(ss);
            const float rstd = rsqrtf(ss * (1.f / 128.f) + EPS) * valid;
#pragma unroll
            for (int mt = 0; mt < 4; ++mt)
#pragma unroll
                for (int g4 = 0; g4 < 4; ++g4) {
                    const int d0 = 32 * mt + 8 * g4 + 4 * h;
                    const f32x4 gv = *(const f32x4*)(kgain0 + d0);
                    u32x2 o;
                    o.x = pk2(acc[mt][4 * g4 + 0] * rstd * gv.x, acc[mt][4 * g4 + 1] * rstd * gv.y);
                    o.y = pk2(acc[mt][4 * g4 + 2] * rstd * gv.z, acc[mt][4 * g4 + 3] * rstd * gv.w);
                    *(u32x2*)(dst + (long)tok * 128 + d0) = o;
                }
        } else {
#pragma unroll
            for (int mt = 0; mt < 4; ++mt)
#pragma unroll
                for (int rg = 0; rg < 16; ++rg) dst[(long)(32 * mt + crow(rg, h)) * 512 + tok] = f2bf(acc[mt][rg] * valid);
        }
    }
};

struct EpiNsaQ {
    bf16_t* QN; float* gates; const float* qgain; const float* bgate;
    DI void operator()(const f32x16 (&acc)[4], int tok, int fbase, int h, unsigned char*, int) const {
        const int b = tok >> 13, s = tok & (SEQ - 1);
        if (fbase < 1024) {
            const int head = fbase >> 7;
            float ss = 0.f;
#pragma unroll
            for (int mt = 0; mt < 4; ++mt)
#pragma unroll
                for (int rg = 0; rg < 16; ++rg) ss += acc[mt][rg] * acc[mt][rg];
            ss = sum_x32(ss);
            const float rstd = rsqrtf(ss * (1.f / 128.f) + EPS) * (0.08838834764831845f * LOG2E);
            bf16_t* row = QN + ((long)(b * 8 + head) * SEQ + s) * 128;
#pragma unroll
            for (int mt = 0; mt < 4; ++mt)
#pragma unroll
                for (int g4 = 0; g4 < 4; ++g4) {
                    const int d0 = 32 * mt + 8 * g4 + 4 * h;
                    const f32x4 gv = *(const f32x4*)(qgain + d0);
                    u32x2 o;
                    o.x = pk2(acc[mt][4 * g4 + 0] * rstd * gv.x, acc[mt][4 * g4 + 1] * rstd * gv.y);
                    o.y = pk2(acc[mt][4 * g4 + 2] * rstd * gv.z, acc[mt][4 * g4 + 3] * rstd * gv.w);
                    *(u32x2*)(row + d0) = o;
                }
        } else if (fbase == 1024) {
#pragma unroll
            for (int rg = 0; rg < 16; ++rg) {
                const int f = crow(rg, h);
                if (f < 24) { const float z = acc[0][rg] + bgate[f]; gates[(long)tok * 24 + f] = frcp(1.f + fexp2(-LOG2E * z)); }
            }
        }
    }
};

struct EpiPeer {
    static constexpr bool STASH = false;
    int* ridx; float* rgate; int ex_off;
    DI void operator()(const f32x16 (&acc)[4], int tok, int fbase, int h, unsigned char* lds, int tid) const {
        const int lane = tid & 63, w = tid >> 6, tg = w & 3, fh = w >> 2, r = lane & 31;
        const int hd = fbase >> 8;
        unsigned* EX = (unsigned*)(lds + ex_off);
        unsigned L[16];
#pragma unroll
        for (int i = 0; i < 16; ++i) L[i] = 0u;
#pragma unroll
        for (int mt = 0; mt < 4; ++mt)
#pragma unroll
            for (int rg = 0; rg < 16; ++rg) {
                const int kidx = 32 * mt + crow(rg, h);
                unsigned x = (f2key(acc[mt][rg]) & ~127u) | (unsigned)(127 - kidx);
#pragma unroll
                for (int i = 0; i < 16; ++i) { const unsigned t = L[i] > x ? L[i] : x; x = L[i] > x ? x : L[i]; L[i] = t; }
            }
        {
            unsigned P[16];
#pragma unroll
            for (int i = 0; i < 16; ++i) P[i] = get_x32(L[i], h);
#pragma unroll
            for (int i = 0; i < 16; ++i) L[i] = L[i] > P[15 - i] ? L[i] : P[15 - i];
#pragma unroll
            for (int st = 8; st >= 1; st >>= 1)
#pragma unroll
                for (int i = 0; i < 16; ++i)
                    if ((i & st) == 0) { const unsigned a = L[i], b2 = L[i + st]; L[i] = a > b2 ? a : b2; L[i + st] = a > b2 ? b2 : a; }
        }
        if (h == 0) {
#pragma unroll
            for (int i = 0; i < 16; i += 4) *(u32x4*)(EX + ((fh * 4 + tg) * 32 + r) * 16 + i) = (u32x4){L[i], L[i + 1], L[i + 2], L[i + 3]};
        }
        __syncthreads();
        unsigned X[16], Y[16];
        {
            const unsigned* l0 = EX + ((0 * 4 + tg) * 32 + r) * 16;
            const unsigned* l1 = EX + ((1 * 4 + tg) * 32 + r) * 16;
            const unsigned* px = h ? l1 : l0;
            const unsigned* py = h ? l0 : l1;
#pragma unroll
            for (int i = 0; i < 16; i += 4) {
                const u32x4 a = *(const u32x4*)(px + i), b2 = *(const u32x4*)(py + i);
                X[i] = a.x; X[i + 1] = a.y; X[i + 2] = a.z; X[i + 3] = a.w;
                Y[i] = b2.x; Y[i + 1] = b2.y; Y[i + 2] = b2.z; Y[i + 3] = b2.w;
            }
        }
        unsigned T[16];
#pragma unroll
        for (int i = 0; i < 16; ++i) T[i] = 0u;
#pragma unroll
        for (int i = 0; i < 16; ++i)
#pragma unroll
            for (int j = i; j < 16; ++j) {
                if ((i + 1) * (j + 1) > 16) continue;
                const float fs = key2f(X[i] & ~127u) + key2f(Y[j] & ~127u);
                const unsigned code = h ? (unsigned)((j << 4) | i) : (unsigned)((i << 4) | j);
                unsigned x = (f2key(fs) & ~255u) | (255u - code);
                if (i == j) x = h ? 0u : x;
#pragma unroll
                for (int k = 0; k < 16; ++k) { const unsigned t = T[k] > x ? T[k] : x; x = T[k] > x ? x : T[k]; T[k] = t; }
            }
        {
            unsigned P[16];
#pragma unroll
            for (int i = 0; i < 16; ++i) P[i] = get_x32(T[i], h);
#pragma unroll
            for (int i = 0; i < 16; ++i) T[i] = T[i] > P[15 - i] ? T[i] : P[15 - i];
#pragma unroll
            for (int st = 8; st >= 1; st >>= 1)
#pragma unroll
                for (int i = 0; i < 16; ++i)
                    if ((i & st) == 0) { const unsigned a = T[i], b2 = T[i + st]; T[i] = a > b2 ? a : b2; T[i + st] = a > b2 ? b2 : a; }
        }
        float sc[16], sum = 0.f;
        const float mx = key2f(T[0] & ~255u);
#pragma unroll
        for (int k = 0; k < 16; ++k) { sc[k] = fexp2((key2f(T[k] & ~255u) - mx) * LOG2E); sum += sc[k]; }
        const float inv = frcp(sum);
        if (h == 0) {
            const unsigned* l0 = EX + ((0 * 4 + tg) * 32 + r) * 16;
            const unsigned* l1 = EX + ((1 * 4 + tg) * 32 + r) * 16;
#pragma unroll
            for (int k = 0; k < 16; ++k) {
                if ((k >> 3) != fh) continue;
                const unsigned code = 255u - (T[k] & 255u);
                const int i1 = 127 - (int)(l0[code >> 4] & 127u), i2 = 127 - (int)(l1[code & 15u] & 127u);
                ridx[(long)tok * 128 + hd * 16 + k] = i1 * 128 + i2;
                rgate[(long)tok * 128 + hd * 16 + k] = sc[k] * inv;
            }
        }
        __syncthreads();
    }
};

DI void p0_transpose_item(const float* __restrict__ W, int K, int N, bf16_t* __restrict__ WT, int item, int ntn, unsigned char* lds, int tid) {
    float* tile = (float*)lds;
    const int kb = item / ntn, nb = item % ntn, k0 = kb * 64, n0 = nb * 64;
    {
        const int nn = tid & 63, kk0 = tid >> 6;
#pragma unroll
        for (int i = 0; i < 8; ++i) { const int kk = kk0 + 8 * i; const int n = n0 + nn; tile[kk * 65 + nn] = n < N ? W[(long)(k0 + kk) * N + n] : 0.f; }
    }
    __syncthreads();
    {
        const int n = tid >> 3, c = tid & 7;
        const float* s = tile + (8 * c) * 65 + n;
        u32x4 o;
        o.x = pk2(s[0], s[65]); o.y = pk2(s[2 * 65], s[3 * 65]); o.z = pk2(s[4 * 65], s[5 * 65]); o.w = pk2(s[6 * 65], s[7 * 65]);
        *(u32x4*)(WT + (long)(n0 + n) * K + k0 + 8 * c) = o;
    }
    __syncthreads();
}

DI void p0_fp8_item(const float* __restrict__ src, unsigned char* __restrict__ dst, float* __restrict__ sinv, bool sliced, int item, int tid) {
    const int lane = tid & 63, row = item * 8 + (tid >> 6);
    const float* rp = src + (long)row * 1024;
    f32x4 v[4]; float am = 0.f;
#pragma unroll
    for (int j = 0; j < 4; ++j) {
        v[j] = *(const f32x4*)(rp + 4 * lane + 256 * j);
        am = fmaxf(am, fmaxf(fmaxf(fabsf(v[j].x), fabsf(v[j].y)), fmaxf(fabsf(v[j].z), fabsf(v[j].w))));
    }
    am = wave_max(am);
    const float sc = am > 0.f ? exp2f(floorf(log2f(384.f / am))) : 1.f;
    if (lane == 0) sinv[row] = 1.f / sc;
#pragma unroll
    for (int j = 0; j < 4; ++j) {
        int pk = 0;
        pk = __builtin_amdgcn_cvt_pk_fp8_f32(v[j].x * sc, v[j].y * sc, pk, false);
        pk = __builtin_amdgcn_cvt_pk_fp8_f32(v[j].z * sc, v[j].w * sc, pk, true);
        const int col = 4 * lane + 256 * j;
        unsigned char* d = sliced ? dst + ((long)(col >> 7) * 16384 + row) * 128 + (col & 127) : dst + (long)row * 1024 + col;
        *(int*)d = pk;
    }
}

DI void p0_weff_item(const float* __restrict__ wq, const float* __restrict__ subk, bf16_t* __restrict__ WT, int item, unsigned char* lds, int tid) {
    const int layer = item >> 8, g = (item >> 4) & 15, ct = item & 15, p = g & 1, c0 = ct * 64;
    float* As = (float*)lds;
    float* Bs = As + 64 * 129;
    const float* wql = wq + (long)layer * 1024 * 2048;
    const float* sk = subk + ((long)layer * 2 + p) * 128 * 128;
    for (int e = tid; e < 64 * 128; e += NTHREADS) { const int c = e >> 7, d = e & 127; As[c * 129 + d] = wql[(long)(c0 + c) * 2048 + g * 128 + d]; }
    for (int e = tid; e < 128 * 128; e += NTHREADS) { const int k = e >> 7, d = e & 127; Bs[k * 129 + d] = sk[k * 128 + d]; }
    __syncthreads();
    const int k = tid & 127, cg4 = tid >> 7;
    float acc[16];
#pragma unroll
    for (int i = 0; i < 16; ++i) acc[i] = 0.f;
    for (int d = 0; d < 128; ++d) {
        const float bv = Bs[k * 129 + d];
#pragma unroll
        for (int i = 0; i < 16; ++i) acc[i] += As[(cg4 * 16 + i) * 129 + d] * bv;
    }
    bf16_t* o = WT + ((long)layer * 2048 + g * 128 + k) * 1024 + c0 + cg4 * 16;
    u32x4 o0, o1;
    o0.x = pk2(acc[0], acc[1]); o0.y = pk2(acc[2], acc[3]); o0.z = pk2(acc[4], acc[5]); o0.w = pk2(acc[6], acc[7]);
    o1.x = pk2(acc[8], acc[9]); o1.y = pk2(acc[10], acc[11]); o1.z = pk2(acc[12], acc[13]); o1.w = pk2(acc[14], acc[15]);
    *(u32x4*)o = o0; *(u32x4*)(o + 8) = o1;
    __syncthreads();
}

DI void p0_posb_item(const float* __restrict__ pos, const float* __restrict__ w1, float* __restrict__ part, int item, unsigned char* lds, int tid) {
    const int kv = item >> 4, ch = item & 15;
    float* red = (float*)lds;
    const int j = tid & 255, half = tid >> 8;
    const float* pp = pos + (long)kv * 4096 + ch * 256 + half * 128;
    const float* ww = w1 + ((long)kv * 4096 + ch * 256 + half * 128) * 256 + j;
    float a = 0.f;
    for (int f = 0; f < 128; ++f) a += pp[f] * ww[(long)f * 256];
    red[half * 256 + j] = a;
    __syncthreads();
    if (tid < 256) part[(kv * 16 + ch) * 256 + tid] = red[tid] + red[256 + tid];
    __syncthreads();
}

DI void p0_ada_item(const Params& p, float* __restrict__ ada, int item, unsigned char* lds, int tid) {
    float* cact = (float*)lds;
    float* red = cact + 4096;
    const float* c = p.in[1];
    for (int e = tid; e < 4096; e += NTHREADS) { const float v = c[e]; cact[e] = v * frcp(1.f + fexp2(-LOG2E * v)); }
    __syncthreads();
    const int colg = item * 64;
    const float* W; const float* bias; int N, n0;
    if (colg < 6144) { W = p.in[3]; bias = p.in[4]; N = 6144; n0 = colg; }
    else if (colg < 12288) { W = p.in[3] + (long)1024 * 6144; bias = p.in[4] + 6144; N = 6144; n0 = colg - 6144; }
    else { W = p.in[14]; bias = p.in[15]; N = 2048; n0 = colg - 12288; }
    const int col = tid & 63, kg = tid >> 6;
    float a0 = 0.f, a1 = 0.f, a2 = 0.f, a3 = 0.f;
    const float* wp = W + (long)(kg * 128) * N + n0 + col;
#pragma unroll 8
    for (int k = 0; k < 128; ++k) {
        const float wv = wp[(long)k * N];
        const int kk = kg * 128 + k;
        a0 += cact[kk] * wv; a1 += cact[1024 + kk] * wv; a2 += cact[2048 + kk] * wv; a3 += cact[3072 + kk] * wv;
    }
    red[(kg * 4 + 0) * 64 + col] = a0; red[(kg * 4 + 1) * 64 + col] = a1; red[(kg * 4 + 2) * 64 + col] = a2; red[(kg * 4 + 3) * 64 + col] = a3;
    __syncthreads();
    if (tid < 256) {
        const int b = tid >> 6, cc = tid & 63;
        float s = bias[n0 + cc];
#pragma unroll
        for (int q = 0; q < 8; ++q) s += red[(q * 4 + b) * 64 + cc];
        ada[b * ADA_STRIDE + colg + cc] = s;
    }
    __syncthreads();
}

constexpr int P0_CONV = 8192, P0_TR_DIN = 768, P0_TR_DOUT = 256, P0_TR_KV = 384, P0_TR_NIN = 288, P0_TR_NOUT = 256, P0_TR_C1 = 512, P0_TR_C2 = 16,
              P0_WEFF = 512, P0_POSB = 32, P0_ADA = 224;
constexpr int P0_TOTAL = P0_CONV + P0_TR_DIN + P0_TR_DOUT + P0_TR_KV + P0_TR_NIN + P0_TR_NOUT + P0_TR_C1 + P0_TR_C2 + P0_WEFF + P0_POSB + P0_ADA;

DI void phase_prep(const Params& p, unsigned char* lds, int tid) {
    unsigned char* ws = p.ws;
    for (int it = blockIdx.x; it < P0_TOTAL; it += gridDim.x) {
        int r = it;
        if (r < P0_ADA) { p0_ada_item(p, (float*)(ws + OFF_ADA), r, lds, tid); continue; } r -= P0_ADA;
        if (r < P0_WEFF) { p0_weff_item(p.in[26], p.in[27], (bf16_t*)(ws + OFF_WT_PEER), r, lds, tid); continue; } r -= P0_WEFF;
        if (r < P0_POSB) { p0_posb_item(p.in[17], p.in[18], (float*)(ws + OFF_POSB), r, lds, tid); continue; } r -= P0_POSB;
        if (r < P0_TR_DIN) { p0_transpose_item(p.in[7], 1024, 3072, (bf16_t*)(ws + OFF_WT_DIN), r, 48, lds, tid); continue; } r -= P0_TR_DIN;
        if (r < P0_TR_DOUT) { p0_transpose_item(p.in[8], 1024, 1024, (bf16_t*)(ws + OFF_WT_DOUT), r, 16, lds, tid); continue; } r -= P0_TR_DOUT;
        if (r < P0_TR_KV) { p0_transpose_item(p.in[16], 1024, 1536, (bf16_t*)(ws + OFF_WT_KV), r, 24, lds, tid); continue; } r -= P0_TR_KV;
        if (r < P0_TR_NIN) { p0_transpose_item(p.in[22], 1024, 1048, (bf16_t*)(ws + OFF_WT_NIN), r, 18, lds, tid); continue; } r -= P0_TR_NIN;
        if (r < P0_TR_NOUT) { p0_transpose_item(p.in[24], 1024, 1024, (bf16_t*)(ws + OFF_WT_NOUT), r, 16, lds, tid); continue; } r -= P0_TR_NOUT;
        if (r < P0_TR_C1) { const int kv = r >> 8; p0_transpose_item(p.in[18] + (long)kv * 4096 * 256, 4096, 256, (bf16_t*)(ws + OFF_WT_C1) + (long)kv * 256 * 4096, r & 255, 4, lds, tid); continue; } r -= P0_TR_C1;
        if (r < P0_TR_C2) { const int kv = r >> 3; p0_transpose_item(p.in[20] + (long)kv * 256 * 128, 256, 128, (bf16_t*)(ws + OFF_WT_C2) + (long)kv * 128 * 256, r & 7, 2, lds, tid); continue; } r -= P0_TR_C2;
        {
            const int tbl = r >> 11, sub = r & 2047;
            const int layer = tbl & 1;
            const float* src = (tbl < 2 ? p.in[28] : p.in[29]) + (long)layer * 16384 * 1024;
            unsigned char* dst = ws + (tbl < 2 ? OFF_PU : OFF_PV) + (long)layer * 16384 * 1024;
            float* sinv = (float*)(ws + (tbl < 2 ? OFF_USI : OFF_VSI)) + layer * 16384;
            p0_fp8_item(src, dst, sinv, tbl >= 2, sub, tid);
        }
    }
}

DI void norm_row_write(const f32x4 (&v)[4], float rstd, const float* gain, const float* shift, const float* scale, bf16_t* orow, int lane) {
#pragma unroll
    for (int j = 0; j < 4; ++j) {
        const int c = 4 * lane + 256 * j;
        const f32x4 g = *(const f32x4*)(gain + c), sh = *(const f32x4*)(shift + c), sc = *(const f32x4*)(scale + c);
        u32x2 o;
        o.x = pk2(v[j].x * rstd * g.x * (1.f + sc.x) + sh.x, v[j].y * rstd * g.y * (1.f + sc.y) + sh.y);
        o.y = pk2(v[j].z * rstd * g.z * (1.f + sc.z) + sh.z, v[j].w * rstd * g.w * (1.f + sc.w) + sh.w);
        *(u32x2*)(orow + c) = o;
    }
}
DI void phase_norm(const float* __restrict__ x, bf16_t* __restrict__ out, const float* gain, const float* ada, int shift_off, int scale_off, int tid) {
    const int lane = tid & 63, gw = blockIdx.x * NWAVES + (tid >> 6), nw = gridDim.x * NWAVES;
    for (int tok = gw; tok < NTOK; tok += nw) {
        const int b = tok >> 13;
        f32x4 v[4]; float ss = 0.f;
#pragma unroll
        for (int j = 0; j < 4; ++j) { v[j] = *(const f32x4*)(x + (long)tok * DM + 4 * lane + 256 * j); ss += v[j].x * v[j].x + v[j].y * v[j].y + v[j].z * v[j].z + v[j].w * v[j].w; }
        const float rstd = rsqrtf(wave_sum(ss) * (1.f / DM) + EPS);
        norm_row_write(v, rstd, gain, ada + b * ADA_STRIDE + shift_off, ada + b * ADA_STRIDE + scale_off, out + (long)tok * DM, lane);
    }
}

DI int kidx(int mt, int i) { return 32 * mt + 16 * (i >> 3) + (i & 7); }
template <int DQK>
DI void attn_qk32(const unsigned char* Ks, const bf16x8 (&qf)[DQK / 16], f32x16& st, int mt, int r, int h) {
    constexpr int RB = DQK * 2, MSK = DQK == 64 ? 7 : 15;
    const int row = 32 * mt + ((r & 0x13) | ((r & 4) << 1) | ((r & 8) >> 1));
#pragma unroll
    for (int i = 0; i < 16; ++i) st[i] = 0.f;
#pragma unroll
    for (int ks = 0; ks < DQK / 16; ++ks) {
        const bf16x8 kf = RB == 128 ? *(const bf16x8*)(Ks + sw2(row, 2 * ks + h)) : *(const bf16x8*)(Ks + row * RB + (((2 * ks + h) ^ (row & MSK)) << 4));
        st = MFMA32(kf, qf[ks], st);
    }
}
DI void attn_pack32(const f32x16& st, bf16x8 (&pf)[2]) {
#pragma unroll
    for (int s = 0; s < 2; ++s) {
        u32x4 t;
        t.x = pk2(st[8 * s + 0], st[8 * s + 1]); t.y = pk2(st[8 * s + 2], st[8 * s + 3]);
        t.z = pk2(st[8 * s + 4], st[8 * s + 5]); t.w = pk2(st[8 * s + 6], st[8 * s + 7]);
        pf[s] = __builtin_bit_cast(bf16x8, t);
    }
}
DI void attn_softmax32(f32x16& st, float& m, float& l, f32x16 (&o)[4]) {
    float mx = st[0];
#pragma unroll
    for (int i = 1; i < 16; ++i) mx = fmaxf(mx, st[i]);
    mx = max_x32(mx);
    const float mn = fmaxf(m, mx);
    if (!__all(mn == m)) {
        const float alpha = fexp2(m - mn);
        l *= alpha;
#pragma unroll
        for (int dt = 0; dt < 4; ++dt)
#pragma unroll
            for (int i = 0; i < 16; ++i) o[dt][i] *= alpha;
        m = mn;
    }
    float sum = 0.f;
#pragma unroll
    for (int i = 0; i < 16; ++i) { const float pv = fexp2(st[i] - m); st[i] = pv; sum += pv; }
    l += sum;
}
DI void attn_pv32(const unsigned char* Vs, const bf16x8 (&pf)[2], f32x16 (&o)[4], int mt, int r, int h) {
#pragma unroll
    for (int dt = 0; dt < 4; ++dt)
#pragma unroll
        for (int s2 = 0; s2 < 2; ++s2) {
            const int row = 32 * dt + r;
            const bf16x8 vf = *(const bf16x8*)(Vs + sw2(row, 2 * (2 * mt + s2) + h));
            o[dt] = MFMA32(vf, pf[s2], o[dt]);
        }
}
template <int RB, int NROWS>
DI void dma_offsets(unsigned (&off)[NROWS * RB / 16 / 512], unsigned gstride, int tid) {
    constexpr int CPR = RB / 16;
#pragma unroll
    for (int i = 0; i < NROWS * CPR / 512; ++i) {
        const int idx = tid + 512 * i;
        int row, cp;
        if (RB == 128) sw2_src(idx, row, cp); else { row = idx / CPR; cp = (idx % CPR) ^ (row & (CPR - 1)); }
        off[i] = (unsigned)row * gstride + (cp << 4);
    }
}
template <int N>
DI void dma_issue(unsigned char* dst, const unsigned char* gbase, const unsigned (&off)[N], int tid) {
    const int wbase = tid & ~63;
#pragma unroll
    for (int i = 0; i < N; ++i)
        __builtin_amdgcn_global_load_lds((const unsigned*)(gbase + off[i]), (unsigned*)(dst + (wbase + 512 * i) * 16), 16, 0, 0);
}

constexpr int AT_STAGE = 32 * 1024;
constexpr int AT_LUT = 2 * AT_STAGE;
constexpr int LUT_N = 1280, LUT_OFF = 1100;
constexpr int LUTC_W = 52;
constexpr int AT_LUTC = AT_LUT + 20 * 1024;
constexpr int AT_IMP = AT_LUTC + 13 * 1024;
constexpr int AT_SEL = AT_IMP + 34 * 1024;

DI void phase_diff_attn(const Params& p, unsigned char* lds, int tid) {
    unsigned char* ws = p.ws;
    const bf16_t* Q = (const bf16_t*)(ws + OFF_Q0);
    const bf16_t* Kk = (const bf16_t*)(ws + OFF_K0);
    const bf16_t* VT = (const bf16_t*)(ws + OFF_VT0);
    bf16_t* O = (bf16_t*)(ws + OFF_H);
    const float* relb = p.in[2];
    const float* lam = p.in[9];
    const float* subln = p.in[12];
    const int lane = tid & 63, w = tid >> 6, comp = w & 1, qg = w >> 1, r = lane & 31, h = lane >> 5;
    float* lut = (float*)(lds + 128 * 1024);
    float lam_full;
    {
        float s01 = 0.f, s23 = 0.f;
        for (int i = 0; i < 64; ++i) { s01 += lam[i] * lam[64 + i]; s23 += lam[128 + i] * lam[192 + i]; }
        lam_full = __expf(s01) - __expf(s23) + 0.2f;
    }
    const int G = gridDim.x, rows_per_it = G >> 5;
    unsigned koff[1], voff[2];
    dma_offsets<128, 64>(koff, 128, tid);
    dma_offsets<128, 128>(voff, SEQ * 2, tid);
    constexpr int ST2 = 64 * 1024;
    for (int it = 0;; ++it) {
        int qb, b, hd;
        if (G == 256) {
            if (it >= 8) break;
            const int xcd = blockIdx.x & 7, lb = blockIdx.x >> 3, pr = xcd * 4 + (it >> 1);
            qb = (it & 1) ? lb : 63 - lb; b = pr >> 3; hd = pr & 7;
        } else {
            int u;
            if ((G & 31) == 0) {
                const int rr = blockIdx.x >> 5, cc = blockIdx.x & 31;
                const int rowi = it * rows_per_it + ((it & 1) ? rows_per_it - 1 - rr : rr);
                u = rowi * 32 + cc;
            } else u = it * G + blockIdx.x;
            if (u >= 2048) break;
            qb = 63 - (u >> 5); b = (u & 31) >> 3; hd = u & 7;
        }
        const int q0 = qb * 128, ntiles = qb + 1;
        const int qpos = q0 + 32 * qg + r, qlo = q0 + 32 * qg, qhi = qlo + 31;
        for (int e = tid; e < LUT_N; e += NTHREADS) { const int d = LUT_OFF - e; lut[e] = d < 0 ? -INFINITY : (d >= 790 ? 0.f : (relb[rel_bucket_i(d) * 8 + hd] - relb[31 * 8 + hd]) * LOG2E); }
        bf16x8 qf[4];
        {
            const bf16_t* qrow = Q + ((long)((b * 8 + hd) * 2 + comp) * SEQ + qpos) * 64;
#pragma unroll
            for (int ks = 0; ks < 4; ++ks) qf[ks] = *(const bf16x8*)(qrow + 16 * ks + 8 * h);
        }
        const unsigned char* k0g = (const unsigned char*)(Kk + (long)((b * 8 + hd) * 2 + 0) * SEQ * 64);
        const unsigned char* k1g = (const unsigned char*)(Kk + (long)((b * 8 + hd) * 2 + 1) * SEQ * 64);
        const unsigned char* vtg = (const unsigned char*)(VT + (long)(b * 8 + hd) * 128 * SEQ);
        f32x16 o[4];
#pragma unroll
        for (int dt = 0; dt < 4; ++dt)
#pragma unroll
            for (int i = 0; i < 16; ++i) o[dt][i] = 0.f;
        float m = -1e30f, l = 0.f;
        auto stage = [&](int kt, unsigned char* st) {
#pragma unroll
            for (int sb = 0; sb < 2; ++sb) {
                dma_issue(st + sb * 8192, k0g + (long)(2 * kt + sb) * 8192, koff, tid);
                dma_issue(st + 16384 + sb * 8192, k1g + (long)(2 * kt + sb) * 8192, koff, tid);
                dma_issue(st + 32768 + sb * 16384, vtg + (long)(2 * kt + sb) * 128, voff, tid);
            }
        };
        stage(0, lds);
        __syncthreads();
        for (int kt = 0; kt < ntiles; ++kt) {
            unsigned char* cur = lds + (kt & 1) * ST2;
            if (kt + 1 < ntiles) stage(kt + 1, lds + ((kt + 1) & 1) * ST2);
            const bool nearb = qlo - (kt * 128 + 127) < 790;
            const int dbase0 = qpos - kt * 128 - 8 * h;
            const unsigned char* kb = cur + comp * 16384;
            f32x16 sa, sbv;
            attn_qk32<64>(kb, qf, sa, 0, r, h);
#pragma unroll
            for (int j = 0; j < 4; ++j) {
                f32x16& sc = (j & 1) ? sbv : sa;
                f32x16& sn = (j & 1) ? sa : sbv;
                if (j < 3) attn_qk32<64>(kb + ((j + 1) >> 1) * 8192, qf, sn, (j + 1) & 1, r, h);
                if (nearb) {
                    const float* lp = lut + (LUT_OFF - dbase0 + 64 * (j >> 1));
#pragma unroll
                    for (int i = 0; i < 16; ++i) sc[i] += lp[kidx(j & 1, i)];
                }
                attn_softmax32(sc, m, l, o);
                bf16x8 pf[2];
                attn_pack32(sc, pf);
                attn_pv32(cur + 32768 + (j >> 1) * 16384, pf, o, j & 1, r, h);
            }
            __syncthreads();
        }
        l = sum_x32(l);
        const float inv = l > 0.f ? frcp(l) : 0.f;
        float* xch = (float*)lds + qg * 4096;
        if (comp == 1) {
            const float sc = inv * lam_full;
#pragma unroll
            for (int dt = 0; dt < 4; ++dt)
#pragma unroll
                for (int i = 0; i < 16; ++i) xch[(dt * 16 + i) * 64 + lane] = o[dt][i] * sc;
        }
        __syncthreads();
        if (comp == 0) {
            float ss = 0.f;
#pragma unroll
            for (int dt = 0; dt < 4; ++dt)
#pragma unroll
                for (int i = 0; i < 16; ++i) { const float v = o[dt][i] * inv - xch[(dt * 16 + i) * 64 + lane]; o[dt][i] = v; ss += v * v; }
            ss = sum_x32(ss);
            const float rstd = rsqrtf(ss * (1.f / 128.f) + EPS) * 0.8f;
            bf16_t* orow = O + (long)(b * SEQ + qpos) * DM + hd * 128;
#pragma unroll
            for (int dt = 0; dt < 4; ++dt)
#pragma unroll
                for (int g4 = 0; g4 < 4; ++g4) {
                    const int d0 = 32 * dt + 8 * g4 + 4 * h;
                    const f32x4 gv = *(const f32x4*)(subln + d0);
                    u32x2 ov;
                    ov.x = pk2(o[dt][4 * g4 + 0] * rstd * gv.x, o[dt][4 * g4 + 1] * rstd * gv.y);
                    ov.y = pk2(o[dt][4 * g4 + 2] * rstd * gv.z, o[dt][4 * g4 + 3] * rstd * gv.w);
                    *(u32x2*)(orow + d0) = ov;
                }
        }
        __syncthreads();
    }
}

template <int VAR>
DI void phase_nsa_attn(const Params& p, unsigned char* lds, int tid) {
    unsigned char* ws = p.ws;
    const bf16_t* QN = (const bf16_t*)(ws + OFF_QN);
    const bf16_t* KS = (const bf16_t*)(ws + OFF_KS);
    const bf16_t* VST = (const bf16_t*)(ws + OFF_VST);
    const bf16_t* KW = (const bf16_t*)(ws + OFF_KW);
    const bf16_t* VWT = (const bf16_t*)(ws + OFF_VWT);
    const bf16_t* KCMP = (const bf16_t*)(ws + OFF_KCMP);
    const bf16_t* VCMPT = (const bf16_t*)(ws + OFF_VCMPT);
    const float* gates = (const float*)(ws + OFF_GATES);
    bf16_t* O = VAR ? (bf16_t*)(ws + OFF_PU + 32 * MB) : (bf16_t*)(ws + OFF_H);
    const float* relb = p.in[2];
    const int lane = tid & 63, w = tid >> 6, hg = w >> 1, th = w & 1, r = lane & 31, h = lane >> 5;
    float* lut = (float*)(lds + AT_LUT);
    float* lutc = (float*)(lds + AT_LUTC);
    float* imp = (float*)(lds + AT_IMP);
    unsigned* selw = (unsigned*)(lds + AT_SEL);
    unsigned short* sel16 = (unsigned short*)selw;
    const int G = gridDim.x, rows_per_it = G >> 3;
    int lut_g = -1;
    for (int it = 0;; ++it) {
        int u;
        if ((G & 7) == 0) {
            const int rr = blockIdx.x >> 3, cc = blockIdx.x & 7;
            const int rowi = it * rows_per_it + ((it & 1) ? rows_per_it - 1 - rr : rr);
            u = rowi * 8 + cc;
        } else u = it * G + blockIdx.x;
        if (u >= 1024) break;
        const int bi = 127 - (u >> 3), b = (u & 7) >> 1, g = u & 1, head = 4 * g + hg;
        const int tq = 64 * bi + 32 * th + r;
        const int tl = 32 * th + r;
        const long tok = (long)b * SEQ + tq;
        if (g != lut_g) {
            lut_g = g;
            for (int e = tid; e < 4 * LUT_N; e += NTHREADS) { const int hh = e / LUT_N, d = LUT_OFF - (e % LUT_N); lut[e] = d < 0 ? -INFINITY : (d >= 790 ? 0.f : (relb[rel_bucket_i(d) * 8 + 4 * g + hh] - relb[31 * 8 + 4 * g + hh]) * LOG2E); }
            for (int e = tid; e < 4 * 16 * LUTC_W; e += NTHREADS) {
                const int hh = e / (16 * LUTC_W), ph = (e / LUTC_W) & 15, ci = e % LUTC_W, d = 16 * (ci - 1) + ph;
                lutc[e] = ci == 0 ? -INFINITY : (d >= 790 ? 0.f : (relb[rel_bucket_i(d) * 8 + 4 * g + hh] - relb[31 * 8 + 4 * g + hh]) * LOG2E);
            }
        }
        if (tid < 4) selw[256 + tid] = 0u;
        const float* mylut = lut + hg * LUT_N;
        bf16x8 qf[8];
        const bf16_t* qrow = QN + ((long)(b * 8 + head) * SEQ + tq) * 128 + 8 * h;
        auto load_q = [&](const bf16_t* qr) {
#pragma unroll
            for (int ks = 0; ks < 8; ++ks) qf[ks] = *(const bf16x8*)(qr + 16 * ks);
        };
        const float* gp = gates + tok * 24 + head * 3;
        bf16_t* orow = O + (VAR ? (tok & 16383) : tok) * DM + head * 128;
        auto stage = [&](const unsigned char* kg, const unsigned char* vg, unsigned vstride, int kt, unsigned char* st) {
            int t2 = tid; asm volatile("" : "+v"(t2));
            unsigned koff[2], vo[2];
            dma_offsets<256, 64>(koff, 256, t2);
            dma_offsets<128, 128>(vo, vstride, t2);
            dma_issue(st, kg + (long)kt * 16384, koff, t2);
            dma_issue(st + 16384, vg + (long)kt * 128, vo, t2);
        };
        f32x16 o[4];
        float m, l;
        auto reset = [&]() {
#pragma unroll
            for (int dt = 0; dt < 4; ++dt)
#pragma unroll
                for (int i = 0; i < 16; ++i) o[dt][i] = 0.f;
            m = -1e30f; l = 0.f;
        };
        const unsigned char* kcg = (const unsigned char*)(KCMP + (long)(b * 2 + g) * 512 * 128);
        const unsigned char* vcg = (const unsigned char*)(VCMPT + (long)(b * 2 + g) * 128 * 512);
        const int nct = ((4 * bi + 2) >> 6) + 1;
        const int hgc = r & 3, tlc = 8 * w + (r >> 2), tqc = 64 * bi + tlc;
        const long tokc = (long)b * SEQ + tqc;
        reset();
        load_q(QN + ((long)(b * 8 + 4 * g + hgc) * SEQ + tqc) * 128 + 8 * h);
        __syncthreads();
        if (VAR != 3) {
            const int cb = (tqc - 31) >> 4;
            const float* lc = lutc + (hgc * 16 + ((tqc - 31) & 15)) * LUTC_W + 1;
            stage(kcg, vcg, 1024u, 0, lds);
            __syncthreads();
            for (int kt = 0; kt < nct; ++kt) {
                unsigned char* cur = lds + (kt & 1) * AT_STAGE;
                if (kt + 1 < nct) stage(kcg, vcg, 1024u, kt + 1, lds + ((kt + 1) & 1) * AT_STAGE);
                const int cbase = cb - kt * 64 - 8 * h;
#pragma unroll
                for (int mt = 0; mt < 2; ++mt) {
                    f32x16 st;
                    attn_qk32<128>(cur, qf, st, mt, r, h);
#pragma unroll
                    for (int i = 0; i < 16; ++i) {
                        const int c = cbase - kidx(mt, i);
                        st[i] += lc[c < -1 ? -1 : (c > 50 ? 50 : c)];
                    }
                    float mx = st[0];
#pragma unroll
                    for (int i = 1; i < 16; ++i) mx = fmaxf(mx, st[i]);
                    mx = max_x32(mx);
                    const float mn = fmaxf(m, mx);
                    l *= fexp2(m - mn); m = mn;
                    float sum = 0.f;
#pragma unroll
                    for (int i = 0; i < 16; ++i) sum += fexp2(st[i] - m);
                    l += sum;
                }
                __syncthreads();
            }
            const float lt = sum_x32(l);
            const float invl = lt > 0.f ? frcp(lt) : 0.f;
            stage(kcg, vcg, 1024u, 0, lds);
            __syncthreads();
            float carry = 0.f;
            for (int kt = 0; kt < nct; ++kt) {
                unsigned char* cur = lds + (kt & 1) * AT_STAGE;
                if (kt + 1 < nct) stage(kcg, vcg, 1024u, kt + 1, lds + ((kt + 1) & 1) * AT_STAGE);
                const int cbase = cb - kt * 64 - 8 * h;
                float o0[4], o1[4], sp[4];
#pragma unroll
                for (int mt = 0; mt < 2; ++mt) {
                    f32x16 st;
                    attn_qk32<128>(cur, qf, st, mt, r, h);
#pragma unroll
                    for (int i = 0; i < 16; ++i) {
                        const int c = cbase - kidx(mt, i);
                        st[i] = fexp2(st[i] + lc[c < -1 ? -1 : (c > 50 ? 50 : c)] - m) * invl;
                    }
#pragma unroll
                    for (int gq = 0; gq < 2; ++gq) {
                        const int G2 = 2 * mt + gq, q0 = 2 * gq, q1 = 2 * gq + 1;
                        const float c20 = 0.5f * st[4 * q0 + 3];
                        o0[G2] = st[4 * q0] + st[4 * q0 + 1] + st[4 * q0 + 2] + c20;
                        o1[G2] = st[4 * q1] + st[4 * q1 + 1] + st[4 * q1 + 2] + 0.5f * st[4 * q1 + 3] + c20;
                        sp[G2] = 0.5f * st[4 * q1 + 3];
                    }
                    bf16x8 pf[2];
                    attn_pack32(st, pf);
                    attn_pv32(cur + 16384, pf, o, mt, r, h);
                }
                float rc[4];
#pragma unroll
                for (int G2 = 0; G2 < 4; ++G2) rc[G2] = __uint_as_float(get_x32(__float_as_uint(sp[G2]), h));
                if (h) {
#pragma unroll
                    for (int G2 = 0; G2 < 4; ++G2) o0[G2] += rc[G2];
                } else {
                    o0[0] += carry; o0[1] += rc[0]; o0[2] += rc[1]; o0[3] += rc[2];
                    carry = rc[3];
                }
#pragma unroll
                for (int G2 = 0; G2 < 4; ++G2) {
                    float a0 = o0[G2], a1 = o1[G2];
                    a0 += lx1(a0); a0 += lx2(a0); a1 += lx1(a1); a1 += lx2(a1);
                    if (hgc == 0) *(f32x2*)(imp + tlc * 130 + kt * 16 + 4 * G2 + 2 * h) = (f32x2){a0, a1};
                }
                __syncthreads();
            }
        }
        {
            const float g_c = gates[tokc * 24 + (4 * g + hgc) * 3];
            bf16_t* orc = O + (VAR ? (tokc & 16383) : tokc) * DM + (4 * g + hgc) * 128;
#pragma unroll
            for (int dt = 0; dt < 4; ++dt)
#pragma unroll
                for (int g4 = 0; g4 < 4; ++g4) {
                    const int d0 = 32 * dt + 8 * g4 + 4 * h;
                    u32x2 ov;
                    ov.x = pk2(o[dt][4 * g4 + 0] * g_c, o[dt][4 * g4 + 1] * g_c);
                    ov.y = pk2(o[dt][4 * g4 + 2] * g_c, o[dt][4 * g4 + 3] * g_c);
                    *(u32x2*)(orc + d0) = ov;
                }
        }
        if (VAR != 5) {
            const int tkn = tid >> 3, part = tid & 7;
            unsigned key[16];
#pragma unroll
            for (int q = 0; q < 16; ++q) {
                const int j = part * 16 + q;
                float v = imp[tkn * 130 + j];
                const int back = bi - j;
                if (j == 0 || (back >= 0 && back < 2)) v = 1e9f;
                if (back < 0) v = -1e30f;
                key[q] = f2key(v);
            }
            auto sum8 = [&](int c) -> int {
                c += __builtin_amdgcn_update_dpp(0, c, 0xB1, 0xF, 0xF, true);
                c += __builtin_amdgcn_update_dpp(0, c, 0x4E, 0xF, 0xF, true);
                c += __builtin_amdgcn_update_dpp(0, c, 0x141, 0xF, 0xF, true);
                return c;
            };
            unsigned T = 0u;
#pragma unroll 4
            for (int bit = 31; bit >= 0; --bit) {
                const unsigned cand = T | (1u << bit);
                int c = 0;
#pragma unroll
                for (int q = 0; q < 16; ++q) c += key[q] >= cand ? 1 : 0;
                if (sum8(c) >= 16) T = cand;
            }
            int cg = 0, ce = 0;
#pragma unroll
            for (int q = 0; q < 16; ++q) { cg += key[q] > T ? 1 : 0; ce += key[q] == T ? 1 : 0; }
            const int need = 16 - sum8(cg);
            int pre = ce;
            { int t = __builtin_amdgcn_update_dpp(0, pre, 0x111, 0xF, 0xF, true); if (part >= 1) pre += t; }
            { int t = __builtin_amdgcn_update_dpp(0, pre, 0x112, 0xF, 0xF, true); if (part >= 2) pre += t; }
            { int t = __builtin_amdgcn_update_dpp(0, pre, 0x114, 0xF, 0xF, true); if (part >= 4) pre += t; }
            int before = pre - ce;
            unsigned bits = 0;
#pragma unroll
            for (int q = 0; q < 16; ++q) {
                const bool eq = key[q] == T;
                const bool selq = key[q] > T || (eq && before < need);
                before += eq ? 1 : 0;
                bits |= (selq && key[q] >= 0x80000000u) ? (1u << q) : 0u;
            }
            sel16[tkn * 8 + part] = (unsigned short)bits;
            atomicOr(&selw[256 + (part >> 1)], bits << ((part & 1) * 16));
        }
        __syncthreads();
        const unsigned un0 = selw[256], un1 = selw[257], un2 = selw[258], un3 = selw[259];
        const unsigned char* ksg = (const unsigned char*)(KS + (long)(b * 2 + g) * SEQ * 128);
        const unsigned char* vsg = (const unsigned char*)(VST + (long)(b * 2 + g) * 128 * SEQ);
        reset(); load_q(qrow);
        {
            const unsigned long long ulo = ((unsigned long long)(unsigned)__builtin_amdgcn_readfirstlane((int)un1) << 32) | (unsigned)__builtin_amdgcn_readfirstlane((int)un0);
            const unsigned long long uhi = ((unsigned long long)(unsigned)__builtin_amdgcn_readfirstlane((int)un3) << 32) | (unsigned)__builtin_amdgcn_readfirstlane((int)un2);
            auto next_tile = [&](int from) -> int {
                if (from < 64) { const unsigned long long mk = ulo >> from; if (mk) return from + __builtin_ctzll(mk); from = 64; }
                if (from < 128) { const unsigned long long mk = uhi >> (from - 64); if (mk) return from + __builtin_ctzll(mk); }
                return 128;
            };
            int jt = (VAR == 1 || VAR == 4 || VAR == 5) ? 128 : next_tile(0);
            int buf = 0;
            if (jt < 128) stage(ksg, vsg, SEQ * 2u, jt, lds);
            __syncthreads();
            while (jt < 128) {
                unsigned char* cur = lds + buf * AT_STAGE;
                const int jn = next_tile(jt + 1);
                if (jn < 128) stage(ksg, vsg, SEQ * 2u, jn, lds + (buf ^ 1) * AT_STAGE);
                const unsigned wd = selw[tl * 4 + (jt >> 5)];
                const bool mysel = (wd >> (jt & 31)) & 1u;
                if (__any(mysel)) {
                    const int k0 = jt * 64;
                    const bool nearb = (64 * bi + 32 * th) - (k0 + 63) < 790;
                    const int dbase = tq - k0 - 8 * h;
                    const float* lp = mylut + (LUT_OFF - dbase);
#pragma unroll
                    for (int mt = 0; mt < 2; ++mt) {
                        f32x16 st;
                        attn_qk32<128>(cur, qf, st, mt, r, h);
                        if (nearb) {
#pragma unroll
                            for (int i = 0; i < 16; ++i) st[i] += lp[kidx(mt, i)];
                        }
                        if (!mysel) {
#pragma unroll
                            for (int i = 0; i < 16; ++i) st[i] = -INFINITY;
                        }
                        attn_softmax32(st, m, l, o);
                        bf16x8 pf[2];
                        attn_pack32(st, pf);
                        attn_pv32(cur + 16384, pf, o, mt, r, h);
                    }
                }
                __syncthreads();
                buf ^= 1; jt = jn;
            }
        }
        {
            const float lt = sum_x32(l);
            const float sc = (lt > 0.f ? frcp(lt) : 0.f) * gp[1];
#pragma unroll
            for (int dt = 0; dt < 4; ++dt)
#pragma unroll
                for (int g4 = 0; g4 < 4; ++g4) {
                    const int d0 = 32 * dt + 8 * g4 + 4 * h;
                    const u32x2 pv = *(const u32x2*)(orow + d0);
                    u32x2 ov;
                    ov.x = pk2(bflo(pv.x) + o[dt][4 * g4 + 0] * sc, bfhi(pv.x) + o[dt][4 * g4 + 1] * sc);
                    ov.y = pk2(bflo(pv.y) + o[dt][4 * g4 + 2] * sc, bfhi(pv.y) + o[dt][4 * g4 + 3] * sc);
                    *(u32x2*)(orow + d0) = ov;
                }
        }
        const unsigned char* kwg = (const unsigned char*)(KW + (long)(b * 2 + g) * SEQ * 128);
        const unsigned char* vwg = (const unsigned char*)(VWT + (long)(b * 2 + g) * 128 * SEQ);
        reset(); load_q(qrow);
        {
            const int j0 = bi >= 8 ? bi - 8 : 0, nt = (VAR == 2 || VAR == 4 || VAR == 5) ? 1 : bi - j0 + 1;
            stage(kwg, vwg, SEQ * 2u, j0, lds);
            __syncthreads();
            for (int kt = 0; kt < nt; ++kt) {
                unsigned char* cur = lds + (kt & 1) * AT_STAGE;
                if (kt + 1 < nt) stage(kwg, vwg, SEQ * 2u, j0 + kt + 1, lds + ((kt + 1) & 1) * AT_STAGE);
                const int k0 = (j0 + kt) * 64;
                const int dbase = tq - k0 - 8 * h;
                const float* lp = mylut + (LUT_OFF - dbase);
#pragma unroll
                for (int mt = 0; mt < 2; ++mt) {
                    f32x16 st;
                    attn_qk32<128>(cur, qf, st, mt, r, h);
#pragma unroll
                    for (int i = 0; i < 16; ++i) st[i] = kidx(mt, i) <= dbase - 512 ? -INFINITY : st[i] + lp[kidx(mt, i)];
                    attn_softmax32(st, m, l, o);
                    bf16x8 pf[2];
                    attn_pack32(st, pf);
                    attn_pv32(cur + 16384, pf, o, mt, r, h);
                }
                __syncthreads();
            }
        }
        {
            const float lt = sum_x32(l);
            const float sc = (lt > 0.f ? frcp(lt) : 0.f) * gp[2];
#pragma unroll
            for (int dt = 0; dt < 4; ++dt)
#pragma unroll
                for (int g4 = 0; g4 < 4; ++g4) {
                    const int d0 = 32 * dt + 8 * g4 + 4 * h;
                    const u32x2 pv = *(const u32x2*)(orow + d0);
                    u32x2 ov;
                    ov.x = pk2(bflo(pv.x) + o[dt][4 * g4 + 0] * sc, bfhi(pv.x) + o[dt][4 * g4 + 1] * sc);
                    ov.y = pk2(bflo(pv.y) + o[dt][4 * g4 + 2] * sc, bfhi(pv.y) + o[dt][4 * g4 + 3] * sc);
                    *(u32x2*)(orow + d0) = ov;
                }
        }
        __syncthreads();
    }
}

DI void fp8x16_fma(const u32x4& q, const f32x4& h0, const f32x4& h1, const f32x4& h2, const f32x4& h3, f32x2& a0, f32x2& a1) {
    a0 += __builtin_amdgcn_cvt_pk_f32_fp8((int)q.x, false) * (f32x2){h0.x, h0.y};
    a1 += __builtin_amdgcn_cvt_pk_f32_fp8((int)q.x, true)  * (f32x2){h0.z, h0.w};
    a0 += __builtin_amdgcn_cvt_pk_f32_fp8((int)q.y, false) * (f32x2){h1.x, h1.y};
    a1 += __builtin_amdgcn_cvt_pk_f32_fp8((int)q.y, true)  * (f32x2){h1.z, h1.w};
    a0 += __builtin_amdgcn_cvt_pk_f32_fp8((int)q.z, false) * (f32x2){h2.x, h2.y};
    a1 += __builtin_amdgcn_cvt_pk_f32_fp8((int)q.z, true)  * (f32x2){h2.z, h2.w};
    a0 += __builtin_amdgcn_cvt_pk_f32_fp8((int)q.w, false) * (f32x2){h3.x, h3.y};
    a1 += __builtin_amdgcn_cvt_pk_f32_fp8((int)q.w, true)  * (f32x2){h3.z, h3.w};
}
template <bool DRY>
DI void phase_peer_u(const Params& p, int layer, unsigned char* lds, int tid) {
    unsigned char* ws = p.ws;
    const bf16_t* H = (const bf16_t*)(ws + OFF_H);
    const int* ridx = (const int*)(ws + OFF_RIDX);
    float* rgate = (float*)(ws + OFF_RGATE);
    const unsigned char* U = ws + OFF_PU + (long)layer * 16384 * 1024;
    const float* usi = (const float*)(ws + OFF_USI) + layer * 16384;
    const float* vsi = (const float*)(ws + OFF_VSI) + layer * 16384;
    const int lane = tid & 63, w = tid >> 6, sub = lane & 3, grp = lane >> 2;
    const int xg = blockIdx.x & 7, lb = blockIdx.x >> 3, nwv = (gridDim.x >> 3) * NWAVES, wv = lb * NWAVES + w;
    unsigned* clb = (unsigned*)(lds + w * 12288);
    float* hbb = (float*)(lds + w * 12288 + 2048);
    const unsigned long long lt = (1ull << lane) - 1ull;
    if (lb >= (int)(gridDim.x >> 3)) return;
    int i0, i1; u32x4 h0, h1;
    auto ld_tok = [&](int tk) {
        tk = tk < NTOK ? tk : wv;
        i0 = ridx[(long)tk * 128 + lane]; i1 = ridx[(long)tk * 128 + 64 + lane];
        h0 = *(const u32x4*)(H + (long)tk * DM + lane * 16); h1 = *(const u32x4*)(H + (long)tk * DM + lane * 16 + 8);
    };
    auto stage_tok = [&](int bi) -> int {
        unsigned* cl = clb + bi * 256; float* hb = hbb + bi * 1024;
        const bool b0 = (i0 >> 11) == xg, b1 = (i1 >> 11) == xg;
        const unsigned long long m0 = __ballot(b0), m1 = __ballot(b1);
        const int n0 = __popcll(m0), n = n0 + __popcll(m1);
        if (b0) { const int k = __popcll(m0 & lt); cl[2 * k] = lane; cl[2 * k + 1] = i0; }
        if (b1) { const int k = n0 + __popcll(m1 & lt); cl[2 * k] = 64 + lane; cl[2 * k + 1] = i1; }
        if (n == 0 && lane == 0) { cl[0] = 0u; cl[1] = 0u; }
        f32x4* hp = (f32x4*)(hb + lane * 16);
        hp[0] = (f32x4){bflo(h0.x), bfhi(h0.x), bflo(h0.y), bfhi(h0.y)}; hp[1] = (f32x4){bflo(h0.z), bfhi(h0.z), bflo(h0.w), bfhi(h0.w)};
        hp[2] = (f32x4){bflo(h1.x), bfhi(h1.x), bflo(h1.y), bfhi(h1.y)}; hp[3] = (f32x4){bflo(h1.z), bfhi(h1.z), bflo(h1.w), bfhi(h1.w)};
        return n;
    };
    ld_tok(wv);
    int nC = stage_tok(0);
    ld_tok(wv + nwv);
    int slotC, idC; bool validC;
    { validC = grp < nC; const int kk = validC ? grp : 0; slotC = clb[2 * kk]; idC = clb[2 * kk + 1]; }
    u32x4 uv[16];
    {
        const unsigned uoff = (unsigned)idC * 1024u + (unsigned)sub * 16u;
#pragma unroll
        for (int t = 0; t < 16; ++t) uv[t] = *(const u32x4*)(U + (uoff + t * 64));
    }
    int it = 0;
    for (int tok = wv; tok < NTOK; tok += nwv, ++it) {
        const int cb = it & 1;
        const unsigned* clC = clb + cb * 256; const unsigned* clN = clb + (cb ^ 1) * 256;
        const float* hbC = hbb + cb * 1024;
        const bool more = tok + nwv < NTOK;
        int nN = 0;
        if (more) { nN = stage_tok(cb ^ 1); ld_tok(tok + 2 * nwv); }
        const int nr = nC > 16 ? (nC + 15) >> 4 : 1;
        for (int rd = 0; rd < nr; ++rd) {
            float g_in = 0.f, su = 0.f, sv = 0.f;
            if (validC && sub == 0) { g_in = rgate[(long)tok * 128 + slotC]; su = usi[idC]; sv = vsi[idC]; }
            int slotN, idN; bool validN;
            if (rd + 1 < nr) { const int k = 16 * (rd + 1) + grp; validN = k < nC; const int kk = validN ? k : 0; slotN = clC[2 * kk]; idN = clC[2 * kk + 1]; }
            else if (more) { validN = grp < nN; const int kk = validN ? grp : 0; slotN = clN[2 * kk]; idN = clN[2 * kk + 1]; }
            else { validN = false; slotN = 0; idN = clC[1]; }
            const unsigned uoffN = (unsigned)idN * 1024u + (unsigned)sub * 16u;
            f32x2 a0 = {0.f, 0.f}, a1 = {0.f, 0.f};
#pragma unroll
            for (int t = 0; t < 16; ++t) {
                const f32x4* hp = (const f32x4*)(hbC + (sub + 4 * t) * 16);
                fp8x16_fma(uv[t], hp[0], hp[1], hp[2], hp[3], a0, a1);
                uv[t] = *(const u32x4*)(U + (uoffN + t * 64));
                if (t & 1) __builtin_amdgcn_sched_barrier(0);
            }
            float d = (a0.x + a0.y) + (a1.x + a1.y);
            d += lx1(d); d += lx2(d);
            if (validC && sub == 0) {
                float* gw = DRY ? (float*)(ws + OFF_R) + (long)tok * 128 + slotC : rgate + (long)tok * 128 + slotC;
                *gw = g_in * gelu_tanh(d * su) * sv;
            }
            slotC = slotN; idC = idN; validC = validN;
        }
        nC = nN;
    }
}

#ifndef VMASK
#define VMASK 0xffffffffu
#endif
template <bool DRY>
DI void phase_peer_v(const Params& p, int layer, int tid) {
    unsigned char* ws = p.ws;
    const int* ridx = (const int*)(ws + OFF_RIDX);
    const float* wact = (const float*)(ws + OFF_RGATE);
    const float* ada = (const float*)(ws + OFF_ADA);
    float* x = opq(p.out);
    const int lane = tid & 63, w = tid >> 6, sub = lane & 7, eg = lane >> 3;
    const int xg = blockIdx.x & 7, lb = blockIdx.x >> 3, nwv = (gridDim.x >> 3) * NWAVES, wv = lb * NWAVES + w;
    if (lb >= (int)(gridDim.x >> 3)) return;
    const unsigned char* Vc = ws + OFF_PV + ((long)(layer * 8 + xg) * 16384) * 128;
    const int col0 = 128 * xg + 16 * sub;
    const __amdgpu_buffer_rsrc_t vrs = __builtin_amdgcn_make_buffer_rsrc((void*)Vc, (short)0, 16384 * 128, 0x00020000);
    auto ld_ids = [&](int tk, u32x4 (&a)[4], f32x4 (&wq)[4]) {
        tk = tk < NTOK ? tk : wv;
        const u32x4* ip = (const u32x4*)(ridx + (long)tk * 128 + eg * 16);
        const f32x4* wp = (const f32x4*)(wact + (long)tk * 128 + eg * 16);
#pragma unroll
        for (int q = 0; q < 4; ++q) { a[q] = ip[q]; wq[q] = wp[q]; }
    };
    u32x4 vv[16];
    u32x4 na[4], pa[4]; f32x4 cw[4], nw[4], pw[4];
    {
        u32x4 a[4];
        ld_ids(wv, a, cw);
#pragma unroll
        for (int j = 0; j < 16; ++j)
            vv[j] = __builtin_bit_cast(u32x4, __builtin_amdgcn_raw_buffer_load_b128(vrs, (int)((a[j >> 2][j & 3] & (DRY ? VMASK : 0xffffffffu)) * 128u + (unsigned)sub * 16u), 0, 0));
    }
    ld_ids(wv + nwv, na, nw);
    f32x4 gfv[4]; int gb = -1;
    for (int tok = wv; tok < NTOK; tok += nwv) {
        ld_ids(tok + 2 * nwv, pa, pw);
        f32x4 xv[4];
        {
            const float* xin = x + (long)tok * DM + col0;
#pragma unroll
            for (int c = 0; c < 4; ++c) xv[c] = *(const f32x4*)(xin + 4 * c);
            const int b = tok >> 13;
            if (b != gb) {
                gb = b;
                const float* gf = ada + b * ADA_STRIDE + layer * 6144 + 5 * 1024 + col0;
#pragma unroll
                for (int c = 0; c < 4; ++c) gfv[c] = *(const f32x4*)(gf + 4 * c);
            }
        }
        f32x2 ap[8];
#pragma unroll
        for (int i = 0; i < 8; ++i) ap[i] = (f32x2){0.f, 0.f};
#pragma unroll
        for (int j = 0; j < 16; ++j) {
            const float ws1 = cw[j >> 2][j & 3]; const f32x2 ww = {ws1, ws1}; const u32x4 v = vv[j];
            ap[0] += __builtin_amdgcn_cvt_pk_f32_fp8((int)v.x, false) * ww; ap[1] += __builtin_amdgcn_cvt_pk_f32_fp8((int)v.x, true) * ww;
            ap[2] += __builtin_amdgcn_cvt_pk_f32_fp8((int)v.y, false) * ww; ap[3] += __builtin_amdgcn_cvt_pk_f32_fp8((int)v.y, true) * ww;
            ap[4] += __builtin_amdgcn_cvt_pk_f32_fp8((int)v.z, false) * ww; ap[5] += __builtin_amdgcn_cvt_pk_f32_fp8((int)v.z, true) * ww;
            ap[6] += __builtin_amdgcn_cvt_pk_f32_fp8((int)v.w, false) * ww; ap[7] += __builtin_amdgcn_cvt_pk_f32_fp8((int)v.w, true) * ww;
            vv[j] = __builtin_bit_cast(u32x4, __builtin_amdgcn_raw_buffer_load_b128(vrs, (int)((na[j >> 2][j & 3] & (DRY ? VMASK : 0xffffffffu)) * 128u + (unsigned)sub * 16u), 0, 0));
        }
        float acc[16];
#pragma unroll
        for (int i = 0; i < 8; ++i) { acc[2 * i] = ap[i].x; acc[2 * i + 1] = ap[i].y; }
#pragma unroll
        for (int i = 0; i < 16; ++i) { acc[i] += lr8(acc[i]); acc[i] = sum_x16(acc[i]); acc[i] = sum_x32(acc[i]); }
        if (eg == 0) {
            float* xr = DRY ? (float*)(ws + OFF_R + 16 * MB) + (long)tok * DM + col0 : x + (long)tok * DM + col0;
#pragma unroll
            for (int c = 0; c < 4; ++c) {
                const f32x4 gv = gfv[c];
                f32x4 o;
                o.x = xv[c].x + gv.x * acc[4 * c + 0]; o.y = xv[c].y + gv.y * acc[4 * c + 1];
                o.z = xv[c].z + gv.z * acc[4 * c + 2]; o.w = xv[c].w + gv.w * acc[4 * c + 3];
                *(f32x4*)(xr + 4 * c) = o;
            }
        }
#pragma unroll
        for (int q = 0; q < 4; ++q) { cw[q] = nw[q]; na[q] = pa[q]; nw[q] = pw[q]; }
    }
}

DI void phase_norm2(const float* __restrict__ x, bf16_t* __restrict__ out1, const float* gain1, int sh1, int sc1,
                    bf16_t* __restrict__ out2, const float* gain2, int sh2, int sc2, const float* ada, int tid) {
    const int lane = tid & 63, gw = blockIdx.x * NWAVES + (tid >> 6), nw = gridDim.x * NWAVES;
    for (int tok = gw; tok < NTOK; tok += nw) {
        const int b = tok >> 13;
        f32x4 v[4]; float ss = 0.f;
#pragma unroll
        for (int j = 0; j < 4; ++j) { v[j] = *(const f32x4*)(x + (long)tok * DM + 4 * lane + 256 * j); ss += v[j].x * v[j].x + v[j].y * v[j].y + v[j].z * v[j].z + v[j].w * v[j].w; }
        const float rstd = rsqrtf(wave_sum(ss) * (1.f / DM) + EPS);
        norm_row_write(v, rstd, gain1, ada + b * ADA_STRIDE + sh1, ada + b * ADA_STRIDE + sc1, out1 + (long)tok * DM, lane);
        norm_row_write(v, rstd, gain2, ada + b * ADA_STRIDE + sh2, ada + b * ADA_STRIDE + sc2, out2 + (long)tok * DM, lane);
    }
}

template <int MT, class Epi>
DI void gemm_phase(const bf16_t* A, long lda, int M, const bf16_t* Bt, long ldb, int N, int K, const Epi& epi, unsigned char* lds, int tid) {
    const int ntm = (M + 128 * MT - 1) / (128 * MT), ntn = (N + 255) / 256, nt = ntm * ntn;
    for (int t = blockIdx.x; t < nt; t += gridDim.x) {
        const int tn = t / ntm, tm = t % ntm;
        gemm_tile<MT>(A, lda, M, Bt, ldb, N, K, tm * 128 * MT, tn * 256, epi, lds, tid);
    }
}

#define XB_TMO      128
#define XB_XCNT(j)  (256  + 64 * (j))
#define XB_XSUB(j)  (1280 + 64 * (j))
#define XB_XGEN(j)  (2304 + 64 * (j))
#define XB_TOP      3328
#define XB_TOPGEN   3392
#define XCD_BAR_WORDS 3456
#define XB_SPIN_CAP (1u << 22)
#define LAS __attribute__((address_space(3)))
DI unsigned xb_ld(unsigned* p) { return __hip_atomic_load(p, __ATOMIC_RELAXED, __HIP_MEMORY_SCOPE_AGENT); }
DI unsigned xb_add(unsigned* p, unsigned v) { return __hip_atomic_fetch_add(p, v, __ATOMIC_RELAXED, __HIP_MEMORY_SCOPE_AGENT); }
DI unsigned xb_xcc_id() { return (unsigned)__builtin_amdgcn_s_getreg((3 << 11) | 20) & 0xFu; }
#define XB_SPIN(cond, bar) do { unsigned _sp = 0; while (cond) { __builtin_amdgcn_s_sleep(1); \
    if ((++_sp & 255u) == 0u) { if (xb_ld(&(bar)[XB_TMO])) break; if (_sp > XB_SPIN_CAP) { atomicAdd(&(bar)[XB_TMO], 1u); break; } } } } while (0)
DI void xcd_barrier_complete(unsigned* bar, unsigned x, unsigned& nloc, unsigned& nx) {
    const unsigned G = gridDim.x;
    unsigned sum, cnt, mine, sp = 0u;
    for (;;) {
        sum = 0u; cnt = 0u; mine = 0u;
#pragma unroll
        for (unsigned j = 0; j < 16; ++j) { const unsigned c = xb_ld(&bar[XB_XCNT(j)]); sum += c; cnt += (c > 0u) ? 1u : 0u; mine = (j == x) ? c : mine; }
        if (sum == G) break;
        __builtin_amdgcn_s_sleep(1);
        if ((++sp & 255u) == 0u) { if (xb_ld(&bar[XB_TMO])) break; if (sp > XB_SPIN_CAP) { atomicAdd(&bar[XB_TMO], 1u); break; } }
    }
    nloc = mine > 0u ? mine : 1u; nx = cnt > 0u ? cnt : 1u;
}
DI void xcd_barrier(unsigned* bar, volatile LAS unsigned* st, int tid) {
    asm volatile("s_waitcnt vmcnt(0)" ::: "memory");
    __syncthreads();
    if (tid == 0) {
        const unsigned x = xb_xcc_id();
        __builtin_amdgcn_s_waitcnt(0);
        unsigned nloc = st[0], nx = st[1];
        if (nloc == 0u) { xcd_barrier_complete(bar, x, nloc, nx); st[0] = nloc; st[1] = nx; }
        const unsigned old = xb_add(&bar[XB_XSUB(x)], 1u);
        const unsigned gen = old / nloc;
        if (old + 1u == (gen + 1u) * nloc) {
            __builtin_amdgcn_fence(__ATOMIC_RELEASE, "agent");
            asm volatile("s_waitcnt vmcnt(0)" ::: "memory");
            const unsigned og = xb_add(&bar[XB_TOP], 1u);
            const unsigned tg = og / nx;
            if (og + 1u == (tg + 1u) * nx) xb_add(&bar[XB_TOPGEN], 1u);
            else XB_SPIN(xb_ld(&bar[XB_TOPGEN]) == tg, bar);
            __builtin_amdgcn_fence(__ATOMIC_ACQUIRE, "agent");
            xb_add(&bar[XB_XGEN(x)], 1u);
            asm volatile("s_waitcnt vmcnt(0)" ::: "memory");
        } else {
            XB_SPIN(xb_ld(&bar[XB_XGEN(x)]) == gen, bar);
            __builtin_amdgcn_fence(__ATOMIC_ACQUIRE, "agent");
            asm volatile("s_waitcnt vmcnt(0)" ::: "memory");
        }
    }
    __syncthreads();
}

#define ftid() ftid_(wave_u)
DI int ftid_(int wave_u) { int t = (wave_u << 6) + (int)__builtin_amdgcn_mbcnt_hi(~0u, __builtin_amdgcn_mbcnt_lo(~0u, 0u)); asm volatile("" : "+v"(t)); return t; }


#if defined(__HIP_DEVICE_COMPILE__)
typedef const __attribute__((address_space(4))) Params* KParamPtr;
DI Params load_params() { KParamPtr kp = (KParamPtr)__builtin_amdgcn_kernarg_segment_ptr(); asm volatile("" : "+s"(kp)); return *kp; }
#else
DI Params load_params() { return Params{}; }
#endif
#define p (load_params())
#define ws (load_params().ws)
#define ada ((const float*)(ws + OFF_ADA))
#define Hb ((bf16_t*)(ws + OFF_H))
#define bar ((unsigned*)(ws + OFF_BAR))
__global__ void __launch_bounds__(NTHREADS) yoco_fwd(Params p_arg) {
    extern __shared__ __attribute__((aligned(16))) unsigned char lds[];
    cg::grid_group grid = cg::this_grid();
    volatile LAS unsigned* bst = (volatile LAS unsigned*)(lds + 144 * 1024);
    const int wave_u = __builtin_amdgcn_readfirstlane((int)(threadIdx.x >> 6));
    { const int t0 = ftid(); if (t0 == 0) { bst[0] = 0u; bst[1] = 0u; }
      if (blockIdx.x == 0) for (int i = t0; i < XCD_BAR_WORDS; i += NTHREADS) bar[i] = 0u; }
    __syncthreads();
    RUN(0) REP(0) phase_prep(p, lds, ftid());
    grid.sync();
    if (ftid() == 0) (void)xb_add(&bar[XB_XCNT(xb_xcc_id())], 1u);
    RUN(1) REP(1) phase_norm(p.in[0], Hb, p.in[5], ada, 0, 1024, ftid());
    xcd_barrier(bar, bst, ftid());
    RUN(2) REP(2) {
        EpiQKV0 e{(bf16_t*)(ws + OFF_Q0), (bf16_t*)(ws + OFF_K0), (bf16_t*)(ws + OFF_VT0), p.in[10], p.in[11]};
        gemm_phase<2>(Hb, DM, NTOK, (const bf16_t*)(ws + OFF_WT_DIN), DM, 3072, DM, e, lds, ftid());
    }
    xcd_barrier(bar, bst, ftid());
    RUN(3) REP(3) phase_diff_attn(p, lds, ftid());
    xcd_barrier(bar, bst, ftid());
    RUN(4) REP(4) {
        EpiResid e{p.in[0], opq(p.out), ada + 2 * 1024};
        gemm_phase<2>(Hb, DM, NTOK, (const bf16_t*)(ws + OFF_WT_DOUT), DM, 1024, DM, e, lds, ftid());
    }
    xcd_barrier(bar, bst, ftid());
    if (STOP_AFTER <= 1) return;
    RUN(1) phase_norm(opq(p.out), Hb, p.in[6], ada, 3 * 1024, 4 * 1024, ftid());
    xcd_barrier(bar, bst, ftid());
    RUN(5) REP(5) {
        EpiPeer e{(int*)(ws + OFF_RIDX), (float*)(ws + OFF_RGATE), 128 * 1024};
        gemm_phase<2>(Hb, DM, NTOK, (const bf16_t*)(ws + OFF_WT_PEER), DM, 2048, DM, e, lds, ftid());
    }
    xcd_barrier(bar, bst, ftid());
    if ((REPEAT_MASK >> 6) & 1) phase_peer_u<true>(p, 0, lds, ftid());
    RUN(6) phase_peer_u<false>(p, 0, lds, ftid());
    xcd_barrier(bar, bst, ftid());
    if ((REPEAT_MASK >> 10) & 1) phase_peer_v<true>(p, 0, ftid());
    RUN(6) phase_peer_v<false>(p, 0, ftid());
    xcd_barrier(bar, bst, ftid());
    RUN(1) phase_norm2(opq(p.out), (bf16_t*)(ws + OFF_H2), p.in[13], 12288, 12288 + 1024, Hb, p.in[5] + 1024, 6144, 6144 + 1024, ada, ftid());
    xcd_barrier(bar, bst, ftid());
    if (STOP_AFTER <= 2) return;
    RUN(7) REP(7) {
        EpiKV e{(bf16_t*)(ws + OFF_KC), (bf16_t*)(ws + OFF_KS), (bf16_t*)(ws + OFF_VST), (bf16_t*)(ws + OFF_KW), (bf16_t*)(ws + OFF_VWT), p.in[21]};
        gemm_phase<2>((const bf16_t*)(ws + OFF_H2), DM, NTOK, (const bf16_t*)(ws + OFF_WT_KV), DM, 1536, DM, e, lds, ftid());
    }
    xcd_barrier(bar, bst, ftid());
    RUN(8) REP(8) {
        EpiNsaQ e{(bf16_t*)(ws + OFF_QN), (float*)(ws + OFF_GATES), p.in[25], p.in[23]};
        gemm_phase<2>(Hb, DM, NTOK, (const bf16_t*)(ws + OFF_WT_NIN), DM, 1048, DM, e, lds, ftid());
        for (int t = blockIdx.x; t < 64; t += gridDim.x) {
            const int pr = t >> 2, tm = t & 3, kv = pr >> 3, bg = pr & 7;
            const bf16_t* Ap = (const bf16_t*)(ws + OFF_KC) + (long)(kv * 8 + bg) * SEQ * 128;
            bf16_t* hid = (bf16_t*)(ws + OFF_HID) + (long)pr * 512 * 256;
            EpiCmp1 e1{hid, (const float*)(ws + OFF_POSB) + kv * 16 * 256, p.in[19] + kv * 256};
            gemm_tile<1>(Ap, 2048, 511, (const bf16_t*)(ws + OFF_WT_C1) + (long)kv * 256 * 4096, 4096, 256, 4096, tm * 128, 0, e1, lds, ftid());
            __syncthreads();
            bf16_t* dst = kv == 0 ? (bf16_t*)(ws + OFF_KCMP) + (long)bg * 512 * 128 : (bf16_t*)(ws + OFF_VCMPT) + (long)bg * 128 * 512;
            EpiCmp2 e2{dst, p.in[21], kv};
            gemm_tile<1>(hid, 256, 512, (const bf16_t*)(ws + OFF_WT_C2) + (long)kv * 128 * 256, 256, 128, 256, tm * 128, 0, e2, lds, ftid());
        }
    }
    xcd_barrier(bar, bst, ftid());
#ifdef NSA_PROBE
    phase_nsa_attn<NSA_PROBE>(p, lds, ftid());
#endif
    RUN(9) REP(9) phase_nsa_attn<0>(p, lds, ftid());
    xcd_barrier(bar, bst, ftid());
    RUN(4) {
        float* xo = opq(p.out);
        EpiResid e{xo, xo, ada + 6144 + 2 * 1024};
        gemm_phase<2>(Hb, DM, NTOK, (const bf16_t*)(ws + OFF_WT_NOUT), DM, 1024, DM, e, lds, ftid());
    }
    xcd_barrier(bar, bst, ftid());
    if (STOP_AFTER <= 3) return;
    RUN(1) phase_norm(opq(p.out), Hb, p.in[6] + 1024, ada, 6144 + 3 * 1024, 6144 + 4 * 1024, ftid());
    xcd_barrier(bar, bst, ftid());
    RUN(5) REP(5) {
        EpiPeer e{(int*)(ws + OFF_RIDX), (float*)(ws + OFF_RGATE), 128 * 1024};
        gemm_phase<2>(Hb, DM, NTOK, (const bf16_t*)(ws + OFF_WT_PEER) + (long)2048 * 1024, DM, 2048, DM, e, lds, ftid());
    }
    xcd_barrier(bar, bst, ftid());
    if ((REPEAT_MASK >> 6) & 1) phase_peer_u<true>(p, 1, lds, ftid());
    RUN(6) phase_peer_u<false>(p, 1, lds, ftid());
    xcd_barrier(bar, bst, ftid());
    if ((REPEAT_MASK >> 10) & 1) phase_peer_v<true>(p, 1, ftid());
    RUN(6) phase_peer_v<false>(p, 1, ftid());
}
#undef p
#undef ws
#undef ada
#undef Hb
#undef bar

extern "C" void kernel_launch(void* const* d_in, const int* in_sizes, int n_in, void* d_out, int out_size, void* d_ws, size_t ws_size,
                              hipStream_t stream) {
    static int grid_blocks = 0;
    if (grid_blocks == 0) {
        if (n_in != 30 || out_size != NTOK * DM || ws_size < WS_END) {
            fprintf(stderr, "kernel_launch: unexpected shapes (n_in %d out %d ws %zu)\n", n_in, out_size, ws_size);
            grid_blocks = -1; return;
        }
        int dev = 0, cus = 0, per_cu = 0;
        hipGetDevice(&dev);
        hipDeviceGetAttribute(&cus, hipDeviceAttributeMultiprocessorCount, dev);
        hipFuncSetAttribute((const void*)yoco_fwd, hipFuncAttributeMaxDynamicSharedMemorySize, LDS_BYTES);
        hipOccupancyMaxActiveBlocksPerMultiprocessor(&per_cu, (const void*)yoco_fwd, NTHREADS, LDS_BYTES);
        if (per_cu < 1) { fprintf(stderr, "kernel_launch: occupancy query says %d blocks per CU\n", per_cu); grid_blocks = -1; return; }
        grid_blocks = cus;
    }
    if (grid_blocks < 0) return;
    Params p{};
    for (int i = 0; i < 30; ++i) p.in[i] = (const float*)d_in[i];
    p.out = (float*)d_out;
    p.ws = (unsigned char*)d_ws;
    void* args[] = {&p};
    hipError_t e = hipLaunchCooperativeKernel((const void*)yoco_fwd, dim3(grid_blocks), dim3(NTHREADS), args, LDS_BYTES, stream);
    if (e != hipSuccess) fprintf(stderr, "cooperative launch failed: %s (grid %d)\n", hipGetErrorString(e), grid_blocks);
}
```

```cpp
#include <hip/hip_runtime.h>
#include <hip/hip_cooperative_groups.h>
#include <cstdio>
#include <cstdint>
namespace cg = cooperative_groups;

#define DI __device__ __forceinline__
#ifndef STOP_AFTER
#define STOP_AFTER 99
#endif
#ifndef ONLY_PHASE
#define ONLY_PHASE -1
#endif
#define RUN(n) if (ONLY_PHASE < 0 || ONLY_PHASE == (n))
#ifndef REPEAT_MASK
#define REPEAT_MASK 0
#endif
#define REP(n) for (int rep_ = 0; rep_ < (((REPEAT_MASK) >> (n)) & 1) + 1; ++rep_)

typedef unsigned short bf16_t;
typedef short bf16x8 __attribute__((ext_vector_type(8)));
typedef float f32x16 __attribute__((ext_vector_type(16)));
typedef float f32x4 __attribute__((ext_vector_type(4)));
typedef float f32x2 __attribute__((ext_vector_type(2)));
typedef unsigned u32x4 __attribute__((ext_vector_type(4)));
typedef unsigned u32x2 __attribute__((ext_vector_type(2)));
typedef __bf16 bf16x2v __attribute__((ext_vector_type(2)));

#define MFMA32(a, b, c) __builtin_amdgcn_mfma_f32_32x32x16_bf16((a), (b), (c), 0, 0, 0)

constexpr int NB = 4, SEQ = 8192, DM = 1024, NTOK = NB * SEQ;
constexpr int NTHREADS = 512, NWAVES = 8;
constexpr float EPS = 1e-6f;
constexpr float LOG2E = 1.4426950408889634f;
constexpr int ADA_STRIDE = 14336;

constexpr size_t MB = 1u << 20;
constexpr size_t OFF_ADA = 0;
constexpr size_t OFF_POSB = 256 * 1024;
constexpr size_t OFF_BAR = 320 * 1024;
constexpr size_t OFF_MB0 = 168 * MB;
constexpr size_t OFF_MB1 = 172 * MB;
constexpr size_t OFF_USI = 384 * 1024;
constexpr size_t OFF_VSI = 512 * 1024;
constexpr size_t OFF_WT_DIN = 1 * MB;
constexpr size_t OFF_WT_DOUT = 7 * MB;
constexpr size_t OFF_WT_KV = 9 * MB;
constexpr size_t OFF_WT_NIN = 12 * MB;
constexpr size_t OFF_WT_NOUT = 15 * MB;
constexpr size_t OFF_WT_PEER = 17 * MB;
constexpr size_t OFF_WT_C1 = 25 * MB;
constexpr size_t OFF_WT_C2 = 29 * MB;
constexpr size_t OFF_GATES = 30 * MB;
constexpr size_t OFF_KCMP = 34 * MB;
constexpr size_t OFF_VCMPT = 35 * MB;
constexpr size_t OFF_HID = 36 * MB;
constexpr size_t OFF_RIDX = 40 * MB;
constexpr size_t OFF_RGATE = 56 * MB;
constexpr size_t OFF_PU = 72 * MB;
constexpr size_t OFF_PV = 136 * MB;
constexpr size_t OFF_H = 200 * MB;
constexpr size_t OFF_R = 264 * MB;
constexpr size_t WS_END = 456 * MB;
constexpr size_t OFF_Q0 = OFF_R, OFF_K0 = OFF_R + 64 * MB, OFF_VT0 = OFF_R + 128 * MB;
constexpr size_t OFF_QN = OFF_R, OFF_H2 = OFF_R, OFF_KC = OFF_R + 64 * MB, OFF_KS = OFF_R + 96 * MB, OFF_VST = OFF_R + 112 * MB,
                 OFF_KW = OFF_R + 128 * MB, OFF_VWT = OFF_R + 144 * MB;

constexpr int LDS_BYTES = 144 * 1024 + 256;

struct Params {
    const float* in[30];
    float* out;
    unsigned char* ws;
};

template <class T> DI T* opq(T* q) { asm volatile("" : "+s"(q)); return (T*)(__attribute__((address_space(1))) T*)q; }
DI unsigned pk2(float lo, float hi) { f32x2 v = {lo, hi}; return __builtin_bit_cast(unsigned, __builtin_convertvector(v, bf16x2v)); }
DI bf16_t f2bf(float x) { return (bf16_t)(pk2(x, 0.f) & 0xffffu); }
DI float bflo(unsigned u) { return __uint_as_float(u << 16); }
DI float bfhi(unsigned u) { return __uint_as_float(u & 0xffff0000u); }
DI float fexp2(float x) { return __builtin_amdgcn_exp2f(x); }
DI float frcp(float x) { return __builtin_amdgcn_rcpf(x); }
DI int crow(int reg, int h) { return (reg & 3) + 8 * (reg >> 2) + 4 * h; }
template <int CTRL> DI float dpp_f(float v) { return __builtin_bit_cast(float, __builtin_amdgcn_update_dpp(0, __builtin_bit_cast(int, v), CTRL, 0xF, 0xF, true)); }
DI float lx1(float v) { return dpp_f<0xB1>(v); }
DI float lx2(float v) { return dpp_f<0x4E>(v); }
DI float lhm(float v) { return dpp_f<0x141>(v); }
DI float lr8(float v) { return dpp_f<0x128>(v); }
DI float sum_x16(float v) { auto s = __builtin_amdgcn_permlane16_swap(__float_as_uint(v), __float_as_uint(v), false, false); return __uint_as_float(s[0]) + __uint_as_float(s[1]); }
DI float sum_x32(float v) { auto s = __builtin_amdgcn_permlane32_swap(__float_as_uint(v), __float_as_uint(v), false, false); return __uint_as_float(s[0]) + __uint_as_float(s[1]); }
DI float max_x16(float v) { auto s = __builtin_amdgcn_permlane16_swap(__float_as_uint(v), __float_as_uint(v), false, false); return fmaxf(__uint_as_float(s[0]), __uint_as_float(s[1])); }
DI float max_x32(float v) { auto s = __builtin_amdgcn_permlane32_swap(__float_as_uint(v), __float_as_uint(v), false, false); return fmaxf(__uint_as_float(s[0]), __uint_as_float(s[1])); }
DI unsigned get_x32(unsigned v, int h) { auto s = __builtin_amdgcn_permlane32_swap(v, v, false, false); return h ? s[0] : s[1]; }
DI float wave_sum(float v) { v += lx1(v); v += lx2(v); v += lhm(v); v += lr8(v); v = sum_x16(v); return sum_x32(v); }
DI float wave_max(float v) { v = fmaxf(v, lx1(v)); v = fmaxf(v, lx2(v)); v = fmaxf(v, lhm(v)); v = fmaxf(v, lr8(v)); v = max_x16(v); return max_x32(v); }
DI int bperm(int v, int srclane) { return __builtin_amdgcn_ds_bpermute(srclane << 2, v); }
DI float bpermf(float v, int srclane) { return __builtin_bit_cast(float, __builtin_amdgcn_ds_bpermute(srclane << 2, __builtin_bit_cast(int, v))); }
DI float gelu_tanh(float x) {
    const float u = 0.7978845608028654f * (x + 0.044715f * x * x * x);
    return x * frcp(1.f + fexp2(-2.f * LOG2E * u));
}
DI float dot2bf(unsigned a, unsigned b, float c) {
    return __builtin_amdgcn_fdot2_f32_bf16(__builtin_bit_cast(bf16x2v, a), __builtin_bit_cast(bf16x2v, b), c, false);
}
DI int rel_bucket_i(int d) {
    if (d < 16) return d < 0 ? 0 : d;
    int b = 16;
    b += d >= 21; b += d >= 27; b += d >= 35; b += d >= 46; b += d >= 59; b += d >= 77; b += d >= 99; b += d >= 128;
    b += d >= 166; b += d >= 216; b += d >= 280; b += d >= 363; b += d >= 470; b += d >= 609; b += d >= 790;
    return b;
}
DI unsigned f2key(float f) { unsigned u = __float_as_uint(f); return u ^ ((unsigned)((int)u >> 31) | 0x80000000u); }
DI float key2f(unsigned k) { unsigned u = (k & 0x80000000u) ? (k ^ 0x80000000u) : ~k; return __uint_as_float(u); }

constexpr int EPI_LDS = 96 * 1024;

DI int sw2(int row, int chunk) { return (row >> 1) * 256 + (((((row & 1) << 3) | chunk) ^ ((row >> 1) & 15)) << 4); }
DI void sw2_src(int P, int& row, int& chunk) { const int R2 = P >> 4, lc = (P & 15) ^ (R2 & 15); row = 2 * R2 + (lc >> 3); chunk = lc & 7; }

template <class T, class = void> struct epi_stash { static constexpr bool value = false, present = false; };
template <class T> struct epi_stash<T, decltype((void)T::STASH)> { static constexpr bool value = T::STASH, present = true; };

template <int MT, class Epi>
DI void gemm_tile(const bf16_t* __restrict__ A, long lda, int M, const bf16_t* __restrict__ Bt, long ldb, int N, int K,
                  int m0, int n0, const Epi& epi, unsigned char* lds, int tid) {
    constexpr int XS = MT * 128 * 128, WS = 256 * 128, STAGE = XS + WS;
    const int lane = tid & 63, w = tid >> 6, tg = w & 3, fh = w >> 2, r = lane & 31, h = lane >> 5;
    const int wbase = tid & ~63;
    unsigned xo[2 * MT], wo[4];
#pragma unroll
    for (int i = 0; i < 2 * MT; ++i) { int row, c; sw2_src(tid + 512 * i, row, c); int m = m0 + row; m = m < M ? m : M - 1; xo[i] = (unsigned)m * (unsigned)(lda * 2) + c * 16; }
#pragma unroll
    for (int i = 0; i < 4; ++i) { int row, c; sw2_src(tid + 512 * i, row, c); int n = n0 + row; n = n < N ? n : N - 1; wo[i] = (unsigned)n * (unsigned)(ldb * 2) + c * 16; }
    const unsigned char* Ab = (const unsigned char*)A;
    const unsigned char* Bb = (const unsigned char*)Bt;
    auto stage = [&](int kt, unsigned char* st) {
#pragma unroll
        for (int i = 0; i < 2 * MT; ++i)
            __builtin_amdgcn_global_load_lds((const unsigned*)(Ab + kt * 128 + xo[i]), (unsigned*)(st + (wbase + 512 * i) * 16), 16, 0, 0);
#pragma unroll
        for (int i = 0; i < 4; ++i)
            __builtin_amdgcn_global_load_lds((const unsigned*)(Bb + kt * 128 + wo[i]), (unsigned*)(st + XS + (wbase + 512 * i) * 16), 16, 0, 0);
    };
    f32x16 acc[MT][4];
#pragma unroll
    for (int s2 = 0; s2 < MT; ++s2)
#pragma unroll
        for (int i = 0; i < 4; ++i)
#pragma unroll
            for (int j = 0; j < 16; ++j) acc[s2][i][j] = 0.f;
    const int nk = K >> 6;
    stage(0, lds);
    __syncthreads();
    for (int kt = 0; kt < nk; ++kt) {
        unsigned char* cur = lds + (kt & 1) * STAGE;
        if (kt + 1 < nk) stage(kt + 1, lds + ((kt + 1) & 1) * STAGE);
        bf16x8 xfa[MT], wfa[4], xfb[MT], wfb[4];
        auto ldf = [&](bf16x8 (&xf)[MT], bf16x8 (&wf)[4], int ks) {
#pragma unroll
            for (int s2 = 0; s2 < MT; ++s2) xf[s2] = *(const bf16x8*)(cur + sw2(32 * MT * tg + 32 * s2 + r, 2 * ks + h));
#pragma unroll
            for (int mt = 0; mt < 4; ++mt) wf[mt] = *(const bf16x8*)(cur + XS + sw2(128 * fh + 32 * mt + r, 2 * ks + h));
        };
        auto mm = [&](const bf16x8 (&xf)[MT], const bf16x8 (&wf)[4]) {
#pragma unroll
            for (int mt = 0; mt < 4; ++mt)
#pragma unroll
                for (int s2 = 0; s2 < MT; ++s2) acc[s2][mt] = MFMA32(wf[mt], xf[s2], acc[s2][mt]);
        };
        ldf(xfa, wfa, 0);
        ldf(xfb, wfb, 1); __builtin_amdgcn_sched_barrier(0); mm(xfa, wfa); __builtin_amdgcn_sched_barrier(0);
        ldf(xfa, wfa, 2); __builtin_amdgcn_sched_barrier(0); mm(xfb, wfb); __builtin_amdgcn_sched_barrier(0);
        ldf(xfb, wfb, 3); __builtin_amdgcn_sched_barrier(0); mm(xfa, wfa); __builtin_amdgcn_sched_barrier(0);
        mm(xfb, wfb);
        __syncthreads();
    }
    if constexpr (MT == 2 && epi_stash<Epi>::value) {
        float* sp = (float*)lds + w * 4096 + lane;
#pragma unroll
        for (int mt = 0; mt < 4; ++mt)
#pragma unroll
            for (int j = 0; j < 16; ++j) sp[(mt * 16 + j) * 64] = acc[1][mt][j];
        epi(acc[0], m0 + 64 * tg + r, n0 + 128 * fh, h, lds, tid);
        f32x16 a2[4];
        const float* sp2 = sp; asm volatile("" : "+v"(sp2));
#pragma unroll
        for (int mt = 0; mt < 4; ++mt)
#pragma unroll
            for (int j = 0; j < 16; ++j) a2[mt][j] = sp2[(mt * 16 + j) * 64];
        epi(a2, m0 + 64 * tg + 32 + r, n0 + 128 * fh, h, lds, tid);
        __syncthreads();
    } else {
        int ho = h, ro = r, to = tid;
        if constexpr (epi_stash<Epi>::present) asm volatile("" : "+v"(ho), "+v"(ro), "+v"(to));
#pragma unroll
        for (int s2 = 0; s2 < MT; ++s2) epi(acc[s2], m0 + 32 * MT * tg + 32 * s2 + ro, n0 + 128 * fh, ho, lds, to);
    }
}

struct EpiQKV0 {
    bf16_t *Q, *Kk, *VT;
    const float *qg, *kg;
    float* MB; const float* relb;
    DI void operator()(const f32x16 (&acc)[4], int tok, int fbase, int h, unsigned char*, int) const {
        const int sec = fbase >> 10, hd = (fbase & 1023) >> 7, b = tok >> 13, s = tok & (SEQ - 1);
        if (sec < 2) {
            const float* gn = sec == 0 ? qg : kg;
            const float sc = sec == 0 ? 0.125f * LOG2E : 1.f;
            bf16_t* dst = sec == 0 ? Q : Kk;
#pragma unroll
            for (int j = 0; j < 2; ++j) {
                float ss = 0.f;
#pragma unroll
                for (int mt = 0; mt < 2; ++mt)
#pragma unroll
                    for (int rg = 0; rg < 16; ++rg) { const float v = acc[2 * j + mt][rg]; ss += v * v; }
                ss = sum_x32(ss);
                const float rstd = rsqrtf(ss * (1.f / 64.f) + EPS) * sc;
                bf16_t* row = dst + ((long)((b * 8 + hd) * 2 + j) * SEQ + s) * 64;
                float qq = 0.f;
#pragma unroll
                for (int mt = 0; mt < 2; ++mt)
#pragma unroll
                    for (int g4 = 0; g4 < 4; ++g4) {
                        const int d0 = 32 * mt + 8 * g4 + 4 * h;
                        const f32x4 gv = *(const f32x4*)(gn + d0);
                        const float v0 = acc[2 * j + mt][4 * g4 + 0] * rstd * gv.x, v1 = acc[2 * j + mt][4 * g4 + 1] * rstd * gv.y;
                        const float v2 = acc[2 * j + mt][4 * g4 + 2] * rstd * gv.z, v3 = acc[2 * j + mt][4 * g4 + 3] * rstd * gv.w;
                        qq += v0 * v0 + v1 * v1 + v2 * v2 + v3 * v3;
                        u32x2 o;
                        o.x = pk2(v0, v1); o.y = pk2(v2, v3);
                        *(u32x2*)(row + d0) = o;
                    }
                if (sec == 0) {
                    qq = sum_x32(qq);
                    float kmx = 0.f;
                    for (int d = 0; d < 64; ++d) kmx = fmaxf(kmx, fabsf(kg[d]));
                    float bmx = 0.f;
                    for (int bk = 0; bk < 32; ++bk) bmx = fmaxf(bmx, relb[bk * 8 + hd] - relb[31 * 8 + hd]);
                    if (h == 0) MB[(long)((b * 8 + hd) * 2 + j) * SEQ + s] = 1.01f * sqrtf(qq) * 8.f * kmx + bmx * LOG2E;
                }
            }
        } else {
            bf16_t* base = VT + (long)(b * 8 + hd) * 128 * SEQ + s;
#pragma unroll
            for (int mt = 0; mt < 4; ++mt)
#pragma unroll
                for (int rg = 0; rg < 16; ++rg) base[(long)(32 * mt + crow(rg, h)) * SEQ] = f2bf(acc[mt][rg]);
        }
    }
};

struct EpiResid {
    const float* xin; float* xout; const float* gate;
    DI void operator()(const f32x16 (&acc)[4], int tok, int fbase, int h, unsigned char*, int) const {
        const int b = tok >> 13;
        const float* gp = gate + b * ADA_STRIDE;
#pragma unroll
        for (int mt = 0; mt < 4; ++mt)
#pragma unroll
            for (int g4 = 0; g4 < 4; ++g4) {
                const int f = fbase + 32 * mt + 8 * g4 + 4 * h;
                const f32x4 xv = *(const f32x4*)(xin + (long)tok * DM + f);
                const f32x4 gv = *(const f32x4*)(gp + f);
                f32x4 o;
                o.x = xv.x + gv.x * acc[mt][4 * g4 + 0]; o.y = xv.y + gv.y * acc[mt][4 * g4 + 1];
                o.z = xv.z + gv.z * acc[mt][4 * g4 + 2]; o.w = xv.w + gv.w * acc[mt][4 * g4 + 3];
                *(f32x4*)(xout + (long)tok * DM + f) = o;
                if (g4 == 3) __builtin_amdgcn_sched_barrier(0);
            }
    }
};

struct EpiKV {
    bf16_t *KC, *KS, *VST, *KW, *VWT;
    const float* kgain;
    DI void operator()(const f32x16 (&acc)[4], int tok, int fbase, int h, unsigned char*, int) const {
        const int c = fbase >> 7, br = c >> 2, kv = (c >> 1) & 1, g = c & 1, b = tok >> 13, s = tok & (SEQ - 1);
        if (br == 0 || kv == 0) {
            float rstd = 1.f;
            bf16_t* row;
            if (br == 0) row = KC + ((long)((kv * 4 + b) * 2 + g) * SEQ + s) * 128;
            else {
                float ss = 0.f;
#pragma unroll
                for (int mt = 0; mt < 4; ++mt)
#pragma unroll
                    for (int rg = 0; rg < 16; ++rg) ss += acc[mt][rg] * acc[mt][rg];
                ss = sum_x32(ss);
                rstd = rsqrtf(ss * (1.f / 128.f) + EPS);
                row = (br == 1 ? KS : KW) + ((long)(b * 2 + g) * SEQ + s) * 128;
            }
#pragma unroll
            for (int mt = 0; mt < 4; ++mt)
#pragma unroll
                for (int g4 = 0; g4 < 4; ++g4) {
                    const int d0 = 32 * mt + 8 * g4 + 4 * h;
                    f32x4 gv = {1.f, 1.f, 1.f, 1.f};
                    if (br != 0) gv = *(const f32x4*)(kgain + br * 128 + d0);
                    u32x2 o;
                    o.x = pk2(acc[mt][4 * g4 + 0] * rstd * gv.x, acc[mt][4 * g4 + 1] * rstd * gv.y);
                    o.y = pk2(acc[mt][4 * g4 + 2] * rstd * gv.z, acc[mt][4 * g4 + 3] * rstd * gv.w);
                    *(u32x2*)(row + d0) = o;
                }
        } else {
            bf16_t* base = (br == 1 ? VST : VWT) + (long)(b * 2 + g) * 128 * SEQ + s;
#pragma unroll
            for (int mt = 0; mt < 4; ++mt)
#pragma unroll
                for (int rg = 0; rg < 16; ++rg) base[(long)(32 * mt + crow(rg, h)) * SEQ] = f2bf(acc[mt][rg]);
        }
    }
};

struct EpiCmp1 {
    bf16_t* hid; const float* posb_part; const float* b1;
    DI void operator()(const f32x16 (&acc)[4], int tok, int fbase, int h, unsigned char*, int) const {
        if (tok >= 512) return;
#pragma unroll
        for (int mt = 0; mt < 4; ++mt)
#pragma unroll
            for (int g4 = 0; g4 < 4; ++g4) {
                const int f = fbase + 32 * mt + 8 * g4 + 4 * h;
                f32x4 pb = *(const f32x4*)(b1 + f);
                for (int c = 0; c < 16; ++c) { const f32x4 t = *(const f32x4*)(posb_part + c * 256 + f); pb.x += t.x; pb.y += t.y; pb.z += t.z; pb.w += t.w; }
                u32x2 o;
                o.x = pk2(gelu_tanh(acc[mt][4 * g4 + 0] + pb.x), gelu_tanh(acc[mt][4 * g4 + 1] + pb.y));
                o.y = pk2(gelu_tanh(acc[mt][4 * g4 + 2] + pb.z), gelu_tanh(acc[mt][4 * g4 + 3] + pb.w));
                *(u32x2*)(hid + (long)tok * 256 + f) = o;
            }
    }
};

struct EpiCmp2 {
    bf16_t* dst; const float* kgain0; int kv;
    DI void operator()(const f32x16 (&acc)[4], int tok, int fbase, int h, unsigned char*, int) const {
        if (fbase != 0 || tok >= 512) return;
        const float valid = tok < 511 ? 1.f : 0.f;
        if (kv == 0) {
            float ss = 0.f;
#pragma unroll
            for (int mt = 0; mt < 4; ++mt)
#pragma unroll
                for (int rg = 0; rg < 16; ++rg) ss += acc[mt][rg] * acc[mt][rg];
            ss = sum_x32(ss);
            const float rstd = rsqrtf(ss * (1.f / 128.f) + EPS) * valid;
#pragma unroll
            for (int mt = 0; mt < 4; ++mt)
#pragma unroll
                for (int g4 = 0; g4 < 4; ++g4) {
                    const int d0 = 32 * mt + 8 * g4 + 4 * h;
                    const f32x4 gv = *(const f32x4*)(kgain0 + d0);
                    u32x2 o;
                    o.x = pk2(acc[mt][4 * g4 + 0] * rstd * gv.x, acc[mt][4 * g4 + 1] * rstd * gv.y);
                    o.y = pk2(acc[mt][4 * g4 + 2] * rstd * gv.z, acc[mt][4 * g4 + 3] * rstd * gv.w);
                    *(u32x2*)(dst + (long)tok * 128 + d0) = o;
                }
        } else {
#pragma unroll
            for (int mt = 0; mt < 4; ++mt)
#pragma unroll
                for (int rg = 0; rg < 16; ++rg) dst[(long)(32 * mt + crow(rg, h)) * 512 + tok] = f2bf(acc[mt][rg] * valid);
        }
    }
};

struct EpiNsaQ {
    bf16_t* QN; float* gates; const float* qgain; const float* bgate; float* qnrm;
    DI void operator()(const f32x16 (&acc)[4], int tok, int fbase, int h, unsigned char*, int) const {
        const int b = tok >> 13, s = tok & (SEQ - 1);
        if (fbase < 1024) {
            const int head = fbase >> 7;
            float ss = 0.f;
#pragma unroll
            for (int mt = 0; mt < 4; ++mt)
#pragma unroll
                for (int rg = 0; rg < 16; ++rg) ss += acc[mt][rg] * acc[mt][rg];
            ss = sum_x32(ss);
            const float rstd = rsqrtf(ss * (1.f / 128.f) + EPS) * (0.08838834764831845f * LOG2E);
            bf16_t* row = QN + ((long)(b * 8 + head) * SEQ + s) * 128;
            float qq = 0.f;
#pragma unroll
            for (int mt = 0; mt < 4; ++mt)
#pragma unroll
                for (int g4 = 0; g4 < 4; ++g4) {
                    const int d0 = 32 * mt + 8 * g4 + 4 * h;
                    const f32x4 gv = *(const f32x4*)(qgain + d0);
                    const float v0 = acc[mt][4 * g4 + 0] * rstd * gv.x, v1 = acc[mt][4 * g4 + 1] * rstd * gv.y;
                    const float v2 = acc[mt][4 * g4 + 2] * rstd * gv.z, v3 = acc[mt][4 * g4 + 3] * rstd * gv.w;
                    qq += v0 * v0 + v1 * v1 + v2 * v2 + v3 * v3;
                    u32x2 o;
                    o.x = pk2(v0, v1); o.y = pk2(v2, v3);
                    *(u32x2*)(row + d0) = o;
                }
            qq = sum_x32(qq);
            if (h == 0) qnrm[(long)tok * 8 + head] = 1.01f * sqrtf(qq);
        } else if (fbase == 1024) {
#pragma unroll
            for (int rg = 0; rg < 16; ++rg) {
                const int f = crow(rg, h);
                if (f < 24) { const float z = acc[0][rg] + bgate[f]; gates[(long)tok * 24 + f] = frcp(1.f + fexp2(-LOG2E * z)); }
            }
        }
    }
};

struct EpiPeer {
    static constexpr bool STASH = false;
    int* ridx; float* rgate; int ex_off;
    DI void operator()(const f32x16 (&acc)[4], int tok, int fbase, int h, unsigned char* lds, int tid) const {
        const int lane = tid & 63, w = tid >> 6, tg = w & 3, fh = w >> 2, r = lane & 31;
        const int hd = fbase >> 8;
        unsigned* EX = (unsigned*)(lds + ex_off);
        unsigned L[16];
#pragma unroll
        for (int i = 0; i < 16; ++i) L[i] = 0u;
#pragma unroll
        for (int mt = 0; mt < 4; ++mt)
#pragma unroll
            for (int rg = 0; rg < 16; ++rg) {
                const int kidx = 32 * mt + crow(rg, h);
                unsigned x = (f2key(acc[mt][rg]) & ~127u) | (unsigned)(127 - kidx);
#pragma unroll
                for (int i = 0; i < 16; ++i) { const unsigned t = L[i] > x ? L[i] : x; x = L[i] > x ? x : L[i]; L[i] = t; }
            }
        {
            unsigned P[16];
#pragma unroll
            for (int i = 0; i < 16; ++i) P[i] = get_x32(L[i], h);
#pragma unroll
            for (int i = 0; i < 16; ++i) L[i] = L[i] > P[15 - i] ? L[i] : P[15 - i];
#pragma unroll
            for (int st = 8; st >= 1; st >>= 1)
#pragma unroll
                for (int i = 0; i < 16; ++i)
                    if ((i & st) == 0) { const unsigned a = L[i], b2 = L[i + st]; L[i] = a > b2 ? a : b2; L[i + st] = a > b2 ? b2 : a; }
        }
        if (h == 0) {
#pragma unroll
            for (int i = 0; i < 16; i += 4) *(u32x4*)(EX + ((fh * 4 + tg) * 32 + r) * 16 + i) = (u32x4){L[i], L[i + 1], L[i + 2], L[i + 3]};
        }
        __syncthreads();
        unsigned X[16], Y[16];
        {
            const unsigned* l0 = EX + ((0 * 4 + tg) * 32 + r) * 16;
            const unsigned* l1 = EX + ((1 * 4 + tg) * 32 + r) * 16;
            const unsigned* px = h ? l1 : l0;
            const unsigned* py = h ? l0 : l1;
#pragma unroll
            for (int i = 0; i < 16; i += 4) {
                const u32x4 a = *(const u32x4*)(px + i), b2 = *(const u32x4*)(py + i);
                X[i] = a.x; X[i + 1] = a.y; X[i + 2] = a.z; X[i + 3] = a.w;
                Y[i] = b2.x; Y[i + 1] = b2.y; Y[i + 2] = b2.z; Y[i + 3] = b2.w;
            }
        }
        unsigned T[16];
#pragma unroll
        for (int i = 0; i < 16; ++i) T[i] = 0u;
#pragma unroll
        for (int i = 0; i < 16; ++i)
#pragma unroll
            for (int j = i; j < 16; ++j) {
                if ((i + 1) * (j + 1) > 16) continue;
                const float fs = key2f(X[i] & ~127u) + key2f(Y[j] & ~127u);
                const unsigned code = h ? (unsigned)((j << 4) | i) : (unsigned)((i << 4) | j);
                unsigned x = (f2key(fs) & ~255u) | (255u - code);
                if (i == j) x = h ? 0u : x;
#pragma unroll
                for (int k = 0; k < 16; ++k) { const unsigned t = T[k] > x ? T[k] : x; x = T[k] > x ? x : T[k]; T[k] = t; }
            }
        {
            unsigned P[16];
#pragma unroll
            for (int i = 0; i < 16; ++i) P[i] = get_x32(T[i], h);
#pragma unroll
            for (int i = 0; i < 16; ++i) T[i] = T[i] > P[15 - i] ? T[i] : P[15 - i];
#pragma unroll
            for (int st = 8; st >= 1; st >>= 1)
#pragma unroll
                for (int i = 0; i < 16; ++i)
                    if ((i & st) == 0) { const unsigned a = T[i], b2 = T[i + st]; T[i] = a > b2 ? a : b2; T[i + st] = a > b2 ? b2 : a; }
        }
        float sc[16], sum = 0.f;
        const float mx = key2f(T[0] & ~255u);
#pragma unroll
        for (int k = 0; k < 16; ++k) { sc[k] = fexp2((key2f(T[k] & ~255u) - mx) * LOG2E); sum += sc[k]; }
        const float inv = frcp(sum);
        if (h == 0) {
            const unsigned* l0 = EX + ((0 * 4 + tg) * 32 + r) * 16;
            const unsigned* l1 = EX + ((1 * 4 + tg) * 32 + r) * 16;
#pragma unroll
            for (int k = 0; k < 16; ++k) {
                if ((k >> 3) != fh) continue;
                const unsigned code = 255u - (T[k] & 255u);
                const int i1 = 127 - (int)(l0[code >> 4] & 127u), i2 = 127 - (int)(l1[code & 15u] & 127u);
                ridx[(long)tok * 128 + hd * 16 + k] = i1 * 128 + i2;
                rgate[(long)tok * 128 + hd * 16 + k] = sc[k] * inv;
            }
        }
        __syncthreads();
    }
};

DI void p0_transpose_item(const float* __restrict__ W, int K, int N, bf16_t* __restrict__ WT, int item, int ntn, unsigned char* lds, int tid) {
    float* tile = (float*)lds;
    const int kb = item / ntn, nb = item % ntn, k0 = kb * 64, n0 = nb * 64;
    {
        const int nn = tid & 63, kk0 = tid >> 6;
#pragma unroll
        for (int i = 0; i < 8; ++i) { const int kk = kk0 + 8 * i; const int n = n0 + nn; tile[kk * 65 + nn] = n < N ? W[(long)(k0 + kk) * N + n] : 0.f; }
    }
    __syncthreads();
    {
        const int n = tid >> 3, c = tid & 7;
        const float* s = tile + (8 * c) * 65 + n;
        u32x4 o;
        o.x = pk2(s[0], s[65]); o.y = pk2(s[2 * 65], s[3 * 65]); o.z = pk2(s[4 * 65], s[5 * 65]); o.w = pk2(s[6 * 65], s[7 * 65]);
        *(u32x4*)(WT + (long)(n0 + n) * K + k0 + 8 * c) = o;
    }
    __syncthreads();
}

DI void p0_fp8_item(const float* __restrict__ src, unsigned char* __restrict__ dst, float* __restrict__ sinv, bool sliced, int item, int tid) {
    const int lane = tid & 63, row = item * 8 + (tid >> 6);
    const float* rp = src + (long)row * 1024;
    f32x4 v[4]; float am = 0.f;
#pragma unroll
    for (int j = 0; j < 4; ++j) {
        v[j] = *(const f32x4*)(rp + 4 * lane + 256 * j);
        am = fmaxf(am, fmaxf(fmaxf(fabsf(v[j].x), fabsf(v[j].y)), fmaxf(fabsf(v[j].z), fabsf(v[j].w))));
    }
    am = wave_max(am);
    const float sc = am > 0.f ? exp2f(floorf(log2f(384.f / am))) : 1.f;
    if (lane == 0) sinv[row] = 1.f / sc;
#pragma unroll
    for (int j = 0; j < 4; ++j) {
        int pk = 0;
        pk = __builtin_amdgcn_cvt_pk_fp8_f32(v[j].x * sc, v[j].y * sc, pk, false);
        pk = __builtin_amdgcn_cvt_pk_fp8_f32(v[j].z * sc, v[j].w * sc, pk, true);
        const int col = 4 * lane + 256 * j;
        unsigned char* d = sliced ? dst + ((long)(col >> 7) * 16384 + row) * 128 + (col & 127) : dst + (long)row * 1024 + col;
        *(int*)d = pk;
    }
}

DI void p0_weff_item(const float* __restrict__ wq, const float* __restrict__ subk, bf16_t* __restrict__ WT, int item, unsigned char* lds, int tid) {
    const int layer = item >> 8, g = (item >> 4) & 15, ct = item & 15, p = g & 1, c0 = ct * 64;
    float* As = (float*)lds;
    float* Bs = As + 64 * 129;
    const float* wql = wq + (long)layer * 1024 * 2048;
    const float* sk = subk + ((long)layer * 2 + p) * 128 * 128;
    for (int e = tid; e < 64 * 128; e += NTHREADS) { const int c = e >> 7, d = e & 127; As[c * 129 + d] = wql[(long)(c0 + c) * 2048 + g * 128 + d]; }
    for (int e = tid; e < 128 * 128; e += NTHREADS) { const int k = e >> 7, d = e & 127; Bs[k * 129 + d] = sk[k * 128 + d]; }
    __syncthreads();
    const int k = tid & 127, cg4 = tid >> 7;
    float acc[16];
#pragma unroll
    for (int i = 0; i < 16; ++i) acc[i] = 0.f;
    for (int d = 0; d < 128; ++d) {
        const float bv = Bs[k * 129 + d];
#pragma unroll
        for (int i = 0; i < 16; ++i) acc[i] += As[(cg4 * 16 + i) * 129 + d] * bv;
    }
    bf16_t* o = WT + ((long)layer * 2048 + g * 128 + k) * 1024 + c0 + cg4 * 16;
    u32x4 o0, o1;
    o0.x = pk2(acc[0], acc[1]); o0.y = pk2(acc[2], acc[3]); o0.z = pk2(acc[4], acc[5]); o0.w = pk2(acc[6], acc[7]);
    o1.x = pk2(acc[8], acc[9]); o1.y = pk2(acc[10], acc[11]); o1.z = pk2(acc[12], acc[13]); o1.w = pk2(acc[14], acc[15]);
    *(u32x4*)o = o0; *(u32x4*)(o + 8) = o1;
    __syncthreads();
}

DI void p0_posb_item(const float* __restrict__ pos, const float* __restrict__ w1, float* __restrict__ part, int item, unsigned char* lds, int tid) {
    const int kv = item >> 4, ch = item & 15;
    float* red = (float*)lds;
    const int j = tid & 255, half = tid >> 8;
    const float* pp = pos + (long)kv * 4096 + ch * 256 + half * 128;
    const float* ww = w1 + ((long)kv * 4096 + ch * 256 + half * 128) * 256 + j;
    float a = 0.f;
    for (int f = 0; f < 128; ++f) a += pp[f] * ww[(long)f * 256];
    red[half * 256 + j] = a;
    __syncthreads();
    if (tid < 256) part[(kv * 16 + ch) * 256 + tid] = red[tid] + red[256 + tid];
    __syncthreads();
}

DI void p0_ada_item(const Params& p, float* __restrict__ ada, int item, unsigned char* lds, int tid) {
    float* cact = (float*)lds;
    float* red = cact + 4096;
    const float* c = p.in[1];
    for (int e = tid; e < 4096; e += NTHREADS) { const float v = c[e]; cact[e] = v * frcp(1.f + fexp2(-LOG2E * v)); }
    __syncthreads();
    const int colg = item * 64;
    const float* W; const float* bias; int N, n0;
    if (colg < 6144) { W = p.in[3]; bias = p.in[4]; N = 6144; n0 = colg; }
    else if (colg < 12288) { W = p.in[3] + (long)1024 * 6144; bias = p.in[4] + 6144; N = 6144; n0 = colg - 6144; }
    else { W = p.in[14]; bias = p.in[15]; N = 2048; n0 = colg - 12288; }
    const int col = tid & 63, kg = tid >> 6;
    float a0 = 0.f, a1 = 0.f, a2 = 0.f, a3 = 0.f;
    const float* wp = W + (long)(kg * 128) * N + n0 + col;
#pragma unroll 8
    for (int k = 0; k < 128; ++k) {
        const float wv = wp[(long)k * N];
        const int kk = kg * 128 + k;
        a0 += cact[kk] * wv; a1 += cact[1024 + kk] * wv; a2 += cact[2048 + kk] * wv; a3 += cact[3072 + kk] * wv;
    }
    red[(kg * 4 + 0) * 64 + col] = a0; red[(kg * 4 + 1) * 64 + col] = a1; red[(kg * 4 + 2) * 64 + col] = a2; red[(kg * 4 + 3) * 64 + col] = a3;
    __syncthreads();
    if (tid < 256) {
        const int b = tid >> 6, cc = tid & 63;
        float s = bias[n0 + cc];
#pragma unroll
        for (int q = 0; q < 8; ++q) s += red[(q * 4 + b) * 64 + cc];
        ada[b * ADA_STRIDE + colg + cc] = s;
    }
    __syncthreads();
}

constexpr int P0_CONV = 8192, P0_TR_DIN = 768, P0_TR_DOUT = 256, P0_TR_KV = 384, P0_TR_NIN = 288, P0_TR_NOUT = 256, P0_TR_C1 = 512, P0_TR_C2 = 16,
              P0_WEFF = 512, P0_POSB = 32, P0_ADA = 224;
constexpr int P0_TOTAL = P0_CONV + P0_TR_DIN + P0_TR_DOUT + P0_TR_KV + P0_TR_NIN + P0_TR_NOUT + P0_TR_C1 + P0_TR_C2 + P0_WEFF + P0_POSB + P0_ADA;

DI void phase_prep(const Params& p, unsigned char* lds, int tid) {
    unsigned char* ws = p.ws;
    for (int it = blockIdx.x; it < P0_TOTAL; it += gridDim.x) {
        int r = it;
        if (r < P0_ADA) { p0_ada_item(p, (float*)(ws + OFF_ADA), r, lds, tid); continue; } r -= P0_ADA;
        if (r < P0_WEFF) { p0_weff_item(p.in[26], p.in[27], (bf16_t*)(ws + OFF_WT_PEER), r, lds, tid); continue; } r -= P0_WEFF;
        if (r < P0_POSB) { p0_posb_item(p.in[17], p.in[18], (float*)(ws + OFF_POSB), r, lds, tid); continue; } r -= P0_POSB;
        if (r < P0_TR_DIN) { p0_transpose_item(p.in[7], 1024, 3072, (bf16_t*)(ws + OFF_WT_DIN), r, 48, lds, tid); continue; } r -= P0_TR_DIN;
        if (r < P0_TR_DOUT) { p0_transpose_item(p.in[8], 1024, 1024, (bf16_t*)(ws + OFF_WT_DOUT), r, 16, lds, tid); continue; } r -= P0_TR_DOUT;
        if (r < P0_TR_KV) { p0_transpose_item(p.in[16], 1024, 1536, (bf16_t*)(ws + OFF_WT_KV), r, 24, lds, tid); continue; } r -= P0_TR_KV;
        if (r < P0_TR_NIN) { p0_transpose_item(p.in[22], 1024, 1048, (bf16_t*)(ws + OFF_WT_NIN), r, 18, lds, tid); continue; } r -= P0_TR_NIN;
        if (r < P0_TR_NOUT) { p0_transpose_item(p.in[24], 1024, 1024, (bf16_t*)(ws + OFF_WT_NOUT), r, 16, lds, tid); continue; } r -= P0_TR_NOUT;
        if (r < P0_TR_C1) { const int kv = r >> 8; p0_transpose_item(p.in[18] + (long)kv * 4096 * 256, 4096, 256, (bf16_t*)(ws + OFF_WT_C1) + (long)kv * 256 * 4096, r & 255, 4, lds, tid); continue; } r -= P0_TR_C1;
        if (r < P0_TR_C2) { const int kv = r >> 3; p0_transpose_item(p.in[20] + (long)kv * 256 * 128, 256, 128, (bf16_t*)(ws + OFF_WT_C2) + (long)kv * 128 * 256, r & 7, 2, lds, tid); continue; } r -= P0_TR_C2;
        {
            const int tbl = r >> 11, sub = r & 2047;
            const int layer = tbl & 1;
            const float* src = (tbl < 2 ? p.in[28] : p.in[29]) + (long)layer * 16384 * 1024;
            unsigned char* dst = ws + (tbl < 2 ? OFF_PU : OFF_PV) + (long)layer * 16384 * 1024;
            float* sinv = (float*)(ws + (tbl < 2 ? OFF_USI : OFF_VSI)) + layer * 16384;
            p0_fp8_item(src, dst, sinv, tbl >= 2, sub, tid);
        }
    }
}

DI void norm_row_write(const f32x4 (&v)[4], float rstd, const float* gain, const float* shift, const float* scale, bf16_t* orow, int lane) {
#pragma unroll
    for (int j = 0; j < 4; ++j) {
        const int c = 4 * lane + 256 * j;
        const f32x4 g = *(const f32x4*)(gain + c), sh = *(const f32x4*)(shift + c), sc = *(const f32x4*)(scale + c);
        u32x2 o;
        o.x = pk2(v[j].x * rstd * g.x * (1.f + sc.x) + sh.x, v[j].y * rstd * g.y * (1.f + sc.y) + sh.y);
        o.y = pk2(v[j].z * rstd * g.z * (1.f + sc.z) + sh.z, v[j].w * rstd * g.w * (1.f + sc.w) + sh.w);
        *(u32x2*)(orow + c) = o;
    }
}
DI void phase_norm(const float* __restrict__ x, bf16_t* __restrict__ out, const float* gain, const float* ada, int shift_off, int scale_off, int tid) {
    const int lane = tid & 63, gw = blockIdx.x * NWAVES + (tid >> 6), nw = gridDim.x * NWAVES;
    for (int tok = gw; tok < NTOK; tok += nw) {
        const int b = tok >> 13;
        f32x4 v[4]; float ss = 0.f;
#pragma unroll
        for (int j = 0; j < 4; ++j) { v[j] = *(const f32x4*)(x + (long)tok * DM + 4 * lane + 256 * j); ss += v[j].x * v[j].x + v[j].y * v[j].y + v[j].z * v[j].z + v[j].w * v[j].w; }
        const float rstd = rsqrtf(wave_sum(ss) * (1.f / DM) + EPS);
        norm_row_write(v, rstd, gain, ada + b * ADA_STRIDE + shift_off, ada + b * ADA_STRIDE + scale_off, out + (long)tok * DM, lane);
    }
}

DI int kidx(int mt, int i) { return 32 * mt + 16 * (i >> 3) + (i & 7); }
template <int DQK>
DI void attn_qk32(const unsigned char* Ks, const bf16x8 (&qf)[DQK / 16], f32x16& st, int mt, int r, int h, float init = 0.f) {
    constexpr int RB = DQK * 2, MSK = DQK == 64 ? 7 : 15;
    const int row = 32 * mt + ((r & 0x13) | ((r & 4) << 1) | ((r & 8) >> 1));
#pragma unroll
    for (int i = 0; i < 16; ++i) st[i] = init;
#pragma unroll
    for (int ks = 0; ks < DQK / 16; ++ks) {
        const bf16x8 kf = RB == 128 ? *(const bf16x8*)(Ks + sw2(row, 2 * ks + h)) : *(const bf16x8*)(Ks + row * RB + (((2 * ks + h) ^ (row & MSK)) << 4));
        st = MFMA32(kf, qf[ks], st);
    }
}
DI void attn_pack32(const f32x16& st, bf16x8 (&pf)[2]) {
#pragma unroll
    for (int s = 0; s < 2; ++s) {
        u32x4 t;
        t.x = pk2(st[8 * s + 0], st[8 * s + 1]); t.y = pk2(st[8 * s + 2], st[8 * s + 3]);
        t.z = pk2(st[8 * s + 4], st[8 * s + 5]); t.w = pk2(st[8 * s + 6], st[8 * s + 7]);
        pf[s] = __builtin_bit_cast(bf16x8, t);
    }
}
DI void attn_softmax32(f32x16& st, float& m, float& l, f32x16 (&o)[4]) {
    float mx = st[0];
#pragma unroll
    for (int i = 1; i < 16; ++i) mx = fmaxf(mx, st[i]);
    mx = max_x32(mx);
    const float mn = fmaxf(m, mx);
    if (!__all(mn == m)) {
        const float alpha = fexp2(m - mn);
        l *= alpha;
#pragma unroll
        for (int dt = 0; dt < 4; ++dt)
#pragma unroll
            for (int i = 0; i < 16; ++i) o[dt][i] *= alpha;
        m = mn;
    }
    float sum = 0.f;
#pragma unroll
    for (int i = 0; i < 16; ++i) { const float pv = fexp2(st[i] - m); st[i] = pv; sum += pv; }
    l += sum;
}
DI void attn_softmax32_b(f32x16& st, float& l) {
    float sum = 0.f;
#pragma unroll
    for (int i = 0; i < 16; ++i) { const float pv = fexp2(st[i]); st[i] = pv; sum += pv; }
    l += sum;
}
DI void attn_pv32(const unsigned char* Vs, const bf16x8 (&pf)[2], f32x16 (&o)[4], int mt, int r, int h) {
#pragma unroll
    for (int dt = 0; dt < 4; ++dt)
#pragma unroll
        for (int s2 = 0; s2 < 2; ++s2) {
            const int row = 32 * dt + r;
            const bf16x8 vf = *(const bf16x8*)(Vs + sw2(row, 2 * (2 * mt + s2) + h));
            o[dt] = MFMA32(vf, pf[s2], o[dt]);
        }
}
template <int RB, int NROWS>
DI void dma_offsets(unsigned (&off)[NROWS * RB / 16 / 512], unsigned gstride, int tid) {
    constexpr int CPR = RB / 16;
#pragma unroll
    for (int i = 0; i < NROWS * CPR / 512; ++i) {
        const int idx = tid + 512 * i;
        int row, cp;
        if (RB == 128) sw2_src(idx, row, cp); else { row = idx / CPR; cp = (idx % CPR) ^ (row & (CPR - 1)); }
        off[i] = (unsigned)row * gstride + (cp << 4);
    }
}
template <int N>
DI void dma_issue(unsigned char* dst, const unsigned char* gbase, const unsigned (&off)[N], int tid) {
    const int wbase = tid & ~63;
#pragma unroll
    for (int i = 0; i < N; ++i)
        __builtin_amdgcn_global_load_lds((const unsigned*)(gbase + off[i]), (unsigned*)(dst + (wbase + 512 * i) * 16), 16, 0, 0);
}

constexpr int AT_STAGE = 32 * 1024;
constexpr int AT_LUT = 2 * AT_STAGE;
constexpr int LUT_N = 1280, LUT_OFF = 1100;
constexpr int LUTC_W = 52;
constexpr int AT_LUTC = AT_LUT + 20 * 1024;
constexpr int AT_IMP = AT_LUTC + 13 * 1024;
constexpr int AT_SEL = AT_IMP + 34 * 1024;

DI void phase_diff_attn(const Params& p, unsigned char* lds, int tid) {
    unsigned char* ws = p.ws;
    const bf16_t* Q = (const bf16_t*)(ws + OFF_Q0);
    const bf16_t* Kk = (const bf16_t*)(ws + OFF_K0);
    const bf16_t* VT = (const bf16_t*)(ws + OFF_VT0);
    bf16_t* O = (bf16_t*)(ws + OFF_H);
    const float* relb = p.in[2];
    const float* lam = p.in[9];
    const float* subln = p.in[12];
    const int lane = tid & 63, w = tid >> 6, comp = w & 1, qg = w >> 1, r = lane & 31, h = lane >> 5;
    float* lut = (float*)(lds + 128 * 1024);
    float lam_full;
    {
        float s01 = 0.f, s23 = 0.f;
        for (int i = 0; i < 64; ++i) { s01 += lam[i] * lam[64 + i]; s23 += lam[128 + i] * lam[192 + i]; }
        lam_full = __expf(s01) - __expf(s23) + 0.2f;
    }
    const int G = gridDim.x, rows_per_it = G >> 5;
    unsigned koff[1], voff[2];
    dma_offsets<128, 64>(koff, 128, tid);
    dma_offsets<128, 128>(voff, SEQ * 2, tid);
    constexpr int ST2 = 64 * 1024;
    for (int it = 0;; ++it) {
        int qb, b, hd;
        if (G == 256) {
            if (it >= 8) break;
            const int xcd = blockIdx.x & 7, lb = blockIdx.x >> 3, pr = xcd * 4 + (it >> 1);
            qb = (it & 1) ? lb : 63 - lb; b = pr >> 3; hd = pr & 7;
        } else {
            int u;
            if ((G & 31) == 0) {
                const int rr = blockIdx.x >> 5, cc = blockIdx.x & 31;
                const int rowi = it * rows_per_it + ((it & 1) ? rows_per_it - 1 - rr : rr);
                u = rowi * 32 + cc;
            } else u = it * G + blockIdx.x;
            if (u >= 2048) break;
            qb = 63 - (u >> 5); b = (u & 31) >> 3; hd = u & 7;
        }
        const int q0 = qb * 128, ntiles = qb + 1;
        const int qpos = q0 + 32 * qg + r, qlo = q0 + 32 * qg, qhi = qlo + 31;
        for (int e = tid; e < LUT_N; e += NTHREADS) { const int d = LUT_OFF - e; lut[e] = d < 0 ? -INFINITY : (d >= 790 ? 0.f : (relb[rel_bucket_i(d) * 8 + hd] - relb[31 * 8 + hd]) * LOG2E); }
        bf16x8 qf[4];
        {
            const bf16_t* qrow = Q + ((long)((b * 8 + hd) * 2 + comp) * SEQ + qpos) * 64;
#pragma unroll
            for (int ks = 0; ks < 4; ++ks) qf[ks] = *(const bf16x8*)(qrow + 16 * ks + 8 * h);
        }
        const unsigned char* k0g = (const unsigned char*)(Kk + (long)((b * 8 + hd) * 2 + 0) * SEQ * 64);
        const unsigned char* k1g = (const unsigned char*)(Kk + (long)((b * 8 + hd) * 2 + 1) * SEQ * 64);
        const unsigned char* vtg = (const unsigned char*)(VT + (long)(b * 8 + hd) * 128 * SEQ);
        f32x16 o[4];
#pragma unroll
        for (int dt = 0; dt < 4; ++dt)
#pragma unroll
            for (int i = 0; i < 16; ++i) o[dt][i] = 0.f;
        float l = 0.f;
        const float nmb = -((const float*)(ws + OFF_MB0))[(long)((b * 8 + hd) * 2 + comp) * SEQ + qpos];
        auto stage = [&](int kt, unsigned char* st) {
#pragma unroll
            for (int sb = 0; sb < 2; ++sb) {
                dma_issue(st + sb * 8192, k0g + (long)(2 * kt + sb) * 8192, koff, tid);
                dma_issue(st + 16384 + sb * 8192, k1g + (long)(2 * kt + sb) * 8192, koff, tid);
                dma_issue(st + 32768 + sb * 16384, vtg + (long)(2 * kt + sb) * 128, voff, tid);
            }
        };
        stage(0, lds);
        __syncthreads();
        for (int kt = 0; kt < ntiles; ++kt) {
            unsigned char* cur = lds + (kt & 1) * ST2;
            if (kt + 1 < ntiles) stage(kt + 1, lds + ((kt + 1) & 1) * ST2);
            const bool nearb = qlo - (kt * 128 + 127) < 790;
            const int dbase0 = qpos - kt * 128 - 8 * h;
            const unsigned char* kb = cur + comp * 16384;
            f32x16 sa, sbv;
            attn_qk32<64>(kb, qf, sa, 0, r, h, nmb);
#pragma unroll
            for (int j = 0; j < 4; ++j) {
                f32x16& sc = (j & 1) ? sbv : sa;
                f32x16& sn = (j & 1) ? sa : sbv;
                if (j < 3) attn_qk32<64>(kb + ((j + 1) >> 1) * 8192, qf, sn, (j + 1) & 1, r, h, nmb);
                if (nearb) {
                    const float* lp = lut + (LUT_OFF - dbase0 + 64 * (j >> 1));
#pragma unroll
                    for (int i = 0; i < 16; ++i) sc[i] += lp[kidx(j & 1, i)];
                }
                attn_softmax32_b(sc, l);
                bf16x8 pf[2];
                attn_pack32(sc, pf);
                attn_pv32(cur + 32768 + (j >> 1) * 16384, pf, o, j & 1, r, h);
            }
            __syncthreads();
        }
        l = sum_x32(l);
        const float inv = l > 0.f ? frcp(l) : 0.f;
        float* xch = (float*)lds + qg * 4096;
        if (comp == 1) {
            const float sc = inv * lam_full;
#pragma unroll
            for (int dt = 0; dt < 4; ++dt)
#pragma unroll
                for (int i = 0; i < 16; ++i) xch[(dt * 16 + i) * 64 + lane] = o[dt][i] * sc;
        }
        __syncthreads();
        if (comp == 0) {
            float ss = 0.f;
#pragma unroll
            for (int dt = 0; dt < 4; ++dt)
#pragma unroll
                for (int i = 0; i < 16; ++i) { const float v = o[dt][i] * inv - xch[(dt * 16 + i) * 64 + lane]; o[dt][i] = v; ss += v * v; }
            ss = sum_x32(ss);
            const float rstd = rsqrtf(ss * (1.f / 128.f) + EPS) * 0.8f;
            bf16_t* orow = O + (long)(b * SEQ + qpos) * DM + hd * 128;
#pragma unroll
            for (int dt = 0; dt < 4; ++dt)
#pragma unroll
                for (int g4 = 0; g4 < 4; ++g4) {
                    const int d0 = 32 * dt + 8 * g4 + 4 * h;
                    const f32x4 gv = *(const f32x4*)(subln + d0);
                    u32x2 ov;
                    ov.x = pk2(o[dt][4 * g4 + 0] * rstd * gv.x, o[dt][4 * g4 + 1] * rstd * gv.y);
                    ov.y = pk2(o[dt][4 * g4 + 2] * rstd * gv.z, o[dt][4 * g4 + 3] * rstd * gv.w);
                    *(u32x2*)(orow + d0) = ov;
                }
        }
        __syncthreads();
    }
}

template <int VAR>
DI void phase_nsa_attn(const Params& p, unsigned char* lds, int tid) {
    unsigned char* ws = p.ws;
    const bf16_t* QN = (const bf16_t*)(ws + OFF_QN);
    const bf16_t* KS = (const bf16_t*)(ws + OFF_KS);
    const bf16_t* VST = (const bf16_t*)(ws + OFF_VST);
    const bf16_t* KW = (const bf16_t*)(ws + OFF_KW);
    const bf16_t* VWT = (const bf16_t*)(ws + OFF_VWT);
    const bf16_t* KCMP = (const bf16_t*)(ws + OFF_KCMP);
    const bf16_t* VCMPT = (const bf16_t*)(ws + OFF_VCMPT);
    const float* gates = (const float*)(ws + OFF_GATES);
    bf16_t* O = VAR ? (bf16_t*)(ws + OFF_PU + 32 * MB) : (bf16_t*)(ws + OFF_H);
    const float* relb = p.in[2];
    const int lane = tid & 63, w = tid >> 6, hg = w >> 1, th = w & 1, r = lane & 31, h = lane >> 5;
    float* lut = (float*)(lds + AT_LUT);
    float* lutc = (float*)(lds + AT_LUTC);
    float* imp = (float*)(lds + AT_IMP);
    unsigned* selw = (unsigned*)(lds + AT_SEL);
    unsigned short* sel16 = (unsigned short*)selw;
    float* bmxs = (float*)(selw + 264);
    const float* qnrm = (const float*)(ws + OFF_MB1);
    float kmx[3];
    for (int br = 0; br < 3; ++br) { float mx = 0.f; for (int d = 0; d < 128; ++d) mx = fmaxf(mx, fabsf(p.in[21][br * 128 + d])); kmx[br] = mx * 11.313708498984761f; }
    const int G = gridDim.x, rows_per_it = G >> 3;
    int lut_g = -1;
    for (int it = 0;; ++it) {
        int u;
        if ((G & 7) == 0) {
            const int rr = blockIdx.x >> 3, cc = blockIdx.x & 7;
            const int rowi = it * rows_per_it + ((it & 1) ? rows_per_it - 1 - rr : rr);
            u = rowi * 8 + cc;
        } else u = it * G + blockIdx.x;
        if (u >= 1024) break;
        const int bi = 127 - (u >> 3), b = (u & 7) >> 1, g = u & 1, head = 4 * g + hg;
        const int tq = 64 * bi + 32 * th + r;
        const int tl = 32 * th + r;
        const long tok = (long)b * SEQ + tq;
        if (g != lut_g) {
            lut_g = g;
            if (tid < 4) { float bm = 0.f; for (int bk = 0; bk < 32; ++bk) bm = fmaxf(bm, relb[bk * 8 + 4 * g + tid] - relb[31 * 8 + 4 * g + tid]); bmxs[tid] = bm * LOG2E; }
            for (int e = tid; e < 4 * LUT_N; e += NTHREADS) { const int hh = e / LUT_N, d = LUT_OFF - (e % LUT_N); lut[e] = d < 0 ? -INFINITY : (d >= 790 ? 0.f : (relb[rel_bucket_i(d) * 8 + 4 * g + hh] - relb[31 * 8 + 4 * g + hh]) * LOG2E); }
            for (int e = tid; e < 4 * 16 * LUTC_W; e += NTHREADS) {
                const int hh = e / (16 * LUTC_W), ph = (e / LUTC_W) & 15, ci = e % LUTC_W, d = 16 * (ci - 1) + ph;
                lutc[e] = ci == 0 ? -INFINITY : (d >= 790 ? 0.f : (relb[rel_bucket_i(d) * 8 + 4 * g + hh] - relb[31 * 8 + 4 * g + hh]) * LOG2E);
            }
        }
        if (tid < 4) selw[256 + tid] = 0u;
        const float* mylut = lut + hg * LUT_N;
        bf16x8 qf[8];
        const bf16_t* qrow = QN + ((long)(b * 8 + head) * SEQ + tq) * 128 + 8 * h;
        auto load_q = [&](const bf16_t* qr) {
#pragma unroll
            for (int ks = 0; ks < 8; ++ks) qf[ks] = *(const bf16x8*)(qr + 16 * ks);
        };
        const float* gp = gates + tok * 24 + head * 3;
        bf16_t* orow = O + (VAR ? (tok & 16383) : tok) * DM + head * 128;
        auto stage = [&](const unsigned char* kg, const unsigned char* vg, unsigned vstride, int kt, unsigned char* st) {
            int t2 = tid; asm volatile("" : "+v"(t2));
            unsigned koff[2], vo[2];
            dma_offsets<256, 64>(koff, 256, t2);
            dma_offsets<128, 128>(vo, vstride, t2);
            dma_issue(st, kg + (long)kt * 16384, koff, t2);
            dma_issue(st + 16384, vg + (long)kt * 128, vo, t2);
        };
        f32x16 o[4];
        float l;
        auto reset = [&]() {
#pragma unroll
            for (int dt = 0; dt < 4; ++dt)
#pragma unroll
                for (int i = 0; i < 16; ++i) o[dt][i] = 0.f;
            l = 0.f;
        };
        const unsigned char* kcg = (const unsigned char*)(KCMP + (long)(b * 2 + g) * 512 * 128);
        const unsigned char* vcg = (const unsigned char*)(VCMPT + (long)(b * 2 + g) * 128 * 512);
        const int nct = ((4 * bi + 2) >> 6) + 1;
        const int hgc = r & 3, tlc = 8 * w + (r >> 2), tqc = 64 * bi + tlc;
        const long tokc = (long)b * SEQ + tqc;
        reset();
        load_q(QN + ((long)(b * 8 + 4 * g + hgc) * SEQ + tqc) * 128 + 8 * h);
        __syncthreads();
        if (VAR != 3) {
            const int cb = (tqc - 31) >> 4;
            const float* lc = lutc + (hgc * 16 + ((tqc - 31) & 15)) * LUTC_W + 1;
            const float nmb = -(qnrm[tokc * 8 + 4 * g + hgc] * kmx[0] + bmxs[hgc]);
            stage(kcg, vcg, 1024u, 0, lds);
            __syncthreads();
            for (int kt = 0; kt < nct; ++kt) {
                unsigned char* cur = lds + (kt & 1) * AT_STAGE;
                if (kt + 1 < nct) stage(kcg, vcg, 1024u, kt + 1, lds + ((kt + 1) & 1) * AT_STAGE);
                const int cbase = cb - kt * 64 - 8 * h;
#pragma unroll
                for (int mt = 0; mt < 2; ++mt) {
                    f32x16 st;
                    attn_qk32<128>(cur, qf, st, mt, r, h, nmb);
                    float sum = 0.f;
#pragma unroll
                    for (int i = 0; i < 16; ++i) {
                        const int c = cbase - kidx(mt, i);
                        sum += fexp2(st[i] + lc[c < -1 ? -1 : (c > 50 ? 50 : c)]);
                    }
                    l += sum;
                }
                __syncthreads();
            }
            const float lt = sum_x32(l);
            const float invl = lt > 0.f ? frcp(lt) : 0.f;
            stage(kcg, vcg, 1024u, 0, lds);
            __syncthreads();
            float carry = 0.f;
            for (int kt = 0; kt < nct; ++kt) {
                unsigned char* cur = lds + (kt & 1) * AT_STAGE;
                if (kt + 1 < nct) stage(kcg, vcg, 1024u, kt + 1, lds + ((kt + 1) & 1) * AT_STAGE);
                const int cbase = cb - kt * 64 - 8 * h;
                float o0[4], o1[4], sp[4];
#pragma unroll
                for (int mt = 0; mt < 2; ++mt) {
                    f32x16 st;
                    attn_qk32<128>(cur, qf, st, mt, r, h, nmb);
#pragma unroll
                    for (int i = 0; i < 16; ++i) {
                        const int c = cbase - kidx(mt, i);
                        st[i] = fexp2(st[i] + lc[c < -1 ? -1 : (c > 50 ? 50 : c)]) * invl;
                    }
#pragma unroll
                    for (int gq = 0; gq < 2; ++gq) {
                        const int G2 = 2 * mt + gq, q0 = 2 * gq, q1 = 2 * gq + 1;
                        const float c20 = 0.5f * st[4 * q0 + 3];
                        o0[G2] = st[4 * q0] + st[4 * q0 + 1] + st[4 * q0 + 2] + c20;
                        o1[G2] = st[4 * q1] + st[4 * q1 + 1] + st[4 * q1 + 2] + 0.5f * st[4 * q1 + 3] + c20;
                        sp[G2] = 0.5f * st[4 * q1 + 3];
                    }
                    bf16x8 pf[2];
                    attn_pack32(st, pf);
                    attn_pv32(cur + 16384, pf, o, mt, r, h);
                }
                float rc[4];
#pragma unroll
                for (int G2 = 0; G2 < 4; ++G2) rc[G2] = __uint_as_float(get_x32(__float_as_uint(sp[G2]), h));
                if (h) {
#pragma unroll
                    for (int G2 = 0; G2 < 4; ++G2) o0[G2] += rc[G2];
                } else {
                    o0[0] += carry; o0[1] += rc[0]; o0[2] += rc[1]; o0[3] += rc[2];
                    carry = rc[3];
                }
#pragma unroll
                for (int G2 = 0; G2 < 4; ++G2) {
                    float a0 = o0[G2], a1 = o1[G2];
                    a0 += lx1(a0); a0 += lx2(a0); a1 += lx1(a1); a1 += lx2(a1);
                    if (hgc == 0) *(f32x2*)(imp + tlc * 130 + kt * 16 + 4 * G2 + 2 * h) = (f32x2){a0, a1};
                }
                __syncthreads();
            }
        }
        {
            const float g_c = gates[tokc * 24 + (4 * g + hgc) * 3];
            bf16_t* orc = O + (VAR ? (tokc & 16383) : tokc) * DM + (4 * g + hgc) * 128;
#pragma unroll
            for (int dt = 0; dt < 4; ++dt)
#pragma unroll
                for (int g4 = 0; g4 < 4; ++g4) {
                    const int d0 = 32 * dt + 8 * g4 + 4 * h;
                    u32x2 ov;
                    ov.x = pk2(o[dt][4 * g4 + 0] * g_c, o[dt][4 * g4 + 1] * g_c);
                    ov.y = pk2(o[dt][4 * g4 + 2] * g_c, o[dt][4 * g4 + 3] * g_c);
                    *(u32x2*)(orc + d0) = ov;
                }
        }
        if (VAR != 5) {
            const int tkn = tid >> 3, part = tid & 7;
            unsigned key[16];
#pragma unroll
            for (int q = 0; q < 16; ++q) {
                const int j = part * 16 + q;
                float v = imp[tkn * 130 + j];
                const int back = bi - j;
                if (j == 0 || (back >= 0 && back < 2)) v = 1e9f;
                if (back < 0) v = -1e30f;
                key[q] = f2key(v);
            }
            auto sum8 = [&](int c) -> int {
                c += __builtin_amdgcn_update_dpp(0, c, 0xB1, 0xF, 0xF, true);
                c += __builtin_amdgcn_update_dpp(0, c, 0x4E, 0xF, 0xF, true);
                c += __builtin_amdgcn_update_dpp(0, c, 0x141, 0xF, 0xF, true);
                return c;
            };
            unsigned T = 0u;
#pragma unroll 4
            for (int bit = 31; bit >= 0; --bit) {
                const unsigned cand = T | (1u << bit);
                int c = 0;
#pragma unroll
                for (int q = 0; q < 16; ++q) c += key[q] >= cand ? 1 : 0;
                if (sum8(c) >= 16) T = cand;
            }
            int cg = 0, ce = 0;
#pragma unroll
            for (int q = 0; q < 16; ++q) { cg += key[q] > T ? 1 : 0; ce += key[q] == T ? 1 : 0; }
            const int need = 16 - sum8(cg);
            int pre = ce;
            { int t = __builtin_amdgcn_update_dpp(0, pre, 0x111, 0xF, 0xF, true); if (part >= 1) pre += t; }
            { int t = __builtin_amdgcn_update_dpp(0, pre, 0x112, 0xF, 0xF, true); if (part >= 2) pre += t; }
            { int t = __builtin_amdgcn_update_dpp(0, pre, 0x114, 0xF, 0xF, true); if (part >= 4) pre += t; }
            int before = pre - ce;
            unsigned bits = 0;
#pragma unroll
            for (int q = 0; q < 16; ++q) {
                const bool eq = key[q] == T;
                const bool selq = key[q] > T || (eq && before < need);
                before += eq ? 1 : 0;
                bits |= (selq && key[q] >= 0x80000000u) ? (1u << q) : 0u;
            }
            sel16[tkn * 8 + part] = (unsigned short)bits;
            atomicOr(&selw[256 + (part >> 1)], bits << ((part & 1) * 16));
        }
        __syncthreads();
        const unsigned un0 = selw[256], un1 = selw[257], un2 = selw[258], un3 = selw[259];
        const unsigned char* ksg = (const unsigned char*)(KS + (long)(b * 2 + g) * SEQ * 128);
        const unsigned char* vsg = (const unsigned char*)(VST + (long)(b * 2 + g) * 128 * SEQ);
        reset(); load_q(qrow);
        const float qn_main = qnrm[tok * 8 + head];
        {
            const float nmb = -(qn_main * kmx[1] + bmxs[hg]);
            const unsigned long long ulo = ((unsigned long long)(unsigned)__builtin_amdgcn_readfirstlane((int)un1) << 32) | (unsigned)__builtin_amdgcn_readfirstlane((int)un0);
            const unsigned long long uhi = ((unsigned long long)(unsigned)__builtin_amdgcn_readfirstlane((int)un3) << 32) | (unsigned)__builtin_amdgcn_readfirstlane((int)un2);
            auto next_tile = [&](int from) -> int {
                if (from < 64) { const unsigned long long mk = ulo >> from; if (mk) return from + __builtin_ctzll(mk); from = 64; }
                if (from < 128) { const unsigned long long mk = uhi >> (from - 64); if (mk) return from + __builtin_ctzll(mk); }
                return 128;
            };
            int jt = (VAR == 1 || VAR == 4 || VAR == 5) ? 128 : next_tile(0);
            int buf = 0;
            if (jt < 128) stage(ksg, vsg, SEQ * 2u, jt, lds);
            __syncthreads();
            while (jt < 128) {
                unsigned char* cur = lds + buf * AT_STAGE;
                const int jn = next_tile(jt + 1);
                if (jn < 128) stage(ksg, vsg, SEQ * 2u, jn, lds + (buf ^ 1) * AT_STAGE);
                const unsigned wd = selw[tl * 4 + (jt >> 5)];
                const bool mysel = (wd >> (jt & 31)) & 1u;
                if (__any(mysel)) {
                    const int k0 = jt * 64;
                    const bool nearb = (64 * bi + 32 * th) - (k0 + 63) < 790;
                    const int dbase = tq - k0 - 8 * h;
                    const float* lp = mylut + (LUT_OFF - dbase);
#pragma unroll
                    for (int mt = 0; mt < 2; ++mt) {
                        f32x16 st;
                        attn_qk32<128>(cur, qf, st, mt, r, h, mysel ? nmb : -INFINITY);
                        if (nearb) {
#pragma unroll
                            for (int i = 0; i < 16; ++i) st[i] += lp[kidx(mt, i)];
                        }
                        attn_softmax32_b(st, l);
                        bf16x8 pf[2];
                        attn_pack32(st, pf);
                        attn_pv32(cur + 16384, pf, o, mt, r, h);
                    }
                }
                __syncthreads();
                buf ^= 1; jt = jn;
            }
        }
        {
            const float lt = sum_x32(l);
            const float sc = (lt > 0.f ? frcp(lt) : 0.f) * gp[1];
#pragma unroll
            for (int dt = 0; dt < 4; ++dt)
#pragma unroll
                for (int g4 = 0; g4 < 4; ++g4) {
                    const int d0 = 32 * dt + 8 * g4 + 4 * h;
                    const u32x2 pv = *(const u32x2*)(orow + d0);
                    u32x2 ov;
                    ov.x = pk2(bflo(pv.x) + o[dt][4 * g4 + 0] * sc, bfhi(pv.x) + o[dt][4 * g4 + 1] * sc);
                    ov.y = pk2(bflo(pv.y) + o[dt][4 * g4 + 2] * sc, bfhi(pv.y) + o[dt][4 * g4 + 3] * sc);
                    *(u32x2*)(orow + d0) = ov;
                }
        }
        const unsigned char* kwg = (const unsigned char*)(KW + (long)(b * 2 + g) * SEQ * 128);
        const unsigned char* vwg = (const unsigned char*)(VWT + (long)(b * 2 + g) * 128 * SEQ);
        reset(); load_q(qrow);
        {
            const float nmb = -(qn_main * kmx[2] + bmxs[hg]);
            const int j0 = bi >= 8 ? bi - 8 : 0, nt = (VAR == 2 || VAR == 4 || VAR == 5) ? 1 : bi - j0 + 1;
            stage(kwg, vwg, SEQ * 2u, j0, lds);
            __syncthreads();
            for (int kt = 0; kt < nt; ++kt) {
                unsigned char* cur = lds + (kt & 1) * AT_STAGE;
                if (kt + 1 < nt) stage(kwg, vwg, SEQ * 2u, j0 + kt + 1, lds + ((kt + 1) & 1) * AT_STAGE);
                const int k0 = (j0 + kt) * 64;
                const int dbase = tq - k0 - 8 * h;
                const float* lp = mylut + (LUT_OFF - dbase);
#pragma unroll
                for (int mt = 0; mt < 2; ++mt) {
                    f32x16 st;
                    attn_qk32<128>(cur, qf, st, mt, r, h, nmb);
#pragma unroll
                    for (int i = 0; i < 16; ++i) st[i] = kidx(mt, i) <= dbase - 512 ? -INFINITY : st[i] + lp[kidx(mt, i)];
                    attn_softmax32_b(st, l);
                    bf16x8 pf[2];
                    attn_pack32(st, pf);
                    attn_pv32(cur + 16384, pf, o, mt, r, h);
                }
                __syncthreads();
            }
        }
        {
            const float lt = sum_x32(l);
            const float sc = (lt > 0.f ? frcp(lt) : 0.f) * gp[2];
#pragma unroll
            for (int dt = 0; dt < 4; ++dt)
#pragma unroll
                for (int g4 = 0; g4 < 4; ++g4) {
                    const int d0 = 32 * dt + 8 * g4 + 4 * h;
                    const u32x2 pv = *(const u32x2*)(orow + d0);
                    u32x2 ov;
                    ov.x = pk2(bflo(pv.x) + o[dt][4 * g4 + 0] * sc, bfhi(pv.x) + o[dt][4 * g4 + 1] * sc);
                    ov.y = pk2(bflo(pv.y) + o[dt][4 * g4 + 2] * sc, bfhi(pv.y) + o[dt][4 * g4 + 3] * sc);
                    *(u32x2*)(orow + d0) = ov;
                }
        }
        __syncthreads();
    }
}

DI void fp8x16_fma(const u32x4& q, const f32x4& h0, const f32x4& h1, const f32x4& h2, const f32x4& h3, f32x2& a0, f32x2& a1) {
    a0 += __builtin_amdgcn_cvt_pk_f32_fp8((int)q.x, false) * (f32x2){h0.x, h0.y};
    a1 += __builtin_amdgcn_cvt_pk_f32_fp8((int)q.x, true)  * (f32x2){h0.z, h0.w};
    a0 += __builtin_amdgcn_cvt_pk_f32_fp8((int)q.y, false) * (f32x2){h1.x, h1.y};
    a1 += __builtin_amdgcn_cvt_pk_f32_fp8((int)q.y, true)  * (f32x2){h1.z, h1.w};
    a0 += __builtin_amdgcn_cvt_pk_f32_fp8((int)q.z, false) * (f32x2){h2.x, h2.y};
    a1 += __builtin_amdgcn_cvt_pk_f32_fp8((int)q.z, true)  * (f32x2){h2.z, h2.w};
    a0 += __builtin_amdgcn_cvt_pk_f32_fp8((int)q.w, false) * (f32x2){h3.x, h3.y};
    a1 += __builtin_amdgcn_cvt_pk_f32_fp8((int)q.w, true)  * (f32x2){h3.z, h3.w};
}
template <bool DRY>
DI void phase_peer_u(const Params& p, int layer, unsigned char* lds, int tid) {
    unsigned char* ws = p.ws;
    const bf16_t* H = (const bf16_t*)(ws + OFF_H);
    const int* ridx = (const int*)(ws + OFF_RIDX);
    float* rgate = (float*)(ws + OFF_RGATE);
    const unsigned char* U = ws + OFF_PU + (long)layer * 16384 * 1024;
    const float* usi = (const float*)(ws + OFF_USI) + layer * 16384;
    const float* vsi = (const float*)(ws + OFF_VSI) + layer * 16384;
    const int lane = tid & 63, w = tid >> 6, sub = lane & 3, grp = lane >> 2;
    const int xg = blockIdx.x & 7, lb = blockIdx.x >> 3, nwv = (gridDim.x >> 3) * NWAVES, wv = lb * NWAVES + w;
    unsigned* clb = (unsigned*)(lds + w * 12288);
    float* hbb = (float*)(lds + w * 12288 + 2048);
    const unsigned long long lt = (1ull << lane) - 1ull;
    if (lb >= (int)(gridDim.x >> 3)) return;
    int i0, i1; u32x4 h0, h1;
    auto ld_tok = [&](int tk) {
        tk = tk < NTOK ? tk : wv;
        i0 = ridx[(long)tk * 128 + lane]; i1 = ridx[(long)tk * 128 + 64 + lane];
        h0 = *(const u32x4*)(H + (long)tk * DM + lane * 16); h1 = *(const u32x4*)(H + (long)tk * DM + lane * 16 + 8);
    };
    auto stage_tok = [&](int bi) -> int {
        unsigned* cl = clb + bi * 256; float* hb = hbb + bi * 1024;
        const bool b0 = (i0 >> 11) == xg, b1 = (i1 >> 11) == xg;
        const unsigned long long m0 = __ballot(b0), m1 = __ballot(b1);
        const int n0 = __popcll(m0), n = n0 + __popcll(m1);
        if (b0) { const int k = __popcll(m0 & lt); cl[2 * k] = lane; cl[2 * k + 1] = i0; }
        if (b1) { const int k = n0 + __popcll(m1 & lt); cl[2 * k] = 64 + lane; cl[2 * k + 1] = i1; }
        if (n == 0 && lane == 0) { cl[0] = 0u; cl[1] = 0u; }
        f32x4* hp = (f32x4*)(hb + lane * 16);
        hp[0] = (f32x4){bflo(h0.x), bfhi(h0.x), bflo(h0.y), bfhi(h0.y)}; hp[1] = (f32x4){bflo(h0.z), bfhi(h0.z), bflo(h0.w), bfhi(h0.w)};
        hp[2] = (f32x4){bflo(h1.x), bfhi(h1.x), bflo(h1.y), bfhi(h1.y)}; hp[3] = (f32x4){bflo(h1.z), bfhi(h1.z), bflo(h1.w), bfhi(h1.w)};
        return n;
    };
    ld_tok(wv);
    int nC = stage_tok(0);
    ld_tok(wv + nwv);
    int slotC, idC; bool validC;
    { validC = grp < nC; const int kk = validC ? grp : 0; slotC = clb[2 * kk]; idC = clb[2 * kk + 1]; }
    u32x4 uv[16];
    {
        const unsigned uoff = (unsigned)idC * 1024u + (unsigned)sub * 16u;
#pragma unroll
        for (int t = 0; t < 16; ++t) uv[t] = *(const u32x4*)(U + (uoff + t * 64));
    }
    int it = 0;
    for (int tok = wv; tok < NTOK; tok += nwv, ++it) {
        const int cb = it & 1;
        const unsigned* clC = clb + cb * 256; const unsigned* clN = clb + (cb ^ 1) * 256;
        const float* hbC = hbb + cb * 1024;
        const bool more = tok + nwv < NTOK;
        int nN = 0;
        if (more) { nN = stage_tok(cb ^ 1); ld_tok(tok + 2 * nwv); }
        const int nr = nC > 16 ? (nC + 15) >> 4 : 1;
        for (int rd = 0; rd < nr; ++rd) {
            float g_in = 0.f, su = 0.f, sv = 0.f;
            if (validC && sub == 0) { g_in = rgate[(long)tok * 128 + slotC]; su = usi[idC]; sv = vsi[idC]; }
            int slotN, idN; bool validN;
            if (rd + 1 < nr) { const int k = 16 * (rd + 1) + grp; validN = k < nC; const int kk = validN ? k : 0; slotN = clC[2 * kk]; idN = clC[2 * kk + 1]; }
            else if (more) { validN = grp < nN; const int kk = validN ? grp : 0; slotN = clN[2 * kk]; idN = clN[2 * kk + 1]; }
            else { validN = false; slotN = 0; idN = clC[1]; }
            const unsigned uoffN = (unsigned)idN * 1024u + (unsigned)sub * 16u;
            f32x2 a0 = {0.f, 0.f}, a1 = {0.f, 0.f};
#pragma unroll
            for (int t = 0; t < 16; ++t) {
                const f32x4* hp = (const f32x4*)(hbC + (sub + 4 * t) * 16);
                fp8x16_fma(uv[t], hp[0], hp[1], hp[2], hp[3], a0, a1);
                uv[t] = *(const u32x4*)(U + (uoffN + t * 64));
                if (t & 1) __builtin_amdgcn_sched_barrier(0);
            }
            float d = (a0.x + a0.y) + (a1.x + a1.y);
            d += lx1(d); d += lx2(d);
            if (validC && sub == 0) {
                float* gw = DRY ? (float*)(ws + OFF_R) + (long)tok * 128 + slotC : rgate + (long)tok * 128 + slotC;
                *gw = g_in * gelu_tanh(d * su) * sv;
            }
            slotC = slotN; idC = idN; validC = validN;
        }
        nC = nN;
    }
}

#ifndef VMASK
#define VMASK 0xffffffffu
#endif
template <bool DRY>
DI void phase_peer_v(const Params& p, int layer, int tid) {
    unsigned char* ws = p.ws;
    const int* ridx = (const int*)(ws + OFF_RIDX);
    const float* wact = (const float*)(ws + OFF_RGATE);
    const float* ada = (const float*)(ws + OFF_ADA);
    float* x = opq(p.out);
    const int lane = tid & 63, w = tid >> 6, sub = lane & 7, eg = lane >> 3;
    const int xg = blockIdx.x & 7, lb = blockIdx.x >> 3, nwv = (gridDim.x >> 3) * NWAVES, wv = lb * NWAVES + w;
    if (lb >= (int)(gridDim.x >> 3)) return;
    const unsigned char* Vc = ws + OFF_PV + ((long)(layer * 8 + xg) * 16384) * 128;
    const int col0 = 128 * xg + 16 * sub;
    const __amdgpu_buffer_rsrc_t vrs = __builtin_amdgcn_make_buffer_rsrc((void*)Vc, (short)0, 16384 * 128, 0x00020000);
    auto ld_ids = [&](int tk, u32x4 (&a)[4], f32x4 (&wq)[4]) {
        tk = tk < NTOK ? tk : wv;
        const u32x4* ip = (const u32x4*)(ridx + (long)tk * 128 + eg * 16);
        const f32x4* wp = (const f32x4*)(wact + (long)tk * 128 + eg * 16);
#pragma unroll
        for (int q = 0; q < 4; ++q) { a[q] = ip[q]; wq[q] = wp[q]; }
    };
    u32x4 vv[16];
    u32x4 na[4], pa[4]; f32x4 cw[4], nw[4], pw[4];
    {
        u32x4 a[4];
        ld_ids(wv, a, cw);
#pragma unroll
        for (int j = 0; j < 16; ++j)
            vv[j] = __builtin_bit_cast(u32x4, __builtin_amdgcn_raw_buffer_load_b128(vrs, (int)((a[j >> 2][j & 3] & (DRY ? VMASK : 0xffffffffu)) * 128u + (unsigned)sub * 16u), 0, 0));
    }
    ld_ids(wv + nwv, na, nw);
    f32x4 gfv[4]; int gb = -1;
    for (int tok = wv; tok < NTOK; tok += nwv) {
        ld_ids(tok + 2 * nwv, pa, pw);
        f32x4 xv[4];
        {
            const float* xin = x + (long)tok * DM + col0;
#pragma unroll
            for (int c = 0; c < 4; ++c) xv[c] = *(const f32x4*)(xin + 4 * c);
            const int b = tok >> 13;
            if (b != gb) {
                gb = b;
                const float* gf = ada + b * ADA_STRIDE + layer * 6144 + 5 * 1024 + col0;
#pragma unroll
                for (int c = 0; c < 4; ++c) gfv[c] = *(const f32x4*)(gf + 4 * c);
            }
        }
        f32x2 ap[8];
#pragma unroll
        for (int i = 0; i < 8; ++i) ap[i] = (f32x2){0.f, 0.f};
#pragma unroll
        for (int j = 0; j < 16; ++j) {
            const float ws1 = cw[j >> 2][j & 3]; const f32x2 ww = {ws1, ws1}; const u32x4 v = vv[j];
            ap[0] += __builtin_amdgcn_cvt_pk_f32_fp8((int)v.x, false) * ww; ap[1] += __builtin_amdgcn_cvt_pk_f32_fp8((int)v.x, true) * ww;
            ap[2] += __builtin_amdgcn_cvt_pk_f32_fp8((int)v.y, false) * ww; ap[3] += __builtin_amdgcn_cvt_pk_f32_fp8((int)v.y, true) * ww;
            ap[4] += __builtin_amdgcn_cvt_pk_f32_fp8((int)v.z, false) * ww; ap[5] += __builtin_amdgcn_cvt_pk_f32_fp8((int)v.z, true) * ww;
            ap[6] += __builtin_amdgcn_cvt_pk_f32_fp8((int)v.w, false) * ww; ap[7] += __builtin_amdgcn_cvt_pk_f32_fp8((int)v.w, true) * ww;
            vv[j] = __builtin_bit_cast(u32x4, __builtin_amdgcn_raw_buffer_load_b128(vrs, (int)((na[j >> 2][j & 3] & (DRY ? VMASK : 0xffffffffu)) * 128u + (unsigned)sub * 16u), 0, 0));
        }
        float acc[16];
#pragma unroll
        for (int i = 0; i < 8; ++i) { acc[2 * i] = ap[i].x; acc[2 * i + 1] = ap[i].y; }
#pragma unroll
        for (int i = 0; i < 16; ++i) { acc[i] += lr8(acc[i]); acc[i] = sum_x16(acc[i]); acc[i] = sum_x32(acc[i]); }
        if (eg == 0) {
            float* xr = DRY ? (float*)(ws + OFF_R + 16 * MB) + (long)tok * DM + col0 : x + (long)tok * DM + col0;
#pragma unroll
            for (int c = 0; c < 4; ++c) {
                const f32x4 gv = gfv[c];
                f32x4 o;
                o.x = xv[c].x + gv.x * acc[4 * c + 0]; o.y = xv[c].y + gv.y * acc[4 * c + 1];
                o.z = xv[c].z + gv.z * acc[4 * c + 2]; o.w = xv[c].w + gv.w * acc[4 * c + 3];
                *(f32x4*)(xr + 4 * c) = o;
            }
        }
#pragma unroll
        for (int q = 0; q < 4; ++q) { cw[q] = nw[q]; na[q] = pa[q]; nw[q] = pw[q]; }
    }
}

DI void phase_norm2(const float* __restrict__ x, bf16_t* __restrict__ out1, const float* gain1, int sh1, int sc1,
                    bf16_t* __restrict__ out2, const float* gain2, int sh2, int sc2, const float* ada, int tid) {
    const int lane = tid & 63, gw = blockIdx.x * NWAVES + (tid >> 6), nw = gridDim.x * NWAVES;
    for (int tok = gw; tok < NTOK; tok += nw) {
        const int b = tok >> 13;
        f32x4 v[4]; float ss = 0.f;
#pragma unroll
        for (int j = 0; j < 4; ++j) { v[j] = *(const f32x4*)(x + (long)tok * DM + 4 * lane + 256 * j); ss += v[j].x * v[j].x + v[j].y * v[j].y + v[j].z * v[j].z + v[j].w * v[j].w; }
        const float rstd = rsqrtf(wave_sum(ss) * (1.f / DM) + EPS);
        norm_row_write(v, rstd, gain1, ada + b * ADA_STRIDE + sh1, ada + b * ADA_STRIDE + sc1, out1 + (long)tok * DM, lane);
        norm_row_write(v, rstd, gain2, ada + b * ADA_STRIDE + sh2, ada + b * ADA_STRIDE + sc2, out2 + (long)tok * DM, lane);
    }
}

template <int MT, class Epi>
DI void gemm_phase(const bf16_t* A, long lda, int M, const bf16_t* Bt, long ldb, int N, int K, const Epi& epi, unsigned char* lds, int tid) {
    const int ntm = (M + 128 * MT - 1) / (128 * MT), ntn = (N + 255) / 256, nt = ntm * ntn;
    if ((gridDim.x & 7) == 0 && (ntm & 31) == 0) {
        const int xcd = blockIdx.x & 7, lb = blockIdx.x >> 3, nlb = gridDim.x >> 3, tmx = ntm >> 3, per = tmx * ntn;
        for (int q = lb; q < per; q += nlb) {
            const int g4 = q / (4 * ntn), rem = q - g4 * 4 * ntn, tn = rem >> 2, tm = xcd * tmx + g4 * 4 + (rem & 3);
            if (tm < (xcd + 1) * tmx) gemm_tile<MT>(A, lda, M, Bt, ldb, N, K, tm * 128 * MT, tn * 256, epi, lds, tid);
        }
        return;
    }
    for (int t = blockIdx.x; t < nt; t += gridDim.x) {
        const int tn = t / ntm, tm = t % ntm;
        gemm_tile<MT>(A, lda, M, Bt, ldb, N, K, tm * 128 * MT, tn * 256, epi, lds, tid);
    }
}

#define XB_TMO      128
#define XB_XCNT(j)  (256  + 64 * (j))
#define XB_XSUB(j)  (1280 + 64 * (j))
#define XB_XGEN(j)  (2304 + 64 * (j))
#define XB_TOP      3328
#define XB_TOPGEN   3392
#define XCD_BAR_WORDS 3456
#define XB_SPIN_CAP (1u << 22)
#define LAS __attribute__((address_space(3)))
DI unsigned xb_ld(unsigned* p) { return __hip_atomic_load(p, __ATOMIC_RELAXED, __HIP_MEMORY_SCOPE_AGENT); }
DI unsigned xb_add(unsigned* p, unsigned v) { return __hip_atomic_fetch_add(p, v, __ATOMIC_RELAXED, __HIP_MEMORY_SCOPE_AGENT); }
DI unsigned xb_xcc_id() { return (unsigned)__builtin_amdgcn_s_getreg((3 << 11) | 20) & 0xFu; }
#define XB_SPIN(cond, bar) do { unsigned _sp = 0; while (cond) { __builtin_amdgcn_s_sleep(1); \
    if ((++_sp & 255u) == 0u) { if (xb_ld(&(bar)[XB_TMO])) break; if (_sp > XB_SPIN_CAP) { atomicAdd(&(bar)[XB_TMO], 1u); break; } } } } while (0)
DI void xcd_barrier_complete(unsigned* bar, unsigned x, unsigned& nloc, unsigned& nx) {
    const unsigned G = gridDim.x;
    unsigned sum, cnt, mine, sp = 0u;
    for (;;) {
        sum = 0u; cnt = 0u; mine = 0u;
#pragma unroll
        for (unsigned j = 0; j < 16; ++j) { const unsigned c = xb_ld(&bar[XB_XCNT(j)]); sum += c; cnt += (c > 0u) ? 1u : 0u; mine = (j == x) ? c : mine; }
        if (sum == G) break;
        __builtin_amdgcn_s_sleep(1);
        if ((++sp & 255u) == 0u) { if (xb_ld(&bar[XB_TMO])) break; if (sp > XB_SPIN_CAP) { atomicAdd(&bar[XB_TMO], 1u); break; } }
    }
    nloc = mine > 0u ? mine : 1u; nx = cnt > 0u ? cnt : 1u;
}
DI void xcd_barrier(unsigned* bar, volatile LAS unsigned* st, int tid) {
    asm volatile("s_waitcnt vmcnt(0)" ::: "memory");
    __syncthreads();
    if (tid == 0) {
        const unsigned x = xb_xcc_id();
        __builtin_amdgcn_s_waitcnt(0);
        unsigned nloc = st[0], nx = st[1];
        if (nloc == 0u) { xcd_barrier_complete(bar, x, nloc, nx); st[0] = nloc; st[1] = nx; }
        const unsigned old = xb_add(&bar[XB_XSUB(x)], 1u);
        const unsigned gen = old / nloc;
        if (old + 1u == (gen + 1u) * nloc) {
            __builtin_amdgcn_fence(__ATOMIC_RELEASE, "agent");
            asm volatile("s_waitcnt vmcnt(0)" ::: "memory");
            const unsigned og = xb_add(&bar[XB_TOP], 1u);
            const unsigned tg = og / nx;
            if (og + 1u == (tg + 1u) * nx) xb_add(&bar[XB_TOPGEN], 1u);
            else XB_SPIN(xb_ld(&bar[XB_TOPGEN]) == tg, bar);
            __builtin_amdgcn_fence(__ATOMIC_ACQUIRE, "agent");
            xb_add(&bar[XB_XGEN(x)], 1u);
            asm volatile("s_waitcnt vmcnt(0)" ::: "memory");
        } else {
            XB_SPIN(xb_ld(&bar[XB_XGEN(x)]) == gen, bar);
            __builtin_amdgcn_fence(__ATOMIC_ACQUIRE, "agent");
            asm volatile("s_waitcnt vmcnt(0)" ::: "memory");
        }
    }
    __syncthreads();
}

#define ftid() ftid_(wave_u)
DI int ftid_(int wave_u) { int t = (wave_u << 6) + (int)__builtin_amdgcn_mbcnt_hi(~0u, __builtin_amdgcn_mbcnt_lo(~0u, 0u)); asm volatile("" : "+v"(t)); return t; }


#if defined(__HIP_DEVICE_COMPILE__)
typedef const __attribute__((address_space(4))) Params* KParamPtr;
DI Params load_params() { KParamPtr kp = (KParamPtr)__builtin_amdgcn_kernarg_segment_ptr(); asm volatile("" : "+s"(kp)); return *kp; }
#else
DI Params load_params() { return Params{}; }
#endif
#define p (load_params())
#define ws (load_params().ws)
#define ada ((const float*)(ws + OFF_ADA))
#define Hb ((bf16_t*)(ws + OFF_H))
#define bar ((unsigned*)(ws + OFF_BAR))
__global__ void __launch_bounds__(NTHREADS) yoco_fwd(Params p_arg) {
    extern __shared__ __attribute__((aligned(16))) unsigned char lds[];
    cg::grid_group grid = cg::this_grid();
    volatile LAS unsigned* bst = (volatile LAS unsigned*)(lds + 144 * 1024);
    const int wave_u = __builtin_amdgcn_readfirstlane((int)(threadIdx.x >> 6));
    { const int t0 = ftid(); if (t0 == 0) { bst[0] = 0u; bst[1] = 0u; }
      if (blockIdx.x == 0) for (int i = t0; i < XCD_BAR_WORDS; i += NTHREADS) bar[i] = 0u; }
    __syncthreads();
    RUN(0) REP(0) phase_prep(p, lds, ftid());
    grid.sync();
    if (ftid() == 0) (void)xb_add(&bar[XB_XCNT(xb_xcc_id())], 1u);
    RUN(1) REP(1) phase_norm(p.in[0], Hb, p.in[5], ada, 0, 1024, ftid());
    xcd_barrier(bar, bst, ftid());
    RUN(2) REP(2) {
        EpiQKV0 e{(bf16_t*)(ws + OFF_Q0), (bf16_t*)(ws + OFF_K0), (bf16_t*)(ws + OFF_VT0), p.in[10], p.in[11], (float*)(ws + OFF_MB0), p.in[2]};
        gemm_phase<2>(Hb, DM, NTOK, (const bf16_t*)(ws + OFF_WT_DIN), DM, 3072, DM, e, lds, ftid());
    }
    xcd_barrier(bar, bst, ftid());
    RUN(3) REP(3) phase_diff_attn(p, lds, ftid());
    xcd_barrier(bar, bst, ftid());
    RUN(4) REP(4) {
        EpiResid e{p.in[0], opq(p.out), ada + 2 * 1024};
        gemm_phase<2>(Hb, DM, NTOK, (const bf16_t*)(ws + OFF_WT_DOUT), DM, 1024, DM, e, lds, ftid());
    }
    xcd_barrier(bar, bst, ftid());
    if (STOP_AFTER <= 1) return;
    RUN(1) phase_norm(opq(p.out), Hb, p.in[6], ada, 3 * 1024, 4 * 1024, ftid());
    xcd_barrier(bar, bst, ftid());
    RUN(5) REP(5) {
        EpiPeer e{(int*)(ws + OFF_RIDX), (float*)(ws + OFF_RGATE), 128 * 1024};
        gemm_phase<2>(Hb, DM, NTOK, (const bf16_t*)(ws + OFF_WT_PEER), DM, 2048, DM, e, lds, ftid());
    }
    xcd_barrier(bar, bst, ftid());
    if ((REPEAT_MASK >> 6) & 1) phase_peer_u<true>(p, 0, lds, ftid());
    RUN(6) phase_peer_u<false>(p, 0, lds, ftid());
    xcd_barrier(bar, bst, ftid());
    if ((REPEAT_MASK >> 10) & 1) phase_peer_v<true>(p, 0, ftid());
    RUN(6) phase_peer_v<false>(p, 0, ftid());
    xcd_barrier(bar, bst, ftid());
    RUN(1) phase_norm2(opq(p.out), (bf16_t*)(ws + OFF_H2), p.in[13], 12288, 12288 + 1024, Hb, p.in[5] + 1024, 6144, 6144 + 1024, ada, ftid());
    xcd_barrier(bar, bst, ftid());
    if (STOP_AFTER <= 2) return;
    RUN(7) REP(7) {
        EpiKV e{(bf16_t*)(ws + OFF_KC), (bf16_t*)(ws + OFF_KS), (bf16_t*)(ws + OFF_VST), (bf16_t*)(ws + OFF_KW), (bf16_t*)(ws + OFF_VWT), p.in[21]};
        gemm_phase<2>((const bf16_t*)(ws + OFF_H2), DM, NTOK, (const bf16_t*)(ws + OFF_WT_KV), DM, 1536, DM, e, lds, ftid());
    }
    xcd_barrier(bar, bst, ftid());
    RUN(8) REP(8) {
        EpiNsaQ e{(bf16_t*)(ws + OFF_QN), (float*)(ws + OFF_GATES), p.in[25], p.in[23], (float*)(ws + OFF_MB1)};
        gemm_phase<2>(Hb, DM, NTOK, (const bf16_t*)(ws + OFF_WT_NIN), DM, 1048, DM, e, lds, ftid());
        for (int t = blockIdx.x; t < 64; t += gridDim.x) {
            const int pr = t >> 2, tm = t & 3, kv = pr >> 3, bg = pr & 7;
            const bf16_t* Ap = (const bf16_t*)(ws + OFF_KC) + (long)(kv * 8 + bg) * SEQ * 128;
            bf16_t* hid = (bf16_t*)(ws + OFF_HID) + (long)pr * 512 * 256;
            EpiCmp1 e1{hid, (const float*)(ws + OFF_POSB) + kv * 16 * 256, p.in[19] + kv * 256};
            gemm_tile<1>(Ap, 2048, 511, (const bf16_t*)(ws + OFF_WT_C1) + (long)kv * 256 * 4096, 4096, 256, 4096, tm * 128, 0, e1, lds, ftid());
            __syncthreads();
            bf16_t* dst = kv == 0 ? (bf16_t*)(ws + OFF_KCMP) + (long)bg * 512 * 128 : (bf16_t*)(ws + OFF_VCMPT) + (long)bg * 128 * 512;
            EpiCmp2 e2{dst, p.in[21], kv};
            gemm_tile<1>(hid, 256, 512, (const bf16_t*)(ws + OFF_WT_C2) + (long)kv * 128 * 256, 256, 128, 256, tm * 128, 0, e2, lds, ftid());
        }
    }
    xcd_barrier(bar, bst, ftid());
#ifdef NSA_PROBE
    phase_nsa_attn<NSA_PROBE>(p, lds, ftid());
#endif
    RUN(9) REP(9) phase_nsa_attn<0>(p, lds, ftid());
    xcd_barrier(bar, bst, ftid());
    RUN(4) {
        float* xo = opq(p.out);
        EpiResid e{xo, xo, ada + 6144 + 2 * 1024};
        gemm_phase<2>(Hb, DM, NTOK, (const bf16_t*)(ws + OFF_WT_NOUT), DM, 1024, DM, e, lds, ftid());
    }
    xcd_barrier(bar, bst, ftid());
    if (STOP_AFTER <= 3) return;
    RUN(1) phase_norm(opq(p.out), Hb, p.in[6] + 1024, ada, 6144 + 3 * 1024, 6144 + 4 * 1024, ftid());
    xcd_barrier(bar, bst, ftid());
    RUN(5) REP(5) {
        EpiPeer e{(int*)(ws + OFF_RIDX), (float*)(ws + OFF_RGATE), 128 * 1024};
        gemm_phase<2>(Hb, DM, NTOK, (const bf16_t*)(ws + OFF_WT_PEER) + (long)2048 * 1024, DM, 2048, DM, e, lds, ftid());
    }
    xcd_barrier(bar, bst, ftid());
    if ((REPEAT_MASK >> 6) & 1) phase_peer_u<true>(p, 1, lds, ftid());
    RUN(6) phase_peer_u<false>(p, 1, lds, ftid());
    xcd_barrier(bar, bst, ftid());
    if ((REPEAT_MASK >> 10) & 1) phase_peer_v<true>(p, 1, ftid());
    RUN(6) phase_peer_v<false>(p, 1, ftid());
}
#undef p
#undef ws
#undef ada
#undef Hb
#undef bar

extern "C" void kernel_launch(void* const* d_in, const int* in_sizes, int n_in, void* d_out, int out_size, void* d_ws, size_t ws_size,
                              hipStream_t stream) {
    static int grid_blocks = 0;
    if (grid_blocks == 0) {
        if (n_in != 30 || out_size != NTOK * DM || ws_size < WS_END) {
            fprintf(stderr, "kernel_launch: unexpected shapes (n_in %d out %d ws %zu)\n", n_in, out_size, ws_size);
            grid_blocks = -1; return;
        }
        int dev = 0, cus = 0, per_cu = 0;
        hipGetDevice(&dev);
        hipDeviceGetAttribute(&cus, hipDeviceAttributeMultiprocessorCount, dev);
        hipFuncSetAttribute((const void*)yoco_fwd, hipFuncAttributeMaxDynamicSharedMemorySize, LDS_BYTES);
        hipOccupancyMaxActiveBlocksPerMultiprocessor(&per_cu, (const void*)yoco_fwd, NTHREADS, LDS_BYTES);
        if (per_cu < 1) { fprintf(stderr, "kernel_launch: occupancy query says %d blocks per CU\n", per_cu); grid_blocks = -1; return; }
        grid_blocks = cus;
    }
    if (grid_blocks < 0) return;
    Params p{};
    for (int i = 0; i < 30; ++i) p.in[i] = (const float*)d_in[i];
    p.out = (float*)d_out;
    p.ws = (unsigned char*)d_ws;
    void* args[] = {&p};
    hipError_t e = hipLaunchCooperativeKernel((const void*)yoco_fwd, dim3(grid_blocks), dim3(NTHREADS), args, LDS_BYTES, stream);
    if (e != hipSuccess) fprintf(stderr, "cooperative launch failed: %s (grid %d)\n", hipGetErrorString(e), grid_blocks);
}
```

```cpp
#include <hip/hip_runtime.h>
#include <hip/hip_cooperative_groups.h>
#include <cstdio>
#include <cstdint>
namespace cg = cooperative_groups;

#define DI __device__ __forceinline__
#ifndef STOP_AFTER
#define STOP_AFTER 99
#endif
#ifndef ONLY_PHASE
#define ONLY_PHASE -1
#endif
#define RUN(n) if (ONLY_PHASE < 0 || ONLY_PHASE == (n))
#ifndef REPEAT_MASK
#define REPEAT_MASK 0
#endif
#define REP(n) for (int rep_ = 0; rep_ < (((REPEAT_MASK) >> (n)) & 1) + 1; ++rep_)

typedef unsigned short bf16_t;
typedef short bf16x8 __attribute__((ext_vector_type(8)));
typedef float f32x16 __attribute__((ext_vector_type(16)));
typedef float f32x4 __attribute__((ext_vector_type(4)));
typedef float f32x2 __attribute__((ext_vector_type(2)));
typedef unsigned u32x4 __attribute__((ext_vector_type(4)));
typedef unsigned u32x2 __attribute__((ext_vector_type(2)));
typedef __bf16 bf16x2v __attribute__((ext_vector_type(2)));

#define MFMA32(a, b, c) __builtin_amdgcn_mfma_f32_32x32x16_bf16((a), (b), (c), 0, 0, 0)

constexpr int NB = 4, SEQ = 8192, DM = 1024, NTOK = NB * SEQ;
constexpr int NTHREADS = 512, NWAVES = 8;
constexpr float EPS = 1e-6f;
constexpr float LOG2E = 1.4426950408889634f;
constexpr int ADA_STRIDE = 14336;

constexpr size_t MB = 1u << 20;
constexpr size_t OFF_ADA = 0;
constexpr size_t OFF_POSB = 256 * 1024;
constexpr size_t OFF_BAR = 320 * 1024;
constexpr size_t OFF_MB0 = 168 * MB;
constexpr size_t OFF_MB1 = 172 * MB;
constexpr size_t OFF_USI = 384 * 1024;
constexpr size_t OFF_VSI = 512 * 1024;
constexpr size_t OFF_WT_DIN = 1 * MB;
constexpr size_t OFF_WT_DOUT = 7 * MB;
constexpr size_t OFF_WT_KV = 9 * MB;
constexpr size_t OFF_WT_NIN = 12 * MB;
constexpr size_t OFF_WT_NOUT = 15 * MB;
constexpr size_t OFF_WT_PEER = 17 * MB;
constexpr size_t OFF_WT_C1 = 25 * MB;
constexpr size_t OFF_WT_C2 = 29 * MB;
constexpr size_t OFF_GATES = 30 * MB;
constexpr size_t OFF_KCMP = 34 * MB;
constexpr size_t OFF_VCMPT = 35 * MB;
constexpr size_t OFF_HID = 36 * MB;
constexpr size_t OFF_RIDX = 40 * MB;
constexpr size_t OFF_RGATE = 56 * MB;
constexpr size_t OFF_PU = 72 * MB;
constexpr size_t OFF_PV = 136 * MB;
constexpr size_t OFF_H = 200 * MB;
constexpr size_t OFF_R = 264 * MB;
constexpr size_t WS_END = 456 * MB;
constexpr size_t OFF_Q0 = OFF_R, OFF_K0 = OFF_R + 64 * MB, OFF_VT0 = OFF_R + 128 * MB;
constexpr size_t OFF_QN = OFF_R, OFF_H2 = OFF_R, OFF_KC = OFF_R + 64 * MB, OFF_KS = OFF_R + 96 * MB, OFF_VST = OFF_R + 112 * MB,
                 OFF_KW = OFF_R + 128 * MB, OFF_VWT = OFF_R + 144 * MB;

constexpr int LDS_BYTES = 144 * 1024 + 256;

struct Params {
    const float* in[30];
    float* out;
    unsigned char* ws;
};

template <class T> DI T* opq(T* q) { asm volatile("" : "+s"(q)); return (T*)(__attribute__((address_space(1))) T*)q; }
DI unsigned pk2(float lo, float hi) { f32x2 v = {lo, hi}; return __builtin_bit_cast(unsigned, __builtin_convertvector(v, bf16x2v)); }
DI bf16_t f2bf(float x) { return (bf16_t)(pk2(x, 0.f) & 0xffffu); }
DI float bflo(unsigned u) { return __uint_as_float(u << 16); }
DI float bfhi(unsigned u) { return __uint_as_float(u & 0xffff0000u); }
DI float fexp2(float x) { return __builtin_amdgcn_exp2f(x); }
DI float frcp(float x) { return __builtin_amdgcn_rcpf(x); }
DI int crow(int reg, int h) { return (reg & 3) + 8 * (reg >> 2) + 4 * h; }
template <int CTRL> DI float dpp_f(float v) { return __builtin_bit_cast(float, __builtin_amdgcn_update_dpp(0, __builtin_bit_cast(int, v), CTRL, 0xF, 0xF, true)); }
DI float lx1(float v) { return dpp_f<0xB1>(v); }
DI float lx2(float v) { return dpp_f<0x4E>(v); }
DI float lhm(float v) { return dpp_f<0x141>(v); }
DI float lr8(float v) { return dpp_f<0x128>(v); }
DI float sum_x16(float v) { auto s = __builtin_amdgcn_permlane16_swap(__float_as_uint(v), __float_as_uint(v), false, false); return __uint_as_float(s[0]) + __uint_as_float(s[1]); }
DI float sum_x32(float v) { auto s = __builtin_amdgcn_permlane32_swap(__float_as_uint(v), __float_as_uint(v), false, false); return __uint_as_float(s[0]) + __uint_as_float(s[1]); }
DI float max_x16(float v) { auto s = __builtin_amdgcn_permlane16_swap(__float_as_uint(v), __float_as_uint(v), false, false); return fmaxf(__uint_as_float(s[0]), __uint_as_float(s[1])); }
DI float max_x32(float v) { auto s = __builtin_amdgcn_permlane32_swap(__float_as_uint(v), __float_as_uint(v), false, false); return fmaxf(__uint_as_float(s[0]), __uint_as_float(s[1])); }
DI unsigned get_x32(unsigned v, int h) { auto s = __builtin_amdgcn_permlane32_swap(v, v, false, false); return h ? s[0] : s[1]; }
DI float wave_sum(float v) { v += lx1(v); v += lx2(v); v += lhm(v); v += lr8(v); v = sum_x16(v); return sum_x32(v); }
DI float wave_max(float v) { v = fmaxf(v, lx1(v)); v = fmaxf(v, lx2(v)); v = fmaxf(v, lhm(v)); v = fmaxf(v, lr8(v)); v = max_x16(v); return max_x32(v); }
DI int bperm(int v, int srclane) { return __builtin_amdgcn_ds_bpermute(srclane << 2, v); }
DI float bpermf(float v, int srclane) { return __builtin_bit_cast(float, __builtin_amdgcn_ds_bpermute(srclane << 2, __builtin_bit_cast(int, v))); }
DI float gelu_tanh(float x) {
    const float u = 0.7978845608028654f * (x + 0.044715f * x * x * x);
    return x * frcp(1.f + fexp2(-2.f * LOG2E * u));
}
DI float dot2bf(unsigned a, unsigned b, float c) {
    return __builtin_amdgcn_fdot2_f32_bf16(__builtin_bit_cast(bf16x2v, a), __builtin_bit_cast(bf16x2v, b), c, false);
}
DI int rel_bucket_i(int d) {
    if (d < 16) return d < 0 ? 0 : d;
    int b = 16;
    b += d >= 21; b += d >= 27; b += d >= 35; b += d >= 46; b += d >= 59; b += d >= 77; b += d >= 99; b += d >= 128;
    b += d >= 166; b += d >= 216; b += d >= 280; b += d >= 363; b += d >= 470; b += d >= 609; b += d >= 790;
    return b;
}
DI unsigned f2key(float f) { unsigned u = __float_as_uint(f); return u ^ ((unsigned)((int)u >> 31) | 0x80000000u); }
DI float key2f(unsigned k) { unsigned u = (k & 0x80000000u) ? (k ^ 0x80000000u) : ~k; return __uint_as_float(u); }

constexpr int EPI_LDS = 96 * 1024;

DI int sw2(int row, int chunk) { return (row >> 1) * 256 + (((((row & 1) << 3) | chunk) ^ ((row >> 1) & 15)) << 4); }
DI void sw2_src(int P, int& row, int& chunk) { const int R2 = P >> 4, lc = (P & 15) ^ (R2 & 15); row = 2 * R2 + (lc >> 3); chunk = lc & 7; }

template <class T, class = void> struct epi_stash { static constexpr bool value = false, present = false; };
template <class T> struct epi_stash<T, decltype((void)T::STASH)> { static constexpr bool value = T::STASH, present = true; };

template <int MT, class Epi>
DI void gemm_tile(const bf16_t* __restrict__ A, long lda, int M, const bf16_t* __restrict__ Bt, long ldb, int N, int K,
                  int m0, int n0, const Epi& epi, unsigned char* lds, int tid) {
    constexpr int XS = MT * 128 * 128, WS = 256 * 128, STAGE = XS + WS;
    const int lane = tid & 63, w = tid >> 6, tg = w & 3, fh = w >> 2, r = lane & 31, h = lane >> 5;
    const int wbase = tid & ~63;
    unsigned xo[2 * MT], wo[4];
#pragma unroll
    for (int i = 0; i < 2 * MT; ++i) { int row, c; sw2_src(tid + 512 * i, row, c); int m = m0 + row; m = m < M ? m : M - 1; xo[i] = (unsigned)m * (unsigned)(lda * 2) + c * 16; }
#pragma unroll
    for (int i = 0; i < 4; ++i) { int row, c; sw2_src(tid + 512 * i, row, c); int n = n0 + row; n = n < N ? n : N - 1; wo[i] = (unsigned)n * (unsigned)(ldb * 2) + c * 16; }
    const unsigned char* Ab = (const unsigned char*)A;
    const unsigned char* Bb = (const unsigned char*)Bt;
    auto stage = [&](int kt, unsigned char* st) {
#pragma unroll
        for (int i = 0; i < 2 * MT; ++i)
            __builtin_amdgcn_global_load_lds((const unsigned*)(Ab + kt * 128 + xo[i]), (unsigned*)(st + (wbase + 512 * i) * 16), 16, 0, 0);
#pragma unroll
        for (int i = 0; i < 4; ++i)
            __builtin_amdgcn_global_load_lds((const unsigned*)(Bb + kt * 128 + wo[i]), (unsigned*)(st + XS + (wbase + 512 * i) * 16), 16, 0, 0);
    };
    f32x16 acc[MT][4];
#pragma unroll
    for (int s2 = 0; s2 < MT; ++s2)
#pragma unroll
        for (int i = 0; i < 4; ++i)
#pragma unroll
            for (int j = 0; j < 16; ++j) acc[s2][i][j] = 0.f;
    const int nk = K >> 6;
    stage(0, lds);
    __syncthreads();
    for (int kt = 0; kt < nk; ++kt) {
        unsigned char* cur = lds + (kt & 1) * STAGE;
        if (kt + 1 < nk) stage(kt + 1, lds + ((kt + 1) & 1) * STAGE);
        bf16x8 xfa[MT], wfa[4], xfb[MT], wfb[4];
        auto ldf = [&](bf16x8 (&xf)[MT], bf16x8 (&wf)[4], int ks) {
#pragma unroll
            for (int s2 = 0; s2 < MT; ++s2) xf[s2] = *(const bf16x8*)(cur + sw2(32 * MT * tg + 32 * s2 + r, 2 * ks + h));
#pragma unroll
            for (int mt = 0; mt < 4; ++mt) wf[mt] = *(const bf16x8*)(cur + XS + sw2(128 * fh + 32 * mt + r, 2 * ks + h));
        };
        auto mm = [&](const bf16x8 (&xf)[MT], const bf16x8 (&wf)[4]) {
#pragma unroll
            for (int mt = 0; mt < 4; ++mt)
#pragma unroll
                for (int s2 = 0; s2 < MT; ++s2) acc[s2][mt] = MFMA32(wf[mt], xf[s2], acc[s2][mt]);
        };
        ldf(xfa, wfa, 0);
        ldf(xfb, wfb, 1); __builtin_amdgcn_sched_barrier(0); mm(xfa, wfa); __builtin_amdgcn_sched_barrier(0);
        ldf(xfa, wfa, 2); __builtin_amdgcn_sched_barrier(0); mm(xfb, wfb); __builtin_amdgcn_sched_barrier(0);
        ldf(xfb, wfb, 3); __builtin_amdgcn_sched_barrier(0); mm(xfa, wfa); __builtin_amdgcn_sched_barrier(0);
        mm(xfb, wfb);
        __syncthreads();
    }
    if constexpr (MT == 2 && epi_stash<Epi>::value) {
        float* sp = (float*)lds + w * 4096 + lane;
#pragma unroll
        for (int mt = 0; mt < 4; ++mt)
#pragma unroll
            for (int j = 0; j < 16; ++j) sp[(mt * 16 + j) * 64] = acc[1][mt][j];
        epi(acc[0], m0 + 64 * tg + r, n0 + 128 * fh, h, lds, tid);
        f32x16 a2[4];
        const float* sp2 = sp; asm volatile("" : "+v"(sp2));
#pragma unroll
        for (int mt = 0; mt < 4; ++mt)
#pragma unroll
            for (int j = 0; j < 16; ++j) a2[mt][j] = sp2[(mt * 16 + j) * 64];
        epi(a2, m0 + 64 * tg + 32 + r, n0 + 128 * fh, h, lds, tid);
        __syncthreads();
    } else {
        int ho = h, ro = r, to = tid;
        if constexpr (epi_stash<Epi>::present) asm volatile("" : "+v"(ho), "+v"(ro), "+v"(to));
#pragma unroll
        for (int s2 = 0; s2 < MT; ++s2) epi(acc[s2], m0 + 32 * MT * tg + 32 * s2 + ro, n0 + 128 * fh, ho, lds, to);
    }
}

struct EpiQKV0 {
    bf16_t *Q, *Kk, *VT;
    const float *qg, *kg;
    float* MB; const float* relb;
    DI void operator()(const f32x16 (&acc)[4], int tok, int fbase, int h, unsigned char*, int) const {
        const int sec = fbase >> 10, hd = (fbase & 1023) >> 7, b = tok >> 13, s = tok & (SEQ - 1);
        if (sec < 2) {
            const float* gn = sec == 0 ? qg : kg;
            const float sc = sec == 0 ? 0.125f * LOG2E : 1.f;
            bf16_t* dst = sec == 0 ? Q : Kk;
#pragma unroll
            for (int j = 0; j < 2; ++j) {
                float ss = 0.f;
#pragma unroll
                for (int mt = 0; mt < 2; ++mt)
#pragma unroll
                    for (int rg = 0; rg < 16; ++rg) { const float v = acc[2 * j + mt][rg]; ss += v * v; }
                ss = sum_x32(ss);
                const float rstd = rsqrtf(ss * (1.f / 64.f) + EPS) * sc;
                bf16_t* row = dst + ((long)((b * 8 + hd) * 2 + j) * SEQ + s) * 64;
                float qq = 0.f;
#pragma unroll
                for (int mt = 0; mt < 2; ++mt)
#pragma unroll
                    for (int g4 = 0; g4 < 4; ++g4) {
                        const int d0 = 32 * mt + 8 * g4 + 4 * h;
                        const f32x4 gv = *(const f32x4*)(gn + d0);
                        const float v0 = acc[2 * j + mt][4 * g4 + 0] * rstd * gv.x, v1 = acc[2 * j + mt][4 * g4 + 1] * rstd * gv.y;
                        const float v2 = acc[2 * j + mt][4 * g4 + 2] * rstd * gv.z, v3 = acc[2 * j + mt][4 * g4 + 3] * rstd * gv.w;
                        qq += v0 * v0 + v1 * v1 + v2 * v2 + v3 * v3;
                        u32x2 o;
                        o.x = pk2(v0, v1); o.y = pk2(v2, v3);
                        *(u32x2*)(row + d0) = o;
                    }
                if (sec == 0) {
                    qq = sum_x32(qq);
                    float kmx = 0.f;
                    for (int d = 0; d < 64; ++d) kmx = fmaxf(kmx, fabsf(kg[d]));
                    float bmx = 0.f;
                    for (int bk = 0; bk < 32; ++bk) bmx = fmaxf(bmx, relb[bk * 8 + hd] - relb[31 * 8 + hd]);
                    if (h == 0) MB[(long)((b * 8 + hd) * 2 + j) * SEQ + s] = 1.01f * sqrtf(qq) * 8.f * kmx + bmx * LOG2E;
                }
            }
        } else {
            bf16_t* base = VT + (long)(b * 8 + hd) * 128 * SEQ + s;
#pragma unroll
            for (int mt = 0; mt < 4; ++mt)
#pragma unroll
                for (int rg = 0; rg < 16; ++rg) base[(long)(32 * mt + crow(rg, h)) * SEQ] = f2bf(acc[mt][rg]);
        }
    }
};

struct EpiResid {
    const float* xin; float* xout; const float* gate;
    DI void operator()(const f32x16 (&acc)[4], int tok, int fbase, int h, unsigned char*, int) const {
        const int b = tok >> 13;
        const float* gp = gate + b * ADA_STRIDE;
#pragma unroll
        for (int mt = 0; mt < 4; ++mt)
#pragma unroll
            for (int g4 = 0; g4 < 4; ++g4) {
                const int f = fbase + 32 * mt + 8 * g4 + 4 * h;
                const f32x4 xv = *(const f32x4*)(xin + (long)tok * DM + f);
                const f32x4 gv = *(const f32x4*)(gp + f);
                f32x4 o;
                o.x = xv.x + gv.x * acc[mt][4 * g4 + 0]; o.y = xv.y + gv.y * acc[mt][4 * g4 + 1];
                o.z = xv.z + gv.z * acc[mt][4 * g4 + 2]; o.w = xv.w + gv.w * acc[mt][4 * g4 + 3];
                *(f32x4*)(xout + (long)tok * DM + f) = o;
                if (g4 == 3) __builtin_amdgcn_sched_barrier(0);
            }
    }
};

struct EpiKV {
    bf16_t *KC, *KS, *VST, *KW, *VWT;
    const float* kgain;
    DI void operator()(const f32x16 (&acc)[4], int tok, int fbase, int h, unsigned char*, int) const {
        const int c = fbase >> 7, br = c >> 2, kv = (c >> 1) & 1, g = c & 1, b = tok >> 13, s = tok & (SEQ - 1);
        if (br == 0 || kv == 0) {
            float rstd = 1.f;
            bf16_t* row;
            if (br == 0) row = KC + ((long)((kv * 4 + b) * 2 + g) * SEQ + s) * 128;
            else {
                float ss = 0.f;
#pragma unroll
                for (int mt = 0; mt < 4; ++mt)
#pragma unroll
                    for (int rg = 0; rg < 16; ++rg) ss += acc[mt][rg] * acc[mt][rg];
                ss = sum_x32(ss);
                rstd = rsqrtf(ss * (1.f / 128.f) + EPS);
                row = (br == 1 ? KS : KW) + ((long)(b * 2 + g) * SEQ + s) * 128;
            }
#pragma unroll
            for (int mt = 0; mt < 4; ++mt)
#pragma unroll
                for (int g4 = 0; g4 < 4; ++g4) {
                    const int d0 = 32 * mt + 8 * g4 + 4 * h;
                    f32x4 gv = {1.f, 1.f, 1.f, 1.f};
                    if (br != 0) gv = *(const f32x4*)(kgain + br * 128 + d0);
                    u32x2 o;
                    o.x = pk2(acc[mt][4 * g4 + 0] * rstd * gv.x, acc[mt][4 * g4 + 1] * rstd * gv.y);
                    o.y = pk2(acc[mt][4 * g4 + 2] * rstd * gv.z, acc[mt][4 * g4 + 3] * rstd * gv.w);
                    *(u32x2*)(row + d0) = o;
                }
        } else {
            bf16_t* base = (br == 1 ? VST : VWT) + (long)(b * 2 + g) * 128 * SEQ + s;
#pragma unroll
            for (int mt = 0; mt < 4; ++mt)
#pragma unroll
                for (int rg = 0; rg < 16; ++rg) base[(long)(32 * mt + crow(rg, h)) * SEQ] = f2bf(acc[mt][rg]);
        }
    }
};

struct EpiCmp1 {
    bf16_t* hid; const float* posb_part; const float* b1;
    DI void operator()(const f32x16 (&acc)[4], int tok, int fbase, int h, unsigned char*, int) const {
        if (tok >= 512) return;
#pragma unroll
        for (int mt = 0; mt < 4; ++mt)
#pragma unroll
            for (int g4 = 0; g4 < 4; ++g4) {
                const int f = fbase + 32 * mt + 8 * g4 + 4 * h;
                f32x4 pb = *(const f32x4*)(b1 + f);
                for (int c = 0; c < 16; ++c) { const f32x4 t = *(const f32x4*)(posb_part + c * 256 + f); pb.x += t.x; pb.y += t.y; pb.z += t.z; pb.w += t.w; }
                u32x2 o;
                o.x = pk2(gelu_tanh(acc[mt][4 * g4 + 0] + pb.x), gelu_tanh(acc[mt][4 * g4 + 1] + pb.y));
                o.y = pk2(gelu_tanh(acc[mt][4 * g4 + 2] + pb.z), gelu_tanh(acc[mt][4 * g4 + 3] + pb.w));
                *(u32x2*)(hid + (long)tok * 256 + f) = o;
            }
    }
};

struct EpiCmp2 {
    bf16_t* dst; const float* kgain0; int kv;
    DI void operator()(const f32x16 (&acc)[4], int tok, int fbase, int h, unsigned char*, int) const {
        if (fbase != 0 || tok >= 512) return;
        const float valid = tok < 511 ? 1.f : 0.f;
        if (kv == 0) {
            float ss = 0.f;
#pragma unroll
            for (int mt = 0; mt < 4; ++mt)
#pragma unroll
                for (int rg = 0; rg < 16; ++rg) ss += acc[mt][rg] * acc[mt][rg];
            ss = sum_x32(ss);
            const float rstd = rsqrtf(ss * (1.f / 128.f) + EPS) * valid;
#pragma unroll
            for (int mt = 0; mt < 4; ++mt)
#pragma unroll
                for (int g4 = 0; g4 < 4; ++g4) {
                    const int d0 = 32 * mt + 8 * g4 + 4 * h;
                    const f32x4 gv = *(const f32x4*)(kgain0 + d0);
                    u32x2 o;
                    o.x = pk2(acc[mt][4 * g4 + 0] * rstd * gv.x, acc[mt][4 * g4 + 1] * rstd * gv.y);
                    o.y = pk2(acc[mt][4 * g4 + 2] * rstd * gv.z, acc[mt][4 * g4 + 3] * rstd * gv.w);
                    *(u32x2*)(dst + (long)tok * 128 + d0) = o;
                }
        } else {
#pragma unroll
            for (int mt = 0; mt < 4; ++mt)
#pragma unroll
                for (int rg = 0; rg < 16; ++rg) dst[(long)(32 * mt + crow(rg, h)) * 512 + tok] = f2bf(acc[mt][rg] * valid);
        }
    }
};

struct EpiNsaQ {
    bf16_t* QN; float* gates; const float* qgain; const float* bgate; float* qnrm;
    DI void operator()(const f32x16 (&acc)[4], int tok, int fbase, int h, unsigned char*, int) const {
        const int b = tok >> 13, s = tok & (SEQ - 1);
        if (fbase < 1024) {
            const int head = fbase >> 7;
            float ss = 0.f;
#pragma unroll
            for (int mt = 0; mt < 4; ++mt)
#pragma unroll
                for (int rg = 0; rg < 16; ++rg) ss += acc[mt][rg] * acc[mt][rg];
            ss = sum_x32(ss);
            const float rstd = rsqrtf(ss * (1.f / 128.f) + EPS) * (0.08838834764831845f * LOG2E);
            bf16_t* row = QN + ((long)(b * 8 + head) * SEQ + s) * 128;
            float qq = 0.f;
#pragma unroll
            for (int mt = 0; mt < 4; ++mt)
#pragma unroll
                for (int g4 = 0; g4 < 4; ++g4) {
                    const int d0 = 32 * mt + 8 * g4 + 4 * h;
                    const f32x4 gv = *(const f32x4*)(qgain + d0);
                    const float v0 = acc[mt][4 * g4 + 0] * rstd * gv.x, v1 = acc[mt][4 * g4 + 1] * rstd * gv.y;
                    const float v2 = acc[mt][4 * g4 + 2] * rstd * gv.z, v3 = acc[mt][4 * g4 + 3] * rstd * gv.w;
                    qq += v0 * v0 + v1 * v1 + v2 * v2 + v3 * v3;
                    u32x2 o;
                    o.x = pk2(v0, v1); o.y = pk2(v2, v3);
                    *(u32x2*)(row + d0) = o;
                }
            qq = sum_x32(qq);
            if (h == 0) qnrm[(long)tok * 8 + head] = 1.01f * sqrtf(qq);
        } else if (fbase == 1024) {
#pragma unroll
            for (int rg = 0; rg < 16; ++rg) {
                const int f = crow(rg, h);
                if (f < 24) { const float z = acc[0][rg] + bgate[f]; gates[(long)tok * 24 + f] = frcp(1.f + fexp2(-LOG2E * z)); }
            }
        }
    }
};

struct EpiPeer {
    static constexpr bool STASH = false;
    int* ridx; float* rgate; int ex_off;
    DI void operator()(const f32x16 (&acc)[4], int tok, int fbase, int h, unsigned char* lds, int tid) const {
        const int lane = tid & 63, w = tid >> 6, tg = w & 3, fh = w >> 2, r = lane & 31;
        const int hd = fbase >> 8;
        unsigned* EX = (unsigned*)(lds + ex_off);
        unsigned L[16];
#pragma unroll
        for (int i = 0; i < 16; ++i) L[i] = 0u;
#pragma unroll
        for (int mt = 0; mt < 4; ++mt)
#pragma unroll
            for (int rg = 0; rg < 16; ++rg) {
                const int kidx = 32 * mt + crow(rg, h);
                unsigned x = (f2key(acc[mt][rg]) & ~127u) | (unsigned)(127 - kidx);
#pragma unroll
                for (int i = 0; i < 16; ++i) { const unsigned t = L[i] > x ? L[i] : x; x = L[i] > x ? x : L[i]; L[i] = t; }
            }
        {
            unsigned P[16];
#pragma unroll
            for (int i = 0; i < 16; ++i) P[i] = get_x32(L[i], h);
#pragma unroll
            for (int i = 0; i < 16; ++i) L[i] = L[i] > P[15 - i] ? L[i] : P[15 - i];
#pragma unroll
            for (int st = 8; st >= 1; st >>= 1)
#pragma unroll
                for (int i = 0; i < 16; ++i)
                    if ((i & st) == 0) { const unsigned a = L[i], b2 = L[i + st]; L[i] = a > b2 ? a : b2; L[i + st] = a > b2 ? b2 : a; }
        }
        if (h == 0) {
#pragma unroll
            for (int i = 0; i < 16; i += 4) *(u32x4*)(EX + ((fh * 4 + tg) * 32 + r) * 16 + i) = (u32x4){L[i], L[i + 1], L[i + 2], L[i + 3]};
        }
        __syncthreads();
        unsigned X[16], Y[16];
        {
            const unsigned* l0 = EX + ((0 * 4 + tg) * 32 + r) * 16;
            const unsigned* l1 = EX + ((1 * 4 + tg) * 32 + r) * 16;
            const unsigned* px = h ? l1 : l0;
            const unsigned* py = h ? l0 : l1;
#pragma unroll
            for (int i = 0; i < 16; i += 4) {
                const u32x4 a = *(const u32x4*)(px + i), b2 = *(const u32x4*)(py + i);
                X[i] = a.x; X[i + 1] = a.y; X[i + 2] = a.z; X[i + 3] = a.w;
                Y[i] = b2.x; Y[i + 1] = b2.y; Y[i + 2] = b2.z; Y[i + 3] = b2.w;
            }
        }
        unsigned T[16];
#pragma unroll
        for (int i = 0; i < 16; ++i) T[i] = 0u;
#pragma unroll
        for (int i = 0; i < 16; ++i)
#pragma unroll
            for (int j = i; j < 16; ++j) {
                if ((i + 1) * (j + 1) > 16) continue;
                const float fs = key2f(X[i] & ~127u) + key2f(Y[j] & ~127u);
                const unsigned code = h ? (unsigned)((j << 4) | i) : (unsigned)((i << 4) | j);
                unsigned x = (f2key(fs) & ~255u) | (255u - code);
                if (i == j) x = h ? 0u : x;
#pragma unroll
                for (int k = 0; k < 16; ++k) { const unsigned t = T[k] > x ? T[k] : x; x = T[k] > x ? x : T[k]; T[k] = t; }
            }
        {
            unsigned P[16];
#pragma unroll
            for (int i = 0; i < 16; ++i) P[i] = get_x32(T[i], h);
#pragma unroll
            for (int i = 0; i < 16; ++i) T[i] = T[i] > P[15 - i] ? T[i] : P[15 - i];
#pragma unroll
            for (int st = 8; st >= 1; st >>= 1)
#pragma unroll
                for (int i = 0; i < 16; ++i)
                    if ((i & st) == 0) { const unsigned a = T[i], b2 = T[i + st]; T[i] = a > b2 ? a : b2; T[i + st] = a > b2 ? b2 : a; }
        }
        float sc[16], sum = 0.f;
        const float mx = key2f(T[0] & ~255u);
#pragma unroll
        for (int k = 0; k < 16; ++k) { sc[k] = fexp2((key2f(T[k] & ~255u) - mx) * LOG2E); sum += sc[k]; }
        const float inv = frcp(sum);
        if (h == 0) {
            const unsigned* l0 = EX + ((0 * 4 + tg) * 32 + r) * 16;
            const unsigned* l1 = EX + ((1 * 4 + tg) * 32 + r) * 16;
#pragma unroll
            for (int k = 0; k < 16; ++k) {
                if ((k >> 3) != fh) continue;
                const unsigned code = 255u - (T[k] & 255u);
                const int i1 = 127 - (int)(l0[code >> 4] & 127u), i2 = 127 - (int)(l1[code & 15u] & 127u);
                ridx[(long)tok * 128 + hd * 16 + k] = i1 * 128 + i2;
                rgate[(long)tok * 128 + hd * 16 + k] = sc[k] * inv;
            }
        }
        __syncthreads();
    }
};

DI void p0_transpose_item(const float* __restrict__ W, int K, int N, bf16_t* __restrict__ WT, int item, int ntn, unsigned char* lds, int tid) {
    float* tile = (float*)lds;
    const int kb = item / ntn, nb = item % ntn, k0 = kb * 64, n0 = nb * 64;
    {
        const int nn = tid & 63, kk0 = tid >> 6;
#pragma unroll
        for (int i = 0; i < 8; ++i) { const int kk = kk0 + 8 * i; const int n = n0 + nn; tile[kk * 65 + nn] = n < N ? W[(long)(k0 + kk) * N + n] : 0.f; }
    }
    __syncthreads();
    {
        const int n = tid >> 3, c = tid & 7;
        const float* s = tile + (8 * c) * 65 + n;
        u32x4 o;
        o.x = pk2(s[0], s[65]); o.y = pk2(s[2 * 65], s[3 * 65]); o.z = pk2(s[4 * 65], s[5 * 65]); o.w = pk2(s[6 * 65], s[7 * 65]);
        *(u32x4*)(WT + (long)(n0 + n) * K + k0 + 8 * c) = o;
    }
    __syncthreads();
}

DI int pack_i8x4(float a, float b, float c, float d) {
    const int ia = __float2int_rn(a), ib = __float2int_rn(b), ic = __float2int_rn(c), id = __float2int_rn(d);
    return (ia & 255) | ((ib & 255) << 8) | ((ic & 255) << 16) | (id << 24);
}
DI void p0_fp8_item(const float* __restrict__ src, unsigned char* __restrict__ dst, float* __restrict__ sinv, bool sliced, int item, int tid) {
    const int lane = tid & 63, row = item * 8 + (tid >> 6);
    const float* rp = src + (long)row * 1024;
    f32x4 v[4]; float am = 0.f;
#pragma unroll
    for (int j = 0; j < 4; ++j) {
        v[j] = *(const f32x4*)(rp + 4 * lane + 256 * j);
        am = fmaxf(am, fmaxf(fmaxf(fabsf(v[j].x), fabsf(v[j].y)), fmaxf(fabsf(v[j].z), fabsf(v[j].w))));
    }
    am = wave_max(am);
    const float sc = sliced ? (am > 0.f ? exp2f(floorf(log2f(384.f / am))) : 1.f) : (am > 0.f ? 127.f / am : 1.f);
    if (lane == 0) sinv[row] = 1.f / sc;
#pragma unroll
    for (int j = 0; j < 4; ++j) {
        int pk = 0;
        if (sliced) {
            pk = __builtin_amdgcn_cvt_pk_fp8_f32(v[j].x * sc, v[j].y * sc, pk, false);
            pk = __builtin_amdgcn_cvt_pk_fp8_f32(v[j].z * sc, v[j].w * sc, pk, true);
        } else pk = pack_i8x4(v[j].x * sc, v[j].y * sc, v[j].z * sc, v[j].w * sc);
        const int col = 4 * lane + 256 * j;
        unsigned char* d = sliced ? dst + ((long)(col >> 7) * 16384 + row) * 128 + (col & 127) : dst + (long)row * 1024 + col;
        *(int*)d = pk;
    }
}

DI void p0_weff_item(const float* __restrict__ wq, const float* __restrict__ subk, bf16_t* __restrict__ WT, int item, unsigned char* lds, int tid) {
    const int layer = item >> 8, g = (item >> 4) & 15, ct = item & 15, p = g & 1, c0 = ct * 64;
    float* As = (float*)lds;
    float* Bs = As + 64 * 129;
    const float* wql = wq + (long)layer * 1024 * 2048;
    const float* sk = subk + ((long)layer * 2 + p) * 128 * 128;
    for (int e = tid; e < 64 * 128; e += NTHREADS) { const int c = e >> 7, d = e & 127; As[c * 129 + d] = wql[(long)(c0 + c) * 2048 + g * 128 + d]; }
    for (int e = tid; e < 128 * 128; e += NTHREADS) { const int k = e >> 7, d = e & 127; Bs[k * 129 + d] = sk[k * 128 + d]; }
    __syncthreads();
    const int k = tid & 127, cg4 = tid >> 7;
    float acc[16];
#pragma unroll
    for (int i = 0; i < 16; ++i) acc[i] = 0.f;
    for (int d = 0; d < 128; ++d) {
        const float bv = Bs[k * 129 + d];
#pragma unroll
        for (int i = 0; i < 16; ++i) acc[i] += As[(cg4 * 16 + i) * 129 + d] * bv;
    }
    bf16_t* o = WT + ((long)layer * 2048 + g * 128 + k) * 1024 + c0 + cg4 * 16;
    u32x4 o0, o1;
    o0.x = pk2(acc[0], acc[1]); o0.y = pk2(acc[2], acc[3]); o0.z = pk2(acc[4], acc[5]); o0.w = pk2(acc[6], acc[7]);
    o1.x = pk2(acc[8], acc[9]); o1.y = pk2(acc[10], acc[11]); o1.z = pk2(acc[12], acc[13]); o1.w = pk2(acc[14], acc[15]);
    *(u32x4*)o = o0; *(u32x4*)(o + 8) = o1;
    __syncthreads();
}

DI void p0_posb_item(const float* __restrict__ pos, const float* __restrict__ w1, float* __restrict__ part, int item, unsigned char* lds, int tid) {
    const int kv = item >> 4, ch = item & 15;
    float* red = (float*)lds;
    const int j = tid & 255, half = tid >> 8;
    const float* pp = pos + (long)kv * 4096 + ch * 256 + half * 128;
    const float* ww = w1 + ((long)kv * 4096 + ch * 256 + half * 128) * 256 + j;
    float a = 0.f;
    for (int f = 0; f < 128; ++f) a += pp[f] * ww[(long)f * 256];
    red[half * 256 + j] = a;
    __syncthreads();
    if (tid < 256) part[(kv * 16 + ch) * 256 + tid] = red[tid] + red[256 + tid];
    __syncthreads();
}

DI void p0_ada_item(const Params& p, float* __restrict__ ada, int item, unsigned char* lds, int tid) {
    float* cact = (float*)lds;
    float* red = cact + 4096;
    const float* c = p.in[1];
    for (int e = tid; e < 4096; e += NTHREADS) { const float v = c[e]; cact[e] = v * frcp(1.f + fexp2(-LOG2E * v)); }
    __syncthreads();
    const int colg = item * 64;
    const float* W; const float* bias; int N, n0;
    if (colg < 6144) { W = p.in[3]; bias = p.in[4]; N = 6144; n0 = colg; }
    else if (colg < 12288) { W = p.in[3] + (long)1024 * 6144; bias = p.in[4] + 6144; N = 6144; n0 = colg - 6144; }
    else { W = p.in[14]; bias = p.in[15]; N = 2048; n0 = colg - 12288; }
    const int col = tid & 63, kg = tid >> 6;
    float a0 = 0.f, a1 = 0.f, a2 = 0.f, a3 = 0.f;
    const float* wp = W + (long)(kg * 128) * N + n0 + col;
#pragma unroll 8
    for (int k = 0; k < 128; ++k) {
        const float wv = wp[(long)k * N];
        const int kk = kg * 128 + k;
        a0 += cact[kk] * wv; a1 += cact[1024 + kk] * wv; a2 += cact[2048 + kk] * wv; a3 += cact[3072 + kk] * wv;
    }
    red[(kg * 4 + 0) * 64 + col] = a0; red[(kg * 4 + 1) * 64 + col] = a1; red[(kg * 4 + 2) * 64 + col] = a2; red[(kg * 4 + 3) * 64 + col] = a3;
    __syncthreads();
    if (tid < 256) {
        const int b = tid >> 6, cc = tid & 63;
        float s = bias[n0 + cc];
#pragma unroll
        for (int q = 0; q < 8; ++q) s += red[(q * 4 + b) * 64 + cc];
        ada[b * ADA_STRIDE + colg + cc] = s;
    }
    __syncthreads();
}

constexpr int P0_CONV = 8192, P0_TR_DIN = 768, P0_TR_DOUT = 256, P0_TR_KV = 384, P0_TR_NIN = 288, P0_TR_NOUT = 256, P0_TR_C1 = 512, P0_TR_C2 = 16,
              P0_WEFF = 512, P0_POSB = 32, P0_ADA = 224;
constexpr int P0_TOTAL = P0_CONV + P0_TR_DIN + P0_TR_DOUT + P0_TR_KV + P0_TR_NIN + P0_TR_NOUT + P0_TR_C1 + P0_TR_C2 + P0_WEFF + P0_POSB + P0_ADA;

DI void phase_prep(const Params& p, unsigned char* lds, int tid) {
    unsigned char* ws = p.ws;
    for (int it = blockIdx.x; it < P0_TOTAL; it += gridDim.x) {
        int r = it;
        if (r < P0_ADA) { p0_ada_item(p, (float*)(ws + OFF_ADA), r, lds, tid); continue; } r -= P0_ADA;
        if (r < P0_WEFF) { p0_weff_item(p.in[26], p.in[27], (bf16_t*)(ws + OFF_WT_PEER), r, lds, tid); continue; } r -= P0_WEFF;
        if (r < P0_POSB) { p0_posb_item(p.in[17], p.in[18], (float*)(ws + OFF_POSB), r, lds, tid); continue; } r -= P0_POSB;
        if (r < P0_TR_DIN) { p0_transpose_item(p.in[7], 1024, 3072, (bf16_t*)(ws + OFF_WT_DIN), r, 48, lds, tid); continue; } r -= P0_TR_DIN;
        if (r < P0_TR_DOUT) { p0_transpose_item(p.in[8], 1024, 1024, (bf16_t*)(ws + OFF_WT_DOUT), r, 16, lds, tid); continue; } r -= P0_TR_DOUT;
        if (r < P0_TR_KV) { p0_transpose_item(p.in[16], 1024, 1536, (bf16_t*)(ws + OFF_WT_KV), r, 24, lds, tid); continue; } r -= P0_TR_KV;
        if (r < P0_TR_NIN) { p0_transpose_item(p.in[22], 1024, 1048, (bf16_t*)(ws + OFF_WT_NIN), r, 18, lds, tid); continue; } r -= P0_TR_NIN;
        if (r < P0_TR_NOUT) { p0_transpose_item(p.in[24], 1024, 1024, (bf16_t*)(ws + OFF_WT_NOUT), r, 16, lds, tid); continue; } r -= P0_TR_NOUT;
        if (r < P0_TR_C1) { const int kv = r >> 8; p0_transpose_item(p.in[18] + (long)kv * 4096 * 256, 4096, 256, (bf16_t*)(ws + OFF_WT_C1) + (long)kv * 256 * 4096, r & 255, 4, lds, tid); continue; } r -= P0_TR_C1;
        if (r < P0_TR_C2) { const int kv = r >> 3; p0_transpose_item(p.in[20] + (long)kv * 256 * 128, 256, 128, (bf16_t*)(ws + OFF_WT_C2) + (long)kv * 128 * 256, r & 7, 2, lds, tid); continue; } r -= P0_TR_C2;
        {
            const int tbl = r >> 11, sub = r & 2047;
            const int layer = tbl & 1;
            const float* src = (tbl < 2 ? p.in[28] : p.in[29]) + (long)layer * 16384 * 1024;
            unsigned char* dst = ws + (tbl < 2 ? OFF_PU : OFF_PV) + (long)layer * 16384 * 1024;
            float* sinv = (float*)(ws + (tbl < 2 ? OFF_USI : OFF_VSI)) + layer * 16384;
            p0_fp8_item(src, dst, sinv, tbl >= 2, sub, tid);
        }
    }
}

DI void norm_row_write(const f32x4 (&v)[4], float rstd, const float* gain, const float* shift, const float* scale, bf16_t* orow, int lane) {
#pragma unroll
    for (int j = 0; j < 4; ++j) {
        const int c = 4 * lane + 256 * j;
        const f32x4 g = *(const f32x4*)(gain + c), sh = *(const f32x4*)(shift + c), sc = *(const f32x4*)(scale + c);
        u32x2 o;
        o.x = pk2(v[j].x * rstd * g.x * (1.f + sc.x) + sh.x, v[j].y * rstd * g.y * (1.f + sc.y) + sh.y);
        o.y = pk2(v[j].z * rstd * g.z * (1.f + sc.z) + sh.z, v[j].w * rstd * g.w * (1.f + sc.w) + sh.w);
        *(u32x2*)(orow + c) = o;
    }
}
DI void phase_norm(const float* __restrict__ x, bf16_t* __restrict__ out, const float* gain, const float* ada, int shift_off, int scale_off, int tid) {
    const int lane = tid & 63, gw = blockIdx.x * NWAVES + (tid >> 6), nw = gridDim.x * NWAVES;
    for (int tok = gw; tok < NTOK; tok += nw) {
        const int b = tok >> 13;
        f32x4 v[4]; float ss = 0.f;
#pragma unroll
        for (int j = 0; j < 4; ++j) { v[j] = *(const f32x4*)(x + (long)tok * DM + 4 * lane + 256 * j); ss += v[j].x * v[j].x + v[j].y * v[j].y + v[j].z * v[j].z + v[j].w * v[j].w; }
        const float rstd = rsqrtf(wave_sum(ss) * (1.f / DM) + EPS);
        norm_row_write(v, rstd, gain, ada + b * ADA_STRIDE + shift_off, ada + b * ADA_STRIDE + scale_off, out + (long)tok * DM, lane);
    }
}

DI int kidx(int mt, int i) { return 32 * mt + 16 * (i >> 3) + (i & 7); }
template <int DQK>
DI void attn_qk32(const unsigned char* Ks, const bf16x8 (&qf)[DQK / 16], f32x16& st, int mt, int r, int h, float init = 0.f) {
    constexpr int RB = DQK * 2, MSK = DQK == 64 ? 7 : 15;
    const int row = 32 * mt + ((r & 0x13) | ((r & 4) << 1) | ((r & 8) >> 1));
#pragma unroll
    for (int i = 0; i < 16; ++i) st[i] = init;
#pragma unroll
    for (int ks = 0; ks < DQK / 16; ++ks) {
        const bf16x8 kf = RB == 128 ? *(const bf16x8*)(Ks + sw2(row, 2 * ks + h)) : *(const bf16x8*)(Ks + row * RB + (((2 * ks + h) ^ (row & MSK)) << 4));
        st = MFMA32(kf, qf[ks], st);
    }
}
DI void attn_pack32(const f32x16& st, bf16x8 (&pf)[2]) {
#pragma unroll
    for (int s = 0; s < 2; ++s) {
        u32x4 t;
        t.x = pk2(st[8 * s + 0], st[8 * s + 1]); t.y = pk2(st[8 * s + 2], st[8 * s + 3]);
        t.z = pk2(st[8 * s + 4], st[8 * s + 5]); t.w = pk2(st[8 * s + 6], st[8 * s + 7]);
        pf[s] = __builtin_bit_cast(bf16x8, t);
    }
}
DI void attn_softmax32(f32x16& st, float& m, float& l, f32x16 (&o)[4]) {
    float mx = st[0];
#pragma unroll
    for (int i = 1; i < 16; ++i) mx = fmaxf(mx, st[i]);
    mx = max_x32(mx);
    const float mn = fmaxf(m, mx);
    if (!__all(mn == m)) {
        const float alpha = fexp2(m - mn);
        l *= alpha;
#pragma unroll
        for (int dt = 0; dt < 4; ++dt)
#pragma unroll
            for (int i = 0; i < 16; ++i) o[dt][i] *= alpha;
        m = mn;
    }
    float sum = 0.f;
#pragma unroll
    for (int i = 0; i < 16; ++i) { const float pv = fexp2(st[i] - m); st[i] = pv; sum += pv; }
    l += sum;
}
DI void attn_softmax32_b(f32x16& st, float& l) {
    float sum = 0.f;
#pragma unroll
    for (int i = 0; i < 16; ++i) { const float pv = fexp2(st[i]); st[i] = pv; sum += pv; }
    l += sum;
}
DI void attn_pv32(const unsigned char* Vs, const bf16x8 (&pf)[2], f32x16 (&o)[4], int mt, int r, int h) {
#pragma unroll
    for (int dt = 0; dt < 4; ++dt)
#pragma unroll
        for (int s2 = 0; s2 < 2; ++s2) {
            const int row = 32 * dt + r;
            const bf16x8 vf = *(const bf16x8*)(Vs + sw2(row, 2 * (2 * mt + s2) + h));
            o[dt] = MFMA32(vf, pf[s2], o[dt]);
        }
}
template <int RB, int NROWS>
DI void dma_offsets(unsigned (&off)[NROWS * RB / 16 / 512], unsigned gstride, int tid) {
    constexpr int CPR = RB / 16;
#pragma unroll
    for (int i = 0; i < NROWS * CPR / 512; ++i) {
        const int idx = tid + 512 * i;
        int row, cp;
        if (RB == 128) sw2_src(idx, row, cp); else { row = idx / CPR; cp = (idx % CPR) ^ (row & (CPR - 1)); }
        off[i] = (unsigned)row * gstride + (cp << 4);
    }
}
template <int N>
DI void dma_issue(unsigned char* dst, const unsigned char* gbase, const unsigned (&off)[N], int tid) {
    const int wbase = tid & ~63;
#pragma unroll
    for (int i = 0; i < N; ++i)
        __builtin_amdgcn_global_load_lds((const unsigned*)(gbase + off[i]), (unsigned*)(dst + (wbase + 512 * i) * 16), 16, 0, 0);
}

constexpr int AT_STAGE = 32 * 1024;
constexpr int AT_LUT = 2 * AT_STAGE;
constexpr int LUT_N = 1280, LUT_OFF = 1100;
constexpr int LUTC_W = 52;
constexpr int AT_LUTC = AT_LUT + 20 * 1024;
constexpr int AT_IMP = AT_LUTC + 13 * 1024;
constexpr int AT_SEL = AT_IMP + 34 * 1024;

DI void phase_diff_attn(const Params& p, unsigned char* lds, int tid) {
    unsigned char* ws = p.ws;
    const bf16_t* Q = (const bf16_t*)(ws + OFF_Q0);
    const bf16_t* Kk = (const bf16_t*)(ws + OFF_K0);
    const bf16_t* VT = (const bf16_t*)(ws + OFF_VT0);
    bf16_t* O = (bf16_t*)(ws + OFF_H);
    const float* relb = p.in[2];
    const float* lam = p.in[9];
    const float* subln = p.in[12];
    const int lane = tid & 63, w = tid >> 6, comp = w & 1, qg = w >> 1, r = lane & 31, h = lane >> 5;
    float* lut = (float*)(lds + 128 * 1024);
    float lam_full;
    {
        float s01 = 0.f, s23 = 0.f;
        for (int i = 0; i < 64; ++i) { s01 += lam[i] * lam[64 + i]; s23 += lam[128 + i] * lam[192 + i]; }
        lam_full = __expf(s01) - __expf(s23) + 0.2f;
    }
    const int G = gridDim.x, rows_per_it = G >> 5;
    unsigned koff[1], voff[2];
    dma_offsets<128, 64>(koff, 128, tid);
    dma_offsets<128, 128>(voff, SEQ * 2, tid);
    constexpr int ST2 = 64 * 1024;
    for (int it = 0;; ++it) {
        int qb, b, hd;
        if (G == 256) {
            if (it >= 8) break;
            const int xcd = blockIdx.x & 7, lb = blockIdx.x >> 3, pr = xcd * 4 + (it >> 1);
            qb = (it & 1) ? lb : 63 - lb; b = pr >> 3; hd = pr & 7;
        } else {
            int u;
            if ((G & 31) == 0) {
                const int rr = blockIdx.x >> 5, cc = blockIdx.x & 31;
                const int rowi = it * rows_per_it + ((it & 1) ? rows_per_it - 1 - rr : rr);
                u = rowi * 32 + cc;
            } else u = it * G + blockIdx.x;
            if (u >= 2048) break;
            qb = 63 - (u >> 5); b = (u & 31) >> 3; hd = u & 7;
        }
        const int q0 = qb * 128, ntiles = qb + 1;
        const int qpos = q0 + 32 * qg + r, qlo = q0 + 32 * qg, qhi = qlo + 31;
        for (int e = tid; e < LUT_N; e += NTHREADS) { const int d = LUT_OFF - e; lut[e] = d < 0 ? -INFINITY : (d >= 790 ? 0.f : (relb[rel_bucket_i(d) * 8 + hd] - relb[31 * 8 + hd]) * LOG2E); }
        bf16x8 qf[4];
        {
            const bf16_t* qrow = Q + ((long)((b * 8 + hd) * 2 + comp) * SEQ + qpos) * 64;
#pragma unroll
            for (int ks = 0; ks < 4; ++ks) qf[ks] = *(const bf16x8*)(qrow + 16 * ks + 8 * h);
        }
        const unsigned char* k0g = (const unsigned char*)(Kk + (long)((b * 8 + hd) * 2 + 0) * SEQ * 64);
        const unsigned char* k1g = (const unsigned char*)(Kk + (long)((b * 8 + hd) * 2 + 1) * SEQ * 64);
        const unsigned char* vtg = (const unsigned char*)(VT + (long)(b * 8 + hd) * 128 * SEQ);
        f32x16 o[4];
#pragma unroll
        for (int dt = 0; dt < 4; ++dt)
#pragma unroll
            for (int i = 0; i < 16; ++i) o[dt][i] = 0.f;
        float l = 0.f;
        const float nmb = -((const float*)(ws + OFF_MB0))[(long)((b * 8 + hd) * 2 + comp) * SEQ + qpos];
        auto stage = [&](int kt, unsigned char* st) {
#pragma unroll
            for (int sb = 0; sb < 2; ++sb) {
                dma_issue(st + sb * 8192, k0g + (long)(2 * kt + sb) * 8192, koff, tid);
                dma_issue(st + 16384 + sb * 8192, k1g + (long)(2 * kt + sb) * 8192, koff, tid);
                dma_issue(st + 32768 + sb * 16384, vtg + (long)(2 * kt + sb) * 128, voff, tid);
            }
        };
        stage(0, lds);
        __syncthreads();
        for (int kt = 0; kt < ntiles; ++kt) {
            unsigned char* cur = lds + (kt & 1) * ST2;
            if (kt + 1 < ntiles) stage(kt + 1, lds + ((kt + 1) & 1) * ST2);
            const bool nearb = qlo - (kt * 128 + 127) < 790;
            const int dbase0 = qpos - kt * 128 - 8 * h;
            const unsigned char* kb = cur + comp * 16384;
            f32x16 sa, sbv;
            attn_qk32<64>(kb, qf, sa, 0, r, h, nmb);
#pragma unroll
            for (int j = 0; j < 4; ++j) {
                f32x16& sc = (j & 1) ? sbv : sa;
                f32x16& sn = (j & 1) ? sa : sbv;
                if (j < 3) attn_qk32<64>(kb + ((j + 1) >> 1) * 8192, qf, sn, (j + 1) & 1, r, h, nmb);
                if (nearb) {
                    const float* lp = lut + (LUT_OFF - dbase0 + 64 * (j >> 1));
#pragma unroll
                    for (int i = 0; i < 16; ++i) sc[i] += lp[kidx(j & 1, i)];
                }
                attn_softmax32_b(sc, l);
                bf16x8 pf[2];
                attn_pack32(sc, pf);
                attn_pv32(cur + 32768 + (j >> 1) * 16384, pf, o, j & 1, r, h);
            }
            __syncthreads();
        }
        l = sum_x32(l);
        const float inv = l > 0.f ? frcp(l) : 0.f;
        float* xch = (float*)lds + qg * 4096;
        if (comp == 1) {
            const float sc = inv * lam_full;
#pragma unroll
            for (int dt = 0; dt < 4; ++dt)
#pragma unroll
                for (int i = 0; i < 16; ++i) xch[(dt * 16 + i) * 64 + lane] = o[dt][i] * sc;
        }
        __syncthreads();
        if (comp == 0) {
            float ss = 0.f;
#pragma unroll
            for (int dt = 0; dt < 4; ++dt)
#pragma unroll
                for (int i = 0; i < 16; ++i) { const float v = o[dt][i] * inv - xch[(dt * 16 + i) * 64 + lane]; o[dt][i] = v; ss += v * v; }
            ss = sum_x32(ss);
            const float rstd = rsqrtf(ss * (1.f / 128.f) + EPS) * 0.8f;
            bf16_t* orow = O + (long)(b * SEQ + qpos) * DM + hd * 128;
#pragma unroll
            for (int dt = 0; dt < 4; ++dt)
#pragma unroll
                for (int g4 = 0; g4 < 4; ++g4) {
                    const int d0 = 32 * dt + 8 * g4 + 4 * h;
                    const f32x4 gv = *(const f32x4*)(subln + d0);
                    u32x2 ov;
                    ov.x = pk2(o[dt][4 * g4 + 0] * rstd * gv.x, o[dt][4 * g4 + 1] * rstd * gv.y);
                    ov.y = pk2(o[dt][4 * g4 + 2] * rstd * gv.z, o[dt][4 * g4 + 3] * rstd * gv.w);
                    *(u32x2*)(orow + d0) = ov;
                }
        }
        __syncthreads();
    }
}

template <int VAR>
DI void phase_nsa_attn(const Params& p, unsigned char* lds, int tid) {
    unsigned char* ws = p.ws;
    const bf16_t* QN = (const bf16_t*)(ws + OFF_QN);
    const bf16_t* KS = (const bf16_t*)(ws + OFF_KS);
    const bf16_t* VST = (const bf16_t*)(ws + OFF_VST);
    const bf16_t* KW = (const bf16_t*)(ws + OFF_KW);
    const bf16_t* VWT = (const bf16_t*)(ws + OFF_VWT);
    const bf16_t* KCMP = (const bf16_t*)(ws + OFF_KCMP);
    const bf16_t* VCMPT = (const bf16_t*)(ws + OFF_VCMPT);
    const float* gates = (const float*)(ws + OFF_GATES);
    bf16_t* O = VAR ? (bf16_t*)(ws + OFF_PU + 32 * MB) : (bf16_t*)(ws + OFF_H);
    const float* relb = p.in[2];
    const int lane = tid & 63, w = tid >> 6, hg = w >> 1, th = w & 1, r = lane & 31, h = lane >> 5;
    float* lut = (float*)(lds + AT_LUT);
    float* lutc = (float*)(lds + AT_LUTC);
    float* imp = (float*)(lds + AT_IMP);
    unsigned* selw = (unsigned*)(lds + AT_SEL);
    unsigned short* sel16 = (unsigned short*)selw;
    float* bmxs = (float*)(selw + 264);
    const float* qnrm = (const float*)(ws + OFF_MB1);
    float kmx[3];
    for (int br = 0; br < 3; ++br) { float mx = 0.f; for (int d = 0; d < 128; ++d) mx = fmaxf(mx, fabsf(p.in[21][br * 128 + d])); kmx[br] = mx * 11.313708498984761f; }
    const int G = gridDim.x, rows_per_it = G >> 3;
    int lut_g = -1;
    for (int it = 0;; ++it) {
        int u;
        if ((G & 7) == 0) {
            const int rr = blockIdx.x >> 3, cc = blockIdx.x & 7;
            const int rowi = it * rows_per_it + ((it & 1) ? rows_per_it - 1 - rr : rr);
            u = rowi * 8 + cc;
        } else u = it * G + blockIdx.x;
        if (u >= 1024) break;
        const int bi = 127 - (u >> 3), b = (u & 7) >> 1, g = u & 1, head = 4 * g + hg;
        const int tq = 64 * bi + 32 * th + r;
        const int tl = 32 * th + r;
        const long tok = (long)b * SEQ + tq;
        if (g != lut_g) {
            lut_g = g;
            if (tid < 4) { float bm = 0.f; for (int bk = 0; bk < 32; ++bk) bm = fmaxf(bm, relb[bk * 8 + 4 * g + tid] - relb[31 * 8 + 4 * g + tid]); bmxs[tid] = bm * LOG2E; }
            for (int e = tid; e < 4 * LUT_N; e += NTHREADS) { const int hh = e / LUT_N, d = LUT_OFF - (e % LUT_N); lut[e] = d < 0 ? -INFINITY : (d >= 790 ? 0.f : (relb[rel_bucket_i(d) * 8 + 4 * g + hh] - relb[31 * 8 + 4 * g + hh]) * LOG2E); }
            for (int e = tid; e < 4 * 16 * LUTC_W; e += NTHREADS) {
                const int hh = e / (16 * LUTC_W), ph = (e / LUTC_W) & 15, ci = e % LUTC_W, d = 16 * (ci - 1) + ph;
                lutc[e] = ci == 0 ? -INFINITY : (d >= 790 ? 0.f : (relb[rel_bucket_i(d) * 8 + 4 * g + hh] - relb[31 * 8 + 4 * g + hh]) * LOG2E);
            }
        }
        if (tid < 4) selw[256 + tid] = 0u;
        const float* mylut = lut + hg * LUT_N;
        bf16x8 qf[8];
        const bf16_t* qrow = QN + ((long)(b * 8 + head) * SEQ + tq) * 128 + 8 * h;
        auto load_q = [&](const bf16_t* qr) {
#pragma unroll
            for (int ks = 0; ks < 8; ++ks) qf[ks] = *(const bf16x8*)(qr + 16 * ks);
        };
        const float* gp = gates + tok * 24 + head * 3;
        bf16_t* orow = O + (VAR ? (tok & 16383) : tok) * DM + head * 128;
        auto stage = [&](const unsigned char* kg, const unsigned char* vg, unsigned vstride, int kt, unsigned char* st) {
            int t2 = tid; asm volatile("" : "+v"(t2));
            unsigned koff[2], vo[2];
            dma_offsets<256, 64>(koff, 256, t2);
            dma_offsets<128, 128>(vo, vstride, t2);
            dma_issue(st, kg + (long)kt * 16384, koff, t2);
            dma_issue(st + 16384, vg + (long)kt * 128, vo, t2);
        };
        f32x16 o[4];
        float l;
        auto reset = [&]() {
#pragma unroll
            for (int dt = 0; dt < 4; ++dt)
#pragma unroll
                for (int i = 0; i < 16; ++i) o[dt][i] = 0.f;
            l = 0.f;
        };
        const unsigned char* kcg = (const unsigned char*)(KCMP + (long)(b * 2 + g) * 512 * 128);
        const unsigned char* vcg = (const unsigned char*)(VCMPT + (long)(b * 2 + g) * 128 * 512);
        const int nct = ((4 * bi + 2) >> 6) + 1;
        const int hgc = r & 3, tlc = 8 * w + (r >> 2), tqc = 64 * bi + tlc;
        const long tokc = (long)b * SEQ + tqc;
        reset();
        load_q(QN + ((long)(b * 8 + 4 * g + hgc) * SEQ + tqc) * 128 + 8 * h);
        __syncthreads();
        if (VAR != 3) {
            const int cb = (tqc - 31) >> 4;
            const float* lc = lutc + (hgc * 16 + ((tqc - 31) & 15)) * LUTC_W + 1;
            const float nmb = -(qnrm[tokc * 8 + 4 * g + hgc] * kmx[0] + bmxs[hgc]);
            stage(kcg, vcg, 1024u, 0, lds);
            __syncthreads();
            for (int kt = 0; kt < nct; ++kt) {
                unsigned char* cur = lds + (kt & 1) * AT_STAGE;
                if (kt + 1 < nct) stage(kcg, vcg, 1024u, kt + 1, lds + ((kt + 1) & 1) * AT_STAGE);
                const int cbase = cb - kt * 64 - 8 * h;
#pragma unroll
                for (int mt = 0; mt < 2; ++mt) {
                    f32x16 st;
                    attn_qk32<128>(cur, qf, st, mt, r, h, nmb);
                    float sum = 0.f;
#pragma unroll
                    for (int i = 0; i < 16; ++i) {
                        const int c = cbase - kidx(mt, i);
                        sum += fexp2(st[i] + lc[c < -1 ? -1 : (c > 50 ? 50 : c)]);
                    }
                    l += sum;
                }
                __syncthreads();
            }
            const float lt = sum_x32(l);
            const float invl = lt > 0.f ? frcp(lt) : 0.f;
            stage(kcg, vcg, 1024u, 0, lds);
            __syncthreads();
            float carry = 0.f;
            for (int kt = 0; kt < nct; ++kt) {
                unsigned char* cur = lds + (kt & 1) * AT_STAGE;
                if (kt + 1 < nct) stage(kcg, vcg, 1024u, kt + 1, lds + ((kt + 1) & 1) * AT_STAGE);
                const int cbase = cb - kt * 64 - 8 * h;
                float o0[4], o1[4], sp[4];
#pragma unroll
                for (int mt = 0; mt < 2; ++mt) {
                    f32x16 st;
                    attn_qk32<128>(cur, qf, st, mt, r, h, nmb);
#pragma unroll
                    for (int i = 0; i < 16; ++i) {
                        const int c = cbase - kidx(mt, i);
                        st[i] = fexp2(st[i] + lc[c < -1 ? -1 : (c > 50 ? 50 : c)]) * invl;
                    }
#pragma unroll
                    for (int gq = 0; gq < 2; ++gq) {
                        const int G2 = 2 * mt + gq, q0 = 2 * gq, q1 = 2 * gq + 1;
                        const float c20 = 0.5f * st[4 * q0 + 3];
                        o0[G2] = st[4 * q0] + st[4 * q0 + 1] + st[4 * q0 + 2] + c20;
                        o1[G2] = st[4 * q1] + st[4 * q1 + 1] + st[4 * q1 + 2] + 0.5f * st[4 * q1 + 3] + c20;
                        sp[G2] = 0.5f * st[4 * q1 + 3];
                    }
                    bf16x8 pf[2];
                    attn_pack32(st, pf);
                    attn_pv32(cur + 16384, pf, o, mt, r, h);
                }
                float rc[4];
#pragma unroll
                for (int G2 = 0; G2 < 4; ++G2) rc[G2] = __uint_as_float(get_x32(__float_as_uint(sp[G2]), h));
                if (h) {
#pragma unroll
                    for (int G2 = 0; G2 < 4; ++G2) o0[G2] += rc[G2];
                } else {
                    o0[0] += carry; o0[1] += rc[0]; o0[2] += rc[1]; o0[3] += rc[2];
                    carry = rc[3];
                }
#pragma unroll
                for (int G2 = 0; G2 < 4; ++G2) {
                    float a0 = o0[G2], a1 = o1[G2];
                    a0 += lx1(a0); a0 += lx2(a0); a1 += lx1(a1); a1 += lx2(a1);
                    if (hgc == 0) *(f32x2*)(imp + tlc * 130 + kt * 16 + 4 * G2 + 2 * h) = (f32x2){a0, a1};
                }
                __syncthreads();
            }
        }
        {
            const float g_c = gates[tokc * 24 + (4 * g + hgc) * 3];
            bf16_t* orc = O + (VAR ? (tokc & 16383) : tokc) * DM + (4 * g + hgc) * 128;
#pragma unroll
            for (int dt = 0; dt < 4; ++dt)
#pragma unroll
                for (int g4 = 0; g4 < 4; ++g4) {
                    const int d0 = 32 * dt + 8 * g4 + 4 * h;
                    u32x2 ov;
                    ov.x = pk2(o[dt][4 * g4 + 0] * g_c, o[dt][4 * g4 + 1] * g_c);
                    ov.y = pk2(o[dt][4 * g4 + 2] * g_c, o[dt][4 * g4 + 3] * g_c);
                    *(u32x2*)(orc + d0) = ov;
                }
        }
        if (VAR != 5) {
            const int tkn = tid >> 3, part = tid & 7;
            unsigned key[16];
#pragma unroll
            for (int q = 0; q < 16; ++q) {
                const int j = part * 16 + q;
                float v = imp[tkn * 130 + j];
                const int back = bi - j;
                if (j == 0 || (back >= 0 && back < 2)) v = 1e9f;
                if (back < 0) v = -1e30f;
                key[q] = f2key(v);
            }
            auto sum8 = [&](int c) -> int {
                c += __builtin_amdgcn_update_dpp(0, c, 0xB1, 0xF, 0xF, true);
                c += __builtin_amdgcn_update_dpp(0, c, 0x4E, 0xF, 0xF, true);
                c += __builtin_amdgcn_update_dpp(0, c, 0x141, 0xF, 0xF, true);
                return c;
            };
            unsigned T = 0u;
#pragma unroll 4
            for (int bit = 31; bit >= 0; --bit) {
                const unsigned cand = T | (1u << bit);
                int c = 0;
#pragma unroll
                for (int q = 0; q < 16; ++q) c += key[q] >= cand ? 1 : 0;
                if (sum8(c) >= 16) T = cand;
            }
            int cg = 0, ce = 0;
#pragma unroll
            for (int q = 0; q < 16; ++q) { cg += key[q] > T ? 1 : 0; ce += key[q] == T ? 1 : 0; }
            const int need = 16 - sum8(cg);
            int pre = ce;
            { int t = __builtin_amdgcn_update_dpp(0, pre, 0x111, 0xF, 0xF, true); if (part >= 1) pre += t; }
            { int t = __builtin_amdgcn_update_dpp(0, pre, 0x112, 0xF, 0xF, true); if (part >= 2) pre += t; }
            { int t = __builtin_amdgcn_update_dpp(0, pre, 0x114, 0xF, 0xF, true); if (part >= 4) pre += t; }
            int before = pre - ce;
            unsigned bits = 0;
#pragma unroll
            for (int q = 0; q < 16; ++q) {
                const bool eq = key[q] == T;
                const bool selq = key[q] > T || (eq && before < need);
                before += eq ? 1 : 0;
                bits |= (selq && key[q] >= 0x80000000u) ? (1u << q) : 0u;
            }
            sel16[tkn * 8 + part] = (unsigned short)bits;
            atomicOr(&selw[256 + (part >> 1)], bits << ((part & 1) * 16));
        }
        __syncthreads();
        const unsigned un0 = selw[256], un1 = selw[257], un2 = selw[258], un3 = selw[259];
        const unsigned char* ksg = (const unsigned char*)(KS + (long)(b * 2 + g) * SEQ * 128);
        const unsigned char* vsg = (const unsigned char*)(VST + (long)(b * 2 + g) * 128 * SEQ);
        reset(); load_q(qrow);
        const float qn_main = qnrm[tok * 8 + head];
        {
            const float nmb = -(qn_main * kmx[1] + bmxs[hg]);
            const unsigned long long ulo = ((unsigned long long)(unsigned)__builtin_amdgcn_readfirstlane((int)un1) << 32) | (unsigned)__builtin_amdgcn_readfirstlane((int)un0);
            const unsigned long long uhi = ((unsigned long long)(unsigned)__builtin_amdgcn_readfirstlane((int)un3) << 32) | (unsigned)__builtin_amdgcn_readfirstlane((int)un2);
            auto next_tile = [&](int from) -> int {
                if (from < 64) { const unsigned long long mk = ulo >> from; if (mk) return from + __builtin_ctzll(mk); from = 64; }
                if (from < 128) { const unsigned long long mk = uhi >> (from - 64); if (mk) return from + __builtin_ctzll(mk); }
                return 128;
            };
            int jt = (VAR == 1 || VAR == 4 || VAR == 5) ? 128 : next_tile(0);
            int buf = 0;
            if (jt < 128) stage(ksg, vsg, SEQ * 2u, jt, lds);
            __syncthreads();
            while (jt < 128) {
                unsigned char* cur = lds + buf * AT_STAGE;
                const int jn = next_tile(jt + 1);
                if (jn < 128) stage(ksg, vsg, SEQ * 2u, jn, lds + (buf ^ 1) * AT_STAGE);
                const unsigned wd = selw[tl * 4 + (jt >> 5)];
                const bool mysel = (wd >> (jt & 31)) & 1u;
                if (__any(mysel)) {
                    const int k0 = jt * 64;
                    const bool nearb = (64 * bi + 32 * th) - (k0 + 63) < 790;
                    const int dbase = tq - k0 - 8 * h;
                    const float* lp = mylut + (LUT_OFF - dbase);
#pragma unroll
                    for (int mt = 0; mt < 2; ++mt) {
                        f32x16 st;
                        attn_qk32<128>(cur, qf, st, mt, r, h, mysel ? nmb : -INFINITY);
                        if (nearb) {
#pragma unroll
                            for (int i = 0; i < 16; ++i) st[i] += lp[kidx(mt, i)];
                        }
                        attn_softmax32_b(st, l);
                        bf16x8 pf[2];
                        attn_pack32(st, pf);
                        attn_pv32(cur + 16384, pf, o, mt, r, h);
                    }
                }
                __syncthreads();
                buf ^= 1; jt = jn;
            }
        }
        {
            const float lt = sum_x32(l);
            const float sc = (lt > 0.f ? frcp(lt) : 0.f) * gp[1];
#pragma unroll
            for (int dt = 0; dt < 4; ++dt)
#pragma unroll
                for (int g4 = 0; g4 < 4; ++g4) {
                    const int d0 = 32 * dt + 8 * g4 + 4 * h;
                    const u32x2 pv = *(const u32x2*)(orow + d0);
                    u32x2 ov;
                    ov.x = pk2(bflo(pv.x) + o[dt][4 * g4 + 0] * sc, bfhi(pv.x) + o[dt][4 * g4 + 1] * sc);
                    ov.y = pk2(bflo(pv.y) + o[dt][4 * g4 + 2] * sc, bfhi(pv.y) + o[dt][4 * g4 + 3] * sc);
                    *(u32x2*)(orow + d0) = ov;
                }
        }
        const unsigned char* kwg = (const unsigned char*)(KW + (long)(b * 2 + g) * SEQ * 128);
        const unsigned char* vwg = (const unsigned char*)(VWT + (long)(b * 2 + g) * 128 * SEQ);
        reset(); load_q(qrow);
        {
            const float nmb = -(qn_main * kmx[2] + bmxs[hg]);
            const int j0 = bi >= 8 ? bi - 8 : 0, nt = (VAR == 2 || VAR == 4 || VAR == 5) ? 1 : bi - j0 + 1;
            stage(kwg, vwg, SEQ * 2u, j0, lds);
            __syncthreads();
            for (int kt = 0; kt < nt; ++kt) {
                unsigned char* cur = lds + (kt & 1) * AT_STAGE;
                if (kt + 1 < nt) stage(kwg, vwg, SEQ * 2u, j0 + kt + 1, lds + ((kt + 1) & 1) * AT_STAGE);
                const int k0 = (j0 + kt) * 64;
                const int dbase = tq - k0 - 8 * h;
                const float* lp = mylut + (LUT_OFF - dbase);
#pragma unroll
                for (int mt = 0; mt < 2; ++mt) {
                    f32x16 st;
                    attn_qk32<128>(cur, qf, st, mt, r, h, nmb);
#pragma unroll
                    for (int i = 0; i < 16; ++i) st[i] = kidx(mt, i) <= dbase - 512 ? -INFINITY : st[i] + lp[kidx(mt, i)];
                    attn_softmax32_b(st, l);
                    bf16x8 pf[2];
                    attn_pack32(st, pf);
                    attn_pv32(cur + 16384, pf, o, mt, r, h);
                }
                __syncthreads();
            }
        }
        {
            const float lt = sum_x32(l);
            const float sc = (lt > 0.f ? frcp(lt) : 0.f) * gp[2];
#pragma unroll
            for (int dt = 0; dt < 4; ++dt)
#pragma unroll
                for (int g4 = 0; g4 < 4; ++g4) {
                    const int d0 = 32 * dt + 8 * g4 + 4 * h;
                    const u32x2 pv = *(const u32x2*)(orow + d0);
                    u32x2 ov;
                    ov.x = pk2(bflo(pv.x) + o[dt][4 * g4 + 0] * sc, bfhi(pv.x) + o[dt][4 * g4 + 1] * sc);
                    ov.y = pk2(bflo(pv.y) + o[dt][4 * g4 + 2] * sc, bfhi(pv.y) + o[dt][4 * g4 + 3] * sc);
                    *(u32x2*)(orow + d0) = ov;
                }
        }
        __syncthreads();
    }
}

DI void fp8x16_fma(const u32x4& q, const f32x4& h0, const f32x4& h1, const f32x4& h2, const f32x4& h3, f32x2& a0, f32x2& a1) {
    a0 += __builtin_amdgcn_cvt_pk_f32_fp8((int)q.x, false) * (f32x2){h0.x, h0.y};
    a1 += __builtin_amdgcn_cvt_pk_f32_fp8((int)q.x, true)  * (f32x2){h0.z, h0.w};
    a0 += __builtin_amdgcn_cvt_pk_f32_fp8((int)q.y, false) * (f32x2){h1.x, h1.y};
    a1 += __builtin_amdgcn_cvt_pk_f32_fp8((int)q.y, true)  * (f32x2){h1.z, h1.w};
    a0 += __builtin_amdgcn_cvt_pk_f32_fp8((int)q.z, false) * (f32x2){h2.x, h2.y};
    a1 += __builtin_amdgcn_cvt_pk_f32_fp8((int)q.z, true)  * (f32x2){h2.z, h2.w};
    a0 += __builtin_amdgcn_cvt_pk_f32_fp8((int)q.w, false) * (f32x2){h3.x, h3.y};
    a1 += __builtin_amdgcn_cvt_pk_f32_fp8((int)q.w, true)  * (f32x2){h3.z, h3.w};
}
template <bool DRY>
DI void phase_peer_u(const Params& p, int layer, unsigned char* lds, int tid) {
    unsigned char* ws = p.ws;
    const bf16_t* H = (const bf16_t*)(ws + OFF_H);
    const int* ridx = (const int*)(ws + OFF_RIDX);
    float* rgate = (float*)(ws + OFF_RGATE);
    const unsigned char* U = ws + OFF_PU + (long)layer * 16384 * 1024;
    const float* usi = (const float*)(ws + OFF_USI) + layer * 16384;
    const float* vsi = (const float*)(ws + OFF_VSI) + layer * 16384;
    const int lane = tid & 63, w = tid >> 6, sub = lane & 7, grp = lane >> 3;
    const int xg = blockIdx.x & 7, lb = blockIdx.x >> 3, nwv = (gridDim.x >> 3) * NWAVES, wv = lb * NWAVES + w;
    unsigned* clb = (unsigned*)(lds + w * 12288);
    unsigned char* hbb = lds + w * 12288 + 2048;
    const unsigned long long lt = (1ull << lane) - 1ull;
    if (lb >= (int)(gridDim.x >> 3)) return;
    int i0, i1; u32x4 h0, h1;
    auto ld_tok = [&](int tk) {
        tk = tk < NTOK ? tk : wv;
        i0 = ridx[(long)tk * 128 + lane]; i1 = ridx[(long)tk * 128 + 64 + lane];
        h0 = *(const u32x4*)(H + (long)tk * DM + lane * 16); h1 = *(const u32x4*)(H + (long)tk * DM + lane * 16 + 8);
    };
    auto stage_tok = [&](int bi, float& hsinv) -> int {
        unsigned* cl = clb + bi * 256; unsigned char* hb = hbb + bi * 4096;
        const bool b0 = (i0 >> 11) == xg, b1 = (i1 >> 11) == xg;
        const unsigned long long m0 = __ballot(b0), m1 = __ballot(b1);
        const int n0 = __popcll(m0), n = n0 + __popcll(m1);
        if (b0) { const int k = __popcll(m0 & lt); cl[2 * k] = lane; cl[2 * k + 1] = i0; }
        if (b1) { const int k = n0 + __popcll(m1 & lt); cl[2 * k] = 64 + lane; cl[2 * k + 1] = i1; }
        if (n == 0 && lane == 0) { cl[0] = 0u; cl[1] = 0u; }
        float hv[16];
        hv[0] = bflo(h0.x); hv[1] = bfhi(h0.x); hv[2] = bflo(h0.y); hv[3] = bfhi(h0.y); hv[4] = bflo(h0.z); hv[5] = bfhi(h0.z); hv[6] = bflo(h0.w); hv[7] = bfhi(h0.w);
        hv[8] = bflo(h1.x); hv[9] = bfhi(h1.x); hv[10] = bflo(h1.y); hv[11] = bfhi(h1.y); hv[12] = bflo(h1.z); hv[13] = bfhi(h1.z); hv[14] = bflo(h1.w); hv[15] = bfhi(h1.w);
        float am = 0.f;
#pragma unroll
        for (int q = 0; q < 16; ++q) am = fmaxf(am, fabsf(hv[q]));
        am = wave_max(am);
        const float sc = am > 0.f ? 127.f / am : 1.f;
        hsinv = am > 0.f ? am * (1.f / 127.f) : 1.f;
        u32x4 o;
        o.x = (unsigned)pack_i8x4(hv[0] * sc, hv[1] * sc, hv[2] * sc, hv[3] * sc); o.y = (unsigned)pack_i8x4(hv[4] * sc, hv[5] * sc, hv[6] * sc, hv[7] * sc);
        o.z = (unsigned)pack_i8x4(hv[8] * sc, hv[9] * sc, hv[10] * sc, hv[11] * sc); o.w = (unsigned)pack_i8x4(hv[12] * sc, hv[13] * sc, hv[14] * sc, hv[15] * sc);
        *(u32x4*)(hb + lane * 16) = o;
        return n;
    };
    float shC, shN = 1.f;
    ld_tok(wv);
    int nC = stage_tok(0, shC);
    ld_tok(wv + nwv);
    int slotC, idC; bool validC;
    { validC = grp < nC; const int kk = validC ? grp : 0; slotC = clb[2 * kk]; idC = clb[2 * kk + 1]; }
    u32x4 uv[8];
    {
        const unsigned uoff = (unsigned)idC * 1024u + (unsigned)sub * 16u;
#pragma unroll
        for (int t = 0; t < 8; ++t) uv[t] = *(const u32x4*)(U + (uoff + t * 128));
    }
    int it = 0;
    for (int tok = wv; tok < NTOK; tok += nwv, ++it) {
        const int cb = it & 1;
        const unsigned* clC = clb + cb * 256; const unsigned* clN = clb + (cb ^ 1) * 256;
        const unsigned char* hbC = hbb + cb * 4096;
        const bool more = tok + nwv < NTOK;
        int nN = 0;
        if (more) { nN = stage_tok(cb ^ 1, shN); ld_tok(tok + 2 * nwv); }
        const int nr = nC > 8 ? (nC + 7) >> 3 : 1;
        u32x4 hq[8];
#pragma unroll
        for (int t = 0; t < 8; ++t) hq[t] = *(const u32x4*)(hbC + (sub + 8 * t) * 16);
        for (int rd = 0; rd < nr; ++rd) {
            float g_in = 0.f, su = 0.f, sv = 0.f;
            if (validC && sub == 0) { g_in = rgate[(long)tok * 128 + slotC]; su = usi[idC]; sv = vsi[idC]; }
            int slotN, idN; bool validN;
            if (rd + 1 < nr) { const int k = 8 * (rd + 1) + grp; validN = k < nC; const int kk = validN ? k : 0; slotN = clC[2 * kk]; idN = clC[2 * kk + 1]; }
            else if (more) { validN = grp < nN; const int kk = validN ? grp : 0; slotN = clN[2 * kk]; idN = clN[2 * kk + 1]; }
            else { validN = false; slotN = 0; idN = clC[1]; }
            const unsigned uoffN = (unsigned)idN * 1024u + (unsigned)sub * 16u;
            int a0 = 0, a1 = 0, a2 = 0, a3 = 0;
#pragma unroll
            for (int t = 0; t < 8; ++t) {
                const u32x4 q = uv[t];
                a0 = __builtin_amdgcn_sdot4((int)q.x, (int)hq[t].x, a0, false); a1 = __builtin_amdgcn_sdot4((int)q.y, (int)hq[t].y, a1, false);
                a2 = __builtin_amdgcn_sdot4((int)q.z, (int)hq[t].z, a2, false); a3 = __builtin_amdgcn_sdot4((int)q.w, (int)hq[t].w, a3, false);
                uv[t] = *(const u32x4*)(U + (uoffN + t * 128));
            }
            int di = (a0 + a1) + (a2 + a3);
            di += __builtin_amdgcn_update_dpp(0, di, 0xB1, 0xF, 0xF, true);
            di += __builtin_amdgcn_update_dpp(0, di, 0x4E, 0xF, 0xF, true);
            di += __builtin_amdgcn_update_dpp(0, di, 0x141, 0xF, 0xF, true);
            if (validC && sub == 0) {
                float* gw = DRY ? (float*)(ws + OFF_R) + (long)tok * 128 + slotC : rgate + (long)tok * 128 + slotC;
                *gw = g_in * gelu_tanh((float)di * su * shC) * sv;
            }
            slotC = slotN; idC = idN; validC = validN;
        }
        nC = nN; shC = shN;
    }
}

#ifndef VMASK
#define VMASK 0xffffffffu
#endif
template <bool DRY>
DI void phase_peer_v(const Params& p, int layer, int tid) {
    unsigned char* ws = p.ws;
    const int* ridx = (const int*)(ws + OFF_RIDX);
    const float* wact = (const float*)(ws + OFF_RGATE);
    const float* ada = (const float*)(ws + OFF_ADA);
    float* x = opq(p.out);
    const int lane = tid & 63, w = tid >> 6, sub = lane & 7, eg = lane >> 3;
    const int xg = blockIdx.x & 7, lb = blockIdx.x >> 3, nwv = (gridDim.x >> 3) * NWAVES, wv = lb * NWAVES + w;
    if (lb >= (int)(gridDim.x >> 3)) return;
    const unsigned char* Vc = ws + OFF_PV + ((long)(layer * 8 + xg) * 16384) * 128;
    const int col0 = 128 * xg + 16 * sub;
    const __amdgpu_buffer_rsrc_t vrs = __builtin_amdgcn_make_buffer_rsrc((void*)Vc, (short)0, 16384 * 128, 0x00020000);
    auto ld_ids = [&](int tk, u32x4 (&a)[4], f32x4 (&wq)[4]) {
        tk = tk < NTOK ? tk : wv;
        const u32x4* ip = (const u32x4*)(ridx + (long)tk * 128 + eg * 16);
        const f32x4* wp = (const f32x4*)(wact + (long)tk * 128 + eg * 16);
#pragma unroll
        for (int q = 0; q < 4; ++q) { a[q] = ip[q]; wq[q] = wp[q]; }
    };
    u32x4 vv[16];
    u32x4 na[4], pa[4]; f32x4 cw[4], nw[4], pw[4];
    {
        u32x4 a[4];
        ld_ids(wv, a, cw);
#pragma unroll
        for (int j = 0; j < 16; ++j)
            vv[j] = __builtin_bit_cast(u32x4, __builtin_amdgcn_raw_buffer_load_b128(vrs, (int)((a[j >> 2][j & 3] & (DRY ? VMASK : 0xffffffffu)) * 128u + (unsigned)sub * 16u), 0, 0));
    }
    ld_ids(wv + nwv, na, nw);
    f32x4 gfv[4]; int gb = -1;
    for (int tok = wv; tok < NTOK; tok += nwv) {
        ld_ids(tok + 2 * nwv, pa, pw);
        f32x4 xv[4];
        {
            const float* xin = x + (long)tok * DM + col0;
#pragma unroll
            for (int c = 0; c < 4; ++c) xv[c] = *(const f32x4*)(xin + 4 * c);
            const int b = tok >> 13;
            if (b != gb) {
                gb = b;
                const float* gf = ada + b * ADA_STRIDE + layer * 6144 + 5 * 1024 + col0;
#pragma unroll
                for (int c = 0; c < 4; ++c) gfv[c] = *(const f32x4*)(gf + 4 * c);
            }
        }
        f32x2 ap[8];
#pragma unroll
        for (int i = 0; i < 8; ++i) ap[i] = (f32x2){0.f, 0.f};
#pragma unroll
        for (int j = 0; j < 16; ++j) {
            const float ws1 = cw[j >> 2][j & 3]; const f32x2 ww = {ws1, ws1}; const u32x4 v = vv[j];
            ap[0] += __builtin_amdgcn_cvt_pk_f32_fp8((int)v.x, false) * ww; ap[1] += __builtin_amdgcn_cvt_pk_f32_fp8((int)v.x, true) * ww;
            ap[2] += __builtin_amdgcn_cvt_pk_f32_fp8((int)v.y, false) * ww; ap[3] += __builtin_amdgcn_cvt_pk_f32_fp8((int)v.y, true) * ww;
            ap[4] += __builtin_amdgcn_cvt_pk_f32_fp8((int)v.z, false) * ww; ap[5] += __builtin_amdgcn_cvt_pk_f32_fp8((int)v.z, true) * ww;
            ap[6] += __builtin_amdgcn_cvt_pk_f32_fp8((int)v.w, false) * ww; ap[7] += __builtin_amdgcn_cvt_pk_f32_fp8((int)v.w, true) * ww;
            vv[j] = __builtin_bit_cast(u32x4, __builtin_amdgcn_raw_buffer_load_b128(vrs, (int)((na[j >> 2][j & 3] & (DRY ? VMASK : 0xffffffffu)) * 128u + (unsigned)sub * 16u), 0, 0));
        }
        float acc[16];
#pragma unroll
        for (int i = 0; i < 8; ++i) { acc[2 * i] = ap[i].x; acc[2 * i + 1] = ap[i].y; }
#pragma unroll
        for (int i = 0; i < 16; ++i) { acc[i] += lr8(acc[i]); acc[i] = sum_x16(acc[i]); acc[i] = sum_x32(acc[i]); }
        if (eg == 0) {
            float* xr = DRY ? (float*)(ws + OFF_R + 16 * MB) + (long)tok * DM + col0 : x + (long)tok * DM + col0;
#pragma unroll
            for (int c = 0; c < 4; ++c) {
                const f32x4 gv = gfv[c];
                f32x4 o;
                o.x = xv[c].x + gv.x * acc[4 * c + 0]; o.y = xv[c].y + gv.y * acc[4 * c + 1];
                o.z = xv[c].z + gv.z * acc[4 * c + 2]; o.w = xv[c].w + gv.w * acc[4 * c + 3];
                *(f32x4*)(xr + 4 * c) = o;
            }
        }
#pragma unroll
        for (int q = 0; q < 4; ++q) { cw[q] = nw[q]; na[q] = pa[q]; nw[q] = pw[q]; }
    }
}

DI void phase_norm2(const float* __restrict__ x, bf16_t* __restrict__ out1, const float* gain1, int sh1, int sc1,
                    bf16_t* __restrict__ out2, const float* gain2, int sh2, int sc2, const float* ada, int tid) {
    const int lane = tid & 63, gw = blockIdx.x * NWAVES + (tid >> 6), nw = gridDim.x * NWAVES;
    for (int tok = gw; tok < NTOK; tok += nw) {
        const int b = tok >> 13;
        f32x4 v[4]; float ss = 0.f;
#pragma unroll
        for (int j = 0; j < 4; ++j) { v[j] = *(const f32x4*)(x + (long)tok * DM + 4 * lane + 256 * j); ss += v[j].x * v[j].x + v[j].y * v[j].y + v[j].z * v[j].z + v[j].w * v[j].w; }
        const float rstd = rsqrtf(wave_sum(ss) * (1.f / DM) + EPS);
        norm_row_write(v, rstd, gain1, ada + b * ADA_STRIDE + sh1, ada + b * ADA_STRIDE + sc1, out1 + (long)tok * DM, lane);
        norm_row_write(v, rstd, gain2, ada + b * ADA_STRIDE + sh2, ada + b * ADA_STRIDE + sc2, out2 + (long)tok * DM, lane);
    }
}

template <int MT, class Epi>
DI void gemm_phase(const bf16_t* A, long lda, int M, const bf16_t* Bt, long ldb, int N, int K, const Epi& epi, unsigned char* lds, int tid) {
    const int ntm = (M + 128 * MT - 1) / (128 * MT), ntn = (N + 255) / 256, nt = ntm * ntn;
    if ((gridDim.x & 7) == 0 && (ntm & 31) == 0) {
        const int xcd = blockIdx.x & 7, lb = blockIdx.x >> 3, nlb = gridDim.x >> 3, tmx = ntm >> 3, per = tmx * ntn;
        for (int q = lb; q < per; q += nlb) {
            const int g4 = q / (4 * ntn), rem = q - g4 * 4 * ntn, tn = rem >> 2, tm = xcd * tmx + g4 * 4 + (rem & 3);
            if (tm < (xcd + 1) * tmx) gemm_tile<MT>(A, lda, M, Bt, ldb, N, K, tm * 128 * MT, tn * 256, epi, lds, tid);
        }
        return;
    }
    for (int t = blockIdx.x; t < nt; t += gridDim.x) {
        const int tn = t / ntm, tm = t % ntm;
        gemm_tile<MT>(A, lda, M, Bt, ldb, N, K, tm * 128 * MT, tn * 256, epi, lds, tid);
    }
}

#define XB_TMO      128
#define XB_XCNT(j)  (256  + 64 * (j))
#define XB_XSUB(j)  (1280 + 64 * (j))
#define XB_XGEN(j)  (2304 + 64 * (j))
#define XB_TOP      3328
#define XB_TOPGEN   3392
#define XCD_BAR_WORDS 3456
#define XB_SPIN_CAP (1u << 22)
#define LAS __attribute__((address_space(3)))
DI unsigned xb_ld(unsigned* p) { return __hip_atomic_load(p, __ATOMIC_RELAXED, __HIP_MEMORY_SCOPE_AGENT); }
DI unsigned xb_add(unsigned* p, unsigned v) { return __hip_atomic_fetch_add(p, v, __ATOMIC_RELAXED, __HIP_MEMORY_SCOPE_AGENT); }
DI unsigned xb_xcc_id() { return (unsigned)__builtin_amdgcn_s_getreg((3 << 11) | 20) & 0xFu; }
#define XB_SPIN(cond, bar) do { unsigned _sp = 0; while (cond) { __builtin_amdgcn_s_sleep(1); \
    if ((++_sp & 255u) == 0u) { if (xb_ld(&(bar)[XB_TMO])) break; if (_sp > XB_SPIN_CAP) { atomicAdd(&(bar)[XB_TMO], 1u); break; } } } } while (0)
DI void xcd_barrier_complete(unsigned* bar, unsigned x, unsigned& nloc, unsigned& nx) {
    const unsigned G = gridDim.x;
    unsigned sum, cnt, mine, sp = 0u;
    for (;;) {
        sum = 0u; cnt = 0u; mine = 0u;
#pragma unroll
        for (unsigned j = 0; j < 16; ++j) { const unsigned c = xb_ld(&bar[XB_XCNT(j)]); sum += c; cnt += (c > 0u) ? 1u : 0u; mine = (j == x) ? c : mine; }
        if (sum == G) break;
        __builtin_amdgcn_s_sleep(1);
        if ((++sp & 255u) == 0u) { if (xb_ld(&bar[XB_TMO])) break; if (sp > XB_SPIN_CAP) { atomicAdd(&bar[XB_TMO], 1u); break; } }
    }
    nloc = mine > 0u ? mine : 1u; nx = cnt > 0u ? cnt : 1u;
}
DI void xcd_barrier(unsigned* bar, volatile LAS unsigned* st, int tid) {
    asm volatile("s_waitcnt vmcnt(0)" ::: "memory");
    __syncthreads();
    if (tid == 0) {
        const unsigned x = xb_xcc_id();
        __builtin_amdgcn_s_waitcnt(0);
        unsigned nloc = st[0], nx = st[1];
        if (nloc == 0u) { xcd_barrier_complete(bar, x, nloc, nx); st[0] = nloc; st[1] = nx; }
        const unsigned old = xb_add(&bar[XB_XSUB(x)], 1u);
        const unsigned gen = old / nloc;
        if (old + 1u == (gen + 1u) * nloc) {
            __builtin_amdgcn_fence(__ATOMIC_RELEASE, "agent");
            asm volatile("s_waitcnt vmcnt(0)" ::: "memory");
            const unsigned og = xb_add(&bar[XB_TOP], 1u);
            const unsigned tg = og / nx;
            if (og + 1u == (tg + 1u) * nx) xb_add(&bar[XB_TOPGEN], 1u);
            else XB_SPIN(xb_ld(&bar[XB_TOPGEN]) == tg, bar);
            __builtin_amdgcn_fence(__ATOMIC_ACQUIRE, "agent");
            xb_add(&bar[XB_XGEN(x)], 1u);
            asm volatile("s_waitcnt vmcnt(0)" ::: "memory");
        } else {
            XB_SPIN(xb_ld(&bar[XB_XGEN(x)]) == gen, bar);
            __builtin_amdgcn_fence(__ATOMIC_ACQUIRE, "agent");
            asm volatile("s_waitcnt vmcnt(0)" ::: "memory");
        }
    }
    __syncthreads();
}

#define ftid() ftid_(wave_u)
DI int ftid_(int wave_u) { int t = (wave_u << 6) + (int)__builtin_amdgcn_mbcnt_hi(~0u, __builtin_amdgcn_mbcnt_lo(~0u, 0u)); asm volatile("" : "+v"(t)); return t; }


#if defined(__HIP_DEVICE_COMPILE__)
typedef const __attribute__((address_space(4))) Params* KParamPtr;
DI Params load_params() { KParamPtr kp = (KParamPtr)__builtin_amdgcn_kernarg_segment_ptr(); asm volatile("" : "+s"(kp)); return *kp; }
#else
DI Params load_params() { return Params{}; }
#endif
#define p (load_params())
#define ws (load_params().ws)
#define ada ((const float*)(ws + OFF_ADA))
#define Hb ((bf16_t*)(ws + OFF_H))
#define bar ((unsigned*)(ws + OFF_BAR))
__global__ void __launch_bounds__(NTHREADS) yoco_fwd(Params p_arg) {
    extern __shared__ __attribute__((aligned(16))) unsigned char lds[];
    cg::grid_group grid = cg::this_grid();
    volatile LAS unsigned* bst = (volatile LAS unsigned*)(lds + 144 * 1024);
    const int wave_u = __builtin_amdgcn_readfirstlane((int)(threadIdx.x >> 6));
    { const int t0 = ftid(); if (t0 == 0) { bst[0] = 0u; bst[1] = 0u; }
      if (blockIdx.x == 0) for (int i = t0; i < XCD_BAR_WORDS; i += NTHREADS) bar[i] = 0u; }
    __syncthreads();
    RUN(0) REP(0) phase_prep(p, lds, ftid());
    grid.sync();
    if (ftid() == 0) (void)xb_add(&bar[XB_XCNT(xb_xcc_id())], 1u);
    RUN(1) REP(1) phase_norm(p.in[0], Hb, p.in[5], ada, 0, 1024, ftid());
    xcd_barrier(bar, bst, ftid());
    RUN(2) REP(2) {
        EpiQKV0 e{(bf16_t*)(ws + OFF_Q0), (bf16_t*)(ws + OFF_K0), (bf16_t*)(ws + OFF_VT0), p.in[10], p.in[11], (float*)(ws + OFF_MB0), p.in[2]};
        gemm_phase<2>(Hb, DM, NTOK, (const bf16_t*)(ws + OFF_WT_DIN), DM, 3072, DM, e, lds, ftid());
    }
    xcd_barrier(bar, bst, ftid());
    RUN(3) REP(3) phase_diff_attn(p, lds, ftid());
    xcd_barrier(bar, bst, ftid());
    RUN(4) REP(4) {
        EpiResid e{p.in[0], opq(p.out), ada + 2 * 1024};
        gemm_phase<2>(Hb, DM, NTOK, (const bf16_t*)(ws + OFF_WT_DOUT), DM, 1024, DM, e, lds, ftid());
    }
    xcd_barrier(bar, bst, ftid());
    if (STOP_AFTER <= 1) return;
    RUN(1) phase_norm(opq(p.out), Hb, p.in[6], ada, 3 * 1024, 4 * 1024, ftid());
    xcd_barrier(bar, bst, ftid());
    RUN(5) REP(5) {
        EpiPeer e{(int*)(ws + OFF_RIDX), (float*)(ws + OFF_RGATE), 128 * 1024};
        gemm_phase<2>(Hb, DM, NTOK, (const bf16_t*)(ws + OFF_WT_PEER), DM, 2048, DM, e, lds, ftid());
    }
    xcd_barrier(bar, bst, ftid());
    if ((REPEAT_MASK >> 6) & 1) phase_peer_u<true>(p, 0, lds, ftid());
    RUN(6) phase_peer_u<false>(p, 0, lds, ftid());
    xcd_barrier(bar, bst, ftid());
    if ((REPEAT_MASK >> 10) & 1) phase_peer_v<true>(p, 0, ftid());
    RUN(6) phase_peer_v<false>(p, 0, ftid());
    xcd_barrier(bar, bst, ftid());
    RUN(1) phase_norm2(opq(p.out), (bf16_t*)(ws + OFF_H2), p.in[13], 12288, 12288 + 1024, Hb, p.in[5] + 1024, 6144, 6144 + 1024, ada, ftid());
    xcd_barrier(bar, bst, ftid());
    if (STOP_AFTER <= 2) return;
    RUN(7) REP(7) {
        EpiKV e{(bf16_t*)(ws + OFF_KC), (bf16_t*)(ws + OFF_KS), (bf16_t*)(ws + OFF_VST), (bf16_t*)(ws + OFF_KW), (bf16_t*)(ws + OFF_VWT), p.in[21]};
        gemm_phase<2>((const bf16_t*)(ws + OFF_H2), DM, NTOK, (const bf16_t*)(ws + OFF_WT_KV), DM, 1536, DM, e, lds, ftid());
    }
    xcd_barrier(bar, bst, ftid());
    RUN(8) REP(8) {
        EpiNsaQ e{(bf16_t*)(ws + OFF_QN), (float*)(ws + OFF_GATES), p.in[25], p.in[23], (float*)(ws + OFF_MB1)};
        gemm_phase<2>(Hb, DM, NTOK, (const bf16_t*)(ws + OFF_WT_NIN), DM, 1048, DM, e, lds, ftid());
        for (int t = blockIdx.x; t < 64; t += gridDim.x) {
            const int pr = t >> 2, tm = t & 3, kv = pr >> 3, bg = pr & 7;
            const bf16_t* Ap = (const bf16_t*)(ws + OFF_KC) + (long)(kv * 8 + bg) * SEQ * 128;
            bf16_t* hid = (bf16_t*)(ws + OFF_HID) + (long)pr * 512 * 256;
            EpiCmp1 e1{hid, (const float*)(ws + OFF_POSB) + kv * 16 * 256, p.in[19] + kv * 256};
            gemm_tile<1>(Ap, 2048, 511, (const bf16_t*)(ws + OFF_WT_C1) + (long)kv * 256 * 4096, 4096, 256, 4096, tm * 128, 0, e1, lds, ftid());
            __syncthreads();
            bf16_t* dst = kv == 0 ? (bf16_t*)(ws + OFF_KCMP) + (long)bg * 512 * 128 : (bf16_t*)(ws + OFF_VCMPT) + (long)bg * 128 * 512;
            EpiCmp2 e2{dst, p.in[21], kv};
            gemm_tile<1>(hid, 256, 512, (const bf16_t*)(ws + OFF_WT_C2) + (long)kv * 128 * 256, 256, 128, 256, tm * 128, 0, e2, lds, ftid());
        }
    }
    xcd_barrier(bar, bst, ftid());
#ifdef NSA_PROBE
    phase_nsa_attn<NSA_PROBE>(p, lds, ftid());
#endif
    RUN(9) REP(9) phase_nsa_attn<0>(p, lds, ftid());
    xcd_barrier(bar, bst, ftid());
    RUN(4) {
        float* xo = opq(p.out);
        EpiResid e{xo, xo, ada + 6144 + 2 * 1024};
        gemm_phase<2>(Hb, DM, NTOK, (const bf16_t*)(ws + OFF_WT_NOUT), DM, 1024, DM, e, lds, ftid());
    }
    xcd_barrier(bar, bst, ftid());
    if (STOP_AFTER <= 3) return;
    RUN(1) phase_norm(opq(p.out), Hb, p.in[6] + 1024, ada, 6144 + 3 * 1024, 6144 + 4 * 1024, ftid());
    xcd_barrier(bar, bst, ftid());
    RUN(5) REP(5) {
        EpiPeer e{(int*)(ws + OFF_RIDX), (float*)(ws + OFF_RGATE), 128 * 1024};
        gemm_phase<2>(Hb, DM, NTOK, (const bf16_t*)(ws + OFF_WT_PEER) + (long)2048 * 1024, DM, 2048, DM, e, lds, ftid());
    }
    xcd_barrier(bar, bst, ftid());
    if ((REPEAT_MASK >> 6) & 1) phase_peer_u<true>(p, 1, lds, ftid());
    RUN(6) phase_peer_u<false>(p, 1, lds, ftid());
    xcd_barrier(bar, bst, ftid());
    if ((REPEAT_MASK >> 10) & 1) phase_peer_v<true>(p, 1, ftid());
    RUN(6) phase_peer_v<false>(p, 1, ftid());
}
#undef p
#undef ws
#undef ada
#undef Hb
#undef bar

extern "C" void kernel_launch(void* const* d_in, const int* in_sizes, int n_in, void* d_out, int out_size, void* d_ws, size_t ws_size,
                              hipStream_t stream) {
    static int grid_blocks = 0;
    if (grid_blocks == 0) {
        if (n_in != 30 || out_size != NTOK * DM || ws_size < WS_END) {
            fprintf(stderr, "kernel_launch: unexpected shapes (n_in %d out %d ws %zu)\n", n_in, out_size, ws_size);
            grid_blocks = -1; return;
        }
        int dev = 0, cus = 0, per_cu = 0;
        hipGetDevice(&dev);
        hipDeviceGetAttribute(&cus, hipDeviceAttributeMultiprocessorCount, dev);
        hipFuncSetAttribute((const void*)yoco_fwd, hipFuncAttributeMaxDynamicSharedMemorySize, LDS_BYTES);
        hipOccupancyMaxActiveBlocksPerMultiprocessor(&per_cu, (const void*)yoco_fwd, NTHREADS, LDS_BYTES);
        if (per_cu < 1) { fprintf(stderr, "kernel_launch: occupancy query says %d blocks per CU\n", per_cu); grid_blocks = -1; return; }
        grid_blocks = cus;
    }
    if (grid_blocks < 0) return;
    Params p{};
    for (int i = 0; i < 30; ++i) p.in[i] = (const float*)d_in[i];
    p.out = (float*)d_out;
    p.ws = (unsigned char*)d_ws;
    void* args[] = {&p};
    hipError_t e = hipLaunchCooperativeKernel((const void*)yoco_fwd, dim3(grid_blocks), dim3(NTHREADS), args, LDS_BYTES, stream);
    if (e != hipSuccess) fprintf(stderr, "cooperative launch failed: %s (grid %d)\n", hipGetErrorString(e), grid_blocks);
}
```

```cpp
#include <hip/hip_runtime.h>
#include <hip/hip_cooperative_groups.h>
#include <cstdio>
#include <cstdint>
namespace cg = cooperative_groups;

#define DI __device__ __forceinline__
#ifndef STOP_AFTER
#define STOP_AFTER 99
#endif
#ifndef ONLY_PHASE
#define ONLY_PHASE -1
#endif
#define RUN(n) if (ONLY_PHASE < 0 || ONLY_PHASE == (n))
#ifndef REPEAT_MASK
#define REPEAT_MASK 0
#endif
#define REP(n) for (int rep_ = 0; rep_ < (((REPEAT_MASK) >> (n)) & 1) + 1; ++rep_)

typedef unsigned short bf16_t;
typedef short bf16x8 __attribute__((ext_vector_type(8)));
typedef float f32x16 __attribute__((ext_vector_type(16)));
typedef float f32x4 __attribute__((ext_vector_type(4)));
typedef float f32x2 __attribute__((ext_vector_type(2)));
typedef unsigned u32x4 __attribute__((ext_vector_type(4)));
typedef unsigned u32x2 __attribute__((ext_vector_type(2)));
typedef __bf16 bf16x2v __attribute__((ext_vector_type(2)));

#define MFMA32(a, b, c) __builtin_amdgcn_mfma_f32_32x32x16_bf16((a), (b), (c), 0, 0, 0)

constexpr int NB = 4, SEQ = 8192, DM = 1024, NTOK = NB * SEQ;
constexpr int NTHREADS = 512, NWAVES = 8;
constexpr float EPS = 1e-6f;
constexpr float LOG2E = 1.4426950408889634f;
constexpr int ADA_STRIDE = 14336;

constexpr size_t MB = 1u << 20;
constexpr size_t OFF_ADA = 0;
constexpr size_t OFF_POSB = 256 * 1024;
constexpr size_t OFF_BAR = 320 * 1024;
constexpr size_t OFF_MB0 = 168 * MB;
constexpr size_t OFF_MB1 = 172 * MB;
constexpr size_t OFF_H8 = 104 * MB;
constexpr size_t OFF_HS = 174 * MB;
constexpr size_t OFF_USI = 384 * 1024;
constexpr size_t OFF_VSI = 512 * 1024;
constexpr size_t OFF_WT_DIN = 1 * MB;
constexpr size_t OFF_WT_DOUT = 7 * MB;
constexpr size_t OFF_WT_KV = 9 * MB;
constexpr size_t OFF_WT_NIN = 12 * MB;
constexpr size_t OFF_WT_NOUT = 15 * MB;
constexpr size_t OFF_WT_PEER = 17 * MB;
constexpr size_t OFF_WT_C1 = 25 * MB;
constexpr size_t OFF_WT_C2 = 29 * MB;
constexpr size_t OFF_GATES = 30 * MB;
constexpr size_t OFF_KCMP = 34 * MB;
constexpr size_t OFF_VCMPT = 35 * MB;
constexpr size_t OFF_HID = 36 * MB;
constexpr size_t OFF_RIDX = 40 * MB;
constexpr size_t OFF_RGATE = 56 * MB;
constexpr size_t OFF_PU = 72 * MB;
constexpr size_t OFF_PV = 136 * MB;
constexpr size_t OFF_H = 200 * MB;
constexpr size_t OFF_R = 264 * MB;
constexpr size_t WS_END = 456 * MB;
constexpr size_t OFF_Q0 = OFF_R, OFF_K0 = OFF_R + 64 * MB, OFF_VT0 = OFF_R + 128 * MB;
constexpr size_t OFF_QN = OFF_R, OFF_H2 = OFF_R, OFF_KC = OFF_R + 64 * MB, OFF_KS = OFF_R + 96 * MB, OFF_VST = OFF_R + 112 * MB,
                 OFF_KW = OFF_R + 128 * MB, OFF_VWT = OFF_R + 144 * MB;

constexpr int LDS_BYTES = 144 * 1024 + 256;

struct Params {
    const float* in[30];
    float* out;
    unsigned char* ws;
};

template <class T> DI T* opq(T* q) { asm volatile("" : "+s"(q)); return (T*)(__attribute__((address_space(1))) T*)q; }
DI unsigned pk2(float lo, float hi) { f32x2 v = {lo, hi}; return __builtin_bit_cast(unsigned, __builtin_convertvector(v, bf16x2v)); }
DI bf16_t f2bf(float x) { return (bf16_t)(pk2(x, 0.f) & 0xffffu); }
DI float bflo(unsigned u) { return __uint_as_float(u << 16); }
DI float bfhi(unsigned u) { return __uint_as_float(u & 0xffff0000u); }
DI float fexp2(float x) { return __builtin_amdgcn_exp2f(x); }
DI float frcp(float x) { return __builtin_amdgcn_rcpf(x); }
DI int crow(int reg, int h) { return (reg & 3) + 8 * (reg >> 2) + 4 * h; }
template <int CTRL> DI float dpp_f(float v) { return __builtin_bit_cast(float, __builtin_amdgcn_update_dpp(0, __builtin_bit_cast(int, v), CTRL, 0xF, 0xF, true)); }
DI float lx1(float v) { return dpp_f<0xB1>(v); }
DI float lx2(float v) { return dpp_f<0x4E>(v); }
DI float lhm(float v) { return dpp_f<0x141>(v); }
DI float lr8(float v) { return dpp_f<0x128>(v); }
DI float sum_x16(float v) { auto s = __builtin_amdgcn_permlane16_swap(__float_as_uint(v), __float_as_uint(v), false, false); return __uint_as_float(s[0]) + __uint_as_float(s[1]); }
DI float sum_x32(float v) { auto s = __builtin_amdgcn_permlane32_swap(__float_as_uint(v), __float_as_uint(v), false, false); return __uint_as_float(s[0]) + __uint_as_float(s[1]); }
DI float max_x16(float v) { auto s = __builtin_amdgcn_permlane16_swap(__float_as_uint(v), __float_as_uint(v), false, false); return fmaxf(__uint_as_float(s[0]), __uint_as_float(s[1])); }
DI float max_x32(float v) { auto s = __builtin_amdgcn_permlane32_swap(__float_as_uint(v), __float_as_uint(v), false, false); return fmaxf(__uint_as_float(s[0]), __uint_as_float(s[1])); }
DI unsigned get_x32(unsigned v, int h) { auto s = __builtin_amdgcn_permlane32_swap(v, v, false, false); return h ? s[0] : s[1]; }
DI float wave_sum(float v) { v += lx1(v); v += lx2(v); v += lhm(v); v += lr8(v); v = sum_x16(v); return sum_x32(v); }
DI float wave_max(float v) { v = fmaxf(v, lx1(v)); v = fmaxf(v, lx2(v)); v = fmaxf(v, lhm(v)); v = fmaxf(v, lr8(v)); v = max_x16(v); return max_x32(v); }
DI int bperm(int v, int srclane) { return __builtin_amdgcn_ds_bpermute(srclane << 2, v); }
DI float bpermf(float v, int srclane) { return __builtin_bit_cast(float, __builtin_amdgcn_ds_bpermute(srclane << 2, __builtin_bit_cast(int, v))); }
DI float gelu_tanh(float x) {
    const float u = 0.7978845608028654f * (x + 0.044715f * x * x * x);
    return x * frcp(1.f + fexp2(-2.f * LOG2E * u));
}
DI float dot2bf(unsigned a, unsigned b, float c) {
    return __builtin_amdgcn_fdot2_f32_bf16(__builtin_bit_cast(bf16x2v, a), __builtin_bit_cast(bf16x2v, b), c, false);
}
DI int rel_bucket_i(int d) {
    if (d < 16) return d < 0 ? 0 : d;
    int b = 16;
    b += d >= 21; b += d >= 27; b += d >= 35; b += d >= 46; b += d >= 59; b += d >= 77; b += d >= 99; b += d >= 128;
    b += d >= 166; b += d >= 216; b += d >= 280; b += d >= 363; b += d >= 470; b += d >= 609; b += d >= 790;
    return b;
}
DI unsigned f2key(float f) { unsigned u = __float_as_uint(f); return u ^ ((unsigned)((int)u >> 31) | 0x80000000u); }
DI float key2f(unsigned k) { unsigned u = (k & 0x80000000u) ? (k ^ 0x80000000u) : ~k; return __uint_as_float(u); }

constexpr int EPI_LDS = 96 * 1024;

DI int sw2(int row, int chunk) { return (row >> 1) * 256 + (((((row & 1) << 3) | chunk) ^ ((row >> 1) & 15)) << 4); }
DI void sw2_src(int P, int& row, int& chunk) { const int R2 = P >> 4, lc = (P & 15) ^ (R2 & 15); row = 2 * R2 + (lc >> 3); chunk = lc & 7; }

template <class T, class = void> struct epi_stash { static constexpr bool value = false, present = false; };
template <class T> struct epi_stash<T, decltype((void)T::STASH)> { static constexpr bool value = T::STASH, present = true; };

template <int MT, class Epi>
DI void gemm_tile(const bf16_t* __restrict__ A, long lda, int M, const bf16_t* __restrict__ Bt, long ldb, int N, int K,
                  int m0, int n0, const Epi& epi, unsigned char* lds, int tid) {
    constexpr int XS = MT * 128 * 128, WS = 256 * 128, STAGE = XS + WS;
    const int lane = tid & 63, w = tid >> 6, tg = w & 3, fh = w >> 2, r = lane & 31, h = lane >> 5;
    const int wbase = tid & ~63;
    unsigned xo[2 * MT], wo[4];
#pragma unroll
    for (int i = 0; i < 2 * MT; ++i) { int row, c; sw2_src(tid + 512 * i, row, c); int m = m0 + row; m = m < M ? m : M - 1; xo[i] = (unsigned)m * (unsigned)(lda * 2) + c * 16; }
#pragma unroll
    for (int i = 0; i < 4; ++i) { int row, c; sw2_src(tid + 512 * i, row, c); int n = n0 + row; n = n < N ? n : N - 1; wo[i] = (unsigned)n * (unsigned)(ldb * 2) + c * 16; }
    const unsigned char* Ab = (const unsigned char*)A;
    const unsigned char* Bb = (const unsigned char*)Bt;
    auto stage = [&](int kt, unsigned char* st) {
#pragma unroll
        for (int i = 0; i < 2 * MT; ++i)
            __builtin_amdgcn_global_load_lds((const unsigned*)(Ab + kt * 128 + xo[i]), (unsigned*)(st + (wbase + 512 * i) * 16), 16, 0, 0);
#pragma unroll
        for (int i = 0; i < 4; ++i)
            __builtin_amdgcn_global_load_lds((const unsigned*)(Bb + kt * 128 + wo[i]), (unsigned*)(st + XS + (wbase + 512 * i) * 16), 16, 0, 0);
    };
    f32x16 acc[MT][4];
#pragma unroll
    for (int s2 = 0; s2 < MT; ++s2)
#pragma unroll
        for (int i = 0; i < 4; ++i)
#pragma unroll
            for (int j = 0; j < 16; ++j) acc[s2][i][j] = 0.f;
    const int nk = K >> 6;
    stage(0, lds);
    __syncthreads();
    for (int kt = 0; kt < nk; ++kt) {
        unsigned char* cur = lds + (kt & 1) * STAGE;
        if (kt + 1 < nk) stage(kt + 1, lds + ((kt + 1) & 1) * STAGE);
        bf16x8 xfa[MT], wfa[4], xfb[MT], wfb[4];
        auto ldf = [&](bf16x8 (&xf)[MT], bf16x8 (&wf)[4], int ks) {
#pragma unroll
            for (int s2 = 0; s2 < MT; ++s2) xf[s2] = *(const bf16x8*)(cur + sw2(32 * MT * tg + 32 * s2 + r, 2 * ks + h));
#pragma unroll
            for (int mt = 0; mt < 4; ++mt) wf[mt] = *(const bf16x8*)(cur + XS + sw2(128 * fh + 32 * mt + r, 2 * ks + h));
        };
        auto mm = [&](const bf16x8 (&xf)[MT], const bf16x8 (&wf)[4]) {
#pragma unroll
            for (int mt = 0; mt < 4; ++mt)
#pragma unroll
                for (int s2 = 0; s2 < MT; ++s2) acc[s2][mt] = MFMA32(wf[mt], xf[s2], acc[s2][mt]);
        };
        ldf(xfa, wfa, 0);
        ldf(xfb, wfb, 1); __builtin_amdgcn_sched_barrier(0); mm(xfa, wfa); __builtin_amdgcn_sched_barrier(0);
        ldf(xfa, wfa, 2); __builtin_amdgcn_sched_barrier(0); mm(xfb, wfb); __builtin_amdgcn_sched_barrier(0);
        ldf(xfb, wfb, 3); __builtin_amdgcn_sched_barrier(0); mm(xfa, wfa); __builtin_amdgcn_sched_barrier(0);
        mm(xfb, wfb);
        __syncthreads();
    }
    if constexpr (MT == 2 && epi_stash<Epi>::value) {
        float* sp = (float*)lds + w * 4096 + lane;
#pragma unroll
        for (int mt = 0; mt < 4; ++mt)
#pragma unroll
            for (int j = 0; j < 16; ++j) sp[(mt * 16 + j) * 64] = acc[1][mt][j];
        epi(acc[0], m0 + 64 * tg + r, n0 + 128 * fh, h, lds, tid);
        f32x16 a2[4];
        const float* sp2 = sp; asm volatile("" : "+v"(sp2));
#pragma unroll
        for (int mt = 0; mt < 4; ++mt)
#pragma unroll
            for (int j = 0; j < 16; ++j) a2[mt][j] = sp2[(mt * 16 + j) * 64];
        epi(a2, m0 + 64 * tg + 32 + r, n0 + 128 * fh, h, lds, tid);
        __syncthreads();
    } else {
        int ho = h, ro = r, to = tid;
        if constexpr (epi_stash<Epi>::present) asm volatile("" : "+v"(ho), "+v"(ro), "+v"(to));
#pragma unroll
        for (int s2 = 0; s2 < MT; ++s2) epi(acc[s2], m0 + 32 * MT * tg + 32 * s2 + ro, n0 + 128 * fh, ho, lds, to);
    }
}

DI void store_vt_tile(bf16_t* base, long rstride, const f32x16& a, int row0, int h, int lane) {
    const bool odd = lane & 1;
#pragma unroll
    for (int rg = 0; rg < 16; rg += 2) {
        const float xa = lx1(a[rg]), xb = lx1(a[rg + 1]);
        const unsigned wv = odd ? pk2(xb, a[rg + 1]) : pk2(a[rg], xa);
        bf16_t* dp = base + (long)(row0 + crow(odd ? rg + 1 : rg, h)) * rstride - (odd ? 1 : 0);
        *(unsigned*)dp = wv;
    }
}
struct EpiQKV0 {
    bf16_t *Q, *Kk, *VT;
    const float *qg, *kg;
    float* MB; const float* relb;
    DI void operator()(const f32x16 (&acc)[4], int tok, int fbase, int h, unsigned char*, int) const {
        const int sec = fbase >> 10, hd = (fbase & 1023) >> 7, b = tok >> 13, s = tok & (SEQ - 1);
        if (sec < 2) {
            const float* gn = sec == 0 ? qg : kg;
            const float sc = sec == 0 ? 0.125f * LOG2E : 1.f;
            bf16_t* dst = sec == 0 ? Q : Kk;
#pragma unroll
            for (int j = 0; j < 2; ++j) {
                float ss = 0.f;
#pragma unroll
                for (int mt = 0; mt < 2; ++mt)
#pragma unroll
                    for (int rg = 0; rg < 16; ++rg) { const float v = acc[2 * j + mt][rg]; ss += v * v; }
                ss = sum_x32(ss);
                const float rstd = rsqrtf(ss * (1.f / 64.f) + EPS) * sc;
                bf16_t* row = dst + ((long)((b * 8 + hd) * 2 + j) * SEQ + s) * 64;
                float qq = 0.f;
#pragma unroll
                for (int mt = 0; mt < 2; ++mt)
#pragma unroll
                    for (int g4 = 0; g4 < 4; ++g4) {
                        const int d0 = 32 * mt + 8 * g4 + 4 * h;
                        const f32x4 gv = *(const f32x4*)(gn + d0);
                        const float v0 = acc[2 * j + mt][4 * g4 + 0] * rstd * gv.x, v1 = acc[2 * j + mt][4 * g4 + 1] * rstd * gv.y;
                        const float v2 = acc[2 * j + mt][4 * g4 + 2] * rstd * gv.z, v3 = acc[2 * j + mt][4 * g4 + 3] * rstd * gv.w;
                        qq += v0 * v0 + v1 * v1 + v2 * v2 + v3 * v3;
                        u32x2 o;
                        o.x = pk2(v0, v1); o.y = pk2(v2, v3);
                        *(u32x2*)(row + d0) = o;
                    }
                if (sec == 0) {
                    qq = sum_x32(qq);
                    float kmx = 0.f;
                    for (int d = 0; d < 64; ++d) kmx = fmaxf(kmx, fabsf(kg[d]));
                    float bmx = 0.f;
                    for (int bk = 0; bk < 32; ++bk) bmx = fmaxf(bmx, relb[bk * 8 + hd] - relb[31 * 8 + hd]);
                    if (h == 0) MB[(long)((b * 8 + hd) * 2 + j) * SEQ + s] = 1.01f * sqrtf(qq) * 8.f * kmx + bmx * LOG2E;
                }
            }
        } else {
            bf16_t* base = VT + (long)(b * 8 + hd) * 128 * SEQ + s;
#pragma unroll
            for (int mt = 0; mt < 4; ++mt) store_vt_tile(base, SEQ, acc[mt], 32 * mt, h, tok);
        }
    }
};

struct EpiResid {
    const float* xin; float* xout; const float* gate;
    DI void operator()(const f32x16 (&acc)[4], int tok, int fbase, int h, unsigned char*, int) const {
        const int b = tok >> 13;
        const float* gp = gate + b * ADA_STRIDE;
#pragma unroll
        for (int mt = 0; mt < 4; ++mt)
#pragma unroll
            for (int g4 = 0; g4 < 4; ++g4) {
                const int f = fbase + 32 * mt + 8 * g4 + 4 * h;
                const f32x4 xv = *(const f32x4*)(xin + (long)tok * DM + f);
                const f32x4 gv = *(const f32x4*)(gp + f);
                f32x4 o;
                o.x = xv.x + gv.x * acc[mt][4 * g4 + 0]; o.y = xv.y + gv.y * acc[mt][4 * g4 + 1];
                o.z = xv.z + gv.z * acc[mt][4 * g4 + 2]; o.w = xv.w + gv.w * acc[mt][4 * g4 + 3];
                *(f32x4*)(xout + (long)tok * DM + f) = o;
                if (g4 == 3) __builtin_amdgcn_sched_barrier(0);
            }
    }
};

struct EpiKV {
    bf16_t *KC, *KS, *VST, *KW, *VWT;
    const float* kgain;
    DI void operator()(const f32x16 (&acc)[4], int tok, int fbase, int h, unsigned char*, int) const {
        const int c = fbase >> 7, br = c >> 2, kv = (c >> 1) & 1, g = c & 1, b = tok >> 13, s = tok & (SEQ - 1);
        if (br == 0 || kv == 0) {
            float rstd = 1.f;
            bf16_t* row;
            if (br == 0) row = KC + ((long)((kv * 4 + b) * 2 + g) * SEQ + s) * 128;
            else {
                float ss = 0.f;
#pragma unroll
                for (int mt = 0; mt < 4; ++mt)
#pragma unroll
                    for (int rg = 0; rg < 16; ++rg) ss += acc[mt][rg] * acc[mt][rg];
                ss = sum_x32(ss);
                rstd = rsqrtf(ss * (1.f / 128.f) + EPS);
                row = (br == 1 ? KS : KW) + ((long)(b * 2 + g) * SEQ + s) * 128;
            }
#pragma unroll
            for (int mt = 0; mt < 4; ++mt)
#pragma unroll
                for (int g4 = 0; g4 < 4; ++g4) {
                    const int d0 = 32 * mt + 8 * g4 + 4 * h;
                    f32x4 gv = {1.f, 1.f, 1.f, 1.f};
                    if (br != 0) gv = *(const f32x4*)(kgain + br * 128 + d0);
                    u32x2 o;
                    o.x = pk2(acc[mt][4 * g4 + 0] * rstd * gv.x, acc[mt][4 * g4 + 1] * rstd * gv.y);
                    o.y = pk2(acc[mt][4 * g4 + 2] * rstd * gv.z, acc[mt][4 * g4 + 3] * rstd * gv.w);
                    *(u32x2*)(row + d0) = o;
                }
        } else {
            bf16_t* base = (br == 1 ? VST : VWT) + (long)(b * 2 + g) * 128 * SEQ + s;
#pragma unroll
            for (int mt = 0; mt < 4; ++mt) store_vt_tile(base, SEQ, acc[mt], 32 * mt, h, tok);
        }
    }
};

struct EpiCmp1 {
    bf16_t* hid; const float* posb_part; const float* b1;
    DI void operator()(const f32x16 (&acc)[4], int tok, int fbase, int h, unsigned char*, int) const {
        if (tok >= 512) return;
#pragma unroll
        for (int mt = 0; mt < 4; ++mt)
#pragma unroll
            for (int g4 = 0; g4 < 4; ++g4) {
                const int f = fbase + 32 * mt + 8 * g4 + 4 * h;
                f32x4 pb = *(const f32x4*)(b1 + f);
                for (int c = 0; c < 16; ++c) { const f32x4 t = *(const f32x4*)(posb_part + c * 256 + f); pb.x += t.x; pb.y += t.y; pb.z += t.z; pb.w += t.w; }
                u32x2 o;
                o.x = pk2(gelu_tanh(acc[mt][4 * g4 + 0] + pb.x), gelu_tanh(acc[mt][4 * g4 + 1] + pb.y));
                o.y = pk2(gelu_tanh(acc[mt][4 * g4 + 2] + pb.z), gelu_tanh(acc[mt][4 * g4 + 3] + pb.w));
                *(u32x2*)(hid + (long)tok * 256 + f) = o;
            }
    }
};

struct EpiCmp2 {
    bf16_t* dst; const float* kgain0; int kv;
    DI void operator()(const f32x16 (&acc)[4], int tok, int fbase, int h, unsigned char*, int) const {
        if (fbase != 0 || tok >= 512) return;
        const float valid = tok < 511 ? 1.f : 0.f;
        if (kv == 0) {
            float ss = 0.f;
#pragma unroll
            for (int mt = 0; mt < 4; ++mt)
#pragma unroll
                for (int rg = 0; rg < 16; ++rg) ss += acc[mt][rg] * acc[mt][rg];
            ss = sum_x32(ss);
            const float rstd = rsqrtf(ss * (1.f / 128.f) + EPS) * valid;
#pragma unroll
            for (int mt = 0; mt < 4; ++mt)
#pragma unroll
                for (int g4 = 0; g4 < 4; ++g4) {
                    const int d0 = 32 * mt + 8 * g4 + 4 * h;
                    const f32x4 gv = *(const f32x4*)(kgain0 + d0);
                    u32x2 o;
                    o.x = pk2(acc[mt][4 * g4 + 0] * rstd * gv.x, acc[mt][4 * g4 + 1] * rstd * gv.y);
                    o.y = pk2(acc[mt][4 * g4 + 2] * rstd * gv.z, acc[mt][4 * g4 + 3] * rstd * gv.w);
                    *(u32x2*)(dst + (long)tok * 128 + d0) = o;
                }
        } else {
#pragma unroll
            for (int mt = 0; mt < 4; ++mt)
#pragma unroll
                for (int rg = 0; rg < 16; ++rg) dst[(long)(32 * mt + crow(rg, h)) * 512 + tok] = f2bf(acc[mt][rg] * valid);
        }
    }
};

struct EpiNsaQ {
    bf16_t* QN; float* gates; const float* qgain; const float* bgate; float* qnrm;
    DI void operator()(const f32x16 (&acc)[4], int tok, int fbase, int h, unsigned char*, int) const {
        const int b = tok >> 13, s = tok & (SEQ - 1);
        if (fbase < 1024) {
            const int head = fbase >> 7;
            float ss = 0.f;
#pragma unroll
            for (int mt = 0; mt < 4; ++mt)
#pragma unroll
                for (int rg = 0; rg < 16; ++rg) ss += acc[mt][rg] * acc[mt][rg];
            ss = sum_x32(ss);
            const float rstd = rsqrtf(ss * (1.f / 128.f) + EPS) * (0.08838834764831845f * LOG2E);
            bf16_t* row = QN + ((long)(b * 8 + head) * SEQ + s) * 128;
            float qq = 0.f;
#pragma unroll
            for (int mt = 0; mt < 4; ++mt)
#pragma unroll
                for (int g4 = 0; g4 < 4; ++g4) {
                    const int d0 = 32 * mt + 8 * g4 + 4 * h;
                    const f32x4 gv = *(const f32x4*)(qgain + d0);
                    const float v0 = acc[mt][4 * g4 + 0] * rstd * gv.x, v1 = acc[mt][4 * g4 + 1] * rstd * gv.y;
                    const float v2 = acc[mt][4 * g4 + 2] * rstd * gv.z, v3 = acc[mt][4 * g4 + 3] * rstd * gv.w;
                    qq += v0 * v0 + v1 * v1 + v2 * v2 + v3 * v3;
                    u32x2 o;
                    o.x = pk2(v0, v1); o.y = pk2(v2, v3);
                    *(u32x2*)(row + d0) = o;
                }
            qq = sum_x32(qq);
            if (h == 0) qnrm[(long)tok * 8 + head] = 1.01f * sqrtf(qq);
        } else if (fbase == 1024) {
#pragma unroll
            for (int rg = 0; rg < 16; ++rg) {
                const int f = crow(rg, h);
                if (f < 24) { const float z = acc[0][rg] + bgate[f]; gates[(long)tok * 24 + f] = frcp(1.f + fexp2(-LOG2E * z)); }
            }
        }
    }
};

struct EpiPeer {
    static constexpr bool STASH = false;
    int* ridx; float* rgate; int ex_off;
    DI void operator()(const f32x16 (&acc)[4], int tok, int fbase, int h, unsigned char* lds, int tid) const {
        const int lane = tid & 63, w = tid >> 6, tg = w & 3, fh = w >> 2, r = lane & 31;
        const int hd = fbase >> 8;
        unsigned* EX = (unsigned*)(lds + ex_off);
        unsigned L[16];
#pragma unroll
        for (int i = 0; i < 16; ++i) L[i] = 0u;
#pragma unroll
        for (int mt = 0; mt < 4; ++mt)
#pragma unroll
            for (int rg = 0; rg < 16; ++rg) {
                const int kidx = 32 * mt + crow(rg, h);
                unsigned x = (f2key(acc[mt][rg]) & ~127u) | (unsigned)(127 - kidx);
#pragma unroll
                for (int i = 0; i < 16; ++i) { const unsigned t = L[i] > x ? L[i] : x; x = L[i] > x ? x : L[i]; L[i] = t; }
            }
        {
            unsigned P[16];
#pragma unroll
            for (int i = 0; i < 16; ++i) P[i] = get_x32(L[i], h);
#pragma unroll
            for (int i = 0; i < 16; ++i) L[i] = L[i] > P[15 - i] ? L[i] : P[15 - i];
#pragma unroll
            for (int st = 8; st >= 1; st >>= 1)
#pragma unroll
                for (int i = 0; i < 16; ++i)
                    if ((i & st) == 0) { const unsigned a = L[i], b2 = L[i + st]; L[i] = a > b2 ? a : b2; L[i + st] = a > b2 ? b2 : a; }
        }
        if (h == 0) {
#pragma unroll
            for (int i = 0; i < 16; i += 4) *(u32x4*)(EX + ((fh * 4 + tg) * 32 + r) * 16 + i) = (u32x4){L[i], L[i + 1], L[i + 2], L[i + 3]};
        }
        __syncthreads();
        unsigned X[16], Y[16];
        {
            const unsigned* l0 = EX + ((0 * 4 + tg) * 32 + r) * 16;
            const unsigned* l1 = EX + ((1 * 4 + tg) * 32 + r) * 16;
            const unsigned* px = h ? l1 : l0;
            const unsigned* py = h ? l0 : l1;
#pragma unroll
            for (int i = 0; i < 16; i += 4) {
                const u32x4 a = *(const u32x4*)(px + i), b2 = *(const u32x4*)(py + i);
                X[i] = a.x; X[i + 1] = a.y; X[i + 2] = a.z; X[i + 3] = a.w;
                Y[i] = b2.x; Y[i + 1] = b2.y; Y[i + 2] = b2.z; Y[i + 3] = b2.w;
            }
        }
        unsigned T[16];
#pragma unroll
        for (int i = 0; i < 16; ++i) T[i] = 0u;
#pragma unroll
        for (int i = 0; i < 16; ++i)
#pragma unroll
            for (int j = i; j < 16; ++j) {
                if ((i + 1) * (j + 1) > 16) continue;
                const float fs = key2f(X[i] & ~127u) + key2f(Y[j] & ~127u);
                const unsigned code = h ? (unsigned)((j << 4) | i) : (unsigned)((i << 4) | j);
                unsigned x = (f2key(fs) & ~255u) | (255u - code);
                if (i == j) x = h ? 0u : x;
#pragma unroll
                for (int k = 0; k < 16; ++k) { const unsigned t = T[k] > x ? T[k] : x; x = T[k] > x ? x : T[k]; T[k] = t; }
            }
        {
            unsigned P[16];
#pragma unroll
            for (int i = 0; i < 16; ++i) P[i] = get_x32(T[i], h);
#pragma unroll
            for (int i = 0; i < 16; ++i) T[i] = T[i] > P[15 - i] ? T[i] : P[15 - i];
#pragma unroll
            for (int st = 8; st >= 1; st >>= 1)
#pragma unroll
                for (int i = 0; i < 16; ++i)
                    if ((i & st) == 0) { const unsigned a = T[i], b2 = T[i + st]; T[i] = a > b2 ? a : b2; T[i + st] = a > b2 ? b2 : a; }
        }
        float sc[16], sum = 0.f;
        const float mx = key2f(T[0] & ~255u);
#pragma unroll
        for (int k = 0; k < 16; ++k) { sc[k] = fexp2((key2f(T[k] & ~255u) - mx) * LOG2E); sum += sc[k]; }
        const float inv = frcp(sum);
        if (h == 0) {
            const unsigned* l0 = EX + ((0 * 4 + tg) * 32 + r) * 16;
            const unsigned* l1 = EX + ((1 * 4 + tg) * 32 + r) * 16;
#pragma unroll
            for (int k = 0; k < 16; ++k) {
                if ((k >> 3) != fh) continue;
                const unsigned code = 255u - (T[k] & 255u);
                const int i1 = 127 - (int)(l0[code >> 4] & 127u), i2 = 127 - (int)(l1[code & 15u] & 127u);
                ridx[(long)tok * 128 + hd * 16 + k] = i1 * 128 + i2;
                rgate[(long)tok * 128 + hd * 16 + k] = sc[k] * inv;
            }
        }
        __syncthreads();
    }
};

DI void p0_transpose_item(const float* __restrict__ W, int K, int N, bf16_t* __restrict__ WT, int item, int ntn, unsigned char* lds, int tid) {
    float* tile = (float*)lds;
    const int kb = item / ntn, nb = item % ntn, k0 = kb * 64, n0 = nb * 64;
    {
        const int nn = tid & 63, kk0 = tid >> 6;
#pragma unroll
        for (int i = 0; i < 8; ++i) { const int kk = kk0 + 8 * i; const int n = n0 + nn; tile[kk * 65 + nn] = n < N ? W[(long)(k0 + kk) * N + n] : 0.f; }
    }
    __syncthreads();
    {
        const int n = tid >> 3, c = tid & 7;
        const float* s = tile + (8 * c) * 65 + n;
        u32x4 o;
        o.x = pk2(s[0], s[65]); o.y = pk2(s[2 * 65], s[3 * 65]); o.z = pk2(s[4 * 65], s[5 * 65]); o.w = pk2(s[6 * 65], s[7 * 65]);
        *(u32x4*)(WT + (long)(n0 + n) * K + k0 + 8 * c) = o;
    }
    __syncthreads();
}

DI int pack_i8x4(float a, float b, float c, float d) {
    const int ia = __float2int_rn(a), ib = __float2int_rn(b), ic = __float2int_rn(c), id = __float2int_rn(d);
    return (ia & 255) | ((ib & 255) << 8) | ((ic & 255) << 16) | (id << 24);
}
DI void p0_fp8_item(const float* __restrict__ src, unsigned char* __restrict__ dst, float* __restrict__ sinv, bool sliced, int item, int tid) {
    const int lane = tid & 63, row = item * 8 + (tid >> 6);
    const float* rp = src + (long)row * 1024;
    f32x4 v[4]; float am = 0.f;
#pragma unroll
    for (int j = 0; j < 4; ++j) {
        v[j] = *(const f32x4*)(rp + 4 * lane + 256 * j);
        am = fmaxf(am, fmaxf(fmaxf(fabsf(v[j].x), fabsf(v[j].y)), fmaxf(fabsf(v[j].z), fabsf(v[j].w))));
    }
    am = wave_max(am);
    const float sc = sliced ? (am > 0.f ? exp2f(floorf(log2f(384.f / am))) : 1.f) : (am > 0.f ? 127.f / am : 1.f);
    if (lane == 0) sinv[row] = 1.f / sc;
#pragma unroll
    for (int j = 0; j < 4; ++j) {
        int pk = 0;
        if (sliced) {
            pk = __builtin_amdgcn_cvt_pk_fp8_f32(v[j].x * sc, v[j].y * sc, pk, false);
            pk = __builtin_amdgcn_cvt_pk_fp8_f32(v[j].z * sc, v[j].w * sc, pk, true);
        } else pk = pack_i8x4(v[j].x * sc, v[j].y * sc, v[j].z * sc, v[j].w * sc);
        const int col = 4 * lane + 256 * j;
        unsigned char* d = sliced ? dst + ((long)(col >> 7) * 16384 + row) * 128 + (col & 127) : dst + (long)row * 1024 + col;
        *(int*)d = pk;
    }
}

DI void p0_weff_item(const float* __restrict__ wq, const float* __restrict__ subk, bf16_t* __restrict__ WT, int item, unsigned char* lds, int tid) {
    const int layer = item >> 8, g = (item >> 4) & 15, ct = item & 15, p = g & 1, c0 = ct * 64;
    float* As = (float*)lds;
    float* Bs = As + 64 * 129;
    const float* wql = wq + (long)layer * 1024 * 2048;
    const float* sk = subk + ((long)layer * 2 + p) * 128 * 128;
    for (int e = tid; e < 64 * 128; e += NTHREADS) { const int c = e >> 7, d = e & 127; As[c * 129 + d] = wql[(long)(c0 + c) * 2048 + g * 128 + d]; }
    for (int e = tid; e < 128 * 128; e += NTHREADS) { const int k = e >> 7, d = e & 127; Bs[k * 129 + d] = sk[k * 128 + d]; }
    __syncthreads();
    const int k = tid & 127, cg4 = tid >> 7;
    float acc[16];
#pragma unroll
    for (int i = 0; i < 16; ++i) acc[i] = 0.f;
    for (int d = 0; d < 128; ++d) {
        const float bv = Bs[k * 129 + d];
#pragma unroll
        for (int i = 0; i < 16; ++i) acc[i] += As[(cg4 * 16 + i) * 129 + d] * bv;
    }
    bf16_t* o = WT + ((long)layer * 2048 + g * 128 + k) * 1024 + c0 + cg4 * 16;
    u32x4 o0, o1;
    o0.x = pk2(acc[0], acc[1]); o0.y = pk2(acc[2], acc[3]); o0.z = pk2(acc[4], acc[5]); o0.w = pk2(acc[6], acc[7]);
    o1.x = pk2(acc[8], acc[9]); o1.y = pk2(acc[10], acc[11]); o1.z = pk2(acc[12], acc[13]); o1.w = pk2(acc[14], acc[15]);
    *(u32x4*)o = o0; *(u32x4*)(o + 8) = o1;
    __syncthreads();
}

DI void p0_posb_item(const float* __restrict__ pos, const float* __restrict__ w1, float* __restrict__ part, int item, unsigned char* lds, int tid) {
    const int kv = item >> 4, ch = item & 15;
    float* red = (float*)lds;
    const int j = tid & 255, half = tid >> 8;
    const float* pp = pos + (long)kv * 4096 + ch * 256 + half * 128;
    const float* ww = w1 + ((long)kv * 4096 + ch * 256 + half * 128) * 256 + j;
    float a = 0.f;
    for (int f = 0; f < 128; ++f) a += pp[f] * ww[(long)f * 256];
    red[half * 256 + j] = a;
    __syncthreads();
    if (tid < 256) part[(kv * 16 + ch) * 256 + tid] = red[tid] + red[256 + tid];
    __syncthreads();
}

DI void p0_ada_item(const Params& p, float* __restrict__ ada, int item, unsigned char* lds, int tid) {
    float* cact = (float*)lds;
    float* red = cact + 4096;
    const float* c = p.in[1];
    for (int e = tid; e < 4096; e += NTHREADS) { const float v = c[e]; cact[e] = v * frcp(1.f + fexp2(-LOG2E * v)); }
    __syncthreads();
    const int colg = item * 64;
    const float* W; const float* bias; int N, n0;
    if (colg < 6144) { W = p.in[3]; bias = p.in[4]; N = 6144; n0 = colg; }
    else if (colg < 12288) { W = p.in[3] + (long)1024 * 6144; bias = p.in[4] + 6144; N = 6144; n0 = colg - 6144; }
    else { W = p.in[14]; bias = p.in[15]; N = 2048; n0 = colg - 12288; }
    const int col = tid & 63, kg = tid >> 6;
    float a0 = 0.f, a1 = 0.f, a2 = 0.f, a3 = 0.f;
    const float* wp = W + (long)(kg * 128) * N + n0 + col;
#pragma unroll 8
    for (int k = 0; k < 128; ++k) {
        const float wv = wp[(long)k * N];
        const int kk = kg * 128 + k;
        a0 += cact[kk] * wv; a1 += cact[1024 + kk] * wv; a2 += cact[2048 + kk] * wv; a3 += cact[3072 + kk] * wv;
    }
    red[(kg * 4 + 0) * 64 + col] = a0; red[(kg * 4 + 1) * 64 + col] = a1; red[(kg * 4 + 2) * 64 + col] = a2; red[(kg * 4 + 3) * 64 + col] = a3;
    __syncthreads();
    if (tid < 256) {
        const int b = tid >> 6, cc = tid & 63;
        float s = bias[n0 + cc];
#pragma unroll
        for (int q = 0; q < 8; ++q) s += red[(q * 4 + b) * 64 + cc];
        ada[b * ADA_STRIDE + colg + cc] = s;
    }
    __syncthreads();
}

constexpr int P0_CONV = 8192, P0_TR_DIN = 768, P0_TR_DOUT = 256, P0_TR_KV = 384, P0_TR_NIN = 288, P0_TR_NOUT = 256, P0_TR_C1 = 512, P0_TR_C2 = 16,
              P0_WEFF = 512, P0_POSB = 32, P0_ADA = 224;
constexpr int P0_TOTAL = P0_CONV + P0_TR_DIN + P0_TR_DOUT + P0_TR_KV + P0_TR_NIN + P0_TR_NOUT + P0_TR_C1 + P0_TR_C2 + P0_WEFF + P0_POSB + P0_ADA;

DI void phase_prep(const Params& p, unsigned char* lds, int tid) {
    unsigned char* ws = p.ws;
    for (int it = blockIdx.x; it < P0_TOTAL; it += gridDim.x) {
        int r = it;
        if (r < P0_ADA) { p0_ada_item(p, (float*)(ws + OFF_ADA), r, lds, tid); continue; } r -= P0_ADA;
        if (r < P0_WEFF) { p0_weff_item(p.in[26], p.in[27], (bf16_t*)(ws + OFF_WT_PEER), r, lds, tid); continue; } r -= P0_WEFF;
        if (r < P0_POSB) { p0_posb_item(p.in[17], p.in[18], (float*)(ws + OFF_POSB), r, lds, tid); continue; } r -= P0_POSB;
        if (r < P0_TR_DIN) { p0_transpose_item(p.in[7], 1024, 3072, (bf16_t*)(ws + OFF_WT_DIN), r, 48, lds, tid); continue; } r -= P0_TR_DIN;
        if (r < P0_TR_DOUT) { p0_transpose_item(p.in[8], 1024, 1024, (bf16_t*)(ws + OFF_WT_DOUT), r, 16, lds, tid); continue; } r -= P0_TR_DOUT;
        if (r < P0_TR_KV) { p0_transpose_item(p.in[16], 1024, 1536, (bf16_t*)(ws + OFF_WT_KV), r, 24, lds, tid); continue; } r -= P0_TR_KV;
        if (r < P0_TR_NIN) { p0_transpose_item(p.in[22], 1024, 1048, (bf16_t*)(ws + OFF_WT_NIN), r, 18, lds, tid); continue; } r -= P0_TR_NIN;
        if (r < P0_TR_NOUT) { p0_transpose_item(p.in[24], 1024, 1024, (bf16_t*)(ws + OFF_WT_NOUT), r, 16, lds, tid); continue; } r -= P0_TR_NOUT;
        if (r < P0_TR_C1) { const int kv = r >> 8; p0_transpose_item(p.in[18] + (long)kv * 4096 * 256, 4096, 256, (bf16_t*)(ws + OFF_WT_C1) + (long)kv * 256 * 4096, r & 255, 4, lds, tid); continue; } r -= P0_TR_C1;
        if (r < P0_TR_C2) { const int kv = r >> 3; p0_transpose_item(p.in[20] + (long)kv * 256 * 128, 256, 128, (bf16_t*)(ws + OFF_WT_C2) + (long)kv * 128 * 256, r & 7, 2, lds, tid); continue; } r -= P0_TR_C2;
        {
            const int tbl = r >> 11, sub = r & 2047;
            const int layer = tbl & 1;
            const float* src = (tbl < 2 ? p.in[28] : p.in[29]) + (long)layer * 16384 * 1024;
            unsigned char* dst = ws + (tbl < 2 ? OFF_PU : OFF_PV) + (long)layer * 16384 * 1024;
            float* sinv = (float*)(ws + (tbl < 2 ? OFF_USI : OFF_VSI)) + layer * 16384;
            p0_fp8_item(src, dst, sinv, tbl >= 2, sub, tid);
        }
    }
}

DI void norm_row_write(const f32x4 (&v)[4], float rstd, const float* gain, const float* shift, const float* scale, bf16_t* orow, int lane) {
#pragma unroll
    for (int j = 0; j < 4; ++j) {
        const int c = 4 * lane + 256 * j;
        const f32x4 g = *(const f32x4*)(gain + c), sh = *(const f32x4*)(shift + c), sc = *(const f32x4*)(scale + c);
        u32x2 o;
        o.x = pk2(v[j].x * rstd * g.x * (1.f + sc.x) + sh.x, v[j].y * rstd * g.y * (1.f + sc.y) + sh.y);
        o.y = pk2(v[j].z * rstd * g.z * (1.f + sc.z) + sh.z, v[j].w * rstd * g.w * (1.f + sc.w) + sh.w);
        *(u32x2*)(orow + c) = o;
    }
}
DI void phase_norm_q8(const float* __restrict__ x, bf16_t* __restrict__ out, unsigned char* __restrict__ out8, float* __restrict__ outs,
                      const float* gain, const float* ada, int shift_off, int scale_off, int tid) {
    const int lane = tid & 63, gw = blockIdx.x * NWAVES + (tid >> 6), nw = gridDim.x * NWAVES;
    for (int tok = gw; tok < NTOK; tok += nw) {
        const int b = tok >> 13;
        f32x4 v[4]; float ss = 0.f;
#pragma unroll
        for (int j = 0; j < 4; ++j) { v[j] = *(const f32x4*)(x + (long)tok * DM + 4 * lane + 256 * j); ss += v[j].x * v[j].x + v[j].y * v[j].y + v[j].z * v[j].z + v[j].w * v[j].w; }
        const float rstd = rsqrtf(wave_sum(ss) * (1.f / DM) + EPS);
        const float* shift = ada + b * ADA_STRIDE + shift_off; const float* scale = ada + b * ADA_STRIDE + scale_off;
        float am = 0.f;
#pragma unroll
        for (int j = 0; j < 4; ++j) {
            const int c = 4 * lane + 256 * j;
            const f32x4 g = *(const f32x4*)(gain + c), sh = *(const f32x4*)(shift + c), sc = *(const f32x4*)(scale + c);
            v[j].x = v[j].x * rstd * g.x * (1.f + sc.x) + sh.x; v[j].y = v[j].y * rstd * g.y * (1.f + sc.y) + sh.y;
            v[j].z = v[j].z * rstd * g.z * (1.f + sc.z) + sh.z; v[j].w = v[j].w * rstd * g.w * (1.f + sc.w) + sh.w;
            u32x2 o; o.x = pk2(v[j].x, v[j].y); o.y = pk2(v[j].z, v[j].w);
            *(u32x2*)(out + (long)tok * DM + c) = o;
            am = fmaxf(am, fmaxf(fmaxf(fabsf(v[j].x), fabsf(v[j].y)), fmaxf(fabsf(v[j].z), fabsf(v[j].w))));
        }
        am = wave_max(am);
        const float qs = am > 0.f ? 127.f / am : 1.f;
#pragma unroll
        for (int j = 0; j < 4; ++j) *(int*)(out8 + (long)tok * DM + 4 * lane + 256 * j) = pack_i8x4(v[j].x * qs, v[j].y * qs, v[j].z * qs, v[j].w * qs);
        if (lane == 0) outs[tok] = am > 0.f ? am * (1.f / 127.f) : 1.f;
    }
}
DI void phase_norm(const float* __restrict__ x, bf16_t* __restrict__ out, const float* gain, const float* ada, int shift_off, int scale_off, int tid) {
    const int lane = tid & 63, gw = blockIdx.x * NWAVES + (tid >> 6), nw = gridDim.x * NWAVES;
    for (int tok = gw; tok < NTOK; tok += nw) {
        const int b = tok >> 13;
        f32x4 v[4]; float ss = 0.f;
#pragma unroll
        for (int j = 0; j < 4; ++j) { v[j] = *(const f32x4*)(x + (long)tok * DM + 4 * lane + 256 * j); ss += v[j].x * v[j].x + v[j].y * v[j].y + v[j].z * v[j].z + v[j].w * v[j].w; }
        const float rstd = rsqrtf(wave_sum(ss) * (1.f / DM) + EPS);
        norm_row_write(v, rstd, gain, ada + b * ADA_STRIDE + shift_off, ada + b * ADA_STRIDE + scale_off, out + (long)tok * DM, lane);
    }
}

DI int kidx(int mt, int i) { return 32 * mt + 16 * (i >> 3) + (i & 7); }
template <int DQK>
DI void attn_qk32(const unsigned char* Ks, const bf16x8 (&qf)[DQK / 16], f32x16& st, int mt, int r, int h, float init = 0.f) {
    constexpr int RB = DQK * 2, MSK = DQK == 64 ? 7 : 15;
    const int row = 32 * mt + ((r & 0x13) | ((r & 4) << 1) | ((r & 8) >> 1));
#pragma unroll
    for (int i = 0; i < 16; ++i) st[i] = init;
#pragma unroll
    for (int ks = 0; ks < DQK / 16; ++ks) {
        const bf16x8 kf = RB == 128 ? *(const bf16x8*)(Ks + sw2(row, 2 * ks + h)) : *(const bf16x8*)(Ks + row * RB + (((2 * ks + h) ^ (row & MSK)) << 4));
        st = MFMA32(kf, qf[ks], st);
    }
}
DI void attn_pack32(const f32x16& st, bf16x8 (&pf)[2]) {
#pragma unroll
    for (int s = 0; s < 2; ++s) {
        u32x4 t;
        t.x = pk2(st[8 * s + 0], st[8 * s + 1]); t.y = pk2(st[8 * s + 2], st[8 * s + 3]);
        t.z = pk2(st[8 * s + 4], st[8 * s + 5]); t.w = pk2(st[8 * s + 6], st[8 * s + 7]);
        pf[s] = __builtin_bit_cast(bf16x8, t);
    }
}
DI void attn_softmax32(f32x16& st, float& m, float& l, f32x16 (&o)[4]) {
    float mx = st[0];
#pragma unroll
    for (int i = 1; i < 16; ++i) mx = fmaxf(mx, st[i]);
    mx = max_x32(mx);
    const float mn = fmaxf(m, mx);
    if (!__all(mn == m)) {
        const float alpha = fexp2(m - mn);
        l *= alpha;
#pragma unroll
        for (int dt = 0; dt < 4; ++dt)
#pragma unroll
            for (int i = 0; i < 16; ++i) o[dt][i] *= alpha;
        m = mn;
    }
    float sum = 0.f;
#pragma unroll
    for (int i = 0; i < 16; ++i) { const float pv = fexp2(st[i] - m); st[i] = pv; sum += pv; }
    l += sum;
}
DI void attn_softmax32_b(f32x16& st, float& l) {
    float sum = 0.f;
#pragma unroll
    for (int i = 0; i < 16; ++i) { const float pv = fexp2(st[i]); st[i] = pv; sum += pv; }
    l += sum;
}
DI void attn_pv32(const unsigned char* Vs, const bf16x8 (&pf)[2], f32x16 (&o)[4], int mt, int r, int h) {
#pragma unroll
    for (int dt = 0; dt < 4; ++dt)
#pragma unroll
        for (int s2 = 0; s2 < 2; ++s2) {
            const int row = 32 * dt + r;
            const bf16x8 vf = *(const bf16x8*)(Vs + sw2(row, 2 * (2 * mt + s2) + h));
            o[dt] = MFMA32(vf, pf[s2], o[dt]);
        }
}
template <int RB, int NROWS>
DI void dma_offsets(unsigned (&off)[NROWS * RB / 16 / 512], unsigned gstride, int tid) {
    constexpr int CPR = RB / 16;
#pragma unroll
    for (int i = 0; i < NROWS * CPR / 512; ++i) {
        const int idx = tid + 512 * i;
        int row, cp;
        if (RB == 128) sw2_src(idx, row, cp); else { row = idx / CPR; cp = (idx % CPR) ^ (row & (CPR - 1)); }
        off[i] = (unsigned)row * gstride + (cp << 4);
    }
}
template <int N>
DI void dma_issue(unsigned char* dst, const unsigned char* gbase, const unsigned (&off)[N], int tid) {
    const int wbase = tid & ~63;
#pragma unroll
    for (int i = 0; i < N; ++i)
        __builtin_amdgcn_global_load_lds((const unsigned*)(gbase + off[i]), (unsigned*)(dst + (wbase + 512 * i) * 16), 16, 0, 0);
}

constexpr int AT_STAGE = 32 * 1024;
constexpr int AT_LUT = 2 * AT_STAGE;
constexpr int LUT_N = 1280, LUT_OFF = 1100;
constexpr int LUTC_W = 52;
constexpr int AT_LUTC = AT_LUT + 20 * 1024;
constexpr int AT_IMP = AT_LUTC + 13 * 1024;
constexpr int AT_SEL = AT_IMP + 34 * 1024;

DI void phase_diff_attn(const Params& p, unsigned char* lds, int tid) {
    unsigned char* ws = p.ws;
    const bf16_t* Q = (const bf16_t*)(ws + OFF_Q0);
    const bf16_t* Kk = (const bf16_t*)(ws + OFF_K0);
    const bf16_t* VT = (const bf16_t*)(ws + OFF_VT0);
    bf16_t* O = (bf16_t*)(ws + OFF_H);
    const float* relb = p.in[2];
    const float* lam = p.in[9];
    const float* subln = p.in[12];
    const int lane = tid & 63, w = tid >> 6, comp = w & 1, qg = w >> 1, r = lane & 31, h = lane >> 5;
    float* lut = (float*)(lds + 128 * 1024);
    float lam_full;
    {
        float s01 = 0.f, s23 = 0.f;
        for (int i = 0; i < 64; ++i) { s01 += lam[i] * lam[64 + i]; s23 += lam[128 + i] * lam[192 + i]; }
        lam_full = __expf(s01) - __expf(s23) + 0.2f;
    }
    const int G = gridDim.x, rows_per_it = G >> 5;
    unsigned koff[1], voff[2];
    dma_offsets<128, 64>(koff, 128, tid);
    dma_offsets<128, 128>(voff, SEQ * 2, tid);
    constexpr int ST2 = 64 * 1024;
    for (int it = 0;; ++it) {
        int qb, b, hd;
        if (G == 256) {
            if (it >= 8) break;
            const int xcd = blockIdx.x & 7, lb = blockIdx.x >> 3, pr = xcd * 4 + (it >> 1);
            qb = (it & 1) ? lb : 63 - lb; b = pr >> 3; hd = pr & 7;
        } else {
            int u;
            if ((G & 31) == 0) {
                const int rr = blockIdx.x >> 5, cc = blockIdx.x & 31;
                const int rowi = it * rows_per_it + ((it & 1) ? rows_per_it - 1 - rr : rr);
                u = rowi * 32 + cc;
            } else u = it * G + blockIdx.x;
            if (u >= 2048) break;
            qb = 63 - (u >> 5); b = (u & 31) >> 3; hd = u & 7;
        }
        const int q0 = qb * 128, ntiles = qb + 1;
        const int qpos = q0 + 32 * qg + r, qlo = q0 + 32 * qg, qhi = qlo + 31;
        for (int e = tid; e < LUT_N; e += NTHREADS) { const int d = LUT_OFF - e; lut[e] = d < 0 ? -INFINITY : (d >= 790 ? 0.f : (relb[rel_bucket_i(d) * 8 + hd] - relb[31 * 8 + hd]) * LOG2E); }
        bf16x8 qf[4];
        {
            const bf16_t* qrow = Q + ((long)((b * 8 + hd) * 2 + comp) * SEQ + qpos) * 64;
#pragma unroll
            for (int ks = 0; ks < 4; ++ks) qf[ks] = *(const bf16x8*)(qrow + 16 * ks + 8 * h);
        }
        const unsigned char* k0g = (const unsigned char*)(Kk + (long)((b * 8 + hd) * 2 + 0) * SEQ * 64);
        const unsigned char* k1g = (const unsigned char*)(Kk + (long)((b * 8 + hd) * 2 + 1) * SEQ * 64);
        const unsigned char* vtg = (const unsigned char*)(VT + (long)(b * 8 + hd) * 128 * SEQ);
        f32x16 o[4];
#pragma unroll
        for (int dt = 0; dt < 4; ++dt)
#pragma unroll
            for (int i = 0; i < 16; ++i) o[dt][i] = 0.f;
        float l = 0.f;
        const float nmb = -((const float*)(ws + OFF_MB0))[(long)((b * 8 + hd) * 2 + comp) * SEQ + qpos];
        auto stage = [&](int kt, unsigned char* st) {
#pragma unroll
            for (int sb = 0; sb < 2; ++sb) {
                dma_issue(st + sb * 8192, k0g + (long)(2 * kt + sb) * 8192, koff, tid);
                dma_issue(st + 16384 + sb * 8192, k1g + (long)(2 * kt + sb) * 8192, koff, tid);
                dma_issue(st + 32768 + sb * 16384, vtg + (long)(2 * kt + sb) * 128, voff, tid);
            }
        };
        stage(0, lds);
        __syncthreads();
        for (int kt = 0; kt < ntiles; ++kt) {
            unsigned char* cur = lds + (kt & 1) * ST2;
            if (kt + 1 < ntiles) stage(kt + 1, lds + ((kt + 1) & 1) * ST2);
            const bool nearb = qlo - (kt * 128 + 127) < 790;
            const int dbase0 = qpos - kt * 128 - 8 * h;
            const unsigned char* kb = cur + comp * 16384;
            f32x16 sa, sbv;
            attn_qk32<64>(kb, qf, sa, 0, r, h, nmb);
#pragma unroll
            for (int j = 0; j < 4; ++j) {
                f32x16& sc = (j & 1) ? sbv : sa;
                f32x16& sn = (j & 1) ? sa : sbv;
                if (j < 3) attn_qk32<64>(kb + ((j + 1) >> 1) * 8192, qf, sn, (j + 1) & 1, r, h, nmb);
                if (nearb) {
                    const float* lp = lut + (LUT_OFF - dbase0 + 64 * (j >> 1));
#pragma unroll
                    for (int i = 0; i < 16; ++i) sc[i] += lp[kidx(j & 1, i)];
                }
                attn_softmax32_b(sc, l);
                bf16x8 pf[2];
                attn_pack32(sc, pf);
                attn_pv32(cur + 32768 + (j >> 1) * 16384, pf, o, j & 1, r, h);
            }
            __syncthreads();
        }
        l = sum_x32(l);
        const float inv = l > 0.f ? frcp(l) : 0.f;
        float* xch = (float*)lds + qg * 4096;
        if (comp == 1) {
            const float sc = inv * lam_full;
#pragma unroll
            for (int dt = 0; dt < 4; ++dt)
#pragma unroll
                for (int i = 0; i < 16; ++i) xch[(dt * 16 + i) * 64 + lane] = o[dt][i] * sc;
        }
        __syncthreads();
        if (comp == 0) {
            float ss = 0.f;
#pragma unroll
            for (int dt = 0; dt < 4; ++dt)
#pragma unroll
                for (int i = 0; i < 16; ++i) { const float v = o[dt][i] * inv - xch[(dt * 16 + i) * 64 + lane]; o[dt][i] = v; ss += v * v; }
            ss = sum_x32(ss);
            const float rstd = rsqrtf(ss * (1.f / 128.f) + EPS) * 0.8f;
            bf16_t* orow = O + (long)(b * SEQ + qpos) * DM + hd * 128;
#pragma unroll
            for (int dt = 0; dt < 4; ++dt)
#pragma unroll
                for (int g4 = 0; g4 < 4; ++g4) {
                    const int d0 = 32 * dt + 8 * g4 + 4 * h;
                    const f32x4 gv = *(const f32x4*)(subln + d0);
                    u32x2 ov;
                    ov.x = pk2(o[dt][4 * g4 + 0] * rstd * gv.x, o[dt][4 * g4 + 1] * rstd * gv.y);
                    ov.y = pk2(o[dt][4 * g4 + 2] * rstd * gv.z, o[dt][4 * g4 + 3] * rstd * gv.w);
                    *(u32x2*)(orow + d0) = ov;
                }
        }
        __syncthreads();
    }
}

template <int VAR>
DI void phase_nsa_attn(const Params& p, unsigned char* lds, int tid) {
    unsigned char* ws = p.ws;
    const bf16_t* QN = (const bf16_t*)(ws + OFF_QN);
    const bf16_t* KS = (const bf16_t*)(ws + OFF_KS);
    const bf16_t* VST = (const bf16_t*)(ws + OFF_VST);
    const bf16_t* KW = (const bf16_t*)(ws + OFF_KW);
    const bf16_t* VWT = (const bf16_t*)(ws + OFF_VWT);
    const bf16_t* KCMP = (const bf16_t*)(ws + OFF_KCMP);
    const bf16_t* VCMPT = (const bf16_t*)(ws + OFF_VCMPT);
    const float* gates = (const float*)(ws + OFF_GATES);
    bf16_t* O = VAR ? (bf16_t*)(ws + OFF_PU + 32 * MB) : (bf16_t*)(ws + OFF_H);
    const float* relb = p.in[2];
    const int lane = tid & 63, w = tid >> 6, hg = w >> 1, th = w & 1, r = lane & 31, h = lane >> 5;
    float* lut = (float*)(lds + AT_LUT);
    float* lutc = (float*)(lds + AT_LUTC);
    float* imp = (float*)(lds + AT_IMP);
    unsigned* selw = (unsigned*)(lds + AT_SEL);
    unsigned short* sel16 = (unsigned short*)selw;
    float* bmxs = (float*)(selw + 264);
    const float* qnrm = (const float*)(ws + OFF_MB1);
    float kmx[3];
    for (int br = 0; br < 3; ++br) { float mx = 0.f; for (int d = 0; d < 128; ++d) mx = fmaxf(mx, fabsf(p.in[21][br * 128 + d])); kmx[br] = mx * 11.313708498984761f; }
    const int G = gridDim.x, rows_per_it = G >> 3;
    int lut_g = -1;
    for (int it = 0;; ++it) {
        int u;
        if ((G & 7) == 0) {
            const int rr = blockIdx.x >> 3, cc = blockIdx.x & 7;
            const int rowi = it * rows_per_it + ((it & 1) ? rows_per_it - 1 - rr : rr);
            u = rowi * 8 + cc;
        } else u = it * G + blockIdx.x;
        if (u >= 1024) break;
        const int bi = 127 - (u >> 3), b = (u & 7) >> 1, g = u & 1, head = 4 * g + hg;
        const int tq = 64 * bi + 32 * th + r;
        const int tl = 32 * th + r;
        const long tok = (long)b * SEQ + tq;
        if (g != lut_g) {
            lut_g = g;
            if (tid < 4) { float bm = 0.f; for (int bk = 0; bk < 32; ++bk) bm = fmaxf(bm, relb[bk * 8 + 4 * g + tid] - relb[31 * 8 + 4 * g + tid]); bmxs[tid] = bm * LOG2E; }
            for (int e = tid; e < 4 * LUT_N; e += NTHREADS) { const int hh = e / LUT_N, d = LUT_OFF - (e % LUT_N); lut[e] = d < 0 ? -INFINITY : (d >= 790 ? 0.f : (relb[rel_bucket_i(d) * 8 + 4 * g + hh] - relb[31 * 8 + 4 * g + hh]) * LOG2E); }
            for (int e = tid; e < 4 * 16 * LUTC_W; e += NTHREADS) {
                const int hh = e / (16 * LUTC_W), ph = (e / LUTC_W) & 15, ci = e % LUTC_W, d = 16 * (ci - 1) + ph;
                lutc[e] = ci == 0 ? -INFINITY : (d >= 790 ? 0.f : (relb[rel_bucket_i(d) * 8 + 4 * g + hh] - relb[31 * 8 + 4 * g + hh]) * LOG2E);
            }
        }
        if (tid < 4) selw[256 + tid] = 0u;
        const float* mylut = lut + hg * LUT_N;
        bf16x8 qf[8];
        const bf16_t* qrow = QN + ((long)(b * 8 + head) * SEQ + tq) * 128 + 8 * h;
        auto load_q = [&](const bf16_t* qr) {
#pragma unroll
            for (int ks = 0; ks < 8; ++ks) qf[ks] = *(const bf16x8*)(qr + 16 * ks);
        };
        const float* gp = gates + tok * 24 + head * 3;
        bf16_t* orow = O + (VAR ? (tok & 16383) : tok) * DM + head * 128;
        auto stage = [&](const unsigned char* kg, const unsigned char* vg, unsigned vstride, int kt, unsigned char* st) {
            int t2 = tid; asm volatile("" : "+v"(t2));
            unsigned koff[2], vo[2];
            dma_offsets<256, 64>(koff, 256, t2);
            dma_offsets<128, 128>(vo, vstride, t2);
            dma_issue(st, kg + (long)kt * 16384, koff, t2);
            dma_issue(st + 16384, vg + (long)kt * 128, vo, t2);
        };
        f32x16 o[4];
        float l;
        auto reset = [&]() {
#pragma unroll
            for (int dt = 0; dt < 4; ++dt)
#pragma unroll
                for (int i = 0; i < 16; ++i) o[dt][i] = 0.f;
            l = 0.f;
        };
        const unsigned char* kcg = (const unsigned char*)(KCMP + (long)(b * 2 + g) * 512 * 128);
        const unsigned char* vcg = (const unsigned char*)(VCMPT + (long)(b * 2 + g) * 128 * 512);
        const int nct = ((4 * bi + 2) >> 6) + 1;
        const int hgc = r & 3, tlc = 8 * w + (r >> 2), tqc = 64 * bi + tlc;
        const long tokc = (long)b * SEQ + tqc;
        reset();
        load_q(QN + ((long)(b * 8 + 4 * g + hgc) * SEQ + tqc) * 128 + 8 * h);
        __syncthreads();
        if (VAR != 3) {
            const int cb = (tqc - 31) >> 4;
            const float* lc = lutc + (hgc * 16 + ((tqc - 31) & 15)) * LUTC_W + 1;
            const float nmb = -(qnrm[tokc * 8 + 4 * g + hgc] * kmx[0] + bmxs[hgc]);
            stage(kcg, vcg, 1024u, 0, lds);
            __syncthreads();
            for (int kt = 0; kt < nct; ++kt) {
                unsigned char* cur = lds + (kt & 1) * AT_STAGE;
                if (kt + 1 < nct) stage(kcg, vcg, 1024u, kt + 1, lds + ((kt + 1) & 1) * AT_STAGE);
                const int cbase = cb - kt * 64 - 8 * h;
#pragma unroll
                for (int mt = 0; mt < 2; ++mt) {
                    f32x16 st;
                    attn_qk32<128>(cur, qf, st, mt, r, h, nmb);
                    float sum = 0.f;
#pragma unroll
                    for (int i = 0; i < 16; ++i) {
                        const int c = cbase - kidx(mt, i);
                        sum += fexp2(st[i] + lc[c < -1 ? -1 : (c > 50 ? 50 : c)]);
                    }
                    l += sum;
                }
                __syncthreads();
            }
            const float lt = sum_x32(l);
            const float invl = lt > 0.f ? frcp(lt) : 0.f;
            stage(kcg, vcg, 1024u, 0, lds);
            __syncthreads();
            float carry = 0.f;
            for (int kt = 0; kt < nct; ++kt) {
                unsigned char* cur = lds + (kt & 1) * AT_STAGE;
                if (kt + 1 < nct) stage(kcg, vcg, 1024u, kt + 1, lds + ((kt + 1) & 1) * AT_STAGE);
                const int cbase = cb - kt * 64 - 8 * h;
                float o0[4], o1[4], sp[4];
#pragma unroll
                for (int mt = 0; mt < 2; ++mt) {
                    f32x16 st;
                    attn_qk32<128>(cur, qf, st, mt, r, h, nmb);
#pragma unroll
                    for (int i = 0; i < 16; ++i) {
                        const int c = cbase - kidx(mt, i);
                        st[i] = fexp2(st[i] + lc[c < -1 ? -1 : (c > 50 ? 50 : c)]) * invl;
                    }
#pragma unroll
                    for (int gq = 0; gq < 2; ++gq) {
                        const int G2 = 2 * mt + gq, q0 = 2 * gq, q1 = 2 * gq + 1;
                        const float c20 = 0.5f * st[4 * q0 + 3];
                        o0[G2] = st[4 * q0] + st[4 * q0 + 1] + st[4 * q0 + 2] + c20;
                        o1[G2] = st[4 * q1] + st[4 * q1 + 1] + st[4 * q1 + 2] + 0.5f * st[4 * q1 + 3] + c20;
                        sp[G2] = 0.5f * st[4 * q1 + 3];
                    }
                    bf16x8 pf[2];
                    attn_pack32(st, pf);
                    attn_pv32(cur + 16384, pf, o, mt, r, h);
                }
                float rc[4];
#pragma unroll
                for (int G2 = 0; G2 < 4; ++G2) rc[G2] = __uint_as_float(get_x32(__float_as_uint(sp[G2]), h));
                if (h) {
#pragma unroll
                    for (int G2 = 0; G2 < 4; ++G2) o0[G2] += rc[G2];
                } else {
                    o0[0] += carry; o0[1] += rc[0]; o0[2] += rc[1]; o0[3] += rc[2];
                    carry = rc[3];
                }
#pragma unroll
                for (int G2 = 0; G2 < 4; ++G2) {
                    float a0 = o0[G2], a1 = o1[G2];
                    a0 += lx1(a0); a0 += lx2(a0); a1 += lx1(a1); a1 += lx2(a1);
                    if (hgc == 0) *(f32x2*)(imp + tlc * 130 + kt * 16 + 4 * G2 + 2 * h) = (f32x2){a0, a1};
                }
                __syncthreads();
            }
        }
        {
            const float g_c = gates[tokc * 24 + (4 * g + hgc) * 3];
            bf16_t* orc = O + (VAR ? (tokc & 16383) : tokc) * DM + (4 * g + hgc) * 128;
#pragma unroll
            for (int dt = 0; dt < 4; ++dt)
#pragma unroll
                for (int g4 = 0; g4 < 4; ++g4) {
                    const int d0 = 32 * dt + 8 * g4 + 4 * h;
                    u32x2 ov;
                    ov.x = pk2(o[dt][4 * g4 + 0] * g_c, o[dt][4 * g4 + 1] * g_c);
                    ov.y = pk2(o[dt][4 * g4 + 2] * g_c, o[dt][4 * g4 + 3] * g_c);
                    *(u32x2*)(orc + d0) = ov;
                }
        }
        if (VAR != 5) {
            const int tkn = tid >> 3, part = tid & 7;
            unsigned key[16];
#pragma unroll
            for (int q = 0; q < 16; ++q) {
                const int j = part * 16 + q;
                float v = imp[tkn * 130 + j];
                const int back = bi - j;
                if (j == 0 || (back >= 0 && back < 2)) v = 1e9f;
                if (back < 0) v = -1e30f;
                key[q] = f2key(v);
            }
            auto sum8 = [&](int c) -> int {
                c += __builtin_amdgcn_update_dpp(0, c, 0xB1, 0xF, 0xF, true);
                c += __builtin_amdgcn_update_dpp(0, c, 0x4E, 0xF, 0xF, true);
                c += __builtin_amdgcn_update_dpp(0, c, 0x141, 0xF, 0xF, true);
                return c;
            };
            unsigned T = 0u;
#pragma unroll 4
            for (int bit = 31; bit >= 0; --bit) {
                const unsigned cand = T | (1u << bit);
                int c = 0;
#pragma unroll
                for (int q = 0; q < 16; ++q) c += key[q] >= cand ? 1 : 0;
                if (sum8(c) >= 16) T = cand;
            }
            int cg = 0, ce = 0;
#pragma unroll
            for (int q = 0; q < 16; ++q) { cg += key[q] > T ? 1 : 0; ce += key[q] == T ? 1 : 0; }
            const int need = 16 - sum8(cg);
            int pre = ce;
            { int t = __builtin_amdgcn_update_dpp(0, pre, 0x111, 0xF, 0xF, true); if (part >= 1) pre += t; }
            { int t = __builtin_amdgcn_update_dpp(0, pre, 0x112, 0xF, 0xF, true); if (part >= 2) pre += t; }
            { int t = __builtin_amdgcn_update_dpp(0, pre, 0x114, 0xF, 0xF, true); if (part >= 4) pre += t; }
            int before = pre - ce;
            unsigned bits = 0;
#pragma unroll
            for (int q = 0; q < 16; ++q) {
                const bool eq = key[q] == T;
                const bool selq = key[q] > T || (eq && before < need);
                before += eq ? 1 : 0;
                bits |= (selq && key[q] >= 0x80000000u) ? (1u << q) : 0u;
            }
            sel16[tkn * 8 + part] = (unsigned short)bits;
            atomicOr(&selw[256 + (part >> 1)], bits << ((part & 1) * 16));
        }
        __syncthreads();
        const unsigned un0 = selw[256], un1 = selw[257], un2 = selw[258], un3 = selw[259];
        const unsigned char* ksg = (const unsigned char*)(KS + (long)(b * 2 + g) * SEQ * 128);
        const unsigned char* vsg = (const unsigned char*)(VST + (long)(b * 2 + g) * 128 * SEQ);
        reset(); load_q(qrow);
        const float qn_main = qnrm[tok * 8 + head];
        {
            const float nmb = -(qn_main * kmx[1] + bmxs[hg]);
            const unsigned long long ulo = ((unsigned long long)(unsigned)__builtin_amdgcn_readfirstlane((int)un1) << 32) | (unsigned)__builtin_amdgcn_readfirstlane((int)un0);
            const unsigned long long uhi = ((unsigned long long)(unsigned)__builtin_amdgcn_readfirstlane((int)un3) << 32) | (unsigned)__builtin_amdgcn_readfirstlane((int)un2);
            auto next_tile = [&](int from) -> int {
                if (from < 64) { const unsigned long long mk = ulo >> from; if (mk) return from + __builtin_ctzll(mk); from = 64; }
                if (from < 128) { const unsigned long long mk = uhi >> (from - 64); if (mk) return from + __builtin_ctzll(mk); }
                return 128;
            };
            int jt = (VAR == 1 || VAR == 4 || VAR == 5) ? 128 : next_tile(0);
            int buf = 0;
            if (jt < 128) stage(ksg, vsg, SEQ * 2u, jt, lds);
            __syncthreads();
            while (jt < 128) {
                unsigned char* cur = lds + buf * AT_STAGE;
                const int jn = next_tile(jt + 1);
                if (jn < 128) stage(ksg, vsg, SEQ * 2u, jn, lds + (buf ^ 1) * AT_STAGE);
                const unsigned wd = selw[tl * 4 + (jt >> 5)];
                const bool mysel = (wd >> (jt & 31)) & 1u;
                if (__any(mysel)) {
                    const int k0 = jt * 64;
                    const bool nearb = (64 * bi + 32 * th) - (k0 + 63) < 790;
                    const int dbase = tq - k0 - 8 * h;
                    const float* lp = mylut + (LUT_OFF - dbase);
#pragma unroll
                    for (int mt = 0; mt < 2; ++mt) {
                        f32x16 st;
                        attn_qk32<128>(cur, qf, st, mt, r, h, mysel ? nmb : -INFINITY);
                        if (nearb) {
#pragma unroll
                            for (int i = 0; i < 16; ++i) st[i] += lp[kidx(mt, i)];
                        }
                        attn_softmax32_b(st, l);
                        bf16x8 pf[2];
                        attn_pack32(st, pf);
                        attn_pv32(cur + 16384, pf, o, mt, r, h);
                    }
                }
                __syncthreads();
                buf ^= 1; jt = jn;
            }
        }
        {
            const float lt = sum_x32(l);
            const float sc = (lt > 0.f ? frcp(lt) : 0.f) * gp[1];
#pragma unroll
            for (int dt = 0; dt < 4; ++dt)
#pragma unroll
                for (int g4 = 0; g4 < 4; ++g4) {
                    const int d0 = 32 * dt + 8 * g4 + 4 * h;
                    const u32x2 pv = *(const u32x2*)(orow + d0);
                    u32x2 ov;
                    ov.x = pk2(bflo(pv.x) + o[dt][4 * g4 + 0] * sc, bfhi(pv.x) + o[dt][4 * g4 + 1] * sc);
                    ov.y = pk2(bflo(pv.y) + o[dt][4 * g4 + 2] * sc, bfhi(pv.y) + o[dt][4 * g4 + 3] * sc);
                    *(u32x2*)(orow + d0) = ov;
                }
        }
        const unsigned char* kwg = (const unsigned char*)(KW + (long)(b * 2 + g) * SEQ * 128);
        const unsigned char* vwg = (const unsigned char*)(VWT + (long)(b * 2 + g) * 128 * SEQ);
        reset(); load_q(qrow);
        {
            const float nmb = -(qn_main * kmx[2] + bmxs[hg]);
            const int j0 = bi >= 8 ? bi - 8 : 0, nt = (VAR == 2 || VAR == 4 || VAR == 5) ? 1 : bi - j0 + 1;
            stage(kwg, vwg, SEQ * 2u, j0, lds);
            __syncthreads();
            for (int kt = 0; kt < nt; ++kt) {
                unsigned char* cur = lds + (kt & 1) * AT_STAGE;
                if (kt + 1 < nt) stage(kwg, vwg, SEQ * 2u, j0 + kt + 1, lds + ((kt + 1) & 1) * AT_STAGE);
                const int k0 = (j0 + kt) * 64;
                const int dbase = tq - k0 - 8 * h;
                const float* lp = mylut + (LUT_OFF - dbase);
#pragma unroll
                for (int mt = 0; mt < 2; ++mt) {
                    f32x16 st;
                    attn_qk32<128>(cur, qf, st, mt, r, h, nmb);
#pragma unroll
                    for (int i = 0; i < 16; ++i) st[i] = kidx(mt, i) <= dbase - 512 ? -INFINITY : st[i] + lp[kidx(mt, i)];
                    attn_softmax32_b(st, l);
                    bf16x8 pf[2];
                    attn_pack32(st, pf);
                    attn_pv32(cur + 16384, pf, o, mt, r, h);
                }
                __syncthreads();
            }
        }
        {
            const float lt = sum_x32(l);
            const float sc = (lt > 0.f ? frcp(lt) : 0.f) * gp[2];
#pragma unroll
            for (int dt = 0; dt < 4; ++dt)
#pragma unroll
                for (int g4 = 0; g4 < 4; ++g4) {
                    const int d0 = 32 * dt + 8 * g4 + 4 * h;
                    const u32x2 pv = *(const u32x2*)(orow + d0);
                    u32x2 ov;
                    ov.x = pk2(bflo(pv.x) + o[dt][4 * g4 + 0] * sc, bfhi(pv.x) + o[dt][4 * g4 + 1] * sc);
                    ov.y = pk2(bflo(pv.y) + o[dt][4 * g4 + 2] * sc, bfhi(pv.y) + o[dt][4 * g4 + 3] * sc);
                    *(u32x2*)(orow + d0) = ov;
                }
        }
        __syncthreads();
    }
}

DI void fp8x16_fma(const u32x4& q, const f32x4& h0, const f32x4& h1, const f32x4& h2, const f32x4& h3, f32x2& a0, f32x2& a1) {
    a0 += __builtin_amdgcn_cvt_pk_f32_fp8((int)q.x, false) * (f32x2){h0.x, h0.y};
    a1 += __builtin_amdgcn_cvt_pk_f32_fp8((int)q.x, true)  * (f32x2){h0.z, h0.w};
    a0 += __builtin_amdgcn_cvt_pk_f32_fp8((int)q.y, false) * (f32x2){h1.x, h1.y};
    a1 += __builtin_amdgcn_cvt_pk_f32_fp8((int)q.y, true)  * (f32x2){h1.z, h1.w};
    a0 += __builtin_amdgcn_cvt_pk_f32_fp8((int)q.z, false) * (f32x2){h2.x, h2.y};
    a1 += __builtin_amdgcn_cvt_pk_f32_fp8((int)q.z, true)  * (f32x2){h2.z, h2.w};
    a0 += __builtin_amdgcn_cvt_pk_f32_fp8((int)q.w, false) * (f32x2){h3.x, h3.y};
    a1 += __builtin_amdgcn_cvt_pk_f32_fp8((int)q.w, true)  * (f32x2){h3.z, h3.w};
}
template <bool DRY>
DI void phase_peer_u(const Params& p, int layer, unsigned char* lds, int tid) {
    unsigned char* ws = p.ws;
    const unsigned char* H8 = ws + OFF_H8;
    const float* HS = (const float*)(ws + OFF_HS);
    const int* ridx = (const int*)(ws + OFF_RIDX);
    float* rgate = (float*)(ws + OFF_RGATE);
    const unsigned char* U = ws + OFF_PU + (long)layer * 16384 * 1024;
    const float* usi = (const float*)(ws + OFF_USI) + layer * 16384;
    const float* vsi = (const float*)(ws + OFF_VSI) + layer * 16384;
    const int lane = tid & 63, w = tid >> 6, sub = lane & 7, grp = lane >> 3;
    const int xg = blockIdx.x & 7, lb = blockIdx.x >> 3, nwv = (gridDim.x >> 3) * NWAVES, wv = lb * NWAVES + w;
    unsigned* clb = (unsigned*)(lds + w * 12288);
    unsigned char* hbb = lds + w * 12288 + 2048;
    const unsigned long long lt = (1ull << lane) - 1ull;
    if (lb >= (int)(gridDim.x >> 3)) return;
    int i0, i1; u32x4 h0; float hs0;
    auto ld_tok = [&](int tk) {
        tk = tk < NTOK ? tk : wv;
        i0 = ridx[(long)tk * 128 + lane]; i1 = ridx[(long)tk * 128 + 64 + lane];
        h0 = *(const u32x4*)(H8 + (long)tk * DM + lane * 16); hs0 = HS[tk];
    };
    auto stage_tok = [&](int bi, float& hsinv) -> int {
        unsigned* cl = clb + bi * 256; unsigned char* hb = hbb + bi * 4096;
        const bool b0 = (i0 >> 11) == xg, b1 = (i1 >> 11) == xg;
        const unsigned long long m0 = __ballot(b0), m1 = __ballot(b1);
        const int n0 = __popcll(m0), n = n0 + __popcll(m1);
        if (b0) { const int k = __popcll(m0 & lt); cl[2 * k] = lane; cl[2 * k + 1] = i0; }
        if (b1) { const int k = n0 + __popcll(m1 & lt); cl[2 * k] = 64 + lane; cl[2 * k + 1] = i1; }
        if (n == 0 && lane == 0) { cl[0] = 0u; cl[1] = 0u; }
        hsinv = hs0;
        *(u32x4*)(hb + lane * 16) = h0;
        return n;
    };
    float shC, shN = 1.f;
    ld_tok(wv);
    int nC = stage_tok(0, shC);
    ld_tok(wv + nwv);
    int slotC, idC; bool validC;
    { validC = grp < nC; const int kk = validC ? grp : 0; slotC = clb[2 * kk]; idC = clb[2 * kk + 1]; }
    u32x4 uv[8];
    {
        const unsigned uoff = (unsigned)idC * 1024u + (unsigned)sub * 16u;
#pragma unroll
        for (int t = 0; t < 8; ++t) uv[t] = *(const u32x4*)(U + (uoff + t * 128));
    }
    int it = 0;
    for (int tok = wv; tok < NTOK; tok += nwv, ++it) {
        const int cb = it & 1;
        const unsigned* clC = clb + cb * 256; const unsigned* clN = clb + (cb ^ 1) * 256;
        const unsigned char* hbC = hbb + cb * 4096;
        const bool more = tok + nwv < NTOK;
        int nN = 0;
        if (more) { nN = stage_tok(cb ^ 1, shN); ld_tok(tok + 2 * nwv); }
        const int nr = nC > 8 ? (nC + 7) >> 3 : 1;
        u32x4 hq[8];
#pragma unroll
        for (int t = 0; t < 8; ++t) hq[t] = *(const u32x4*)(hbC + (sub + 8 * t) * 16);
        for (int rd = 0; rd < nr; ++rd) {
            float g_in = 0.f, su = 0.f, sv = 0.f;
            if (validC && sub == 0) { g_in = rgate[(long)tok * 128 + slotC]; su = usi[idC]; sv = vsi[idC]; }
            int slotN, idN; bool validN;
            if (rd + 1 < nr) { const int k = 8 * (rd + 1) + grp; validN = k < nC; const int kk = validN ? k : 0; slotN = clC[2 * kk]; idN = clC[2 * kk + 1]; }
            else if (more) { validN = grp < nN; const int kk = validN ? grp : 0; slotN = clN[2 * kk]; idN = clN[2 * kk + 1]; }
            else { validN = false; slotN = 0; idN = clC[1]; }
            const unsigned uoffN = (unsigned)idN * 1024u + (unsigned)sub * 16u;
            int a0 = 0, a1 = 0, a2 = 0, a3 = 0;
#pragma unroll
            for (int t = 0; t < 8; ++t) {
                const u32x4 q = uv[t];
                a0 = __builtin_amdgcn_sdot4((int)q.x, (int)hq[t].x, a0, false); a1 = __builtin_amdgcn_sdot4((int)q.y, (int)hq[t].y, a1, false);
                a2 = __builtin_amdgcn_sdot4((int)q.z, (int)hq[t].z, a2, false); a3 = __builtin_amdgcn_sdot4((int)q.w, (int)hq[t].w, a3, false);
                uv[t] = *(const u32x4*)(U + (uoffN + t * 128));
            }
            int di = (a0 + a1) + (a2 + a3);
            di += __builtin_amdgcn_update_dpp(0, di, 0xB1, 0xF, 0xF, true);
            di += __builtin_amdgcn_update_dpp(0, di, 0x4E, 0xF, 0xF, true);
            di += __builtin_amdgcn_update_dpp(0, di, 0x141, 0xF, 0xF, true);
            if (validC && sub == 0) {
                float* gw = DRY ? (float*)(ws + OFF_R) + (long)tok * 128 + slotC : rgate + (long)tok * 128 + slotC;
                *gw = g_in * gelu_tanh((float)di * su * shC) * sv;
            }
            slotC = slotN; idC = idN; validC = validN;
        }
        nC = nN; shC = shN;
    }
}

#ifndef VMASK
#define VMASK 0xffffffffu
#endif
template <bool DRY>
DI void phase_peer_v(const Params& p, int layer, int tid) {
    unsigned char* ws = p.ws;
    const int* ridx = (const int*)(ws + OFF_RIDX);
    const float* wact = (const float*)(ws + OFF_RGATE);
    const float* ada = (const float*)(ws + OFF_ADA);
    float* x = opq(p.out);
    const int lane = tid & 63, w = tid >> 6, sub = lane & 7, eg = lane >> 3;
    const int xg = blockIdx.x & 7, lb = blockIdx.x >> 3, nwv = (gridDim.x >> 3) * NWAVES, wv = lb * NWAVES + w;
    if (lb >= (int)(gridDim.x >> 3)) return;
    const unsigned char* Vc = ws + OFF_PV + ((long)(layer * 8 + xg) * 16384) * 128;
    const int col0 = 128 * xg + 16 * sub;
    const __amdgpu_buffer_rsrc_t vrs = __builtin_amdgcn_make_buffer_rsrc((void*)Vc, (short)0, 16384 * 128, 0x00020000);
    auto ld_ids = [&](int tk, u32x4 (&a)[4], f32x4 (&wq)[4]) {
        tk = tk < NTOK ? tk : wv;
        const u32x4* ip = (const u32x4*)(ridx + (long)tk * 128 + eg * 16);
        const f32x4* wp = (const f32x4*)(wact + (long)tk * 128 + eg * 16);
#pragma unroll
        for (int q = 0; q < 4; ++q) { a[q] = ip[q]; wq[q] = wp[q]; }
    };
    u32x4 vv[16];
    u32x4 na[4], pa[4]; f32x4 cw[4], nw[4], pw[4];
    {
        u32x4 a[4];
        ld_ids(wv, a, cw);
#pragma unroll
        for (int j = 0; j < 16; ++j)
            vv[j] = __builtin_bit_cast(u32x4, __builtin_amdgcn_raw_buffer_load_b128(vrs, (int)((a[j >> 2][j & 3] & (DRY ? VMASK : 0xffffffffu)) * 128u + (unsigned)sub * 16u), 0, 0));
    }
    ld_ids(wv + nwv, na, nw);
    f32x4 gfv[4]; int gb = -1;
    for (int tok = wv; tok < NTOK; tok += nwv) {
        ld_ids(tok + 2 * nwv, pa, pw);
        f32x4 xv[4];
        {
            const float* xin = x + (long)tok * DM + col0;
#pragma unroll
            for (int c = 0; c < 4; ++c) xv[c] = *(const f32x4*)(xin + 4 * c);
            const int b = tok >> 13;
            if (b != gb) {
                gb = b;
                const float* gf = ada + b * ADA_STRIDE + layer * 6144 + 5 * 1024 + col0;
#pragma unroll
                for (int c = 0; c < 4; ++c) gfv[c] = *(const f32x4*)(gf + 4 * c);
            }
        }
        f32x2 ap[8];
#pragma unroll
        for (int i = 0; i < 8; ++i) ap[i] = (f32x2){0.f, 0.f};
#pragma unroll
        for (int j = 0; j < 16; ++j) {
            const float ws1 = cw[j >> 2][j & 3]; const f32x2 ww = {ws1, ws1}; const u32x4 v = vv[j];
            ap[0] += __builtin_amdgcn_cvt_pk_f32_fp8((int)v.x, false) * ww; ap[1] += __builtin_amdgcn_cvt_pk_f32_fp8((int)v.x, true) * ww;
            ap[2] += __builtin_amdgcn_cvt_pk_f32_fp8((int)v.y, false) * ww; ap[3] += __builtin_amdgcn_cvt_pk_f32_fp8((int)v.y, true) * ww;
            ap[4] += __builtin_amdgcn_cvt_pk_f32_fp8((int)v.z, false) * ww; ap[5] += __builtin_amdgcn_cvt_pk_f32_fp8((int)v.z, true) * ww;
            ap[6] += __builtin_amdgcn_cvt_pk_f32_fp8((int)v.w, false) * ww; ap[7] += __builtin_amdgcn_cvt_pk_f32_fp8((int)v.w, true) * ww;
            vv[j] = __builtin_bit_cast(u32x4, __builtin_amdgcn_raw_buffer_load_b128(vrs, (int)((na[j >> 2][j & 3] & (DRY ? VMASK : 0xffffffffu)) * 128u + (unsigned)sub * 16u), 0, 0));
        }
        float acc[16];
#pragma unroll
        for (int i = 0; i < 8; ++i) { acc[2 * i] = ap[i].x; acc[2 * i + 1] = ap[i].y; }
#pragma unroll
        for (int i = 0; i < 16; ++i) { acc[i] += lr8(acc[i]); acc[i] = sum_x16(acc[i]); acc[i] = sum_x32(acc[i]); }
        if (eg == 0) {
            float* xr = DRY ? (float*)(ws + OFF_R + 16 * MB) + (long)tok * DM + col0 : x + (long)tok * DM + col0;
#pragma unroll
            for (int c = 0; c < 4; ++c) {
                const f32x4 gv = gfv[c];
                f32x4 o;
                o.x = xv[c].x + gv.x * acc[4 * c + 0]; o.y = xv[c].y + gv.y * acc[4 * c + 1];
                o.z = xv[c].z + gv.z * acc[4 * c + 2]; o.w = xv[c].w + gv.w * acc[4 * c + 3];
                *(f32x4*)(xr + 4 * c) = o;
            }
        }
#pragma unroll
        for (int q = 0; q < 4; ++q) { cw[q] = nw[q]; na[q] = pa[q]; nw[q] = pw[q]; }
    }
}

DI void phase_norm2(const float* __restrict__ x, bf16_t* __restrict__ out1, const float* gain1, int sh1, int sc1,
                    bf16_t* __restrict__ out2, const float* gain2, int sh2, int sc2, const float* ada, int tid) {
    const int lane = tid & 63, gw = blockIdx.x * NWAVES + (tid >> 6), nw = gridDim.x * NWAVES;
    for (int tok = gw; tok < NTOK; tok += nw) {
        const int b = tok >> 13;
        f32x4 v[4]; float ss = 0.f;
#pragma unroll
        for (int j = 0; j < 4; ++j) { v[j] = *(const f32x4*)(x + (long)tok * DM + 4 * lane + 256 * j); ss += v[j].x * v[j].x + v[j].y * v[j].y + v[j].z * v[j].z + v[j].w * v[j].w; }
        const float rstd = rsqrtf(wave_sum(ss) * (1.f / DM) + EPS);
        norm_row_write(v, rstd, gain1, ada + b * ADA_STRIDE + sh1, ada + b * ADA_STRIDE + sc1, out1 + (long)tok * DM, lane);
        norm_row_write(v, rstd, gain2, ada + b * ADA_STRIDE + sh2, ada + b * ADA_STRIDE + sc2, out2 + (long)tok * DM, lane);
    }
}

template <int MT, class Epi>
DI void gemm_phase(const bf16_t* A, long lda, int M, const bf16_t* Bt, long ldb, int N, int K, const Epi& epi, unsigned char* lds, int tid) {
    const int ntm = (M + 128 * MT - 1) / (128 * MT), ntn = (N + 255) / 256, nt = ntm * ntn;
    if ((gridDim.x & 7) == 0 && (ntm & 31) == 0) {
        const int xcd = blockIdx.x & 7, lb = blockIdx.x >> 3, nlb = gridDim.x >> 3, tmx = ntm >> 3, per = tmx * ntn;
        for (int q = lb; q < per; q += nlb) {
            const int g4 = q / (4 * ntn), rem = q - g4 * 4 * ntn, tn = rem >> 2, tm = xcd * tmx + g4 * 4 + (rem & 3);
            if (tm < (xcd + 1) * tmx) gemm_tile<MT>(A, lda, M, Bt, ldb, N, K, tm * 128 * MT, tn * 256, epi, lds, tid);
        }
        return;
    }
    for (int t = blockIdx.x; t < nt; t += gridDim.x) {
        const int tn = t / ntm, tm = t % ntm;
        gemm_tile<MT>(A, lda, M, Bt, ldb, N, K, tm * 128 * MT, tn * 256, epi, lds, tid);
    }
}

#define XB_TMO      128
#define XB_XCNT(j)  (256  + 64 * (j))
#define XB_XSUB(j)  (1280 + 64 * (j))
#define XB_XGEN(j)  (2304 + 64 * (j))
#define XB_TOP      3328
#define XB_TOPGEN   3392
#define XCD_BAR_WORDS 3456
#define XB_SPIN_CAP (1u << 22)
#define LAS __attribute__((address_space(3)))
DI unsigned xb_ld(unsigned* p) { return __hip_atomic_load(p, __ATOMIC_RELAXED, __HIP_MEMORY_SCOPE_AGENT); }
DI unsigned xb_add(unsigned* p, unsigned v) { return __hip_atomic_fetch_add(p, v, __ATOMIC_RELAXED, __HIP_MEMORY_SCOPE_AGENT); }
DI unsigned xb_xcc_id() { return (unsigned)__builtin_amdgcn_s_getreg((3 << 11) | 20) & 0xFu; }
#define XB_SPIN(cond, bar) do { unsigned _sp = 0; while (cond) { __builtin_amdgcn_s_sleep(1); \
    if ((++_sp & 255u) == 0u) { if (xb_ld(&(bar)[XB_TMO])) break; if (_sp > XB_SPIN_CAP) { atomicAdd(&(bar)[XB_TMO], 1u); break; } } } } while (0)
DI void xcd_barrier_complete(unsigned* bar, unsigned x, unsigned& nloc, unsigned& nx) {
    const unsigned G = gridDim.x;
    unsigned sum, cnt, mine, sp = 0u;
    for (;;) {
        sum = 0u; cnt = 0u; mine = 0u;
#pragma unroll
        for (unsigned j = 0; j < 16; ++j) { const unsigned c = xb_ld(&bar[XB_XCNT(j)]); sum += c; cnt += (c > 0u) ? 1u : 0u; mine = (j == x) ? c : mine; }
        if (sum == G) break;
        __builtin_amdgcn_s_sleep(1);
        if ((++sp & 255u) == 0u) { if (xb_ld(&bar[XB_TMO])) break; if (sp > XB_SPIN_CAP) { atomicAdd(&bar[XB_TMO], 1u); break; } }
    }
    nloc = mine > 0u ? mine : 1u; nx = cnt > 0u ? cnt : 1u;
}
DI void xcd_barrier(unsigned* bar, volatile LAS unsigned* st, int tid) {
    asm volatile("s_waitcnt vmcnt(0)" ::: "memory");
    __syncthreads();
    if (tid == 0) {
        const unsigned x = xb_xcc_id();
        __builtin_amdgcn_s_waitcnt(0);
        unsigned nloc = st[0], nx = st[1];
        if (nloc == 0u) { xcd_barrier_complete(bar, x, nloc, nx); st[0] = nloc; st[1] = nx; }
        const unsigned old = xb_add(&bar[XB_XSUB(x)], 1u);
        const unsigned gen = old / nloc;
        if (old + 1u == (gen + 1u) * nloc) {
            __builtin_amdgcn_fence(__ATOMIC_RELEASE, "agent");
            asm volatile("s_waitcnt vmcnt(0)" ::: "memory");
            const unsigned og = xb_add(&bar[XB_TOP], 1u);
            const unsigned tg = og / nx;
            if (og + 1u == (tg + 1u) * nx) xb_add(&bar[XB_TOPGEN], 1u);
            else XB_SPIN(xb_ld(&bar[XB_TOPGEN]) == tg, bar);
            __builtin_amdgcn_fence(__ATOMIC_ACQUIRE, "agent");
            xb_add(&bar[XB_XGEN(x)], 1u);
            asm volatile("s_waitcnt vmcnt(0)" ::: "memory");
        } else {
            XB_SPIN(xb_ld(&bar[XB_XGEN(x)]) == gen, bar);
            __builtin_amdgcn_fence(__ATOMIC_ACQUIRE, "agent");
            asm volatile("s_waitcnt vmcnt(0)" ::: "memory");
        }
    }
    __syncthreads();
}

#define ftid() ftid_(wave_u)
DI int ftid_(int wave_u) { int t = (wave_u << 6) + (int)__builtin_amdgcn_mbcnt_hi(~0u, __builtin_amdgcn_mbcnt_lo(~0u, 0u)); asm volatile("" : "+v"(t)); return t; }


#if defined(__HIP_DEVICE_COMPILE__)
typedef const __attribute__((address_space(4))) Params* KParamPtr;
DI Params load_params() { KParamPtr kp = (KParamPtr)__builtin_amdgcn_kernarg_segment_ptr(); asm volatile("" : "+s"(kp)); return *kp; }
#else
DI Params load_params() { return Params{}; }
#endif
#define p (load_params())
#define ws (load_params().ws)
#define ada ((const float*)(ws + OFF_ADA))
#define Hb ((bf16_t*)(ws + OFF_H))
#define bar ((unsigned*)(ws + OFF_BAR))
__global__ void __launch_bounds__(NTHREADS) yoco_fwd(Params p_arg) {
    extern __shared__ __attribute__((aligned(16))) unsigned char lds[];
    cg::grid_group grid = cg::this_grid();
    volatile LAS unsigned* bst = (volatile LAS unsigned*)(lds + 144 * 1024);
    const int wave_u = __builtin_amdgcn_readfirstlane((int)(threadIdx.x >> 6));
    { const int t0 = ftid(); if (t0 == 0) { bst[0] = 0u; bst[1] = 0u; }
      if (blockIdx.x == 0) for (int i = t0; i < XCD_BAR_WORDS; i += NTHREADS) bar[i] = 0u; }
    __syncthreads();
    RUN(0) REP(0) phase_prep(p, lds, ftid());
    grid.sync();
    if (ftid() == 0) (void)xb_add(&bar[XB_XCNT(xb_xcc_id())], 1u);
    RUN(1) REP(1) phase_norm(p.in[0], Hb, p.in[5], ada, 0, 1024, ftid());
    xcd_barrier(bar, bst, ftid());
    RUN(2) REP(2) {
        EpiQKV0 e{(bf16_t*)(ws + OFF_Q0), (bf16_t*)(ws + OFF_K0), (bf16_t*)(ws + OFF_VT0), p.in[10], p.in[11], (float*)(ws + OFF_MB0), p.in[2]};
        gemm_phase<2>(Hb, DM, NTOK, (const bf16_t*)(ws + OFF_WT_DIN), DM, 3072, DM, e, lds, ftid());
    }
    xcd_barrier(bar, bst, ftid());
    RUN(3) REP(3) phase_diff_attn(p, lds, ftid());
    xcd_barrier(bar, bst, ftid());
    RUN(4) REP(4) {
        EpiResid e{p.in[0], opq(p.out), ada + 2 * 1024};
        gemm_phase<2>(Hb, DM, NTOK, (const bf16_t*)(ws + OFF_WT_DOUT), DM, 1024, DM, e, lds, ftid());
    }
    xcd_barrier(bar, bst, ftid());
    if (STOP_AFTER <= 1) return;
    RUN(1) phase_norm_q8(opq(p.out), Hb, ws + OFF_H8, (float*)(ws + OFF_HS), p.in[6], ada, 3 * 1024, 4 * 1024, ftid());
    xcd_barrier(bar, bst, ftid());
    RUN(5) REP(5) {
        EpiPeer e{(int*)(ws + OFF_RIDX), (float*)(ws + OFF_RGATE), 128 * 1024};
        gemm_phase<2>(Hb, DM, NTOK, (const bf16_t*)(ws + OFF_WT_PEER), DM, 2048, DM, e, lds, ftid());
    }
    xcd_barrier(bar, bst, ftid());
    if ((REPEAT_MASK >> 6) & 1) phase_peer_u<true>(p, 0, lds, ftid());
    RUN(6) phase_peer_u<false>(p, 0, lds, ftid());
    xcd_barrier(bar, bst, ftid());
    if ((REPEAT_MASK >> 10) & 1) phase_peer_v<true>(p, 0, ftid());
    RUN(6) phase_peer_v<false>(p, 0, ftid());
    xcd_barrier(bar, bst, ftid());
    RUN(1) phase_norm2(opq(p.out), (bf16_t*)(ws + OFF_H2), p.in[13], 12288, 12288 + 1024, Hb, p.in[5] + 1024, 6144, 6144 + 1024, ada, ftid());
    xcd_barrier(bar, bst, ftid());
    if (STOP_AFTER <= 2) return;
    RUN(7) REP(7) {
        EpiKV e{(bf16_t*)(ws + OFF_KC), (bf16_t*)(ws + OFF_KS), (bf16_t*)(ws + OFF_VST), (bf16_t*)(ws + OFF_KW), (bf16_t*)(ws + OFF_VWT), p.in[21]};
        gemm_phase<2>((const bf16_t*)(ws + OFF_H2), DM, NTOK, (const bf16_t*)(ws + OFF_WT_KV), DM, 1536, DM, e, lds, ftid());
    }
    xcd_barrier(bar, bst, ftid());
    RUN(8) REP(8) {
        EpiNsaQ e{(bf16_t*)(ws + OFF_QN), (float*)(ws + OFF_GATES), p.in[25], p.in[23], (float*)(ws + OFF_MB1)};
        gemm_phase<2>(Hb, DM, NTOK, (const bf16_t*)(ws + OFF_WT_NIN), DM, 1048, DM, e, lds, ftid());
        for (int t = blockIdx.x; t < 64; t += gridDim.x) {
            const int pr = t >> 2, tm = t & 3, kv = pr >> 3, bg = pr & 7;
            const bf16_t* Ap = (const bf16_t*)(ws + OFF_KC) + (long)(kv * 8 + bg) * SEQ * 128;
            bf16_t* hid = (bf16_t*)(ws + OFF_HID) + (long)pr * 512 * 256;
            EpiCmp1 e1{hid, (const float*)(ws + OFF_POSB) + kv * 16 * 256, p.in[19] + kv * 256};
            gemm_tile<1>(Ap, 2048, 511, (const bf16_t*)(ws + OFF_WT_C1) + (long)kv * 256 * 4096, 4096, 256, 4096, tm * 128, 0, e1, lds, ftid());
            __syncthreads();
            bf16_t* dst = kv == 0 ? (bf16_t*)(ws + OFF_KCMP) + (long)bg * 512 * 128 : (bf16_t*)(ws + OFF_VCMPT) + (long)bg * 128 * 512;
            EpiCmp2 e2{dst, p.in[21], kv};
            gemm_tile<1>(hid, 256, 512, (const bf16_t*)(ws + OFF_WT_C2) + (long)kv * 128 * 256, 256, 128, 256, tm * 128, 0, e2, lds, ftid());
        }
    }
    xcd_barrier(bar, bst, ftid());
#ifdef NSA_PROBE
    phase_nsa_attn<NSA_PROBE>(p, lds, ftid());
#endif
    RUN(9) REP(9) phase_nsa_attn<0>(p, lds, ftid());
    xcd_barrier(bar, bst, ftid());
    RUN(4) {
        float* xo = opq(p.out);
        EpiResid e{xo, xo, ada + 6144 + 2 * 1024};
        gemm_phase<2>(Hb, DM, NTOK, (const bf16_t*)(ws + OFF_WT_NOUT), DM, 1024, DM, e, lds, ftid());
    }
    xcd_barrier(bar, bst, ftid());
    if (STOP_AFTER <= 3) return;
    RUN(1) phase_norm_q8(opq(p.out), Hb, ws + OFF_H8, (float*)(ws + OFF_HS), p.in[6] + 1024, ada, 6144 + 3 * 1024, 6144 + 4 * 1024, ftid());
    xcd_barrier(bar, bst, ftid());
    RUN(5) REP(5) {
        EpiPeer e{(int*)(ws + OFF_RIDX), (float*)(ws + OFF_RGATE), 128 * 1024};
        gemm_phase<2>(Hb, DM, NTOK, (const bf16_t*)(ws + OFF_WT_PEER) + (long)2048 * 1024, DM, 2048, DM, e, lds, ftid());
    }
    xcd_barrier(bar, bst, ftid());
    if ((REPEAT_MASK >> 6) & 1) phase_peer_u<true>(p, 1, lds, ftid());
    RUN(6) phase_peer_u<false>(p, 1, lds, ftid());
    xcd_barrier(bar, bst, ftid());
    if ((REPEAT_MASK >> 10) & 1) phase_peer_v<true>(p, 1, ftid());
    RUN(6) phase_peer_v<false>(p, 1, ftid());
}
#undef p
#undef ws
#undef ada
#undef Hb
#undef bar

extern "C" void kernel_launch(void* const* d_in, const int* in_sizes, int n_in, void* d_out, int out_size, void* d_ws, size_t ws_size,
                              hipStream_t stream) {
    static int grid_blocks = 0;
    if (grid_blocks == 0) {
        if (n_in != 30 || out_size != NTOK * DM || ws_size < WS_END) {
            fprintf(stderr, "kernel_launch: unexpected shapes (n_in %d out %d ws %zu)\n", n_in, out_size, ws_size);
            grid_blocks = -1; return;
        }
        int dev = 0, cus = 0, per_cu = 0;
        hipGetDevice(&dev);
        hipDeviceGetAttribute(&cus, hipDeviceAttributeMultiprocessorCount, dev);
        hipFuncSetAttribute((const void*)yoco_fwd, hipFuncAttributeMaxDynamicSharedMemorySize, LDS_BYTES);
        hipOccupancyMaxActiveBlocksPerMultiprocessor(&per_cu, (const void*)yoco_fwd, NTHREADS, LDS_BYTES);
        if (per_cu < 1) { fprintf(stderr, "kernel_launch: occupancy query says %d blocks per CU\n", per_cu); grid_blocks = -1; return; }
        grid_blocks = cus;
    }
    if (grid_blocks < 0) return;
    Params p{};
    for (int i = 0; i < 30; ++i) p.in[i] = (const float*)d_in[i];
    p.out = (float*)d_out;
    p.ws = (unsigned char*)d_ws;
    void* args[] = {&p};
    hipError_t e = hipLaunchCooperativeKernel((const void*)yoco_fwd, dim3(grid_blocks), dim3(NTHREADS), args, LDS_BYTES, stream);
    if (e != hipSuccess) fprintf(stderr, "cooperative launch failed: %s (grid %d)\n", hipGetErrorString(e), grid_blocks);
}
```

```cpp
#include <hip/hip_runtime.h>
#include <hip/hip_cooperative_groups.h>
#include <cstdio>
#include <cstdint>
namespace cg = cooperative_groups;

#define DI __device__ __forceinline__
#ifndef STOP_AFTER
#define STOP_AFTER 99
#endif
#ifndef ONLY_PHASE
#define ONLY_PHASE -1
#endif
#define RUN(n) if (ONLY_PHASE < 0 || ONLY_PHASE == (n))
#ifndef REPEAT_MASK
#define REPEAT_MASK 0
#endif
#define REP(n) for (int rep_ = 0; rep_ < (((REPEAT_MASK) >> (n)) & 1) + 1; ++rep_)

typedef unsigned short bf16_t;
typedef short bf16x8 __attribute__((ext_vector_type(8)));
typedef float f32x16 __attribute__((ext_vector_type(16)));
typedef float f32x4 __attribute__((ext_vector_type(4)));
typedef float f32x2 __attribute__((ext_vector_type(2)));
typedef unsigned u32x4 __attribute__((ext_vector_type(4)));
typedef unsigned u32x2 __attribute__((ext_vector_type(2)));
typedef __bf16 bf16x2v __attribute__((ext_vector_type(2)));

#define MFMA32(a, b, c) __builtin_amdgcn_mfma_f32_32x32x16_bf16((a), (b), (c), 0, 0, 0)
typedef int i32x4 __attribute__((ext_vector_type(4)));
typedef int i32x16 __attribute__((ext_vector_type(16)));
#define MFMA32I8(a, b, c) __builtin_amdgcn_mfma_i32_32x32x32_i8((a), (b), (c), 0, 0, 0)

constexpr int NB = 4, SEQ = 8192, DM = 1024, NTOK = NB * SEQ;
constexpr int NTHREADS = 512, NWAVES = 8;
constexpr float EPS = 1e-6f;
constexpr float LOG2E = 1.4426950408889634f;
constexpr int ADA_STRIDE = 14336;

constexpr size_t MB = 1u << 20;
constexpr size_t OFF_ADA = 0;
constexpr size_t OFF_POSB = 256 * 1024;
constexpr size_t OFF_BAR = 320 * 1024;
constexpr size_t OFF_MB0 = 168 * MB;
constexpr size_t OFF_MB1 = 172 * MB;
constexpr size_t OFF_H8 = 104 * MB;
constexpr size_t OFF_HS = 174 * MB;
constexpr size_t OFF_W8 = 176 * MB;
constexpr size_t OFF_W8_DIN = OFF_W8, OFF_W8_KV = OFF_W8 + 3 * MB, OFF_W8_NIN = OFF_W8 + 5 * MB, OFF_W8_PEER = OFF_W8 + 7 * MB;
constexpr size_t OFF_W8S = 188 * MB;
constexpr int W8S_DIN = 0, W8S_KV = 3072, W8S_NIN = 4608, W8S_PEER = 5760, W8S_TOTAL = 9856;
constexpr size_t OFF_USI = 384 * 1024;
constexpr size_t OFF_VSI = 512 * 1024;
constexpr size_t OFF_WT_DIN = 1 * MB;
constexpr size_t OFF_WT_DOUT = 7 * MB;
constexpr size_t OFF_WT_KV = 9 * MB;
constexpr size_t OFF_WT_NIN = 12 * MB;
constexpr size_t OFF_WT_NOUT = 15 * MB;
constexpr size_t OFF_WT_PEER = 17 * MB;
constexpr size_t OFF_WT_C1 = 25 * MB;
constexpr size_t OFF_WT_C2 = 29 * MB;
constexpr size_t OFF_GATES = 30 * MB;
constexpr size_t OFF_KCMP = 34 * MB;
constexpr size_t OFF_VCMPT = 35 * MB;
constexpr size_t OFF_HID = 36 * MB;
constexpr size_t OFF_RIDX = 40 * MB;
constexpr size_t OFF_RGATE = 56 * MB;
constexpr size_t OFF_PU = 72 * MB;
constexpr size_t OFF_PV = 136 * MB;
constexpr size_t OFF_H = 200 * MB;
constexpr size_t OFF_R = 264 * MB;
constexpr size_t WS_END = 456 * MB;
constexpr size_t OFF_Q0 = OFF_R, OFF_K0 = OFF_R + 64 * MB, OFF_VT0 = OFF_R + 128 * MB;
constexpr size_t OFF_QN = OFF_R, OFF_H2 = OFF_R, OFF_KC = OFF_R + 64 * MB, OFF_KS = OFF_R + 96 * MB, OFF_VST = OFF_R + 112 * MB,
                 OFF_KW = OFF_R + 128 * MB, OFF_VWT = OFF_R + 144 * MB;

constexpr int LDS_BYTES = 144 * 1024 + 256;

struct Params {
    const float* in[30];
    float* out;
    unsigned char* ws;
};

template <class T> DI T* opq(T* q) { asm volatile("" : "+s"(q)); return (T*)(__attribute__((address_space(1))) T*)q; }
DI unsigned pk2(float lo, float hi) { f32x2 v = {lo, hi}; return __builtin_bit_cast(unsigned, __builtin_convertvector(v, bf16x2v)); }
DI bf16_t f2bf(float x) { return (bf16_t)(pk2(x, 0.f) & 0xffffu); }
DI float bflo(unsigned u) { return __uint_as_float(u << 16); }
DI float bfhi(unsigned u) { return __uint_as_float(u & 0xffff0000u); }
DI float fexp2(float x) { return __builtin_amdgcn_exp2f(x); }
DI float frcp(float x) { return __builtin_amdgcn_rcpf(x); }
DI int crow(int reg, int h) { return (reg & 3) + 8 * (reg >> 2) + 4 * h; }
template <int CTRL> DI float dpp_f(float v) { return __builtin_bit_cast(float, __builtin_amdgcn_update_dpp(0, __builtin_bit_cast(int, v), CTRL, 0xF, 0xF, true)); }
DI float lx1(float v) { return dpp_f<0xB1>(v); }
DI float lx2(float v) { return dpp_f<0x4E>(v); }
DI float lhm(float v) { return dpp_f<0x141>(v); }
DI float lr8(float v) { return dpp_f<0x128>(v); }
DI float sum_x16(float v) { auto s = __builtin_amdgcn_permlane16_swap(__float_as_uint(v), __float_as_uint(v), false, false); return __uint_as_float(s[0]) + __uint_as_float(s[1]); }
DI float sum_x32(float v) { auto s = __builtin_amdgcn_permlane32_swap(__float_as_uint(v), __float_as_uint(v), false, false); return __uint_as_float(s[0]) + __uint_as_float(s[1]); }
DI float max_x16(float v) { auto s = __builtin_amdgcn_permlane16_swap(__float_as_uint(v), __float_as_uint(v), false, false); return fmaxf(__uint_as_float(s[0]), __uint_as_float(s[1])); }
DI float max_x32(float v) { auto s = __builtin_amdgcn_permlane32_swap(__float_as_uint(v), __float_as_uint(v), false, false); return fmaxf(__uint_as_float(s[0]), __uint_as_float(s[1])); }
DI unsigned get_x32(unsigned v, int h) { auto s = __builtin_amdgcn_permlane32_swap(v, v, false, false); return h ? s[0] : s[1]; }
DI float wave_sum(float v) { v += lx1(v); v += lx2(v); v += lhm(v); v += lr8(v); v = sum_x16(v); return sum_x32(v); }
DI float wave_max(float v) { v = fmaxf(v, lx1(v)); v = fmaxf(v, lx2(v)); v = fmaxf(v, lhm(v)); v = fmaxf(v, lr8(v)); v = max_x16(v); return max_x32(v); }
DI int bperm(int v, int srclane) { return __builtin_amdgcn_ds_bpermute(srclane << 2, v); }
DI float bpermf(float v, int srclane) { return __builtin_bit_cast(float, __builtin_amdgcn_ds_bpermute(srclane << 2, __builtin_bit_cast(int, v))); }
DI float gelu_tanh(float x) {
    const float u = 0.7978845608028654f * (x + 0.044715f * x * x * x);
    return x * frcp(1.f + fexp2(-2.f * LOG2E * u));
}
DI float dot2bf(unsigned a, unsigned b, float c) {
    return __builtin_amdgcn_fdot2_f32_bf16(__builtin_bit_cast(bf16x2v, a), __builtin_bit_cast(bf16x2v, b), c, false);
}
DI int rel_bucket_i(int d) {
    if (d < 16) return d < 0 ? 0 : d;
    int b = 16;
    b += d >= 21; b += d >= 27; b += d >= 35; b += d >= 46; b += d >= 59; b += d >= 77; b += d >= 99; b += d >= 128;
    b += d >= 166; b += d >= 216; b += d >= 280; b += d >= 363; b += d >= 470; b += d >= 609; b += d >= 790;
    return b;
}
DI unsigned f2key(float f) { unsigned u = __float_as_uint(f); return u ^ ((unsigned)((int)u >> 31) | 0x80000000u); }
DI float key2f(unsigned k) { unsigned u = (k & 0x80000000u) ? (k ^ 0x80000000u) : ~k; return __uint_as_float(u); }

constexpr int EPI_LDS = 96 * 1024;

DI int sw2(int row, int chunk) { return (row >> 1) * 256 + (((((row & 1) << 3) | chunk) ^ ((row >> 1) & 15)) << 4); }
DI void sw2_src(int P, int& row, int& chunk) { const int R2 = P >> 4, lc = (P & 15) ^ (R2 & 15); row = 2 * R2 + (lc >> 3); chunk = lc & 7; }

template <class T, class = void> struct epi_stash { static constexpr bool value = false, present = false; };
template <class T> struct epi_stash<T, decltype((void)T::STASH)> { static constexpr bool value = T::STASH, present = true; };

template <int MT, class Epi>
DI void gemm_tile(const bf16_t* __restrict__ A, long lda, int M, const bf16_t* __restrict__ Bt, long ldb, int N, int K,
                  int m0, int n0, const Epi& epi, unsigned char* lds, int tid) {
    constexpr int XS = MT * 128 * 128, WS = 256 * 128, STAGE = XS + WS;
    const int lane = tid & 63, w = tid >> 6, tg = w & 3, fh = w >> 2, r = lane & 31, h = lane >> 5;
    const int wbase = tid & ~63;
    unsigned xo[2 * MT], wo[4];
#pragma unroll
    for (int i = 0; i < 2 * MT; ++i) { int row, c; sw2_src(tid + 512 * i, row, c); int m = m0 + row; m = m < M ? m : M - 1; xo[i] = (unsigned)m * (unsigned)(lda * 2) + c * 16; }
#pragma unroll
    for (int i = 0; i < 4; ++i) { int row, c; sw2_src(tid + 512 * i, row, c); int n = n0 + row; n = n < N ? n : N - 1; wo[i] = (unsigned)n * (unsigned)(ldb * 2) + c * 16; }
    const unsigned char* Ab = (const unsigned char*)A;
    const unsigned char* Bb = (const unsigned char*)Bt;
    auto stage = [&](int kt, unsigned char* st) {
#pragma unroll
        for (int i = 0; i < 2 * MT; ++i)
            __builtin_amdgcn_global_load_lds((const unsigned*)(Ab + kt * 128 + xo[i]), (unsigned*)(st + (wbase + 512 * i) * 16), 16, 0, 0);
#pragma unroll
        for (int i = 0; i < 4; ++i)
            __builtin_amdgcn_global_load_lds((const unsigned*)(Bb + kt * 128 + wo[i]), (unsigned*)(st + XS + (wbase + 512 * i) * 16), 16, 0, 0);
    };
    f32x16 acc[MT][4];
#pragma unroll
    for (int s2 = 0; s2 < MT; ++s2)
#pragma unroll
        for (int i = 0; i < 4; ++i)
#pragma unroll
            for (int j = 0; j < 16; ++j) acc[s2][i][j] = 0.f;
    const int nk = K >> 6;
    stage(0, lds);
    __syncthreads();
    for (int kt = 0; kt < nk; ++kt) {
        unsigned char* cur = lds + (kt & 1) * STAGE;
        if (kt + 1 < nk) stage(kt + 1, lds + ((kt + 1) & 1) * STAGE);
        bf16x8 xfa[MT], wfa[4], xfb[MT], wfb[4];
        auto ldf = [&](bf16x8 (&xf)[MT], bf16x8 (&wf)[4], int ks) {
#pragma unroll
            for (int s2 = 0; s2 < MT; ++s2) xf[s2] = *(const bf16x8*)(cur + sw2(32 * MT * tg + 32 * s2 + r, 2 * ks + h));
#pragma unroll
            for (int mt = 0; mt < 4; ++mt) wf[mt] = *(const bf16x8*)(cur + XS + sw2(128 * fh + 32 * mt + r, 2 * ks + h));
        };
        auto mm = [&](const bf16x8 (&xf)[MT], const bf16x8 (&wf)[4]) {
#pragma unroll
            for (int mt = 0; mt < 4; ++mt)
#pragma unroll
                for (int s2 = 0; s2 < MT; ++s2) acc[s2][mt] = MFMA32(wf[mt], xf[s2], acc[s2][mt]);
        };
        ldf(xfa, wfa, 0);
        ldf(xfb, wfb, 1); __builtin_amdgcn_sched_barrier(0); mm(xfa, wfa); __builtin_amdgcn_sched_barrier(0);
        ldf(xfa, wfa, 2); __builtin_amdgcn_sched_barrier(0); mm(xfb, wfb); __builtin_amdgcn_sched_barrier(0);
        ldf(xfb, wfb, 3); __builtin_amdgcn_sched_barrier(0); mm(xfa, wfa); __builtin_amdgcn_sched_barrier(0);
        mm(xfb, wfb);
        __syncthreads();
    }
    if constexpr (MT == 2 && epi_stash<Epi>::value) {
        float* sp = (float*)lds + w * 4096 + lane;
#pragma unroll
        for (int mt = 0; mt < 4; ++mt)
#pragma unroll
            for (int j = 0; j < 16; ++j) sp[(mt * 16 + j) * 64] = acc[1][mt][j];
        epi(acc[0], m0 + 64 * tg + r, n0 + 128 * fh, h, lds, tid);
        f32x16 a2[4];
        const float* sp2 = sp; asm volatile("" : "+v"(sp2));
#pragma unroll
        for (int mt = 0; mt < 4; ++mt)
#pragma unroll
            for (int j = 0; j < 16; ++j) a2[mt][j] = sp2[(mt * 16 + j) * 64];
        epi(a2, m0 + 64 * tg + 32 + r, n0 + 128 * fh, h, lds, tid);
        __syncthreads();
    } else {
        int ho = h, ro = r, to = tid;
        if constexpr (epi_stash<Epi>::present) asm volatile("" : "+v"(ho), "+v"(ro), "+v"(to));
#pragma unroll
        for (int s2 = 0; s2 < MT; ++s2) epi(acc[s2], m0 + 32 * MT * tg + 32 * s2 + ro, n0 + 128 * fh, ho, lds, to);
    }
}

DI void store_vt_tile(bf16_t* base, long rstride, const f32x16& a, int row0, int h, int lane) {
    const bool odd = lane & 1;
#pragma unroll
    for (int rg = 0; rg < 16; rg += 2) {
        const float xa = lx1(a[rg]), xb = lx1(a[rg + 1]);
        const unsigned wv = odd ? pk2(xb, a[rg + 1]) : pk2(a[rg], xa);
        bf16_t* dp = base + (long)(row0 + crow(odd ? rg + 1 : rg, h)) * rstride - (odd ? 1 : 0);
        *(unsigned*)dp = wv;
    }
}
struct EpiQKV0 {
    bf16_t *Q, *Kk, *VT;
    const float *qg, *kg;
    float* MB; const float* relb;
    DI void operator()(const f32x16 (&acc)[4], int tok, int fbase, int h, unsigned char*, int) const {
        const int sec = fbase >> 10, hd = (fbase & 1023) >> 7, b = tok >> 13, s = tok & (SEQ - 1);
        if (sec < 2) {
            const float* gn = sec == 0 ? qg : kg;
            const float sc = sec == 0 ? 0.125f * LOG2E : 1.f;
            bf16_t* dst = sec == 0 ? Q : Kk;
#pragma unroll
            for (int j = 0; j < 2; ++j) {
                float ss = 0.f;
#pragma unroll
                for (int mt = 0; mt < 2; ++mt)
#pragma unroll
                    for (int rg = 0; rg < 16; ++rg) { const float v = acc[2 * j + mt][rg]; ss += v * v; }
                ss = sum_x32(ss);
                const float rstd = rsqrtf(ss * (1.f / 64.f) + EPS) * sc;
                bf16_t* row = dst + ((long)((b * 8 + hd) * 2 + j) * SEQ + s) * 64;
                float qq = 0.f;
#pragma unroll
                for (int mt = 0; mt < 2; ++mt)
#pragma unroll
                    for (int g4 = 0; g4 < 4; ++g4) {
                        const int d0 = 32 * mt + 8 * g4 + 4 * h;
                        const f32x4 gv = *(const f32x4*)(gn + d0);
                        const float v0 = acc[2 * j + mt][4 * g4 + 0] * rstd * gv.x, v1 = acc[2 * j + mt][4 * g4 + 1] * rstd * gv.y;
                        const float v2 = acc[2 * j + mt][4 * g4 + 2] * rstd * gv.z, v3 = acc[2 * j + mt][4 * g4 + 3] * rstd * gv.w;
                        qq += v0 * v0 + v1 * v1 + v2 * v2 + v3 * v3;
                        u32x2 o;
                        o.x = pk2(v0, v1); o.y = pk2(v2, v3);
                        *(u32x2*)(row + d0) = o;
                    }
                if (sec == 0) {
                    qq = sum_x32(qq);
                    float kmx = 0.f;
                    for (int d = 0; d < 64; ++d) kmx = fmaxf(kmx, fabsf(kg[d]));
                    float bmx = 0.f;
                    for (int bk = 0; bk < 32; ++bk) bmx = fmaxf(bmx, relb[bk * 8 + hd] - relb[31 * 8 + hd]);
                    if (h == 0) MB[(long)((b * 8 + hd) * 2 + j) * SEQ + s] = 1.01f * sqrtf(qq) * 8.f * kmx + bmx * LOG2E;
                }
            }
        } else {
            bf16_t* base = VT + (long)(b * 8 + hd) * 128 * SEQ + s;
#pragma unroll
            for (int mt = 0; mt < 4; ++mt) store_vt_tile(base, SEQ, acc[mt], 32 * mt, h, tok);
        }
    }
};

struct EpiResid {
    const float* xin; float* xout; const float* gate;
    DI void operator()(const f32x16 (&acc)[4], int tok, int fbase, int h, unsigned char*, int) const {
        const int b = tok >> 13;
        const float* gp = gate + b * ADA_STRIDE;
#pragma unroll
        for (int mt = 0; mt < 4; ++mt)
#pragma unroll
            for (int g4 = 0; g4 < 4; ++g4) {
                const int f = fbase + 32 * mt + 8 * g4 + 4 * h;
                const f32x4 xv = *(const f32x4*)(xin + (long)tok * DM + f);
                const f32x4 gv = *(const f32x4*)(gp + f);
                f32x4 o;
                o.x = xv.x + gv.x * acc[mt][4 * g4 + 0]; o.y = xv.y + gv.y * acc[mt][4 * g4 + 1];
                o.z = xv.z + gv.z * acc[mt][4 * g4 + 2]; o.w = xv.w + gv.w * acc[mt][4 * g4 + 3];
                *(f32x4*)(xout + (long)tok * DM + f) = o;
                if (g4 == 3) __builtin_amdgcn_sched_barrier(0);
            }
    }
};

struct EpiKV {
    bf16_t *KC, *KS, *VST, *KW, *VWT;
    const float* kgain;
    DI void operator()(const f32x16 (&acc)[4], int tok, int fbase, int h, unsigned char*, int) const {
        const int c = fbase >> 7, br = c >> 2, kv = (c >> 1) & 1, g = c & 1, b = tok >> 13, s = tok & (SEQ - 1);
        if (br == 0 || kv == 0) {
            float rstd = 1.f;
            bf16_t* row;
            if (br == 0) row = KC + ((long)((kv * 4 + b) * 2 + g) * SEQ + s) * 128;
            else {
                float ss = 0.f;
#pragma unroll
                for (int mt = 0; mt < 4; ++mt)
#pragma unroll
                    for (int rg = 0; rg < 16; ++rg) ss += acc[mt][rg] * acc[mt][rg];
                ss = sum_x32(ss);
                rstd = rsqrtf(ss * (1.f / 128.f) + EPS);
                row = (br == 1 ? KS : KW) + ((long)(b * 2 + g) * SEQ + s) * 128;
            }
#pragma unroll
            for (int mt = 0; mt < 4; ++mt)
#pragma unroll
                for (int g4 = 0; g4 < 4; ++g4) {
                    const int d0 = 32 * mt + 8 * g4 + 4 * h;
                    f32x4 gv = {1.f, 1.f, 1.f, 1.f};
                    if (br != 0) gv = *(const f32x4*)(kgain + br * 128 + d0);
                    u32x2 o;
                    o.x = pk2(acc[mt][4 * g4 + 0] * rstd * gv.x, acc[mt][4 * g4 + 1] * rstd * gv.y);
                    o.y = pk2(acc[mt][4 * g4 + 2] * rstd * gv.z, acc[mt][4 * g4 + 3] * rstd * gv.w);
                    *(u32x2*)(row + d0) = o;
                }
        } else {
            bf16_t* base = (br == 1 ? VST : VWT) + (long)(b * 2 + g) * 128 * SEQ + s;
#pragma unroll
            for (int mt = 0; mt < 4; ++mt) store_vt_tile(base, SEQ, acc[mt], 32 * mt, h, tok);
        }
    }
};

struct EpiCmp1 {
    bf16_t* hid; const float* posb_part; const float* b1;
    DI void operator()(const f32x16 (&acc)[4], int tok, int fbase, int h, unsigned char*, int) const {
        if (tok >= 512) return;
#pragma unroll
        for (int mt = 0; mt < 4; ++mt)
#pragma unroll
            for (int g4 = 0; g4 < 4; ++g4) {
                const int f = fbase + 32 * mt + 8 * g4 + 4 * h;
                f32x4 pb = *(const f32x4*)(b1 + f);
                for (int c = 0; c < 16; ++c) { const f32x4 t = *(const f32x4*)(posb_part + c * 256 + f); pb.x += t.x; pb.y += t.y; pb.z += t.z; pb.w += t.w; }
                u32x2 o;
                o.x = pk2(gelu_tanh(acc[mt][4 * g4 + 0] + pb.x), gelu_tanh(acc[mt][4 * g4 + 1] + pb.y));
                o.y = pk2(gelu_tanh(acc[mt][4 * g4 + 2] + pb.z), gelu_tanh(acc[mt][4 * g4 + 3] + pb.w));
                *(u32x2*)(hid + (long)tok * 256 + f) = o;
            }
    }
};

struct EpiCmp2 {
    bf16_t* dst; const float* kgain0; int kv;
    DI void operator()(const f32x16 (&acc)[4], int tok, int fbase, int h, unsigned char*, int) const {
        if (fbase != 0 || tok >= 512) return;
        const float valid = tok < 511 ? 1.f : 0.f;
        if (kv == 0) {
            float ss = 0.f;
#pragma unroll
            for (int mt = 0; mt < 4; ++mt)
#pragma unroll
                for (int rg = 0; rg < 16; ++rg) ss += acc[mt][rg] * acc[mt][rg];
            ss = sum_x32(ss);
            const float rstd = rsqrtf(ss * (1.f / 128.f) + EPS) * valid;
#pragma unroll
            for (int mt = 0; mt < 4; ++mt)
#pragma unroll
                for (int g4 = 0; g4 < 4; ++g4) {
                    const int d0 = 32 * mt + 8 * g4 + 4 * h;
                    const f32x4 gv = *(const f32x4*)(kgain0 + d0);
                    u32x2 o;
                    o.x = pk2(acc[mt][4 * g4 + 0] * rstd * gv.x, acc[mt][4 * g4 + 1] * rstd * gv.y);
                    o.y = pk2(acc[mt][4 * g4 + 2] * rstd * gv.z, acc[mt][4 * g4 + 3] * rstd * gv.w);
                    *(u32x2*)(dst + (long)tok * 128 + d0) = o;
                }
        } else {
#pragma unroll
            for (int mt = 0; mt < 4; ++mt)
#pragma unroll
                for (int rg = 0; rg < 16; ++rg) dst[(long)(32 * mt + crow(rg, h)) * 512 + tok] = f2bf(acc[mt][rg] * valid);
        }
    }
};

struct EpiNsaQ {
    bf16_t* QN; float* gates; const float* qgain; const float* bgate; float* qnrm;
    DI void operator()(const f32x16 (&acc)[4], int tok, int fbase, int h, unsigned char*, int) const {
        const int b = tok >> 13, s = tok & (SEQ - 1);
        if (fbase < 1024) {
            const int head = fbase >> 7;
            float ss = 0.f;
#pragma unroll
            for (int mt = 0; mt < 4; ++mt)
#pragma unroll
                for (int rg = 0; rg < 16; ++rg) ss += acc[mt][rg] * acc[mt][rg];
            ss = sum_x32(ss);
            const float rstd = rsqrtf(ss * (1.f / 128.f) + EPS) * (0.08838834764831845f * LOG2E);
            bf16_t* row = QN + ((long)(b * 8 + head) * SEQ + s) * 128;
            float qq = 0.f;
#pragma unroll
            for (int mt = 0; mt < 4; ++mt)
#pragma unroll
                for (int g4 = 0; g4 < 4; ++g4) {
                    const int d0 = 32 * mt + 8 * g4 + 4 * h;
                    const f32x4 gv = *(const f32x4*)(qgain + d0);
                    const float v0 = acc[mt][4 * g4 + 0] * rstd * gv.x, v1 = acc[mt][4 * g4 + 1] * rstd * gv.y;
                    const float v2 = acc[mt][4 * g4 + 2] * rstd * gv.z, v3 = acc[mt][4 * g4 + 3] * rstd * gv.w;
                    qq += v0 * v0 + v1 * v1 + v2 * v2 + v3 * v3;
                    u32x2 o;
                    o.x = pk2(v0, v1); o.y = pk2(v2, v3);
                    *(u32x2*)(row + d0) = o;
                }
            qq = sum_x32(qq);
            if (h == 0) qnrm[(long)tok * 8 + head] = 1.01f * sqrtf(qq);
        } else if (fbase == 1024) {
#pragma unroll
            for (int rg = 0; rg < 16; ++rg) {
                const int f = crow(rg, h);
                if (f < 24) { const float z = acc[0][rg] + bgate[f]; gates[(long)tok * 24 + f] = frcp(1.f + fexp2(-LOG2E * z)); }
            }
        }
    }
};

struct EpiPeer {
    static constexpr bool STASH = false;
    int* ridx; float* rgate; int ex_off;
    DI void operator()(const f32x16 (&acc)[4], int tok, int fbase, int h, unsigned char* lds, int tid) const {
        const int lane = tid & 63, w = tid >> 6, tg = w & 3, fh = w >> 2, r = lane & 31;
        const int hd = fbase >> 8;
        unsigned* EX = (unsigned*)(lds + ex_off);
        unsigned L[16];
#pragma unroll
        for (int i = 0; i < 16; ++i) L[i] = 0u;
#pragma unroll
        for (int mt = 0; mt < 4; ++mt)
#pragma unroll
            for (int rg = 0; rg < 16; ++rg) {
                const int kidx = 32 * mt + crow(rg, h);
                unsigned x = (f2key(acc[mt][rg]) & ~127u) | (unsigned)(127 - kidx);
#pragma unroll
                for (int i = 0; i < 16; ++i) { const unsigned t = L[i] > x ? L[i] : x; x = L[i] > x ? x : L[i]; L[i] = t; }
            }
        {
            unsigned P[16];
#pragma unroll
            for (int i = 0; i < 16; ++i) P[i] = get_x32(L[i], h);
#pragma unroll
            for (int i = 0; i < 16; ++i) L[i] = L[i] > P[15 - i] ? L[i] : P[15 - i];
#pragma unroll
            for (int st = 8; st >= 1; st >>= 1)
#pragma unroll
                for (int i = 0; i < 16; ++i)
                    if ((i & st) == 0) { const unsigned a = L[i], b2 = L[i + st]; L[i] = a > b2 ? a : b2; L[i + st] = a > b2 ? b2 : a; }
        }
        if (h == 0) {
#pragma unroll
            for (int i = 0; i < 16; i += 4) *(u32x4*)(EX + ((fh * 4 + tg) * 32 + r) * 16 + i) = (u32x4){L[i], L[i + 1], L[i + 2], L[i + 3]};
        }
        __syncthreads();
        unsigned X[16], Y[16];
        {
            const unsigned* l0 = EX + ((0 * 4 + tg) * 32 + r) * 16;
            const unsigned* l1 = EX + ((1 * 4 + tg) * 32 + r) * 16;
            const unsigned* px = h ? l1 : l0;
            const unsigned* py = h ? l0 : l1;
#pragma unroll
            for (int i = 0; i < 16; i += 4) {
                const u32x4 a = *(const u32x4*)(px + i), b2 = *(const u32x4*)(py + i);
                X[i] = a.x; X[i + 1] = a.y; X[i + 2] = a.z; X[i + 3] = a.w;
                Y[i] = b2.x; Y[i + 1] = b2.y; Y[i + 2] = b2.z; Y[i + 3] = b2.w;
            }
        }
        unsigned T[16];
#pragma unroll
        for (int i = 0; i < 16; ++i) T[i] = 0u;
#pragma unroll
        for (int i = 0; i < 16; ++i)
#pragma unroll
            for (int j = i; j < 16; ++j) {
                if ((i + 1) * (j + 1) > 16) continue;
                const float fs = key2f(X[i] & ~127u) + key2f(Y[j] & ~127u);
                const unsigned code = h ? (unsigned)((j << 4) | i) : (unsigned)((i << 4) | j);
                unsigned x = (f2key(fs) & ~255u) | (255u - code);
                if (i == j) x = h ? 0u : x;
#pragma unroll
                for (int k = 0; k < 16; ++k) { const unsigned t = T[k] > x ? T[k] : x; x = T[k] > x ? x : T[k]; T[k] = t; }
            }
        {
            unsigned P[16];
#pragma unroll
            for (int i = 0; i < 16; ++i) P[i] = get_x32(T[i], h);
#pragma unroll
            for (int i = 0; i < 16; ++i) T[i] = T[i] > P[15 - i] ? T[i] : P[15 - i];
#pragma unroll
            for (int st = 8; st >= 1; st >>= 1)
#pragma unroll
                for (int i = 0; i < 16; ++i)
                    if ((i & st) == 0) { const unsigned a = T[i], b2 = T[i + st]; T[i] = a > b2 ? a : b2; T[i + st] = a > b2 ? b2 : a; }
        }
        float sc[16], sum = 0.f;
        const float mx = key2f(T[0] & ~255u);
#pragma unroll
        for (int k = 0; k < 16; ++k) { sc[k] = fexp2((key2f(T[k] & ~255u) - mx) * LOG2E); sum += sc[k]; }
        const float inv = frcp(sum);
        if (h == 0) {
            const unsigned* l0 = EX + ((0 * 4 + tg) * 32 + r) * 16;
            const unsigned* l1 = EX + ((1 * 4 + tg) * 32 + r) * 16;
#pragma unroll
            for (int k = 0; k < 16; ++k) {
                if ((k >> 3) != fh) continue;
                const unsigned code = 255u - (T[k] & 255u);
                const int i1 = 127 - (int)(l0[code >> 4] & 127u), i2 = 127 - (int)(l1[code & 15u] & 127u);
                ridx[(long)tok * 128 + hd * 16 + k] = i1 * 128 + i2;
                rgate[(long)tok * 128 + hd * 16 + k] = sc[k] * inv;
            }
        }
        __syncthreads();
    }
};

DI void p0_transpose_item(const float* __restrict__ W, int K, int N, bf16_t* __restrict__ WT, int item, int ntn, unsigned char* lds, int tid) {
    float* tile = (float*)lds;
    const int kb = item / ntn, nb = item % ntn, k0 = kb * 64, n0 = nb * 64;
    {
        const int nn = tid & 63, kk0 = tid >> 6;
#pragma unroll
        for (int i = 0; i < 8; ++i) { const int kk = kk0 + 8 * i; const int n = n0 + nn; tile[kk * 65 + nn] = n < N ? W[(long)(k0 + kk) * N + n] : 0.f; }
    }
    __syncthreads();
    {
        const int n = tid >> 3, c = tid & 7;
        const float* s = tile + (8 * c) * 65 + n;
        u32x4 o;
        o.x = pk2(s[0], s[65]); o.y = pk2(s[2 * 65], s[3 * 65]); o.z = pk2(s[4 * 65], s[5 * 65]); o.w = pk2(s[6 * 65], s[7 * 65]);
        *(u32x4*)(WT + (long)(n0 + n) * K + k0 + 8 * c) = o;
    }
    __syncthreads();
}

DI int pack_i8x4(float a, float b, float c, float d) {
    const int ia = __float2int_rn(a), ib = __float2int_rn(b), ic = __float2int_rn(c), id = __float2int_rn(d);
    return (ia & 255) | ((ib & 255) << 8) | ((ic & 255) << 16) | (id << 24);
}
DI void p0_fp8_item(const float* __restrict__ src, unsigned char* __restrict__ dst, float* __restrict__ sinv, bool sliced, int item, int tid) {
    const int lane = tid & 63, row = item * 8 + (tid >> 6);
    const float* rp = src + (long)row * 1024;
    f32x4 v[4]; float am = 0.f;
#pragma unroll
    for (int j = 0; j < 4; ++j) {
        v[j] = *(const f32x4*)(rp + 4 * lane + 256 * j);
        am = fmaxf(am, fmaxf(fmaxf(fabsf(v[j].x), fabsf(v[j].y)), fmaxf(fabsf(v[j].z), fabsf(v[j].w))));
    }
    am = wave_max(am);
    const float sc = sliced ? (am > 0.f ? exp2f(floorf(log2f(384.f / am))) : 1.f) : (am > 0.f ? 127.f / am : 1.f);
    if (lane == 0) sinv[row] = 1.f / sc;
#pragma unroll
    for (int j = 0; j < 4; ++j) {
        int pk = 0;
        if (sliced) {
            pk = __builtin_amdgcn_cvt_pk_fp8_f32(v[j].x * sc, v[j].y * sc, pk, false);
            pk = __builtin_amdgcn_cvt_pk_fp8_f32(v[j].z * sc, v[j].w * sc, pk, true);
        } else pk = pack_i8x4(v[j].x * sc, v[j].y * sc, v[j].z * sc, v[j].w * sc);
        const int col = 4 * lane + 256 * j;
        unsigned char* d = sliced ? dst + ((long)(col >> 7) * 16384 + row) * 128 + (col & 127) : dst + (long)row * 1024 + col;
        *(int*)d = pk;
    }
}

DI void p0_weff_item(const float* __restrict__ wq, const float* __restrict__ subk, bf16_t* __restrict__ WT, int item, unsigned char* lds, int tid) {
    const int layer = item >> 8, g = (item >> 4) & 15, ct = item & 15, p = g & 1, c0 = ct * 64;
    float* As = (float*)lds;
    float* Bs = As + 64 * 129;
    const float* wql = wq + (long)layer * 1024 * 2048;
    const float* sk = subk + ((long)layer * 2 + p) * 128 * 128;
    for (int e = tid; e < 64 * 128; e += NTHREADS) { const int c = e >> 7, d = e & 127; As[c * 129 + d] = wql[(long)(c0 + c) * 2048 + g * 128 + d]; }
    for (int e = tid; e < 128 * 128; e += NTHREADS) { const int k = e >> 7, d = e & 127; Bs[k * 129 + d] = sk[k * 128 + d]; }
    __syncthreads();
    const int k = tid & 127, cg4 = tid >> 7;
    float acc[16];
#pragma unroll
    for (int i = 0; i < 16; ++i) acc[i] = 0.f;
    for (int d = 0; d < 128; ++d) {
        const float bv = Bs[k * 129 + d];
#pragma unroll
        for (int i = 0; i < 16; ++i) acc[i] += As[(cg4 * 16 + i) * 129 + d] * bv;
    }
    bf16_t* o = WT + ((long)layer * 2048 + g * 128 + k) * 1024 + c0 + cg4 * 16;
    u32x4 o0, o1;
    o0.x = pk2(acc[0], acc[1]); o0.y = pk2(acc[2], acc[3]); o0.z = pk2(acc[4], acc[5]); o0.w = pk2(acc[6], acc[7]);
    o1.x = pk2(acc[8], acc[9]); o1.y = pk2(acc[10], acc[11]); o1.z = pk2(acc[12], acc[13]); o1.w = pk2(acc[14], acc[15]);
    *(u32x4*)o = o0; *(u32x4*)(o + 8) = o1;
    __syncthreads();
}

DI void p0_posb_item(const float* __restrict__ pos, const float* __restrict__ w1, float* __restrict__ part, int item, unsigned char* lds, int tid) {
    const int kv = item >> 4, ch = item & 15;
    float* red = (float*)lds;
    const int j = tid & 255, half = tid >> 8;
    const float* pp = pos + (long)kv * 4096 + ch * 256 + half * 128;
    const float* ww = w1 + ((long)kv * 4096 + ch * 256 + half * 128) * 256 + j;
    float a = 0.f;
    for (int f = 0; f < 128; ++f) a += pp[f] * ww[(long)f * 256];
    red[half * 256 + j] = a;
    __syncthreads();
    if (tid < 256) part[(kv * 16 + ch) * 256 + tid] = red[tid] + red[256 + tid];
    __syncthreads();
}

DI void p0_ada_item(const Params& p, float* __restrict__ ada, int item, unsigned char* lds, int tid) {
    float* cact = (float*)lds;
    float* red = cact + 4096;
    const float* c = p.in[1];
    for (int e = tid; e < 4096; e += NTHREADS) { const float v = c[e]; cact[e] = v * frcp(1.f + fexp2(-LOG2E * v)); }
    __syncthreads();
    const int colg = item * 64;
    const float* W; const float* bias; int N, n0;
    if (colg < 6144) { W = p.in[3]; bias = p.in[4]; N = 6144; n0 = colg; }
    else if (colg < 12288) { W = p.in[3] + (long)1024 * 6144; bias = p.in[4] + 6144; N = 6144; n0 = colg - 6144; }
    else { W = p.in[14]; bias = p.in[15]; N = 2048; n0 = colg - 12288; }
    const int col = tid & 63, kg = tid >> 6;
    float a0 = 0.f, a1 = 0.f, a2 = 0.f, a3 = 0.f;
    const float* wp = W + (long)(kg * 128) * N + n0 + col;
#pragma unroll 8
    for (int k = 0; k < 128; ++k) {
        const float wv = wp[(long)k * N];
        const int kk = kg * 128 + k;
        a0 += cact[kk] * wv; a1 += cact[1024 + kk] * wv; a2 += cact[2048 + kk] * wv; a3 += cact[3072 + kk] * wv;
    }
    red[(kg * 4 + 0) * 64 + col] = a0; red[(kg * 4 + 1) * 64 + col] = a1; red[(kg * 4 + 2) * 64 + col] = a2; red[(kg * 4 + 3) * 64 + col] = a3;
    __syncthreads();
    if (tid < 256) {
        const int b = tid >> 6, cc = tid & 63;
        float s = bias[n0 + cc];
#pragma unroll
        for (int q = 0; q < 8; ++q) s += red[(q * 4 + b) * 64 + cc];
        ada[b * ADA_STRIDE + colg + cc] = s;
    }
    __syncthreads();
}

constexpr int P0_CONV = 8192, P0_TR_DIN = 768, P0_TR_DOUT = 256, P0_TR_KV = 384, P0_TR_NIN = 288, P0_TR_NOUT = 256, P0_TR_C1 = 512, P0_TR_C2 = 16,
              P0_WEFF = 512, P0_POSB = 32, P0_ADA = 224;
constexpr int P0_TOTAL = P0_CONV + P0_TR_DIN + P0_TR_DOUT + P0_TR_KV + P0_TR_NIN + P0_TR_NOUT + P0_TR_C1 + P0_TR_C2 + P0_WEFF + P0_POSB + P0_ADA;

DI void phase_prep(const Params& p, unsigned char* lds, int tid) {
    unsigned char* ws = p.ws;
    for (int it = blockIdx.x; it < P0_TOTAL; it += gridDim.x) {
        int r = it;
        if (r < P0_ADA) { p0_ada_item(p, (float*)(ws + OFF_ADA), r, lds, tid); continue; } r -= P0_ADA;
        if (r < P0_WEFF) { p0_weff_item(p.in[26], p.in[27], (bf16_t*)(ws + OFF_WT_PEER), r, lds, tid); continue; } r -= P0_WEFF;
        if (r < P0_POSB) { p0_posb_item(p.in[17], p.in[18], (float*)(ws + OFF_POSB), r, lds, tid); continue; } r -= P0_POSB;
        if (r < P0_TR_DIN) { p0_transpose_item(p.in[7], 1024, 3072, (bf16_t*)(ws + OFF_WT_DIN), r, 48, lds, tid); continue; } r -= P0_TR_DIN;
        if (r < P0_TR_DOUT) { p0_transpose_item(p.in[8], 1024, 1024, (bf16_t*)(ws + OFF_WT_DOUT), r, 16, lds, tid); continue; } r -= P0_TR_DOUT;
        if (r < P0_TR_KV) { p0_transpose_item(p.in[16], 1024, 1536, (bf16_t*)(ws + OFF_WT_KV), r, 24, lds, tid); continue; } r -= P0_TR_KV;
        if (r < P0_TR_NIN) { p0_transpose_item(p.in[22], 1024, 1048, (bf16_t*)(ws + OFF_WT_NIN), r, 18, lds, tid); continue; } r -= P0_TR_NIN;
        if (r < P0_TR_NOUT) { p0_transpose_item(p.in[24], 1024, 1024, (bf16_t*)(ws + OFF_WT_NOUT), r, 16, lds, tid); continue; } r -= P0_TR_NOUT;
        if (r < P0_TR_C1) { const int kv = r >> 8; p0_transpose_item(p.in[18] + (long)kv * 4096 * 256, 4096, 256, (bf16_t*)(ws + OFF_WT_C1) + (long)kv * 256 * 4096, r & 255, 4, lds, tid); continue; } r -= P0_TR_C1;
        if (r < P0_TR_C2) { const int kv = r >> 3; p0_transpose_item(p.in[20] + (long)kv * 256 * 128, 256, 128, (bf16_t*)(ws + OFF_WT_C2) + (long)kv * 128 * 256, r & 7, 2, lds, tid); continue; } r -= P0_TR_C2;
        {
            const int tbl = r >> 11, sub = r & 2047;
            const int layer = tbl & 1;
            const float* src = (tbl < 2 ? p.in[28] : p.in[29]) + (long)layer * 16384 * 1024;
            unsigned char* dst = ws + (tbl < 2 ? OFF_PU : OFF_PV) + (long)layer * 16384 * 1024;
            float* sinv = (float*)(ws + (tbl < 2 ? OFF_USI : OFF_VSI)) + layer * 16384;
            p0_fp8_item(src, dst, sinv, tbl >= 2, sub, tid);
        }
    }
}

DI void norm_row_write(const f32x4 (&v)[4], float rstd, const float* gain, const float* shift, const float* scale, bf16_t* orow, int lane) {
#pragma unroll
    for (int j = 0; j < 4; ++j) {
        const int c = 4 * lane + 256 * j;
        const f32x4 g = *(const f32x4*)(gain + c), sh = *(const f32x4*)(shift + c), sc = *(const f32x4*)(scale + c);
        u32x2 o;
        o.x = pk2(v[j].x * rstd * g.x * (1.f + sc.x) + sh.x, v[j].y * rstd * g.y * (1.f + sc.y) + sh.y);
        o.y = pk2(v[j].z * rstd * g.z * (1.f + sc.z) + sh.z, v[j].w * rstd * g.w * (1.f + sc.w) + sh.w);
        *(u32x2*)(orow + c) = o;
    }
}
DI void phase_norm_q8(const float* __restrict__ x, bf16_t* __restrict__ out, unsigned char* __restrict__ out8, float* __restrict__ outs,
                      const float* gain, const float* ada, int shift_off, int scale_off, int tid) {
    const int lane = tid & 63, gw = blockIdx.x * NWAVES + (tid >> 6), nw = gridDim.x * NWAVES;
    for (int tok = gw; tok < NTOK; tok += nw) {
        const int b = tok >> 13;
        f32x4 v[4]; float ss = 0.f;
#pragma unroll
        for (int j = 0; j < 4; ++j) { v[j] = *(const f32x4*)(x + (long)tok * DM + 4 * lane + 256 * j); ss += v[j].x * v[j].x + v[j].y * v[j].y + v[j].z * v[j].z + v[j].w * v[j].w; }
        const float rstd = rsqrtf(wave_sum(ss) * (1.f / DM) + EPS);
        const float* shift = ada + b * ADA_STRIDE + shift_off; const float* scale = ada + b * ADA_STRIDE + scale_off;
        float am = 0.f;
#pragma unroll
        for (int j = 0; j < 4; ++j) {
            const int c = 4 * lane + 256 * j;
            const f32x4 g = *(const f32x4*)(gain + c), sh = *(const f32x4*)(shift + c), sc = *(const f32x4*)(scale + c);
            v[j].x = v[j].x * rstd * g.x * (1.f + sc.x) + sh.x; v[j].y = v[j].y * rstd * g.y * (1.f + sc.y) + sh.y;
            v[j].z = v[j].z * rstd * g.z * (1.f + sc.z) + sh.z; v[j].w = v[j].w * rstd * g.w * (1.f + sc.w) + sh.w;
            u32x2 o; o.x = pk2(v[j].x, v[j].y); o.y = pk2(v[j].z, v[j].w);
            *(u32x2*)(out + (long)tok * DM + c) = o;
            am = fmaxf(am, fmaxf(fmaxf(fabsf(v[j].x), fabsf(v[j].y)), fmaxf(fabsf(v[j].z), fabsf(v[j].w))));
        }
        am = wave_max(am);
        const float qs = am > 0.f ? 127.f / am : 1.f;
#pragma unroll
        for (int j = 0; j < 4; ++j) *(int*)(out8 + (long)tok * DM + 4 * lane + 256 * j) = pack_i8x4(v[j].x * qs, v[j].y * qs, v[j].z * qs, v[j].w * qs);
        if (lane == 0) outs[tok] = am > 0.f ? am * (1.f / 127.f) : 1.f;
    }
}
DI void phase_norm(const float* __restrict__ x, bf16_t* __restrict__ out, const float* gain, const float* ada, int shift_off, int scale_off, int tid) {
    const int lane = tid & 63, gw = blockIdx.x * NWAVES + (tid >> 6), nw = gridDim.x * NWAVES;
    for (int tok = gw; tok < NTOK; tok += nw) {
        const int b = tok >> 13;
        f32x4 v[4]; float ss = 0.f;
#pragma unroll
        for (int j = 0; j < 4; ++j) { v[j] = *(const f32x4*)(x + (long)tok * DM + 4 * lane + 256 * j); ss += v[j].x * v[j].x + v[j].y * v[j].y + v[j].z * v[j].z + v[j].w * v[j].w; }
        const float rstd = rsqrtf(wave_sum(ss) * (1.f / DM) + EPS);
        norm_row_write(v, rstd, gain, ada + b * ADA_STRIDE + shift_off, ada + b * ADA_STRIDE + scale_off, out + (long)tok * DM, lane);
    }
}

DI int kidx(int mt, int i) { return 32 * mt + 16 * (i >> 3) + (i & 7); }
template <int DQK>
DI void attn_qk32(const unsigned char* Ks, const bf16x8 (&qf)[DQK / 16], f32x16& st, int mt, int r, int h, float init = 0.f) {
    constexpr int RB = DQK * 2, MSK = DQK == 64 ? 7 : 15;
    const int row = 32 * mt + ((r & 0x13) | ((r & 4) << 1) | ((r & 8) >> 1));
#pragma unroll
    for (int i = 0; i < 16; ++i) st[i] = init;
#pragma unroll
    for (int ks = 0; ks < DQK / 16; ++ks) {
        const bf16x8 kf = RB == 128 ? *(const bf16x8*)(Ks + sw2(row, 2 * ks + h)) : *(const bf16x8*)(Ks + row * RB + (((2 * ks + h) ^ (row & MSK)) << 4));
        st = MFMA32(kf, qf[ks], st);
    }
}
DI void attn_pack32(const f32x16& st, bf16x8 (&pf)[2]) {
#pragma unroll
    for (int s = 0; s < 2; ++s) {
        u32x4 t;
        t.x = pk2(st[8 * s + 0], st[8 * s + 1]); t.y = pk2(st[8 * s + 2], st[8 * s + 3]);
        t.z = pk2(st[8 * s + 4], st[8 * s + 5]); t.w = pk2(st[8 * s + 6], st[8 * s + 7]);
        pf[s] = __builtin_bit_cast(bf16x8, t);
    }
}
DI void attn_softmax32(f32x16& st, float& m, float& l, f32x16 (&o)[4]) {
    float mx = st[0];
#pragma unroll
    for (int i = 1; i < 16; ++i) mx = fmaxf(mx, st[i]);
    mx = max_x32(mx);
    const float mn = fmaxf(m, mx);
    if (!__all(mn == m)) {
        const float alpha = fexp2(m - mn);
        l *= alpha;
#pragma unroll
        for (int dt = 0; dt < 4; ++dt)
#pragma unroll
            for (int i = 0; i < 16; ++i) o[dt][i] *= alpha;
        m = mn;
    }
    float sum = 0.f;
#pragma unroll
    for (int i = 0; i < 16; ++i) { const float pv = fexp2(st[i] - m); st[i] = pv; sum += pv; }
    l += sum;
}
DI void attn_softmax32_b(f32x16& st, float& l) {
    float sum = 0.f;
#pragma unroll
    for (int i = 0; i < 16; ++i) { const float pv = fexp2(st[i]); st[i] = pv; sum += pv; }
    l += sum;
}
DI void attn_pv32(const unsigned char* Vs, const bf16x8 (&pf)[2], f32x16 (&o)[4], int mt, int r, int h) {
#pragma unroll
    for (int dt = 0; dt < 4; ++dt)
#pragma unroll
        for (int s2 = 0; s2 < 2; ++s2) {
            const int row = 32 * dt + r;
            const bf16x8 vf = *(const bf16x8*)(Vs + sw2(row, 2 * (2 * mt + s2) + h));
            o[dt] = MFMA32(vf, pf[s2], o[dt]);
        }
}
template <int RB, int NROWS>
DI void dma_offsets(unsigned (&off)[NROWS * RB / 16 / 512], unsigned gstride, int tid) {
    constexpr int CPR = RB / 16;
#pragma unroll
    for (int i = 0; i < NROWS * CPR / 512; ++i) {
        const int idx = tid + 512 * i;
        int row, cp;
        if (RB == 128) sw2_src(idx, row, cp); else { row = idx / CPR; cp = (idx % CPR) ^ (row & (CPR - 1)); }
        off[i] = (unsigned)row * gstride + (cp << 4);
    }
}
template <int N>
DI void dma_issue(unsigned char* dst, const unsigned char* gbase, const unsigned (&off)[N], int tid) {
    const int wbase = tid & ~63;
#pragma unroll
    for (int i = 0; i < N; ++i)
        __builtin_amdgcn_global_load_lds((const unsigned*)(gbase + off[i]), (unsigned*)(dst + (wbase + 512 * i) * 16), 16, 0, 0);
}

constexpr int AT_STAGE = 32 * 1024;
constexpr int AT_LUT = 2 * AT_STAGE;
constexpr int LUT_N = 1280, LUT_OFF = 1100;
constexpr int LUTC_W = 52;
constexpr int AT_LUTC = AT_LUT + 20 * 1024;
constexpr int AT_IMP = AT_LUTC + 13 * 1024;
constexpr int AT_SEL = AT_IMP + 34 * 1024;

DI void phase_diff_attn(const Params& p, unsigned char* lds, int tid) {
    unsigned char* ws = p.ws;
    const bf16_t* Q = (const bf16_t*)(ws + OFF_Q0);
    const bf16_t* Kk = (const bf16_t*)(ws + OFF_K0);
    const bf16_t* VT = (const bf16_t*)(ws + OFF_VT0);
    bf16_t* O = (bf16_t*)(ws + OFF_H);
    const float* relb = p.in[2];
    const float* lam = p.in[9];
    const float* subln = p.in[12];
    const int lane = tid & 63, w = tid >> 6, comp = w & 1, qg = w >> 1, r = lane & 31, h = lane >> 5;
    float* lut = (float*)(lds + 128 * 1024);
    float lam_full;
    {
        float s01 = 0.f, s23 = 0.f;
        for (int i = 0; i < 64; ++i) { s01 += lam[i] * lam[64 + i]; s23 += lam[128 + i] * lam[192 + i]; }
        lam_full = __expf(s01) - __expf(s23) + 0.2f;
    }
    const int G = gridDim.x, rows_per_it = G >> 5;
    unsigned koff[1], voff[2];
    dma_offsets<128, 64>(koff, 128, tid);
    dma_offsets<128, 128>(voff, SEQ * 2, tid);
    constexpr int ST2 = 64 * 1024;
    for (int it = 0;; ++it) {
        int qb, b, hd;
        if (G == 256) {
            if (it >= 8) break;
            const int xcd = blockIdx.x & 7, lb = blockIdx.x >> 3, pr = xcd * 4 + (it >> 1);
            qb = (it & 1) ? lb : 63 - lb; b = pr >> 3; hd = pr & 7;
        } else {
            int u;
            if ((G & 31) == 0) {
                const int rr = blockIdx.x >> 5, cc = blockIdx.x & 31;
                const int rowi = it * rows_per_it + ((it & 1) ? rows_per_it - 1 - rr : rr);
                u = rowi * 32 + cc;
            } else u = it * G + blockIdx.x;
            if (u >= 2048) break;
            qb = 63 - (u >> 5); b = (u & 31) >> 3; hd = u & 7;
        }
        const int q0 = qb * 128, ntiles = qb + 1;
        const int qpos = q0 + 32 * qg + r, qlo = q0 + 32 * qg, qhi = qlo + 31;
        for (int e = tid; e < LUT_N; e += NTHREADS) { const int d = LUT_OFF - e; lut[e] = d < 0 ? -INFINITY : (d >= 790 ? 0.f : (relb[rel_bucket_i(d) * 8 + hd] - relb[31 * 8 + hd]) * LOG2E); }
        bf16x8 qf[4];
        {
            const bf16_t* qrow = Q + ((long)((b * 8 + hd) * 2 + comp) * SEQ + qpos) * 64;
#pragma unroll
            for (int ks = 0; ks < 4; ++ks) qf[ks] = *(const bf16x8*)(qrow + 16 * ks + 8 * h);
        }
        const unsigned char* k0g = (const unsigned char*)(Kk + (long)((b * 8 + hd) * 2 + 0) * SEQ * 64);
        const unsigned char* k1g = (const unsigned char*)(Kk + (long)((b * 8 + hd) * 2 + 1) * SEQ * 64);
        const unsigned char* vtg = (const unsigned char*)(VT + (long)(b * 8 + hd) * 128 * SEQ);
        f32x16 o[4];
#pragma unroll
        for (int dt = 0; dt < 4; ++dt)
#pragma unroll
            for (int i = 0; i < 16; ++i) o[dt][i] = 0.f;
        float l = 0.f;
        const float nmb = -((const float*)(ws + OFF_MB0))[(long)((b * 8 + hd) * 2 + comp) * SEQ + qpos];
        auto stage = [&](int kt, unsigned char* st) {
#pragma unroll
            for (int sb = 0; sb < 2; ++sb) {
                dma_issue(st + sb * 8192, k0g + (long)(2 * kt + sb) * 8192, koff, tid);
                dma_issue(st + 16384 + sb * 8192, k1g + (long)(2 * kt + sb) * 8192, koff, tid);
                dma_issue(st + 32768 + sb * 16384, vtg + (long)(2 * kt + sb) * 128, voff, tid);
            }
        };
        stage(0, lds);
        __syncthreads();
        for (int kt = 0; kt < ntiles; ++kt) {
            unsigned char* cur = lds + (kt & 1) * ST2;
            if (kt + 1 < ntiles) stage(kt + 1, lds + ((kt + 1) & 1) * ST2);
            const bool nearb = qlo - (kt * 128 + 127) < 790;
            const int dbase0 = qpos - kt * 128 - 8 * h;
            const unsigned char* kb = cur + comp * 16384;
            f32x16 sa, sbv;
            attn_qk32<64>(kb, qf, sa, 0, r, h, nmb);
#pragma unroll
            for (int j = 0; j < 4; ++j) {
                f32x16& sc = (j & 1) ? sbv : sa;
                f32x16& sn = (j & 1) ? sa : sbv;
                if (j < 3) attn_qk32<64>(kb + ((j + 1) >> 1) * 8192, qf, sn, (j + 1) & 1, r, h, nmb);
                if (nearb) {
                    const float* lp = lut + (LUT_OFF - dbase0 + 64 * (j >> 1));
#pragma unroll
                    for (int i = 0; i < 16; ++i) sc[i] += lp[kidx(j & 1, i)];
                }
                attn_softmax32_b(sc, l);
                bf16x8 pf[2];
                attn_pack32(sc, pf);
                attn_pv32(cur + 32768 + (j >> 1) * 16384, pf, o, j & 1, r, h);
            }
            __syncthreads();
        }
        l = sum_x32(l);
        const float inv = l > 0.f ? frcp(l) : 0.f;
        float* xch = (float*)lds + qg * 4096;
        if (comp == 1) {
            const float sc = inv * lam_full;
#pragma unroll
            for (int dt = 0; dt < 4; ++dt)
#pragma unroll
                for (int i = 0; i < 16; ++i) xch[(dt * 16 + i) * 64 + lane] = o[dt][i] * sc;
        }
        __syncthreads();
        if (comp == 0) {
            float ss = 0.f;
#pragma unroll
            for (int dt = 0; dt < 4; ++dt)
#pragma unroll
                for (int i = 0; i < 16; ++i) { const float v = o[dt][i] * inv - xch[(dt * 16 + i) * 64 + lane]; o[dt][i] = v; ss += v * v; }
            ss = sum_x32(ss);
            const float rstd = rsqrtf(ss * (1.f / 128.f) + EPS) * 0.8f;
            bf16_t* orow = O + (long)(b * SEQ + qpos) * DM + hd * 128;
#pragma unroll
            for (int dt = 0; dt < 4; ++dt)
#pragma unroll
                for (int g4 = 0; g4 < 4; ++g4) {
                    const int d0 = 32 * dt + 8 * g4 + 4 * h;
                    const f32x4 gv = *(const f32x4*)(subln + d0);
                    u32x2 ov;
                    ov.x = pk2(o[dt][4 * g4 + 0] * rstd * gv.x, o[dt][4 * g4 + 1] * rstd * gv.y);
                    ov.y = pk2(o[dt][4 * g4 + 2] * rstd * gv.z, o[dt][4 * g4 + 3] * rstd * gv.w);
                    *(u32x2*)(orow + d0) = ov;
                }
        }
        __syncthreads();
    }
}

template <int VAR>
DI void phase_nsa_attn(const Params& p, unsigned char* lds, int tid) {
    unsigned char* ws = p.ws;
    const bf16_t* QN = (const bf16_t*)(ws + OFF_QN);
    const bf16_t* KS = (const bf16_t*)(ws + OFF_KS);
    const bf16_t* VST = (const bf16_t*)(ws + OFF_VST);
    const bf16_t* KW = (const bf16_t*)(ws + OFF_KW);
    const bf16_t* VWT = (const bf16_t*)(ws + OFF_VWT);
    const bf16_t* KCMP = (const bf16_t*)(ws + OFF_KCMP);
    const bf16_t* VCMPT = (const bf16_t*)(ws + OFF_VCMPT);
    const float* gates = (const float*)(ws + OFF_GATES);
    bf16_t* O = VAR ? (bf16_t*)(ws + OFF_PU + 32 * MB) : (bf16_t*)(ws + OFF_H);
    const float* relb = p.in[2];
    const int lane = tid & 63, w = tid >> 6, hg = w >> 1, th = w & 1, r = lane & 31, h = lane >> 5;
    float* lut = (float*)(lds + AT_LUT);
    float* lutc = (float*)(lds + AT_LUTC);
    float* imp = (float*)(lds + AT_IMP);
    unsigned* selw = (unsigned*)(lds + AT_SEL);
    unsigned short* sel16 = (unsigned short*)selw;
    float* bmxs = (float*)(selw + 264);
    const float* qnrm = (const float*)(ws + OFF_MB1);
    float kmx[3];
    for (int br = 0; br < 3; ++br) { float mx = 0.f; for (int d = 0; d < 128; ++d) mx = fmaxf(mx, fabsf(p.in[21][br * 128 + d])); kmx[br] = mx * 11.313708498984761f; }
    const int G = gridDim.x, rows_per_it = G >> 3;
    int lut_g = -1;
    for (int it = 0;; ++it) {
        int u;
        if ((G & 7) == 0) {
            const int rr = blockIdx.x >> 3, cc = blockIdx.x & 7;
            const int rowi = it * rows_per_it + ((it & 1) ? rows_per_it - 1 - rr : rr);
            u = rowi * 8 + cc;
        } else u = it * G + blockIdx.x;
        if (u >= 1024) break;
        const int bi = 127 - (u >> 3), b = (u & 7) >> 1, g = u & 1, head = 4 * g + hg;
        const int tq = 64 * bi + 32 * th + r;
        const int tl = 32 * th + r;
        const long tok = (long)b * SEQ + tq;
        if (g != lut_g) {
            lut_g = g;
            if (tid < 4) { float bm = 0.f; for (int bk = 0; bk < 32; ++bk) bm = fmaxf(bm, relb[bk * 8 + 4 * g + tid] - relb[31 * 8 + 4 * g + tid]); bmxs[tid] = bm * LOG2E; }
            for (int e = tid; e < 4 * LUT_N; e += NTHREADS) { const int hh = e / LUT_N, d = LUT_OFF - (e % LUT_N); lut[e] = d < 0 ? -INFINITY : (d >= 790 ? 0.f : (relb[rel_bucket_i(d) * 8 + 4 * g + hh] - relb[31 * 8 + 4 * g + hh]) * LOG2E); }
            for (int e = tid; e < 4 * 16 * LUTC_W; e += NTHREADS) {
                const int hh = e / (16 * LUTC_W), ph = (e / LUTC_W) & 15, ci = e % LUTC_W, d = 16 * (ci - 1) + ph;
                lutc[e] = ci == 0 ? -INFINITY : (d >= 790 ? 0.f : (relb[rel_bucket_i(d) * 8 + 4 * g + hh] - relb[31 * 8 + 4 * g + hh]) * LOG2E);
            }
        }
        if (tid < 4) selw[256 + tid] = 0u;
        const float* mylut = lut + hg * LUT_N;
        bf16x8 qf[8];
        const bf16_t* qrow = QN + ((long)(b * 8 + head) * SEQ + tq) * 128 + 8 * h;
        auto load_q = [&](const bf16_t* qr) {
#pragma unroll
            for (int ks = 0; ks < 8; ++ks) qf[ks] = *(const bf16x8*)(qr + 16 * ks);
        };
        const float* gp = gates + tok * 24 + head * 3;
        bf16_t* orow = O + (VAR ? (tok & 16383) : tok) * DM + head * 128;
        auto stage = [&](const unsigned char* kg, const unsigned char* vg, unsigned vstride, int kt, unsigned char* st) {
            int t2 = tid; asm volatile("" : "+v"(t2));
            unsigned koff[2], vo[2];
            dma_offsets<256, 64>(koff, 256, t2);
            dma_offsets<128, 128>(vo, vstride, t2);
            dma_issue(st, kg + (long)kt * 16384, koff, t2);
            dma_issue(st + 16384, vg + (long)kt * 128, vo, t2);
        };
        f32x16 o[4];
        float l;
        auto reset = [&]() {
#pragma unroll
            for (int dt = 0; dt < 4; ++dt)
#pragma unroll
                for (int i = 0; i < 16; ++i) o[dt][i] = 0.f;
            l = 0.f;
        };
        const unsigned char* kcg = (const unsigned char*)(KCMP + (long)(b * 2 + g) * 512 * 128);
        const unsigned char* vcg = (const unsigned char*)(VCMPT + (long)(b * 2 + g) * 128 * 512);
        const int nct = ((4 * bi + 2) >> 6) + 1;
        const int hgc = r & 3, tlc = 8 * w + (r >> 2), tqc = 64 * bi + tlc;
        const long tokc = (long)b * SEQ + tqc;
        reset();
        load_q(QN + ((long)(b * 8 + 4 * g + hgc) * SEQ + tqc) * 128 + 8 * h);
        __syncthreads();
        if (VAR != 3) {
            const int cb = (tqc - 31) >> 4;
            const float* lc = lutc + (hgc * 16 + ((tqc - 31) & 15)) * LUTC_W + 1;
            const float nmb = -(qnrm[tokc * 8 + 4 * g + hgc] * kmx[0] + bmxs[hgc]);
            stage(kcg, vcg, 1024u, 0, lds);
            __syncthreads();
            for (int kt = 0; kt < nct; ++kt) {
                unsigned char* cur = lds + (kt & 1) * AT_STAGE;
                if (kt + 1 < nct) stage(kcg, vcg, 1024u, kt + 1, lds + ((kt + 1) & 1) * AT_STAGE);
                const int cbase = cb - kt * 64 - 8 * h;
#pragma unroll
                for (int mt = 0; mt < 2; ++mt) {
                    f32x16 st;
                    attn_qk32<128>(cur, qf, st, mt, r, h, nmb);
                    float sum = 0.f;
#pragma unroll
                    for (int i = 0; i < 16; ++i) {
                        const int c = cbase - kidx(mt, i);
                        sum += fexp2(st[i] + lc[c < -1 ? -1 : (c > 50 ? 50 : c)]);
                    }
                    l += sum;
                }
                __syncthreads();
            }
            const float lt = sum_x32(l);
            const float invl = lt > 0.f ? frcp(lt) : 0.f;
            stage(kcg, vcg, 1024u, 0, lds);
            __syncthreads();
            float carry = 0.f;
            for (int kt = 0; kt < nct; ++kt) {
                unsigned char* cur = lds + (kt & 1) * AT_STAGE;
                if (kt + 1 < nct) stage(kcg, vcg, 1024u, kt + 1, lds + ((kt + 1) & 1) * AT_STAGE);
                const int cbase = cb - kt * 64 - 8 * h;
                float o0[4], o1[4], sp[4];
#pragma unroll
                for (int mt = 0; mt < 2; ++mt) {
                    f32x16 st;
                    attn_qk32<128>(cur, qf, st, mt, r, h, nmb);
#pragma unroll
                    for (int i = 0; i < 16; ++i) {
                        const int c = cbase - kidx(mt, i);
                        st[i] = fexp2(st[i] + lc[c < -1 ? -1 : (c > 50 ? 50 : c)]) * invl;
                    }
#pragma unroll
                    for (int gq = 0; gq < 2; ++gq) {
                        const int G2 = 2 * mt + gq, q0 = 2 * gq, q1 = 2 * gq + 1;
                        const float c20 = 0.5f * st[4 * q0 + 3];
                        o0[G2] = st[4 * q0] + st[4 * q0 + 1] + st[4 * q0 + 2] + c20;
                        o1[G2] = st[4 * q1] + st[4 * q1 + 1] + st[4 * q1 + 2] + 0.5f * st[4 * q1 + 3] + c20;
                        sp[G2] = 0.5f * st[4 * q1 + 3];
                    }
                    bf16x8 pf[2];
                    attn_pack32(st, pf);
                    attn_pv32(cur + 16384, pf, o, mt, r, h);
                }
                float rc[4];
#pragma unroll
                for (int G2 = 0; G2 < 4; ++G2) rc[G2] = __uint_as_float(get_x32(__float_as_uint(sp[G2]), h));
                if (h) {
#pragma unroll
                    for (int G2 = 0; G2 < 4; ++G2) o0[G2] += rc[G2];
                } else {
                    o0[0] += carry; o0[1] += rc[0]; o0[2] += rc[1]; o0[3] += rc[2];
                    carry = rc[3];
                }
#pragma unroll
                for (int G2 = 0; G2 < 4; ++G2) {
                    float a0 = o0[G2], a1 = o1[G2];
                    a0 += lx1(a0); a0 += lx2(a0); a1 += lx1(a1); a1 += lx2(a1);
                    if (hgc == 0) *(f32x2*)(imp + tlc * 130 + kt * 16 + 4 * G2 + 2 * h) = (f32x2){a0, a1};
                }
                __syncthreads();
            }
        }
        {
            const float g_c = gates[tokc * 24 + (4 * g + hgc) * 3];
            bf16_t* orc = O + (VAR ? (tokc & 16383) : tokc) * DM + (4 * g + hgc) * 128;
#pragma unroll
            for (int dt = 0; dt < 4; ++dt)
#pragma unroll
                for (int g4 = 0; g4 < 4; ++g4) {
                    const int d0 = 32 * dt + 8 * g4 + 4 * h;
                    u32x2 ov;
                    ov.x = pk2(o[dt][4 * g4 + 0] * g_c, o[dt][4 * g4 + 1] * g_c);
                    ov.y = pk2(o[dt][4 * g4 + 2] * g_c, o[dt][4 * g4 + 3] * g_c);
                    *(u32x2*)(orc + d0) = ov;
                }
        }
        if (VAR != 5) {
            const int tkn = tid >> 3, part = tid & 7;
            unsigned key[16];
#pragma unroll
            for (int q = 0; q < 16; ++q) {
                const int j = part * 16 + q;
                float v = imp[tkn * 130 + j];
                const int back = bi - j;
                if (j == 0 || (back >= 0 && back < 2)) v = 1e9f;
                if (back < 0) v = -1e30f;
                key[q] = f2key(v);
            }
            auto sum8 = [&](int c) -> int {
                c += __builtin_amdgcn_update_dpp(0, c, 0xB1, 0xF, 0xF, true);
                c += __builtin_amdgcn_update_dpp(0, c, 0x4E, 0xF, 0xF, true);
                c += __builtin_amdgcn_update_dpp(0, c, 0x141, 0xF, 0xF, true);
                return c;
            };
            unsigned T = 0u;
#pragma unroll 4
            for (int bit = 31; bit >= 0; --bit) {
                const unsigned cand = T | (1u << bit);
                int c = 0;
#pragma unroll
                for (int q = 0; q < 16; ++q) c += key[q] >= cand ? 1 : 0;
                if (sum8(c) >= 16) T = cand;
            }
            int cg = 0, ce = 0;
#pragma unroll
            for (int q = 0; q < 16; ++q) { cg += key[q] > T ? 1 : 0; ce += key[q] == T ? 1 : 0; }
            const int need = 16 - sum8(cg);
            int pre = ce;
            { int t = __builtin_amdgcn_update_dpp(0, pre, 0x111, 0xF, 0xF, true); if (part >= 1) pre += t; }
            { int t = __builtin_amdgcn_update_dpp(0, pre, 0x112, 0xF, 0xF, true); if (part >= 2) pre += t; }
            { int t = __builtin_amdgcn_update_dpp(0, pre, 0x114, 0xF, 0xF, true); if (part >= 4) pre += t; }
            int before = pre - ce;
            unsigned bits = 0;
#pragma unroll
            for (int q = 0; q < 16; ++q) {
                const bool eq = key[q] == T;
                const bool selq = key[q] > T || (eq && before < need);
                before += eq ? 1 : 0;
                bits |= (selq && key[q] >= 0x80000000u) ? (1u << q) : 0u;
            }
            sel16[tkn * 8 + part] = (unsigned short)bits;
            atomicOr(&selw[256 + (part >> 1)], bits << ((part & 1) * 16));
        }
        __syncthreads();
        const unsigned un0 = selw[256], un1 = selw[257], un2 = selw[258], un3 = selw[259];
        const unsigned char* ksg = (const unsigned char*)(KS + (long)(b * 2 + g) * SEQ * 128);
        const unsigned char* vsg = (const unsigned char*)(VST + (long)(b * 2 + g) * 128 * SEQ);
        reset(); load_q(qrow);
        const float qn_main = qnrm[tok * 8 + head];
        {
            const float nmb = -(qn_main * kmx[1] + bmxs[hg]);
            const unsigned long long ulo = ((unsigned long long)(unsigned)__builtin_amdgcn_readfirstlane((int)un1) << 32) | (unsigned)__builtin_amdgcn_readfirstlane((int)un0);
            const unsigned long long uhi = ((unsigned long long)(unsigned)__builtin_amdgcn_readfirstlane((int)un3) << 32) | (unsigned)__builtin_amdgcn_readfirstlane((int)un2);
            auto next_tile = [&](int from) -> int {
                if (from < 64) { const unsigned long long mk = ulo >> from; if (mk) return from + __builtin_ctzll(mk); from = 64; }
                if (from < 128) { const unsigned long long mk = uhi >> (from - 64); if (mk) return from + __builtin_ctzll(mk); }
                return 128;
            };
            int jt = (VAR == 1 || VAR == 4 || VAR == 5) ? 128 : next_tile(0);
            int buf = 0;
            if (jt < 128) stage(ksg, vsg, SEQ * 2u, jt, lds);
            __syncthreads();
            while (jt < 128) {
                unsigned char* cur = lds + buf * AT_STAGE;
                const int jn = next_tile(jt + 1);
                if (jn < 128) stage(ksg, vsg, SEQ * 2u, jn, lds + (buf ^ 1) * AT_STAGE);
                const unsigned wd = selw[tl * 4 + (jt >> 5)];
                const bool mysel = (wd >> (jt & 31)) & 1u;
                if (__any(mysel)) {
                    const int k0 = jt * 64;
                    const bool nearb = (64 * bi + 32 * th) - (k0 + 63) < 790;
                    const int dbase = tq - k0 - 8 * h;
                    const float* lp = mylut + (LUT_OFF - dbase);
#pragma unroll
                    for (int mt = 0; mt < 2; ++mt) {
                        f32x16 st;
                        attn_qk32<128>(cur, qf, st, mt, r, h, mysel ? nmb : -INFINITY);
                        if (nearb) {
#pragma unroll
                            for (int i = 0; i < 16; ++i) st[i] += lp[kidx(mt, i)];
                        }
                        attn_softmax32_b(st, l);
                        bf16x8 pf[2];
                        attn_pack32(st, pf);
                        attn_pv32(cur + 16384, pf, o, mt, r, h);
                    }
                }
                __syncthreads();
                buf ^= 1; jt = jn;
            }
        }
        {
            const float lt = sum_x32(l);
            const float sc = (lt > 0.f ? frcp(lt) : 0.f) * gp[1];
#pragma unroll
            for (int dt = 0; dt < 4; ++dt)
#pragma unroll
                for (int g4 = 0; g4 < 4; ++g4) {
                    const int d0 = 32 * dt + 8 * g4 + 4 * h;
                    const u32x2 pv = *(const u32x2*)(orow + d0);
                    u32x2 ov;
                    ov.x = pk2(bflo(pv.x) + o[dt][4 * g4 + 0] * sc, bfhi(pv.x) + o[dt][4 * g4 + 1] * sc);
                    ov.y = pk2(bflo(pv.y) + o[dt][4 * g4 + 2] * sc, bfhi(pv.y) + o[dt][4 * g4 + 3] * sc);
                    *(u32x2*)(orow + d0) = ov;
                }
        }
        const unsigned char* kwg = (const unsigned char*)(KW + (long)(b * 2 + g) * SEQ * 128);
        const unsigned char* vwg = (const unsigned char*)(VWT + (long)(b * 2 + g) * 128 * SEQ);
        reset(); load_q(qrow);
        {
            const float nmb = -(qn_main * kmx[2] + bmxs[hg]);
            const int j0 = bi >= 8 ? bi - 8 : 0, nt = (VAR == 2 || VAR == 4 || VAR == 5) ? 1 : bi - j0 + 1;
            stage(kwg, vwg, SEQ * 2u, j0, lds);
            __syncthreads();
            for (int kt = 0; kt < nt; ++kt) {
                unsigned char* cur = lds + (kt & 1) * AT_STAGE;
                if (kt + 1 < nt) stage(kwg, vwg, SEQ * 2u, j0 + kt + 1, lds + ((kt + 1) & 1) * AT_STAGE);
                const int k0 = (j0 + kt) * 64;
                const int dbase = tq - k0 - 8 * h;
                const float* lp = mylut + (LUT_OFF - dbase);
#pragma unroll
                for (int mt = 0; mt < 2; ++mt) {
                    f32x16 st;
                    attn_qk32<128>(cur, qf, st, mt, r, h, nmb);
#pragma unroll
                    for (int i = 0; i < 16; ++i) st[i] = kidx(mt, i) <= dbase - 512 ? -INFINITY : st[i] + lp[kidx(mt, i)];
                    attn_softmax32_b(st, l);
                    bf16x8 pf[2];
                    attn_pack32(st, pf);
                    attn_pv32(cur + 16384, pf, o, mt, r, h);
                }
                __syncthreads();
            }
        }
        {
            const float lt = sum_x32(l);
            const float sc = (lt > 0.f ? frcp(lt) : 0.f) * gp[2];
#pragma unroll
            for (int dt = 0; dt < 4; ++dt)
#pragma unroll
                for (int g4 = 0; g4 < 4; ++g4) {
                    const int d0 = 32 * dt + 8 * g4 + 4 * h;
                    const u32x2 pv = *(const u32x2*)(orow + d0);
                    u32x2 ov;
                    ov.x = pk2(bflo(pv.x) + o[dt][4 * g4 + 0] * sc, bfhi(pv.x) + o[dt][4 * g4 + 1] * sc);
                    ov.y = pk2(bflo(pv.y) + o[dt][4 * g4 + 2] * sc, bfhi(pv.y) + o[dt][4 * g4 + 3] * sc);
                    *(u32x2*)(orow + d0) = ov;
                }
        }
        __syncthreads();
    }
}

DI void fp8x16_fma(const u32x4& q, const f32x4& h0, const f32x4& h1, const f32x4& h2, const f32x4& h3, f32x2& a0, f32x2& a1) {
    a0 += __builtin_amdgcn_cvt_pk_f32_fp8((int)q.x, false) * (f32x2){h0.x, h0.y};
    a1 += __builtin_amdgcn_cvt_pk_f32_fp8((int)q.x, true)  * (f32x2){h0.z, h0.w};
    a0 += __builtin_amdgcn_cvt_pk_f32_fp8((int)q.y, false) * (f32x2){h1.x, h1.y};
    a1 += __builtin_amdgcn_cvt_pk_f32_fp8((int)q.y, true)  * (f32x2){h1.z, h1.w};
    a0 += __builtin_amdgcn_cvt_pk_f32_fp8((int)q.z, false) * (f32x2){h2.x, h2.y};
    a1 += __builtin_amdgcn_cvt_pk_f32_fp8((int)q.z, true)  * (f32x2){h2.z, h2.w};
    a0 += __builtin_amdgcn_cvt_pk_f32_fp8((int)q.w, false) * (f32x2){h3.x, h3.y};
    a1 += __builtin_amdgcn_cvt_pk_f32_fp8((int)q.w, true)  * (f32x2){h3.z, h3.w};
}
template <bool DRY>
DI void phase_peer_u(const Params& p, int layer, unsigned char* lds, int tid) {
    unsigned char* ws = p.ws;
    const unsigned char* H8 = ws + OFF_H8;
    const float* HS = (const float*)(ws + OFF_HS);
    const int* ridx = (const int*)(ws + OFF_RIDX);
    float* rgate = (float*)(ws + OFF_RGATE);
    const unsigned char* U = ws + OFF_PU + (long)layer * 16384 * 1024;
    const float* usi = (const float*)(ws + OFF_USI) + layer * 16384;
    const float* vsi = (const float*)(ws + OFF_VSI) + layer * 16384;
    const int lane = tid & 63, w = tid >> 6, sub = lane & 7, grp = lane >> 3;
    const int xg = blockIdx.x & 7, lb = blockIdx.x >> 3, nwv = (gridDim.x >> 3) * NWAVES, wv = lb * NWAVES + w;
    unsigned* clb = (unsigned*)(lds + w * 12288);
    unsigned char* hbb = lds + w * 12288 + 2048;
    const unsigned long long lt = (1ull << lane) - 1ull;
    if (lb >= (int)(gridDim.x >> 3)) return;
    int i0, i1; u32x4 h0; float hs0;
    auto ld_tok = [&](int tk) {
        tk = tk < NTOK ? tk : wv;
        i0 = ridx[(long)tk * 128 + lane]; i1 = ridx[(long)tk * 128 + 64 + lane];
        h0 = *(const u32x4*)(H8 + (long)tk * DM + lane * 16); hs0 = HS[tk];
    };
    auto stage_tok = [&](int bi, float& hsinv) -> int {
        unsigned* cl = clb + bi * 256; unsigned char* hb = hbb + bi * 4096;
        const bool b0 = (i0 >> 11) == xg, b1 = (i1 >> 11) == xg;
        const unsigned long long m0 = __ballot(b0), m1 = __ballot(b1);
        const int n0 = __popcll(m0), n = n0 + __popcll(m1);
        if (b0) { const int k = __popcll(m0 & lt); cl[2 * k] = lane; cl[2 * k + 1] = i0; }
        if (b1) { const int k = n0 + __popcll(m1 & lt); cl[2 * k] = 64 + lane; cl[2 * k + 1] = i1; }
        if (n == 0 && lane == 0) { cl[0] = 0u; cl[1] = 0u; }
        hsinv = hs0;
        *(u32x4*)(hb + lane * 16) = h0;
        return n;
    };
    float shC, shN = 1.f;
    ld_tok(wv);
    int nC = stage_tok(0, shC);
    ld_tok(wv + nwv);
    int slotC, idC; bool validC;
    { validC = grp < nC; const int kk = validC ? grp : 0; slotC = clb[2 * kk]; idC = clb[2 * kk + 1]; }
    u32x4 uv[8];
    {
        const unsigned uoff = (unsigned)idC * 1024u + (unsigned)sub * 16u;
#pragma unroll
        for (int t = 0; t < 8; ++t) uv[t] = *(const u32x4*)(U + (uoff + t * 128));
    }
    int it = 0;
    for (int tok = wv; tok < NTOK; tok += nwv, ++it) {
        const int cb = it & 1;
        const unsigned* clC = clb + cb * 256; const unsigned* clN = clb + (cb ^ 1) * 256;
        const unsigned char* hbC = hbb + cb * 4096;
        const bool more = tok + nwv < NTOK;
        int nN = 0;
        if (more) { nN = stage_tok(cb ^ 1, shN); ld_tok(tok + 2 * nwv); }
        const int nr = nC > 8 ? (nC + 7) >> 3 : 1;
        u32x4 hq[8];
#pragma unroll
        for (int t = 0; t < 8; ++t) hq[t] = *(const u32x4*)(hbC + (sub + 8 * t) * 16);
        for (int rd = 0; rd < nr; ++rd) {
            float g_in = 0.f, su = 0.f, sv = 0.f;
            if (validC && sub == 0) { g_in = rgate[(long)tok * 128 + slotC]; su = usi[idC]; sv = vsi[idC]; }
            int slotN, idN; bool validN;
            if (rd + 1 < nr) { const int k = 8 * (rd + 1) + grp; validN = k < nC; const int kk = validN ? k : 0; slotN = clC[2 * kk]; idN = clC[2 * kk + 1]; }
            else if (more) { validN = grp < nN; const int kk = validN ? grp : 0; slotN = clN[2 * kk]; idN = clN[2 * kk + 1]; }
            else { validN = false; slotN = 0; idN = clC[1]; }
            const unsigned uoffN = (unsigned)idN * 1024u + (unsigned)sub * 16u;
            int a0 = 0, a1 = 0, a2 = 0, a3 = 0;
#pragma unroll
            for (int t = 0; t < 8; ++t) {
                const u32x4 q = uv[t];
                a0 = __builtin_amdgcn_sdot4((int)q.x, (int)hq[t].x, a0, false); a1 = __builtin_amdgcn_sdot4((int)q.y, (int)hq[t].y, a1, false);
                a2 = __builtin_amdgcn_sdot4((int)q.z, (int)hq[t].z, a2, false); a3 = __builtin_amdgcn_sdot4((int)q.w, (int)hq[t].w, a3, false);
                uv[t] = *(const u32x4*)(U + (uoffN + t * 128));
            }
            int di = (a0 + a1) + (a2 + a3);
            di += __builtin_amdgcn_update_dpp(0, di, 0xB1, 0xF, 0xF, true);
            di += __builtin_amdgcn_update_dpp(0, di, 0x4E, 0xF, 0xF, true);
            di += __builtin_amdgcn_update_dpp(0, di, 0x141, 0xF, 0xF, true);
            if (validC && sub == 0) {
                float* gw = DRY ? (float*)(ws + OFF_R) + (long)tok * 128 + slotC : rgate + (long)tok * 128 + slotC;
                *gw = g_in * gelu_tanh((float)di * su * shC) * sv;
            }
            slotC = slotN; idC = idN; validC = validN;
        }
        nC = nN; shC = shN;
    }
}

#ifndef VMASK
#define VMASK 0xffffffffu
#endif
template <bool DRY>
DI void phase_peer_v(const Params& p, int layer, int tid) {
    unsigned char* ws = p.ws;
    const int* ridx = (const int*)(ws + OFF_RIDX);
    const float* wact = (const float*)(ws + OFF_RGATE);
    const float* ada = (const float*)(ws + OFF_ADA);
    float* x = opq(p.out);
    const int lane = tid & 63, w = tid >> 6, sub = lane & 7, eg = lane >> 3;
    const int xg = blockIdx.x & 7, lb = blockIdx.x >> 3, nwv = (gridDim.x >> 3) * NWAVES, wv = lb * NWAVES + w;
    if (lb >= (int)(gridDim.x >> 3)) return;
    const unsigned char* Vc = ws + OFF_PV + ((long)(layer * 8 + xg) * 16384) * 128;
    const int col0 = 128 * xg + 16 * sub;
    const __amdgpu_buffer_rsrc_t vrs = __builtin_amdgcn_make_buffer_rsrc((void*)Vc, (short)0, 16384 * 128, 0x00020000);
    auto ld_ids = [&](int tk, u32x4 (&a)[4], f32x4 (&wq)[4]) {
        tk = tk < NTOK ? tk : wv;
        const u32x4* ip = (const u32x4*)(ridx + (long)tk * 128 + eg * 16);
        const f32x4* wp = (const f32x4*)(wact + (long)tk * 128 + eg * 16);
#pragma unroll
        for (int q = 0; q < 4; ++q) { a[q] = ip[q]; wq[q] = wp[q]; }
    };
    u32x4 vv[16];
    u32x4 na[4], pa[4]; f32x4 cw[4], nw[4], pw[4];
    {
        u32x4 a[4];
        ld_ids(wv, a, cw);
#pragma unroll
        for (int j = 0; j < 16; ++j)
            vv[j] = __builtin_bit_cast(u32x4, __builtin_amdgcn_raw_buffer_load_b128(vrs, (int)((a[j >> 2][j & 3] & (DRY ? VMASK : 0xffffffffu)) * 128u + (unsigned)sub * 16u), 0, 0));
    }
    ld_ids(wv + nwv, na, nw);
    f32x4 gfv[4]; int gb = -1;
    for (int tok = wv; tok < NTOK; tok += nwv) {
        ld_ids(tok + 2 * nwv, pa, pw);
        f32x4 xv[4];
        {
            const float* xin = x + (long)tok * DM + col0;
#pragma unroll
            for (int c = 0; c < 4; ++c) xv[c] = *(const f32x4*)(xin + 4 * c);
            const int b = tok >> 13;
            if (b != gb) {
                gb = b;
                const float* gf = ada + b * ADA_STRIDE + layer * 6144 + 5 * 1024 + col0;
#pragma unroll
                for (int c = 0; c < 4; ++c) gfv[c] = *(const f32x4*)(gf + 4 * c);
            }
        }
        f32x2 ap[8];
#pragma unroll
        for (int i = 0; i < 8; ++i) ap[i] = (f32x2){0.f, 0.f};
#pragma unroll
        for (int j = 0; j < 16; ++j) {
            const float ws1 = cw[j >> 2][j & 3]; const f32x2 ww = {ws1, ws1}; const u32x4 v = vv[j];
            ap[0] += __builtin_amdgcn_cvt_pk_f32_fp8((int)v.x, false) * ww; ap[1] += __builtin_amdgcn_cvt_pk_f32_fp8((int)v.x, true) * ww;
            ap[2] += __builtin_amdgcn_cvt_pk_f32_fp8((int)v.y, false) * ww; ap[3] += __builtin_amdgcn_cvt_pk_f32_fp8((int)v.y, true) * ww;
            ap[4] += __builtin_amdgcn_cvt_pk_f32_fp8((int)v.z, false) * ww; ap[5] += __builtin_amdgcn_cvt_pk_f32_fp8((int)v.z, true) * ww;
            ap[6] += __builtin_amdgcn_cvt_pk_f32_fp8((int)v.w, false) * ww; ap[7] += __builtin_amdgcn_cvt_pk_f32_fp8((int)v.w, true) * ww;
            vv[j] = __builtin_bit_cast(u32x4, __builtin_amdgcn_raw_buffer_load_b128(vrs, (int)((na[j >> 2][j & 3] & (DRY ? VMASK : 0xffffffffu)) * 128u + (unsigned)sub * 16u), 0, 0));
        }
        float acc[16];
#pragma unroll
        for (int i = 0; i < 8; ++i) { acc[2 * i] = ap[i].x; acc[2 * i + 1] = ap[i].y; }
#pragma unroll
        for (int i = 0; i < 16; ++i) { acc[i] += lr8(acc[i]); acc[i] = sum_x16(acc[i]); acc[i] = sum_x32(acc[i]); }
        if (eg == 0) {
            float* xr = DRY ? (float*)(ws + OFF_R + 16 * MB) + (long)tok * DM + col0 : x + (long)tok * DM + col0;
#pragma unroll
            for (int c = 0; c < 4; ++c) {
                const f32x4 gv = gfv[c];
                f32x4 o;
                o.x = xv[c].x + gv.x * acc[4 * c + 0]; o.y = xv[c].y + gv.y * acc[4 * c + 1];
                o.z = xv[c].z + gv.z * acc[4 * c + 2]; o.w = xv[c].w + gv.w * acc[4 * c + 3];
                *(f32x4*)(xr + 4 * c) = o;
            }
        }
#pragma unroll
        for (int q = 0; q < 4; ++q) { cw[q] = nw[q]; na[q] = pa[q]; nw[q] = pw[q]; }
    }
}

DI void phase_norm2(const float* __restrict__ x, bf16_t* __restrict__ out1, const float* gain1, int sh1, int sc1,
                    bf16_t* __restrict__ out2, const float* gain2, int sh2, int sc2, const float* ada, int tid) {
    const int lane = tid & 63, gw = blockIdx.x * NWAVES + (tid >> 6), nw = gridDim.x * NWAVES;
    for (int tok = gw; tok < NTOK; tok += nw) {
        const int b = tok >> 13;
        f32x4 v[4]; float ss = 0.f;
#pragma unroll
        for (int j = 0; j < 4; ++j) { v[j] = *(const f32x4*)(x + (long)tok * DM + 4 * lane + 256 * j); ss += v[j].x * v[j].x + v[j].y * v[j].y + v[j].z * v[j].z + v[j].w * v[j].w; }
        const float rstd = rsqrtf(wave_sum(ss) * (1.f / DM) + EPS);
        norm_row_write(v, rstd, gain1, ada + b * ADA_STRIDE + sh1, ada + b * ADA_STRIDE + sc1, out1 + (long)tok * DM, lane);
        norm_row_write(v, rstd, gain2, ada + b * ADA_STRIDE + sh2, ada + b * ADA_STRIDE + sc2, out2 + (long)tok * DM, lane);
    }
}

template <int MT, class Epi>
DI void gemm_phase(const bf16_t* A, long lda, int M, const bf16_t* Bt, long ldb, int N, int K, const Epi& epi, unsigned char* lds, int tid) {
    const int ntm = (M + 128 * MT - 1) / (128 * MT), ntn = (N + 255) / 256, nt = ntm * ntn;
    if ((gridDim.x & 7) == 0 && (ntm & 31) == 0) {
        const int xcd = blockIdx.x & 7, lb = blockIdx.x >> 3, nlb = gridDim.x >> 3, tmx = ntm >> 3, per = tmx * ntn;
        for (int q = lb; q < per; q += nlb) {
            const int g4 = q / (4 * ntn), rem = q - g4 * 4 * ntn, tn = rem >> 2, tm = xcd * tmx + g4 * 4 + (rem & 3);
            if (tm < (xcd + 1) * tmx) gemm_tile<MT>(A, lda, M, Bt, ldb, N, K, tm * 128 * MT, tn * 256, epi, lds, tid);
        }
        return;
    }
    for (int t = blockIdx.x; t < nt; t += gridDim.x) {
        const int tn = t / ntm, tm = t % ntm;
        gemm_tile<MT>(A, lda, M, Bt, ldb, N, K, tm * 128 * MT, tn * 256, epi, lds, tid);
    }
}

template <int MT, class Epi>
DI void gemm_tile_i8(const unsigned char* __restrict__ A, int M, const float* __restrict__ as, const unsigned char* __restrict__ Bt, int N, const float* __restrict__ bs,
                     int K, int m0, int n0, const Epi& epi, unsigned char* lds, int tid) {
    constexpr int XS = MT * 128 * 128, WS = 256 * 128, STAGE = XS + WS;
    const int lane = tid & 63, w = tid >> 6, tg = w & 3, fh = w >> 2, r = lane & 31, h = lane >> 5;
    const int wbase = tid & ~63;
    unsigned xo[2 * MT], wo[4];
#pragma unroll
    for (int i = 0; i < 2 * MT; ++i) { int row, c; sw2_src(tid + 512 * i, row, c); int m = m0 + row; m = m < M ? m : M - 1; xo[i] = (unsigned)m * (unsigned)K + c * 16; }
#pragma unroll
    for (int i = 0; i < 4; ++i) { int row, c; sw2_src(tid + 512 * i, row, c); int n = n0 + row; n = n < N ? n : N - 1; wo[i] = (unsigned)n * (unsigned)K + c * 16; }
    auto stage = [&](int kt, unsigned char* st) {
#pragma unroll
        for (int i = 0; i < 2 * MT; ++i)
            __builtin_amdgcn_global_load_lds((const unsigned*)(A + kt * 128 + xo[i]), (unsigned*)(st + (wbase + 512 * i) * 16), 16, 0, 0);
#pragma unroll
        for (int i = 0; i < 4; ++i)
            __builtin_amdgcn_global_load_lds((const unsigned*)(Bt + kt * 128 + wo[i]), (unsigned*)(st + XS + (wbase + 512 * i) * 16), 16, 0, 0);
    };
    i32x16 acc[MT][4];
#pragma unroll
    for (int s2 = 0; s2 < MT; ++s2)
#pragma unroll
        for (int i = 0; i < 4; ++i)
#pragma unroll
            for (int j = 0; j < 16; ++j) acc[s2][i][j] = 0;
    const int nk = K >> 7;
    stage(0, lds);
    __syncthreads();
#pragma unroll 2
    for (int kt = 0; kt < nk; ++kt) {
        unsigned char* cur = lds + (kt & 1) * STAGE;
        if (kt + 1 < nk) stage(kt + 1, lds + ((kt + 1) & 1) * STAGE);
        i32x4 xfa[MT], wfa[4], xfb[MT], wfb[4];
        auto ldf = [&](i32x4 (&xf)[MT], i32x4 (&wf)[4], int ks) {
#pragma unroll
            for (int s2 = 0; s2 < MT; ++s2) xf[s2] = *(const i32x4*)(cur + sw2(32 * MT * tg + 32 * s2 + r, 2 * ks + h));
#pragma unroll
            for (int mt = 0; mt < 4; ++mt) wf[mt] = *(const i32x4*)(cur + XS + sw2(128 * fh + 32 * mt + r, 2 * ks + h));
        };
        auto mm = [&](const i32x4 (&xf)[MT], const i32x4 (&wf)[4]) {
#pragma unroll
            for (int mt = 0; mt < 4; ++mt)
#pragma unroll
                for (int s2 = 0; s2 < MT; ++s2) acc[s2][mt] = MFMA32I8(wf[mt], xf[s2], acc[s2][mt]);
        };
        ldf(xfa, wfa, 0);
        ldf(xfb, wfb, 1); __builtin_amdgcn_sched_barrier(0); mm(xfa, wfa); __builtin_amdgcn_sched_barrier(0);
        ldf(xfa, wfa, 2); __builtin_amdgcn_sched_barrier(0); mm(xfb, wfb); __builtin_amdgcn_sched_barrier(0);
        ldf(xfb, wfb, 3); __builtin_amdgcn_sched_barrier(0); mm(xfa, wfa); __builtin_amdgcn_sched_barrier(0);
        mm(xfb, wfb);
        __syncthreads();
    }
    auto fin = [&](const i32x16 (&ai)[4], int s2, int ho, int ro, int to) {
        const int tok = m0 + 32 * MT * tg + 32 * s2 + ro, fbase = n0 + 128 * fh;
        const float sa = as[tok < M ? tok : M - 1];
        f32x16 af[4];
#pragma unroll
        for (int mt = 0; mt < 4; ++mt) {
#pragma unroll
            for (int g4 = 0; g4 < 4; ++g4) {
                int f0 = fbase + 32 * mt + 8 * g4 + 4 * ho; f0 = f0 + 3 < N ? f0 : (N - 4 > 0 ? N - 4 : 0);
                const f32x4 sb = *(const f32x4*)(bs + f0);
                af[mt][4 * g4 + 0] = (float)ai[mt][4 * g4 + 0] * (sa * sb.x); af[mt][4 * g4 + 1] = (float)ai[mt][4 * g4 + 1] * (sa * sb.y);
                af[mt][4 * g4 + 2] = (float)ai[mt][4 * g4 + 2] * (sa * sb.z); af[mt][4 * g4 + 3] = (float)ai[mt][4 * g4 + 3] * (sa * sb.w);
            }
            __builtin_amdgcn_sched_barrier(0);
        }
        epi(af, tok, fbase, ho, lds, to);
        __builtin_amdgcn_sched_barrier(0);
    };
    if constexpr (MT == 2 && epi_stash<Epi>::present) {
        int* sp = (int*)lds + w * 4096 + lane;
#pragma unroll
        for (int mt = 0; mt < 4; ++mt)
#pragma unroll
            for (int j = 0; j < 16; ++j) sp[(mt * 16 + j) * 64] = acc[1][mt][j];
        int ho = h, ro = r, to = tid;
        asm volatile("" : "+v"(ho), "+v"(ro), "+v"(to));
        fin(acc[0], 0, ho, ro, to);
        i32x16 a2[4];
        const int* sp2 = sp; asm volatile("" : "+v"(sp2));
#pragma unroll
        for (int mt = 0; mt < 4; ++mt)
#pragma unroll
            for (int j = 0; j < 16; ++j) a2[mt][j] = sp2[(mt * 16 + j) * 64];
        asm volatile("" : "+v"(ho), "+v"(ro), "+v"(to));
        fin(a2, 1, ho, ro, to);
        __syncthreads();
    } else {
#pragma unroll
        for (int s2 = 0; s2 < MT; ++s2) fin(acc[s2], s2, h, r, tid);
    }
}
template <int MT, class Epi>
DI void gemm_phase_i8(const unsigned char* A, int M, const float* as, const unsigned char* Bt, int N, const float* bs, int K, const Epi& epi, unsigned char* lds, int tid) {
    const int ntm = (M + 128 * MT - 1) / (128 * MT), ntn = (N + 255) / 256, nt = ntm * ntn;
    if ((gridDim.x & 7) == 0 && (ntm & 31) == 0) {
        const int xcd = blockIdx.x & 7, lb = blockIdx.x >> 3, nlb = gridDim.x >> 3, tmx = ntm >> 3, per = tmx * ntn;
        for (int q = lb; q < per; q += nlb) {
            const int g4 = q / (4 * ntn), rem = q - g4 * 4 * ntn, tn = rem >> 2, tm = xcd * tmx + g4 * 4 + (rem & 3);
            gemm_tile_i8<MT>(A, M, as, Bt, N, bs, K, tm * 128 * MT, tn * 256, epi, lds, tid);
        }
        return;
    }
    for (int t = blockIdx.x; t < nt; t += gridDim.x) {
        const int tn = t / ntm, tm = t % ntm;
        gemm_tile_i8<MT>(A, M, as, Bt, N, bs, K, tm * 128 * MT, tn * 256, epi, lds, tid);
    }
}

DI void wquant_rows(const bf16_t* __restrict__ src, unsigned char* __restrict__ dst, float* __restrict__ sc, int nrows, int gw, int nw, int lane) {
    for (int n = gw; n < nrows; n += nw) {
        const u32x4 a = *(const u32x4*)(src + (long)n * 1024 + 16 * lane), b = *(const u32x4*)(src + (long)n * 1024 + 16 * lane + 8);
        float v[16];
        v[0] = bflo(a.x); v[1] = bfhi(a.x); v[2] = bflo(a.y); v[3] = bfhi(a.y); v[4] = bflo(a.z); v[5] = bfhi(a.z); v[6] = bflo(a.w); v[7] = bfhi(a.w);
        v[8] = bflo(b.x); v[9] = bfhi(b.x); v[10] = bflo(b.y); v[11] = bfhi(b.y); v[12] = bflo(b.z); v[13] = bfhi(b.z); v[14] = bflo(b.w); v[15] = bfhi(b.w);
        float am = 0.f;
#pragma unroll
        for (int q = 0; q < 16; ++q) am = fmaxf(am, fabsf(v[q]));
        am = wave_max(am);
        const float qs = am > 0.f ? 127.f / am : 1.f;
        u32x4 o;
        o.x = (unsigned)pack_i8x4(v[0] * qs, v[1] * qs, v[2] * qs, v[3] * qs); o.y = (unsigned)pack_i8x4(v[4] * qs, v[5] * qs, v[6] * qs, v[7] * qs);
        o.z = (unsigned)pack_i8x4(v[8] * qs, v[9] * qs, v[10] * qs, v[11] * qs); o.w = (unsigned)pack_i8x4(v[12] * qs, v[13] * qs, v[14] * qs, v[15] * qs);
        *(u32x4*)(dst + (long)n * 1024 + 16 * lane) = o;
        if (lane == 0) sc[n] = am > 0.f ? am * (1.f / 127.f) : 1.f;
    }
}
DI void phase_wquant(unsigned char* ws, int tid) {
    const int lane = tid & 63, gw = blockIdx.x * NWAVES + (tid >> 6), nw = gridDim.x * NWAVES;
    float* sc = (float*)(ws + OFF_W8S);
    wquant_rows((const bf16_t*)(ws + OFF_WT_PEER), ws + OFF_W8_PEER, sc + W8S_PEER, 4096, gw, nw, lane);
    wquant_rows((const bf16_t*)(ws + OFF_WT_DIN), ws + OFF_W8_DIN, sc + W8S_DIN, 3072, gw, nw, lane);
    wquant_rows((const bf16_t*)(ws + OFF_WT_KV), ws + OFF_W8_KV, sc + W8S_KV, 1536, gw, nw, lane);
    wquant_rows((const bf16_t*)(ws + OFF_WT_NIN), ws + OFF_W8_NIN, sc + W8S_NIN, 1152, gw, nw, lane);
}

#define XB_TMO      128
#define XB_XCNT(j)  (256  + 64 * (j))
#define XB_XSUB(j)  (1280 + 64 * (j))
#define XB_XGEN(j)  (2304 + 64 * (j))
#define XB_TOP      3328
#define XB_TOPGEN   3392
#define XCD_BAR_WORDS 3456
#define XB_SPIN_CAP (1u << 22)
#define LAS __attribute__((address_space(3)))
DI unsigned xb_ld(unsigned* p) { return __hip_atomic_load(p, __ATOMIC_RELAXED, __HIP_MEMORY_SCOPE_AGENT); }
DI unsigned xb_add(unsigned* p, unsigned v) { return __hip_atomic_fetch_add(p, v, __ATOMIC_RELAXED, __HIP_MEMORY_SCOPE_AGENT); }
DI unsigned xb_xcc_id() { return (unsigned)__builtin_amdgcn_s_getreg((3 << 11) | 20) & 0xFu; }
#define XB_SPIN(cond, bar) do { unsigned _sp = 0; while (cond) { __builtin_amdgcn_s_sleep(1); \
    if ((++_sp & 255u) == 0u) { if (xb_ld(&(bar)[XB_TMO])) break; if (_sp > XB_SPIN_CAP) { atomicAdd(&(bar)[XB_TMO], 1u); break; } } } } while (0)
DI void xcd_barrier_complete(unsigned* bar, unsigned x, unsigned& nloc, unsigned& nx) {
    const unsigned G = gridDim.x;
    unsigned sum, cnt, mine, sp = 0u;
    for (;;) {
        sum = 0u; cnt = 0u; mine = 0u;
#pragma unroll
        for (unsigned j = 0; j < 16; ++j) { const unsigned c = xb_ld(&bar[XB_XCNT(j)]); sum += c; cnt += (c > 0u) ? 1u : 0u; mine = (j == x) ? c : mine; }
        if (sum == G) break;
        __builtin_amdgcn_s_sleep(1);
        if ((++sp & 255u) == 0u) { if (xb_ld(&bar[XB_TMO])) break; if (sp > XB_SPIN_CAP) { atomicAdd(&bar[XB_TMO], 1u); break; } }
    }
    nloc = mine > 0u ? mine : 1u; nx = cnt > 0u ? cnt : 1u;
}
DI void xcd_barrier(unsigned* bar, volatile LAS unsigned* st, int tid) {
    asm volatile("s_waitcnt vmcnt(0)" ::: "memory");
    __syncthreads();
    if (tid == 0) {
        const unsigned x = xb_xcc_id();
        __builtin_amdgcn_s_waitcnt(0);
        unsigned nloc = st[0], nx = st[1];
        if (nloc == 0u) { xcd_barrier_complete(bar, x, nloc, nx); st[0] = nloc; st[1] = nx; }
        const unsigned old = xb_add(&bar[XB_XSUB(x)], 1u);
        const unsigned gen = old / nloc;
        if (old + 1u == (gen + 1u) * nloc) {
            __builtin_amdgcn_fence(__ATOMIC_RELEASE, "agent");
            asm volatile("s_waitcnt vmcnt(0)" ::: "memory");
            const unsigned og = xb_add(&bar[XB_TOP], 1u);
            const unsigned tg = og / nx;
            if (og + 1u == (tg + 1u) * nx) xb_add(&bar[XB_TOPGEN], 1u);
            else XB_SPIN(xb_ld(&bar[XB_TOPGEN]) == tg, bar);
            __builtin_amdgcn_fence(__ATOMIC_ACQUIRE, "agent");
            xb_add(&bar[XB_XGEN(x)], 1u);
            asm volatile("s_waitcnt vmcnt(0)" ::: "memory");
        } else {
            XB_SPIN(xb_ld(&bar[XB_XGEN(x)]) == gen, bar);
            __builtin_amdgcn_fence(__ATOMIC_ACQUIRE, "agent");
            asm volatile("s_waitcnt vmcnt(0)" ::: "memory");
        }
    }
    __syncthreads();
}

#define ftid() ftid_(wave_u)
DI int ftid_(int wave_u) { int t = (wave_u << 6) + (int)__builtin_amdgcn_mbcnt_hi(~0u, __builtin_amdgcn_mbcnt_lo(~0u, 0u)); asm volatile("" : "+v"(t)); return t; }


#if defined(__HIP_DEVICE_COMPILE__)
typedef const __attribute__((address_space(4))) Params* KParamPtr;
DI Params load_params() { KParamPtr kp = (KParamPtr)__builtin_amdgcn_kernarg_segment_ptr(); asm volatile("" : "+s"(kp)); return *kp; }
#else
DI Params load_params() { return Params{}; }
#endif
#define p (load_params())
#define ws (load_params().ws)
#define ada ((const float*)(ws + OFF_ADA))
#define Hb ((bf16_t*)(ws + OFF_H))
#define bar ((unsigned*)(ws + OFF_BAR))
__global__ void __launch_bounds__(NTHREADS) yoco_fwd(Params p_arg) {
    extern __shared__ __attribute__((aligned(16))) unsigned char lds[];
    cg::grid_group grid = cg::this_grid();
    volatile LAS unsigned* bst = (volatile LAS unsigned*)(lds + 144 * 1024);
    const int wave_u = __builtin_amdgcn_readfirstlane((int)(threadIdx.x >> 6));
    { const int t0 = ftid(); if (t0 == 0) { bst[0] = 0u; bst[1] = 0u; }
      if (blockIdx.x == 0) for (int i = t0; i < XCD_BAR_WORDS; i += NTHREADS) bar[i] = 0u; }
    __syncthreads();
    RUN(0) REP(0) phase_prep(p, lds, ftid());
    grid.sync();
    if (ftid() == 0) (void)xb_add(&bar[XB_XCNT(xb_xcc_id())], 1u);
    RUN(1) REP(1) phase_norm(p.in[0], Hb, p.in[5], ada, 0, 1024, ftid());
    RUN(1) phase_wquant(ws, ftid());
    xcd_barrier(bar, bst, ftid());
    RUN(2) REP(2) {
        EpiQKV0 e{(bf16_t*)(ws + OFF_Q0), (bf16_t*)(ws + OFF_K0), (bf16_t*)(ws + OFF_VT0), p.in[10], p.in[11], (float*)(ws + OFF_MB0), p.in[2]};
        gemm_phase<2>(Hb, DM, NTOK, (const bf16_t*)(ws + OFF_WT_DIN), DM, 3072, DM, e, lds, ftid());
    }
    xcd_barrier(bar, bst, ftid());
    RUN(3) REP(3) phase_diff_attn(p, lds, ftid());
    xcd_barrier(bar, bst, ftid());
    RUN(4) REP(4) {
        EpiResid e{p.in[0], opq(p.out), ada + 2 * 1024};
        gemm_phase<2>(Hb, DM, NTOK, (const bf16_t*)(ws + OFF_WT_DOUT), DM, 1024, DM, e, lds, ftid());
    }
    xcd_barrier(bar, bst, ftid());
    if (STOP_AFTER <= 1) return;
    RUN(1) phase_norm_q8(opq(p.out), Hb, ws + OFF_H8, (float*)(ws + OFF_HS), p.in[6], ada, 3 * 1024, 4 * 1024, ftid());
    xcd_barrier(bar, bst, ftid());
    RUN(5) REP(5) {
        EpiPeer e{(int*)(ws + OFF_RIDX), (float*)(ws + OFF_RGATE), 128 * 1024};
        gemm_phase_i8<2>(ws + OFF_H8, NTOK, (const float*)(ws + OFF_HS), ws + OFF_W8_PEER, 2048, (const float*)(ws + OFF_W8S) + W8S_PEER, DM, e, lds, ftid());
    }
    xcd_barrier(bar, bst, ftid());
    if ((REPEAT_MASK >> 6) & 1) phase_peer_u<true>(p, 0, lds, ftid());
    RUN(6) phase_peer_u<false>(p, 0, lds, ftid());
    xcd_barrier(bar, bst, ftid());
    if ((REPEAT_MASK >> 10) & 1) phase_peer_v<true>(p, 0, ftid());
    RUN(6) phase_peer_v<false>(p, 0, ftid());
    xcd_barrier(bar, bst, ftid());
    RUN(1) phase_norm2(opq(p.out), (bf16_t*)(ws + OFF_H2), p.in[13], 12288, 12288 + 1024, Hb, p.in[5] + 1024, 6144, 6144 + 1024, ada, ftid());
    xcd_barrier(bar, bst, ftid());
    if (STOP_AFTER <= 2) return;
    RUN(7) REP(7) {
        EpiKV e{(bf16_t*)(ws + OFF_KC), (bf16_t*)(ws + OFF_KS), (bf16_t*)(ws + OFF_VST), (bf16_t*)(ws + OFF_KW), (bf16_t*)(ws + OFF_VWT), p.in[21]};
        gemm_phase<2>((const bf16_t*)(ws + OFF_H2), DM, NTOK, (const bf16_t*)(ws + OFF_WT_KV), DM, 1536, DM, e, lds, ftid());
    }
    xcd_barrier(bar, bst, ftid());
    RUN(8) REP(8) {
        EpiNsaQ e{(bf16_t*)(ws + OFF_QN), (float*)(ws + OFF_GATES), p.in[25], p.in[23], (float*)(ws + OFF_MB1)};
        gemm_phase<2>(Hb, DM, NTOK, (const bf16_t*)(ws + OFF_WT_NIN), DM, 1048, DM, e, lds, ftid());
        for (int t = blockIdx.x; t < 64; t += gridDim.x) {
            const int pr = t >> 2, tm = t & 3, kv = pr >> 3, bg = pr & 7;
            const bf16_t* Ap = (const bf16_t*)(ws + OFF_KC) + (long)(kv * 8 + bg) * SEQ * 128;
            bf16_t* hid = (bf16_t*)(ws + OFF_HID) + (long)pr * 512 * 256;
            EpiCmp1 e1{hid, (const float*)(ws + OFF_POSB) + kv * 16 * 256, p.in[19] + kv * 256};
            gemm_tile<1>(Ap, 2048, 511, (const bf16_t*)(ws + OFF_WT_C1) + (long)kv * 256 * 4096, 4096, 256, 4096, tm * 128, 0, e1, lds, ftid());
            __syncthreads();
            bf16_t* dst = kv == 0 ? (bf16_t*)(ws + OFF_KCMP) + (long)bg * 512 * 128 : (bf16_t*)(ws + OFF_VCMPT) + (long)bg * 128 * 512;
            EpiCmp2 e2{dst, p.in[21], kv};
            gemm_tile<1>(hid, 256, 512, (const bf16_t*)(ws + OFF_WT_C2) + (long)kv * 128 * 256, 256, 128, 256, tm * 128, 0, e2, lds, ftid());
        }
    }
    xcd_barrier(bar, bst, ftid());
#ifdef NSA_PROBE
    phase_nsa_attn<NSA_PROBE>(p, lds, ftid());
#endif
    RUN(9) REP(9) phase_nsa_attn<0>(p, lds, ftid());
    xcd_barrier(bar, bst, ftid());
    RUN(4) {
        float* xo = opq(p.out);
        EpiResid e{xo, xo, ada + 6144 + 2 * 1024};
        gemm_phase<2>(Hb, DM, NTOK, (const bf16_t*)(ws + OFF_WT_NOUT), DM, 1024, DM, e, lds, ftid());
    }
    xcd_barrier(bar, bst, ftid());
    if (STOP_AFTER <= 3) return;
    RUN(1) phase_norm_q8(opq(p.out), Hb, ws + OFF_H8, (float*)(ws + OFF_HS), p.in[6] + 1024, ada, 6144 + 3 * 1024, 6144 + 4 * 1024, ftid());
    xcd_barrier(bar, bst, ftid());
    RUN(5) REP(5) {
        EpiPeer e{(int*)(ws + OFF_RIDX), (float*)(ws + OFF_RGATE), 128 * 1024};
        gemm_phase_i8<2>(ws + OFF_H8, NTOK, (const float*)(ws + OFF_HS), ws + OFF_W8_PEER + (long)2048 * 1024, 2048, (const float*)(ws + OFF_W8S) + W8S_PEER + 2048, DM, e, lds, ftid());
    }
    xcd_barrier(bar, bst, ftid());
    if ((REPEAT_MASK >> 6) & 1) phase_peer_u<true>(p, 1, lds, ftid());
    RUN(6) phase_peer_u<false>(p, 1, lds, ftid());
    xcd_barrier(bar, bst, ftid());
    if ((REPEAT_MASK >> 10) & 1) phase_peer_v<true>(p, 1, ftid());
    RUN(6) phase_peer_v<false>(p, 1, ftid());
}
#undef p
#undef ws
#undef ada
#undef Hb
#undef bar

extern "C" void kernel_launch(void* const* d_in, const int* in_sizes, int n_in, void* d_out, int out_size, void* d_ws, size_t ws_size,
                              hipStream_t stream) {
    static int grid_blocks = 0;
    if (grid_blocks == 0) {
        if (n_in != 30 || out_size != NTOK * DM || ws_size < WS_END) {
            fprintf(stderr, "kernel_launch: unexpected shapes (n_in %d out %d ws %zu)\n", n_in, out_size, ws_size);
            grid_blocks = -1; return;
        }
        int dev = 0, cus = 0, per_cu = 0;
        hipGetDevice(&dev);
        hipDeviceGetAttribute(&cus, hipDeviceAttributeMultiprocessorCount, dev);
        hipFuncSetAttribute((const void*)yoco_fwd, hipFuncAttributeMaxDynamicSharedMemorySize, LDS_BYTES);
        hipOccupancyMaxActiveBlocksPerMultiprocessor(&per_cu, (const void*)yoco_fwd, NTHREADS, LDS_BYTES);
        if (per_cu < 1) { fprintf(stderr, "kernel_launch: occupancy query says %d blocks per CU\n", per_cu); grid_blocks = -1; return; }
        grid_blocks = cus;
    }
    if (grid_blocks < 0) return;
    Params p{};
    for (int i = 0; i < 30; ++i) p.in[i] = (const float*)d_in[i];
    p.out = (float*)d_out;
    p.ws = (unsigned char*)d_ws;
    void* args[] = {&p};
    hipError_t e = hipLaunchCooperativeKernel((const void*)yoco_fwd, dim3(grid_blocks), dim3(NTHREADS), args, LDS_BYTES, stream);
    if (e != hipSuccess) fprintf(stderr, "cooperative launch failed: %s (grid %d)\n", hipGetErrorString(e), grid_blocks);
}
```

```cpp
#include <hip/hip_runtime.h>
#include <hip/hip_cooperative_groups.h>
#include <cstdio>
#include <cstdint>
namespace cg = cooperative_groups;

#define DI __device__ __forceinline__
#ifndef STOP_AFTER
#define STOP_AFTER 99
#endif
#ifndef ONLY_PHASE
#define ONLY_PHASE -1
#endif
#define RUN(n) if (ONLY_PHASE < 0 || ONLY_PHASE == (n))
#ifndef REPEAT_MASK
#define REPEAT_MASK 0
#endif
#define REP(n) for (int rep_ = 0; rep_ < (((REPEAT_MASK) >> (n)) & 1) + 1; ++rep_)

typedef unsigned short bf16_t;
typedef short bf16x8 __attribute__((ext_vector_type(8)));
typedef float f32x16 __attribute__((ext_vector_type(16)));
typedef float f32x4 __attribute__((ext_vector_type(4)));
typedef float f32x2 __attribute__((ext_vector_type(2)));
typedef unsigned u32x4 __attribute__((ext_vector_type(4)));
typedef unsigned u32x2 __attribute__((ext_vector_type(2)));
typedef __bf16 bf16x2v __attribute__((ext_vector_type(2)));

#define MFMA32(a, b, c) __builtin_amdgcn_mfma_f32_32x32x16_bf16((a), (b), (c), 0, 0, 0)
typedef int i32x4 __attribute__((ext_vector_type(4)));
typedef int i32x16 __attribute__((ext_vector_type(16)));
#define MFMA32I8(a, b, c) __builtin_amdgcn_mfma_i32_32x32x32_i8((a), (b), (c), 0, 0, 0)

constexpr int NB = 4, SEQ = 8192, DM = 1024, NTOK = NB * SEQ;
constexpr int NTHREADS = 512, NWAVES = 8;
constexpr float EPS = 1e-6f;
constexpr float LOG2E = 1.4426950408889634f;
constexpr int ADA_STRIDE = 14336;

constexpr size_t MB = 1u << 20;
constexpr size_t OFF_ADA = 0;
constexpr size_t OFF_POSB = 256 * 1024;
constexpr size_t OFF_BAR = 320 * 1024;
constexpr size_t OFF_MB0 = 168 * MB;
constexpr size_t OFF_MB1 = 172 * MB;
constexpr size_t OFF_H8 = 104 * MB;
constexpr size_t OFF_HS = 174 * MB;
constexpr size_t OFF_W8 = 176 * MB;
constexpr size_t OFF_W8_DIN = OFF_W8, OFF_W8_KV = OFF_W8 + 3 * MB, OFF_W8_NIN = OFF_W8 + 5 * MB, OFF_W8_PEER = OFF_W8 + 7 * MB;
constexpr size_t OFF_W8S = 188 * MB;
constexpr int W8S_DIN = 0, W8S_KV = 3072, W8S_NIN = 4608, W8S_PEER = 5760, W8S_TOTAL = 9856;
constexpr size_t OFF_USI = 384 * 1024;
constexpr size_t OFF_VSI = 512 * 1024;
constexpr size_t OFF_WT_DIN = 1 * MB;
constexpr size_t OFF_WT_DOUT = 7 * MB;
constexpr size_t OFF_WT_KV = 9 * MB;
constexpr size_t OFF_WT_NIN = 12 * MB;
constexpr size_t OFF_WT_NOUT = 15 * MB;
constexpr size_t OFF_WT_PEER = 17 * MB;
constexpr size_t OFF_WT_C1 = 25 * MB;
constexpr size_t OFF_WT_C2 = 29 * MB;
constexpr size_t OFF_GATES = 30 * MB;
constexpr size_t OFF_KCMP = 34 * MB;
constexpr size_t OFF_VCMPT = 35 * MB;
constexpr size_t OFF_HID = 36 * MB;
constexpr size_t OFF_RIDX = 40 * MB;
constexpr size_t OFF_RGATE = 56 * MB;
constexpr size_t OFF_PU = 72 * MB;
constexpr size_t OFF_PV = 136 * MB;
constexpr size_t OFF_H = 200 * MB;
constexpr size_t OFF_R = 264 * MB;
constexpr size_t WS_END = 456 * MB;
constexpr size_t OFF_Q0 = OFF_R, OFF_K0 = OFF_R + 64 * MB, OFF_VT0 = OFF_R + 128 * MB;
constexpr size_t OFF_QN = OFF_R, OFF_H2 = OFF_R, OFF_KC = OFF_R + 64 * MB, OFF_KS = OFF_R + 96 * MB, OFF_VST = OFF_R + 112 * MB,
                 OFF_KW = OFF_R + 128 * MB, OFF_VWT = OFF_R + 144 * MB;

constexpr int LDS_BYTES = 144 * 1024 + 256;

struct Params {
    const float* in[30];
    float* out;
    unsigned char* ws;
};

template <class T> DI T* opq(T* q) { asm volatile("" : "+s"(q)); return (T*)(__attribute__((address_space(1))) T*)q; }
DI unsigned pk2(float lo, float hi) { f32x2 v = {lo, hi}; return __builtin_bit_cast(unsigned, __builtin_convertvector(v, bf16x2v)); }
DI bf16_t f2bf(float x) { return (bf16_t)(pk2(x, 0.f) & 0xffffu); }
DI float bflo(unsigned u) { return __uint_as_float(u << 16); }
DI float bfhi(unsigned u) { return __uint_as_float(u & 0xffff0000u); }
DI float fexp2(float x) { return __builtin_amdgcn_exp2f(x); }
DI float frcp(float x) { return __builtin_amdgcn_rcpf(x); }
DI int crow(int reg, int h) { return (reg & 3) + 8 * (reg >> 2) + 4 * h; }
template <int CTRL> DI float dpp_f(float v) { return __builtin_bit_cast(float, __builtin_amdgcn_update_dpp(0, __builtin_bit_cast(int, v), CTRL, 0xF, 0xF, true)); }
DI float lx1(float v) { return dpp_f<0xB1>(v); }
DI float lx2(float v) { return dpp_f<0x4E>(v); }
DI float lhm(float v) { return dpp_f<0x141>(v); }
DI float lr8(float v) { return dpp_f<0x128>(v); }
DI float sum_x16(float v) { auto s = __builtin_amdgcn_permlane16_swap(__float_as_uint(v), __float_as_uint(v), false, false); return __uint_as_float(s[0]) + __uint_as_float(s[1]); }
DI float sum_x32(float v) { auto s = __builtin_amdgcn_permlane32_swap(__float_as_uint(v), __float_as_uint(v), false, false); return __uint_as_float(s[0]) + __uint_as_float(s[1]); }
DI float max_x16(float v) { auto s = __builtin_amdgcn_permlane16_swap(__float_as_uint(v), __float_as_uint(v), false, false); return fmaxf(__uint_as_float(s[0]), __uint_as_float(s[1])); }
DI float max_x32(float v) { auto s = __builtin_amdgcn_permlane32_swap(__float_as_uint(v), __float_as_uint(v), false, false); return fmaxf(__uint_as_float(s[0]), __uint_as_float(s[1])); }
DI unsigned get_x32(unsigned v, int h) { auto s = __builtin_amdgcn_permlane32_swap(v, v, false, false); return h ? s[0] : s[1]; }
DI float wave_sum(float v) { v += lx1(v); v += lx2(v); v += lhm(v); v += lr8(v); v = sum_x16(v); return sum_x32(v); }
DI float wave_max(float v) { v = fmaxf(v, lx1(v)); v = fmaxf(v, lx2(v)); v = fmaxf(v, lhm(v)); v = fmaxf(v, lr8(v)); v = max_x16(v); return max_x32(v); }
DI int bperm(int v, int srclane) { return __builtin_amdgcn_ds_bpermute(srclane << 2, v); }
DI float bpermf(float v, int srclane) { return __builtin_bit_cast(float, __builtin_amdgcn_ds_bpermute(srclane << 2, __builtin_bit_cast(int, v))); }
DI float gelu_tanh(float x) {
    const float u = 0.7978845608028654f * (x + 0.044715f * x * x * x);
    return x * frcp(1.f + fexp2(-2.f * LOG2E * u));
}
DI float dot2bf(unsigned a, unsigned b, float c) {
    return __builtin_amdgcn_fdot2_f32_bf16(__builtin_bit_cast(bf16x2v, a), __builtin_bit_cast(bf16x2v, b), c, false);
}
DI int rel_bucket_i(int d) {
    if (d < 16) return d < 0 ? 0 : d;
    int b = 16;
    b += d >= 21; b += d >= 27; b += d >= 35; b += d >= 46; b += d >= 59; b += d >= 77; b += d >= 99; b += d >= 128;
    b += d >= 166; b += d >= 216; b += d >= 280; b += d >= 363; b += d >= 470; b += d >= 609; b += d >= 790;
    return b;
}
DI unsigned f2key(float f) { unsigned u = __float_as_uint(f); return u ^ ((unsigned)((int)u >> 31) | 0x80000000u); }
DI float key2f(unsigned k) { unsigned u = (k & 0x80000000u) ? (k ^ 0x80000000u) : ~k; return __uint_as_float(u); }

constexpr int EPI_LDS = 96 * 1024;

DI int sw2(int row, int chunk) { return (row >> 1) * 256 + (((((row & 1) << 3) | chunk) ^ ((row >> 1) & 15)) << 4); }
DI void sw2_src(int P, int& row, int& chunk) { const int R2 = P >> 4, lc = (P & 15) ^ (R2 & 15); row = 2 * R2 + (lc >> 3); chunk = lc & 7; }

template <class T, class = void> struct epi_stash { static constexpr bool value = false, present = false; };
template <class T> struct epi_stash<T, decltype((void)T::STASH)> { static constexpr bool value = T::STASH, present = true; };

template <int MT, class Epi>
DI void gemm_tile(const bf16_t* __restrict__ A, long lda, int M, const bf16_t* __restrict__ Bt, long ldb, int N, int K,
                  int m0, int n0, const Epi& epi, unsigned char* lds, int tid) {
    constexpr int XS = MT * 128 * 128, WS = 256 * 128, STAGE = XS + WS;
    const int lane = tid & 63, w = tid >> 6, tg = w & 3, fh = w >> 2, r = lane & 31, h = lane >> 5;
    const int wbase = tid & ~63;
    unsigned xo[2 * MT], wo[4];
#pragma unroll
    for (int i = 0; i < 2 * MT; ++i) { int row, c; sw2_src(tid + 512 * i, row, c); int m = m0 + row; m = m < M ? m : M - 1; xo[i] = (unsigned)m * (unsigned)(lda * 2) + c * 16; }
#pragma unroll
    for (int i = 0; i < 4; ++i) { int row, c; sw2_src(tid + 512 * i, row, c); int n = n0 + row; n = n < N ? n : N - 1; wo[i] = (unsigned)n * (unsigned)(ldb * 2) + c * 16; }
    const unsigned char* Ab = (const unsigned char*)A;
    const unsigned char* Bb = (const unsigned char*)Bt;
    auto stage = [&](int kt, unsigned char* st) {
#pragma unroll
        for (int i = 0; i < 2 * MT; ++i)
            __builtin_amdgcn_global_load_lds((const unsigned*)(Ab + kt * 128 + xo[i]), (unsigned*)(st + (wbase + 512 * i) * 16), 16, 0, 0);
#pragma unroll
        for (int i = 0; i < 4; ++i)
            __builtin_amdgcn_global_load_lds((const unsigned*)(Bb + kt * 128 + wo[i]), (unsigned*)(st + XS + (wbase + 512 * i) * 16), 16, 0, 0);
    };
    f32x16 acc[MT][4];
#pragma unroll
    for (int s2 = 0; s2 < MT; ++s2)
#pragma unroll
        for (int i = 0; i < 4; ++i)
#pragma unroll
            for (int j = 0; j < 16; ++j) acc[s2][i][j] = 0.f;
    const int nk = K >> 6;
    stage(0, lds);
    __syncthreads();
    for (int kt = 0; kt < nk; ++kt) {
        unsigned char* cur = lds + (kt & 1) * STAGE;
        if (kt + 1 < nk) stage(kt + 1, lds + ((kt + 1) & 1) * STAGE);
        bf16x8 xfa[MT], wfa[4], xfb[MT], wfb[4];
        auto ldf = [&](bf16x8 (&xf)[MT], bf16x8 (&wf)[4], int ks) {
#pragma unroll
            for (int s2 = 0; s2 < MT; ++s2) xf[s2] = *(const bf16x8*)(cur + sw2(32 * MT * tg + 32 * s2 + r, 2 * ks + h));
#pragma unroll
            for (int mt = 0; mt < 4; ++mt) wf[mt] = *(const bf16x8*)(cur + XS + sw2(128 * fh + 32 * mt + r, 2 * ks + h));
        };
        auto mm = [&](const bf16x8 (&xf)[MT], const bf16x8 (&wf)[4]) {
#pragma unroll
            for (int mt = 0; mt < 4; ++mt)
#pragma unroll
                for (int s2 = 0; s2 < MT; ++s2) acc[s2][mt] = MFMA32(wf[mt], xf[s2], acc[s2][mt]);
        };
        ldf(xfa, wfa, 0);
        ldf(xfb, wfb, 1); __builtin_amdgcn_sched_barrier(0); mm(xfa, wfa); __builtin_amdgcn_sched_barrier(0);
        ldf(xfa, wfa, 2); __builtin_amdgcn_sched_barrier(0); mm(xfb, wfb); __builtin_amdgcn_sched_barrier(0);
        ldf(xfb, wfb, 3); __builtin_amdgcn_sched_barrier(0); mm(xfa, wfa); __builtin_amdgcn_sched_barrier(0);
        mm(xfb, wfb);
        __syncthreads();
    }
    if constexpr (MT == 2 && epi_stash<Epi>::value) {
        float* sp = (float*)lds + w * 4096 + lane;
#pragma unroll
        for (int mt = 0; mt < 4; ++mt)
#pragma unroll
            for (int j = 0; j < 16; ++j) sp[(mt * 16 + j) * 64] = acc[1][mt][j];
        epi(acc[0], m0 + 64 * tg + r, n0 + 128 * fh, h, lds, tid);
        f32x16 a2[4];
        const float* sp2 = sp; asm volatile("" : "+v"(sp2));
#pragma unroll
        for (int mt = 0; mt < 4; ++mt)
#pragma unroll
            for (int j = 0; j < 16; ++j) a2[mt][j] = sp2[(mt * 16 + j) * 64];
        epi(a2, m0 + 64 * tg + 32 + r, n0 + 128 * fh, h, lds, tid);
        __syncthreads();
    } else {
        int ho = h, ro = r, to = tid;
        if constexpr (epi_stash<Epi>::present) asm volatile("" : "+v"(ho), "+v"(ro), "+v"(to));
#pragma unroll
        for (int s2 = 0; s2 < MT; ++s2) epi(acc[s2], m0 + 32 * MT * tg + 32 * s2 + ro, n0 + 128 * fh, ho, lds, to);
    }
}

DI void store_vt_tile(bf16_t* base, long rstride, const f32x16& a, int row0, int h, int lane) {
    const bool odd = lane & 1;
#pragma unroll
    for (int rg = 0; rg < 16; rg += 2) {
        const float xa = lx1(a[rg]), xb = lx1(a[rg + 1]);
        const unsigned wv = odd ? pk2(xb, a[rg + 1]) : pk2(a[rg], xa);
        bf16_t* dp = base + (long)(row0 + crow(odd ? rg + 1 : rg, h)) * rstride - (odd ? 1 : 0);
        *(unsigned*)dp = wv;
    }
}
struct EpiQKV0 {
    bf16_t *Q, *Kk, *VT;
    const float *qg, *kg;
    float* MB; const float* relb;
    DI void operator()(const f32x16 (&acc)[4], int tok, int fbase, int h, unsigned char*, int) const {
        const int sec = fbase >> 10, hd = (fbase & 1023) >> 7, b = tok >> 13, s = tok & (SEQ - 1);
        if (sec < 2) {
            const float* gn = sec == 0 ? qg : kg;
            const float sc = sec == 0 ? 0.125f * LOG2E : 1.f;
            bf16_t* dst = sec == 0 ? Q : Kk;
#pragma unroll
            for (int j = 0; j < 2; ++j) {
                float ss = 0.f;
#pragma unroll
                for (int mt = 0; mt < 2; ++mt)
#pragma unroll
                    for (int rg = 0; rg < 16; ++rg) { const float v = acc[2 * j + mt][rg]; ss += v * v; }
                ss = sum_x32(ss);
                const float rstd = rsqrtf(ss * (1.f / 64.f) + EPS) * sc;
                bf16_t* row = dst + ((long)((b * 8 + hd) * 2 + j) * SEQ + s) * 64;
                float qq = 0.f;
#pragma unroll
                for (int mt = 0; mt < 2; ++mt)
#pragma unroll
                    for (int g4 = 0; g4 < 4; ++g4) {
                        const int d0 = 32 * mt + 8 * g4 + 4 * h;
                        const f32x4 gv = *(const f32x4*)(gn + d0);
                        const float v0 = acc[2 * j + mt][4 * g4 + 0] * rstd * gv.x, v1 = acc[2 * j + mt][4 * g4 + 1] * rstd * gv.y;
                        const float v2 = acc[2 * j + mt][4 * g4 + 2] * rstd * gv.z, v3 = acc[2 * j + mt][4 * g4 + 3] * rstd * gv.w;
                        qq += v0 * v0 + v1 * v1 + v2 * v2 + v3 * v3;
                        u32x2 o;
                        o.x = pk2(v0, v1); o.y = pk2(v2, v3);
                        *(u32x2*)(row + d0) = o;
                    }
                if (sec == 0) {
                    qq = sum_x32(qq);
                    float kmx = 0.f;
                    for (int d = 0; d < 64; ++d) kmx = fmaxf(kmx, fabsf(kg[d]));
                    float bmx = 0.f;
                    for (int bk = 0; bk < 32; ++bk) bmx = fmaxf(bmx, relb[bk * 8 + hd] - relb[31 * 8 + hd]);
                    if (h == 0) MB[(long)((b * 8 + hd) * 2 + j) * SEQ + s] = 1.01f * sqrtf(qq) * 8.f * kmx + bmx * LOG2E;
                }
            }
        } else {
            bf16_t* base = VT + (long)(b * 8 + hd) * 128 * SEQ + s;
#pragma unroll
            for (int mt = 0; mt < 4; ++mt) store_vt_tile(base, SEQ, acc[mt], 32 * mt, h, tok);
        }
    }
};

struct EpiResid {
    const float* xin; float* xout; const float* gate;
    DI void operator()(const f32x16 (&acc)[4], int tok, int fbase, int h, unsigned char*, int) const {
        const int b = tok >> 13;
        const float* gp = gate + b * ADA_STRIDE;
#pragma unroll
        for (int mt = 0; mt < 4; ++mt)
#pragma unroll
            for (int g4 = 0; g4 < 4; ++g4) {
                const int f = fbase + 32 * mt + 8 * g4 + 4 * h;
                const f32x4 xv = *(const f32x4*)(xin + (long)tok * DM + f);
                const f32x4 gv = *(const f32x4*)(gp + f);
                f32x4 o;
                o.x = xv.x + gv.x * acc[mt][4 * g4 + 0]; o.y = xv.y + gv.y * acc[mt][4 * g4 + 1];
                o.z = xv.z + gv.z * acc[mt][4 * g4 + 2]; o.w = xv.w + gv.w * acc[mt][4 * g4 + 3];
                *(f32x4*)(xout + (long)tok * DM + f) = o;
                if (g4 == 3) __builtin_amdgcn_sched_barrier(0);
            }
    }
};

struct EpiKV {
    bf16_t *KC, *KS, *VST, *KW, *VWT;
    const float* kgain;
    DI void operator()(const f32x16 (&acc)[4], int tok, int fbase, int h, unsigned char*, int) const {
        const int c = fbase >> 7, br = c >> 2, kv = (c >> 1) & 1, g = c & 1, b = tok >> 13, s = tok & (SEQ - 1);
        if (br == 0 || kv == 0) {
            float rstd = 1.f;
            bf16_t* row;
            if (br == 0) row = KC + ((long)((kv * 4 + b) * 2 + g) * SEQ + s) * 128;
            else {
                float ss = 0.f;
#pragma unroll
                for (int mt = 0; mt < 4; ++mt)
#pragma unroll
                    for (int rg = 0; rg < 16; ++rg) ss += acc[mt][rg] * acc[mt][rg];
                ss = sum_x32(ss);
                rstd = rsqrtf(ss * (1.f / 128.f) + EPS);
                row = (br == 1 ? KS : KW) + ((long)(b * 2 + g) * SEQ + s) * 128;
            }
#pragma unroll
            for (int mt = 0; mt < 4; ++mt)
#pragma unroll
                for (int g4 = 0; g4 < 4; ++g4) {
                    const int d0 = 32 * mt + 8 * g4 + 4 * h;
                    f32x4 gv = {1.f, 1.f, 1.f, 1.f};
                    if (br != 0) gv = *(const f32x4*)(kgain + br * 128 + d0);
                    u32x2 o;
                    o.x = pk2(acc[mt][4 * g4 + 0] * rstd * gv.x, acc[mt][4 * g4 + 1] * rstd * gv.y);
                    o.y = pk2(acc[mt][4 * g4 + 2] * rstd * gv.z, acc[mt][4 * g4 + 3] * rstd * gv.w);
                    *(u32x2*)(row + d0) = o;
                }
        } else {
            bf16_t* base = (br == 1 ? VST : VWT) + (long)(b * 2 + g) * 128 * SEQ + s;
#pragma unroll
            for (int mt = 0; mt < 4; ++mt) store_vt_tile(base, SEQ, acc[mt], 32 * mt, h, tok);
        }
    }
};

struct EpiCmp1 {
    bf16_t* hid; const float* posb_part; const float* b1;
    DI void operator()(const f32x16 (&acc)[4], int tok, int fbase, int h, unsigned char*, int) const {
        if (tok >= 512) return;
#pragma unroll
        for (int mt = 0; mt < 4; ++mt)
#pragma unroll
            for (int g4 = 0; g4 < 4; ++g4) {
                const int f = fbase + 32 * mt + 8 * g4 + 4 * h;
                f32x4 pb = *(const f32x4*)(b1 + f);
                for (int c = 0; c < 16; ++c) { const f32x4 t = *(const f32x4*)(posb_part + c * 256 + f); pb.x += t.x; pb.y += t.y; pb.z += t.z; pb.w += t.w; }
                u32x2 o;
                o.x = pk2(gelu_tanh(acc[mt][4 * g4 + 0] + pb.x), gelu_tanh(acc[mt][4 * g4 + 1] + pb.y));
                o.y = pk2(gelu_tanh(acc[mt][4 * g4 + 2] + pb.z), gelu_tanh(acc[mt][4 * g4 + 3] + pb.w));
                *(u32x2*)(hid + (long)tok * 256 + f) = o;
            }
    }
};

struct EpiCmp2 {
    bf16_t* dst; const float* kgain0; int kv;
    DI void operator()(const f32x16 (&acc)[4], int tok, int fbase, int h, unsigned char*, int) const {
        if (fbase != 0 || tok >= 512) return;
        const float valid = tok < 511 ? 1.f : 0.f;
        if (kv == 0) {
            float ss = 0.f;
#pragma unroll
            for (int mt = 0; mt < 4; ++mt)
#pragma unroll
                for (int rg = 0; rg < 16; ++rg) ss += acc[mt][rg] * acc[mt][rg];
            ss = sum_x32(ss);
            const float rstd = rsqrtf(ss * (1.f / 128.f) + EPS) * valid;
#pragma unroll
            for (int mt = 0; mt < 4; ++mt)
#pragma unroll
                for (int g4 = 0; g4 < 4; ++g4) {
                    const int d0 = 32 * mt + 8 * g4 + 4 * h;
                    const f32x4 gv = *(const f32x4*)(kgain0 + d0);
                    u32x2 o;
                    o.x = pk2(acc[mt][4 * g4 + 0] * rstd * gv.x, acc[mt][4 * g4 + 1] * rstd * gv.y);
                    o.y = pk2(acc[mt][4 * g4 + 2] * rstd * gv.z, acc[mt][4 * g4 + 3] * rstd * gv.w);
                    *(u32x2*)(dst + (long)tok * 128 + d0) = o;
                }
        } else {
#pragma unroll
            for (int mt = 0; mt < 4; ++mt)
#pragma unroll
                for (int rg = 0; rg < 16; ++rg) dst[(long)(32 * mt + crow(rg, h)) * 512 + tok] = f2bf(acc[mt][rg] * valid);
        }
    }
};

struct EpiNsaQ {
    bf16_t* QN; float* gates; const float* qgain; const float* bgate; float* qnrm;
    DI void operator()(const f32x16 (&acc)[4], int tok, int fbase, int h, unsigned char*, int) const {
        const int b = tok >> 13, s = tok & (SEQ - 1);
        if (fbase < 1024) {
            const int head = fbase >> 7;
            float ss = 0.f;
#pragma unroll
            for (int mt = 0; mt < 4; ++mt)
#pragma unroll
                for (int rg = 0; rg < 16; ++rg) ss += acc[mt][rg] * acc[mt][rg];
            ss = sum_x32(ss);
            const float rstd = rsqrtf(ss * (1.f / 128.f) + EPS) * (0.08838834764831845f * LOG2E);
            bf16_t* row = QN + ((long)(b * 8 + head) * SEQ + s) * 128;
            float qq = 0.f;
#pragma unroll
            for (int mt = 0; mt < 4; ++mt)
#pragma unroll
                for (int g4 = 0; g4 < 4; ++g4) {
                    const int d0 = 32 * mt + 8 * g4 + 4 * h;
                    const f32x4 gv = *(const f32x4*)(qgain + d0);
                    const float v0 = acc[mt][4 * g4 + 0] * rstd * gv.x, v1 = acc[mt][4 * g4 + 1] * rstd * gv.y;
                    const float v2 = acc[mt][4 * g4 + 2] * rstd * gv.z, v3 = acc[mt][4 * g4 + 3] * rstd * gv.w;
                    qq += v0 * v0 + v1 * v1 + v2 * v2 + v3 * v3;
                    u32x2 o;
                    o.x = pk2(v0, v1); o.y = pk2(v2, v3);
                    *(u32x2*)(row + d0) = o;
                }
            qq = sum_x32(qq);
            if (h == 0) qnrm[(long)tok * 8 + head] = 1.01f * sqrtf(qq);
        } else if (fbase == 1024) {
#pragma unroll
            for (int rg = 0; rg < 16; ++rg) {
                const int f = crow(rg, h);
                if (f < 24) { const float z = acc[0][rg] + bgate[f]; gates[(long)tok * 24 + f] = frcp(1.f + fexp2(-LOG2E * z)); }
            }
        }
    }
};

DI void ce_desc(unsigned& a, unsigned& b) { const unsigned hi = a > b ? a : b, lo = a > b ? b : a; a = hi; b = lo; }
DI void sort16_desc(unsigned (&a)[16]) {
#pragma unroll
    for (int k = 2; k <= 16; k <<= 1)
#pragma unroll
        for (int j = k >> 1; j > 0; j >>= 1)
#pragma unroll
            for (int i = 0; i < 16; ++i) {
                const int l = i ^ j;
                if (l > i) { if ((i & k) == 0 || k == 16) ce_desc(a[i], a[l]); else ce_desc(a[l], a[i]); }
            }
}
DI void bitonic_merge16_desc(unsigned (&a)[16]) {
#pragma unroll
    for (int st = 8; st >= 1; st >>= 1)
#pragma unroll
        for (int i = 0; i < 16; ++i)
            if ((i & st) == 0) ce_desc(a[i], a[i + st]);
}
DI void merge_top16(unsigned (&a)[16], const unsigned (&b)[16]) {
#pragma unroll
    for (int i = 0; i < 16; ++i) a[i] = a[i] > b[15 - i] ? a[i] : b[15 - i];
    bitonic_merge16_desc(a);
}

struct EpiPeer {
    static constexpr bool STASH = false;
    int* ridx; float* rgate; int ex_off;
    DI void operator()(const f32x16 (&acc)[4], int tok, int fbase, int h, unsigned char* lds, int tid) const {
        const int lane = tid & 63, w = tid >> 6, tg = w & 3, fh = w >> 2, r = lane & 31;
        const int hd = fbase >> 8;
        unsigned* EX = (unsigned*)(lds + ex_off);
        unsigned L[16];
        {
            unsigned G1[16], G2[16], G3[16];
#pragma unroll
            for (int rg = 0; rg < 16; ++rg) {
                const int c = crow(rg, h);
                L[rg] = (f2key(acc[0][rg]) & ~127u) | (unsigned)(127 - c);
                G1[rg] = (f2key(acc[1][rg]) & ~127u) | (unsigned)(127 - 32 - c);
                G2[rg] = (f2key(acc[2][rg]) & ~127u) | (unsigned)(127 - 64 - c);
                G3[rg] = (f2key(acc[3][rg]) & ~127u) | (unsigned)(127 - 96 - c);
            }
            sort16_desc(L); sort16_desc(G1); merge_top16(L, G1);
            sort16_desc(G2); sort16_desc(G3); merge_top16(G2, G3);
            merge_top16(L, G2);
        }
        {
            unsigned P[16];
#pragma unroll
            for (int i = 0; i < 16; ++i) P[i] = get_x32(L[i], h);
            merge_top16(L, P);
        }
        if (h == 0) {
#pragma unroll
            for (int i = 0; i < 16; i += 4) *(u32x4*)(EX + ((fh * 4 + tg) * 32 + r) * 16 + i) = (u32x4){L[i], L[i + 1], L[i + 2], L[i + 3]};
        }
        __syncthreads();
        float xf[4], ys[16];
        {
            const unsigned* l0 = EX + ((0 * 4 + tg) * 32 + r) * 16;
            const unsigned* l1 = EX + ((1 * 4 + tg) * 32 + r) * 16;
            const unsigned* px = h ? l1 : l0;
            const unsigned* py = h ? l0 : l1;
            const u32x4 a = *(const u32x4*)px;
            xf[0] = key2f(a.x & ~127u); xf[1] = key2f(a.y & ~127u); xf[2] = key2f(a.z & ~127u); xf[3] = key2f(a.w & ~127u);
            unsigned Y[16];
#pragma unroll
            for (int i = 0; i < 16; i += 4) { const u32x4 b2 = *(const u32x4*)(py + i); Y[i] = b2.x; Y[i + 1] = b2.y; Y[i + 2] = b2.z; Y[i + 3] = b2.w; }
#pragma unroll
            for (int k = 0; k < 15; ++k) ys[k] = key2f((h ? Y[k + 1] : Y[k]) & ~127u);
            ys[15] = key2f(Y[15] & ~127u);
        }
        auto pkey = [&](int i, int k) -> unsigned {
            const float fs = xf[i] + ys[k];
            const unsigned code = h ? (unsigned)((((k + 1) & 15) << 4) | i) : (unsigned)((i << 4) | k);
            return (f2key(fs) & ~255u) | (255u - code);
        };
        unsigned T[16], E[16];
#pragma unroll
        for (int k = 0; k < 16; ++k) T[k] = pkey(0, k);
        T[15] = h ? 0u : T[15];
#pragma unroll
        for (int k = 1; k <= 7; ++k) E[k - 1] = pkey(1, k);
#pragma unroll
        for (int k = 2; k <= 4; ++k) E[7 + k - 2] = pkey(2, k);
        E[10] = pkey(3, 3);
#pragma unroll
        for (int k = 11; k < 16; ++k) E[k] = 0u;
        sort16_desc(E);
        merge_top16(T, E);
        {
            unsigned P[16];
#pragma unroll
            for (int i = 0; i < 16; ++i) P[i] = get_x32(T[i], h);
            merge_top16(T, P);
        }
        float sc[16], sum = 0.f;
        const float mx = key2f(T[0] & ~255u);
#pragma unroll
        for (int k = 0; k < 16; ++k) { sc[k] = fexp2((key2f(T[k] & ~255u) - mx) * LOG2E); sum += sc[k]; }
        const float inv = frcp(sum);
        if (h == 0) {
            const unsigned* l0 = EX + ((0 * 4 + tg) * 32 + r) * 16;
            const unsigned* l1 = EX + ((1 * 4 + tg) * 32 + r) * 16;
#pragma unroll
            for (int k = 0; k < 16; ++k) {
                if ((k >> 3) != fh) continue;
                const unsigned code = 255u - (T[k] & 255u);
                const int i1 = 127 - (int)(l0[code >> 4] & 127u), i2 = 127 - (int)(l1[code & 15u] & 127u);
                ridx[(long)tok * 128 + hd * 16 + k] = i1 * 128 + i2;
                rgate[(long)tok * 128 + hd * 16 + k] = sc[k] * inv;
            }
        }
        __syncthreads();
    }
};

DI void p0_transpose_item(const float* __restrict__ W, int K, int N, bf16_t* __restrict__ WT, int item, int ntn, unsigned char* lds, int tid) {
    float* tile = (float*)lds;
    const int kb = item / ntn, nb = item % ntn, k0 = kb * 64, n0 = nb * 64;
    {
        const int nn = tid & 63, kk0 = tid >> 6;
#pragma unroll
        for (int i = 0; i < 8; ++i) { const int kk = kk0 + 8 * i; const int n = n0 + nn; tile[kk * 65 + nn] = n < N ? W[(long)(k0 + kk) * N + n] : 0.f; }
    }
    __syncthreads();
    {
        const int n = tid >> 3, c = tid & 7;
        const float* s = tile + (8 * c) * 65 + n;
        u32x4 o;
        o.x = pk2(s[0], s[65]); o.y = pk2(s[2 * 65], s[3 * 65]); o.z = pk2(s[4 * 65], s[5 * 65]); o.w = pk2(s[6 * 65], s[7 * 65]);
        *(u32x4*)(WT + (long)(n0 + n) * K + k0 + 8 * c) = o;
    }
    __syncthreads();
}

DI int pack_i8x4(float a, float b, float c, float d) {
    const int ia = __float2int_rn(a), ib = __float2int_rn(b), ic = __float2int_rn(c), id = __float2int_rn(d);
    return (ia & 255) | ((ib & 255) << 8) | ((ic & 255) << 16) | (id << 24);
}
DI void p0_fp8_item(const float* __restrict__ src, unsigned char* __restrict__ dst, float* __restrict__ sinv, bool sliced, int item, int tid) {
    const int lane = tid & 63, row = item * 8 + (tid >> 6);
    const float* rp = src + (long)row * 1024;
    f32x4 v[4]; float am = 0.f;
#pragma unroll
    for (int j = 0; j < 4; ++j) {
        v[j] = *(const f32x4*)(rp + 4 * lane + 256 * j);
        am = fmaxf(am, fmaxf(fmaxf(fabsf(v[j].x), fabsf(v[j].y)), fmaxf(fabsf(v[j].z), fabsf(v[j].w))));
    }
    am = wave_max(am);
    const float sc = sliced ? (am > 0.f ? exp2f(floorf(log2f(384.f / am))) : 1.f) : (am > 0.f ? 127.f / am : 1.f);
    if (lane == 0) sinv[row] = 1.f / sc;
#pragma unroll
    for (int j = 0; j < 4; ++j) {
        int pk = 0;
        if (sliced) {
            pk = __builtin_amdgcn_cvt_pk_fp8_f32(v[j].x * sc, v[j].y * sc, pk, false);
            pk = __builtin_amdgcn_cvt_pk_fp8_f32(v[j].z * sc, v[j].w * sc, pk, true);
        } else pk = pack_i8x4(v[j].x * sc, v[j].y * sc, v[j].z * sc, v[j].w * sc);
        const int col = 4 * lane + 256 * j;
        unsigned char* d = sliced ? dst + ((long)(col >> 7) * 16384 + row) * 128 + (col & 127) : dst + (long)row * 1024 + col;
        *(int*)d = pk;
    }
}

DI void p0_weff_item(const float* __restrict__ wq, const float* __restrict__ subk, bf16_t* __restrict__ WT, int item, unsigned char* lds, int tid) {
    const int layer = item >> 8, g = (item >> 4) & 15, ct = item & 15, p = g & 1, c0 = ct * 64;
    float* As = (float*)lds;
    float* Bs = As + 64 * 129;
    const float* wql = wq + (long)layer * 1024 * 2048;
    const float* sk = subk + ((long)layer * 2 + p) * 128 * 128;
    for (int e = tid; e < 64 * 128; e += NTHREADS) { const int c = e >> 7, d = e & 127; As[c * 129 + d] = wql[(long)(c0 + c) * 2048 + g * 128 + d]; }
    for (int e = tid; e < 128 * 128; e += NTHREADS) { const int k = e >> 7, d = e & 127; Bs[k * 129 + d] = sk[k * 128 + d]; }
    __syncthreads();
    const int k = tid & 127, cg4 = tid >> 7;
    float acc[16];
#pragma unroll
    for (int i = 0; i < 16; ++i) acc[i] = 0.f;
    for (int d = 0; d < 128; ++d) {
        const float bv = Bs[k * 129 + d];
#pragma unroll
        for (int i = 0; i < 16; ++i) acc[i] += As[(cg4 * 16 + i) * 129 + d] * bv;
    }
    bf16_t* o = WT + ((long)layer * 2048 + g * 128 + k) * 1024 + c0 + cg4 * 16;
    u32x4 o0, o1;
    o0.x = pk2(acc[0], acc[1]); o0.y = pk2(acc[2], acc[3]); o0.z = pk2(acc[4], acc[5]); o0.w = pk2(acc[6], acc[7]);
    o1.x = pk2(acc[8], acc[9]); o1.y = pk2(acc[10], acc[11]); o1.z = pk2(acc[12], acc[13]); o1.w = pk2(acc[14], acc[15]);
    *(u32x4*)o = o0; *(u32x4*)(o + 8) = o1;
    __syncthreads();
}

DI void p0_posb_item(const float* __restrict__ pos, const float* __restrict__ w1, float* __restrict__ part, int item, unsigned char* lds, int tid) {
    const int kv = item >> 4, ch = item & 15;
    float* red = (float*)lds;
    const int j = tid & 255, half = tid >> 8;
    const float* pp = pos + (long)kv * 4096 + ch * 256 + half * 128;
    const float* ww = w1 + ((long)kv * 4096 + ch * 256 + half * 128) * 256 + j;
    float a = 0.f;
    for (int f = 0; f < 128; ++f) a += pp[f] * ww[(long)f * 256];
    red[half * 256 + j] = a;
    __syncthreads();
    if (tid < 256) part[(kv * 16 + ch) * 256 + tid] = red[tid] + red[256 + tid];
    __syncthreads();
}

DI void p0_ada_item(const Params& p, float* __restrict__ ada, int item, unsigned char* lds, int tid) {
    float* cact = (float*)lds;
    float* red = cact + 4096;
    const float* c = p.in[1];
    for (int e = tid; e < 4096; e += NTHREADS) { const float v = c[e]; cact[e] = v * frcp(1.f + fexp2(-LOG2E * v)); }
    __syncthreads();
    const int colg = item * 64;
    const float* W; const float* bias; int N, n0;
    if (colg < 6144) { W = p.in[3]; bias = p.in[4]; N = 6144; n0 = colg; }
    else if (colg < 12288) { W = p.in[3] + (long)1024 * 6144; bias = p.in[4] + 6144; N = 6144; n0 = colg - 6144; }
    else { W = p.in[14]; bias = p.in[15]; N = 2048; n0 = colg - 12288; }
    const int col = tid & 63, kg = tid >> 6;
    float a0 = 0.f, a1 = 0.f, a2 = 0.f, a3 = 0.f;
    const float* wp = W + (long)(kg * 128) * N + n0 + col;
#pragma unroll 8
    for (int k = 0; k < 128; ++k) {
        const float wv = wp[(long)k * N];
        const int kk = kg * 128 + k;
        a0 += cact[kk] * wv; a1 += cact[1024 + kk] * wv; a2 += cact[2048 + kk] * wv; a3 += cact[3072 + kk] * wv;
    }
    red[(kg * 4 + 0) * 64 + col] = a0; red[(kg * 4 + 1) * 64 + col] = a1; red[(kg * 4 + 2) * 64 + col] = a2; red[(kg * 4 + 3) * 64 + col] = a3;
    __syncthreads();
    if (tid < 256) {
        const int b = tid >> 6, cc = tid & 63;
        float s = bias[n0 + cc];
#pragma unroll
        for (int q = 0; q < 8; ++q) s += red[(q * 4 + b) * 64 + cc];
        ada[b * ADA_STRIDE + colg + cc] = s;
    }
    __syncthreads();
}

constexpr int P0_CONV = 8192, P0_TR_DIN = 768, P0_TR_DOUT = 256, P0_TR_KV = 384, P0_TR_NIN = 288, P0_TR_NOUT = 256, P0_TR_C1 = 512, P0_TR_C2 = 16,
              P0_WEFF = 512, P0_POSB = 32, P0_ADA = 224;
constexpr int P0_TOTAL = P0_CONV + P0_TR_DIN + P0_TR_DOUT + P0_TR_KV + P0_TR_NIN + P0_TR_NOUT + P0_TR_C1 + P0_TR_C2 + P0_WEFF + P0_POSB + P0_ADA;

DI void phase_prep(const Params& p, unsigned char* lds, int tid) {
    unsigned char* ws = p.ws;
    for (int it = blockIdx.x; it < P0_TOTAL; it += gridDim.x) {
        int r = it;
        if (r < P0_ADA) { p0_ada_item(p, (float*)(ws + OFF_ADA), r, lds, tid); continue; } r -= P0_ADA;
        if (r < P0_WEFF) { p0_weff_item(p.in[26], p.in[27], (bf16_t*)(ws + OFF_WT_PEER), r, lds, tid); continue; } r -= P0_WEFF;
        if (r < P0_POSB) { p0_posb_item(p.in[17], p.in[18], (float*)(ws + OFF_POSB), r, lds, tid); continue; } r -= P0_POSB;
        if (r < P0_TR_DIN) { p0_transpose_item(p.in[7], 1024, 3072, (bf16_t*)(ws + OFF_WT_DIN), r, 48, lds, tid); continue; } r -= P0_TR_DIN;
        if (r < P0_TR_DOUT) { p0_transpose_item(p.in[8], 1024, 1024, (bf16_t*)(ws + OFF_WT_DOUT), r, 16, lds, tid); continue; } r -= P0_TR_DOUT;
        if (r < P0_TR_KV) { p0_transpose_item(p.in[16], 1024, 1536, (bf16_t*)(ws + OFF_WT_KV), r, 24, lds, tid); continue; } r -= P0_TR_KV;
        if (r < P0_TR_NIN) { p0_transpose_item(p.in[22], 1024, 1048, (bf16_t*)(ws + OFF_WT_NIN), r, 18, lds, tid); continue; } r -= P0_TR_NIN;
        if (r < P0_TR_NOUT) { p0_transpose_item(p.in[24], 1024, 1024, (bf16_t*)(ws + OFF_WT_NOUT), r, 16, lds, tid); continue; } r -= P0_TR_NOUT;
        if (r < P0_TR_C1) { const int kv = r >> 8; p0_transpose_item(p.in[18] + (long)kv * 4096 * 256, 4096, 256, (bf16_t*)(ws + OFF_WT_C1) + (long)kv * 256 * 4096, r & 255, 4, lds, tid); continue; } r -= P0_TR_C1;
        if (r < P0_TR_C2) { const int kv = r >> 3; p0_transpose_item(p.in[20] + (long)kv * 256 * 128, 256, 128, (bf16_t*)(ws + OFF_WT_C2) + (long)kv * 128 * 256, r & 7, 2, lds, tid); continue; } r -= P0_TR_C2;
        {
            const int tbl = r >> 11, sub = r & 2047;
            const int layer = tbl & 1;
            const float* src = (tbl < 2 ? p.in[28] : p.in[29]) + (long)layer * 16384 * 1024;
            unsigned char* dst = ws + (tbl < 2 ? OFF_PU : OFF_PV) + (long)layer * 16384 * 1024;
            float* sinv = (float*)(ws + (tbl < 2 ? OFF_USI : OFF_VSI)) + layer * 16384;
            p0_fp8_item(src, dst, sinv, tbl >= 2, sub, tid);
        }
    }
}

DI void norm_row_write(const f32x4 (&v)[4], float rstd, const float* gain, const float* shift, const float* scale, bf16_t* orow, int lane) {
#pragma unroll
    for (int j = 0; j < 4; ++j) {
        const int c = 4 * lane + 256 * j;
        const f32x4 g = *(const f32x4*)(gain + c), sh = *(const f32x4*)(shift + c), sc = *(const f32x4*)(scale + c);
        u32x2 o;
        o.x = pk2(v[j].x * rstd * g.x * (1.f + sc.x) + sh.x, v[j].y * rstd * g.y * (1.f + sc.y) + sh.y);
        o.y = pk2(v[j].z * rstd * g.z * (1.f + sc.z) + sh.z, v[j].w * rstd * g.w * (1.f + sc.w) + sh.w);
        *(u32x2*)(orow + c) = o;
    }
}
DI void phase_norm_q8(const float* __restrict__ x, bf16_t* __restrict__ out, unsigned char* __restrict__ out8, float* __restrict__ outs,
                      const float* gain, const float* ada, int shift_off, int scale_off, int tid) {
    const int lane = tid & 63, gw = blockIdx.x * NWAVES + (tid >> 6), nw = gridDim.x * NWAVES;
    for (int tok = gw; tok < NTOK; tok += nw) {
        const int b = tok >> 13;
        f32x4 v[4]; float ss = 0.f;
#pragma unroll
        for (int j = 0; j < 4; ++j) { v[j] = *(const f32x4*)(x + (long)tok * DM + 4 * lane + 256 * j); ss += v[j].x * v[j].x + v[j].y * v[j].y + v[j].z * v[j].z + v[j].w * v[j].w; }
        const float rstd = rsqrtf(wave_sum(ss) * (1.f / DM) + EPS);
        const float* shift = ada + b * ADA_STRIDE + shift_off; const float* scale = ada + b * ADA_STRIDE + scale_off;
        float am = 0.f;
#pragma unroll
        for (int j = 0; j < 4; ++j) {
            const int c = 4 * lane + 256 * j;
            const f32x4 g = *(const f32x4*)(gain + c), sh = *(const f32x4*)(shift + c), sc = *(const f32x4*)(scale + c);
            v[j].x = v[j].x * rstd * g.x * (1.f + sc.x) + sh.x; v[j].y = v[j].y * rstd * g.y * (1.f + sc.y) + sh.y;
            v[j].z = v[j].z * rstd * g.z * (1.f + sc.z) + sh.z; v[j].w = v[j].w * rstd * g.w * (1.f + sc.w) + sh.w;
            u32x2 o; o.x = pk2(v[j].x, v[j].y); o.y = pk2(v[j].z, v[j].w);
            *(u32x2*)(out + (long)tok * DM + c) = o;
            am = fmaxf(am, fmaxf(fmaxf(fabsf(v[j].x), fabsf(v[j].y)), fmaxf(fabsf(v[j].z), fabsf(v[j].w))));
        }
        am = wave_max(am);
        const float qs = am > 0.f ? 127.f / am : 1.f;
#pragma unroll
        for (int j = 0; j < 4; ++j) *(int*)(out8 + (long)tok * DM + 4 * lane + 256 * j) = pack_i8x4(v[j].x * qs, v[j].y * qs, v[j].z * qs, v[j].w * qs);
        if (lane == 0) outs[tok] = am > 0.f ? am * (1.f / 127.f) : 1.f;
    }
}
DI void phase_norm(const float* __restrict__ x, bf16_t* __restrict__ out, const float* gain, const float* ada, int shift_off, int scale_off, int tid) {
    const int lane = tid & 63, gw = blockIdx.x * NWAVES + (tid >> 6), nw = gridDim.x * NWAVES;
    for (int tok = gw; tok < NTOK; tok += nw) {
        const int b = tok >> 13;
        f32x4 v[4]; float ss = 0.f;
#pragma unroll
        for (int j = 0; j < 4; ++j) { v[j] = *(const f32x4*)(x + (long)tok * DM + 4 * lane + 256 * j); ss += v[j].x * v[j].x + v[j].y * v[j].y + v[j].z * v[j].z + v[j].w * v[j].w; }
        const float rstd = rsqrtf(wave_sum(ss) * (1.f / DM) + EPS);
        norm_row_write(v, rstd, gain, ada + b * ADA_STRIDE + shift_off, ada + b * ADA_STRIDE + scale_off, out + (long)tok * DM, lane);
    }
}

DI int kidx(int mt, int i) { return 32 * mt + 16 * (i >> 3) + (i & 7); }
template <int DQK>
DI void attn_qk32(const unsigned char* Ks, const bf16x8 (&qf)[DQK / 16], f32x16& st, int mt, int r, int h, float init = 0.f) {
    constexpr int RB = DQK * 2, MSK = DQK == 64 ? 7 : 15;
    const int row = 32 * mt + ((r & 0x13) | ((r & 4) << 1) | ((r & 8) >> 1));
#pragma unroll
    for (int i = 0; i < 16; ++i) st[i] = init;
#pragma unroll
    for (int ks = 0; ks < DQK / 16; ++ks) {
        const bf16x8 kf = RB == 128 ? *(const bf16x8*)(Ks + sw2(row, 2 * ks + h)) : *(const bf16x8*)(Ks + row * RB + (((2 * ks + h) ^ (row & MSK)) << 4));
        st = MFMA32(kf, qf[ks], st);
    }
}
DI void attn_pack32(const f32x16& st, bf16x8 (&pf)[2]) {
#pragma unroll
    for (int s = 0; s < 2; ++s) {
        u32x4 t;
        t.x = pk2(st[8 * s + 0], st[8 * s + 1]); t.y = pk2(st[8 * s + 2], st[8 * s + 3]);
        t.z = pk2(st[8 * s + 4], st[8 * s + 5]); t.w = pk2(st[8 * s + 6], st[8 * s + 7]);
        pf[s] = __builtin_bit_cast(bf16x8, t);
    }
}
DI void attn_softmax32(f32x16& st, float& m, float& l, f32x16 (&o)[4]) {
    float mx = st[0];
#pragma unroll
    for (int i = 1; i < 16; ++i) mx = fmaxf(mx, st[i]);
    mx = max_x32(mx);
    const float mn = fmaxf(m, mx);
    if (!__all(mn == m)) {
        const float alpha = fexp2(m - mn);
        l *= alpha;
#pragma unroll
        for (int dt = 0; dt < 4; ++dt)
#pragma unroll
            for (int i = 0; i < 16; ++i) o[dt][i] *= alpha;
        m = mn;
    }
    float sum = 0.f;
#pragma unroll
    for (int i = 0; i < 16; ++i) { const float pv = fexp2(st[i] - m); st[i] = pv; sum += pv; }
    l += sum;
}
DI void attn_softmax32_b(f32x16& st, float& l) {
    float sum = 0.f;
#pragma unroll
    for (int i = 0; i < 16; ++i) { const float pv = fexp2(st[i]); st[i] = pv; sum += pv; }
    l += sum;
}
DI void attn_pv32(const unsigned char* Vs, const bf16x8 (&pf)[2], f32x16 (&o)[4], int mt, int r, int h) {
#pragma unroll
    for (int dt = 0; dt < 4; ++dt)
#pragma unroll
        for (int s2 = 0; s2 < 2; ++s2) {
            const int row = 32 * dt + r;
            const bf16x8 vf = *(const bf16x8*)(Vs + sw2(row, 2 * (2 * mt + s2) + h));
            o[dt] = MFMA32(vf, pf[s2], o[dt]);
        }
}
template <int RB, int NROWS>
DI void dma_offsets(unsigned (&off)[NROWS * RB / 16 / 512], unsigned gstride, int tid) {
    constexpr int CPR = RB / 16;
#pragma unroll
    for (int i = 0; i < NROWS * CPR / 512; ++i) {
        const int idx = tid + 512 * i;
        int row, cp;
        if (RB == 128) sw2_src(idx, row, cp); else { row = idx / CPR; cp = (idx % CPR) ^ (row & (CPR - 1)); }
        off[i] = (unsigned)row * gstride + (cp << 4);
    }
}
template <int N>
DI void dma_issue(unsigned char* dst, const unsigned char* gbase, const unsigned (&off)[N], int tid) {
    const int wbase = tid & ~63;
#pragma unroll
    for (int i = 0; i < N; ++i)
        __builtin_amdgcn_global_load_lds((const unsigned*)(gbase + off[i]), (unsigned*)(dst + (wbase + 512 * i) * 16), 16, 0, 0);
}

constexpr int AT_STAGE = 32 * 1024;
constexpr int AT_LUT = 2 * AT_STAGE;
constexpr int LUT_N = 1280, LUT_OFF = 1100;
constexpr int LUTC_W = 52;
constexpr int AT_LUTC = AT_LUT + 20 * 1024;
constexpr int AT_IMP = AT_LUTC + 13 * 1024;
constexpr int AT_SEL = AT_IMP + 34 * 1024;

DI void phase_diff_attn(const Params& p, unsigned char* lds, int tid) {
    unsigned char* ws = p.ws;
    const bf16_t* Q = (const bf16_t*)(ws + OFF_Q0);
    const bf16_t* Kk = (const bf16_t*)(ws + OFF_K0);
    const bf16_t* VT = (const bf16_t*)(ws + OFF_VT0);
    bf16_t* O = (bf16_t*)(ws + OFF_H);
    const float* relb = p.in[2];
    const float* lam = p.in[9];
    const float* subln = p.in[12];
    const int lane = tid & 63, w = tid >> 6, comp = w & 1, qg = w >> 1, r = lane & 31, h = lane >> 5;
    float* lut = (float*)(lds + 128 * 1024);
    float lam_full;
    {
        float s01 = 0.f, s23 = 0.f;
        for (int i = 0; i < 64; ++i) { s01 += lam[i] * lam[64 + i]; s23 += lam[128 + i] * lam[192 + i]; }
        lam_full = __expf(s01) - __expf(s23) + 0.2f;
    }
    const int G = gridDim.x, rows_per_it = G >> 5;
    unsigned koff[1], voff[2];
    dma_offsets<128, 64>(koff, 128, tid);
    dma_offsets<128, 128>(voff, SEQ * 2, tid);
    constexpr int ST2 = 64 * 1024;
    for (int it = 0;; ++it) {
        int qb, b, hd;
        if (G == 256) {
            if (it >= 8) break;
            const int xcd = blockIdx.x & 7, lb = blockIdx.x >> 3, pr = xcd * 4 + (it >> 1);
            qb = (it & 1) ? lb : 63 - lb; b = pr >> 3; hd = pr & 7;
        } else {
            int u;
            if ((G & 31) == 0) {
                const int rr = blockIdx.x >> 5, cc = blockIdx.x & 31;
                const int rowi = it * rows_per_it + ((it & 1) ? rows_per_it - 1 - rr : rr);
                u = rowi * 32 + cc;
            } else u = it * G + blockIdx.x;
            if (u >= 2048) break;
            qb = 63 - (u >> 5); b = (u & 31) >> 3; hd = u & 7;
        }
        const int q0 = qb * 128, ntiles = qb + 1;
        const int qpos = q0 + 32 * qg + r, qlo = q0 + 32 * qg, qhi = qlo + 31;
        for (int e = tid; e < LUT_N; e += NTHREADS) { const int d = LUT_OFF - e; lut[e] = d < 0 ? -INFINITY : (d >= 790 ? 0.f : (relb[rel_bucket_i(d) * 8 + hd] - relb[31 * 8 + hd]) * LOG2E); }
        bf16x8 qf[4];
        {
            const bf16_t* qrow = Q + ((long)((b * 8 + hd) * 2 + comp) * SEQ + qpos) * 64;
#pragma unroll
            for (int ks = 0; ks < 4; ++ks) qf[ks] = *(const bf16x8*)(qrow + 16 * ks + 8 * h);
        }
        const unsigned char* k0g = (const unsigned char*)(Kk + (long)((b * 8 + hd) * 2 + 0) * SEQ * 64);
        const unsigned char* k1g = (const unsigned char*)(Kk + (long)((b * 8 + hd) * 2 + 1) * SEQ * 64);
        const unsigned char* vtg = (const unsigned char*)(VT + (long)(b * 8 + hd) * 128 * SEQ);
        f32x16 o[4];
#pragma unroll
        for (int dt = 0; dt < 4; ++dt)
#pragma unroll
            for (int i = 0; i < 16; ++i) o[dt][i] = 0.f;
        float l = 0.f;
        const float nmb = -((const float*)(ws + OFF_MB0))[(long)((b * 8 + hd) * 2 + comp) * SEQ + qpos];
        auto stage = [&](int kt, unsigned char* st) {
#pragma unroll
            for (int sb = 0; sb < 2; ++sb) {
                dma_issue(st + sb * 8192, k0g + (long)(2 * kt + sb) * 8192, koff, tid);
                dma_issue(st + 16384 + sb * 8192, k1g + (long)(2 * kt + sb) * 8192, koff, tid);
                dma_issue(st + 32768 + sb * 16384, vtg + (long)(2 * kt + sb) * 128, voff, tid);
            }
        };
        stage(0, lds);
        __syncthreads();
        for (int kt = 0; kt < ntiles; ++kt) {
            unsigned char* cur = lds + (kt & 1) * ST2;
            if (kt + 1 < ntiles) stage(kt + 1, lds + ((kt + 1) & 1) * ST2);
            const bool nearb = qlo - (kt * 128 + 127) < 790;
            const int dbase0 = qpos - kt * 128 - 8 * h;
            const unsigned char* kb = cur + comp * 16384;
            f32x16 sa, sbv;
            attn_qk32<64>(kb, qf, sa, 0, r, h, nmb);
#pragma unroll
            for (int j = 0; j < 4; ++j) {
                f32x16& sc = (j & 1) ? sbv : sa;
                f32x16& sn = (j & 1) ? sa : sbv;
                if (j < 3) attn_qk32<64>(kb + ((j + 1) >> 1) * 8192, qf, sn, (j + 1) & 1, r, h, nmb);
                if (nearb) {
                    const float* lp = lut + (LUT_OFF - dbase0 + 64 * (j >> 1));
#pragma unroll
                    for (int i = 0; i < 16; ++i) sc[i] += lp[kidx(j & 1, i)];
                }
                attn_softmax32_b(sc, l);
                bf16x8 pf[2];
                attn_pack32(sc, pf);
                attn_pv32(cur + 32768 + (j >> 1) * 16384, pf, o, j & 1, r, h);
            }
            __syncthreads();
        }
        l = sum_x32(l);
        const float inv = l > 0.f ? frcp(l) : 0.f;
        float* xch = (float*)lds + qg * 4096;
        if (comp == 1) {
            const float sc = inv * lam_full;
#pragma unroll
            for (int dt = 0; dt < 4; ++dt)
#pragma unroll
                for (int i = 0; i < 16; ++i) xch[(dt * 16 + i) * 64 + lane] = o[dt][i] * sc;
        }
        __syncthreads();
        if (comp == 0) {
            float ss = 0.f;
#pragma unroll
            for (int dt = 0; dt < 4; ++dt)
#pragma unroll
                for (int i = 0; i < 16; ++i) { const float v = o[dt][i] * inv - xch[(dt * 16 + i) * 64 + lane]; o[dt][i] = v; ss += v * v; }
            ss = sum_x32(ss);
            const float rstd = rsqrtf(ss * (1.f / 128.f) + EPS) * 0.8f;
            bf16_t* orow = O + (long)(b * SEQ + qpos) * DM + hd * 128;
#pragma unroll
            for (int dt = 0; dt < 4; ++dt)
#pragma unroll
                for (int g4 = 0; g4 < 4; ++g4) {
                    const int d0 = 32 * dt + 8 * g4 + 4 * h;
                    const f32x4 gv = *(const f32x4*)(subln + d0);
                    u32x2 ov;
                    ov.x = pk2(o[dt][4 * g4 + 0] * rstd * gv.x, o[dt][4 * g4 + 1] * rstd * gv.y);
                    ov.y = pk2(o[dt][4 * g4 + 2] * rstd * gv.z, o[dt][4 * g4 + 3] * rstd * gv.w);
                    *(u32x2*)(orow + d0) = ov;
                }
        }
        __syncthreads();
    }
}

template <int VAR>
DI void phase_nsa_attn(const Params& p, unsigned char* lds, int tid) {
    unsigned char* ws = p.ws;
    const bf16_t* QN = (const bf16_t*)(ws + OFF_QN);
    const bf16_t* KS = (const bf16_t*)(ws + OFF_KS);
    const bf16_t* VST = (const bf16_t*)(ws + OFF_VST);
    const bf16_t* KW = (const bf16_t*)(ws + OFF_KW);
    const bf16_t* VWT = (const bf16_t*)(ws + OFF_VWT);
    const bf16_t* KCMP = (const bf16_t*)(ws + OFF_KCMP);
    const bf16_t* VCMPT = (const bf16_t*)(ws + OFF_VCMPT);
    const float* gates = (const float*)(ws + OFF_GATES);
    bf16_t* O = VAR ? (bf16_t*)(ws + OFF_PU + 32 * MB) : (bf16_t*)(ws + OFF_H);
    const float* relb = p.in[2];
    const int lane = tid & 63, w = tid >> 6, hg = w >> 1, th = w & 1, r = lane & 31, h = lane >> 5;
    float* lut = (float*)(lds + AT_LUT);
    float* lutc = (float*)(lds + AT_LUTC);
    float* imp = (float*)(lds + AT_IMP);
    unsigned* selw = (unsigned*)(lds + AT_SEL);
    unsigned short* sel16 = (unsigned short*)selw;
    float* bmxs = (float*)(selw + 264);
    const float* qnrm = (const float*)(ws + OFF_MB1);
    float kmx[3];
    for (int br = 0; br < 3; ++br) { float mx = 0.f; for (int d = 0; d < 128; ++d) mx = fmaxf(mx, fabsf(p.in[21][br * 128 + d])); kmx[br] = mx * 11.313708498984761f; }
    const int G = gridDim.x, rows_per_it = G >> 3;
    int lut_g = -1;
    for (int it = 0;; ++it) {
        int u;
        if ((G & 7) == 0) {
            const int rr = blockIdx.x >> 3, cc = blockIdx.x & 7;
            const int rowi = it * rows_per_it + ((it & 1) ? rows_per_it - 1 - rr : rr);
            u = rowi * 8 + cc;
        } else u = it * G + blockIdx.x;
        if (u >= 1024) break;
        const int bi = 127 - (u >> 3), b = (u & 7) >> 1, g = u & 1, head = 4 * g + hg;
        const int tq = 64 * bi + 32 * th + r;
        const int tl = 32 * th + r;
        const long tok = (long)b * SEQ + tq;
        if (g != lut_g) {
            lut_g = g;
            if (tid < 4) { float bm = 0.f; for (int bk = 0; bk < 32; ++bk) bm = fmaxf(bm, relb[bk * 8 + 4 * g + tid] - relb[31 * 8 + 4 * g + tid]); bmxs[tid] = bm * LOG2E; }
            for (int e = tid; e < 4 * LUT_N; e += NTHREADS) { const int hh = e / LUT_N, d = LUT_OFF - (e % LUT_N); lut[e] = d < 0 ? -INFINITY : (d >= 790 ? 0.f : (relb[rel_bucket_i(d) * 8 + 4 * g + hh] - relb[31 * 8 + 4 * g + hh]) * LOG2E); }
            for (int e = tid; e < 4 * 16 * LUTC_W; e += NTHREADS) {
                const int hh = e / (16 * LUTC_W), ph = (e / LUTC_W) & 15, ci = e % LUTC_W, d = 16 * (ci - 1) + ph;
                lutc[e] = ci == 0 ? -INFINITY : (d >= 790 ? 0.f : (relb[rel_bucket_i(d) * 8 + 4 * g + hh] - relb[31 * 8 + 4 * g + hh]) * LOG2E);
            }
        }
        if (tid < 4) selw[256 + tid] = 0u;
        const float* mylut = lut + hg * LUT_N;
        bf16x8 qf[8];
        const bf16_t* qrow = QN + ((long)(b * 8 + head) * SEQ + tq) * 128 + 8 * h;
        auto load_q = [&](const bf16_t* qr) {
#pragma unroll
            for (int ks = 0; ks < 8; ++ks) qf[ks] = *(const bf16x8*)(qr + 16 * ks);
        };
        const float* gp = gates + tok * 24 + head * 3;
        bf16_t* orow = O + (VAR ? (tok & 16383) : tok) * DM + head * 128;
        auto stage = [&](const unsigned char* kg, const unsigned char* vg, unsigned vstride, int kt, unsigned char* st) {
            int t2 = tid; asm volatile("" : "+v"(t2));
            unsigned koff[2], vo[2];
            dma_offsets<256, 64>(koff, 256, t2);
            dma_offsets<128, 128>(vo, vstride, t2);
            dma_issue(st, kg + (long)kt * 16384, koff, t2);
            dma_issue(st + 16384, vg + (long)kt * 128, vo, t2);
        };
        f32x16 o[4];
        float l;
        auto reset = [&]() {
#pragma unroll
            for (int dt = 0; dt < 4; ++dt)
#pragma unroll
                for (int i = 0; i < 16; ++i) o[dt][i] = 0.f;
            l = 0.f;
        };
        const unsigned char* kcg = (const unsigned char*)(KCMP + (long)(b * 2 + g) * 512 * 128);
        const unsigned char* vcg = (const unsigned char*)(VCMPT + (long)(b * 2 + g) * 128 * 512);
        const int nct = ((4 * bi + 2) >> 6) + 1;
        const int hgc = r & 3, tlc = 8 * w + (r >> 2), tqc = 64 * bi + tlc;
        const long tokc = (long)b * SEQ + tqc;
        reset();
        load_q(QN + ((long)(b * 8 + 4 * g + hgc) * SEQ + tqc) * 128 + 8 * h);
        __syncthreads();
        if (VAR != 3) {
            const int cb = (tqc - 31) >> 4;
            const float* lc = lutc + (hgc * 16 + ((tqc - 31) & 15)) * LUTC_W + 1;
            const float nmb = -(qnrm[tokc * 8 + 4 * g + hgc] * kmx[0] + bmxs[hgc]);
            stage(kcg, vcg, 1024u, 0, lds);
            __syncthreads();
            for (int kt = 0; kt < nct; ++kt) {
                unsigned char* cur = lds + (kt & 1) * AT_STAGE;
                if (kt + 1 < nct) stage(kcg, vcg, 1024u, kt + 1, lds + ((kt + 1) & 1) * AT_STAGE);
                const int cbase = cb - kt * 64 - 8 * h;
#pragma unroll
                for (int mt = 0; mt < 2; ++mt) {
                    f32x16 st;
                    attn_qk32<128>(cur, qf, st, mt, r, h, nmb);
                    float sum = 0.f;
#pragma unroll
                    for (int i = 0; i < 16; ++i) {
                        const int c = cbase - kidx(mt, i);
                        sum += fexp2(st[i] + lc[c < -1 ? -1 : (c > 50 ? 50 : c)]);
                    }
                    l += sum;
                }
                __syncthreads();
            }
            const float lt = sum_x32(l);
            const float invl = lt > 0.f ? frcp(lt) : 0.f;
            stage(kcg, vcg, 1024u, 0, lds);
            __syncthreads();
            float carry = 0.f;
            for (int kt = 0; kt < nct; ++kt) {
                unsigned char* cur = lds + (kt & 1) * AT_STAGE;
                if (kt + 1 < nct) stage(kcg, vcg, 1024u, kt + 1, lds + ((kt + 1) & 1) * AT_STAGE);
                const int cbase = cb - kt * 64 - 8 * h;
                float o0[4], o1[4], sp[4];
#pragma unroll
                for (int mt = 0; mt < 2; ++mt) {
                    f32x16 st;
                    attn_qk32<128>(cur, qf, st, mt, r, h, nmb);
#pragma unroll
                    for (int i = 0; i < 16; ++i) {
                        const int c = cbase - kidx(mt, i);
                        st[i] = fexp2(st[i] + lc[c < -1 ? -1 : (c > 50 ? 50 : c)]) * invl;
                    }
#pragma unroll
                    for (int gq = 0; gq < 2; ++gq) {
                        const int G2 = 2 * mt + gq, q0 = 2 * gq, q1 = 2 * gq + 1;
                        const float c20 = 0.5f * st[4 * q0 + 3];
                        o0[G2] = st[4 * q0] + st[4 * q0 + 1] + st[4 * q0 + 2] + c20;
                        o1[G2] = st[4 * q1] + st[4 * q1 + 1] + st[4 * q1 + 2] + 0.5f * st[4 * q1 + 3] + c20;
                        sp[G2] = 0.5f * st[4 * q1 + 3];
                    }
                    bf16x8 pf[2];
                    attn_pack32(st, pf);
                    attn_pv32(cur + 16384, pf, o, mt, r, h);
                }
                float rc[4];
#pragma unroll
                for (int G2 = 0; G2 < 4; ++G2) rc[G2] = __uint_as_float(get_x32(__float_as_uint(sp[G2]), h));
                if (h) {
#pragma unroll
                    for (int G2 = 0; G2 < 4; ++G2) o0[G2] += rc[G2];
                } else {
                    o0[0] += carry; o0[1] += rc[0]; o0[2] += rc[1]; o0[3] += rc[2];
                    carry = rc[3];
                }
#pragma unroll
                for (int G2 = 0; G2 < 4; ++G2) {
                    float a0 = o0[G2], a1 = o1[G2];
                    a0 += lx1(a0); a0 += lx2(a0); a1 += lx1(a1); a1 += lx2(a1);
                    if (hgc == 0) *(f32x2*)(imp + tlc * 130 + kt * 16 + 4 * G2 + 2 * h) = (f32x2){a0, a1};
                }
                __syncthreads();
            }
        }
        {
            const float g_c = gates[tokc * 24 + (4 * g + hgc) * 3];
            bf16_t* orc = O + (VAR ? (tokc & 16383) : tokc) * DM + (4 * g + hgc) * 128;
#pragma unroll
            for (int dt = 0; dt < 4; ++dt)
#pragma unroll
                for (int g4 = 0; g4 < 4; ++g4) {
                    const int d0 = 32 * dt + 8 * g4 + 4 * h;
                    u32x2 ov;
                    ov.x = pk2(o[dt][4 * g4 + 0] * g_c, o[dt][4 * g4 + 1] * g_c);
                    ov.y = pk2(o[dt][4 * g4 + 2] * g_c, o[dt][4 * g4 + 3] * g_c);
                    *(u32x2*)(orc + d0) = ov;
                }
        }
        if (VAR != 5) {
            const int tkn = tid >> 3, part = tid & 7;
            unsigned key[16];
#pragma unroll
            for (int q = 0; q < 16; ++q) {
                const int j = part * 16 + q;
                float v = imp[tkn * 130 + j];
                const int back = bi - j;
                if (j == 0 || (back >= 0 && back < 2)) v = 1e9f;
                if (back < 0) v = -1e30f;
                key[q] = f2key(v);
            }
            auto sum8 = [&](int c) -> int {
                c += __builtin_amdgcn_update_dpp(0, c, 0xB1, 0xF, 0xF, true);
                c += __builtin_amdgcn_update_dpp(0, c, 0x4E, 0xF, 0xF, true);
                c += __builtin_amdgcn_update_dpp(0, c, 0x141, 0xF, 0xF, true);
                return c;
            };
            unsigned T = 0u;
#pragma unroll 4
            for (int bit = 31; bit >= 0; --bit) {
                const unsigned cand = T | (1u << bit);
                int c = 0;
#pragma unroll
                for (int q = 0; q < 16; ++q) c += key[q] >= cand ? 1 : 0;
                if (sum8(c) >= 16) T = cand;
            }
            int cg = 0, ce = 0;
#pragma unroll
            for (int q = 0; q < 16; ++q) { cg += key[q] > T ? 1 : 0; ce += key[q] == T ? 1 : 0; }
            const int need = 16 - sum8(cg);
            int pre = ce;
            { int t = __builtin_amdgcn_update_dpp(0, pre, 0x111, 0xF, 0xF, true); if (part >= 1) pre += t; }
            { int t = __builtin_amdgcn_update_dpp(0, pre, 0x112, 0xF, 0xF, true); if (part >= 2) pre += t; }
            { int t = __builtin_amdgcn_update_dpp(0, pre, 0x114, 0xF, 0xF, true); if (part >= 4) pre += t; }
            int before = pre - ce;
            unsigned bits = 0;
#pragma unroll
            for (int q = 0; q < 16; ++q) {
                const bool eq = key[q] == T;
                const bool selq = key[q] > T || (eq && before < need);
                before += eq ? 1 : 0;
                bits |= (selq && key[q] >= 0x80000000u) ? (1u << q) : 0u;
            }
            sel16[tkn * 8 + part] = (unsigned short)bits;
            atomicOr(&selw[256 + (part >> 1)], bits << ((part & 1) * 16));
        }
        __syncthreads();
        const unsigned un0 = selw[256], un1 = selw[257], un2 = selw[258], un3 = selw[259];
        const unsigned char* ksg = (const unsigned char*)(KS + (long)(b * 2 + g) * SEQ * 128);
        const unsigned char* vsg = (const unsigned char*)(VST + (long)(b * 2 + g) * 128 * SEQ);
        reset(); load_q(qrow);
        const float qn_main = qnrm[tok * 8 + head];
        {
            const float nmb = -(qn_main * kmx[1] + bmxs[hg]);
            const unsigned long long ulo = ((unsigned long long)(unsigned)__builtin_amdgcn_readfirstlane((int)un1) << 32) | (unsigned)__builtin_amdgcn_readfirstlane((int)un0);
            const unsigned long long uhi = ((unsigned long long)(unsigned)__builtin_amdgcn_readfirstlane((int)un3) << 32) | (unsigned)__builtin_amdgcn_readfirstlane((int)un2);
            auto next_tile = [&](int from) -> int {
                if (from < 64) { const unsigned long long mk = ulo >> from; if (mk) return from + __builtin_ctzll(mk); from = 64; }
                if (from < 128) { const unsigned long long mk = uhi >> (from - 64); if (mk) return from + __builtin_ctzll(mk); }
                return 128;
            };
            int jt = (VAR == 1 || VAR == 4 || VAR == 5) ? 128 : next_tile(0);
            int buf = 0;
            if (jt < 128) stage(ksg, vsg, SEQ * 2u, jt, lds);
            __syncthreads();
            while (jt < 128) {
                unsigned char* cur = lds + buf * AT_STAGE;
                const int jn = next_tile(jt + 1);
                if (jn < 128) stage(ksg, vsg, SEQ * 2u, jn, lds + (buf ^ 1) * AT_STAGE);
                const unsigned wd = selw[tl * 4 + (jt >> 5)];
                const bool mysel = (wd >> (jt & 31)) & 1u;
                if (__any(mysel)) {
                    const int k0 = jt * 64;
                    const bool nearb = (64 * bi + 32 * th) - (k0 + 63) < 790;
                    const int dbase = tq - k0 - 8 * h;
                    const float* lp = mylut + (LUT_OFF - dbase);
#pragma unroll
                    for (int mt = 0; mt < 2; ++mt) {
                        f32x16 st;
                        attn_qk32<128>(cur, qf, st, mt, r, h, mysel ? nmb : -INFINITY);
                        if (nearb) {
#pragma unroll
                            for (int i = 0; i < 16; ++i) st[i] += lp[kidx(mt, i)];
                        }
                        attn_softmax32_b(st, l);
                        bf16x8 pf[2];
                        attn_pack32(st, pf);
                        attn_pv32(cur + 16384, pf, o, mt, r, h);
                    }
                }
                __syncthreads();
                buf ^= 1; jt = jn;
            }
        }
        {
            const float lt = sum_x32(l);
            const float sc = (lt > 0.f ? frcp(lt) : 0.f) * gp[1];
#pragma unroll
            for (int dt = 0; dt < 4; ++dt)
#pragma unroll
                for (int g4 = 0; g4 < 4; ++g4) {
                    const int d0 = 32 * dt + 8 * g4 + 4 * h;
                    const u32x2 pv = *(const u32x2*)(orow + d0);
                    u32x2 ov;
                    ov.x = pk2(bflo(pv.x) + o[dt][4 * g4 + 0] * sc, bfhi(pv.x) + o[dt][4 * g4 + 1] * sc);
                    ov.y = pk2(bflo(pv.y) + o[dt][4 * g4 + 2] * sc, bfhi(pv.y) + o[dt][4 * g4 + 3] * sc);
                    *(u32x2*)(orow + d0) = ov;
                }
        }
        const unsigned char* kwg = (const unsigned char*)(KW + (long)(b * 2 + g) * SEQ * 128);
        const unsigned char* vwg = (const unsigned char*)(VWT + (long)(b * 2 + g) * 128 * SEQ);
        reset(); load_q(qrow);
        {
            const float nmb = -(qn_main * kmx[2] + bmxs[hg]);
            const int j0 = bi >= 8 ? bi - 8 : 0, nt = (VAR == 2 || VAR == 4 || VAR == 5) ? 1 : bi - j0 + 1;
            stage(kwg, vwg, SEQ * 2u, j0, lds);
            __syncthreads();
            for (int kt = 0; kt < nt; ++kt) {
                unsigned char* cur = lds + (kt & 1) * AT_STAGE;
                if (kt + 1 < nt) stage(kwg, vwg, SEQ * 2u, j0 + kt + 1, lds + ((kt + 1) & 1) * AT_STAGE);
                const int k0 = (j0 + kt) * 64;
                const int dbase = tq - k0 - 8 * h;
                const float* lp = mylut + (LUT_OFF - dbase);
#pragma unroll
                for (int mt = 0; mt < 2; ++mt) {
                    f32x16 st;
                    attn_qk32<128>(cur, qf, st, mt, r, h, nmb);
#pragma unroll
                    for (int i = 0; i < 16; ++i) st[i] = kidx(mt, i) <= dbase - 512 ? -INFINITY : st[i] + lp[kidx(mt, i)];
                    attn_softmax32_b(st, l);
                    bf16x8 pf[2];
                    attn_pack32(st, pf);
                    attn_pv32(cur + 16384, pf, o, mt, r, h);
                }
                __syncthreads();
            }
        }
        {
            const float lt = sum_x32(l);
            const float sc = (lt > 0.f ? frcp(lt) : 0.f) * gp[2];
#pragma unroll
            for (int dt = 0; dt < 4; ++dt)
#pragma unroll
                for (int g4 = 0; g4 < 4; ++g4) {
                    const int d0 = 32 * dt + 8 * g4 + 4 * h;
                    const u32x2 pv = *(const u32x2*)(orow + d0);
                    u32x2 ov;
                    ov.x = pk2(bflo(pv.x) + o[dt][4 * g4 + 0] * sc, bfhi(pv.x) + o[dt][4 * g4 + 1] * sc);
                    ov.y = pk2(bflo(pv.y) + o[dt][4 * g4 + 2] * sc, bfhi(pv.y) + o[dt][4 * g4 + 3] * sc);
                    *(u32x2*)(orow + d0) = ov;
                }
        }
        __syncthreads();
    }
}

DI void fp8x16_fma(const u32x4& q, const f32x4& h0, const f32x4& h1, const f32x4& h2, const f32x4& h3, f32x2& a0, f32x2& a1) {
    a0 += __builtin_amdgcn_cvt_pk_f32_fp8((int)q.x, false) * (f32x2){h0.x, h0.y};
    a1 += __builtin_amdgcn_cvt_pk_f32_fp8((int)q.x, true)  * (f32x2){h0.z, h0.w};
    a0 += __builtin_amdgcn_cvt_pk_f32_fp8((int)q.y, false) * (f32x2){h1.x, h1.y};
    a1 += __builtin_amdgcn_cvt_pk_f32_fp8((int)q.y, true)  * (f32x2){h1.z, h1.w};
    a0 += __builtin_amdgcn_cvt_pk_f32_fp8((int)q.z, false) * (f32x2){h2.x, h2.y};
    a1 += __builtin_amdgcn_cvt_pk_f32_fp8((int)q.z, true)  * (f32x2){h2.z, h2.w};
    a0 += __builtin_amdgcn_cvt_pk_f32_fp8((int)q.w, false) * (f32x2){h3.x, h3.y};
    a1 += __builtin_amdgcn_cvt_pk_f32_fp8((int)q.w, true)  * (f32x2){h3.z, h3.w};
}
template <bool DRY>
DI void phase_peer_u(const Params& p, int layer, unsigned char* lds, int tid) {
    unsigned char* ws = p.ws;
    const unsigned char* H8 = ws + OFF_H8;
    const float* HS = (const float*)(ws + OFF_HS);
    const int* ridx = (const int*)(ws + OFF_RIDX);
    float* rgate = (float*)(ws + OFF_RGATE);
    const unsigned char* U = ws + OFF_PU + (long)layer * 16384 * 1024;
    const float* usi = (const float*)(ws + OFF_USI) + layer * 16384;
    const float* vsi = (const float*)(ws + OFF_VSI) + layer * 16384;
    const int lane = tid & 63, w = tid >> 6, sub = lane & 7, grp = lane >> 3;
    const int xg = blockIdx.x & 7, lb = blockIdx.x >> 3, nwv = (gridDim.x >> 3) * NWAVES, wv = lb * NWAVES + w;
    unsigned* clb = (unsigned*)(lds + w * 12288);
    unsigned char* hbb = lds + w * 12288 + 2048;
    const unsigned long long lt = (1ull << lane) - 1ull;
    if (lb >= (int)(gridDim.x >> 3)) return;
    int i0, i1; u32x4 h0; float hs0;
    auto ld_tok = [&](int tk) {
        tk = tk < NTOK ? tk : wv;
        i0 = ridx[(long)tk * 128 + lane]; i1 = ridx[(long)tk * 128 + 64 + lane];
        h0 = *(const u32x4*)(H8 + (long)tk * DM + lane * 16); hs0 = HS[tk];
    };
    auto stage_tok = [&](int bi, float& hsinv) -> int {
        unsigned* cl = clb + bi * 256; unsigned char* hb = hbb + bi * 4096;
        const bool b0 = (i0 >> 11) == xg, b1 = (i1 >> 11) == xg;
        const unsigned long long m0 = __ballot(b0), m1 = __ballot(b1);
        const int n0 = __popcll(m0), n = n0 + __popcll(m1);
        if (b0) { const int k = __popcll(m0 & lt); cl[2 * k] = lane; cl[2 * k + 1] = i0; }
        if (b1) { const int k = n0 + __popcll(m1 & lt); cl[2 * k] = 64 + lane; cl[2 * k + 1] = i1; }
        if (n == 0 && lane == 0) { cl[0] = 0u; cl[1] = 0u; }
        hsinv = hs0;
        *(u32x4*)(hb + lane * 16) = h0;
        return n;
    };
    float shC, shN = 1.f;
    ld_tok(wv);
    int nC = stage_tok(0, shC);
    ld_tok(wv + nwv);
    int slotC, idC; bool validC;
    { validC = grp < nC; const int kk = validC ? grp : 0; slotC = clb[2 * kk]; idC = clb[2 * kk + 1]; }
    u32x4 uv[8];
    {
        const unsigned uoff = (unsigned)idC * 1024u + (unsigned)sub * 16u;
#pragma unroll
        for (int t = 0; t < 8; ++t) uv[t] = *(const u32x4*)(U + (uoff + t * 128));
    }
    int it = 0;
    for (int tok = wv; tok < NTOK; tok += nwv, ++it) {
        const int cb = it & 1;
        const unsigned* clC = clb + cb * 256; const unsigned* clN = clb + (cb ^ 1) * 256;
        const unsigned char* hbC = hbb + cb * 4096;
        const bool more = tok + nwv < NTOK;
        int nN = 0;
        if (more) { nN = stage_tok(cb ^ 1, shN); ld_tok(tok + 2 * nwv); }
        const int nr = nC > 8 ? (nC + 7) >> 3 : 1;
        u32x4 hq[8];
#pragma unroll
        for (int t = 0; t < 8; ++t) hq[t] = *(const u32x4*)(hbC + (sub + 8 * t) * 16);
        for (int rd = 0; rd < nr; ++rd) {
            float g_in = 0.f, su = 0.f, sv = 0.f;
            if (validC && sub == 0) { g_in = rgate[(long)tok * 128 + slotC]; su = usi[idC]; sv = vsi[idC]; }
            int slotN, idN; bool validN;
            if (rd + 1 < nr) { const int k = 8 * (rd + 1) + grp; validN = k < nC; const int kk = validN ? k : 0; slotN = clC[2 * kk]; idN = clC[2 * kk + 1]; }
            else if (more) { validN = grp < nN; const int kk = validN ? grp : 0; slotN = clN[2 * kk]; idN = clN[2 * kk + 1]; }
            else { validN = false; slotN = 0; idN = clC[1]; }
            const unsigned uoffN = (unsigned)idN * 1024u + (unsigned)sub * 16u;
            int a0 = 0, a1 = 0, a2 = 0, a3 = 0;
#pragma unroll
            for (int t = 0; t < 8; ++t) {
                const u32x4 q = uv[t];
                a0 = __builtin_amdgcn_sdot4((int)q.x, (int)hq[t].x, a0, false); a1 = __builtin_amdgcn_sdot4((int)q.y, (int)hq[t].y, a1, false);
                a2 = __builtin_amdgcn_sdot4((int)q.z, (int)hq[t].z, a2, false); a3 = __builtin_amdgcn_sdot4((int)q.w, (int)hq[t].w, a3, false);
                uv[t] = *(const u32x4*)(U + (uoffN + t * 128));
            }
            int di = (a0 + a1) + (a2 + a3);
            di += __builtin_amdgcn_update_dpp(0, di, 0xB1, 0xF, 0xF, true);
            di += __builtin_amdgcn_update_dpp(0, di, 0x4E, 0xF, 0xF, true);
            di += __builtin_amdgcn_update_dpp(0, di, 0x141, 0xF, 0xF, true);
            if (validC && sub == 0) {
                float* gw = DRY ? (float*)(ws + OFF_R) + (long)tok * 128 + slotC : rgate + (long)tok * 128 + slotC;
                *gw = g_in * gelu_tanh((float)di * su * shC) * sv;
            }
            slotC = slotN; idC = idN; validC = validN;
        }
        nC = nN; shC = shN;
    }
}

#ifndef VMASK
#define VMASK 0xffffffffu
#endif
template <bool DRY>
DI void phase_peer_v(const Params& p, int layer, int tid) {
    unsigned char* ws = p.ws;
    const int* ridx = (const int*)(ws + OFF_RIDX);
    const float* wact = (const float*)(ws + OFF_RGATE);
    const float* ada = (const float*)(ws + OFF_ADA);
    float* x = opq(p.out);
    const int lane = tid & 63, w = tid >> 6, sub = lane & 7, eg = lane >> 3;
    const int xg = blockIdx.x & 7, lb = blockIdx.x >> 3, nwv = (gridDim.x >> 3) * NWAVES, wv = lb * NWAVES + w;
    if (lb >= (int)(gridDim.x >> 3)) return;
    const unsigned char* Vc = ws + OFF_PV + ((long)(layer * 8 + xg) * 16384) * 128;
    const int col0 = 128 * xg + 16 * sub;
    const __amdgpu_buffer_rsrc_t vrs = __builtin_amdgcn_make_buffer_rsrc((void*)Vc, (short)0, 16384 * 128, 0x00020000);
    auto ld_ids = [&](int tk, u32x4 (&a)[4], f32x4 (&wq)[4]) {
        tk = tk < NTOK ? tk : wv;
        const u32x4* ip = (const u32x4*)(ridx + (long)tk * 128 + eg * 16);
        const f32x4* wp = (const f32x4*)(wact + (long)tk * 128 + eg * 16);
#pragma unroll
        for (int q = 0; q < 4; ++q) { a[q] = ip[q]; wq[q] = wp[q]; }
    };
    u32x4 vv[16];
    u32x4 na[4], pa[4]; f32x4 cw[4], nw[4], pw[4];
    {
        u32x4 a[4];
        ld_ids(wv, a, cw);
#pragma unroll
        for (int j = 0; j < 16; ++j)
            vv[j] = __builtin_bit_cast(u32x4, __builtin_amdgcn_raw_buffer_load_b128(vrs, (int)((a[j >> 2][j & 3] & (DRY ? VMASK : 0xffffffffu)) * 128u + (unsigned)sub * 16u), 0, 0));
    }
    ld_ids(wv + nwv, na, nw);
    f32x4 gfv[4]; int gb = -1;
    for (int tok = wv; tok < NTOK; tok += nwv) {
        ld_ids(tok + 2 * nwv, pa, pw);
        f32x4 xv[4];
        {
            const float* xin = x + (long)tok * DM + col0;
#pragma unroll
            for (int c = 0; c < 4; ++c) xv[c] = *(const f32x4*)(xin + 4 * c);
            const int b = tok >> 13;
            if (b != gb) {
                gb = b;
                const float* gf = ada + b * ADA_STRIDE + layer * 6144 + 5 * 1024 + col0;
#pragma unroll
                for (int c = 0; c < 4; ++c) gfv[c] = *(const f32x4*)(gf + 4 * c);
            }
        }
        f32x2 ap[8];
#pragma unroll
        for (int i = 0; i < 8; ++i) ap[i] = (f32x2){0.f, 0.f};
#pragma unroll
        for (int j = 0; j < 16; ++j) {
            const float ws1 = cw[j >> 2][j & 3]; const f32x2 ww = {ws1, ws1}; const u32x4 v = vv[j];
            ap[0] += __builtin_amdgcn_cvt_pk_f32_fp8((int)v.x, false) * ww; ap[1] += __builtin_amdgcn_cvt_pk_f32_fp8((int)v.x, true) * ww;
            ap[2] += __builtin_amdgcn_cvt_pk_f32_fp8((int)v.y, false) * ww; ap[3] += __builtin_amdgcn_cvt_pk_f32_fp8((int)v.y, true) * ww;
            ap[4] += __builtin_amdgcn_cvt_pk_f32_fp8((int)v.z, false) * ww; ap[5] += __builtin_amdgcn_cvt_pk_f32_fp8((int)v.z, true) * ww;
            ap[6] += __builtin_amdgcn_cvt_pk_f32_fp8((int)v.w, false) * ww; ap[7] += __builtin_amdgcn_cvt_pk_f32_fp8((int)v.w, true) * ww;
            vv[j] = __builtin_bit_cast(u32x4, __builtin_amdgcn_raw_buffer_load_b128(vrs, (int)((na[j >> 2][j & 3] & (DRY ? VMASK : 0xffffffffu)) * 128u + (unsigned)sub * 16u), 0, 0));
        }
        float acc[16];
#pragma unroll
        for (int i = 0; i < 8; ++i) { acc[2 * i] = ap[i].x; acc[2 * i + 1] = ap[i].y; }
#pragma unroll
        for (int i = 0; i < 16; ++i) { acc[i] += lr8(acc[i]); acc[i] = sum_x16(acc[i]); acc[i] = sum_x32(acc[i]); }
        if (eg == 0) {
            float* xr = DRY ? (float*)(ws + OFF_R + 16 * MB) + (long)tok * DM + col0 : x + (long)tok * DM + col0;
#pragma unroll
            for (int c = 0; c < 4; ++c) {
                const f32x4 gv = gfv[c];
                f32x4 o;
                o.x = xv[c].x + gv.x * acc[4 * c + 0]; o.y = xv[c].y + gv.y * acc[4 * c + 1];
                o.z = xv[c].z + gv.z * acc[4 * c + 2]; o.w = xv[c].w + gv.w * acc[4 * c + 3];
                *(f32x4*)(xr + 4 * c) = o;
            }
        }
#pragma unroll
        for (int q = 0; q < 4; ++q) { cw[q] = nw[q]; na[q] = pa[q]; nw[q] = pw[q]; }
    }
}

DI void phase_norm2(const float* __restrict__ x, bf16_t* __restrict__ out1, const float* gain1, int sh1, int sc1,
                    bf16_t* __restrict__ out2, const float* gain2, int sh2, int sc2, const float* ada, int tid) {
    const int lane = tid & 63, gw = blockIdx.x * NWAVES + (tid >> 6), nw = gridDim.x * NWAVES;
    for (int tok = gw; tok < NTOK; tok += nw) {
        const int b = tok >> 13;
        f32x4 v[4]; float ss = 0.f;
#pragma unroll
        for (int j = 0; j < 4; ++j) { v[j] = *(const f32x4*)(x + (long)tok * DM + 4 * lane + 256 * j); ss += v[j].x * v[j].x + v[j].y * v[j].y + v[j].z * v[j].z + v[j].w * v[j].w; }
        const float rstd = rsqrtf(wave_sum(ss) * (1.f / DM) + EPS);
        norm_row_write(v, rstd, gain1, ada + b * ADA_STRIDE + sh1, ada + b * ADA_STRIDE + sc1, out1 + (long)tok * DM, lane);
        norm_row_write(v, rstd, gain2, ada + b * ADA_STRIDE + sh2, ada + b * ADA_STRIDE + sc2, out2 + (long)tok * DM, lane);
    }
}

template <int MT, class Epi>
DI void gemm_phase(const bf16_t* A, long lda, int M, const bf16_t* Bt, long ldb, int N, int K, const Epi& epi, unsigned char* lds, int tid) {
    const int ntm = (M + 128 * MT - 1) / (128 * MT), ntn = (N + 255) / 256, nt = ntm * ntn;
    if ((gridDim.x & 7) == 0 && (ntm & 31) == 0) {
        const int xcd = blockIdx.x & 7, lb = blockIdx.x >> 3, nlb = gridDim.x >> 3, tmx = ntm >> 3, per = tmx * ntn;
        for (int q = lb; q < per; q += nlb) {
            const int g4 = q / (4 * ntn), rem = q - g4 * 4 * ntn, tn = rem >> 2, tm = xcd * tmx + g4 * 4 + (rem & 3);
            if (tm < (xcd + 1) * tmx) gemm_tile<MT>(A, lda, M, Bt, ldb, N, K, tm * 128 * MT, tn * 256, epi, lds, tid);
        }
        return;
    }
    for (int t = blockIdx.x; t < nt; t += gridDim.x) {
        const int tn = t / ntm, tm = t % ntm;
        gemm_tile<MT>(A, lda, M, Bt, ldb, N, K, tm * 128 * MT, tn * 256, epi, lds, tid);
    }
}

template <int MT, class Epi>
DI void gemm_tile_i8(const unsigned char* __restrict__ A, int M, const float* __restrict__ as, const unsigned char* __restrict__ Bt, int N, const float* __restrict__ bs,
                     int K, int m0, int n0, const Epi& epi, unsigned char* lds, int tid) {
    constexpr int XS = MT * 128 * 128, WS = 256 * 128, STAGE = XS + WS;
    const int lane = tid & 63, w = tid >> 6, tg = w & 3, fh = w >> 2, r = lane & 31, h = lane >> 5;
    const int wbase = tid & ~63;
    unsigned xo[2 * MT], wo[4];
#pragma unroll
    for (int i = 0; i < 2 * MT; ++i) { int row, c; sw2_src(tid + 512 * i, row, c); int m = m0 + row; m = m < M ? m : M - 1; xo[i] = (unsigned)m * (unsigned)K + c * 16; }
#pragma unroll
    for (int i = 0; i < 4; ++i) { int row, c; sw2_src(tid + 512 * i, row, c); int n = n0 + row; n = n < N ? n : N - 1; wo[i] = (unsigned)n * (unsigned)K + c * 16; }
    auto stage = [&](int kt, unsigned char* st) {
#pragma unroll
        for (int i = 0; i < 2 * MT; ++i)
            __builtin_amdgcn_global_load_lds((const unsigned*)(A + kt * 128 + xo[i]), (unsigned*)(st + (wbase + 512 * i) * 16), 16, 0, 0);
#pragma unroll
        for (int i = 0; i < 4; ++i)
            __builtin_amdgcn_global_load_lds((const unsigned*)(Bt + kt * 128 + wo[i]), (unsigned*)(st + XS + (wbase + 512 * i) * 16), 16, 0, 0);
    };
    i32x16 acc[MT][4];
#pragma unroll
    for (int s2 = 0; s2 < MT; ++s2)
#pragma unroll
        for (int i = 0; i < 4; ++i)
#pragma unroll
            for (int j = 0; j < 16; ++j) acc[s2][i][j] = 0;
    const int nk = K >> 7;
    stage(0, lds);
    __syncthreads();
#pragma unroll 2
    for (int kt = 0; kt < nk; ++kt) {
        unsigned char* cur = lds + (kt & 1) * STAGE;
        if (kt + 1 < nk) stage(kt + 1, lds + ((kt + 1) & 1) * STAGE);
        i32x4 xfa[MT], wfa[4], xfb[MT], wfb[4];
        auto ldf = [&](i32x4 (&xf)[MT], i32x4 (&wf)[4], int ks) {
#pragma unroll
            for (int s2 = 0; s2 < MT; ++s2) xf[s2] = *(const i32x4*)(cur + sw2(32 * MT * tg + 32 * s2 + r, 2 * ks + h));
#pragma unroll
            for (int mt = 0; mt < 4; ++mt) wf[mt] = *(const i32x4*)(cur + XS + sw2(128 * fh + 32 * mt + r, 2 * ks + h));
        };
        auto mm = [&](const i32x4 (&xf)[MT], const i32x4 (&wf)[4]) {
#pragma unroll
            for (int mt = 0; mt < 4; ++mt)
#pragma unroll
                for (int s2 = 0; s2 < MT; ++s2) acc[s2][mt] = MFMA32I8(wf[mt], xf[s2], acc[s2][mt]);
        };
        ldf(xfa, wfa, 0);
        ldf(xfb, wfb, 1); __builtin_amdgcn_sched_barrier(0); mm(xfa, wfa); __builtin_amdgcn_sched_barrier(0);
        ldf(xfa, wfa, 2); __builtin_amdgcn_sched_barrier(0); mm(xfb, wfb); __builtin_amdgcn_sched_barrier(0);
        ldf(xfb, wfb, 3); __builtin_amdgcn_sched_barrier(0); mm(xfa, wfa); __builtin_amdgcn_sched_barrier(0);
        mm(xfb, wfb);
        __syncthreads();
    }
    auto fin = [&](const i32x16 (&ai)[4], int s2, int ho, int ro, int to) {
        const int tok = m0 + 32 * MT * tg + 32 * s2 + ro, fbase = n0 + 128 * fh;
        const float sa = as[tok < M ? tok : M - 1];
        f32x16 af[4];
#pragma unroll
        for (int mt = 0; mt < 4; ++mt) {
#pragma unroll
            for (int g4 = 0; g4 < 4; ++g4) {
                int f0 = fbase + 32 * mt + 8 * g4 + 4 * ho; f0 = f0 + 3 < N ? f0 : (N - 4 > 0 ? N - 4 : 0);
                const f32x4 sb = *(const f32x4*)(bs + f0);
                af[mt][4 * g4 + 0] = (float)ai[mt][4 * g4 + 0] * (sa * sb.x); af[mt][4 * g4 + 1] = (float)ai[mt][4 * g4 + 1] * (sa * sb.y);
                af[mt][4 * g4 + 2] = (float)ai[mt][4 * g4 + 2] * (sa * sb.z); af[mt][4 * g4 + 3] = (float)ai[mt][4 * g4 + 3] * (sa * sb.w);
            }
            __builtin_amdgcn_sched_barrier(0);
        }
        epi(af, tok, fbase, ho, lds, to);
        __builtin_amdgcn_sched_barrier(0);
    };
    if constexpr (MT == 2 && epi_stash<Epi>::present) {
        int* sp = (int*)lds + w * 4096 + lane;
#pragma unroll
        for (int mt = 0; mt < 4; ++mt)
#pragma unroll
            for (int j = 0; j < 16; ++j) sp[(mt * 16 + j) * 64] = acc[1][mt][j];
        int ho = h, ro = r, to = tid;
        asm volatile("" : "+v"(ho), "+v"(ro), "+v"(to));
        fin(acc[0], 0, ho, ro, to);
        i32x16 a2[4];
        const int* sp2 = sp; asm volatile("" : "+v"(sp2));
#pragma unroll
        for (int mt = 0; mt < 4; ++mt)
#pragma unroll
            for (int j = 0; j < 16; ++j) a2[mt][j] = sp2[(mt * 16 + j) * 64];
        asm volatile("" : "+v"(ho), "+v"(ro), "+v"(to));
        fin(a2, 1, ho, ro, to);
        __syncthreads();
    } else {
#pragma unroll
        for (int s2 = 0; s2 < MT; ++s2) fin(acc[s2], s2, h, r, tid);
    }
}
template <int MT, class Epi>
DI void gemm_phase_i8(const unsigned char* A, int M, const float* as, const unsigned char* Bt, int N, const float* bs, int K, const Epi& epi, unsigned char* lds, int tid) {
    const int ntm = (M + 128 * MT - 1) / (128 * MT), ntn = (N + 255) / 256, nt = ntm * ntn;
    if ((gridDim.x & 7) == 0 && (ntm & 31) == 0) {
        const int xcd = blockIdx.x & 7, lb = blockIdx.x >> 3, nlb = gridDim.x >> 3, tmx = ntm >> 3, per = tmx * ntn;
        for (int q = lb; q < per; q += nlb) {
            const int g4 = q / (4 * ntn), rem = q - g4 * 4 * ntn, tn = rem >> 2, tm = xcd * tmx + g4 * 4 + (rem & 3);
            gemm_tile_i8<MT>(A, M, as, Bt, N, bs, K, tm * 128 * MT, tn * 256, epi, lds, tid);
        }
        return;
    }
    for (int t = blockIdx.x; t < nt; t += gridDim.x) {
        const int tn = t / ntm, tm = t % ntm;
        gemm_tile_i8<MT>(A, M, as, Bt, N, bs, K, tm * 128 * MT, tn * 256, epi, lds, tid);
    }
}

DI void wquant_rows(const bf16_t* __restrict__ src, unsigned char* __restrict__ dst, float* __restrict__ sc, int nrows, int gw, int nw, int lane) {
    for (int n = gw; n < nrows; n += nw) {
        const u32x4 a = *(const u32x4*)(src + (long)n * 1024 + 16 * lane), b = *(const u32x4*)(src + (long)n * 1024 + 16 * lane + 8);
        float v[16];
        v[0] = bflo(a.x); v[1] = bfhi(a.x); v[2] = bflo(a.y); v[3] = bfhi(a.y); v[4] = bflo(a.z); v[5] = bfhi(a.z); v[6] = bflo(a.w); v[7] = bfhi(a.w);
        v[8] = bflo(b.x); v[9] = bfhi(b.x); v[10] = bflo(b.y); v[11] = bfhi(b.y); v[12] = bflo(b.z); v[13] = bfhi(b.z); v[14] = bflo(b.w); v[15] = bfhi(b.w);
        float am = 0.f;
#pragma unroll
        for (int q = 0; q < 16; ++q) am = fmaxf(am, fabsf(v[q]));
        am = wave_max(am);
        const float qs = am > 0.f ? 127.f / am : 1.f;
        u32x4 o;
        o.x = (unsigned)pack_i8x4(v[0] * qs, v[1] * qs, v[2] * qs, v[3] * qs); o.y = (unsigned)pack_i8x4(v[4] * qs, v[5] * qs, v[6] * qs, v[7] * qs);
        o.z = (unsigned)pack_i8x4(v[8] * qs, v[9] * qs, v[10] * qs, v[11] * qs); o.w = (unsigned)pack_i8x4(v[12] * qs, v[13] * qs, v[14] * qs, v[15] * qs);
        *(u32x4*)(dst + (long)n * 1024 + 16 * lane) = o;
        if (lane == 0) sc[n] = am > 0.f ? am * (1.f / 127.f) : 1.f;
    }
}
DI void phase_wquant(unsigned char* ws, int tid) {
    const int lane = tid & 63, gw = blockIdx.x * NWAVES + (tid >> 6), nw = gridDim.x * NWAVES;
    float* sc = (float*)(ws + OFF_W8S);
    wquant_rows((const bf16_t*)(ws + OFF_WT_PEER), ws + OFF_W8_PEER, sc + W8S_PEER, 4096, gw, nw, lane);
    wquant_rows((const bf16_t*)(ws + OFF_WT_DIN), ws + OFF_W8_DIN, sc + W8S_DIN, 3072, gw, nw, lane);
    wquant_rows((const bf16_t*)(ws + OFF_WT_KV), ws + OFF_W8_KV, sc + W8S_KV, 1536, gw, nw, lane);
    wquant_rows((const bf16_t*)(ws + OFF_WT_NIN), ws + OFF_W8_NIN, sc + W8S_NIN, 1152, gw, nw, lane);
}

#define XB_TMO      128
#define XB_XCNT(j)  (256  + 64 * (j))
#define XB_XSUB(j)  (1280 + 64 * (j))
#define XB_XGEN(j)  (2304 + 64 * (j))
#define XB_TOP      3328
#define XB_TOPGEN   3392
#define XCD_BAR_WORDS 3456
#define XB_SPIN_CAP (1u << 22)
#define LAS __attribute__((address_space(3)))
DI unsigned xb_ld(unsigned* p) { return __hip_atomic_load(p, __ATOMIC_RELAXED, __HIP_MEMORY_SCOPE_AGENT); }
DI unsigned xb_add(unsigned* p, unsigned v) { return __hip_atomic_fetch_add(p, v, __ATOMIC_RELAXED, __HIP_MEMORY_SCOPE_AGENT); }
DI unsigned xb_xcc_id() { return (unsigned)__builtin_amdgcn_s_getreg((3 << 11) | 20) & 0xFu; }
#define XB_SPIN(cond, bar) do { unsigned _sp = 0; while (cond) { __builtin_amdgcn_s_sleep(1); \
    if ((++_sp & 255u) == 0u) { if (xb_ld(&(bar)[XB_TMO])) break; if (_sp > XB_SPIN_CAP) { atomicAdd(&(bar)[XB_TMO], 1u); break; } } } } while (0)
DI void xcd_barrier_complete(unsigned* bar, unsigned x, unsigned& nloc, unsigned& nx) {
    const unsigned G = gridDim.x;
    unsigned sum, cnt, mine, sp = 0u;
    for (;;) {
        sum = 0u; cnt = 0u; mine = 0u;
#pragma unroll
        for (unsigned j = 0; j < 16; ++j) { const unsigned c = xb_ld(&bar[XB_XCNT(j)]); sum += c; cnt += (c > 0u) ? 1u : 0u; mine = (j == x) ? c : mine; }
        if (sum == G) break;
        __builtin_amdgcn_s_sleep(1);
        if ((++sp & 255u) == 0u) { if (xb_ld(&bar[XB_TMO])) break; if (sp > XB_SPIN_CAP) { atomicAdd(&bar[XB_TMO], 1u); break; } }
    }
    nloc = mine > 0u ? mine : 1u; nx = cnt > 0u ? cnt : 1u;
}
DI void xcd_barrier(unsigned* bar, volatile LAS unsigned* st, int tid) {
    asm volatile("s_waitcnt vmcnt(0)" ::: "memory");
    __syncthreads();
    if (tid == 0) {
        const unsigned x = xb_xcc_id();
        __builtin_amdgcn_s_waitcnt(0);
        unsigned nloc = st[0], nx = st[1];
        if (nloc == 0u) { xcd_barrier_complete(bar, x, nloc, nx); st[0] = nloc; st[1] = nx; }
        const unsigned old = xb_add(&bar[XB_XSUB(x)], 1u);
        const unsigned gen = old / nloc;
        if (old + 1u == (gen + 1u) * nloc) {
            __builtin_amdgcn_fence(__ATOMIC_RELEASE, "agent");
            asm volatile("s_waitcnt vmcnt(0)" ::: "memory");
            const unsigned og = xb_add(&bar[XB_TOP], 1u);
            const unsigned tg = og / nx;
            if (og + 1u == (tg + 1u) * nx) xb_add(&bar[XB_TOPGEN], 1u);
            else XB_SPIN(xb_ld(&bar[XB_TOPGEN]) == tg, bar);
            __builtin_amdgcn_fence(__ATOMIC_ACQUIRE, "agent");
            xb_add(&bar[XB_XGEN(x)], 1u);
            asm volatile("s_waitcnt vmcnt(0)" ::: "memory");
        } else {
            XB_SPIN(xb_ld(&bar[XB_XGEN(x)]) == gen, bar);
            __builtin_amdgcn_fence(__ATOMIC_ACQUIRE, "agent");
            asm volatile("s_waitcnt vmcnt(0)" ::: "memory");
        }
    }
    __syncthreads();
}

#define ftid() ftid_(wave_u)
DI int ftid_(int wave_u) { int t = (wave_u << 6) + (int)__builtin_amdgcn_mbcnt_hi(~0u, __builtin_amdgcn_mbcnt_lo(~0u, 0u)); asm volatile("" : "+v"(t)); return t; }


#if defined(__HIP_DEVICE_COMPILE__)
typedef const __attribute__((address_space(4))) Params* KParamPtr;
DI Params load_params() { KParamPtr kp = (KParamPtr)__builtin_amdgcn_kernarg_segment_ptr(); asm volatile("" : "+s"(kp)); return *kp; }
#else
DI Params load_params() { return Params{}; }
#endif
#define p (load_params())
#define ws (load_params().ws)
#define ada ((const float*)(ws + OFF_ADA))
#define Hb ((bf16_t*)(ws + OFF_H))
#define bar ((unsigned*)(ws + OFF_BAR))
__global__ void __launch_bounds__(NTHREADS) yoco_fwd(Params p_arg) {
    extern __shared__ __attribute__((aligned(16))) unsigned char lds[];
    cg::grid_group grid = cg::this_grid();
    volatile LAS unsigned* bst = (volatile LAS unsigned*)(lds + 144 * 1024);
    const int wave_u = __builtin_amdgcn_readfirstlane((int)(threadIdx.x >> 6));
    { const int t0 = ftid(); if (t0 == 0) { bst[0] = 0u; bst[1] = 0u; }
      if (blockIdx.x == 0) for (int i = t0; i < XCD_BAR_WORDS; i += NTHREADS) bar[i] = 0u; }
    __syncthreads();
    RUN(0) REP(0) phase_prep(p, lds, ftid());
    grid.sync();
    if (ftid() == 0) (void)xb_add(&bar[XB_XCNT(xb_xcc_id())], 1u);
    RUN(1) REP(1) phase_norm(p.in[0], Hb, p.in[5], ada, 0, 1024, ftid());
    RUN(1) phase_wquant(ws, ftid());
    xcd_barrier(bar, bst, ftid());
    RUN(2) REP(2) {
        EpiQKV0 e{(bf16_t*)(ws + OFF_Q0), (bf16_t*)(ws + OFF_K0), (bf16_t*)(ws + OFF_VT0), p.in[10], p.in[11], (float*)(ws + OFF_MB0), p.in[2]};
        gemm_phase<2>(Hb, DM, NTOK, (const bf16_t*)(ws + OFF_WT_DIN), DM, 3072, DM, e, lds, ftid());
    }
    xcd_barrier(bar, bst, ftid());
    RUN(3) REP(3) phase_diff_attn(p, lds, ftid());
    xcd_barrier(bar, bst, ftid());
    RUN(4) REP(4) {
        EpiResid e{p.in[0], opq(p.out), ada + 2 * 1024};
        gemm_phase<2>(Hb, DM, NTOK, (const bf16_t*)(ws + OFF_WT_DOUT), DM, 1024, DM, e, lds, ftid());
    }
    xcd_barrier(bar, bst, ftid());
    if (STOP_AFTER <= 1) return;
    RUN(1) phase_norm_q8(opq(p.out), Hb, ws + OFF_H8, (float*)(ws + OFF_HS), p.in[6], ada, 3 * 1024, 4 * 1024, ftid());
    xcd_barrier(bar, bst, ftid());
    RUN(5) REP(5) {
        EpiPeer e{(int*)(ws + OFF_RIDX), (float*)(ws + OFF_RGATE), 128 * 1024};
        gemm_phase_i8<2>(ws + OFF_H8, NTOK, (const float*)(ws + OFF_HS), ws + OFF_W8_PEER, 2048, (const float*)(ws + OFF_W8S) + W8S_PEER, DM, e, lds, ftid());
    }
    xcd_barrier(bar, bst, ftid());
    if ((REPEAT_MASK >> 6) & 1) phase_peer_u<true>(p, 0, lds, ftid());
    RUN(6) phase_peer_u<false>(p, 0, lds, ftid());
    xcd_barrier(bar, bst, ftid());
    if ((REPEAT_MASK >> 10) & 1) phase_peer_v<true>(p, 0, ftid());
    RUN(6) phase_peer_v<false>(p, 0, ftid());
    xcd_barrier(bar, bst, ftid());
    RUN(1) phase_norm2(opq(p.out), (bf16_t*)(ws + OFF_H2), p.in[13], 12288, 12288 + 1024, Hb, p.in[5] + 1024, 6144, 6144 + 1024, ada, ftid());
    xcd_barrier(bar, bst, ftid());
    if (STOP_AFTER <= 2) return;
    RUN(7) REP(7) {
        EpiKV e{(bf16_t*)(ws + OFF_KC), (bf16_t*)(ws + OFF_KS), (bf16_t*)(ws + OFF_VST), (bf16_t*)(ws + OFF_KW), (bf16_t*)(ws + OFF_VWT), p.in[21]};
        gemm_phase<2>((const bf16_t*)(ws + OFF_H2), DM, NTOK, (const bf16_t*)(ws + OFF_WT_KV), DM, 1536, DM, e, lds, ftid());
    }
    xcd_barrier(bar, bst, ftid());
    RUN(8) REP(8) {
        EpiNsaQ e{(bf16_t*)(ws + OFF_QN), (float*)(ws + OFF_GATES), p.in[25], p.in[23], (float*)(ws + OFF_MB1)};
        gemm_phase<2>(Hb, DM, NTOK, (const bf16_t*)(ws + OFF_WT_NIN), DM, 1048, DM, e, lds, ftid());
        for (int t = blockIdx.x; t < 64; t += gridDim.x) {
            const int pr = t >> 2, tm = t & 3, kv = pr >> 3, bg = pr & 7;
            const bf16_t* Ap = (const bf16_t*)(ws + OFF_KC) + (long)(kv * 8 + bg) * SEQ * 128;
            bf16_t* hid = (bf16_t*)(ws + OFF_HID) + (long)pr * 512 * 256;
            EpiCmp1 e1{hid, (const float*)(ws + OFF_POSB) + kv * 16 * 256, p.in[19] + kv * 256};
            gemm_tile<1>(Ap, 2048, 511, (const bf16_t*)(ws + OFF_WT_C1) + (long)kv * 256 * 4096, 4096, 256, 4096, tm * 128, 0, e1, lds, ftid());
            __syncthreads();
            bf16_t* dst = kv == 0 ? (bf16_t*)(ws + OFF_KCMP) + (long)bg * 512 * 128 : (bf16_t*)(ws + OFF_VCMPT) + (long)bg * 128 * 512;
            EpiCmp2 e2{dst, p.in[21], kv};
            gemm_tile<1>(hid, 256, 512, (const bf16_t*)(ws + OFF_WT_C2) + (long)kv * 128 * 256, 256, 128, 256, tm * 128, 0, e2, lds, ftid());
        }
    }
    xcd_barrier(bar, bst, ftid());
#ifdef NSA_PROBE
    phase_nsa_attn<NSA_PROBE>(p, lds, ftid());
#endif
    RUN(9) REP(9) phase_nsa_attn<0>(p, lds, ftid());
    xcd_barrier(bar, bst, ftid());
    RUN(4) {
        float* xo = opq(p.out);
        EpiResid e{xo, xo, ada + 6144 + 2 * 1024};
        gemm_phase<2>(Hb, DM, NTOK, (const bf16_t*)(ws + OFF_WT_NOUT), DM, 1024, DM, e, lds, ftid());
    }
    xcd_barrier(bar, bst, ftid());
    if (STOP_AFTER <= 3) return;
    RUN(1) phase_norm_q8(opq(p.out), Hb, ws + OFF_H8, (float*)(ws + OFF_HS), p.in[6] + 1024, ada, 6144 + 3 * 1024, 6144 + 4 * 1024, ftid());
    xcd_barrier(bar, bst, ftid());
    RUN(5) REP(5) {
        EpiPeer e{(int*)(ws + OFF_RIDX), (float*)(ws + OFF_RGATE), 128 * 1024};
        gemm_phase_i8<2>(ws + OFF_H8, NTOK, (const float*)(ws + OFF_HS), ws + OFF_W8_PEER + (long)2048 * 1024, 2048, (const float*)(ws + OFF_W8S) + W8S_PEER + 2048, DM, e, lds, ftid());
    }
    xcd_barrier(bar, bst, ftid());
    if ((REPEAT_MASK >> 6) & 1) phase_peer_u<true>(p, 1, lds, ftid());
    RUN(6) phase_peer_u<false>(p, 1, lds, ftid());
    xcd_barrier(bar, bst, ftid());
    if ((REPEAT_MASK >> 10) & 1) phase_peer_v<true>(p, 1, ftid());
    RUN(6) phase_peer_v<false>(p, 1, ftid());
}
#undef p
#undef ws
#undef ada
#undef Hb
#undef bar

extern "C" void kernel_launch(void* const* d_in, const int* in_sizes, int n_in, void* d_out, int out_size, void* d_ws, size_t ws_size,
                              hipStream_t stream) {
    static int grid_blocks = 0;
    if (grid_blocks == 0) {
        if (n_in != 30 || out_size != NTOK * DM || ws_size < WS_END) {
            fprintf(stderr, "kernel_launch: unexpected shapes (n_in %d out %d ws %zu)\n", n_in, out_size, ws_size);
            grid_blocks = -1; return;
        }
        int dev = 0, cus = 0, per_cu = 0;
        hipGetDevice(&dev);
        hipDeviceGetAttribute(&cus, hipDeviceAttributeMultiprocessorCount, dev);
        hipFuncSetAttribute((const void*)yoco_fwd, hipFuncAttributeMaxDynamicSharedMemorySize, LDS_BYTES);
        hipOccupancyMaxActiveBlocksPerMultiprocessor(&per_cu, (const void*)yoco_fwd, NTHREADS, LDS_BYTES);
        if (per_cu < 1) { fprintf(stderr, "kernel_launch: occupancy query says %d blocks per CU\n", per_cu); grid_blocks = -1; return; }
        grid_blocks = cus;
    }
    if (grid_blocks < 0) return;
    Params p{};
    for (int i = 0; i < 30; ++i) p.in[i] = (const float*)d_in[i];
    p.out = (float*)d_out;
    p.ws = (unsigned char*)d_ws;
    void* args[] = {&p};
    hipError_t e = hipLaunchCooperativeKernel((const void*)yoco_fwd, dim3(grid_blocks), dim3(NTHREADS), args, LDS_BYTES, stream);
    if (e != hipSuccess) fprintf(stderr, "cooperative launch failed: %s (grid %d)\n", hipGetErrorString(e), grid_blocks);
}
```

```cpp
#include <hip/hip_runtime.h>
#include <hip/hip_cooperative_groups.h>
#include <cstdio>
#include <cstdint>
namespace cg = cooperative_groups;

#define DI __device__ __forceinline__
#ifndef STOP_AFTER
#define STOP_AFTER 99
#endif
#ifndef ONLY_PHASE
#define ONLY_PHASE -1
#endif
#define RUN(n) if (ONLY_PHASE < 0 || ONLY_PHASE == (n))
#ifndef REPEAT_MASK
#define REPEAT_MASK 0
#endif
#define REP(n) for (int rep_ = 0; rep_ < (((REPEAT_MASK) >> (n)) & 1) + 1; ++rep_)

typedef unsigned short bf16_t;
typedef short bf16x8 __attribute__((ext_vector_type(8)));
typedef float f32x16 __attribute__((ext_vector_type(16)));
typedef float f32x4 __attribute__((ext_vector_type(4)));
typedef float f32x2 __attribute__((ext_vector_type(2)));
typedef unsigned u32x4 __attribute__((ext_vector_type(4)));
typedef unsigned u32x2 __attribute__((ext_vector_type(2)));
typedef __bf16 bf16x2v __attribute__((ext_vector_type(2)));

#define MFMA32(a, b, c) __builtin_amdgcn_mfma_f32_32x32x16_bf16((a), (b), (c), 0, 0, 0)
typedef int i32x4 __attribute__((ext_vector_type(4)));
typedef int i32x16 __attribute__((ext_vector_type(16)));
#define MFMA32I8(a, b, c) __builtin_amdgcn_mfma_i32_32x32x32_i8((a), (b), (c), 0, 0, 0)

constexpr int NB = 4, SEQ = 8192, DM = 1024, NTOK = NB * SEQ;
constexpr int NTHREADS = 512, NWAVES = 8;
constexpr float EPS = 1e-6f;
constexpr float LOG2E = 1.4426950408889634f;
constexpr int ADA_STRIDE = 14336;

constexpr size_t MB = 1u << 20;
constexpr size_t OFF_ADA = 0;
constexpr size_t OFF_POSB = 256 * 1024;
constexpr size_t OFF_BAR = 320 * 1024;
constexpr size_t OFF_MB0 = 168 * MB;
constexpr size_t OFF_MB1 = 172 * MB;
constexpr size_t OFF_H8 = 104 * MB;
constexpr size_t OFF_HS = 174 * MB;
constexpr size_t OFF_W8 = 176 * MB;
constexpr size_t OFF_W8_DIN = OFF_W8, OFF_W8_KV = OFF_W8 + 3 * MB, OFF_W8_NIN = OFF_W8 + 5 * MB, OFF_W8_PEER = OFF_W8 + 7 * MB;
constexpr size_t OFF_W8S = 188 * MB;
constexpr int W8S_DIN = 0, W8S_KV = 3072, W8S_NIN = 4608, W8S_PEER = 5760, W8S_TOTAL = 9856;
constexpr size_t OFF_USI = 384 * 1024;
constexpr size_t OFF_VSI = 512 * 1024;
constexpr size_t OFF_WT_DIN = 1 * MB;
constexpr size_t OFF_WT_DOUT = 7 * MB;
constexpr size_t OFF_WT_KV = 9 * MB;
constexpr size_t OFF_WT_NIN = 12 * MB;
constexpr size_t OFF_WT_NOUT = 15 * MB;
constexpr size_t OFF_WT_PEER = 17 * MB;
constexpr size_t OFF_WT_C1 = 25 * MB;
constexpr size_t OFF_WT_C2 = 29 * MB;
constexpr size_t OFF_GATES = 30 * MB;
constexpr size_t OFF_KCMP = 34 * MB;
constexpr size_t OFF_VCMPT = 35 * MB;
constexpr size_t OFF_HID = 36 * MB;
constexpr size_t OFF_RIDX = 40 * MB;
constexpr size_t OFF_RGATE = 56 * MB;
constexpr size_t OFF_PU = 72 * MB;
constexpr size_t OFF_PV = 136 * MB;
constexpr size_t OFF_H = 200 * MB;
constexpr size_t OFF_R = 264 * MB;
constexpr size_t WS_END = 456 * MB;
constexpr size_t OFF_Q0 = OFF_R, OFF_K0 = OFF_R + 64 * MB, OFF_VT0 = OFF_R + 128 * MB;
constexpr size_t OFF_QN = OFF_R, OFF_H2 = OFF_R, OFF_KC = OFF_R + 64 * MB, OFF_KS = OFF_R + 96 * MB, OFF_VST = OFF_R + 112 * MB,
                 OFF_KW = OFF_R + 128 * MB, OFF_VWT = OFF_R + 144 * MB;

constexpr int LDS_BYTES = 144 * 1024 + 256;

struct Params {
    const float* in[30];
    float* out;
    unsigned char* ws;
};

template <class T> DI T* opq(T* q) { asm volatile("" : "+s"(q)); return (T*)(__attribute__((address_space(1))) T*)q; }
DI unsigned pk2(float lo, float hi) { f32x2 v = {lo, hi}; return __builtin_bit_cast(unsigned, __builtin_convertvector(v, bf16x2v)); }
DI bf16_t f2bf(float x) { return (bf16_t)(pk2(x, 0.f) & 0xffffu); }
DI float bflo(unsigned u) { return __uint_as_float(u << 16); }
DI float bfhi(unsigned u) { return __uint_as_float(u & 0xffff0000u); }
DI float fexp2(float x) { return __builtin_amdgcn_exp2f(x); }
DI float frcp(float x) { return __builtin_amdgcn_rcpf(x); }
DI int crow(int reg, int h) { return (reg & 3) + 8 * (reg >> 2) + 4 * h; }
template <int CTRL> DI float dpp_f(float v) { return __builtin_bit_cast(float, __builtin_amdgcn_update_dpp(0, __builtin_bit_cast(int, v), CTRL, 0xF, 0xF, true)); }
DI float lx1(float v) { return dpp_f<0xB1>(v); }
DI float lx2(float v) { return dpp_f<0x4E>(v); }
DI float lhm(float v) { return dpp_f<0x141>(v); }
DI float lr8(float v) { return dpp_f<0x128>(v); }
DI float sum_x16(float v) { auto s = __builtin_amdgcn_permlane16_swap(__float_as_uint(v), __float_as_uint(v), false, false); return __uint_as_float(s[0]) + __uint_as_float(s[1]); }
DI float sum_x32(float v) { auto s = __builtin_amdgcn_permlane32_swap(__float_as_uint(v), __float_as_uint(v), false, false); return __uint_as_float(s[0]) + __uint_as_float(s[1]); }
DI float max_x16(float v) { auto s = __builtin_amdgcn_permlane16_swap(__float_as_uint(v), __float_as_uint(v), false, false); return fmaxf(__uint_as_float(s[0]), __uint_as_float(s[1])); }
DI float max_x32(float v) { auto s = __builtin_amdgcn_permlane32_swap(__float_as_uint(v), __float_as_uint(v), false, false); return fmaxf(__uint_as_float(s[0]), __uint_as_float(s[1])); }
DI unsigned get_x32(unsigned v, int h) { auto s = __builtin_amdgcn_permlane32_swap(v, v, false, false); return h ? s[0] : s[1]; }
DI float wave_sum(float v) { v += lx1(v); v += lx2(v); v += lhm(v); v += lr8(v); v = sum_x16(v); return sum_x32(v); }
DI float wave_max(float v) { v = fmaxf(v, lx1(v)); v = fmaxf(v, lx2(v)); v = fmaxf(v, lhm(v)); v = fmaxf(v, lr8(v)); v = max_x16(v); return max_x32(v); }
DI int bperm(int v, int srclane) { return __builtin_amdgcn_ds_bpermute(srclane << 2, v); }
DI float bpermf(float v, int srclane) { return __builtin_bit_cast(float, __builtin_amdgcn_ds_bpermute(srclane << 2, __builtin_bit_cast(int, v))); }
DI float gelu_tanh(float x) {
    const float u = 0.7978845608028654f * (x + 0.044715f * x * x * x);
    return x * frcp(1.f + fexp2(-2.f * LOG2E * u));
}
DI float dot2bf(unsigned a, unsigned b, float c) {
    return __builtin_amdgcn_fdot2_f32_bf16(__builtin_bit_cast(bf16x2v, a), __builtin_bit_cast(bf16x2v, b), c, false);
}
DI int rel_bucket_i(int d) {
    if (d < 16) return d < 0 ? 0 : d;
    int b = 16;
    b += d >= 21; b += d >= 27; b += d >= 35; b += d >= 46; b += d >= 59; b += d >= 77; b += d >= 99; b += d >= 128;
    b += d >= 166; b += d >= 216; b += d >= 280; b += d >= 363; b += d >= 470; b += d >= 609; b += d >= 790;
    return b;
}
DI unsigned f2key(float f) { unsigned u = __float_as_uint(f); return u ^ ((unsigned)((int)u >> 31) | 0x80000000u); }
DI float key2f(unsigned k) { unsigned u = (k & 0x80000000u) ? (k ^ 0x80000000u) : ~k; return __uint_as_float(u); }

constexpr int EPI_LDS = 96 * 1024;

DI int sw2(int row, int chunk) { return (row >> 1) * 256 + (((((row & 1) << 3) | chunk) ^ ((row >> 1) & 15)) << 4); }
DI void sw2_src(int P, int& row, int& chunk) { const int R2 = P >> 4, lc = (P & 15) ^ (R2 & 15); row = 2 * R2 + (lc >> 3); chunk = lc & 7; }

template <class T, class = void> struct epi_stash { static constexpr bool value = false, present = false; };
template <class T> struct epi_stash<T, decltype((void)T::STASH)> { static constexpr bool value = T::STASH, present = true; };

template <int MT, class Epi>
DI void gemm_tile(const bf16_t* __restrict__ A, long lda, int M, const bf16_t* __restrict__ Bt, long ldb, int N, int K,
                  int m0, int n0, const Epi& epi, unsigned char* lds, int tid) {
    constexpr int XS = MT * 128 * 128, WS = 256 * 128, STAGE = XS + WS;
    const int lane = tid & 63, w = tid >> 6, tg = w & 3, fh = w >> 2, r = lane & 31, h = lane >> 5;
    const int wbase = tid & ~63;
    unsigned xo[2 * MT], wo[4];
#pragma unroll
    for (int i = 0; i < 2 * MT; ++i) { int row, c; sw2_src(tid + 512 * i, row, c); int m = m0 + row; m = m < M ? m : M - 1; xo[i] = (unsigned)m * (unsigned)(lda * 2) + c * 16; }
#pragma unroll
    for (int i = 0; i < 4; ++i) { int row, c; sw2_src(tid + 512 * i, row, c); int n = n0 + row; n = n < N ? n : N - 1; wo[i] = (unsigned)n * (unsigned)(ldb * 2) + c * 16; }
    const unsigned char* Ab = (const unsigned char*)A;
    const unsigned char* Bb = (const unsigned char*)Bt;
    auto stage = [&](int kt, unsigned char* st) {
#pragma unroll
        for (int i = 0; i < 2 * MT; ++i)
            __builtin_amdgcn_global_load_lds((const unsigned*)(Ab + kt * 128 + xo[i]), (unsigned*)(st + (wbase + 512 * i) * 16), 16, 0, 0);
#pragma unroll
        for (int i = 0; i < 4; ++i)
            __builtin_amdgcn_global_load_lds((const unsigned*)(Bb + kt * 128 + wo[i]), (unsigned*)(st + XS + (wbase + 512 * i) * 16), 16, 0, 0);
    };
    f32x16 acc[MT][4];
#pragma unroll
    for (int s2 = 0; s2 < MT; ++s2)
#pragma unroll
        for (int i = 0; i < 4; ++i)
#pragma unroll
            for (int j = 0; j < 16; ++j) acc[s2][i][j] = 0.f;
    const int nk = K >> 6;
    stage(0, lds);
    __syncthreads();
    for (int kt = 0; kt < nk; ++kt) {
        unsigned char* cur = lds + (kt & 1) * STAGE;
        if (kt + 1 < nk) stage(kt + 1, lds + ((kt + 1) & 1) * STAGE);
        bf16x8 xfa[MT], wfa[4], xfb[MT], wfb[4];
        auto ldf = [&](bf16x8 (&xf)[MT], bf16x8 (&wf)[4], int ks) {
#pragma unroll
            for (int s2 = 0; s2 < MT; ++s2) xf[s2] = *(const bf16x8*)(cur + sw2(32 * MT * tg + 32 * s2 + r, 2 * ks + h));
#pragma unroll
            for (int mt = 0; mt < 4; ++mt) wf[mt] = *(const bf16x8*)(cur + XS + sw2(128 * fh + 32 * mt + r, 2 * ks + h));
        };
        auto mm = [&](const bf16x8 (&xf)[MT], const bf16x8 (&wf)[4]) {
#pragma unroll
            for (int mt = 0; mt < 4; ++mt)
#pragma unroll
                for (int s2 = 0; s2 < MT; ++s2) acc[s2][mt] = MFMA32(wf[mt], xf[s2], acc[s2][mt]);
        };
        ldf(xfa, wfa, 0);
        ldf(xfb, wfb, 1); __builtin_amdgcn_sched_barrier(0); mm(xfa, wfa); __builtin_amdgcn_sched_barrier(0);
        ldf(xfa, wfa, 2); __builtin_amdgcn_sched_barrier(0); mm(xfb, wfb); __builtin_amdgcn_sched_barrier(0);
        ldf(xfb, wfb, 3); __builtin_amdgcn_sched_barrier(0); mm(xfa, wfa); __builtin_amdgcn_sched_barrier(0);
        mm(xfb, wfb);
        __syncthreads();
    }
    if constexpr (MT == 2 && epi_stash<Epi>::value) {
        float* sp = (float*)lds + w * 4096 + lane;
#pragma unroll
        for (int mt = 0; mt < 4; ++mt)
#pragma unroll
            for (int j = 0; j < 16; ++j) sp[(mt * 16 + j) * 64] = acc[1][mt][j];
        epi(acc[0], m0 + 64 * tg + r, n0 + 128 * fh, h, lds, tid);
        f32x16 a2[4];
        const float* sp2 = sp; asm volatile("" : "+v"(sp2));
#pragma unroll
        for (int mt = 0; mt < 4; ++mt)
#pragma unroll
            for (int j = 0; j < 16; ++j) a2[mt][j] = sp2[(mt * 16 + j) * 64];
        epi(a2, m0 + 64 * tg + 32 + r, n0 + 128 * fh, h, lds, tid);
        __syncthreads();
    } else {
        int ho = h, ro = r, to = tid;
        if constexpr (epi_stash<Epi>::present) asm volatile("" : "+v"(ho), "+v"(ro), "+v"(to));
#pragma unroll
        for (int s2 = 0; s2 < MT; ++s2) epi(acc[s2], m0 + 32 * MT * tg + 32 * s2 + ro, n0 + 128 * fh, ho, lds, to);
    }
}

DI void store_vt_tile(bf16_t* base, long rstride, const f32x16& a, int row0, int h, int lane) {
    const bool odd = lane & 1;
#pragma unroll
    for (int rg = 0; rg < 16; rg += 2) {
        const float xa = lx1(a[rg]), xb = lx1(a[rg + 1]);
        const unsigned wv = odd ? pk2(xb, a[rg + 1]) : pk2(a[rg], xa);
        bf16_t* dp = base + (long)(row0 + crow(odd ? rg + 1 : rg, h)) * rstride - (odd ? 1 : 0);
        *(unsigned*)dp = wv;
    }
}
struct EpiQKV0 {
    bf16_t *Q, *Kk, *VT;
    const float *qg, *kg;
    float* MB; const float* relb;
    DI void operator()(const f32x16 (&acc)[4], int tok, int fbase, int h, unsigned char*, int) const {
        const int sec = fbase >> 10, hd = (fbase & 1023) >> 7, b = tok >> 13, s = tok & (SEQ - 1);
        if (sec < 2) {
            const float* gn = sec == 0 ? qg : kg;
            const float sc = sec == 0 ? 0.125f * LOG2E : 1.f;
            bf16_t* dst = sec == 0 ? Q : Kk;
#pragma unroll
            for (int j = 0; j < 2; ++j) {
                float ss = 0.f;
#pragma unroll
                for (int mt = 0; mt < 2; ++mt)
#pragma unroll
                    for (int rg = 0; rg < 16; ++rg) { const float v = acc[2 * j + mt][rg]; ss += v * v; }
                ss = sum_x32(ss);
                const float rstd = rsqrtf(ss * (1.f / 64.f) + EPS) * sc;
                bf16_t* row = dst + ((long)((b * 8 + hd) * 2 + j) * SEQ + s) * 64;
                float qq = 0.f;
#pragma unroll
                for (int mt = 0; mt < 2; ++mt)
#pragma unroll
                    for (int g4 = 0; g4 < 4; ++g4) {
                        const int d0 = 32 * mt + 8 * g4 + 4 * h;
                        const f32x4 gv = *(const f32x4*)(gn + d0);
                        const float v0 = acc[2 * j + mt][4 * g4 + 0] * rstd * gv.x, v1 = acc[2 * j + mt][4 * g4 + 1] * rstd * gv.y;
                        const float v2 = acc[2 * j + mt][4 * g4 + 2] * rstd * gv.z, v3 = acc[2 * j + mt][4 * g4 + 3] * rstd * gv.w;
                        qq += v0 * v0 + v1 * v1 + v2 * v2 + v3 * v3;
                        u32x2 o;
                        o.x = pk2(v0, v1); o.y = pk2(v2, v3);
                        *(u32x2*)(row + d0) = o;
                    }
                if (sec == 0) {
                    qq = sum_x32(qq);
                    float kmx = 0.f;
                    for (int d = 0; d < 64; ++d) kmx = fmaxf(kmx, fabsf(kg[d]));
                    float bmx = 0.f;
                    for (int bk = 0; bk < 32; ++bk) bmx = fmaxf(bmx, relb[bk * 8 + hd] - relb[31 * 8 + hd]);
                    if (h == 0) MB[(long)((b * 8 + hd) * 2 + j) * SEQ + s] = 1.01f * sqrtf(qq) * 8.f * kmx + bmx * LOG2E;
                }
            }
        } else {
            bf16_t* base = VT + (long)(b * 8 + hd) * 128 * SEQ + s;
#pragma unroll
            for (int mt = 0; mt < 4; ++mt) store_vt_tile(base, SEQ, acc[mt], 32 * mt, h, tok);
        }
    }
};

struct EpiResid {
    const float* xin; float* xout; const float* gate;
    DI void operator()(const f32x16 (&acc)[4], int tok, int fbase, int h, unsigned char*, int) const {
        const int b = tok >> 13;
        const float* gp = gate + b * ADA_STRIDE;
#pragma unroll
        for (int mt = 0; mt < 4; ++mt)
#pragma unroll
            for (int g4 = 0; g4 < 4; ++g4) {
                const int f = fbase + 32 * mt + 8 * g4 + 4 * h;
                const f32x4 xv = *(const f32x4*)(xin + (long)tok * DM + f);
                const f32x4 gv = *(const f32x4*)(gp + f);
                f32x4 o;
                o.x = xv.x + gv.x * acc[mt][4 * g4 + 0]; o.y = xv.y + gv.y * acc[mt][4 * g4 + 1];
                o.z = xv.z + gv.z * acc[mt][4 * g4 + 2]; o.w = xv.w + gv.w * acc[mt][4 * g4 + 3];
                *(f32x4*)(xout + (long)tok * DM + f) = o;
                if (g4 == 3) __builtin_amdgcn_sched_barrier(0);
            }
    }
};

struct EpiKV {
    bf16_t *KC, *KS, *VST, *KW, *VWT;
    const float* kgain;
    DI void operator()(const f32x16 (&acc)[4], int tok, int fbase, int h, unsigned char*, int) const {
        const int c = fbase >> 7, br = c >> 2, kv = (c >> 1) & 1, g = c & 1, b = tok >> 13, s = tok & (SEQ - 1);
        if (br == 0 || kv == 0) {
            float rstd = 1.f;
            bf16_t* row;
            if (br == 0) row = KC + ((long)((kv * 4 + b) * 2 + g) * SEQ + s) * 128;
            else {
                float ss = 0.f;
#pragma unroll
                for (int mt = 0; mt < 4; ++mt)
#pragma unroll
                    for (int rg = 0; rg < 16; ++rg) ss += acc[mt][rg] * acc[mt][rg];
                ss = sum_x32(ss);
                rstd = rsqrtf(ss * (1.f / 128.f) + EPS);
                row = (br == 1 ? KS : KW) + ((long)(b * 2 + g) * SEQ + s) * 128;
            }
#pragma unroll
            for (int mt = 0; mt < 4; ++mt)
#pragma unroll
                for (int g4 = 0; g4 < 4; ++g4) {
                    const int d0 = 32 * mt + 8 * g4 + 4 * h;
                    f32x4 gv = {1.f, 1.f, 1.f, 1.f};
                    if (br != 0) gv = *(const f32x4*)(kgain + br * 128 + d0);
                    u32x2 o;
                    o.x = pk2(acc[mt][4 * g4 + 0] * rstd * gv.x, acc[mt][4 * g4 + 1] * rstd * gv.y);
                    o.y = pk2(acc[mt][4 * g4 + 2] * rstd * gv.z, acc[mt][4 * g4 + 3] * rstd * gv.w);
                    *(u32x2*)(row + d0) = o;
                }
        } else {
            bf16_t* base = (br == 1 ? VST : VWT) + (long)(b * 2 + g) * 128 * SEQ + s;
#pragma unroll
            for (int mt = 0; mt < 4; ++mt) store_vt_tile(base, SEQ, acc[mt], 32 * mt, h, tok);
        }
    }
};

struct EpiCmp1 {
    bf16_t* hid; const float* posb_part; const float* b1;
    DI void operator()(const f32x16 (&acc)[4], int tok, int fbase, int h, unsigned char*, int) const {
        if (tok >= 512) return;
#pragma unroll
        for (int mt = 0; mt < 4; ++mt)
#pragma unroll
            for (int g4 = 0; g4 < 4; ++g4) {
                const int f = fbase + 32 * mt + 8 * g4 + 4 * h;
                f32x4 pb = *(const f32x4*)(b1 + f);
                for (int c = 0; c < 16; ++c) { const f32x4 t = *(const f32x4*)(posb_part + c * 256 + f); pb.x += t.x; pb.y += t.y; pb.z += t.z; pb.w += t.w; }
                u32x2 o;
                o.x = pk2(gelu_tanh(acc[mt][4 * g4 + 0] + pb.x), gelu_tanh(acc[mt][4 * g4 + 1] + pb.y));
                o.y = pk2(gelu_tanh(acc[mt][4 * g4 + 2] + pb.z), gelu_tanh(acc[mt][4 * g4 + 3] + pb.w));
                *(u32x2*)(hid + (long)tok * 256 + f) = o;
            }
    }
};

struct EpiCmp2 {
    bf16_t* dst; const float* kgain0; int kv;
    DI void operator()(const f32x16 (&acc)[4], int tok, int fbase, int h, unsigned char*, int) const {
        if (fbase != 0 || tok >= 512) return;
        const float valid = tok < 511 ? 1.f : 0.f;
        if (kv == 0) {
            float ss = 0.f;
#pragma unroll
            for (int mt = 0; mt < 4; ++mt)
#pragma unroll
                for (int rg = 0; rg < 16; ++rg) ss += acc[mt][rg] * acc[mt][rg];
            ss = sum_x32(ss);
            const float rstd = rsqrtf(ss * (1.f / 128.f) + EPS) * valid;
#pragma unroll
            for (int mt = 0; mt < 4; ++mt)
#pragma unroll
                for (int g4 = 0; g4 < 4; ++g4) {
                    const int d0 = 32 * mt + 8 * g4 + 4 * h;
                    const f32x4 gv = *(const f32x4*)(kgain0 + d0);
                    u32x2 o;
                    o.x = pk2(acc[mt][4 * g4 + 0] * rstd * gv.x, acc[mt][4 * g4 + 1] * rstd * gv.y);
                    o.y = pk2(acc[mt][4 * g4 + 2] * rstd * gv.z, acc[mt][4 * g4 + 3] * rstd * gv.w);
                    *(u32x2*)(dst + (long)tok * 128 + d0) = o;
                }
        } else {
#pragma unroll
            for (int mt = 0; mt < 4; ++mt)
#pragma unroll
                for (int rg = 0; rg < 16; ++rg) dst[(long)(32 * mt + crow(rg, h)) * 512 + tok] = f2bf(acc[mt][rg] * valid);
        }
    }
};

struct EpiNsaQ {
    bf16_t* QN; float* gates; const float* qgain; const float* bgate; float* qnrm;
    DI void operator()(const f32x16 (&acc)[4], int tok, int fbase, int h, unsigned char*, int) const {
        const int b = tok >> 13, s = tok & (SEQ - 1);
        if (fbase < 1024) {
            const int head = fbase >> 7;
            float ss = 0.f;
#pragma unroll
            for (int mt = 0; mt < 4; ++mt)
#pragma unroll
                for (int rg = 0; rg < 16; ++rg) ss += acc[mt][rg] * acc[mt][rg];
            ss = sum_x32(ss);
            const float rstd = rsqrtf(ss * (1.f / 128.f) + EPS) * (0.08838834764831845f * LOG2E);
            bf16_t* row = QN + ((long)(b * 8 + head) * SEQ + s) * 128;
            float qq = 0.f;
#pragma unroll
            for (int mt = 0; mt < 4; ++mt)
#pragma unroll
                for (int g4 = 0; g4 < 4; ++g4) {
                    const int d0 = 32 * mt + 8 * g4 + 4 * h;
                    const f32x4 gv = *(const f32x4*)(qgain + d0);
                    const float v0 = acc[mt][4 * g4 + 0] * rstd * gv.x, v1 = acc[mt][4 * g4 + 1] * rstd * gv.y;
                    const float v2 = acc[mt][4 * g4 + 2] * rstd * gv.z, v3 = acc[mt][4 * g4 + 3] * rstd * gv.w;
                    qq += v0 * v0 + v1 * v1 + v2 * v2 + v3 * v3;
                    u32x2 o;
                    o.x = pk2(v0, v1); o.y = pk2(v2, v3);
                    *(u32x2*)(row + d0) = o;
                }
            qq = sum_x32(qq);
            if (h == 0) qnrm[(long)tok * 8 + head] = 1.01f * sqrtf(qq);
        } else if (fbase == 1024) {
#pragma unroll
            for (int rg = 0; rg < 16; ++rg) {
                const int f = crow(rg, h);
                if (f < 24) { const float z = acc[0][rg] + bgate[f]; gates[(long)tok * 24 + f] = frcp(1.f + fexp2(-LOG2E * z)); }
            }
        }
    }
};

DI void ce_desc(unsigned& a, unsigned& b) { const unsigned hi = a > b ? a : b, lo = a > b ? b : a; a = hi; b = lo; }
DI void sort16_desc(unsigned (&a)[16]) {
#pragma unroll
    for (int k = 2; k <= 16; k <<= 1)
#pragma unroll
        for (int j = k >> 1; j > 0; j >>= 1)
#pragma unroll
            for (int i = 0; i < 16; ++i) {
                const int l = i ^ j;
                if (l > i) { if ((i & k) == 0 || k == 16) ce_desc(a[i], a[l]); else ce_desc(a[l], a[i]); }
            }
}
DI void bitonic_merge16_desc(unsigned (&a)[16]) {
#pragma unroll
    for (int st = 8; st >= 1; st >>= 1)
#pragma unroll
        for (int i = 0; i < 16; ++i)
            if ((i & st) == 0) ce_desc(a[i], a[i + st]);
}
DI void merge_top16(unsigned (&a)[16], const unsigned (&b)[16]) {
#pragma unroll
    for (int i = 0; i < 16; ++i) a[i] = a[i] > b[15 - i] ? a[i] : b[15 - i];
    bitonic_merge16_desc(a);
}

struct EpiPeer {
    static constexpr bool STASH = false;
    int* ridx; float* rgate; int ex_off;
    DI void operator()(const f32x16 (&acc)[4], int tok, int fbase, int h, unsigned char* lds, int tid) const {
        const int lane = tid & 63, w = tid >> 6, tg = w & 3, fh = w >> 2, r = lane & 31;
        const int hd = fbase >> 8;
        unsigned* EX = (unsigned*)(lds + ex_off);
        unsigned L[16];
        {
            unsigned G1[16], G2[16], G3[16];
#pragma unroll
            for (int rg = 0; rg < 16; ++rg) {
                const int c = crow(rg, h);
                L[rg] = (f2key(acc[0][rg]) & ~127u) | (unsigned)(127 - c);
                G1[rg] = (f2key(acc[1][rg]) & ~127u) | (unsigned)(127 - 32 - c);
                G2[rg] = (f2key(acc[2][rg]) & ~127u) | (unsigned)(127 - 64 - c);
                G3[rg] = (f2key(acc[3][rg]) & ~127u) | (unsigned)(127 - 96 - c);
            }
            sort16_desc(L); sort16_desc(G1); merge_top16(L, G1);
            sort16_desc(G2); sort16_desc(G3); merge_top16(G2, G3);
            merge_top16(L, G2);
        }
        {
            unsigned P[16];
#pragma unroll
            for (int i = 0; i < 16; ++i) P[i] = get_x32(L[i], h);
            merge_top16(L, P);
        }
        if (h == 0) {
#pragma unroll
            for (int i = 0; i < 16; i += 4) *(u32x4*)(EX + ((fh * 4 + tg) * 32 + r) * 16 + i) = (u32x4){L[i], L[i + 1], L[i + 2], L[i + 3]};
        }
        __syncthreads();
        float xf[4], ys[16];
        {
            const unsigned* l0 = EX + ((0 * 4 + tg) * 32 + r) * 16;
            const unsigned* l1 = EX + ((1 * 4 + tg) * 32 + r) * 16;
            const unsigned* px = h ? l1 : l0;
            const unsigned* py = h ? l0 : l1;
            const u32x4 a = *(const u32x4*)px;
            xf[0] = key2f(a.x & ~127u); xf[1] = key2f(a.y & ~127u); xf[2] = key2f(a.z & ~127u); xf[3] = key2f(a.w & ~127u);
            unsigned Y[16];
#pragma unroll
            for (int i = 0; i < 16; i += 4) { const u32x4 b2 = *(const u32x4*)(py + i); Y[i] = b2.x; Y[i + 1] = b2.y; Y[i + 2] = b2.z; Y[i + 3] = b2.w; }
#pragma unroll
            for (int k = 0; k < 15; ++k) ys[k] = key2f((h ? Y[k + 1] : Y[k]) & ~127u);
            ys[15] = key2f(Y[15] & ~127u);
        }
        auto pkey = [&](int i, int k) -> unsigned {
            const float fs = xf[i] + ys[k];
            const unsigned code = h ? (unsigned)((((k + 1) & 15) << 4) | i) : (unsigned)((i << 4) | k);
            return (f2key(fs) & ~255u) | (255u - code);
        };
        unsigned T[16], E[16];
#pragma unroll
        for (int k = 0; k < 16; ++k) T[k] = pkey(0, k);
        T[15] = h ? 0u : T[15];
#pragma unroll
        for (int k = 1; k <= 7; ++k) E[k - 1] = pkey(1, k);
#pragma unroll
        for (int k = 2; k <= 4; ++k) E[7 + k - 2] = pkey(2, k);
        E[10] = pkey(3, 3);
#pragma unroll
        for (int k = 11; k < 16; ++k) E[k] = 0u;
        sort16_desc(E);
        merge_top16(T, E);
        {
            unsigned P[16];
#pragma unroll
            for (int i = 0; i < 16; ++i) P[i] = get_x32(T[i], h);
            merge_top16(T, P);
        }
        float sc[16], sum = 0.f;
        const float mx = key2f(T[0] & ~255u);
#pragma unroll
        for (int k = 0; k < 16; ++k) { sc[k] = fexp2((key2f(T[k] & ~255u) - mx) * LOG2E); sum += sc[k]; }
        const float inv = frcp(sum);
        if (h == 0) {
            const unsigned* l0 = EX + ((0 * 4 + tg) * 32 + r) * 16;
            const unsigned* l1 = EX + ((1 * 4 + tg) * 32 + r) * 16;
#pragma unroll
            for (int k = 0; k < 16; ++k) {
                if ((k >> 3) != fh) continue;
                const unsigned code = 255u - (T[k] & 255u);
                const int i1 = 127 - (int)(l0[code >> 4] & 127u), i2 = 127 - (int)(l1[code & 15u] & 127u);
                ridx[(long)tok * 128 + hd * 16 + k] = i1 * 128 + i2;
                rgate[(long)tok * 128 + hd * 16 + k] = sc[k] * inv;
            }
        }
        __syncthreads();
    }
};

DI void p0_transpose_item(const float* __restrict__ W, int K, int N, bf16_t* __restrict__ WT, int item, int ntn, unsigned char* lds, int tid) {
    float* tile = (float*)lds;
    const int kb = item / ntn, nb = item % ntn, k0 = kb * 64, n0 = nb * 64;
    {
        const int nn = tid & 63, kk0 = tid >> 6;
#pragma unroll
        for (int i = 0; i < 8; ++i) { const int kk = kk0 + 8 * i; const int n = n0 + nn; tile[kk * 65 + nn] = n < N ? W[(long)(k0 + kk) * N + n] : 0.f; }
    }
    __syncthreads();
    {
        const int n = tid >> 3, c = tid & 7;
        const float* s = tile + (8 * c) * 65 + n;
        u32x4 o;
        o.x = pk2(s[0], s[65]); o.y = pk2(s[2 * 65], s[3 * 65]); o.z = pk2(s[4 * 65], s[5 * 65]); o.w = pk2(s[6 * 65], s[7 * 65]);
        *(u32x4*)(WT + (long)(n0 + n) * K + k0 + 8 * c) = o;
    }
    __syncthreads();
}

DI int pack_i8x4(float a, float b, float c, float d) {
    const int ia = __float2int_rn(a), ib = __float2int_rn(b), ic = __float2int_rn(c), id = __float2int_rn(d);
    return (ia & 255) | ((ib & 255) << 8) | ((ic & 255) << 16) | (id << 24);
}
DI void p0_fp8_item(const float* __restrict__ src, unsigned char* __restrict__ dst, float* __restrict__ sinv, bool sliced, int item, int tid) {
    const int lane = tid & 63, row = item * 8 + (tid >> 6);
    const float* rp = src + (long)row * 1024;
    f32x4 v[4]; float am = 0.f;
#pragma unroll
    for (int j = 0; j < 4; ++j) {
        v[j] = *(const f32x4*)(rp + 4 * lane + 256 * j);
        am = fmaxf(am, fmaxf(fmaxf(fabsf(v[j].x), fabsf(v[j].y)), fmaxf(fabsf(v[j].z), fabsf(v[j].w))));
    }
    am = wave_max(am);
    const float sc = sliced ? (am > 0.f ? exp2f(floorf(log2f(384.f / am))) : 1.f) : (am > 0.f ? 127.f / am : 1.f);
    if (lane == 0) sinv[row] = 1.f / sc;
#pragma unroll
    for (int j = 0; j < 4; ++j) {
        int pk = 0;
        if (sliced) {
            pk = __builtin_amdgcn_cvt_pk_fp8_f32(v[j].x * sc, v[j].y * sc, pk, false);
            pk = __builtin_amdgcn_cvt_pk_fp8_f32(v[j].z * sc, v[j].w * sc, pk, true);
        } else pk = pack_i8x4(v[j].x * sc, v[j].y * sc, v[j].z * sc, v[j].w * sc);
        const int col = 4 * lane + 256 * j;
        unsigned char* d = sliced ? dst + ((long)(col >> 7) * 16384 + row) * 128 + (col & 127) : dst + (long)row * 1024 + col;
        *(int*)d = pk;
    }
}

DI void p0_weff_item(const float* __restrict__ wq, const float* __restrict__ subk, bf16_t* __restrict__ WT, int item, unsigned char* lds, int tid) {
    const int layer = item >> 8, g = (item >> 4) & 15, ct = item & 15, p = g & 1, c0 = ct * 64;
    float* As = (float*)lds;
    float* Bs = As + 64 * 129;
    const float* wql = wq + (long)layer * 1024 * 2048;
    const float* sk = subk + ((long)layer * 2 + p) * 128 * 128;
    for (int e = tid; e < 64 * 128; e += NTHREADS) { const int c = e >> 7, d = e & 127; As[c * 129 + d] = wql[(long)(c0 + c) * 2048 + g * 128 + d]; }
    for (int e = tid; e < 128 * 128; e += NTHREADS) { const int k = e >> 7, d = e & 127; Bs[k * 129 + d] = sk[k * 128 + d]; }
    __syncthreads();
    const int k = tid & 127, cg4 = tid >> 7;
    float acc[16];
#pragma unroll
    for (int i = 0; i < 16; ++i) acc[i] = 0.f;
    for (int d = 0; d < 128; ++d) {
        const float bv = Bs[k * 129 + d];
#pragma unroll
        for (int i = 0; i < 16; ++i) acc[i] += As[(cg4 * 16 + i) * 129 + d] * bv;
    }
    bf16_t* o = WT + ((long)layer * 2048 + g * 128 + k) * 1024 + c0 + cg4 * 16;
    u32x4 o0, o1;
    o0.x = pk2(acc[0], acc[1]); o0.y = pk2(acc[2], acc[3]); o0.z = pk2(acc[4], acc[5]); o0.w = pk2(acc[6], acc[7]);
    o1.x = pk2(acc[8], acc[9]); o1.y = pk2(acc[10], acc[11]); o1.z = pk2(acc[12], acc[13]); o1.w = pk2(acc[14], acc[15]);
    *(u32x4*)o = o0; *(u32x4*)(o + 8) = o1;
    __syncthreads();
}

DI void p0_posb_item(const float* __restrict__ pos, const float* __restrict__ w1, float* __restrict__ part, int item, unsigned char* lds, int tid) {
    const int kv = item >> 4, ch = item & 15;
    float* red = (float*)lds;
    const int j = tid & 255, half = tid >> 8;
    const float* pp = pos + (long)kv * 4096 + ch * 256 + half * 128;
    const float* ww = w1 + ((long)kv * 4096 + ch * 256 + half * 128) * 256 + j;
    float a = 0.f;
    for (int f = 0; f < 128; ++f) a += pp[f] * ww[(long)f * 256];
    red[half * 256 + j] = a;
    __syncthreads();
    if (tid < 256) part[(kv * 16 + ch) * 256 + tid] = red[tid] + red[256 + tid];
    __syncthreads();
}

DI void p0_ada_item(const Params& p, float* __restrict__ ada, int item, unsigned char* lds, int tid) {
    float* cact = (float*)lds;
    float* red = cact + 4096;
    const float* c = p.in[1];
    for (int e = tid; e < 4096; e += NTHREADS) { const float v = c[e]; cact[e] = v * frcp(1.f + fexp2(-LOG2E * v)); }
    __syncthreads();
    const int colg = item * 64;
    const float* W; const float* bias; int N, n0;
    if (colg < 6144) { W = p.in[3]; bias = p.in[4]; N = 6144; n0 = colg; }
    else if (colg < 12288) { W = p.in[3] + (long)1024 * 6144; bias = p.in[4] + 6144; N = 6144; n0 = colg - 6144; }
    else { W = p.in[14]; bias = p.in[15]; N = 2048; n0 = colg - 12288; }
    const int col = tid & 63, kg = tid >> 6;
    float a0 = 0.f, a1 = 0.f, a2 = 0.f, a3 = 0.f;
    const float* wp = W + (long)(kg * 128) * N + n0 + col;
#pragma unroll 8
    for (int k = 0; k < 128; ++k) {
        const float wv = wp[(long)k * N];
        const int kk = kg * 128 + k;
        a0 += cact[kk] * wv; a1 += cact[1024 + kk] * wv; a2 += cact[2048 + kk] * wv; a3 += cact[3072 + kk] * wv;
    }
    red[(kg * 4 + 0) * 64 + col] = a0; red[(kg * 4 + 1) * 64 + col] = a1; red[(kg * 4 + 2) * 64 + col] = a2; red[(kg * 4 + 3) * 64 + col] = a3;
    __syncthreads();
    if (tid < 256) {
        const int b = tid >> 6, cc = tid & 63;
        float s = bias[n0 + cc];
#pragma unroll
        for (int q = 0; q < 8; ++q) s += red[(q * 4 + b) * 64 + cc];
        ada[b * ADA_STRIDE + colg + cc] = s;
    }
    __syncthreads();
}

constexpr int P0_CONV = 8192, P0_TR_DIN = 768, P0_TR_DOUT = 256, P0_TR_KV = 384, P0_TR_NIN = 288, P0_TR_NOUT = 256, P0_TR_C1 = 512, P0_TR_C2 = 16,
              P0_WEFF = 512, P0_POSB = 32, P0_ADA = 224;
constexpr int P0_TOTAL = P0_CONV + P0_TR_DIN + P0_TR_DOUT + P0_TR_KV + P0_TR_NIN + P0_TR_NOUT + P0_TR_C1 + P0_TR_C2 + P0_WEFF + P0_POSB + P0_ADA;

DI void phase_prep(const Params& p, unsigned char* lds, int tid) {
    unsigned char* ws = p.ws;
    for (int it = blockIdx.x; it < P0_TOTAL; it += gridDim.x) {
        int r = it;
        if (r < P0_ADA) { p0_ada_item(p, (float*)(ws + OFF_ADA), r, lds, tid); continue; } r -= P0_ADA;
        if (r < P0_WEFF) { p0_weff_item(p.in[26], p.in[27], (bf16_t*)(ws + OFF_WT_PEER), r, lds, tid); continue; } r -= P0_WEFF;
        if (r < P0_POSB) { p0_posb_item(p.in[17], p.in[18], (float*)(ws + OFF_POSB), r, lds, tid); continue; } r -= P0_POSB;
        if (r < P0_TR_DIN) { p0_transpose_item(p.in[7], 1024, 3072, (bf16_t*)(ws + OFF_WT_DIN), r, 48, lds, tid); continue; } r -= P0_TR_DIN;
        if (r < P0_TR_DOUT) { p0_transpose_item(p.in[8], 1024, 1024, (bf16_t*)(ws + OFF_WT_DOUT), r, 16, lds, tid); continue; } r -= P0_TR_DOUT;
        if (r < P0_TR_KV) { p0_transpose_item(p.in[16], 1024, 1536, (bf16_t*)(ws + OFF_WT_KV), r, 24, lds, tid); continue; } r -= P0_TR_KV;
        if (r < P0_TR_NIN) { p0_transpose_item(p.in[22], 1024, 1048, (bf16_t*)(ws + OFF_WT_NIN), r, 18, lds, tid); continue; } r -= P0_TR_NIN;
        if (r < P0_TR_NOUT) { p0_transpose_item(p.in[24], 1024, 1024, (bf16_t*)(ws + OFF_WT_NOUT), r, 16, lds, tid); continue; } r -= P0_TR_NOUT;
        if (r < P0_TR_C1) { const int kv = r >> 8; p0_transpose_item(p.in[18] + (long)kv * 4096 * 256, 4096, 256, (bf16_t*)(ws + OFF_WT_C1) + (long)kv * 256 * 4096, r & 255, 4, lds, tid); continue; } r -= P0_TR_C1;
        if (r < P0_TR_C2) { const int kv = r >> 3; p0_transpose_item(p.in[20] + (long)kv * 256 * 128, 256, 128, (bf16_t*)(ws + OFF_WT_C2) + (long)kv * 128 * 256, r & 7, 2, lds, tid); continue; } r -= P0_TR_C2;
        {
            const int tbl = r >> 11, sub = r & 2047;
            const int layer = tbl & 1;
            const float* src = (tbl < 2 ? p.in[28] : p.in[29]) + (long)layer * 16384 * 1024;
            unsigned char* dst = ws + (tbl < 2 ? OFF_PU : OFF_PV) + (long)layer * 16384 * 1024;
            float* sinv = (float*)(ws + (tbl < 2 ? OFF_USI : OFF_VSI)) + layer * 16384;
            p0_fp8_item(src, dst, sinv, tbl >= 2, sub, tid);
        }
    }
}

DI void norm_row_write(const f32x4 (&v)[4], float rstd, const float* gain, const float* shift, const float* scale, bf16_t* orow, int lane) {
#pragma unroll
    for (int j = 0; j < 4; ++j) {
        const int c = 4 * lane + 256 * j;
        const f32x4 g = *(const f32x4*)(gain + c), sh = *(const f32x4*)(shift + c), sc = *(const f32x4*)(scale + c);
        u32x2 o;
        o.x = pk2(v[j].x * rstd * g.x * (1.f + sc.x) + sh.x, v[j].y * rstd * g.y * (1.f + sc.y) + sh.y);
        o.y = pk2(v[j].z * rstd * g.z * (1.f + sc.z) + sh.z, v[j].w * rstd * g.w * (1.f + sc.w) + sh.w);
        *(u32x2*)(orow + c) = o;
    }
}
template <bool BF>
DI void phase_norm_q8(const float* __restrict__ x, bf16_t* __restrict__ out, unsigned char* __restrict__ out8, float* __restrict__ outs,
                      const float* gain, const float* ada, int shift_off, int scale_off, int tid) {
    const int lane = tid & 63, gw = blockIdx.x * NWAVES + (tid >> 6), nw = gridDim.x * NWAVES;
    for (int tok = gw; tok < NTOK; tok += nw) {
        const int b = tok >> 13;
        f32x4 v[4]; float ss = 0.f;
#pragma unroll
        for (int j = 0; j < 4; ++j) { v[j] = *(const f32x4*)(x + (long)tok * DM + 4 * lane + 256 * j); ss += v[j].x * v[j].x + v[j].y * v[j].y + v[j].z * v[j].z + v[j].w * v[j].w; }
        const float rstd = rsqrtf(wave_sum(ss) * (1.f / DM) + EPS);
        const float* shift = ada + b * ADA_STRIDE + shift_off; const float* scale = ada + b * ADA_STRIDE + scale_off;
        float am = 0.f;
#pragma unroll
        for (int j = 0; j < 4; ++j) {
            const int c = 4 * lane + 256 * j;
            const f32x4 g = *(const f32x4*)(gain + c), sh = *(const f32x4*)(shift + c), sc = *(const f32x4*)(scale + c);
            v[j].x = v[j].x * rstd * g.x * (1.f + sc.x) + sh.x; v[j].y = v[j].y * rstd * g.y * (1.f + sc.y) + sh.y;
            v[j].z = v[j].z * rstd * g.z * (1.f + sc.z) + sh.z; v[j].w = v[j].w * rstd * g.w * (1.f + sc.w) + sh.w;
            if constexpr (BF) { u32x2 o; o.x = pk2(v[j].x, v[j].y); o.y = pk2(v[j].z, v[j].w); *(u32x2*)(out + (long)tok * DM + c) = o; }
            am = fmaxf(am, fmaxf(fmaxf(fabsf(v[j].x), fabsf(v[j].y)), fmaxf(fabsf(v[j].z), fabsf(v[j].w))));
        }
        am = wave_max(am);
        const float qs = am > 0.f ? 127.f / am : 1.f;
#pragma unroll
        for (int j = 0; j < 4; ++j) *(int*)(out8 + (long)tok * DM + 4 * lane + 256 * j) = pack_i8x4(v[j].x * qs, v[j].y * qs, v[j].z * qs, v[j].w * qs);
        if (lane == 0) outs[tok] = am > 0.f ? am * (1.f / 127.f) : 1.f;
    }
}
DI void phase_norm(const float* __restrict__ x, bf16_t* __restrict__ out, const float* gain, const float* ada, int shift_off, int scale_off, int tid) {
    const int lane = tid & 63, gw = blockIdx.x * NWAVES + (tid >> 6), nw = gridDim.x * NWAVES;
    for (int tok = gw; tok < NTOK; tok += nw) {
        const int b = tok >> 13;
        f32x4 v[4]; float ss = 0.f;
#pragma unroll
        for (int j = 0; j < 4; ++j) { v[j] = *(const f32x4*)(x + (long)tok * DM + 4 * lane + 256 * j); ss += v[j].x * v[j].x + v[j].y * v[j].y + v[j].z * v[j].z + v[j].w * v[j].w; }
        const float rstd = rsqrtf(wave_sum(ss) * (1.f / DM) + EPS);
        norm_row_write(v, rstd, gain, ada + b * ADA_STRIDE + shift_off, ada + b * ADA_STRIDE + scale_off, out + (long)tok * DM, lane);
    }
}

DI int kidx(int mt, int i) { return 32 * mt + 16 * (i >> 3) + (i & 7); }
template <int DQK>
DI void attn_qk32(const unsigned char* Ks, const bf16x8 (&qf)[DQK / 16], f32x16& st, int mt, int r, int h, float init = 0.f) {
    constexpr int RB = DQK * 2, MSK = DQK == 64 ? 7 : 15;
    const int row = 32 * mt + ((r & 0x13) | ((r & 4) << 1) | ((r & 8) >> 1));
#pragma unroll
    for (int i = 0; i < 16; ++i) st[i] = init;
#pragma unroll
    for (int ks = 0; ks < DQK / 16; ++ks) {
        const bf16x8 kf = RB == 128 ? *(const bf16x8*)(Ks + sw2(row, 2 * ks + h)) : *(const bf16x8*)(Ks + row * RB + (((2 * ks + h) ^ (row & MSK)) << 4));
        st = MFMA32(kf, qf[ks], st);
    }
}
DI void attn_pack32(const f32x16& st, bf16x8 (&pf)[2]) {
#pragma unroll
    for (int s = 0; s < 2; ++s) {
        u32x4 t;
        t.x = pk2(st[8 * s + 0], st[8 * s + 1]); t.y = pk2(st[8 * s + 2], st[8 * s + 3]);
        t.z = pk2(st[8 * s + 4], st[8 * s + 5]); t.w = pk2(st[8 * s + 6], st[8 * s + 7]);
        pf[s] = __builtin_bit_cast(bf16x8, t);
    }
}
DI void attn_softmax32(f32x16& st, float& m, float& l, f32x16 (&o)[4]) {
    float mx = st[0];
#pragma unroll
    for (int i = 1; i < 16; ++i) mx = fmaxf(mx, st[i]);
    mx = max_x32(mx);
    const float mn = fmaxf(m, mx);
    if (!__all(mn == m)) {
        const float alpha = fexp2(m - mn);
        l *= alpha;
#pragma unroll
        for (int dt = 0; dt < 4; ++dt)
#pragma unroll
            for (int i = 0; i < 16; ++i) o[dt][i] *= alpha;
        m = mn;
    }
    float sum = 0.f;
#pragma unroll
    for (int i = 0; i < 16; ++i) { const float pv = fexp2(st[i] - m); st[i] = pv; sum += pv; }
    l += sum;
}
DI void attn_softmax32_b(f32x16& st, float& l) {
    float sum = 0.f;
#pragma unroll
    for (int i = 0; i < 16; ++i) { const float pv = fexp2(st[i]); st[i] = pv; sum += pv; }
    l += sum;
}
DI void attn_pv32(const unsigned char* Vs, const bf16x8 (&pf)[2], f32x16 (&o)[4], int mt, int r, int h) {
#pragma unroll
    for (int dt = 0; dt < 4; ++dt)
#pragma unroll
        for (int s2 = 0; s2 < 2; ++s2) {
            const int row = 32 * dt + r;
            const bf16x8 vf = *(const bf16x8*)(Vs + sw2(row, 2 * (2 * mt + s2) + h));
            o[dt] = MFMA32(vf, pf[s2], o[dt]);
        }
}
template <int RB, int NROWS>
DI void dma_offsets(unsigned (&off)[NROWS * RB / 16 / 512], unsigned gstride, int tid) {
    constexpr int CPR = RB / 16;
#pragma unroll
    for (int i = 0; i < NROWS * CPR / 512; ++i) {
        const int idx = tid + 512 * i;
        int row, cp;
        if (RB == 128) sw2_src(idx, row, cp); else { row = idx / CPR; cp = (idx % CPR) ^ (row & (CPR - 1)); }
        off[i] = (unsigned)row * gstride + (cp << 4);
    }
}
template <int N>
DI void dma_issue(unsigned char* dst, const unsigned char* gbase, const unsigned (&off)[N], int tid) {
    const int wbase = tid & ~63;
#pragma unroll
    for (int i = 0; i < N; ++i)
        __builtin_amdgcn_global_load_lds((const unsigned*)(gbase + off[i]), (unsigned*)(dst + (wbase + 512 * i) * 16), 16, 0, 0);
}

constexpr int AT_STAGE = 32 * 1024;
constexpr int AT_LUT = 2 * AT_STAGE;
constexpr int LUT_N = 1280, LUT_OFF = 1100;
constexpr int LUTC_W = 52;
constexpr int AT_LUTC = AT_LUT + 20 * 1024;
constexpr int AT_IMP = AT_LUTC + 13 * 1024;
constexpr int AT_SEL = AT_IMP + 34 * 1024;

DI void phase_diff_attn(const Params& p, unsigned char* lds, int tid) {
    unsigned char* ws = p.ws;
    const bf16_t* Q = (const bf16_t*)(ws + OFF_Q0);
    const bf16_t* Kk = (const bf16_t*)(ws + OFF_K0);
    const bf16_t* VT = (const bf16_t*)(ws + OFF_VT0);
    bf16_t* O = (bf16_t*)(ws + OFF_H);
    const float* relb = p.in[2];
    const float* lam = p.in[9];
    const float* subln = p.in[12];
    const int lane = tid & 63, w = tid >> 6, comp = w & 1, qg = w >> 1, r = lane & 31, h = lane >> 5;
    float* lut = (float*)(lds + 128 * 1024);
    float lam_full;
    {
        float s01 = 0.f, s23 = 0.f;
        for (int i = 0; i < 64; ++i) { s01 += lam[i] * lam[64 + i]; s23 += lam[128 + i] * lam[192 + i]; }
        lam_full = __expf(s01) - __expf(s23) + 0.2f;
    }
    const int G = gridDim.x, rows_per_it = G >> 5;
    unsigned koff[1], voff[2];
    dma_offsets<128, 64>(koff, 128, tid);
    dma_offsets<128, 128>(voff, SEQ * 2, tid);
    constexpr int ST2 = 64 * 1024;
    for (int it = 0;; ++it) {
        int qb, b, hd;
        if (G == 256) {
            if (it >= 8) break;
            const int xcd = blockIdx.x & 7, lb = blockIdx.x >> 3, pr = xcd * 4 + (it >> 1);
            qb = (it & 1) ? lb : 63 - lb; b = pr >> 3; hd = pr & 7;
        } else {
            int u;
            if ((G & 31) == 0) {
                const int rr = blockIdx.x >> 5, cc = blockIdx.x & 31;
                const int rowi = it * rows_per_it + ((it & 1) ? rows_per_it - 1 - rr : rr);
                u = rowi * 32 + cc;
            } else u = it * G + blockIdx.x;
            if (u >= 2048) break;
            qb = 63 - (u >> 5); b = (u & 31) >> 3; hd = u & 7;
        }
        const int q0 = qb * 128, ntiles = qb + 1;
        const int qpos = q0 + 32 * qg + r, qlo = q0 + 32 * qg, qhi = qlo + 31;
        for (int e = tid; e < LUT_N; e += NTHREADS) { const int d = LUT_OFF - e; lut[e] = d < 0 ? -INFINITY : (d >= 790 ? 0.f : (relb[rel_bucket_i(d) * 8 + hd] - relb[31 * 8 + hd]) * LOG2E); }
        bf16x8 qf[4];
        {
            const bf16_t* qrow = Q + ((long)((b * 8 + hd) * 2 + comp) * SEQ + qpos) * 64;
#pragma unroll
            for (int ks = 0; ks < 4; ++ks) qf[ks] = *(const bf16x8*)(qrow + 16 * ks + 8 * h);
        }
        const unsigned char* k0g = (const unsigned char*)(Kk + (long)((b * 8 + hd) * 2 + 0) * SEQ * 64);
        const unsigned char* k1g = (const unsigned char*)(Kk + (long)((b * 8 + hd) * 2 + 1) * SEQ * 64);
        const unsigned char* vtg = (const unsigned char*)(VT + (long)(b * 8 + hd) * 128 * SEQ);
        f32x16 o[4];
#pragma unroll
        for (int dt = 0; dt < 4; ++dt)
#pragma unroll
            for (int i = 0; i < 16; ++i) o[dt][i] = 0.f;
        float l = 0.f;
        const float nmb = -((const float*)(ws + OFF_MB0))[(long)((b * 8 + hd) * 2 + comp) * SEQ + qpos];
        auto stage = [&](int kt, unsigned char* st) {
#pragma unroll
            for (int sb = 0; sb < 2; ++sb) {
                dma_issue(st + sb * 8192, k0g + (long)(2 * kt + sb) * 8192, koff, tid);
                dma_issue(st + 16384 + sb * 8192, k1g + (long)(2 * kt + sb) * 8192, koff, tid);
                dma_issue(st + 32768 + sb * 16384, vtg + (long)(2 * kt + sb) * 128, voff, tid);
            }
        };
        stage(0, lds);
        __syncthreads();
        for (int kt = 0; kt < ntiles; ++kt) {
            unsigned char* cur = lds + (kt & 1) * ST2;
            if (kt + 1 < ntiles) stage(kt + 1, lds + ((kt + 1) & 1) * ST2);
            const bool nearb = qlo - (kt * 128 + 127) < 790;
            const int dbase0 = qpos - kt * 128 - 8 * h;
            const unsigned char* kb = cur + comp * 16384;
            f32x16 sa, sbv;
            attn_qk32<64>(kb, qf, sa, 0, r, h, nmb);
#pragma unroll
            for (int j = 0; j < 4; ++j) {
                f32x16& sc = (j & 1) ? sbv : sa;
                f32x16& sn = (j & 1) ? sa : sbv;
                if (j < 3) attn_qk32<64>(kb + ((j + 1) >> 1) * 8192, qf, sn, (j + 1) & 1, r, h, nmb);
                if (nearb) {
                    const float* lp = lut + (LUT_OFF - dbase0 + 64 * (j >> 1));
#pragma unroll
                    for (int i = 0; i < 16; ++i) sc[i] += lp[kidx(j & 1, i)];
                }
                attn_softmax32_b(sc, l);
                bf16x8 pf[2];
                attn_pack32(sc, pf);
                attn_pv32(cur + 32768 + (j >> 1) * 16384, pf, o, j & 1, r, h);
            }
            __syncthreads();
        }
        l = sum_x32(l);
        const float inv = l > 0.f ? frcp(l) : 0.f;
        float* xch = (float*)lds + qg * 4096;
        if (comp == 1) {
            const float sc = inv * lam_full;
#pragma unroll
            for (int dt = 0; dt < 4; ++dt)
#pragma unroll
                for (int i = 0; i < 16; ++i) xch[(dt * 16 + i) * 64 + lane] = o[dt][i] * sc;
        }
        __syncthreads();
        if (comp == 0) {
            float ss = 0.f;
#pragma unroll
            for (int dt = 0; dt < 4; ++dt)
#pragma unroll
                for (int i = 0; i < 16; ++i) { const float v = o[dt][i] * inv - xch[(dt * 16 + i) * 64 + lane]; o[dt][i] = v; ss += v * v; }
            ss = sum_x32(ss);
            const float rstd = rsqrtf(ss * (1.f / 128.f) + EPS) * 0.8f;
            bf16_t* orow = O + (long)(b * SEQ + qpos) * DM + hd * 128;
#pragma unroll
            for (int dt = 0; dt < 4; ++dt)
#pragma unroll
                for (int g4 = 0; g4 < 4; ++g4) {
                    const int d0 = 32 * dt + 8 * g4 + 4 * h;
                    const f32x4 gv = *(const f32x4*)(subln + d0);
                    u32x2 ov;
                    ov.x = pk2(o[dt][4 * g4 + 0] * rstd * gv.x, o[dt][4 * g4 + 1] * rstd * gv.y);
                    ov.y = pk2(o[dt][4 * g4 + 2] * rstd * gv.z, o[dt][4 * g4 + 3] * rstd * gv.w);
                    *(u32x2*)(orow + d0) = ov;
                }
        }
        __syncthreads();
    }
}

template <int VAR>
DI void phase_nsa_attn(const Params& p, unsigned char* lds, int tid) {
    unsigned char* ws = p.ws;
    const bf16_t* QN = (const bf16_t*)(ws + OFF_QN);
    const bf16_t* KS = (const bf16_t*)(ws + OFF_KS);
    const bf16_t* VST = (const bf16_t*)(ws + OFF_VST);
    const bf16_t* KW = (const bf16_t*)(ws + OFF_KW);
    const bf16_t* VWT = (const bf16_t*)(ws + OFF_VWT);
    const bf16_t* KCMP = (const bf16_t*)(ws + OFF_KCMP);
    const bf16_t* VCMPT = (const bf16_t*)(ws + OFF_VCMPT);
    const float* gates = (const float*)(ws + OFF_GATES);
    bf16_t* O = VAR ? (bf16_t*)(ws + OFF_PU + 32 * MB) : (bf16_t*)(ws + OFF_H);
    const float* relb = p.in[2];
    const int lane = tid & 63, w = tid >> 6, hg = w >> 1, th = w & 1, r = lane & 31, h = lane >> 5;
    float* lut = (float*)(lds + AT_LUT);
    float* lutc = (float*)(lds + AT_LUTC);
    float* imp = (float*)(lds + AT_IMP);
    unsigned* selw = (unsigned*)(lds + AT_SEL);
    unsigned short* sel16 = (unsigned short*)selw;
    float* bmxs = (float*)(selw + 264);
    const float* qnrm = (const float*)(ws + OFF_MB1);
    float kmx[3];
    for (int br = 0; br < 3; ++br) { float mx = 0.f; for (int d = 0; d < 128; ++d) mx = fmaxf(mx, fabsf(p.in[21][br * 128 + d])); kmx[br] = mx * 11.313708498984761f; }
    const int G = gridDim.x, rows_per_it = G >> 3;
    int lut_g = -1;
    for (int it = 0;; ++it) {
        int u;
        if ((G & 7) == 0) {
            const int rr = blockIdx.x >> 3, cc = blockIdx.x & 7;
            const int rowi = it * rows_per_it + ((it & 1) ? rows_per_it - 1 - rr : rr);
            u = rowi * 8 + cc;
        } else u = it * G + blockIdx.x;
        if (u >= 1024) break;
        const int bi = 127 - (u >> 3), b = (u & 7) >> 1, g = u & 1, head = 4 * g + hg;
        const int tq = 64 * bi + 32 * th + r;
        const int tl = 32 * th + r;
        const long tok = (long)b * SEQ + tq;
        if (g != lut_g) {
            lut_g = g;
            if (tid < 4) { float bm = 0.f; for (int bk = 0; bk < 32; ++bk) bm = fmaxf(bm, relb[bk * 8 + 4 * g + tid] - relb[31 * 8 + 4 * g + tid]); bmxs[tid] = bm * LOG2E; }
            for (int e = tid; e < 4 * LUT_N; e += NTHREADS) { const int hh = e / LUT_N, d = LUT_OFF - (e % LUT_N); lut[e] = d < 0 ? -INFINITY : (d >= 790 ? 0.f : (relb[rel_bucket_i(d) * 8 + 4 * g + hh] - relb[31 * 8 + 4 * g + hh]) * LOG2E); }
            for (int e = tid; e < 4 * 16 * LUTC_W; e += NTHREADS) {
                const int hh = e / (16 * LUTC_W), ph = (e / LUTC_W) & 15, ci = e % LUTC_W, d = 16 * (ci - 1) + ph;
                lutc[e] = ci == 0 ? -INFINITY : (d >= 790 ? 0.f : (relb[rel_bucket_i(d) * 8 + 4 * g + hh] - relb[31 * 8 + 4 * g + hh]) * LOG2E);
            }
        }
        if (tid < 4) selw[256 + tid] = 0u;
        const float* mylut = lut + hg * LUT_N;
        bf16x8 qf[8];
        const bf16_t* qrow = QN + ((long)(b * 8 + head) * SEQ + tq) * 128 + 8 * h;
        auto load_q = [&](const bf16_t* qr) {
#pragma unroll
            for (int ks = 0; ks < 8; ++ks) qf[ks] = *(const bf16x8*)(qr + 16 * ks);
        };
        const float* gp = gates + tok * 24 + head * 3;
        bf16_t* orow = O + (VAR ? (tok & 16383) : tok) * DM + head * 128;
        auto stage = [&](const unsigned char* kg, const unsigned char* vg, unsigned vstride, int kt, unsigned char* st) {
            int t2 = tid; asm volatile("" : "+v"(t2));
            unsigned koff[2], vo[2];
            dma_offsets<256, 64>(koff, 256, t2);
            dma_offsets<128, 128>(vo, vstride, t2);
            dma_issue(st, kg + (long)kt * 16384, koff, t2);
            dma_issue(st + 16384, vg + (long)kt * 128, vo, t2);
        };
        f32x16 o[4];
        float l;
        auto reset = [&]() {
#pragma unroll
            for (int dt = 0; dt < 4; ++dt)
#pragma unroll
                for (int i = 0; i < 16; ++i) o[dt][i] = 0.f;
            l = 0.f;
        };
        const unsigned char* kcg = (const unsigned char*)(KCMP + (long)(b * 2 + g) * 512 * 128);
        const unsigned char* vcg = (const unsigned char*)(VCMPT + (long)(b * 2 + g) * 128 * 512);
        const int nct = ((4 * bi + 2) >> 6) + 1;
        const int hgc = r & 3, tlc = 8 * w + (r >> 2), tqc = 64 * bi + tlc;
        const long tokc = (long)b * SEQ + tqc;
        reset();
        load_q(QN + ((long)(b * 8 + 4 * g + hgc) * SEQ + tqc) * 128 + 8 * h);
        __syncthreads();
        if (VAR != 3) {
            const int cb = (tqc - 31) >> 4;
            const float* lc = lutc + (hgc * 16 + ((tqc - 31) & 15)) * LUTC_W + 1;
            const float nmb = -(qnrm[tokc * 8 + 4 * g + hgc] * kmx[0] + bmxs[hgc]);
            stage(kcg, vcg, 1024u, 0, lds);
            __syncthreads();
            for (int kt = 0; kt < nct; ++kt) {
                unsigned char* cur = lds + (kt & 1) * AT_STAGE;
                if (kt + 1 < nct) stage(kcg, vcg, 1024u, kt + 1, lds + ((kt + 1) & 1) * AT_STAGE);
                const int cbase = cb - kt * 64 - 8 * h;
#pragma unroll
                for (int mt = 0; mt < 2; ++mt) {
                    f32x16 st;
                    attn_qk32<128>(cur, qf, st, mt, r, h, nmb);
                    float sum = 0.f;
#pragma unroll
                    for (int i = 0; i < 16; ++i) {
                        const int c = cbase - kidx(mt, i);
                        sum += fexp2(st[i] + lc[c < -1 ? -1 : (c > 50 ? 50 : c)]);
                    }
                    l += sum;
                }
                __syncthreads();
            }
            const float lt = sum_x32(l);
            const float invl = lt > 0.f ? frcp(lt) : 0.f;
            stage(kcg, vcg, 1024u, 0, lds);
            __syncthreads();
            float carry = 0.f;
            for (int kt = 0; kt < nct; ++kt) {
                unsigned char* cur = lds + (kt & 1) * AT_STAGE;
                if (kt + 1 < nct) stage(kcg, vcg, 1024u, kt + 1, lds + ((kt + 1) & 1) * AT_STAGE);
                const int cbase = cb - kt * 64 - 8 * h;
                float o0[4], o1[4], sp[4];
#pragma unroll
                for (int mt = 0; mt < 2; ++mt) {
                    f32x16 st;
                    attn_qk32<128>(cur, qf, st, mt, r, h, nmb);
#pragma unroll
                    for (int i = 0; i < 16; ++i) {
                        const int c = cbase - kidx(mt, i);
                        st[i] = fexp2(st[i] + lc[c < -1 ? -1 : (c > 50 ? 50 : c)]) * invl;
                    }
#pragma unroll
                    for (int gq = 0; gq < 2; ++gq) {
                        const int G2 = 2 * mt + gq, q0 = 2 * gq, q1 = 2 * gq + 1;
                        const float c20 = 0.5f * st[4 * q0 + 3];
                        o0[G2] = st[4 * q0] + st[4 * q0 + 1] + st[4 * q0 + 2] + c20;
                        o1[G2] = st[4 * q1] + st[4 * q1 + 1] + st[4 * q1 + 2] + 0.5f * st[4 * q1 + 3] + c20;
                        sp[G2] = 0.5f * st[4 * q1 + 3];
                    }
                    bf16x8 pf[2];
                    attn_pack32(st, pf);
                    attn_pv32(cur + 16384, pf, o, mt, r, h);
                }
                float rc[4];
#pragma unroll
                for (int G2 = 0; G2 < 4; ++G2) rc[G2] = __uint_as_float(get_x32(__float_as_uint(sp[G2]), h));
                if (h) {
#pragma unroll
                    for (int G2 = 0; G2 < 4; ++G2) o0[G2] += rc[G2];
                } else {
                    o0[0] += carry; o0[1] += rc[0]; o0[2] += rc[1]; o0[3] += rc[2];
                    carry = rc[3];
                }
#pragma unroll
                for (int G2 = 0; G2 < 4; ++G2) {
                    float a0 = o0[G2], a1 = o1[G2];
                    a0 += lx1(a0); a0 += lx2(a0); a1 += lx1(a1); a1 += lx2(a1);
                    if (hgc == 0) *(f32x2*)(imp + tlc * 130 + kt * 16 + 4 * G2 + 2 * h) = (f32x2){a0, a1};
                }
                __syncthreads();
            }
        }
        {
            const float g_c = gates[tokc * 24 + (4 * g + hgc) * 3];
            bf16_t* orc = O + (VAR ? (tokc & 16383) : tokc) * DM + (4 * g + hgc) * 128;
#pragma unroll
            for (int dt = 0; dt < 4; ++dt)
#pragma unroll
                for (int g4 = 0; g4 < 4; ++g4) {
                    const int d0 = 32 * dt + 8 * g4 + 4 * h;
                    u32x2 ov;
                    ov.x = pk2(o[dt][4 * g4 + 0] * g_c, o[dt][4 * g4 + 1] * g_c);
                    ov.y = pk2(o[dt][4 * g4 + 2] * g_c, o[dt][4 * g4 + 3] * g_c);
                    *(u32x2*)(orc + d0) = ov;
                }
        }
        if (VAR != 5) {
            const int tkn = tid >> 3, part = tid & 7;
            unsigned key[16];
#pragma unroll
            for (int q = 0; q < 16; ++q) {
                const int j = part * 16 + q;
                float v = imp[tkn * 130 + j];
                const int back = bi - j;
                if (j == 0 || (back >= 0 && back < 2)) v = 1e9f;
                if (back < 0) v = -1e30f;
                key[q] = f2key(v);
            }
            auto sum8 = [&](int c) -> int {
                c += __builtin_amdgcn_update_dpp(0, c, 0xB1, 0xF, 0xF, true);
                c += __builtin_amdgcn_update_dpp(0, c, 0x4E, 0xF, 0xF, true);
                c += __builtin_amdgcn_update_dpp(0, c, 0x141, 0xF, 0xF, true);
                return c;
            };
            unsigned T = 0u;
#pragma unroll 4
            for (int bit = 31; bit >= 0; --bit) {
                const unsigned cand = T | (1u << bit);
                int c = 0;
#pragma unroll
                for (int q = 0; q < 16; ++q) c += key[q] >= cand ? 1 : 0;
                if (sum8(c) >= 16) T = cand;
            }
            int cg = 0, ce = 0;
#pragma unroll
            for (int q = 0; q < 16; ++q) { cg += key[q] > T ? 1 : 0; ce += key[q] == T ? 1 : 0; }
            const int need = 16 - sum8(cg);
            int pre = ce;
            { int t = __builtin_amdgcn_update_dpp(0, pre, 0x111, 0xF, 0xF, true); if (part >= 1) pre += t; }
            { int t = __builtin_amdgcn_update_dpp(0, pre, 0x112, 0xF, 0xF, true); if (part >= 2) pre += t; }
            { int t = __builtin_amdgcn_update_dpp(0, pre, 0x114, 0xF, 0xF, true); if (part >= 4) pre += t; }
            int before = pre - ce;
            unsigned bits = 0;
#pragma unroll
            for (int q = 0; q < 16; ++q) {
                const bool eq = key[q] == T;
                const bool selq = key[q] > T || (eq && before < need);
                before += eq ? 1 : 0;
                bits |= (selq && key[q] >= 0x80000000u) ? (1u << q) : 0u;
            }
            sel16[tkn * 8 + part] = (unsigned short)bits;
            atomicOr(&selw[256 + (part >> 1)], bits << ((part & 1) * 16));
        }
        __syncthreads();
        const unsigned un0 = selw[256], un1 = selw[257], un2 = selw[258], un3 = selw[259];
        const unsigned char* ksg = (const unsigned char*)(KS + (long)(b * 2 + g) * SEQ * 128);
        const unsigned char* vsg = (const unsigned char*)(VST + (long)(b * 2 + g) * 128 * SEQ);
        reset(); load_q(qrow);
        const float qn_main = qnrm[tok * 8 + head];
        {
            const float nmb = -(qn_main * kmx[1] + bmxs[hg]);
            const unsigned long long ulo = ((unsigned long long)(unsigned)__builtin_amdgcn_readfirstlane((int)un1) << 32) | (unsigned)__builtin_amdgcn_readfirstlane((int)un0);
            const unsigned long long uhi = ((unsigned long long)(unsigned)__builtin_amdgcn_readfirstlane((int)un3) << 32) | (unsigned)__builtin_amdgcn_readfirstlane((int)un2);
            auto next_tile = [&](int from) -> int {
                if (from < 64) { const unsigned long long mk = ulo >> from; if (mk) return from + __builtin_ctzll(mk); from = 64; }
                if (from < 128) { const unsigned long long mk = uhi >> (from - 64); if (mk) return from + __builtin_ctzll(mk); }
                return 128;
            };
            int jt = (VAR == 1 || VAR == 4 || VAR == 5) ? 128 : next_tile(0);
            int buf = 0;
            if (jt < 128) stage(ksg, vsg, SEQ * 2u, jt, lds);
            __syncthreads();
            while (jt < 128) {
                unsigned char* cur = lds + buf * AT_STAGE;
                const int jn = next_tile(jt + 1);
                if (jn < 128) stage(ksg, vsg, SEQ * 2u, jn, lds + (buf ^ 1) * AT_STAGE);
                const unsigned wd = selw[tl * 4 + (jt >> 5)];
                const bool mysel = (wd >> (jt & 31)) & 1u;
                if (__any(mysel)) {
                    const int k0 = jt * 64;
                    const bool nearb = (64 * bi + 32 * th) - (k0 + 63) < 790;
                    const int dbase = tq - k0 - 8 * h;
                    const float* lp = mylut + (LUT_OFF - dbase);
#pragma unroll
                    for (int mt = 0; mt < 2; ++mt) {
                        f32x16 st;
                        attn_qk32<128>(cur, qf, st, mt, r, h, mysel ? nmb : -INFINITY);
                        if (nearb) {
#pragma unroll
                            for (int i = 0; i < 16; ++i) st[i] += lp[kidx(mt, i)];
                        }
                        attn_softmax32_b(st, l);
                        bf16x8 pf[2];
                        attn_pack32(st, pf);
                        attn_pv32(cur + 16384, pf, o, mt, r, h);
                    }
                }
                __syncthreads();
                buf ^= 1; jt = jn;
            }
        }
        {
            const float lt = sum_x32(l);
            const float sc = (lt > 0.f ? frcp(lt) : 0.f) * gp[1];
#pragma unroll
            for (int dt = 0; dt < 4; ++dt)
#pragma unroll
                for (int g4 = 0; g4 < 4; ++g4) {
                    const int d0 = 32 * dt + 8 * g4 + 4 * h;
                    const u32x2 pv = *(const u32x2*)(orow + d0);
                    u32x2 ov;
                    ov.x = pk2(bflo(pv.x) + o[dt][4 * g4 + 0] * sc, bfhi(pv.x) + o[dt][4 * g4 + 1] * sc);
                    ov.y = pk2(bflo(pv.y) + o[dt][4 * g4 + 2] * sc, bfhi(pv.y) + o[dt][4 * g4 + 3] * sc);
                    *(u32x2*)(orow + d0) = ov;
                }
        }
        const unsigned char* kwg = (const unsigned char*)(KW + (long)(b * 2 + g) * SEQ * 128);
        const unsigned char* vwg = (const unsigned char*)(VWT + (long)(b * 2 + g) * 128 * SEQ);
        reset(); load_q(qrow);
        {
            const float nmb = -(qn_main * kmx[2] + bmxs[hg]);
            const int j0 = bi >= 8 ? bi - 8 : 0, nt = (VAR == 2 || VAR == 4 || VAR == 5) ? 1 : bi - j0 + 1;
            stage(kwg, vwg, SEQ * 2u, j0, lds);
            __syncthreads();
            for (int kt = 0; kt < nt; ++kt) {
                unsigned char* cur = lds + (kt & 1) * AT_STAGE;
                if (kt + 1 < nt) stage(kwg, vwg, SEQ * 2u, j0 + kt + 1, lds + ((kt + 1) & 1) * AT_STAGE);
                const int k0 = (j0 + kt) * 64;
                const int dbase = tq - k0 - 8 * h;
                const float* lp = mylut + (LUT_OFF - dbase);
#pragma unroll
                for (int mt = 0; mt < 2; ++mt) {
                    f32x16 st;
                    attn_qk32<128>(cur, qf, st, mt, r, h, nmb);
#pragma unroll
                    for (int i = 0; i < 16; ++i) st[i] = kidx(mt, i) <= dbase - 512 ? -INFINITY : st[i] + lp[kidx(mt, i)];
                    attn_softmax32_b(st, l);
                    bf16x8 pf[2];
                    attn_pack32(st, pf);
                    attn_pv32(cur + 16384, pf, o, mt, r, h);
                }
                __syncthreads();
            }
        }
        {
            const float lt = sum_x32(l);
            const float sc = (lt > 0.f ? frcp(lt) : 0.f) * gp[2];
#pragma unroll
            for (int dt = 0; dt < 4; ++dt)
#pragma unroll
                for (int g4 = 0; g4 < 4; ++g4) {
                    const int d0 = 32 * dt + 8 * g4 + 4 * h;
                    const u32x2 pv = *(const u32x2*)(orow + d0);
                    u32x2 ov;
                    ov.x = pk2(bflo(pv.x) + o[dt][4 * g4 + 0] * sc, bfhi(pv.x) + o[dt][4 * g4 + 1] * sc);
                    ov.y = pk2(bflo(pv.y) + o[dt][4 * g4 + 2] * sc, bfhi(pv.y) + o[dt][4 * g4 + 3] * sc);
                    *(u32x2*)(orow + d0) = ov;
                }
        }
        __syncthreads();
    }
}

DI void fp8x16_fma(const u32x4& q, const f32x4& h0, const f32x4& h1, const f32x4& h2, const f32x4& h3, f32x2& a0, f32x2& a1) {
    a0 += __builtin_amdgcn_cvt_pk_f32_fp8((int)q.x, false) * (f32x2){h0.x, h0.y};
    a1 += __builtin_amdgcn_cvt_pk_f32_fp8((int)q.x, true)  * (f32x2){h0.z, h0.w};
    a0 += __builtin_amdgcn_cvt_pk_f32_fp8((int)q.y, false) * (f32x2){h1.x, h1.y};
    a1 += __builtin_amdgcn_cvt_pk_f32_fp8((int)q.y, true)  * (f32x2){h1.z, h1.w};
    a0 += __builtin_amdgcn_cvt_pk_f32_fp8((int)q.z, false) * (f32x2){h2.x, h2.y};
    a1 += __builtin_amdgcn_cvt_pk_f32_fp8((int)q.z, true)  * (f32x2){h2.z, h2.w};
    a0 += __builtin_amdgcn_cvt_pk_f32_fp8((int)q.w, false) * (f32x2){h3.x, h3.y};
    a1 += __builtin_amdgcn_cvt_pk_f32_fp8((int)q.w, true)  * (f32x2){h3.z, h3.w};
}
template <bool DRY>
DI void phase_peer_u(const Params& p, int layer, unsigned char* lds, int tid) {
    unsigned char* ws = p.ws;
    const unsigned char* H8 = ws + OFF_H8;
    const float* HS = (const float*)(ws + OFF_HS);
    const int* ridx = (const int*)(ws + OFF_RIDX);
    float* rgate = (float*)(ws + OFF_RGATE);
    const unsigned char* U = ws + OFF_PU + (long)layer * 16384 * 1024;
    const float* usi = (const float*)(ws + OFF_USI) + layer * 16384;
    const float* vsi = (const float*)(ws + OFF_VSI) + layer * 16384;
    const int lane = tid & 63, w = tid >> 6, sub = lane & 7, grp = lane >> 3;
    const int xg = blockIdx.x & 7, lb = blockIdx.x >> 3, nwv = (gridDim.x >> 3) * NWAVES, wv = lb * NWAVES + w;
    unsigned* clb = (unsigned*)(lds + w * 12288);
    unsigned char* hbb = lds + w * 12288 + 2048;
    const unsigned long long lt = (1ull << lane) - 1ull;
    if (lb >= (int)(gridDim.x >> 3)) return;
    int i0, i1; u32x4 h0; float hs0;
    auto ld_tok = [&](int tk) {
        tk = tk < NTOK ? tk : wv;
        i0 = ridx[(long)tk * 128 + lane]; i1 = ridx[(long)tk * 128 + 64 + lane];
        h0 = *(const u32x4*)(H8 + (long)tk * DM + lane * 16); hs0 = HS[tk];
    };
    auto stage_tok = [&](int bi, float& hsinv) -> int {
        unsigned* cl = clb + bi * 256; unsigned char* hb = hbb + bi * 4096;
        const bool b0 = (i0 >> 11) == xg, b1 = (i1 >> 11) == xg;
        const unsigned long long m0 = __ballot(b0), m1 = __ballot(b1);
        const int n0 = __popcll(m0), n = n0 + __popcll(m1);
        if (b0) { const int k = __popcll(m0 & lt); cl[2 * k] = lane; cl[2 * k + 1] = i0; }
        if (b1) { const int k = n0 + __popcll(m1 & lt); cl[2 * k] = 64 + lane; cl[2 * k + 1] = i1; }
        if (n == 0 && lane == 0) { cl[0] = 0u; cl[1] = 0u; }
        hsinv = hs0;
        *(u32x4*)(hb + lane * 16) = h0;
        return n;
    };
    float shC, shN = 1.f;
    ld_tok(wv);
    int nC = stage_tok(0, shC);
    ld_tok(wv + nwv);
    int slotC, idC; bool validC;
    { validC = grp < nC; const int kk = validC ? grp : 0; slotC = clb[2 * kk]; idC = clb[2 * kk + 1]; }
    u32x4 uv[8];
    {
        const unsigned uoff = (unsigned)idC * 1024u + (unsigned)sub * 16u;
#pragma unroll
        for (int t = 0; t < 8; ++t) uv[t] = *(const u32x4*)(U + (uoff + t * 128));
    }
    int it = 0;
    for (int tok = wv; tok < NTOK; tok += nwv, ++it) {
        const int cb = it & 1;
        const unsigned* clC = clb + cb * 256; const unsigned* clN = clb + (cb ^ 1) * 256;
        const unsigned char* hbC = hbb + cb * 4096;
        const bool more = tok + nwv < NTOK;
        int nN = 0;
        if (more) { nN = stage_tok(cb ^ 1, shN); ld_tok(tok + 2 * nwv); }
        const int nr = nC > 8 ? (nC + 7) >> 3 : 1;
        u32x4 hq[8];
#pragma unroll
        for (int t = 0; t < 8; ++t) hq[t] = *(const u32x4*)(hbC + (sub + 8 * t) * 16);
        for (int rd = 0; rd < nr; ++rd) {
            float g_in = 0.f, su = 0.f, sv = 0.f;
            if (validC && sub == 0) { g_in = rgate[(long)tok * 128 + slotC]; su = usi[idC]; sv = vsi[idC]; }
            int slotN, idN; bool validN;
            if (rd + 1 < nr) { const int k = 8 * (rd + 1) + grp; validN = k < nC; const int kk = validN ? k : 0; slotN = clC[2 * kk]; idN = clC[2 * kk + 1]; }
            else if (more) { validN = grp < nN; const int kk = validN ? grp : 0; slotN = clN[2 * kk]; idN = clN[2 * kk + 1]; }
            else { validN = false; slotN = 0; idN = clC[1]; }
            const unsigned uoffN = (unsigned)idN * 1024u + (unsigned)sub * 16u;
            int a0 = 0, a1 = 0, a2 = 0, a3 = 0;
#pragma unroll
            for (int t = 0; t < 8; ++t) {
                const u32x4 q = uv[t];
                a0 = __builtin_amdgcn_sdot4((int)q.x, (int)hq[t].x, a0, false); a1 = __builtin_amdgcn_sdot4((int)q.y, (int)hq[t].y, a1, false);
                a2 = __builtin_amdgcn_sdot4((int)q.z, (int)hq[t].z, a2, false); a3 = __builtin_amdgcn_sdot4((int)q.w, (int)hq[t].w, a3, false);
                uv[t] = *(const u32x4*)(U + (uoffN + t * 128));
            }
            int di = (a0 + a1) + (a2 + a3);
            di += __builtin_amdgcn_update_dpp(0, di, 0xB1, 0xF, 0xF, true);
            di += __builtin_amdgcn_update_dpp(0, di, 0x4E, 0xF, 0xF, true);
            di += __builtin_amdgcn_update_dpp(0, di, 0x141, 0xF, 0xF, true);
            if (validC && sub == 0) {
                float* gw = DRY ? (float*)(ws + OFF_R) + (long)tok * 128 + slotC : rgate + (long)tok * 128 + slotC;
                *gw = g_in * gelu_tanh((float)di * su * shC) * sv;
            }
            slotC = slotN; idC = idN; validC = validN;
        }
        nC = nN; shC = shN;
    }
}

#ifndef VMASK
#define VMASK 0xffffffffu
#endif
template <bool DRY>
DI void phase_peer_v(const Params& p, int layer, int tid) {
    unsigned char* ws = p.ws;
    const int* ridx = (const int*)(ws + OFF_RIDX);
    const float* wact = (const float*)(ws + OFF_RGATE);
    const float* ada = (const float*)(ws + OFF_ADA);
    float* x = opq(p.out);
    const int lane = tid & 63, w = tid >> 6, sub = lane & 7, eg = lane >> 3;
    const int xg = blockIdx.x & 7, lb = blockIdx.x >> 3, nwv = (gridDim.x >> 3) * NWAVES, wv = lb * NWAVES + w;
    if (lb >= (int)(gridDim.x >> 3)) return;
    const unsigned char* Vc = ws + OFF_PV + ((long)(layer * 8 + xg) * 16384) * 128;
    const int col0 = 128 * xg + 16 * sub;
    const __amdgpu_buffer_rsrc_t vrs = __builtin_amdgcn_make_buffer_rsrc((void*)Vc, (short)0, 16384 * 128, 0x00020000);
    auto ld_ids = [&](int tk, u32x4 (&a)[4], f32x4 (&wq)[4]) {
        tk = tk < NTOK ? tk : wv;
        const u32x4* ip = (const u32x4*)(ridx + (long)tk * 128 + eg * 16);
        const f32x4* wp = (const f32x4*)(wact + (long)tk * 128 + eg * 16);
#pragma unroll
        for (int q = 0; q < 4; ++q) { a[q] = ip[q]; wq[q] = wp[q]; }
    };
    u32x4 vv[16];
    u32x4 na[4], pa[4]; f32x4 cw[4], nw[4], pw[4];
    {
        u32x4 a[4];
        ld_ids(wv, a, cw);
#pragma unroll
        for (int j = 0; j < 16; ++j)
            vv[j] = __builtin_bit_cast(u32x4, __builtin_amdgcn_raw_buffer_load_b128(vrs, (int)((a[j >> 2][j & 3] & (DRY ? VMASK : 0xffffffffu)) * 128u + (unsigned)sub * 16u), 0, 0));
    }
    ld_ids(wv + nwv, na, nw);
    f32x4 gfv[4]; int gb = -1;
    for (int tok = wv; tok < NTOK; tok += nwv) {
        ld_ids(tok + 2 * nwv, pa, pw);
        f32x4 xv[4];
        {
            const float* xin = x + (long)tok * DM + col0;
#pragma unroll
            for (int c = 0; c < 4; ++c) xv[c] = *(const f32x4*)(xin + 4 * c);
            const int b = tok >> 13;
            if (b != gb) {
                gb = b;
                const float* gf = ada + b * ADA_STRIDE + layer * 6144 + 5 * 1024 + col0;
#pragma unroll
                for (int c = 0; c < 4; ++c) gfv[c] = *(const f32x4*)(gf + 4 * c);
            }
        }
        f32x2 ap[8];
#pragma unroll
        for (int i = 0; i < 8; ++i) ap[i] = (f32x2){0.f, 0.f};
#pragma unroll
        for (int j = 0; j < 16; ++j) {
            const float ws1 = cw[j >> 2][j & 3]; const f32x2 ww = {ws1, ws1}; const u32x4 v = vv[j];
            ap[0] += __builtin_amdgcn_cvt_pk_f32_fp8((int)v.x, false) * ww; ap[1] += __builtin_amdgcn_cvt_pk_f32_fp8((int)v.x, true) * ww;
            ap[2] += __builtin_amdgcn_cvt_pk_f32_fp8((int)v.y, false) * ww; ap[3] += __builtin_amdgcn_cvt_pk_f32_fp8((int)v.y, true) * ww;
            ap[4] += __builtin_amdgcn_cvt_pk_f32_fp8((int)v.z, false) * ww; ap[5] += __builtin_amdgcn_cvt_pk_f32_fp8((int)v.z, true) * ww;
            ap[6] += __builtin_amdgcn_cvt_pk_f32_fp8((int)v.w, false) * ww; ap[7] += __builtin_amdgcn_cvt_pk_f32_fp8((int)v.w, true) * ww;
            vv[j] = __builtin_bit_cast(u32x4, __builtin_amdgcn_raw_buffer_load_b128(vrs, (int)((na[j >> 2][j & 3] & (DRY ? VMASK : 0xffffffffu)) * 128u + (unsigned)sub * 16u), 0, 0));
        }
        float acc[16];
#pragma unroll
        for (int i = 0; i < 8; ++i) { acc[2 * i] = ap[i].x; acc[2 * i + 1] = ap[i].y; }
#pragma unroll
        for (int i = 0; i < 16; ++i) { acc[i] += lr8(acc[i]); acc[i] = sum_x16(acc[i]); acc[i] = sum_x32(acc[i]); }
        if (eg == 0) {
            float* xr = DRY ? (float*)(ws + OFF_R + 16 * MB) + (long)tok * DM + col0 : x + (long)tok * DM + col0;
#pragma unroll
            for (int c = 0; c < 4; ++c) {
                const f32x4 gv = gfv[c];
                f32x4 o;
                o.x = xv[c].x + gv.x * acc[4 * c + 0]; o.y = xv[c].y + gv.y * acc[4 * c + 1];
                o.z = xv[c].z + gv.z * acc[4 * c + 2]; o.w = xv[c].w + gv.w * acc[4 * c + 3];
                *(f32x4*)(xr + 4 * c) = o;
            }
        }
#pragma unroll
        for (int q = 0; q < 4; ++q) { cw[q] = nw[q]; na[q] = pa[q]; nw[q] = pw[q]; }
    }
}

DI void norm_row_q8(const f32x4 (&v)[4], float rstd, const float* gain, const float* shift, const float* scale, unsigned char* orow, float* os, int lane) {
    f32x4 y[4]; float am = 0.f;
#pragma unroll
    for (int j = 0; j < 4; ++j) {
        const int c = 4 * lane + 256 * j;
        const f32x4 g = *(const f32x4*)(gain + c), sh = *(const f32x4*)(shift + c), sc = *(const f32x4*)(scale + c);
        y[j].x = v[j].x * rstd * g.x * (1.f + sc.x) + sh.x; y[j].y = v[j].y * rstd * g.y * (1.f + sc.y) + sh.y;
        y[j].z = v[j].z * rstd * g.z * (1.f + sc.z) + sh.z; y[j].w = v[j].w * rstd * g.w * (1.f + sc.w) + sh.w;
        am = fmaxf(am, fmaxf(fmaxf(fabsf(y[j].x), fabsf(y[j].y)), fmaxf(fabsf(y[j].z), fabsf(y[j].w))));
    }
    am = wave_max(am);
    const float qs = am > 0.f ? 127.f / am : 1.f;
#pragma unroll
    for (int j = 0; j < 4; ++j) *(int*)(orow + 4 * lane + 256 * j) = pack_i8x4(y[j].x * qs, y[j].y * qs, y[j].z * qs, y[j].w * qs);
    if (lane == 0) *os = am > 0.f ? am * (1.f / 127.f) : 1.f;
}
DI void phase_norm2(const float* __restrict__ x, unsigned char* __restrict__ out1, float* __restrict__ os1, const float* gain1, int sh1, int sc1,
                    unsigned char* __restrict__ out2, float* __restrict__ os2, const float* gain2, int sh2, int sc2, const float* ada, int tid) {
    const int lane = tid & 63, gw = blockIdx.x * NWAVES + (tid >> 6), nw = gridDim.x * NWAVES;
    for (int tok = gw; tok < NTOK; tok += nw) {
        const int b = tok >> 13;
        f32x4 v[4]; float ss = 0.f;
#pragma unroll
        for (int j = 0; j < 4; ++j) { v[j] = *(const f32x4*)(x + (long)tok * DM + 4 * lane + 256 * j); ss += v[j].x * v[j].x + v[j].y * v[j].y + v[j].z * v[j].z + v[j].w * v[j].w; }
        const float rstd = rsqrtf(wave_sum(ss) * (1.f / DM) + EPS);
        norm_row_q8(v, rstd, gain1, ada + b * ADA_STRIDE + sh1, ada + b * ADA_STRIDE + sc1, out1 + (long)tok * DM, os1 + tok, lane);
        norm_row_q8(v, rstd, gain2, ada + b * ADA_STRIDE + sh2, ada + b * ADA_STRIDE + sc2, out2 + (long)tok * DM, os2 + tok, lane);
    }
}

template <int MT, class Epi>
DI void gemm_phase(const bf16_t* A, long lda, int M, const bf16_t* Bt, long ldb, int N, int K, const Epi& epi, unsigned char* lds, int tid) {
    const int ntm = (M + 128 * MT - 1) / (128 * MT), ntn = (N + 255) / 256, nt = ntm * ntn;
    if ((gridDim.x & 7) == 0 && (ntm & 31) == 0) {
        const int xcd = blockIdx.x & 7, lb = blockIdx.x >> 3, nlb = gridDim.x >> 3, tmx = ntm >> 3, per = tmx * ntn;
        for (int q = lb; q < per; q += nlb) {
            const int g4 = q / (4 * ntn), rem = q - g4 * 4 * ntn, tn = rem >> 2, tm = xcd * tmx + g4 * 4 + (rem & 3);
            if (tm < (xcd + 1) * tmx) gemm_tile<MT>(A, lda, M, Bt, ldb, N, K, tm * 128 * MT, tn * 256, epi, lds, tid);
        }
        return;
    }
    for (int t = blockIdx.x; t < nt; t += gridDim.x) {
        const int tn = t / ntm, tm = t % ntm;
        gemm_tile<MT>(A, lda, M, Bt, ldb, N, K, tm * 128 * MT, tn * 256, epi, lds, tid);
    }
}

template <int MT, class Epi>
DI void gemm_tile_i8(const unsigned char* __restrict__ A, int M, const float* __restrict__ as, const unsigned char* __restrict__ Bt, int N, const float* __restrict__ bs,
                     int K, int m0, int n0, const Epi& epi, unsigned char* lds, int tid) {
    constexpr int XS = MT * 128 * 128, WS = 256 * 128, STAGE = XS + WS;
    const int lane = tid & 63, w = tid >> 6, tg = w & 3, fh = w >> 2, r = lane & 31, h = lane >> 5;
    const int wbase = tid & ~63;
    unsigned xo[2 * MT], wo[4];
#pragma unroll
    for (int i = 0; i < 2 * MT; ++i) { int row, c; sw2_src(tid + 512 * i, row, c); int m = m0 + row; m = m < M ? m : M - 1; xo[i] = (unsigned)m * (unsigned)K + c * 16; }
#pragma unroll
    for (int i = 0; i < 4; ++i) { int row, c; sw2_src(tid + 512 * i, row, c); int n = n0 + row; n = n < N ? n : N - 1; wo[i] = (unsigned)n * (unsigned)K + c * 16; }
    auto stage = [&](int kt, unsigned char* st) {
#pragma unroll
        for (int i = 0; i < 2 * MT; ++i)
            __builtin_amdgcn_global_load_lds((const unsigned*)(A + kt * 128 + xo[i]), (unsigned*)(st + (wbase + 512 * i) * 16), 16, 0, 0);
#pragma unroll
        for (int i = 0; i < 4; ++i)
            __builtin_amdgcn_global_load_lds((const unsigned*)(Bt + kt * 128 + wo[i]), (unsigned*)(st + XS + (wbase + 512 * i) * 16), 16, 0, 0);
    };
    i32x16 acc[MT][4];
#pragma unroll
    for (int s2 = 0; s2 < MT; ++s2)
#pragma unroll
        for (int i = 0; i < 4; ++i)
#pragma unroll
            for (int j = 0; j < 16; ++j) acc[s2][i][j] = 0;
    const int nk = K >> 7;
    stage(0, lds);
    __syncthreads();
#pragma unroll 2
    for (int kt = 0; kt < nk; ++kt) {
        unsigned char* cur = lds + (kt & 1) * STAGE;
        if (kt + 1 < nk) stage(kt + 1, lds + ((kt + 1) & 1) * STAGE);
        i32x4 xfa[MT], wfa[4], xfb[MT], wfb[4];
        auto ldf = [&](i32x4 (&xf)[MT], i32x4 (&wf)[4], int ks) {
#pragma unroll
            for (int s2 = 0; s2 < MT; ++s2) xf[s2] = *(const i32x4*)(cur + sw2(32 * MT * tg + 32 * s2 + r, 2 * ks + h));
#pragma unroll
            for (int mt = 0; mt < 4; ++mt) wf[mt] = *(const i32x4*)(cur + XS + sw2(128 * fh + 32 * mt + r, 2 * ks + h));
        };
        auto mm = [&](const i32x4 (&xf)[MT], const i32x4 (&wf)[4]) {
#pragma unroll
            for (int mt = 0; mt < 4; ++mt)
#pragma unroll
                for (int s2 = 0; s2 < MT; ++s2) acc[s2][mt] = MFMA32I8(wf[mt], xf[s2], acc[s2][mt]);
        };
        ldf(xfa, wfa, 0);
        ldf(xfb, wfb, 1); __builtin_amdgcn_sched_barrier(0); mm(xfa, wfa); __builtin_amdgcn_sched_barrier(0);
        ldf(xfa, wfa, 2); __builtin_amdgcn_sched_barrier(0); mm(xfb, wfb); __builtin_amdgcn_sched_barrier(0);
        ldf(xfb, wfb, 3); __builtin_amdgcn_sched_barrier(0); mm(xfa, wfa); __builtin_amdgcn_sched_barrier(0);
        mm(xfb, wfb);
        __syncthreads();
    }
    auto fin = [&](const i32x16 (&ai)[4], int s2, int ho, int ro, int to) {
        const int tok = m0 + 32 * MT * tg + 32 * s2 + ro, fbase = n0 + 128 * fh;
        const float sa = as[tok < M ? tok : M - 1];
        f32x16 af[4];
#pragma unroll
        for (int mt = 0; mt < 4; ++mt) {
#pragma unroll
            for (int g4 = 0; g4 < 4; ++g4) {
                int f0 = fbase + 32 * mt + 8 * g4 + 4 * ho; f0 = f0 + 3 < N ? f0 : (N - 4 > 0 ? N - 4 : 0);
                const f32x4 sb = *(const f32x4*)(bs + f0);
                af[mt][4 * g4 + 0] = (float)ai[mt][4 * g4 + 0] * (sa * sb.x); af[mt][4 * g4 + 1] = (float)ai[mt][4 * g4 + 1] * (sa * sb.y);
                af[mt][4 * g4 + 2] = (float)ai[mt][4 * g4 + 2] * (sa * sb.z); af[mt][4 * g4 + 3] = (float)ai[mt][4 * g4 + 3] * (sa * sb.w);
            }
            __builtin_amdgcn_sched_barrier(0);
        }
        epi(af, tok, fbase, ho, lds, to);
        __builtin_amdgcn_sched_barrier(0);
    };
    if constexpr (MT == 2 && epi_stash<Epi>::present) {
        int* sp = (int*)lds + w * 4096 + lane;
#pragma unroll
        for (int mt = 0; mt < 4; ++mt)
#pragma unroll
            for (int j = 0; j < 16; ++j) sp[(mt * 16 + j) * 64] = acc[1][mt][j];
        int ho = h, ro = r, to = tid;
        asm volatile("" : "+v"(ho), "+v"(ro), "+v"(to));
        fin(acc[0], 0, ho, ro, to);
        i32x16 a2[4];
        const int* sp2 = sp; asm volatile("" : "+v"(sp2));
#pragma unroll
        for (int mt = 0; mt < 4; ++mt)
#pragma unroll
            for (int j = 0; j < 16; ++j) a2[mt][j] = sp2[(mt * 16 + j) * 64];
        asm volatile("" : "+v"(ho), "+v"(ro), "+v"(to));
        fin(a2, 1, ho, ro, to);
        __syncthreads();
    } else {
        int ho = h, ro = r, to = tid;
#pragma unroll
        for (int s2 = 0; s2 < MT; ++s2) { asm volatile("" : "+v"(ho), "+v"(ro), "+v"(to)); fin(acc[s2], s2, ho, ro, to); }
    }
}
template <int MT, class Epi>
DI void gemm_phase_i8(const unsigned char* A, int M, const float* as, const unsigned char* Bt, int N, const float* bs, int K, const Epi& epi, unsigned char* lds, int tid) {
    const int ntm = (M + 128 * MT - 1) / (128 * MT), ntn = (N + 255) / 256, nt = ntm * ntn;
    if ((gridDim.x & 7) == 0 && (ntm & 31) == 0) {
        const int xcd = blockIdx.x & 7, lb = blockIdx.x >> 3, nlb = gridDim.x >> 3, tmx = ntm >> 3, per = tmx * ntn;
        for (int q = lb; q < per; q += nlb) {
            const int g4 = q / (4 * ntn), rem = q - g4 * 4 * ntn, tn = rem >> 2, tm = xcd * tmx + g4 * 4 + (rem & 3);
            gemm_tile_i8<MT>(A, M, as, Bt, N, bs, K, tm * 128 * MT, tn * 256, epi, lds, tid);
        }
        return;
    }
    for (int t = blockIdx.x; t < nt; t += gridDim.x) {
        const int tn = t / ntm, tm = t % ntm;
        gemm_tile_i8<MT>(A, M, as, Bt, N, bs, K, tm * 128 * MT, tn * 256, epi, lds, tid);
    }
}

DI void wquant_rows(const bf16_t* __restrict__ src, unsigned char* __restrict__ dst, float* __restrict__ sc, int nrows, int gw, int nw, int lane) {
    for (int n = gw; n < nrows; n += nw) {
        const u32x4 a = *(const u32x4*)(src + (long)n * 1024 + 16 * lane), b = *(const u32x4*)(src + (long)n * 1024 + 16 * lane + 8);
        float v[16];
        v[0] = bflo(a.x); v[1] = bfhi(a.x); v[2] = bflo(a.y); v[3] = bfhi(a.y); v[4] = bflo(a.z); v[5] = bfhi(a.z); v[6] = bflo(a.w); v[7] = bfhi(a.w);
        v[8] = bflo(b.x); v[9] = bfhi(b.x); v[10] = bflo(b.y); v[11] = bfhi(b.y); v[12] = bflo(b.z); v[13] = bfhi(b.z); v[14] = bflo(b.w); v[15] = bfhi(b.w);
        float am = 0.f;
#pragma unroll
        for (int q = 0; q < 16; ++q) am = fmaxf(am, fabsf(v[q]));
        am = wave_max(am);
        const float qs = am > 0.f ? 127.f / am : 1.f;
        u32x4 o;
        o.x = (unsigned)pack_i8x4(v[0] * qs, v[1] * qs, v[2] * qs, v[3] * qs); o.y = (unsigned)pack_i8x4(v[4] * qs, v[5] * qs, v[6] * qs, v[7] * qs);
        o.z = (unsigned)pack_i8x4(v[8] * qs, v[9] * qs, v[10] * qs, v[11] * qs); o.w = (unsigned)pack_i8x4(v[12] * qs, v[13] * qs, v[14] * qs, v[15] * qs);
        *(u32x4*)(dst + (long)n * 1024 + 16 * lane) = o;
        if (lane == 0) sc[n] = am > 0.f ? am * (1.f / 127.f) : 1.f;
    }
}
DI void phase_wquant(unsigned char* ws, int tid) {
    const int lane = tid & 63, gw = blockIdx.x * NWAVES + (tid >> 6), nw = gridDim.x * NWAVES;
    float* sc = (float*)(ws + OFF_W8S);
    wquant_rows((const bf16_t*)(ws + OFF_WT_PEER), ws + OFF_W8_PEER, sc + W8S_PEER, 4096, gw, nw, lane);
    wquant_rows((const bf16_t*)(ws + OFF_WT_DIN), ws + OFF_W8_DIN, sc + W8S_DIN, 3072, gw, nw, lane);
    wquant_rows((const bf16_t*)(ws + OFF_WT_KV), ws + OFF_W8_KV, sc + W8S_KV, 1536, gw, nw, lane);
    wquant_rows((const bf16_t*)(ws + OFF_WT_NIN), ws + OFF_W8_NIN, sc + W8S_NIN, 1088, gw, nw, lane);
}

#define XB_TMO      128
#define XB_XCNT(j)  (256  + 64 * (j))
#define XB_XSUB(j)  (1280 + 64 * (j))
#define XB_XGEN(j)  (2304 + 64 * (j))
#define XB_TOP      3328
#define XB_TOPGEN   3392
#define XCD_BAR_WORDS 3456
#define XB_SPIN_CAP (1u << 22)
#define LAS __attribute__((address_space(3)))
DI unsigned xb_ld(unsigned* p) { return __hip_atomic_load(p, __ATOMIC_RELAXED, __HIP_MEMORY_SCOPE_AGENT); }
DI unsigned xb_add(unsigned* p, unsigned v) { return __hip_atomic_fetch_add(p, v, __ATOMIC_RELAXED, __HIP_MEMORY_SCOPE_AGENT); }
DI unsigned xb_xcc_id() { return (unsigned)__builtin_amdgcn_s_getreg((3 << 11) | 20) & 0xFu; }
#define XB_SPIN(cond, bar) do { unsigned _sp = 0; while (cond) { __builtin_amdgcn_s_sleep(1); \
    if ((++_sp & 255u) == 0u) { if (xb_ld(&(bar)[XB_TMO])) break; if (_sp > XB_SPIN_CAP) { atomicAdd(&(bar)[XB_TMO], 1u); break; } } } } while (0)
DI void xcd_barrier_complete(unsigned* bar, unsigned x, unsigned& nloc, unsigned& nx) {
    const unsigned G = gridDim.x;
    unsigned sum, cnt, mine, sp = 0u;
    for (;;) {
        sum = 0u; cnt = 0u; mine = 0u;
#pragma unroll
        for (unsigned j = 0; j < 16; ++j) { const unsigned c = xb_ld(&bar[XB_XCNT(j)]); sum += c; cnt += (c > 0u) ? 1u : 0u; mine = (j == x) ? c : mine; }
        if (sum == G) break;
        __builtin_amdgcn_s_sleep(1);
        if ((++sp & 255u) == 0u) { if (xb_ld(&bar[XB_TMO])) break; if (sp > XB_SPIN_CAP) { atomicAdd(&bar[XB_TMO], 1u); break; } }
    }
    nloc = mine > 0u ? mine : 1u; nx = cnt > 0u ? cnt : 1u;
}
DI void xcd_barrier(unsigned* bar, volatile LAS unsigned* st, int tid) {
    asm volatile("s_waitcnt vmcnt(0)" ::: "memory");
    __syncthreads();
    if (tid == 0) {
        const unsigned x = xb_xcc_id();
        __builtin_amdgcn_s_waitcnt(0);
        unsigned nloc = st[0], nx = st[1];
        if (nloc == 0u) { xcd_barrier_complete(bar, x, nloc, nx); st[0] = nloc; st[1] = nx; }
        const unsigned old = xb_add(&bar[XB_XSUB(x)], 1u);
        const unsigned gen = old / nloc;
        if (old + 1u == (gen + 1u) * nloc) {
            __builtin_amdgcn_fence(__ATOMIC_RELEASE, "agent");
            asm volatile("s_waitcnt vmcnt(0)" ::: "memory");
            const unsigned og = xb_add(&bar[XB_TOP], 1u);
            const unsigned tg = og / nx;
            if (og + 1u == (tg + 1u) * nx) xb_add(&bar[XB_TOPGEN], 1u);
            else XB_SPIN(xb_ld(&bar[XB_TOPGEN]) == tg, bar);
            __builtin_amdgcn_fence(__ATOMIC_ACQUIRE, "agent");
            xb_add(&bar[XB_XGEN(x)], 1u);
            asm volatile("s_waitcnt vmcnt(0)" ::: "memory");
        } else {
            XB_SPIN(xb_ld(&bar[XB_XGEN(x)]) == gen, bar);
            __builtin_amdgcn_fence(__ATOMIC_ACQUIRE, "agent");
            asm volatile("s_waitcnt vmcnt(0)" ::: "memory");
        }
    }
    __syncthreads();
}

#define ftid() ftid_(wave_u)
DI int ftid_(int wave_u) { int t = (wave_u << 6) + (int)__builtin_amdgcn_mbcnt_hi(~0u, __builtin_amdgcn_mbcnt_lo(~0u, 0u)); asm volatile("" : "+v"(t)); return t; }


#if defined(__HIP_DEVICE_COMPILE__)
typedef const __attribute__((address_space(4))) Params* KParamPtr;
DI Params load_params() { KParamPtr kp = (KParamPtr)__builtin_amdgcn_kernarg_segment_ptr(); asm volatile("" : "+s"(kp)); return *kp; }
#else
DI Params load_params() { return Params{}; }
#endif
#define p (load_params())
#define ws (load_params().ws)
#define ada ((const float*)(ws + OFF_ADA))
#define Hb ((bf16_t*)(ws + OFF_H))
#define bar ((unsigned*)(ws + OFF_BAR))
__global__ void __launch_bounds__(NTHREADS) yoco_fwd(Params p_arg) {
    extern __shared__ __attribute__((aligned(16))) unsigned char lds[];
    cg::grid_group grid = cg::this_grid();
    volatile LAS unsigned* bst = (volatile LAS unsigned*)(lds + 144 * 1024);
    const int wave_u = __builtin_amdgcn_readfirstlane((int)(threadIdx.x >> 6));
    { const int t0 = ftid(); if (t0 == 0) { bst[0] = 0u; bst[1] = 0u; }
      if (blockIdx.x == 0) for (int i = t0; i < XCD_BAR_WORDS; i += NTHREADS) bar[i] = 0u; }
    __syncthreads();
    RUN(0) REP(0) phase_prep(p, lds, ftid());
    grid.sync();
    if (ftid() == 0) (void)xb_add(&bar[XB_XCNT(xb_xcc_id())], 1u);
    RUN(1) REP(1) phase_norm_q8<false>(p.in[0], Hb, ws + OFF_H8, (float*)(ws + OFF_HS), p.in[5], ada, 0, 1024, ftid());
    RUN(1) phase_wquant(ws, ftid());
    xcd_barrier(bar, bst, ftid());
    RUN(2) REP(2) {
        EpiQKV0 e{(bf16_t*)(ws + OFF_Q0), (bf16_t*)(ws + OFF_K0), (bf16_t*)(ws + OFF_VT0), p.in[10], p.in[11], (float*)(ws + OFF_MB0), p.in[2]};
        gemm_phase_i8<2>(ws + OFF_H8, NTOK, (const float*)(ws + OFF_HS), ws + OFF_W8_DIN, 3072, (const float*)(ws + OFF_W8S) + W8S_DIN, DM, e, lds, ftid());
    }
    xcd_barrier(bar, bst, ftid());
    RUN(3) REP(3) phase_diff_attn(p, lds, ftid());
    xcd_barrier(bar, bst, ftid());
    RUN(4) REP(4) {
        EpiResid e{p.in[0], opq(p.out), ada + 2 * 1024};
        gemm_phase<2>(Hb, DM, NTOK, (const bf16_t*)(ws + OFF_WT_DOUT), DM, 1024, DM, e, lds, ftid());
    }
    xcd_barrier(bar, bst, ftid());
    if (STOP_AFTER <= 1) return;
    RUN(1) phase_norm_q8<false>(opq(p.out), Hb, ws + OFF_H8, (float*)(ws + OFF_HS), p.in[6], ada, 3 * 1024, 4 * 1024, ftid());
    xcd_barrier(bar, bst, ftid());
    RUN(5) REP(5) {
        EpiPeer e{(int*)(ws + OFF_RIDX), (float*)(ws + OFF_RGATE), 128 * 1024};
        gemm_phase_i8<2>(ws + OFF_H8, NTOK, (const float*)(ws + OFF_HS), ws + OFF_W8_PEER, 2048, (const float*)(ws + OFF_W8S) + W8S_PEER, DM, e, lds, ftid());
    }
    xcd_barrier(bar, bst, ftid());
    if ((REPEAT_MASK >> 6) & 1) phase_peer_u<true>(p, 0, lds, ftid());
    RUN(6) phase_peer_u<false>(p, 0, lds, ftid());
    xcd_barrier(bar, bst, ftid());
    if ((REPEAT_MASK >> 10) & 1) phase_peer_v<true>(p, 0, ftid());
    RUN(6) phase_peer_v<false>(p, 0, ftid());
    xcd_barrier(bar, bst, ftid());
    RUN(1) phase_norm2(opq(p.out), ws + OFF_H8, (float*)(ws + OFF_HS), p.in[13], 12288, 12288 + 1024, ws + OFF_H, (float*)(ws + OFF_HS) + NTOK, p.in[5] + 1024, 6144, 6144 + 1024, ada, ftid());
    xcd_barrier(bar, bst, ftid());
    if (STOP_AFTER <= 2) return;
    RUN(7) REP(7) {
        EpiKV e{(bf16_t*)(ws + OFF_KC), (bf16_t*)(ws + OFF_KS), (bf16_t*)(ws + OFF_VST), (bf16_t*)(ws + OFF_KW), (bf16_t*)(ws + OFF_VWT), p.in[21]};
        gemm_phase_i8<2>(ws + OFF_H8, NTOK, (const float*)(ws + OFF_HS), ws + OFF_W8_KV, 1536, (const float*)(ws + OFF_W8S) + W8S_KV, DM, e, lds, ftid());
    }
    xcd_barrier(bar, bst, ftid());
    RUN(8) REP(8) {
        EpiNsaQ e{(bf16_t*)(ws + OFF_QN), (float*)(ws + OFF_GATES), p.in[25], p.in[23], (float*)(ws + OFF_MB1)};
        gemm_phase_i8<2>(ws + OFF_H, NTOK, (const float*)(ws + OFF_HS) + NTOK, ws + OFF_W8_NIN, 1048, (const float*)(ws + OFF_W8S) + W8S_NIN, DM, e, lds, ftid());
        for (int t = blockIdx.x; t < 64; t += gridDim.x) {
            const int pr = t >> 2, tm = t & 3, kv = pr >> 3, bg = pr & 7;
            const bf16_t* Ap = (const bf16_t*)(ws + OFF_KC) + (long)(kv * 8 + bg) * SEQ * 128;
            bf16_t* hid = (bf16_t*)(ws + OFF_HID) + (long)pr * 512 * 256;
            EpiCmp1 e1{hid, (const float*)(ws + OFF_POSB) + kv * 16 * 256, p.in[19] + kv * 256};
            gemm_tile<1>(Ap, 2048, 511, (const bf16_t*)(ws + OFF_WT_C1) + (long)kv * 256 * 4096, 4096, 256, 4096, tm * 128, 0, e1, lds, ftid());
            __syncthreads();
            bf16_t* dst = kv == 0 ? (bf16_t*)(ws + OFF_KCMP) + (long)bg * 512 * 128 : (bf16_t*)(ws + OFF_VCMPT) + (long)bg * 128 * 512;
            EpiCmp2 e2{dst, p.in[21], kv};
            gemm_tile<1>(hid, 256, 512, (const bf16_t*)(ws + OFF_WT_C2) + (long)kv * 128 * 256, 256, 128, 256, tm * 128, 0, e2, lds, ftid());
        }
    }
    xcd_barrier(bar, bst, ftid());
#ifdef NSA_PROBE
    phase_nsa_attn<NSA_PROBE>(p, lds, ftid());
#endif
    RUN(9) REP(9) phase_nsa_attn<0>(p, lds, ftid());
    xcd_barrier(bar, bst, ftid());
    RUN(4) {
        float* xo = opq(p.out);
        EpiResid e{xo, xo, ada + 6144 + 2 * 1024};
        gemm_phase<2>(Hb, DM, NTOK, (const bf16_t*)(ws + OFF_WT_NOUT), DM, 1024, DM, e, lds, ftid());
    }
    xcd_barrier(bar, bst, ftid());
    if (STOP_AFTER <= 3) return;
    RUN(1) phase_norm_q8<false>(opq(p.out), Hb, ws + OFF_H8, (float*)(ws + OFF_HS), p.in[6] + 1024, ada, 6144 + 3 * 1024, 6144 + 4 * 1024, ftid());
    xcd_barrier(bar, bst, ftid());
    RUN(5) REP(5) {
        EpiPeer e{(int*)(ws + OFF_RIDX), (float*)(ws + OFF_RGATE), 128 * 1024};
        gemm_phase_i8<2>(ws + OFF_H8, NTOK, (const float*)(ws + OFF_HS), ws + OFF_W8_PEER + (long)2048 * 1024, 2048, (const float*)(ws + OFF_W8S) + W8S_PEER + 2048, DM, e, lds, ftid());
    }
    xcd_barrier(bar, bst, ftid());
    if ((REPEAT_MASK >> 6) & 1) phase_peer_u<true>(p, 1, lds, ftid());
    RUN(6) phase_peer_u<false>(p, 1, lds, ftid());
    xcd_barrier(bar, bst, ftid());
    if ((REPEAT_MASK >> 10) & 1) phase_peer_v<true>(p, 1, ftid());
    RUN(6) phase_peer_v<false>(p, 1, ftid());
}
#undef p
#undef ws
#undef ada
#undef Hb
#undef bar

extern "C" void kernel_launch(void* const* d_in, const int* in_sizes, int n_in, void* d_out, int out_size, void* d_ws, size_t ws_size,
                              hipStream_t stream) {
    static int grid_blocks = 0;
    if (grid_blocks == 0) {
        if (n_in != 30 || out_size != NTOK * DM || ws_size < WS_END) {
            fprintf(stderr, "kernel_launch: unexpected shapes (n_in %d out %d ws %zu)\n", n_in, out_size, ws_size);
            grid_blocks = -1; return;
        }
        int dev = 0, cus = 0, per_cu = 0;
        hipGetDevice(&dev);
        hipDeviceGetAttribute(&cus, hipDeviceAttributeMultiprocessorCount, dev);
        hipFuncSetAttribute((const void*)yoco_fwd, hipFuncAttributeMaxDynamicSharedMemorySize, LDS_BYTES);
        hipOccupancyMaxActiveBlocksPerMultiprocessor(&per_cu, (const void*)yoco_fwd, NTHREADS, LDS_BYTES);
        if (per_cu < 1) { fprintf(stderr, "kernel_launch: occupancy query says %d blocks per CU\n", per_cu); grid_blocks = -1; return; }
        grid_blocks = cus;
    }
    if (grid_blocks < 0) return;
    Params p{};
    for (int i = 0; i < 30; ++i) p.in[i] = (const float*)d_in[i];
    p.out = (float*)d_out;
    p.ws = (unsigned char*)d_ws;
    void* args[] = {&p};
    hipError_t e = hipLaunchCooperativeKernel((const void*)yoco_fwd, dim3(grid_blocks), dim3(NTHREADS), args, LDS_BYTES, stream);
    if (e != hipSuccess) fprintf(stderr, "cooperative launch failed: %s (grid %d)\n", hipGetErrorString(e), grid_blocks);
}
```

```cpp
#include <hip/hip_runtime.h>
#include <hip/hip_cooperative_groups.h>
#include <cstdio>
#include <cstdint>
namespace cg = cooperative_groups;

#define DI __device__ __forceinline__
#ifndef STOP_AFTER
#define STOP_AFTER 99
#endif
#ifndef ONLY_PHASE
#define ONLY_PHASE -1
#endif
#define RUN(n) if (ONLY_PHASE < 0 || ONLY_PHASE == (n))
#ifndef REPEAT_MASK
#define REPEAT_MASK 0
#endif
#define REP(n) for (int rep_ = 0; rep_ < (((REPEAT_MASK) >> (n)) & 1) + 1; ++rep_)

typedef unsigned short bf16_t;
typedef short bf16x8 __attribute__((ext_vector_type(8)));
typedef float f32x16 __attribute__((ext_vector_type(16)));
typedef float f32x4 __attribute__((ext_vector_type(4)));
typedef float f32x2 __attribute__((ext_vector_type(2)));
typedef unsigned u32x4 __attribute__((ext_vector_type(4)));
typedef unsigned u32x2 __attribute__((ext_vector_type(2)));
typedef __bf16 bf16x2v __attribute__((ext_vector_type(2)));

#define MFMA32(a, b, c) __builtin_amdgcn_mfma_f32_32x32x16_bf16((a), (b), (c), 0, 0, 0)
typedef int i32x4 __attribute__((ext_vector_type(4)));
typedef int i32x16 __attribute__((ext_vector_type(16)));
#define MFMA32I8(a, b, c) __builtin_amdgcn_mfma_i32_32x32x32_i8((a), (b), (c), 0, 0, 0)

constexpr int NB = 4, SEQ = 8192, DM = 1024, NTOK = NB * SEQ;
constexpr int NTHREADS = 512, NWAVES = 8;
constexpr float EPS = 1e-6f;
constexpr float LOG2E = 1.4426950408889634f;
constexpr int ADA_STRIDE = 14336;

constexpr size_t MB = 1u << 20;
constexpr size_t OFF_ADA = 0;
constexpr size_t OFF_POSB = 256 * 1024;
constexpr size_t OFF_BAR = 320 * 1024;
constexpr size_t OFF_MB0 = 168 * MB;
constexpr size_t OFF_MB1 = 172 * MB;
constexpr size_t OFF_H8 = 104 * MB;
constexpr size_t OFF_HS = 174 * MB;
constexpr size_t OFF_W8 = 176 * MB;
constexpr size_t OFF_W8_DIN = OFF_W8, OFF_W8_KV = OFF_W8 + 3 * MB, OFF_W8_NIN = OFF_W8 + 5 * MB, OFF_W8_PEER = OFF_W8 + 7 * MB;
constexpr size_t OFF_W8S = 188 * MB;
constexpr int W8S_DIN = 0, W8S_KV = 3072, W8S_NIN = 4608, W8S_PEER = 5760, W8S_TOTAL = 9856;
constexpr size_t OFF_USI = 384 * 1024;
constexpr size_t OFF_VSI = 512 * 1024;
constexpr size_t OFF_WT_DIN = 1 * MB;
constexpr size_t OFF_WT_DOUT = 7 * MB;
constexpr size_t OFF_WT_KV = 9 * MB;
constexpr size_t OFF_WT_NIN = 12 * MB;
constexpr size_t OFF_WT_NOUT = 15 * MB;
constexpr size_t OFF_WT_PEER = 17 * MB;
constexpr size_t OFF_WT_C1 = 25 * MB;
constexpr size_t OFF_WT_C2 = 29 * MB;
constexpr size_t OFF_GATES = 30 * MB;
constexpr size_t OFF_KCMP = 34 * MB;
constexpr size_t OFF_VCMPT = 35 * MB;
constexpr size_t OFF_HID = 36 * MB;
constexpr size_t OFF_RIDX = 40 * MB;
constexpr size_t OFF_RGATE = 56 * MB;
constexpr size_t OFF_PU = 72 * MB;
constexpr size_t OFF_PV = 136 * MB;
constexpr size_t OFF_H = 200 * MB;
constexpr size_t OFF_R = 264 * MB;
constexpr size_t WS_END = 456 * MB;
constexpr size_t OFF_Q0 = OFF_R, OFF_K0 = OFF_R + 64 * MB, OFF_VT0 = OFF_R + 128 * MB;
constexpr size_t OFF_QN = OFF_R, OFF_H2 = OFF_R, OFF_KC = OFF_R + 64 * MB, OFF_KS = OFF_R + 96 * MB, OFF_VST = OFF_R + 112 * MB,
                 OFF_KW = OFF_R + 128 * MB, OFF_VWT = OFF_R + 144 * MB;

constexpr int LDS_BYTES = 144 * 1024 + 256;

struct Params {
    const float* in[30];
    float* out;
    unsigned char* ws;
};

template <class T> DI T* opq(T* q) { asm volatile("" : "+s"(q)); return (T*)(__attribute__((address_space(1))) T*)q; }
DI unsigned pk2(float lo, float hi) { f32x2 v = {lo, hi}; return __builtin_bit_cast(unsigned, __builtin_convertvector(v, bf16x2v)); }
DI bf16_t f2bf(float x) { return (bf16_t)(pk2(x, 0.f) & 0xffffu); }
DI float bflo(unsigned u) { return __uint_as_float(u << 16); }
DI float bfhi(unsigned u) { return __uint_as_float(u & 0xffff0000u); }
DI float fexp2(float x) { return __builtin_amdgcn_exp2f(x); }
DI float frcp(float x) { return __builtin_amdgcn_rcpf(x); }
DI int crow(int reg, int h) { return (reg & 3) + 8 * (reg >> 2) + 4 * h; }
template <int CTRL> DI float dpp_f(float v) { return __builtin_bit_cast(float, __builtin_amdgcn_update_dpp(0, __builtin_bit_cast(int, v), CTRL, 0xF, 0xF, true)); }
DI float lx1(float v) { return dpp_f<0xB1>(v); }
DI float lx2(float v) { return dpp_f<0x4E>(v); }
DI float lhm(float v) { return dpp_f<0x141>(v); }
DI float lr8(float v) { return dpp_f<0x128>(v); }
DI float sum_x16(float v) { auto s = __builtin_amdgcn_permlane16_swap(__float_as_uint(v), __float_as_uint(v), false, false); return __uint_as_float(s[0]) + __uint_as_float(s[1]); }
DI float sum_x32(float v) { auto s = __builtin_amdgcn_permlane32_swap(__float_as_uint(v), __float_as_uint(v), false, false); return __uint_as_float(s[0]) + __uint_as_float(s[1]); }
DI float max_x16(float v) { auto s = __builtin_amdgcn_permlane16_swap(__float_as_uint(v), __float_as_uint(v), false, false); return fmaxf(__uint_as_float(s[0]), __uint_as_float(s[1])); }
DI float max_x32(float v) { auto s = __builtin_amdgcn_permlane32_swap(__float_as_uint(v), __float_as_uint(v), false, false); return fmaxf(__uint_as_float(s[0]), __uint_as_float(s[1])); }
DI unsigned get_x32(unsigned v, int h) { auto s = __builtin_amdgcn_permlane32_swap(v, v, false, false); return h ? s[0] : s[1]; }
DI float wave_sum(float v) { v += lx1(v); v += lx2(v); v += lhm(v); v += lr8(v); v = sum_x16(v); return sum_x32(v); }
DI float wave_max(float v) { v = fmaxf(v, lx1(v)); v = fmaxf(v, lx2(v)); v = fmaxf(v, lhm(v)); v = fmaxf(v, lr8(v)); v = max_x16(v); return max_x32(v); }
DI int bperm(int v, int srclane) { return __builtin_amdgcn_ds_bpermute(srclane << 2, v); }
DI float bpermf(float v, int srclane) { return __builtin_bit_cast(float, __builtin_amdgcn_ds_bpermute(srclane << 2, __builtin_bit_cast(int, v))); }
DI float gelu_tanh(float x) {
    const float u = 0.7978845608028654f * (x + 0.044715f * x * x * x);
    return x * frcp(1.f + fexp2(-2.f * LOG2E * u));
}
DI float dot2bf(unsigned a, unsigned b, float c) {
    return __builtin_amdgcn_fdot2_f32_bf16(__builtin_bit_cast(bf16x2v, a), __builtin_bit_cast(bf16x2v, b), c, false);
}
DI int rel_bucket_i(int d) {
    if (d < 16) return d < 0 ? 0 : d;
    int b = 16;
    b += d >= 21; b += d >= 27; b += d >= 35; b += d >= 46; b += d >= 59; b += d >= 77; b += d >= 99; b += d >= 128;
    b += d >= 166; b += d >= 216; b += d >= 280; b += d >= 363; b += d >= 470; b += d >= 609; b += d >= 790;
    return b;
}
DI unsigned f2key(float f) { unsigned u = __float_as_uint(f); return u ^ ((unsigned)((int)u >> 31) | 0x80000000u); }
DI float key2f(unsigned k) { unsigned u = (k & 0x80000000u) ? (k ^ 0x80000000u) : ~k; return __uint_as_float(u); }

constexpr int EPI_LDS = 96 * 1024;

DI int sw2(int row, int chunk) { return (row >> 1) * 256 + (((((row & 1) << 3) | chunk) ^ ((row >> 1) & 15)) << 4); }
DI void sw2_src(int P, int& row, int& chunk) { const int R2 = P >> 4, lc = (P & 15) ^ (R2 & 15); row = 2 * R2 + (lc >> 3); chunk = lc & 7; }

template <class T, class = void> struct epi_stash { static constexpr bool value = false, present = false; };
template <class T> struct epi_stash<T, decltype((void)T::STASH)> { static constexpr bool value = T::STASH, present = true; };

template <int MT, class Epi>
DI void gemm_tile(const bf16_t* __restrict__ A, long lda, int M, const bf16_t* __restrict__ Bt, long ldb, int N, int K,
                  int m0, int n0, const Epi& epi, unsigned char* lds, int tid) {
    constexpr int XS = MT * 128 * 128, WS = 256 * 128, STAGE = XS + WS;
    const int lane = tid & 63, w = tid >> 6, tg = w & 3, fh = w >> 2, r = lane & 31, h = lane >> 5;
    const int wbase = tid & ~63;
    unsigned xo[2 * MT], wo[4];
#pragma unroll
    for (int i = 0; i < 2 * MT; ++i) { int row, c; sw2_src(tid + 512 * i, row, c); int m = m0 + row; m = m < M ? m : M - 1; xo[i] = (unsigned)m * (unsigned)(lda * 2) + c * 16; }
#pragma unroll
    for (int i = 0; i < 4; ++i) { int row, c; sw2_src(tid + 512 * i, row, c); int n = n0 + row; n = n < N ? n : N - 1; wo[i] = (unsigned)n * (unsigned)(ldb * 2) + c * 16; }
    const unsigned char* Ab = (const unsigned char*)A;
    const unsigned char* Bb = (const unsigned char*)Bt;
    auto stage = [&](int kt, unsigned char* st) {
#pragma unroll
        for (int i = 0; i < 2 * MT; ++i)
            __builtin_amdgcn_global_load_lds((const unsigned*)(Ab + kt * 128 + xo[i]), (unsigned*)(st + (wbase + 512 * i) * 16), 16, 0, 0);
#pragma unroll
        for (int i = 0; i < 4; ++i)
            __builtin_amdgcn_global_load_lds((const unsigned*)(Bb + kt * 128 + wo[i]), (unsigned*)(st + XS + (wbase + 512 * i) * 16), 16, 0, 0);
    };
    f32x16 acc[MT][4];
#pragma unroll
    for (int s2 = 0; s2 < MT; ++s2)
#pragma unroll
        for (int i = 0; i < 4; ++i)
#pragma unroll
            for (int j = 0; j < 16; ++j) acc[s2][i][j] = 0.f;
    const int nk = K >> 6;
    stage(0, lds);
    __syncthreads();
    for (int kt = 0; kt < nk; ++kt) {
        unsigned char* cur = lds + (kt & 1) * STAGE;
        if (kt + 1 < nk) stage(kt + 1, lds + ((kt + 1) & 1) * STAGE);
        bf16x8 xfa[MT], wfa[4], xfb[MT], wfb[4];
        auto ldf = [&](bf16x8 (&xf)[MT], bf16x8 (&wf)[4], int ks) {
#pragma unroll
            for (int s2 = 0; s2 < MT; ++s2) xf[s2] = *(const bf16x8*)(cur + sw2(32 * MT * tg + 32 * s2 + r, 2 * ks + h));
#pragma unroll
            for (int mt = 0; mt < 4; ++mt) wf[mt] = *(const bf16x8*)(cur + XS + sw2(128 * fh + 32 * mt + r, 2 * ks + h));
        };
        auto mm = [&](const bf16x8 (&xf)[MT], const bf16x8 (&wf)[4]) {
#pragma unroll
            for (int mt = 0; mt < 4; ++mt)
#pragma unroll
                for (int s2 = 0; s2 < MT; ++s2) acc[s2][mt] = MFMA32(wf[mt], xf[s2], acc[s2][mt]);
        };
        ldf(xfa, wfa, 0);
        ldf(xfb, wfb, 1); __builtin_amdgcn_sched_barrier(0); mm(xfa, wfa); __builtin_amdgcn_sched_barrier(0);
        ldf(xfa, wfa, 2); __builtin_amdgcn_sched_barrier(0); mm(xfb, wfb); __builtin_amdgcn_sched_barrier(0);
        ldf(xfb, wfb, 3); __builtin_amdgcn_sched_barrier(0); mm(xfa, wfa); __builtin_amdgcn_sched_barrier(0);
        mm(xfb, wfb);
        __syncthreads();
    }
    if constexpr (MT == 2 && epi_stash<Epi>::value) {
        float* sp = (float*)lds + w * 4096 + lane;
#pragma unroll
        for (int mt = 0; mt < 4; ++mt)
#pragma unroll
            for (int j = 0; j < 16; ++j) sp[(mt * 16 + j) * 64] = acc[1][mt][j];
        epi(acc[0], m0 + 64 * tg + r, n0 + 128 * fh, h, lds, tid);
        f32x16 a2[4];
        const float* sp2 = sp; asm volatile("" : "+v"(sp2));
#pragma unroll
        for (int mt = 0; mt < 4; ++mt)
#pragma unroll
            for (int j = 0; j < 16; ++j) a2[mt][j] = sp2[(mt * 16 + j) * 64];
        epi(a2, m0 + 64 * tg + 32 + r, n0 + 128 * fh, h, lds, tid);
        __syncthreads();
    } else {
        int ho = h, ro = r, to = tid;
        if constexpr (epi_stash<Epi>::present) asm volatile("" : "+v"(ho), "+v"(ro), "+v"(to));
#pragma unroll
        for (int s2 = 0; s2 < MT; ++s2) epi(acc[s2], m0 + 32 * MT * tg + 32 * s2 + ro, n0 + 128 * fh, ho, lds, to);
    }
}

DI void store_vt_tile(bf16_t* base, long rstride, const f32x16& a, int row0, int h, int lane) {
    const bool odd = lane & 1;
#pragma unroll
    for (int rg = 0; rg < 16; rg += 2) {
        const float xa = lx1(a[rg]), xb = lx1(a[rg + 1]);
        const unsigned wv = odd ? pk2(xb, a[rg + 1]) : pk2(a[rg], xa);
        bf16_t* dp = base + (long)(row0 + crow(odd ? rg + 1 : rg, h)) * rstride - (odd ? 1 : 0);
        *(unsigned*)dp = wv;
    }
}
struct EpiQKV0 {
    bf16_t *Q, *Kk, *VT;
    const float *qg, *kg;
    float* MB; const float* relb;
    DI void operator()(const f32x16 (&acc)[4], int tok, int fbase, int h, unsigned char*, int) const {
        const int sec = fbase >> 10, hd = (fbase & 1023) >> 7, b = tok >> 13, s = tok & (SEQ - 1);
        if (sec < 2) {
            const float* gn = sec == 0 ? qg : kg;
            const float sc = sec == 0 ? 0.125f * LOG2E : 1.f;
            bf16_t* dst = sec == 0 ? Q : Kk;
#pragma unroll
            for (int j = 0; j < 2; ++j) {
                float ss = 0.f;
#pragma unroll
                for (int mt = 0; mt < 2; ++mt)
#pragma unroll
                    for (int rg = 0; rg < 16; ++rg) { const float v = acc[2 * j + mt][rg]; ss += v * v; }
                ss = sum_x32(ss);
                const float rstd = rsqrtf(ss * (1.f / 64.f) + EPS) * sc;
                bf16_t* row = dst + ((long)((b * 8 + hd) * 2 + j) * SEQ + s) * 64;
                float qq = 0.f;
#pragma unroll
                for (int mt = 0; mt < 2; ++mt)
#pragma unroll
                    for (int g4 = 0; g4 < 4; ++g4) {
                        const int d0 = 32 * mt + 8 * g4 + 4 * h;
                        const f32x4 gv = *(const f32x4*)(gn + d0);
                        const float v0 = acc[2 * j + mt][4 * g4 + 0] * rstd * gv.x, v1 = acc[2 * j + mt][4 * g4 + 1] * rstd * gv.y;
                        const float v2 = acc[2 * j + mt][4 * g4 + 2] * rstd * gv.z, v3 = acc[2 * j + mt][4 * g4 + 3] * rstd * gv.w;
                        qq += v0 * v0 + v1 * v1 + v2 * v2 + v3 * v3;
                        u32x2 o;
                        o.x = pk2(v0, v1); o.y = pk2(v2, v3);
                        *(u32x2*)(row + d0) = o;
                    }
                if (sec == 0) {
                    qq = sum_x32(qq);
                    float kmx = 0.f;
                    for (int d = 0; d < 64; ++d) kmx = fmaxf(kmx, fabsf(kg[d]));
                    float bmx = 0.f;
                    for (int bk = 0; bk < 32; ++bk) bmx = fmaxf(bmx, relb[bk * 8 + hd] - relb[31 * 8 + hd]);
                    if (h == 0) MB[(long)((b * 8 + hd) * 2 + j) * SEQ + s] = 1.01f * sqrtf(qq) * 8.f * kmx + bmx * LOG2E;
                }
            }
        } else {
            bf16_t* base = VT + (long)(b * 8 + hd) * 128 * SEQ + s;
#pragma unroll
            for (int mt = 0; mt < 4; ++mt) store_vt_tile(base, SEQ, acc[mt], 32 * mt, h, tok);
        }
    }
};

struct EpiResid {
    const float* xin; float* xout; const float* gate;
    DI void operator()(const f32x16 (&acc)[4], int tok, int fbase, int h, unsigned char*, int) const {
        const int b = tok >> 13;
        const float* gp = gate + b * ADA_STRIDE;
#pragma unroll
        for (int mt = 0; mt < 4; ++mt)
#pragma unroll
            for (int g4 = 0; g4 < 4; ++g4) {
                const int f = fbase + 32 * mt + 8 * g4 + 4 * h;
                const f32x4 xv = *(const f32x4*)(xin + (long)tok * DM + f);
                const f32x4 gv = *(const f32x4*)(gp + f);
                f32x4 o;
                o.x = xv.x + gv.x * acc[mt][4 * g4 + 0]; o.y = xv.y + gv.y * acc[mt][4 * g4 + 1];
                o.z = xv.z + gv.z * acc[mt][4 * g4 + 2]; o.w = xv.w + gv.w * acc[mt][4 * g4 + 3];
                *(f32x4*)(xout + (long)tok * DM + f) = o;
                if (g4 == 3) __builtin_amdgcn_sched_barrier(0);
            }
    }
};

struct EpiKV {
    bf16_t *KC, *KS, *VST, *KW, *VWT;
    const float* kgain;
    DI void operator()(const f32x16 (&acc)[4], int tok, int fbase, int h, unsigned char*, int) const {
        const int c = fbase >> 7, br = c >> 2, kv = (c >> 1) & 1, g = c & 1, b = tok >> 13, s = tok & (SEQ - 1);
        if (br == 0 || kv == 0) {
            float rstd = 1.f;
            bf16_t* row;
            if (br == 0) row = KC + ((long)((kv * 4 + b) * 2 + g) * SEQ + s) * 128;
            else {
                float ss = 0.f;
#pragma unroll
                for (int mt = 0; mt < 4; ++mt)
#pragma unroll
                    for (int rg = 0; rg < 16; ++rg) ss += acc[mt][rg] * acc[mt][rg];
                ss = sum_x32(ss);
                rstd = rsqrtf(ss * (1.f / 128.f) + EPS);
                row = (br == 1 ? KS : KW) + ((long)(b * 2 + g) * SEQ + s) * 128;
            }
#pragma unroll
            for (int mt = 0; mt < 4; ++mt)
#pragma unroll
                for (int g4 = 0; g4 < 4; ++g4) {
                    const int d0 = 32 * mt + 8 * g4 + 4 * h;
                    f32x4 gv = {1.f, 1.f, 1.f, 1.f};
                    if (br != 0) gv = *(const f32x4*)(kgain + br * 128 + d0);
                    u32x2 o;
                    o.x = pk2(acc[mt][4 * g4 + 0] * rstd * gv.x, acc[mt][4 * g4 + 1] * rstd * gv.y);
                    o.y = pk2(acc[mt][4 * g4 + 2] * rstd * gv.z, acc[mt][4 * g4 + 3] * rstd * gv.w);
                    *(u32x2*)(row + d0) = o;
                }
        } else {
            bf16_t* base = (br == 1 ? VST : VWT) + (long)(b * 2 + g) * 128 * SEQ + s;
#pragma unroll
            for (int mt = 0; mt < 4; ++mt) store_vt_tile(base, SEQ, acc[mt], 32 * mt, h, tok);
        }
    }
};

struct EpiCmp1 {
    bf16_t* hid; const float* posb_part; const float* b1;
    DI void operator()(const f32x16 (&acc)[4], int tok, int fbase, int h, unsigned char*, int) const {
        if (tok >= 512) return;
#pragma unroll
        for (int mt = 0; mt < 4; ++mt)
#pragma unroll
            for (int g4 = 0; g4 < 4; ++g4) {
                const int f = fbase + 32 * mt + 8 * g4 + 4 * h;
                f32x4 pb = *(const f32x4*)(b1 + f);
                for (int c = 0; c < 16; ++c) { const f32x4 t = *(const f32x4*)(posb_part + c * 256 + f); pb.x += t.x; pb.y += t.y; pb.z += t.z; pb.w += t.w; }
                u32x2 o;
                o.x = pk2(gelu_tanh(acc[mt][4 * g4 + 0] + pb.x), gelu_tanh(acc[mt][4 * g4 + 1] + pb.y));
                o.y = pk2(gelu_tanh(acc[mt][4 * g4 + 2] + pb.z), gelu_tanh(acc[mt][4 * g4 + 3] + pb.w));
                *(u32x2*)(hid + (long)tok * 256 + f) = o;
            }
    }
};

struct EpiCmp2 {
    bf16_t* dst; const float* kgain0; int kv;
    DI void operator()(const f32x16 (&acc)[4], int tok, int fbase, int h, unsigned char*, int) const {
        if (fbase != 0 || tok >= 512) return;
        const float valid = tok < 511 ? 1.f : 0.f;
        if (kv == 0) {
            float ss = 0.f;
#pragma unroll
            for (int mt = 0; mt < 4; ++mt)
#pragma unroll
                for (int rg = 0; rg < 16; ++rg) ss += acc[mt][rg] * acc[mt][rg];
            ss = sum_x32(ss);
            const float rstd = rsqrtf(ss * (1.f / 128.f) + EPS) * valid;
#pragma unroll
            for (int mt = 0; mt < 4; ++mt)
#pragma unroll
                for (int g4 = 0; g4 < 4; ++g4) {
                    const int d0 = 32 * mt + 8 * g4 + 4 * h;
                    const f32x4 gv = *(const f32x4*)(kgain0 + d0);
                    u32x2 o;
                    o.x = pk2(acc[mt][4 * g4 + 0] * rstd * gv.x, acc[mt][4 * g4 + 1] * rstd * gv.y);
                    o.y = pk2(acc[mt][4 * g4 + 2] * rstd * gv.z, acc[mt][4 * g4 + 3] * rstd * gv.w);
                    *(u32x2*)(dst + (long)tok * 128 + d0) = o;
                }
        } else {
#pragma unroll
            for (int mt = 0; mt < 4; ++mt)
#pragma unroll
                for (int rg = 0; rg < 16; ++rg) dst[(long)(32 * mt + crow(rg, h)) * 512 + tok] = f2bf(acc[mt][rg] * valid);
        }
    }
};

struct EpiNsaQ {
    bf16_t* QN; float* gates; const float* qgain; const float* bgate; float* qnrm;
    DI void operator()(const f32x16 (&acc)[4], int tok, int fbase, int h, unsigned char*, int) const {
        const int b = tok >> 13, s = tok & (SEQ - 1);
        if (fbase < 1024) {
            const int head = fbase >> 7;
            float ss = 0.f;
#pragma unroll
            for (int mt = 0; mt < 4; ++mt)
#pragma unroll
                for (int rg = 0; rg < 16; ++rg) ss += acc[mt][rg] * acc[mt][rg];
            ss = sum_x32(ss);
            const float rstd = rsqrtf(ss * (1.f / 128.f) + EPS) * (0.08838834764831845f * LOG2E);
            bf16_t* row = QN + ((long)(b * 8 + head) * SEQ + s) * 128;
            float qq = 0.f;
#pragma unroll
            for (int mt = 0; mt < 4; ++mt)
#pragma unroll
                for (int g4 = 0; g4 < 4; ++g4) {
                    const int d0 = 32 * mt + 8 * g4 + 4 * h;
                    const f32x4 gv = *(const f32x4*)(qgain + d0);
                    const float v0 = acc[mt][4 * g4 + 0] * rstd * gv.x, v1 = acc[mt][4 * g4 + 1] * rstd * gv.y;
                    const float v2 = acc[mt][4 * g4 + 2] * rstd * gv.z, v3 = acc[mt][4 * g4 + 3] * rstd * gv.w;
                    qq += v0 * v0 + v1 * v1 + v2 * v2 + v3 * v3;
                    u32x2 o;
                    o.x = pk2(v0, v1); o.y = pk2(v2, v3);
                    *(u32x2*)(row + d0) = o;
                }
            qq = sum_x32(qq);
            if (h == 0) qnrm[(long)tok * 8 + head] = 1.01f * sqrtf(qq);
        } else if (fbase == 1024) {
#pragma unroll
            for (int rg = 0; rg < 16; ++rg) {
                const int f = crow(rg, h);
                if (f < 24) { const float z = acc[0][rg] + bgate[f]; gates[(long)tok * 24 + f] = frcp(1.f + fexp2(-LOG2E * z)); }
            }
        }
    }
};

DI void ce_desc(unsigned& a, unsigned& b) { const unsigned hi = a > b ? a : b, lo = a > b ? b : a; a = hi; b = lo; }
DI void sort16_desc(unsigned (&a)[16]) {
#pragma unroll
    for (int k = 2; k <= 16; k <<= 1)
#pragma unroll
        for (int j = k >> 1; j > 0; j >>= 1)
#pragma unroll
            for (int i = 0; i < 16; ++i) {
                const int l = i ^ j;
                if (l > i) { if ((i & k) == 0 || k == 16) ce_desc(a[i], a[l]); else ce_desc(a[l], a[i]); }
            }
}
DI void bitonic_merge16_desc(unsigned (&a)[16]) {
#pragma unroll
    for (int st = 8; st >= 1; st >>= 1)
#pragma unroll
        for (int i = 0; i < 16; ++i)
            if ((i & st) == 0) ce_desc(a[i], a[i + st]);
}
DI void merge_top16(unsigned (&a)[16], const unsigned (&b)[16]) {
#pragma unroll
    for (int i = 0; i < 16; ++i) a[i] = a[i] > b[15 - i] ? a[i] : b[15 - i];
    bitonic_merge16_desc(a);
}

struct EpiPeer {
    static constexpr bool STASH = false;
    int* ridx; float* rgate; int ex_off;
    DI void operator()(const f32x16 (&acc)[4], int tok, int fbase, int h, unsigned char* lds, int tid) const {
        const int lane = tid & 63, w = tid >> 6, tg = w & 3, fh = w >> 2, r = lane & 31;
        const int hd = fbase >> 8;
        unsigned* EX = (unsigned*)(lds + ex_off);
        unsigned L[16];
        {
            unsigned G1[16], G2[16], G3[16];
#pragma unroll
            for (int rg = 0; rg < 16; ++rg) {
                const int c = crow(rg, h);
                L[rg] = (f2key(acc[0][rg]) & ~127u) | (unsigned)(127 - c);
                G1[rg] = (f2key(acc[1][rg]) & ~127u) | (unsigned)(127 - 32 - c);
                G2[rg] = (f2key(acc[2][rg]) & ~127u) | (unsigned)(127 - 64 - c);
                G3[rg] = (f2key(acc[3][rg]) & ~127u) | (unsigned)(127 - 96 - c);
            }
            sort16_desc(L); sort16_desc(G1); merge_top16(L, G1);
            sort16_desc(G2); sort16_desc(G3); merge_top16(G2, G3);
            merge_top16(L, G2);
        }
        {
            unsigned P[16];
#pragma unroll
            for (int i = 0; i < 16; ++i) P[i] = get_x32(L[i], h);
            merge_top16(L, P);
        }
        if (h == 0) {
#pragma unroll
            for (int i = 0; i < 16; i += 4) *(u32x4*)(EX + ((fh * 4 + tg) * 32 + r) * 16 + i) = (u32x4){L[i], L[i + 1], L[i + 2], L[i + 3]};
        }
        __syncthreads();
        float xf[4], ys[16];
        {
            const unsigned* l0 = EX + ((0 * 4 + tg) * 32 + r) * 16;
            const unsigned* l1 = EX + ((1 * 4 + tg) * 32 + r) * 16;
            const unsigned* px = h ? l1 : l0;
            const unsigned* py = h ? l0 : l1;
            const u32x4 a = *(const u32x4*)px;
            xf[0] = key2f(a.x & ~127u); xf[1] = key2f(a.y & ~127u); xf[2] = key2f(a.z & ~127u); xf[3] = key2f(a.w & ~127u);
            unsigned Y[16];
#pragma unroll
            for (int i = 0; i < 16; i += 4) { const u32x4 b2 = *(const u32x4*)(py + i); Y[i] = b2.x; Y[i + 1] = b2.y; Y[i + 2] = b2.z; Y[i + 3] = b2.w; }
#pragma unroll
            for (int k = 0; k < 15; ++k) ys[k] = key2f((h ? Y[k + 1] : Y[k]) & ~127u);
            ys[15] = key2f(Y[15] & ~127u);
        }
        auto pkey = [&](int i, int k) -> unsigned {
            const float fs = xf[i] + ys[k];
            const unsigned code = h ? (unsigned)((((k + 1) & 15) << 4) | i) : (unsigned)((i << 4) | k);
            return (f2key(fs) & ~255u) | (255u - code);
        };
        unsigned T[16], E[16];
#pragma unroll
        for (int k = 0; k < 16; ++k) T[k] = pkey(0, k);
        T[15] = h ? 0u : T[15];
#pragma unroll
        for (int k = 1; k <= 7; ++k) E[k - 1] = pkey(1, k);
#pragma unroll
        for (int k = 2; k <= 4; ++k) E[7 + k - 2] = pkey(2, k);
        E[10] = pkey(3, 3);
#pragma unroll
        for (int k = 11; k < 16; ++k) E[k] = 0u;
        sort16_desc(E);
        merge_top16(T, E);
        {
            unsigned P[16];
#pragma unroll
            for (int i = 0; i < 16; ++i) P[i] = get_x32(T[i], h);
            merge_top16(T, P);
        }
        float sc[16], sum = 0.f;
        const float mx = key2f(T[0] & ~255u);
#pragma unroll
        for (int k = 0; k < 16; ++k) { sc[k] = fexp2((key2f(T[k] & ~255u) - mx) * LOG2E); sum += sc[k]; }
        const float inv = frcp(sum);
        if (h == 0) {
            const unsigned* l0 = EX + ((0 * 4 + tg) * 32 + r) * 16;
            const unsigned* l1 = EX + ((1 * 4 + tg) * 32 + r) * 16;
#pragma unroll
            for (int k = 0; k < 16; ++k) {
                if ((k >> 3) != fh) continue;
                const unsigned code = 255u - (T[k] & 255u);
                const int i1 = 127 - (int)(l0[code >> 4] & 127u), i2 = 127 - (int)(l1[code & 15u] & 127u);
                ridx[(long)tok * 128 + hd * 16 + k] = i1 * 128 + i2;
                rgate[(long)tok * 128 + hd * 16 + k] = sc[k] * inv;
            }
        }
        __syncthreads();
    }
};

DI void p0_transpose_item(const float* __restrict__ W, int K, int N, bf16_t* __restrict__ WT, int item, int ntn, unsigned char* lds, int tid) {
    float* tile = (float*)lds;
    const int kb = item / ntn, nb = item % ntn, k0 = kb * 64, n0 = nb * 64;
    {
        const int nn = tid & 63, kk0 = tid >> 6;
#pragma unroll
        for (int i = 0; i < 8; ++i) { const int kk = kk0 + 8 * i; const int n = n0 + nn; tile[kk * 65 + nn] = n < N ? W[(long)(k0 + kk) * N + n] : 0.f; }
    }
    __syncthreads();
    {
        const int n = tid >> 3, c = tid & 7;
        const float* s = tile + (8 * c) * 65 + n;
        u32x4 o;
        o.x = pk2(s[0], s[65]); o.y = pk2(s[2 * 65], s[3 * 65]); o.z = pk2(s[4 * 65], s[5 * 65]); o.w = pk2(s[6 * 65], s[7 * 65]);
        *(u32x4*)(WT + (long)(n0 + n) * K + k0 + 8 * c) = o;
    }
    __syncthreads();
}

DI int pack_i8x4(float a, float b, float c, float d) {
    const int ia = __float2int_rn(a), ib = __float2int_rn(b), ic = __float2int_rn(c), id = __float2int_rn(d);
    return (ia & 255) | ((ib & 255) << 8) | ((ic & 255) << 16) | (id << 24);
}
DI void p0_fp8_item(const float* __restrict__ src, unsigned char* __restrict__ dst, float* __restrict__ sinv, bool sliced, int item, int tid) {
    const int lane = tid & 63, row = item * 8 + (tid >> 6);
    const float* rp = src + (long)row * 1024;
    f32x4 v[4]; float am = 0.f;
#pragma unroll
    for (int j = 0; j < 4; ++j) {
        v[j] = *(const f32x4*)(rp + 4 * lane + 256 * j);
        am = fmaxf(am, fmaxf(fmaxf(fabsf(v[j].x), fabsf(v[j].y)), fmaxf(fabsf(v[j].z), fabsf(v[j].w))));
    }
    am = wave_max(am);
    const float sc = sliced ? (am > 0.f ? exp2f(floorf(log2f(384.f / am))) : 1.f) : (am > 0.f ? 127.f / am : 1.f);
    if (lane == 0) sinv[row] = 1.f / sc;
#pragma unroll
    for (int j = 0; j < 4; ++j) {
        int pk = 0;
        if (sliced) {
            pk = __builtin_amdgcn_cvt_pk_fp8_f32(v[j].x * sc, v[j].y * sc, pk, false);
            pk = __builtin_amdgcn_cvt_pk_fp8_f32(v[j].z * sc, v[j].w * sc, pk, true);
        } else pk = pack_i8x4(v[j].x * sc, v[j].y * sc, v[j].z * sc, v[j].w * sc);
        const int col = 4 * lane + 256 * j;
        unsigned char* d = sliced ? dst + ((long)(col >> 7) * 16384 + row) * 128 + (col & 127) : dst + (long)row * 1024 + col;
        *(int*)d = pk;
    }
}

DI void p0_weff_item(const float* __restrict__ wq, const float* __restrict__ subk, bf16_t* __restrict__ WT, int item, unsigned char* lds, int tid) {
    const int layer = item >> 8, g = (item >> 4) & 15, ct = item & 15, p = g & 1, c0 = ct * 64;
    float* As = (float*)lds;
    float* Bs = As + 64 * 129;
    const float* wql = wq + (long)layer * 1024 * 2048;
    const float* sk = subk + ((long)layer * 2 + p) * 128 * 128;
    for (int e = tid; e < 64 * 128; e += NTHREADS) { const int c = e >> 7, d = e & 127; As[c * 129 + d] = wql[(long)(c0 + c) * 2048 + g * 128 + d]; }
    for (int e = tid; e < 128 * 128; e += NTHREADS) { const int k = e >> 7, d = e & 127; Bs[k * 129 + d] = sk[k * 128 + d]; }
    __syncthreads();
    const int k = tid & 127, cg4 = tid >> 7;
    float acc[16];
#pragma unroll
    for (int i = 0; i < 16; ++i) acc[i] = 0.f;
    for (int d = 0; d < 128; ++d) {
        const float bv = Bs[k * 129 + d];
#pragma unroll
        for (int i = 0; i < 16; ++i) acc[i] += As[(cg4 * 16 + i) * 129 + d] * bv;
    }
    bf16_t* o = WT + ((long)layer * 2048 + g * 128 + k) * 1024 + c0 + cg4 * 16;
    u32x4 o0, o1;
    o0.x = pk2(acc[0], acc[1]); o0.y = pk2(acc[2], acc[3]); o0.z = pk2(acc[4], acc[5]); o0.w = pk2(acc[6], acc[7]);
    o1.x = pk2(acc[8], acc[9]); o1.y = pk2(acc[10], acc[11]); o1.z = pk2(acc[12], acc[13]); o1.w = pk2(acc[14], acc[15]);
    *(u32x4*)o = o0; *(u32x4*)(o + 8) = o1;
    __syncthreads();
}

DI void p0_posb_item(const float* __restrict__ pos, const float* __restrict__ w1, float* __restrict__ part, int item, unsigned char* lds, int tid) {
    const int kv = item >> 4, ch = item & 15;
    float* red = (float*)lds;
    const int j = tid & 255, half = tid >> 8;
    const float* pp = pos + (long)kv * 4096 + ch * 256 + half * 128;
    const float* ww = w1 + ((long)kv * 4096 + ch * 256 + half * 128) * 256 + j;
    float a = 0.f;
    for (int f = 0; f < 128; ++f) a += pp[f] * ww[(long)f * 256];
    red[half * 256 + j] = a;
    __syncthreads();
    if (tid < 256) part[(kv * 16 + ch) * 256 + tid] = red[tid] + red[256 + tid];
    __syncthreads();
}

DI void p0_ada_item(const Params& p, float* __restrict__ ada, int item, unsigned char* lds, int tid) {
    float* cact = (float*)lds;
    float* red = cact + 4096;
    const float* c = p.in[1];
    for (int e = tid; e < 4096; e += NTHREADS) { const float v = c[e]; cact[e] = v * frcp(1.f + fexp2(-LOG2E * v)); }
    __syncthreads();
    const int colg = item * 64;
    const float* W; const float* bias; int N, n0;
    if (colg < 6144) { W = p.in[3]; bias = p.in[4]; N = 6144; n0 = colg; }
    else if (colg < 12288) { W = p.in[3] + (long)1024 * 6144; bias = p.in[4] + 6144; N = 6144; n0 = colg - 6144; }
    else { W = p.in[14]; bias = p.in[15]; N = 2048; n0 = colg - 12288; }
    const int col = tid & 63, kg = tid >> 6;
    float a0 = 0.f, a1 = 0.f, a2 = 0.f, a3 = 0.f;
    const float* wp = W + (long)(kg * 128) * N + n0 + col;
#pragma unroll 8
    for (int k = 0; k < 128; ++k) {
        const float wv = wp[(long)k * N];
        const int kk = kg * 128 + k;
        a0 += cact[kk] * wv; a1 += cact[1024 + kk] * wv; a2 += cact[2048 + kk] * wv; a3 += cact[3072 + kk] * wv;
    }
    red[(kg * 4 + 0) * 64 + col] = a0; red[(kg * 4 + 1) * 64 + col] = a1; red[(kg * 4 + 2) * 64 + col] = a2; red[(kg * 4 + 3) * 64 + col] = a3;
    __syncthreads();
    if (tid < 256) {
        const int b = tid >> 6, cc = tid & 63;
        float s = bias[n0 + cc];
#pragma unroll
        for (int q = 0; q < 8; ++q) s += red[(q * 4 + b) * 64 + cc];
        ada[b * ADA_STRIDE + colg + cc] = s;
    }
    __syncthreads();
}

constexpr int P0_CONV = 8192, P0_TR_DIN = 768, P0_TR_DOUT = 256, P0_TR_KV = 384, P0_TR_NIN = 288, P0_TR_NOUT = 256, P0_TR_C1 = 512, P0_TR_C2 = 16,
              P0_WEFF = 512, P0_POSB = 32, P0_ADA = 224;
constexpr int P0_TOTAL = P0_CONV + P0_TR_DIN + P0_TR_DOUT + P0_TR_KV + P0_TR_NIN + P0_TR_NOUT + P0_TR_C1 + P0_TR_C2 + P0_WEFF + P0_POSB + P0_ADA;

DI void phase_prep(const Params& p, unsigned char* lds, int tid) {
    unsigned char* ws = p.ws;
    for (int it = blockIdx.x; it < P0_TOTAL; it += gridDim.x) {
        int r = it;
        if (r < P0_ADA) { p0_ada_item(p, (float*)(ws + OFF_ADA), r, lds, tid); continue; } r -= P0_ADA;
        if (r < P0_WEFF) { p0_weff_item(p.in[26], p.in[27], (bf16_t*)(ws + OFF_WT_PEER), r, lds, tid); continue; } r -= P0_WEFF;
        if (r < P0_POSB) { p0_posb_item(p.in[17], p.in[18], (float*)(ws + OFF_POSB), r, lds, tid); continue; } r -= P0_POSB;
        if (r < P0_TR_DIN) { p0_transpose_item(p.in[7], 1024, 3072, (bf16_t*)(ws + OFF_WT_DIN), r, 48, lds, tid); continue; } r -= P0_TR_DIN;
        if (r < P0_TR_DOUT) { p0_transpose_item(p.in[8], 1024, 1024, (bf16_t*)(ws + OFF_WT_DOUT), r, 16, lds, tid); continue; } r -= P0_TR_DOUT;
        if (r < P0_TR_KV) { p0_transpose_item(p.in[16], 1024, 1536, (bf16_t*)(ws + OFF_WT_KV), r, 24, lds, tid); continue; } r -= P0_TR_KV;
        if (r < P0_TR_NIN) { p0_transpose_item(p.in[22], 1024, 1048, (bf16_t*)(ws + OFF_WT_NIN), r, 18, lds, tid); continue; } r -= P0_TR_NIN;
        if (r < P0_TR_NOUT) { p0_transpose_item(p.in[24], 1024, 1024, (bf16_t*)(ws + OFF_WT_NOUT), r, 16, lds, tid); continue; } r -= P0_TR_NOUT;
        if (r < P0_TR_C1) { const int kv = r >> 8; p0_transpose_item(p.in[18] + (long)kv * 4096 * 256, 4096, 256, (bf16_t*)(ws + OFF_WT_C1) + (long)kv * 256 * 4096, r & 255, 4, lds, tid); continue; } r -= P0_TR_C1;
        if (r < P0_TR_C2) { const int kv = r >> 3; p0_transpose_item(p.in[20] + (long)kv * 256 * 128, 256, 128, (bf16_t*)(ws + OFF_WT_C2) + (long)kv * 128 * 256, r & 7, 2, lds, tid); continue; } r -= P0_TR_C2;
        {
            const int tbl = r >> 11, sub = r & 2047;
            const int layer = tbl & 1;
            const float* src = (tbl < 2 ? p.in[28] : p.in[29]) + (long)layer * 16384 * 1024;
            unsigned char* dst = ws + (tbl < 2 ? OFF_PU : OFF_PV) + (long)layer * 16384 * 1024;
            float* sinv = (float*)(ws + (tbl < 2 ? OFF_USI : OFF_VSI)) + layer * 16384;
            p0_fp8_item(src, dst, sinv, tbl >= 2, sub, tid);
        }
    }
}

DI void norm_row_write(const f32x4 (&v)[4], float rstd, const float* gain, const float* shift, const float* scale, bf16_t* orow, int lane) {
#pragma unroll
    for (int j = 0; j < 4; ++j) {
        const int c = 4 * lane + 256 * j;
        const f32x4 g = *(const f32x4*)(gain + c), sh = *(const f32x4*)(shift + c), sc = *(const f32x4*)(scale + c);
        u32x2 o;
        o.x = pk2(v[j].x * rstd * g.x * (1.f + sc.x) + sh.x, v[j].y * rstd * g.y * (1.f + sc.y) + sh.y);
        o.y = pk2(v[j].z * rstd * g.z * (1.f + sc.z) + sh.z, v[j].w * rstd * g.w * (1.f + sc.w) + sh.w);
        *(u32x2*)(orow + c) = o;
    }
}
template <bool BF>
DI void phase_norm_q8(const float* __restrict__ x, bf16_t* __restrict__ out, unsigned char* __restrict__ out8, float* __restrict__ outs,
                      const float* gain, const float* ada, int shift_off, int scale_off, int tid) {
    const int lane = tid & 63, gw = blockIdx.x * NWAVES + (tid >> 6), nw = gridDim.x * NWAVES;
    for (int tok = gw; tok < NTOK; tok += nw) {
        const int b = tok >> 13;
        f32x4 v[4]; float ss = 0.f;
#pragma unroll
        for (int j = 0; j < 4; ++j) { v[j] = *(const f32x4*)(x + (long)tok * DM + 4 * lane + 256 * j); ss += v[j].x * v[j].x + v[j].y * v[j].y + v[j].z * v[j].z + v[j].w * v[j].w; }
        const float rstd = rsqrtf(wave_sum(ss) * (1.f / DM) + EPS);
        const float* shift = ada + b * ADA_STRIDE + shift_off; const float* scale = ada + b * ADA_STRIDE + scale_off;
        float am = 0.f;
#pragma unroll
        for (int j = 0; j < 4; ++j) {
            const int c = 4 * lane + 256 * j;
            const f32x4 g = *(const f32x4*)(gain + c), sh = *(const f32x4*)(shift + c), sc = *(const f32x4*)(scale + c);
            v[j].x = v[j].x * rstd * g.x * (1.f + sc.x) + sh.x; v[j].y = v[j].y * rstd * g.y * (1.f + sc.y) + sh.y;
            v[j].z = v[j].z * rstd * g.z * (1.f + sc.z) + sh.z; v[j].w = v[j].w * rstd * g.w * (1.f + sc.w) + sh.w;
            if constexpr (BF) { u32x2 o; o.x = pk2(v[j].x, v[j].y); o.y = pk2(v[j].z, v[j].w); *(u32x2*)(out + (long)tok * DM + c) = o; }
            am = fmaxf(am, fmaxf(fmaxf(fabsf(v[j].x), fabsf(v[j].y)), fmaxf(fabsf(v[j].z), fabsf(v[j].w))));
        }
        am = wave_max(am);
        const float qs = am > 0.f ? 127.f / am : 1.f;
#pragma unroll
        for (int j = 0; j < 4; ++j) *(int*)(out8 + (long)tok * DM + 4 * lane + 256 * j) = pack_i8x4(v[j].x * qs, v[j].y * qs, v[j].z * qs, v[j].w * qs);
        if (lane == 0) outs[tok] = am > 0.f ? am * (1.f / 127.f) : 1.f;
    }
}
DI void phase_norm(const float* __restrict__ x, bf16_t* __restrict__ out, const float* gain, const float* ada, int shift_off, int scale_off, int tid) {
    const int lane = tid & 63, gw = blockIdx.x * NWAVES + (tid >> 6), nw = gridDim.x * NWAVES;
    for (int tok = gw; tok < NTOK; tok += nw) {
        const int b = tok >> 13;
        f32x4 v[4]; float ss = 0.f;
#pragma unroll
        for (int j = 0; j < 4; ++j) { v[j] = *(const f32x4*)(x + (long)tok * DM + 4 * lane + 256 * j); ss += v[j].x * v[j].x + v[j].y * v[j].y + v[j].z * v[j].z + v[j].w * v[j].w; }
        const float rstd = rsqrtf(wave_sum(ss) * (1.f / DM) + EPS);
        norm_row_write(v, rstd, gain, ada + b * ADA_STRIDE + shift_off, ada + b * ADA_STRIDE + scale_off, out + (long)tok * DM, lane);
    }
}

DI int kidx(int mt, int i) { return 32 * mt + 16 * (i >> 3) + (i & 7); }
template <int DQK>
DI void attn_qk32(const unsigned char* Ks, const bf16x8 (&qf)[DQK / 16], f32x16& st, int mt, int r, int h, float init = 0.f) {
    constexpr int RB = DQK * 2, MSK = DQK == 64 ? 7 : 15;
    const int row = 32 * mt + ((r & 0x13) | ((r & 4) << 1) | ((r & 8) >> 1));
#pragma unroll
    for (int i = 0; i < 16; ++i) st[i] = init;
#pragma unroll
    for (int ks = 0; ks < DQK / 16; ++ks) {
        const bf16x8 kf = RB == 128 ? *(const bf16x8*)(Ks + sw2(row, 2 * ks + h)) : *(const bf16x8*)(Ks + row * RB + (((2 * ks + h) ^ (row & MSK)) << 4));
        st = MFMA32(kf, qf[ks], st);
    }
}
DI void attn_pack32(const f32x16& st, bf16x8 (&pf)[2]) {
#pragma unroll
    for (int s = 0; s < 2; ++s) {
        u32x4 t;
        t.x = pk2(st[8 * s + 0], st[8 * s + 1]); t.y = pk2(st[8 * s + 2], st[8 * s + 3]);
        t.z = pk2(st[8 * s + 4], st[8 * s + 5]); t.w = pk2(st[8 * s + 6], st[8 * s + 7]);
        pf[s] = __builtin_bit_cast(bf16x8, t);
    }
}
DI void attn_softmax32(f32x16& st, float& m, float& l, f32x16 (&o)[4]) {
    float mx = st[0];
#pragma unroll
    for (int i = 1; i < 16; ++i) mx = fmaxf(mx, st[i]);
    mx = max_x32(mx);
    const float mn = fmaxf(m, mx);
    if (!__all(mn == m)) {
        const float alpha = fexp2(m - mn);
        l *= alpha;
#pragma unroll
        for (int dt = 0; dt < 4; ++dt)
#pragma unroll
            for (int i = 0; i < 16; ++i) o[dt][i] *= alpha;
        m = mn;
    }
    float sum = 0.f;
#pragma unroll
    for (int i = 0; i < 16; ++i) { const float pv = fexp2(st[i] - m); st[i] = pv; sum += pv; }
    l += sum;
}
DI void attn_softmax32_b(f32x16& st, float& l) {
    float sum = 0.f;
#pragma unroll
    for (int i = 0; i < 16; ++i) { const float pv = fexp2(st[i]); st[i] = pv; sum += pv; }
    l += sum;
}
DI void attn_pv32(const unsigned char* Vs, const bf16x8 (&pf)[2], f32x16 (&o)[4], int mt, int r, int h) {
#pragma unroll
    for (int dt = 0; dt < 4; ++dt)
#pragma unroll
        for (int s2 = 0; s2 < 2; ++s2) {
            const int row = 32 * dt + r;
            const bf16x8 vf = *(const bf16x8*)(Vs + sw2(row, 2 * (2 * mt + s2) + h));
            o[dt] = MFMA32(vf, pf[s2], o[dt]);
        }
}
template <int RB, int NROWS>
DI void dma_offsets(unsigned (&off)[NROWS * RB / 16 / 512], unsigned gstride, int tid) {
    constexpr int CPR = RB / 16;
#pragma unroll
    for (int i = 0; i < NROWS * CPR / 512; ++i) {
        const int idx = tid + 512 * i;
        int row, cp;
        if (RB == 128) sw2_src(idx, row, cp); else { row = idx / CPR; cp = (idx % CPR) ^ (row & (CPR - 1)); }
        off[i] = (unsigned)row * gstride + (cp << 4);
    }
}
template <int N>
DI void dma_issue(unsigned char* dst, const unsigned char* gbase, const unsigned (&off)[N], int tid) {
    const int wbase = tid & ~63;
#pragma unroll
    for (int i = 0; i < N; ++i)
        __builtin_amdgcn_global_load_lds((const unsigned*)(gbase + off[i]), (unsigned*)(dst + (wbase + 512 * i) * 16), 16, 0, 0);
}

constexpr int AT_STAGE = 32 * 1024;
constexpr int AT_LUT = 2 * AT_STAGE;
constexpr int LUT_N = 1280, LUT_OFF = 1100;
constexpr int LUTC_W = 52;
constexpr int AT_LUTC = AT_LUT + 20 * 1024;
constexpr int AT_IMP = AT_LUTC + 13 * 1024;
constexpr int AT_SEL = AT_IMP + 34 * 1024;

DI void phase_diff_attn(const Params& p, unsigned char* lds, int tid) {
    unsigned char* ws = p.ws;
    const bf16_t* Q = (const bf16_t*)(ws + OFF_Q0);
    const bf16_t* Kk = (const bf16_t*)(ws + OFF_K0);
    const bf16_t* VT = (const bf16_t*)(ws + OFF_VT0);
    bf16_t* O = (bf16_t*)(ws + OFF_H);
    const float* relb = p.in[2];
    const float* lam = p.in[9];
    const float* subln = p.in[12];
    const int lane = tid & 63, w = tid >> 6, comp = w & 1, qg = w >> 1, r = lane & 31, h = lane >> 5;
    float* lut = (float*)(lds + 128 * 1024);
    float lam_full;
    {
        float s01 = 0.f, s23 = 0.f;
        for (int i = 0; i < 64; ++i) { s01 += lam[i] * lam[64 + i]; s23 += lam[128 + i] * lam[192 + i]; }
        lam_full = __expf(s01) - __expf(s23) + 0.2f;
    }
    const int G = gridDim.x, rows_per_it = G >> 5;
    unsigned koff[1], voff[2];
    dma_offsets<128, 64>(koff, 128, tid);
    dma_offsets<128, 128>(voff, SEQ * 2, tid);
    constexpr int ST2 = 64 * 1024;
    for (int it = 0;; ++it) {
        int qb, b, hd;
        if (G == 256) {
            if (it >= 8) break;
            const int xcd = blockIdx.x & 7, lb = blockIdx.x >> 3, pr = xcd * 4 + (it >> 1);
            qb = (it & 1) ? lb : 63 - lb; b = pr >> 3; hd = pr & 7;
        } else {
            int u;
            if ((G & 31) == 0) {
                const int rr = blockIdx.x >> 5, cc = blockIdx.x & 31;
                const int rowi = it * rows_per_it + ((it & 1) ? rows_per_it - 1 - rr : rr);
                u = rowi * 32 + cc;
            } else u = it * G + blockIdx.x;
            if (u >= 2048) break;
            qb = 63 - (u >> 5); b = (u & 31) >> 3; hd = u & 7;
        }
        const int q0 = qb * 128, ntiles = qb + 1;
        const int qpos = q0 + 32 * qg + r, qlo = q0 + 32 * qg, qhi = qlo + 31;
        for (int e = tid; e < LUT_N; e += NTHREADS) { const int d = LUT_OFF - e; lut[e] = d < 0 ? -INFINITY : (d >= 790 ? 0.f : (relb[rel_bucket_i(d) * 8 + hd] - relb[31 * 8 + hd]) * LOG2E); }
        bf16x8 qf[4];
        {
            const bf16_t* qrow = Q + ((long)((b * 8 + hd) * 2 + comp) * SEQ + qpos) * 64;
#pragma unroll
            for (int ks = 0; ks < 4; ++ks) qf[ks] = *(const bf16x8*)(qrow + 16 * ks + 8 * h);
        }
        const unsigned char* k0g = (const unsigned char*)(Kk + (long)((b * 8 + hd) * 2 + 0) * SEQ * 64);
        const unsigned char* k1g = (const unsigned char*)(Kk + (long)((b * 8 + hd) * 2 + 1) * SEQ * 64);
        const unsigned char* vtg = (const unsigned char*)(VT + (long)(b * 8 + hd) * 128 * SEQ);
        f32x16 o[4];
#pragma unroll
        for (int dt = 0; dt < 4; ++dt)
#pragma unroll
            for (int i = 0; i < 16; ++i) o[dt][i] = 0.f;
        float l = 0.f;
        const float nmb = -((const float*)(ws + OFF_MB0))[(long)((b * 8 + hd) * 2 + comp) * SEQ + qpos];
        auto stage = [&](int kt, unsigned char* st) {
#pragma unroll
            for (int sb = 0; sb < 2; ++sb) {
                dma_issue(st + sb * 8192, k0g + (long)(2 * kt + sb) * 8192, koff, tid);
                dma_issue(st + 16384 + sb * 8192, k1g + (long)(2 * kt + sb) * 8192, koff, tid);
                dma_issue(st + 32768 + sb * 16384, vtg + (long)(2 * kt + sb) * 128, voff, tid);
            }
        };
        stage(0, lds);
        __syncthreads();
        for (int kt = 0; kt < ntiles; ++kt) {
            unsigned char* cur = lds + (kt & 1) * ST2;
            if (kt + 1 < ntiles) stage(kt + 1, lds + ((kt + 1) & 1) * ST2);
            const bool nearb = qlo - (kt * 128 + 127) < 790;
            const int dbase0 = qpos - kt * 128 - 8 * h;
            const unsigned char* kb = cur + comp * 16384;
            f32x16 sa, sbv;
            attn_qk32<64>(kb, qf, sa, 0, r, h, nmb);
#pragma unroll
            for (int j = 0; j < 4; ++j) {
                f32x16& sc = (j & 1) ? sbv : sa;
                f32x16& sn = (j & 1) ? sa : sbv;
                if (j < 3) attn_qk32<64>(kb + ((j + 1) >> 1) * 8192, qf, sn, (j + 1) & 1, r, h, nmb);
                if (nearb) {
                    const float* lp = lut + (LUT_OFF - dbase0 + 64 * (j >> 1));
#pragma unroll
                    for (int i = 0; i < 16; ++i) sc[i] += lp[kidx(j & 1, i)];
                }
                attn_softmax32_b(sc, l);
                bf16x8 pf[2];
                attn_pack32(sc, pf);
                attn_pv32(cur + 32768 + (j >> 1) * 16384, pf, o, j & 1, r, h);
            }
            __syncthreads();
        }
        l = sum_x32(l);
        const float inv = l > 0.f ? frcp(l) : 0.f;
        float* xch = (float*)lds + qg * 4096;
        if (comp == 1) {
            const float sc = inv * lam_full;
#pragma unroll
            for (int dt = 0; dt < 4; ++dt)
#pragma unroll
                for (int i = 0; i < 16; ++i) xch[(dt * 16 + i) * 64 + lane] = o[dt][i] * sc;
        }
        __syncthreads();
        if (comp == 0) {
            float ss = 0.f;
#pragma unroll
            for (int dt = 0; dt < 4; ++dt)
#pragma unroll
                for (int i = 0; i < 16; ++i) { const float v = o[dt][i] * inv - xch[(dt * 16 + i) * 64 + lane]; o[dt][i] = v; ss += v * v; }
            ss = sum_x32(ss);
            const float rstd = rsqrtf(ss * (1.f / 128.f) + EPS) * 0.8f;
            bf16_t* orow = O + (long)(b * SEQ + qpos) * DM + hd * 128;
#pragma unroll
            for (int dt = 0; dt < 4; ++dt)
#pragma unroll
                for (int g4 = 0; g4 < 4; ++g4) {
                    const int d0 = 32 * dt + 8 * g4 + 4 * h;
                    const f32x4 gv = *(const f32x4*)(subln + d0);
                    u32x2 ov;
                    ov.x = pk2(o[dt][4 * g4 + 0] * rstd * gv.x, o[dt][4 * g4 + 1] * rstd * gv.y);
                    ov.y = pk2(o[dt][4 * g4 + 2] * rstd * gv.z, o[dt][4 * g4 + 3] * rstd * gv.w);
                    *(u32x2*)(orow + d0) = ov;
                }
        }
        __syncthreads();
    }
}

template <int VAR>
DI void phase_nsa_attn(const Params& p, unsigned char* lds, int tid) {
    unsigned char* ws = p.ws;
    const bf16_t* QN = (const bf16_t*)(ws + OFF_QN);
    const bf16_t* KS = (const bf16_t*)(ws + OFF_KS);
    const bf16_t* VST = (const bf16_t*)(ws + OFF_VST);
    const bf16_t* KW = (const bf16_t*)(ws + OFF_KW);
    const bf16_t* VWT = (const bf16_t*)(ws + OFF_VWT);
    const bf16_t* KCMP = (const bf16_t*)(ws + OFF_KCMP);
    const bf16_t* VCMPT = (const bf16_t*)(ws + OFF_VCMPT);
    const float* gates = (const float*)(ws + OFF_GATES);
    bf16_t* O = VAR ? (bf16_t*)(ws + OFF_PU + 32 * MB) : (bf16_t*)(ws + OFF_H);
    const float* relb = p.in[2];
    const int lane = tid & 63, w = tid >> 6, hg = w >> 1, th = w & 1, r = lane & 31, h = lane >> 5;
    float* lut = (float*)(lds + AT_LUT);
    float* lutc = (float*)(lds + AT_LUTC);
    float* imp = (float*)(lds + AT_IMP);
    unsigned* selw = (unsigned*)(lds + AT_SEL);
    unsigned short* sel16 = (unsigned short*)selw;
    float* bmxs = (float*)(selw + 264);
    const float* qnrm = (const float*)(ws + OFF_MB1);
    float kmx[3];
    for (int br = 0; br < 3; ++br) { float mx = 0.f; for (int d = 0; d < 128; ++d) mx = fmaxf(mx, fabsf(p.in[21][br * 128 + d])); kmx[br] = mx * 11.313708498984761f; }
    const int G = gridDim.x, rows_per_it = G >> 3;
    int lut_g = -1;
    for (int it = 0;; ++it) {
        int u;
        if ((G & 7) == 0) {
            const int rr = blockIdx.x >> 3, cc = blockIdx.x & 7;
            const int rowi = it * rows_per_it + ((it & 1) ? rows_per_it - 1 - rr : rr);
            u = rowi * 8 + cc;
        } else u = it * G + blockIdx.x;
        if (u >= 1024) break;
        const int bi = 127 - (u >> 3), b = (u & 7) >> 1, g = u & 1, head = 4 * g + hg;
        const int tq = 64 * bi + 32 * th + r;
        const int tl = 32 * th + r;
        const long tok = (long)b * SEQ + tq;
        if (g != lut_g) {
            lut_g = g;
            if (tid < 4) { float bm = 0.f; for (int bk = 0; bk < 32; ++bk) bm = fmaxf(bm, relb[bk * 8 + 4 * g + tid] - relb[31 * 8 + 4 * g + tid]); bmxs[tid] = bm * LOG2E; }
            for (int e = tid; e < 4 * LUT_N; e += NTHREADS) { const int hh = e / LUT_N, d = LUT_OFF - (e % LUT_N); lut[e] = d < 0 ? -INFINITY : (d >= 790 ? 0.f : (relb[rel_bucket_i(d) * 8 + 4 * g + hh] - relb[31 * 8 + 4 * g + hh]) * LOG2E); }
            for (int e = tid; e < 4 * 16 * LUTC_W; e += NTHREADS) {
                const int hh = e / (16 * LUTC_W), ph = (e / LUTC_W) & 15, ci = e % LUTC_W, d = 16 * (ci - 1) + ph;
                lutc[e] = ci == 0 ? -INFINITY : (d >= 790 ? 0.f : (relb[rel_bucket_i(d) * 8 + 4 * g + hh] - relb[31 * 8 + 4 * g + hh]) * LOG2E);
            }
        }
        if (tid < 4) selw[256 + tid] = 0u;
        const float* mylut = lut + hg * LUT_N;
        bf16x8 qf[8];
        const bf16_t* qrow = QN + ((long)(b * 8 + head) * SEQ + tq) * 128 + 8 * h;
        auto load_q = [&](const bf16_t* qr) {
#pragma unroll
            for (int ks = 0; ks < 8; ++ks) qf[ks] = *(const bf16x8*)(qr + 16 * ks);
        };
        const float* gp = gates + tok * 24 + head * 3;
        bf16_t* orow = O + (VAR ? (tok & 16383) : tok) * DM + head * 128;
        auto stage = [&](const unsigned char* kg, const unsigned char* vg, unsigned vstride, int kt, unsigned char* st) {
            int t2 = tid; asm volatile("" : "+v"(t2));
            unsigned koff[2], vo[2];
            dma_offsets<256, 64>(koff, 256, t2);
            dma_offsets<128, 128>(vo, vstride, t2);
            dma_issue(st, kg + (long)kt * 16384, koff, t2);
            dma_issue(st + 16384, vg + (long)kt * 128, vo, t2);
        };
        f32x16 o[4];
        float l;
        auto reset = [&]() {
#pragma unroll
            for (int dt = 0; dt < 4; ++dt)
#pragma unroll
                for (int i = 0; i < 16; ++i) o[dt][i] = 0.f;
            l = 0.f;
        };
        const unsigned char* kcg = (const unsigned char*)(KCMP + (long)(b * 2 + g) * 512 * 128);
        const unsigned char* vcg = (const unsigned char*)(VCMPT + (long)(b * 2 + g) * 128 * 512);
        const int nct = ((4 * bi + 2) >> 6) + 1;
        const int hgc = r & 3, tlc = 8 * w + (r >> 2), tqc = 64 * bi + tlc;
        const long tokc = (long)b * SEQ + tqc;
        reset();
        load_q(QN + ((long)(b * 8 + 4 * g + hgc) * SEQ + tqc) * 128 + 8 * h);
        __syncthreads();
        if (VAR != 3) {
            const int cb = (tqc - 31) >> 4;
            const float* lc = lutc + (hgc * 16 + ((tqc - 31) & 15)) * LUTC_W + 1;
            const float nmb = -(qnrm[tokc * 8 + 4 * g + hgc] * kmx[0] + bmxs[hgc]);
            stage(kcg, vcg, 1024u, 0, lds);
            __syncthreads();
            for (int kt = 0; kt < nct; ++kt) {
                unsigned char* cur = lds + (kt & 1) * AT_STAGE;
                if (kt + 1 < nct) stage(kcg, vcg, 1024u, kt + 1, lds + ((kt + 1) & 1) * AT_STAGE);
                const int cbase = cb - kt * 64 - 8 * h;
#pragma unroll
                for (int mt = 0; mt < 2; ++mt) {
                    f32x16 st;
                    attn_qk32<128>(cur, qf, st, mt, r, h, nmb);
                    float sum = 0.f;
#pragma unroll
                    for (int i = 0; i < 16; ++i) {
                        const int c = cbase - kidx(mt, i);
                        sum += fexp2(st[i] + lc[c < -1 ? -1 : (c > 50 ? 50 : c)]);
                    }
                    l += sum;
                }
                __syncthreads();
            }
            const float lt = sum_x32(l);
            const float invl = lt > 0.f ? frcp(lt) : 0.f;
            stage(kcg, vcg, 1024u, 0, lds);
            __syncthreads();
            float carry = 0.f;
            for (int kt = 0; kt < nct; ++kt) {
                unsigned char* cur = lds + (kt & 1) * AT_STAGE;
                if (kt + 1 < nct) stage(kcg, vcg, 1024u, kt + 1, lds + ((kt + 1) & 1) * AT_STAGE);
                const int cbase = cb - kt * 64 - 8 * h;
                float o0[4], o1[4], sp[4];
#pragma unroll
                for (int mt = 0; mt < 2; ++mt) {
                    f32x16 st;
                    attn_qk32<128>(cur, qf, st, mt, r, h, nmb);
#pragma unroll
                    for (int i = 0; i < 16; ++i) {
                        const int c = cbase - kidx(mt, i);
                        st[i] = fexp2(st[i] + lc[c < -1 ? -1 : (c > 50 ? 50 : c)]) * invl;
                    }
#pragma unroll
                    for (int gq = 0; gq < 2; ++gq) {
                        const int G2 = 2 * mt + gq, q0 = 2 * gq, q1 = 2 * gq + 1;
                        const float c20 = 0.5f * st[4 * q0 + 3];
                        o0[G2] = st[4 * q0] + st[4 * q0 + 1] + st[4 * q0 + 2] + c20;
                        o1[G2] = st[4 * q1] + st[4 * q1 + 1] + st[4 * q1 + 2] + 0.5f * st[4 * q1 + 3] + c20;
                        sp[G2] = 0.5f * st[4 * q1 + 3];
                    }
                    bf16x8 pf[2];
                    attn_pack32(st, pf);
                    attn_pv32(cur + 16384, pf, o, mt, r, h);
                }
                float rc[4];
#pragma unroll
                for (int G2 = 0; G2 < 4; ++G2) rc[G2] = __uint_as_float(get_x32(__float_as_uint(sp[G2]), h));
                if (h) {
#pragma unroll
                    for (int G2 = 0; G2 < 4; ++G2) o0[G2] += rc[G2];
                } else {
                    o0[0] += carry; o0[1] += rc[0]; o0[2] += rc[1]; o0[3] += rc[2];
                    carry = rc[3];
                }
#pragma unroll
                for (int G2 = 0; G2 < 4; ++G2) {
                    float a0 = o0[G2], a1 = o1[G2];
                    a0 += lx1(a0); a0 += lx2(a0); a1 += lx1(a1); a1 += lx2(a1);
                    if (hgc == 0) *(f32x2*)(imp + tlc * 130 + kt * 16 + 4 * G2 + 2 * h) = (f32x2){a0, a1};
                }
                __syncthreads();
            }
        }
        {
            const float g_c = gates[tokc * 24 + (4 * g + hgc) * 3];
            bf16_t* orc = O + (VAR ? (tokc & 16383) : tokc) * DM + (4 * g + hgc) * 128;
#pragma unroll
            for (int dt = 0; dt < 4; ++dt)
#pragma unroll
                for (int g4 = 0; g4 < 4; ++g4) {
                    const int d0 = 32 * dt + 8 * g4 + 4 * h;
                    u32x2 ov;
                    ov.x = pk2(o[dt][4 * g4 + 0] * g_c, o[dt][4 * g4 + 1] * g_c);
                    ov.y = pk2(o[dt][4 * g4 + 2] * g_c, o[dt][4 * g4 + 3] * g_c);
                    *(u32x2*)(orc + d0) = ov;
                }
        }
        if (VAR != 5) {
            const int tkn = tid >> 3, part = tid & 7;
            unsigned key[16];
#pragma unroll
            for (int q = 0; q < 16; ++q) {
                const int j = part * 16 + q;
                float v = imp[tkn * 130 + j];
                const int back = bi - j;
                if (j == 0 || (back >= 0 && back < 2)) v = 1e9f;
                if (back < 0) v = -1e30f;
                key[q] = f2key(v);
            }
            auto sum8 = [&](int c) -> int {
                c += __builtin_amdgcn_update_dpp(0, c, 0xB1, 0xF, 0xF, true);
                c += __builtin_amdgcn_update_dpp(0, c, 0x4E, 0xF, 0xF, true);
                c += __builtin_amdgcn_update_dpp(0, c, 0x141, 0xF, 0xF, true);
                return c;
            };
            unsigned T = 0u;
#pragma unroll 4
            for (int bit = 31; bit >= 0; --bit) {
                const unsigned cand = T | (1u << bit);
                int c = 0;
#pragma unroll
                for (int q = 0; q < 16; ++q) c += key[q] >= cand ? 1 : 0;
                if (sum8(c) >= 16) T = cand;
            }
            int cg = 0, ce = 0;
#pragma unroll
            for (int q = 0; q < 16; ++q) { cg += key[q] > T ? 1 : 0; ce += key[q] == T ? 1 : 0; }
            const int need = 16 - sum8(cg);
            int pre = ce;
            { int t = __builtin_amdgcn_update_dpp(0, pre, 0x111, 0xF, 0xF, true); if (part >= 1) pre += t; }
            { int t = __builtin_amdgcn_update_dpp(0, pre, 0x112, 0xF, 0xF, true); if (part >= 2) pre += t; }
            { int t = __builtin_amdgcn_update_dpp(0, pre, 0x114, 0xF, 0xF, true); if (part >= 4) pre += t; }
            int before = pre - ce;
            unsigned bits = 0;
#pragma unroll
            for (int q = 0; q < 16; ++q) {
                const bool eq = key[q] == T;
                const bool selq = key[q] > T || (eq && before < need);
                before += eq ? 1 : 0;
                bits |= (selq && key[q] >= 0x80000000u) ? (1u << q) : 0u;
            }
            sel16[tkn * 8 + part] = (unsigned short)bits;
            atomicOr(&selw[256 + (part >> 1)], bits << ((part & 1) * 16));
        }
        __syncthreads();
        const unsigned un0 = selw[256], un1 = selw[257], un2 = selw[258], un3 = selw[259];
        const unsigned char* ksg = (const unsigned char*)(KS + (long)(b * 2 + g) * SEQ * 128);
        const unsigned char* vsg = (const unsigned char*)(VST + (long)(b * 2 + g) * 128 * SEQ);
        reset(); load_q(qrow);
        const float qn_main = qnrm[tok * 8 + head];
        {
            const float nmb = -(qn_main * kmx[1] + bmxs[hg]);
            const unsigned long long ulo = ((unsigned long long)(unsigned)__builtin_amdgcn_readfirstlane((int)un1) << 32) | (unsigned)__builtin_amdgcn_readfirstlane((int)un0);
            const unsigned long long uhi = ((unsigned long long)(unsigned)__builtin_amdgcn_readfirstlane((int)un3) << 32) | (unsigned)__builtin_amdgcn_readfirstlane((int)un2);
            auto next_tile = [&](int from) -> int {
                if (from < 64) { const unsigned long long mk = ulo >> from; if (mk) return from + __builtin_ctzll(mk); from = 64; }
                if (from < 128) { const unsigned long long mk = uhi >> (from - 64); if (mk) return from + __builtin_ctzll(mk); }
                return 128;
            };
            int jt = (VAR == 1 || VAR == 4 || VAR == 5) ? 128 : next_tile(0);
            int buf = 0;
            if (jt < 128) stage(ksg, vsg, SEQ * 2u, jt, lds);
            __syncthreads();
            while (jt < 128) {
                unsigned char* cur = lds + buf * AT_STAGE;
                const int jn = next_tile(jt + 1);
                if (jn < 128) stage(ksg, vsg, SEQ * 2u, jn, lds + (buf ^ 1) * AT_STAGE);
                const unsigned wd = selw[tl * 4 + (jt >> 5)];
                const bool mysel = (wd >> (jt & 31)) & 1u;
                if (__any(mysel)) {
                    const int k0 = jt * 64;
                    const bool nearb = (64 * bi + 32 * th) - (k0 + 63) < 790;
                    const int dbase = tq - k0 - 8 * h;
                    const float* lp = mylut + (LUT_OFF - dbase);
#pragma unroll
                    for (int mt = 0; mt < 2; ++mt) {
                        f32x16 st;
                        attn_qk32<128>(cur, qf, st, mt, r, h, mysel ? nmb : -INFINITY);
                        if (nearb) {
#pragma unroll
                            for (int i = 0; i < 16; ++i) st[i] += lp[kidx(mt, i)];
                        }
                        attn_softmax32_b(st, l);
                        bf16x8 pf[2];
                        attn_pack32(st, pf);
                        attn_pv32(cur + 16384, pf, o, mt, r, h);
                    }
                }
                __syncthreads();
                buf ^= 1; jt = jn;
            }
        }
        {
            const float lt = sum_x32(l);
            const float sc = (lt > 0.f ? frcp(lt) : 0.f) * gp[1];
#pragma unroll
            for (int dt = 0; dt < 4; ++dt)
#pragma unroll
                for (int g4 = 0; g4 < 4; ++g4) {
                    const int d0 = 32 * dt + 8 * g4 + 4 * h;
                    const u32x2 pv = *(const u32x2*)(orow + d0);
                    u32x2 ov;
                    ov.x = pk2(bflo(pv.x) + o[dt][4 * g4 + 0] * sc, bfhi(pv.x) + o[dt][4 * g4 + 1] * sc);
                    ov.y = pk2(bflo(pv.y) + o[dt][4 * g4 + 2] * sc, bfhi(pv.y) + o[dt][4 * g4 + 3] * sc);
                    *(u32x2*)(orow + d0) = ov;
                }
        }
        const unsigned char* kwg = (const unsigned char*)(KW + (long)(b * 2 + g) * SEQ * 128);
        const unsigned char* vwg = (const unsigned char*)(VWT + (long)(b * 2 + g) * 128 * SEQ);
        reset(); load_q(qrow);
        {
            const float nmb = -(qn_main * kmx[2] + bmxs[hg]);
            const int j0 = bi >= 8 ? bi - 8 : 0, nt = (VAR == 2 || VAR == 4 || VAR == 5) ? 1 : bi - j0 + 1;
            stage(kwg, vwg, SEQ * 2u, j0, lds);
            __syncthreads();
            for (int kt = 0; kt < nt; ++kt) {
                unsigned char* cur = lds + (kt & 1) * AT_STAGE;
                if (kt + 1 < nt) stage(kwg, vwg, SEQ * 2u, j0 + kt + 1, lds + ((kt + 1) & 1) * AT_STAGE);
                const int k0 = (j0 + kt) * 64;
                const int dbase = tq - k0 - 8 * h;
                const float* lp = mylut + (LUT_OFF - dbase);
#pragma unroll
                for (int mt = 0; mt < 2; ++mt) {
                    f32x16 st;
                    attn_qk32<128>(cur, qf, st, mt, r, h, nmb);
#pragma unroll
                    for (int i = 0; i < 16; ++i) st[i] = kidx(mt, i) <= dbase - 512 ? -INFINITY : st[i] + lp[kidx(mt, i)];
                    attn_softmax32_b(st, l);
                    bf16x8 pf[2];
                    attn_pack32(st, pf);
                    attn_pv32(cur + 16384, pf, o, mt, r, h);
                }
                __syncthreads();
            }
        }
        {
            const float lt = sum_x32(l);
            const float sc = (lt > 0.f ? frcp(lt) : 0.f) * gp[2];
#pragma unroll
            for (int dt = 0; dt < 4; ++dt)
#pragma unroll
                for (int g4 = 0; g4 < 4; ++g4) {
                    const int d0 = 32 * dt + 8 * g4 + 4 * h;
                    const u32x2 pv = *(const u32x2*)(orow + d0);
                    u32x2 ov;
                    ov.x = pk2(bflo(pv.x) + o[dt][4 * g4 + 0] * sc, bfhi(pv.x) + o[dt][4 * g4 + 1] * sc);
                    ov.y = pk2(bflo(pv.y) + o[dt][4 * g4 + 2] * sc, bfhi(pv.y) + o[dt][4 * g4 + 3] * sc);
                    *(u32x2*)(orow + d0) = ov;
                }
        }
        __syncthreads();
    }
}

DI void fp8x16_fma(const u32x4& q, const f32x4& h0, const f32x4& h1, const f32x4& h2, const f32x4& h3, f32x2& a0, f32x2& a1) {
    a0 += __builtin_amdgcn_cvt_pk_f32_fp8((int)q.x, false) * (f32x2){h0.x, h0.y};
    a1 += __builtin_amdgcn_cvt_pk_f32_fp8((int)q.x, true)  * (f32x2){h0.z, h0.w};
    a0 += __builtin_amdgcn_cvt_pk_f32_fp8((int)q.y, false) * (f32x2){h1.x, h1.y};
    a1 += __builtin_amdgcn_cvt_pk_f32_fp8((int)q.y, true)  * (f32x2){h1.z, h1.w};
    a0 += __builtin_amdgcn_cvt_pk_f32_fp8((int)q.z, false) * (f32x2){h2.x, h2.y};
    a1 += __builtin_amdgcn_cvt_pk_f32_fp8((int)q.z, true)  * (f32x2){h2.z, h2.w};
    a0 += __builtin_amdgcn_cvt_pk_f32_fp8((int)q.w, false) * (f32x2){h3.x, h3.y};
    a1 += __builtin_amdgcn_cvt_pk_f32_fp8((int)q.w, true)  * (f32x2){h3.z, h3.w};
}
#ifndef UMASK
#define UMASK 0xffffffffu
#endif
template <bool DRY>
DI void phase_peer_u(const Params& p, int layer, unsigned char* lds, int tid) {
    unsigned char* ws = p.ws;
    const unsigned char* H8 = ws + OFF_H8;
    const float* HS = (const float*)(ws + OFF_HS);
    const int* ridx = (const int*)(ws + OFF_RIDX);
    float* rgate = (float*)(ws + OFF_RGATE);
    const unsigned char* U = ws + OFF_PU + (long)layer * 16384 * 1024;
    const float* usi = (const float*)(ws + OFF_USI) + layer * 16384;
    const float* vsi = (const float*)(ws + OFF_VSI) + layer * 16384;
    const int lane = tid & 63, w = __builtin_amdgcn_readfirstlane(tid >> 6), sub = lane & 7, grp = lane >> 3;
    const int xg = blockIdx.x & 7, lb = blockIdx.x >> 3, nwv = (gridDim.x >> 3) * NWAVES, wv = lb * NWAVES + w;
    unsigned* clb = (unsigned*)(lds + w * 12288);
    unsigned char* hbb = lds + w * 12288 + 4096;
    const unsigned long long lt = (1ull << lane) - 1ull;
    if (lb >= (int)(gridDim.x >> 3)) return;
    int i0, i1; unsigned g0, g1; u32x4 h0; float hs0;
    auto ld_tok = [&](int tk) {
        tk = tk < NTOK ? tk : wv;
        i0 = ridx[(long)tk * 128 + lane]; i1 = ridx[(long)tk * 128 + 64 + lane];
        g0 = __float_as_uint(rgate[(long)tk * 128 + lane]); g1 = __float_as_uint(rgate[(long)tk * 128 + 64 + lane]);
        h0 = *(const u32x4*)(H8 + (long)tk * DM + lane * 16); hs0 = HS[tk];
    };
    bool sb0, sb1; int sk0, sk1; float su0, sv0, su1, sv1;
    auto stage_tok = [&](int bi) -> int {
        unsigned* cl = clb + bi * 512; unsigned char* hb = hbb + bi * 4096;
        const bool b0 = (i0 >> 11) == xg, b1 = (i1 >> 11) == xg;
        const unsigned long long m0 = __ballot(b0), m1 = __ballot(b1);
        const int n0 = __popcll(m0), n = n0 + __popcll(m1);
        sb0 = b0; sb1 = b1; sk0 = __popcll(m0 & lt); sk1 = n0 + __popcll(m1 & lt);
        if (b0) { *(u32x4*)(cl + 4 * sk0) = (u32x4){(unsigned)lane, (unsigned)i0, g0, 0u}; su0 = usi[i0]; sv0 = vsi[i0]; }
        if (b1) { *(u32x4*)(cl + 4 * sk1) = (u32x4){(unsigned)(64 + lane), (unsigned)i1, g1, 0u}; su1 = usi[i1]; sv1 = vsi[i1]; }
        if (n == 0 && lane == 0) *(u32x4*)cl = (u32x4){0u, 0u, 0u, 0u};
        *(u32x4*)(hb + lane * 16) = h0;
        if (lane == 0) *(float*)(hb + 1024) = hs0;
        return n;
    };
    auto flush_scales = [&](int bi) {
        float* cs = (float*)(hbb + bi * 4096 + 1536);
        if (sb0) *(f32x2*)(cs + 2 * sk0) = (f32x2){su0, sv0};
        if (sb1) *(f32x2*)(cs + 2 * sk1) = (f32x2){su1, sv1};
    };
    ld_tok(wv);
    int nC = stage_tok(0);
    flush_scales(0);
    ld_tok(wv + nwv);
    int slotC, idC; bool validC; float g_in;
    { validC = grp < nC; const int kk = validC ? grp : 0; const u32x4 e = *(const u32x4*)(clb + 4 * kk); slotC = e.x; idC = e.y; g_in = __uint_as_float(e.z); }
    u32x4 uv[8];
    {
        const unsigned uoff = (unsigned)idC * 1024u + (unsigned)sub * 16u;
#pragma unroll
        for (int t = 0; t < 8; ++t) { uv[t] = *(const u32x4*)(U + (uoff + t * 128)); __builtin_amdgcn_sched_barrier(0); }
    }
    int it = 0;
    for (int tok = wv; tok < NTOK; tok += nwv, ++it) {
        const int cb = it & 1;
        const unsigned* clC = clb + cb * 512; const unsigned* clN = clb + (cb ^ 1) * 512;
        const unsigned char* hbC = hbb + cb * 4096;
        const bool more = tok + nwv < NTOK;
        const int nN = stage_tok(cb ^ 1); ld_tok(tok + 2 * nwv);
        const float shC = *(const float*)(hbC + 1024);
        const int nr = nC > 8 ? (nC + 7) >> 3 : 1;
        u32x4 hq[8];
#pragma unroll
        for (int t = 0; t < 8; ++t) hq[t] = *(const u32x4*)(hbC + (sub + 8 * t) * 16);
        auto do_round = [&](int rd) {
            const f32x2 s2 = *(const f32x2*)(hbC + 1536 + 8 * (validC ? 8 * rd + grp : 0));
            int slotN, idN; bool validN; float g_inN;
            {
                u32x4 e;
                if (rd + 1 < nr) { const int k = 8 * (rd + 1) + grp; validN = k < nC; e = *(const u32x4*)(clC + 4 * (validN ? k : 0)); }
                else if (more) { validN = grp < nN; e = *(const u32x4*)(clN + 4 * (validN ? grp : 0)); }
                else { validN = false; e = *(const u32x4*)clC; }
                slotN = e.x; idN = e.y; g_inN = __uint_as_float(e.z);
            }
            const unsigned uoffN = ((unsigned)idN & (DRY ? UMASK : 0xffffffffu)) * 1024u + (unsigned)sub * 16u;
            __builtin_amdgcn_sched_barrier(0);
            int a0 = 0, a1 = 0, a2 = 0, a3 = 0;
#pragma unroll
            for (int t = 0; t < 8; ++t) {
                const u32x4 q = uv[t];
                a0 = __builtin_amdgcn_sdot4((int)q.x, (int)hq[t].x, a0, false); a1 = __builtin_amdgcn_sdot4((int)q.y, (int)hq[t].y, a1, false);
                a2 = __builtin_amdgcn_sdot4((int)q.z, (int)hq[t].z, a2, false); a3 = __builtin_amdgcn_sdot4((int)q.w, (int)hq[t].w, a3, false);
                uv[t] = *(const u32x4*)(U + (uoffN + t * 128));
                __builtin_amdgcn_sched_barrier(0);
            }
            int di = (a0 + a1) + (a2 + a3);
            di += __builtin_amdgcn_update_dpp(0, di, 0xB1, 0xF, 0xF, true);
            di += __builtin_amdgcn_update_dpp(0, di, 0x4E, 0xF, 0xF, true);
            di += __builtin_amdgcn_update_dpp(0, di, 0x141, 0xF, 0xF, true);
            if (validC && sub == 0) {
                float* gw = DRY ? (float*)(ws + OFF_R) + (long)tok * 128 + slotC : rgate + (long)tok * 128 + slotC;
                *gw = g_in * gelu_tanh((float)di * s2.x * shC) * s2.y;
            }
            slotC = slotN; idC = idN; validC = validN; g_in = g_inN;
        };
        do_round(0);
        for (int rd = 1; rd < nr; ++rd) do_round(rd);
        flush_scales(cb ^ 1);
        nC = nN;
    }
}

#ifndef VMASK
#define VMASK 0xffffffffu
#endif
template <bool DRY>
DI void phase_peer_v(const Params& p, int layer, unsigned char* lds, int tid) {
    unsigned char* ws = p.ws;
    const int* ridx = (const int*)(ws + OFF_RIDX);
    const float* wact = (const float*)(ws + OFF_RGATE);
    const float* ada = (const float*)(ws + OFF_ADA);
    float* x = opq(p.out);
    const int lane = tid & 63, w = __builtin_amdgcn_readfirstlane(tid >> 6), sub = lane & 7, eg = lane >> 3;
    const int xg = blockIdx.x & 7, lb = blockIdx.x >> 3, nwv = (gridDim.x >> 3) * NWAVES, wv = lb * NWAVES + w;
    if (lb >= (int)(gridDim.x >> 3)) return;
    const unsigned char* Vc = ws + OFF_PV + ((long)(layer * 8 + xg) * 16384) * 128;
    const int col0 = 128 * xg + 16 * sub;
    unsigned* ring = (unsigned*)(lds + w * 4096);
    int ia, ib; float wa, wb;
    auto ld_tokv = [&](int tk) {
        tk = tk < NTOK ? tk : wv;
        ia = ridx[(long)tk * 128 + lane]; ib = ridx[(long)tk * 128 + 64 + lane];
        wa = wact[(long)tk * 128 + lane]; wb = wact[(long)tk * 128 + 64 + lane];
    };
    auto st_ring = [&](int slot) {
        unsigned* rs = ring + slot * 256;
        rs[lane] = (unsigned)ia; rs[64 + lane] = (unsigned)ib; rs[128 + lane] = __float_as_uint(wa); rs[192 + lane] = __float_as_uint(wb);
    };
    auto rd_ids = [&](int slot, u32x4 (&a)[4]) {
        const u32x4* ip = (const u32x4*)(ring + slot * 256 + eg * 16);
#pragma unroll
        for (int q = 0; q < 4; ++q) a[q] = ip[q];
    };
    auto rd_w = [&](int slot, f32x4 (&wq)[4]) {
        const f32x4* wp = (const f32x4*)(ring + slot * 256 + 128 + eg * 16);
#pragma unroll
        for (int q = 0; q < 4; ++q) wq[q] = wp[q];
    };
    u32x4 vv[16];
    ld_tokv(wv); st_ring(0);
    ld_tokv(wv + nwv); st_ring(1);
    ld_tokv(wv + 2 * nwv);
    {
        u32x4 a[4];
        rd_ids(0, a);
#pragma unroll
        for (int j = 0; j < 16; ++j) {
            vv[j] = *(const u32x4*)(Vc + ((a[j >> 2][j & 3] & (DRY ? VMASK : 0xffffffffu)) * 128u + (unsigned)sub * 16u));
            __builtin_amdgcn_sched_barrier(0);
        }
    }
    f32x4 gfv[4]; int gb = -1;
    f32x4 xv[4];
    if (eg == 0) {
#pragma unroll
        for (int c = 0; c < 4; ++c) xv[c] = *(const f32x4*)(x + (long)wv * DM + col0 + 4 * c);
    }
    int it = 0;
    for (int tok = wv; tok < NTOK; tok += nwv, ++it) {
        st_ring((it + 2) & 3);
        ld_tokv(tok + 3 * nwv);
        u32x4 na[4]; f32x4 cw[4];
        rd_ids((it + 1) & 3, na);
        rd_w(it & 3, cw);
        {
            const int b = tok >> 13;
            if (b != gb) {
                gb = b;
                const float* gf = ada + b * ADA_STRIDE + layer * 6144 + 5 * 1024 + col0;
#pragma unroll
                for (int c = 0; c < 4; ++c) gfv[c] = *(const f32x4*)(gf + 4 * c);
            }
        }
        f32x2 ap[8];
#pragma unroll
        for (int i = 0; i < 8; ++i) ap[i] = (f32x2){0.f, 0.f};
#pragma unroll
        for (int j = 0; j < 16; ++j) {
            const float ws1 = cw[j >> 2][j & 3]; const f32x2 ww = {ws1, ws1}; const u32x4 v = vv[j];
            ap[0] += __builtin_amdgcn_cvt_pk_f32_fp8((int)v.x, false) * ww; ap[1] += __builtin_amdgcn_cvt_pk_f32_fp8((int)v.x, true) * ww;
            ap[2] += __builtin_amdgcn_cvt_pk_f32_fp8((int)v.y, false) * ww; ap[3] += __builtin_amdgcn_cvt_pk_f32_fp8((int)v.y, true) * ww;
            ap[4] += __builtin_amdgcn_cvt_pk_f32_fp8((int)v.z, false) * ww; ap[5] += __builtin_amdgcn_cvt_pk_f32_fp8((int)v.z, true) * ww;
            ap[6] += __builtin_amdgcn_cvt_pk_f32_fp8((int)v.w, false) * ww; ap[7] += __builtin_amdgcn_cvt_pk_f32_fp8((int)v.w, true) * ww;
            vv[j] = *(const u32x4*)(Vc + ((na[j >> 2][j & 3] & (DRY ? VMASK : 0xffffffffu)) * 128u + (unsigned)sub * 16u));
        }
        float acc[16];
#pragma unroll
        for (int i = 0; i < 8; ++i) { acc[2 * i] = ap[i].x; acc[2 * i + 1] = ap[i].y; }
#pragma unroll
        for (int i = 0; i < 16; ++i) { acc[i] += lr8(acc[i]); acc[i] = sum_x16(acc[i]); acc[i] = sum_x32(acc[i]); }
        if (eg == 0) {
            float* xr = DRY ? (float*)(ws + OFF_R + 16 * MB) + (long)tok * DM + col0 : x + (long)tok * DM + col0;
#pragma unroll
            for (int c = 0; c < 4; ++c) {
                const f32x4 gv = gfv[c];
                f32x4 o;
                o.x = xv[c].x + gv.x * acc[4 * c + 0]; o.y = xv[c].y + gv.y * acc[4 * c + 1];
                o.z = xv[c].z + gv.z * acc[4 * c + 2]; o.w = xv[c].w + gv.w * acc[4 * c + 3];
                *(f32x4*)(xr + 4 * c) = o;
            }
            const int tn = tok + nwv < NTOK ? tok + nwv : wv;
#pragma unroll
            for (int c = 0; c < 4; ++c) xv[c] = *(const f32x4*)(x + (long)tn * DM + col0 + 4 * c);
        }
    }
}

DI void norm_row_q8(const f32x4 (&v)[4], float rstd, const float* gain, const float* shift, const float* scale, unsigned char* orow, float* os, int lane) {
    f32x4 y[4]; float am = 0.f;
#pragma unroll
    for (int j = 0; j < 4; ++j) {
        const int c = 4 * lane + 256 * j;
        const f32x4 g = *(const f32x4*)(gain + c), sh = *(const f32x4*)(shift + c), sc = *(const f32x4*)(scale + c);
        y[j].x = v[j].x * rstd * g.x * (1.f + sc.x) + sh.x; y[j].y = v[j].y * rstd * g.y * (1.f + sc.y) + sh.y;
        y[j].z = v[j].z * rstd * g.z * (1.f + sc.z) + sh.z; y[j].w = v[j].w * rstd * g.w * (1.f + sc.w) + sh.w;
        am = fmaxf(am, fmaxf(fmaxf(fabsf(y[j].x), fabsf(y[j].y)), fmaxf(fabsf(y[j].z), fabsf(y[j].w))));
    }
    am = wave_max(am);
    const float qs = am > 0.f ? 127.f / am : 1.f;
#pragma unroll
    for (int j = 0; j < 4; ++j) *(int*)(orow + 4 * lane + 256 * j) = pack_i8x4(y[j].x * qs, y[j].y * qs, y[j].z * qs, y[j].w * qs);
    if (lane == 0) *os = am > 0.f ? am * (1.f / 127.f) : 1.f;
}
DI void phase_norm2(const float* __restrict__ x, unsigned char* __restrict__ out1, float* __restrict__ os1, const float* gain1, int sh1, int sc1,
                    unsigned char* __restrict__ out2, float* __restrict__ os2, const float* gain2, int sh2, int sc2, const float* ada, int tid) {
    const int lane = tid & 63, gw = blockIdx.x * NWAVES + (tid >> 6), nw = gridDim.x * NWAVES;
    for (int tok = gw; tok < NTOK; tok += nw) {
        const int b = tok >> 13;
        f32x4 v[4]; float ss = 0.f;
#pragma unroll
        for (int j = 0; j < 4; ++j) { v[j] = *(const f32x4*)(x + (long)tok * DM + 4 * lane + 256 * j); ss += v[j].x * v[j].x + v[j].y * v[j].y + v[j].z * v[j].z + v[j].w * v[j].w; }
        const float rstd = rsqrtf(wave_sum(ss) * (1.f / DM) + EPS);
        norm_row_q8(v, rstd, gain1, ada + b * ADA_STRIDE + sh1, ada + b * ADA_STRIDE + sc1, out1 + (long)tok * DM, os1 + tok, lane);
        norm_row_q8(v, rstd, gain2, ada + b * ADA_STRIDE + sh2, ada + b * ADA_STRIDE + sc2, out2 + (long)tok * DM, os2 + tok, lane);
    }
}

template <int MT, class Epi>
DI void gemm_phase(const bf16_t* A, long lda, int M, const bf16_t* Bt, long ldb, int N, int K, const Epi& epi, unsigned char* lds, int tid) {
    const int ntm = (M + 128 * MT - 1) / (128 * MT), ntn = (N + 255) / 256, nt = ntm * ntn;
    if ((gridDim.x & 7) == 0 && (ntm & 31) == 0) {
        const int xcd = blockIdx.x & 7, lb = blockIdx.x >> 3, nlb = gridDim.x >> 3, tmx = ntm >> 3, per = tmx * ntn;
        for (int q = lb; q < per; q += nlb) {
            const int g4 = q / (4 * ntn), rem = q - g4 * 4 * ntn, tn = rem >> 2, tm = xcd * tmx + g4 * 4 + (rem & 3);
            if (tm < (xcd + 1) * tmx) gemm_tile<MT>(A, lda, M, Bt, ldb, N, K, tm * 128 * MT, tn * 256, epi, lds, tid);
        }
        return;
    }
    for (int t = blockIdx.x; t < nt; t += gridDim.x) {
        const int tn = t / ntm, tm = t % ntm;
        gemm_tile<MT>(A, lda, M, Bt, ldb, N, K, tm * 128 * MT, tn * 256, epi, lds, tid);
    }
}

template <int MT, class Epi>
DI void gemm_tile_i8(const unsigned char* __restrict__ A, int M, const float* __restrict__ as, const unsigned char* __restrict__ Bt, int N, const float* __restrict__ bs,
                     int K, int m0, int n0, const Epi& epi, unsigned char* lds, int tid) {
    constexpr int XS = MT * 128 * 128, WS = 256 * 128, STAGE = XS + WS;
    const int lane = tid & 63, w = tid >> 6, tg = w & 3, fh = w >> 2, r = lane & 31, h = lane >> 5;
    const int wbase = tid & ~63;
    unsigned xo[2 * MT], wo[4];
#pragma unroll
    for (int i = 0; i < 2 * MT; ++i) { int row, c; sw2_src(tid + 512 * i, row, c); int m = m0 + row; m = m < M ? m : M - 1; xo[i] = (unsigned)m * (unsigned)K + c * 16; }
#pragma unroll
    for (int i = 0; i < 4; ++i) { int row, c; sw2_src(tid + 512 * i, row, c); int n = n0 + row; n = n < N ? n : N - 1; wo[i] = (unsigned)n * (unsigned)K + c * 16; }
    auto stage = [&](int kt, unsigned char* st) {
#pragma unroll
        for (int i = 0; i < 2 * MT; ++i)
            __builtin_amdgcn_global_load_lds((const unsigned*)(A + kt * 128 + xo[i]), (unsigned*)(st + (wbase + 512 * i) * 16), 16, 0, 0);
#pragma unroll
        for (int i = 0; i < 4; ++i)
            __builtin_amdgcn_global_load_lds((const unsigned*)(Bt + kt * 128 + wo[i]), (unsigned*)(st + XS + (wbase + 512 * i) * 16), 16, 0, 0);
    };
    i32x16 acc[MT][4];
#pragma unroll
    for (int s2 = 0; s2 < MT; ++s2)
#pragma unroll
        for (int i = 0; i < 4; ++i)
#pragma unroll
            for (int j = 0; j < 16; ++j) acc[s2][i][j] = 0;
    const int nk = K >> 7;
    stage(0, lds);
    __syncthreads();
#pragma unroll 2
    for (int kt = 0; kt < nk; ++kt) {
        unsigned char* cur = lds + (kt & 1) * STAGE;
        if (kt + 1 < nk) stage(kt + 1, lds + ((kt + 1) & 1) * STAGE);
        i32x4 xfa[MT], wfa[4], xfb[MT], wfb[4];
        auto ldf = [&](i32x4 (&xf)[MT], i32x4 (&wf)[4], int ks) {
#pragma unroll
            for (int s2 = 0; s2 < MT; ++s2) xf[s2] = *(const i32x4*)(cur + sw2(32 * MT * tg + 32 * s2 + r, 2 * ks + h));
#pragma unroll
            for (int mt = 0; mt < 4; ++mt) wf[mt] = *(const i32x4*)(cur + XS + sw2(128 * fh + 32 * mt + r, 2 * ks + h));
        };
        auto mm = [&](const i32x4 (&xf)[MT], const i32x4 (&wf)[4]) {
#pragma unroll
            for (int mt = 0; mt < 4; ++mt)
#pragma unroll
                for (int s2 = 0; s2 < MT; ++s2) acc[s2][mt] = MFMA32I8(wf[mt], xf[s2], acc[s2][mt]);
        };
        ldf(xfa, wfa, 0);
        ldf(xfb, wfb, 1); __builtin_amdgcn_sched_barrier(0); mm(xfa, wfa); __builtin_amdgcn_sched_barrier(0);
        ldf(xfa, wfa, 2); __builtin_amdgcn_sched_barrier(0); mm(xfb, wfb); __builtin_amdgcn_sched_barrier(0);
        ldf(xfb, wfb, 3); __builtin_amdgcn_sched_barrier(0); mm(xfa, wfa); __builtin_amdgcn_sched_barrier(0);
        mm(xfb, wfb);
        __syncthreads();
    }
    auto fin = [&](const i32x16 (&ai)[4], int s2, int ho, int ro, int to) {
        const int tok = m0 + 32 * MT * tg + 32 * s2 + ro, fbase = n0 + 128 * fh;
        const float sa = as[tok < M ? tok : M - 1];
        f32x16 af[4];
#pragma unroll
        for (int mt = 0; mt < 4; ++mt) {
#pragma unroll
            for (int g4 = 0; g4 < 4; ++g4) {
                int f0 = fbase + 32 * mt + 8 * g4 + 4 * ho; f0 = f0 + 3 < N ? f0 : (N - 4 > 0 ? N - 4 : 0);
                const f32x4 sb = *(const f32x4*)(bs + f0);
                af[mt][4 * g4 + 0] = (float)ai[mt][4 * g4 + 0] * (sa * sb.x); af[mt][4 * g4 + 1] = (float)ai[mt][4 * g4 + 1] * (sa * sb.y);
                af[mt][4 * g4 + 2] = (float)ai[mt][4 * g4 + 2] * (sa * sb.z); af[mt][4 * g4 + 3] = (float)ai[mt][4 * g4 + 3] * (sa * sb.w);
            }
            __builtin_amdgcn_sched_barrier(0);
        }
        epi(af, tok, fbase, ho, lds, to);
        __builtin_amdgcn_sched_barrier(0);
    };
    if constexpr (MT == 2 && epi_stash<Epi>::present) {
        int* sp = (int*)lds + w * 4096 + lane;
#pragma unroll
        for (int mt = 0; mt < 4; ++mt)
#pragma unroll
            for (int j = 0; j < 16; ++j) sp[(mt * 16 + j) * 64] = acc[1][mt][j];
        int ho = h, ro = r, to = tid;
        asm volatile("" : "+v"(ho), "+v"(ro), "+v"(to));
        fin(acc[0], 0, ho, ro, to);
        i32x16 a2[4];
        const int* sp2 = sp; asm volatile("" : "+v"(sp2));
#pragma unroll
        for (int mt = 0; mt < 4; ++mt)
#pragma unroll
            for (int j = 0; j < 16; ++j) a2[mt][j] = sp2[(mt * 16 + j) * 64];
        asm volatile("" : "+v"(ho), "+v"(ro), "+v"(to));
        fin(a2, 1, ho, ro, to);
        __syncthreads();
    } else {
        int ho = h, ro = r, to = tid;
#pragma unroll
        for (int s2 = 0; s2 < MT; ++s2) { asm volatile("" : "+v"(ho), "+v"(ro), "+v"(to)); fin(acc[s2], s2, ho, ro, to); }
    }
}
template <int MT, class Epi>
DI void gemm_phase_i8(const unsigned char* A, int M, const float* as, const unsigned char* Bt, int N, const float* bs, int K, const Epi& epi, unsigned char* lds, int tid) {
    const int ntm = (M + 128 * MT - 1) / (128 * MT), ntn = (N + 255) / 256, nt = ntm * ntn;
    if ((gridDim.x & 7) == 0 && (ntm & 31) == 0) {
        const int xcd = blockIdx.x & 7, lb = blockIdx.x >> 3, nlb = gridDim.x >> 3, tmx = ntm >> 3, per = tmx * ntn;
        for (int q = lb; q < per; q += nlb) {
            const int g4 = q / (4 * ntn), rem = q - g4 * 4 * ntn, tn = rem >> 2, tm = xcd * tmx + g4 * 4 + (rem & 3);
            gemm_tile_i8<MT>(A, M, as, Bt, N, bs, K, tm * 128 * MT, tn * 256, epi, lds, tid);
        }
        return;
    }
    for (int t = blockIdx.x; t < nt; t += gridDim.x) {
        const int tn = t / ntm, tm = t % ntm;
        gemm_tile_i8<MT>(A, M, as, Bt, N, bs, K, tm * 128 * MT, tn * 256, epi, lds, tid);
    }
}

DI void wquant_rows(const bf16_t* __restrict__ src, unsigned char* __restrict__ dst, float* __restrict__ sc, int nrows, int gw, int nw, int lane) {
    for (int n = gw; n < nrows; n += nw) {
        const u32x4 a = *(const u32x4*)(src + (long)n * 1024 + 16 * lane), b = *(const u32x4*)(src + (long)n * 1024 + 16 * lane + 8);
        float v[16];
        v[0] = bflo(a.x); v[1] = bfhi(a.x); v[2] = bflo(a.y); v[3] = bfhi(a.y); v[4] = bflo(a.z); v[5] = bfhi(a.z); v[6] = bflo(a.w); v[7] = bfhi(a.w);
        v[8] = bflo(b.x); v[9] = bfhi(b.x); v[10] = bflo(b.y); v[11] = bfhi(b.y); v[12] = bflo(b.z); v[13] = bfhi(b.z); v[14] = bflo(b.w); v[15] = bfhi(b.w);
        float am = 0.f;
#pragma unroll
        for (int q = 0; q < 16; ++q) am = fmaxf(am, fabsf(v[q]));
        am = wave_max(am);
        const float qs = am > 0.f ? 127.f / am : 1.f;
        u32x4 o;
        o.x = (unsigned)pack_i8x4(v[0] * qs, v[1] * qs, v[2] * qs, v[3] * qs); o.y = (unsigned)pack_i8x4(v[4] * qs, v[5] * qs, v[6] * qs, v[7] * qs);
        o.z = (unsigned)pack_i8x4(v[8] * qs, v[9] * qs, v[10] * qs, v[11] * qs); o.w = (unsigned)pack_i8x4(v[12] * qs, v[13] * qs, v[14] * qs, v[15] * qs);
        *(u32x4*)(dst + (long)n * 1024 + 16 * lane) = o;
        if (lane == 0) sc[n] = am > 0.f ? am * (1.f / 127.f) : 1.f;
    }
}
DI void phase_wquant(unsigned char* ws, int tid) {
    const int lane = tid & 63, gw = blockIdx.x * NWAVES + (tid >> 6), nw = gridDim.x * NWAVES;
    float* sc = (float*)(ws + OFF_W8S);
    wquant_rows((const bf16_t*)(ws + OFF_WT_PEER), ws + OFF_W8_PEER, sc + W8S_PEER, 4096, gw, nw, lane);
    wquant_rows((const bf16_t*)(ws + OFF_WT_DIN), ws + OFF_W8_DIN, sc + W8S_DIN, 3072, gw, nw, lane);
    wquant_rows((const bf16_t*)(ws + OFF_WT_KV), ws + OFF_W8_KV, sc + W8S_KV, 1536, gw, nw, lane);
    wquant_rows((const bf16_t*)(ws + OFF_WT_NIN), ws + OFF_W8_NIN, sc + W8S_NIN, 1088, gw, nw, lane);
}

#define XB_TMO      128
#define XB_XCNT(j)  (256  + 64 * (j))
#define XB_XSUB(j)  (1280 + 64 * (j))
#define XB_XGEN(j)  (2304 + 64 * (j))
#define XB_TOP      3328
#define XB_TOPGEN   3392
#define XCD_BAR_WORDS 3456
#define XB_SPIN_CAP (1u << 22)
#define LAS __attribute__((address_space(3)))
DI unsigned xb_ld(unsigned* p) { return __hip_atomic_load(p, __ATOMIC_RELAXED, __HIP_MEMORY_SCOPE_AGENT); }
DI unsigned xb_add(unsigned* p, unsigned v) { return __hip_atomic_fetch_add(p, v, __ATOMIC_RELAXED, __HIP_MEMORY_SCOPE_AGENT); }
DI unsigned xb_xcc_id() { return (unsigned)__builtin_amdgcn_s_getreg((3 << 11) | 20) & 0xFu; }
#define XB_SPIN(cond, bar) do { unsigned _sp = 0; while (cond) { __builtin_amdgcn_s_sleep(1); \
    if ((++_sp & 255u) == 0u) { if (xb_ld(&(bar)[XB_TMO])) break; if (_sp > XB_SPIN_CAP) { atomicAdd(&(bar)[XB_TMO], 1u); break; } } } } while (0)
DI void xcd_barrier_complete(unsigned* bar, unsigned x, unsigned& nloc, unsigned& nx) {
    const unsigned G = gridDim.x;
    unsigned sum, cnt, mine, sp = 0u;
    for (;;) {
        sum = 0u; cnt = 0u; mine = 0u;
#pragma unroll
        for (unsigned j = 0; j < 16; ++j) { const unsigned c = xb_ld(&bar[XB_XCNT(j)]); sum += c; cnt += (c > 0u) ? 1u : 0u; mine = (j == x) ? c : mine; }
        if (sum == G) break;
        __builtin_amdgcn_s_sleep(1);
        if ((++sp & 255u) == 0u) { if (xb_ld(&bar[XB_TMO])) break; if (sp > XB_SPIN_CAP) { atomicAdd(&bar[XB_TMO], 1u); break; } }
    }
    nloc = mine > 0u ? mine : 1u; nx = cnt > 0u ? cnt : 1u;
}
DI void xcd_barrier(unsigned* bar, volatile LAS unsigned* st, int tid) {
    asm volatile("s_waitcnt vmcnt(0)" ::: "memory");
    __syncthreads();
    if (tid == 0) {
        const unsigned x = xb_xcc_id();
        __builtin_amdgcn_s_waitcnt(0);
        unsigned nloc = st[0], nx = st[1];
        if (nloc == 0u) { xcd_barrier_complete(bar, x, nloc, nx); st[0] = nloc; st[1] = nx; }
        const unsigned old = xb_add(&bar[XB_XSUB(x)], 1u);
        const unsigned gen = old / nloc;
        if (old + 1u == (gen + 1u) * nloc) {
            __builtin_amdgcn_fence(__ATOMIC_RELEASE, "agent");
            asm volatile("s_waitcnt vmcnt(0)" ::: "memory");
            const unsigned og = xb_add(&bar[XB_TOP], 1u);
            const unsigned tg = og / nx;
            if (og + 1u == (tg + 1u) * nx) xb_add(&bar[XB_TOPGEN], 1u);
            else XB_SPIN(xb_ld(&bar[XB_TOPGEN]) == tg, bar);
            __builtin_amdgcn_fence(__ATOMIC_ACQUIRE, "agent");
            xb_add(&bar[XB_XGEN(x)], 1u);
            asm volatile("s_waitcnt vmcnt(0)" ::: "memory");
        } else {
            XB_SPIN(xb_ld(&bar[XB_XGEN(x)]) == gen, bar);
            __builtin_amdgcn_fence(__ATOMIC_ACQUIRE, "agent");
            asm volatile("s_waitcnt vmcnt(0)" ::: "memory");
        }
    }
    __syncthreads();
}

#define ftid() ftid_(wave_u)
DI int ftid_(int wave_u) { int t = (wave_u << 6) + (int)__builtin_amdgcn_mbcnt_hi(~0u, __builtin_amdgcn_mbcnt_lo(~0u, 0u)); asm volatile("" : "+v"(t)); return t; }


#if defined(__HIP_DEVICE_COMPILE__)
typedef const __attribute__((address_space(4))) Params* KParamPtr;
DI Params load_params() { KParamPtr kp = (KParamPtr)__builtin_amdgcn_kernarg_segment_ptr(); asm volatile("" : "+s"(kp)); return *kp; }
#else
DI Params load_params() { return Params{}; }
#endif
#define p (load_params())
#define ws (load_params().ws)
#define ada ((const float*)(ws + OFF_ADA))
#define Hb ((bf16_t*)(ws + OFF_H))
#define bar ((unsigned*)(ws + OFF_BAR))
__global__ void __launch_bounds__(NTHREADS) yoco_fwd(Params p_arg) {
    extern __shared__ __attribute__((aligned(16))) unsigned char lds[];
    cg::grid_group grid = cg::this_grid();
    volatile LAS unsigned* bst = (volatile LAS unsigned*)(lds + 144 * 1024);
    const int wave_u = __builtin_amdgcn_readfirstlane((int)(threadIdx.x >> 6));
    { const int t0 = ftid(); if (t0 == 0) { bst[0] = 0u; bst[1] = 0u; }
      if (blockIdx.x == 0) for (int i = t0; i < XCD_BAR_WORDS; i += NTHREADS) bar[i] = 0u; }
    __syncthreads();
    RUN(0) REP(0) phase_prep(p, lds, ftid());
    grid.sync();
    if (ftid() == 0) (void)xb_add(&bar[XB_XCNT(xb_xcc_id())], 1u);
    RUN(1) REP(1) phase_norm_q8<false>(p.in[0], Hb, ws + OFF_H8, (float*)(ws + OFF_HS), p.in[5], ada, 0, 1024, ftid());
    RUN(1) phase_wquant(ws, ftid());
    xcd_barrier(bar, bst, ftid());
    RUN(2) REP(2) {
        EpiQKV0 e{(bf16_t*)(ws + OFF_Q0), (bf16_t*)(ws + OFF_K0), (bf16_t*)(ws + OFF_VT0), p.in[10], p.in[11], (float*)(ws + OFF_MB0), p.in[2]};
        gemm_phase_i8<2>(ws + OFF_H8, NTOK, (const float*)(ws + OFF_HS), ws + OFF_W8_DIN, 3072, (const float*)(ws + OFF_W8S) + W8S_DIN, DM, e, lds, ftid());
    }
    xcd_barrier(bar, bst, ftid());
    RUN(3) REP(3) phase_diff_attn(p, lds, ftid());
    xcd_barrier(bar, bst, ftid());
    RUN(4) REP(4) {
        EpiResid e{p.in[0], opq(p.out), ada + 2 * 1024};
        gemm_phase<2>(Hb, DM, NTOK, (const bf16_t*)(ws + OFF_WT_DOUT), DM, 1024, DM, e, lds, ftid());
    }
    xcd_barrier(bar, bst, ftid());
    if (STOP_AFTER <= 1) return;
    RUN(1) phase_norm_q8<false>(opq(p.out), Hb, ws + OFF_H8, (float*)(ws + OFF_HS), p.in[6], ada, 3 * 1024, 4 * 1024, ftid());
    xcd_barrier(bar, bst, ftid());
    RUN(5) REP(5) {
        EpiPeer e{(int*)(ws + OFF_RIDX), (float*)(ws + OFF_RGATE), 128 * 1024};
        gemm_phase_i8<2>(ws + OFF_H8, NTOK, (const float*)(ws + OFF_HS), ws + OFF_W8_PEER, 2048, (const float*)(ws + OFF_W8S) + W8S_PEER, DM, e, lds, ftid());
    }
    xcd_barrier(bar, bst, ftid());
    if ((REPEAT_MASK >> 6) & 1) phase_peer_u<true>(p, 0, lds, ftid());
    RUN(6) phase_peer_u<false>(p, 0, lds, ftid());
    xcd_barrier(bar, bst, ftid());
    if ((REPEAT_MASK >> 10) & 1) phase_peer_v<true>(p, 0, lds, ftid());
    RUN(6) phase_peer_v<false>(p, 0, lds, ftid());
    xcd_barrier(bar, bst, ftid());
    RUN(1) phase_norm2(opq(p.out), ws + OFF_H8, (float*)(ws + OFF_HS), p.in[13], 12288, 12288 + 1024, ws + OFF_H, (float*)(ws + OFF_HS) + NTOK, p.in[5] + 1024, 6144, 6144 + 1024, ada, ftid());
    xcd_barrier(bar, bst, ftid());
    if (STOP_AFTER <= 2) return;
    RUN(7) REP(7) {
        EpiKV e{(bf16_t*)(ws + OFF_KC), (bf16_t*)(ws + OFF_KS), (bf16_t*)(ws + OFF_VST), (bf16_t*)(ws + OFF_KW), (bf16_t*)(ws + OFF_VWT), p.in[21]};
        gemm_phase_i8<2>(ws + OFF_H8, NTOK, (const float*)(ws + OFF_HS), ws + OFF_W8_KV, 1536, (const float*)(ws + OFF_W8S) + W8S_KV, DM, e, lds, ftid());
    }
    xcd_barrier(bar, bst, ftid());
    RUN(8) REP(8) {
        EpiNsaQ e{(bf16_t*)(ws + OFF_QN), (float*)(ws + OFF_GATES), p.in[25], p.in[23], (float*)(ws + OFF_MB1)};
        gemm_phase_i8<2>(ws + OFF_H, NTOK, (const float*)(ws + OFF_HS) + NTOK, ws + OFF_W8_NIN, 1048, (const float*)(ws + OFF_W8S) + W8S_NIN, DM, e, lds, ftid());
        for (int t = blockIdx.x; t < 64; t += gridDim.x) {
            const int pr = t >> 2, tm = t & 3, kv = pr >> 3, bg = pr & 7;
            const bf16_t* Ap = (const bf16_t*)(ws + OFF_KC) + (long)(kv * 8 + bg) * SEQ * 128;
            bf16_t* hid = (bf16_t*)(ws + OFF_HID) + (long)pr * 512 * 256;
            EpiCmp1 e1{hid, (const float*)(ws + OFF_POSB) + kv * 16 * 256, p.in[19] + kv * 256};
            gemm_tile<1>(Ap, 2048, 511, (const bf16_t*)(ws + OFF_WT_C1) + (long)kv * 256 * 4096, 4096, 256, 4096, tm * 128, 0, e1, lds, ftid());
            __syncthreads();
            bf16_t* dst = kv == 0 ? (bf16_t*)(ws + OFF_KCMP) + (long)bg * 512 * 128 : (bf16_t*)(ws + OFF_VCMPT) + (long)bg * 128 * 512;
            EpiCmp2 e2{dst, p.in[21], kv};
            gemm_tile<1>(hid, 256, 512, (const bf16_t*)(ws + OFF_WT_C2) + (long)kv * 128 * 256, 256, 128, 256, tm * 128, 0, e2, lds, ftid());
        }
    }
    xcd_barrier(bar, bst, ftid());
#ifdef NSA_PROBE
    phase_nsa_attn<NSA_PROBE>(p, lds, ftid());
#endif
    RUN(9) REP(9) phase_nsa_attn<0>(p, lds, ftid());
    xcd_barrier(bar, bst, ftid());
    RUN(4) {
        float* xo = opq(p.out);
        EpiResid e{xo, xo, ada + 6144 + 2 * 1024};
        gemm_phase<2>(Hb, DM, NTOK, (const bf16_t*)(ws + OFF_WT_NOUT), DM, 1024, DM, e, lds, ftid());
    }
    xcd_barrier(bar, bst, ftid());
    if (STOP_AFTER <= 3) return;
    RUN(1) phase_norm_q8<false>(opq(p.out), Hb, ws + OFF_H8, (float*)(ws + OFF_HS), p.in[6] + 1024, ada, 6144 + 3 * 1024, 6144 + 4 * 1024, ftid());
    xcd_barrier(bar, bst, ftid());
    RUN(5) REP(5) {
        EpiPeer e{(int*)(ws + OFF_RIDX), (float*)(ws + OFF_RGATE), 128 * 1024};
        gemm_phase_i8<2>(ws + OFF_H8, NTOK, (const float*)(ws + OFF_HS), ws + OFF_W8_PEER + (long)2048 * 1024, 2048, (const float*)(ws + OFF_W8S) + W8S_PEER + 2048, DM, e, lds, ftid());
    }
    xcd_barrier(bar, bst, ftid());
    if ((REPEAT_MASK >> 6) & 1) phase_peer_u<true>(p, 1, lds, ftid());
    RUN(6) phase_peer_u<false>(p, 1, lds, ftid());
    xcd_barrier(bar, bst, ftid());
    if ((REPEAT_MASK >> 10) & 1) phase_peer_v<true>(p, 1, lds, ftid());
    RUN(6) phase_peer_v<false>(p, 1, lds, ftid());
}
#undef p
#undef ws
#undef ada
#undef Hb
#undef bar

extern "C" void kernel_launch(void* const* d_in, const int* in_sizes, int n_in, void* d_out, int out_size, void* d_ws, size_t ws_size,
                              hipStream_t stream) {
    static int grid_blocks = 0;
    if (grid_blocks == 0) {
        if (n_in != 30 || out_size != NTOK * DM || ws_size < WS_END) {
            fprintf(stderr, "kernel_launch: unexpected shapes (n_in %d out %d ws %zu)\n", n_in, out_size, ws_size);
            grid_blocks = -1; return;
        }
        int dev = 0, cus = 0, per_cu = 0;
        hipGetDevice(&dev);
        hipDeviceGetAttribute(&cus, hipDeviceAttributeMultiprocessorCount, dev);
        hipFuncSetAttribute((const void*)yoco_fwd, hipFuncAttributeMaxDynamicSharedMemorySize, LDS_BYTES);
        hipOccupancyMaxActiveBlocksPerMultiprocessor(&per_cu, (const void*)yoco_fwd, NTHREADS, LDS_BYTES);
        if (per_cu < 1) { fprintf(stderr, "kernel_launch: occupancy query says %d blocks per CU\n", per_cu); grid_blocks = -1; return; }
        grid_blocks = cus;
    }
    if (grid_blocks < 0) return;
    Params p{};
    for (int i = 0; i < 30; ++i) p.in[i] = (const float*)d_in[i];
    p.out = (float*)d_out;
    p.ws = (unsigned char*)d_ws;
    void* args[] = {&p};
    hipError_t e = hipLaunchCooperativeKernel((const void*)yoco_fwd, dim3(grid_blocks), dim3(NTHREADS), args, LDS_BYTES, stream);
    if (e != hipSuccess) fprintf(stderr, "cooperative launch failed: %s (grid %d)\n", hipGetErrorString(e), grid_blocks);
}
```

```cpp
#include <hip/hip_runtime.h>
#include <hip/hip_cooperative_groups.h>
#include <cstdio>
#include <cstdint>
namespace cg = cooperative_groups;

#define DI __device__ __forceinline__
#ifndef STOP_AFTER
#define STOP_AFTER 99
#endif
#ifndef ONLY_PHASE
#define ONLY_PHASE -1
#endif
#define RUN(n) if (ONLY_PHASE < 0 || ONLY_PHASE == (n))
#ifndef REPEAT_MASK
#define REPEAT_MASK 0
#endif
#define REP(n) for (int rep_ = 0; rep_ < (((REPEAT_MASK) >> (n)) & 1) + 1; ++rep_)

typedef unsigned short bf16_t;
typedef short bf16x8 __attribute__((ext_vector_type(8)));
typedef float f32x16 __attribute__((ext_vector_type(16)));
typedef float f32x4 __attribute__((ext_vector_type(4)));
typedef float f32x2 __attribute__((ext_vector_type(2)));
typedef unsigned u32x4 __attribute__((ext_vector_type(4)));
typedef unsigned u32x2 __attribute__((ext_vector_type(2)));
typedef __bf16 bf16x2v __attribute__((ext_vector_type(2)));

#define MFMA32(a, b, c) __builtin_amdgcn_mfma_f32_32x32x16_bf16((a), (b), (c), 0, 0, 0)
typedef int i32x4 __attribute__((ext_vector_type(4)));
typedef int i32x16 __attribute__((ext_vector_type(16)));
#define MFMA32I8(a, b, c) __builtin_amdgcn_mfma_i32_32x32x32_i8((a), (b), (c), 0, 0, 0)

constexpr int NB = 4, SEQ = 8192, DM = 1024, NTOK = NB * SEQ;
constexpr int NTHREADS = 512, NWAVES = 8;
constexpr float EPS = 1e-6f;
constexpr float LOG2E = 1.4426950408889634f;
constexpr int ADA_STRIDE = 14336;

constexpr size_t MB = 1u << 20;
constexpr size_t OFF_ADA = 0;
constexpr size_t OFF_POSB = 256 * 1024;
constexpr size_t OFF_BAR = 320 * 1024;
constexpr size_t OFF_MB0 = 168 * MB;
constexpr size_t OFF_MB1 = 172 * MB;
constexpr size_t OFF_H8 = 104 * MB;
constexpr size_t OFF_HS = 174 * MB;
constexpr size_t OFF_W8 = 176 * MB;
constexpr size_t OFF_W8_DIN = OFF_W8, OFF_W8_KV = OFF_W8 + 3 * MB, OFF_W8_NIN = OFF_W8 + 5 * MB, OFF_W8_PEER = OFF_W8 + 7 * MB;
constexpr size_t OFF_W8S = 188 * MB;
constexpr int W8S_DIN = 0, W8S_KV = 3072, W8S_NIN = 4608, W8S_PEER = 5760, W8S_TOTAL = 9856;
constexpr size_t OFF_USI = 384 * 1024;
constexpr size_t OFF_VSI = 512 * 1024;
constexpr size_t OFF_WT_DIN = 1 * MB;
constexpr size_t OFF_WT_DOUT = 7 * MB;
constexpr size_t OFF_WT_KV = 9 * MB;
constexpr size_t OFF_WT_NIN = 12 * MB;
constexpr size_t OFF_WT_NOUT = 15 * MB;
constexpr size_t OFF_WT_PEER = 17 * MB;
constexpr size_t OFF_WT_C1 = 25 * MB;
constexpr size_t OFF_WT_C2 = 29 * MB;
constexpr size_t OFF_GATES = 30 * MB;
constexpr size_t OFF_KCMP = 34 * MB;
constexpr size_t OFF_VCMPT = 35 * MB;
constexpr size_t OFF_HID = 36 * MB;
constexpr size_t OFF_RIDX = 40 * MB;
constexpr size_t OFF_RGATE = 56 * MB;
constexpr size_t OFF_PU = 72 * MB;
constexpr size_t OFF_PV = 136 * MB;
constexpr size_t OFF_H = 200 * MB;
constexpr size_t OFF_R = 264 * MB;
constexpr size_t WS_END = 456 * MB;
constexpr size_t OFF_Q0 = OFF_R, OFF_K0 = OFF_R + 64 * MB, OFF_VT0 = OFF_R + 128 * MB;
constexpr size_t OFF_QN = OFF_R, OFF_H2 = OFF_R, OFF_KC = OFF_R + 64 * MB, OFF_KS = OFF_R + 96 * MB, OFF_VST = OFF_R + 112 * MB,
                 OFF_KW = OFF_R + 128 * MB, OFF_VWT = OFF_R + 144 * MB;

constexpr int LDS_BAR = 159 * 1024;
constexpr int LDS_BYTES = LDS_BAR + 256;

struct Params {
    const float* in[30];
    float* out;
    unsigned char* ws;
};

template <class T> DI T* opq(T* q) { asm volatile("" : "+s"(q)); return (T*)(__attribute__((address_space(1))) T*)q; }
DI unsigned pk2(float lo, float hi) { f32x2 v = {lo, hi}; return __builtin_bit_cast(unsigned, __builtin_convertvector(v, bf16x2v)); }
DI bf16_t f2bf(float x) { return (bf16_t)(pk2(x, 0.f) & 0xffffu); }
DI float bflo(unsigned u) { return __uint_as_float(u << 16); }
DI float bfhi(unsigned u) { return __uint_as_float(u & 0xffff0000u); }
DI float fexp2(float x) { return __builtin_amdgcn_exp2f(x); }
DI float frcp(float x) { return __builtin_amdgcn_rcpf(x); }
DI int crow(int reg, int h) { return (reg & 3) + 8 * (reg >> 2) + 4 * h; }
template <int CTRL> DI float dpp_f(float v) { return __builtin_bit_cast(float, __builtin_amdgcn_update_dpp(0, __builtin_bit_cast(int, v), CTRL, 0xF, 0xF, true)); }
DI float lx1(float v) { return dpp_f<0xB1>(v); }
DI float lx2(float v) { return dpp_f<0x4E>(v); }
DI float lhm(float v) { return dpp_f<0x141>(v); }
DI float lr8(float v) { return dpp_f<0x128>(v); }
DI float sum_x16(float v) { auto s = __builtin_amdgcn_permlane16_swap(__float_as_uint(v), __float_as_uint(v), false, false); return __uint_as_float(s[0]) + __uint_as_float(s[1]); }
DI float sum_x32(float v) { auto s = __builtin_amdgcn_permlane32_swap(__float_as_uint(v), __float_as_uint(v), false, false); return __uint_as_float(s[0]) + __uint_as_float(s[1]); }
DI float max_x16(float v) { auto s = __builtin_amdgcn_permlane16_swap(__float_as_uint(v), __float_as_uint(v), false, false); return fmaxf(__uint_as_float(s[0]), __uint_as_float(s[1])); }
DI float max_x32(float v) { auto s = __builtin_amdgcn_permlane32_swap(__float_as_uint(v), __float_as_uint(v), false, false); return fmaxf(__uint_as_float(s[0]), __uint_as_float(s[1])); }
DI unsigned get_x32(unsigned v, int h) { auto s = __builtin_amdgcn_permlane32_swap(v, v, false, false); return h ? s[0] : s[1]; }
DI float wave_sum(float v) { v += lx1(v); v += lx2(v); v += lhm(v); v += lr8(v); v = sum_x16(v); return sum_x32(v); }
DI float wave_max(float v) { v = fmaxf(v, lx1(v)); v = fmaxf(v, lx2(v)); v = fmaxf(v, lhm(v)); v = fmaxf(v, lr8(v)); v = max_x16(v); return max_x32(v); }
DI int bperm(int v, int srclane) { return __builtin_amdgcn_ds_bpermute(srclane << 2, v); }
DI float bpermf(float v, int srclane) { return __builtin_bit_cast(float, __builtin_amdgcn_ds_bpermute(srclane << 2, __builtin_bit_cast(int, v))); }
DI float gelu_tanh(float x) {
    const float u = 0.7978845608028654f * (x + 0.044715f * x * x * x);
    return x * frcp(1.f + fexp2(-2.f * LOG2E * u));
}
DI float dot2bf(unsigned a, unsigned b, float c) {
    return __builtin_amdgcn_fdot2_f32_bf16(__builtin_bit_cast(bf16x2v, a), __builtin_bit_cast(bf16x2v, b), c, false);
}
DI int rel_bucket_i(int d) {
    if (d < 16) return d < 0 ? 0 : d;
    int b = 16;
    b += d >= 21; b += d >= 27; b += d >= 35; b += d >= 46; b += d >= 59; b += d >= 77; b += d >= 99; b += d >= 128;
    b += d >= 166; b += d >= 216; b += d >= 280; b += d >= 363; b += d >= 470; b += d >= 609; b += d >= 790;
    return b;
}
DI unsigned f2key(float f) { unsigned u = __float_as_uint(f); return u ^ ((unsigned)((int)u >> 31) | 0x80000000u); }
DI float key2f(unsigned k) { unsigned u = (k & 0x80000000u) ? (k ^ 0x80000000u) : ~k; return __uint_as_float(u); }

constexpr int EPI_LDS = 96 * 1024;

DI int sw2(int row, int chunk) { return (row >> 1) * 256 + (((((row & 1) << 3) | chunk) ^ ((row >> 1) & 15)) << 4); }
DI void sw2_src(int P, int& row, int& chunk) { const int R2 = P >> 4, lc = (P & 15) ^ (R2 & 15); row = 2 * R2 + (lc >> 3); chunk = lc & 7; }

template <class T, class = void> struct epi_stash { static constexpr bool value = false, present = false; };
template <class T> struct epi_stash<T, decltype((void)T::STASH)> { static constexpr bool value = T::STASH, present = true; };

template <int MT, class Epi>
DI void gemm_tile(const bf16_t* __restrict__ A, long lda, int M, const bf16_t* __restrict__ Bt, long ldb, int N, int K,
                  int m0, int n0, const Epi& epi, unsigned char* lds, int tid) {
    constexpr int XS = MT * 128 * 128, WS = 256 * 128, STAGE = XS + WS;
    const int lane = tid & 63, w = tid >> 6, tg = w & 3, fh = w >> 2, r = lane & 31, h = lane >> 5;
    const int wbase = tid & ~63;
    unsigned xo[2 * MT], wo[4];
#pragma unroll
    for (int i = 0; i < 2 * MT; ++i) { int row, c; sw2_src(tid + 512 * i, row, c); int m = m0 + row; m = m < M ? m : M - 1; xo[i] = (unsigned)m * (unsigned)(lda * 2) + c * 16; }
#pragma unroll
    for (int i = 0; i < 4; ++i) { int row, c; sw2_src(tid + 512 * i, row, c); int n = n0 + row; n = n < N ? n : N - 1; wo[i] = (unsigned)n * (unsigned)(ldb * 2) + c * 16; }
    const unsigned char* Ab = (const unsigned char*)A;
    const unsigned char* Bb = (const unsigned char*)Bt;
    auto stage = [&](int kt, unsigned char* st) {
#pragma unroll
        for (int i = 0; i < 2 * MT; ++i)
            __builtin_amdgcn_global_load_lds((const unsigned*)(Ab + kt * 128 + xo[i]), (unsigned*)(st + (wbase + 512 * i) * 16), 16, 0, 0);
#pragma unroll
        for (int i = 0; i < 4; ++i)
            __builtin_amdgcn_global_load_lds((const unsigned*)(Bb + kt * 128 + wo[i]), (unsigned*)(st + XS + (wbase + 512 * i) * 16), 16, 0, 0);
    };
    f32x16 acc[MT][4];
#pragma unroll
    for (int s2 = 0; s2 < MT; ++s2)
#pragma unroll
        for (int i = 0; i < 4; ++i)
#pragma unroll
            for (int j = 0; j < 16; ++j) acc[s2][i][j] = 0.f;
    const int nk = K >> 6;
    stage(0, lds);
    __syncthreads();
    for (int kt = 0; kt < nk; ++kt) {
        unsigned char* cur = lds + (kt & 1) * STAGE;
        if (kt + 1 < nk) stage(kt + 1, lds + ((kt + 1) & 1) * STAGE);
        bf16x8 xfa[MT], wfa[4], xfb[MT], wfb[4];
        auto ldf = [&](bf16x8 (&xf)[MT], bf16x8 (&wf)[4], int ks) {
#pragma unroll
            for (int s2 = 0; s2 < MT; ++s2) xf[s2] = *(const bf16x8*)(cur + sw2(32 * MT * tg + 32 * s2 + r, 2 * ks + h));
#pragma unroll
            for (int mt = 0; mt < 4; ++mt) wf[mt] = *(const bf16x8*)(cur + XS + sw2(128 * fh + 32 * mt + r, 2 * ks + h));
        };
        auto mm = [&](const bf16x8 (&xf)[MT], const bf16x8 (&wf)[4]) {
#pragma unroll
            for (int mt = 0; mt < 4; ++mt)
#pragma unroll
                for (int s2 = 0; s2 < MT; ++s2) acc[s2][mt] = MFMA32(wf[mt], xf[s2], acc[s2][mt]);
        };
        ldf(xfa, wfa, 0);
        ldf(xfb, wfb, 1); __builtin_amdgcn_sched_barrier(0); mm(xfa, wfa); __builtin_amdgcn_sched_barrier(0);
        ldf(xfa, wfa, 2); __builtin_amdgcn_sched_barrier(0); mm(xfb, wfb); __builtin_amdgcn_sched_barrier(0);
        ldf(xfb, wfb, 3); __builtin_amdgcn_sched_barrier(0); mm(xfa, wfa); __builtin_amdgcn_sched_barrier(0);
        mm(xfb, wfb);
        __syncthreads();
    }
    if constexpr (MT == 2 && epi_stash<Epi>::value) {
        float* sp = (float*)lds + w * 4096 + lane;
#pragma unroll
        for (int mt = 0; mt < 4; ++mt)
#pragma unroll
            for (int j = 0; j < 16; ++j) sp[(mt * 16 + j) * 64] = acc[1][mt][j];
        epi(acc[0], m0 + 64 * tg + r, n0 + 128 * fh, h, lds, tid);
        f32x16 a2[4];
        const float* sp2 = sp; asm volatile("" : "+v"(sp2));
#pragma unroll
        for (int mt = 0; mt < 4; ++mt)
#pragma unroll
            for (int j = 0; j < 16; ++j) a2[mt][j] = sp2[(mt * 16 + j) * 64];
        epi(a2, m0 + 64 * tg + 32 + r, n0 + 128 * fh, h, lds, tid);
        __syncthreads();
    } else {
        int ho = h, ro = r, to = tid;
        if constexpr (epi_stash<Epi>::present) asm volatile("" : "+v"(ho), "+v"(ro), "+v"(to));
#pragma unroll
        for (int s2 = 0; s2 < MT; ++s2) epi(acc[s2], m0 + 32 * MT * tg + 32 * s2 + ro, n0 + 128 * fh, ho, lds, to);
    }
}

DI void store_vt_tile(bf16_t* base, long rstride, const f32x16& a, int row0, int h, int lane) {
    const bool odd = lane & 1;
#pragma unroll
    for (int rg = 0; rg < 16; rg += 2) {
        const float xa = lx1(a[rg]), xb = lx1(a[rg + 1]);
        const unsigned wv = odd ? pk2(xb, a[rg + 1]) : pk2(a[rg], xa);
        bf16_t* dp = base + (long)(row0 + crow(odd ? rg + 1 : rg, h)) * rstride - (odd ? 1 : 0);
        *(unsigned*)dp = wv;
    }
}
struct EpiQKV0 {
    bf16_t *Q, *Kk, *VT;
    const float *qg, *kg;
    float* MB; const float* relb;
    DI void operator()(const f32x16 (&acc)[4], int tok, int fbase, int h, unsigned char*, int) const {
        const int sec = fbase >> 10, hd = (fbase & 1023) >> 7, b = tok >> 13, s = tok & (SEQ - 1);
        if (sec < 2) {
            const float* gn = sec == 0 ? qg : kg;
            const float sc = sec == 0 ? 0.125f * LOG2E : 1.f;
            bf16_t* dst = sec == 0 ? Q : Kk;
#pragma unroll
            for (int j = 0; j < 2; ++j) {
                float ss = 0.f;
#pragma unroll
                for (int mt = 0; mt < 2; ++mt)
#pragma unroll
                    for (int rg = 0; rg < 16; ++rg) { const float v = acc[2 * j + mt][rg]; ss += v * v; }
                ss = sum_x32(ss);
                const float rstd = rsqrtf(ss * (1.f / 64.f) + EPS) * sc;
                bf16_t* row = dst + ((long)((b * 8 + hd) * 2 + j) * SEQ + s) * 64;
                float qq = 0.f;
#pragma unroll
                for (int mt = 0; mt < 2; ++mt)
#pragma unroll
                    for (int g4 = 0; g4 < 4; ++g4) {
                        const int d0 = 32 * mt + 8 * g4 + 4 * h;
                        const f32x4 gv = *(const f32x4*)(gn + d0);
                        const float v0 = acc[2 * j + mt][4 * g4 + 0] * rstd * gv.x, v1 = acc[2 * j + mt][4 * g4 + 1] * rstd * gv.y;
                        const float v2 = acc[2 * j + mt][4 * g4 + 2] * rstd * gv.z, v3 = acc[2 * j + mt][4 * g4 + 3] * rstd * gv.w;
                        qq += v0 * v0 + v1 * v1 + v2 * v2 + v3 * v3;
                        u32x2 o;
                        o.x = pk2(v0, v1); o.y = pk2(v2, v3);
                        *(u32x2*)(row + d0) = o;
                    }
                if (sec == 0) {
                    qq = sum_x32(qq);
                    float kmx = 0.f;
                    for (int d = 0; d < 64; ++d) kmx = fmaxf(kmx, fabsf(kg[d]));
                    float bmx = 0.f;
                    for (int bk = 0; bk < 32; ++bk) bmx = fmaxf(bmx, relb[bk * 8 + hd] - relb[31 * 8 + hd]);
                    if (h == 0) MB[(long)((b * 8 + hd) * 2 + j) * SEQ + s] = 1.01f * sqrtf(qq) * 8.f * kmx + bmx * LOG2E;
                }
            }
        } else {
            bf16_t* base = VT + (long)(b * 8 + hd) * 128 * SEQ + s;
#pragma unroll
            for (int mt = 0; mt < 4; ++mt) store_vt_tile(base, SEQ, acc[mt], 32 * mt, h, tok);
        }
    }
};

struct EpiResid {
    const float* xin; float* xout; const float* gate;
    DI void operator()(const f32x16 (&acc)[4], int tok, int fbase, int h, unsigned char*, int) const {
        const int b = tok >> 13;
        const float* gp = gate + b * ADA_STRIDE;
#pragma unroll
        for (int mt = 0; mt < 4; ++mt)
#pragma unroll
            for (int g4 = 0; g4 < 4; ++g4) {
                const int f = fbase + 32 * mt + 8 * g4 + 4 * h;
                const f32x4 xv = *(const f32x4*)(xin + (long)tok * DM + f);
                const f32x4 gv = *(const f32x4*)(gp + f);
                f32x4 o;
                o.x = xv.x + gv.x * acc[mt][4 * g4 + 0]; o.y = xv.y + gv.y * acc[mt][4 * g4 + 1];
                o.z = xv.z + gv.z * acc[mt][4 * g4 + 2]; o.w = xv.w + gv.w * acc[mt][4 * g4 + 3];
                *(f32x4*)(xout + (long)tok * DM + f) = o;
                if (g4 == 3) __builtin_amdgcn_sched_barrier(0);
            }
    }
};

struct EpiKV {
    bf16_t *KC, *KS, *VST, *KW, *VWT;
    const float* kgain;
    DI void operator()(const f32x16 (&acc)[4], int tok, int fbase, int h, unsigned char*, int) const {
        const int c = fbase >> 7, br = c >> 2, kv = (c >> 1) & 1, g = c & 1, b = tok >> 13, s = tok & (SEQ - 1);
        if (br == 0 || kv == 0) {
            float rstd = 1.f;
            bf16_t* row;
            if (br == 0) row = KC + ((long)((kv * 4 + b) * 2 + g) * SEQ + s) * 128;
            else {
                float ss = 0.f;
#pragma unroll
                for (int mt = 0; mt < 4; ++mt)
#pragma unroll
                    for (int rg = 0; rg < 16; ++rg) ss += acc[mt][rg] * acc[mt][rg];
                ss = sum_x32(ss);
                rstd = rsqrtf(ss * (1.f / 128.f) + EPS);
                row = (br == 1 ? KS : KW) + ((long)(b * 2 + g) * SEQ + s) * 128;
            }
#pragma unroll
            for (int mt = 0; mt < 4; ++mt)
#pragma unroll
                for (int g4 = 0; g4 < 4; ++g4) {
                    const int d0 = 32 * mt + 8 * g4 + 4 * h;
                    f32x4 gv = {1.f, 1.f, 1.f, 1.f};
                    if (br != 0) gv = *(const f32x4*)(kgain + br * 128 + d0);
                    u32x2 o;
                    o.x = pk2(acc[mt][4 * g4 + 0] * rstd * gv.x, acc[mt][4 * g4 + 1] * rstd * gv.y);
                    o.y = pk2(acc[mt][4 * g4 + 2] * rstd * gv.z, acc[mt][4 * g4 + 3] * rstd * gv.w);
                    *(u32x2*)(row + d0) = o;
                }
        } else {
            bf16_t* base = (br == 1 ? VST : VWT) + (long)(b * 2 + g) * 128 * SEQ + s;
#pragma unroll
            for (int mt = 0; mt < 4; ++mt) store_vt_tile(base, SEQ, acc[mt], 32 * mt, h, tok);
        }
    }
};

struct EpiCmp1 {
    bf16_t* hid; const float* posb_part; const float* b1;
    DI void operator()(const f32x16 (&acc)[4], int tok, int fbase, int h, unsigned char*, int) const {
        if (tok >= 512) return;
#pragma unroll
        for (int mt = 0; mt < 4; ++mt)
#pragma unroll
            for (int g4 = 0; g4 < 4; ++g4) {
                const int f = fbase + 32 * mt + 8 * g4 + 4 * h;
                f32x4 pb = *(const f32x4*)(b1 + f);
                for (int c = 0; c < 16; ++c) { const f32x4 t = *(const f32x4*)(posb_part + c * 256 + f); pb.x += t.x; pb.y += t.y; pb.z += t.z; pb.w += t.w; }
                u32x2 o;
                o.x = pk2(gelu_tanh(acc[mt][4 * g4 + 0] + pb.x), gelu_tanh(acc[mt][4 * g4 + 1] + pb.y));
                o.y = pk2(gelu_tanh(acc[mt][4 * g4 + 2] + pb.z), gelu_tanh(acc[mt][4 * g4 + 3] + pb.w));
                *(u32x2*)(hid + (long)tok * 256 + f) = o;
            }
    }
};

struct EpiCmp2 {
    bf16_t* dst; const float* kgain0; int kv;
    DI void operator()(const f32x16 (&acc)[4], int tok, int fbase, int h, unsigned char*, int) const {
        if (fbase != 0 || tok >= 512) return;
        const float valid = tok < 511 ? 1.f : 0.f;
        if (kv == 0) {
            float ss = 0.f;
#pragma unroll
            for (int mt = 0; mt < 4; ++mt)
#pragma unroll
                for (int rg = 0; rg < 16; ++rg) ss += acc[mt][rg] * acc[mt][rg];
            ss = sum_x32(ss);
            const float rstd = rsqrtf(ss * (1.f / 128.f) + EPS) * valid;
#pragma unroll
            for (int mt = 0; mt < 4; ++mt)
#pragma unroll
                for (int g4 = 0; g4 < 4; ++g4) {
                    const int d0 = 32 * mt + 8 * g4 + 4 * h;
                    const f32x4 gv = *(const f32x4*)(kgain0 + d0);
                    u32x2 o;
                    o.x = pk2(acc[mt][4 * g4 + 0] * rstd * gv.x, acc[mt][4 * g4 + 1] * rstd * gv.y);
                    o.y = pk2(acc[mt][4 * g4 + 2] * rstd * gv.z, acc[mt][4 * g4 + 3] * rstd * gv.w);
                    *(u32x2*)(dst + (long)tok * 128 + d0) = o;
                }
        } else {
#pragma unroll
            for (int mt = 0; mt < 4; ++mt)
#pragma unroll
                for (int rg = 0; rg < 16; ++rg) dst[(long)(32 * mt + crow(rg, h)) * 512 + tok] = f2bf(acc[mt][rg] * valid);
        }
    }
};

struct EpiNsaQ {
    bf16_t* QN; float* gates; const float* qgain; const float* bgate; float* qnrm;
    DI void operator()(const f32x16 (&acc)[4], int tok, int fbase, int h, unsigned char*, int) const {
        const int b = tok >> 13, s = tok & (SEQ - 1);
        if (fbase < 1024) {
            const int head = fbase >> 7;
            float ss = 0.f;
#pragma unroll
            for (int mt = 0; mt < 4; ++mt)
#pragma unroll
                for (int rg = 0; rg < 16; ++rg) ss += acc[mt][rg] * acc[mt][rg];
            ss = sum_x32(ss);
            const float rstd = rsqrtf(ss * (1.f / 128.f) + EPS) * (0.08838834764831845f * LOG2E);
            bf16_t* row = QN + ((long)(b * 8 + head) * SEQ + s) * 128;
            float qq = 0.f;
#pragma unroll
            for (int mt = 0; mt < 4; ++mt)
#pragma unroll
                for (int g4 = 0; g4 < 4; ++g4) {
                    const int d0 = 32 * mt + 8 * g4 + 4 * h;
                    const f32x4 gv = *(const f32x4*)(qgain + d0);
                    const float v0 = acc[mt][4 * g4 + 0] * rstd * gv.x, v1 = acc[mt][4 * g4 + 1] * rstd * gv.y;
                    const float v2 = acc[mt][4 * g4 + 2] * rstd * gv.z, v3 = acc[mt][4 * g4 + 3] * rstd * gv.w;
                    qq += v0 * v0 + v1 * v1 + v2 * v2 + v3 * v3;
                    u32x2 o;
                    o.x = pk2(v0, v1); o.y = pk2(v2, v3);
                    *(u32x2*)(row + d0) = o;
                }
            qq = sum_x32(qq);
            if (h == 0) qnrm[(long)tok * 8 + head] = 1.01f * sqrtf(qq);
        } else if (fbase == 1024) {
#pragma unroll
            for (int rg = 0; rg < 16; ++rg) {
                const int f = crow(rg, h);
                if (f < 24) { const float z = acc[0][rg] + bgate[f]; gates[(long)tok * 24 + f] = frcp(1.f + fexp2(-LOG2E * z)); }
            }
        }
    }
};

DI void ce_desc(unsigned& a, unsigned& b) { const unsigned hi = a > b ? a : b, lo = a > b ? b : a; a = hi; b = lo; }
DI void sort16_desc(unsigned (&a)[16]) {
#pragma unroll
    for (int k = 2; k <= 16; k <<= 1)
#pragma unroll
        for (int j = k >> 1; j > 0; j >>= 1)
#pragma unroll
            for (int i = 0; i < 16; ++i) {
                const int l = i ^ j;
                if (l > i) { if ((i & k) == 0 || k == 16) ce_desc(a[i], a[l]); else ce_desc(a[l], a[i]); }
            }
}
DI void bitonic_merge16_desc(unsigned (&a)[16]) {
#pragma unroll
    for (int st = 8; st >= 1; st >>= 1)
#pragma unroll
        for (int i = 0; i < 16; ++i)
            if ((i & st) == 0) ce_desc(a[i], a[i + st]);
}
DI void merge_top16(unsigned (&a)[16], const unsigned (&b)[16]) {
#pragma unroll
    for (int i = 0; i < 16; ++i) a[i] = a[i] > b[15 - i] ? a[i] : b[15 - i];
    bitonic_merge16_desc(a);
}

struct EpiPeer {
    static constexpr bool STASH = false;
    int* ridx; float* rgate; int ex_off;
    DI void operator()(const f32x16 (&acc)[4], int tok, int fbase, int h, unsigned char* lds, int tid) const {
        const int lane = tid & 63, w = tid >> 6, tg = w & 3, fh = w >> 2, r = lane & 31;
        const int hd = fbase >> 8;
        unsigned* EX = (unsigned*)(lds + ex_off);
        unsigned L[16];
        {
            unsigned G1[16], G2[16], G3[16];
#pragma unroll
            for (int rg = 0; rg < 16; ++rg) {
                const int c = crow(rg, h);
                L[rg] = (f2key(acc[0][rg]) & ~127u) | (unsigned)(127 - c);
                G1[rg] = (f2key(acc[1][rg]) & ~127u) | (unsigned)(127 - 32 - c);
                G2[rg] = (f2key(acc[2][rg]) & ~127u) | (unsigned)(127 - 64 - c);
                G3[rg] = (f2key(acc[3][rg]) & ~127u) | (unsigned)(127 - 96 - c);
            }
            sort16_desc(L); sort16_desc(G1); merge_top16(L, G1);
            sort16_desc(G2); sort16_desc(G3); merge_top16(G2, G3);
            merge_top16(L, G2);
        }
        {
            unsigned P[16];
#pragma unroll
            for (int i = 0; i < 16; ++i) P[i] = get_x32(L[i], h);
            merge_top16(L, P);
        }
        if (h == 0) {
#pragma unroll
            for (int i = 0; i < 16; i += 4) *(u32x4*)(EX + ((fh * 4 + tg) * 32 + r) * 16 + i) = (u32x4){L[i], L[i + 1], L[i + 2], L[i + 3]};
        }
        __syncthreads();
        float xf[4], ys[16];
        {
            const unsigned* l0 = EX + ((0 * 4 + tg) * 32 + r) * 16;
            const unsigned* l1 = EX + ((1 * 4 + tg) * 32 + r) * 16;
            const unsigned* px = h ? l1 : l0;
            const unsigned* py = h ? l0 : l1;
            const u32x4 a = *(const u32x4*)px;
            xf[0] = key2f(a.x & ~127u); xf[1] = key2f(a.y & ~127u); xf[2] = key2f(a.z & ~127u); xf[3] = key2f(a.w & ~127u);
            unsigned Y[16];
#pragma unroll
            for (int i = 0; i < 16; i += 4) { const u32x4 b2 = *(const u32x4*)(py + i); Y[i] = b2.x; Y[i + 1] = b2.y; Y[i + 2] = b2.z; Y[i + 3] = b2.w; }
#pragma unroll
            for (int k = 0; k < 15; ++k) ys[k] = key2f((h ? Y[k + 1] : Y[k]) & ~127u);
            ys[15] = key2f(Y[15] & ~127u);
        }
        auto pkey = [&](int i, int k) -> unsigned {
            const float fs = xf[i] + ys[k];
            const unsigned code = h ? (unsigned)((((k + 1) & 15) << 4) | i) : (unsigned)((i << 4) | k);
            return (f2key(fs) & ~255u) | (255u - code);
        };
        unsigned T[16], E[16];
#pragma unroll
        for (int k = 0; k < 16; ++k) T[k] = pkey(0, k);
        T[15] = h ? 0u : T[15];
#pragma unroll
        for (int k = 1; k <= 7; ++k) E[k - 1] = pkey(1, k);
#pragma unroll
        for (int k = 2; k <= 4; ++k) E[7 + k - 2] = pkey(2, k);
        E[10] = pkey(3, 3);
#pragma unroll
        for (int k = 11; k < 16; ++k) E[k] = 0u;
        sort16_desc(E);
        merge_top16(T, E);
        {
            unsigned P[16];
#pragma unroll
            for (int i = 0; i < 16; ++i) P[i] = get_x32(T[i], h);
            merge_top16(T, P);
        }
        float sc[16], sum = 0.f;
        const float mx = key2f(T[0] & ~255u);
#pragma unroll
        for (int k = 0; k < 16; ++k) { sc[k] = fexp2((key2f(T[k] & ~255u) - mx) * LOG2E); sum += sc[k]; }
        const float inv = frcp(sum);
        if (h == 0) {
            const unsigned* l0 = EX + ((0 * 4 + tg) * 32 + r) * 16;
            const unsigned* l1 = EX + ((1 * 4 + tg) * 32 + r) * 16;
#pragma unroll
            for (int k = 0; k < 16; ++k) {
                if ((k >> 3) != fh) continue;
                const unsigned code = 255u - (T[k] & 255u);
                const int i1 = 127 - (int)(l0[code >> 4] & 127u), i2 = 127 - (int)(l1[code & 15u] & 127u);
                ridx[(long)tok * 128 + hd * 16 + k] = i1 * 128 + i2;
                rgate[(long)tok * 128 + hd * 16 + k] = sc[k] * inv;
            }
        }
        __syncthreads();
    }
};

DI void p0_transpose_item(const float* __restrict__ W, int K, int N, bf16_t* __restrict__ WT, int item, int ntn, unsigned char* lds, int tid) {
    float* tile = (float*)lds;
    const int kb = item / ntn, nb = item % ntn, k0 = kb * 64, n0 = nb * 64;
    {
        const int nn = tid & 63, kk0 = tid >> 6;
#pragma unroll
        for (int i = 0; i < 8; ++i) { const int kk = kk0 + 8 * i; const int n = n0 + nn; tile[kk * 65 + nn] = n < N ? W[(long)(k0 + kk) * N + n] : 0.f; }
    }
    __syncthreads();
    {
        const int n = tid >> 3, c = tid & 7;
        const float* s = tile + (8 * c) * 65 + n;
        u32x4 o;
        o.x = pk2(s[0], s[65]); o.y = pk2(s[2 * 65], s[3 * 65]); o.z = pk2(s[4 * 65], s[5 * 65]); o.w = pk2(s[6 * 65], s[7 * 65]);
        *(u32x4*)(WT + (long)(n0 + n) * K + k0 + 8 * c) = o;
    }
    __syncthreads();
}

DI int pack_i8x4(float a, float b, float c, float d) {
    const int ia = __float2int_rn(a), ib = __float2int_rn(b), ic = __float2int_rn(c), id = __float2int_rn(d);
    return (ia & 255) | ((ib & 255) << 8) | ((ic & 255) << 16) | (id << 24);
}
DI void p0_fp8_item(const float* __restrict__ src, unsigned char* __restrict__ dst, float* __restrict__ sinv, bool sliced, int item, int tid) {
    const int lane = tid & 63, row = item * 8 + (tid >> 6);
    const float* rp = src + (long)row * 1024;
    f32x4 v[4]; float am = 0.f;
#pragma unroll
    for (int j = 0; j < 4; ++j) {
        v[j] = *(const f32x4*)(rp + 4 * lane + 256 * j);
        am = fmaxf(am, fmaxf(fmaxf(fabsf(v[j].x), fabsf(v[j].y)), fmaxf(fabsf(v[j].z), fabsf(v[j].w))));
    }
    am = wave_max(am);
    const float sc = sliced ? (am > 0.f ? exp2f(floorf(log2f(384.f / am))) : 1.f) : (am > 0.f ? 127.f / am : 1.f);
    if (lane == 0) sinv[row] = 1.f / sc;
#pragma unroll
    for (int j = 0; j < 4; ++j) {
        int pk = 0;
        if (sliced) {
            pk = __builtin_amdgcn_cvt_pk_fp8_f32(v[j].x * sc, v[j].y * sc, pk, false);
            pk = __builtin_amdgcn_cvt_pk_fp8_f32(v[j].z * sc, v[j].w * sc, pk, true);
        } else pk = pack_i8x4(v[j].x * sc, v[j].y * sc, v[j].z * sc, v[j].w * sc);
        const int col = 4 * lane + 256 * j;
        unsigned char* d = sliced ? dst + ((long)(col >> 7) * 16384 + row) * 128 + (col & 127) : dst + (long)row * 1024 + col;
        *(int*)d = pk;
    }
}

DI void p0_weff_item(const float* __restrict__ wq, const float* __restrict__ subk, bf16_t* __restrict__ WT, int item, unsigned char* lds, int tid) {
    const int layer = item >> 8, g = (item >> 4) & 15, ct = item & 15, p = g & 1, c0 = ct * 64;
    float* As = (float*)lds;
    float* Bs = As + 64 * 129;
    const float* wql = wq + (long)layer * 1024 * 2048;
    const float* sk = subk + ((long)layer * 2 + p) * 128 * 128;
    for (int e = tid; e < 64 * 128; e += NTHREADS) { const int c = e >> 7, d = e & 127; As[c * 129 + d] = wql[(long)(c0 + c) * 2048 + g * 128 + d]; }
    for (int e = tid; e < 128 * 128; e += NTHREADS) { const int k = e >> 7, d = e & 127; Bs[k * 129 + d] = sk[k * 128 + d]; }
    __syncthreads();
    const int k = tid & 127, cg4 = tid >> 7;
    float acc[16];
#pragma unroll
    for (int i = 0; i < 16; ++i) acc[i] = 0.f;
    for (int d = 0; d < 128; ++d) {
        const float bv = Bs[k * 129 + d];
#pragma unroll
        for (int i = 0; i < 16; ++i) acc[i] += As[(cg4 * 16 + i) * 129 + d] * bv;
    }
    bf16_t* o = WT + ((long)layer * 2048 + g * 128 + k) * 1024 + c0 + cg4 * 16;
    u32x4 o0, o1;
    o0.x = pk2(acc[0], acc[1]); o0.y = pk2(acc[2], acc[3]); o0.z = pk2(acc[4], acc[5]); o0.w = pk2(acc[6], acc[7]);
    o1.x = pk2(acc[8], acc[9]); o1.y = pk2(acc[10], acc[11]); o1.z = pk2(acc[12], acc[13]); o1.w = pk2(acc[14], acc[15]);
    *(u32x4*)o = o0; *(u32x4*)(o + 8) = o1;
    __syncthreads();
}

DI void p0_posb_item(const float* __restrict__ pos, const float* __restrict__ w1, float* __restrict__ part, int item, unsigned char* lds, int tid) {
    const int kv = item >> 4, ch = item & 15;
    float* red = (float*)lds;
    const int j = tid & 255, half = tid >> 8;
    const float* pp = pos + (long)kv * 4096 + ch * 256 + half * 128;
    const float* ww = w1 + ((long)kv * 4096 + ch * 256 + half * 128) * 256 + j;
    float a = 0.f;
    for (int f = 0; f < 128; ++f) a += pp[f] * ww[(long)f * 256];
    red[half * 256 + j] = a;
    __syncthreads();
    if (tid < 256) part[(kv * 16 + ch) * 256 + tid] = red[tid] + red[256 + tid];
    __syncthreads();
}

DI void p0_ada_item(const Params& p, float* __restrict__ ada, int item, unsigned char* lds, int tid) {
    float* cact = (float*)lds;
    float* red = cact + 4096;
    const float* c = p.in[1];
    for (int e = tid; e < 4096; e += NTHREADS) { const float v = c[e]; cact[e] = v * frcp(1.f + fexp2(-LOG2E * v)); }
    __syncthreads();
    const int colg = item * 64;
    const float* W; const float* bias; int N, n0;
    if (colg < 6144) { W = p.in[3]; bias = p.in[4]; N = 6144; n0 = colg; }
    else if (colg < 12288) { W = p.in[3] + (long)1024 * 6144; bias = p.in[4] + 6144; N = 6144; n0 = colg - 6144; }
    else { W = p.in[14]; bias = p.in[15]; N = 2048; n0 = colg - 12288; }
    const int col = tid & 63, kg = tid >> 6;
    float a0 = 0.f, a1 = 0.f, a2 = 0.f, a3 = 0.f;
    const float* wp = W + (long)(kg * 128) * N + n0 + col;
#pragma unroll 8
    for (int k = 0; k < 128; ++k) {
        const float wv = wp[(long)k * N];
        const int kk = kg * 128 + k;
        a0 += cact[kk] * wv; a1 += cact[1024 + kk] * wv; a2 += cact[2048 + kk] * wv; a3 += cact[3072 + kk] * wv;
    }
    red[(kg * 4 + 0) * 64 + col] = a0; red[(kg * 4 + 1) * 64 + col] = a1; red[(kg * 4 + 2) * 64 + col] = a2; red[(kg * 4 + 3) * 64 + col] = a3;
    __syncthreads();
    if (tid < 256) {
        const int b = tid >> 6, cc = tid & 63;
        float s = bias[n0 + cc];
#pragma unroll
        for (int q = 0; q < 8; ++q) s += red[(q * 4 + b) * 64 + cc];
        ada[b * ADA_STRIDE + colg + cc] = s;
    }
    __syncthreads();
}

constexpr int P0_CONV = 8192, P0_TR_DIN = 768, P0_TR_DOUT = 256, P0_TR_KV = 384, P0_TR_NIN = 288, P0_TR_NOUT = 256, P0_TR_C1 = 512, P0_TR_C2 = 16,
              P0_WEFF = 512, P0_POSB = 32, P0_ADA = 224;
constexpr int P0_TOTAL = P0_CONV + P0_TR_DIN + P0_TR_DOUT + P0_TR_KV + P0_TR_NIN + P0_TR_NOUT + P0_TR_C1 + P0_TR_C2 + P0_WEFF + P0_POSB + P0_ADA;

DI void phase_prep(const Params& p, unsigned char* lds, int tid) {
    unsigned char* ws = p.ws;
    for (int it = blockIdx.x; it < P0_TOTAL; it += gridDim.x) {
        int r = it;
        if (r < P0_ADA) { p0_ada_item(p, (float*)(ws + OFF_ADA), r, lds, tid); continue; } r -= P0_ADA;
        if (r < P0_WEFF) { p0_weff_item(p.in[26], p.in[27], (bf16_t*)(ws + OFF_WT_PEER), r, lds, tid); continue; } r -= P0_WEFF;
        if (r < P0_POSB) { p0_posb_item(p.in[17], p.in[18], (float*)(ws + OFF_POSB), r, lds, tid); continue; } r -= P0_POSB;
        if (r < P0_TR_DIN) { p0_transpose_item(p.in[7], 1024, 3072, (bf16_t*)(ws + OFF_WT_DIN), r, 48, lds, tid); continue; } r -= P0_TR_DIN;
        if (r < P0_TR_DOUT) { p0_transpose_item(p.in[8], 1024, 1024, (bf16_t*)(ws + OFF_WT_DOUT), r, 16, lds, tid); continue; } r -= P0_TR_DOUT;
        if (r < P0_TR_KV) { p0_transpose_item(p.in[16], 1024, 1536, (bf16_t*)(ws + OFF_WT_KV), r, 24, lds, tid); continue; } r -= P0_TR_KV;
        if (r < P0_TR_NIN) { p0_transpose_item(p.in[22], 1024, 1048, (bf16_t*)(ws + OFF_WT_NIN), r, 18, lds, tid); continue; } r -= P0_TR_NIN;
        if (r < P0_TR_NOUT) { p0_transpose_item(p.in[24], 1024, 1024, (bf16_t*)(ws + OFF_WT_NOUT), r, 16, lds, tid); continue; } r -= P0_TR_NOUT;
        if (r < P0_TR_C1) { const int kv = r >> 8; p0_transpose_item(p.in[18] + (long)kv * 4096 * 256, 4096, 256, (bf16_t*)(ws + OFF_WT_C1) + (long)kv * 256 * 4096, r & 255, 4, lds, tid); continue; } r -= P0_TR_C1;
        if (r < P0_TR_C2) { const int kv = r >> 3; p0_transpose_item(p.in[20] + (long)kv * 256 * 128, 256, 128, (bf16_t*)(ws + OFF_WT_C2) + (long)kv * 128 * 256, r & 7, 2, lds, tid); continue; } r -= P0_TR_C2;
        {
            const int tbl = r >> 11, sub = r & 2047;
            const int layer = tbl & 1;
            const float* src = (tbl < 2 ? p.in[28] : p.in[29]) + (long)layer * 16384 * 1024;
            unsigned char* dst = ws + (tbl < 2 ? OFF_PU : OFF_PV) + (long)layer * 16384 * 1024;
            float* sinv = (float*)(ws + (tbl < 2 ? OFF_USI : OFF_VSI)) + layer * 16384;
            p0_fp8_item(src, dst, sinv, tbl >= 2, sub, tid);
        }
    }
}

DI void norm_row_write(const f32x4 (&v)[4], float rstd, const float* gain, const float* shift, const float* scale, bf16_t* orow, int lane) {
#pragma unroll
    for (int j = 0; j < 4; ++j) {
        const int c = 4 * lane + 256 * j;
        const f32x4 g = *(const f32x4*)(gain + c), sh = *(const f32x4*)(shift + c), sc = *(const f32x4*)(scale + c);
        u32x2 o;
        o.x = pk2(v[j].x * rstd * g.x * (1.f + sc.x) + sh.x, v[j].y * rstd * g.y * (1.f + sc.y) + sh.y);
        o.y = pk2(v[j].z * rstd * g.z * (1.f + sc.z) + sh.z, v[j].w * rstd * g.w * (1.f + sc.w) + sh.w);
        *(u32x2*)(orow + c) = o;
    }
}
template <bool BF>
DI void phase_norm_q8(const float* __restrict__ x, bf16_t* __restrict__ out, unsigned char* __restrict__ out8, float* __restrict__ outs,
                      const float* gain, const float* ada, int shift_off, int scale_off, int tid) {
    const int lane = tid & 63, gw = blockIdx.x * NWAVES + (tid >> 6), nw = gridDim.x * NWAVES;
    for (int tok = gw; tok < NTOK; tok += nw) {
        const int b = tok >> 13;
        f32x4 v[4]; float ss = 0.f;
#pragma unroll
        for (int j = 0; j < 4; ++j) { v[j] = *(const f32x4*)(x + (long)tok * DM + 4 * lane + 256 * j); ss += v[j].x * v[j].x + v[j].y * v[j].y + v[j].z * v[j].z + v[j].w * v[j].w; }
        const float rstd = rsqrtf(wave_sum(ss) * (1.f / DM) + EPS);
        const float* shift = ada + b * ADA_STRIDE + shift_off; const float* scale = ada + b * ADA_STRIDE + scale_off;
        float am = 0.f;
#pragma unroll
        for (int j = 0; j < 4; ++j) {
            const int c = 4 * lane + 256 * j;
            const f32x4 g = *(const f32x4*)(gain + c), sh = *(const f32x4*)(shift + c), sc = *(const f32x4*)(scale + c);
            v[j].x = v[j].x * rstd * g.x * (1.f + sc.x) + sh.x; v[j].y = v[j].y * rstd * g.y * (1.f + sc.y) + sh.y;
            v[j].z = v[j].z * rstd * g.z * (1.f + sc.z) + sh.z; v[j].w = v[j].w * rstd * g.w * (1.f + sc.w) + sh.w;
            if constexpr (BF) { u32x2 o; o.x = pk2(v[j].x, v[j].y); o.y = pk2(v[j].z, v[j].w); *(u32x2*)(out + (long)tok * DM + c) = o; }
            am = fmaxf(am, fmaxf(fmaxf(fabsf(v[j].x), fabsf(v[j].y)), fmaxf(fabsf(v[j].z), fabsf(v[j].w))));
        }
        am = wave_max(am);
        const float qs = am > 0.f ? 127.f / am : 1.f;
#pragma unroll
        for (int j = 0; j < 4; ++j) *(int*)(out8 + (long)tok * DM + 4 * lane + 256 * j) = pack_i8x4(v[j].x * qs, v[j].y * qs, v[j].z * qs, v[j].w * qs);
        if (lane == 0) outs[tok] = am > 0.f ? am * (1.f / 127.f) : 1.f;
    }
}
DI void phase_norm(const float* __restrict__ x, bf16_t* __restrict__ out, const float* gain, const float* ada, int shift_off, int scale_off, int tid) {
    const int lane = tid & 63, gw = blockIdx.x * NWAVES + (tid >> 6), nw = gridDim.x * NWAVES;
    for (int tok = gw; tok < NTOK; tok += nw) {
        const int b = tok >> 13;
        f32x4 v[4]; float ss = 0.f;
#pragma unroll
        for (int j = 0; j < 4; ++j) { v[j] = *(const f32x4*)(x + (long)tok * DM + 4 * lane + 256 * j); ss += v[j].x * v[j].x + v[j].y * v[j].y + v[j].z * v[j].z + v[j].w * v[j].w; }
        const float rstd = rsqrtf(wave_sum(ss) * (1.f / DM) + EPS);
        norm_row_write(v, rstd, gain, ada + b * ADA_STRIDE + shift_off, ada + b * ADA_STRIDE + scale_off, out + (long)tok * DM, lane);
    }
}

DI int kidx(int mt, int i) { return 32 * mt + 16 * (i >> 3) + (i & 7); }
template <int DQK>
DI void attn_qk32(const unsigned char* Ks, const bf16x8 (&qf)[DQK / 16], f32x16& st, int mt, int r, int h, float init = 0.f) {
    constexpr int RB = DQK * 2, MSK = DQK == 64 ? 7 : 15;
    const int row = 32 * mt + ((r & 0x13) | ((r & 4) << 1) | ((r & 8) >> 1));
#pragma unroll
    for (int i = 0; i < 16; ++i) st[i] = init;
#pragma unroll
    for (int ks = 0; ks < DQK / 16; ++ks) {
        const bf16x8 kf = RB == 128 ? *(const bf16x8*)(Ks + sw2(row, 2 * ks + h)) : *(const bf16x8*)(Ks + row * RB + (((2 * ks + h) ^ (row & MSK)) << 4));
        st = MFMA32(kf, qf[ks], st);
    }
}
DI void attn_pack32(const f32x16& st, bf16x8 (&pf)[2]) {
#pragma unroll
    for (int s = 0; s < 2; ++s) {
        u32x4 t;
        t.x = pk2(st[8 * s + 0], st[8 * s + 1]); t.y = pk2(st[8 * s + 2], st[8 * s + 3]);
        t.z = pk2(st[8 * s + 4], st[8 * s + 5]); t.w = pk2(st[8 * s + 6], st[8 * s + 7]);
        pf[s] = __builtin_bit_cast(bf16x8, t);
    }
}
DI void attn_softmax32(f32x16& st, float& m, float& l, f32x16 (&o)[4]) {
    float mx = st[0];
#pragma unroll
    for (int i = 1; i < 16; ++i) mx = fmaxf(mx, st[i]);
    mx = max_x32(mx);
    const float mn = fmaxf(m, mx);
    if (!__all(mn == m)) {
        const float alpha = fexp2(m - mn);
        l *= alpha;
#pragma unroll
        for (int dt = 0; dt < 4; ++dt)
#pragma unroll
            for (int i = 0; i < 16; ++i) o[dt][i] *= alpha;
        m = mn;
    }
    float sum = 0.f;
#pragma unroll
    for (int i = 0; i < 16; ++i) { const float pv = fexp2(st[i] - m); st[i] = pv; sum += pv; }
    l += sum;
}
DI void attn_softmax32_b(f32x16& st, float& l) {
    float sum = 0.f;
#pragma unroll
    for (int i = 0; i < 16; ++i) { const float pv = fexp2(st[i]); st[i] = pv; sum += pv; }
    l += sum;
}
DI void attn_pv32(const unsigned char* Vs, const bf16x8 (&pf)[2], f32x16 (&o)[4], int mt, int r, int h) {
#pragma unroll
    for (int dt = 0; dt < 4; ++dt)
#pragma unroll
        for (int s2 = 0; s2 < 2; ++s2) {
            const int row = 32 * dt + r;
            const bf16x8 vf = *(const bf16x8*)(Vs + sw2(row, 2 * (2 * mt + s2) + h));
            o[dt] = MFMA32(vf, pf[s2], o[dt]);
        }
}
template <int RB, int NROWS>
DI void dma_offsets(unsigned (&off)[NROWS * RB / 16 / 512], unsigned gstride, int tid) {
    constexpr int CPR = RB / 16;
#pragma unroll
    for (int i = 0; i < NROWS * CPR / 512; ++i) {
        const int idx = tid + 512 * i;
        int row, cp;
        if (RB == 128) sw2_src(idx, row, cp); else { row = idx / CPR; cp = (idx % CPR) ^ (row & (CPR - 1)); }
        off[i] = (unsigned)row * gstride + (cp << 4);
    }
}
template <int N>
DI void dma_issue(unsigned char* dst, const unsigned char* gbase, const unsigned (&off)[N], int tid) {
    const int wbase = tid & ~63;
#pragma unroll
    for (int i = 0; i < N; ++i)
        __builtin_amdgcn_global_load_lds((const unsigned*)(gbase + off[i]), (unsigned*)(dst + (wbase + 512 * i) * 16), 16, 0, 0);
}

constexpr int AT_STAGE = 32 * 1024;
constexpr int AT_LUT = 2 * AT_STAGE;
constexpr int LUT_N = 1280, LUT_OFF = 1100;
constexpr int LUTC_W = 52;
constexpr int AT_LUTC = AT_LUT + 20 * 1024;
constexpr int AT_IMP = AT_LUTC + 13 * 1024;
constexpr int AT_SEL = AT_IMP + 34 * 1024;

DI void phase_diff_attn(const Params& p, unsigned char* lds, int tid) {
    unsigned char* ws = p.ws;
    const bf16_t* Q = (const bf16_t*)(ws + OFF_Q0);
    const bf16_t* Kk = (const bf16_t*)(ws + OFF_K0);
    const bf16_t* VT = (const bf16_t*)(ws + OFF_VT0);
    bf16_t* O = (bf16_t*)(ws + OFF_H);
    const float* relb = p.in[2];
    const float* lam = p.in[9];
    const float* subln = p.in[12];
    const int lane = tid & 63, w = tid >> 6, comp = w & 1, qg = w >> 1, r = lane & 31, h = lane >> 5;
    float* lut = (float*)(lds + 128 * 1024);
    float lam_full;
    {
        float s01 = 0.f, s23 = 0.f;
        for (int i = 0; i < 64; ++i) { s01 += lam[i] * lam[64 + i]; s23 += lam[128 + i] * lam[192 + i]; }
        lam_full = __expf(s01) - __expf(s23) + 0.2f;
    }
    const int G = gridDim.x, rows_per_it = G >> 5;
    unsigned koff[1], voff[2];
    dma_offsets<128, 64>(koff, 128, tid);
    dma_offsets<128, 128>(voff, SEQ * 2, tid);
    constexpr int ST2 = 64 * 1024;
    for (int it = 0;; ++it) {
        int qb, b, hd;
        if (G == 256) {
            if (it >= 8) break;
            const int xcd = blockIdx.x & 7, lb = blockIdx.x >> 3, pr = xcd * 4 + (it >> 1);
            qb = (it & 1) ? lb : 63 - lb; b = pr >> 3; hd = pr & 7;
        } else {
            int u;
            if ((G & 31) == 0) {
                const int rr = blockIdx.x >> 5, cc = blockIdx.x & 31;
                const int rowi = it * rows_per_it + ((it & 1) ? rows_per_it - 1 - rr : rr);
                u = rowi * 32 + cc;
            } else u = it * G + blockIdx.x;
            if (u >= 2048) break;
            qb = 63 - (u >> 5); b = (u & 31) >> 3; hd = u & 7;
        }
        const int q0 = qb * 128, ntiles = qb + 1;
        const int qpos = q0 + 32 * qg + r, qlo = q0 + 32 * qg, qhi = qlo + 31;
        for (int e = tid; e < LUT_N; e += NTHREADS) { const int d = LUT_OFF - e; lut[e] = d < 0 ? -INFINITY : (d >= 790 ? 0.f : (relb[rel_bucket_i(d) * 8 + hd] - relb[31 * 8 + hd]) * LOG2E); }
        bf16x8 qf[4];
        {
            const bf16_t* qrow = Q + ((long)((b * 8 + hd) * 2 + comp) * SEQ + qpos) * 64;
#pragma unroll
            for (int ks = 0; ks < 4; ++ks) qf[ks] = *(const bf16x8*)(qrow + 16 * ks + 8 * h);
        }
        const unsigned char* k0g = (const unsigned char*)(Kk + (long)((b * 8 + hd) * 2 + 0) * SEQ * 64);
        const unsigned char* k1g = (const unsigned char*)(Kk + (long)((b * 8 + hd) * 2 + 1) * SEQ * 64);
        const unsigned char* vtg = (const unsigned char*)(VT + (long)(b * 8 + hd) * 128 * SEQ);
        f32x16 o[4];
#pragma unroll
        for (int dt = 0; dt < 4; ++dt)
#pragma unroll
            for (int i = 0; i < 16; ++i) o[dt][i] = 0.f;
        float l = 0.f;
        const float nmb = -((const float*)(ws + OFF_MB0))[(long)((b * 8 + hd) * 2 + comp) * SEQ + qpos];
        auto stage = [&](int kt, unsigned char* st) {
#pragma unroll
            for (int sb = 0; sb < 2; ++sb) {
                dma_issue(st + sb * 8192, k0g + (long)(2 * kt + sb) * 8192, koff, tid);
                dma_issue(st + 16384 + sb * 8192, k1g + (long)(2 * kt + sb) * 8192, koff, tid);
                dma_issue(st + 32768 + sb * 16384, vtg + (long)(2 * kt + sb) * 128, voff, tid);
            }
        };
        stage(0, lds);
        __syncthreads();
        for (int kt = 0; kt < ntiles; ++kt) {
            unsigned char* cur = lds + (kt & 1) * ST2;
            if (kt + 1 < ntiles) stage(kt + 1, lds + ((kt + 1) & 1) * ST2);
            const bool nearb = qlo - (kt * 128 + 127) < 790;
            const int dbase0 = qpos - kt * 128 - 8 * h;
            const unsigned char* kb = cur + comp * 16384;
            f32x16 sa, sbv;
            attn_qk32<64>(kb, qf, sa, 0, r, h, nmb);
#pragma unroll
            for (int j = 0; j < 4; ++j) {
                f32x16& sc = (j & 1) ? sbv : sa;
                f32x16& sn = (j & 1) ? sa : sbv;
                if (j < 3) attn_qk32<64>(kb + ((j + 1) >> 1) * 8192, qf, sn, (j + 1) & 1, r, h, nmb);
                if (nearb) {
                    const float* lp = lut + (LUT_OFF - dbase0 + 64 * (j >> 1));
#pragma unroll
                    for (int i = 0; i < 16; ++i) sc[i] += lp[kidx(j & 1, i)];
                }
                attn_softmax32_b(sc, l);
                bf16x8 pf[2];
                attn_pack32(sc, pf);
                attn_pv32(cur + 32768 + (j >> 1) * 16384, pf, o, j & 1, r, h);
            }
            __syncthreads();
        }
        l = sum_x32(l);
        const float inv = l > 0.f ? frcp(l) : 0.f;
        float* xch = (float*)lds + qg * 4096;
        if (comp == 1) {
            const float sc = inv * lam_full;
#pragma unroll
            for (int dt = 0; dt < 4; ++dt)
#pragma unroll
                for (int i = 0; i < 16; ++i) xch[(dt * 16 + i) * 64 + lane] = o[dt][i] * sc;
        }
        __syncthreads();
        if (comp == 0) {
            float ss = 0.f;
#pragma unroll
            for (int dt = 0; dt < 4; ++dt)
#pragma unroll
                for (int i = 0; i < 16; ++i) { const float v = o[dt][i] * inv - xch[(dt * 16 + i) * 64 + lane]; o[dt][i] = v; ss += v * v; }
            ss = sum_x32(ss);
            const float rstd = rsqrtf(ss * (1.f / 128.f) + EPS) * 0.8f;
            bf16_t* orow = O + (long)(b * SEQ + qpos) * DM + hd * 128;
#pragma unroll
            for (int dt = 0; dt < 4; ++dt)
#pragma unroll
                for (int g4 = 0; g4 < 4; ++g4) {
                    const int d0 = 32 * dt + 8 * g4 + 4 * h;
                    const f32x4 gv = *(const f32x4*)(subln + d0);
                    u32x2 ov;
                    ov.x = pk2(o[dt][4 * g4 + 0] * rstd * gv.x, o[dt][4 * g4 + 1] * rstd * gv.y);
                    ov.y = pk2(o[dt][4 * g4 + 2] * rstd * gv.z, o[dt][4 * g4 + 3] * rstd * gv.w);
                    *(u32x2*)(orow + d0) = ov;
                }
        }
        __syncthreads();
    }
}

template <int VAR>
DI void phase_nsa_attn(const Params& p, unsigned char* lds, int tid) {
    unsigned char* ws = p.ws;
    const bf16_t* QN = (const bf16_t*)(ws + OFF_QN);
    const bf16_t* KS = (const bf16_t*)(ws + OFF_KS);
    const bf16_t* VST = (const bf16_t*)(ws + OFF_VST);
    const bf16_t* KW = (const bf16_t*)(ws + OFF_KW);
    const bf16_t* VWT = (const bf16_t*)(ws + OFF_VWT);
    const bf16_t* KCMP = (const bf16_t*)(ws + OFF_KCMP);
    const bf16_t* VCMPT = (const bf16_t*)(ws + OFF_VCMPT);
    const float* gates = (const float*)(ws + OFF_GATES);
    bf16_t* O = VAR ? (bf16_t*)(ws + OFF_PU + 32 * MB) : (bf16_t*)(ws + OFF_H);
    const float* relb = p.in[2];
    const int lane = tid & 63, w = tid >> 6, hg = w >> 1, th = w & 1, r = lane & 31, h = lane >> 5;
    float* lut = (float*)(lds + AT_LUT);
    float* lutc = (float*)(lds + AT_LUTC);
    float* imp = (float*)(lds + AT_IMP);
    unsigned* selw = (unsigned*)(lds + AT_SEL);
    unsigned short* sel16 = (unsigned short*)selw;
    float* bmxs = (float*)(selw + 264);
    const float* qnrm = (const float*)(ws + OFF_MB1);
    float kmx[3];
    for (int br = 0; br < 3; ++br) { float mx = 0.f; for (int d = 0; d < 128; ++d) mx = fmaxf(mx, fabsf(p.in[21][br * 128 + d])); kmx[br] = mx * 11.313708498984761f; }
    const int G = gridDim.x, rows_per_it = G >> 3;
    int lut_g = -1;
    for (int it = 0;; ++it) {
        int u;
        if ((G & 7) == 0) {
            const int rr = blockIdx.x >> 3, cc = blockIdx.x & 7;
            const int rowi = it * rows_per_it + ((it & 1) ? rows_per_it - 1 - rr : rr);
            u = rowi * 8 + cc;
        } else u = it * G + blockIdx.x;
        if (u >= 1024) break;
        const int bi = 127 - (u >> 3), b = (u & 7) >> 1, g = u & 1, head = 4 * g + hg;
        const int tq = 64 * bi + 32 * th + r;
        const int tl = 32 * th + r;
        const long tok = (long)b * SEQ + tq;
        if (g != lut_g) {
            lut_g = g;
            if (tid < 4) { float bm = 0.f; for (int bk = 0; bk < 32; ++bk) bm = fmaxf(bm, relb[bk * 8 + 4 * g + tid] - relb[31 * 8 + 4 * g + tid]); bmxs[tid] = bm * LOG2E; }
            for (int e = tid; e < 4 * LUT_N; e += NTHREADS) { const int hh = e / LUT_N, d = LUT_OFF - (e % LUT_N); lut[e] = d < 0 ? -INFINITY : (d >= 790 ? 0.f : (relb[rel_bucket_i(d) * 8 + 4 * g + hh] - relb[31 * 8 + 4 * g + hh]) * LOG2E); }
            for (int e = tid; e < 4 * 16 * LUTC_W; e += NTHREADS) {
                const int hh = e / (16 * LUTC_W), ph = (e / LUTC_W) & 15, ci = e % LUTC_W, d = 16 * (ci - 1) + ph;
                lutc[e] = ci == 0 ? -INFINITY : (d >= 790 ? 0.f : (relb[rel_bucket_i(d) * 8 + 4 * g + hh] - relb[31 * 8 + 4 * g + hh]) * LOG2E);
            }
        }
        if (tid < 4) selw[256 + tid] = 0u;
        const float* mylut = lut + hg * LUT_N;
        bf16x8 qf[8];
        const bf16_t* qrow = QN + ((long)(b * 8 + head) * SEQ + tq) * 128 + 8 * h;
        auto load_q = [&](const bf16_t* qr) {
#pragma unroll
            for (int ks = 0; ks < 8; ++ks) qf[ks] = *(const bf16x8*)(qr + 16 * ks);
        };
        const float* gp = gates + tok * 24 + head * 3;
        bf16_t* orow = O + (VAR ? (tok & 16383) : tok) * DM + head * 128;
        auto stage = [&](const unsigned char* kg, const unsigned char* vg, unsigned vstride, int kt, unsigned char* st) {
            int t2 = tid; asm volatile("" : "+v"(t2));
            unsigned koff[2], vo[2];
            dma_offsets<256, 64>(koff, 256, t2);
            dma_offsets<128, 128>(vo, vstride, t2);
            dma_issue(st, kg + (long)kt * 16384, koff, t2);
            dma_issue(st + 16384, vg + (long)kt * 128, vo, t2);
        };
        f32x16 o[4];
        float l;
        auto reset = [&]() {
#pragma unroll
            for (int dt = 0; dt < 4; ++dt)
#pragma unroll
                for (int i = 0; i < 16; ++i) o[dt][i] = 0.f;
            l = 0.f;
        };
        const unsigned char* kcg = (const unsigned char*)(KCMP + (long)(b * 2 + g) * 512 * 128);
        const unsigned char* vcg = (const unsigned char*)(VCMPT + (long)(b * 2 + g) * 128 * 512);
        const int nct = ((4 * bi + 2) >> 6) + 1;
        const int hgc = r & 3, tlc = 8 * w + (r >> 2), tqc = 64 * bi + tlc;
        const long tokc = (long)b * SEQ + tqc;
        reset();
        load_q(QN + ((long)(b * 8 + 4 * g + hgc) * SEQ + tqc) * 128 + 8 * h);
        __syncthreads();
        if (VAR != 3) {
            const int cb = (tqc - 31) >> 4;
            const float* lc = lutc + (hgc * 16 + ((tqc - 31) & 15)) * LUTC_W + 1;
            const float nmb = -(qnrm[tokc * 8 + 4 * g + hgc] * kmx[0] + bmxs[hgc]);
            stage(kcg, vcg, 1024u, 0, lds);
            __syncthreads();
            for (int kt = 0; kt < nct; ++kt) {
                unsigned char* cur = lds + (kt & 1) * AT_STAGE;
                if (kt + 1 < nct) stage(kcg, vcg, 1024u, kt + 1, lds + ((kt + 1) & 1) * AT_STAGE);
                const int cbase = cb - kt * 64 - 8 * h;
#pragma unroll
                for (int mt = 0; mt < 2; ++mt) {
                    f32x16 st;
                    attn_qk32<128>(cur, qf, st, mt, r, h, nmb);
                    float sum = 0.f;
#pragma unroll
                    for (int i = 0; i < 16; ++i) {
                        const int c = cbase - kidx(mt, i);
                        sum += fexp2(st[i] + lc[c < -1 ? -1 : (c > 50 ? 50 : c)]);
                    }
                    l += sum;
                }
                __syncthreads();
            }
            const float lt = sum_x32(l);
            const float invl = lt > 0.f ? frcp(lt) : 0.f;
            stage(kcg, vcg, 1024u, 0, lds);
            __syncthreads();
            float carry = 0.f;
            for (int kt = 0; kt < nct; ++kt) {
                unsigned char* cur = lds + (kt & 1) * AT_STAGE;
                if (kt + 1 < nct) stage(kcg, vcg, 1024u, kt + 1, lds + ((kt + 1) & 1) * AT_STAGE);
                const int cbase = cb - kt * 64 - 8 * h;
                float o0[4], o1[4], sp[4];
#pragma unroll
                for (int mt = 0; mt < 2; ++mt) {
                    f32x16 st;
                    attn_qk32<128>(cur, qf, st, mt, r, h, nmb);
#pragma unroll
                    for (int i = 0; i < 16; ++i) {
                        const int c = cbase - kidx(mt, i);
                        st[i] = fexp2(st[i] + lc[c < -1 ? -1 : (c > 50 ? 50 : c)]) * invl;
                    }
#pragma unroll
                    for (int gq = 0; gq < 2; ++gq) {
                        const int G2 = 2 * mt + gq, q0 = 2 * gq, q1 = 2 * gq + 1;
                        const float c20 = 0.5f * st[4 * q0 + 3];
                        o0[G2] = st[4 * q0] + st[4 * q0 + 1] + st[4 * q0 + 2] + c20;
                        o1[G2] = st[4 * q1] + st[4 * q1 + 1] + st[4 * q1 + 2] + 0.5f * st[4 * q1 + 3] + c20;
                        sp[G2] = 0.5f * st[4 * q1 + 3];
                    }
                    bf16x8 pf[2];
                    attn_pack32(st, pf);
                    attn_pv32(cur + 16384, pf, o, mt, r, h);
                }
                float rc[4];
#pragma unroll
                for (int G2 = 0; G2 < 4; ++G2) rc[G2] = __uint_as_float(get_x32(__float_as_uint(sp[G2]), h));
                if (h) {
#pragma unroll
                    for (int G2 = 0; G2 < 4; ++G2) o0[G2] += rc[G2];
                } else {
                    o0[0] += carry; o0[1] += rc[0]; o0[2] += rc[1]; o0[3] += rc[2];
                    carry = rc[3];
                }
#pragma unroll
                for (int G2 = 0; G2 < 4; ++G2) {
                    float a0 = o0[G2], a1 = o1[G2];
                    a0 += lx1(a0); a0 += lx2(a0); a1 += lx1(a1); a1 += lx2(a1);
                    if (hgc == 0) *(f32x2*)(imp + tlc * 130 + kt * 16 + 4 * G2 + 2 * h) = (f32x2){a0, a1};
                }
                __syncthreads();
            }
        }
        {
            const float g_c = gates[tokc * 24 + (4 * g + hgc) * 3];
            bf16_t* orc = O + (VAR ? (tokc & 16383) : tokc) * DM + (4 * g + hgc) * 128;
#pragma unroll
            for (int dt = 0; dt < 4; ++dt)
#pragma unroll
                for (int g4 = 0; g4 < 4; ++g4) {
                    const int d0 = 32 * dt + 8 * g4 + 4 * h;
                    u32x2 ov;
                    ov.x = pk2(o[dt][4 * g4 + 0] * g_c, o[dt][4 * g4 + 1] * g_c);
                    ov.y = pk2(o[dt][4 * g4 + 2] * g_c, o[dt][4 * g4 + 3] * g_c);
                    *(u32x2*)(orc + d0) = ov;
                }
        }
        if (VAR != 5) {
            const int tkn = tid >> 3, part = tid & 7;
            unsigned key[16];
#pragma unroll
            for (int q = 0; q < 16; ++q) {
                const int j = part * 16 + q;
                float v = imp[tkn * 130 + j];
                const int back = bi - j;
                if (j == 0 || (back >= 0 && back < 2)) v = 1e9f;
                if (back < 0) v = -1e30f;
                key[q] = f2key(v);
            }
            auto sum8 = [&](int c) -> int {
                c += __builtin_amdgcn_update_dpp(0, c, 0xB1, 0xF, 0xF, true);
                c += __builtin_amdgcn_update_dpp(0, c, 0x4E, 0xF, 0xF, true);
                c += __builtin_amdgcn_update_dpp(0, c, 0x141, 0xF, 0xF, true);
                return c;
            };
            unsigned T = 0u;
#pragma unroll 4
            for (int bit = 31; bit >= 0; --bit) {
                const unsigned cand = T | (1u << bit);
                int c = 0;
#pragma unroll
                for (int q = 0; q < 16; ++q) c += key[q] >= cand ? 1 : 0;
                if (sum8(c) >= 16) T = cand;
            }
            int cg = 0, ce = 0;
#pragma unroll
            for (int q = 0; q < 16; ++q) { cg += key[q] > T ? 1 : 0; ce += key[q] == T ? 1 : 0; }
            const int need = 16 - sum8(cg);
            int pre = ce;
            { int t = __builtin_amdgcn_update_dpp(0, pre, 0x111, 0xF, 0xF, true); if (part >= 1) pre += t; }
            { int t = __builtin_amdgcn_update_dpp(0, pre, 0x112, 0xF, 0xF, true); if (part >= 2) pre += t; }
            { int t = __builtin_amdgcn_update_dpp(0, pre, 0x114, 0xF, 0xF, true); if (part >= 4) pre += t; }
            int before = pre - ce;
            unsigned bits = 0;
#pragma unroll
            for (int q = 0; q < 16; ++q) {
                const bool eq = key[q] == T;
                const bool selq = key[q] > T || (eq && before < need);
                before += eq ? 1 : 0;
                bits |= (selq && key[q] >= 0x80000000u) ? (1u << q) : 0u;
            }
            sel16[tkn * 8 + part] = (unsigned short)bits;
            atomicOr(&selw[256 + (part >> 1)], bits << ((part & 1) * 16));
        }
        __syncthreads();
        const unsigned un0 = selw[256], un1 = selw[257], un2 = selw[258], un3 = selw[259];
        const unsigned char* ksg = (const unsigned char*)(KS + (long)(b * 2 + g) * SEQ * 128);
        const unsigned char* vsg = (const unsigned char*)(VST + (long)(b * 2 + g) * 128 * SEQ);
        reset(); load_q(qrow);
        const float qn_main = qnrm[tok * 8 + head];
        {
            const float nmb = -(qn_main * kmx[1] + bmxs[hg]);
            const unsigned long long ulo = ((unsigned long long)(unsigned)__builtin_amdgcn_readfirstlane((int)un1) << 32) | (unsigned)__builtin_amdgcn_readfirstlane((int)un0);
            const unsigned long long uhi = ((unsigned long long)(unsigned)__builtin_amdgcn_readfirstlane((int)un3) << 32) | (unsigned)__builtin_amdgcn_readfirstlane((int)un2);
            auto next_tile = [&](int from) -> int {
                if (from < 64) { const unsigned long long mk = ulo >> from; if (mk) return from + __builtin_ctzll(mk); from = 64; }
                if (from < 128) { const unsigned long long mk = uhi >> (from - 64); if (mk) return from + __builtin_ctzll(mk); }
                return 128;
            };
            int jt = (VAR == 1 || VAR == 4 || VAR == 5) ? 128 : next_tile(0);
            int buf = 0;
            if (jt < 128) stage(ksg, vsg, SEQ * 2u, jt, lds);
            __syncthreads();
            while (jt < 128) {
                unsigned char* cur = lds + buf * AT_STAGE;
                const int jn = next_tile(jt + 1);
                if (jn < 128) stage(ksg, vsg, SEQ * 2u, jn, lds + (buf ^ 1) * AT_STAGE);
                const unsigned wd = selw[tl * 4 + (jt >> 5)];
                const bool mysel = (wd >> (jt & 31)) & 1u;
                if (__any(mysel)) {
                    const int k0 = jt * 64;
                    const bool nearb = (64 * bi + 32 * th) - (k0 + 63) < 790;
                    const int dbase = tq - k0 - 8 * h;
                    const float* lp = mylut + (LUT_OFF - dbase);
#pragma unroll
                    for (int mt = 0; mt < 2; ++mt) {
                        f32x16 st;
                        attn_qk32<128>(cur, qf, st, mt, r, h, mysel ? nmb : -INFINITY);
                        if (nearb) {
#pragma unroll
                            for (int i = 0; i < 16; ++i) st[i] += lp[kidx(mt, i)];
                        }
                        attn_softmax32_b(st, l);
                        bf16x8 pf[2];
                        attn_pack32(st, pf);
                        attn_pv32(cur + 16384, pf, o, mt, r, h);
                    }
                }
                __syncthreads();
                buf ^= 1; jt = jn;
            }
        }
        {
            const float lt = sum_x32(l);
            const float sc = (lt > 0.f ? frcp(lt) : 0.f) * gp[1];
#pragma unroll
            for (int dt = 0; dt < 4; ++dt)
#pragma unroll
                for (int g4 = 0; g4 < 4; ++g4) {
                    const int d0 = 32 * dt + 8 * g4 + 4 * h;
                    const u32x2 pv = *(const u32x2*)(orow + d0);
                    u32x2 ov;
                    ov.x = pk2(bflo(pv.x) + o[dt][4 * g4 + 0] * sc, bfhi(pv.x) + o[dt][4 * g4 + 1] * sc);
                    ov.y = pk2(bflo(pv.y) + o[dt][4 * g4 + 2] * sc, bfhi(pv.y) + o[dt][4 * g4 + 3] * sc);
                    *(u32x2*)(orow + d0) = ov;
                }
        }
        const unsigned char* kwg = (const unsigned char*)(KW + (long)(b * 2 + g) * SEQ * 128);
        const unsigned char* vwg = (const unsigned char*)(VWT + (long)(b * 2 + g) * 128 * SEQ);
        reset(); load_q(qrow);
        {
            const float nmb = -(qn_main * kmx[2] + bmxs[hg]);
            const int j0 = bi >= 8 ? bi - 8 : 0, nt = (VAR == 2 || VAR == 4 || VAR == 5) ? 1 : bi - j0 + 1;
            stage(kwg, vwg, SEQ * 2u, j0, lds);
            __syncthreads();
            for (int kt = 0; kt < nt; ++kt) {
                unsigned char* cur = lds + (kt & 1) * AT_STAGE;
                if (kt + 1 < nt) stage(kwg, vwg, SEQ * 2u, j0 + kt + 1, lds + ((kt + 1) & 1) * AT_STAGE);
                const int k0 = (j0 + kt) * 64;
                const int dbase = tq - k0 - 8 * h;
                const float* lp = mylut + (LUT_OFF - dbase);
#pragma unroll
                for (int mt = 0; mt < 2; ++mt) {
                    f32x16 st;
                    attn_qk32<128>(cur, qf, st, mt, r, h, nmb);
#pragma unroll
                    for (int i = 0; i < 16; ++i) st[i] = kidx(mt, i) <= dbase - 512 ? -INFINITY : st[i] + lp[kidx(mt, i)];
                    attn_softmax32_b(st, l);
                    bf16x8 pf[2];
                    attn_pack32(st, pf);
                    attn_pv32(cur + 16384, pf, o, mt, r, h);
                }
                __syncthreads();
            }
        }
        {
            const float lt = sum_x32(l);
            const float sc = (lt > 0.f ? frcp(lt) : 0.f) * gp[2];
#pragma unroll
            for (int dt = 0; dt < 4; ++dt)
#pragma unroll
                for (int g4 = 0; g4 < 4; ++g4) {
                    const int d0 = 32 * dt + 8 * g4 + 4 * h;
                    const u32x2 pv = *(const u32x2*)(orow + d0);
                    u32x2 ov;
                    ov.x = pk2(bflo(pv.x) + o[dt][4 * g4 + 0] * sc, bfhi(pv.x) + o[dt][4 * g4 + 1] * sc);
                    ov.y = pk2(bflo(pv.y) + o[dt][4 * g4 + 2] * sc, bfhi(pv.y) + o[dt][4 * g4 + 3] * sc);
                    *(u32x2*)(orow + d0) = ov;
                }
        }
        __syncthreads();
    }
}

DI void fp8x16_fma(const u32x4& q, const f32x4& h0, const f32x4& h1, const f32x4& h2, const f32x4& h3, f32x2& a0, f32x2& a1) {
    a0 += __builtin_amdgcn_cvt_pk_f32_fp8((int)q.x, false) * (f32x2){h0.x, h0.y};
    a1 += __builtin_amdgcn_cvt_pk_f32_fp8((int)q.x, true)  * (f32x2){h0.z, h0.w};
    a0 += __builtin_amdgcn_cvt_pk_f32_fp8((int)q.y, false) * (f32x2){h1.x, h1.y};
    a1 += __builtin_amdgcn_cvt_pk_f32_fp8((int)q.y, true)  * (f32x2){h1.z, h1.w};
    a0 += __builtin_amdgcn_cvt_pk_f32_fp8((int)q.z, false) * (f32x2){h2.x, h2.y};
    a1 += __builtin_amdgcn_cvt_pk_f32_fp8((int)q.z, true)  * (f32x2){h2.z, h2.w};
    a0 += __builtin_amdgcn_cvt_pk_f32_fp8((int)q.w, false) * (f32x2){h3.x, h3.y};
    a1 += __builtin_amdgcn_cvt_pk_f32_fp8((int)q.w, true)  * (f32x2){h3.z, h3.w};
}
#ifndef UMASK
#define UMASK 0xffffffffu
#endif
template <bool DRY>
DI void phase_peer_u(const Params& p, int layer, unsigned char* lds, int tid) {
    unsigned char* ws = p.ws;
    const unsigned char* H8 = ws + OFF_H8;
    const float* HS = (const float*)(ws + OFF_HS);
    const int* ridx = (const int*)(ws + OFF_RIDX);
    float* rgate = (float*)(ws + OFF_RGATE);
    const unsigned char* U = ws + OFF_PU + (long)layer * 16384 * 1024;
    const float* usi = (const float*)(ws + OFF_USI) + layer * 16384;
    const float* vsi = (const float*)(ws + OFF_VSI) + layer * 16384;
    const int lane = tid & 63, w = __builtin_amdgcn_readfirstlane(tid >> 6), sub = lane & 7, grp = lane >> 3;
    const int xg = blockIdx.x & 7, lb = blockIdx.x >> 3, nwv = (gridDim.x >> 3) * NWAVES, wv = lb * NWAVES + w;
    unsigned* clb = (unsigned*)(lds + w * 12288);
    unsigned char* hbb = lds + w * 12288 + 4096;
    const unsigned long long lt = (1ull << lane) - 1ull;
    if (lb >= (int)(gridDim.x >> 3)) return;
    int i0, i1; unsigned g0, g1; u32x4 h0; float hs0;
    auto ld_tok = [&](int tk) {
        tk = tk < NTOK ? tk : wv;
        i0 = ridx[(long)tk * 128 + lane]; i1 = ridx[(long)tk * 128 + 64 + lane];
        g0 = __float_as_uint(rgate[(long)tk * 128 + lane]); g1 = __float_as_uint(rgate[(long)tk * 128 + 64 + lane]);
        h0 = *(const u32x4*)(H8 + (long)tk * DM + lane * 16); hs0 = HS[tk];
    };
    bool sb0, sb1; int sk0, sk1; float su0, sv0, su1, sv1;
    auto stage_tok = [&](int bi) -> int {
        unsigned* cl = clb + bi * 512; unsigned char* hb = hbb + bi * 4096;
        const bool b0 = (i0 >> 11) == xg, b1 = (i1 >> 11) == xg;
        const unsigned long long m0 = __ballot(b0), m1 = __ballot(b1);
        const int n0 = __popcll(m0), n = n0 + __popcll(m1);
        sb0 = b0; sb1 = b1; sk0 = __popcll(m0 & lt); sk1 = n0 + __popcll(m1 & lt);
        if (b0) { *(u32x4*)(cl + 4 * sk0) = (u32x4){(unsigned)lane, (unsigned)i0, g0, 0u}; su0 = usi[i0]; sv0 = vsi[i0]; }
        if (b1) { *(u32x4*)(cl + 4 * sk1) = (u32x4){(unsigned)(64 + lane), (unsigned)i1, g1, 0u}; su1 = usi[i1]; sv1 = vsi[i1]; }
        if (n == 0 && lane == 0) *(u32x4*)cl = (u32x4){0u, 0u, 0u, 0u};
        *(u32x4*)(hb + lane * 16) = h0;
        if (lane == 0) *(float*)(hb + 1024) = hs0;
        return n;
    };
    auto flush_scales = [&](int bi) {
        float* cs = (float*)(hbb + bi * 4096 + 1536);
        if (sb0) *(f32x2*)(cs + 2 * sk0) = (f32x2){su0, sv0};
        if (sb1) *(f32x2*)(cs + 2 * sk1) = (f32x2){su1, sv1};
    };
    ld_tok(wv);
    int nC = stage_tok(0);
    flush_scales(0);
    ld_tok(wv + nwv);
    int slotC, idC; bool validC; float g_in;
    { validC = grp < nC; const int kk = validC ? grp : 0; const u32x4 e = *(const u32x4*)(clb + 4 * kk); slotC = e.x; idC = e.y; g_in = __uint_as_float(e.z); }
    u32x4 uv[8];
    {
        const unsigned uoff = (unsigned)idC * 1024u + (unsigned)sub * 16u;
#pragma unroll
        for (int t = 0; t < 8; ++t) { uv[t] = *(const u32x4*)(U + (uoff + t * 128)); __builtin_amdgcn_sched_barrier(0); }
    }
    int it = 0;
    for (int tok = wv; tok < NTOK; tok += nwv, ++it) {
        const int cb = it & 1;
        const unsigned* clC = clb + cb * 512; const unsigned* clN = clb + (cb ^ 1) * 512;
        const unsigned char* hbC = hbb + cb * 4096;
        const bool more = tok + nwv < NTOK;
        const int nN = stage_tok(cb ^ 1); ld_tok(tok + 2 * nwv);
        const float shC = *(const float*)(hbC + 1024);
        const int nr = nC > 8 ? (nC + 7) >> 3 : 1;
        u32x4 hq[8];
#pragma unroll
        for (int t = 0; t < 8; ++t) hq[t] = *(const u32x4*)(hbC + (sub + 8 * t) * 16);
        auto do_round = [&](int rd) {
            const f32x2 s2 = *(const f32x2*)(hbC + 1536 + 8 * (validC ? 8 * rd + grp : 0));
            int slotN, idN; bool validN; float g_inN;
            {
                u32x4 e;
                if (rd + 1 < nr) { const int k = 8 * (rd + 1) + grp; validN = k < nC; e = *(const u32x4*)(clC + 4 * (validN ? k : 0)); }
                else if (more) { validN = grp < nN; e = *(const u32x4*)(clN + 4 * (validN ? grp : 0)); }
                else { validN = false; e = *(const u32x4*)clC; }
                slotN = e.x; idN = e.y; g_inN = __uint_as_float(e.z);
            }
            const unsigned uoffN = ((unsigned)idN & (DRY ? UMASK : 0xffffffffu)) * 1024u + (unsigned)sub * 16u;
            __builtin_amdgcn_sched_barrier(0);
            int a0 = 0, a1 = 0, a2 = 0, a3 = 0;
#pragma unroll
            for (int t = 0; t < 8; ++t) {
                const u32x4 q = uv[t];
                a0 = __builtin_amdgcn_sdot4((int)q.x, (int)hq[t].x, a0, false); a1 = __builtin_amdgcn_sdot4((int)q.y, (int)hq[t].y, a1, false);
                a2 = __builtin_amdgcn_sdot4((int)q.z, (int)hq[t].z, a2, false); a3 = __builtin_amdgcn_sdot4((int)q.w, (int)hq[t].w, a3, false);
                uv[t] = *(const u32x4*)(U + (uoffN + t * 128));
                __builtin_amdgcn_sched_barrier(0);
            }
            int di = (a0 + a1) + (a2 + a3);
            di += __builtin_amdgcn_update_dpp(0, di, 0xB1, 0xF, 0xF, true);
            di += __builtin_amdgcn_update_dpp(0, di, 0x4E, 0xF, 0xF, true);
            di += __builtin_amdgcn_update_dpp(0, di, 0x141, 0xF, 0xF, true);
            if (validC && sub == 0) {
                float* gw = DRY ? (float*)(ws + OFF_R) + (long)tok * 128 + slotC : rgate + (long)tok * 128 + slotC;
                *gw = g_in * gelu_tanh((float)di * s2.x * shC) * s2.y;
            }
            slotC = slotN; idC = idN; validC = validN; g_in = g_inN;
        };
        do_round(0);
        for (int rd = 1; rd < nr; ++rd) do_round(rd);
        flush_scales(cb ^ 1);
        nC = nN;
    }
}

#ifndef VMASK
#define VMASK 0xffffffffu
#endif
#ifndef V_MFMA
#define V_MFMA 1
#endif
#define LAS __attribute__((address_space(3)))
typedef int v2i_t __attribute__((ext_vector_type(2)));
template <bool DRY>
DI void phase_peer_v(const Params& p, int layer, unsigned char* lds, int tid) {
    unsigned char* ws = p.ws;
    const int* ridx = (const int*)(ws + OFF_RIDX);
    const float* wact = (const float*)(ws + OFF_RGATE);
    const float* ada = (const float*)(ws + OFF_ADA);
    float* x = opq(p.out);
    const int lane = tid & 63, w = __builtin_amdgcn_readfirstlane(tid >> 6), sub = lane & 7, eg = lane >> 3;
    const int xg = blockIdx.x & 7, lb = blockIdx.x >> 3, nwv = (gridDim.x >> 3) * NWAVES, wv = lb * NWAVES + w;
    if (lb >= (int)(gridDim.x >> 3)) return;
    const unsigned char* Vc = ws + OFF_PV + ((long)(layer * 8 + xg) * 16384) * 128;
    unsigned char* gr = lds + w * 16384;
    unsigned* ring = (unsigned*)(lds + 128 * 1024 + w * 3072);
    int ia, ib; float wa, wb;
    auto ld_tokv = [&](int tk) {
        tk = tk < NTOK ? tk : wv;
        ia = ridx[(long)tk * 128 + lane]; ib = ridx[(long)tk * 128 + 64 + lane];
        wa = wact[(long)tk * 128 + lane]; wb = wact[(long)tk * 128 + 64 + lane];
    };
    auto st_ring = [&](int slot) {
        unsigned* rs = ring + slot * 256;
        rs[lane] = (unsigned)ia; rs[64 + lane] = (unsigned)ib; rs[128 + lane] = __float_as_uint(wa); rs[192 + lane] = __float_as_uint(wb);
    };
    auto rd_ids = [&](int slot, u32x4 (&a)[4]) {
        const u32x4* ip = (const u32x4*)(ring + slot * 256 + eg * 16);
#pragma unroll
        for (int q = 0; q < 4; ++q) a[q] = ip[q];
    };
    auto issue = [&](int j, const u32x4 (&a)[4]) {
#pragma unroll
        for (int i = 0; i < 4; ++i) {
            const int g = 4 * (i & 1) + (eg >> 1);
            const unsigned src = (a[j][i] & (DRY ? VMASK : 0xffffffffu)) * 128u + (unsigned)((sub ^ g) << 4);
            __builtin_amdgcn_global_load_lds((const unsigned*)(Vc + src), (unsigned*)(gr + j * 4096 + i * 1024), 16, 0, 0);
        }
    };
    const int col0 = 128 * xg + 16 * sub;
    ld_tokv(wv); st_ring(0);
    ld_tokv(wv + nwv); st_ring(1);
    ld_tokv(wv + 2 * nwv);
    {
        u32x4 a[4];
        rd_ids(0, a);
#pragma unroll
        for (int j = 0; j < 4; ++j) issue(j, a);
    }
#if V_MFMA
    unsigned char* wb8 = lds + 152 * 1024 + w * 256;
    const int m16 = lane & 15, q4 = lane >> 4;
    int boff[8];
    {
        const int rowL = 8 * q4 + (m16 >> 1), gL = (rowL >> 1) & 7;
#pragma unroll
        for (int nt = 0; nt < 8; ++nt) boff[nt] = rowL * 128 + ((nt ^ gL) << 4) + 8 * (m16 & 1);
    }
    unsigned baddr[8];
    const unsigned gr3 = (unsigned)(unsigned long)(LAS unsigned char*)gr;
#pragma unroll
    for (int nt = 0; nt < 8; ++nt) baddr[nt] = gr3 + (unsigned)boff[nt];
    const unsigned aaddr = (unsigned)(unsigned long)(LAS unsigned char*)wb8 + (unsigned)((m16 & 1) * 128 + 8 * q4);
    float xv[8], gfv[8]; int gb = -1;
    const int colx = 128 * xg + m16;
    if (lane < 16) {
#pragma unroll
        for (int nt = 0; nt < 8; ++nt) xv[nt] = x[(long)wv * DM + colx + 16 * nt];
    }
#else
    f32x4 gfv[4]; int gb = -1;
    f32x4 xv[4];
    if (eg == 0) {
#pragma unroll
        for (int c = 0; c < 4; ++c) xv[c] = *(const f32x4*)(x + (long)wv * DM + col0 + 4 * c);
    }
#endif
    int it = 0, s3 = 0;
    for (int tok = wv; tok < NTOK; tok += nwv, ++it) {
        const int sl0 = s3, sl1 = s3 == 2 ? 0 : s3 + 1, sl2 = s3 == 0 ? 2 : s3 - 1;
        st_ring(sl2);
        ld_tokv(tok + 3 * nwv);
        u32x4 na[4];
        rd_ids(sl1, na);
        {
            const int b = tok >> 13;
            if (b != gb) {
                gb = b;
#if V_MFMA
                if (lane < 16) {
#pragma unroll
                    for (int nt = 0; nt < 8; ++nt) gfv[nt] = ada[b * ADA_STRIDE + layer * 6144 + 5 * 1024 + colx + 16 * nt];
                }
#else
                const float* gf = ada + b * ADA_STRIDE + layer * 6144 + 5 * 1024 + col0;
#pragma unroll
                for (int c = 0; c < 4; ++c) gfv[c] = *(const f32x4*)(gf + 4 * c);
#endif
                asm volatile("s_waitcnt vmcnt(0)" ::: "memory");
            }
        }
#if V_MFMA
        float invS;
        {
            const float w0 = __uint_as_float(ring[sl0 * 256 + 128 + lane]), w1 = __uint_as_float(ring[sl0 * 256 + 192 + lane]);
            const float mx = wave_max(fmaxf(fabsf(w0), fabsf(w1)));
            int ex = (int)((__float_as_uint(mx) >> 23) & 255u) - 127;
            ex = ex < -100 ? -100 : ex;
            const float S = __uint_as_float((unsigned)(127 + 7 - ex) << 23);
            invS = __uint_as_float((unsigned)(127 - 7 + ex) << 23);
            const float a0 = w0 * S, a1 = w1 * S;
            const int hi = __builtin_amdgcn_cvt_pk_fp8_f32(a0, a1, 0, false);
            const f32x2 hf = __builtin_amdgcn_cvt_pk_f32_fp8(hi, false);
            const int lo = __builtin_amdgcn_cvt_pk_fp8_f32(a0 - hf.x, a1 - hf.y, 0, false);
            const int p0 = 8 * (lane & 15) + (lane >> 4);
            wb8[p0] = (unsigned char)(hi & 255); wb8[p0 + 4] = (unsigned char)((hi >> 8) & 255);
            wb8[128 + p0] = (unsigned char)(lo & 255); wb8[128 + p0 + 4] = (unsigned char)((lo >> 8) & 255);
        }
        f32x4 d[8];
#pragma unroll
        for (int nt = 0; nt < 8; ++nt) d[nt] = (f32x4){0.f, 0.f, 0.f, 0.f};
#pragma unroll
        for (int j = 0; j < 4; ++j) {
            asm volatile("s_waitcnt vmcnt(24)" ::: "memory");
            v2i_t aq, b0, b1, b2, b3, b4, b5, b6, b7;
            asm volatile("ds_read_b64 %0, %9 offset:%18\n\t"
                         "ds_read_b64_tr_b8 %1, %10 offset:%19\n\tds_read_b64_tr_b8 %2, %11 offset:%19\n\t"
                         "ds_read_b64_tr_b8 %3, %12 offset:%19\n\tds_read_b64_tr_b8 %4, %13 offset:%19\n\t"
                         "ds_read_b64_tr_b8 %5, %14 offset:%19\n\tds_read_b64_tr_b8 %6, %15 offset:%19\n\t"
                         "ds_read_b64_tr_b8 %7, %16 offset:%19\n\tds_read_b64_tr_b8 %8, %17 offset:%19\n\t"
                         "s_waitcnt lgkmcnt(0)"
                         : "=&v"(aq), "=&v"(b0), "=&v"(b1), "=&v"(b2), "=&v"(b3), "=&v"(b4), "=&v"(b5), "=&v"(b6), "=&v"(b7)
                         : "v"(aaddr), "v"(baddr[0]), "v"(baddr[1]), "v"(baddr[2]), "v"(baddr[3]), "v"(baddr[4]), "v"(baddr[5]), "v"(baddr[6]), "v"(baddr[7]),
                           "i"(32 * j), "i"(4096 * j)
                         : "memory");
            long a8 = ((long)(unsigned)aq.y << 32) | (unsigned)aq.x;
            a8 = m16 < 2 ? a8 : 0l;
            const v2i_t bq[8] = {b0, b1, b2, b3, b4, b5, b6, b7};
#pragma unroll
            for (int nt = 0; nt < 8; ++nt) {
                const long b8 = ((long)(unsigned)bq[nt].y << 32) | (unsigned)bq[nt].x;
                d[nt] = __builtin_amdgcn_mfma_f32_16x16x32_fp8_fp8(a8, b8, d[nt], 0, 0, 0);
            }
            issue(j, na);
        }
        if (lane < 16) {
            float* xr = DRY ? (float*)(ws + OFF_R + 16 * MB) + (long)tok * DM + colx : x + (long)tok * DM + colx;
#pragma unroll
            for (int nt = 0; nt < 8; ++nt) xr[16 * nt] = xv[nt] + gfv[nt] * ((d[nt].x + d[nt].y) * invS);
            const int tn = tok + nwv < NTOK ? tok + nwv : wv;
#pragma unroll
            for (int nt = 0; nt < 8; ++nt) xv[nt] = x[(long)tn * DM + colx + 16 * nt];
        }
#else
        f32x4 cw[4];
        {
            const f32x4* wp = (const f32x4*)(ring + sl0 * 256 + 128 + eg * 16);
#pragma unroll
            for (int q = 0; q < 4; ++q) cw[q] = wp[q];
        }
        f32x2 ap[8];
#pragma unroll
        for (int i = 0; i < 8; ++i) ap[i] = (f32x2){0.f, 0.f};
#pragma unroll
        for (int j = 0; j < 4; ++j) {
            asm volatile("s_waitcnt vmcnt(20)" ::: "memory");
#pragma unroll
            for (int i = 0; i < 4; ++i) {
                const int rs = 8 * i + eg, g = 4 * (i & 1) + (eg >> 1);
                const u32x4 v = *(const u32x4*)(gr + j * 4096 + rs * 128 + ((sub ^ g) << 4));
                const float ws1 = cw[j][i]; const f32x2 ww = {ws1, ws1};
                ap[0] += __builtin_amdgcn_cvt_pk_f32_fp8((int)v.x, false) * ww; ap[1] += __builtin_amdgcn_cvt_pk_f32_fp8((int)v.x, true) * ww;
                ap[2] += __builtin_amdgcn_cvt_pk_f32_fp8((int)v.y, false) * ww; ap[3] += __builtin_amdgcn_cvt_pk_f32_fp8((int)v.y, true) * ww;
                ap[4] += __builtin_amdgcn_cvt_pk_f32_fp8((int)v.z, false) * ww; ap[5] += __builtin_amdgcn_cvt_pk_f32_fp8((int)v.z, true) * ww;
                ap[6] += __builtin_amdgcn_cvt_pk_f32_fp8((int)v.w, false) * ww; ap[7] += __builtin_amdgcn_cvt_pk_f32_fp8((int)v.w, true) * ww;
            }
            asm volatile("s_waitcnt lgkmcnt(0)" ::: "memory");
            issue(j, na);
        }
        float acc[16];
#pragma unroll
        for (int i = 0; i < 8; ++i) { acc[2 * i] = ap[i].x; acc[2 * i + 1] = ap[i].y; }
#pragma unroll
        for (int i = 0; i < 16; ++i) { acc[i] += lr8(acc[i]); acc[i] = sum_x16(acc[i]); acc[i] = sum_x32(acc[i]); }
        if (eg == 0) {
            float* xr = DRY ? (float*)(ws + OFF_R + 16 * MB) + (long)tok * DM + col0 : x + (long)tok * DM + col0;
#pragma unroll
            for (int c = 0; c < 4; ++c) {
                const f32x4 gv = gfv[c];
                f32x4 o;
                o.x = xv[c].x + gv.x * acc[4 * c + 0]; o.y = xv[c].y + gv.y * acc[4 * c + 1];
                o.z = xv[c].z + gv.z * acc[4 * c + 2]; o.w = xv[c].w + gv.w * acc[4 * c + 3];
                *(f32x4*)(xr + 4 * c) = o;
            }
            const int tn = tok + nwv < NTOK ? tok + nwv : wv;
#pragma unroll
            for (int c = 0; c < 4; ++c) xv[c] = *(const f32x4*)(x + (long)tn * DM + col0 + 4 * c);
        }
#endif
        s3 = sl1;
    }
    asm volatile("s_waitcnt vmcnt(0)" ::: "memory");
}

DI void norm_row_q8(const f32x4 (&v)[4], float rstd, const float* gain, const float* shift, const float* scale, unsigned char* orow, float* os, int lane) {
    f32x4 y[4]; float am = 0.f;
#pragma unroll
    for (int j = 0; j < 4; ++j) {
        const int c = 4 * lane + 256 * j;
        const f32x4 g = *(const f32x4*)(gain + c), sh = *(const f32x4*)(shift + c), sc = *(const f32x4*)(scale + c);
        y[j].x = v[j].x * rstd * g.x * (1.f + sc.x) + sh.x; y[j].y = v[j].y * rstd * g.y * (1.f + sc.y) + sh.y;
        y[j].z = v[j].z * rstd * g.z * (1.f + sc.z) + sh.z; y[j].w = v[j].w * rstd * g.w * (1.f + sc.w) + sh.w;
        am = fmaxf(am, fmaxf(fmaxf(fabsf(y[j].x), fabsf(y[j].y)), fmaxf(fabsf(y[j].z), fabsf(y[j].w))));
    }
    am = wave_max(am);
    const float qs = am > 0.f ? 127.f / am : 1.f;
#pragma unroll
    for (int j = 0; j < 4; ++j) *(int*)(orow + 4 * lane + 256 * j) = pack_i8x4(y[j].x * qs, y[j].y * qs, y[j].z * qs, y[j].w * qs);
    if (lane == 0) *os = am > 0.f ? am * (1.f / 127.f) : 1.f;
}
DI void phase_norm2(const float* __restrict__ x, unsigned char* __restrict__ out1, float* __restrict__ os1, const float* gain1, int sh1, int sc1,
                    unsigned char* __restrict__ out2, float* __restrict__ os2, const float* gain2, int sh2, int sc2, const float* ada, int tid) {
    const int lane = tid & 63, gw = blockIdx.x * NWAVES + (tid >> 6), nw = gridDim.x * NWAVES;
    for (int tok = gw; tok < NTOK; tok += nw) {
        const int b = tok >> 13;
        f32x4 v[4]; float ss = 0.f;
#pragma unroll
        for (int j = 0; j < 4; ++j) { v[j] = *(const f32x4*)(x + (long)tok * DM + 4 * lane + 256 * j); ss += v[j].x * v[j].x + v[j].y * v[j].y + v[j].z * v[j].z + v[j].w * v[j].w; }
        const float rstd = rsqrtf(wave_sum(ss) * (1.f / DM) + EPS);
        norm_row_q8(v, rstd, gain1, ada + b * ADA_STRIDE + sh1, ada + b * ADA_STRIDE + sc1, out1 + (long)tok * DM, os1 + tok, lane);
        norm_row_q8(v, rstd, gain2, ada + b * ADA_STRIDE + sh2, ada + b * ADA_STRIDE + sc2, out2 + (long)tok * DM, os2 + tok, lane);
    }
}

template <int MT, class Epi>
DI void gemm_phase(const bf16_t* A, long lda, int M, const bf16_t* Bt, long ldb, int N, int K, const Epi& epi, unsigned char* lds, int tid) {
    const int ntm = (M + 128 * MT - 1) / (128 * MT), ntn = (N + 255) / 256, nt = ntm * ntn;
    if ((gridDim.x & 7) == 0 && (ntm & 31) == 0) {
        const int xcd = blockIdx.x & 7, lb = blockIdx.x >> 3, nlb = gridDim.x >> 3, tmx = ntm >> 3, per = tmx * ntn;
        for (int q = lb; q < per; q += nlb) {
            const int g4 = q / (4 * ntn), rem = q - g4 * 4 * ntn, tn = rem >> 2, tm = xcd * tmx + g4 * 4 + (rem & 3);
            if (tm < (xcd + 1) * tmx) gemm_tile<MT>(A, lda, M, Bt, ldb, N, K, tm * 128 * MT, tn * 256, epi, lds, tid);
        }
        return;
    }
    for (int t = blockIdx.x; t < nt; t += gridDim.x) {
        const int tn = t / ntm, tm = t % ntm;
        gemm_tile<MT>(A, lda, M, Bt, ldb, N, K, tm * 128 * MT, tn * 256, epi, lds, tid);
    }
}

template <int MT, class Epi>
DI void gemm_tile_i8(const unsigned char* __restrict__ A, int M, const float* __restrict__ as, const unsigned char* __restrict__ Bt, int N, const float* __restrict__ bs,
                     int K, int m0, int n0, const Epi& epi, unsigned char* lds, int tid) {
    constexpr int XS = MT * 128 * 128, WS = 256 * 128, STAGE = XS + WS;
    const int lane = tid & 63, w = tid >> 6, tg = w & 3, fh = w >> 2, r = lane & 31, h = lane >> 5;
    const int wbase = tid & ~63;
    unsigned xo[2 * MT], wo[4];
#pragma unroll
    for (int i = 0; i < 2 * MT; ++i) { int row, c; sw2_src(tid + 512 * i, row, c); int m = m0 + row; m = m < M ? m : M - 1; xo[i] = (unsigned)m * (unsigned)K + c * 16; }
#pragma unroll
    for (int i = 0; i < 4; ++i) { int row, c; sw2_src(tid + 512 * i, row, c); int n = n0 + row; n = n < N ? n : N - 1; wo[i] = (unsigned)n * (unsigned)K + c * 16; }
    auto stage = [&](int kt, unsigned char* st) {
#pragma unroll
        for (int i = 0; i < 2 * MT; ++i)
            __builtin_amdgcn_global_load_lds((const unsigned*)(A + kt * 128 + xo[i]), (unsigned*)(st + (wbase + 512 * i) * 16), 16, 0, 0);
#pragma unroll
        for (int i = 0; i < 4; ++i)
            __builtin_amdgcn_global_load_lds((const unsigned*)(Bt + kt * 128 + wo[i]), (unsigned*)(st + XS + (wbase + 512 * i) * 16), 16, 0, 0);
    };
    i32x16 acc[MT][4];
#pragma unroll
    for (int s2 = 0; s2 < MT; ++s2)
#pragma unroll
        for (int i = 0; i < 4; ++i)
#pragma unroll
            for (int j = 0; j < 16; ++j) acc[s2][i][j] = 0;
    const int nk = K >> 7;
    stage(0, lds);
    __syncthreads();
#pragma unroll 2
    for (int kt = 0; kt < nk; ++kt) {
        unsigned char* cur = lds + (kt & 1) * STAGE;
        if (kt + 1 < nk) stage(kt + 1, lds + ((kt + 1) & 1) * STAGE);
        i32x4 xfa[MT], wfa[4], xfb[MT], wfb[4];
        auto ldf = [&](i32x4 (&xf)[MT], i32x4 (&wf)[4], int ks) {
#pragma unroll
            for (int s2 = 0; s2 < MT; ++s2) xf[s2] = *(const i32x4*)(cur + sw2(32 * MT * tg + 32 * s2 + r, 2 * ks + h));
#pragma unroll
            for (int mt = 0; mt < 4; ++mt) wf[mt] = *(const i32x4*)(cur + XS + sw2(128 * fh + 32 * mt + r, 2 * ks + h));
        };
        auto mm = [&](const i32x4 (&xf)[MT], const i32x4 (&wf)[4]) {
#pragma unroll
            for (int mt = 0; mt < 4; ++mt)
#pragma unroll
                for (int s2 = 0; s2 < MT; ++s2) acc[s2][mt] = MFMA32I8(wf[mt], xf[s2], acc[s2][mt]);
        };
        ldf(xfa, wfa, 0);
        ldf(xfb, wfb, 1); __builtin_amdgcn_sched_barrier(0); mm(xfa, wfa); __builtin_amdgcn_sched_barrier(0);
        ldf(xfa, wfa, 2); __builtin_amdgcn_sched_barrier(0); mm(xfb, wfb); __builtin_amdgcn_sched_barrier(0);
        ldf(xfb, wfb, 3); __builtin_amdgcn_sched_barrier(0); mm(xfa, wfa); __builtin_amdgcn_sched_barrier(0);
        mm(xfb, wfb);
        __syncthreads();
    }
    auto fin = [&](const i32x16 (&ai)[4], int s2, int ho, int ro, int to) {
        const int tok = m0 + 32 * MT * tg + 32 * s2 + ro, fbase = n0 + 128 * fh;
        const float sa = as[tok < M ? tok : M - 1];
        f32x16 af[4];
#pragma unroll
        for (int mt = 0; mt < 4; ++mt) {
#pragma unroll
            for (int g4 = 0; g4 < 4; ++g4) {
                int f0 = fbase + 32 * mt + 8 * g4 + 4 * ho; f0 = f0 + 3 < N ? f0 : (N - 4 > 0 ? N - 4 : 0);
                const f32x4 sb = *(const f32x4*)(bs + f0);
                af[mt][4 * g4 + 0] = (float)ai[mt][4 * g4 + 0] * (sa * sb.x); af[mt][4 * g4 + 1] = (float)ai[mt][4 * g4 + 1] * (sa * sb.y);
                af[mt][4 * g4 + 2] = (float)ai[mt][4 * g4 + 2] * (sa * sb.z); af[mt][4 * g4 + 3] = (float)ai[mt][4 * g4 + 3] * (sa * sb.w);
            }
            __builtin_amdgcn_sched_barrier(0);
        }
        epi(af, tok, fbase, ho, lds, to);
        __builtin_amdgcn_sched_barrier(0);
    };
    if constexpr (MT == 2 && epi_stash<Epi>::present) {
        int* sp = (int*)lds + w * 4096 + lane;
#pragma unroll
        for (int mt = 0; mt < 4; ++mt)
#pragma unroll
            for (int j = 0; j < 16; ++j) sp[(mt * 16 + j) * 64] = acc[1][mt][j];
        int ho = h, ro = r, to = tid;
        asm volatile("" : "+v"(ho), "+v"(ro), "+v"(to));
        fin(acc[0], 0, ho, ro, to);
        i32x16 a2[4];
        const int* sp2 = sp; asm volatile("" : "+v"(sp2));
#pragma unroll
        for (int mt = 0; mt < 4; ++mt)
#pragma unroll
            for (int j = 0; j < 16; ++j) a2[mt][j] = sp2[(mt * 16 + j) * 64];
        asm volatile("" : "+v"(ho), "+v"(ro), "+v"(to));
        fin(a2, 1, ho, ro, to);
        __syncthreads();
    } else {
        int ho = h, ro = r, to = tid;
#pragma unroll
        for (int s2 = 0; s2 < MT; ++s2) { asm volatile("" : "+v"(ho), "+v"(ro), "+v"(to)); fin(acc[s2], s2, ho, ro, to); }
    }
}
template <int MT, class Epi>
DI void gemm_phase_i8(const unsigned char* A, int M, const float* as, const unsigned char* Bt, int N, const float* bs, int K, const Epi& epi, unsigned char* lds, int tid) {
    const int ntm = (M + 128 * MT - 1) / (128 * MT), ntn = (N + 255) / 256, nt = ntm * ntn;
    if ((gridDim.x & 7) == 0 && (ntm & 31) == 0) {
        const int xcd = blockIdx.x & 7, lb = blockIdx.x >> 3, nlb = gridDim.x >> 3, tmx = ntm >> 3, per = tmx * ntn;
        for (int q = lb; q < per; q += nlb) {
            const int g4 = q / (4 * ntn), rem = q - g4 * 4 * ntn, tn = rem >> 2, tm = xcd * tmx + g4 * 4 + (rem & 3);
            gemm_tile_i8<MT>(A, M, as, Bt, N, bs, K, tm * 128 * MT, tn * 256, epi, lds, tid);
        }
        return;
    }
    for (int t = blockIdx.x; t < nt; t += gridDim.x) {
        const int tn = t / ntm, tm = t % ntm;
        gemm_tile_i8<MT>(A, M, as, Bt, N, bs, K, tm * 128 * MT, tn * 256, epi, lds, tid);
    }
}

DI void wquant_rows(const bf16_t* __restrict__ src, unsigned char* __restrict__ dst, float* __restrict__ sc, int nrows, int gw, int nw, int lane) {
    for (int n = gw; n < nrows; n += nw) {
        const u32x4 a = *(const u32x4*)(src + (long)n * 1024 + 16 * lane), b = *(const u32x4*)(src + (long)n * 1024 + 16 * lane + 8);
        float v[16];
        v[0] = bflo(a.x); v[1] = bfhi(a.x); v[2] = bflo(a.y); v[3] = bfhi(a.y); v[4] = bflo(a.z); v[5] = bfhi(a.z); v[6] = bflo(a.w); v[7] = bfhi(a.w);
        v[8] = bflo(b.x); v[9] = bfhi(b.x); v[10] = bflo(b.y); v[11] = bfhi(b.y); v[12] = bflo(b.z); v[13] = bfhi(b.z); v[14] = bflo(b.w); v[15] = bfhi(b.w);
        float am = 0.f;
#pragma unroll
        for (int q = 0; q < 16; ++q) am = fmaxf(am, fabsf(v[q]));
        am = wave_max(am);
        const float qs = am > 0.f ? 127.f / am : 1.f;
        u32x4 o;
        o.x = (unsigned)pack_i8x4(v[0] * qs, v[1] * qs, v[2] * qs, v[3] * qs); o.y = (unsigned)pack_i8x4(v[4] * qs, v[5] * qs, v[6] * qs, v[7] * qs);
        o.z = (unsigned)pack_i8x4(v[8] * qs, v[9] * qs, v[10] * qs, v[11] * qs); o.w = (unsigned)pack_i8x4(v[12] * qs, v[13] * qs, v[14] * qs, v[15] * qs);
        *(u32x4*)(dst + (long)n * 1024 + 16 * lane) = o;
        if (lane == 0) sc[n] = am > 0.f ? am * (1.f / 127.f) : 1.f;
    }
}
DI void phase_wquant(unsigned char* ws, int tid) {
    const int lane = tid & 63, gw = blockIdx.x * NWAVES + (tid >> 6), nw = gridDim.x * NWAVES;
    float* sc = (float*)(ws + OFF_W8S);
    wquant_rows((const bf16_t*)(ws + OFF_WT_PEER), ws + OFF_W8_PEER, sc + W8S_PEER, 4096, gw, nw, lane);
    wquant_rows((const bf16_t*)(ws + OFF_WT_DIN), ws + OFF_W8_DIN, sc + W8S_DIN, 3072, gw, nw, lane);
    wquant_rows((const bf16_t*)(ws + OFF_WT_KV), ws + OFF_W8_KV, sc + W8S_KV, 1536, gw, nw, lane);
    wquant_rows((const bf16_t*)(ws + OFF_WT_NIN), ws + OFF_W8_NIN, sc + W8S_NIN, 1088, gw, nw, lane);
}

#define XB_TMO      128
#define XB_XCNT(j)  (256  + 64 * (j))
#define XB_XSUB(j)  (1280 + 64 * (j))
#define XB_XGEN(j)  (2304 + 64 * (j))
#define XB_TOP      3328
#define XB_TOPGEN   3392
#define XCD_BAR_WORDS 3456
#define XB_SPIN_CAP (1u << 22)
DI unsigned xb_ld(unsigned* p) { return __hip_atomic_load(p, __ATOMIC_RELAXED, __HIP_MEMORY_SCOPE_AGENT); }
DI unsigned xb_add(unsigned* p, unsigned v) { return __hip_atomic_fetch_add(p, v, __ATOMIC_RELAXED, __HIP_MEMORY_SCOPE_AGENT); }
DI unsigned xb_xcc_id() { return (unsigned)__builtin_amdgcn_s_getreg((3 << 11) | 20) & 0xFu; }
#define XB_SPIN(cond, bar) do { unsigned _sp = 0; while (cond) { __builtin_amdgcn_s_sleep(1); \
    if ((++_sp & 255u) == 0u) { if (xb_ld(&(bar)[XB_TMO])) break; if (_sp > XB_SPIN_CAP) { atomicAdd(&(bar)[XB_TMO], 1u); break; } } } } while (0)
DI void xcd_barrier_complete(unsigned* bar, unsigned x, unsigned& nloc, unsigned& nx) {
    const unsigned G = gridDim.x;
    unsigned sum, cnt, mine, sp = 0u;
    for (;;) {
        sum = 0u; cnt = 0u; mine = 0u;
#pragma unroll
        for (unsigned j = 0; j < 16; ++j) { const unsigned c = xb_ld(&bar[XB_XCNT(j)]); sum += c; cnt += (c > 0u) ? 1u : 0u; mine = (j == x) ? c : mine; }
        if (sum == G) break;
        __builtin_amdgcn_s_sleep(1);
        if ((++sp & 255u) == 0u) { if (xb_ld(&bar[XB_TMO])) break; if (sp > XB_SPIN_CAP) { atomicAdd(&bar[XB_TMO], 1u); break; } }
    }
    nloc = mine > 0u ? mine : 1u; nx = cnt > 0u ? cnt : 1u;
}
DI void xcd_barrier(unsigned* bar, volatile LAS unsigned* st, int tid) {
    asm volatile("s_waitcnt vmcnt(0)" ::: "memory");
    __syncthreads();
    if (tid == 0) {
        const unsigned x = xb_xcc_id();
        __builtin_amdgcn_s_waitcnt(0);
        unsigned nloc = st[0], nx = st[1];
        if (nloc == 0u) { xcd_barrier_complete(bar, x, nloc, nx); st[0] = nloc; st[1] = nx; }
        const unsigned old = xb_add(&bar[XB_XSUB(x)], 1u);
        const unsigned gen = old / nloc;
        if (old + 1u == (gen + 1u) * nloc) {
            __builtin_amdgcn_fence(__ATOMIC_RELEASE, "agent");
            asm volatile("s_waitcnt vmcnt(0)" ::: "memory");
            const unsigned og = xb_add(&bar[XB_TOP], 1u);
            const unsigned tg = og / nx;
            if (og + 1u == (tg + 1u) * nx) xb_add(&bar[XB_TOPGEN], 1u);
            else XB_SPIN(xb_ld(&bar[XB_TOPGEN]) == tg, bar);
            __builtin_amdgcn_fence(__ATOMIC_ACQUIRE, "agent");
            xb_add(&bar[XB_XGEN(x)], 1u);
            asm volatile("s_waitcnt vmcnt(0)" ::: "memory");
        } else {
            XB_SPIN(xb_ld(&bar[XB_XGEN(x)]) == gen, bar);
            __builtin_amdgcn_fence(__ATOMIC_ACQUIRE, "agent");
            asm volatile("s_waitcnt vmcnt(0)" ::: "memory");
        }
    }
    __syncthreads();
}

#define ftid() ftid_(wave_u)
DI int ftid_(int wave_u) { int t = (wave_u << 6) + (int)__builtin_amdgcn_mbcnt_hi(~0u, __builtin_amdgcn_mbcnt_lo(~0u, 0u)); asm volatile("" : "+v"(t)); return t; }


#if defined(__HIP_DEVICE_COMPILE__)
typedef const __attribute__((address_space(4))) Params* KParamPtr;
DI Params load_params() { KParamPtr kp = (KParamPtr)__builtin_amdgcn_kernarg_segment_ptr(); asm volatile("" : "+s"(kp)); return *kp; }
#else
DI Params load_params() { return Params{}; }
#endif
#define p (load_params())
#define ws (load_params().ws)
#define ada ((const float*)(ws + OFF_ADA))
#define Hb ((bf16_t*)(ws + OFF_H))
#define bar ((unsigned*)(ws + OFF_BAR))
__global__ void __launch_bounds__(NTHREADS) yoco_fwd(Params p_arg) {
    extern __shared__ __attribute__((aligned(16))) unsigned char lds[];
    cg::grid_group grid = cg::this_grid();
    volatile LAS unsigned* bst = (volatile LAS unsigned*)(lds + LDS_BAR);
    const int wave_u = __builtin_amdgcn_readfirstlane((int)(threadIdx.x >> 6));
    { const int t0 = ftid(); if (t0 == 0) { bst[0] = 0u; bst[1] = 0u; }
      if (blockIdx.x == 0) for (int i = t0; i < XCD_BAR_WORDS; i += NTHREADS) bar[i] = 0u; }
    __syncthreads();
    RUN(0) REP(0) phase_prep(p, lds, ftid());
    grid.sync();
    if (ftid() == 0) (void)xb_add(&bar[XB_XCNT(xb_xcc_id())], 1u);
    RUN(1) REP(1) phase_norm_q8<false>(p.in[0], Hb, ws + OFF_H8, (float*)(ws + OFF_HS), p.in[5], ada, 0, 1024, ftid());
    RUN(1) phase_wquant(ws, ftid());
    xcd_barrier(bar, bst, ftid());
    RUN(2) REP(2) {
        EpiQKV0 e{(bf16_t*)(ws + OFF_Q0), (bf16_t*)(ws + OFF_K0), (bf16_t*)(ws + OFF_VT0), p.in[10], p.in[11], (float*)(ws + OFF_MB0), p.in[2]};
        gemm_phase_i8<2>(ws + OFF_H8, NTOK, (const float*)(ws + OFF_HS), ws + OFF_W8_DIN, 3072, (const float*)(ws + OFF_W8S) + W8S_DIN, DM, e, lds, ftid());
    }
    xcd_barrier(bar, bst, ftid());
    RUN(3) REP(3) phase_diff_attn(p, lds, ftid());
    xcd_barrier(bar, bst, ftid());
    RUN(4) REP(4) {
        EpiResid e{p.in[0], opq(p.out), ada + 2 * 1024};
        gemm_phase<2>(Hb, DM, NTOK, (const bf16_t*)(ws + OFF_WT_DOUT), DM, 1024, DM, e, lds, ftid());
    }
    xcd_barrier(bar, bst, ftid());
    if (STOP_AFTER <= 1) return;
    RUN(1) phase_norm_q8<false>(opq(p.out), Hb, ws + OFF_H8, (float*)(ws + OFF_HS), p.in[6], ada, 3 * 1024, 4 * 1024, ftid());
    xcd_barrier(bar, bst, ftid());
    RUN(5) REP(5) {
        EpiPeer e{(int*)(ws + OFF_RIDX), (float*)(ws + OFF_RGATE), 128 * 1024};
        gemm_phase_i8<2>(ws + OFF_H8, NTOK, (const float*)(ws + OFF_HS), ws + OFF_W8_PEER, 2048, (const float*)(ws + OFF_W8S) + W8S_PEER, DM, e, lds, ftid());
    }
    xcd_barrier(bar, bst, ftid());
    if ((REPEAT_MASK >> 6) & 1) phase_peer_u<true>(p, 0, lds, ftid());
    RUN(6) phase_peer_u<false>(p, 0, lds, ftid());
    xcd_barrier(bar, bst, ftid());
    if ((REPEAT_MASK >> 10) & 1) phase_peer_v<true>(p, 0, lds, ftid());
    RUN(6) phase_peer_v<false>(p, 0, lds, ftid());
    xcd_barrier(bar, bst, ftid());
    RUN(1) phase_norm2(opq(p.out), ws + OFF_H8, (float*)(ws + OFF_HS), p.in[13], 12288, 12288 + 1024, ws + OFF_H, (float*)(ws + OFF_HS) + NTOK, p.in[5] + 1024, 6144, 6144 + 1024, ada, ftid());
    xcd_barrier(bar, bst, ftid());
    if (STOP_AFTER <= 2) return;
    RUN(7) REP(7) {
        EpiKV e{(bf16_t*)(ws + OFF_KC), (bf16_t*)(ws + OFF_KS), (bf16_t*)(ws + OFF_VST), (bf16_t*)(ws + OFF_KW), (bf16_t*)(ws + OFF_VWT), p.in[21]};
        gemm_phase_i8<2>(ws + OFF_H8, NTOK, (const float*)(ws + OFF_HS), ws + OFF_W8_KV, 1536, (const float*)(ws + OFF_W8S) + W8S_KV, DM, e, lds, ftid());
    }
    xcd_barrier(bar, bst, ftid());
    RUN(8) REP(8) {
        EpiNsaQ e{(bf16_t*)(ws + OFF_QN), (float*)(ws + OFF_GATES), p.in[25], p.in[23], (float*)(ws + OFF_MB1)};
        gemm_phase_i8<2>(ws + OFF_H, NTOK, (const float*)(ws + OFF_HS) + NTOK, ws + OFF_W8_NIN, 1048, (const float*)(ws + OFF_W8S) + W8S_NIN, DM, e, lds, ftid());
        for (int t = blockIdx.x; t < 64; t += gridDim.x) {
            const int pr = t >> 2, tm = t & 3, kv = pr >> 3, bg = pr & 7;
            const bf16_t* Ap = (const bf16_t*)(ws + OFF_KC) + (long)(kv * 8 + bg) * SEQ * 128;
            bf16_t* hid = (bf16_t*)(ws + OFF_HID) + (long)pr * 512 * 256;
            EpiCmp1 e1{hid, (const float*)(ws + OFF_POSB) + kv * 16 * 256, p.in[19] + kv * 256};
            gemm_tile<1>(Ap, 2048, 511, (const bf16_t*)(ws + OFF_WT_C1) + (long)kv * 256 * 4096, 4096, 256, 4096, tm * 128, 0, e1, lds, ftid());
            __syncthreads();
            bf16_t* dst = kv == 0 ? (bf16_t*)(ws + OFF_KCMP) + (long)bg * 512 * 128 : (bf16_t*)(ws + OFF_VCMPT) + (long)bg * 128 * 512;
            EpiCmp2 e2{dst, p.in[21], kv};
            gemm_tile<1>(hid, 256, 512, (const bf16_t*)(ws + OFF_WT_C2) + (long)kv * 128 * 256, 256, 128, 256, tm * 128, 0, e2, lds, ftid());
        }
    }
    xcd_barrier(bar, bst, ftid());
#ifdef NSA_PROBE
    phase_nsa_attn<NSA_PROBE>(p, lds, ftid());
#endif
    RUN(9) REP(9) phase_nsa_attn<0>(p, lds, ftid());
    xcd_barrier(bar, bst, ftid());
    RUN(4) {
        float* xo = opq(p.out);
        EpiResid e{xo, xo, ada + 6144 + 2 * 1024};
        gemm_phase<2>(Hb, DM, NTOK, (const bf16_t*)(ws + OFF_WT_NOUT), DM, 1024, DM, e, lds, ftid());
    }
    xcd_barrier(bar, bst, ftid());
    if (STOP_AFTER <= 3) return;
    RUN(1) phase_norm_q8<false>(opq(p.out), Hb, ws + OFF_H8, (float*)(ws + OFF_HS), p.in[6] + 1024, ada, 6144 + 3 * 1024, 6144 + 4 * 1024, ftid());
    xcd_barrier(bar, bst, ftid());
    RUN(5) REP(5) {
        EpiPeer e{(int*)(ws + OFF_RIDX), (float*)(ws + OFF_RGATE), 128 * 1024};
        gemm_phase_i8<2>(ws + OFF_H8, NTOK, (const float*)(ws + OFF_HS), ws + OFF_W8_PEER + (long)2048 * 1024, 2048, (const float*)(ws + OFF_W8S) + W8S_PEER + 2048, DM, e, lds, ftid());
    }
    xcd_barrier(bar, bst, ftid());
    if ((REPEAT_MASK >> 6) & 1) phase_peer_u<true>(p, 1, lds, ftid());
    RUN(6) phase_peer_u<false>(p, 1, lds, ftid());
    xcd_barrier(bar, bst, ftid());
    if ((REPEAT_MASK >> 10) & 1) phase_peer_v<true>(p, 1, lds, ftid());
    RUN(6) phase_peer_v<false>(p, 1, lds, ftid());
}
#undef p
#undef ws
#undef ada
#undef Hb
#undef bar

extern "C" void kernel_launch(void* const* d_in, const int* in_sizes, int n_in, void* d_out, int out_size, void* d_ws, size_t ws_size,
                              hipStream_t stream) {
    static int grid_blocks = 0;
    if (grid_blocks == 0) {
        if (n_in != 30 || out_size != NTOK * DM || ws_size < WS_END) {
            fprintf(stderr, "kernel_launch: unexpected shapes (n_in %d out %d ws %zu)\n", n_in, out_size, ws_size);
            grid_blocks = -1; return;
        }
        int dev = 0, cus = 0, per_cu = 0;
        hipGetDevice(&dev);
        hipDeviceGetAttribute(&cus, hipDeviceAttributeMultiprocessorCount, dev);
        hipFuncSetAttribute((const void*)yoco_fwd, hipFuncAttributeMaxDynamicSharedMemorySize, LDS_BYTES);
        hipOccupancyMaxActiveBlocksPerMultiprocessor(&per_cu, (const void*)yoco_fwd, NTHREADS, LDS_BYTES);
        if (per_cu < 1) { fprintf(stderr, "kernel_launch: occupancy query says %d blocks per CU\n", per_cu); grid_blocks = -1; return; }
        grid_blocks = cus;
    }
    if (grid_blocks < 0) return;
    Params p{};
    for (int i = 0; i < 30; ++i) p.in[i] = (const float*)d_in[i];
    p.out = (float*)d_out;
    p.ws = (unsigned char*)d_ws;
    void* args[] = {&p};
    hipError_t e = hipLaunchCooperativeKernel((const void*)yoco_fwd, dim3(grid_blocks), dim3(NTHREADS), args, LDS_BYTES, stream);
    if (e != hipSuccess) fprintf(stderr, "cooperative launch failed: %s (grid %d)\n", hipGetErrorString(e), grid_blocks);
}
```

```cpp
#include <hip/hip_runtime.h>
#include <hip/hip_cooperative_groups.h>
#include <cstdio>
#include <cstdint>
namespace cg = cooperative_groups;

#define DI __device__ __forceinline__
#ifndef STOP_AFTER
#define STOP_AFTER 99
#endif
#ifndef ONLY_PHASE
#define ONLY_PHASE -1
#endif
#define RUN(n) if (ONLY_PHASE < 0 || ONLY_PHASE == (n))
#ifndef REPEAT_MASK
#define REPEAT_MASK 0
#endif
#define REP(n) for (int rep_ = 0; rep_ < (((REPEAT_MASK) >> (n)) & 1) + 1; ++rep_)

typedef unsigned short bf16_t;
typedef short bf16x8 __attribute__((ext_vector_type(8)));
typedef float f32x16 __attribute__((ext_vector_type(16)));
typedef float f32x4 __attribute__((ext_vector_type(4)));
typedef float f32x2 __attribute__((ext_vector_type(2)));
typedef unsigned u32x4 __attribute__((ext_vector_type(4)));
typedef unsigned u32x2 __attribute__((ext_vector_type(2)));
typedef __bf16 bf16x2v __attribute__((ext_vector_type(2)));

#define MFMA32(a, b, c) __builtin_amdgcn_mfma_f32_32x32x16_bf16((a), (b), (c), 0, 0, 0)
typedef int i32x4 __attribute__((ext_vector_type(4)));
typedef int i32x16 __attribute__((ext_vector_type(16)));
#define MFMA32I8(a, b, c) __builtin_amdgcn_mfma_i32_32x32x32_i8((a), (b), (c), 0, 0, 0)

constexpr int NB = 4, SEQ = 8192, DM = 1024, NTOK = NB * SEQ;
constexpr int NTHREADS = 512, NWAVES = 8;
constexpr float EPS = 1e-6f;
constexpr float LOG2E = 1.4426950408889634f;
constexpr int ADA_STRIDE = 14336;

constexpr size_t MB = 1u << 20;
constexpr size_t OFF_ADA = 0;
constexpr size_t OFF_POSB = 256 * 1024;
constexpr size_t OFF_BAR = 320 * 1024;
constexpr size_t OFF_MB0 = 168 * MB;
constexpr size_t OFF_MB1 = 172 * MB;
constexpr size_t OFF_H8 = 104 * MB;
constexpr size_t OFF_HS = 174 * MB;
constexpr size_t OFF_W8 = 176 * MB;
constexpr size_t OFF_W8_DIN = OFF_W8, OFF_W8_KV = OFF_W8 + 3 * MB, OFF_W8_NIN = OFF_W8 + 5 * MB, OFF_W8_PEER = OFF_W8 + 7 * MB;
constexpr size_t OFF_W8S = 188 * MB;
constexpr int W8S_DIN = 0, W8S_KV = 3072, W8S_NIN = 4608, W8S_PEER = 5760, W8S_TOTAL = 9856;
constexpr size_t OFF_USI = 384 * 1024;
constexpr size_t OFF_VSI = 512 * 1024;
constexpr size_t OFF_WT_DIN = 1 * MB;
constexpr size_t OFF_WT_DOUT = 7 * MB;
constexpr size_t OFF_WT_KV = 9 * MB;
constexpr size_t OFF_WT_NIN = 12 * MB;
constexpr size_t OFF_WT_NOUT = 15 * MB;
constexpr size_t OFF_WT_PEER = 17 * MB;
constexpr size_t OFF_WT_C1 = 25 * MB;
constexpr size_t OFF_WT_C2 = 29 * MB;
constexpr size_t OFF_GATES = 30 * MB;
constexpr size_t OFF_KCMP = 34 * MB;
constexpr size_t OFF_VCMPT = 35 * MB;
constexpr size_t OFF_HID = 36 * MB;
constexpr size_t OFF_RIDX = 40 * MB;
constexpr size_t OFF_RGATE = 56 * MB;
constexpr size_t OFF_PU = 72 * MB;
constexpr size_t OFF_PV = 136 * MB;
constexpr size_t OFF_H = 200 * MB;
constexpr size_t OFF_R = 264 * MB;
constexpr size_t WS_END = 456 * MB;
constexpr size_t OFF_Q0 = OFF_R, OFF_K0 = OFF_R + 64 * MB, OFF_VT0 = OFF_R + 128 * MB;
constexpr size_t OFF_QN = OFF_R, OFF_H2 = OFF_R, OFF_KC = OFF_R + 64 * MB, OFF_KS = OFF_R + 96 * MB, OFF_VST = OFF_R + 112 * MB,
                 OFF_KW = OFF_R + 128 * MB, OFF_VWT = OFF_R + 144 * MB;

constexpr int LDS_BAR = 159 * 1024;
constexpr int LDS_BYTES = LDS_BAR + 256;

struct Params {
    const float* in[30];
    float* out;
    unsigned char* ws;
};

template <class T> DI T* opq(T* q) { asm volatile("" : "+s"(q)); return (T*)(__attribute__((address_space(1))) T*)q; }
DI unsigned pk2(float lo, float hi) { f32x2 v = {lo, hi}; return __builtin_bit_cast(unsigned, __builtin_convertvector(v, bf16x2v)); }
DI bf16_t f2bf(float x) { return (bf16_t)(pk2(x, 0.f) & 0xffffu); }
DI float bflo(unsigned u) { return __uint_as_float(u << 16); }
DI float bfhi(unsigned u) { return __uint_as_float(u & 0xffff0000u); }
DI float fexp2(float x) { return __builtin_amdgcn_exp2f(x); }
DI float frcp(float x) { return __builtin_amdgcn_rcpf(x); }
DI int crow(int reg, int h) { return (reg & 3) + 8 * (reg >> 2) + 4 * h; }
template <int CTRL> DI float dpp_f(float v) { return __builtin_bit_cast(float, __builtin_amdgcn_update_dpp(0, __builtin_bit_cast(int, v), CTRL, 0xF, 0xF, true)); }
DI float lx1(float v) { return dpp_f<0xB1>(v); }
DI float lx2(float v) { return dpp_f<0x4E>(v); }
DI float lhm(float v) { return dpp_f<0x141>(v); }
DI float lr8(float v) { return dpp_f<0x128>(v); }
DI float sum_x16(float v) { auto s = __builtin_amdgcn_permlane16_swap(__float_as_uint(v), __float_as_uint(v), false, false); return __uint_as_float(s[0]) + __uint_as_float(s[1]); }
DI float sum_x32(float v) { auto s = __builtin_amdgcn_permlane32_swap(__float_as_uint(v), __float_as_uint(v), false, false); return __uint_as_float(s[0]) + __uint_as_float(s[1]); }
DI float max_x16(float v) { auto s = __builtin_amdgcn_permlane16_swap(__float_as_uint(v), __float_as_uint(v), false, false); return fmaxf(__uint_as_float(s[0]), __uint_as_float(s[1])); }
DI float max_x32(float v) { auto s = __builtin_amdgcn_permlane32_swap(__float_as_uint(v), __float_as_uint(v), false, false); return fmaxf(__uint_as_float(s[0]), __uint_as_float(s[1])); }
DI unsigned get_x32(unsigned v, int h) { auto s = __builtin_amdgcn_permlane32_swap(v, v, false, false); return h ? s[0] : s[1]; }
DI float wave_sum(float v) { v += lx1(v); v += lx2(v); v += lhm(v); v += lr8(v); v = sum_x16(v); return sum_x32(v); }
DI float wave_max(float v) { v = fmaxf(v, lx1(v)); v = fmaxf(v, lx2(v)); v = fmaxf(v, lhm(v)); v = fmaxf(v, lr8(v)); v = max_x16(v); return max_x32(v); }
DI int bperm(int v, int srclane) { return __builtin_amdgcn_ds_bpermute(srclane << 2, v); }
DI float bpermf(float v, int srclane) { return __builtin_bit_cast(float, __builtin_amdgcn_ds_bpermute(srclane << 2, __builtin_bit_cast(int, v))); }
DI float gelu_tanh(float x) {
    const float u = 0.7978845608028654f * (x + 0.044715f * x * x * x);
    return x * frcp(1.f + fexp2(-2.f * LOG2E * u));
}
DI float dot2bf(unsigned a, unsigned b, float c) {
    return __builtin_amdgcn_fdot2_f32_bf16(__builtin_bit_cast(bf16x2v, a), __builtin_bit_cast(bf16x2v, b), c, false);
}
DI int rel_bucket_i(int d) {
    if (d < 16) return d < 0 ? 0 : d;
    int b = 16;
    b += d >= 21; b += d >= 27; b += d >= 35; b += d >= 46; b += d >= 59; b += d >= 77; b += d >= 99; b += d >= 128;
    b += d >= 166; b += d >= 216; b += d >= 280; b += d >= 363; b += d >= 470; b += d >= 609; b += d >= 790;
    return b;
}
DI unsigned f2key(float f) { unsigned u = __float_as_uint(f); return u ^ ((unsigned)((int)u >> 31) | 0x80000000u); }
DI float key2f(unsigned k) { unsigned u = (k & 0x80000000u) ? (k ^ 0x80000000u) : ~k; return __uint_as_float(u); }

constexpr int EPI_LDS = 96 * 1024;

DI int sw2(int row, int chunk) { return (row >> 1) * 256 + (((((row & 1) << 3) | chunk) ^ ((row >> 1) & 15)) << 4); }
DI void sw2_src(int P, int& row, int& chunk) { const int R2 = P >> 4, lc = (P & 15) ^ (R2 & 15); row = 2 * R2 + (lc >> 3); chunk = lc & 7; }

template <class T, class = void> struct epi_stash { static constexpr bool value = false, present = false; };
template <class T> struct epi_stash<T, decltype((void)T::STASH)> { static constexpr bool value = T::STASH, present = true; };

template <int MT, class Epi>
DI void gemm_tile(const bf16_t* __restrict__ A, long lda, int M, const bf16_t* __restrict__ Bt, long ldb, int N, int K,
                  int m0, int n0, const Epi& epi, unsigned char* lds, int tid) {
    constexpr int XS = MT * 128 * 128, WS = 256 * 128, STAGE = XS + WS;
    const int lane = tid & 63, w = tid >> 6, tg = w & 3, fh = w >> 2, r = lane & 31, h = lane >> 5;
    const int wbase = tid & ~63;
    unsigned xo[2 * MT], wo[4];
#pragma unroll
    for (int i = 0; i < 2 * MT; ++i) { int row, c; sw2_src(tid + 512 * i, row, c); int m = m0 + row; m = m < M ? m : M - 1; xo[i] = (unsigned)m * (unsigned)(lda * 2) + c * 16; }
#pragma unroll
    for (int i = 0; i < 4; ++i) { int row, c; sw2_src(tid + 512 * i, row, c); int n = n0 + row; n = n < N ? n : N - 1; wo[i] = (unsigned)n * (unsigned)(ldb * 2) + c * 16; }
    const unsigned char* Ab = (const unsigned char*)A;
    const unsigned char* Bb = (const unsigned char*)Bt;
    auto stage = [&](int kt, unsigned char* st) {
#pragma unroll
        for (int i = 0; i < 2 * MT; ++i)
            __builtin_amdgcn_global_load_lds((const unsigned*)(Ab + kt * 128 + xo[i]), (unsigned*)(st + (wbase + 512 * i) * 16), 16, 0, 0);
#pragma unroll
        for (int i = 0; i < 4; ++i)
            __builtin_amdgcn_global_load_lds((const unsigned*)(Bb + kt * 128 + wo[i]), (unsigned*)(st + XS + (wbase + 512 * i) * 16), 16, 0, 0);
    };
    f32x16 acc[MT][4];
#pragma unroll
    for (int s2 = 0; s2 < MT; ++s2)
#pragma unroll
        for (int i = 0; i < 4; ++i)
#pragma unroll
            for (int j = 0; j < 16; ++j) acc[s2][i][j] = 0.f;
    const int nk = K >> 6;
    stage(0, lds);
    __syncthreads();
    for (int kt = 0; kt < nk; ++kt) {
        unsigned char* cur = lds + (kt & 1) * STAGE;
        if (kt + 1 < nk) stage(kt + 1, lds + ((kt + 1) & 1) * STAGE);
        bf16x8 xfa[MT], wfa[4], xfb[MT], wfb[4];
        auto ldf = [&](bf16x8 (&xf)[MT], bf16x8 (&wf)[4], int ks) {
#pragma unroll
            for (int s2 = 0; s2 < MT; ++s2) xf[s2] = *(const bf16x8*)(cur + sw2(32 * MT * tg + 32 * s2 + r, 2 * ks + h));
#pragma unroll
            for (int mt = 0; mt < 4; ++mt) wf[mt] = *(const bf16x8*)(cur + XS + sw2(128 * fh + 32 * mt + r, 2 * ks + h));
        };
        auto mm = [&](const bf16x8 (&xf)[MT], const bf16x8 (&wf)[4]) {
#pragma unroll
            for (int mt = 0; mt < 4; ++mt)
#pragma unroll
                for (int s2 = 0; s2 < MT; ++s2) acc[s2][mt] = MFMA32(wf[mt], xf[s2], acc[s2][mt]);
        };
        ldf(xfa, wfa, 0);
        ldf(xfb, wfb, 1); __builtin_amdgcn_sched_barrier(0); mm(xfa, wfa); __builtin_amdgcn_sched_barrier(0);
        ldf(xfa, wfa, 2); __builtin_amdgcn_sched_barrier(0); mm(xfb, wfb); __builtin_amdgcn_sched_barrier(0);
        ldf(xfb, wfb, 3); __builtin_amdgcn_sched_barrier(0); mm(xfa, wfa); __builtin_amdgcn_sched_barrier(0);
        mm(xfb, wfb);
        __syncthreads();
    }
    if constexpr (MT == 2 && epi_stash<Epi>::value) {
        float* sp = (float*)lds + w * 4096 + lane;
#pragma unroll
        for (int mt = 0; mt < 4; ++mt)
#pragma unroll
            for (int j = 0; j < 16; ++j) sp[(mt * 16 + j) * 64] = acc[1][mt][j];
        epi(acc[0], m0 + 64 * tg + r, n0 + 128 * fh, h, lds, tid);
        f32x16 a2[4];
        const float* sp2 = sp; asm volatile("" : "+v"(sp2));
#pragma unroll
        for (int mt = 0; mt < 4; ++mt)
#pragma unroll
            for (int j = 0; j < 16; ++j) a2[mt][j] = sp2[(mt * 16 + j) * 64];
        epi(a2, m0 + 64 * tg + 32 + r, n0 + 128 * fh, h, lds, tid);
        __syncthreads();
    } else {
        int ho = h, ro = r, to = tid;
        if constexpr (epi_stash<Epi>::present) asm volatile("" : "+v"(ho), "+v"(ro), "+v"(to));
#pragma unroll
        for (int s2 = 0; s2 < MT; ++s2) epi(acc[s2], m0 + 32 * MT * tg + 32 * s2 + ro, n0 + 128 * fh, ho, lds, to);
    }
}

DI void store_vt_tile(bf16_t* base, long rstride, const f32x16& a, int row0, int h, int lane) {
    const bool odd = lane & 1;
#pragma unroll
    for (int rg = 0; rg < 16; rg += 2) {
        const float xa = lx1(a[rg]), xb = lx1(a[rg + 1]);
        const unsigned wv = odd ? pk2(xb, a[rg + 1]) : pk2(a[rg], xa);
        bf16_t* dp = base + (long)(row0 + crow(odd ? rg + 1 : rg, h)) * rstride - (odd ? 1 : 0);
        *(unsigned*)dp = wv;
    }
}
struct EpiQKV0 {
    bf16_t *Q, *Kk, *VT;
    const float *qg, *kg;
    float* MB; const float* relb;
    DI void operator()(const f32x16 (&acc)[4], int tok, int fbase, int h, unsigned char*, int) const {
        const int sec = fbase >> 10, hd = (fbase & 1023) >> 7, b = tok >> 13, s = tok & (SEQ - 1);
        if (sec < 2) {
            const float* gn = sec == 0 ? qg : kg;
            const float sc = sec == 0 ? 0.125f * LOG2E : 1.f;
            bf16_t* dst = sec == 0 ? Q : Kk;
#pragma unroll
            for (int j = 0; j < 2; ++j) {
                float ss = 0.f;
#pragma unroll
                for (int mt = 0; mt < 2; ++mt)
#pragma unroll
                    for (int rg = 0; rg < 16; ++rg) { const float v = acc[2 * j + mt][rg]; ss += v * v; }
                ss = sum_x32(ss);
                const float rstd = rsqrtf(ss * (1.f / 64.f) + EPS) * sc;
                bf16_t* row = dst + ((long)((b * 8 + hd) * 2 + j) * SEQ + s) * 64;
                float qq = 0.f;
#pragma unroll
                for (int mt = 0; mt < 2; ++mt)
#pragma unroll
                    for (int g4 = 0; g4 < 4; ++g4) {
                        const int d0 = 32 * mt + 8 * g4 + 4 * h;
                        const f32x4 gv = *(const f32x4*)(gn + d0);
                        const float v0 = acc[2 * j + mt][4 * g4 + 0] * rstd * gv.x, v1 = acc[2 * j + mt][4 * g4 + 1] * rstd * gv.y;
                        const float v2 = acc[2 * j + mt][4 * g4 + 2] * rstd * gv.z, v3 = acc[2 * j + mt][4 * g4 + 3] * rstd * gv.w;
                        qq += v0 * v0 + v1 * v1 + v2 * v2 + v3 * v3;
                        u32x2 o;
                        o.x = pk2(v0, v1); o.y = pk2(v2, v3);
                        *(u32x2*)(row + d0) = o;
                    }
                if (sec == 0) {
                    qq = sum_x32(qq);
                    float kmx = 0.f;
                    for (int d = 0; d < 64; ++d) kmx = fmaxf(kmx, fabsf(kg[d]));
                    float bmx = 0.f;
                    for (int bk = 0; bk < 32; ++bk) bmx = fmaxf(bmx, relb[bk * 8 + hd] - relb[31 * 8 + hd]);
                    if (h == 0) MB[(long)((b * 8 + hd) * 2 + j) * SEQ + s] = 1.01f * sqrtf(qq) * 8.f * kmx + bmx * LOG2E;
                }
            }
        } else {
            bf16_t* base = VT + (long)(b * 8 + hd) * 128 * SEQ + s;
#pragma unroll
            for (int mt = 0; mt < 4; ++mt) store_vt_tile(base, SEQ, acc[mt], 32 * mt, h, tok);
        }
    }
};

struct EpiResid {
    const float* xin; float* xout; const float* gate;
    DI void operator()(const f32x16 (&acc)[4], int tok, int fbase, int h, unsigned char*, int) const {
        const int b = tok >> 13;
        const float* gp = gate + b * ADA_STRIDE;
#pragma unroll
        for (int mt = 0; mt < 4; ++mt)
#pragma unroll
            for (int g4 = 0; g4 < 4; ++g4) {
                const int f = fbase + 32 * mt + 8 * g4 + 4 * h;
                const f32x4 xv = *(const f32x4*)(xin + (long)tok * DM + f);
                const f32x4 gv = *(const f32x4*)(gp + f);
                f32x4 o;
                o.x = xv.x + gv.x * acc[mt][4 * g4 + 0]; o.y = xv.y + gv.y * acc[mt][4 * g4 + 1];
                o.z = xv.z + gv.z * acc[mt][4 * g4 + 2]; o.w = xv.w + gv.w * acc[mt][4 * g4 + 3];
                *(f32x4*)(xout + (long)tok * DM + f) = o;
                if (g4 == 3) __builtin_amdgcn_sched_barrier(0);
            }
    }
};

struct EpiKV {
    bf16_t *KC, *KS, *VST, *KW, *VWT;
    const float* kgain;
    DI void operator()(const f32x16 (&acc)[4], int tok, int fbase, int h, unsigned char*, int) const {
        const int c = fbase >> 7, br = c >> 2, kv = (c >> 1) & 1, g = c & 1, b = tok >> 13, s = tok & (SEQ - 1);
        if (br == 0 || kv == 0) {
            float rstd = 1.f;
            bf16_t* row;
            if (br == 0) row = KC + ((long)((kv * 4 + b) * 2 + g) * SEQ + s) * 128;
            else {
                float ss = 0.f;
#pragma unroll
                for (int mt = 0; mt < 4; ++mt)
#pragma unroll
                    for (int rg = 0; rg < 16; ++rg) ss += acc[mt][rg] * acc[mt][rg];
                ss = sum_x32(ss);
                rstd = rsqrtf(ss * (1.f / 128.f) + EPS);
                row = (br == 1 ? KS : KW) + ((long)(b * 2 + g) * SEQ + s) * 128;
            }
#pragma unroll
            for (int mt = 0; mt < 4; ++mt)
#pragma unroll
                for (int g4 = 0; g4 < 4; ++g4) {
                    const int d0 = 32 * mt + 8 * g4 + 4 * h;
                    f32x4 gv = {1.f, 1.f, 1.f, 1.f};
                    if (br != 0) gv = *(const f32x4*)(kgain + br * 128 + d0);
                    u32x2 o;
                    o.x = pk2(acc[mt][4 * g4 + 0] * rstd * gv.x, acc[mt][4 * g4 + 1] * rstd * gv.y);
                    o.y = pk2(acc[mt][4 * g4 + 2] * rstd * gv.z, acc[mt][4 * g4 + 3] * rstd * gv.w);
                    *(u32x2*)(row + d0) = o;
                }
        } else {
            bf16_t* base = (br == 1 ? VST : VWT) + (long)(b * 2 + g) * 128 * SEQ + s;
#pragma unroll
            for (int mt = 0; mt < 4; ++mt) store_vt_tile(base, SEQ, acc[mt], 32 * mt, h, tok);
        }
    }
};

struct EpiCmp1 {
    bf16_t* hid; const float* posb_part; const float* b1;
    DI void operator()(const f32x16 (&acc)[4], int tok, int fbase, int h, unsigned char*, int) const {
        if (tok >= 512) return;
#pragma unroll
        for (int mt = 0; mt < 4; ++mt)
#pragma unroll
            for (int g4 = 0; g4 < 4; ++g4) {
                const int f = fbase + 32 * mt + 8 * g4 + 4 * h;
                f32x4 pb = *(const f32x4*)(b1 + f);
                for (int c = 0; c < 16; ++c) { const f32x4 t = *(const f32x4*)(posb_part + c * 256 + f); pb.x += t.x; pb.y += t.y; pb.z += t.z; pb.w += t.w; }
                u32x2 o;
                o.x = pk2(gelu_tanh(acc[mt][4 * g4 + 0] + pb.x), gelu_tanh(acc[mt][4 * g4 + 1] + pb.y));
                o.y = pk2(gelu_tanh(acc[mt][4 * g4 + 2] + pb.z), gelu_tanh(acc[mt][4 * g4 + 3] + pb.w));
                *(u32x2*)(hid + (long)tok * 256 + f) = o;
            }
    }
};

struct EpiCmp2 {
    bf16_t* dst; const float* kgain0; int kv;
    DI void operator()(const f32x16 (&acc)[4], int tok, int fbase, int h, unsigned char*, int) const {
        if (fbase != 0 || tok >= 512) return;
        const float valid = tok < 511 ? 1.f : 0.f;
        if (kv == 0) {
            float ss = 0.f;
#pragma unroll
            for (int mt = 0; mt < 4; ++mt)
#pragma unroll
                for (int rg = 0; rg < 16; ++rg) ss += acc[mt][rg] * acc[mt][rg];
            ss = sum_x32(ss);
            const float rstd = rsqrtf(ss * (1.f / 128.f) + EPS) * valid;
#pragma unroll
            for (int mt = 0; mt < 4; ++mt)
#pragma unroll
                for (int g4 = 0; g4 < 4; ++g4) {
                    const int d0 = 32 * mt + 8 * g4 + 4 * h;
                    const f32x4 gv = *(const f32x4*)(kgain0 + d0);
                    u32x2 o;
                    o.x = pk2(acc[mt][4 * g4 + 0] * rstd * gv.x, acc[mt][4 * g4 + 1] * rstd * gv.y);
                    o.y = pk2(acc[mt][4 * g4 + 2] * rstd * gv.z, acc[mt][4 * g4 + 3] * rstd * gv.w);
                    *(u32x2*)(dst + (long)tok * 128 + d0) = o;
                }
        } else {
#pragma unroll
            for (int mt = 0; mt < 4; ++mt)
#pragma unroll
                for (int rg = 0; rg < 16; ++rg) dst[(long)(32 * mt + crow(rg, h)) * 512 + tok] = f2bf(acc[mt][rg] * valid);
        }
    }
};

struct EpiNsaQ {
    bf16_t* QN; float* gates; const float* qgain; const float* bgate; float* qnrm;
    DI void operator()(const f32x16 (&acc)[4], int tok, int fbase, int h, unsigned char*, int) const {
        const int b = tok >> 13, s = tok & (SEQ - 1);
        if (fbase < 1024) {
            const int head = fbase >> 7;
            float ss = 0.f;
#pragma unroll
            for (int mt = 0; mt < 4; ++mt)
#pragma unroll
                for (int rg = 0; rg < 16; ++rg) ss += acc[mt][rg] * acc[mt][rg];
            ss = sum_x32(ss);
            const float rstd = rsqrtf(ss * (1.f / 128.f) + EPS) * (0.08838834764831845f * LOG2E);
            bf16_t* row = QN + ((long)(b * 8 + head) * SEQ + s) * 128;
            float qq = 0.f;
#pragma unroll
            for (int mt = 0; mt < 4; ++mt)
#pragma unroll
                for (int g4 = 0; g4 < 4; ++g4) {
                    const int d0 = 32 * mt + 8 * g4 + 4 * h;
                    const f32x4 gv = *(const f32x4*)(qgain + d0);
                    const float v0 = acc[mt][4 * g4 + 0] * rstd * gv.x, v1 = acc[mt][4 * g4 + 1] * rstd * gv.y;
                    const float v2 = acc[mt][4 * g4 + 2] * rstd * gv.z, v3 = acc[mt][4 * g4 + 3] * rstd * gv.w;
                    qq += v0 * v0 + v1 * v1 + v2 * v2 + v3 * v3;
                    u32x2 o;
                    o.x = pk2(v0, v1); o.y = pk2(v2, v3);
                    *(u32x2*)(row + d0) = o;
                }
            qq = sum_x32(qq);
            if (h == 0) qnrm[(long)tok * 8 + head] = 1.01f * sqrtf(qq);
        } else if (fbase == 1024) {
#pragma unroll
            for (int rg = 0; rg < 16; ++rg) {
                const int f = crow(rg, h);
                if (f < 24) { const float z = acc[0][rg] + bgate[f]; gates[(long)tok * 24 + f] = frcp(1.f + fexp2(-LOG2E * z)); }
            }
        }
    }
};

DI void ce_desc(unsigned& a, unsigned& b) { const unsigned hi = a > b ? a : b, lo = a > b ? b : a; a = hi; b = lo; }
DI void sort16_desc(unsigned (&a)[16]) {
#pragma unroll
    for (int k = 2; k <= 16; k <<= 1)
#pragma unroll
        for (int j = k >> 1; j > 0; j >>= 1)
#pragma unroll
            for (int i = 0; i < 16; ++i) {
                const int l = i ^ j;
                if (l > i) { if ((i & k) == 0 || k == 16) ce_desc(a[i], a[l]); else ce_desc(a[l], a[i]); }
            }
}
DI void bitonic_merge16_desc(unsigned (&a)[16]) {
#pragma unroll
    for (int st = 8; st >= 1; st >>= 1)
#pragma unroll
        for (int i = 0; i < 16; ++i)
            if ((i & st) == 0) ce_desc(a[i], a[i + st]);
}
DI void merge_top16(unsigned (&a)[16], const unsigned (&b)[16]) {
#pragma unroll
    for (int i = 0; i < 16; ++i) a[i] = a[i] > b[15 - i] ? a[i] : b[15 - i];
    bitonic_merge16_desc(a);
}

struct EpiPeer {
    static constexpr bool STASH = false;
    int* ridx; float* rgate; int ex_off;
    DI void operator()(const f32x16 (&acc)[4], int tok, int fbase, int h, unsigned char* lds, int tid) const {
        const int lane = tid & 63, w = tid >> 6, tg = w & 3, fh = w >> 2, r = lane & 31;
        const int hd = fbase >> 8;
        unsigned* EX = (unsigned*)(lds + ex_off);
        unsigned L[16];
        {
            unsigned G1[16], G2[16], G3[16];
#pragma unroll
            for (int rg = 0; rg < 16; ++rg) {
                const int c = crow(rg, h);
                L[rg] = (f2key(acc[0][rg]) & ~127u) | (unsigned)(127 - c);
                G1[rg] = (f2key(acc[1][rg]) & ~127u) | (unsigned)(127 - 32 - c);
                G2[rg] = (f2key(acc[2][rg]) & ~127u) | (unsigned)(127 - 64 - c);
                G3[rg] = (f2key(acc[3][rg]) & ~127u) | (unsigned)(127 - 96 - c);
            }
            sort16_desc(L); sort16_desc(G1); merge_top16(L, G1);
            sort16_desc(G2); sort16_desc(G3); merge_top16(G2, G3);
            merge_top16(L, G2);
        }
        {
            unsigned P[16];
#pragma unroll
            for (int i = 0; i < 16; ++i) P[i] = get_x32(L[i], h);
            merge_top16(L, P);
        }
        if (h == 0) {
#pragma unroll
            for (int i = 0; i < 16; i += 4) *(u32x4*)(EX + ((fh * 4 + tg) * 32 + r) * 16 + i) = (u32x4){L[i], L[i + 1], L[i + 2], L[i + 3]};
        }
        __syncthreads();
        float xf[4], ys[16];
        {
            const unsigned* l0 = EX + ((0 * 4 + tg) * 32 + r) * 16;
            const unsigned* l1 = EX + ((1 * 4 + tg) * 32 + r) * 16;
            const unsigned* px = h ? l1 : l0;
            const unsigned* py = h ? l0 : l1;
            const u32x4 a = *(const u32x4*)px;
            xf[0] = key2f(a.x & ~127u); xf[1] = key2f(a.y & ~127u); xf[2] = key2f(a.z & ~127u); xf[3] = key2f(a.w & ~127u);
            unsigned Y[16];
#pragma unroll
            for (int i = 0; i < 16; i += 4) { const u32x4 b2 = *(const u32x4*)(py + i); Y[i] = b2.x; Y[i + 1] = b2.y; Y[i + 2] = b2.z; Y[i + 3] = b2.w; }
#pragma unroll
            for (int k = 0; k < 15; ++k) ys[k] = key2f((h ? Y[k + 1] : Y[k]) & ~127u);
            ys[15] = key2f(Y[15] & ~127u);
        }
        auto pkey = [&](int i, int k) -> unsigned {
            const float fs = xf[i] + ys[k];
            const unsigned code = h ? (unsigned)((((k + 1) & 15) << 4) | i) : (unsigned)((i << 4) | k);
            return (f2key(fs) & ~255u) | (255u - code);
        };
        unsigned T[16], E[16];
#pragma unroll
        for (int k = 0; k < 16; ++k) T[k] = pkey(0, k);
        T[15] = h ? 0u : T[15];
#pragma unroll
        for (int k = 1; k <= 7; ++k) E[k - 1] = pkey(1, k);
#pragma unroll
        for (int k = 2; k <= 4; ++k) E[7 + k - 2] = pkey(2, k);
        E[10] = pkey(3, 3);
#pragma unroll
        for (int k = 11; k < 16; ++k) E[k] = 0u;
        sort16_desc(E);
        merge_top16(T, E);
        {
            unsigned P[16];
#pragma unroll
            for (int i = 0; i < 16; ++i) P[i] = get_x32(T[i], h);
            merge_top16(T, P);
        }
        float sc[16], sum = 0.f;
        const float mx = key2f(T[0] & ~255u);
#pragma unroll
        for (int k = 0; k < 16; ++k) { sc[k] = fexp2((key2f(T[k] & ~255u) - mx) * LOG2E); sum += sc[k]; }
        const float inv = frcp(sum);
        if (h == 0) {
            const unsigned* l0 = EX + ((0 * 4 + tg) * 32 + r) * 16;
            const unsigned* l1 = EX + ((1 * 4 + tg) * 32 + r) * 16;
#pragma unroll
            for (int k = 0; k < 16; ++k) {
                if ((k >> 3) != fh) continue;
                const unsigned code = 255u - (T[k] & 255u);
                const int i1 = 127 - (int)(l0[code >> 4] & 127u), i2 = 127 - (int)(l1[code & 15u] & 127u);
                ridx[(long)tok * 128 + hd * 16 + k] = i1 * 128 + i2;
                rgate[(long)tok * 128 + hd * 16 + k] = sc[k] * inv;
            }
        }
        __syncthreads();
    }
};

DI void p0_transpose_item(const float* __restrict__ W, int K, int N, bf16_t* __restrict__ WT, int item, int ntn, unsigned char* lds, int tid) {
    float* tile = (float*)lds;
    const int kb = item / ntn, nb = item % ntn, k0 = kb * 64, n0 = nb * 64;
    {
        const int nn = tid & 63, kk0 = tid >> 6;
#pragma unroll
        for (int i = 0; i < 8; ++i) { const int kk = kk0 + 8 * i; const int n = n0 + nn; tile[kk * 65 + nn] = n < N ? W[(long)(k0 + kk) * N + n] : 0.f; }
    }
    __syncthreads();
    {
        const int n = tid >> 3, c = tid & 7;
        const float* s = tile + (8 * c) * 65 + n;
        u32x4 o;
        o.x = pk2(s[0], s[65]); o.y = pk2(s[2 * 65], s[3 * 65]); o.z = pk2(s[4 * 65], s[5 * 65]); o.w = pk2(s[6 * 65], s[7 * 65]);
        *(u32x4*)(WT + (long)(n0 + n) * K + k0 + 8 * c) = o;
    }
    __syncthreads();
}

DI int pack_i8x4(float a, float b, float c, float d) {
    const int ia = __float2int_rn(a), ib = __float2int_rn(b), ic = __float2int_rn(c), id = __float2int_rn(d);
    return (ia & 255) | ((ib & 255) << 8) | ((ic & 255) << 16) | (id << 24);
}
DI void p0_fp8_item(const float* __restrict__ src, unsigned char* __restrict__ dst, float* __restrict__ sinv, bool sliced, int item, int tid) {
    const int lane = tid & 63, row = item * 8 + (tid >> 6);
    const float* rp = src + (long)row * 1024;
    f32x4 v[4]; float am = 0.f;
#pragma unroll
    for (int j = 0; j < 4; ++j) {
        v[j] = *(const f32x4*)(rp + 4 * lane + 256 * j);
        am = fmaxf(am, fmaxf(fmaxf(fabsf(v[j].x), fabsf(v[j].y)), fmaxf(fabsf(v[j].z), fabsf(v[j].w))));
    }
    am = wave_max(am);
    const float sc = sliced ? (am > 0.f ? exp2f(floorf(log2f(384.f / am))) : 1.f) : (am > 0.f ? 127.f / am : 1.f);
    if (lane == 0) sinv[row] = 1.f / sc;
#pragma unroll
    for (int j = 0; j < 4; ++j) {
        int pk = 0;
        if (sliced) {
            pk = __builtin_amdgcn_cvt_pk_fp8_f32(v[j].x * sc, v[j].y * sc, pk, false);
            pk = __builtin_amdgcn_cvt_pk_fp8_f32(v[j].z * sc, v[j].w * sc, pk, true);
        } else pk = pack_i8x4(v[j].x * sc, v[j].y * sc, v[j].z * sc, v[j].w * sc);
        const int col = 4 * lane + 256 * j;
        unsigned char* d = sliced ? dst + ((long)(col >> 7) * 16384 + row) * 128 + (col & 127) : dst + (long)row * 1024 + col;
        *(int*)d = pk;
    }
}

DI void p0_weff_item(const float* __restrict__ wq, const float* __restrict__ subk, bf16_t* __restrict__ WT, int item, unsigned char* lds, int tid) {
    const int layer = item >> 8, g = (item >> 4) & 15, ct = item & 15, p = g & 1, c0 = ct * 64;
    float* As = (float*)lds;
    float* Bs = As + 64 * 129;
    const float* wql = wq + (long)layer * 1024 * 2048;
    const float* sk = subk + ((long)layer * 2 + p) * 128 * 128;
    for (int e = tid; e < 64 * 128; e += NTHREADS) { const int c = e >> 7, d = e & 127; As[c * 129 + d] = wql[(long)(c0 + c) * 2048 + g * 128 + d]; }
    for (int e = tid; e < 128 * 128; e += NTHREADS) { const int k = e >> 7, d = e & 127; Bs[k * 129 + d] = sk[k * 128 + d]; }
    __syncthreads();
    const int k = tid & 127, cg4 = tid >> 7;
    float acc[16];
#pragma unroll
    for (int i = 0; i < 16; ++i) acc[i] = 0.f;
    for (int d = 0; d < 128; ++d) {
        const float bv = Bs[k * 129 + d];
#pragma unroll
        for (int i = 0; i < 16; ++i) acc[i] += As[(cg4 * 16 + i) * 129 + d] * bv;
    }
    bf16_t* o = WT + ((long)layer * 2048 + g * 128 + k) * 1024 + c0 + cg4 * 16;
    u32x4 o0, o1;
    o0.x = pk2(acc[0], acc[1]); o0.y = pk2(acc[2], acc[3]); o0.z = pk2(acc[4], acc[5]); o0.w = pk2(acc[6], acc[7]);
    o1.x = pk2(acc[8], acc[9]); o1.y = pk2(acc[10], acc[11]); o1.z = pk2(acc[12], acc[13]); o1.w = pk2(acc[14], acc[15]);
    *(u32x4*)o = o0; *(u32x4*)(o + 8) = o1;
    __syncthreads();
}

DI void p0_posb_item(const float* __restrict__ pos, const float* __restrict__ w1, float* __restrict__ part, int item, unsigned char* lds, int tid) {
    const int kv = item >> 4, ch = item & 15;
    float* red = (float*)lds;
    const int j = tid & 255, half = tid >> 8;
    const float* pp = pos + (long)kv * 4096 + ch * 256 + half * 128;
    const float* ww = w1 + ((long)kv * 4096 + ch * 256 + half * 128) * 256 + j;
    float a = 0.f;
    for (int f = 0; f < 128; ++f) a += pp[f] * ww[(long)f * 256];
    red[half * 256 + j] = a;
    __syncthreads();
    if (tid < 256) part[(kv * 16 + ch) * 256 + tid] = red[tid] + red[256 + tid];
    __syncthreads();
}

DI void p0_ada_item(const Params& p, float* __restrict__ ada, int item, unsigned char* lds, int tid) {
    float* cact = (float*)lds;
    float* red = cact + 4096;
    const float* c = p.in[1];
    for (int e = tid; e < 4096; e += NTHREADS) { const float v = c[e]; cact[e] = v * frcp(1.f + fexp2(-LOG2E * v)); }
    __syncthreads();
    const int colg = item * 64;
    const float* W; const float* bias; int N, n0;
    if (colg < 6144) { W = p.in[3]; bias = p.in[4]; N = 6144; n0 = colg; }
    else if (colg < 12288) { W = p.in[3] + (long)1024 * 6144; bias = p.in[4] + 6144; N = 6144; n0 = colg - 6144; }
    else { W = p.in[14]; bias = p.in[15]; N = 2048; n0 = colg - 12288; }
    const int col = tid & 63, kg = tid >> 6;
    float a0 = 0.f, a1 = 0.f, a2 = 0.f, a3 = 0.f;
    const float* wp = W + (long)(kg * 128) * N + n0 + col;
#pragma unroll 8
    for (int k = 0; k < 128; ++k) {
        const float wv = wp[(long)k * N];
        const int kk = kg * 128 + k;
        a0 += cact[kk] * wv; a1 += cact[1024 + kk] * wv; a2 += cact[2048 + kk] * wv; a3 += cact[3072 + kk] * wv;
    }
    red[(kg * 4 + 0) * 64 + col] = a0; red[(kg * 4 + 1) * 64 + col] = a1; red[(kg * 4 + 2) * 64 + col] = a2; red[(kg * 4 + 3) * 64 + col] = a3;
    __syncthreads();
    if (tid < 256) {
        const int b = tid >> 6, cc = tid & 63;
        float s = bias[n0 + cc];
#pragma unroll
        for (int q = 0; q < 8; ++q) s += red[(q * 4 + b) * 64 + cc];
        ada[b * ADA_STRIDE + colg + cc] = s;
    }
    __syncthreads();
}

constexpr int P0_CONV = 8192, P0_TR_DIN = 768, P0_TR_DOUT = 256, P0_TR_KV = 384, P0_TR_NIN = 288, P0_TR_NOUT = 256, P0_TR_C1 = 512, P0_TR_C2 = 16,
              P0_WEFF = 512, P0_POSB = 32, P0_ADA = 224;
constexpr int P0_TOTAL = P0_CONV + P0_TR_DIN + P0_TR_DOUT + P0_TR_KV + P0_TR_NIN + P0_TR_NOUT + P0_TR_C1 + P0_TR_C2 + P0_WEFF + P0_POSB + P0_ADA;

DI void phase_prep(const Params& p, unsigned char* lds, int tid) {
    unsigned char* ws = p.ws;
    for (int it = blockIdx.x; it < P0_TOTAL; it += gridDim.x) {
        int r = it;
        if (r < P0_ADA) { p0_ada_item(p, (float*)(ws + OFF_ADA), r, lds, tid); continue; } r -= P0_ADA;
        if (r < P0_WEFF) { p0_weff_item(p.in[26], p.in[27], (bf16_t*)(ws + OFF_WT_PEER), r, lds, tid); continue; } r -= P0_WEFF;
        if (r < P0_POSB) { p0_posb_item(p.in[17], p.in[18], (float*)(ws + OFF_POSB), r, lds, tid); continue; } r -= P0_POSB;
        if (r < P0_TR_DIN) { p0_transpose_item(p.in[7], 1024, 3072, (bf16_t*)(ws + OFF_WT_DIN), r, 48, lds, tid); continue; } r -= P0_TR_DIN;
        if (r < P0_TR_DOUT) { p0_transpose_item(p.in[8], 1024, 1024, (bf16_t*)(ws + OFF_WT_DOUT), r, 16, lds, tid); continue; } r -= P0_TR_DOUT;
        if (r < P0_TR_KV) { p0_transpose_item(p.in[16], 1024, 1536, (bf16_t*)(ws + OFF_WT_KV), r, 24, lds, tid); continue; } r -= P0_TR_KV;
        if (r < P0_TR_NIN) { p0_transpose_item(p.in[22], 1024, 1048, (bf16_t*)(ws + OFF_WT_NIN), r, 18, lds, tid); continue; } r -= P0_TR_NIN;
        if (r < P0_TR_NOUT) { p0_transpose_item(p.in[24], 1024, 1024, (bf16_t*)(ws + OFF_WT_NOUT), r, 16, lds, tid); continue; } r -= P0_TR_NOUT;
        if (r < P0_TR_C1) { const int kv = r >> 8; p0_transpose_item(p.in[18] + (long)kv * 4096 * 256, 4096, 256, (bf16_t*)(ws + OFF_WT_C1) + (long)kv * 256 * 4096, r & 255, 4, lds, tid); continue; } r -= P0_TR_C1;
        if (r < P0_TR_C2) { const int kv = r >> 3; p0_transpose_item(p.in[20] + (long)kv * 256 * 128, 256, 128, (bf16_t*)(ws + OFF_WT_C2) + (long)kv * 128 * 256, r & 7, 2, lds, tid); continue; } r -= P0_TR_C2;
        {
            const int tbl = r >> 11, sub = r & 2047;
            const int layer = tbl & 1;
            const float* src = (tbl < 2 ? p.in[28] : p.in[29]) + (long)layer * 16384 * 1024;
            unsigned char* dst = ws + (tbl < 2 ? OFF_PU : OFF_PV) + (long)layer * 16384 * 1024;
            float* sinv = (float*)(ws + (tbl < 2 ? OFF_USI : OFF_VSI)) + layer * 16384;
            p0_fp8_item(src, dst, sinv, tbl >= 2, sub, tid);
        }
    }
}

DI void norm_row_write(const f32x4 (&v)[4], float rstd, const float* gain, const float* shift, const float* scale, bf16_t* orow, int lane) {
#pragma unroll
    for (int j = 0; j < 4; ++j) {
        const int c = 4 * lane + 256 * j;
        const f32x4 g = *(const f32x4*)(gain + c), sh = *(const f32x4*)(shift + c), sc = *(const f32x4*)(scale + c);
        u32x2 o;
        o.x = pk2(v[j].x * rstd * g.x * (1.f + sc.x) + sh.x, v[j].y * rstd * g.y * (1.f + sc.y) + sh.y);
        o.y = pk2(v[j].z * rstd * g.z * (1.f + sc.z) + sh.z, v[j].w * rstd * g.w * (1.f + sc.w) + sh.w);
        *(u32x2*)(orow + c) = o;
    }
}
template <bool BF>
DI void phase_norm_q8(const float* __restrict__ x, bf16_t* __restrict__ out, unsigned char* __restrict__ out8, float* __restrict__ outs,
                      const float* gain, const float* ada, int shift_off, int scale_off, int tid) {
    const int lane = tid & 63, gw = blockIdx.x * NWAVES + (tid >> 6), nw = gridDim.x * NWAVES;
    for (int tok = gw; tok < NTOK; tok += nw) {
        const int b = tok >> 13;
        f32x4 v[4]; float ss = 0.f;
#pragma unroll
        for (int j = 0; j < 4; ++j) { v[j] = *(const f32x4*)(x + (long)tok * DM + 4 * lane + 256 * j); ss += v[j].x * v[j].x + v[j].y * v[j].y + v[j].z * v[j].z + v[j].w * v[j].w; }
        const float rstd = rsqrtf(wave_sum(ss) * (1.f / DM) + EPS);
        const float* shift = ada + b * ADA_STRIDE + shift_off; const float* scale = ada + b * ADA_STRIDE + scale_off;
        float am = 0.f;
#pragma unroll
        for (int j = 0; j < 4; ++j) {
            const int c = 4 * lane + 256 * j;
            const f32x4 g = *(const f32x4*)(gain + c), sh = *(const f32x4*)(shift + c), sc = *(const f32x4*)(scale + c);
            v[j].x = v[j].x * rstd * g.x * (1.f + sc.x) + sh.x; v[j].y = v[j].y * rstd * g.y * (1.f + sc.y) + sh.y;
            v[j].z = v[j].z * rstd * g.z * (1.f + sc.z) + sh.z; v[j].w = v[j].w * rstd * g.w * (1.f + sc.w) + sh.w;
            if constexpr (BF) { u32x2 o; o.x = pk2(v[j].x, v[j].y); o.y = pk2(v[j].z, v[j].w); *(u32x2*)(out + (long)tok * DM + c) = o; }
            am = fmaxf(am, fmaxf(fmaxf(fabsf(v[j].x), fabsf(v[j].y)), fmaxf(fabsf(v[j].z), fabsf(v[j].w))));
        }
        am = wave_max(am);
        const float qs = am > 0.f ? 127.f / am : 1.f;
#pragma unroll
        for (int j = 0; j < 4; ++j) *(int*)(out8 + (long)tok * DM + 4 * lane + 256 * j) = pack_i8x4(v[j].x * qs, v[j].y * qs, v[j].z * qs, v[j].w * qs);
        if (lane == 0) outs[tok] = am > 0.f ? am * (1.f / 127.f) : 1.f;
    }
}
DI void phase_norm(const float* __restrict__ x, bf16_t* __restrict__ out, const float* gain, const float* ada, int shift_off, int scale_off, int tid) {
    const int lane = tid & 63, gw = blockIdx.x * NWAVES + (tid >> 6), nw = gridDim.x * NWAVES;
    for (int tok = gw; tok < NTOK; tok += nw) {
        const int b = tok >> 13;
        f32x4 v[4]; float ss = 0.f;
#pragma unroll
        for (int j = 0; j < 4; ++j) { v[j] = *(const f32x4*)(x + (long)tok * DM + 4 * lane + 256 * j); ss += v[j].x * v[j].x + v[j].y * v[j].y + v[j].z * v[j].z + v[j].w * v[j].w; }
        const float rstd = rsqrtf(wave_sum(ss) * (1.f / DM) + EPS);
        norm_row_write(v, rstd, gain, ada + b * ADA_STRIDE + shift_off, ada + b * ADA_STRIDE + scale_off, out + (long)tok * DM, lane);
    }
}

DI int kidx(int mt, int i) { return 32 * mt + 16 * (i >> 3) + (i & 7); }
template <int DQK>
DI void attn_qk32(const unsigned char* Ks, const bf16x8 (&qf)[DQK / 16], f32x16& st, int mt, int r, int h, float init = 0.f) {
    constexpr int RB = DQK * 2, MSK = DQK == 64 ? 7 : 15;
    const int row = 32 * mt + ((r & 0x13) | ((r & 4) << 1) | ((r & 8) >> 1));
#pragma unroll
    for (int i = 0; i < 16; ++i) st[i] = init;
#pragma unroll
    for (int ks = 0; ks < DQK / 16; ++ks) {
        const bf16x8 kf = RB == 128 ? *(const bf16x8*)(Ks + sw2(row, 2 * ks + h)) : *(const bf16x8*)(Ks + row * RB + (((2 * ks + h) ^ (row & MSK)) << 4));
        st = MFMA32(kf, qf[ks], st);
    }
}
DI void attn_pack32(const f32x16& st, bf16x8 (&pf)[2]) {
#pragma unroll
    for (int s = 0; s < 2; ++s) {
        u32x4 t;
        t.x = pk2(st[8 * s + 0], st[8 * s + 1]); t.y = pk2(st[8 * s + 2], st[8 * s + 3]);
        t.z = pk2(st[8 * s + 4], st[8 * s + 5]); t.w = pk2(st[8 * s + 6], st[8 * s + 7]);
        pf[s] = __builtin_bit_cast(bf16x8, t);
    }
}
DI void attn_softmax32(f32x16& st, float& m, float& l, f32x16 (&o)[4]) {
    float mx = st[0];
#pragma unroll
    for (int i = 1; i < 16; ++i) mx = fmaxf(mx, st[i]);
    mx = max_x32(mx);
    const float mn = fmaxf(m, mx);
    if (!__all(mn == m)) {
        const float alpha = fexp2(m - mn);
        l *= alpha;
#pragma unroll
        for (int dt = 0; dt < 4; ++dt)
#pragma unroll
            for (int i = 0; i < 16; ++i) o[dt][i] *= alpha;
        m = mn;
    }
    float sum = 0.f;
#pragma unroll
    for (int i = 0; i < 16; ++i) { const float pv = fexp2(st[i] - m); st[i] = pv; sum += pv; }
    l += sum;
}
DI void attn_softmax32_b(f32x16& st, float& l) {
    float sum = 0.f;
#pragma unroll
    for (int i = 0; i < 16; ++i) { const float pv = fexp2(st[i]); st[i] = pv; sum += pv; }
    l += sum;
}
DI void attn_pv32(const unsigned char* Vs, const bf16x8 (&pf)[2], f32x16 (&o)[4], int mt, int r, int h) {
#pragma unroll
    for (int dt = 0; dt < 4; ++dt)
#pragma unroll
        for (int s2 = 0; s2 < 2; ++s2) {
            const int row = 32 * dt + r;
            const bf16x8 vf = *(const bf16x8*)(Vs + sw2(row, 2 * (2 * mt + s2) + h));
            o[dt] = MFMA32(vf, pf[s2], o[dt]);
        }
}
template <int RB, int NROWS>
DI void dma_offsets(unsigned (&off)[NROWS * RB / 16 / 512], unsigned gstride, int tid) {
    constexpr int CPR = RB / 16;
#pragma unroll
    for (int i = 0; i < NROWS * CPR / 512; ++i) {
        const int idx = tid + 512 * i;
        int row, cp;
        if (RB == 128) sw2_src(idx, row, cp); else { row = idx / CPR; cp = (idx % CPR) ^ (row & (CPR - 1)); }
        off[i] = (unsigned)row * gstride + (cp << 4);
    }
}
template <int N>
DI void dma_issue(unsigned char* dst, const unsigned char* gbase, const unsigned (&off)[N], int tid) {
    const int wbase = tid & ~63;
#pragma unroll
    for (int i = 0; i < N; ++i)
        __builtin_amdgcn_global_load_lds((const unsigned*)(gbase + off[i]), (unsigned*)(dst + (wbase + 512 * i) * 16), 16, 0, 0);
}

constexpr int AT_STAGE = 32 * 1024;
constexpr int AT_LUT = 2 * AT_STAGE;
constexpr int LUT_N = 1280, LUT_OFF = 1100;
constexpr int LUTC_W = 52;
constexpr int AT_LUTC = AT_LUT + 20 * 1024;
constexpr int AT_IMP = AT_LUTC + 13 * 1024;
constexpr int AT_SEL = AT_IMP + 34 * 1024;

DI void phase_diff_attn(const Params& p, unsigned char* lds, int tid) {
    unsigned char* ws = p.ws;
    const bf16_t* Q = (const bf16_t*)(ws + OFF_Q0);
    const bf16_t* Kk = (const bf16_t*)(ws + OFF_K0);
    const bf16_t* VT = (const bf16_t*)(ws + OFF_VT0);
    bf16_t* O = (bf16_t*)(ws + OFF_H);
    const float* relb = p.in[2];
    const float* lam = p.in[9];
    const float* subln = p.in[12];
    const int lane = tid & 63, w = tid >> 6, comp = w & 1, qg = w >> 1, r = lane & 31, h = lane >> 5;
    float* lut = (float*)(lds + 128 * 1024);
    float lam_full;
    {
        float s01 = 0.f, s23 = 0.f;
        for (int i = 0; i < 64; ++i) { s01 += lam[i] * lam[64 + i]; s23 += lam[128 + i] * lam[192 + i]; }
        lam_full = __expf(s01) - __expf(s23) + 0.2f;
    }
    const int G = gridDim.x, rows_per_it = G >> 5;
    unsigned koff[1], voff[2];
    dma_offsets<128, 64>(koff, 128, tid);
    dma_offsets<128, 128>(voff, SEQ * 2, tid);
    constexpr int ST2 = 64 * 1024;
    for (int it = 0;; ++it) {
        int qb, b, hd;
        if (G == 256) {
            if (it >= 8) break;
            const int xcd = blockIdx.x & 7, lb = blockIdx.x >> 3, pr = xcd * 4 + (it >> 1);
            qb = (it & 1) ? lb : 63 - lb; b = pr >> 3; hd = pr & 7;
        } else {
            int u;
            if ((G & 31) == 0) {
                const int rr = blockIdx.x >> 5, cc = blockIdx.x & 31;
                const int rowi = it * rows_per_it + ((it & 1) ? rows_per_it - 1 - rr : rr);
                u = rowi * 32 + cc;
            } else u = it * G + blockIdx.x;
            if (u >= 2048) break;
            qb = 63 - (u >> 5); b = (u & 31) >> 3; hd = u & 7;
        }
        const int q0 = qb * 128, ntiles = qb + 1;
        const int qpos = q0 + 32 * qg + r, qlo = q0 + 32 * qg, qhi = qlo + 31;
        for (int e = tid; e < LUT_N; e += NTHREADS) { const int d = LUT_OFF - e; lut[e] = d < 0 ? -INFINITY : (d >= 790 ? 0.f : (relb[rel_bucket_i(d) * 8 + hd] - relb[31 * 8 + hd]) * LOG2E); }
        bf16x8 qf[4];
        {
            const bf16_t* qrow = Q + ((long)((b * 8 + hd) * 2 + comp) * SEQ + qpos) * 64;
#pragma unroll
            for (int ks = 0; ks < 4; ++ks) qf[ks] = *(const bf16x8*)(qrow + 16 * ks + 8 * h);
        }
        const unsigned char* k0g = (const unsigned char*)(Kk + (long)((b * 8 + hd) * 2 + 0) * SEQ * 64);
        const unsigned char* k1g = (const unsigned char*)(Kk + (long)((b * 8 + hd) * 2 + 1) * SEQ * 64);
        const unsigned char* vtg = (const unsigned char*)(VT + (long)(b * 8 + hd) * 128 * SEQ);
        f32x16 o[4];
#pragma unroll
        for (int dt = 0; dt < 4; ++dt)
#pragma unroll
            for (int i = 0; i < 16; ++i) o[dt][i] = 0.f;
        float l = 0.f;
        const float nmb = -((const float*)(ws + OFF_MB0))[(long)((b * 8 + hd) * 2 + comp) * SEQ + qpos];
        auto stage = [&](int kt, unsigned char* st) {
#pragma unroll
            for (int sb = 0; sb < 2; ++sb) {
                dma_issue(st + sb * 8192, k0g + (long)(2 * kt + sb) * 8192, koff, tid);
                dma_issue(st + 16384 + sb * 8192, k1g + (long)(2 * kt + sb) * 8192, koff, tid);
                dma_issue(st + 32768 + sb * 16384, vtg + (long)(2 * kt + sb) * 128, voff, tid);
            }
        };
        stage(0, lds);
        __syncthreads();
        for (int kt = 0; kt < ntiles; ++kt) {
            unsigned char* cur = lds + (kt & 1) * ST2;
            if (kt + 1 < ntiles) stage(kt + 1, lds + ((kt + 1) & 1) * ST2);
            const bool nearb = qlo - (kt * 128 + 127) < 790;
            const int dbase0 = qpos - kt * 128 - 8 * h;
            const unsigned char* kb = cur + comp * 16384;
            f32x16 sa, sbv;
            attn_qk32<64>(kb, qf, sa, 0, r, h, nmb);
#pragma unroll
            for (int j = 0; j < 4; ++j) {
                f32x16& sc = (j & 1) ? sbv : sa;
                f32x16& sn = (j & 1) ? sa : sbv;
                if (j < 3) attn_qk32<64>(kb + ((j + 1) >> 1) * 8192, qf, sn, (j + 1) & 1, r, h, nmb);
                if (nearb) {
                    const float* lp = lut + (LUT_OFF - dbase0 + 64 * (j >> 1));
#pragma unroll
                    for (int i = 0; i < 16; ++i) sc[i] += lp[kidx(j & 1, i)];
                }
                attn_softmax32_b(sc, l);
                bf16x8 pf[2];
                attn_pack32(sc, pf);
                attn_pv32(cur + 32768 + (j >> 1) * 16384, pf, o, j & 1, r, h);
            }
            __syncthreads();
        }
        l = sum_x32(l);
        const float inv = l > 0.f ? frcp(l) : 0.f;
        float* xch = (float*)lds + qg * 4096;
        if (comp == 1) {
            const float sc = inv * lam_full;
#pragma unroll
            for (int dt = 0; dt < 4; ++dt)
#pragma unroll
                for (int i = 0; i < 16; ++i) xch[(dt * 16 + i) * 64 + lane] = o[dt][i] * sc;
        }
        __syncthreads();
        if (comp == 0) {
            float ss = 0.f;
#pragma unroll
            for (int dt = 0; dt < 4; ++dt)
#pragma unroll
                for (int i = 0; i < 16; ++i) { const float v = o[dt][i] * inv - xch[(dt * 16 + i) * 64 + lane]; o[dt][i] = v; ss += v * v; }
            ss = sum_x32(ss);
            const float rstd = rsqrtf(ss * (1.f / 128.f) + EPS) * 0.8f;
            bf16_t* orow = O + (long)(b * SEQ + qpos) * DM + hd * 128;
#pragma unroll
            for (int dt = 0; dt < 4; ++dt)
#pragma unroll
                for (int g4 = 0; g4 < 4; ++g4) {
                    const int d0 = 32 * dt + 8 * g4 + 4 * h;
                    const f32x4 gv = *(const f32x4*)(subln + d0);
                    u32x2 ov;
                    ov.x = pk2(o[dt][4 * g4 + 0] * rstd * gv.x, o[dt][4 * g4 + 1] * rstd * gv.y);
                    ov.y = pk2(o[dt][4 * g4 + 2] * rstd * gv.z, o[dt][4 * g4 + 3] * rstd * gv.w);
                    *(u32x2*)(orow + d0) = ov;
                }
        }
        __syncthreads();
    }
}

template <int VAR>
DI void phase_nsa_attn(const Params& p, unsigned char* lds, int tid) {
    unsigned char* ws = p.ws;
    const bf16_t* QN = (const bf16_t*)(ws + OFF_QN);
    const bf16_t* KS = (const bf16_t*)(ws + OFF_KS);
    const bf16_t* VST = (const bf16_t*)(ws + OFF_VST);
    const bf16_t* KW = (const bf16_t*)(ws + OFF_KW);
    const bf16_t* VWT = (const bf16_t*)(ws + OFF_VWT);
    const bf16_t* KCMP = (const bf16_t*)(ws + OFF_KCMP);
    const bf16_t* VCMPT = (const bf16_t*)(ws + OFF_VCMPT);
    const float* gates = (const float*)(ws + OFF_GATES);
    bf16_t* O = VAR ? (bf16_t*)(ws + OFF_PU + 32 * MB) : (bf16_t*)(ws + OFF_H);
    const float* relb = p.in[2];
    const int lane = tid & 63, w = tid >> 6, hg = w >> 1, th = w & 1, r = lane & 31, h = lane >> 5;
    float* lut = (float*)(lds + AT_LUT);
    float* lutc = (float*)(lds + AT_LUTC);
    float* imp = (float*)(lds + AT_IMP);
    unsigned* selw = (unsigned*)(lds + AT_SEL);
    unsigned short* sel16 = (unsigned short*)selw;
    float* bmxs = (float*)(selw + 264);
    const float* qnrm = (const float*)(ws + OFF_MB1);
    float kmx[3];
    for (int br = 0; br < 3; ++br) { float mx = 0.f; for (int d = 0; d < 128; ++d) mx = fmaxf(mx, fabsf(p.in[21][br * 128 + d])); kmx[br] = mx * 11.313708498984761f; }
    const int G = gridDim.x, rows_per_it = G >> 3;
    int lut_g = -1;
    for (int it = 0;; ++it) {
        int u;
        if ((G & 7) == 0) {
            const int rr = blockIdx.x >> 3, cc = blockIdx.x & 7;
            const int rowi = it * rows_per_it + ((it & 1) ? rows_per_it - 1 - rr : rr);
            u = rowi * 8 + cc;
        } else u = it * G + blockIdx.x;
        if (u >= 1024) break;
        const int bi = 127 - (u >> 3), b = (u & 7) >> 1, g = u & 1, head = 4 * g + hg;
        const int tq = 64 * bi + 32 * th + r;
        const int tl = 32 * th + r;
        const long tok = (long)b * SEQ + tq;
        if (g != lut_g) {
            lut_g = g;
            if (tid < 4) { float bm = 0.f; for (int bk = 0; bk < 32; ++bk) bm = fmaxf(bm, relb[bk * 8 + 4 * g + tid] - relb[31 * 8 + 4 * g + tid]); bmxs[tid] = bm * LOG2E; }
            for (int e = tid; e < 4 * LUT_N; e += NTHREADS) { const int hh = e / LUT_N, d = LUT_OFF - (e % LUT_N); lut[e] = d < 0 ? -INFINITY : (d >= 790 ? 0.f : (relb[rel_bucket_i(d) * 8 + 4 * g + hh] - relb[31 * 8 + 4 * g + hh]) * LOG2E); }
            for (int e = tid; e < 4 * 16 * LUTC_W; e += NTHREADS) {
                const int hh = e / (16 * LUTC_W), ph = (e / LUTC_W) & 15, ci = e % LUTC_W, d = 16 * (ci - 1) + ph;
                lutc[e] = ci == 0 ? -INFINITY : (d >= 790 ? 0.f : (relb[rel_bucket_i(d) * 8 + 4 * g + hh] - relb[31 * 8 + 4 * g + hh]) * LOG2E);
            }
        }
        if (tid < 4) selw[256 + tid] = 0u;
        const float* mylut = lut + hg * LUT_N;
        bf16x8 qf[8];
        const bf16_t* qrow = QN + ((long)(b * 8 + head) * SEQ + tq) * 128 + 8 * h;
        auto load_q = [&](const bf16_t* qr) {
#pragma unroll
            for (int ks = 0; ks < 8; ++ks) qf[ks] = *(const bf16x8*)(qr + 16 * ks);
        };
        const float* gp = gates + tok * 24 + head * 3;
        bf16_t* orow = O + (VAR ? (tok & 16383) : tok) * DM + head * 128;
        auto stage = [&](const unsigned char* kg, const unsigned char* vg, unsigned vstride, int kt, unsigned char* st) {
            int t2 = tid; asm volatile("" : "+v"(t2));
            unsigned koff[2], vo[2];
            dma_offsets<256, 64>(koff, 256, t2);
            dma_offsets<128, 128>(vo, vstride, t2);
            dma_issue(st, kg + (long)kt * 16384, koff, t2);
            dma_issue(st + 16384, vg + (long)kt * 128, vo, t2);
        };
        f32x16 o[4];
        float l;
        auto reset = [&]() {
#pragma unroll
            for (int dt = 0; dt < 4; ++dt)
#pragma unroll
                for (int i = 0; i < 16; ++i) o[dt][i] = 0.f;
            l = 0.f;
        };
        const unsigned char* kcg = (const unsigned char*)(KCMP + (long)(b * 2 + g) * 512 * 128);
        const unsigned char* vcg = (const unsigned char*)(VCMPT + (long)(b * 2 + g) * 128 * 512);
        const int nct = ((4 * bi + 2) >> 6) + 1;
        const int hgc = r & 3, tlc = 8 * w + (r >> 2), tqc = 64 * bi + tlc;
        const long tokc = (long)b * SEQ + tqc;
        reset();
        load_q(QN + ((long)(b * 8 + 4 * g + hgc) * SEQ + tqc) * 128 + 8 * h);
        __syncthreads();
        if (VAR != 3) {
            const int cb = (tqc - 31) >> 4;
            const float* lc = lutc + (hgc * 16 + ((tqc - 31) & 15)) * LUTC_W + 1;
            const float nmb = -(qnrm[tokc * 8 + 4 * g + hgc] * kmx[0] + bmxs[hgc]);
            stage(kcg, vcg, 1024u, 0, lds);
            __syncthreads();
            for (int kt = 0; kt < nct; ++kt) {
                unsigned char* cur = lds + (kt & 1) * AT_STAGE;
                if (kt + 1 < nct) stage(kcg, vcg, 1024u, kt + 1, lds + ((kt + 1) & 1) * AT_STAGE);
                const int cbase = cb - kt * 64 - 8 * h;
#pragma unroll
                for (int mt = 0; mt < 2; ++mt) {
                    f32x16 st;
                    attn_qk32<128>(cur, qf, st, mt, r, h, nmb);
                    float sum = 0.f;
#pragma unroll
                    for (int i = 0; i < 16; ++i) {
                        const int c = cbase - kidx(mt, i);
                        sum += fexp2(st[i] + lc[c < -1 ? -1 : (c > 50 ? 50 : c)]);
                    }
                    l += sum;
                }
                __syncthreads();
            }
            const float lt = sum_x32(l);
            const float invl = lt > 0.f ? frcp(lt) : 0.f;
            stage(kcg, vcg, 1024u, 0, lds);
            __syncthreads();
            float carry = 0.f;
            for (int kt = 0; kt < nct; ++kt) {
                unsigned char* cur = lds + (kt & 1) * AT_STAGE;
                if (kt + 1 < nct) stage(kcg, vcg, 1024u, kt + 1, lds + ((kt + 1) & 1) * AT_STAGE);
                const int cbase = cb - kt * 64 - 8 * h;
                float o0[4], o1[4], sp[4];
#pragma unroll
                for (int mt = 0; mt < 2; ++mt) {
                    f32x16 st;
                    attn_qk32<128>(cur, qf, st, mt, r, h, nmb);
#pragma unroll
                    for (int i = 0; i < 16; ++i) {
                        const int c = cbase - kidx(mt, i);
                        st[i] = fexp2(st[i] + lc[c < -1 ? -1 : (c > 50 ? 50 : c)]) * invl;
                    }
#pragma unroll
                    for (int gq = 0; gq < 2; ++gq) {
                        const int G2 = 2 * mt + gq, q0 = 2 * gq, q1 = 2 * gq + 1;
                        const float c20 = 0.5f * st[4 * q0 + 3];
                        o0[G2] = st[4 * q0] + st[4 * q0 + 1] + st[4 * q0 + 2] + c20;
                        o1[G2] = st[4 * q1] + st[4 * q1 + 1] + st[4 * q1 + 2] + 0.5f * st[4 * q1 + 3] + c20;
                        sp[G2] = 0.5f * st[4 * q1 + 3];
                    }
                    bf16x8 pf[2];
                    attn_pack32(st, pf);
                    attn_pv32(cur + 16384, pf, o, mt, r, h);
                }
                float rc[4];
#pragma unroll
                for (int G2 = 0; G2 < 4; ++G2) rc[G2] = __uint_as_float(get_x32(__float_as_uint(sp[G2]), h));
                if (h) {
#pragma unroll
                    for (int G2 = 0; G2 < 4; ++G2) o0[G2] += rc[G2];
                } else {
                    o0[0] += carry; o0[1] += rc[0]; o0[2] += rc[1]; o0[3] += rc[2];
                    carry = rc[3];
                }
#pragma unroll
                for (int G2 = 0; G2 < 4; ++G2) {
                    float a0 = o0[G2], a1 = o1[G2];
                    a0 += lx1(a0); a0 += lx2(a0); a1 += lx1(a1); a1 += lx2(a1);
                    if (hgc == 0) *(f32x2*)(imp + tlc * 130 + kt * 16 + 4 * G2 + 2 * h) = (f32x2){a0, a1};
                }
                __syncthreads();
            }
        }
        {
            const float g_c = gates[tokc * 24 + (4 * g + hgc) * 3];
            bf16_t* orc = O + (VAR ? (tokc & 16383) : tokc) * DM + (4 * g + hgc) * 128;
#pragma unroll
            for (int dt = 0; dt < 4; ++dt)
#pragma unroll
                for (int g4 = 0; g4 < 4; ++g4) {
                    const int d0 = 32 * dt + 8 * g4 + 4 * h;
                    u32x2 ov;
                    ov.x = pk2(o[dt][4 * g4 + 0] * g_c, o[dt][4 * g4 + 1] * g_c);
                    ov.y = pk2(o[dt][4 * g4 + 2] * g_c, o[dt][4 * g4 + 3] * g_c);
                    *(u32x2*)(orc + d0) = ov;
                }
        }
        if (VAR != 5) {
            const int tkn = tid >> 3, part = tid & 7;
            unsigned key[16];
#pragma unroll
            for (int q = 0; q < 16; ++q) {
                const int j = part * 16 + q;
                float v = imp[tkn * 130 + j];
                const int back = bi - j;
                if (j == 0 || (back >= 0 && back < 2)) v = 1e9f;
                if (back < 0) v = -1e30f;
                key[q] = f2key(v);
            }
            auto sum8 = [&](int c) -> int {
                c += __builtin_amdgcn_update_dpp(0, c, 0xB1, 0xF, 0xF, true);
                c += __builtin_amdgcn_update_dpp(0, c, 0x4E, 0xF, 0xF, true);
                c += __builtin_amdgcn_update_dpp(0, c, 0x141, 0xF, 0xF, true);
                return c;
            };
            unsigned T = 0u;
#pragma unroll 4
            for (int bit = 31; bit >= 0; --bit) {
                const unsigned cand = T | (1u << bit);
                int c = 0;
#pragma unroll
                for (int q = 0; q < 16; ++q) c += key[q] >= cand ? 1 : 0;
                if (sum8(c) >= 16) T = cand;
            }
            int cg = 0, ce = 0;
#pragma unroll
            for (int q = 0; q < 16; ++q) { cg += key[q] > T ? 1 : 0; ce += key[q] == T ? 1 : 0; }
            const int need = 16 - sum8(cg);
            int pre = ce;
            { int t = __builtin_amdgcn_update_dpp(0, pre, 0x111, 0xF, 0xF, true); if (part >= 1) pre += t; }
            { int t = __builtin_amdgcn_update_dpp(0, pre, 0x112, 0xF, 0xF, true); if (part >= 2) pre += t; }
            { int t = __builtin_amdgcn_update_dpp(0, pre, 0x114, 0xF, 0xF, true); if (part >= 4) pre += t; }
            int before = pre - ce;
            unsigned bits = 0;
#pragma unroll
            for (int q = 0; q < 16; ++q) {
                const bool eq = key[q] == T;
                const bool selq = key[q] > T || (eq && before < need);
                before += eq ? 1 : 0;
                bits |= (selq && key[q] >= 0x80000000u) ? (1u << q) : 0u;
            }
            sel16[tkn * 8 + part] = (unsigned short)bits;
            atomicOr(&selw[256 + (part >> 1)], bits << ((part & 1) * 16));
        }
        __syncthreads();
        const unsigned un0 = selw[256], un1 = selw[257], un2 = selw[258], un3 = selw[259];
        const unsigned char* ksg = (const unsigned char*)(KS + (long)(b * 2 + g) * SEQ * 128);
        const unsigned char* vsg = (const unsigned char*)(VST + (long)(b * 2 + g) * 128 * SEQ);
        reset(); load_q(qrow);
        const float qn_main = qnrm[tok * 8 + head];
        {
            const float nmb = -(qn_main * kmx[1] + bmxs[hg]);
            const unsigned long long ulo = ((unsigned long long)(unsigned)__builtin_amdgcn_readfirstlane((int)un1) << 32) | (unsigned)__builtin_amdgcn_readfirstlane((int)un0);
            const unsigned long long uhi = ((unsigned long long)(unsigned)__builtin_amdgcn_readfirstlane((int)un3) << 32) | (unsigned)__builtin_amdgcn_readfirstlane((int)un2);
            auto next_tile = [&](int from) -> int {
                if (from < 64) { const unsigned long long mk = ulo >> from; if (mk) return from + __builtin_ctzll(mk); from = 64; }
                if (from < 128) { const unsigned long long mk = uhi >> (from - 64); if (mk) return from + __builtin_ctzll(mk); }
                return 128;
            };
            int jt = (VAR == 1 || VAR == 4 || VAR == 5) ? 128 : next_tile(0);
            int buf = 0;
            if (jt < 128) stage(ksg, vsg, SEQ * 2u, jt, lds);
            __syncthreads();
            while (jt < 128) {
                unsigned char* cur = lds + buf * AT_STAGE;
                const int jn = next_tile(jt + 1);
                if (jn < 128) stage(ksg, vsg, SEQ * 2u, jn, lds + (buf ^ 1) * AT_STAGE);
                const unsigned wd = selw[tl * 4 + (jt >> 5)];
                const bool mysel = (wd >> (jt & 31)) & 1u;
                if (__any(mysel)) {
                    const int k0 = jt * 64;
                    const bool nearb = (64 * bi + 32 * th) - (k0 + 63) < 790;
                    const int dbase = tq - k0 - 8 * h;
                    const float* lp = mylut + (LUT_OFF - dbase);
#pragma unroll
                    for (int mt = 0; mt < 2; ++mt) {
                        f32x16 st;
                        attn_qk32<128>(cur, qf, st, mt, r, h, mysel ? nmb : -INFINITY);
                        if (nearb) {
#pragma unroll
                            for (int i = 0; i < 16; ++i) st[i] += lp[kidx(mt, i)];
                        }
                        attn_softmax32_b(st, l);
                        bf16x8 pf[2];
                        attn_pack32(st, pf);
                        attn_pv32(cur + 16384, pf, o, mt, r, h);
                    }
                }
                __syncthreads();
                buf ^= 1; jt = jn;
            }
        }
        {
            const float lt = sum_x32(l);
            const float sc = (lt > 0.f ? frcp(lt) : 0.f) * gp[1];
#pragma unroll
            for (int dt = 0; dt < 4; ++dt)
#pragma unroll
                for (int g4 = 0; g4 < 4; ++g4) {
                    const int d0 = 32 * dt + 8 * g4 + 4 * h;
                    const u32x2 pv = *(const u32x2*)(orow + d0);
                    u32x2 ov;
                    ov.x = pk2(bflo(pv.x) + o[dt][4 * g4 + 0] * sc, bfhi(pv.x) + o[dt][4 * g4 + 1] * sc);
                    ov.y = pk2(bflo(pv.y) + o[dt][4 * g4 + 2] * sc, bfhi(pv.y) + o[dt][4 * g4 + 3] * sc);
                    *(u32x2*)(orow + d0) = ov;
                }
        }
        const unsigned char* kwg = (const unsigned char*)(KW + (long)(b * 2 + g) * SEQ * 128);
        const unsigned char* vwg = (const unsigned char*)(VWT + (long)(b * 2 + g) * 128 * SEQ);
        reset(); load_q(qrow);
        {
            const float nmb = -(qn_main * kmx[2] + bmxs[hg]);
            const int j0 = bi >= 8 ? bi - 8 : 0, nt = (VAR == 2 || VAR == 4 || VAR == 5) ? 1 : bi - j0 + 1;
            stage(kwg, vwg, SEQ * 2u, j0, lds);
            __syncthreads();
            for (int kt = 0; kt < nt; ++kt) {
                unsigned char* cur = lds + (kt & 1) * AT_STAGE;
                if (kt + 1 < nt) stage(kwg, vwg, SEQ * 2u, j0 + kt + 1, lds + ((kt + 1) & 1) * AT_STAGE);
                const int k0 = (j0 + kt) * 64;
                const int dbase = tq - k0 - 8 * h;
                const float* lp = mylut + (LUT_OFF - dbase);
#pragma unroll
                for (int mt = 0; mt < 2; ++mt) {
                    f32x16 st;
                    attn_qk32<128>(cur, qf, st, mt, r, h, nmb);
#pragma unroll
                    for (int i = 0; i < 16; ++i) st[i] = kidx(mt, i) <= dbase - 512 ? -INFINITY : st[i] + lp[kidx(mt, i)];
                    attn_softmax32_b(st, l);
                    bf16x8 pf[2];
                    attn_pack32(st, pf);
                    attn_pv32(cur + 16384, pf, o, mt, r, h);
                }
                __syncthreads();
            }
        }
        {
            const float lt = sum_x32(l);
            const float sc = (lt > 0.f ? frcp(lt) : 0.f) * gp[2];
#pragma unroll
            for (int dt = 0; dt < 4; ++dt)
#pragma unroll
                for (int g4 = 0; g4 < 4; ++g4) {
                    const int d0 = 32 * dt + 8 * g4 + 4 * h;
                    const u32x2 pv = *(const u32x2*)(orow + d0);
                    u32x2 ov;
                    ov.x = pk2(bflo(pv.x) + o[dt][4 * g4 + 0] * sc, bfhi(pv.x) + o[dt][4 * g4 + 1] * sc);
                    ov.y = pk2(bflo(pv.y) + o[dt][4 * g4 + 2] * sc, bfhi(pv.y) + o[dt][4 * g4 + 3] * sc);
                    *(u32x2*)(orow + d0) = ov;
                }
        }
        __syncthreads();
    }
}

DI void fp8x16_fma(const u32x4& q, const f32x4& h0, const f32x4& h1, const f32x4& h2, const f32x4& h3, f32x2& a0, f32x2& a1) {
    a0 += __builtin_amdgcn_cvt_pk_f32_fp8((int)q.x, false) * (f32x2){h0.x, h0.y};
    a1 += __builtin_amdgcn_cvt_pk_f32_fp8((int)q.x, true)  * (f32x2){h0.z, h0.w};
    a0 += __builtin_amdgcn_cvt_pk_f32_fp8((int)q.y, false) * (f32x2){h1.x, h1.y};
    a1 += __builtin_amdgcn_cvt_pk_f32_fp8((int)q.y, true)  * (f32x2){h1.z, h1.w};
    a0 += __builtin_amdgcn_cvt_pk_f32_fp8((int)q.z, false) * (f32x2){h2.x, h2.y};
    a1 += __builtin_amdgcn_cvt_pk_f32_fp8((int)q.z, true)  * (f32x2){h2.z, h2.w};
    a0 += __builtin_amdgcn_cvt_pk_f32_fp8((int)q.w, false) * (f32x2){h3.x, h3.y};
    a1 += __builtin_amdgcn_cvt_pk_f32_fp8((int)q.w, true)  * (f32x2){h3.z, h3.w};
}
#ifndef UMASK
#define UMASK 0xffffffffu
#endif
template <bool DRY>
DI void phase_peer_u(const Params& p, int layer, unsigned char* lds, int tid) {
    unsigned char* ws = p.ws;
    const unsigned char* H8 = ws + OFF_H8;
    const float* HS = (const float*)(ws + OFF_HS);
    const int* ridx = (const int*)(ws + OFF_RIDX);
    float* rgate = (float*)(ws + OFF_RGATE);
    const unsigned char* U = ws + OFF_PU + (long)layer * 16384 * 1024;
    const __amdgpu_buffer_rsrc_t urs = __builtin_amdgcn_make_buffer_rsrc((void*)U, (short)0, 16384 * 1024, 0x00020000);
    const float* usi = (const float*)(ws + OFF_USI) + layer * 16384;
    const float* vsi = (const float*)(ws + OFF_VSI) + layer * 16384;
    const int lane = tid & 63, w = __builtin_amdgcn_readfirstlane(tid >> 6), sub = lane & 7, grp = lane >> 3;
    const int xg = blockIdx.x & 7, lb = blockIdx.x >> 3, nwv = (gridDim.x >> 3) * NWAVES, wv = lb * NWAVES + w;
    unsigned* clb = (unsigned*)(lds + w * 12288);
    unsigned char* hbb = lds + w * 12288 + 4096;
    const unsigned long long lt = (1ull << lane) - 1ull;
    if (lb >= (int)(gridDim.x >> 3)) return;
    int i0, i1; unsigned g0, g1; u32x4 h0; float hs0;
    auto ld_tok = [&](int tk) {
        tk = tk < NTOK ? tk : wv;
        i0 = ridx[(long)tk * 128 + lane]; i1 = ridx[(long)tk * 128 + 64 + lane];
        g0 = __float_as_uint(rgate[(long)tk * 128 + lane]); g1 = __float_as_uint(rgate[(long)tk * 128 + 64 + lane]);
        h0 = *(const u32x4*)(H8 + (long)tk * DM + lane * 16); hs0 = HS[tk];
    };
    bool sb0, sb1; int sk0, sk1; float su0, sv0, su1, sv1;
    auto stage_tok = [&](int bi) -> int {
        unsigned* cl = clb + bi * 512; unsigned char* hb = hbb + bi * 4096;
        const bool b0 = (i0 >> 11) == xg, b1 = (i1 >> 11) == xg;
        const unsigned long long m0 = __ballot(b0), m1 = __ballot(b1);
        const int n0 = __popcll(m0), n = n0 + __popcll(m1);
        sb0 = b0; sb1 = b1; sk0 = __popcll(m0 & lt); sk1 = n0 + __popcll(m1 & lt);
        if (b0) { *(u32x4*)(cl + 4 * sk0) = (u32x4){(unsigned)lane, (unsigned)i0, g0, 0u}; su0 = usi[i0]; sv0 = vsi[i0]; }
        if (b1) { *(u32x4*)(cl + 4 * sk1) = (u32x4){(unsigned)(64 + lane), (unsigned)i1, g1, 0u}; su1 = usi[i1]; sv1 = vsi[i1]; }
        if (n == 0 && lane == 0) *(u32x4*)cl = (u32x4){0u, 0u, 0u, 0u};
        *(u32x4*)(hb + lane * 16) = h0;
        if (lane == 0) *(float*)(hb + 1024) = hs0;
        return n;
    };
    auto flush_scales = [&](int bi) {
        float* cs = (float*)(hbb + bi * 4096 + 1536);
        if (sb0) *(f32x2*)(cs + 2 * sk0) = (f32x2){su0, sv0};
        if (sb1) *(f32x2*)(cs + 2 * sk1) = (f32x2){su1, sv1};
    };
    ld_tok(wv);
    int nC = stage_tok(0);
    flush_scales(0);
    ld_tok(wv + nwv);
    int slotC, idC; bool validC; float g_in;
    { validC = grp < nC; const int kk = validC ? grp : 0; const u32x4 e = *(const u32x4*)(clb + 4 * kk); slotC = e.x; idC = e.y; g_in = __uint_as_float(e.z); }
    u32x4 uv[8];
    {
        const unsigned uoff = validC ? (unsigned)idC * 1024u + (unsigned)sub * 16u : 0x40000000u;
#pragma unroll
        for (int t = 0; t < 8; ++t) { uv[t] = __builtin_bit_cast(u32x4, __builtin_amdgcn_raw_buffer_load_b128(urs, (int)(uoff + t * 128), 0, 0)); __builtin_amdgcn_sched_barrier(0); }
    }
    int it = 0;
    for (int tok = wv; tok < NTOK; tok += nwv, ++it) {
        const int cb = it & 1;
        const unsigned* clC = clb + cb * 512; const unsigned* clN = clb + (cb ^ 1) * 512;
        const unsigned char* hbC = hbb + cb * 4096;
        const bool more = tok + nwv < NTOK;
        const int nN = stage_tok(cb ^ 1); ld_tok(tok + 2 * nwv);
        const float shC = *(const float*)(hbC + 1024);
        const int nr = nC > 8 ? (nC + 7) >> 3 : 1;
        u32x4 hq[8];
#pragma unroll
        for (int t = 0; t < 8; ++t) hq[t] = *(const u32x4*)(hbC + (sub + 8 * t) * 16);
        auto do_round = [&](int rd) {
            const f32x2 s2 = *(const f32x2*)(hbC + 1536 + 8 * (validC ? 8 * rd + grp : 0));
            int slotN, idN; bool validN; float g_inN;
            {
                u32x4 e;
                if (rd + 1 < nr) { const int k = 8 * (rd + 1) + grp; validN = k < nC; e = *(const u32x4*)(clC + 4 * (validN ? k : 0)); }
                else if (more) { validN = grp < nN; e = *(const u32x4*)(clN + 4 * (validN ? grp : 0)); }
                else { validN = false; e = *(const u32x4*)clC; }
                slotN = e.x; idN = e.y; g_inN = __uint_as_float(e.z);
            }
            const unsigned uoffN = validN ? ((unsigned)idN & (DRY ? UMASK : 0xffffffffu)) * 1024u + (unsigned)sub * 16u : 0x40000000u;
            __builtin_amdgcn_sched_barrier(0);
            int a0 = 0, a1 = 0, a2 = 0, a3 = 0;
#pragma unroll
            for (int t = 0; t < 8; ++t) {
                const u32x4 q = uv[t];
                a0 = __builtin_amdgcn_sdot4((int)q.x, (int)hq[t].x, a0, false); a1 = __builtin_amdgcn_sdot4((int)q.y, (int)hq[t].y, a1, false);
                a2 = __builtin_amdgcn_sdot4((int)q.z, (int)hq[t].z, a2, false); a3 = __builtin_amdgcn_sdot4((int)q.w, (int)hq[t].w, a3, false);
                uv[t] = __builtin_bit_cast(u32x4, __builtin_amdgcn_raw_buffer_load_b128(urs, (int)(uoffN + t * 128), 0, 0));
                __builtin_amdgcn_sched_barrier(0);
            }
            int di = (a0 + a1) + (a2 + a3);
            di += __builtin_amdgcn_update_dpp(0, di, 0xB1, 0xF, 0xF, true);
            di += __builtin_amdgcn_update_dpp(0, di, 0x4E, 0xF, 0xF, true);
            di += __builtin_amdgcn_update_dpp(0, di, 0x141, 0xF, 0xF, true);
            if (validC && sub == 0) {
                float* gw = DRY ? (float*)(ws + OFF_R) + (long)tok * 128 + slotC : rgate + (long)tok * 128 + slotC;
                *gw = g_in * gelu_tanh((float)di * s2.x * shC) * s2.y;
            }
            slotC = slotN; idC = idN; validC = validN; g_in = g_inN;
        };
        do_round(0);
        for (int rd = 1; rd < nr; ++rd) do_round(rd);
        flush_scales(cb ^ 1);
        nC = nN;
    }
}

#ifndef VMASK
#define VMASK 0xffffffffu
#endif
#ifndef V_MFMA
#define V_MFMA 1
#endif
#define LAS __attribute__((address_space(3)))
typedef int v2i_t __attribute__((ext_vector_type(2)));
template <bool DRY>
DI void phase_peer_v(const Params& p, int layer, unsigned char* lds, int tid) {
    unsigned char* ws = p.ws;
    const int* ridx = (const int*)(ws + OFF_RIDX);
    const float* wact = (const float*)(ws + OFF_RGATE);
    const float* ada = (const float*)(ws + OFF_ADA);
    float* x = opq(p.out);
    const int lane = tid & 63, w = __builtin_amdgcn_readfirstlane(tid >> 6), sub = lane & 7, eg = lane >> 3;
    const int xg = blockIdx.x & 7, lb = blockIdx.x >> 3, nwv = (gridDim.x >> 3) * NWAVES, wv = lb * NWAVES + w;
    if (lb >= (int)(gridDim.x >> 3)) return;
    const unsigned char* Vc = ws + OFF_PV + ((long)(layer * 8 + xg) * 16384) * 128;
    unsigned char* gr = lds + w * 16384;
    unsigned* ring = (unsigned*)(lds + 128 * 1024 + w * 3072);
    int ia, ib; float wa, wb;
    auto ld_tokv = [&](int tk) {
        tk = tk < NTOK ? tk : wv;
        ia = ridx[(long)tk * 128 + lane]; ib = ridx[(long)tk * 128 + 64 + lane];
        wa = wact[(long)tk * 128 + lane]; wb = wact[(long)tk * 128 + 64 + lane];
    };
    auto st_ring = [&](int slot) {
        unsigned* rs = ring + slot * 256;
        rs[lane] = (unsigned)ia; rs[64 + lane] = (unsigned)ib; rs[128 + lane] = __float_as_uint(wa); rs[192 + lane] = __float_as_uint(wb);
    };
    auto rd_ids = [&](int slot, u32x4 (&a)[4]) {
        const u32x4* ip = (const u32x4*)(ring + slot * 256 + eg * 16);
#pragma unroll
        for (int q = 0; q < 4; ++q) a[q] = ip[q];
    };
    auto issue = [&](int j, const u32x4 (&a)[4]) {
#pragma unroll
        for (int i = 0; i < 4; ++i) {
            const int g = 4 * (i & 1) + (eg >> 1);
            const unsigned src = (a[j][i] & (DRY ? VMASK : 0xffffffffu)) * 128u + (unsigned)((sub ^ g) << 4);
            __builtin_amdgcn_global_load_lds((const unsigned*)(Vc + src), (unsigned*)(gr + j * 4096 + i * 1024), 16, 0, 0);
        }
    };
    const int col0 = 128 * xg + 16 * sub;
    ld_tokv(wv); st_ring(0);
    ld_tokv(wv + nwv); st_ring(1);
    ld_tokv(wv + 2 * nwv);
    {
        u32x4 a[4];
        rd_ids(0, a);
#pragma unroll
        for (int j = 0; j < 4; ++j) issue(j, a);
    }
#if V_MFMA
    unsigned char* wb8 = lds + 152 * 1024 + w * 256;
    const int m16 = lane & 15, q4 = lane >> 4;
    int boff[8];
    {
        const int rowL = 8 * q4 + (m16 >> 1), gL = (rowL >> 1) & 7;
#pragma unroll
        for (int nt = 0; nt < 8; ++nt) boff[nt] = rowL * 128 + ((nt ^ gL) << 4) + 8 * (m16 & 1);
    }
    unsigned baddr[8];
    const unsigned gr3 = (unsigned)(unsigned long)(LAS unsigned char*)gr;
#pragma unroll
    for (int nt = 0; nt < 8; ++nt) baddr[nt] = gr3 + (unsigned)boff[nt];
    const unsigned aaddr = (unsigned)(unsigned long)(LAS unsigned char*)wb8 + (unsigned)((m16 & 1) * 128 + 8 * q4);
    float xv[8], gfv[8]; int gb = -1;
    const int colx = 128 * xg + m16;
    if (lane < 16) {
#pragma unroll
        for (int nt = 0; nt < 8; ++nt) xv[nt] = x[(long)wv * DM + colx + 16 * nt];
    }
#else
    f32x4 gfv[4]; int gb = -1;
    f32x4 xv[4];
    if (eg == 0) {
#pragma unroll
        for (int c = 0; c < 4; ++c) xv[c] = *(const f32x4*)(x + (long)wv * DM + col0 + 4 * c);
    }
#endif
    int it = 0, s3 = 0;
    for (int tok = wv; tok < NTOK; tok += nwv, ++it) {
        const int sl0 = s3, sl1 = s3 == 2 ? 0 : s3 + 1, sl2 = s3 == 0 ? 2 : s3 - 1;
        st_ring(sl2);
        ld_tokv(tok + 3 * nwv);
        u32x4 na[4];
        rd_ids(sl1, na);
        {
            const int b = tok >> 13;
            if (b != gb) {
                gb = b;
#if V_MFMA
                if (lane < 16) {
#pragma unroll
                    for (int nt = 0; nt < 8; ++nt) gfv[nt] = ada[b * ADA_STRIDE + layer * 6144 + 5 * 1024 + colx + 16 * nt];
                }
#else
                const float* gf = ada + b * ADA_STRIDE + layer * 6144 + 5 * 1024 + col0;
#pragma unroll
                for (int c = 0; c < 4; ++c) gfv[c] = *(const f32x4*)(gf + 4 * c);
#endif
                asm volatile("s_waitcnt vmcnt(0)" ::: "memory");
            }
        }
#if V_MFMA
        float invS;
        {
            const float w0 = __uint_as_float(ring[sl0 * 256 + 128 + lane]), w1 = __uint_as_float(ring[sl0 * 256 + 192 + lane]);
            const float mx = wave_max(fmaxf(fabsf(w0), fabsf(w1)));
            int ex = (int)((__float_as_uint(mx) >> 23) & 255u) - 127;
            ex = ex < -100 ? -100 : ex;
            const float S = __uint_as_float((unsigned)(127 + 7 - ex) << 23);
            invS = __uint_as_float((unsigned)(127 - 7 + ex) << 23);
            const float a0 = w0 * S, a1 = w1 * S;
            const int hi = __builtin_amdgcn_cvt_pk_fp8_f32(a0, a1, 0, false);
            const f32x2 hf = __builtin_amdgcn_cvt_pk_f32_fp8(hi, false);
            const int lo = __builtin_amdgcn_cvt_pk_fp8_f32(a0 - hf.x, a1 - hf.y, 0, false);
            const int p0 = 8 * (lane & 15) + (lane >> 4);
            wb8[p0] = (unsigned char)(hi & 255); wb8[p0 + 4] = (unsigned char)((hi >> 8) & 255);
            wb8[128 + p0] = (unsigned char)(lo & 255); wb8[128 + p0 + 4] = (unsigned char)((lo >> 8) & 255);
        }
        f32x4 d[8];
#pragma unroll
        for (int nt = 0; nt < 8; ++nt) d[nt] = (f32x4){0.f, 0.f, 0.f, 0.f};
#pragma unroll
        for (int j = 0; j < 4; ++j) {
            asm volatile("s_waitcnt vmcnt(24)" ::: "memory");
            v2i_t aq, b0, b1, b2, b3, b4, b5, b6, b7;
            asm volatile("ds_read_b64 %0, %9 offset:%18\n\t"
                         "ds_read_b64_tr_b8 %1, %10 offset:%19\n\tds_read_b64_tr_b8 %2, %11 offset:%19\n\t"
                         "ds_read_b64_tr_b8 %3, %12 offset:%19\n\tds_read_b64_tr_b8 %4, %13 offset:%19\n\t"
                         "ds_read_b64_tr_b8 %5, %14 offset:%19\n\tds_read_b64_tr_b8 %6, %15 offset:%19\n\t"
                         "ds_read_b64_tr_b8 %7, %16 offset:%19\n\tds_read_b64_tr_b8 %8, %17 offset:%19\n\t"
                         "s_waitcnt lgkmcnt(0)"
                         : "=&v"(aq), "=&v"(b0), "=&v"(b1), "=&v"(b2), "=&v"(b3), "=&v"(b4), "=&v"(b5), "=&v"(b6), "=&v"(b7)
                         : "v"(aaddr), "v"(baddr[0]), "v"(baddr[1]), "v"(baddr[2]), "v"(baddr[3]), "v"(baddr[4]), "v"(baddr[5]), "v"(baddr[6]), "v"(baddr[7]),
                           "i"(32 * j), "i"(4096 * j)
                         : "memory");
            long a8 = ((long)(unsigned)aq.y << 32) | (unsigned)aq.x;
            a8 = m16 < 2 ? a8 : 0l;
            const v2i_t bq[8] = {b0, b1, b2, b3, b4, b5, b6, b7};
#pragma unroll
            for (int nt = 0; nt < 8; ++nt) {
                const long b8 = ((long)(unsigned)bq[nt].y << 32) | (unsigned)bq[nt].x;
                d[nt] = __builtin_amdgcn_mfma_f32_16x16x32_fp8_fp8(a8, b8, d[nt], 0, 0, 0);
            }
            issue(j, na);
        }
        if (lane < 16) {
            float* xr = DRY ? (float*)(ws + OFF_R + 16 * MB) + (long)tok * DM + colx : x + (long)tok * DM + colx;
#pragma unroll
            for (int nt = 0; nt < 8; ++nt) xr[16 * nt] = xv[nt] + gfv[nt] * ((d[nt].x + d[nt].y) * invS);
            const int tn = tok + nwv < NTOK ? tok + nwv : wv;
#pragma unroll
            for (int nt = 0; nt < 8; ++nt) xv[nt] = x[(long)tn * DM + colx + 16 * nt];
        }
#else
        f32x4 cw[4];
        {
            const f32x4* wp = (const f32x4*)(ring + sl0 * 256 + 128 + eg * 16);
#pragma unroll
            for (int q = 0; q < 4; ++q) cw[q] = wp[q];
        }
        f32x2 ap[8];
#pragma unroll
        for (int i = 0; i < 8; ++i) ap[i] = (f32x2){0.f, 0.f};
#pragma unroll
        for (int j = 0; j < 4; ++j) {
            asm volatile("s_waitcnt vmcnt(20)" ::: "memory");
#pragma unroll
            for (int i = 0; i < 4; ++i) {
                const int rs = 8 * i + eg, g = 4 * (i & 1) + (eg >> 1);
                const u32x4 v = *(const u32x4*)(gr + j * 4096 + rs * 128 + ((sub ^ g) << 4));
                const float ws1 = cw[j][i]; const f32x2 ww = {ws1, ws1};
                ap[0] += __builtin_amdgcn_cvt_pk_f32_fp8((int)v.x, false) * ww; ap[1] += __builtin_amdgcn_cvt_pk_f32_fp8((int)v.x, true) * ww;
                ap[2] += __builtin_amdgcn_cvt_pk_f32_fp8((int)v.y, false) * ww; ap[3] += __builtin_amdgcn_cvt_pk_f32_fp8((int)v.y, true) * ww;
                ap[4] += __builtin_amdgcn_cvt_pk_f32_fp8((int)v.z, false) * ww; ap[5] += __builtin_amdgcn_cvt_pk_f32_fp8((int)v.z, true) * ww;
                ap[6] += __builtin_amdgcn_cvt_pk_f32_fp8((int)v.w, false) * ww; ap[7] += __builtin_amdgcn_cvt_pk_f32_fp8((int)v.w, true) * ww;
            }
            asm volatile("s_waitcnt lgkmcnt(0)" ::: "memory");
            issue(j, na);
        }
        float acc[16];
#pragma unroll
        for (int i = 0; i < 8; ++i) { acc[2 * i] = ap[i].x; acc[2 * i + 1] = ap[i].y; }
#pragma unroll
        for (int i = 0; i < 16; ++i) { acc[i] += lr8(acc[i]); acc[i] = sum_x16(acc[i]); acc[i] = sum_x32(acc[i]); }
        if (eg == 0) {
            float* xr = DRY ? (float*)(ws + OFF_R + 16 * MB) + (long)tok * DM + col0 : x + (long)tok * DM + col0;
#pragma unroll
            for (int c = 0; c < 4; ++c) {
                const f32x4 gv = gfv[c];
                f32x4 o;
                o.x = xv[c].x + gv.x * acc[4 * c + 0]; o.y = xv[c].y + gv.y * acc[4 * c + 1];
                o.z = xv[c].z + gv.z * acc[4 * c + 2]; o.w = xv[c].w + gv.w * acc[4 * c + 3];
                *(f32x4*)(xr + 4 * c) = o;
            }
            const int tn = tok + nwv < NTOK ? tok + nwv : wv;
#pragma unroll
            for (int c = 0; c < 4; ++c) xv[c] = *(const f32x4*)(x + (long)tn * DM + col0 + 4 * c);
        }
#endif
        s3 = sl1;
    }
    asm volatile("s_waitcnt vmcnt(0)" ::: "memory");
}

DI void norm_row_q8(const f32x4 (&v)[4], float rstd, const float* gain, const float* shift, const float* scale, unsigned char* orow, float* os, int lane) {
    f32x4 y[4]; float am = 0.f;
#pragma unroll
    for (int j = 0; j < 4; ++j) {
        const int c = 4 * lane + 256 * j;
        const f32x4 g = *(const f32x4*)(gain + c), sh = *(const f32x4*)(shift + c), sc = *(const f32x4*)(scale + c);
        y[j].x = v[j].x * rstd * g.x * (1.f + sc.x) + sh.x; y[j].y = v[j].y * rstd * g.y * (1.f + sc.y) + sh.y;
        y[j].z = v[j].z * rstd * g.z * (1.f + sc.z) + sh.z; y[j].w = v[j].w * rstd * g.w * (1.f + sc.w) + sh.w;
        am = fmaxf(am, fmaxf(fmaxf(fabsf(y[j].x), fabsf(y[j].y)), fmaxf(fabsf(y[j].z), fabsf(y[j].w))));
    }
    am = wave_max(am);
    const float qs = am > 0.f ? 127.f / am : 1.f;
#pragma unroll
    for (int j = 0; j < 4; ++j) *(int*)(orow + 4 * lane + 256 * j) = pack_i8x4(y[j].x * qs, y[j].y * qs, y[j].z * qs, y[j].w * qs);
    if (lane == 0) *os = am > 0.f ? am * (1.f / 127.f) : 1.f;
}
DI void phase_norm2(const float* __restrict__ x, unsigned char* __restrict__ out1, float* __restrict__ os1, const float* gain1, int sh1, int sc1,
                    unsigned char* __restrict__ out2, float* __restrict__ os2, const float* gain2, int sh2, int sc2, const float* ada, int tid) {
    const int lane = tid & 63, gw = blockIdx.x * NWAVES + (tid >> 6), nw = gridDim.x * NWAVES;
    for (int tok = gw; tok < NTOK; tok += nw) {
        const int b = tok >> 13;
        f32x4 v[4]; float ss = 0.f;
#pragma unroll
        for (int j = 0; j < 4; ++j) { v[j] = *(const f32x4*)(x + (long)tok * DM + 4 * lane + 256 * j); ss += v[j].x * v[j].x + v[j].y * v[j].y + v[j].z * v[j].z + v[j].w * v[j].w; }
        const float rstd = rsqrtf(wave_sum(ss) * (1.f / DM) + EPS);
        norm_row_q8(v, rstd, gain1, ada + b * ADA_STRIDE + sh1, ada + b * ADA_STRIDE + sc1, out1 + (long)tok * DM, os1 + tok, lane);
        norm_row_q8(v, rstd, gain2, ada + b * ADA_STRIDE + sh2, ada + b * ADA_STRIDE + sc2, out2 + (long)tok * DM, os2 + tok, lane);
    }
}

template <int MT, class Epi>
DI void gemm_phase(const bf16_t* A, long lda, int M, const bf16_t* Bt, long ldb, int N, int K, const Epi& epi, unsigned char* lds, int tid) {
    const int ntm = (M + 128 * MT - 1) / (128 * MT), ntn = (N + 255) / 256, nt = ntm * ntn;
    if ((gridDim.x & 7) == 0 && (ntm & 31) == 0) {
        const int xcd = blockIdx.x & 7, lb = blockIdx.x >> 3, nlb = gridDim.x >> 3, tmx = ntm >> 3, per = tmx * ntn;
        for (int q = lb; q < per; q += nlb) {
            const int g4 = q / (4 * ntn), rem = q - g4 * 4 * ntn, tn = rem >> 2, tm = xcd * tmx + g4 * 4 + (rem & 3);
            if (tm < (xcd + 1) * tmx) gemm_tile<MT>(A, lda, M, Bt, ldb, N, K, tm * 128 * MT, tn * 256, epi, lds, tid);
        }
        return;
    }
    for (int t = blockIdx.x; t < nt; t += gridDim.x) {
        const int tn = t / ntm, tm = t % ntm;
        gemm_tile<MT>(A, lda, M, Bt, ldb, N, K, tm * 128 * MT, tn * 256, epi, lds, tid);
    }
}

template <int MT, class Epi>
DI void gemm_tile_i8(const unsigned char* __restrict__ A, int M, const float* __restrict__ as, const unsigned char* __restrict__ Bt, int N, const float* __restrict__ bs,
                     int K, int m0, int n0, const Epi& epi, unsigned char* lds, int tid) {
    constexpr int XS = MT * 128 * 128, WS = 256 * 128, STAGE = XS + WS;
    const int lane = tid & 63, w = tid >> 6, tg = w & 3, fh = w >> 2, r = lane & 31, h = lane >> 5;
    const int wbase = tid & ~63;
    unsigned xo[2 * MT], wo[4];
#pragma unroll
    for (int i = 0; i < 2 * MT; ++i) { int row, c; sw2_src(tid + 512 * i, row, c); int m = m0 + row; m = m < M ? m : M - 1; xo[i] = (unsigned)m * (unsigned)K + c * 16; }
#pragma unroll
    for (int i = 0; i < 4; ++i) { int row, c; sw2_src(tid + 512 * i, row, c); int n = n0 + row; n = n < N ? n : N - 1; wo[i] = (unsigned)n * (unsigned)K + c * 16; }
    auto stage = [&](int kt, unsigned char* st) {
#pragma unroll
        for (int i = 0; i < 2 * MT; ++i)
            __builtin_amdgcn_global_load_lds((const unsigned*)(A + kt * 128 + xo[i]), (unsigned*)(st + (wbase + 512 * i) * 16), 16, 0, 0);
#pragma unroll
        for (int i = 0; i < 4; ++i)
            __builtin_amdgcn_global_load_lds((const unsigned*)(Bt + kt * 128 + wo[i]), (unsigned*)(st + XS + (wbase + 512 * i) * 16), 16, 0, 0);
    };
    i32x16 acc[MT][4];
#pragma unroll
    for (int s2 = 0; s2 < MT; ++s2)
#pragma unroll
        for (int i = 0; i < 4; ++i)
#pragma unroll
            for (int j = 0; j < 16; ++j) acc[s2][i][j] = 0;
    const int nk = K >> 7;
    stage(0, lds);
    __syncthreads();
#pragma unroll 2
    for (int kt = 0; kt < nk; ++kt) {
        unsigned char* cur = lds + (kt & 1) * STAGE;
        if (kt + 1 < nk) stage(kt + 1, lds + ((kt + 1) & 1) * STAGE);
        i32x4 xfa[MT], wfa[4], xfb[MT], wfb[4];
        auto ldf = [&](i32x4 (&xf)[MT], i32x4 (&wf)[4], int ks) {
#pragma unroll
            for (int s2 = 0; s2 < MT; ++s2) xf[s2] = *(const i32x4*)(cur + sw2(32 * MT * tg + 32 * s2 + r, 2 * ks + h));
#pragma unroll
            for (int mt = 0; mt < 4; ++mt) wf[mt] = *(const i32x4*)(cur + XS + sw2(128 * fh + 32 * mt + r, 2 * ks + h));
        };
        auto mm = [&](const i32x4 (&xf)[MT], const i32x4 (&wf)[4]) {
#pragma unroll
            for (int mt = 0; mt < 4; ++mt)
#pragma unroll
                for (int s2 = 0; s2 < MT; ++s2) acc[s2][mt] = MFMA32I8(wf[mt], xf[s2], acc[s2][mt]);
        };
        ldf(xfa, wfa, 0);
        ldf(xfb, wfb, 1); __builtin_amdgcn_sched_barrier(0); mm(xfa, wfa); __builtin_amdgcn_sched_barrier(0);
        ldf(xfa, wfa, 2); __builtin_amdgcn_sched_barrier(0); mm(xfb, wfb); __builtin_amdgcn_sched_barrier(0);
        ldf(xfb, wfb, 3); __builtin_amdgcn_sched_barrier(0); mm(xfa, wfa); __builtin_amdgcn_sched_barrier(0);
        mm(xfb, wfb);
        __syncthreads();
    }
    auto fin = [&](const i32x16 (&ai)[4], int s2, int ho, int ro, int to) {
        const int tok = m0 + 32 * MT * tg + 32 * s2 + ro, fbase = n0 + 128 * fh;
        const float sa = as[tok < M ? tok : M - 1];
        f32x16 af[4];
#pragma unroll
        for (int mt = 0; mt < 4; ++mt) {
#pragma unroll
            for (int g4 = 0; g4 < 4; ++g4) {
                int f0 = fbase + 32 * mt + 8 * g4 + 4 * ho; f0 = f0 + 3 < N ? f0 : (N - 4 > 0 ? N - 4 : 0);
                const f32x4 sb = *(const f32x4*)(bs + f0);
                af[mt][4 * g4 + 0] = (float)ai[mt][4 * g4 + 0] * (sa * sb.x); af[mt][4 * g4 + 1] = (float)ai[mt][4 * g4 + 1] * (sa * sb.y);
                af[mt][4 * g4 + 2] = (float)ai[mt][4 * g4 + 2] * (sa * sb.z); af[mt][4 * g4 + 3] = (float)ai[mt][4 * g4 + 3] * (sa * sb.w);
            }
            __builtin_amdgcn_sched_barrier(0);
        }
        epi(af, tok, fbase, ho, lds, to);
        __builtin_amdgcn_sched_barrier(0);
    };
    if constexpr (MT == 2 && epi_stash<Epi>::present) {
        int* sp = (int*)lds + w * 4096 + lane;
#pragma unroll
        for (int mt = 0; mt < 4; ++mt)
#pragma unroll
            for (int j = 0; j < 16; ++j) sp[(mt * 16 + j) * 64] = acc[1][mt][j];
        int ho = h, ro = r, to = tid;
        asm volatile("" : "+v"(ho), "+v"(ro), "+v"(to));
        fin(acc[0], 0, ho, ro, to);
        i32x16 a2[4];
        const int* sp2 = sp; asm volatile("" : "+v"(sp2));
#pragma unroll
        for (int mt = 0; mt < 4; ++mt)
#pragma unroll
            for (int j = 0; j < 16; ++j) a2[mt][j] = sp2[(mt * 16 + j) * 64];
        asm volatile("" : "+v"(ho), "+v"(ro), "+v"(to));
        fin(a2, 1, ho, ro, to);
        __syncthreads();
    } else {
        int ho = h, ro = r, to = tid;
#pragma unroll
        for (int s2 = 0; s2 < MT; ++s2) { asm volatile("" : "+v"(ho), "+v"(ro), "+v"(to)); fin(acc[s2], s2, ho, ro, to); }
    }
}
template <int MT, class Epi>
DI void gemm_phase_i8(const unsigned char* A, int M, const float* as, const unsigned char* Bt, int N, const float* bs, int K, const Epi& epi, unsigned char* lds, int tid,
                      int skip = 0) {
    const int ntm = (M + 128 * MT - 1) / (128 * MT), ntn = (N + 255) / 256, nt = ntm * ntn;
    const int bid = (int)blockIdx.x - skip, nbl = (int)gridDim.x - skip;
    if (bid < 0) return;
    if ((gridDim.x & 7) == 0 && (ntm & 31) == 0) {
        const int xcd = bid & 7, lb = bid >> 3, nlb = nbl >> 3, tmx = ntm >> 3, per = tmx * ntn;
        for (int q = lb; q < per; q += nlb) {
            const int g4 = q / (4 * ntn), rem = q - g4 * 4 * ntn, tn = rem >> 2, tm = xcd * tmx + g4 * 4 + (rem & 3);
            gemm_tile_i8<MT>(A, M, as, Bt, N, bs, K, tm * 128 * MT, tn * 256, epi, lds, tid);
        }
        return;
    }
    for (int t = bid; t < nt; t += nbl) {
        const int tn = t / ntm, tm = t % ntm;
        gemm_tile_i8<MT>(A, M, as, Bt, N, bs, K, tm * 128 * MT, tn * 256, epi, lds, tid);
    }
}

DI void wquant_rows(const bf16_t* __restrict__ src, unsigned char* __restrict__ dst, float* __restrict__ sc, int nrows, int gw, int nw, int lane) {
    for (int n = gw; n < nrows; n += nw) {
        const u32x4 a = *(const u32x4*)(src + (long)n * 1024 + 16 * lane), b = *(const u32x4*)(src + (long)n * 1024 + 16 * lane + 8);
        float v[16];
        v[0] = bflo(a.x); v[1] = bfhi(a.x); v[2] = bflo(a.y); v[3] = bfhi(a.y); v[4] = bflo(a.z); v[5] = bfhi(a.z); v[6] = bflo(a.w); v[7] = bfhi(a.w);
        v[8] = bflo(b.x); v[9] = bfhi(b.x); v[10] = bflo(b.y); v[11] = bfhi(b.y); v[12] = bflo(b.z); v[13] = bfhi(b.z); v[14] = bflo(b.w); v[15] = bfhi(b.w);
        float am = 0.f;
#pragma unroll
        for (int q = 0; q < 16; ++q) am = fmaxf(am, fabsf(v[q]));
        am = wave_max(am);
        const float qs = am > 0.f ? 127.f / am : 1.f;
        u32x4 o;
        o.x = (unsigned)pack_i8x4(v[0] * qs, v[1] * qs, v[2] * qs, v[3] * qs); o.y = (unsigned)pack_i8x4(v[4] * qs, v[5] * qs, v[6] * qs, v[7] * qs);
        o.z = (unsigned)pack_i8x4(v[8] * qs, v[9] * qs, v[10] * qs, v[11] * qs); o.w = (unsigned)pack_i8x4(v[12] * qs, v[13] * qs, v[14] * qs, v[15] * qs);
        *(u32x4*)(dst + (long)n * 1024 + 16 * lane) = o;
        if (lane == 0) sc[n] = am > 0.f ? am * (1.f / 127.f) : 1.f;
    }
}
DI void phase_wquant(unsigned char* ws, int tid) {
    const int lane = tid & 63, gw = blockIdx.x * NWAVES + (tid >> 6), nw = gridDim.x * NWAVES;
    float* sc = (float*)(ws + OFF_W8S);
    wquant_rows((const bf16_t*)(ws + OFF_WT_PEER), ws + OFF_W8_PEER, sc + W8S_PEER, 4096, gw, nw, lane);
    wquant_rows((const bf16_t*)(ws + OFF_WT_DIN), ws + OFF_W8_DIN, sc + W8S_DIN, 3072, gw, nw, lane);
    wquant_rows((const bf16_t*)(ws + OFF_WT_KV), ws + OFF_W8_KV, sc + W8S_KV, 1536, gw, nw, lane);
    wquant_rows((const bf16_t*)(ws + OFF_WT_NIN), ws + OFF_W8_NIN, sc + W8S_NIN, 1088, gw, nw, lane);
}

#define XB_TMO      128
#define XB_XCNT(j)  (256  + 64 * (j))
#define XB_XSUB(j)  (1280 + 64 * (j))
#define XB_XGEN(j)  (2304 + 64 * (j))
#define XB_TOP      3328
#define XB_TOPGEN   3392
#define XCD_BAR_WORDS 3456
#define XB_SPIN_CAP (1u << 22)
DI unsigned xb_ld(unsigned* p) { return __hip_atomic_load(p, __ATOMIC_RELAXED, __HIP_MEMORY_SCOPE_AGENT); }
DI unsigned xb_add(unsigned* p, unsigned v) { return __hip_atomic_fetch_add(p, v, __ATOMIC_RELAXED, __HIP_MEMORY_SCOPE_AGENT); }
DI unsigned xb_xcc_id() { return (unsigned)__builtin_amdgcn_s_getreg((3 << 11) | 20) & 0xFu; }
#define XB_SPIN(cond, bar) do { unsigned _sp = 0; while (cond) { __builtin_amdgcn_s_sleep(1); \
    if ((++_sp & 255u) == 0u) { if (xb_ld(&(bar)[XB_TMO])) break; if (_sp > XB_SPIN_CAP) { atomicAdd(&(bar)[XB_TMO], 1u); break; } } } } while (0)
DI void xcd_barrier_complete(unsigned* bar, unsigned x, unsigned& nloc, unsigned& nx) {
    const unsigned G = gridDim.x;
    unsigned sum, cnt, mine, sp = 0u;
    for (;;) {
        sum = 0u; cnt = 0u; mine = 0u;
#pragma unroll
        for (unsigned j = 0; j < 16; ++j) { const unsigned c = xb_ld(&bar[XB_XCNT(j)]); sum += c; cnt += (c > 0u) ? 1u : 0u; mine = (j == x) ? c : mine; }
        if (sum == G) break;
        __builtin_amdgcn_s_sleep(1);
        if ((++sp & 255u) == 0u) { if (xb_ld(&bar[XB_TMO])) break; if (sp > XB_SPIN_CAP) { atomicAdd(&bar[XB_TMO], 1u); break; } }
    }
    nloc = mine > 0u ? mine : 1u; nx = cnt > 0u ? cnt : 1u;
}
DI void xcd_barrier(unsigned* bar, volatile LAS unsigned* st, int tid) {
    asm volatile("s_waitcnt vmcnt(0)" ::: "memory");
    __syncthreads();
    if (tid == 0) {
        const unsigned x = xb_xcc_id();
        __builtin_amdgcn_s_waitcnt(0);
        unsigned nloc = st[0], nx = st[1];
        if (nloc == 0u) { xcd_barrier_complete(bar, x, nloc, nx); st[0] = nloc; st[1] = nx; }
        const unsigned old = xb_add(&bar[XB_XSUB(x)], 1u);
        const unsigned gen = old / nloc;
        if (old + 1u == (gen + 1u) * nloc) {
            __builtin_amdgcn_fence(__ATOMIC_RELEASE, "agent");
            asm volatile("s_waitcnt vmcnt(0)" ::: "memory");
            const unsigned og = xb_add(&bar[XB_TOP], 1u);
            const unsigned tg = og / nx;
            if (og + 1u == (tg + 1u) * nx) xb_add(&bar[XB_TOPGEN], 1u);
            else XB_SPIN(xb_ld(&bar[XB_TOPGEN]) == tg, bar);
            __builtin_amdgcn_fence(__ATOMIC_ACQUIRE, "agent");
            xb_add(&bar[XB_XGEN(x)], 1u);
            asm volatile("s_waitcnt vmcnt(0)" ::: "memory");
        } else {
            XB_SPIN(xb_ld(&bar[XB_XGEN(x)]) == gen, bar);
            __builtin_amdgcn_fence(__ATOMIC_ACQUIRE, "agent");
            asm volatile("s_waitcnt vmcnt(0)" ::: "memory");
        }
    }
    __syncthreads();
}

#define ftid() ftid_(wave_u)
DI int ftid_(int wave_u) { int t = (wave_u << 6) + (int)__builtin_amdgcn_mbcnt_hi(~0u, __builtin_amdgcn_mbcnt_lo(~0u, 0u)); asm volatile("" : "+v"(t)); return t; }


#if defined(__HIP_DEVICE_COMPILE__)
typedef const __attribute__((address_space(4))) Params* KParamPtr;
DI Params load_params() { KParamPtr kp = (KParamPtr)__builtin_amdgcn_kernarg_segment_ptr(); asm volatile("" : "+s"(kp)); return *kp; }
#else
DI Params load_params() { return Params{}; }
#endif
#define p (load_params())
#define ws (load_params().ws)
#define ada ((const float*)(ws + OFF_ADA))
#define Hb ((bf16_t*)(ws + OFF_H))
#define bar ((unsigned*)(ws + OFF_BAR))
__global__ void __launch_bounds__(NTHREADS) yoco_fwd(Params p_arg) {
    extern __shared__ __attribute__((aligned(16))) unsigned char lds[];
    cg::grid_group grid = cg::this_grid();
    volatile LAS unsigned* bst = (volatile LAS unsigned*)(lds + LDS_BAR);
    const int wave_u = __builtin_amdgcn_readfirstlane((int)(threadIdx.x >> 6));
    { const int t0 = ftid(); if (t0 == 0) { bst[0] = 0u; bst[1] = 0u; }
      if (blockIdx.x == 0) for (int i = t0; i < XCD_BAR_WORDS; i += NTHREADS) bar[i] = 0u; }
    __syncthreads();
    RUN(0) REP(0) phase_prep(p, lds, ftid());
    grid.sync();
    if (ftid() == 0) (void)xb_add(&bar[XB_XCNT(xb_xcc_id())], 1u);
    RUN(1) REP(1) phase_norm_q8<false>(p.in[0], Hb, ws + OFF_H8, (float*)(ws + OFF_HS), p.in[5], ada, 0, 1024, ftid());
    RUN(1) phase_wquant(ws, ftid());
    xcd_barrier(bar, bst, ftid());
    RUN(2) REP(2) {
        EpiQKV0 e{(bf16_t*)(ws + OFF_Q0), (bf16_t*)(ws + OFF_K0), (bf16_t*)(ws + OFF_VT0), p.in[10], p.in[11], (float*)(ws + OFF_MB0), p.in[2]};
        gemm_phase_i8<2>(ws + OFF_H8, NTOK, (const float*)(ws + OFF_HS), ws + OFF_W8_DIN, 3072, (const float*)(ws + OFF_W8S) + W8S_DIN, DM, e, lds, ftid());
    }
    xcd_barrier(bar, bst, ftid());
    RUN(3) REP(3) phase_diff_attn(p, lds, ftid());
    xcd_barrier(bar, bst, ftid());
    RUN(4) REP(4) {
        EpiResid e{p.in[0], opq(p.out), ada + 2 * 1024};
        gemm_phase<2>(Hb, DM, NTOK, (const bf16_t*)(ws + OFF_WT_DOUT), DM, 1024, DM, e, lds, ftid());
    }
    xcd_barrier(bar, bst, ftid());
    if (STOP_AFTER <= 1) return;
    RUN(1) phase_norm_q8<false>(opq(p.out), Hb, ws + OFF_H8, (float*)(ws + OFF_HS), p.in[6], ada, 3 * 1024, 4 * 1024, ftid());
    xcd_barrier(bar, bst, ftid());
    RUN(5) REP(5) {
        EpiPeer e{(int*)(ws + OFF_RIDX), (float*)(ws + OFF_RGATE), 128 * 1024};
        gemm_phase_i8<2>(ws + OFF_H8, NTOK, (const float*)(ws + OFF_HS), ws + OFF_W8_PEER, 2048, (const float*)(ws + OFF_W8S) + W8S_PEER, DM, e, lds, ftid());
    }
    xcd_barrier(bar, bst, ftid());
    if ((REPEAT_MASK >> 6) & 1) phase_peer_u<true>(p, 0, lds, ftid());
    RUN(6) phase_peer_u<false>(p, 0, lds, ftid());
    xcd_barrier(bar, bst, ftid());
    if ((REPEAT_MASK >> 10) & 1) phase_peer_v<true>(p, 0, lds, ftid());
    RUN(6) phase_peer_v<false>(p, 0, lds, ftid());
    xcd_barrier(bar, bst, ftid());
    RUN(1) phase_norm2(opq(p.out), ws + OFF_H8, (float*)(ws + OFF_HS), p.in[13], 12288, 12288 + 1024, ws + OFF_H, (float*)(ws + OFF_HS) + NTOK, p.in[5] + 1024, 6144, 6144 + 1024, ada, ftid());
    xcd_barrier(bar, bst, ftid());
    if (STOP_AFTER <= 2) return;
    RUN(7) REP(7) {
        EpiKV e{(bf16_t*)(ws + OFF_KC), (bf16_t*)(ws + OFF_KS), (bf16_t*)(ws + OFF_VST), (bf16_t*)(ws + OFF_KW), (bf16_t*)(ws + OFF_VWT), p.in[21]};
        gemm_phase_i8<2>(ws + OFF_H8, NTOK, (const float*)(ws + OFF_HS), ws + OFF_W8_KV, 1536, (const float*)(ws + OFF_W8S) + W8S_KV, DM, e, lds, ftid());
    }
    xcd_barrier(bar, bst, ftid());
    RUN(8) REP(8) {
        EpiNsaQ e{(bf16_t*)(ws + OFF_QN), (float*)(ws + OFF_GATES), p.in[25], p.in[23], (float*)(ws + OFF_MB1)};
        gemm_phase_i8<2>(ws + OFF_H, NTOK, (const float*)(ws + OFF_HS) + NTOK, ws + OFF_W8_NIN, 1048, (const float*)(ws + OFF_W8S) + W8S_NIN, DM, e, lds, ftid(),
                         gridDim.x >= 128 ? 64 : 0);
        for (int t = blockIdx.x; t < 64; t += gridDim.x) {
            const int pr = t >> 2, tm = t & 3, kv = pr >> 3, bg = pr & 7;
            const bf16_t* Ap = (const bf16_t*)(ws + OFF_KC) + (long)(kv * 8 + bg) * SEQ * 128;
            bf16_t* hid = (bf16_t*)(ws + OFF_HID) + (long)pr * 512 * 256;
            EpiCmp1 e1{hid, (const float*)(ws + OFF_POSB) + kv * 16 * 256, p.in[19] + kv * 256};
            gemm_tile<1>(Ap, 2048, 511, (const bf16_t*)(ws + OFF_WT_C1) + (long)kv * 256 * 4096, 4096, 256, 4096, tm * 128, 0, e1, lds, ftid());
            __syncthreads();
            bf16_t* dst = kv == 0 ? (bf16_t*)(ws + OFF_KCMP) + (long)bg * 512 * 128 : (bf16_t*)(ws + OFF_VCMPT) + (long)bg * 128 * 512;
            EpiCmp2 e2{dst, p.in[21], kv};
            gemm_tile<1>(hid, 256, 512, (const bf16_t*)(ws + OFF_WT_C2) + (long)kv * 128 * 256, 256, 128, 256, tm * 128, 0, e2, lds, ftid());
        }
    }
    xcd_barrier(bar, bst, ftid());
#ifdef NSA_PROBE
    phase_nsa_attn<NSA_PROBE>(p, lds, ftid());
#endif
    RUN(9) REP(9) phase_nsa_attn<0>(p, lds, ftid());
    xcd_barrier(bar, bst, ftid());
    RUN(4) {
        float* xo = opq(p.out);
        EpiResid e{xo, xo, ada + 6144 + 2 * 1024};
        gemm_phase<2>(Hb, DM, NTOK, (const bf16_t*)(ws + OFF_WT_NOUT), DM, 1024, DM, e, lds, ftid());
    }
    xcd_barrier(bar, bst, ftid());
    if (STOP_AFTER <= 3) return;
    RUN(1) phase_norm_q8<false>(opq(p.out), Hb, ws + OFF_H8, (float*)(ws + OFF_HS), p.in[6] + 1024, ada, 6144 + 3 * 1024, 6144 + 4 * 1024, ftid());
    xcd_barrier(bar, bst, ftid());
    RUN(5) REP(5) {
        EpiPeer e{(int*)(ws + OFF_RIDX), (float*)(ws + OFF_RGATE), 128 * 1024};
        gemm_phase_i8<2>(ws + OFF_H8, NTOK, (const float*)(ws + OFF_HS), ws + OFF_W8_PEER + (long)2048 * 1024, 2048, (const float*)(ws + OFF_W8S) + W8S_PEER + 2048, DM, e, lds, ftid());
    }
    xcd_barrier(bar, bst, ftid());
    if ((REPEAT_MASK >> 6) & 1) phase_peer_u<true>(p, 1, lds, ftid());
    RUN(6) phase_peer_u<false>(p, 1, lds, ftid());
    xcd_barrier(bar, bst, ftid());
    if ((REPEAT_MASK >> 10) & 1) phase_peer_v<true>(p, 1, lds, ftid());
    RUN(6) phase_peer_v<false>(p, 1, lds, ftid());
}
#undef p
#undef ws
#undef ada
#undef Hb
#undef bar

extern "C" void kernel_launch(void* const* d_in, const int* in_sizes, int n_in, void* d_out, int out_size, void* d_ws, size_t ws_size,
                              hipStream_t stream) {
    static int grid_blocks = 0;
    if (grid_blocks == 0) {
        if (n_in != 30 || out_size != NTOK * DM || ws_size < WS_END) {
            fprintf(stderr, "kernel_launch: unexpected shapes (n_in %d out %d ws %zu)\n", n_in, out_size, ws_size);
            grid_blocks = -1; return;
        }
        int dev = 0, cus = 0, per_cu = 0;
        hipGetDevice(&dev);
        hipDeviceGetAttribute(&cus, hipDeviceAttributeMultiprocessorCount, dev);
        hipFuncSetAttribute((const void*)yoco_fwd, hipFuncAttributeMaxDynamicSharedMemorySize, LDS_BYTES);
        hipOccupancyMaxActiveBlocksPerMultiprocessor(&per_cu, (const void*)yoco_fwd, NTHREADS, LDS_BYTES);
        if (per_cu < 1) { fprintf(stderr, "kernel_launch: occupancy query says %d blocks per CU\n", per_cu); grid_blocks = -1; return; }
        grid_blocks = cus;
    }
    if (grid_blocks < 0) return;
    Params p{};
    for (int i = 0; i < 30; ++i) p.in[i] = (const float*)d_in[i];
    p.out = (float*)d_out;
    p.ws = (unsigned char*)d_ws;
    void* args[] = {&p};
    hipError_t e = hipLaunchCooperativeKernel((const void*)yoco_fwd, dim3(grid_blocks), dim3(NTHREADS), args, LDS_BYTES, stream);
    if (e != hipSuccess) fprintf(stderr, "cooperative launch failed: %s (grid %d)\n", hipGetErrorString(e), grid_blocks);
}
```

```cpp
#include <hip/hip_runtime.h>
#include <hip/hip_cooperative_groups.h>
#include <cstdio>
#include <cstdint>
namespace cg = cooperative_groups;

#define DI __device__ __forceinline__
#ifndef STOP_AFTER
#define STOP_AFTER 99
#endif
#ifndef ONLY_PHASE
#define ONLY_PHASE -1
#endif
#define RUN(n) if (ONLY_PHASE < 0 || ONLY_PHASE == (n))
#ifndef REPEAT_MASK
#define REPEAT_MASK 0
#endif
#define REP(n) for (int rep_ = 0; rep_ < (((REPEAT_MASK) >> (n)) & 1) + 1; ++rep_)

typedef unsigned short bf16_t;
typedef short bf16x8 __attribute__((ext_vector_type(8)));
typedef float f32x16 __attribute__((ext_vector_type(16)));
typedef float f32x4 __attribute__((ext_vector_type(4)));
typedef float f32x2 __attribute__((ext_vector_type(2)));
typedef unsigned u32x4 __attribute__((ext_vector_type(4)));
typedef unsigned u32x2 __attribute__((ext_vector_type(2)));
typedef __bf16 bf16x2v __attribute__((ext_vector_type(2)));

#define MFMA32(a, b, c) __builtin_amdgcn_mfma_f32_32x32x16_bf16((a), (b), (c), 0, 0, 0)
typedef int i32x4 __attribute__((ext_vector_type(4)));
typedef int i32x16 __attribute__((ext_vector_type(16)));
#define MFMA32I8(a, b, c) __builtin_amdgcn_mfma_i32_32x32x32_i8((a), (b), (c), 0, 0, 0)

constexpr int NB = 4, SEQ = 8192, DM = 1024, NTOK = NB * SEQ;
constexpr int NTHREADS = 512, NWAVES = 8;
constexpr float EPS = 1e-6f;
constexpr float LOG2E = 1.4426950408889634f;
constexpr int ADA_STRIDE = 14336;

constexpr size_t MB = 1u << 20;
constexpr size_t OFF_ADA = 0;
constexpr size_t OFF_POSB = 256 * 1024;
constexpr size_t OFF_BAR = 320 * 1024;
constexpr size_t OFF_MB0 = 168 * MB;
constexpr size_t OFF_MB1 = 172 * MB;
constexpr size_t OFF_H8 = 104 * MB;
constexpr size_t OFF_HS = 174 * MB;
constexpr size_t OFF_W8 = 176 * MB;
constexpr size_t OFF_W8_DIN = OFF_W8, OFF_W8_KV = OFF_W8 + 3 * MB, OFF_W8_NIN = OFF_W8 + 5 * MB, OFF_W8_PEER = OFF_W8 + 7 * MB;
constexpr size_t OFF_W8S = 188 * MB;
constexpr int W8S_DIN = 0, W8S_KV = 3072, W8S_NIN = 4608, W8S_PEER = 5760, W8S_TOTAL = 9856;
constexpr size_t OFF_USI = 384 * 1024;
constexpr size_t OFF_VSI = 512 * 1024;
constexpr size_t OFF_WT_DIN = 1 * MB;
constexpr size_t OFF_WT_DOUT = 7 * MB;
constexpr size_t OFF_WT_KV = 9 * MB;
constexpr size_t OFF_WT_NIN = 12 * MB;
constexpr size_t OFF_WT_NOUT = 15 * MB;
constexpr size_t OFF_WT_PEER = 17 * MB;
constexpr size_t OFF_WT_C1 = 25 * MB;
constexpr size_t OFF_WT_C2 = 29 * MB;
constexpr size_t OFF_GATES = 30 * MB;
constexpr size_t OFF_KCMP = 34 * MB;
constexpr size_t OFF_VCMPT = 35 * MB;
constexpr size_t OFF_HID = 36 * MB;
constexpr size_t OFF_RIDX = 40 * MB;
constexpr size_t OFF_RGATE = 56 * MB;
constexpr size_t OFF_PU = 72 * MB;
constexpr size_t OFF_PV = 136 * MB;
constexpr size_t OFF_H = 200 * MB;
constexpr size_t OFF_R = 264 * MB;
constexpr size_t WS_END = 456 * MB;
constexpr size_t OFF_Q0 = OFF_R, OFF_K0 = OFF_R + 64 * MB, OFF_VT0 = OFF_R + 128 * MB;
constexpr size_t OFF_QN = OFF_R, OFF_H2 = OFF_R, OFF_KC = OFF_R + 64 * MB, OFF_KS = OFF_R + 96 * MB, OFF_VST = OFF_R + 112 * MB,
                 OFF_KW = OFF_R + 128 * MB, OFF_VWT = OFF_R + 144 * MB;

constexpr int LDS_BAR = 159 * 1024;
constexpr int LDS_BYTES = LDS_BAR + 256;

struct Params {
    const float* in[30];
    float* out;
    unsigned char* ws;
};

template <class T> DI T* opq(T* q) { asm volatile("" : "+s"(q)); return (T*)(__attribute__((address_space(1))) T*)q; }
DI unsigned pk2(float lo, float hi) { f32x2 v = {lo, hi}; return __builtin_bit_cast(unsigned, __builtin_convertvector(v, bf16x2v)); }
DI bf16_t f2bf(float x) { return (bf16_t)(pk2(x, 0.f) & 0xffffu); }
DI float bflo(unsigned u) { return __uint_as_float(u << 16); }
DI float bfhi(unsigned u) { return __uint_as_float(u & 0xffff0000u); }
DI float fexp2(float x) { return __builtin_amdgcn_exp2f(x); }
DI float frcp(float x) { return __builtin_amdgcn_rcpf(x); }
DI int crow(int reg, int h) { return (reg & 3) + 8 * (reg >> 2) + 4 * h; }
template <int CTRL> DI float dpp_f(float v) { return __builtin_bit_cast(float, __builtin_amdgcn_update_dpp(0, __builtin_bit_cast(int, v), CTRL, 0xF, 0xF, true)); }
DI float lx1(float v) { return dpp_f<0xB1>(v); }
DI float lx2(float v) { return dpp_f<0x4E>(v); }
DI float lhm(float v) { return dpp_f<0x141>(v); }
DI float lr8(float v) { return dpp_f<0x128>(v); }
DI float sum_x16(float v) { auto s = __builtin_amdgcn_permlane16_swap(__float_as_uint(v), __float_as_uint(v), false, false); return __uint_as_float(s[0]) + __uint_as_float(s[1]); }
DI float sum_x32(float v) { auto s = __builtin_amdgcn_permlane32_swap(__float_as_uint(v), __float_as_uint(v), false, false); return __uint_as_float(s[0]) + __uint_as_float(s[1]); }
DI float max_x16(float v) { auto s = __builtin_amdgcn_permlane16_swap(__float_as_uint(v), __float_as_uint(v), false, false); return fmaxf(__uint_as_float(s[0]), __uint_as_float(s[1])); }
DI float max_x32(float v) { auto s = __builtin_amdgcn_permlane32_swap(__float_as_uint(v), __float_as_uint(v), false, false); return fmaxf(__uint_as_float(s[0]), __uint_as_float(s[1])); }
DI unsigned get_x32(unsigned v, int h) { auto s = __builtin_amdgcn_permlane32_swap(v, v, false, false); return h ? s[0] : s[1]; }
DI float wave_sum(float v) { v += lx1(v); v += lx2(v); v += lhm(v); v += lr8(v); v = sum_x16(v); return sum_x32(v); }
DI float wave_max(float v) { v = fmaxf(v, lx1(v)); v = fmaxf(v, lx2(v)); v = fmaxf(v, lhm(v)); v = fmaxf(v, lr8(v)); v = max_x16(v); return max_x32(v); }
DI int bperm(int v, int srclane) { return __builtin_amdgcn_ds_bpermute(srclane << 2, v); }
DI float bpermf(float v, int srclane) { return __builtin_bit_cast(float, __builtin_amdgcn_ds_bpermute(srclane << 2, __builtin_bit_cast(int, v))); }
DI float gelu_tanh(float x) {
    const float u = 0.7978845608028654f * (x + 0.044715f * x * x * x);
    return x * frcp(1.f + fexp2(-2.f * LOG2E * u));
}
DI float dot2bf(unsigned a, unsigned b, float c) {
    return __builtin_amdgcn_fdot2_f32_bf16(__builtin_bit_cast(bf16x2v, a), __builtin_bit_cast(bf16x2v, b), c, false);
}
DI int rel_bucket_i(int d) {
    if (d < 16) return d < 0 ? 0 : d;
    int b = 16;
    b += d >= 21; b += d >= 27; b += d >= 35; b += d >= 46; b += d >= 59; b += d >= 77; b += d >= 99; b += d >= 128;
    b += d >= 166; b += d >= 216; b += d >= 280; b += d >= 363; b += d >= 470; b += d >= 609; b += d >= 790;
    return b;
}
DI unsigned f2key(float f) { unsigned u = __float_as_uint(f); return u ^ ((unsigned)((int)u >> 31) | 0x80000000u); }
DI float key2f(unsigned k) { unsigned u = (k & 0x80000000u) ? (k ^ 0x80000000u) : ~k; return __uint_as_float(u); }

constexpr int EPI_LDS = 96 * 1024;

DI int sw2(int row, int chunk) { return (row >> 1) * 256 + (((((row & 1) << 3) | chunk) ^ ((row >> 1) & 15)) << 4); }
DI void sw2_src(int P, int& row, int& chunk) { const int R2 = P >> 4, lc = (P & 15) ^ (R2 & 15); row = 2 * R2 + (lc >> 3); chunk = lc & 7; }

template <class T, class = void> struct epi_stash { static constexpr bool value = false, present = false; };
template <class T> struct epi_stash<T, decltype((void)T::STASH)> { static constexpr bool value = T::STASH, present = true; };

template <int MT, class Epi>
DI void gemm_tile(const bf16_t* __restrict__ A, long lda, int M, const bf16_t* __restrict__ Bt, long ldb, int N, int K,
                  int m0, int n0, const Epi& epi, unsigned char* lds, int tid) {
    constexpr int XS = MT * 128 * 128, WS = 256 * 128, STAGE = XS + WS;
    const int lane = tid & 63, w = tid >> 6, tg = w & 3, fh = w >> 2, r = lane & 31, h = lane >> 5;
    const int wbase = tid & ~63;
    unsigned xo[2 * MT], wo[4];
#pragma unroll
    for (int i = 0; i < 2 * MT; ++i) { int row, c; sw2_src(tid + 512 * i, row, c); int m = m0 + row; m = m < M ? m : M - 1; xo[i] = (unsigned)m * (unsigned)(lda * 2) + c * 16; }
#pragma unroll
    for (int i = 0; i < 4; ++i) { int row, c; sw2_src(tid + 512 * i, row, c); int n = n0 + row; n = n < N ? n : N - 1; wo[i] = (unsigned)n * (unsigned)(ldb * 2) + c * 16; }
    const unsigned char* Ab = (const unsigned char*)A;
    const unsigned char* Bb = (const unsigned char*)Bt;
    auto stage = [&](int kt, unsigned char* st) {
#pragma unroll
        for (int i = 0; i < 2 * MT; ++i)
            __builtin_amdgcn_global_load_lds((const unsigned*)(Ab + kt * 128 + xo[i]), (unsigned*)(st + (wbase + 512 * i) * 16), 16, 0, 0);
#pragma unroll
        for (int i = 0; i < 4; ++i)
            __builtin_amdgcn_global_load_lds((const unsigned*)(Bb + kt * 128 + wo[i]), (unsigned*)(st + XS + (wbase + 512 * i) * 16), 16, 0, 0);
    };
    f32x16 acc[MT][4];
#pragma unroll
    for (int s2 = 0; s2 < MT; ++s2)
#pragma unroll
        for (int i = 0; i < 4; ++i)
#pragma unroll
            for (int j = 0; j < 16; ++j) acc[s2][i][j] = 0.f;
    const int nk = K >> 6;
    stage(0, lds);
    __syncthreads();
    for (int kt = 0; kt < nk; ++kt) {
        unsigned char* cur = lds + (kt & 1) * STAGE;
        if (kt + 1 < nk) stage(kt + 1, lds + ((kt + 1) & 1) * STAGE);
        bf16x8 xfa[MT], wfa[4], xfb[MT], wfb[4];
        auto ldf = [&](bf16x8 (&xf)[MT], bf16x8 (&wf)[4], int ks) {
#pragma unroll
            for (int s2 = 0; s2 < MT; ++s2) xf[s2] = *(const bf16x8*)(cur + sw2(32 * MT * tg + 32 * s2 + r, 2 * ks + h));
#pragma unroll
            for (int mt = 0; mt < 4; ++mt) wf[mt] = *(const bf16x8*)(cur + XS + sw2(128 * fh + 32 * mt + r, 2 * ks + h));
        };
        auto mm = [&](const bf16x8 (&xf)[MT], const bf16x8 (&wf)[4]) {
#pragma unroll
            for (int mt = 0; mt < 4; ++mt)
#pragma unroll
                for (int s2 = 0; s2 < MT; ++s2) acc[s2][mt] = MFMA32(wf[mt], xf[s2], acc[s2][mt]);
        };
        ldf(xfa, wfa, 0);
        ldf(xfb, wfb, 1); __builtin_amdgcn_sched_barrier(0); mm(xfa, wfa); __builtin_amdgcn_sched_barrier(0);
        ldf(xfa, wfa, 2); __builtin_amdgcn_sched_barrier(0); mm(xfb, wfb); __builtin_amdgcn_sched_barrier(0);
        ldf(xfb, wfb, 3); __builtin_amdgcn_sched_barrier(0); mm(xfa, wfa); __builtin_amdgcn_sched_barrier(0);
        mm(xfb, wfb);
        __syncthreads();
    }
    if constexpr (MT == 2 && epi_stash<Epi>::value) {
        float* sp = (float*)lds + w * 4096 + lane;
#pragma unroll
        for (int mt = 0; mt < 4; ++mt)
#pragma unroll
            for (int j = 0; j < 16; ++j) sp[(mt * 16 + j) * 64] = acc[1][mt][j];
        epi(acc[0], m0 + 64 * tg + r, n0 + 128 * fh, h, lds, tid);
        f32x16 a2[4];
        const float* sp2 = sp; asm volatile("" : "+v"(sp2));
#pragma unroll
        for (int mt = 0; mt < 4; ++mt)
#pragma unroll
            for (int j = 0; j < 16; ++j) a2[mt][j] = sp2[(mt * 16 + j) * 64];
        epi(a2, m0 + 64 * tg + 32 + r, n0 + 128 * fh, h, lds, tid);
        __syncthreads();
    } else {
        int ho = h, ro = r, to = tid;
        if constexpr (epi_stash<Epi>::present) asm volatile("" : "+v"(ho), "+v"(ro), "+v"(to));
#pragma unroll
        for (int s2 = 0; s2 < MT; ++s2) epi(acc[s2], m0 + 32 * MT * tg + 32 * s2 + ro, n0 + 128 * fh, ho, lds, to);
    }
}

DI void store_vt_tile(bf16_t* base, long rstride, const f32x16& a, int row0, int h, int lane) {
    const bool odd = lane & 1;
#pragma unroll
    for (int rg = 0; rg < 16; rg += 2) {
        const float xa = lx1(a[rg]), xb = lx1(a[rg + 1]);
        const unsigned wv = odd ? pk2(xb, a[rg + 1]) : pk2(a[rg], xa);
        bf16_t* dp = base + (long)(row0 + crow(odd ? rg + 1 : rg, h)) * rstride - (odd ? 1 : 0);
        *(unsigned*)dp = wv;
    }
}
struct EpiQKV0 {
    bf16_t *Q, *Kk, *VT;
    const float *qg, *kg;
    float* MB; const float* relb;
    DI void operator()(const f32x16 (&acc)[4], int tok, int fbase, int h, unsigned char*, int) const {
        const int sec = fbase >> 10, hd = (fbase & 1023) >> 7, b = tok >> 13, s = tok & (SEQ - 1);
        if (sec < 2) {
            const float* gn = sec == 0 ? qg : kg;
            const float sc = sec == 0 ? 0.125f * LOG2E : 1.f;
            bf16_t* dst = sec == 0 ? Q : Kk;
#pragma unroll
            for (int j = 0; j < 2; ++j) {
                float ss = 0.f;
#pragma unroll
                for (int mt = 0; mt < 2; ++mt)
#pragma unroll
                    for (int rg = 0; rg < 16; ++rg) { const float v = acc[2 * j + mt][rg]; ss += v * v; }
                ss = sum_x32(ss);
                const float rstd = rsqrtf(ss * (1.f / 64.f) + EPS) * sc;
                bf16_t* row = dst + ((long)((b * 8 + hd) * 2 + j) * SEQ + s) * 64;
                float qq = 0.f;
#pragma unroll
                for (int mt = 0; mt < 2; ++mt)
#pragma unroll
                    for (int g4 = 0; g4 < 4; ++g4) {
                        const int d0 = 32 * mt + 8 * g4 + 4 * h;
                        const f32x4 gv = *(const f32x4*)(gn + d0);
                        const float v0 = acc[2 * j + mt][4 * g4 + 0] * rstd * gv.x, v1 = acc[2 * j + mt][4 * g4 + 1] * rstd * gv.y;
                        const float v2 = acc[2 * j + mt][4 * g4 + 2] * rstd * gv.z, v3 = acc[2 * j + mt][4 * g4 + 3] * rstd * gv.w;
                        qq += v0 * v0 + v1 * v1 + v2 * v2 + v3 * v3;
                        u32x2 o;
                        o.x = pk2(v0, v1); o.y = pk2(v2, v3);
                        *(u32x2*)(row + d0) = o;
                    }
                if (sec == 0) {
                    qq = sum_x32(qq);
                    float kmx = 0.f;
                    for (int d = 0; d < 64; ++d) kmx = fmaxf(kmx, fabsf(kg[d]));
                    float bmx = 0.f;
                    for (int bk = 0; bk < 32; ++bk) bmx = fmaxf(bmx, relb[bk * 8 + hd] - relb[31 * 8 + hd]);
                    if (h == 0) MB[(long)((b * 8 + hd) * 2 + j) * SEQ + s] = 1.01f * sqrtf(qq) * 8.f * kmx + bmx * LOG2E;
                }
            }
        } else {
            bf16_t* base = VT + (long)(b * 8 + hd) * 128 * SEQ + s;
#pragma unroll
            for (int mt = 0; mt < 4; ++mt) store_vt_tile(base, SEQ, acc[mt], 32 * mt, h, tok);
        }
    }
};

struct EpiResid {
    const float* xin; float* xout; const float* gate;
    DI void operator()(const f32x16 (&acc)[4], int tok, int fbase, int h, unsigned char*, int) const {
        const int b = tok >> 13;
        const float* gp = gate + b * ADA_STRIDE;
#pragma unroll
        for (int mt = 0; mt < 4; ++mt)
#pragma unroll
            for (int g4 = 0; g4 < 4; ++g4) {
                const int f = fbase + 32 * mt + 8 * g4 + 4 * h;
                const f32x4 xv = *(const f32x4*)(xin + (long)tok * DM + f);
                const f32x4 gv = *(const f32x4*)(gp + f);
                f32x4 o;
                o.x = xv.x + gv.x * acc[mt][4 * g4 + 0]; o.y = xv.y + gv.y * acc[mt][4 * g4 + 1];
                o.z = xv.z + gv.z * acc[mt][4 * g4 + 2]; o.w = xv.w + gv.w * acc[mt][4 * g4 + 3];
                *(f32x4*)(xout + (long)tok * DM + f) = o;
                if (g4 == 3) __builtin_amdgcn_sched_barrier(0);
            }
    }
};

struct EpiKV {
    bf16_t *KC, *KS, *VST, *KW, *VWT;
    const float* kgain;
    DI void operator()(const f32x16 (&acc)[4], int tok, int fbase, int h, unsigned char*, int) const {
        const int c = fbase >> 7, br = c >> 2, kv = (c >> 1) & 1, g = c & 1, b = tok >> 13, s = tok & (SEQ - 1);
        if (br == 0 || kv == 0) {
            float rstd = 1.f;
            bf16_t* row;
            if (br == 0) row = KC + ((long)((kv * 4 + b) * 2 + g) * SEQ + s) * 128;
            else {
                float ss = 0.f;
#pragma unroll
                for (int mt = 0; mt < 4; ++mt)
#pragma unroll
                    for (int rg = 0; rg < 16; ++rg) ss += acc[mt][rg] * acc[mt][rg];
                ss = sum_x32(ss);
                rstd = rsqrtf(ss * (1.f / 128.f) + EPS);
                row = (br == 1 ? KS : KW) + ((long)(b * 2 + g) * SEQ + s) * 128;
            }
#pragma unroll
            for (int mt = 0; mt < 4; ++mt)
#pragma unroll
                for (int g4 = 0; g4 < 4; ++g4) {
                    const int d0 = 32 * mt + 8 * g4 + 4 * h;
                    f32x4 gv = {1.f, 1.f, 1.f, 1.f};
                    if (br != 0) gv = *(const f32x4*)(kgain + br * 128 + d0);
                    u32x2 o;
                    o.x = pk2(acc[mt][4 * g4 + 0] * rstd * gv.x, acc[mt][4 * g4 + 1] * rstd * gv.y);
                    o.y = pk2(acc[mt][4 * g4 + 2] * rstd * gv.z, acc[mt][4 * g4 + 3] * rstd * gv.w);
                    *(u32x2*)(row + d0) = o;
                }
        } else {
            bf16_t* base = (br == 1 ? VST : VWT) + (long)(b * 2 + g) * 128 * SEQ + s;
#pragma unroll
            for (int mt = 0; mt < 4; ++mt) store_vt_tile(base, SEQ, acc[mt], 32 * mt, h, tok);
        }
    }
};

struct EpiCmp1 {
    bf16_t* hid; const float* posb_part; const float* b1;
    DI void operator()(const f32x16 (&acc)[4], int tok, int fbase, int h, unsigned char*, int) const {
        if (tok >= 512) return;
#pragma unroll
        for (int mt = 0; mt < 4; ++mt)
#pragma unroll
            for (int g4 = 0; g4 < 4; ++g4) {
                const int f = fbase + 32 * mt + 8 * g4 + 4 * h;
                f32x4 pb = *(const f32x4*)(b1 + f);
                for (int c = 0; c < 16; ++c) { const f32x4 t = *(const f32x4*)(posb_part + c * 256 + f); pb.x += t.x; pb.y += t.y; pb.z += t.z; pb.w += t.w; }
                u32x2 o;
                o.x = pk2(gelu_tanh(acc[mt][4 * g4 + 0] + pb.x), gelu_tanh(acc[mt][4 * g4 + 1] + pb.y));
                o.y = pk2(gelu_tanh(acc[mt][4 * g4 + 2] + pb.z), gelu_tanh(acc[mt][4 * g4 + 3] + pb.w));
                *(u32x2*)(hid + (long)tok * 256 + f) = o;
            }
    }
};

struct EpiCmp2 {
    bf16_t* dst; const float* kgain0; int kv;
    DI void operator()(const f32x16 (&acc)[4], int tok, int fbase, int h, unsigned char*, int) const {
        if (fbase != 0 || tok >= 512) return;
        const float valid = tok < 511 ? 1.f : 0.f;
        if (kv == 0) {
            float ss = 0.f;
#pragma unroll
            for (int mt = 0; mt < 4; ++mt)
#pragma unroll
                for (int rg = 0; rg < 16; ++rg) ss += acc[mt][rg] * acc[mt][rg];
            ss = sum_x32(ss);
            const float rstd = rsqrtf(ss * (1.f / 128.f) + EPS) * valid;
#pragma unroll
            for (int mt = 0; mt < 4; ++mt)
#pragma unroll
                for (int g4 = 0; g4 < 4; ++g4) {
                    const int d0 = 32 * mt + 8 * g4 + 4 * h;
                    const f32x4 gv = *(const f32x4*)(kgain0 + d0);
                    u32x2 o;
                    o.x = pk2(acc[mt][4 * g4 + 0] * rstd * gv.x, acc[mt][4 * g4 + 1] * rstd * gv.y);
                    o.y = pk2(acc[mt][4 * g4 + 2] * rstd * gv.z, acc[mt][4 * g4 + 3] * rstd * gv.w);
                    *(u32x2*)(dst + (long)tok * 128 + d0) = o;
                }
        } else {
#pragma unroll
            for (int mt = 0; mt < 4; ++mt)
#pragma unroll
                for (int rg = 0; rg < 16; ++rg) dst[(long)(32 * mt + crow(rg, h)) * 512 + tok] = f2bf(acc[mt][rg] * valid);
        }
    }
};

struct EpiNsaQ {
    bf16_t* QN; float* gates; const float* qgain; const float* bgate; float* qnrm;
    DI void operator()(const f32x16 (&acc)[4], int tok, int fbase, int h, unsigned char*, int) const {
        const int b = tok >> 13, s = tok & (SEQ - 1);
        if (fbase < 1024) {
            const int head = fbase >> 7;
            float ss = 0.f;
#pragma unroll
            for (int mt = 0; mt < 4; ++mt)
#pragma unroll
                for (int rg = 0; rg < 16; ++rg) ss += acc[mt][rg] * acc[mt][rg];
            ss = sum_x32(ss);
            const float rstd = rsqrtf(ss * (1.f / 128.f) + EPS) * (0.08838834764831845f * LOG2E);
            bf16_t* row = QN + ((long)(b * 8 + head) * SEQ + s) * 128;
            float qq = 0.f;
#pragma unroll
            for (int mt = 0; mt < 4; ++mt)
#pragma unroll
                for (int g4 = 0; g4 < 4; ++g4) {
                    const int d0 = 32 * mt + 8 * g4 + 4 * h;
                    const f32x4 gv = *(const f32x4*)(qgain + d0);
                    const float v0 = acc[mt][4 * g4 + 0] * rstd * gv.x, v1 = acc[mt][4 * g4 + 1] * rstd * gv.y;
                    const float v2 = acc[mt][4 * g4 + 2] * rstd * gv.z, v3 = acc[mt][4 * g4 + 3] * rstd * gv.w;
                    qq += v0 * v0 + v1 * v1 + v2 * v2 + v3 * v3;
                    u32x2 o;
                    o.x = pk2(v0, v1); o.y = pk2(v2, v3);
                    *(u32x2*)(row + d0) = o;
                }
            qq = sum_x32(qq);
            if (h == 0) qnrm[(long)tok * 8 + head] = 1.01f * sqrtf(qq);
        } else if (fbase == 1024) {
#pragma unroll
            for (int rg = 0; rg < 16; ++rg) {
                const int f = crow(rg, h);
                if (f < 24) { const float z = acc[0][rg] + bgate[f]; gates[(long)tok * 24 + f] = frcp(1.f + fexp2(-LOG2E * z)); }
            }
        }
    }
};

DI void ce_desc(unsigned& a, unsigned& b) { const unsigned hi = a > b ? a : b, lo = a > b ? b : a; a = hi; b = lo; }
DI void sort16_desc(unsigned (&a)[16]) {
#define CE_(i, j) ce_desc(a[i], a[j]);
    CE_(0,13) CE_(1,12) CE_(2,15) CE_(3,14) CE_(4,8) CE_(5,6) CE_(7,11) CE_(9,10)
    CE_(0,5) CE_(1,7) CE_(2,9) CE_(3,4) CE_(6,13) CE_(8,14) CE_(10,15) CE_(11,12)
    CE_(0,1) CE_(2,3) CE_(4,5) CE_(6,8) CE_(7,9) CE_(10,11) CE_(12,13) CE_(14,15)
    CE_(0,2) CE_(1,3) CE_(4,10) CE_(5,11) CE_(6,7) CE_(8,9) CE_(12,14) CE_(13,15)
    CE_(1,2) CE_(3,12) CE_(4,6) CE_(5,7) CE_(8,10) CE_(9,11) CE_(13,14)
    CE_(1,4) CE_(2,6) CE_(5,8) CE_(7,10) CE_(9,13) CE_(11,14)
    CE_(2,4) CE_(3,6) CE_(9,12) CE_(11,13)
    CE_(3,5) CE_(6,8) CE_(7,9) CE_(10,12)
    CE_(3,4) CE_(5,6) CE_(7,8) CE_(9,10) CE_(11,12)
    CE_(6,7) CE_(8,9)
#undef CE_
}
DI void bitonic_merge16_desc(unsigned (&a)[16]) {
#pragma unroll
    for (int st = 8; st >= 1; st >>= 1)
#pragma unroll
        for (int i = 0; i < 16; ++i)
            if ((i & st) == 0) ce_desc(a[i], a[i + st]);
}
DI void merge_top16(unsigned (&a)[16], const unsigned (&b)[16]) {
#pragma unroll
    for (int i = 0; i < 16; ++i) a[i] = a[i] > b[15 - i] ? a[i] : b[15 - i];
    bitonic_merge16_desc(a);
}

struct EpiPeer {
    static constexpr bool STASH = false;
    int* ridx; float* rgate; int ex_off;
    DI void operator()(const f32x16 (&acc)[4], int tok, int fbase, int h, unsigned char* lds, int tid) const {
        const int lane = tid & 63, w = tid >> 6, tg = w & 3, fh = w >> 2, r = lane & 31;
        const int hd = fbase >> 8;
        unsigned* EX = (unsigned*)(lds + ex_off);
        unsigned L[16];
        {
            unsigned G1[16], G2[16], G3[16];
#pragma unroll
            for (int rg = 0; rg < 16; ++rg) {
                const int c = crow(rg, h);
                L[rg] = (f2key(acc[0][rg]) & ~127u) | (unsigned)(127 - c);
                G1[rg] = (f2key(acc[1][rg]) & ~127u) | (unsigned)(127 - 32 - c);
                G2[rg] = (f2key(acc[2][rg]) & ~127u) | (unsigned)(127 - 64 - c);
                G3[rg] = (f2key(acc[3][rg]) & ~127u) | (unsigned)(127 - 96 - c);
            }
            sort16_desc(L); sort16_desc(G1); merge_top16(L, G1);
            sort16_desc(G2); sort16_desc(G3); merge_top16(G2, G3);
            merge_top16(L, G2);
        }
        {
            unsigned P[16];
#pragma unroll
            for (int i = 0; i < 16; ++i) P[i] = get_x32(L[i], h);
            merge_top16(L, P);
        }
        if (h == 0) {
#pragma unroll
            for (int i = 0; i < 16; i += 4) *(u32x4*)(EX + ((fh * 4 + tg) * 32 + r) * 16 + i) = (u32x4){L[i], L[i + 1], L[i + 2], L[i + 3]};
        }
        __syncthreads();
        float xf[4], ys[16];
        {
            const unsigned* l0 = EX + ((0 * 4 + tg) * 32 + r) * 16;
            const unsigned* l1 = EX + ((1 * 4 + tg) * 32 + r) * 16;
            const unsigned* px = h ? l1 : l0;
            const unsigned* py = h ? l0 : l1;
            const u32x4 a = *(const u32x4*)px;
            xf[0] = key2f(a.x & ~127u); xf[1] = key2f(a.y & ~127u); xf[2] = key2f(a.z & ~127u); xf[3] = key2f(a.w & ~127u);
            unsigned Y[16];
#pragma unroll
            for (int i = 0; i < 16; i += 4) { const u32x4 b2 = *(const u32x4*)(py + i); Y[i] = b2.x; Y[i + 1] = b2.y; Y[i + 2] = b2.z; Y[i + 3] = b2.w; }
#pragma unroll
            for (int k = 0; k < 15; ++k) ys[k] = key2f((h ? Y[k + 1] : Y[k]) & ~127u);
            ys[15] = key2f(Y[15] & ~127u);
        }
        auto pkey = [&](int i, int k) -> unsigned {
            const float fs = xf[i] + ys[k];
            const unsigned code = h ? (unsigned)((((k + 1) & 15) << 4) | i) : (unsigned)((i << 4) | k);
            return (f2key(fs) & ~255u) | (255u - code);
        };
        unsigned T[16], E[16];
#pragma unroll
        for (int k = 0; k < 16; ++k) T[k] = pkey(0, k);
        T[15] = h ? 0u : T[15];
#pragma unroll
        for (int k = 1; k <= 7; ++k) E[k - 1] = pkey(1, k);
#pragma unroll
        for (int k = 2; k <= 4; ++k) E[7 + k - 2] = pkey(2, k);
        E[10] = pkey(3, 3);
#pragma unroll
        for (int k = 11; k < 16; ++k) E[k] = 0u;
        sort16_desc(E);
        merge_top16(T, E);
        {
            unsigned P[16];
#pragma unroll
            for (int i = 0; i < 16; ++i) P[i] = get_x32(T[i], h);
            merge_top16(T, P);
        }
        float sc[16], sum = 0.f;
        const float mx = key2f(T[0] & ~255u);
#pragma unroll
        for (int k = 0; k < 16; ++k) { sc[k] = fexp2((key2f(T[k] & ~255u) - mx) * LOG2E); sum += sc[k]; }
        const float inv = frcp(sum);
        if (h == 0) {
            const unsigned* l0 = EX + ((0 * 4 + tg) * 32 + r) * 16;
            const unsigned* l1 = EX + ((1 * 4 + tg) * 32 + r) * 16;
#pragma unroll
            for (int k = 0; k < 16; ++k) {
                if ((k >> 3) != fh) continue;
                const unsigned code = 255u - (T[k] & 255u);
                const int i1 = 127 - (int)(l0[code >> 4] & 127u), i2 = 127 - (int)(l1[code & 15u] & 127u);
                ridx[(long)tok * 128 + hd * 16 + k] = i1 * 128 + i2;
                rgate[(long)tok * 128 + hd * 16 + k] = sc[k] * inv;
            }
        }
        __syncthreads();
    }
};

DI void p0_transpose_item(const float* __restrict__ W, int K, int N, bf16_t* __restrict__ WT, int item, int ntn, unsigned char* lds, int tid) {
    float* tile = (float*)lds;
    const int kb = item / ntn, nb = item % ntn, k0 = kb * 64, n0 = nb * 64;
    {
        const int nn = tid & 63, kk0 = tid >> 6;
#pragma unroll
        for (int i = 0; i < 8; ++i) { const int kk = kk0 + 8 * i; const int n = n0 + nn; tile[kk * 65 + nn] = n < N ? W[(long)(k0 + kk) * N + n] : 0.f; }
    }
    __syncthreads();
    {
        const int n = tid >> 3, c = tid & 7;
        const float* s = tile + (8 * c) * 65 + n;
        u32x4 o;
        o.x = pk2(s[0], s[65]); o.y = pk2(s[2 * 65], s[3 * 65]); o.z = pk2(s[4 * 65], s[5 * 65]); o.w = pk2(s[6 * 65], s[7 * 65]);
        *(u32x4*)(WT + (long)(n0 + n) * K + k0 + 8 * c) = o;
    }
    __syncthreads();
}

DI int pack_i8x4(float a, float b, float c, float d) {
    const int ia = __float2int_rn(a), ib = __float2int_rn(b), ic = __float2int_rn(c), id = __float2int_rn(d);
    return (ia & 255) | ((ib & 255) << 8) | ((ic & 255) << 16) | (id << 24);
}
DI void p0_fp8_item(const float* __restrict__ src, unsigned char* __restrict__ dst, float* __restrict__ sinv, bool sliced, int item, int tid) {
    const int lane = tid & 63, row = item * 8 + (tid >> 6);
    const float* rp = src + (long)row * 1024;
    f32x4 v[4]; float am = 0.f;
#pragma unroll
    for (int j = 0; j < 4; ++j) {
        v[j] = *(const f32x4*)(rp + 4 * lane + 256 * j);
        am = fmaxf(am, fmaxf(fmaxf(fabsf(v[j].x), fabsf(v[j].y)), fmaxf(fabsf(v[j].z), fabsf(v[j].w))));
    }
    am = wave_max(am);
    const float sc = sliced ? (am > 0.f ? exp2f(floorf(log2f(384.f / am))) : 1.f) : (am > 0.f ? 127.f / am : 1.f);
    if (lane == 0) sinv[row] = 1.f / sc;
#pragma unroll
    for (int j = 0; j < 4; ++j) {
        int pk = 0;
        if (sliced) {
            pk = __builtin_amdgcn_cvt_pk_fp8_f32(v[j].x * sc, v[j].y * sc, pk, false);
            pk = __builtin_amdgcn_cvt_pk_fp8_f32(v[j].z * sc, v[j].w * sc, pk, true);
        } else pk = pack_i8x4(v[j].x * sc, v[j].y * sc, v[j].z * sc, v[j].w * sc);
        const int col = 4 * lane + 256 * j;
        unsigned char* d = sliced ? dst + ((long)(col >> 7) * 16384 + row) * 128 + (col & 127) : dst + (long)row * 1024 + col;
        *(int*)d = pk;
    }
}

DI void p0_weff_item(const float* __restrict__ wq, const float* __restrict__ subk, bf16_t* __restrict__ WT, int item, unsigned char* lds, int tid) {
    const int layer = item >> 8, g = (item >> 4) & 15, ct = item & 15, p = g & 1, c0 = ct * 64;
    float* As = (float*)lds;
    float* Bs = As + 64 * 129;
    const float* wql = wq + (long)layer * 1024 * 2048;
    const float* sk = subk + ((long)layer * 2 + p) * 128 * 128;
    for (int e = tid; e < 64 * 128; e += NTHREADS) { const int c = e >> 7, d = e & 127; As[c * 129 + d] = wql[(long)(c0 + c) * 2048 + g * 128 + d]; }
    for (int e = tid; e < 128 * 128; e += NTHREADS) { const int k = e >> 7, d = e & 127; Bs[k * 129 + d] = sk[k * 128 + d]; }
    __syncthreads();
    const int lane = tid & 63, w = tid >> 6, ti = w & 3, tj = w >> 2, r = lane & 31, h = lane >> 5;
    f32x16 acc;
#pragma unroll
    for (int i = 0; i < 16; ++i) acc[i] = 0.f;
    const float* ap = Bs + (32 * ti + r) * 129 + h;
    const float* bp = As + (32 * tj + r) * 129 + h;
#pragma unroll 8
    for (int d = 0; d < 128; d += 2) acc = __builtin_amdgcn_mfma_f32_32x32x2f32(ap[d], bp[d], acc, 0, 0, 0);
    bf16_t* o = WT + ((long)layer * 2048 + g * 128 + 32 * ti) * 1024 + c0 + 32 * tj + r;
#pragma unroll
    for (int i = 0; i < 16; ++i) o[(long)crow(i, h) * 1024] = f2bf(acc[i]);
    __syncthreads();
}

DI void p0_posb_item(const float* __restrict__ pos, const float* __restrict__ w1, float* __restrict__ part, int item, unsigned char* lds, int tid) {
    const int kv = item >> 4, ch = item & 15;
    float* red = (float*)lds;
    const int j = tid & 255, half = tid >> 8;
    const float* pp = pos + (long)kv * 4096 + ch * 256 + half * 128;
    const float* ww = w1 + ((long)kv * 4096 + ch * 256 + half * 128) * 256 + j;
    float a = 0.f;
    for (int f = 0; f < 128; ++f) a += pp[f] * ww[(long)f * 256];
    red[half * 256 + j] = a;
    __syncthreads();
    if (tid < 256) part[(kv * 16 + ch) * 256 + tid] = red[tid] + red[256 + tid];
    __syncthreads();
}

DI void p0_ada_item(const Params& p, float* __restrict__ ada, int item, unsigned char* lds, int tid) {
    float* cact = (float*)lds;
    float* red = cact + 4096;
    const float* c = p.in[1];
    for (int e = tid; e < 4096; e += NTHREADS) { const float v = c[e]; cact[e] = v * frcp(1.f + fexp2(-LOG2E * v)); }
    __syncthreads();
    const int colg = item * 64;
    const float* W; const float* bias; int N, n0;
    if (colg < 6144) { W = p.in[3]; bias = p.in[4]; N = 6144; n0 = colg; }
    else if (colg < 12288) { W = p.in[3] + (long)1024 * 6144; bias = p.in[4] + 6144; N = 6144; n0 = colg - 6144; }
    else { W = p.in[14]; bias = p.in[15]; N = 2048; n0 = colg - 12288; }
    const int col = tid & 63, kg = tid >> 6;
    float a0 = 0.f, a1 = 0.f, a2 = 0.f, a3 = 0.f;
    const float* wp = W + (long)(kg * 128) * N + n0 + col;
#pragma unroll 8
    for (int k = 0; k < 128; ++k) {
        const float wv = wp[(long)k * N];
        const int kk = kg * 128 + k;
        a0 += cact[kk] * wv; a1 += cact[1024 + kk] * wv; a2 += cact[2048 + kk] * wv; a3 += cact[3072 + kk] * wv;
    }
    red[(kg * 4 + 0) * 64 + col] = a0; red[(kg * 4 + 1) * 64 + col] = a1; red[(kg * 4 + 2) * 64 + col] = a2; red[(kg * 4 + 3) * 64 + col] = a3;
    __syncthreads();
    if (tid < 256) {
        const int b = tid >> 6, cc = tid & 63;
        float s = bias[n0 + cc];
#pragma unroll
        for (int q = 0; q < 8; ++q) s += red[(q * 4 + b) * 64 + cc];
        ada[b * ADA_STRIDE + colg + cc] = s;
    }
    __syncthreads();
}

constexpr int P0_CONV = 8192, P0_TR_DIN = 768, P0_TR_DOUT = 256, P0_TR_KV = 384, P0_TR_NIN = 288, P0_TR_NOUT = 256, P0_TR_C1 = 512, P0_TR_C2 = 16,
              P0_WEFF = 512, P0_POSB = 32, P0_ADA = 224;
constexpr int P0_TOTAL = P0_CONV + P0_TR_DIN + P0_TR_DOUT + P0_TR_KV + P0_TR_NIN + P0_TR_NOUT + P0_TR_C1 + P0_TR_C2 + P0_WEFF + P0_POSB + P0_ADA;

DI void phase_prep(const Params& p, unsigned char* lds, int tid) {
    unsigned char* ws = p.ws;
    for (int it = blockIdx.x; it < P0_TOTAL; it += gridDim.x) {
        int r = it;
        if (r < P0_ADA) { p0_ada_item(p, (float*)(ws + OFF_ADA), r, lds, tid); continue; } r -= P0_ADA;
        if (r < P0_WEFF) { p0_weff_item(p.in[26], p.in[27], (bf16_t*)(ws + OFF_WT_PEER), r, lds, tid); continue; } r -= P0_WEFF;
        if (r < P0_POSB) { p0_posb_item(p.in[17], p.in[18], (float*)(ws + OFF_POSB), r, lds, tid); continue; } r -= P0_POSB;
        if (r < P0_TR_DIN) { p0_transpose_item(p.in[7], 1024, 3072, (bf16_t*)(ws + OFF_WT_DIN), r, 48, lds, tid); continue; } r -= P0_TR_DIN;
        if (r < P0_TR_DOUT) { p0_transpose_item(p.in[8], 1024, 1024, (bf16_t*)(ws + OFF_WT_DOUT), r, 16, lds, tid); continue; } r -= P0_TR_DOUT;
        if (r < P0_TR_KV) { p0_transpose_item(p.in[16], 1024, 1536, (bf16_t*)(ws + OFF_WT_KV), r, 24, lds, tid); continue; } r -= P0_TR_KV;
        if (r < P0_TR_NIN) { p0_transpose_item(p.in[22], 1024, 1048, (bf16_t*)(ws + OFF_WT_NIN), r, 18, lds, tid); continue; } r -= P0_TR_NIN;
        if (r < P0_TR_NOUT) { p0_transpose_item(p.in[24], 1024, 1024, (bf16_t*)(ws + OFF_WT_NOUT), r, 16, lds, tid); continue; } r -= P0_TR_NOUT;
        if (r < P0_TR_C1) { const int kv = r >> 8; p0_transpose_item(p.in[18] + (long)kv * 4096 * 256, 4096, 256, (bf16_t*)(ws + OFF_WT_C1) + (long)kv * 256 * 4096, r & 255, 4, lds, tid); continue; } r -= P0_TR_C1;
        if (r < P0_TR_C2) { const int kv = r >> 3; p0_transpose_item(p.in[20] + (long)kv * 256 * 128, 256, 128, (bf16_t*)(ws + OFF_WT_C2) + (long)kv * 128 * 256, r & 7, 2, lds, tid); continue; } r -= P0_TR_C2;
        {
            const int tbl = r >> 11, sub = r & 2047;
            const int layer = tbl & 1;
            const float* src = (tbl < 2 ? p.in[28] : p.in[29]) + (long)layer * 16384 * 1024;
            unsigned char* dst = ws + (tbl < 2 ? OFF_PU : OFF_PV) + (long)layer * 16384 * 1024;
            float* sinv = (float*)(ws + (tbl < 2 ? OFF_USI : OFF_VSI)) + layer * 16384;
            p0_fp8_item(src, dst, sinv, tbl >= 2, sub, tid);
        }
    }
}

DI void norm_row_write(const f32x4 (&v)[4], float rstd, const float* gain, const float* shift, const float* scale, bf16_t* orow, int lane) {
#pragma unroll
    for (int j = 0; j < 4; ++j) {
        const int c = 4 * lane + 256 * j;
        const f32x4 g = *(const f32x4*)(gain + c), sh = *(const f32x4*)(shift + c), sc = *(const f32x4*)(scale + c);
        u32x2 o;
        o.x = pk2(v[j].x * rstd * g.x * (1.f + sc.x) + sh.x, v[j].y * rstd * g.y * (1.f + sc.y) + sh.y);
        o.y = pk2(v[j].z * rstd * g.z * (1.f + sc.z) + sh.z, v[j].w * rstd * g.w * (1.f + sc.w) + sh.w);
        *(u32x2*)(orow + c) = o;
    }
}
template <bool BF>
DI void phase_norm_q8(const float* __restrict__ x, bf16_t* __restrict__ out, unsigned char* __restrict__ out8, float* __restrict__ outs,
                      const float* gain, const float* ada, int shift_off, int scale_off, int tid) {
    const int lane = tid & 63, gw = blockIdx.x * NWAVES + (tid >> 6), nw = gridDim.x * NWAVES;
    for (int tok = gw; tok < NTOK; tok += nw) {
        const int b = tok >> 13;
        f32x4 v[4]; float ss = 0.f;
#pragma unroll
        for (int j = 0; j < 4; ++j) { v[j] = *(const f32x4*)(x + (long)tok * DM + 4 * lane + 256 * j); ss += v[j].x * v[j].x + v[j].y * v[j].y + v[j].z * v[j].z + v[j].w * v[j].w; }
        const float rstd = rsqrtf(wave_sum(ss) * (1.f / DM) + EPS);
        const float* shift = ada + b * ADA_STRIDE + shift_off; const float* scale = ada + b * ADA_STRIDE + scale_off;
        float am = 0.f;
#pragma unroll
        for (int j = 0; j < 4; ++j) {
            const int c = 4 * lane + 256 * j;
            const f32x4 g = *(const f32x4*)(gain + c), sh = *(const f32x4*)(shift + c), sc = *(const f32x4*)(scale + c);
            v[j].x = v[j].x * rstd * g.x * (1.f + sc.x) + sh.x; v[j].y = v[j].y * rstd * g.y * (1.f + sc.y) + sh.y;
            v[j].z = v[j].z * rstd * g.z * (1.f + sc.z) + sh.z; v[j].w = v[j].w * rstd * g.w * (1.f + sc.w) + sh.w;
            if constexpr (BF) { u32x2 o; o.x = pk2(v[j].x, v[j].y); o.y = pk2(v[j].z, v[j].w); *(u32x2*)(out + (long)tok * DM + c) = o; }
            am = fmaxf(am, fmaxf(fmaxf(fabsf(v[j].x), fabsf(v[j].y)), fmaxf(fabsf(v[j].z), fabsf(v[j].w))));
        }
        am = wave_max(am);
        const float qs = am > 0.f ? 127.f / am : 1.f;
#pragma unroll
        for (int j = 0; j < 4; ++j) *(int*)(out8 + (long)tok * DM + 4 * lane + 256 * j) = pack_i8x4(v[j].x * qs, v[j].y * qs, v[j].z * qs, v[j].w * qs);
        if (lane == 0) outs[tok] = am > 0.f ? am * (1.f / 127.f) : 1.f;
    }
}
DI void phase_norm(const float* __restrict__ x, bf16_t* __restrict__ out, const float* gain, const float* ada, int shift_off, int scale_off, int tid) {
    const int lane = tid & 63, gw = blockIdx.x * NWAVES + (tid >> 6), nw = gridDim.x * NWAVES;
    for (int tok = gw; tok < NTOK; tok += nw) {
        const int b = tok >> 13;
        f32x4 v[4]; float ss = 0.f;
#pragma unroll
        for (int j = 0; j < 4; ++j) { v[j] = *(const f32x4*)(x + (long)tok * DM + 4 * lane + 256 * j); ss += v[j].x * v[j].x + v[j].y * v[j].y + v[j].z * v[j].z + v[j].w * v[j].w; }
        const float rstd = rsqrtf(wave_sum(ss) * (1.f / DM) + EPS);
        norm_row_write(v, rstd, gain, ada + b * ADA_STRIDE + shift_off, ada + b * ADA_STRIDE + scale_off, out + (long)tok * DM, lane);
    }
}

DI int kidx(int mt, int i) { return 32 * mt + 16 * (i >> 3) + (i & 7); }
template <int DQK>
DI void attn_qk32(const unsigned char* Ks, const bf16x8 (&qf)[DQK / 16], f32x16& st, int mt, int r, int h, float init = 0.f) {
    constexpr int RB = DQK * 2, MSK = DQK == 64 ? 7 : 15;
    const int row = 32 * mt + ((r & 0x13) | ((r & 4) << 1) | ((r & 8) >> 1));
#pragma unroll
    for (int i = 0; i < 16; ++i) st[i] = init;
#pragma unroll
    for (int ks = 0; ks < DQK / 16; ++ks) {
        const bf16x8 kf = RB == 128 ? *(const bf16x8*)(Ks + sw2(row, 2 * ks + h)) : *(const bf16x8*)(Ks + row * RB + (((2 * ks + h) ^ (row & MSK)) << 4));
        st = MFMA32(kf, qf[ks], st);
    }
}
DI void attn_pack32(const f32x16& st, bf16x8 (&pf)[2]) {
#pragma unroll
    for (int s = 0; s < 2; ++s) {
        u32x4 t;
        t.x = pk2(st[8 * s + 0], st[8 * s + 1]); t.y = pk2(st[8 * s + 2], st[8 * s + 3]);
        t.z = pk2(st[8 * s + 4], st[8 * s + 5]); t.w = pk2(st[8 * s + 6], st[8 * s + 7]);
        pf[s] = __builtin_bit_cast(bf16x8, t);
    }
}
DI void attn_softmax32(f32x16& st, float& m, float& l, f32x16 (&o)[4]) {
    float mx = st[0];
#pragma unroll
    for (int i = 1; i < 16; ++i) mx = fmaxf(mx, st[i]);
    mx = max_x32(mx);
    const float mn = fmaxf(m, mx);
    if (!__all(mn == m)) {
        const float alpha = fexp2(m - mn);
        l *= alpha;
#pragma unroll
        for (int dt = 0; dt < 4; ++dt)
#pragma unroll
            for (int i = 0; i < 16; ++i) o[dt][i] *= alpha;
        m = mn;
    }
    float sum = 0.f;
#pragma unroll
    for (int i = 0; i < 16; ++i) { const float pv = fexp2(st[i] - m); st[i] = pv; sum += pv; }
    l += sum;
}
DI void attn_softmax32_b(f32x16& st, float& l) {
    float sum = 0.f;
#pragma unroll
    for (int i = 0; i < 16; ++i) { const float pv = fexp2(st[i]); st[i] = pv; sum += pv; }
    l += sum;
}
DI void attn_pv32(const unsigned char* Vs, const bf16x8 (&pf)[2], f32x16 (&o)[4], int mt, int r, int h) {
#pragma unroll
    for (int dt = 0; dt < 4; ++dt)
#pragma unroll
        for (int s2 = 0; s2 < 2; ++s2) {
            const int row = 32 * dt + r;
            const bf16x8 vf = *(const bf16x8*)(Vs + sw2(row, 2 * (2 * mt + s2) + h));
            o[dt] = MFMA32(vf, pf[s2], o[dt]);
        }
}
template <int RB, int NROWS>
DI void dma_offsets(unsigned (&off)[NROWS * RB / 16 / 512], unsigned gstride, int tid) {
    constexpr int CPR = RB / 16;
#pragma unroll
    for (int i = 0; i < NROWS * CPR / 512; ++i) {
        const int idx = tid + 512 * i;
        int row, cp;
        if (RB == 128) sw2_src(idx, row, cp); else { row = idx / CPR; cp = (idx % CPR) ^ (row & (CPR - 1)); }
        off[i] = (unsigned)row * gstride + (cp << 4);
    }
}
template <int N>
DI void dma_issue(unsigned char* dst, const unsigned char* gbase, const unsigned (&off)[N], int tid) {
    const int wbase = tid & ~63;
#pragma unroll
    for (int i = 0; i < N; ++i)
        __builtin_amdgcn_global_load_lds((const unsigned*)(gbase + off[i]), (unsigned*)(dst + (wbase + 512 * i) * 16), 16, 0, 0);
}

constexpr int AT_STAGE = 32 * 1024;
constexpr int AT_LUT = 2 * AT_STAGE;
constexpr int LUT_N = 1280, LUT_OFF = 1100;
constexpr int LUTC_W = 52;
constexpr int AT_LUTC = AT_LUT + 20 * 1024;
constexpr int AT_IMP = AT_LUTC + 13 * 1024;
constexpr int AT_SEL = AT_IMP + 34 * 1024;

DI void phase_diff_attn(const Params& p, unsigned char* lds, int tid) {
    unsigned char* ws = p.ws;
    const bf16_t* Q = (const bf16_t*)(ws + OFF_Q0);
    const bf16_t* Kk = (const bf16_t*)(ws + OFF_K0);
    const bf16_t* VT = (const bf16_t*)(ws + OFF_VT0);
    bf16_t* O = (bf16_t*)(ws + OFF_H);
    const float* relb = p.in[2];
    const float* lam = p.in[9];
    const float* subln = p.in[12];
    const int lane = tid & 63, w = tid >> 6, comp = w & 1, qg = w >> 1, r = lane & 31, h = lane >> 5;
    float* lut = (float*)(lds + 128 * 1024);
    float lam_full;
    {
        float s01 = 0.f, s23 = 0.f;
        for (int i = 0; i < 64; ++i) { s01 += lam[i] * lam[64 + i]; s23 += lam[128 + i] * lam[192 + i]; }
        lam_full = __expf(s01) - __expf(s23) + 0.2f;
    }
    const int G = gridDim.x, rows_per_it = G >> 5;
    unsigned koff[1], voff[2];
    dma_offsets<128, 64>(koff, 128, tid);
    dma_offsets<128, 128>(voff, SEQ * 2, tid);
    constexpr int ST2 = 64 * 1024;
    for (int it = 0;; ++it) {
        int qb, b, hd;
        if (G == 256) {
            if (it >= 8) break;
            const int xcd = blockIdx.x & 7, lb = blockIdx.x >> 3, pr = xcd * 4 + (it >> 1);
            qb = (it & 1) ? lb : 63 - lb; b = pr >> 3; hd = pr & 7;
        } else {
            int u;
            if ((G & 31) == 0) {
                const int rr = blockIdx.x >> 5, cc = blockIdx.x & 31;
                const int rowi = it * rows_per_it + ((it & 1) ? rows_per_it - 1 - rr : rr);
                u = rowi * 32 + cc;
            } else u = it * G + blockIdx.x;
            if (u >= 2048) break;
            qb = 63 - (u >> 5); b = (u & 31) >> 3; hd = u & 7;
        }
        const int q0 = qb * 128, ntiles = qb + 1;
        const int qpos = q0 + 32 * qg + r, qlo = q0 + 32 * qg, qhi = qlo + 31;
        for (int e = tid; e < LUT_N; e += NTHREADS) { const int d = LUT_OFF - e; lut[e] = d < 0 ? -INFINITY : (d >= 790 ? 0.f : (relb[rel_bucket_i(d) * 8 + hd] - relb[31 * 8 + hd]) * LOG2E); }
        bf16x8 qf[4];
        {
            const bf16_t* qrow = Q + ((long)((b * 8 + hd) * 2 + comp) * SEQ + qpos) * 64;
#pragma unroll
            for (int ks = 0; ks < 4; ++ks) qf[ks] = *(const bf16x8*)(qrow + 16 * ks + 8 * h);
        }
        const unsigned char* k0g = (const unsigned char*)(Kk + (long)((b * 8 + hd) * 2 + 0) * SEQ * 64);
        const unsigned char* k1g = (const unsigned char*)(Kk + (long)((b * 8 + hd) * 2 + 1) * SEQ * 64);
        const unsigned char* vtg = (const unsigned char*)(VT + (long)(b * 8 + hd) * 128 * SEQ);
        f32x16 o[4];
#pragma unroll
        for (int dt = 0; dt < 4; ++dt)
#pragma unroll
            for (int i = 0; i < 16; ++i) o[dt][i] = 0.f;
        float l = 0.f;
        const float nmb = -((const float*)(ws + OFF_MB0))[(long)((b * 8 + hd) * 2 + comp) * SEQ + qpos];
        auto stage = [&](int kt, unsigned char* st) {
#pragma unroll
            for (int sb = 0; sb < 2; ++sb) {
                dma_issue(st + sb * 8192, k0g + (long)(2 * kt + sb) * 8192, koff, tid);
                dma_issue(st + 16384 + sb * 8192, k1g + (long)(2 * kt + sb) * 8192, koff, tid);
                dma_issue(st + 32768 + sb * 16384, vtg + (long)(2 * kt + sb) * 128, voff, tid);
            }
        };
        stage(0, lds);
        __syncthreads();
        for (int kt = 0; kt < ntiles; ++kt) {
            unsigned char* cur = lds + (kt & 1) * ST2;
            if (kt + 1 < ntiles) stage(kt + 1, lds + ((kt + 1) & 1) * ST2);
            const bool nearb = qlo - (kt * 128 + 127) < 790;
            const int dbase0 = qpos - kt * 128 - 8 * h;
            const unsigned char* kb = cur + comp * 16384;
            f32x16 sa, sbv;
            attn_qk32<64>(kb, qf, sa, 0, r, h, nmb);
#pragma unroll
            for (int j = 0; j < 4; ++j) {
                f32x16& sc = (j & 1) ? sbv : sa;
                f32x16& sn = (j & 1) ? sa : sbv;
                if (j < 3) attn_qk32<64>(kb + ((j + 1) >> 1) * 8192, qf, sn, (j + 1) & 1, r, h, nmb);
                if (nearb) {
                    const float* lp = lut + (LUT_OFF - dbase0 + 64 * (j >> 1));
#pragma unroll
                    for (int i = 0; i < 16; ++i) sc[i] += lp[kidx(j & 1, i)];
                }
                attn_softmax32_b(sc, l);
                bf16x8 pf[2];
                attn_pack32(sc, pf);
                attn_pv32(cur + 32768 + (j >> 1) * 16384, pf, o, j & 1, r, h);
            }
            __syncthreads();
        }
        l = sum_x32(l);
        const float inv = l > 0.f ? frcp(l) : 0.f;
        float* xch = (float*)lds + qg * 4096;
        if (comp == 1) {
            const float sc = inv * lam_full;
#pragma unroll
            for (int dt = 0; dt < 4; ++dt)
#pragma unroll
                for (int i = 0; i < 16; ++i) xch[(dt * 16 + i) * 64 + lane] = o[dt][i] * sc;
        }
        __syncthreads();
        if (comp == 0) {
            float ss = 0.f;
#pragma unroll
            for (int dt = 0; dt < 4; ++dt)
#pragma unroll
                for (int i = 0; i < 16; ++i) { const float v = o[dt][i] * inv - xch[(dt * 16 + i) * 64 + lane]; o[dt][i] = v; ss += v * v; }
            ss = sum_x32(ss);
            const float rstd = rsqrtf(ss * (1.f / 128.f) + EPS) * 0.8f;
            bf16_t* orow = O + (long)(b * SEQ + qpos) * DM + hd * 128;
#pragma unroll
            for (int dt = 0; dt < 4; ++dt)
#pragma unroll
                for (int g4 = 0; g4 < 4; ++g4) {
                    const int d0 = 32 * dt + 8 * g4 + 4 * h;
                    const f32x4 gv = *(const f32x4*)(subln + d0);
                    u32x2 ov;
                    ov.x = pk2(o[dt][4 * g4 + 0] * rstd * gv.x, o[dt][4 * g4 + 1] * rstd * gv.y);
                    ov.y = pk2(o[dt][4 * g4 + 2] * rstd * gv.z, o[dt][4 * g4 + 3] * rstd * gv.w);
                    *(u32x2*)(orow + d0) = ov;
                }
        }
        __syncthreads();
    }
}

template <int VAR>
DI void phase_nsa_attn(const Params& p, unsigned char* lds, int tid) {
    unsigned char* ws = p.ws;
    const bf16_t* QN = (const bf16_t*)(ws + OFF_QN);
    const bf16_t* KS = (const bf16_t*)(ws + OFF_KS);
    const bf16_t* VST = (const bf16_t*)(ws + OFF_VST);
    const bf16_t* KW = (const bf16_t*)(ws + OFF_KW);
    const bf16_t* VWT = (const bf16_t*)(ws + OFF_VWT);
    const bf16_t* KCMP = (const bf16_t*)(ws + OFF_KCMP);
    const bf16_t* VCMPT = (const bf16_t*)(ws + OFF_VCMPT);
    const float* gates = (const float*)(ws + OFF_GATES);
    bf16_t* O = VAR ? (bf16_t*)(ws + OFF_PU + 32 * MB) : (bf16_t*)(ws + OFF_H);
    const float* relb = p.in[2];
    const int lane = tid & 63, w = tid >> 6, hg = w >> 1, th = w & 1, r = lane & 31, h = lane >> 5;
    float* lut = (float*)(lds + AT_LUT);
    float* lutc = (float*)(lds + AT_LUTC);
    float* imp = (float*)(lds + AT_IMP);
    unsigned* selw = (unsigned*)(lds + AT_SEL);
    unsigned short* sel16 = (unsigned short*)selw;
    float* bmxs = (float*)(selw + 264);
    const float* qnrm = (const float*)(ws + OFF_MB1);
    float kmx[3];
    for (int br = 0; br < 3; ++br) { float mx = 0.f; for (int d = 0; d < 128; ++d) mx = fmaxf(mx, fabsf(p.in[21][br * 128 + d])); kmx[br] = mx * 11.313708498984761f; }
    const int G = gridDim.x, rows_per_it = G >> 3;
    int lut_g = -1;
    for (int it = 0;; ++it) {
        int u;
        if ((G & 7) == 0) {
            const int rr = blockIdx.x >> 3, cc = blockIdx.x & 7;
            const int rowi = it * rows_per_it + ((it & 1) ? rows_per_it - 1 - rr : rr);
            u = rowi * 8 + cc;
        } else u = it * G + blockIdx.x;
        if (u >= 1024) break;
        const int bi = 127 - (u >> 3), b = (u & 7) >> 1, g = u & 1, head = 4 * g + hg;
        const int tq = 64 * bi + 32 * th + r;
        const int tl = 32 * th + r;
        const long tok = (long)b * SEQ + tq;
        if (g != lut_g) {
            lut_g = g;
            if (tid < 4) { float bm = 0.f; for (int bk = 0; bk < 32; ++bk) bm = fmaxf(bm, relb[bk * 8 + 4 * g + tid] - relb[31 * 8 + 4 * g + tid]); bmxs[tid] = bm * LOG2E; }
            for (int e = tid; e < 4 * LUT_N; e += NTHREADS) { const int hh = e / LUT_N, d = LUT_OFF - (e % LUT_N); lut[e] = d < 0 ? -INFINITY : (d >= 790 ? 0.f : (relb[rel_bucket_i(d) * 8 + 4 * g + hh] - relb[31 * 8 + 4 * g + hh]) * LOG2E); }
            for (int e = tid; e < 4 * 16 * LUTC_W; e += NTHREADS) {
                const int hh = e / (16 * LUTC_W), ph = (e / LUTC_W) & 15, ci = e % LUTC_W, d = 16 * (ci - 1) + ph;
                lutc[e] = ci == 0 ? -INFINITY : (d >= 790 ? 0.f : (relb[rel_bucket_i(d) * 8 + 4 * g + hh] - relb[31 * 8 + 4 * g + hh]) * LOG2E);
            }
        }
        if (tid < 4) selw[256 + tid] = 0u;
        const float* mylut = lut + hg * LUT_N;
        bf16x8 qf[8];
        const bf16_t* qrow = QN + ((long)(b * 8 + head) * SEQ + tq) * 128 + 8 * h;
        auto load_q = [&](const bf16_t* qr) {
#pragma unroll
            for (int ks = 0; ks < 8; ++ks) qf[ks] = *(const bf16x8*)(qr + 16 * ks);
        };
        const float* gp = gates + tok * 24 + head * 3;
        bf16_t* orow = O + (VAR ? (tok & 16383) : tok) * DM + head * 128;
        auto stage = [&](const unsigned char* kg, const unsigned char* vg, unsigned vstride, int kt, unsigned char* st) {
            int t2 = tid; asm volatile("" : "+v"(t2));
            unsigned koff[2], vo[2];
            dma_offsets<256, 64>(koff, 256, t2);
            dma_offsets<128, 128>(vo, vstride, t2);
            dma_issue(st, kg + (long)kt * 16384, koff, t2);
            dma_issue(st + 16384, vg + (long)kt * 128, vo, t2);
        };
        f32x16 o[4];
        float l;
        auto reset = [&]() {
#pragma unroll
            for (int dt = 0; dt < 4; ++dt)
#pragma unroll
                for (int i = 0; i < 16; ++i) o[dt][i] = 0.f;
            l = 0.f;
        };
        const unsigned char* kcg = (const unsigned char*)(KCMP + (long)(b * 2 + g) * 512 * 128);
        const unsigned char* vcg = (const unsigned char*)(VCMPT + (long)(b * 2 + g) * 128 * 512);
        const int nct = ((4 * bi + 2) >> 6) + 1;
        const int hgc = r & 3, tlc = 8 * w + (r >> 2), tqc = 64 * bi + tlc;
        const long tokc = (long)b * SEQ + tqc;
        reset();
        load_q(QN + ((long)(b * 8 + 4 * g + hgc) * SEQ + tqc) * 128 + 8 * h);
        __syncthreads();
        if (VAR != 3) {
            const int cb = (tqc - 31) >> 4;
            const float* lc = lutc + (hgc * 16 + ((tqc - 31) & 15)) * LUTC_W + 1;
            const float nmb = -(qnrm[tokc * 8 + 4 * g + hgc] * kmx[0] + bmxs[hgc]);
            stage(kcg, vcg, 1024u, 0, lds);
            __syncthreads();
            for (int kt = 0; kt < nct; ++kt) {
                unsigned char* cur = lds + (kt & 1) * AT_STAGE;
                if (kt + 1 < nct) stage(kcg, vcg, 1024u, kt + 1, lds + ((kt + 1) & 1) * AT_STAGE);
                const int cbase = cb - kt * 64 - 8 * h;
#pragma unroll
                for (int mt = 0; mt < 2; ++mt) {
                    f32x16 st;
                    attn_qk32<128>(cur, qf, st, mt, r, h, nmb);
                    float sum = 0.f;
#pragma unroll
                    for (int i = 0; i < 16; ++i) {
                        const int c = cbase - kidx(mt, i);
                        sum += fexp2(st[i] + lc[c < -1 ? -1 : (c > 50 ? 50 : c)]);
                    }
                    l += sum;
                }
                __syncthreads();
            }
            const float lt = sum_x32(l);
            const float invl = lt > 0.f ? frcp(lt) : 0.f;
            stage(kcg, vcg, 1024u, 0, lds);
            __syncthreads();
            float carry = 0.f;
            for (int kt = 0; kt < nct; ++kt) {
                unsigned char* cur = lds + (kt & 1) * AT_STAGE;
                if (kt + 1 < nct) stage(kcg, vcg, 1024u, kt + 1, lds + ((kt + 1) & 1) * AT_STAGE);
                const int cbase = cb - kt * 64 - 8 * h;
                float o0[4], o1[4], sp[4];
#pragma unroll
                for (int mt = 0; mt < 2; ++mt) {
                    f32x16 st;
                    attn_qk32<128>(cur, qf, st, mt, r, h, nmb);
#pragma unroll
                    for (int i = 0; i < 16; ++i) {
                        const int c = cbase - kidx(mt, i);
                        st[i] = fexp2(st[i] + lc[c < -1 ? -1 : (c > 50 ? 50 : c)]) * invl;
                    }
#pragma unroll
                    for (int gq = 0; gq < 2; ++gq) {
                        const int G2 = 2 * mt + gq, q0 = 2 * gq, q1 = 2 * gq + 1;
                        const float c20 = 0.5f * st[4 * q0 + 3];
                        o0[G2] = st[4 * q0] + st[4 * q0 + 1] + st[4 * q0 + 2] + c20;
                        o1[G2] = st[4 * q1] + st[4 * q1 + 1] + st[4 * q1 + 2] + 0.5f * st[4 * q1 + 3] + c20;
                        sp[G2] = 0.5f * st[4 * q1 + 3];
                    }
                    bf16x8 pf[2];
                    attn_pack32(st, pf);
                    attn_pv32(cur + 16384, pf, o, mt, r, h);
                }
                float rc[4];
#pragma unroll
                for (int G2 = 0; G2 < 4; ++G2) rc[G2] = __uint_as_float(get_x32(__float_as_uint(sp[G2]), h));
                if (h) {
#pragma unroll
                    for (int G2 = 0; G2 < 4; ++G2) o0[G2] += rc[G2];
                } else {
                    o0[0] += carry; o0[1] += rc[0]; o0[2] += rc[1]; o0[3] += rc[2];
                    carry = rc[3];
                }
#pragma unroll
                for (int G2 = 0; G2 < 4; ++G2) {
                    float a0 = o0[G2], a1 = o1[G2];
                    a0 += lx1(a0); a0 += lx2(a0); a1 += lx1(a1); a1 += lx2(a1);
                    if (hgc == 0) *(f32x2*)(imp + tlc * 130 + kt * 16 + 4 * G2 + 2 * h) = (f32x2){a0, a1};
                }
                __syncthreads();
            }
        }
        {
            const float g_c = gates[tokc * 24 + (4 * g + hgc) * 3];
            bf16_t* orc = O + (VAR ? (tokc & 16383) : tokc) * DM + (4 * g + hgc) * 128;
#pragma unroll
            for (int dt = 0; dt < 4; ++dt)
#pragma unroll
                for (int g4 = 0; g4 < 4; ++g4) {
                    const int d0 = 32 * dt + 8 * g4 + 4 * h;
                    u32x2 ov;
                    ov.x = pk2(o[dt][4 * g4 + 0] * g_c, o[dt][4 * g4 + 1] * g_c);
                    ov.y = pk2(o[dt][4 * g4 + 2] * g_c, o[dt][4 * g4 + 3] * g_c);
                    *(u32x2*)(orc + d0) = ov;
                }
        }
        if (VAR != 5) {
            const int tkn = tid >> 3, part = tid & 7;
            unsigned key[16];
#pragma unroll
            for (int q = 0; q < 16; ++q) {
                const int j = part * 16 + q;
                float v = imp[tkn * 130 + j];
                const int back = bi - j;
                if (j == 0 || (back >= 0 && back < 2)) v = 1e9f;
                if (back < 0) v = -1e30f;
                key[q] = f2key(v);
            }
            auto sum8 = [&](int c) -> int {
                c += __builtin_amdgcn_update_dpp(0, c, 0xB1, 0xF, 0xF, true);
                c += __builtin_amdgcn_update_dpp(0, c, 0x4E, 0xF, 0xF, true);
                c += __builtin_amdgcn_update_dpp(0, c, 0x141, 0xF, 0xF, true);
                return c;
            };
            unsigned T = 0u;
#pragma unroll 4
            for (int bit = 31; bit >= 0; --bit) {
                const unsigned cand = T | (1u << bit);
                int c = 0;
#pragma unroll
                for (int q = 0; q < 16; ++q) c += key[q] >= cand ? 1 : 0;
                if (sum8(c) >= 16) T = cand;
            }
            int cg = 0, ce = 0;
#pragma unroll
            for (int q = 0; q < 16; ++q) { cg += key[q] > T ? 1 : 0; ce += key[q] == T ? 1 : 0; }
            const int need = 16 - sum8(cg);
            int pre = ce;
            { int t = __builtin_amdgcn_update_dpp(0, pre, 0x111, 0xF, 0xF, true); if (part >= 1) pre += t; }
            { int t = __builtin_amdgcn_update_dpp(0, pre, 0x112, 0xF, 0xF, true); if (part >= 2) pre += t; }
            { int t = __builtin_amdgcn_update_dpp(0, pre, 0x114, 0xF, 0xF, true); if (part >= 4) pre += t; }
            int before = pre - ce;
            unsigned bits = 0;
#pragma unroll
            for (int q = 0; q < 16; ++q) {
                const bool eq = key[q] == T;
                const bool selq = key[q] > T || (eq && before < need);
                before += eq ? 1 : 0;
                bits |= (selq && key[q] >= 0x80000000u) ? (1u << q) : 0u;
            }
            sel16[tkn * 8 + part] = (unsigned short)bits;
            atomicOr(&selw[256 + (part >> 1)], bits << ((part & 1) * 16));
        }
        __syncthreads();
        const unsigned un0 = selw[256], un1 = selw[257], un2 = selw[258], un3 = selw[259];
        const unsigned char* ksg = (const unsigned char*)(KS + (long)(b * 2 + g) * SEQ * 128);
        const unsigned char* vsg = (const unsigned char*)(VST + (long)(b * 2 + g) * 128 * SEQ);
        reset(); load_q(qrow);
        const float qn_main = qnrm[tok * 8 + head];
        {
            const float nmb = -(qn_main * kmx[1] + bmxs[hg]);
            const unsigned long long ulo = ((unsigned long long)(unsigned)__builtin_amdgcn_readfirstlane((int)un1) << 32) | (unsigned)__builtin_amdgcn_readfirstlane((int)un0);
            const unsigned long long uhi = ((unsigned long long)(unsigned)__builtin_amdgcn_readfirstlane((int)un3) << 32) | (unsigned)__builtin_amdgcn_readfirstlane((int)un2);
            auto next_tile = [&](int from) -> int {
                if (from < 64) { const unsigned long long mk = ulo >> from; if (mk) return from + __builtin_ctzll(mk); from = 64; }
                if (from < 128) { const unsigned long long mk = uhi >> (from - 64); if (mk) return from + __builtin_ctzll(mk); }
                return 128;
            };
            int jt = (VAR == 1 || VAR == 4 || VAR == 5) ? 128 : next_tile(0);
            int buf = 0;
            if (jt < 128) stage(ksg, vsg, SEQ * 2u, jt, lds);
            __syncthreads();
            while (jt < 128) {
                unsigned char* cur = lds + buf * AT_STAGE;
                const int jn = next_tile(jt + 1);
                if (jn < 128) stage(ksg, vsg, SEQ * 2u, jn, lds + (buf ^ 1) * AT_STAGE);
                const unsigned wd = selw[tl * 4 + (jt >> 5)];
                const bool mysel = (wd >> (jt & 31)) & 1u;
                if (__any(mysel)) {
                    const int k0 = jt * 64;
                    const bool nearb = (64 * bi + 32 * th) - (k0 + 63) < 790;
                    const int dbase = tq - k0 - 8 * h;
                    const float* lp = mylut + (LUT_OFF - dbase);
#pragma unroll
                    for (int mt = 0; mt < 2; ++mt) {
                        f32x16 st;
                        attn_qk32<128>(cur, qf, st, mt, r, h, mysel ? nmb : -INFINITY);
                        if (nearb) {
#pragma unroll
                            for (int i = 0; i < 16; ++i) st[i] += lp[kidx(mt, i)];
                        }
                        attn_softmax32_b(st, l);
                        bf16x8 pf[2];
                        attn_pack32(st, pf);
                        attn_pv32(cur + 16384, pf, o, mt, r, h);
                    }
                }
                __syncthreads();
                buf ^= 1; jt = jn;
            }
        }
        {
            const float lt = sum_x32(l);
            const float sc = (lt > 0.f ? frcp(lt) : 0.f) * gp[1];
#pragma unroll
            for (int dt = 0; dt < 4; ++dt)
#pragma unroll
                for (int g4 = 0; g4 < 4; ++g4) {
                    const int d0 = 32 * dt + 8 * g4 + 4 * h;
                    const u32x2 pv = *(const u32x2*)(orow + d0);
                    u32x2 ov;
                    ov.x = pk2(bflo(pv.x) + o[dt][4 * g4 + 0] * sc, bfhi(pv.x) + o[dt][4 * g4 + 1] * sc);
                    ov.y = pk2(bflo(pv.y) + o[dt][4 * g4 + 2] * sc, bfhi(pv.y) + o[dt][4 * g4 + 3] * sc);
                    *(u32x2*)(orow + d0) = ov;
                }
        }
        const unsigned char* kwg = (const unsigned char*)(KW + (long)(b * 2 + g) * SEQ * 128);
        const unsigned char* vwg = (const unsigned char*)(VWT + (long)(b * 2 + g) * 128 * SEQ);
        reset(); load_q(qrow);
        {
            const float nmb = -(qn_main * kmx[2] + bmxs[hg]);
            const int j0 = bi >= 8 ? bi - 8 : 0, nt = (VAR == 2 || VAR == 4 || VAR == 5) ? 1 : bi - j0 + 1;
            stage(kwg, vwg, SEQ * 2u, j0, lds);
            __syncthreads();
            for (int kt = 0; kt < nt; ++kt) {
                unsigned char* cur = lds + (kt & 1) * AT_STAGE;
                if (kt + 1 < nt) stage(kwg, vwg, SEQ * 2u, j0 + kt + 1, lds + ((kt + 1) & 1) * AT_STAGE);
                const int k0 = (j0 + kt) * 64;
                const int dbase = tq - k0 - 8 * h;
                const float* lp = mylut + (LUT_OFF - dbase);
#pragma unroll
                for (int mt = 0; mt < 2; ++mt) {
                    f32x16 st;
                    attn_qk32<128>(cur, qf, st, mt, r, h, nmb);
#pragma unroll
                    for (int i = 0; i < 16; ++i) st[i] = kidx(mt, i) <= dbase - 512 ? -INFINITY : st[i] + lp[kidx(mt, i)];
                    attn_softmax32_b(st, l);
                    bf16x8 pf[2];
                    attn_pack32(st, pf);
                    attn_pv32(cur + 16384, pf, o, mt, r, h);
                }
                __syncthreads();
            }
        }
        {
            const float lt = sum_x32(l);
            const float sc = (lt > 0.f ? frcp(lt) : 0.f) * gp[2];
#pragma unroll
            for (int dt = 0; dt < 4; ++dt)
#pragma unroll
                for (int g4 = 0; g4 < 4; ++g4) {
                    const int d0 = 32 * dt + 8 * g4 + 4 * h;
                    const u32x2 pv = *(const u32x2*)(orow + d0);
                    u32x2 ov;
                    ov.x = pk2(bflo(pv.x) + o[dt][4 * g4 + 0] * sc, bfhi(pv.x) + o[dt][4 * g4 + 1] * sc);
                    ov.y = pk2(bflo(pv.y) + o[dt][4 * g4 + 2] * sc, bfhi(pv.y) + o[dt][4 * g4 + 3] * sc);
                    *(u32x2*)(orow + d0) = ov;
                }
        }
        __syncthreads();
    }
}

DI void fp8x16_fma(const u32x4& q, const f32x4& h0, const f32x4& h1, const f32x4& h2, const f32x4& h3, f32x2& a0, f32x2& a1) {
    a0 += __builtin_amdgcn_cvt_pk_f32_fp8((int)q.x, false) * (f32x2){h0.x, h0.y};
    a1 += __builtin_amdgcn_cvt_pk_f32_fp8((int)q.x, true)  * (f32x2){h0.z, h0.w};
    a0 += __builtin_amdgcn_cvt_pk_f32_fp8((int)q.y, false) * (f32x2){h1.x, h1.y};
    a1 += __builtin_amdgcn_cvt_pk_f32_fp8((int)q.y, true)  * (f32x2){h1.z, h1.w};
    a0 += __builtin_amdgcn_cvt_pk_f32_fp8((int)q.z, false) * (f32x2){h2.x, h2.y};
    a1 += __builtin_amdgcn_cvt_pk_f32_fp8((int)q.z, true)  * (f32x2){h2.z, h2.w};
    a0 += __builtin_amdgcn_cvt_pk_f32_fp8((int)q.w, false) * (f32x2){h3.x, h3.y};
    a1 += __builtin_amdgcn_cvt_pk_f32_fp8((int)q.w, true)  * (f32x2){h3.z, h3.w};
}
#ifndef UMASK
#define UMASK 0xffffffffu
#endif
template <bool DRY>
DI void phase_peer_u(const Params& p, int layer, unsigned char* lds, int tid) {
    unsigned char* ws = p.ws;
    const unsigned char* H8 = ws + OFF_H8;
    const float* HS = (const float*)(ws + OFF_HS);
    const int* ridx = (const int*)(ws + OFF_RIDX);
    float* rgate = (float*)(ws + OFF_RGATE);
    const unsigned char* U = ws + OFF_PU + (long)layer * 16384 * 1024;
    const __amdgpu_buffer_rsrc_t urs = __builtin_amdgcn_make_buffer_rsrc((void*)U, (short)0, 16384 * 1024, 0x00020000);
    const float* usi = (const float*)(ws + OFF_USI) + layer * 16384;
    const float* vsi = (const float*)(ws + OFF_VSI) + layer * 16384;
    const int lane = tid & 63, w = __builtin_amdgcn_readfirstlane(tid >> 6), sub = lane & 7, grp = lane >> 3;
    const int xg = blockIdx.x & 7, lb = blockIdx.x >> 3, nwv = (gridDim.x >> 3) * NWAVES, wv = lb * NWAVES + w;
    unsigned* clb = (unsigned*)(lds + w * 12288);
    unsigned char* hbb = lds + w * 12288 + 4096;
    const unsigned long long lt = (1ull << lane) - 1ull;
    if (lb >= (int)(gridDim.x >> 3)) return;
    int i0, i1; unsigned g0, g1; u32x4 h0; float hs0;
    auto ld_tok = [&](int tk) {
        tk = tk < NTOK ? tk : wv;
        i0 = ridx[(long)tk * 128 + lane]; i1 = ridx[(long)tk * 128 + 64 + lane];
        g0 = __float_as_uint(rgate[(long)tk * 128 + lane]); g1 = __float_as_uint(rgate[(long)tk * 128 + 64 + lane]);
        h0 = *(const u32x4*)(H8 + (long)tk * DM + lane * 16); hs0 = HS[tk];
    };
    bool sb0, sb1; int sk0, sk1; float su0, sv0, su1, sv1;
    auto stage_tok = [&](int bi) -> int {
        unsigned* cl = clb + bi * 512; unsigned char* hb = hbb + bi * 4096;
        const bool b0 = (i0 >> 11) == xg, b1 = (i1 >> 11) == xg;
        const unsigned long long m0 = __ballot(b0), m1 = __ballot(b1);
        const int n0 = __popcll(m0), n = n0 + __popcll(m1);
        sb0 = b0; sb1 = b1; sk0 = __popcll(m0 & lt); sk1 = n0 + __popcll(m1 & lt);
        if (b0) { *(u32x4*)(cl + 4 * sk0) = (u32x4){(unsigned)lane, (unsigned)i0, g0, 0u}; su0 = usi[i0]; sv0 = vsi[i0]; }
        if (b1) { *(u32x4*)(cl + 4 * sk1) = (u32x4){(unsigned)(64 + lane), (unsigned)i1, g1, 0u}; su1 = usi[i1]; sv1 = vsi[i1]; }
        if (n == 0 && lane == 0) *(u32x4*)cl = (u32x4){0u, 0u, 0u, 0u};
        *(u32x4*)(hb + lane * 16) = h0;
        if (lane == 0) *(float*)(hb + 1024) = hs0;
        return n;
    };
    auto flush_scales = [&](int bi) {
        float* cs = (float*)(hbb + bi * 4096 + 1536);
        if (sb0) *(f32x2*)(cs + 2 * sk0) = (f32x2){su0, sv0};
        if (sb1) *(f32x2*)(cs + 2 * sk1) = (f32x2){su1, sv1};
    };
    ld_tok(wv);
    int nC = stage_tok(0);
    flush_scales(0);
    ld_tok(wv + nwv);
    int slotC, idC; bool validC; float g_in;
    { validC = grp < nC; const int kk = validC ? grp : 0; const u32x4 e = *(const u32x4*)(clb + 4 * kk); slotC = e.x; idC = e.y; g_in = __uint_as_float(e.z); }
    u32x4 uv[8];
    {
        const unsigned uoff = validC ? (unsigned)idC * 1024u + (unsigned)sub * 16u : 0x40000000u;
#pragma unroll
        for (int t = 0; t < 8; ++t) { uv[t] = __builtin_bit_cast(u32x4, __builtin_amdgcn_raw_buffer_load_b128(urs, (int)(uoff + t * 128), 0, 0)); __builtin_amdgcn_sched_barrier(0); }
    }
    int it = 0;
    for (int tok = wv; tok < NTOK; tok += nwv, ++it) {
        const int cb = it & 1;
        const unsigned* clC = clb + cb * 512; const unsigned* clN = clb + (cb ^ 1) * 512;
        const unsigned char* hbC = hbb + cb * 4096;
        const bool more = tok + nwv < NTOK;
        const int nN = stage_tok(cb ^ 1); ld_tok(tok + 2 * nwv);
        const float shC = *(const float*)(hbC + 1024);
        const int nr = nC > 8 ? (nC + 7) >> 3 : 1;
        u32x4 hq[8];
#pragma unroll
        for (int t = 0; t < 8; ++t) hq[t] = *(const u32x4*)(hbC + (sub + 8 * t) * 16);
        auto do_round = [&](int rd) {
            const f32x2 s2 = *(const f32x2*)(hbC + 1536 + 8 * (validC ? 8 * rd + grp : 0));
            int slotN, idN; bool validN; float g_inN;
            {
                u32x4 e;
                if (rd + 1 < nr) { const int k = 8 * (rd + 1) + grp; validN = k < nC; e = *(const u32x4*)(clC + 4 * (validN ? k : 0)); }
                else if (more) { validN = grp < nN; e = *(const u32x4*)(clN + 4 * (validN ? grp : 0)); }
                else { validN = false; e = *(const u32x4*)clC; }
                slotN = e.x; idN = e.y; g_inN = __uint_as_float(e.z);
            }
            const unsigned uoffN = validN ? ((unsigned)idN & (DRY ? UMASK : 0xffffffffu)) * 1024u + (unsigned)sub * 16u : 0x40000000u;
            __builtin_amdgcn_sched_barrier(0);
            int a0 = 0, a1 = 0, a2 = 0, a3 = 0;
#pragma unroll
            for (int t = 0; t < 8; ++t) {
                const u32x4 q = uv[t];
                a0 = __builtin_amdgcn_sdot4((int)q.x, (int)hq[t].x, a0, false); a1 = __builtin_amdgcn_sdot4((int)q.y, (int)hq[t].y, a1, false);
                a2 = __builtin_amdgcn_sdot4((int)q.z, (int)hq[t].z, a2, false); a3 = __builtin_amdgcn_sdot4((int)q.w, (int)hq[t].w, a3, false);
                uv[t] = __builtin_bit_cast(u32x4, __builtin_amdgcn_raw_buffer_load_b128(urs, (int)(uoffN + t * 128), 0, 0));
                __builtin_amdgcn_sched_barrier(0);
            }
            int di = (a0 + a1) + (a2 + a3);
            di += __builtin_amdgcn_update_dpp(0, di, 0xB1, 0xF, 0xF, true);
            di += __builtin_amdgcn_update_dpp(0, di, 0x4E, 0xF, 0xF, true);
            di += __builtin_amdgcn_update_dpp(0, di, 0x141, 0xF, 0xF, true);
            if (validC && sub == 0) {
                float* gw = DRY ? (float*)(ws + OFF_R) + (long)tok * 128 + slotC : rgate + (long)tok * 128 + slotC;
                *gw = g_in * gelu_tanh((float)di * s2.x * shC) * s2.y;
            }
            slotC = slotN; idC = idN; validC = validN; g_in = g_inN;
        };
        do_round(0);
        for (int rd = 1; rd < nr; ++rd) do_round(rd);
        flush_scales(cb ^ 1);
        nC = nN;
    }
}

#ifndef VMASK
#define VMASK 0xffffffffu
#endif
#ifndef V_MFMA
#define V_MFMA 1
#endif
#define LAS __attribute__((address_space(3)))
typedef int v2i_t __attribute__((ext_vector_type(2)));
template <bool DRY>
DI void phase_peer_v(const Params& p, int layer, unsigned char* lds, int tid) {
    unsigned char* ws = p.ws;
    const int* ridx = (const int*)(ws + OFF_RIDX);
    const float* wact = (const float*)(ws + OFF_RGATE);
    const float* ada = (const float*)(ws + OFF_ADA);
    float* x = opq(p.out);
    const int lane = tid & 63, w = __builtin_amdgcn_readfirstlane(tid >> 6), sub = lane & 7, eg = lane >> 3;
    const int xg = blockIdx.x & 7, lb = blockIdx.x >> 3, nwv = (gridDim.x >> 3) * NWAVES, wv = lb * NWAVES + w;
    if (lb >= (int)(gridDim.x >> 3)) return;
    const unsigned char* Vc = ws + OFF_PV + ((long)(layer * 8 + xg) * 16384) * 128;
    unsigned char* gr = lds + w * 16384;
    unsigned* ring = (unsigned*)(lds + 128 * 1024 + w * 3072);
    int ia, ib; float wa, wb;
    auto ld_tokv = [&](int tk) {
        tk = tk < NTOK ? tk : wv;
        ia = ridx[(long)tk * 128 + lane]; ib = ridx[(long)tk * 128 + 64 + lane];
        wa = wact[(long)tk * 128 + lane]; wb = wact[(long)tk * 128 + 64 + lane];
    };
    auto st_ring = [&](int slot) {
        unsigned* rs = ring + slot * 256;
        rs[lane] = (unsigned)ia; rs[64 + lane] = (unsigned)ib; rs[128 + lane] = __float_as_uint(wa); rs[192 + lane] = __float_as_uint(wb);
    };
    auto rd_ids = [&](int slot, u32x4 (&a)[4]) {
        const u32x4* ip = (const u32x4*)(ring + slot * 256 + eg * 16);
#pragma unroll
        for (int q = 0; q < 4; ++q) a[q] = ip[q];
    };
    auto issue = [&](int j, const u32x4 (&a)[4]) {
#pragma unroll
        for (int i = 0; i < 4; ++i) {
            const int g = 4 * (i & 1) + (eg >> 1);
            const unsigned src = (a[j][i] & (DRY ? VMASK : 0xffffffffu)) * 128u + (unsigned)((sub ^ g) << 4);
            __builtin_amdgcn_global_load_lds((const unsigned*)(Vc + src), (unsigned*)(gr + j * 4096 + i * 1024), 16, 0, 0);
        }
    };
    const int col0 = 128 * xg + 16 * sub;
    ld_tokv(wv); st_ring(0);
    ld_tokv(wv + nwv); st_ring(1);
    ld_tokv(wv + 2 * nwv);
    {
        u32x4 a[4];
        rd_ids(0, a);
#pragma unroll
        for (int j = 0; j < 4; ++j) issue(j, a);
    }
#if V_MFMA
    unsigned char* wb8 = lds + 152 * 1024 + w * 256;
    const int m16 = lane & 15, q4 = lane >> 4;
    int boff[8];
    {
        const int rowL = 8 * q4 + (m16 >> 1), gL = (rowL >> 1) & 7;
#pragma unroll
        for (int nt = 0; nt < 8; ++nt) boff[nt] = rowL * 128 + ((nt ^ gL) << 4) + 8 * (m16 & 1);
    }
    unsigned baddr[8];
    const unsigned gr3 = (unsigned)(unsigned long)(LAS unsigned char*)gr;
#pragma unroll
    for (int nt = 0; nt < 8; ++nt) baddr[nt] = gr3 + (unsigned)boff[nt];
    const unsigned aaddr = (unsigned)(unsigned long)(LAS unsigned char*)wb8 + (unsigned)((m16 & 1) * 128 + 8 * q4);
    float xv[8], gfv[8]; int gb = -1;
    const int colx = 128 * xg + m16;
    if (lane < 16) {
#pragma unroll
        for (int nt = 0; nt < 8; ++nt) xv[nt] = x[(long)wv * DM + colx + 16 * nt];
    }
#else
    f32x4 gfv[4]; int gb = -1;
    f32x4 xv[4];
    if (eg == 0) {
#pragma unroll
        for (int c = 0; c < 4; ++c) xv[c] = *(const f32x4*)(x + (long)wv * DM + col0 + 4 * c);
    }
#endif
    int it = 0, s3 = 0;
    for (int tok = wv; tok < NTOK; tok += nwv, ++it) {
        const int sl0 = s3, sl1 = s3 == 2 ? 0 : s3 + 1, sl2 = s3 == 0 ? 2 : s3 - 1;
        st_ring(sl2);
        ld_tokv(tok + 3 * nwv);
        u32x4 na[4];
        rd_ids(sl1, na);
        {
            const int b = tok >> 13;
            if (b != gb) {
                gb = b;
#if V_MFMA
                if (lane < 16) {
#pragma unroll
                    for (int nt = 0; nt < 8; ++nt) gfv[nt] = ada[b * ADA_STRIDE + layer * 6144 + 5 * 1024 + colx + 16 * nt];
                }
#else
                const float* gf = ada + b * ADA_STRIDE + layer * 6144 + 5 * 1024 + col0;
#pragma unroll
                for (int c = 0; c < 4; ++c) gfv[c] = *(const f32x4*)(gf + 4 * c);
#endif
                asm volatile("s_waitcnt vmcnt(0)" ::: "memory");
            }
        }
#if V_MFMA
        float invS;
        {
            const float w0 = __uint_as_float(ring[sl0 * 256 + 128 + lane]), w1 = __uint_as_float(ring[sl0 * 256 + 192 + lane]);
            const float mx = wave_max(fmaxf(fabsf(w0), fabsf(w1)));
            int ex = (int)((__float_as_uint(mx) >> 23) & 255u) - 127;
            ex = ex < -100 ? -100 : ex;
            const float S = __uint_as_float((unsigned)(127 + 7 - ex) << 23);
            invS = __uint_as_float((unsigned)(127 - 7 + ex) << 23);
            const float a0 = w0 * S, a1 = w1 * S;
            const int hi = __builtin_amdgcn_cvt_pk_fp8_f32(a0, a1, 0, false);
            const f32x2 hf = __builtin_amdgcn_cvt_pk_f32_fp8(hi, false);
            const int lo = __builtin_amdgcn_cvt_pk_fp8_f32(a0 - hf.x, a1 - hf.y, 0, false);
            const int p0 = 8 * (lane & 15) + (lane >> 4);
            wb8[p0] = (unsigned char)(hi & 255); wb8[p0 + 4] = (unsigned char)((hi >> 8) & 255);
            wb8[128 + p0] = (unsigned char)(lo & 255); wb8[128 + p0 + 4] = (unsigned char)((lo >> 8) & 255);
        }
        f32x4 d[8];
#pragma unroll
        for (int nt = 0; nt < 8; ++nt) d[nt] = (f32x4){0.f, 0.f, 0.f, 0.f};
#pragma unroll
        for (int j = 0; j < 4; ++j) {
            asm volatile("s_waitcnt vmcnt(24)" ::: "memory");
            v2i_t aq, b0, b1, b2, b3, b4, b5, b6, b7;
            asm volatile("ds_read_b64 %0, %9 offset:%18\n\t"
                         "ds_read_b64_tr_b8 %1, %10 offset:%19\n\tds_read_b64_tr_b8 %2, %11 offset:%19\n\t"
                         "ds_read_b64_tr_b8 %3, %12 offset:%19\n\tds_read_b64_tr_b8 %4, %13 offset:%19\n\t"
                         "ds_read_b64_tr_b8 %5, %14 offset:%19\n\tds_read_b64_tr_b8 %6, %15 offset:%19\n\t"
                         "ds_read_b64_tr_b8 %7, %16 offset:%19\n\tds_read_b64_tr_b8 %8, %17 offset:%19\n\t"
                         "s_waitcnt lgkmcnt(0)"
                         : "=&v"(aq), "=&v"(b0), "=&v"(b1), "=&v"(b2), "=&v"(b3), "=&v"(b4), "=&v"(b5), "=&v"(b6), "=&v"(b7)
                         : "v"(aaddr), "v"(baddr[0]), "v"(baddr[1]), "v"(baddr[2]), "v"(baddr[3]), "v"(baddr[4]), "v"(baddr[5]), "v"(baddr[6]), "v"(baddr[7]),
                           "i"(32 * j), "i"(4096 * j)
                         : "memory");
            long a8 = ((long)(unsigned)aq.y << 32) | (unsigned)aq.x;
            a8 = m16 < 2 ? a8 : 0l;
            const v2i_t bq[8] = {b0, b1, b2, b3, b4, b5, b6, b7};
#pragma unroll
            for (int nt = 0; nt < 8; ++nt) {
                const long b8 = ((long)(unsigned)bq[nt].y << 32) | (unsigned)bq[nt].x;
                d[nt] = __builtin_amdgcn_mfma_f32_16x16x32_fp8_fp8(a8, b8, d[nt], 0, 0, 0);
            }
            issue(j, na);
        }
        if (lane < 16) {
            float* xr = DRY ? (float*)(ws + OFF_R + 16 * MB) + (long)tok * DM + colx : x + (long)tok * DM + colx;
#pragma unroll
            for (int nt = 0; nt < 8; ++nt) xr[16 * nt] = xv[nt] + gfv[nt] * ((d[nt].x + d[nt].y) * invS);
            const int tn = tok + nwv < NTOK ? tok + nwv : wv;
#pragma unroll
            for (int nt = 0; nt < 8; ++nt) xv[nt] = x[(long)tn * DM + colx + 16 * nt];
        }
#else
        f32x4 cw[4];
        {
            const f32x4* wp = (const f32x4*)(ring + sl0 * 256 + 128 + eg * 16);
#pragma unroll
            for (int q = 0; q < 4; ++q) cw[q] = wp[q];
        }
        f32x2 ap[8];
#pragma unroll
        for (int i = 0; i < 8; ++i) ap[i] = (f32x2){0.f, 0.f};
#pragma unroll
        for (int j = 0; j < 4; ++j) {
            asm volatile("s_waitcnt vmcnt(20)" ::: "memory");
#pragma unroll
            for (int i = 0; i < 4; ++i) {
                const int rs = 8 * i + eg, g = 4 * (i & 1) + (eg >> 1);
                const u32x4 v = *(const u32x4*)(gr + j * 4096 + rs * 128 + ((sub ^ g) << 4));
                const float ws1 = cw[j][i]; const f32x2 ww = {ws1, ws1};
                ap[0] += __builtin_amdgcn_cvt_pk_f32_fp8((int)v.x, false) * ww; ap[1] += __builtin_amdgcn_cvt_pk_f32_fp8((int)v.x, true) * ww;
                ap[2] += __builtin_amdgcn_cvt_pk_f32_fp8((int)v.y, false) * ww; ap[3] += __builtin_amdgcn_cvt_pk_f32_fp8((int)v.y, true) * ww;
                ap[4] += __builtin_amdgcn_cvt_pk_f32_fp8((int)v.z, false) * ww; ap[5] += __builtin_amdgcn_cvt_pk_f32_fp8((int)v.z, true) * ww;
                ap[6] += __builtin_amdgcn_cvt_pk_f32_fp8((int)v.w, false) * ww; ap[7] += __builtin_amdgcn_cvt_pk_f32_fp8((int)v.w, true) * ww;
            }
            asm volatile("s_waitcnt lgkmcnt(0)" ::: "memory");
            issue(j, na);
        }
        float acc[16];
#pragma unroll
        for (int i = 0; i < 8; ++i) { acc[2 * i] = ap[i].x; acc[2 * i + 1] = ap[i].y; }
#pragma unroll
        for (int i = 0; i < 16; ++i) { acc[i] += lr8(acc[i]); acc[i] = sum_x16(acc[i]); acc[i] = sum_x32(acc[i]); }
        if (eg == 0) {
            float* xr = DRY ? (float*)(ws + OFF_R + 16 * MB) + (long)tok * DM + col0 : x + (long)tok * DM + col0;
#pragma unroll
            for (int c = 0; c < 4; ++c) {
                const f32x4 gv = gfv[c];
                f32x4 o;
                o.x = xv[c].x + gv.x * acc[4 * c + 0]; o.y = xv[c].y + gv.y * acc[4 * c + 1];
                o.z = xv[c].z + gv.z * acc[4 * c + 2]; o.w = xv[c].w + gv.w * acc[4 * c + 3];
                *(f32x4*)(xr + 4 * c) = o;
            }
            const int tn = tok + nwv < NTOK ? tok + nwv : wv;
#pragma unroll
            for (int c = 0; c < 4; ++c) xv[c] = *(const f32x4*)(x + (long)tn * DM + col0 + 4 * c);
        }
#endif
        s3 = sl1;
    }
    asm volatile("s_waitcnt vmcnt(0)" ::: "memory");
}

DI void norm_row_q8(const f32x4 (&v)[4], float rstd, const float* gain, const float* shift, const float* scale, unsigned char* orow, float* os, int lane) {
    f32x4 y[4]; float am = 0.f;
#pragma unroll
    for (int j = 0; j < 4; ++j) {
        const int c = 4 * lane + 256 * j;
        const f32x4 g = *(const f32x4*)(gain + c), sh = *(const f32x4*)(shift + c), sc = *(const f32x4*)(scale + c);
        y[j].x = v[j].x * rstd * g.x * (1.f + sc.x) + sh.x; y[j].y = v[j].y * rstd * g.y * (1.f + sc.y) + sh.y;
        y[j].z = v[j].z * rstd * g.z * (1.f + sc.z) + sh.z; y[j].w = v[j].w * rstd * g.w * (1.f + sc.w) + sh.w;
        am = fmaxf(am, fmaxf(fmaxf(fabsf(y[j].x), fabsf(y[j].y)), fmaxf(fabsf(y[j].z), fabsf(y[j].w))));
    }
    am = wave_max(am);
    const float qs = am > 0.f ? 127.f / am : 1.f;
#pragma unroll
    for (int j = 0; j < 4; ++j) *(int*)(orow + 4 * lane + 256 * j) = pack_i8x4(y[j].x * qs, y[j].y * qs, y[j].z * qs, y[j].w * qs);
    if (lane == 0) *os = am > 0.f ? am * (1.f / 127.f) : 1.f;
}
DI void phase_norm2(const float* __restrict__ x, unsigned char* __restrict__ out1, float* __restrict__ os1, const float* gain1, int sh1, int sc1,
                    unsigned char* __restrict__ out2, float* __restrict__ os2, const float* gain2, int sh2, int sc2, const float* ada, int tid) {
    const int lane = tid & 63, gw = blockIdx.x * NWAVES + (tid >> 6), nw = gridDim.x * NWAVES;
    for (int tok = gw; tok < NTOK; tok += nw) {
        const int b = tok >> 13;
        f32x4 v[4]; float ss = 0.f;
#pragma unroll
        for (int j = 0; j < 4; ++j) { v[j] = *(const f32x4*)(x + (long)tok * DM + 4 * lane + 256 * j); ss += v[j].x * v[j].x + v[j].y * v[j].y + v[j].z * v[j].z + v[j].w * v[j].w; }
        const float rstd = rsqrtf(wave_sum(ss) * (1.f / DM) + EPS);
        norm_row_q8(v, rstd, gain1, ada + b * ADA_STRIDE + sh1, ada + b * ADA_STRIDE + sc1, out1 + (long)tok * DM, os1 + tok, lane);
        norm_row_q8(v, rstd, gain2, ada + b * ADA_STRIDE + sh2, ada + b * ADA_STRIDE + sc2, out2 + (long)tok * DM, os2 + tok, lane);
    }
}

template <int MT, class Epi>
DI void gemm_phase(const bf16_t* A, long lda, int M, const bf16_t* Bt, long ldb, int N, int K, const Epi& epi, unsigned char* lds, int tid) {
    const int ntm = (M + 128 * MT - 1) / (128 * MT), ntn = (N + 255) / 256, nt = ntm * ntn;
    if ((gridDim.x & 7) == 0 && (ntm & 31) == 0) {
        const int xcd = blockIdx.x & 7, lb = blockIdx.x >> 3, nlb = gridDim.x >> 3, tmx = ntm >> 3, per = tmx * ntn;
        for (int q = lb; q < per; q += nlb) {
            const int g4 = q / (4 * ntn), rem = q - g4 * 4 * ntn, tn = rem >> 2, tm = xcd * tmx + g4 * 4 + (rem & 3);
            if (tm < (xcd + 1) * tmx) gemm_tile<MT>(A, lda, M, Bt, ldb, N, K, tm * 128 * MT, tn * 256, epi, lds, tid);
        }
        return;
    }
    for (int t = blockIdx.x; t < nt; t += gridDim.x) {
        const int tn = t / ntm, tm = t % ntm;
        gemm_tile<MT>(A, lda, M, Bt, ldb, N, K, tm * 128 * MT, tn * 256, epi, lds, tid);
    }
}

template <int MT, class Epi>
DI void gemm_tile_i8(const unsigned char* __restrict__ A, int M, const float* __restrict__ as, const unsigned char* __restrict__ Bt, int N, const float* __restrict__ bs,
                     int K, int m0, int n0, const Epi& epi, unsigned char* lds, int tid) {
    constexpr int XS = MT * 128 * 128, WS = 256 * 128, STAGE = XS + WS;
    const int lane = tid & 63, w = tid >> 6, tg = w & 3, fh = w >> 2, r = lane & 31, h = lane >> 5;
    const int wbase = tid & ~63;
    unsigned xo[2 * MT], wo[4];
#pragma unroll
    for (int i = 0; i < 2 * MT; ++i) { int row, c; sw2_src(tid + 512 * i, row, c); int m = m0 + row; m = m < M ? m : M - 1; xo[i] = (unsigned)m * (unsigned)K + c * 16; }
#pragma unroll
    for (int i = 0; i < 4; ++i) { int row, c; sw2_src(tid + 512 * i, row, c); int n = n0 + row; n = n < N ? n : N - 1; wo[i] = (unsigned)n * (unsigned)K + c * 16; }
    auto stage = [&](int kt, unsigned char* st) {
#pragma unroll
        for (int i = 0; i < 2 * MT; ++i)
            __builtin_amdgcn_global_load_lds((const unsigned*)(A + kt * 128 + xo[i]), (unsigned*)(st + (wbase + 512 * i) * 16), 16, 0, 0);
#pragma unroll
        for (int i = 0; i < 4; ++i)
            __builtin_amdgcn_global_load_lds((const unsigned*)(Bt + kt * 128 + wo[i]), (unsigned*)(st + XS + (wbase + 512 * i) * 16), 16, 0, 0);
    };
    i32x16 acc[MT][4];
#pragma unroll
    for (int s2 = 0; s2 < MT; ++s2)
#pragma unroll
        for (int i = 0; i < 4; ++i)
#pragma unroll
            for (int j = 0; j < 16; ++j) acc[s2][i][j] = 0;
    const int nk = K >> 7;
    stage(0, lds);
    __syncthreads();
#pragma unroll 2
    for (int kt = 0; kt < nk; ++kt) {
        unsigned char* cur = lds + (kt & 1) * STAGE;
        if (kt + 1 < nk) stage(kt + 1, lds + ((kt + 1) & 1) * STAGE);
        i32x4 xfa[MT], wfa[4], xfb[MT], wfb[4];
        auto ldf = [&](i32x4 (&xf)[MT], i32x4 (&wf)[4], int ks) {
#pragma unroll
            for (int s2 = 0; s2 < MT; ++s2) xf[s2] = *(const i32x4*)(cur + sw2(32 * MT * tg + 32 * s2 + r, 2 * ks + h));
#pragma unroll
            for (int mt = 0; mt < 4; ++mt) wf[mt] = *(const i32x4*)(cur + XS + sw2(128 * fh + 32 * mt + r, 2 * ks + h));
        };
        auto mm = [&](const i32x4 (&xf)[MT], const i32x4 (&wf)[4]) {
#pragma unroll
            for (int mt = 0; mt < 4; ++mt)
#pragma unroll
                for (int s2 = 0; s2 < MT; ++s2) acc[s2][mt] = MFMA32I8(wf[mt], xf[s2], acc[s2][mt]);
        };
        ldf(xfa, wfa, 0);
        ldf(xfb, wfb, 1); __builtin_amdgcn_sched_barrier(0); mm(xfa, wfa); __builtin_amdgcn_sched_barrier(0);
        ldf(xfa, wfa, 2); __builtin_amdgcn_sched_barrier(0); mm(xfb, wfb); __builtin_amdgcn_sched_barrier(0);
        ldf(xfb, wfb, 3); __builtin_amdgcn_sched_barrier(0); mm(xfa, wfa); __builtin_amdgcn_sched_barrier(0);
        mm(xfb, wfb);
        __syncthreads();
    }
    auto fin = [&](const i32x16 (&ai)[4], int s2, int ho, int ro, int to) {
        const int tok = m0 + 32 * MT * tg + 32 * s2 + ro, fbase = n0 + 128 * fh;
        const float sa = as[tok < M ? tok : M - 1];
        f32x16 af[4];
#pragma unroll
        for (int mt = 0; mt < 4; ++mt) {
#pragma unroll
            for (int g4 = 0; g4 < 4; ++g4) {
                int f0 = fbase + 32 * mt + 8 * g4 + 4 * ho; f0 = f0 + 3 < N ? f0 : (N - 4 > 0 ? N - 4 : 0);
                const f32x4 sb = *(const f32x4*)(bs + f0);
                af[mt][4 * g4 + 0] = (float)ai[mt][4 * g4 + 0] * (sa * sb.x); af[mt][4 * g4 + 1] = (float)ai[mt][4 * g4 + 1] * (sa * sb.y);
                af[mt][4 * g4 + 2] = (float)ai[mt][4 * g4 + 2] * (sa * sb.z); af[mt][4 * g4 + 3] = (float)ai[mt][4 * g4 + 3] * (sa * sb.w);
            }
            __builtin_amdgcn_sched_barrier(0);
        }
        epi(af, tok, fbase, ho, lds, to);
        __builtin_amdgcn_sched_barrier(0);
    };
    if constexpr (MT == 2 && epi_stash<Epi>::present) {
        int* sp = (int*)lds + w * 4096 + lane;
#pragma unroll
        for (int mt = 0; mt < 4; ++mt)
#pragma unroll
            for (int j = 0; j < 16; ++j) sp[(mt * 16 + j) * 64] = acc[1][mt][j];
        int ho = h, ro = r, to = tid;
        asm volatile("" : "+v"(ho), "+v"(ro), "+v"(to));
        fin(acc[0], 0, ho, ro, to);
        i32x16 a2[4];
        const int* sp2 = sp; asm volatile("" : "+v"(sp2));
#pragma unroll
        for (int mt = 0; mt < 4; ++mt)
#pragma unroll
            for (int j = 0; j < 16; ++j) a2[mt][j] = sp2[(mt * 16 + j) * 64];
        asm volatile("" : "+v"(ho), "+v"(ro), "+v"(to));
        fin(a2, 1, ho, ro, to);
        __syncthreads();
    } else {
        int ho = h, ro = r, to = tid;
#pragma unroll
        for (int s2 = 0; s2 < MT; ++s2) { asm volatile("" : "+v"(ho), "+v"(ro), "+v"(to)); fin(acc[s2], s2, ho, ro, to); }
    }
}
template <int MT, class Epi>
DI void gemm_phase_i8(const unsigned char* A, int M, const float* as, const unsigned char* Bt, int N, const float* bs, int K, const Epi& epi, unsigned char* lds, int tid,
                      int skip = 0) {
    const int ntm = (M + 128 * MT - 1) / (128 * MT), ntn = (N + 255) / 256, nt = ntm * ntn;
    const int bid = (int)blockIdx.x - skip, nbl = (int)gridDim.x - skip;
    if (bid < 0) return;
    if ((gridDim.x & 7) == 0 && (ntm & 31) == 0) {
        const int xcd = bid & 7, lb = bid >> 3, nlb = nbl >> 3, tmx = ntm >> 3, per = tmx * ntn;
        for (int q = lb; q < per; q += nlb) {
            const int g4 = q / (4 * ntn), rem = q - g4 * 4 * ntn, tn = rem >> 2, tm = xcd * tmx + g4 * 4 + (rem & 3);
            gemm_tile_i8<MT>(A, M, as, Bt, N, bs, K, tm * 128 * MT, tn * 256, epi, lds, tid);
        }
        return;
    }
    for (int t = bid; t < nt; t += nbl) {
        const int tn = t / ntm, tm = t % ntm;
        gemm_tile_i8<MT>(A, M, as, Bt, N, bs, K, tm * 128 * MT, tn * 256, epi, lds, tid);
    }
}

DI void wquant_rows(const bf16_t* __restrict__ src, unsigned char* __restrict__ dst, float* __restrict__ sc, int nrows, int gw, int nw, int lane) {
    for (int n = gw; n < nrows; n += nw) {
        const u32x4 a = *(const u32x4*)(src + (long)n * 1024 + 16 * lane), b = *(const u32x4*)(src + (long)n * 1024 + 16 * lane + 8);
        float v[16];
        v[0] = bflo(a.x); v[1] = bfhi(a.x); v[2] = bflo(a.y); v[3] = bfhi(a.y); v[4] = bflo(a.z); v[5] = bfhi(a.z); v[6] = bflo(a.w); v[7] = bfhi(a.w);
        v[8] = bflo(b.x); v[9] = bfhi(b.x); v[10] = bflo(b.y); v[11] = bfhi(b.y); v[12] = bflo(b.z); v[13] = bfhi(b.z); v[14] = bflo(b.w); v[15] = bfhi(b.w);
        float am = 0.f;
#pragma unroll
        for (int q = 0; q < 16; ++q) am = fmaxf(am, fabsf(v[q]));
        am = wave_max(am);
        const float qs = am > 0.f ? 127.f / am : 1.f;
        u32x4 o;
        o.x = (unsigned)pack_i8x4(v[0] * qs, v[1] * qs, v[2] * qs, v[3] * qs); o.y = (unsigned)pack_i8x4(v[4] * qs, v[5] * qs, v[6] * qs, v[7] * qs);
        o.z = (unsigned)pack_i8x4(v[8] * qs, v[9] * qs, v[10] * qs, v[11] * qs); o.w = (unsigned)pack_i8x4(v[12] * qs, v[13] * qs, v[14] * qs, v[15] * qs);
        *(u32x4*)(dst + (long)n * 1024 + 16 * lane) = o;
        if (lane == 0) sc[n] = am > 0.f ? am * (1.f / 127.f) : 1.f;
    }
}
DI void phase_wquant(unsigned char* ws, int tid) {
    const int lane = tid & 63, gw = blockIdx.x * NWAVES + (tid >> 6), nw = gridDim.x * NWAVES;
    float* sc = (float*)(ws + OFF_W8S);
    wquant_rows((const bf16_t*)(ws + OFF_WT_PEER), ws + OFF_W8_PEER, sc + W8S_PEER, 4096, gw, nw, lane);
    wquant_rows((const bf16_t*)(ws + OFF_WT_DIN), ws + OFF_W8_DIN, sc + W8S_DIN, 3072, gw, nw, lane);
    wquant_rows((const bf16_t*)(ws + OFF_WT_KV), ws + OFF_W8_KV, sc + W8S_KV, 1536, gw, nw, lane);
    wquant_rows((const bf16_t*)(ws + OFF_WT_NIN), ws + OFF_W8_NIN, sc + W8S_NIN, 1088, gw, nw, lane);
}

#define XB_TMO      128
#define XB_XCNT(j)  (256  + 64 * (j))
#define XB_XSUB(j)  (1280 + 64 * (j))
#define XB_XGEN(j)  (2304 + 64 * (j))
#define XB_TOP      3328
#define XB_TOPGEN   3392
#define XCD_BAR_WORDS 3456
#define XB_SPIN_CAP (1u << 22)
DI unsigned xb_ld(unsigned* p) { return __hip_atomic_load(p, __ATOMIC_RELAXED, __HIP_MEMORY_SCOPE_AGENT); }
DI unsigned xb_add(unsigned* p, unsigned v) { return __hip_atomic_fetch_add(p, v, __ATOMIC_RELAXED, __HIP_MEMORY_SCOPE_AGENT); }
DI unsigned xb_xcc_id() { return (unsigned)__builtin_amdgcn_s_getreg((3 << 11) | 20) & 0xFu; }
#define XB_SPIN(cond, bar) do { unsigned _sp = 0; while (cond) { __builtin_amdgcn_s_sleep(1); \
    if ((++_sp & 255u) == 0u) { if (xb_ld(&(bar)[XB_TMO])) break; if (_sp > XB_SPIN_CAP) { atomicAdd(&(bar)[XB_TMO], 1u); break; } } } } while (0)
DI void xcd_barrier_complete(unsigned* bar, unsigned x, unsigned& nloc, unsigned& nx) {
    const unsigned G = gridDim.x;
    unsigned sum, cnt, mine, sp = 0u;
    for (;;) {
        sum = 0u; cnt = 0u; mine = 0u;
#pragma unroll
        for (unsigned j = 0; j < 16; ++j) { const unsigned c = xb_ld(&bar[XB_XCNT(j)]); sum += c; cnt += (c > 0u) ? 1u : 0u; mine = (j == x) ? c : mine; }
        if (sum == G) break;
        __builtin_amdgcn_s_sleep(1);
        if ((++sp & 255u) == 0u) { if (xb_ld(&bar[XB_TMO])) break; if (sp > XB_SPIN_CAP) { atomicAdd(&bar[XB_TMO], 1u); break; } }
    }
    nloc = mine > 0u ? mine : 1u; nx = cnt > 0u ? cnt : 1u;
}
DI void xcd_barrier(unsigned* bar, volatile LAS unsigned* st, int tid) {
    asm volatile("s_waitcnt vmcnt(0)" ::: "memory");
    __syncthreads();
    if (tid == 0) {
        const unsigned x = xb_xcc_id();
        __builtin_amdgcn_s_waitcnt(0);
        unsigned nloc = st[0], nx = st[1];
        if (nloc == 0u) { xcd_barrier_complete(bar, x, nloc, nx); st[0] = nloc; st[1] = nx; }
        const unsigned old = xb_add(&bar[XB_XSUB(x)], 1u);
        const unsigned gen = old / nloc;
        if (old + 1u == (gen + 1u) * nloc) {
            __builtin_amdgcn_fence(__ATOMIC_RELEASE, "agent");
            asm volatile("s_waitcnt vmcnt(0)" ::: "memory");
            const unsigned og = xb_add(&bar[XB_TOP], 1u);
            const unsigned tg = og / nx;
            if (og + 1u == (tg + 1u) * nx) xb_add(&bar[XB_TOPGEN], 1u);
            else XB_SPIN(xb_ld(&bar[XB_TOPGEN]) == tg, bar);
            __builtin_amdgcn_fence(__ATOMIC_ACQUIRE, "agent");
            xb_add(&bar[XB_XGEN(x)], 1u);
            asm volatile("s_waitcnt vmcnt(0)" ::: "memory");
        } else {
            XB_SPIN(xb_ld(&bar[XB_XGEN(x)]) == gen, bar);
            __builtin_amdgcn_fence(__ATOMIC_ACQUIRE, "agent");
            asm volatile("s_waitcnt vmcnt(0)" ::: "memory");
        }
    }
    __syncthreads();
}

#define ftid() ftid_(wave_u)
DI int ftid_(int wave_u) { int t = (wave_u << 6) + (int)__builtin_amdgcn_mbcnt_hi(~0u, __builtin_amdgcn_mbcnt_lo(~0u, 0u)); asm volatile("" : "+v"(t)); return t; }


#if defined(__HIP_DEVICE_COMPILE__)
typedef const __attribute__((address_space(4))) Params* KParamPtr;
DI Params load_params() { KParamPtr kp = (KParamPtr)__builtin_amdgcn_kernarg_segment_ptr(); asm volatile("" : "+s"(kp)); return *kp; }
#else
DI Params load_params() { return Params{}; }
#endif
#define p (load_params())
#define ws (load_params().ws)
#define ada ((const float*)(ws + OFF_ADA))
#define Hb ((bf16_t*)(ws + OFF_H))
#define bar ((unsigned*)(ws + OFF_BAR))
__global__ void __launch_bounds__(NTHREADS) yoco_fwd(Params p_arg) {
    extern __shared__ __attribute__((aligned(16))) unsigned char lds[];
    cg::grid_group grid = cg::this_grid();
    volatile LAS unsigned* bst = (volatile LAS unsigned*)(lds + LDS_BAR);
    const int wave_u = __builtin_amdgcn_readfirstlane((int)(threadIdx.x >> 6));
    { const int t0 = ftid(); if (t0 == 0) { bst[0] = 0u; bst[1] = 0u; }
      if (blockIdx.x == 0) for (int i = t0; i < XCD_BAR_WORDS; i += NTHREADS) bar[i] = 0u; }
    __syncthreads();
    RUN(0) REP(0) phase_prep(p, lds, ftid());
    grid.sync();
    if (ftid() == 0) (void)xb_add(&bar[XB_XCNT(xb_xcc_id())], 1u);
    RUN(1) REP(1) phase_norm_q8<false>(p.in[0], Hb, ws + OFF_H8, (float*)(ws + OFF_HS), p.in[5], ada, 0, 1024, ftid());
    RUN(1) phase_wquant(ws, ftid());
    xcd_barrier(bar, bst, ftid());
    RUN(2) REP(2) {
        EpiQKV0 e{(bf16_t*)(ws + OFF_Q0), (bf16_t*)(ws + OFF_K0), (bf16_t*)(ws + OFF_VT0), p.in[10], p.in[11], (float*)(ws + OFF_MB0), p.in[2]};
        gemm_phase_i8<2>(ws + OFF_H8, NTOK, (const float*)(ws + OFF_HS), ws + OFF_W8_DIN, 3072, (const float*)(ws + OFF_W8S) + W8S_DIN, DM, e, lds, ftid());
    }
    xcd_barrier(bar, bst, ftid());
    RUN(3) REP(3) phase_diff_attn(p, lds, ftid());
    xcd_barrier(bar, bst, ftid());
    RUN(4) REP(4) {
        EpiResid e{p.in[0], opq(p.out), ada + 2 * 1024};
        gemm_phase<2>(Hb, DM, NTOK, (const bf16_t*)(ws + OFF_WT_DOUT), DM, 1024, DM, e, lds, ftid());
    }
    xcd_barrier(bar, bst, ftid());
    if (STOP_AFTER <= 1) return;
    RUN(1) phase_norm_q8<false>(opq(p.out), Hb, ws + OFF_H8, (float*)(ws + OFF_HS), p.in[6], ada, 3 * 1024, 4 * 1024, ftid());
    xcd_barrier(bar, bst, ftid());
    RUN(5) REP(5) {
        EpiPeer e{(int*)(ws + OFF_RIDX), (float*)(ws + OFF_RGATE), 128 * 1024};
        gemm_phase_i8<2>(ws + OFF_H8, NTOK, (const float*)(ws + OFF_HS), ws + OFF_W8_PEER, 2048, (const float*)(ws + OFF_W8S) + W8S_PEER, DM, e, lds, ftid());
    }
    xcd_barrier(bar, bst, ftid());
    if ((REPEAT_MASK >> 6) & 1) phase_peer_u<true>(p, 0, lds, ftid());
    RUN(6) phase_peer_u<false>(p, 0, lds, ftid());
    xcd_barrier(bar, bst, ftid());
    if ((REPEAT_MASK >> 10) & 1) phase_peer_v<true>(p, 0, lds, ftid());
    RUN(6) phase_peer_v<false>(p, 0, lds, ftid());
    xcd_barrier(bar, bst, ftid());
    RUN(1) phase_norm2(opq(p.out), ws + OFF_H8, (float*)(ws + OFF_HS), p.in[13], 12288, 12288 + 1024, ws + OFF_H, (float*)(ws + OFF_HS) + NTOK, p.in[5] + 1024, 6144, 6144 + 1024, ada, ftid());
    xcd_barrier(bar, bst, ftid());
    if (STOP_AFTER <= 2) return;
    RUN(7) REP(7) {
        EpiKV e{(bf16_t*)(ws + OFF_KC), (bf16_t*)(ws + OFF_KS), (bf16_t*)(ws + OFF_VST), (bf16_t*)(ws + OFF_KW), (bf16_t*)(ws + OFF_VWT), p.in[21]};
        gemm_phase_i8<2>(ws + OFF_H8, NTOK, (const float*)(ws + OFF_HS), ws + OFF_W8_KV, 1536, (const float*)(ws + OFF_W8S) + W8S_KV, DM, e, lds, ftid());
    }
    xcd_barrier(bar, bst, ftid());
    RUN(8) REP(8) {
        EpiNsaQ e{(bf16_t*)(ws + OFF_QN), (float*)(ws + OFF_GATES), p.in[25], p.in[23], (float*)(ws + OFF_MB1)};
        gemm_phase_i8<2>(ws + OFF_H, NTOK, (const float*)(ws + OFF_HS) + NTOK, ws + OFF_W8_NIN, 1048, (const float*)(ws + OFF_W8S) + W8S_NIN, DM, e, lds, ftid(),
                         gridDim.x >= 128 ? 64 : 0);
        for (int t = blockIdx.x; t < 64; t += gridDim.x) {
            const int pr = t >> 2, tm = t & 3, kv = pr >> 3, bg = pr & 7;
            const bf16_t* Ap = (const bf16_t*)(ws + OFF_KC) + (long)(kv * 8 + bg) * SEQ * 128;
            bf16_t* hid = (bf16_t*)(ws + OFF_HID) + (long)pr * 512 * 256;
            EpiCmp1 e1{hid, (const float*)(ws + OFF_POSB) + kv * 16 * 256, p.in[19] + kv * 256};
            gemm_tile<1>(Ap, 2048, 511, (const bf16_t*)(ws + OFF_WT_C1) + (long)kv * 256 * 4096, 4096, 256, 4096, tm * 128, 0, e1, lds, ftid());
            __syncthreads();
            bf16_t* dst = kv == 0 ? (bf16_t*)(ws + OFF_KCMP) + (long)bg * 512 * 128 : (bf16_t*)(ws + OFF_VCMPT) + (long)bg * 128 * 512;
            EpiCmp2 e2{dst, p.in[21], kv};
            gemm_tile<1>(hid, 256, 512, (const bf16_t*)(ws + OFF_WT_C2) + (long)kv * 128 * 256, 256, 128, 256, tm * 128, 0, e2, lds, ftid());
        }
    }
    xcd_barrier(bar, bst, ftid());
#ifdef NSA_PROBE
    phase_nsa_attn<NSA_PROBE>(p, lds, ftid());
#endif
    RUN(9) REP(9) phase_nsa_attn<0>(p, lds, ftid());
    xcd_barrier(bar, bst, ftid());
    RUN(4) {
        float* xo = opq(p.out);
        EpiResid e{xo, xo, ada + 6144 + 2 * 1024};
        gemm_phase<2>(Hb, DM, NTOK, (const bf16_t*)(ws + OFF_WT_NOUT), DM, 1024, DM, e, lds, ftid());
    }
    xcd_barrier(bar, bst, ftid());
    if (STOP_AFTER <= 3) return;
    RUN(1) phase_norm_q8<false>(opq(p.out), Hb, ws + OFF_H8, (float*)(ws + OFF_HS), p.in[6] + 1024, ada, 6144 + 3 * 1024, 6144 + 4 * 1024, ftid());
    xcd_barrier(bar, bst, ftid());
    RUN(5) REP(5) {
        EpiPeer e{(int*)(ws + OFF_RIDX), (float*)(ws + OFF_RGATE), 128 * 1024};
        gemm_phase_i8<2>(ws + OFF_H8, NTOK, (const float*)(ws + OFF_HS), ws + OFF_W8_PEER + (long)2048 * 1024, 2048, (const float*)(ws + OFF_W8S) + W8S_PEER + 2048, DM, e, lds, ftid());
    }
    xcd_barrier(bar, bst, ftid());
    if ((REPEAT_MASK >> 6) & 1) phase_peer_u<true>(p, 1, lds, ftid());
    RUN(6) phase_peer_u<false>(p, 1, lds, ftid());
    xcd_barrier(bar, bst, ftid());
    if ((REPEAT_MASK >> 10) & 1) phase_peer_v<true>(p, 1, lds, ftid());
    RUN(6) phase_peer_v<false>(p, 1, lds, ftid());
}
#undef p
#undef ws
#undef ada
#undef Hb
#undef bar

extern "C" void kernel_launch(void* const* d_in, const int* in_sizes, int n_in, void* d_out, int out_size, void* d_ws, size_t ws_size,
                              hipStream_t stream) {
    static int grid_blocks = 0;
    if (grid_blocks == 0) {
        if (n_in != 30 || out_size != NTOK * DM || ws_size < WS_END) {
            fprintf(stderr, "kernel_launch: unexpected shapes (n_in %d out %d ws %zu)\n", n_in, out_size, ws_size);
            grid_blocks = -1; return;
        }
        int dev = 0, cus = 0, per_cu = 0;
        hipGetDevice(&dev);
        hipDeviceGetAttribute(&cus, hipDeviceAttributeMultiprocessorCount, dev);
        hipFuncSetAttribute((const void*)yoco_fwd, hipFuncAttributeMaxDynamicSharedMemorySize, LDS_BYTES);
        hipOccupancyMaxActiveBlocksPerMultiprocessor(&per_cu, (const void*)yoco_fwd, NTHREADS, LDS_BYTES);
        if (per_cu < 1) { fprintf(stderr, "kernel_launch: occupancy query says %d blocks per CU\n", per_cu); grid_blocks = -1; return; }
        grid_blocks = cus;
    }
    if (grid_blocks < 0) return;
    Params p{};
    for (int i = 0; i < 30; ++i) p.in[i] = (const float*)d_in[i];
    p.out = (float*)d_out;
    p.ws = (unsigned char*)d_ws;
    void* args[] = {&p};
    hipError_t e = hipLaunchCooperativeKernel((const void*)yoco_fwd, dim3(grid_blocks), dim3(NTHREADS), args, LDS_BYTES, stream);
    if (e != hipSuccess) fprintf(stderr, "cooperative launch failed: %s (grid %d)\n", hipGetErrorString(e), grid_blocks);
}
```

```cpp
#include <hip/hip_runtime.h>
#include <hip/hip_cooperative_groups.h>
#include <cstdio>
#include <cstdint>
namespace cg = cooperative_groups;

#define DI __device__ __forceinline__
#ifndef STOP_AFTER
#define STOP_AFTER 99
#endif
#ifndef ONLY_PHASE
#define ONLY_PHASE -1
#endif
#define RUN(n) if (ONLY_PHASE < 0 || ONLY_PHASE == (n))
#ifndef REPEAT_MASK
#define REPEAT_MASK 0
#endif
#define REP(n) for (int rep_ = 0; rep_ < (((REPEAT_MASK) >> (n)) & 1) + 1; ++rep_)

typedef unsigned short bf16_t;
typedef short bf16x8 __attribute__((ext_vector_type(8)));
typedef float f32x16 __attribute__((ext_vector_type(16)));
typedef float f32x4 __attribute__((ext_vector_type(4)));
typedef float f32x2 __attribute__((ext_vector_type(2)));
typedef unsigned u32x4 __attribute__((ext_vector_type(4)));
typedef unsigned u32x2 __attribute__((ext_vector_type(2)));
typedef __bf16 bf16x2v __attribute__((ext_vector_type(2)));

#define MFMA32(a, b, c) __builtin_amdgcn_mfma_f32_32x32x16_bf16((a), (b), (c), 0, 0, 0)
typedef int i32x4 __attribute__((ext_vector_type(4)));
typedef int i32x16 __attribute__((ext_vector_type(16)));
#define MFMA32I8(a, b, c) __builtin_amdgcn_mfma_i32_32x32x32_i8((a), (b), (c), 0, 0, 0)

constexpr int NB = 4, SEQ = 8192, DM = 1024, NTOK = NB * SEQ;
constexpr int NTHREADS = 512, NWAVES = 8;
constexpr float EPS = 1e-6f;
constexpr float LOG2E = 1.4426950408889634f;
constexpr int ADA_STRIDE = 14336;

constexpr size_t MB = 1u << 20;
constexpr size_t OFF_ADA = 0;
constexpr size_t OFF_POSB = 256 * 1024;
constexpr size_t OFF_BAR = 320 * 1024;
constexpr size_t OFF_MB0 = 168 * MB;
constexpr size_t OFF_MB1 = 172 * MB;
constexpr size_t OFF_H8 = 104 * MB;
constexpr size_t OFF_HS = 174 * MB;
constexpr size_t OFF_W8 = 176 * MB;
constexpr size_t OFF_W8_DIN = OFF_W8, OFF_W8_KV = OFF_W8 + 3 * MB, OFF_W8_NIN = OFF_W8 + 5 * MB, OFF_W8_PEER = OFF_W8 + 7 * MB;
constexpr size_t OFF_W8S = 188 * MB;
constexpr int W8S_DIN = 0, W8S_KV = 3072, W8S_NIN = 4608, W8S_PEER = 5760, W8S_TOTAL = 9856;
constexpr size_t OFF_USI = 384 * 1024;
constexpr size_t OFF_VSI = 512 * 1024;
constexpr size_t OFF_WT_DIN = 1 * MB;
constexpr size_t OFF_WT_DOUT = 7 * MB;
constexpr size_t OFF_WT_KV = 9 * MB;
constexpr size_t OFF_WT_NIN = 12 * MB;
constexpr size_t OFF_WT_NOUT = 15 * MB;
constexpr size_t OFF_WT_PEER = 17 * MB;
constexpr size_t OFF_WT_C1 = 25 * MB;
constexpr size_t OFF_WT_C2 = 29 * MB;
constexpr size_t OFF_GATES = 30 * MB;
constexpr size_t OFF_KCMP = 34 * MB;
constexpr size_t OFF_VCMPT = 35 * MB;
constexpr size_t OFF_HID = 36 * MB;
constexpr size_t OFF_RIDX = 40 * MB;
constexpr size_t OFF_RGATE = 56 * MB;
constexpr size_t OFF_PU = 72 * MB;
constexpr size_t OFF_PV = 136 * MB;
constexpr size_t OFF_H = 200 * MB;
constexpr size_t OFF_R = 264 * MB;
constexpr size_t WS_END = 456 * MB;
constexpr size_t OFF_Q0 = OFF_R, OFF_K0 = OFF_R + 64 * MB, OFF_VT0 = OFF_R + 128 * MB;
constexpr size_t OFF_QN = OFF_R, OFF_H2 = OFF_R, OFF_KC = OFF_R + 64 * MB, OFF_KS = OFF_R + 96 * MB, OFF_VST = OFF_R + 112 * MB,
                 OFF_KW = OFF_R + 128 * MB, OFF_VWT = OFF_R + 144 * MB;

constexpr int LDS_BAR = 159 * 1024;
constexpr int LDS_BYTES = LDS_BAR + 256;

struct Params {
    const float* in[30];
    float* out;
    unsigned char* ws;
};

template <class T> DI T* opq(T* q) { asm volatile("" : "+s"(q)); return (T*)(__attribute__((address_space(1))) T*)q; }
DI unsigned pk2(float lo, float hi) { f32x2 v = {lo, hi}; return __builtin_bit_cast(unsigned, __builtin_convertvector(v, bf16x2v)); }
DI bf16_t f2bf(float x) { return (bf16_t)(pk2(x, 0.f) & 0xffffu); }
DI float bflo(unsigned u) { return __uint_as_float(u << 16); }
DI float bfhi(unsigned u) { return __uint_as_float(u & 0xffff0000u); }
DI float fexp2(float x) { return __builtin_amdgcn_exp2f(x); }
DI float frcp(float x) { return __builtin_amdgcn_rcpf(x); }
DI int crow(int reg, int h) { return (reg & 3) + 8 * (reg >> 2) + 4 * h; }
template <int CTRL> DI float dpp_f(float v) { return __builtin_bit_cast(float, __builtin_amdgcn_update_dpp(0, __builtin_bit_cast(int, v), CTRL, 0xF, 0xF, true)); }
DI float lx1(float v) { return dpp_f<0xB1>(v); }
DI float lx2(float v) { return dpp_f<0x4E>(v); }
DI float lhm(float v) { return dpp_f<0x141>(v); }
DI float lr8(float v) { return dpp_f<0x128>(v); }
DI float sum_x16(float v) { auto s = __builtin_amdgcn_permlane16_swap(__float_as_uint(v), __float_as_uint(v), false, false); return __uint_as_float(s[0]) + __uint_as_float(s[1]); }
DI float sum_x32(float v) { auto s = __builtin_amdgcn_permlane32_swap(__float_as_uint(v), __float_as_uint(v), false, false); return __uint_as_float(s[0]) + __uint_as_float(s[1]); }
DI float max_x16(float v) { auto s = __builtin_amdgcn_permlane16_swap(__float_as_uint(v), __float_as_uint(v), false, false); return fmaxf(__uint_as_float(s[0]), __uint_as_float(s[1])); }
DI float max_x32(float v) { auto s = __builtin_amdgcn_permlane32_swap(__float_as_uint(v), __float_as_uint(v), false, false); return fmaxf(__uint_as_float(s[0]), __uint_as_float(s[1])); }
DI unsigned get_x32(unsigned v, int h) { auto s = __builtin_amdgcn_permlane32_swap(v, v, false, false); return h ? s[0] : s[1]; }
DI float wave_sum(float v) { v += lx1(v); v += lx2(v); v += lhm(v); v += lr8(v); v = sum_x16(v); return sum_x32(v); }
DI float wave_max(float v) { v = fmaxf(v, lx1(v)); v = fmaxf(v, lx2(v)); v = fmaxf(v, lhm(v)); v = fmaxf(v, lr8(v)); v = max_x16(v); return max_x32(v); }
DI int bperm(int v, int srclane) { return __builtin_amdgcn_ds_bpermute(srclane << 2, v); }
DI float bpermf(float v, int srclane) { return __builtin_bit_cast(float, __builtin_amdgcn_ds_bpermute(srclane << 2, __builtin_bit_cast(int, v))); }
DI float gelu_tanh(float x) {
    const float u = 0.7978845608028654f * (x + 0.044715f * x * x * x);
    return x * frcp(1.f + fexp2(-2.f * LOG2E * u));
}
DI float dot2bf(unsigned a, unsigned b, float c) {
    return __builtin_amdgcn_fdot2_f32_bf16(__builtin_bit_cast(bf16x2v, a), __builtin_bit_cast(bf16x2v, b), c, false);
}
DI int rel_bucket_i(int d) {
    if (d < 16) return d < 0 ? 0 : d;
    int b = 16;
    b += d >= 21; b += d >= 27; b += d >= 35; b += d >= 46; b += d >= 59; b += d >= 77; b += d >= 99; b += d >= 128;
    b += d >= 166; b += d >= 216; b += d >= 280; b += d >= 363; b += d >= 470; b += d >= 609; b += d >= 790;
    return b;
}
DI unsigned f2key(float f) { unsigned u = __float_as_uint(f); return u ^ ((unsigned)((int)u >> 31) | 0x80000000u); }
DI float key2f(unsigned k) { unsigned u = (k & 0x80000000u) ? (k ^ 0x80000000u) : ~k; return __uint_as_float(u); }

constexpr int EPI_LDS = 96 * 1024;

DI int sw2(int row, int chunk) { return (row >> 1) * 256 + (((((row & 1) << 3) | chunk) ^ ((row >> 1) & 15)) << 4); }
DI void sw2_src(int P, int& row, int& chunk) { const int R2 = P >> 4, lc = (P & 15) ^ (R2 & 15); row = 2 * R2 + (lc >> 3); chunk = lc & 7; }

template <class T, class = void> struct epi_stash { static constexpr bool value = false, present = false; };
template <class T> struct epi_stash<T, decltype((void)T::STASH)> { static constexpr bool value = T::STASH, present = true; };

template <int MT, class Epi>
DI void gemm_tile(const bf16_t* __restrict__ A, long lda, int M, const bf16_t* __restrict__ Bt, long ldb, int N, int K,
                  int m0, int n0, const Epi& epi, unsigned char* lds, int tid) {
    constexpr int XS = MT * 128 * 128, WS = 256 * 128, STAGE = XS + WS;
    const int lane = tid & 63, w = tid >> 6, tg = w & 3, fh = w >> 2, r = lane & 31, h = lane >> 5;
    const int wbase = tid & ~63;
    unsigned xo[2 * MT], wo[4];
#pragma unroll
    for (int i = 0; i < 2 * MT; ++i) { int row, c; sw2_src(tid + 512 * i, row, c); int m = m0 + row; m = m < M ? m : M - 1; xo[i] = (unsigned)m * (unsigned)(lda * 2) + c * 16; }
#pragma unroll
    for (int i = 0; i < 4; ++i) { int row, c; sw2_src(tid + 512 * i, row, c); int n = n0 + row; n = n < N ? n : N - 1; wo[i] = (unsigned)n * (unsigned)(ldb * 2) + c * 16; }
    const unsigned char* Ab = (const unsigned char*)A;
    const unsigned char* Bb = (const unsigned char*)Bt;
    auto stage = [&](int kt, unsigned char* st) {
#pragma unroll
        for (int i = 0; i < 2 * MT; ++i)
            __builtin_amdgcn_global_load_lds((const unsigned*)(Ab + kt * 128 + xo[i]), (unsigned*)(st + (wbase + 512 * i) * 16), 16, 0, 0);
#pragma unroll
        for (int i = 0; i < 4; ++i)
            __builtin_amdgcn_global_load_lds((const unsigned*)(Bb + kt * 128 + wo[i]), (unsigned*)(st + XS + (wbase + 512 * i) * 16), 16, 0, 0);
    };
    f32x16 acc[MT][4];
#pragma unroll
    for (int s2 = 0; s2 < MT; ++s2)
#pragma unroll
        for (int i = 0; i < 4; ++i)
#pragma unroll
            for (int j = 0; j < 16; ++j) acc[s2][i][j] = 0.f;
    const int nk = K >> 6;
    stage(0, lds);
    __syncthreads();
    for (int kt = 0; kt < nk; ++kt) {
        unsigned char* cur = lds + (kt & 1) * STAGE;
        if (kt + 1 < nk) stage(kt + 1, lds + ((kt + 1) & 1) * STAGE);
        bf16x8 xfa[MT], wfa[4], xfb[MT], wfb[4];
        auto ldf = [&](bf16x8 (&xf)[MT], bf16x8 (&wf)[4], int ks) {
#pragma unroll
            for (int s2 = 0; s2 < MT; ++s2) xf[s2] = *(const bf16x8*)(cur + sw2(32 * MT * tg + 32 * s2 + r, 2 * ks + h));
#pragma unroll
            for (int mt = 0; mt < 4; ++mt) wf[mt] = *(const bf16x8*)(cur + XS + sw2(128 * fh + 32 * mt + r, 2 * ks + h));
        };
        auto mm = [&](const bf16x8 (&xf)[MT], const bf16x8 (&wf)[4]) {
#pragma unroll
            for (int mt = 0; mt < 4; ++mt)
#pragma unroll
                for (int s2 = 0; s2 < MT; ++s2) acc[s2][mt] = MFMA32(wf[mt], xf[s2], acc[s2][mt]);
        };
        ldf(xfa, wfa, 0);
        ldf(xfb, wfb, 1); __builtin_amdgcn_sched_barrier(0); mm(xfa, wfa); __builtin_amdgcn_sched_barrier(0);
        ldf(xfa, wfa, 2); __builtin_amdgcn_sched_barrier(0); mm(xfb, wfb); __builtin_amdgcn_sched_barrier(0);
        ldf(xfb, wfb, 3); __builtin_amdgcn_sched_barrier(0); mm(xfa, wfa); __builtin_amdgcn_sched_barrier(0);
        mm(xfb, wfb);
        __syncthreads();
    }
    if constexpr (MT == 2 && epi_stash<Epi>::value) {
        float* sp = (float*)lds + w * 4096 + lane;
#pragma unroll
        for (int mt = 0; mt < 4; ++mt)
#pragma unroll
            for (int j = 0; j < 16; ++j) sp[(mt * 16 + j) * 64] = acc[1][mt][j];
        epi(acc[0], m0 + 64 * tg + r, n0 + 128 * fh, h, lds, tid);
        f32x16 a2[4];
        const float* sp2 = sp; asm volatile("" : "+v"(sp2));
#pragma unroll
        for (int mt = 0; mt < 4; ++mt)
#pragma unroll
            for (int j = 0; j < 16; ++j) a2[mt][j] = sp2[(mt * 16 + j) * 64];
        epi(a2, m0 + 64 * tg + 32 + r, n0 + 128 * fh, h, lds, tid);
        __syncthreads();
    } else {
        int ho = h, ro = r, to = tid;
        if constexpr (epi_stash<Epi>::present) asm volatile("" : "+v"(ho), "+v"(ro), "+v"(to));
#pragma unroll
        for (int s2 = 0; s2 < MT; ++s2) epi(acc[s2], m0 + 32 * MT * tg + 32 * s2 + ro, n0 + 128 * fh, ho, lds, to);
    }
}

DI void store_vt_tile(bf16_t* base, long rstride, const f32x16& a, int row0, int h, int lane) {
    const bool odd = lane & 1;
#pragma unroll
    for (int rg = 0; rg < 16; rg += 2) {
        const float xa = lx1(a[rg]), xb = lx1(a[rg + 1]);
        const unsigned wv = odd ? pk2(xb, a[rg + 1]) : pk2(a[rg], xa);
        bf16_t* dp = base + (long)(row0 + crow(odd ? rg + 1 : rg, h)) * rstride - (odd ? 1 : 0);
        *(unsigned*)dp = wv;
    }
}
struct EpiQKV0 {
    bf16_t *Q, *Kk, *VT;
    const float *qg, *kg;
    float* MB; const float* relb;
    DI void operator()(const f32x16 (&acc)[4], int tok, int fbase, int h, unsigned char*, int) const {
        const int sec = fbase >> 10, hd = (fbase & 1023) >> 7, b = tok >> 13, s = tok & (SEQ - 1);
        if (sec < 2) {
            const float* gn = sec == 0 ? qg : kg;
            const float sc = sec == 0 ? 0.125f * LOG2E : 1.f;
            bf16_t* dst = sec == 0 ? Q : Kk;
#pragma unroll
            for (int j = 0; j < 2; ++j) {
                float ss = 0.f;
#pragma unroll
                for (int mt = 0; mt < 2; ++mt)
#pragma unroll
                    for (int rg = 0; rg < 16; ++rg) { const float v = acc[2 * j + mt][rg]; ss += v * v; }
                ss = sum_x32(ss);
                const float rstd = rsqrtf(ss * (1.f / 64.f) + EPS) * sc;
                bf16_t* row = dst + ((long)((b * 8 + hd) * 2 + j) * SEQ + s) * 64;
                float qq = 0.f;
#pragma unroll
                for (int mt = 0; mt < 2; ++mt)
#pragma unroll
                    for (int g4 = 0; g4 < 4; ++g4) {
                        const int d0 = 32 * mt + 8 * g4 + 4 * h;
                        const f32x4 gv = *(const f32x4*)(gn + d0);
                        const float v0 = acc[2 * j + mt][4 * g4 + 0] * rstd * gv.x, v1 = acc[2 * j + mt][4 * g4 + 1] * rstd * gv.y;
                        const float v2 = acc[2 * j + mt][4 * g4 + 2] * rstd * gv.z, v3 = acc[2 * j + mt][4 * g4 + 3] * rstd * gv.w;
                        qq += v0 * v0 + v1 * v1 + v2 * v2 + v3 * v3;
                        u32x2 o;
                        o.x = pk2(v0, v1); o.y = pk2(v2, v3);
                        *(u32x2*)(row + d0) = o;
                    }
                if (sec == 0) {
                    qq = sum_x32(qq);
                    float kmx = 0.f;
                    for (int d = 0; d < 64; ++d) kmx = fmaxf(kmx, fabsf(kg[d]));
                    float bmx = 0.f;
                    for (int bk = 0; bk < 32; ++bk) bmx = fmaxf(bmx, relb[bk * 8 + hd] - relb[31 * 8 + hd]);
                    if (h == 0) MB[(long)((b * 8 + hd) * 2 + j) * SEQ + s] = 1.01f * sqrtf(qq) * 8.f * kmx + bmx * LOG2E;
                }
            }
        } else {
            bf16_t* base = VT + (long)(b * 8 + hd) * 128 * SEQ + s;
#pragma unroll
            for (int mt = 0; mt < 4; ++mt) store_vt_tile(base, SEQ, acc[mt], 32 * mt, h, tok);
        }
    }
};

struct EpiResid {
    const float* xin; float* xout; const float* gate;
    DI void operator()(const f32x16 (&acc)[4], int tok, int fbase, int h, unsigned char*, int) const {
        const int b = tok >> 13;
        const float* gp = gate + b * ADA_STRIDE;
#pragma unroll
        for (int mt = 0; mt < 4; ++mt)
#pragma unroll
            for (int g4 = 0; g4 < 4; ++g4) {
                const int f = fbase + 32 * mt + 8 * g4 + 4 * h;
                const f32x4 xv = *(const f32x4*)(xin + (long)tok * DM + f);
                const f32x4 gv = *(const f32x4*)(gp + f);
                f32x4 o;
                o.x = xv.x + gv.x * acc[mt][4 * g4 + 0]; o.y = xv.y + gv.y * acc[mt][4 * g4 + 1];
                o.z = xv.z + gv.z * acc[mt][4 * g4 + 2]; o.w = xv.w + gv.w * acc[mt][4 * g4 + 3];
                *(f32x4*)(xout + (long)tok * DM + f) = o;
                if (g4 == 3) __builtin_amdgcn_sched_barrier(0);
            }
    }
};

struct EpiKV {
    bf16_t *KC, *KS, *VST, *KW, *VWT;
    const float* kgain;
    DI void operator()(const f32x16 (&acc)[4], int tok, int fbase, int h, unsigned char*, int) const {
        const int c = fbase >> 7, br = c >> 2, kv = (c >> 1) & 1, g = c & 1, b = tok >> 13, s = tok & (SEQ - 1);
        if (br == 0 || kv == 0) {
            float rstd = 1.f;
            bf16_t* row;
            if (br == 0) row = KC + ((long)((kv * 4 + b) * 2 + g) * SEQ + s) * 128;
            else {
                float ss = 0.f;
#pragma unroll
                for (int mt = 0; mt < 4; ++mt)
#pragma unroll
                    for (int rg = 0; rg < 16; ++rg) ss += acc[mt][rg] * acc[mt][rg];
                ss = sum_x32(ss);
                rstd = rsqrtf(ss * (1.f / 128.f) + EPS);
                row = (br == 1 ? KS : KW) + ((long)(b * 2 + g) * SEQ + s) * 128;
            }
#pragma unroll
            for (int mt = 0; mt < 4; ++mt)
#pragma unroll
                for (int g4 = 0; g4 < 4; ++g4) {
                    const int d0 = 32 * mt + 8 * g4 + 4 * h;
                    f32x4 gv = {1.f, 1.f, 1.f, 1.f};
                    if (br != 0) gv = *(const f32x4*)(kgain + br * 128 + d0);
                    u32x2 o;
                    o.x = pk2(acc[mt][4 * g4 + 0] * rstd * gv.x, acc[mt][4 * g4 + 1] * rstd * gv.y);
                    o.y = pk2(acc[mt][4 * g4 + 2] * rstd * gv.z, acc[mt][4 * g4 + 3] * rstd * gv.w);
                    *(u32x2*)(row + d0) = o;
                }
        } else {
            bf16_t* base = (br == 1 ? VST : VWT) + (long)(b * 2 + g) * 128 * SEQ + s;
#pragma unroll
            for (int mt = 0; mt < 4; ++mt) store_vt_tile(base, SEQ, acc[mt], 32 * mt, h, tok);
        }
    }
};

struct EpiCmp1 {
    bf16_t* hid; const float* posb_part; const float* b1;
    DI void operator()(const f32x16 (&acc)[4], int tok, int fbase, int h, unsigned char*, int) const {
        if (tok >= 512) return;
#pragma unroll
        for (int mt = 0; mt < 4; ++mt)
#pragma unroll
            for (int g4 = 0; g4 < 4; ++g4) {
                const int f = fbase + 32 * mt + 8 * g4 + 4 * h;
                f32x4 pb = *(const f32x4*)(b1 + f);
                for (int c = 0; c < 16; ++c) { const f32x4 t = *(const f32x4*)(posb_part + c * 256 + f); pb.x += t.x; pb.y += t.y; pb.z += t.z; pb.w += t.w; }
                u32x2 o;
                o.x = pk2(gelu_tanh(acc[mt][4 * g4 + 0] + pb.x), gelu_tanh(acc[mt][4 * g4 + 1] + pb.y));
                o.y = pk2(gelu_tanh(acc[mt][4 * g4 + 2] + pb.z), gelu_tanh(acc[mt][4 * g4 + 3] + pb.w));
                *(u32x2*)(hid + (long)tok * 256 + f) = o;
            }
    }
};

struct EpiCmp2 {
    bf16_t* dst; const float* kgain0; int kv;
    DI void operator()(const f32x16 (&acc)[4], int tok, int fbase, int h, unsigned char*, int) const {
        if (fbase != 0 || tok >= 512) return;
        const float valid = tok < 511 ? 1.f : 0.f;
        if (kv == 0) {
            float ss = 0.f;
#pragma unroll
            for (int mt = 0; mt < 4; ++mt)
#pragma unroll
                for (int rg = 0; rg < 16; ++rg) ss += acc[mt][rg] * acc[mt][rg];
            ss = sum_x32(ss);
            const float rstd = rsqrtf(ss * (1.f / 128.f) + EPS) * valid;
#pragma unroll
            for (int mt = 0; mt < 4; ++mt)
#pragma unroll
                for (int g4 = 0; g4 < 4; ++g4) {
                    const int d0 = 32 * mt + 8 * g4 + 4 * h;
                    const f32x4 gv = *(const f32x4*)(kgain0 + d0);
                    u32x2 o;
                    o.x = pk2(acc[mt][4 * g4 + 0] * rstd * gv.x, acc[mt][4 * g4 + 1] * rstd * gv.y);
                    o.y = pk2(acc[mt][4 * g4 + 2] * rstd * gv.z, acc[mt][4 * g4 + 3] * rstd * gv.w);
                    *(u32x2*)(dst + (long)tok * 128 + d0) = o;
                }
        } else {
#pragma unroll
            for (int mt = 0; mt < 4; ++mt)
#pragma unroll
                for (int rg = 0; rg < 16; ++rg) dst[(long)(32 * mt + crow(rg, h)) * 512 + tok] = f2bf(acc[mt][rg] * valid);
        }
    }
};

struct EpiNsaQ {
    bf16_t* QN; float* gates; const float* qgain; const float* bgate; float* qnrm;
    DI void operator()(const f32x16 (&acc)[4], int tok, int fbase, int h, unsigned char*, int) const {
        const int b = tok >> 13, s = tok & (SEQ - 1);
        if (fbase < 1024) {
            const int head = fbase >> 7;
            float ss = 0.f;
#pragma unroll
            for (int mt = 0; mt < 4; ++mt)
#pragma unroll
                for (int rg = 0; rg < 16; ++rg) ss += acc[mt][rg] * acc[mt][rg];
            ss = sum_x32(ss);
            const float rstd = rsqrtf(ss * (1.f / 128.f) + EPS) * (0.08838834764831845f * LOG2E);
            bf16_t* row = QN + ((long)(b * 8 + head) * SEQ + s) * 128;
            float qq = 0.f;
#pragma unroll
            for (int mt = 0; mt < 4; ++mt)
#pragma unroll
                for (int g4 = 0; g4 < 4; ++g4) {
                    const int d0 = 32 * mt + 8 * g4 + 4 * h;
                    const f32x4 gv = *(const f32x4*)(qgain + d0);
                    const float v0 = acc[mt][4 * g4 + 0] * rstd * gv.x, v1 = acc[mt][4 * g4 + 1] * rstd * gv.y;
                    const float v2 = acc[mt][4 * g4 + 2] * rstd * gv.z, v3 = acc[mt][4 * g4 + 3] * rstd * gv.w;
                    qq += v0 * v0 + v1 * v1 + v2 * v2 + v3 * v3;
                    u32x2 o;
                    o.x = pk2(v0, v1); o.y = pk2(v2, v3);
                    *(u32x2*)(row + d0) = o;
                }
            qq = sum_x32(qq);
            if (h == 0) qnrm[(long)tok * 8 + head] = 1.01f * sqrtf(qq);
        } else if (fbase == 1024) {
#pragma unroll
            for (int rg = 0; rg < 16; ++rg) {
                const int f = crow(rg, h);
                if (f < 24) { const float z = acc[0][rg] + bgate[f]; gates[(long)tok * 24 + f] = frcp(1.f + fexp2(-LOG2E * z)); }
            }
        }
    }
};

DI void ce_desc(unsigned& a, unsigned& b) { const unsigned hi = a > b ? a : b, lo = a > b ? b : a; a = hi; b = lo; }
DI void sort16_desc(unsigned (&a)[16]) {
#define CE_(i, j) ce_desc(a[i], a[j]);
    CE_(0,13) CE_(1,12) CE_(2,15) CE_(3,14) CE_(4,8) CE_(5,6) CE_(7,11) CE_(9,10)
    CE_(0,5) CE_(1,7) CE_(2,9) CE_(3,4) CE_(6,13) CE_(8,14) CE_(10,15) CE_(11,12)
    CE_(0,1) CE_(2,3) CE_(4,5) CE_(6,8) CE_(7,9) CE_(10,11) CE_(12,13) CE_(14,15)
    CE_(0,2) CE_(1,3) CE_(4,10) CE_(5,11) CE_(6,7) CE_(8,9) CE_(12,14) CE_(13,15)
    CE_(1,2) CE_(3,12) CE_(4,6) CE_(5,7) CE_(8,10) CE_(9,11) CE_(13,14)
    CE_(1,4) CE_(2,6) CE_(5,8) CE_(7,10) CE_(9,13) CE_(11,14)
    CE_(2,4) CE_(3,6) CE_(9,12) CE_(11,13)
    CE_(3,5) CE_(6,8) CE_(7,9) CE_(10,12)
    CE_(3,4) CE_(5,6) CE_(7,8) CE_(9,10) CE_(11,12)
    CE_(6,7) CE_(8,9)
#undef CE_
}
DI void bitonic_merge16_desc(unsigned (&a)[16]) {
#pragma unroll
    for (int st = 8; st >= 1; st >>= 1)
#pragma unroll
        for (int i = 0; i < 16; ++i)
            if ((i & st) == 0) ce_desc(a[i], a[i + st]);
}
DI void merge_top16(unsigned (&a)[16], const unsigned (&b)[16]) {
#pragma unroll
    for (int i = 0; i < 16; ++i) a[i] = a[i] > b[15 - i] ? a[i] : b[15 - i];
    bitonic_merge16_desc(a);
}

struct EpiPeer {
    static constexpr bool STASH = false;
    int* ridx; float* rgate; int ex_off;
    DI void operator()(const f32x16 (&acc)[4], int tok, int fbase, int h, unsigned char* lds, int tid) const {
        const int lane = tid & 63, w = tid >> 6, tg = w & 3, fh = w >> 2, r = lane & 31;
        const int hd = fbase >> 8;
        unsigned* EX = (unsigned*)(lds + ex_off);
        unsigned L[16];
        {
            unsigned G1[16], G2[16], G3[16];
#pragma unroll
            for (int rg = 0; rg < 16; ++rg) {
                const int c = crow(rg, h);
                L[rg] = (f2key(acc[0][rg]) & ~127u) | (unsigned)(127 - c);
                G1[rg] = (f2key(acc[1][rg]) & ~127u) | (unsigned)(127 - 32 - c);
                G2[rg] = (f2key(acc[2][rg]) & ~127u) | (unsigned)(127 - 64 - c);
                G3[rg] = (f2key(acc[3][rg]) & ~127u) | (unsigned)(127 - 96 - c);
            }
            sort16_desc(L); sort16_desc(G1); merge_top16(L, G1);
            sort16_desc(G2); sort16_desc(G3); merge_top16(G2, G3);
            merge_top16(L, G2);
        }
        {
            unsigned P[16];
#pragma unroll
            for (int i = 0; i < 16; ++i) P[i] = get_x32(L[i], h);
            merge_top16(L, P);
        }
        if (h == 0) {
#pragma unroll
            for (int i = 0; i < 16; i += 4) *(u32x4*)(EX + ((fh * 4 + tg) * 32 + r) * 16 + i) = (u32x4){L[i], L[i + 1], L[i + 2], L[i + 3]};
        }
        __syncthreads();
        float xf[4], ys[16];
        {
            const unsigned* l0 = EX + ((0 * 4 + tg) * 32 + r) * 16;
            const unsigned* l1 = EX + ((1 * 4 + tg) * 32 + r) * 16;
            const unsigned* px = h ? l1 : l0;
            const unsigned* py = h ? l0 : l1;
            const u32x4 a = *(const u32x4*)px;
            xf[0] = key2f(a.x & ~127u); xf[1] = key2f(a.y & ~127u); xf[2] = key2f(a.z & ~127u); xf[3] = key2f(a.w & ~127u);
            unsigned Y[16];
#pragma unroll
            for (int i = 0; i < 16; i += 4) { const u32x4 b2 = *(const u32x4*)(py + i); Y[i] = b2.x; Y[i + 1] = b2.y; Y[i + 2] = b2.z; Y[i + 3] = b2.w; }
#pragma unroll
            for (int k = 0; k < 15; ++k) ys[k] = key2f((h ? Y[k + 1] : Y[k]) & ~127u);
            ys[15] = key2f(Y[15] & ~127u);
        }
        auto pkey = [&](int i, int k) -> unsigned {
            const float fs = xf[i] + ys[k];
            const unsigned code = h ? (unsigned)((((k + 1) & 15) << 4) | i) : (unsigned)((i << 4) | k);
            return (f2key(fs) & ~255u) | (255u - code);
        };
        unsigned T[16], E[16];
#pragma unroll
        for (int k = 0; k < 16; ++k) T[k] = pkey(0, k);
        T[15] = h ? 0u : T[15];
#pragma unroll
        for (int k = 1; k <= 7; ++k) E[k - 1] = pkey(1, k);
#pragma unroll
        for (int k = 2; k <= 4; ++k) E[7 + k - 2] = pkey(2, k);
        E[10] = pkey(3, 3);
#pragma unroll
        for (int k = 11; k < 16; ++k) E[k] = 0u;
        sort16_desc(E);
        merge_top16(T, E);
        {
            unsigned P[16];
#pragma unroll
            for (int i = 0; i < 16; ++i) P[i] = get_x32(T[i], h);
            merge_top16(T, P);
        }
        float sc[16], sum = 0.f;
        const float mx = key2f(T[0] & ~255u);
#pragma unroll
        for (int k = 0; k < 16; ++k) { sc[k] = fexp2((key2f(T[k] & ~255u) - mx) * LOG2E); sum += sc[k]; }
        const float inv = frcp(sum);
        if (h == 0) {
            const unsigned* l0 = EX + ((0 * 4 + tg) * 32 + r) * 16;
            const unsigned* l1 = EX + ((1 * 4 + tg) * 32 + r) * 16;
#pragma unroll
            for (int k = 0; k < 16; ++k) {
                if ((k >> 3) != fh) continue;
                const unsigned code = 255u - (T[k] & 255u);
                const int i1 = 127 - (int)(l0[code >> 4] & 127u), i2 = 127 - (int)(l1[code & 15u] & 127u);
                ridx[(long)tok * 128 + hd * 16 + k] = i1 * 128 + i2;
                rgate[(long)tok * 128 + hd * 16 + k] = sc[k] * inv;
            }
        }
        __syncthreads();
    }
};

DI void p0_transpose_item(const float* __restrict__ W, int K, int N, bf16_t* __restrict__ WT, int item, int ntn, unsigned char* lds, int tid) {
    float* tile = (float*)lds;
    const int kb = item / ntn, nb = item % ntn, k0 = kb * 64, n0 = nb * 64;
    {
        const int nn = tid & 63, kk0 = tid >> 6;
#pragma unroll
        for (int i = 0; i < 8; ++i) { const int kk = kk0 + 8 * i; const int n = n0 + nn; tile[kk * 65 + nn] = n < N ? W[(long)(k0 + kk) * N + n] : 0.f; }
    }
    __syncthreads();
    {
        const int n = tid >> 3, c = tid & 7;
        const float* s = tile + (8 * c) * 65 + n;
        u32x4 o;
        o.x = pk2(s[0], s[65]); o.y = pk2(s[2 * 65], s[3 * 65]); o.z = pk2(s[4 * 65], s[5 * 65]); o.w = pk2(s[6 * 65], s[7 * 65]);
        *(u32x4*)(WT + (long)(n0 + n) * K + k0 + 8 * c) = o;
    }
    __syncthreads();
}

DI int pack_i8x4(float a, float b, float c, float d) {
    const int ia = __float2int_rn(a), ib = __float2int_rn(b), ic = __float2int_rn(c), id = __float2int_rn(d);
    return (ia & 255) | ((ib & 255) << 8) | ((ic & 255) << 16) | (id << 24);
}
DI void p0_fp8_item(const float* __restrict__ src, unsigned char* __restrict__ dst, float* __restrict__ sinv, bool sliced, int item, int tid) {
    const int lane = tid & 63, row = item * 8 + (tid >> 6);
    const float* rp = src + (long)row * 1024;
    f32x4 v[4]; float am = 0.f;
#pragma unroll
    for (int j = 0; j < 4; ++j) {
        v[j] = *(const f32x4*)(rp + 4 * lane + 256 * j);
        am = fmaxf(am, fmaxf(fmaxf(fabsf(v[j].x), fabsf(v[j].y)), fmaxf(fabsf(v[j].z), fabsf(v[j].w))));
    }
    am = wave_max(am);
    const float sc = sliced ? (am > 0.f ? exp2f(floorf(log2f(384.f / am))) : 1.f) : (am > 0.f ? 127.f / am : 1.f);
    if (lane == 0) sinv[row] = 1.f / sc;
#pragma unroll
    for (int j = 0; j < 4; ++j) {
        int pk = 0;
        if (sliced) {
            pk = __builtin_amdgcn_cvt_pk_fp8_f32(v[j].x * sc, v[j].y * sc, pk, false);
            pk = __builtin_amdgcn_cvt_pk_fp8_f32(v[j].z * sc, v[j].w * sc, pk, true);
        } else pk = pack_i8x4(v[j].x * sc, v[j].y * sc, v[j].z * sc, v[j].w * sc);
        const int col = 4 * lane + 256 * j;
        unsigned char* d = sliced ? dst + ((long)(col >> 7) * 16384 + row) * 128 + (col & 127) : dst + (long)row * 1024 + col;
        *(int*)d = pk;
    }
}

DI void p0_weff_item(const float* __restrict__ wq, const float* __restrict__ subk, bf16_t* __restrict__ WT, int item, unsigned char* lds, int tid) {
    const int layer = item >> 8, g = (item >> 4) & 15, ct = item & 15, p = g & 1, c0 = ct * 64;
    float* As = (float*)lds;
    float* Bs = As + 64 * 129;
    const float* wql = wq + (long)layer * 1024 * 2048;
    const float* sk = subk + ((long)layer * 2 + p) * 128 * 128;
    for (int e = tid; e < 64 * 128; e += NTHREADS) { const int c = e >> 7, d = e & 127; As[c * 129 + d] = wql[(long)(c0 + c) * 2048 + g * 128 + d]; }
    for (int e = tid; e < 128 * 128; e += NTHREADS) { const int k = e >> 7, d = e & 127; Bs[k * 129 + d] = sk[k * 128 + d]; }
    __syncthreads();
    const int lane = tid & 63, w = tid >> 6, ti = w & 3, tj = w >> 2, r = lane & 31, h = lane >> 5;
    f32x16 acc;
#pragma unroll
    for (int i = 0; i < 16; ++i) acc[i] = 0.f;
    const float* ap = Bs + (32 * ti + r) * 129 + h;
    const float* bp = As + (32 * tj + r) * 129 + h;
#pragma unroll 8
    for (int d = 0; d < 128; d += 2) acc = __builtin_amdgcn_mfma_f32_32x32x2f32(ap[d], bp[d], acc, 0, 0, 0);
    bf16_t* o = WT + ((long)layer * 2048 + g * 128 + 32 * ti) * 1024 + c0 + 32 * tj + r;
#pragma unroll
    for (int i = 0; i < 16; ++i) o[(long)crow(i, h) * 1024] = f2bf(acc[i]);
    __syncthreads();
}

DI void p0_posb_item(const float* __restrict__ pos, const float* __restrict__ w1, float* __restrict__ part, int item, unsigned char* lds, int tid) {
    const int kv = item >> 4, ch = item & 15;
    float* red = (float*)lds;
    const int j = tid & 255, half = tid >> 8;
    const float* pp = pos + (long)kv * 4096 + ch * 256 + half * 128;
    const float* ww = w1 + ((long)kv * 4096 + ch * 256 + half * 128) * 256 + j;
    float a = 0.f;
    for (int f = 0; f < 128; ++f) a += pp[f] * ww[(long)f * 256];
    red[half * 256 + j] = a;
    __syncthreads();
    if (tid < 256) part[(kv * 16 + ch) * 256 + tid] = red[tid] + red[256 + tid];
    __syncthreads();
}

DI void p0_ada_item(const Params& p, float* __restrict__ ada, int item, unsigned char* lds, int tid) {
    float* cact = (float*)lds;
    float* red = cact + 4096;
    const float* c = p.in[1];
    for (int e = tid; e < 4096; e += NTHREADS) { const float v = c[e]; cact[e] = v * frcp(1.f + fexp2(-LOG2E * v)); }
    __syncthreads();
    const int colg = item * 64;
    const float* W; const float* bias; int N, n0;
    if (colg < 6144) { W = p.in[3]; bias = p.in[4]; N = 6144; n0 = colg; }
    else if (colg < 12288) { W = p.in[3] + (long)1024 * 6144; bias = p.in[4] + 6144; N = 6144; n0 = colg - 6144; }
    else { W = p.in[14]; bias = p.in[15]; N = 2048; n0 = colg - 12288; }
    const int col = tid & 63, kg = tid >> 6;
    float a0 = 0.f, a1 = 0.f, a2 = 0.f, a3 = 0.f;
    const float* wp = W + (long)(kg * 128) * N + n0 + col;
#pragma unroll 8
    for (int k = 0; k < 128; ++k) {
        const float wv = wp[(long)k * N];
        const int kk = kg * 128 + k;
        a0 += cact[kk] * wv; a1 += cact[1024 + kk] * wv; a2 += cact[2048 + kk] * wv; a3 += cact[3072 + kk] * wv;
    }
    red[(kg * 4 + 0) * 64 + col] = a0; red[(kg * 4 + 1) * 64 + col] = a1; red[(kg * 4 + 2) * 64 + col] = a2; red[(kg * 4 + 3) * 64 + col] = a3;
    __syncthreads();
    if (tid < 256) {
        const int b = tid >> 6, cc = tid & 63;
        float s = bias[n0 + cc];
#pragma unroll
        for (int q = 0; q < 8; ++q) s += red[(q * 4 + b) * 64 + cc];
        ada[b * ADA_STRIDE + colg + cc] = s;
    }
    __syncthreads();
}

constexpr int P0_CONV = 8192, P0_TR_DIN = 768, P0_TR_DOUT = 256, P0_TR_KV = 384, P0_TR_NIN = 288, P0_TR_NOUT = 256, P0_TR_C1 = 512, P0_TR_C2 = 16,
              P0_WEFF = 512, P0_POSB = 32, P0_ADA = 224;
constexpr int P0_TOTAL = P0_CONV + P0_TR_DIN + P0_TR_DOUT + P0_TR_KV + P0_TR_NIN + P0_TR_NOUT + P0_TR_C1 + P0_TR_C2 + P0_WEFF + P0_POSB + P0_ADA;

DI void phase_prep(const Params& p, unsigned char* lds, int tid) {
    unsigned char* ws = p.ws;
    for (int it = blockIdx.x; it < P0_TOTAL; it += gridDim.x) {
        int r = it;
        if (r < P0_ADA) { p0_ada_item(p, (float*)(ws + OFF_ADA), r, lds, tid); continue; } r -= P0_ADA;
        if (r < P0_WEFF) { p0_weff_item(p.in[26], p.in[27], (bf16_t*)(ws + OFF_WT_PEER), r, lds, tid); continue; } r -= P0_WEFF;
        if (r < P0_POSB) { p0_posb_item(p.in[17], p.in[18], (float*)(ws + OFF_POSB), r, lds, tid); continue; } r -= P0_POSB;
        if (r < P0_TR_DIN) { p0_transpose_item(p.in[7], 1024, 3072, (bf16_t*)(ws + OFF_WT_DIN), r, 48, lds, tid); continue; } r -= P0_TR_DIN;
        if (r < P0_TR_DOUT) { p0_transpose_item(p.in[8], 1024, 1024, (bf16_t*)(ws + OFF_WT_DOUT), r, 16, lds, tid); continue; } r -= P0_TR_DOUT;
        if (r < P0_TR_KV) { p0_transpose_item(p.in[16], 1024, 1536, (bf16_t*)(ws + OFF_WT_KV), r, 24, lds, tid); continue; } r -= P0_TR_KV;
        if (r < P0_TR_NIN) { p0_transpose_item(p.in[22], 1024, 1048, (bf16_t*)(ws + OFF_WT_NIN), r, 18, lds, tid); continue; } r -= P0_TR_NIN;
        if (r < P0_TR_NOUT) { p0_transpose_item(p.in[24], 1024, 1024, (bf16_t*)(ws + OFF_WT_NOUT), r, 16, lds, tid); continue; } r -= P0_TR_NOUT;
        if (r < P0_TR_C1) { const int kv = r >> 8; p0_transpose_item(p.in[18] + (long)kv * 4096 * 256, 4096, 256, (bf16_t*)(ws + OFF_WT_C1) + (long)kv * 256 * 4096, r & 255, 4, lds, tid); continue; } r -= P0_TR_C1;
        if (r < P0_TR_C2) { const int kv = r >> 3; p0_transpose_item(p.in[20] + (long)kv * 256 * 128, 256, 128, (bf16_t*)(ws + OFF_WT_C2) + (long)kv * 128 * 256, r & 7, 2, lds, tid); continue; } r -= P0_TR_C2;
        {
            const int tbl = r >> 11, sub = r & 2047;
            const int layer = tbl & 1;
            const float* src = (tbl < 2 ? p.in[28] : p.in[29]) + (long)layer * 16384 * 1024;
            unsigned char* dst = ws + (tbl < 2 ? OFF_PU : OFF_PV) + (long)layer * 16384 * 1024;
            float* sinv = (float*)(ws + (tbl < 2 ? OFF_USI : OFF_VSI)) + layer * 16384;
            p0_fp8_item(src, dst, sinv, tbl >= 2, sub, tid);
        }
    }
}

DI void norm_row_write(const f32x4 (&v)[4], float rstd, const float* gain, const float* shift, const float* scale, bf16_t* orow, int lane) {
#pragma unroll
    for (int j = 0; j < 4; ++j) {
        const int c = 4 * lane + 256 * j;
        const f32x4 g = *(const f32x4*)(gain + c), sh = *(const f32x4*)(shift + c), sc = *(const f32x4*)(scale + c);
        u32x2 o;
        o.x = pk2(v[j].x * rstd * g.x * (1.f + sc.x) + sh.x, v[j].y * rstd * g.y * (1.f + sc.y) + sh.y);
        o.y = pk2(v[j].z * rstd * g.z * (1.f + sc.z) + sh.z, v[j].w * rstd * g.w * (1.f + sc.w) + sh.w);
        *(u32x2*)(orow + c) = o;
    }
}
template <bool BF>
DI void phase_norm_q8(const float* __restrict__ x, bf16_t* __restrict__ out, unsigned char* __restrict__ out8, float* __restrict__ outs,
                      const float* gain, const float* ada, int shift_off, int scale_off, int tid) {
    const int lane = tid & 63, gw = blockIdx.x * NWAVES + (tid >> 6), nw = gridDim.x * NWAVES;
    for (int tok = gw; tok < NTOK; tok += nw) {
        const int b = tok >> 13;
        f32x4 v[4]; float ss = 0.f;
#pragma unroll
        for (int j = 0; j < 4; ++j) { v[j] = *(const f32x4*)(x + (long)tok * DM + 4 * lane + 256 * j); ss += v[j].x * v[j].x + v[j].y * v[j].y + v[j].z * v[j].z + v[j].w * v[j].w; }
        const float rstd = rsqrtf(wave_sum(ss) * (1.f / DM) + EPS);
        const float* shift = ada + b * ADA_STRIDE + shift_off; const float* scale = ada + b * ADA_STRIDE + scale_off;
        float am = 0.f;
#pragma unroll
        for (int j = 0; j < 4; ++j) {
            const int c = 4 * lane + 256 * j;
            const f32x4 g = *(const f32x4*)(gain + c), sh = *(const f32x4*)(shift + c), sc = *(const f32x4*)(scale + c);
            v[j].x = v[j].x * rstd * g.x * (1.f + sc.x) + sh.x; v[j].y = v[j].y * rstd * g.y * (1.f + sc.y) + sh.y;
            v[j].z = v[j].z * rstd * g.z * (1.f + sc.z) + sh.z; v[j].w = v[j].w * rstd * g.w * (1.f + sc.w) + sh.w;
            if constexpr (BF) { u32x2 o; o.x = pk2(v[j].x, v[j].y); o.y = pk2(v[j].z, v[j].w); *(u32x2*)(out + (long)tok * DM + c) = o; }
            am = fmaxf(am, fmaxf(fmaxf(fabsf(v[j].x), fabsf(v[j].y)), fmaxf(fabsf(v[j].z), fabsf(v[j].w))));
        }
        am = wave_max(am);
        const float qs = am > 0.f ? 127.f / am : 1.f;
#pragma unroll
        for (int j = 0; j < 4; ++j) *(int*)(out8 + (long)tok * DM + 4 * lane + 256 * j) = pack_i8x4(v[j].x * qs, v[j].y * qs, v[j].z * qs, v[j].w * qs);
        if (lane == 0) outs[tok] = am > 0.f ? am * (1.f / 127.f) : 1.f;
    }
}
DI void phase_norm(const float* __restrict__ x, bf16_t* __restrict__ out, const float* gain, const float* ada, int shift_off, int scale_off, int tid) {
    const int lane = tid & 63, gw = blockIdx.x * NWAVES + (tid >> 6), nw = gridDim.x * NWAVES;
    for (int tok = gw; tok < NTOK; tok += nw) {
        const int b = tok >> 13;
        f32x4 v[4]; float ss = 0.f;
#pragma unroll
        for (int j = 0; j < 4; ++j) { v[j] = *(const f32x4*)(x + (long)tok * DM + 4 * lane + 256 * j); ss += v[j].x * v[j].x + v[j].y * v[j].y + v[j].z * v[j].z + v[j].w * v[j].w; }
        const float rstd = rsqrtf(wave_sum(ss) * (1.f / DM) + EPS);
        norm_row_write(v, rstd, gain, ada + b * ADA_STRIDE + shift_off, ada + b * ADA_STRIDE + scale_off, out + (long)tok * DM, lane);
    }
}

DI int kidx(int mt, int i) { return 32 * mt + 16 * (i >> 3) + (i & 7); }
template <int DQK>
DI void attn_qk32(const unsigned char* Ks, const bf16x8 (&qf)[DQK / 16], f32x16& st, int mt, int r, int h, float init = 0.f) {
    constexpr int RB = DQK * 2, MSK = DQK == 64 ? 7 : 15;
    const int row = 32 * mt + ((r & 0x13) | ((r & 4) << 1) | ((r & 8) >> 1));
#pragma unroll
    for (int i = 0; i < 16; ++i) st[i] = init;
#pragma unroll
    for (int ks = 0; ks < DQK / 16; ++ks) {
        const bf16x8 kf = RB == 128 ? *(const bf16x8*)(Ks + sw2(row, 2 * ks + h)) : *(const bf16x8*)(Ks + row * RB + (((2 * ks + h) ^ (row & MSK)) << 4));
        st = MFMA32(kf, qf[ks], st);
    }
}
DI void attn_pack32(const f32x16& st, bf16x8 (&pf)[2]) {
#pragma unroll
    for (int s = 0; s < 2; ++s) {
        u32x4 t;
        t.x = pk2(st[8 * s + 0], st[8 * s + 1]); t.y = pk2(st[8 * s + 2], st[8 * s + 3]);
        t.z = pk2(st[8 * s + 4], st[8 * s + 5]); t.w = pk2(st[8 * s + 6], st[8 * s + 7]);
        pf[s] = __builtin_bit_cast(bf16x8, t);
    }
}
DI void attn_softmax32(f32x16& st, float& m, float& l, f32x16 (&o)[4]) {
    float mx = st[0];
#pragma unroll
    for (int i = 1; i < 16; ++i) mx = fmaxf(mx, st[i]);
    mx = max_x32(mx);
    const float mn = fmaxf(m, mx);
    if (!__all(mn == m)) {
        const float alpha = fexp2(m - mn);
        l *= alpha;
#pragma unroll
        for (int dt = 0; dt < 4; ++dt)
#pragma unroll
            for (int i = 0; i < 16; ++i) o[dt][i] *= alpha;
        m = mn;
    }
    float sum = 0.f;
#pragma unroll
    for (int i = 0; i < 16; ++i) { const float pv = fexp2(st[i] - m); st[i] = pv; sum += pv; }
    l += sum;
}
DI void attn_softmax32_b(f32x16& st, float& l) {
    float sum = 0.f;
#pragma unroll
    for (int i = 0; i < 16; ++i) { const float pv = fexp2(st[i]); st[i] = pv; sum += pv; }
    l += sum;
}
DI void attn_pv32(const unsigned char* Vs, const bf16x8 (&pf)[2], f32x16 (&o)[4], int mt, int r, int h) {
#pragma unroll
    for (int dt = 0; dt < 4; ++dt)
#pragma unroll
        for (int s2 = 0; s2 < 2; ++s2) {
            const int row = 32 * dt + r;
            const bf16x8 vf = *(const bf16x8*)(Vs + sw2(row, 2 * (2 * mt + s2) + h));
            o[dt] = MFMA32(vf, pf[s2], o[dt]);
        }
}
template <int RB, int NROWS>
DI void dma_offsets(unsigned (&off)[NROWS * RB / 16 / 512], unsigned gstride, int tid) {
    constexpr int CPR = RB / 16;
#pragma unroll
    for (int i = 0; i < NROWS * CPR / 512; ++i) {
        const int idx = tid + 512 * i;
        int row, cp;
        if (RB == 128) sw2_src(idx, row, cp); else { row = idx / CPR; cp = (idx % CPR) ^ (row & (CPR - 1)); }
        off[i] = (unsigned)row * gstride + (cp << 4);
    }
}
template <int N>
DI void dma_issue(unsigned char* dst, const unsigned char* gbase, const unsigned (&off)[N], int tid) {
    const int wbase = tid & ~63;
#pragma unroll
    for (int i = 0; i < N; ++i)
        __builtin_amdgcn_global_load_lds((const unsigned*)(gbase + off[i]), (unsigned*)(dst + (wbase + 512 * i) * 16), 16, 0, 0);
}

constexpr int AT_STAGE = 32 * 1024;
constexpr int AT_LUT = 2 * AT_STAGE;
constexpr int LUT_N = 1280, LUT_OFF = 1100;
constexpr int LUTC_W = 52;
constexpr int AT_LUTC = AT_LUT + 20 * 1024;
constexpr int AT_IMP = AT_LUTC + 13 * 1024;
constexpr int AT_SEL = AT_IMP + 34 * 1024;

DI void phase_diff_attn(const Params& p, unsigned char* lds, int tid) {
    unsigned char* ws = p.ws;
    const bf16_t* Q = (const bf16_t*)(ws + OFF_Q0);
    const bf16_t* Kk = (const bf16_t*)(ws + OFF_K0);
    const bf16_t* VT = (const bf16_t*)(ws + OFF_VT0);
    bf16_t* O = (bf16_t*)(ws + OFF_H);
    const float* relb = p.in[2];
    const float* lam = p.in[9];
    const float* subln = p.in[12];
    const int lane = tid & 63, w = tid >> 6, comp = w & 1, qg = w >> 1, r = lane & 31, h = lane >> 5;
    float* lut = (float*)(lds + 128 * 1024);
    float lam_full;
    {
        const float s01 = wave_sum(lam[lane] * lam[64 + lane]), s23 = wave_sum(lam[128 + lane] * lam[192 + lane]);
        lam_full = __expf(s01) - __expf(s23) + 0.2f;
    }
    const int G = gridDim.x, rows_per_it = G >> 5;
    unsigned koff[1], voff[2];
    dma_offsets<128, 64>(koff, 128, tid);
    dma_offsets<128, 128>(voff, SEQ * 2, tid);
    constexpr int ST2 = 64 * 1024;
    for (int it = 0;; ++it) {
        int qb, b, hd;
        if (G == 256) {
            if (it >= 8) break;
            const int xcd = blockIdx.x & 7, lb = blockIdx.x >> 3, pr = xcd * 4 + (it >> 1);
            qb = (it & 1) ? lb : 63 - lb; b = pr >> 3; hd = pr & 7;
        } else {
            int u;
            if ((G & 31) == 0) {
                const int rr = blockIdx.x >> 5, cc = blockIdx.x & 31;
                const int rowi = it * rows_per_it + ((it & 1) ? rows_per_it - 1 - rr : rr);
                u = rowi * 32 + cc;
            } else u = it * G + blockIdx.x;
            if (u >= 2048) break;
            qb = 63 - (u >> 5); b = (u & 31) >> 3; hd = u & 7;
        }
        const int q0 = qb * 128, ntiles = qb + 1;
        const int qpos = q0 + 32 * qg + r, qlo = q0 + 32 * qg, qhi = qlo + 31;
        for (int e = tid; e < LUT_N; e += NTHREADS) { const int d = LUT_OFF - e; lut[e] = d < 0 ? -INFINITY : (d >= 790 ? 0.f : (relb[rel_bucket_i(d) * 8 + hd] - relb[31 * 8 + hd]) * LOG2E); }
        bf16x8 qf[4];
        {
            const bf16_t* qrow = Q + ((long)((b * 8 + hd) * 2 + comp) * SEQ + qpos) * 64;
#pragma unroll
            for (int ks = 0; ks < 4; ++ks) qf[ks] = *(const bf16x8*)(qrow + 16 * ks + 8 * h);
        }
        const unsigned char* k0g = (const unsigned char*)(Kk + (long)((b * 8 + hd) * 2 + 0) * SEQ * 64);
        const unsigned char* k1g = (const unsigned char*)(Kk + (long)((b * 8 + hd) * 2 + 1) * SEQ * 64);
        const unsigned char* vtg = (const unsigned char*)(VT + (long)(b * 8 + hd) * 128 * SEQ);
        f32x16 o[4];
#pragma unroll
        for (int dt = 0; dt < 4; ++dt)
#pragma unroll
            for (int i = 0; i < 16; ++i) o[dt][i] = 0.f;
        float l = 0.f;
        const float nmb = -((const float*)(ws + OFF_MB0))[(long)((b * 8 + hd) * 2 + comp) * SEQ + qpos];
        auto stage = [&](int kt, unsigned char* st) {
#pragma unroll
            for (int sb = 0; sb < 2; ++sb) {
                dma_issue(st + sb * 8192, k0g + (long)(2 * kt + sb) * 8192, koff, tid);
                dma_issue(st + 16384 + sb * 8192, k1g + (long)(2 * kt + sb) * 8192, koff, tid);
                dma_issue(st + 32768 + sb * 16384, vtg + (long)(2 * kt + sb) * 128, voff, tid);
            }
        };
        stage(0, lds);
        __syncthreads();
        for (int kt = 0; kt < ntiles; ++kt) {
            unsigned char* cur = lds + (kt & 1) * ST2;
            if (kt + 1 < ntiles) stage(kt + 1, lds + ((kt + 1) & 1) * ST2);
            const bool nearb = qlo - (kt * 128 + 127) < 790;
            const int dbase0 = qpos - kt * 128 - 8 * h;
            const unsigned char* kb = cur + comp * 16384;
            f32x16 sa, sbv;
            attn_qk32<64>(kb, qf, sa, 0, r, h, nmb);
#pragma unroll
            for (int j = 0; j < 4; ++j) {
                f32x16& sc = (j & 1) ? sbv : sa;
                f32x16& sn = (j & 1) ? sa : sbv;
                if (j < 3) attn_qk32<64>(kb + ((j + 1) >> 1) * 8192, qf, sn, (j + 1) & 1, r, h, nmb);
                if (nearb) {
                    const float* lp = lut + (LUT_OFF - dbase0 + 64 * (j >> 1));
#pragma unroll
                    for (int i = 0; i < 16; ++i) sc[i] += lp[kidx(j & 1, i)];
                }
                attn_softmax32_b(sc, l);
                bf16x8 pf[2];
                attn_pack32(sc, pf);
                attn_pv32(cur + 32768 + (j >> 1) * 16384, pf, o, j & 1, r, h);
            }
            __syncthreads();
        }
        l = sum_x32(l);
        const float inv = l > 0.f ? frcp(l) : 0.f;
        float* xch = (float*)lds + qg * 4096;
        if (comp == 1) {
            const float sc = inv * lam_full;
#pragma unroll
            for (int dt = 0; dt < 4; ++dt)
#pragma unroll
                for (int i = 0; i < 16; ++i) xch[(dt * 16 + i) * 64 + lane] = o[dt][i] * sc;
        }
        __syncthreads();
        if (comp == 0) {
            float ss = 0.f;
#pragma unroll
            for (int dt = 0; dt < 4; ++dt)
#pragma unroll
                for (int i = 0; i < 16; ++i) { const float v = o[dt][i] * inv - xch[(dt * 16 + i) * 64 + lane]; o[dt][i] = v; ss += v * v; }
            ss = sum_x32(ss);
            const float rstd = rsqrtf(ss * (1.f / 128.f) + EPS) * 0.8f;
            bf16_t* orow = O + (long)(b * SEQ + qpos) * DM + hd * 128;
#pragma unroll
            for (int dt = 0; dt < 4; ++dt)
#pragma unroll
                for (int g4 = 0; g4 < 4; ++g4) {
                    const int d0 = 32 * dt + 8 * g4 + 4 * h;
                    const f32x4 gv = *(const f32x4*)(subln + d0);
                    u32x2 ov;
                    ov.x = pk2(o[dt][4 * g4 + 0] * rstd * gv.x, o[dt][4 * g4 + 1] * rstd * gv.y);
                    ov.y = pk2(o[dt][4 * g4 + 2] * rstd * gv.z, o[dt][4 * g4 + 3] * rstd * gv.w);
                    *(u32x2*)(orow + d0) = ov;
                }
        }
        __syncthreads();
    }
}

template <int VAR>
DI void phase_nsa_attn(const Params& p, unsigned char* lds, int tid) {
    unsigned char* ws = p.ws;
    const bf16_t* QN = (const bf16_t*)(ws + OFF_QN);
    const bf16_t* KS = (const bf16_t*)(ws + OFF_KS);
    const bf16_t* VST = (const bf16_t*)(ws + OFF_VST);
    const bf16_t* KW = (const bf16_t*)(ws + OFF_KW);
    const bf16_t* VWT = (const bf16_t*)(ws + OFF_VWT);
    const bf16_t* KCMP = (const bf16_t*)(ws + OFF_KCMP);
    const bf16_t* VCMPT = (const bf16_t*)(ws + OFF_VCMPT);
    const float* gates = (const float*)(ws + OFF_GATES);
    bf16_t* O = VAR ? (bf16_t*)(ws + OFF_PU + 32 * MB) : (bf16_t*)(ws + OFF_H);
    const float* relb = p.in[2];
    const int lane = tid & 63, w = tid >> 6, hg = w >> 1, th = w & 1, r = lane & 31, h = lane >> 5;
    float* lut = (float*)(lds + AT_LUT);
    float* lutc = (float*)(lds + AT_LUTC);
    float* imp = (float*)(lds + AT_IMP);
    unsigned* selw = (unsigned*)(lds + AT_SEL);
    unsigned short* sel16 = (unsigned short*)selw;
    float* bmxs = (float*)(selw + 264);
    const float* qnrm = (const float*)(ws + OFF_MB1);
    float kmx[3];
    for (int br = 0; br < 3; ++br) kmx[br] = wave_max(fmaxf(fabsf(p.in[21][br * 128 + lane]), fabsf(p.in[21][br * 128 + 64 + lane]))) * 11.313708498984761f;
    const int G = gridDim.x, rows_per_it = G >> 3;
    int lut_g = -1;
    for (int it = 0;; ++it) {
        int u;
        if ((G & 7) == 0) {
            const int rr = blockIdx.x >> 3, cc = blockIdx.x & 7;
            const int rowi = it * rows_per_it + ((it & 1) ? rows_per_it - 1 - rr : rr);
            u = rowi * 8 + cc;
        } else u = it * G + blockIdx.x;
        if (u >= 1024) break;
        const int bi = 127 - (u >> 3), b = (u & 7) >> 1, g = u & 1, head = 4 * g + hg;
        const int tq = 64 * bi + 32 * th + r;
        const int tl = 32 * th + r;
        const long tok = (long)b * SEQ + tq;
        if (g != lut_g) {
            lut_g = g;
            if (tid < 128) {
                const int hh = tid >> 5, bk = tid & 31;
                float bm = fmaxf(0.f, relb[bk * 8 + 4 * g + hh] - relb[31 * 8 + 4 * g + hh]);
                bm = fmaxf(bm, lx1(bm)); bm = fmaxf(bm, lx2(bm)); bm = fmaxf(bm, lhm(bm)); bm = fmaxf(bm, lr8(bm)); bm = max_x16(bm);
                if (bk == 0) bmxs[hh] = bm * LOG2E;
            }
            for (int e = tid; e < 4 * LUT_N; e += NTHREADS) { const int hh = e / LUT_N, d = LUT_OFF - (e % LUT_N); lut[e] = d < 0 ? -INFINITY : (d >= 790 ? 0.f : (relb[rel_bucket_i(d) * 8 + 4 * g + hh] - relb[31 * 8 + 4 * g + hh]) * LOG2E); }
            for (int e = tid; e < 4 * 16 * LUTC_W; e += NTHREADS) {
                const int hh = e / (16 * LUTC_W), ph = (e / LUTC_W) & 15, ci = e % LUTC_W, d = 16 * (ci - 1) + ph;
                lutc[e] = ci == 0 ? -INFINITY : (d >= 790 ? 0.f : (relb[rel_bucket_i(d) * 8 + 4 * g + hh] - relb[31 * 8 + 4 * g + hh]) * LOG2E);
            }
        }
        if (tid < 4) selw[256 + tid] = 0u;
        const float* mylut = lut + hg * LUT_N;
        bf16x8 qf[8];
        const bf16_t* qrow = QN + ((long)(b * 8 + head) * SEQ + tq) * 128 + 8 * h;
        auto load_q = [&](const bf16_t* qr) {
#pragma unroll
            for (int ks = 0; ks < 8; ++ks) qf[ks] = *(const bf16x8*)(qr + 16 * ks);
        };
        const float* gp = gates + tok * 24 + head * 3;
        bf16_t* orow = O + (VAR ? (tok & 16383) : tok) * DM + head * 128;
        auto stage = [&](const unsigned char* kg, const unsigned char* vg, unsigned vstride, int kt, unsigned char* st) {
            int t2 = tid; asm volatile("" : "+v"(t2));
            unsigned koff[2], vo[2];
            dma_offsets<256, 64>(koff, 256, t2);
            dma_offsets<128, 128>(vo, vstride, t2);
            dma_issue(st, kg + (long)kt * 16384, koff, t2);
            dma_issue(st + 16384, vg + (long)kt * 128, vo, t2);
        };
        f32x16 o[4];
        float l;
        auto reset = [&]() {
#pragma unroll
            for (int dt = 0; dt < 4; ++dt)
#pragma unroll
                for (int i = 0; i < 16; ++i) o[dt][i] = 0.f;
            l = 0.f;
        };
        const unsigned char* kcg = (const unsigned char*)(KCMP + (long)(b * 2 + g) * 512 * 128);
        const unsigned char* vcg = (const unsigned char*)(VCMPT + (long)(b * 2 + g) * 128 * 512);
        const int nct = ((4 * bi + 2) >> 6) + 1;
        const int hgc = r & 3, tlc = 8 * w + (r >> 2), tqc = 64 * bi + tlc;
        const long tokc = (long)b * SEQ + tqc;
        reset();
        load_q(QN + ((long)(b * 8 + 4 * g + hgc) * SEQ + tqc) * 128 + 8 * h);
        __syncthreads();
        if (VAR != 3) {
            const int cb = (tqc - 31) >> 4;
            const float* lc = lutc + (hgc * 16 + ((tqc - 31) & 15)) * LUTC_W + 1;
            const float nmb = -(qnrm[tokc * 8 + 4 * g + hgc] * kmx[0] + bmxs[hgc]);
            stage(kcg, vcg, 1024u, 0, lds);
            __syncthreads();
            for (int kt = 0; kt < nct; ++kt) {
                unsigned char* cur = lds + (kt & 1) * AT_STAGE;
                if (kt + 1 < nct) stage(kcg, vcg, 1024u, kt + 1, lds + ((kt + 1) & 1) * AT_STAGE);
                const int cbase = cb - kt * 64 - 8 * h;
#pragma unroll
                for (int mt = 0; mt < 2; ++mt) {
                    f32x16 st;
                    attn_qk32<128>(cur, qf, st, mt, r, h, nmb);
                    float sum = 0.f;
#pragma unroll
                    for (int i = 0; i < 16; ++i) {
                        const int c = cbase - kidx(mt, i);
                        sum += fexp2(st[i] + lc[c < -1 ? -1 : (c > 50 ? 50 : c)]);
                    }
                    l += sum;
                }
                __syncthreads();
            }
            const float lt = sum_x32(l);
            const float invl = lt > 0.f ? frcp(lt) : 0.f;
            stage(kcg, vcg, 1024u, 0, lds);
            __syncthreads();
            float carry = 0.f;
            for (int kt = 0; kt < nct; ++kt) {
                unsigned char* cur = lds + (kt & 1) * AT_STAGE;
                if (kt + 1 < nct) stage(kcg, vcg, 1024u, kt + 1, lds + ((kt + 1) & 1) * AT_STAGE);
                const int cbase = cb - kt * 64 - 8 * h;
                float o0[4], o1[4], sp[4];
#pragma unroll
                for (int mt = 0; mt < 2; ++mt) {
                    f32x16 st;
                    attn_qk32<128>(cur, qf, st, mt, r, h, nmb);
#pragma unroll
                    for (int i = 0; i < 16; ++i) {
                        const int c = cbase - kidx(mt, i);
                        st[i] = fexp2(st[i] + lc[c < -1 ? -1 : (c > 50 ? 50 : c)]) * invl;
                    }
#pragma unroll
                    for (int gq = 0; gq < 2; ++gq) {
                        const int G2 = 2 * mt + gq, q0 = 2 * gq, q1 = 2 * gq + 1;
                        const float c20 = 0.5f * st[4 * q0 + 3];
                        o0[G2] = st[4 * q0] + st[4 * q0 + 1] + st[4 * q0 + 2] + c20;
                        o1[G2] = st[4 * q1] + st[4 * q1 + 1] + st[4 * q1 + 2] + 0.5f * st[4 * q1 + 3] + c20;
                        sp[G2] = 0.5f * st[4 * q1 + 3];
                    }
                    bf16x8 pf[2];
                    attn_pack32(st, pf);
                    attn_pv32(cur + 16384, pf, o, mt, r, h);
                }
                float rc[4];
#pragma unroll
                for (int G2 = 0; G2 < 4; ++G2) rc[G2] = __uint_as_float(get_x32(__float_as_uint(sp[G2]), h));
                if (h) {
#pragma unroll
                    for (int G2 = 0; G2 < 4; ++G2) o0[G2] += rc[G2];
                } else {
                    o0[0] += carry; o0[1] += rc[0]; o0[2] += rc[1]; o0[3] += rc[2];
                    carry = rc[3];
                }
#pragma unroll
                for (int G2 = 0; G2 < 4; ++G2) {
                    float a0 = o0[G2], a1 = o1[G2];
                    a0 += lx1(a0); a0 += lx2(a0); a1 += lx1(a1); a1 += lx2(a1);
                    if (hgc == 0) *(f32x2*)(imp + tlc * 130 + kt * 16 + 4 * G2 + 2 * h) = (f32x2){a0, a1};
                }
                __syncthreads();
            }
        }
        {
            const float g_c = gates[tokc * 24 + (4 * g + hgc) * 3];
            bf16_t* orc = O + (VAR ? (tokc & 16383) : tokc) * DM + (4 * g + hgc) * 128;
#pragma unroll
            for (int dt = 0; dt < 4; ++dt)
#pragma unroll
                for (int g4 = 0; g4 < 4; ++g4) {
                    const int d0 = 32 * dt + 8 * g4 + 4 * h;
                    u32x2 ov;
                    ov.x = pk2(o[dt][4 * g4 + 0] * g_c, o[dt][4 * g4 + 1] * g_c);
                    ov.y = pk2(o[dt][4 * g4 + 2] * g_c, o[dt][4 * g4 + 3] * g_c);
                    *(u32x2*)(orc + d0) = ov;
                }
        }
        if (VAR != 5) {
            const int tkn = tid >> 3, part = tid & 7;
            unsigned key[16];
#pragma unroll
            for (int q = 0; q < 16; ++q) {
                const int j = part * 16 + q;
                float v = imp[tkn * 130 + j];
                const int back = bi - j;
                if (j == 0 || (back >= 0 && back < 2)) v = 1e9f;
                if (back < 0) v = -1e30f;
                key[q] = f2key(v);
            }
            auto sum8 = [&](int c) -> int {
                c += __builtin_amdgcn_update_dpp(0, c, 0xB1, 0xF, 0xF, true);
                c += __builtin_amdgcn_update_dpp(0, c, 0x4E, 0xF, 0xF, true);
                c += __builtin_amdgcn_update_dpp(0, c, 0x141, 0xF, 0xF, true);
                return c;
            };
            unsigned T = 0u;
#pragma unroll 4
            for (int bit = 31; bit >= 0; --bit) {
                const unsigned cand = T | (1u << bit);
                int c = 0;
#pragma unroll
                for (int q = 0; q < 16; ++q) c += key[q] >= cand ? 1 : 0;
                if (sum8(c) >= 16) T = cand;
            }
            int cg = 0, ce = 0;
#pragma unroll
            for (int q = 0; q < 16; ++q) { cg += key[q] > T ? 1 : 0; ce += key[q] == T ? 1 : 0; }
            const int need = 16 - sum8(cg);
            int pre = ce;
            { int t = __builtin_amdgcn_update_dpp(0, pre, 0x111, 0xF, 0xF, true); if (part >= 1) pre += t; }
            { int t = __builtin_amdgcn_update_dpp(0, pre, 0x112, 0xF, 0xF, true); if (part >= 2) pre += t; }
            { int t = __builtin_amdgcn_update_dpp(0, pre, 0x114, 0xF, 0xF, true); if (part >= 4) pre += t; }
            int before = pre - ce;
            unsigned bits = 0;
#pragma unroll
            for (int q = 0; q < 16; ++q) {
                const bool eq = key[q] == T;
                const bool selq = key[q] > T || (eq && before < need);
                before += eq ? 1 : 0;
                bits |= (selq && key[q] >= 0x80000000u) ? (1u << q) : 0u;
            }
            sel16[tkn * 8 + part] = (unsigned short)bits;
            atomicOr(&selw[256 + (part >> 1)], bits << ((part & 1) * 16));
        }
        __syncthreads();
        const unsigned un0 = selw[256], un1 = selw[257], un2 = selw[258], un3 = selw[259];
        const unsigned char* ksg = (const unsigned char*)(KS + (long)(b * 2 + g) * SEQ * 128);
        const unsigned char* vsg = (const unsigned char*)(VST + (long)(b * 2 + g) * 128 * SEQ);
        reset(); load_q(qrow);
        const float qn_main = qnrm[tok * 8 + head];
        {
            const float nmb = -(qn_main * kmx[1] + bmxs[hg]);
            const unsigned long long ulo = ((unsigned long long)(unsigned)__builtin_amdgcn_readfirstlane((int)un1) << 32) | (unsigned)__builtin_amdgcn_readfirstlane((int)un0);
            const unsigned long long uhi = ((unsigned long long)(unsigned)__builtin_amdgcn_readfirstlane((int)un3) << 32) | (unsigned)__builtin_amdgcn_readfirstlane((int)un2);
            auto next_tile = [&](int from) -> int {
                if (from < 64) { const unsigned long long mk = ulo >> from; if (mk) return from + __builtin_ctzll(mk); from = 64; }
                if (from < 128) { const unsigned long long mk = uhi >> (from - 64); if (mk) return from + __builtin_ctzll(mk); }
                return 128;
            };
            int jt = (VAR == 1 || VAR == 4 || VAR == 5) ? 128 : next_tile(0);
            int buf = 0;
            if (jt < 128) stage(ksg, vsg, SEQ * 2u, jt, lds);
            __syncthreads();
            while (jt < 128) {
                unsigned char* cur = lds + buf * AT_STAGE;
                const int jn = next_tile(jt + 1);
                if (jn < 128) stage(ksg, vsg, SEQ * 2u, jn, lds + (buf ^ 1) * AT_STAGE);
                const unsigned wd = selw[tl * 4 + (jt >> 5)];
                const bool mysel = (wd >> (jt & 31)) & 1u;
                if (__any(mysel)) {
                    const int k0 = jt * 64;
                    const bool nearb = (64 * bi + 32 * th) - (k0 + 63) < 790;
                    const int dbase = tq - k0 - 8 * h;
                    const float* lp = mylut + (LUT_OFF - dbase);
#pragma unroll
                    for (int mt = 0; mt < 2; ++mt) {
                        f32x16 st;
                        attn_qk32<128>(cur, qf, st, mt, r, h, mysel ? nmb : -INFINITY);
                        if (nearb) {
#pragma unroll
                            for (int i = 0; i < 16; ++i) st[i] += lp[kidx(mt, i)];
                        }
                        attn_softmax32_b(st, l);
                        bf16x8 pf[2];
                        attn_pack32(st, pf);
                        attn_pv32(cur + 16384, pf, o, mt, r, h);
                    }
                }
                __syncthreads();
                buf ^= 1; jt = jn;
            }
        }
        {
            const float lt = sum_x32(l);
            const float sc = (lt > 0.f ? frcp(lt) : 0.f) * gp[1];
#pragma unroll
            for (int dt = 0; dt < 4; ++dt)
#pragma unroll
                for (int g4 = 0; g4 < 4; ++g4) {
                    const int d0 = 32 * dt + 8 * g4 + 4 * h;
                    const u32x2 pv = *(const u32x2*)(orow + d0);
                    u32x2 ov;
                    ov.x = pk2(bflo(pv.x) + o[dt][4 * g4 + 0] * sc, bfhi(pv.x) + o[dt][4 * g4 + 1] * sc);
                    ov.y = pk2(bflo(pv.y) + o[dt][4 * g4 + 2] * sc, bfhi(pv.y) + o[dt][4 * g4 + 3] * sc);
                    *(u32x2*)(orow + d0) = ov;
                }
        }
        const unsigned char* kwg = (const unsigned char*)(KW + (long)(b * 2 + g) * SEQ * 128);
        const unsigned char* vwg = (const unsigned char*)(VWT + (long)(b * 2 + g) * 128 * SEQ);
        reset(); load_q(qrow);
        {
            const float nmb = -(qn_main * kmx[2] + bmxs[hg]);
            const int j0 = bi >= 8 ? bi - 8 : 0, nt = (VAR == 2 || VAR == 4 || VAR == 5) ? 1 : bi - j0 + 1;
            stage(kwg, vwg, SEQ * 2u, j0, lds);
            __syncthreads();
            for (int kt = 0; kt < nt; ++kt) {
                unsigned char* cur = lds + (kt & 1) * AT_STAGE;
                if (kt + 1 < nt) stage(kwg, vwg, SEQ * 2u, j0 + kt + 1, lds + ((kt + 1) & 1) * AT_STAGE);
                const int k0 = (j0 + kt) * 64;
                const int dbase = tq - k0 - 8 * h;
                const float* lp = mylut + (LUT_OFF - dbase);
#pragma unroll
                for (int mt = 0; mt < 2; ++mt) {
                    f32x16 st;
                    attn_qk32<128>(cur, qf, st, mt, r, h, nmb);
#pragma unroll
                    for (int i = 0; i < 16; ++i) st[i] = kidx(mt, i) <= dbase - 512 ? -INFINITY : st[i] + lp[kidx(mt, i)];
                    attn_softmax32_b(st, l);
                    bf16x8 pf[2];
                    attn_pack32(st, pf);
                    attn_pv32(cur + 16384, pf, o, mt, r, h);
                }
                __syncthreads();
            }
        }
        {
            const float lt = sum_x32(l);
            const float sc = (lt > 0.f ? frcp(lt) : 0.f) * gp[2];
#pragma unroll
            for (int dt = 0; dt < 4; ++dt)
#pragma unroll
                for (int g4 = 0; g4 < 4; ++g4) {
                    const int d0 = 32 * dt + 8 * g4 + 4 * h;
                    const u32x2 pv = *(const u32x2*)(orow + d0);
                    u32x2 ov;
                    ov.x = pk2(bflo(pv.x) + o[dt][4 * g4 + 0] * sc, bfhi(pv.x) + o[dt][4 * g4 + 1] * sc);
                    ov.y = pk2(bflo(pv.y) + o[dt][4 * g4 + 2] * sc, bfhi(pv.y) + o[dt][4 * g4 + 3] * sc);
                    *(u32x2*)(orow + d0) = ov;
                }
        }
        __syncthreads();
    }
}

DI void fp8x16_fma(const u32x4& q, const f32x4& h0, const f32x4& h1, const f32x4& h2, const f32x4& h3, f32x2& a0, f32x2& a1) {
    a0 += __builtin_amdgcn_cvt_pk_f32_fp8((int)q.x, false) * (f32x2){h0.x, h0.y};
    a1 += __builtin_amdgcn_cvt_pk_f32_fp8((int)q.x, true)  * (f32x2){h0.z, h0.w};
    a0 += __builtin_amdgcn_cvt_pk_f32_fp8((int)q.y, false) * (f32x2){h1.x, h1.y};
    a1 += __builtin_amdgcn_cvt_pk_f32_fp8((int)q.y, true)  * (f32x2){h1.z, h1.w};
    a0 += __builtin_amdgcn_cvt_pk_f32_fp8((int)q.z, false) * (f32x2){h2.x, h2.y};
    a1 += __builtin_amdgcn_cvt_pk_f32_fp8((int)q.z, true)  * (f32x2){h2.z, h2.w};
    a0 += __builtin_amdgcn_cvt_pk_f32_fp8((int)q.w, false) * (f32x2){h3.x, h3.y};
    a1 += __builtin_amdgcn_cvt_pk_f32_fp8((int)q.w, true)  * (f32x2){h3.z, h3.w};
}
#ifndef UMASK
#define UMASK 0xffffffffu
#endif
template <bool DRY>
DI void phase_peer_u(const Params& p, int layer, unsigned char* lds, int tid) {
    unsigned char* ws = p.ws;
    const unsigned char* H8 = ws + OFF_H8;
    const float* HS = (const float*)(ws + OFF_HS);
    const int* ridx = (const int*)(ws + OFF_RIDX);
    float* rgate = (float*)(ws + OFF_RGATE);
    const unsigned char* U = ws + OFF_PU + (long)layer * 16384 * 1024;
    const __amdgpu_buffer_rsrc_t urs = __builtin_amdgcn_make_buffer_rsrc((void*)U, (short)0, 16384 * 1024, 0x00020000);
    const float* usi = (const float*)(ws + OFF_USI) + layer * 16384;
    const float* vsi = (const float*)(ws + OFF_VSI) + layer * 16384;
    const int lane = tid & 63, w = __builtin_amdgcn_readfirstlane(tid >> 6), sub = lane & 7, grp = lane >> 3;
    const int xg = blockIdx.x & 7, lb = blockIdx.x >> 3, nwv = (gridDim.x >> 3) * NWAVES, wv = lb * NWAVES + w;
    unsigned* clb = (unsigned*)(lds + w * 12288);
    unsigned char* hbb = lds + w * 12288 + 4096;
    const unsigned long long lt = (1ull << lane) - 1ull;
    if (lb >= (int)(gridDim.x >> 3)) return;
    int i0, i1; unsigned g0, g1; u32x4 h0; float hs0;
    auto ld_tok = [&](int tk) {
        tk = tk < NTOK ? tk : wv;
        i0 = ridx[(long)tk * 128 + lane]; i1 = ridx[(long)tk * 128 + 64 + lane];
        g0 = __float_as_uint(rgate[(long)tk * 128 + lane]); g1 = __float_as_uint(rgate[(long)tk * 128 + 64 + lane]);
        h0 = *(const u32x4*)(H8 + (long)tk * DM + lane * 16); hs0 = HS[tk];
    };
    bool sb0, sb1; int sk0, sk1; float su0, sv0, su1, sv1;
    auto stage_tok = [&](int bi) -> int {
        unsigned* cl = clb + bi * 512; unsigned char* hb = hbb + bi * 4096;
        const bool b0 = (i0 >> 11) == xg, b1 = (i1 >> 11) == xg;
        const unsigned long long m0 = __ballot(b0), m1 = __ballot(b1);
        const int n0 = __popcll(m0), n = n0 + __popcll(m1);
        sb0 = b0; sb1 = b1; sk0 = __popcll(m0 & lt); sk1 = n0 + __popcll(m1 & lt);
        if (b0) { *(u32x4*)(cl + 4 * sk0) = (u32x4){(unsigned)lane, (unsigned)i0, g0, 0u}; su0 = usi[i0]; sv0 = vsi[i0]; }
        if (b1) { *(u32x4*)(cl + 4 * sk1) = (u32x4){(unsigned)(64 + lane), (unsigned)i1, g1, 0u}; su1 = usi[i1]; sv1 = vsi[i1]; }
        if (n == 0 && lane == 0) *(u32x4*)cl = (u32x4){0u, 0u, 0u, 0u};
        *(u32x4*)(hb + lane * 16) = h0;
        if (lane == 0) *(float*)(hb + 1024) = hs0;
        return n;
    };
    auto flush_scales = [&](int bi) {
        float* cs = (float*)(hbb + bi * 4096 + 1536);
        if (sb0) *(f32x2*)(cs + 2 * sk0) = (f32x2){su0, sv0};
        if (sb1) *(f32x2*)(cs + 2 * sk1) = (f32x2){su1, sv1};
    };
    ld_tok(wv);
    int nC = stage_tok(0);
    flush_scales(0);
    ld_tok(wv + nwv);
    int slotC, idC; bool validC; float g_in;
    { validC = grp < nC; const int kk = validC ? grp : 0; const u32x4 e = *(const u32x4*)(clb + 4 * kk); slotC = e.x; idC = e.y; g_in = __uint_as_float(e.z); }
    u32x4 uv[8];
    {
        const unsigned uoff = validC ? (unsigned)idC * 1024u + (unsigned)sub * 16u : 0x40000000u;
#pragma unroll
        for (int t = 0; t < 8; ++t) { uv[t] = __builtin_bit_cast(u32x4, __builtin_amdgcn_raw_buffer_load_b128(urs, (int)(uoff + t * 128), 0, 0)); __builtin_amdgcn_sched_barrier(0); }
    }
    int it = 0;
    for (int tok = wv; tok < NTOK; tok += nwv, ++it) {
        const int cb = it & 1;
        const unsigned* clC = clb + cb * 512; const unsigned* clN = clb + (cb ^ 1) * 512;
        const unsigned char* hbC = hbb + cb * 4096;
        const bool more = tok + nwv < NTOK;
        const int nN = stage_tok(cb ^ 1); ld_tok(tok + 2 * nwv);
        const float shC = *(const float*)(hbC + 1024);
        const int nr = nC > 8 ? (nC + 7) >> 3 : 1;
        u32x4 hq[8];
#pragma unroll
        for (int t = 0; t < 8; ++t) hq[t] = *(const u32x4*)(hbC + (sub + 8 * t) * 16);
        auto do_round = [&](int rd) {
            const f32x2 s2 = *(const f32x2*)(hbC + 1536 + 8 * (validC ? 8 * rd + grp : 0));
            int slotN, idN; bool validN; float g_inN;
            {
                u32x4 e;
                if (rd + 1 < nr) { const int k = 8 * (rd + 1) + grp; validN = k < nC; e = *(const u32x4*)(clC + 4 * (validN ? k : 0)); }
                else if (more) { validN = grp < nN; e = *(const u32x4*)(clN + 4 * (validN ? grp : 0)); }
                else { validN = false; e = *(const u32x4*)clC; }
                slotN = e.x; idN = e.y; g_inN = __uint_as_float(e.z);
            }
            const unsigned uoffN = validN ? ((unsigned)idN & (DRY ? UMASK : 0xffffffffu)) * 1024u + (unsigned)sub * 16u : 0x40000000u;
            __builtin_amdgcn_sched_barrier(0);
            int a0 = 0, a1 = 0, a2 = 0, a3 = 0;
#pragma unroll
            for (int t = 0; t < 8; ++t) {
                const u32x4 q = uv[t];
                a0 = __builtin_amdgcn_sdot4((int)q.x, (int)hq[t].x, a0, false); a1 = __builtin_amdgcn_sdot4((int)q.y, (int)hq[t].y, a1, false);
                a2 = __builtin_amdgcn_sdot4((int)q.z, (int)hq[t].z, a2, false); a3 = __builtin_amdgcn_sdot4((int)q.w, (int)hq[t].w, a3, false);
                uv[t] = __builtin_bit_cast(u32x4, __builtin_amdgcn_raw_buffer_load_b128(urs, (int)(uoffN + t * 128), 0, 0));
                __builtin_amdgcn_sched_barrier(0);
            }
            int di = (a0 + a1) + (a2 + a3);
            di += __builtin_amdgcn_update_dpp(0, di, 0xB1, 0xF, 0xF, true);
            di += __builtin_amdgcn_update_dpp(0, di, 0x4E, 0xF, 0xF, true);
            di += __builtin_amdgcn_update_dpp(0, di, 0x141, 0xF, 0xF, true);
            if (validC && sub == 0) {
                float* gw = DRY ? (float*)(ws + OFF_R) + (long)tok * 128 + slotC : rgate + (long)tok * 128 + slotC;
                *gw = g_in * gelu_tanh((float)di * s2.x * shC) * s2.y;
            }
            slotC = slotN; idC = idN; validC = validN; g_in = g_inN;
        };
        do_round(0);
        for (int rd = 1; rd < nr; ++rd) do_round(rd);
        flush_scales(cb ^ 1);
        nC = nN;
    }
}

#ifndef VMASK
#define VMASK 0xffffffffu
#endif
#ifndef V_MFMA
#define V_MFMA 1
#endif
#define LAS __attribute__((address_space(3)))
typedef int v2i_t __attribute__((ext_vector_type(2)));
template <bool DRY>
DI void phase_peer_v(const Params& p, int layer, unsigned char* lds, int tid) {
    unsigned char* ws = p.ws;
    const int* ridx = (const int*)(ws + OFF_RIDX);
    const float* wact = (const float*)(ws + OFF_RGATE);
    const float* ada = (const float*)(ws + OFF_ADA);
    float* x = opq(p.out);
    const int lane = tid & 63, w = __builtin_amdgcn_readfirstlane(tid >> 6), sub = lane & 7, eg = lane >> 3;
    const int xg = blockIdx.x & 7, lb = blockIdx.x >> 3, nwv = (gridDim.x >> 3) * NWAVES, wv = lb * NWAVES + w;
    if (lb >= (int)(gridDim.x >> 3)) return;
    const unsigned char* Vc = ws + OFF_PV + ((long)(layer * 8 + xg) * 16384) * 128;
    unsigned char* gr = lds + w * 16384;
    unsigned* ring = (unsigned*)(lds + 128 * 1024 + w * 3072);
    int ia, ib; float wa, wb;
    auto ld_tokv = [&](int tk) {
        tk = tk < NTOK ? tk : wv;
        ia = ridx[(long)tk * 128 + lane]; ib = ridx[(long)tk * 128 + 64 + lane];
        wa = wact[(long)tk * 128 + lane]; wb = wact[(long)tk * 128 + 64 + lane];
    };
    auto st_ring = [&](int slot) {
        unsigned* rs = ring + slot * 256;
        rs[lane] = (unsigned)ia; rs[64 + lane] = (unsigned)ib; rs[128 + lane] = __float_as_uint(wa); rs[192 + lane] = __float_as_uint(wb);
    };
    auto rd_ids = [&](int slot, u32x4 (&a)[4]) {
        const u32x4* ip = (const u32x4*)(ring + slot * 256 + eg * 16);
#pragma unroll
        for (int q = 0; q < 4; ++q) a[q] = ip[q];
    };
    auto issue = [&](int j, const u32x4 (&a)[4]) {
#pragma unroll
        for (int i = 0; i < 4; ++i) {
            const int g = 4 * (i & 1) + (eg >> 1);
            const unsigned src = (a[j][i] & (DRY ? VMASK : 0xffffffffu)) * 128u + (unsigned)((sub ^ g) << 4);
            __builtin_amdgcn_global_load_lds((const unsigned*)(Vc + src), (unsigned*)(gr + j * 4096 + i * 1024), 16, 0, 0);
        }
    };
    const int col0 = 128 * xg + 16 * sub;
    ld_tokv(wv); st_ring(0);
    ld_tokv(wv + nwv); st_ring(1);
    ld_tokv(wv + 2 * nwv);
    {
        u32x4 a[4];
        rd_ids(0, a);
#pragma unroll
        for (int j = 0; j < 4; ++j) issue(j, a);
    }
#if V_MFMA
    unsigned char* wb8 = lds + 152 * 1024 + w * 256;
    const int m16 = lane & 15, q4 = lane >> 4;
    int boff[8];
    {
        const int rowL = 8 * q4 + (m16 >> 1), gL = (rowL >> 1) & 7;
#pragma unroll
        for (int nt = 0; nt < 8; ++nt) boff[nt] = rowL * 128 + ((nt ^ gL) << 4) + 8 * (m16 & 1);
    }
    unsigned baddr[8];
    const unsigned gr3 = (unsigned)(unsigned long)(LAS unsigned char*)gr;
#pragma unroll
    for (int nt = 0; nt < 8; ++nt) baddr[nt] = gr3 + (unsigned)boff[nt];
    const unsigned aaddr = (unsigned)(unsigned long)(LAS unsigned char*)wb8 + (unsigned)((m16 & 1) * 128 + 8 * q4);
    float xv[8], gfv[8]; int gb = -1;
    const int colx = 128 * xg + m16;
    if (lane < 16) {
#pragma unroll
        for (int nt = 0; nt < 8; ++nt) xv[nt] = x[(long)wv * DM + colx + 16 * nt];
    }
#else
    f32x4 gfv[4]; int gb = -1;
    f32x4 xv[4];
    if (eg == 0) {
#pragma unroll
        for (int c = 0; c < 4; ++c) xv[c] = *(const f32x4*)(x + (long)wv * DM + col0 + 4 * c);
    }
#endif
    int it = 0, s3 = 0;
    for (int tok = wv; tok < NTOK; tok += nwv, ++it) {
        const int sl0 = s3, sl1 = s3 == 2 ? 0 : s3 + 1, sl2 = s3 == 0 ? 2 : s3 - 1;
        st_ring(sl2);
        ld_tokv(tok + 3 * nwv);
        u32x4 na[4];
        rd_ids(sl1, na);
        {
            const int b = tok >> 13;
            if (b != gb) {
                gb = b;
#if V_MFMA
                if (lane < 16) {
#pragma unroll
                    for (int nt = 0; nt < 8; ++nt) gfv[nt] = ada[b * ADA_STRIDE + layer * 6144 + 5 * 1024 + colx + 16 * nt];
                }
#else
                const float* gf = ada + b * ADA_STRIDE + layer * 6144 + 5 * 1024 + col0;
#pragma unroll
                for (int c = 0; c < 4; ++c) gfv[c] = *(const f32x4*)(gf + 4 * c);
#endif
                asm volatile("s_waitcnt vmcnt(0)" ::: "memory");
            }
        }
#if V_MFMA
        float invS;
        {
            const float w0 = __uint_as_float(ring[sl0 * 256 + 128 + lane]), w1 = __uint_as_float(ring[sl0 * 256 + 192 + lane]);
            const float mx = wave_max(fmaxf(fabsf(w0), fabsf(w1)));
            int ex = (int)((__float_as_uint(mx) >> 23) & 255u) - 127;
            ex = ex < -100 ? -100 : ex;
            const float S = __uint_as_float((unsigned)(127 + 7 - ex) << 23);
            invS = __uint_as_float((unsigned)(127 - 7 + ex) << 23);
            const float a0 = w0 * S, a1 = w1 * S;
            const int hi = __builtin_amdgcn_cvt_pk_fp8_f32(a0, a1, 0, false);
            const f32x2 hf = __builtin_amdgcn_cvt_pk_f32_fp8(hi, false);
            const int lo = __builtin_amdgcn_cvt_pk_fp8_f32(a0 - hf.x, a1 - hf.y, 0, false);
            const int p0 = 8 * (lane & 15) + (lane >> 4);
            wb8[p0] = (unsigned char)(hi & 255); wb8[p0 + 4] = (unsigned char)((hi >> 8) & 255);
            wb8[128 + p0] = (unsigned char)(lo & 255); wb8[128 + p0 + 4] = (unsigned char)((lo >> 8) & 255);
        }
        f32x4 d[8];
#pragma unroll
        for (int nt = 0; nt < 8; ++nt) d[nt] = (f32x4){0.f, 0.f, 0.f, 0.f};
#pragma unroll
        for (int j = 0; j < 4; ++j) {
            asm volatile("s_waitcnt vmcnt(24)" ::: "memory");
            v2i_t aq, b0, b1, b2, b3, b4, b5, b6, b7;
            asm volatile("ds_read_b64 %0, %9 offset:%18\n\t"
                         "ds_read_b64_tr_b8 %1, %10 offset:%19\n\tds_read_b64_tr_b8 %2, %11 offset:%19\n\t"
                         "ds_read_b64_tr_b8 %3, %12 offset:%19\n\tds_read_b64_tr_b8 %4, %13 offset:%19\n\t"
                         "ds_read_b64_tr_b8 %5, %14 offset:%19\n\tds_read_b64_tr_b8 %6, %15 offset:%19\n\t"
                         "ds_read_b64_tr_b8 %7, %16 offset:%19\n\tds_read_b64_tr_b8 %8, %17 offset:%19\n\t"
                         "s_waitcnt lgkmcnt(0)"
                         : "=&v"(aq), "=&v"(b0), "=&v"(b1), "=&v"(b2), "=&v"(b3), "=&v"(b4), "=&v"(b5), "=&v"(b6), "=&v"(b7)
                         : "v"(aaddr), "v"(baddr[0]), "v"(baddr[1]), "v"(baddr[2]), "v"(baddr[3]), "v"(baddr[4]), "v"(baddr[5]), "v"(baddr[6]), "v"(baddr[7]),
                           "i"(32 * j), "i"(4096 * j)
                         : "memory");
            long a8 = ((long)(unsigned)aq.y << 32) | (unsigned)aq.x;
            a8 = m16 < 2 ? a8 : 0l;
            const v2i_t bq[8] = {b0, b1, b2, b3, b4, b5, b6, b7};
#pragma unroll
            for (int nt = 0; nt < 8; ++nt) {
                const long b8 = ((long)(unsigned)bq[nt].y << 32) | (unsigned)bq[nt].x;
                d[nt] = __builtin_amdgcn_mfma_f32_16x16x32_fp8_fp8(a8, b8, d[nt], 0, 0, 0);
            }
            issue(j, na);
        }
        if (lane < 16) {
            float* xr = DRY ? (float*)(ws + OFF_R + 16 * MB) + (long)tok * DM + colx : x + (long)tok * DM + colx;
#pragma unroll
            for (int nt = 0; nt < 8; ++nt) xr[16 * nt] = xv[nt] + gfv[nt] * ((d[nt].x + d[nt].y) * invS);
            const int tn = tok + nwv < NTOK ? tok + nwv : wv;
#pragma unroll
            for (int nt = 0; nt < 8; ++nt) xv[nt] = x[(long)tn * DM + colx + 16 * nt];
        }
#else
        f32x4 cw[4];
        {
            const f32x4* wp = (const f32x4*)(ring + sl0 * 256 + 128 + eg * 16);
#pragma unroll
            for (int q = 0; q < 4; ++q) cw[q] = wp[q];
        }
        f32x2 ap[8];
#pragma unroll
        for (int i = 0; i < 8; ++i) ap[i] = (f32x2){0.f, 0.f};
#pragma unroll
        for (int j = 0; j < 4; ++j) {
            asm volatile("s_waitcnt vmcnt(20)" ::: "memory");
#pragma unroll
            for (int i = 0; i < 4; ++i) {
                const int rs = 8 * i + eg, g = 4 * (i & 1) + (eg >> 1);
                const u32x4 v = *(const u32x4*)(gr + j * 4096 + rs * 128 + ((sub ^ g) << 4));
                const float ws1 = cw[j][i]; const f32x2 ww = {ws1, ws1};
                ap[0] += __builtin_amdgcn_cvt_pk_f32_fp8((int)v.x, false) * ww; ap[1] += __builtin_amdgcn_cvt_pk_f32_fp8((int)v.x, true) * ww;
                ap[2] += __builtin_amdgcn_cvt_pk_f32_fp8((int)v.y, false) * ww; ap[3] += __builtin_amdgcn_cvt_pk_f32_fp8((int)v.y, true) * ww;
                ap[4] += __builtin_amdgcn_cvt_pk_f32_fp8((int)v.z, false) * ww; ap[5] += __builtin_amdgcn_cvt_pk_f32_fp8((int)v.z, true) * ww;
                ap[6] += __builtin_amdgcn_cvt_pk_f32_fp8((int)v.w, false) * ww; ap[7] += __builtin_amdgcn_cvt_pk_f32_fp8((int)v.w, true) * ww;
            }
            asm volatile("s_waitcnt lgkmcnt(0)" ::: "memory");
            issue(j, na);
        }
        float acc[16];
#pragma unroll
        for (int i = 0; i < 8; ++i) { acc[2 * i] = ap[i].x; acc[2 * i + 1] = ap[i].y; }
#pragma unroll
        for (int i = 0; i < 16; ++i) { acc[i] += lr8(acc[i]); acc[i] = sum_x16(acc[i]); acc[i] = sum_x32(acc[i]); }
        if (eg == 0) {
            float* xr = DRY ? (float*)(ws + OFF_R + 16 * MB) + (long)tok * DM + col0 : x + (long)tok * DM + col0;
#pragma unroll
            for (int c = 0; c < 4; ++c) {
                const f32x4 gv = gfv[c];
                f32x4 o;
                o.x = xv[c].x + gv.x * acc[4 * c + 0]; o.y = xv[c].y + gv.y * acc[4 * c + 1];
                o.z = xv[c].z + gv.z * acc[4 * c + 2]; o.w = xv[c].w + gv.w * acc[4 * c + 3];
                *(f32x4*)(xr + 4 * c) = o;
            }
            const int tn = tok + nwv < NTOK ? tok + nwv : wv;
#pragma unroll
            for (int c = 0; c < 4; ++c) xv[c] = *(const f32x4*)(x + (long)tn * DM + col0 + 4 * c);
        }
#endif
        s3 = sl1;
    }
    asm volatile("s_waitcnt vmcnt(0)" ::: "memory");
}

DI void norm_row_q8(const f32x4 (&v)[4], float rstd, const float* gain, const float* shift, const float* scale, unsigned char* orow, float* os, int lane) {
    f32x4 y[4]; float am = 0.f;
#pragma unroll
    for (int j = 0; j < 4; ++j) {
        const int c = 4 * lane + 256 * j;
        const f32x4 g = *(const f32x4*)(gain + c), sh = *(const f32x4*)(shift + c), sc = *(const f32x4*)(scale + c);
        y[j].x = v[j].x * rstd * g.x * (1.f + sc.x) + sh.x; y[j].y = v[j].y * rstd * g.y * (1.f + sc.y) + sh.y;
        y[j].z = v[j].z * rstd * g.z * (1.f + sc.z) + sh.z; y[j].w = v[j].w * rstd * g.w * (1.f + sc.w) + sh.w;
        am = fmaxf(am, fmaxf(fmaxf(fabsf(y[j].x), fabsf(y[j].y)), fmaxf(fabsf(y[j].z), fabsf(y[j].w))));
    }
    am = wave_max(am);
    const float qs = am > 0.f ? 127.f / am : 1.f;
#pragma unroll
    for (int j = 0; j < 4; ++j) *(int*)(orow + 4 * lane + 256 * j) = pack_i8x4(y[j].x * qs, y[j].y * qs, y[j].z * qs, y[j].w * qs);
    if (lane == 0) *os = am > 0.f ? am * (1.f / 127.f) : 1.f;
}
DI void phase_norm2(const float* __restrict__ x, unsigned char* __restrict__ out1, float* __restrict__ os1, const float* gain1, int sh1, int sc1,
                    unsigned char* __restrict__ out2, float* __restrict__ os2, const float* gain2, int sh2, int sc2, const float* ada, int tid) {
    const int lane = tid & 63, gw = blockIdx.x * NWAVES + (tid >> 6), nw = gridDim.x * NWAVES;
    for (int tok = gw; tok < NTOK; tok += nw) {
        const int b = tok >> 13;
        f32x4 v[4]; float ss = 0.f;
#pragma unroll
        for (int j = 0; j < 4; ++j) { v[j] = *(const f32x4*)(x + (long)tok * DM + 4 * lane + 256 * j); ss += v[j].x * v[j].x + v[j].y * v[j].y + v[j].z * v[j].z + v[j].w * v[j].w; }
        const float rstd = rsqrtf(wave_sum(ss) * (1.f / DM) + EPS);
        norm_row_q8(v, rstd, gain1, ada + b * ADA_STRIDE + sh1, ada + b * ADA_STRIDE + sc1, out1 + (long)tok * DM, os1 + tok, lane);
        norm_row_q8(v, rstd, gain2, ada + b * ADA_STRIDE + sh2, ada + b * ADA_STRIDE + sc2, out2 + (long)tok * DM, os2 + tok, lane);
    }
}

template <int MT, class Epi>
DI void gemm_phase(const bf16_t* A, long lda, int M, const bf16_t* Bt, long ldb, int N, int K, const Epi& epi, unsigned char* lds, int tid) {
    const int ntm = (M + 128 * MT - 1) / (128 * MT), ntn = (N + 255) / 256, nt = ntm * ntn;
    if ((gridDim.x & 7) == 0 && (ntm & 31) == 0) {
        const int xcd = blockIdx.x & 7, lb = blockIdx.x >> 3, nlb = gridDim.x >> 3, tmx = ntm >> 3, per = tmx * ntn;
        for (int q = lb; q < per; q += nlb) {
            const int g4 = q / (4 * ntn), rem = q - g4 * 4 * ntn, tn = rem >> 2, tm = xcd * tmx + g4 * 4 + (rem & 3);
            if (tm < (xcd + 1) * tmx) gemm_tile<MT>(A, lda, M, Bt, ldb, N, K, tm * 128 * MT, tn * 256, epi, lds, tid);
        }
        return;
    }
    for (int t = blockIdx.x; t < nt; t += gridDim.x) {
        const int tn = t / ntm, tm = t % ntm;
        gemm_tile<MT>(A, lda, M, Bt, ldb, N, K, tm * 128 * MT, tn * 256, epi, lds, tid);
    }
}

template <int MT, class Epi>
DI void gemm_tile_i8(const unsigned char* __restrict__ A, int M, const float* __restrict__ as, const unsigned char* __restrict__ Bt, int N, const float* __restrict__ bs,
                     int K, int m0, int n0, const Epi& epi, unsigned char* lds, int tid) {
    constexpr int XS = MT * 128 * 128, WS = 256 * 128, STAGE = XS + WS;
    const int lane = tid & 63, w = tid >> 6, tg = w & 3, fh = w >> 2, r = lane & 31, h = lane >> 5;
    const int wbase = tid & ~63;
    unsigned xo[2 * MT], wo[4];
#pragma unroll
    for (int i = 0; i < 2 * MT; ++i) { int row, c; sw2_src(tid + 512 * i, row, c); int m = m0 + row; m = m < M ? m : M - 1; xo[i] = (unsigned)m * (unsigned)K + c * 16; }
#pragma unroll
    for (int i = 0; i < 4; ++i) { int row, c; sw2_src(tid + 512 * i, row, c); int n = n0 + row; n = n < N ? n : N - 1; wo[i] = (unsigned)n * (unsigned)K + c * 16; }
    auto stage = [&](int kt, unsigned char* st) {
#pragma unroll
        for (int i = 0; i < 2 * MT; ++i)
            __builtin_amdgcn_global_load_lds((const unsigned*)(A + kt * 128 + xo[i]), (unsigned*)(st + (wbase + 512 * i) * 16), 16, 0, 0);
#pragma unroll
        for (int i = 0; i < 4; ++i)
            __builtin_amdgcn_global_load_lds((const unsigned*)(Bt + kt * 128 + wo[i]), (unsigned*)(st + XS + (wbase + 512 * i) * 16), 16, 0, 0);
    };
    i32x16 acc[MT][4];
#pragma unroll
    for (int s2 = 0; s2 < MT; ++s2)
#pragma unroll
        for (int i = 0; i < 4; ++i)
#pragma unroll
            for (int j = 0; j < 16; ++j) acc[s2][i][j] = 0;
    const int nk = K >> 7;
    stage(0, lds);
    __syncthreads();
#pragma unroll 2
    for (int kt = 0; kt < nk; ++kt) {
        unsigned char* cur = lds + (kt & 1) * STAGE;
        if (kt + 1 < nk) stage(kt + 1, lds + ((kt + 1) & 1) * STAGE);
        i32x4 xfa[MT], wfa[4], xfb[MT], wfb[4];
        auto ldf = [&](i32x4 (&xf)[MT], i32x4 (&wf)[4], int ks) {
#pragma unroll
            for (int s2 = 0; s2 < MT; ++s2) xf[s2] = *(const i32x4*)(cur + sw2(32 * MT * tg + 32 * s2 + r, 2 * ks + h));
#pragma unroll
            for (int mt = 0; mt < 4; ++mt) wf[mt] = *(const i32x4*)(cur + XS + sw2(128 * fh + 32 * mt + r, 2 * ks + h));
        };
        auto mm = [&](const i32x4 (&xf)[MT], const i32x4 (&wf)[4]) {
#pragma unroll
            for (int mt = 0; mt < 4; ++mt)
#pragma unroll
                for (int s2 = 0; s2 < MT; ++s2) acc[s2][mt] = MFMA32I8(wf[mt], xf[s2], acc[s2][mt]);
        };
        ldf(xfa, wfa, 0);
        ldf(xfb, wfb, 1); __builtin_amdgcn_sched_barrier(0); mm(xfa, wfa); __builtin_amdgcn_sched_barrier(0);
        ldf(xfa, wfa, 2); __builtin_amdgcn_sched_barrier(0); mm(xfb, wfb); __builtin_amdgcn_sched_barrier(0);
        ldf(xfb, wfb, 3); __builtin_amdgcn_sched_barrier(0); mm(xfa, wfa); __builtin_amdgcn_sched_barrier(0);
        mm(xfb, wfb);
        __syncthreads();
    }
    auto fin = [&](const i32x16 (&ai)[4], int s2, int ho, int ro, int to) {
        const int tok = m0 + 32 * MT * tg + 32 * s2 + ro, fbase = n0 + 128 * fh;
        const float sa = as[tok < M ? tok : M - 1];
        f32x16 af[4];
#pragma unroll
        for (int mt = 0; mt < 4; ++mt) {
#pragma unroll
            for (int g4 = 0; g4 < 4; ++g4) {
                int f0 = fbase + 32 * mt + 8 * g4 + 4 * ho; f0 = f0 + 3 < N ? f0 : (N - 4 > 0 ? N - 4 : 0);
                const f32x4 sb = *(const f32x4*)(bs + f0);
                af[mt][4 * g4 + 0] = (float)ai[mt][4 * g4 + 0] * (sa * sb.x); af[mt][4 * g4 + 1] = (float)ai[mt][4 * g4 + 1] * (sa * sb.y);
                af[mt][4 * g4 + 2] = (float)ai[mt][4 * g4 + 2] * (sa * sb.z); af[mt][4 * g4 + 3] = (float)ai[mt][4 * g4 + 3] * (sa * sb.w);
            }
            __builtin_amdgcn_sched_barrier(0);
        }
        epi(af, tok, fbase, ho, lds, to);
        __builtin_amdgcn_sched_barrier(0);
    };
    if constexpr (MT == 2 && epi_stash<Epi>::present) {
        int* sp = (int*)lds + w * 4096 + lane;
#pragma unroll
        for (int mt = 0; mt < 4; ++mt)
#pragma unroll
            for (int j = 0; j < 16; ++j) sp[(mt * 16 + j) * 64] = acc[1][mt][j];
        int ho = h, ro = r, to = tid;
        asm volatile("" : "+v"(ho), "+v"(ro), "+v"(to));
        fin(acc[0], 0, ho, ro, to);
        i32x16 a2[4];
        const int* sp2 = sp; asm volatile("" : "+v"(sp2));
#pragma unroll
        for (int mt = 0; mt < 4; ++mt)
#pragma unroll
            for (int j = 0; j < 16; ++j) a2[mt][j] = sp2[(mt * 16 + j) * 64];
        asm volatile("" : "+v"(ho), "+v"(ro), "+v"(to));
        fin(a2, 1, ho, ro, to);
        __syncthreads();
    } else {
        int ho = h, ro = r, to = tid;
#pragma unroll
        for (int s2 = 0; s2 < MT; ++s2) { asm volatile("" : "+v"(ho), "+v"(ro), "+v"(to)); fin(acc[s2], s2, ho, ro, to); }
    }
}
template <int MT, class Epi>
DI void gemm_phase_i8(const unsigned char* A, int M, const float* as, const unsigned char* Bt, int N, const float* bs, int K, const Epi& epi, unsigned char* lds, int tid,
                      int skip = 0) {
    const int ntm = (M + 128 * MT - 1) / (128 * MT), ntn = (N + 255) / 256, nt = ntm * ntn;
    const int bid = (int)blockIdx.x - skip, nbl = (int)gridDim.x - skip;
    if (bid < 0) return;
    if ((gridDim.x & 7) == 0 && (ntm & 31) == 0) {
        const int xcd = bid & 7, lb = bid >> 3, nlb = nbl >> 3, tmx = ntm >> 3, per = tmx * ntn;
        for (int q = lb; q < per; q += nlb) {
            const int g4 = q / (4 * ntn), rem = q - g4 * 4 * ntn, tn = rem >> 2, tm = xcd * tmx + g4 * 4 + (rem & 3);
            gemm_tile_i8<MT>(A, M, as, Bt, N, bs, K, tm * 128 * MT, tn * 256, epi, lds, tid);
        }
        return;
    }
    for (int t = bid; t < nt; t += nbl) {
        const int tn = t / ntm, tm = t % ntm;
        gemm_tile_i8<MT>(A, M, as, Bt, N, bs, K, tm * 128 * MT, tn * 256, epi, lds, tid);
    }
}

DI void wquant_rows(const bf16_t* __restrict__ src, unsigned char* __restrict__ dst, float* __restrict__ sc, int nrows, int gw, int nw, int lane) {
    for (int n = gw; n < nrows; n += nw) {
        const u32x4 a = *(const u32x4*)(src + (long)n * 1024 + 16 * lane), b = *(const u32x4*)(src + (long)n * 1024 + 16 * lane + 8);
        float v[16];
        v[0] = bflo(a.x); v[1] = bfhi(a.x); v[2] = bflo(a.y); v[3] = bfhi(a.y); v[4] = bflo(a.z); v[5] = bfhi(a.z); v[6] = bflo(a.w); v[7] = bfhi(a.w);
        v[8] = bflo(b.x); v[9] = bfhi(b.x); v[10] = bflo(b.y); v[11] = bfhi(b.y); v[12] = bflo(b.z); v[13] = bfhi(b.z); v[14] = bflo(b.w); v[15] = bfhi(b.w);
        float am = 0.f;
#pragma unroll
        for (int q = 0; q < 16; ++q) am = fmaxf(am, fabsf(v[q]));
        am = wave_max(am);
        const float qs = am > 0.f ? 127.f / am : 1.f;
        u32x4 o;
        o.x = (unsigned)pack_i8x4(v[0] * qs, v[1] * qs, v[2] * qs, v[3] * qs); o.y = (unsigned)pack_i8x4(v[4] * qs, v[5] * qs, v[6] * qs, v[7] * qs);
        o.z = (unsigned)pack_i8x4(v[8] * qs, v[9] * qs, v[10] * qs, v[11] * qs); o.w = (unsigned)pack_i8x4(v[12] * qs, v[13] * qs, v[14] * qs, v[15] * qs);
        *(u32x4*)(dst + (long)n * 1024 + 16 * lane) = o;
        if (lane == 0) sc[n] = am > 0.f ? am * (1.f / 127.f) : 1.f;
    }
}
DI void phase_wquant(unsigned char* ws, int tid) {
    const int lane = tid & 63, gw = blockIdx.x * NWAVES + (tid >> 6), nw = gridDim.x * NWAVES;
    float* sc = (float*)(ws + OFF_W8S);
    wquant_rows((const bf16_t*)(ws + OFF_WT_PEER), ws + OFF_W8_PEER, sc + W8S_PEER, 4096, gw, nw, lane);
    wquant_rows((const bf16_t*)(ws + OFF_WT_DIN), ws + OFF_W8_DIN, sc + W8S_DIN, 3072, gw, nw, lane);
    wquant_rows((const bf16_t*)(ws + OFF_WT_KV), ws + OFF_W8_KV, sc + W8S_KV, 1536, gw, nw, lane);
    wquant_rows((const bf16_t*)(ws + OFF_WT_NIN), ws + OFF_W8_NIN, sc + W8S_NIN, 1088, gw, nw, lane);
}

#define XB_TMO      128
#define XB_XCNT(j)  (256  + 64 * (j))
#define XB_XSUB(j)  (1280 + 64 * (j))
#define XB_XGEN(j)  (2304 + 64 * (j))
#define XB_TOP      3328
#define XB_TOPGEN   3392
#define XCD_BAR_WORDS 3456
#define XB_SPIN_CAP (1u << 22)
DI unsigned xb_ld(unsigned* p) { return __hip_atomic_load(p, __ATOMIC_RELAXED, __HIP_MEMORY_SCOPE_AGENT); }
DI unsigned xb_add(unsigned* p, unsigned v) { return __hip_atomic_fetch_add(p, v, __ATOMIC_RELAXED, __HIP_MEMORY_SCOPE_AGENT); }
DI unsigned xb_xcc_id() { return (unsigned)__builtin_amdgcn_s_getreg((3 << 11) | 20) & 0xFu; }
#define XB_SPIN(cond, bar) do { unsigned _sp = 0; while (cond) { __builtin_amdgcn_s_sleep(1); \
    if ((++_sp & 255u) == 0u) { if (xb_ld(&(bar)[XB_TMO])) break; if (_sp > XB_SPIN_CAP) { atomicAdd(&(bar)[XB_TMO], 1u); break; } } } } while (0)
DI void xcd_barrier_complete(unsigned* bar, unsigned x, unsigned& nloc, unsigned& nx) {
    const unsigned G = gridDim.x;
    unsigned sum, cnt, mine, sp = 0u;
    for (;;) {
        sum = 0u; cnt = 0u; mine = 0u;
#pragma unroll
        for (unsigned j = 0; j < 16; ++j) { const unsigned c = xb_ld(&bar[XB_XCNT(j)]); sum += c; cnt += (c > 0u) ? 1u : 0u; mine = (j == x) ? c : mine; }
        if (sum == G) break;
        __builtin_amdgcn_s_sleep(1);
        if ((++sp & 255u) == 0u) { if (xb_ld(&bar[XB_TMO])) break; if (sp > XB_SPIN_CAP) { atomicAdd(&bar[XB_TMO], 1u); break; } }
    }
    nloc = mine > 0u ? mine : 1u; nx = cnt > 0u ? cnt : 1u;
}
DI void xcd_barrier(unsigned* bar, volatile LAS unsigned* st, int tid) {
    asm volatile("s_waitcnt vmcnt(0)" ::: "memory");
    __syncthreads();
    if (tid == 0) {
        const unsigned x = xb_xcc_id();
        __builtin_amdgcn_s_waitcnt(0);
        unsigned nloc = st[0], nx = st[1];
        if (nloc == 0u) { xcd_barrier_complete(bar, x, nloc, nx); st[0] = nloc; st[1] = nx; }
        const unsigned old = xb_add(&bar[XB_XSUB(x)], 1u);
        const unsigned gen = old / nloc;
        if (old + 1u == (gen + 1u) * nloc) {
            __builtin_amdgcn_fence(__ATOMIC_RELEASE, "agent");
            asm volatile("s_waitcnt vmcnt(0)" ::: "memory");
            const unsigned og = xb_add(&bar[XB_TOP], 1u);
            const unsigned tg = og / nx;
            if (og + 1u == (tg + 1u) * nx) xb_add(&bar[XB_TOPGEN], 1u);
            else XB_SPIN(xb_ld(&bar[XB_TOPGEN]) == tg, bar);
            __builtin_amdgcn_fence(__ATOMIC_ACQUIRE, "agent");
            xb_add(&bar[XB_XGEN(x)], 1u);
            asm volatile("s_waitcnt vmcnt(0)" ::: "memory");
        } else {
            XB_SPIN(xb_ld(&bar[XB_XGEN(x)]) == gen, bar);
            __builtin_amdgcn_fence(__ATOMIC_ACQUIRE, "agent");
            asm volatile("s_waitcnt vmcnt(0)" ::: "memory");
        }
    }
    __syncthreads();
}

#define ftid() ftid_(wave_u)
DI int ftid_(int wave_u) { int t = (wave_u << 6) + (int)__builtin_amdgcn_mbcnt_hi(~0u, __builtin_amdgcn_mbcnt_lo(~0u, 0u)); asm volatile("" : "+v"(t)); return t; }


#if defined(__HIP_DEVICE_COMPILE__)
typedef const __attribute__((address_space(4))) Params* KParamPtr;
DI Params load_params() { KParamPtr kp = (KParamPtr)__builtin_amdgcn_kernarg_segment_ptr(); asm volatile("" : "+s"(kp)); return *kp; }
#else
DI Params load_params() { return Params{}; }
#endif
#define p (load_params())
#define ws (load_params().ws)
#define ada ((const float*)(ws + OFF_ADA))
#define Hb ((bf16_t*)(ws + OFF_H))
#define bar ((unsigned*)(ws + OFF_BAR))
__global__ void __launch_bounds__(NTHREADS) yoco_fwd(Params p_arg) {
    extern __shared__ __attribute__((aligned(16))) unsigned char lds[];
    cg::grid_group grid = cg::this_grid();
    volatile LAS unsigned* bst = (volatile LAS unsigned*)(lds + LDS_BAR);
    const int wave_u = __builtin_amdgcn_readfirstlane((int)(threadIdx.x >> 6));
    { const int t0 = ftid(); if (t0 == 0) { bst[0] = 0u; bst[1] = 0u; }
      if (blockIdx.x == 0) for (int i = t0; i < XCD_BAR_WORDS; i += NTHREADS) bar[i] = 0u; }
    __syncthreads();
    RUN(0) REP(0) phase_prep(p, lds, ftid());
    grid.sync();
    if (ftid() == 0) (void)xb_add(&bar[XB_XCNT(xb_xcc_id())], 1u);
    RUN(1) REP(1) phase_norm_q8<false>(p.in[0], Hb, ws + OFF_H8, (float*)(ws + OFF_HS), p.in[5], ada, 0, 1024, ftid());
    RUN(1) phase_wquant(ws, ftid());
    xcd_barrier(bar, bst, ftid());
    RUN(2) REP(2) {
        EpiQKV0 e{(bf16_t*)(ws + OFF_Q0), (bf16_t*)(ws + OFF_K0), (bf16_t*)(ws + OFF_VT0), p.in[10], p.in[11], (float*)(ws + OFF_MB0), p.in[2]};
        gemm_phase_i8<2>(ws + OFF_H8, NTOK, (const float*)(ws + OFF_HS), ws + OFF_W8_DIN, 3072, (const float*)(ws + OFF_W8S) + W8S_DIN, DM, e, lds, ftid());
    }
    xcd_barrier(bar, bst, ftid());
    RUN(3) REP(3) phase_diff_attn(p, lds, ftid());
    xcd_barrier(bar, bst, ftid());
    RUN(4) REP(4) {
        EpiResid e{p.in[0], opq(p.out), ada + 2 * 1024};
        gemm_phase<2>(Hb, DM, NTOK, (const bf16_t*)(ws + OFF_WT_DOUT), DM, 1024, DM, e, lds, ftid());
    }
    xcd_barrier(bar, bst, ftid());
    if (STOP_AFTER <= 1) return;
    RUN(1) phase_norm_q8<false>(opq(p.out), Hb, ws + OFF_H8, (float*)(ws + OFF_HS), p.in[6], ada, 3 * 1024, 4 * 1024, ftid());
    xcd_barrier(bar, bst, ftid());
    RUN(5) REP(5) {
        EpiPeer e{(int*)(ws + OFF_RIDX), (float*)(ws + OFF_RGATE), 128 * 1024};
        gemm_phase_i8<2>(ws + OFF_H8, NTOK, (const float*)(ws + OFF_HS), ws + OFF_W8_PEER, 2048, (const float*)(ws + OFF_W8S) + W8S_PEER, DM, e, lds, ftid());
    }
    xcd_barrier(bar, bst, ftid());
    if ((REPEAT_MASK >> 6) & 1) phase_peer_u<true>(p, 0, lds, ftid());
    RUN(6) phase_peer_u<false>(p, 0, lds, ftid());
    xcd_barrier(bar, bst, ftid());
    if ((REPEAT_MASK >> 10) & 1) phase_peer_v<true>(p, 0, lds, ftid());
    RUN(6) phase_peer_v<false>(p, 0, lds, ftid());
    xcd_barrier(bar, bst, ftid());
    RUN(1) phase_norm2(opq(p.out), ws + OFF_H8, (float*)(ws + OFF_HS), p.in[13], 12288, 12288 + 1024, ws + OFF_H, (float*)(ws + OFF_HS) + NTOK, p.in[5] + 1024, 6144, 6144 + 1024, ada, ftid());
    xcd_barrier(bar, bst, ftid());
    if (STOP_AFTER <= 2) return;
    RUN(7) REP(7) {
        EpiKV e{(bf16_t*)(ws + OFF_KC), (bf16_t*)(ws + OFF_KS), (bf16_t*)(ws + OFF_VST), (bf16_t*)(ws + OFF_KW), (bf16_t*)(ws + OFF_VWT), p.in[21]};
        gemm_phase_i8<2>(ws + OFF_H8, NTOK, (const float*)(ws + OFF_HS), ws + OFF_W8_KV, 1536, (const float*)(ws + OFF_W8S) + W8S_KV, DM, e, lds, ftid());
    }
    xcd_barrier(bar, bst, ftid());
    RUN(8) REP(8) {
        EpiNsaQ e{(bf16_t*)(ws + OFF_QN), (float*)(ws + OFF_GATES), p.in[25], p.in[23], (float*)(ws + OFF_MB1)};
        gemm_phase_i8<2>(ws + OFF_H, NTOK, (const float*)(ws + OFF_HS) + NTOK, ws + OFF_W8_NIN, 1048, (const float*)(ws + OFF_W8S) + W8S_NIN, DM, e, lds, ftid(),
                         gridDim.x >= 128 ? 64 : 0);
        for (int t = blockIdx.x; t < 64; t += gridDim.x) {
            const int pr = t >> 2, tm = t & 3, kv = pr >> 3, bg = pr & 7;
            const bf16_t* Ap = (const bf16_t*)(ws + OFF_KC) + (long)(kv * 8 + bg) * SEQ * 128;
            bf16_t* hid = (bf16_t*)(ws + OFF_HID) + (long)pr * 512 * 256;
            EpiCmp1 e1{hid, (const float*)(ws + OFF_POSB) + kv * 16 * 256, p.in[19] + kv * 256};
            gemm_tile<1>(Ap, 2048, 511, (const bf16_t*)(ws + OFF_WT_C1) + (long)kv * 256 * 4096, 4096, 256, 4096, tm * 128, 0, e1, lds, ftid());
            __syncthreads();
            bf16_t* dst = kv == 0 ? (bf16_t*)(ws + OFF_KCMP) + (long)bg * 512 * 128 : (bf16_t*)(ws + OFF_VCMPT) + (long)bg * 128 * 512;
            EpiCmp2 e2{dst, p.in[21], kv};
            gemm_tile<1>(hid, 256, 512, (const bf16_t*)(ws + OFF_WT_C2) + (long)kv * 128 * 256, 256, 128, 256, tm * 128, 0, e2, lds, ftid());
        }
    }
    xcd_barrier(bar, bst, ftid());
#ifdef NSA_PROBE
    phase_nsa_attn<NSA_PROBE>(p, lds, ftid());
#endif
    RUN(9) REP(9) phase_nsa_attn<0>(p, lds, ftid());
    xcd_barrier(bar, bst, ftid());
    RUN(4) {
        float* xo = opq(p.out);
        EpiResid e{xo, xo, ada + 6144 + 2 * 1024};
        gemm_phase<2>(Hb, DM, NTOK, (const bf16_t*)(ws + OFF_WT_NOUT), DM, 1024, DM, e, lds, ftid());
    }
    xcd_barrier(bar, bst, ftid());
    if (STOP_AFTER <= 3) return;
    RUN(1) phase_norm_q8<false>(opq(p.out), Hb, ws + OFF_H8, (float*)(ws + OFF_HS), p.in[6] + 1024, ada, 6144 + 3 * 1024, 6144 + 4 * 1024, ftid());
    xcd_barrier(bar, bst, ftid());
    RUN(5) REP(5) {
        EpiPeer e{(int*)(ws + OFF_RIDX), (float*)(ws + OFF_RGATE), 128 * 1024};
        gemm_phase_i8<2>(ws + OFF_H8, NTOK, (const float*)(ws + OFF_HS), ws + OFF_W8_PEER + (long)2048 * 1024, 2048, (const float*)(ws + OFF_W8S) + W8S_PEER + 2048, DM, e, lds, ftid());
    }
    xcd_barrier(bar, bst, ftid());
    if ((REPEAT_MASK >> 6) & 1) phase_peer_u<true>(p, 1, lds, ftid());
    RUN(6) phase_peer_u<false>(p, 1, lds, ftid());
    xcd_barrier(bar, bst, ftid());
    if ((REPEAT_MASK >> 10) & 1) phase_peer_v<true>(p, 1, lds, ftid());
    RUN(6) phase_peer_v<false>(p, 1, lds, ftid());
}
#undef p
#undef ws
#undef ada
#undef Hb
#undef bar

extern "C" void kernel_launch(void* const* d_in, const int* in_sizes, int n_in, void* d_out, int out_size, void* d_ws, size_t ws_size,
                              hipStream_t stream) {
    static int grid_blocks = 0;
    if (grid_blocks == 0) {
        if (n_in != 30 || out_size != NTOK * DM || ws_size < WS_END) {
            fprintf(stderr, "kernel_launch: unexpected shapes (n_in %d out %d ws %zu)\n", n_in, out_size, ws_size);
            grid_blocks = -1; return;
        }
        int dev = 0, cus = 0, per_cu = 0;
        hipGetDevice(&dev);
        hipDeviceGetAttribute(&cus, hipDeviceAttributeMultiprocessorCount, dev);
        hipFuncSetAttribute((const void*)yoco_fwd, hipFuncAttributeMaxDynamicSharedMemorySize, LDS_BYTES);
        hipOccupancyMaxActiveBlocksPerMultiprocessor(&per_cu, (const void*)yoco_fwd, NTHREADS, LDS_BYTES);
        if (per_cu < 1) { fprintf(stderr, "kernel_launch: occupancy query says %d blocks per CU\n", per_cu); grid_blocks = -1; return; }
        grid_blocks = cus;
    }
    if (grid_blocks < 0) return;
    Params p{};
    for (int i = 0; i < 30; ++i) p.in[i] = (const float*)d_in[i];
    p.out = (float*)d_out;
    p.ws = (unsigned char*)d_ws;
    void* args[] = {&p};
    hipError_t e = hipLaunchCooperativeKernel((const void*)yoco_fwd, dim3(grid_blocks), dim3(NTHREADS), args, LDS_BYTES, stream);
    if (e != hipSuccess) fprintf(stderr, "cooperative launch failed: %s (grid %d)\n", hipGetErrorString(e), grid_blocks);
}
```

```cpp
#include <hip/hip_runtime.h>
#include <hip/hip_cooperative_groups.h>
#include <cstdio>
#include <cstdint>
namespace cg = cooperative_groups;

#define DI __device__ __forceinline__
#ifndef STOP_AFTER
#define STOP_AFTER 99
#endif
#ifndef ONLY_PHASE
#define ONLY_PHASE -1
#endif
#define RUN(n) if (ONLY_PHASE < 0 || ONLY_PHASE == (n))
#ifndef REPEAT_MASK
#define REPEAT_MASK 0
#endif
#define REP(n) for (int rep_ = 0; rep_ < (((REPEAT_MASK) >> (n)) & 1) + 1; ++rep_)

typedef unsigned short bf16_t;
typedef short bf16x8 __attribute__((ext_vector_type(8)));
typedef float f32x16 __attribute__((ext_vector_type(16)));
typedef float f32x4 __attribute__((ext_vector_type(4)));
typedef float f32x2 __attribute__((ext_vector_type(2)));
typedef unsigned u32x4 __attribute__((ext_vector_type(4)));
typedef unsigned u32x2 __attribute__((ext_vector_type(2)));
typedef __bf16 bf16x2v __attribute__((ext_vector_type(2)));

#define MFMA32(a, b, c) __builtin_amdgcn_mfma_f32_32x32x16_bf16((a), (b), (c), 0, 0, 0)
typedef int i32x4 __attribute__((ext_vector_type(4)));
typedef int i32x16 __attribute__((ext_vector_type(16)));
#define MFMA32I8(a, b, c) __builtin_amdgcn_mfma_i32_32x32x32_i8((a), (b), (c), 0, 0, 0)

constexpr int NB = 4, SEQ = 8192, DM = 1024, NTOK = NB * SEQ;
constexpr int NTHREADS = 512, NWAVES = 8;
constexpr float EPS = 1e-6f;
constexpr float LOG2E = 1.4426950408889634f;
constexpr int ADA_STRIDE = 14336;

constexpr size_t MB = 1u << 20;
constexpr size_t OFF_ADA = 0;
constexpr size_t OFF_POSB = 256 * 1024;
constexpr size_t OFF_BAR = 320 * 1024;
constexpr size_t OFF_MB0 = 168 * MB;
constexpr size_t OFF_MB1 = 172 * MB;
constexpr size_t OFF_H8 = 104 * MB;
constexpr size_t OFF_HS = 174 * MB;
constexpr size_t OFF_W8 = 176 * MB;
constexpr size_t OFF_W8_DIN = OFF_W8, OFF_W8_KV = OFF_W8 + 3 * MB, OFF_W8_NIN = OFF_W8 + 5 * MB, OFF_W8_PEER = OFF_W8 + 7 * MB;
constexpr size_t OFF_W8S = 188 * MB;
constexpr int W8S_DIN = 0, W8S_KV = 3072, W8S_NIN = 4608, W8S_PEER = 5760, W8S_TOTAL = 9856;
constexpr size_t OFF_USI = 384 * 1024;
constexpr size_t OFF_VSI = 512 * 1024;
constexpr size_t OFF_WT_DIN = 1 * MB;
constexpr size_t OFF_WT_DOUT = 7 * MB;
constexpr size_t OFF_WT_KV = 9 * MB;
constexpr size_t OFF_WT_NIN = 12 * MB;
constexpr size_t OFF_WT_NOUT = 15 * MB;
constexpr size_t OFF_WT_PEER = 17 * MB;
constexpr size_t OFF_WT_C1 = 25 * MB;
constexpr size_t OFF_WT_C2 = 29 * MB;
constexpr size_t OFF_GATES = 30 * MB;
constexpr size_t OFF_KCMP = 34 * MB;
constexpr size_t OFF_VCMPT = 35 * MB;
constexpr size_t OFF_HID = 36 * MB;
constexpr size_t OFF_RIDX = 40 * MB;
constexpr size_t OFF_RGATE = 56 * MB;
constexpr size_t OFF_PU = 72 * MB;
constexpr size_t OFF_PV = 136 * MB;
constexpr size_t OFF_H = 200 * MB;
constexpr size_t OFF_R = 264 * MB;
constexpr size_t WS_END = 456 * MB;
constexpr size_t OFF_Q0 = OFF_R, OFF_K0 = OFF_R + 64 * MB, OFF_VT0 = OFF_R + 128 * MB;
constexpr size_t OFF_QN = OFF_R, OFF_H2 = OFF_R, OFF_KC = OFF_R + 64 * MB, OFF_KS = OFF_R + 96 * MB, OFF_VST = OFF_R + 112 * MB,
                 OFF_KW = OFF_R + 128 * MB, OFF_VWT = OFF_R + 144 * MB;

constexpr int LDS_BAR = 159 * 1024;
constexpr int LDS_BYTES = LDS_BAR + 256;

struct Params {
    const float* in[30];
    float* out;
    unsigned char* ws;
};

template <class T> DI T* opq(T* q) { asm volatile("" : "+s"(q)); return (T*)(__attribute__((address_space(1))) T*)q; }
DI unsigned pk2(float lo, float hi) { f32x2 v = {lo, hi}; return __builtin_bit_cast(unsigned, __builtin_convertvector(v, bf16x2v)); }
DI bf16_t f2bf(float x) { return (bf16_t)(pk2(x, 0.f) & 0xffffu); }
DI float bflo(unsigned u) { return __uint_as_float(u << 16); }
DI float bfhi(unsigned u) { return __uint_as_float(u & 0xffff0000u); }
DI float fexp2(float x) { return __builtin_amdgcn_exp2f(x); }
DI float frcp(float x) { return __builtin_amdgcn_rcpf(x); }
DI int crow(int reg, int h) { return (reg & 3) + 8 * (reg >> 2) + 4 * h; }
template <int CTRL> DI float dpp_f(float v) { return __builtin_bit_cast(float, __builtin_amdgcn_update_dpp(0, __builtin_bit_cast(int, v), CTRL, 0xF, 0xF, true)); }
DI float lx1(float v) { return dpp_f<0xB1>(v); }
DI float lx2(float v) { return dpp_f<0x4E>(v); }
DI float lhm(float v) { return dpp_f<0x141>(v); }
DI float lr8(float v) { return dpp_f<0x128>(v); }
DI float sum_x16(float v) { auto s = __builtin_amdgcn_permlane16_swap(__float_as_uint(v), __float_as_uint(v), false, false); return __uint_as_float(s[0]) + __uint_as_float(s[1]); }
DI float sum_x32(float v) { auto s = __builtin_amdgcn_permlane32_swap(__float_as_uint(v), __float_as_uint(v), false, false); return __uint_as_float(s[0]) + __uint_as_float(s[1]); }
DI float max_x16(float v) { auto s = __builtin_amdgcn_permlane16_swap(__float_as_uint(v), __float_as_uint(v), false, false); return fmaxf(__uint_as_float(s[0]), __uint_as_float(s[1])); }
DI float max_x32(float v) { auto s = __builtin_amdgcn_permlane32_swap(__float_as_uint(v), __float_as_uint(v), false, false); return fmaxf(__uint_as_float(s[0]), __uint_as_float(s[1])); }
DI unsigned get_x32(unsigned v, int h) { auto s = __builtin_amdgcn_permlane32_swap(v, v, false, false); return h ? s[0] : s[1]; }
DI float wave_sum(float v) { v += lx1(v); v += lx2(v); v += lhm(v); v += lr8(v); v = sum_x16(v); return sum_x32(v); }
DI float wave_max(float v) { v = fmaxf(v, lx1(v)); v = fmaxf(v, lx2(v)); v = fmaxf(v, lhm(v)); v = fmaxf(v, lr8(v)); v = max_x16(v); return max_x32(v); }
DI int bperm(int v, int srclane) { return __builtin_amdgcn_ds_bpermute(srclane << 2, v); }
DI float bpermf(float v, int srclane) { return __builtin_bit_cast(float, __builtin_amdgcn_ds_bpermute(srclane << 2, __builtin_bit_cast(int, v))); }
DI float gelu_tanh(float x) {
    const float u = 0.7978845608028654f * (x + 0.044715f * x * x * x);
    return x * frcp(1.f + fexp2(-2.f * LOG2E * u));
}
DI float dot2bf(unsigned a, unsigned b, float c) {
    return __builtin_amdgcn_fdot2_f32_bf16(__builtin_bit_cast(bf16x2v, a), __builtin_bit_cast(bf16x2v, b), c, false);
}
DI int rel_bucket_i(int d) {
    if (d < 16) return d < 0 ? 0 : d;
    int b = 16;
    b += d >= 21; b += d >= 27; b += d >= 35; b += d >= 46; b += d >= 59; b += d >= 77; b += d >= 99; b += d >= 128;
    b += d >= 166; b += d >= 216; b += d >= 280; b += d >= 363; b += d >= 470; b += d >= 609; b += d >= 790;
    return b;
}
DI unsigned f2key(float f) { unsigned u = __float_as_uint(f); return u ^ ((unsigned)((int)u >> 31) | 0x80000000u); }
DI float key2f(unsigned k) { unsigned u = (k & 0x80000000u) ? (k ^ 0x80000000u) : ~k; return __uint_as_float(u); }

constexpr int EPI_LDS = 96 * 1024;

DI int sw2(int row, int chunk) { return (row >> 1) * 256 + (((((row & 1) << 3) | chunk) ^ ((row >> 1) & 15)) << 4); }
DI void sw2_src(int P, int& row, int& chunk) { const int R2 = P >> 4, lc = (P & 15) ^ (R2 & 15); row = 2 * R2 + (lc >> 3); chunk = lc & 7; }

template <class T, class = void> struct epi_stash { static constexpr bool value = false, present = false; };
template <class T> struct epi_stash<T, decltype((void)T::STASH)> { static constexpr bool value = T::STASH, present = true; };

template <int MT, class Epi>
DI void gemm_tile(const bf16_t* __restrict__ A, long lda, int M, const bf16_t* __restrict__ Bt, long ldb, int N, int K,
                  int m0, int n0, const Epi& epi, unsigned char* lds, int tid) {
    constexpr int XS = MT * 128 * 128, WS = 256 * 128, STAGE = XS + WS;
    const int lane = tid & 63, w = tid >> 6, tg = w & 3, fh = w >> 2, r = lane & 31, h = lane >> 5;
    const int wbase = tid & ~63;
    unsigned xo[2 * MT], wo[4];
#pragma unroll
    for (int i = 0; i < 2 * MT; ++i) { int row, c; sw2_src(tid + 512 * i, row, c); int m = m0 + row; m = m < M ? m : M - 1; xo[i] = (unsigned)m * (unsigned)(lda * 2) + c * 16; }
#pragma unroll
    for (int i = 0; i < 4; ++i) { int row, c; sw2_src(tid + 512 * i, row, c); int n = n0 + row; n = n < N ? n : N - 1; wo[i] = (unsigned)n * (unsigned)(ldb * 2) + c * 16; }
    const unsigned char* Ab = (const unsigned char*)A;
    const unsigned char* Bb = (const unsigned char*)Bt;
    auto stage = [&](int kt, unsigned char* st) {
#pragma unroll
        for (int i = 0; i < 2 * MT; ++i)
            __builtin_amdgcn_global_load_lds((const unsigned*)(Ab + kt * 128 + xo[i]), (unsigned*)(st + (wbase + 512 * i) * 16), 16, 0, 0);
#pragma unroll
        for (int i = 0; i < 4; ++i)
            __builtin_amdgcn_global_load_lds((const unsigned*)(Bb + kt * 128 + wo[i]), (unsigned*)(st + XS + (wbase + 512 * i) * 16), 16, 0, 0);
    };
    f32x16 acc[MT][4];
#pragma unroll
    for (int s2 = 0; s2 < MT; ++s2)
#pragma unroll
        for (int i = 0; i < 4; ++i)
#pragma unroll
            for (int j = 0; j < 16; ++j) acc[s2][i][j] = 0.f;
    const int nk = K >> 6;
    stage(0, lds);
    __syncthreads();
    for (int kt = 0; kt < nk; ++kt) {
        unsigned char* cur = lds + (kt & 1) * STAGE;
        if (kt + 1 < nk) stage(kt + 1, lds + ((kt + 1) & 1) * STAGE);
        bf16x8 xfa[MT], wfa[4], xfb[MT], wfb[4];
        auto ldf = [&](bf16x8 (&xf)[MT], bf16x8 (&wf)[4], int ks) {
#pragma unroll
            for (int s2 = 0; s2 < MT; ++s2) xf[s2] = *(const bf16x8*)(cur + sw2(32 * MT * tg + 32 * s2 + r, 2 * ks + h));
#pragma unroll
            for (int mt = 0; mt < 4; ++mt) wf[mt] = *(const bf16x8*)(cur + XS + sw2(128 * fh + 32 * mt + r, 2 * ks + h));
        };
        auto mm = [&](const bf16x8 (&xf)[MT], const bf16x8 (&wf)[4]) {
#pragma unroll
            for (int mt = 0; mt < 4; ++mt)
#pragma unroll
                for (int s2 = 0; s2 < MT; ++s2) acc[s2][mt] = MFMA32(wf[mt], xf[s2], acc[s2][mt]);
        };
        ldf(xfa, wfa, 0);
        ldf(xfb, wfb, 1); __builtin_amdgcn_sched_barrier(0); mm(xfa, wfa); __builtin_amdgcn_sched_barrier(0);
        ldf(xfa, wfa, 2); __builtin_amdgcn_sched_barrier(0); mm(xfb, wfb); __builtin_amdgcn_sched_barrier(0);
        ldf(xfb, wfb, 3); __builtin_amdgcn_sched_barrier(0); mm(xfa, wfa); __builtin_amdgcn_sched_barrier(0);
        mm(xfb, wfb);
        __syncthreads();
    }
    if constexpr (MT == 2 && epi_stash<Epi>::value) {
        float* sp = (float*)lds + w * 4096 + lane;
#pragma unroll
        for (int mt = 0; mt < 4; ++mt)
#pragma unroll
            for (int j = 0; j < 16; ++j) sp[(mt * 16 + j) * 64] = acc[1][mt][j];
        epi(acc[0], m0 + 64 * tg + r, n0 + 128 * fh, h, lds, tid);
        f32x16 a2[4];
        const float* sp2 = sp; asm volatile("" : "+v"(sp2));
#pragma unroll
        for (int mt = 0; mt < 4; ++mt)
#pragma unroll
            for (int j = 0; j < 16; ++j) a2[mt][j] = sp2[(mt * 16 + j) * 64];
        epi(a2, m0 + 64 * tg + 32 + r, n0 + 128 * fh, h, lds, tid);
        __syncthreads();
    } else {
        int ho = h, ro = r, to = tid;
        if constexpr (epi_stash<Epi>::present) asm volatile("" : "+v"(ho), "+v"(ro), "+v"(to));
#pragma unroll
        for (int s2 = 0; s2 < MT; ++s2) epi(acc[s2], m0 + 32 * MT * tg + 32 * s2 + ro, n0 + 128 * fh, ho, lds, to);
    }
}

DI void store_vt_tile(bf16_t* base, long rstride, const f32x16& a, int row0, int h, int lane) {
    const bool odd = lane & 1;
#pragma unroll
    for (int rg = 0; rg < 16; rg += 2) {
        const float xa = lx1(a[rg]), xb = lx1(a[rg + 1]);
        const unsigned wv = odd ? pk2(xb, a[rg + 1]) : pk2(a[rg], xa);
        bf16_t* dp = base + (long)(row0 + crow(odd ? rg + 1 : rg, h)) * rstride - (odd ? 1 : 0);
        *(unsigned*)dp = wv;
    }
}
struct EpiQKV0 {
    bf16_t *Q, *Kk, *VT;
    const float *qg, *kg;
    float* MB; const float* relb;
    DI void operator()(const f32x16 (&acc)[4], int tok, int fbase, int h, unsigned char*, int) const {
        const int sec = fbase >> 10, hd = (fbase & 1023) >> 7, b = tok >> 13, s = tok & (SEQ - 1);
        if (sec < 2) {
            const float* gn = sec == 0 ? qg : kg;
            const float sc = sec == 0 ? 0.125f * LOG2E : 1.f;
            bf16_t* dst = sec == 0 ? Q : Kk;
#pragma unroll
            for (int j = 0; j < 2; ++j) {
                float ss = 0.f;
#pragma unroll
                for (int mt = 0; mt < 2; ++mt)
#pragma unroll
                    for (int rg = 0; rg < 16; ++rg) { const float v = acc[2 * j + mt][rg]; ss += v * v; }
                ss = sum_x32(ss);
                const float rstd = rsqrtf(ss * (1.f / 64.f) + EPS) * sc;
                bf16_t* row = dst + ((long)((b * 8 + hd) * 2 + j) * SEQ + s) * 64;
                float qq = 0.f;
#pragma unroll
                for (int mt = 0; mt < 2; ++mt)
#pragma unroll
                    for (int g4 = 0; g4 < 4; ++g4) {
                        const int d0 = 32 * mt + 8 * g4 + 4 * h;
                        const f32x4 gv = *(const f32x4*)(gn + d0);
                        const float v0 = acc[2 * j + mt][4 * g4 + 0] * rstd * gv.x, v1 = acc[2 * j + mt][4 * g4 + 1] * rstd * gv.y;
                        const float v2 = acc[2 * j + mt][4 * g4 + 2] * rstd * gv.z, v3 = acc[2 * j + mt][4 * g4 + 3] * rstd * gv.w;
                        qq += v0 * v0 + v1 * v1 + v2 * v2 + v3 * v3;
                        u32x2 o;
                        o.x = pk2(v0, v1); o.y = pk2(v2, v3);
                        *(u32x2*)(row + d0) = o;
                    }
                if (sec == 0) {
                    qq = sum_x32(qq);
                    float kmx = 0.f;
                    for (int d = 0; d < 64; ++d) kmx = fmaxf(kmx, fabsf(kg[d]));
                    float bmx = 0.f;
                    for (int bk = 0; bk < 32; ++bk) bmx = fmaxf(bmx, relb[bk * 8 + hd] - relb[31 * 8 + hd]);
                    if (h == 0) MB[(long)((b * 8 + hd) * 2 + j) * SEQ + s] = 1.01f * sqrtf(qq) * 8.f * kmx + bmx * LOG2E;
                }
            }
        } else {
            bf16_t* base = VT + (long)(b * 8 + hd) * 128 * SEQ + s;
#pragma unroll
            for (int mt = 0; mt < 4; ++mt) store_vt_tile(base, SEQ, acc[mt], 32 * mt, h, tok);
        }
    }
};

struct EpiResid {
    const float* xin; float* xout; const float* gate;
    DI void operator()(const f32x16 (&acc)[4], int tok, int fbase, int h, unsigned char* lds, int tid) const {
        const int lane = tid & 63, w = tid >> 6, r = lane & 31, hh = lane >> 5;
        float* T = (float*)(lds + w * 16896);
#pragma unroll
        for (int mt = 0; mt < 4; ++mt)
#pragma unroll
            for (int g4 = 0; g4 < 4; ++g4)
                *(f32x4*)(T + r * 132 + 32 * mt + 8 * g4 + 4 * h) = (f32x4){acc[mt][4 * g4 + 0], acc[mt][4 * g4 + 1], acc[mt][4 * g4 + 2], acc[mt][4 * g4 + 3]};
        const int tok0 = tok - r, b = tok0 >> 13, f = fbase + 4 * r;
        const f32x4 gv = *(const f32x4*)(gate + b * ADA_STRIDE + f);
        __builtin_amdgcn_sched_barrier(0);
        const float* xp = xin + (long)(tok0 + hh) * DM + f;
        float* op = xout + (long)(tok0 + hh) * DM + f;
        const float* tp = T + hh * 132 + 4 * r;
#pragma unroll
        for (int i0 = 0; i0 < 16; i0 += 4) {
            f32x4 xv[4];
#pragma unroll
            for (int i = 0; i < 4; ++i) xv[i] = *(const f32x4*)(xp + (long)(2 * (i0 + i)) * DM);
#pragma unroll
            for (int i = 0; i < 4; ++i) {
                const f32x4 a = *(const f32x4*)(tp + 2 * (i0 + i) * 132);
                f32x4 o;
                o.x = xv[i].x + gv.x * a.x; o.y = xv[i].y + gv.y * a.y; o.z = xv[i].z + gv.z * a.z; o.w = xv[i].w + gv.w * a.w;
                *(f32x4*)(op + (long)(2 * (i0 + i)) * DM) = o;
            }
            __builtin_amdgcn_sched_barrier(0);
        }
        __syncthreads();
    }
};

struct EpiKV {
    bf16_t *KC, *KS, *VST, *KW, *VWT;
    const float* kgain;
    DI void operator()(const f32x16 (&acc)[4], int tok, int fbase, int h, unsigned char*, int) const {
        const int c = fbase >> 7, br = c >> 2, kv = (c >> 1) & 1, g = c & 1, b = tok >> 13, s = tok & (SEQ - 1);
        if (br == 0 || kv == 0) {
            float rstd = 1.f;
            bf16_t* row;
            if (br == 0) row = KC + ((long)((kv * 4 + b) * 2 + g) * SEQ + s) * 128;
            else {
                float ss = 0.f;
#pragma unroll
                for (int mt = 0; mt < 4; ++mt)
#pragma unroll
                    for (int rg = 0; rg < 16; ++rg) ss += acc[mt][rg] * acc[mt][rg];
                ss = sum_x32(ss);
                rstd = rsqrtf(ss * (1.f / 128.f) + EPS);
                row = (br == 1 ? KS : KW) + ((long)(b * 2 + g) * SEQ + s) * 128;
            }
#pragma unroll
            for (int mt = 0; mt < 4; ++mt)
#pragma unroll
                for (int g4 = 0; g4 < 4; ++g4) {
                    const int d0 = 32 * mt + 8 * g4 + 4 * h;
                    f32x4 gv = {1.f, 1.f, 1.f, 1.f};
                    if (br != 0) gv = *(const f32x4*)(kgain + br * 128 + d0);
                    u32x2 o;
                    o.x = pk2(acc[mt][4 * g4 + 0] * rstd * gv.x, acc[mt][4 * g4 + 1] * rstd * gv.y);
                    o.y = pk2(acc[mt][4 * g4 + 2] * rstd * gv.z, acc[mt][4 * g4 + 3] * rstd * gv.w);
                    *(u32x2*)(row + d0) = o;
                }
        } else {
            bf16_t* base = (br == 1 ? VST : VWT) + (long)(b * 2 + g) * 128 * SEQ + s;
#pragma unroll
            for (int mt = 0; mt < 4; ++mt) store_vt_tile(base, SEQ, acc[mt], 32 * mt, h, tok);
        }
    }
};

struct EpiCmp1 {
    bf16_t* hid; const float* posb_part; const float* b1;
    DI void operator()(const f32x16 (&acc)[4], int tok, int fbase, int h, unsigned char*, int) const {
        if (tok >= 512) return;
#pragma unroll
        for (int mt = 0; mt < 4; ++mt)
#pragma unroll
            for (int g4 = 0; g4 < 4; ++g4) {
                const int f = fbase + 32 * mt + 8 * g4 + 4 * h;
                f32x4 pb = *(const f32x4*)(b1 + f);
                for (int c = 0; c < 16; ++c) { const f32x4 t = *(const f32x4*)(posb_part + c * 256 + f); pb.x += t.x; pb.y += t.y; pb.z += t.z; pb.w += t.w; }
                u32x2 o;
                o.x = pk2(gelu_tanh(acc[mt][4 * g4 + 0] + pb.x), gelu_tanh(acc[mt][4 * g4 + 1] + pb.y));
                o.y = pk2(gelu_tanh(acc[mt][4 * g4 + 2] + pb.z), gelu_tanh(acc[mt][4 * g4 + 3] + pb.w));
                *(u32x2*)(hid + (long)tok * 256 + f) = o;
            }
    }
};

struct EpiCmp2 {
    bf16_t* dst; const float* kgain0; int kv;
    DI void operator()(const f32x16 (&acc)[4], int tok, int fbase, int h, unsigned char*, int) const {
        if (fbase != 0 || tok >= 512) return;
        const float valid = tok < 511 ? 1.f : 0.f;
        if (kv == 0) {
            float ss = 0.f;
#pragma unroll
            for (int mt = 0; mt < 4; ++mt)
#pragma unroll
                for (int rg = 0; rg < 16; ++rg) ss += acc[mt][rg] * acc[mt][rg];
            ss = sum_x32(ss);
            const float rstd = rsqrtf(ss * (1.f / 128.f) + EPS) * valid;
#pragma unroll
            for (int mt = 0; mt < 4; ++mt)
#pragma unroll
                for (int g4 = 0; g4 < 4; ++g4) {
                    const int d0 = 32 * mt + 8 * g4 + 4 * h;
                    const f32x4 gv = *(const f32x4*)(kgain0 + d0);
                    u32x2 o;
                    o.x = pk2(acc[mt][4 * g4 + 0] * rstd * gv.x, acc[mt][4 * g4 + 1] * rstd * gv.y);
                    o.y = pk2(acc[mt][4 * g4 + 2] * rstd * gv.z, acc[mt][4 * g4 + 3] * rstd * gv.w);
                    *(u32x2*)(dst + (long)tok * 128 + d0) = o;
                }
        } else {
#pragma unroll
            for (int mt = 0; mt < 4; ++mt)
#pragma unroll
                for (int rg = 0; rg < 16; ++rg) dst[(long)(32 * mt + crow(rg, h)) * 512 + tok] = f2bf(acc[mt][rg] * valid);
        }
    }
};

struct EpiNsaQ {
    bf16_t* QN; float* gates; const float* qgain; const float* bgate; float* qnrm;
    DI void operator()(const f32x16 (&acc)[4], int tok, int fbase, int h, unsigned char*, int) const {
        const int b = tok >> 13, s = tok & (SEQ - 1);
        if (fbase < 1024) {
            const int head = fbase >> 7;
            float ss = 0.f;
#pragma unroll
            for (int mt = 0; mt < 4; ++mt)
#pragma unroll
                for (int rg = 0; rg < 16; ++rg) ss += acc[mt][rg] * acc[mt][rg];
            ss = sum_x32(ss);
            const float rstd = rsqrtf(ss * (1.f / 128.f) + EPS) * (0.08838834764831845f * LOG2E);
            bf16_t* row = QN + ((long)(b * 8 + head) * SEQ + s) * 128;
            float qq = 0.f;
#pragma unroll
            for (int mt = 0; mt < 4; ++mt)
#pragma unroll
                for (int g4 = 0; g4 < 4; ++g4) {
                    const int d0 = 32 * mt + 8 * g4 + 4 * h;
                    const f32x4 gv = *(const f32x4*)(qgain + d0);
                    const float v0 = acc[mt][4 * g4 + 0] * rstd * gv.x, v1 = acc[mt][4 * g4 + 1] * rstd * gv.y;
                    const float v2 = acc[mt][4 * g4 + 2] * rstd * gv.z, v3 = acc[mt][4 * g4 + 3] * rstd * gv.w;
                    qq += v0 * v0 + v1 * v1 + v2 * v2 + v3 * v3;
                    u32x2 o;
                    o.x = pk2(v0, v1); o.y = pk2(v2, v3);
                    *(u32x2*)(row + d0) = o;
                }
            qq = sum_x32(qq);
            if (h == 0) qnrm[(long)tok * 8 + head] = 1.01f * sqrtf(qq);
        } else if (fbase == 1024) {
#pragma unroll
            for (int rg = 0; rg < 16; ++rg) {
                const int f = crow(rg, h);
                if (f < 24) { const float z = acc[0][rg] + bgate[f]; gates[(long)tok * 24 + f] = frcp(1.f + fexp2(-LOG2E * z)); }
            }
        }
    }
};

DI void ce_desc(unsigned& a, unsigned& b) { const unsigned hi = a > b ? a : b, lo = a > b ? b : a; a = hi; b = lo; }
DI void sort16_desc(unsigned (&a)[16]) {
#define CE_(i, j) ce_desc(a[i], a[j]);
    CE_(0,13) CE_(1,12) CE_(2,15) CE_(3,14) CE_(4,8) CE_(5,6) CE_(7,11) CE_(9,10)
    CE_(0,5) CE_(1,7) CE_(2,9) CE_(3,4) CE_(6,13) CE_(8,14) CE_(10,15) CE_(11,12)
    CE_(0,1) CE_(2,3) CE_(4,5) CE_(6,8) CE_(7,9) CE_(10,11) CE_(12,13) CE_(14,15)
    CE_(0,2) CE_(1,3) CE_(4,10) CE_(5,11) CE_(6,7) CE_(8,9) CE_(12,14) CE_(13,15)
    CE_(1,2) CE_(3,12) CE_(4,6) CE_(5,7) CE_(8,10) CE_(9,11) CE_(13,14)
    CE_(1,4) CE_(2,6) CE_(5,8) CE_(7,10) CE_(9,13) CE_(11,14)
    CE_(2,4) CE_(3,6) CE_(9,12) CE_(11,13)
    CE_(3,5) CE_(6,8) CE_(7,9) CE_(10,12)
    CE_(3,4) CE_(5,6) CE_(7,8) CE_(9,10) CE_(11,12)
    CE_(6,7) CE_(8,9)
#undef CE_
}
DI void bitonic_merge16_desc(unsigned (&a)[16]) {
#pragma unroll
    for (int st = 8; st >= 1; st >>= 1)
#pragma unroll
        for (int i = 0; i < 16; ++i)
            if ((i & st) == 0) ce_desc(a[i], a[i + st]);
}
DI void merge_top16(unsigned (&a)[16], const unsigned (&b)[16]) {
#pragma unroll
    for (int i = 0; i < 16; ++i) a[i] = a[i] > b[15 - i] ? a[i] : b[15 - i];
    bitonic_merge16_desc(a);
}

struct EpiPeer {
    static constexpr bool STASH = false;
    int* ridx; float* rgate; int ex_off;
    DI void operator()(const f32x16 (&acc)[4], int tok, int fbase, int h, unsigned char* lds, int tid) const {
        const int lane = tid & 63, w = tid >> 6, tg = w & 3, fh = w >> 2, r = lane & 31;
        const int hd = fbase >> 8;
        unsigned* EX = (unsigned*)(lds + ex_off);
        unsigned L[16];
        {
            unsigned G1[16], G2[16], G3[16];
#pragma unroll
            for (int rg = 0; rg < 16; ++rg) {
                const int c = crow(rg, h);
                L[rg] = (f2key(acc[0][rg]) & ~127u) | (unsigned)(127 - c);
                G1[rg] = (f2key(acc[1][rg]) & ~127u) | (unsigned)(127 - 32 - c);
                G2[rg] = (f2key(acc[2][rg]) & ~127u) | (unsigned)(127 - 64 - c);
                G3[rg] = (f2key(acc[3][rg]) & ~127u) | (unsigned)(127 - 96 - c);
            }
            sort16_desc(L); sort16_desc(G1); merge_top16(L, G1);
            sort16_desc(G2); sort16_desc(G3); merge_top16(G2, G3);
            merge_top16(L, G2);
        }
        {
            unsigned P[16];
#pragma unroll
            for (int i = 0; i < 16; ++i) P[i] = get_x32(L[i], h);
            merge_top16(L, P);
        }
        if (h == 0) {
#pragma unroll
            for (int i = 0; i < 16; i += 4) *(u32x4*)(EX + ((fh * 4 + tg) * 32 + r) * 16 + i) = (u32x4){L[i], L[i + 1], L[i + 2], L[i + 3]};
        }
        __syncthreads();
        float xf[4], ys[16];
        {
            const unsigned* l0 = EX + ((0 * 4 + tg) * 32 + r) * 16;
            const unsigned* l1 = EX + ((1 * 4 + tg) * 32 + r) * 16;
            const unsigned* px = h ? l1 : l0;
            const unsigned* py = h ? l0 : l1;
            const u32x4 a = *(const u32x4*)px;
            xf[0] = key2f(a.x & ~127u); xf[1] = key2f(a.y & ~127u); xf[2] = key2f(a.z & ~127u); xf[3] = key2f(a.w & ~127u);
            unsigned Y[16];
#pragma unroll
            for (int i = 0; i < 16; i += 4) { const u32x4 b2 = *(const u32x4*)(py + i); Y[i] = b2.x; Y[i + 1] = b2.y; Y[i + 2] = b2.z; Y[i + 3] = b2.w; }
#pragma unroll
            for (int k = 0; k < 15; ++k) ys[k] = key2f((h ? Y[k + 1] : Y[k]) & ~127u);
            ys[15] = key2f(Y[15] & ~127u);
        }
        auto pkey = [&](int i, int k) -> unsigned {
            const float fs = xf[i] + ys[k];
            const unsigned code = h ? (unsigned)((((k + 1) & 15) << 4) | i) : (unsigned)((i << 4) | k);
            return (f2key(fs) & ~255u) | (255u - code);
        };
        unsigned T[16], E[16];
#pragma unroll
        for (int k = 0; k < 16; ++k) T[k] = pkey(0, k);
        T[15] = h ? 0u : T[15];
#pragma unroll
        for (int k = 1; k <= 7; ++k) E[k - 1] = pkey(1, k);
#pragma unroll
        for (int k = 2; k <= 4; ++k) E[7 + k - 2] = pkey(2, k);
        E[10] = pkey(3, 3);
#pragma unroll
        for (int k = 11; k < 16; ++k) E[k] = 0u;
        sort16_desc(E);
        merge_top16(T, E);
        {
            unsigned P[16];
#pragma unroll
            for (int i = 0; i < 16; ++i) P[i] = get_x32(T[i], h);
            merge_top16(T, P);
        }
        float sc[16], sum = 0.f;
        const float mx = key2f(T[0] & ~255u);
#pragma unroll
        for (int k = 0; k < 16; ++k) { sc[k] = fexp2((key2f(T[k] & ~255u) - mx) * LOG2E); sum += sc[k]; }
        const float inv = frcp(sum);
        if (h == 0) {
            const unsigned* l0 = EX + ((0 * 4 + tg) * 32 + r) * 16;
            const unsigned* l1 = EX + ((1 * 4 + tg) * 32 + r) * 16;
#pragma unroll
            for (int k = 0; k < 16; ++k) {
                if ((k >> 3) != fh) continue;
                const unsigned code = 255u - (T[k] & 255u);
                const int i1 = 127 - (int)(l0[code >> 4] & 127u), i2 = 127 - (int)(l1[code & 15u] & 127u);
                ridx[(long)tok * 128 + hd * 16 + k] = i1 * 128 + i2;
                rgate[(long)tok * 128 + hd * 16 + k] = sc[k] * inv;
            }
        }
        __syncthreads();
    }
};

DI void p0_transpose_item(const float* __restrict__ W, int K, int N, bf16_t* __restrict__ WT, int item, int ntn, unsigned char* lds, int tid) {
    float* tile = (float*)lds;
    const int kb = item / ntn, nb = item % ntn, k0 = kb * 64, n0 = nb * 64;
    {
        const int nn = tid & 63, kk0 = tid >> 6;
#pragma unroll
        for (int i = 0; i < 8; ++i) { const int kk = kk0 + 8 * i; const int n = n0 + nn; tile[kk * 65 + nn] = n < N ? W[(long)(k0 + kk) * N + n] : 0.f; }
    }
    __syncthreads();
    {
        const int n = tid >> 3, c = tid & 7;
        const float* s = tile + (8 * c) * 65 + n;
        u32x4 o;
        o.x = pk2(s[0], s[65]); o.y = pk2(s[2 * 65], s[3 * 65]); o.z = pk2(s[4 * 65], s[5 * 65]); o.w = pk2(s[6 * 65], s[7 * 65]);
        *(u32x4*)(WT + (long)(n0 + n) * K + k0 + 8 * c) = o;
    }
    __syncthreads();
}

DI int pack_i8x4(float a, float b, float c, float d) {
    const int ia = __float2int_rn(a), ib = __float2int_rn(b), ic = __float2int_rn(c), id = __float2int_rn(d);
    return (ia & 255) | ((ib & 255) << 8) | ((ic & 255) << 16) | (id << 24);
}
DI void p0_fp8_item(const float* __restrict__ src, unsigned char* __restrict__ dst, float* __restrict__ sinv, bool sliced, int item, int tid) {
    const int lane = tid & 63, row = item * 8 + (tid >> 6);
    const float* rp = src + (long)row * 1024;
    f32x4 v[4]; float am = 0.f;
#pragma unroll
    for (int j = 0; j < 4; ++j) {
        v[j] = *(const f32x4*)(rp + 4 * lane + 256 * j);
        am = fmaxf(am, fmaxf(fmaxf(fabsf(v[j].x), fabsf(v[j].y)), fmaxf(fabsf(v[j].z), fabsf(v[j].w))));
    }
    am = wave_max(am);
    const float sc = sliced ? (am > 0.f ? exp2f(floorf(log2f(384.f / am))) : 1.f) : (am > 0.f ? 127.f / am : 1.f);
    if (lane == 0) sinv[row] = 1.f / sc;
#pragma unroll
    for (int j = 0; j < 4; ++j) {
        int pk = 0;
        if (sliced) {
            pk = __builtin_amdgcn_cvt_pk_fp8_f32(v[j].x * sc, v[j].y * sc, pk, false);
            pk = __builtin_amdgcn_cvt_pk_fp8_f32(v[j].z * sc, v[j].w * sc, pk, true);
        } else pk = pack_i8x4(v[j].x * sc, v[j].y * sc, v[j].z * sc, v[j].w * sc);
        const int col = 4 * lane + 256 * j;
        unsigned char* d = sliced ? dst + ((long)(col >> 7) * 16384 + row) * 128 + (col & 127) : dst + (long)row * 1024 + col;
        *(int*)d = pk;
    }
}

DI void p0_weff_item(const float* __restrict__ wq, const float* __restrict__ subk, bf16_t* __restrict__ WT, int item, unsigned char* lds, int tid) {
    const int layer = item >> 8, g = (item >> 4) & 15, ct = item & 15, p = g & 1, c0 = ct * 64;
    float* As = (float*)lds;
    float* Bs = As + 64 * 129;
    const float* wql = wq + (long)layer * 1024 * 2048;
    const float* sk = subk + ((long)layer * 2 + p) * 128 * 128;
    for (int e = tid; e < 64 * 128; e += NTHREADS) { const int c = e >> 7, d = e & 127; As[c * 129 + d] = wql[(long)(c0 + c) * 2048 + g * 128 + d]; }
    for (int e = tid; e < 128 * 128; e += NTHREADS) { const int k = e >> 7, d = e & 127; Bs[k * 129 + d] = sk[k * 128 + d]; }
    __syncthreads();
    const int lane = tid & 63, w = tid >> 6, ti = w & 3, tj = w >> 2, r = lane & 31, h = lane >> 5;
    f32x16 acc;
#pragma unroll
    for (int i = 0; i < 16; ++i) acc[i] = 0.f;
    const float* ap = Bs + (32 * ti + r) * 129 + h;
    const float* bp = As + (32 * tj + r) * 129 + h;
#pragma unroll 8
    for (int d = 0; d < 128; d += 2) acc = __builtin_amdgcn_mfma_f32_32x32x2f32(ap[d], bp[d], acc, 0, 0, 0);
    bf16_t* o = WT + ((long)layer * 2048 + g * 128 + 32 * ti) * 1024 + c0 + 32 * tj + r;
#pragma unroll
    for (int i = 0; i < 16; ++i) o[(long)crow(i, h) * 1024] = f2bf(acc[i]);
    __syncthreads();
}

DI void p0_posb_item(const float* __restrict__ pos, const float* __restrict__ w1, float* __restrict__ part, int item, unsigned char* lds, int tid) {
    const int kv = item >> 4, ch = item & 15;
    float* red = (float*)lds;
    const int j = tid & 255, half = tid >> 8;
    const float* pp = pos + (long)kv * 4096 + ch * 256 + half * 128;
    const float* ww = w1 + ((long)kv * 4096 + ch * 256 + half * 128) * 256 + j;
    float a = 0.f;
    for (int f = 0; f < 128; ++f) a += pp[f] * ww[(long)f * 256];
    red[half * 256 + j] = a;
    __syncthreads();
    if (tid < 256) part[(kv * 16 + ch) * 256 + tid] = red[tid] + red[256 + tid];
    __syncthreads();
}

DI void p0_ada_item(const Params& p, float* __restrict__ ada, int item, unsigned char* lds, int tid) {
    float* cact = (float*)lds;
    float* red = cact + 4096;
    const float* c = p.in[1];
    for (int e = tid; e < 4096; e += NTHREADS) { const float v = c[e]; cact[e] = v * frcp(1.f + fexp2(-LOG2E * v)); }
    __syncthreads();
    const int colg = item * 64;
    const float* W; const float* bias; int N, n0;
    if (colg < 6144) { W = p.in[3]; bias = p.in[4]; N = 6144; n0 = colg; }
    else if (colg < 12288) { W = p.in[3] + (long)1024 * 6144; bias = p.in[4] + 6144; N = 6144; n0 = colg - 6144; }
    else { W = p.in[14]; bias = p.in[15]; N = 2048; n0 = colg - 12288; }
    const int col = tid & 63, kg = tid >> 6;
    float a0 = 0.f, a1 = 0.f, a2 = 0.f, a3 = 0.f;
    const float* wp = W + (long)(kg * 128) * N + n0 + col;
#pragma unroll 8
    for (int k = 0; k < 128; ++k) {
        const float wv = wp[(long)k * N];
        const int kk = kg * 128 + k;
        a0 += cact[kk] * wv; a1 += cact[1024 + kk] * wv; a2 += cact[2048 + kk] * wv; a3 += cact[3072 + kk] * wv;
    }
    red[(kg * 4 + 0) * 64 + col] = a0; red[(kg * 4 + 1) * 64 + col] = a1; red[(kg * 4 + 2) * 64 + col] = a2; red[(kg * 4 + 3) * 64 + col] = a3;
    __syncthreads();
    if (tid < 256) {
        const int b = tid >> 6, cc = tid & 63;
        float s = bias[n0 + cc];
#pragma unroll
        for (int q = 0; q < 8; ++q) s += red[(q * 4 + b) * 64 + cc];
        ada[b * ADA_STRIDE + colg + cc] = s;
    }
    __syncthreads();
}

constexpr int P0_CONV = 8192, P0_TR_DIN = 768, P0_TR_DOUT = 256, P0_TR_KV = 384, P0_TR_NIN = 288, P0_TR_NOUT = 256, P0_TR_C1 = 512, P0_TR_C2 = 16,
              P0_WEFF = 512, P0_POSB = 32, P0_ADA = 224;
constexpr int P0_TOTAL = P0_CONV + P0_TR_DIN + P0_TR_DOUT + P0_TR_KV + P0_TR_NIN + P0_TR_NOUT + P0_TR_C1 + P0_TR_C2 + P0_WEFF + P0_POSB + P0_ADA;

DI void phase_prep(const Params& p, unsigned char* lds, int tid) {
    unsigned char* ws = p.ws;
    for (int it = blockIdx.x; it < P0_TOTAL; it += gridDim.x) {
        int r = it;
        if (r < P0_ADA) { p0_ada_item(p, (float*)(ws + OFF_ADA), r, lds, tid); continue; } r -= P0_ADA;
        if (r < P0_WEFF) { p0_weff_item(p.in[26], p.in[27], (bf16_t*)(ws + OFF_WT_PEER), r, lds, tid); continue; } r -= P0_WEFF;
        if (r < P0_POSB) { p0_posb_item(p.in[17], p.in[18], (float*)(ws + OFF_POSB), r, lds, tid); continue; } r -= P0_POSB;
        if (r < P0_TR_DIN) { p0_transpose_item(p.in[7], 1024, 3072, (bf16_t*)(ws + OFF_WT_DIN), r, 48, lds, tid); continue; } r -= P0_TR_DIN;
        if (r < P0_TR_DOUT) { p0_transpose_item(p.in[8], 1024, 1024, (bf16_t*)(ws + OFF_WT_DOUT), r, 16, lds, tid); continue; } r -= P0_TR_DOUT;
        if (r < P0_TR_KV) { p0_transpose_item(p.in[16], 1024, 1536, (bf16_t*)(ws + OFF_WT_KV), r, 24, lds, tid); continue; } r -= P0_TR_KV;
        if (r < P0_TR_NIN) { p0_transpose_item(p.in[22], 1024, 1048, (bf16_t*)(ws + OFF_WT_NIN), r, 18, lds, tid); continue; } r -= P0_TR_NIN;
        if (r < P0_TR_NOUT) { p0_transpose_item(p.in[24], 1024, 1024, (bf16_t*)(ws + OFF_WT_NOUT), r, 16, lds, tid); continue; } r -= P0_TR_NOUT;
        if (r < P0_TR_C1) { const int kv = r >> 8; p0_transpose_item(p.in[18] + (long)kv * 4096 * 256, 4096, 256, (bf16_t*)(ws + OFF_WT_C1) + (long)kv * 256 * 4096, r & 255, 4, lds, tid); continue; } r -= P0_TR_C1;
        if (r < P0_TR_C2) { const int kv = r >> 3; p0_transpose_item(p.in[20] + (long)kv * 256 * 128, 256, 128, (bf16_t*)(ws + OFF_WT_C2) + (long)kv * 128 * 256, r & 7, 2, lds, tid); continue; } r -= P0_TR_C2;
        {
            const int tbl = r >> 11, sub = r & 2047;
            const int layer = tbl & 1;
            const float* src = (tbl < 2 ? p.in[28] : p.in[29]) + (long)layer * 16384 * 1024;
            unsigned char* dst = ws + (tbl < 2 ? OFF_PU : OFF_PV) + (long)layer * 16384 * 1024;
            float* sinv = (float*)(ws + (tbl < 2 ? OFF_USI : OFF_VSI)) + layer * 16384;
            p0_fp8_item(src, dst, sinv, tbl >= 2, sub, tid);
        }
    }
}

DI void norm_row_write(const f32x4 (&v)[4], float rstd, const float* gain, const float* shift, const float* scale, bf16_t* orow, int lane) {
#pragma unroll
    for (int j = 0; j < 4; ++j) {
        const int c = 4 * lane + 256 * j;
        const f32x4 g = *(const f32x4*)(gain + c), sh = *(const f32x4*)(shift + c), sc = *(const f32x4*)(scale + c);
        u32x2 o;
        o.x = pk2(v[j].x * rstd * g.x * (1.f + sc.x) + sh.x, v[j].y * rstd * g.y * (1.f + sc.y) + sh.y);
        o.y = pk2(v[j].z * rstd * g.z * (1.f + sc.z) + sh.z, v[j].w * rstd * g.w * (1.f + sc.w) + sh.w);
        *(u32x2*)(orow + c) = o;
    }
}
template <bool BF>
DI void phase_norm_q8(const float* __restrict__ x, bf16_t* __restrict__ out, unsigned char* __restrict__ out8, float* __restrict__ outs,
                      const float* gain, const float* ada, int shift_off, int scale_off, int tid) {
    const int lane = tid & 63, gw = blockIdx.x * NWAVES + (tid >> 6), nw = gridDim.x * NWAVES;
    for (int tok = gw; tok < NTOK; tok += nw) {
        const int b = tok >> 13;
        f32x4 v[4]; float ss = 0.f;
#pragma unroll
        for (int j = 0; j < 4; ++j) { v[j] = *(const f32x4*)(x + (long)tok * DM + 4 * lane + 256 * j); ss += v[j].x * v[j].x + v[j].y * v[j].y + v[j].z * v[j].z + v[j].w * v[j].w; }
        const float rstd = rsqrtf(wave_sum(ss) * (1.f / DM) + EPS);
        const float* shift = ada + b * ADA_STRIDE + shift_off; const float* scale = ada + b * ADA_STRIDE + scale_off;
        float am = 0.f;
#pragma unroll
        for (int j = 0; j < 4; ++j) {
            const int c = 4 * lane + 256 * j;
            const f32x4 g = *(const f32x4*)(gain + c), sh = *(const f32x4*)(shift + c), sc = *(const f32x4*)(scale + c);
            v[j].x = v[j].x * rstd * g.x * (1.f + sc.x) + sh.x; v[j].y = v[j].y * rstd * g.y * (1.f + sc.y) + sh.y;
            v[j].z = v[j].z * rstd * g.z * (1.f + sc.z) + sh.z; v[j].w = v[j].w * rstd * g.w * (1.f + sc.w) + sh.w;
            if constexpr (BF) { u32x2 o; o.x = pk2(v[j].x, v[j].y); o.y = pk2(v[j].z, v[j].w); *(u32x2*)(out + (long)tok * DM + c) = o; }
            am = fmaxf(am, fmaxf(fmaxf(fabsf(v[j].x), fabsf(v[j].y)), fmaxf(fabsf(v[j].z), fabsf(v[j].w))));
        }
        am = wave_max(am);
        const float qs = am > 0.f ? 127.f / am : 1.f;
#pragma unroll
        for (int j = 0; j < 4; ++j) *(int*)(out8 + (long)tok * DM + 4 * lane + 256 * j) = pack_i8x4(v[j].x * qs, v[j].y * qs, v[j].z * qs, v[j].w * qs);
        if (lane == 0) outs[tok] = am > 0.f ? am * (1.f / 127.f) : 1.f;
    }
}
DI void phase_norm(const float* __restrict__ x, bf16_t* __restrict__ out, const float* gain, const float* ada, int shift_off, int scale_off, int tid) {
    const int lane = tid & 63, gw = blockIdx.x * NWAVES + (tid >> 6), nw = gridDim.x * NWAVES;
    for (int tok = gw; tok < NTOK; tok += nw) {
        const int b = tok >> 13;
        f32x4 v[4]; float ss = 0.f;
#pragma unroll
        for (int j = 0; j < 4; ++j) { v[j] = *(const f32x4*)(x + (long)tok * DM + 4 * lane + 256 * j); ss += v[j].x * v[j].x + v[j].y * v[j].y + v[j].z * v[j].z + v[j].w * v[j].w; }
        const float rstd = rsqrtf(wave_sum(ss) * (1.f / DM) + EPS);
        norm_row_write(v, rstd, gain, ada + b * ADA_STRIDE + shift_off, ada + b * ADA_STRIDE + scale_off, out + (long)tok * DM, lane);
    }
}

DI int kidx(int mt, int i) { return 32 * mt + 16 * (i >> 3) + (i & 7); }
template <int DQK>
DI void attn_qk32(const unsigned char* Ks, const bf16x8 (&qf)[DQK / 16], f32x16& st, int mt, int r, int h, float init = 0.f) {
    constexpr int RB = DQK * 2, MSK = DQK == 64 ? 7 : 15;
    const int row = 32 * mt + ((r & 0x13) | ((r & 4) << 1) | ((r & 8) >> 1));
#pragma unroll
    for (int i = 0; i < 16; ++i) st[i] = init;
#pragma unroll
    for (int ks = 0; ks < DQK / 16; ++ks) {
        const bf16x8 kf = RB == 128 ? *(const bf16x8*)(Ks + sw2(row, 2 * ks + h)) : *(const bf16x8*)(Ks + row * RB + (((2 * ks + h) ^ (row & MSK)) << 4));
        st = MFMA32(kf, qf[ks], st);
    }
}
DI void attn_pack32(const f32x16& st, bf16x8 (&pf)[2]) {
#pragma unroll
    for (int s = 0; s < 2; ++s) {
        u32x4 t;
        t.x = pk2(st[8 * s + 0], st[8 * s + 1]); t.y = pk2(st[8 * s + 2], st[8 * s + 3]);
        t.z = pk2(st[8 * s + 4], st[8 * s + 5]); t.w = pk2(st[8 * s + 6], st[8 * s + 7]);
        pf[s] = __builtin_bit_cast(bf16x8, t);
    }
}
DI void attn_softmax32(f32x16& st, float& m, float& l, f32x16 (&o)[4]) {
    float mx = st[0];
#pragma unroll
    for (int i = 1; i < 16; ++i) mx = fmaxf(mx, st[i]);
    mx = max_x32(mx);
    const float mn = fmaxf(m, mx);
    if (!__all(mn == m)) {
        const float alpha = fexp2(m - mn);
        l *= alpha;
#pragma unroll
        for (int dt = 0; dt < 4; ++dt)
#pragma unroll
            for (int i = 0; i < 16; ++i) o[dt][i] *= alpha;
        m = mn;
    }
    float sum = 0.f;
#pragma unroll
    for (int i = 0; i < 16; ++i) { const float pv = fexp2(st[i] - m); st[i] = pv; sum += pv; }
    l += sum;
}
DI void attn_softmax32_b(f32x16& st, float& l) {
    float sum = 0.f;
#pragma unroll
    for (int i = 0; i < 16; ++i) { const float pv = fexp2(st[i]); st[i] = pv; sum += pv; }
    l += sum;
}
DI void attn_pv32(const unsigned char* Vs, const bf16x8 (&pf)[2], f32x16 (&o)[4], int mt, int r, int h) {
#pragma unroll
    for (int dt = 0; dt < 4; ++dt)
#pragma unroll
        for (int s2 = 0; s2 < 2; ++s2) {
            const int row = 32 * dt + r;
            const bf16x8 vf = *(const bf16x8*)(Vs + sw2(row, 2 * (2 * mt + s2) + h));
            o[dt] = MFMA32(vf, pf[s2], o[dt]);
        }
}
template <int RB, int NROWS>
DI void dma_offsets(unsigned (&off)[NROWS * RB / 16 / 512], unsigned gstride, int tid) {
    constexpr int CPR = RB / 16;
#pragma unroll
    for (int i = 0; i < NROWS * CPR / 512; ++i) {
        const int idx = tid + 512 * i;
        int row, cp;
        if (RB == 128) sw2_src(idx, row, cp); else { row = idx / CPR; cp = (idx % CPR) ^ (row & (CPR - 1)); }
        off[i] = (unsigned)row * gstride + (cp << 4);
    }
}
template <int N>
DI void dma_issue(unsigned char* dst, const unsigned char* gbase, const unsigned (&off)[N], int tid) {
    const int wbase = tid & ~63;
#pragma unroll
    for (int i = 0; i < N; ++i)
        __builtin_amdgcn_global_load_lds((const unsigned*)(gbase + off[i]), (unsigned*)(dst + (wbase + 512 * i) * 16), 16, 0, 0);
}

constexpr int AT_STAGE = 32 * 1024;
constexpr int AT_LUT = 2 * AT_STAGE;
constexpr int LUT_N = 1280, LUT_OFF = 1100;
constexpr int LUTC_W = 52;
constexpr int AT_LUTC = AT_LUT + 20 * 1024;
constexpr int AT_IMP = AT_LUTC + 13 * 1024;
constexpr int AT_SEL = AT_IMP + 34 * 1024;

DI void phase_diff_attn(const Params& p, unsigned char* lds, int tid) {
    unsigned char* ws = p.ws;
    const bf16_t* Q = (const bf16_t*)(ws + OFF_Q0);
    const bf16_t* Kk = (const bf16_t*)(ws + OFF_K0);
    const bf16_t* VT = (const bf16_t*)(ws + OFF_VT0);
    bf16_t* O = (bf16_t*)(ws + OFF_H);
    const float* relb = p.in[2];
    const float* lam = p.in[9];
    const float* subln = p.in[12];
    const int lane = tid & 63, w = tid >> 6, comp = w & 1, qg = w >> 1, r = lane & 31, h = lane >> 5;
    float* lut = (float*)(lds + 128 * 1024);
    if (w >= 4) __builtin_amdgcn_s_setprio(1);
    float lam_full;
    {
        const float s01 = wave_sum(lam[lane] * lam[64 + lane]), s23 = wave_sum(lam[128 + lane] * lam[192 + lane]);
        lam_full = __expf(s01) - __expf(s23) + 0.2f;
    }
    const int G = gridDim.x, rows_per_it = G >> 5;
    unsigned koff[1], voff[2];
    dma_offsets<128, 64>(koff, 128, tid);
    dma_offsets<128, 128>(voff, SEQ * 2, tid);
    constexpr int ST2 = 64 * 1024;
    for (int it = 0;; ++it) {
        int qb, b, hd;
        if (G == 256) {
            if (it >= 8) break;
            const int xcd = blockIdx.x & 7, lb = blockIdx.x >> 3, pr = xcd * 4 + (it >> 1);
            qb = (it & 1) ? lb : 63 - lb; b = pr >> 3; hd = pr & 7;
        } else {
            int u;
            if ((G & 31) == 0) {
                const int rr = blockIdx.x >> 5, cc = blockIdx.x & 31;
                const int rowi = it * rows_per_it + ((it & 1) ? rows_per_it - 1 - rr : rr);
                u = rowi * 32 + cc;
            } else u = it * G + blockIdx.x;
            if (u >= 2048) break;
            qb = 63 - (u >> 5); b = (u & 31) >> 3; hd = u & 7;
        }
        const int q0 = qb * 128, ntiles = qb + 1;
        const int qpos = q0 + 32 * qg + r, qlo = q0 + 32 * qg, qhi = qlo + 31;
        for (int e = tid; e < LUT_N; e += NTHREADS) { const int d = LUT_OFF - e; lut[e] = d < 0 ? -INFINITY : (d >= 790 ? 0.f : (relb[rel_bucket_i(d) * 8 + hd] - relb[31 * 8 + hd]) * LOG2E); }
        bf16x8 qf[4];
        {
            const bf16_t* qrow = Q + ((long)((b * 8 + hd) * 2 + comp) * SEQ + qpos) * 64;
#pragma unroll
            for (int ks = 0; ks < 4; ++ks) qf[ks] = *(const bf16x8*)(qrow + 16 * ks + 8 * h);
        }
        const unsigned char* k0g = (const unsigned char*)(Kk + (long)((b * 8 + hd) * 2 + 0) * SEQ * 64);
        const unsigned char* k1g = (const unsigned char*)(Kk + (long)((b * 8 + hd) * 2 + 1) * SEQ * 64);
        const unsigned char* vtg = (const unsigned char*)(VT + (long)(b * 8 + hd) * 128 * SEQ);
        f32x16 o[4];
#pragma unroll
        for (int dt = 0; dt < 4; ++dt)
#pragma unroll
            for (int i = 0; i < 16; ++i) o[dt][i] = 0.f;
        float l = 0.f;
        const float nmb = -((const float*)(ws + OFF_MB0))[(long)((b * 8 + hd) * 2 + comp) * SEQ + qpos];
        auto stage = [&](int kt, unsigned char* st) {
#pragma unroll
            for (int sb = 0; sb < 2; ++sb) {
                dma_issue(st + sb * 8192, k0g + (long)(2 * kt + sb) * 8192, koff, tid);
                dma_issue(st + 16384 + sb * 8192, k1g + (long)(2 * kt + sb) * 8192, koff, tid);
                dma_issue(st + 32768 + sb * 16384, vtg + (long)(2 * kt + sb) * 128, voff, tid);
            }
        };
        stage(0, lds);
        __syncthreads();
        for (int kt = 0; kt < ntiles; ++kt) {
            unsigned char* cur = lds + (kt & 1) * ST2;
            if (kt + 1 < ntiles) stage(kt + 1, lds + ((kt + 1) & 1) * ST2);
            const bool nearb = qlo - (kt * 128 + 127) < 790;
            const int dbase0 = qpos - kt * 128 - 8 * h;
            const unsigned char* kb = cur + comp * 16384;
            f32x16 sa, sbv;
            attn_qk32<64>(kb, qf, sa, 0, r, h, nmb);
#pragma unroll
            for (int j = 0; j < 4; ++j) {
                f32x16& sc = (j & 1) ? sbv : sa;
                f32x16& sn = (j & 1) ? sa : sbv;
                if (j < 3) attn_qk32<64>(kb + ((j + 1) >> 1) * 8192, qf, sn, (j + 1) & 1, r, h, nmb);
                if (nearb) {
                    const float* lp = lut + (LUT_OFF - dbase0 + 64 * (j >> 1));
#pragma unroll
                    for (int i = 0; i < 16; ++i) sc[i] += lp[kidx(j & 1, i)];
                }
                attn_softmax32_b(sc, l);
                bf16x8 pf[2];
                attn_pack32(sc, pf);
                attn_pv32(cur + 32768 + (j >> 1) * 16384, pf, o, j & 1, r, h);
            }
            __syncthreads();
        }
        l = sum_x32(l);
        const float inv = l > 0.f ? frcp(l) : 0.f;
        float* xch = (float*)lds + qg * 4096;
        if (comp == 1) {
            const float sc = inv * lam_full;
#pragma unroll
            for (int dt = 0; dt < 4; ++dt)
#pragma unroll
                for (int i = 0; i < 16; ++i) xch[(dt * 16 + i) * 64 + lane] = o[dt][i] * sc;
        }
        __syncthreads();
        if (comp == 0) {
            float ss = 0.f;
#pragma unroll
            for (int dt = 0; dt < 4; ++dt)
#pragma unroll
                for (int i = 0; i < 16; ++i) { const float v = o[dt][i] * inv - xch[(dt * 16 + i) * 64 + lane]; o[dt][i] = v; ss += v * v; }
            ss = sum_x32(ss);
            const float rstd = rsqrtf(ss * (1.f / 128.f) + EPS) * 0.8f;
            bf16_t* orow = O + (long)(b * SEQ + qpos) * DM + hd * 128;
#pragma unroll
            for (int dt = 0; dt < 4; ++dt)
#pragma unroll
                for (int g4 = 0; g4 < 4; ++g4) {
                    const int d0 = 32 * dt + 8 * g4 + 4 * h;
                    const f32x4 gv = *(const f32x4*)(subln + d0);
                    u32x2 ov;
                    ov.x = pk2(o[dt][4 * g4 + 0] * rstd * gv.x, o[dt][4 * g4 + 1] * rstd * gv.y);
                    ov.y = pk2(o[dt][4 * g4 + 2] * rstd * gv.z, o[dt][4 * g4 + 3] * rstd * gv.w);
                    *(u32x2*)(orow + d0) = ov;
                }
        }
        __syncthreads();
    }
}

template <int VAR>
DI void phase_nsa_attn(const Params& p, unsigned char* lds, int tid) {
    unsigned char* ws = p.ws;
    const bf16_t* QN = (const bf16_t*)(ws + OFF_QN);
    const bf16_t* KS = (const bf16_t*)(ws + OFF_KS);
    const bf16_t* VST = (const bf16_t*)(ws + OFF_VST);
    const bf16_t* KW = (const bf16_t*)(ws + OFF_KW);
    const bf16_t* VWT = (const bf16_t*)(ws + OFF_VWT);
    const bf16_t* KCMP = (const bf16_t*)(ws + OFF_KCMP);
    const bf16_t* VCMPT = (const bf16_t*)(ws + OFF_VCMPT);
    const float* gates = (const float*)(ws + OFF_GATES);
    bf16_t* O = VAR ? (bf16_t*)(ws + OFF_PU + 32 * MB) : (bf16_t*)(ws + OFF_H);
    const float* relb = p.in[2];
    const int lane = tid & 63, w = tid >> 6, hg = w >> 1, th = w & 1, r = lane & 31, h = lane >> 5;
    float* lut = (float*)(lds + AT_LUT);
    float* lutc = (float*)(lds + AT_LUTC);
    float* imp = (float*)(lds + AT_IMP);
    unsigned* selw = (unsigned*)(lds + AT_SEL);
    unsigned short* sel16 = (unsigned short*)selw;
    float* bmxs = (float*)(selw + 264);
    const float* qnrm = (const float*)(ws + OFF_MB1);
    float kmx[3];
    for (int br = 0; br < 3; ++br) kmx[br] = wave_max(fmaxf(fabsf(p.in[21][br * 128 + lane]), fabsf(p.in[21][br * 128 + 64 + lane]))) * 11.313708498984761f;
    const int G = gridDim.x, rows_per_it = G >> 3;
    int lut_g = -1;
    for (int it = 0;; ++it) {
        int u;
        if ((G & 7) == 0) {
            const int rr = blockIdx.x >> 3, cc = blockIdx.x & 7;
            const int rowi = it * rows_per_it + ((it & 1) ? rows_per_it - 1 - rr : rr);
            u = rowi * 8 + cc;
        } else u = it * G + blockIdx.x;
        if (u >= 1024) break;
        const int bi = 127 - (u >> 3), b = (u & 7) >> 1, g = u & 1, head = 4 * g + hg;
        const int tq = 64 * bi + 32 * th + r;
        const int tl = 32 * th + r;
        const long tok = (long)b * SEQ + tq;
        if (g != lut_g) {
            lut_g = g;
            if (tid < 128) {
                const int hh = tid >> 5, bk = tid & 31;
                float bm = fmaxf(0.f, relb[bk * 8 + 4 * g + hh] - relb[31 * 8 + 4 * g + hh]);
                bm = fmaxf(bm, lx1(bm)); bm = fmaxf(bm, lx2(bm)); bm = fmaxf(bm, lhm(bm)); bm = fmaxf(bm, lr8(bm)); bm = max_x16(bm);
                if (bk == 0) bmxs[hh] = bm * LOG2E;
            }
            for (int e = tid; e < 4 * LUT_N; e += NTHREADS) { const int hh = e / LUT_N, d = LUT_OFF - (e % LUT_N); lut[e] = d < 0 ? -INFINITY : (d >= 790 ? 0.f : (relb[rel_bucket_i(d) * 8 + 4 * g + hh] - relb[31 * 8 + 4 * g + hh]) * LOG2E); }
            for (int e = tid; e < 4 * 16 * LUTC_W; e += NTHREADS) {
                const int hh = e / (16 * LUTC_W), ph = (e / LUTC_W) & 15, ci = e % LUTC_W, d = 16 * (ci - 1) + ph;
                lutc[e] = ci == 0 ? -INFINITY : (d >= 790 ? 0.f : (relb[rel_bucket_i(d) * 8 + 4 * g + hh] - relb[31 * 8 + 4 * g + hh]) * LOG2E);
            }
        }
        if (tid < 4) selw[256 + tid] = 0u;
        const float* mylut = lut + hg * LUT_N;
        bf16x8 qf[8];
        const bf16_t* qrow = QN + ((long)(b * 8 + head) * SEQ + tq) * 128 + 8 * h;
        auto load_q = [&](const bf16_t* qr) {
#pragma unroll
            for (int ks = 0; ks < 8; ++ks) qf[ks] = *(const bf16x8*)(qr + 16 * ks);
        };
        const float* gp = gates + tok * 24 + head * 3;
        bf16_t* orow = O + (VAR ? (tok & 16383) : tok) * DM + head * 128;
        auto stage = [&](const unsigned char* kg, const unsigned char* vg, unsigned vstride, int kt, unsigned char* st) {
            int t2 = tid; asm volatile("" : "+v"(t2));
            unsigned koff[2], vo[2];
            dma_offsets<256, 64>(koff, 256, t2);
            dma_offsets<128, 128>(vo, vstride, t2);
            dma_issue(st, kg + (long)kt * 16384, koff, t2);
            dma_issue(st + 16384, vg + (long)kt * 128, vo, t2);
        };
        f32x16 o[4];
        float l;
        auto reset = [&]() {
#pragma unroll
            for (int dt = 0; dt < 4; ++dt)
#pragma unroll
                for (int i = 0; i < 16; ++i) o[dt][i] = 0.f;
            l = 0.f;
        };
        const unsigned char* kcg = (const unsigned char*)(KCMP + (long)(b * 2 + g) * 512 * 128);
        const unsigned char* vcg = (const unsigned char*)(VCMPT + (long)(b * 2 + g) * 128 * 512);
        const int nct = ((4 * bi + 2) >> 6) + 1;
        const int hgc = r & 3, tlc = 8 * w + (r >> 2), tqc = 64 * bi + tlc;
        const long tokc = (long)b * SEQ + tqc;
        reset();
        load_q(QN + ((long)(b * 8 + 4 * g + hgc) * SEQ + tqc) * 128 + 8 * h);
        __syncthreads();
        if (VAR != 3) {
            const int cb = (tqc - 31) >> 4;
            const float* lc = lutc + (hgc * 16 + ((tqc - 31) & 15)) * LUTC_W + 1;
            const float nmb = -(qnrm[tokc * 8 + 4 * g + hgc] * kmx[0] + bmxs[hgc]);
            stage(kcg, vcg, 1024u, 0, lds);
            __syncthreads();
            for (int kt = 0; kt < nct; ++kt) {
                unsigned char* cur = lds + (kt & 1) * AT_STAGE;
                if (kt + 1 < nct) stage(kcg, vcg, 1024u, kt + 1, lds + ((kt + 1) & 1) * AT_STAGE);
                const int cbase = cb - kt * 64 - 8 * h;
#pragma unroll
                for (int mt = 0; mt < 2; ++mt) {
                    f32x16 st;
                    attn_qk32<128>(cur, qf, st, mt, r, h, nmb);
                    float sum = 0.f;
#pragma unroll
                    for (int i = 0; i < 16; ++i) {
                        const int c = cbase - kidx(mt, i);
                        sum += fexp2(st[i] + lc[c < -1 ? -1 : (c > 50 ? 50 : c)]);
                    }
                    l += sum;
                }
                __syncthreads();
            }
            const float lt = sum_x32(l);
            const float invl = lt > 0.f ? frcp(lt) : 0.f;
            stage(kcg, vcg, 1024u, 0, lds);
            __syncthreads();
            float carry = 0.f;
            for (int kt = 0; kt < nct; ++kt) {
                unsigned char* cur = lds + (kt & 1) * AT_STAGE;
                if (kt + 1 < nct) stage(kcg, vcg, 1024u, kt + 1, lds + ((kt + 1) & 1) * AT_STAGE);
                const int cbase = cb - kt * 64 - 8 * h;
                float o0[4], o1[4], sp[4];
#pragma unroll
                for (int mt = 0; mt < 2; ++mt) {
                    f32x16 st;
                    attn_qk32<128>(cur, qf, st, mt, r, h, nmb);
#pragma unroll
                    for (int i = 0; i < 16; ++i) {
                        const int c = cbase - kidx(mt, i);
                        st[i] = fexp2(st[i] + lc[c < -1 ? -1 : (c > 50 ? 50 : c)]) * invl;
                    }
#pragma unroll
                    for (int gq = 0; gq < 2; ++gq) {
                        const int G2 = 2 * mt + gq, q0 = 2 * gq, q1 = 2 * gq + 1;
                        const float c20 = 0.5f * st[4 * q0 + 3];
                        o0[G2] = st[4 * q0] + st[4 * q0 + 1] + st[4 * q0 + 2] + c20;
                        o1[G2] = st[4 * q1] + st[4 * q1 + 1] + st[4 * q1 + 2] + 0.5f * st[4 * q1 + 3] + c20;
                        sp[G2] = 0.5f * st[4 * q1 + 3];
                    }
                    bf16x8 pf[2];
                    attn_pack32(st, pf);
                    attn_pv32(cur + 16384, pf, o, mt, r, h);
                }
                float rc[4];
#pragma unroll
                for (int G2 = 0; G2 < 4; ++G2) rc[G2] = __uint_as_float(get_x32(__float_as_uint(sp[G2]), h));
                if (h) {
#pragma unroll
                    for (int G2 = 0; G2 < 4; ++G2) o0[G2] += rc[G2];
                } else {
                    o0[0] += carry; o0[1] += rc[0]; o0[2] += rc[1]; o0[3] += rc[2];
                    carry = rc[3];
                }
#pragma unroll
                for (int G2 = 0; G2 < 4; ++G2) {
                    float a0 = o0[G2], a1 = o1[G2];
                    a0 += lx1(a0); a0 += lx2(a0); a1 += lx1(a1); a1 += lx2(a1);
                    if (hgc == 0) *(f32x2*)(imp + tlc * 130 + kt * 16 + 4 * G2 + 2 * h) = (f32x2){a0, a1};
                }
                __syncthreads();
            }
        }
        {
            const float g_c = gates[tokc * 24 + (4 * g + hgc) * 3];
            bf16_t* orc = O + (VAR ? (tokc & 16383) : tokc) * DM + (4 * g + hgc) * 128;
#pragma unroll
            for (int dt = 0; dt < 4; ++dt)
#pragma unroll
                for (int g4 = 0; g4 < 4; ++g4) {
                    const int d0 = 32 * dt + 8 * g4 + 4 * h;
                    u32x2 ov;
                    ov.x = pk2(o[dt][4 * g4 + 0] * g_c, o[dt][4 * g4 + 1] * g_c);
                    ov.y = pk2(o[dt][4 * g4 + 2] * g_c, o[dt][4 * g4 + 3] * g_c);
                    *(u32x2*)(orc + d0) = ov;
                }
        }
        if (VAR != 5) {
            const int tkn = tid >> 3, part = tid & 7;
            unsigned key[16];
#pragma unroll
            for (int q = 0; q < 16; ++q) {
                const int j = part * 16 + q;
                float v = imp[tkn * 130 + j];
                const int back = bi - j;
                if (j == 0 || (back >= 0 && back < 2)) v = 1e9f;
                if (back < 0) v = -1e30f;
                key[q] = f2key(v);
            }
            unsigned srt[16];
#pragma unroll
            for (int q = 0; q < 16; ++q) { key[q] = (key[q] & ~127u) | (unsigned)(127 - (part * 16 + q)); srt[q] = key[q]; }
            sort16_desc(srt);
            {
                unsigned pr[16];
#pragma unroll
                for (int q = 0; q < 16; ++q) pr[q] = (unsigned)__builtin_amdgcn_update_dpp(0, (int)srt[q], 0xB1, 0xF, 0xF, true);
                merge_top16(srt, pr);
#pragma unroll
                for (int q = 0; q < 16; ++q) pr[q] = (unsigned)__builtin_amdgcn_update_dpp(0, (int)srt[q], 0x4E, 0xF, 0xF, true);
                merge_top16(srt, pr);
#pragma unroll
                for (int q = 0; q < 16; ++q) pr[q] = (unsigned)__builtin_amdgcn_update_dpp(0, (int)srt[q], 0x141, 0xF, 0xF, true);
                merge_top16(srt, pr);
            }
            const unsigned T16 = srt[15];
            unsigned bits = 0;
#pragma unroll
            for (int q = 0; q < 16; ++q) bits |= (key[q] >= T16 && key[q] >= 0x80000000u) ? (1u << q) : 0u;
            sel16[tkn * 8 + part] = (unsigned short)bits;
            atomicOr(&selw[256 + (part >> 1)], bits << ((part & 1) * 16));
        }
        __syncthreads();
        const unsigned un0 = selw[256], un1 = selw[257], un2 = selw[258], un3 = selw[259];
        const unsigned char* ksg = (const unsigned char*)(KS + (long)(b * 2 + g) * SEQ * 128);
        const unsigned char* vsg = (const unsigned char*)(VST + (long)(b * 2 + g) * 128 * SEQ);
        reset(); load_q(qrow);
        const float qn_main = qnrm[tok * 8 + head];
        {
            const float nmb = -(qn_main * kmx[1] + bmxs[hg]);
            const unsigned long long ulo = ((unsigned long long)(unsigned)__builtin_amdgcn_readfirstlane((int)un1) << 32) | (unsigned)__builtin_amdgcn_readfirstlane((int)un0);
            const unsigned long long uhi = ((unsigned long long)(unsigned)__builtin_amdgcn_readfirstlane((int)un3) << 32) | (unsigned)__builtin_amdgcn_readfirstlane((int)un2);
            auto next_tile = [&](int from) -> int {
                if (from < 64) { const unsigned long long mk = ulo >> from; if (mk) return from + __builtin_ctzll(mk); from = 64; }
                if (from < 128) { const unsigned long long mk = uhi >> (from - 64); if (mk) return from + __builtin_ctzll(mk); }
                return 128;
            };
            int jt = (VAR == 1 || VAR == 4 || VAR == 5) ? 128 : next_tile(0);
            int buf = 0;
            if (jt < 128) stage(ksg, vsg, SEQ * 2u, jt, lds);
            __syncthreads();
            while (jt < 128) {
                unsigned char* cur = lds + buf * AT_STAGE;
                const int jn = next_tile(jt + 1);
                if (jn < 128) stage(ksg, vsg, SEQ * 2u, jn, lds + (buf ^ 1) * AT_STAGE);
                const unsigned wd = selw[tl * 4 + (jt >> 5)];
                const bool mysel = (wd >> (jt & 31)) & 1u;
                if (__any(mysel)) {
                    const int k0 = jt * 64;
                    const bool nearb = (64 * bi + 32 * th) - (k0 + 63) < 790;
                    const int dbase = tq - k0 - 8 * h;
                    const float* lp = mylut + (LUT_OFF - dbase);
#pragma unroll
                    for (int mt = 0; mt < 2; ++mt) {
                        f32x16 st;
                        attn_qk32<128>(cur, qf, st, mt, r, h, mysel ? nmb : -INFINITY);
                        if (nearb) {
#pragma unroll
                            for (int i = 0; i < 16; ++i) st[i] += lp[kidx(mt, i)];
                        }
                        attn_softmax32_b(st, l);
                        bf16x8 pf[2];
                        attn_pack32(st, pf);
                        attn_pv32(cur + 16384, pf, o, mt, r, h);
                    }
                }
                __syncthreads();
                buf ^= 1; jt = jn;
            }
        }
        {
            const float lt = sum_x32(l);
            const float sc = (lt > 0.f ? frcp(lt) : 0.f) * gp[1];
#pragma unroll
            for (int dt = 0; dt < 4; ++dt)
#pragma unroll
                for (int g4 = 0; g4 < 4; ++g4) {
                    const int d0 = 32 * dt + 8 * g4 + 4 * h;
                    const u32x2 pv = *(const u32x2*)(orow + d0);
                    u32x2 ov;
                    ov.x = pk2(bflo(pv.x) + o[dt][4 * g4 + 0] * sc, bfhi(pv.x) + o[dt][4 * g4 + 1] * sc);
                    ov.y = pk2(bflo(pv.y) + o[dt][4 * g4 + 2] * sc, bfhi(pv.y) + o[dt][4 * g4 + 3] * sc);
                    *(u32x2*)(orow + d0) = ov;
                }
        }
        const unsigned char* kwg = (const unsigned char*)(KW + (long)(b * 2 + g) * SEQ * 128);
        const unsigned char* vwg = (const unsigned char*)(VWT + (long)(b * 2 + g) * 128 * SEQ);
        reset(); load_q(qrow);
        {
            const float nmb = -(qn_main * kmx[2] + bmxs[hg]);
            const int j0 = bi >= 8 ? bi - 8 : 0, nt = (VAR == 2 || VAR == 4 || VAR == 5) ? 1 : bi - j0 + 1;
            stage(kwg, vwg, SEQ * 2u, j0, lds);
            __syncthreads();
            for (int kt = 0; kt < nt; ++kt) {
                unsigned char* cur = lds + (kt & 1) * AT_STAGE;
                if (kt + 1 < nt) stage(kwg, vwg, SEQ * 2u, j0 + kt + 1, lds + ((kt + 1) & 1) * AT_STAGE);
                const int k0 = (j0 + kt) * 64;
                const int dbase = tq - k0 - 8 * h;
                const float* lp = mylut + (LUT_OFF - dbase);
#pragma unroll
                for (int mt = 0; mt < 2; ++mt) {
                    f32x16 st;
                    attn_qk32<128>(cur, qf, st, mt, r, h, nmb);
#pragma unroll
                    for (int i = 0; i < 16; ++i) st[i] = kidx(mt, i) <= dbase - 512 ? -INFINITY : st[i] + lp[kidx(mt, i)];
                    attn_softmax32_b(st, l);
                    bf16x8 pf[2];
                    attn_pack32(st, pf);
                    attn_pv32(cur + 16384, pf, o, mt, r, h);
                }
                __syncthreads();
            }
        }
        {
            const float lt = sum_x32(l);
            const float sc = (lt > 0.f ? frcp(lt) : 0.f) * gp[2];
#pragma unroll
            for (int dt = 0; dt < 4; ++dt)
#pragma unroll
                for (int g4 = 0; g4 < 4; ++g4) {
                    const int d0 = 32 * dt + 8 * g4 + 4 * h;
                    const u32x2 pv = *(const u32x2*)(orow + d0);
                    u32x2 ov;
                    ov.x = pk2(bflo(pv.x) + o[dt][4 * g4 + 0] * sc, bfhi(pv.x) + o[dt][4 * g4 + 1] * sc);
                    ov.y = pk2(bflo(pv.y) + o[dt][4 * g4 + 2] * sc, bfhi(pv.y) + o[dt][4 * g4 + 3] * sc);
                    *(u32x2*)(orow + d0) = ov;
                }
        }
        __syncthreads();
    }
}

DI void fp8x16_fma(const u32x4& q, const f32x4& h0, const f32x4& h1, const f32x4& h2, const f32x4& h3, f32x2& a0, f32x2& a1) {
    a0 += __builtin_amdgcn_cvt_pk_f32_fp8((int)q.x, false) * (f32x2){h0.x, h0.y};
    a1 += __builtin_amdgcn_cvt_pk_f32_fp8((int)q.x, true)  * (f32x2){h0.z, h0.w};
    a0 += __builtin_amdgcn_cvt_pk_f32_fp8((int)q.y, false) * (f32x2){h1.x, h1.y};
    a1 += __builtin_amdgcn_cvt_pk_f32_fp8((int)q.y, true)  * (f32x2){h1.z, h1.w};
    a0 += __builtin_amdgcn_cvt_pk_f32_fp8((int)q.z, false) * (f32x2){h2.x, h2.y};
    a1 += __builtin_amdgcn_cvt_pk_f32_fp8((int)q.z, true)  * (f32x2){h2.z, h2.w};
    a0 += __builtin_amdgcn_cvt_pk_f32_fp8((int)q.w, false) * (f32x2){h3.x, h3.y};
    a1 += __builtin_amdgcn_cvt_pk_f32_fp8((int)q.w, true)  * (f32x2){h3.z, h3.w};
}
#ifndef UMASK
#define UMASK 0xffffffffu
#endif
template <bool DRY>
DI void phase_peer_u(const Params& p, int layer, unsigned char* lds, int tid) {
    unsigned char* ws = p.ws;
    const unsigned char* H8 = ws + OFF_H8;
    const float* HS = (const float*)(ws + OFF_HS);
    const int* ridx = (const int*)(ws + OFF_RIDX);
    float* rgate = (float*)(ws + OFF_RGATE);
    const unsigned char* U = ws + OFF_PU + (long)layer * 16384 * 1024;
    const __amdgpu_buffer_rsrc_t urs = __builtin_amdgcn_make_buffer_rsrc((void*)U, (short)0, 16384 * 1024, 0x00020000);
    const float* usi = (const float*)(ws + OFF_USI) + layer * 16384;
    const float* vsi = (const float*)(ws + OFF_VSI) + layer * 16384;
    const int lane = tid & 63, w = __builtin_amdgcn_readfirstlane(tid >> 6), sub = lane & 7, grp = lane >> 3;
    const int xg = blockIdx.x & 7, lb = blockIdx.x >> 3, nwv = (gridDim.x >> 3) * NWAVES, wv = lb * NWAVES + w;
    unsigned* clb = (unsigned*)(lds + w * 12288);
    unsigned char* hbb = lds + w * 12288 + 4096;
    const unsigned long long lt = (1ull << lane) - 1ull;
    if (lb >= (int)(gridDim.x >> 3)) return;
    int i0, i1; unsigned g0, g1; u32x4 h0; float hs0;
    auto ld_tok = [&](int tk) {
        tk = tk < NTOK ? tk : wv;
        i0 = ridx[(long)tk * 128 + lane]; i1 = ridx[(long)tk * 128 + 64 + lane];
        g0 = __float_as_uint(rgate[(long)tk * 128 + lane]); g1 = __float_as_uint(rgate[(long)tk * 128 + 64 + lane]);
        h0 = *(const u32x4*)(H8 + (long)tk * DM + lane * 16); hs0 = HS[tk];
    };
    bool sb0, sb1; int sk0, sk1; float su0, sv0, su1, sv1;
    auto stage_tok = [&](int bi) -> int {
        unsigned* cl = clb + bi * 512; unsigned char* hb = hbb + bi * 4096;
        const bool b0 = (i0 >> 11) == xg, b1 = (i1 >> 11) == xg;
        const unsigned long long m0 = __ballot(b0), m1 = __ballot(b1);
        const int n0 = __popcll(m0), n = n0 + __popcll(m1);
        sb0 = b0; sb1 = b1; sk0 = __popcll(m0 & lt); sk1 = n0 + __popcll(m1 & lt);
        if (b0) { *(u32x4*)(cl + 4 * sk0) = (u32x4){(unsigned)lane, (unsigned)i0, g0, 0u}; su0 = usi[i0]; sv0 = vsi[i0]; }
        if (b1) { *(u32x4*)(cl + 4 * sk1) = (u32x4){(unsigned)(64 + lane), (unsigned)i1, g1, 0u}; su1 = usi[i1]; sv1 = vsi[i1]; }
        if (n == 0 && lane == 0) *(u32x4*)cl = (u32x4){0u, 0u, 0u, 0u};
        *(u32x4*)(hb + lane * 16) = h0;
        if (lane == 0) *(float*)(hb + 1024) = hs0;
        return n;
    };
    auto flush_scales = [&](int bi) {
        float* cs = (float*)(hbb + bi * 4096 + 1536);
        if (sb0) *(f32x2*)(cs + 2 * sk0) = (f32x2){su0, sv0};
        if (sb1) *(f32x2*)(cs + 2 * sk1) = (f32x2){su1, sv1};
    };
    ld_tok(wv);
    int nC = stage_tok(0);
    flush_scales(0);
    ld_tok(wv + nwv);
    int slotC, idC; bool validC; float g_in;
    { validC = grp < nC; const int kk = validC ? grp : 0; const u32x4 e = *(const u32x4*)(clb + 4 * kk); slotC = e.x; idC = e.y; g_in = __uint_as_float(e.z); }
    u32x4 uv[8];
    {
        const unsigned uoff = validC ? (unsigned)idC * 1024u + (unsigned)sub * 16u : 0x40000000u;
#pragma unroll
        for (int t = 0; t < 8; ++t) { uv[t] = __builtin_bit_cast(u32x4, __builtin_amdgcn_raw_buffer_load_b128(urs, (int)(uoff + t * 128), 0, 0)); __builtin_amdgcn_sched_barrier(0); }
    }
    int it = 0;
    for (int tok = wv; tok < NTOK; tok += nwv, ++it) {
        const int cb = it & 1;
        const unsigned* clC = clb + cb * 512; const unsigned* clN = clb + (cb ^ 1) * 512;
        const unsigned char* hbC = hbb + cb * 4096;
        const bool more = tok + nwv < NTOK;
        const int nN = stage_tok(cb ^ 1); ld_tok(tok + 2 * nwv);
        const float shC = *(const float*)(hbC + 1024);
        const int nr = nC > 8 ? (nC + 7) >> 3 : 1;
        u32x4 hq[8];
#pragma unroll
        for (int t = 0; t < 8; ++t) hq[t] = *(const u32x4*)(hbC + (sub + 8 * t) * 16);
        auto do_round = [&](int rd) {
            const f32x2 s2 = *(const f32x2*)(hbC + 1536 + 8 * (validC ? 8 * rd + grp : 0));
            int slotN, idN; bool validN; float g_inN;
            {
                u32x4 e;
                if (rd + 1 < nr) { const int k = 8 * (rd + 1) + grp; validN = k < nC; e = *(const u32x4*)(clC + 4 * (validN ? k : 0)); }
                else if (more) { validN = grp < nN; e = *(const u32x4*)(clN + 4 * (validN ? grp : 0)); }
                else { validN = false; e = *(const u32x4*)clC; }
                slotN = e.x; idN = e.y; g_inN = __uint_as_float(e.z);
            }
            const unsigned uoffN = validN ? ((unsigned)idN & (DRY ? UMASK : 0xffffffffu)) * 1024u + (unsigned)sub * 16u : 0x40000000u;
            __builtin_amdgcn_sched_barrier(0);
            int a0 = 0, a1 = 0, a2 = 0, a3 = 0;
#pragma unroll
            for (int t = 0; t < 8; ++t) {
                const u32x4 q = uv[t];
                a0 = __builtin_amdgcn_sdot4((int)q.x, (int)hq[t].x, a0, false); a1 = __builtin_amdgcn_sdot4((int)q.y, (int)hq[t].y, a1, false);
                a2 = __builtin_amdgcn_sdot4((int)q.z, (int)hq[t].z, a2, false); a3 = __builtin_amdgcn_sdot4((int)q.w, (int)hq[t].w, a3, false);
                uv[t] = __builtin_bit_cast(u32x4, __builtin_amdgcn_raw_buffer_load_b128(urs, (int)(uoffN + t * 128), 0, 0));
                __builtin_amdgcn_sched_barrier(0);
            }
            int di = (a0 + a1) + (a2 + a3);
            di += __builtin_amdgcn_update_dpp(0, di, 0xB1, 0xF, 0xF, true);
            di += __builtin_amdgcn_update_dpp(0, di, 0x4E, 0xF, 0xF, true);
            di += __builtin_amdgcn_update_dpp(0, di, 0x141, 0xF, 0xF, true);
            if (validC && sub == 0) {
                float* gw = DRY ? (float*)(ws + OFF_R) + (long)tok * 128 + slotC : rgate + (long)tok * 128 + slotC;
                *gw = g_in * gelu_tanh((float)di * s2.x * shC) * s2.y;
            }
            slotC = slotN; idC = idN; validC = validN; g_in = g_inN;
        };
        do_round(0);
        for (int rd = 1; rd < nr; ++rd) do_round(rd);
        flush_scales(cb ^ 1);
        nC = nN;
    }
}

#ifndef VMASK
#define VMASK 0xffffffffu
#endif
#ifndef V_MFMA
#define V_MFMA 1
#endif
#define LAS __attribute__((address_space(3)))
typedef int v2i_t __attribute__((ext_vector_type(2)));
template <bool DRY>
DI void phase_peer_v(const Params& p, int layer, unsigned char* lds, int tid) {
    unsigned char* ws = p.ws;
    const int* ridx = (const int*)(ws + OFF_RIDX);
    const float* wact = (const float*)(ws + OFF_RGATE);
    const float* ada = (const float*)(ws + OFF_ADA);
    float* x = opq(p.out);
    const int lane = tid & 63, w = __builtin_amdgcn_readfirstlane(tid >> 6), sub = lane & 7, eg = lane >> 3;
    const int xg = blockIdx.x & 7, lb = blockIdx.x >> 3, nwv = (gridDim.x >> 3) * NWAVES, wv = lb * NWAVES + w;
    if (lb >= (int)(gridDim.x >> 3)) return;
    const unsigned char* Vc = ws + OFF_PV + ((long)(layer * 8 + xg) * 16384) * 128;
    unsigned char* gr = lds + w * 16384;
    unsigned* ring = (unsigned*)(lds + 128 * 1024 + w * 3072);
    int ia, ib; float wa, wb;
    auto ld_tokv = [&](int tk) {
        tk = tk < NTOK ? tk : wv;
        ia = ridx[(long)tk * 128 + lane]; ib = ridx[(long)tk * 128 + 64 + lane];
        wa = wact[(long)tk * 128 + lane]; wb = wact[(long)tk * 128 + 64 + lane];
    };
    auto st_ring = [&](int slot) {
        unsigned* rs = ring + slot * 256;
        rs[lane] = (unsigned)ia; rs[64 + lane] = (unsigned)ib; rs[128 + lane] = __float_as_uint(wa); rs[192 + lane] = __float_as_uint(wb);
    };
    auto rd_ids = [&](int slot, u32x4 (&a)[4]) {
        const u32x4* ip = (const u32x4*)(ring + slot * 256 + eg * 16);
#pragma unroll
        for (int q = 0; q < 4; ++q) a[q] = ip[q];
    };
    auto issue = [&](int j, const u32x4 (&a)[4]) {
#pragma unroll
        for (int i = 0; i < 4; ++i) {
            const int g = 4 * (i & 1) + (eg >> 1);
            const unsigned src = (a[j][i] & (DRY ? VMASK : 0xffffffffu)) * 128u + (unsigned)((sub ^ g) << 4);
            __builtin_amdgcn_global_load_lds((const unsigned*)(Vc + src), (unsigned*)(gr + j * 4096 + i * 1024), 16, 0, 0);
        }
    };
    const int col0 = 128 * xg + 16 * sub;
    ld_tokv(wv); st_ring(0);
    ld_tokv(wv + nwv); st_ring(1);
    ld_tokv(wv + 2 * nwv);
    {
        u32x4 a[4];
        rd_ids(0, a);
#pragma unroll
        for (int j = 0; j < 4; ++j) issue(j, a);
    }
#if V_MFMA
    unsigned char* wb8 = lds + 152 * 1024 + w * 256;
    const int m16 = lane & 15, q4 = lane >> 4;
    int boff[8];
    {
        const int rowL = 8 * q4 + (m16 >> 1), gL = (rowL >> 1) & 7;
#pragma unroll
        for (int nt = 0; nt < 8; ++nt) boff[nt] = rowL * 128 + ((nt ^ gL) << 4) + 8 * (m16 & 1);
    }
    unsigned baddr[8];
    const unsigned gr3 = (unsigned)(unsigned long)(LAS unsigned char*)gr;
#pragma unroll
    for (int nt = 0; nt < 8; ++nt) baddr[nt] = gr3 + (unsigned)boff[nt];
    const unsigned aaddr = (unsigned)(unsigned long)(LAS unsigned char*)wb8 + (unsigned)((m16 & 1) * 128 + 8 * q4);
    float xv[8], gfv[8]; int gb = -1;
    const int colx = 128 * xg + m16;
    if (lane < 16) {
#pragma unroll
        for (int nt = 0; nt < 8; ++nt) xv[nt] = x[(long)wv * DM + colx + 16 * nt];
    }
#else
    f32x4 gfv[4]; int gb = -1;
    f32x4 xv[4];
    if (eg == 0) {
#pragma unroll
        for (int c = 0; c < 4; ++c) xv[c] = *(const f32x4*)(x + (long)wv * DM + col0 + 4 * c);
    }
#endif
    int it = 0, s3 = 0;
    for (int tok = wv; tok < NTOK; tok += nwv, ++it) {
        const int sl0 = s3, sl1 = s3 == 2 ? 0 : s3 + 1, sl2 = s3 == 0 ? 2 : s3 - 1;
        st_ring(sl2);
        ld_tokv(tok + 3 * nwv);
        u32x4 na[4];
        rd_ids(sl1, na);
        {
            const int b = tok >> 13;
            if (b != gb) {
                gb = b;
#if V_MFMA
                if (lane < 16) {
#pragma unroll
                    for (int nt = 0; nt < 8; ++nt) gfv[nt] = ada[b * ADA_STRIDE + layer * 6144 + 5 * 1024 + colx + 16 * nt];
                }
#else
                const float* gf = ada + b * ADA_STRIDE + layer * 6144 + 5 * 1024 + col0;
#pragma unroll
                for (int c = 0; c < 4; ++c) gfv[c] = *(const f32x4*)(gf + 4 * c);
#endif
                asm volatile("s_waitcnt vmcnt(0)" ::: "memory");
            }
        }
#if V_MFMA
        float invS;
        {
            const float w0 = __uint_as_float(ring[sl0 * 256 + 128 + lane]), w1 = __uint_as_float(ring[sl0 * 256 + 192 + lane]);
            const float mx = wave_max(fmaxf(fabsf(w0), fabsf(w1)));
            int ex = (int)((__float_as_uint(mx) >> 23) & 255u) - 127;
            ex = ex < -100 ? -100 : ex;
            const float S = __uint_as_float((unsigned)(127 + 7 - ex) << 23);
            invS = __uint_as_float((unsigned)(127 - 7 + ex) << 23);
            const float a0 = w0 * S, a1 = w1 * S;
            const int hi = __builtin_amdgcn_cvt_pk_fp8_f32(a0, a1, 0, false);
            const f32x2 hf = __builtin_amdgcn_cvt_pk_f32_fp8(hi, false);
            const int lo = __builtin_amdgcn_cvt_pk_fp8_f32(a0 - hf.x, a1 - hf.y, 0, false);
            const int p0 = 8 * (lane & 15) + (lane >> 4);
            wb8[p0] = (unsigned char)(hi & 255); wb8[p0 + 4] = (unsigned char)((hi >> 8) & 255);
            wb8[128 + p0] = (unsigned char)(lo & 255); wb8[128 + p0 + 4] = (unsigned char)((lo >> 8) & 255);
        }
        f32x4 d[8];
#pragma unroll
        for (int nt = 0; nt < 8; ++nt) d[nt] = (f32x4){0.f, 0.f, 0.f, 0.f};
#pragma unroll
        for (int j = 0; j < 4; ++j) {
            asm volatile("s_waitcnt vmcnt(24)" ::: "memory");
            v2i_t aq, b0, b1, b2, b3, b4, b5, b6, b7;
            asm volatile("ds_read_b64 %0, %9 offset:%18\n\t"
                         "ds_read_b64_tr_b8 %1, %10 offset:%19\n\tds_read_b64_tr_b8 %2, %11 offset:%19\n\t"
                         "ds_read_b64_tr_b8 %3, %12 offset:%19\n\tds_read_b64_tr_b8 %4, %13 offset:%19\n\t"
                         "ds_read_b64_tr_b8 %5, %14 offset:%19\n\tds_read_b64_tr_b8 %6, %15 offset:%19\n\t"
                         "ds_read_b64_tr_b8 %7, %16 offset:%19\n\tds_read_b64_tr_b8 %8, %17 offset:%19\n\t"
                         "s_waitcnt lgkmcnt(0)"
                         : "=&v"(aq), "=&v"(b0), "=&v"(b1), "=&v"(b2), "=&v"(b3), "=&v"(b4), "=&v"(b5), "=&v"(b6), "=&v"(b7)
                         : "v"(aaddr), "v"(baddr[0]), "v"(baddr[1]), "v"(baddr[2]), "v"(baddr[3]), "v"(baddr[4]), "v"(baddr[5]), "v"(baddr[6]), "v"(baddr[7]),
                           "i"(32 * j), "i"(4096 * j)
                         : "memory");
            long a8 = ((long)(unsigned)aq.y << 32) | (unsigned)aq.x;
            a8 = m16 < 2 ? a8 : 0l;
            const v2i_t bq[8] = {b0, b1, b2, b3, b4, b5, b6, b7};
#pragma unroll
            for (int nt = 0; nt < 8; ++nt) {
                const long b8 = ((long)(unsigned)bq[nt].y << 32) | (unsigned)bq[nt].x;
                d[nt] = __builtin_amdgcn_mfma_f32_16x16x32_fp8_fp8(a8, b8, d[nt], 0, 0, 0);
            }
            issue(j, na);
        }
        if (lane < 16) {
            float* xr = DRY ? (float*)(ws + OFF_R + 16 * MB) + (long)tok * DM + colx : x + (long)tok * DM + colx;
#pragma unroll
            for (int nt = 0; nt < 8; ++nt) xr[16 * nt] = xv[nt] + gfv[nt] * ((d[nt].x + d[nt].y) * invS);
            const int tn = tok + nwv < NTOK ? tok + nwv : wv;
#pragma unroll
            for (int nt = 0; nt < 8; ++nt) xv[nt] = x[(long)tn * DM + colx + 16 * nt];
        }
#else
        f32x4 cw[4];
        {
            const f32x4* wp = (const f32x4*)(ring + sl0 * 256 + 128 + eg * 16);
#pragma unroll
            for (int q = 0; q < 4; ++q) cw[q] = wp[q];
        }
        f32x2 ap[8];
#pragma unroll
        for (int i = 0; i < 8; ++i) ap[i] = (f32x2){0.f, 0.f};
#pragma unroll
        for (int j = 0; j < 4; ++j) {
            asm volatile("s_waitcnt vmcnt(20)" ::: "memory");
#pragma unroll
            for (int i = 0; i < 4; ++i) {
                const int rs = 8 * i + eg, g = 4 * (i & 1) + (eg >> 1);
                const u32x4 v = *(const u32x4*)(gr + j * 4096 + rs * 128 + ((sub ^ g) << 4));
                const float ws1 = cw[j][i]; const f32x2 ww = {ws1, ws1};
                ap[0] += __builtin_amdgcn_cvt_pk_f32_fp8((int)v.x, false) * ww; ap[1] += __builtin_amdgcn_cvt_pk_f32_fp8((int)v.x, true) * ww;
                ap[2] += __builtin_amdgcn_cvt_pk_f32_fp8((int)v.y, false) * ww; ap[3] += __builtin_amdgcn_cvt_pk_f32_fp8((int)v.y, true) * ww;
                ap[4] += __builtin_amdgcn_cvt_pk_f32_fp8((int)v.z, false) * ww; ap[5] += __builtin_amdgcn_cvt_pk_f32_fp8((int)v.z, true) * ww;
                ap[6] += __builtin_amdgcn_cvt_pk_f32_fp8((int)v.w, false) * ww; ap[7] += __builtin_amdgcn_cvt_pk_f32_fp8((int)v.w, true) * ww;
            }
            asm volatile("s_waitcnt lgkmcnt(0)" ::: "memory");
            issue(j, na);
        }
        float acc[16];
#pragma unroll
        for (int i = 0; i < 8; ++i) { acc[2 * i] = ap[i].x; acc[2 * i + 1] = ap[i].y; }
#pragma unroll
        for (int i = 0; i < 16; ++i) { acc[i] += lr8(acc[i]); acc[i] = sum_x16(acc[i]); acc[i] = sum_x32(acc[i]); }
        if (eg == 0) {
            float* xr = DRY ? (float*)(ws + OFF_R + 16 * MB) + (long)tok * DM + col0 : x + (long)tok * DM + col0;
#pragma unroll
            for (int c = 0; c < 4; ++c) {
                const f32x4 gv = gfv[c];
                f32x4 o;
                o.x = xv[c].x + gv.x * acc[4 * c + 0]; o.y = xv[c].y + gv.y * acc[4 * c + 1];
                o.z = xv[c].z + gv.z * acc[4 * c + 2]; o.w = xv[c].w + gv.w * acc[4 * c + 3];
                *(f32x4*)(xr + 4 * c) = o;
            }
            const int tn = tok + nwv < NTOK ? tok + nwv : wv;
#pragma unroll
            for (int c = 0; c < 4; ++c) xv[c] = *(const f32x4*)(x + (long)tn * DM + col0 + 4 * c);
        }
#endif
        s3 = sl1;
    }
    asm volatile("s_waitcnt vmcnt(0)" ::: "memory");
}

DI void norm_row_q8(const f32x4 (&v)[4], float rstd, const float* gain, const float* shift, const float* scale, unsigned char* orow, float* os, int lane) {
    f32x4 y[4]; float am = 0.f;
#pragma unroll
    for (int j = 0; j < 4; ++j) {
        const int c = 4 * lane + 256 * j;
        const f32x4 g = *(const f32x4*)(gain + c), sh = *(const f32x4*)(shift + c), sc = *(const f32x4*)(scale + c);
        y[j].x = v[j].x * rstd * g.x * (1.f + sc.x) + sh.x; y[j].y = v[j].y * rstd * g.y * (1.f + sc.y) + sh.y;
        y[j].z = v[j].z * rstd * g.z * (1.f + sc.z) + sh.z; y[j].w = v[j].w * rstd * g.w * (1.f + sc.w) + sh.w;
        am = fmaxf(am, fmaxf(fmaxf(fabsf(y[j].x), fabsf(y[j].y)), fmaxf(fabsf(y[j].z), fabsf(y[j].w))));
    }
    am = wave_max(am);
    const float qs = am > 0.f ? 127.f / am : 1.f;
#pragma unroll
    for (int j = 0; j < 4; ++j) *(int*)(orow + 4 * lane + 256 * j) = pack_i8x4(y[j].x * qs, y[j].y * qs, y[j].z * qs, y[j].w * qs);
    if (lane == 0) *os = am > 0.f ? am * (1.f / 127.f) : 1.f;
}
DI void phase_norm2(const float* __restrict__ x, unsigned char* __restrict__ out1, float* __restrict__ os1, const float* gain1, int sh1, int sc1,
                    unsigned char* __restrict__ out2, float* __restrict__ os2, const float* gain2, int sh2, int sc2, const float* ada, int tid) {
    const int lane = tid & 63, gw = blockIdx.x * NWAVES + (tid >> 6), nw = gridDim.x * NWAVES;
    for (int tok = gw; tok < NTOK; tok += nw) {
        const int b = tok >> 13;
        f32x4 v[4]; float ss = 0.f;
#pragma unroll
        for (int j = 0; j < 4; ++j) { v[j] = *(const f32x4*)(x + (long)tok * DM + 4 * lane + 256 * j); ss += v[j].x * v[j].x + v[j].y * v[j].y + v[j].z * v[j].z + v[j].w * v[j].w; }
        const float rstd = rsqrtf(wave_sum(ss) * (1.f / DM) + EPS);
        norm_row_q8(v, rstd, gain1, ada + b * ADA_STRIDE + sh1, ada + b * ADA_STRIDE + sc1, out1 + (long)tok * DM, os1 + tok, lane);
        norm_row_q8(v, rstd, gain2, ada + b * ADA_STRIDE + sh2, ada + b * ADA_STRIDE + sc2, out2 + (long)tok * DM, os2 + tok, lane);
    }
}

template <int MT, class Epi>
DI void gemm_phase(const bf16_t* A, long lda, int M, const bf16_t* Bt, long ldb, int N, int K, const Epi& epi, unsigned char* lds, int tid) {
    const int ntm = (M + 128 * MT - 1) / (128 * MT), ntn = (N + 255) / 256, nt = ntm * ntn;
    if ((gridDim.x & 7) == 0 && (ntm & 31) == 0) {
        const int xcd = blockIdx.x & 7, lb = blockIdx.x >> 3, nlb = gridDim.x >> 3, tmx = ntm >> 3, per = tmx * ntn;
        for (int q = lb; q < per; q += nlb) {
            const int g4 = q / (4 * ntn), rem = q - g4 * 4 * ntn, tn = rem >> 2, tm = xcd * tmx + g4 * 4 + (rem & 3);
            if (tm < (xcd + 1) * tmx) gemm_tile<MT>(A, lda, M, Bt, ldb, N, K, tm * 128 * MT, tn * 256, epi, lds, tid);
        }
        return;
    }
    for (int t = blockIdx.x; t < nt; t += gridDim.x) {
        const int tn = t / ntm, tm = t % ntm;
        gemm_tile<MT>(A, lda, M, Bt, ldb, N, K, tm * 128 * MT, tn * 256, epi, lds, tid);
    }
}

template <int MT, class Epi>
DI void gemm_tile_i8(const unsigned char* __restrict__ A, int M, const float* __restrict__ as, const unsigned char* __restrict__ Bt, int N, const float* __restrict__ bs,
                     int K, int m0, int n0, const Epi& epi, unsigned char* lds, int tid) {
    constexpr int XS = MT * 128 * 128, WS = 256 * 128, STAGE = XS + WS;
    const int lane = tid & 63, w = tid >> 6, tg = w & 3, fh = w >> 2, r = lane & 31, h = lane >> 5;
    const int wbase = tid & ~63;
    unsigned xo[2 * MT], wo[4];
#pragma unroll
    for (int i = 0; i < 2 * MT; ++i) { int row, c; sw2_src(tid + 512 * i, row, c); int m = m0 + row; m = m < M ? m : M - 1; xo[i] = (unsigned)m * (unsigned)K + c * 16; }
#pragma unroll
    for (int i = 0; i < 4; ++i) { int row, c; sw2_src(tid + 512 * i, row, c); int n = n0 + row; n = n < N ? n : N - 1; wo[i] = (unsigned)n * (unsigned)K + c * 16; }
    auto stage = [&](int kt, unsigned char* st) {
#pragma unroll
        for (int i = 0; i < 2 * MT; ++i)
            __builtin_amdgcn_global_load_lds((const unsigned*)(A + kt * 128 + xo[i]), (unsigned*)(st + (wbase + 512 * i) * 16), 16, 0, 0);
#pragma unroll
        for (int i = 0; i < 4; ++i)
            __builtin_amdgcn_global_load_lds((const unsigned*)(Bt + kt * 128 + wo[i]), (unsigned*)(st + XS + (wbase + 512 * i) * 16), 16, 0, 0);
    };
    i32x16 acc[MT][4];
#pragma unroll
    for (int s2 = 0; s2 < MT; ++s2)
#pragma unroll
        for (int i = 0; i < 4; ++i)
#pragma unroll
            for (int j = 0; j < 16; ++j) acc[s2][i][j] = 0;
    const int nk = K >> 7;
    stage(0, lds);
    __syncthreads();
#pragma unroll 2
    for (int kt = 0; kt < nk; ++kt) {
        unsigned char* cur = lds + (kt & 1) * STAGE;
        if (kt + 1 < nk) stage(kt + 1, lds + ((kt + 1) & 1) * STAGE);
        i32x4 xfa[MT], wfa[4], xfb[MT], wfb[4];
        auto ldf = [&](i32x4 (&xf)[MT], i32x4 (&wf)[4], int ks) {
#pragma unroll
            for (int s2 = 0; s2 < MT; ++s2) xf[s2] = *(const i32x4*)(cur + sw2(32 * MT * tg + 32 * s2 + r, 2 * ks + h));
#pragma unroll
            for (int mt = 0; mt < 4; ++mt) wf[mt] = *(const i32x4*)(cur + XS + sw2(128 * fh + 32 * mt + r, 2 * ks + h));
        };
        auto mm = [&](const i32x4 (&xf)[MT], const i32x4 (&wf)[4]) {
#pragma unroll
            for (int mt = 0; mt < 4; ++mt)
#pragma unroll
                for (int s2 = 0; s2 < MT; ++s2) acc[s2][mt] = MFMA32I8(wf[mt], xf[s2], acc[s2][mt]);
        };
        ldf(xfa, wfa, 0);
        ldf(xfb, wfb, 1); __builtin_amdgcn_sched_barrier(0); mm(xfa, wfa); __builtin_amdgcn_sched_barrier(0);
        ldf(xfa, wfa, 2); __builtin_amdgcn_sched_barrier(0); mm(xfb, wfb); __builtin_amdgcn_sched_barrier(0);
        ldf(xfb, wfb, 3); __builtin_amdgcn_sched_barrier(0); mm(xfa, wfa); __builtin_amdgcn_sched_barrier(0);
        mm(xfb, wfb);
        __syncthreads();
    }
    auto fin = [&](const i32x16 (&ai)[4], int s2, int ho, int ro, int to) {
        const int tok = m0 + 32 * MT * tg + 32 * s2 + ro, fbase = n0 + 128 * fh;
        const float sa = as[tok < M ? tok : M - 1];
        f32x16 af[4];
#pragma unroll
        for (int mt = 0; mt < 4; ++mt) {
#pragma unroll
            for (int g4 = 0; g4 < 4; ++g4) {
                int f0 = fbase + 32 * mt + 8 * g4 + 4 * ho; f0 = f0 + 3 < N ? f0 : (N - 4 > 0 ? N - 4 : 0);
                const f32x4 sb = *(const f32x4*)(bs + f0);
                af[mt][4 * g4 + 0] = (float)ai[mt][4 * g4 + 0] * (sa * sb.x); af[mt][4 * g4 + 1] = (float)ai[mt][4 * g4 + 1] * (sa * sb.y);
                af[mt][4 * g4 + 2] = (float)ai[mt][4 * g4 + 2] * (sa * sb.z); af[mt][4 * g4 + 3] = (float)ai[mt][4 * g4 + 3] * (sa * sb.w);
            }
            __builtin_amdgcn_sched_barrier(0);
        }
        epi(af, tok, fbase, ho, lds, to);
        __builtin_amdgcn_sched_barrier(0);
    };
    if constexpr (MT == 2 && epi_stash<Epi>::present) {
        int* sp = (int*)lds + w * 4096 + lane;
#pragma unroll
        for (int mt = 0; mt < 4; ++mt)
#pragma unroll
            for (int j = 0; j < 16; ++j) sp[(mt * 16 + j) * 64] = acc[1][mt][j];
        int ho = h, ro = r, to = tid;
        asm volatile("" : "+v"(ho), "+v"(ro), "+v"(to));
        fin(acc[0], 0, ho, ro, to);
        i32x16 a2[4];
        const int* sp2 = sp; asm volatile("" : "+v"(sp2));
#pragma unroll
        for (int mt = 0; mt < 4; ++mt)
#pragma unroll
            for (int j = 0; j < 16; ++j) a2[mt][j] = sp2[(mt * 16 + j) * 64];
        asm volatile("" : "+v"(ho), "+v"(ro), "+v"(to));
        fin(a2, 1, ho, ro, to);
        __syncthreads();
    } else {
        int ho = h, ro = r, to = tid;
#pragma unroll
        for (int s2 = 0; s2 < MT; ++s2) { asm volatile("" : "+v"(ho), "+v"(ro), "+v"(to)); fin(acc[s2], s2, ho, ro, to); }
    }
}
template <int MT, class Epi>
DI void gemm_phase_i8(const unsigned char* A, int M, const float* as, const unsigned char* Bt, int N, const float* bs, int K, const Epi& epi, unsigned char* lds, int tid,
                      int skip = 0) {
    const int ntm = (M + 128 * MT - 1) / (128 * MT), ntn = (N + 255) / 256, nt = ntm * ntn;
    const int bid = (int)blockIdx.x - skip, nbl = (int)gridDim.x - skip;
    if (bid < 0) return;
    if ((gridDim.x & 7) == 0 && (ntm & 31) == 0) {
        const int xcd = bid & 7, lb = bid >> 3, nlb = nbl >> 3, tmx = ntm >> 3, per = tmx * ntn;
        for (int q = lb; q < per; q += nlb) {
            const int g4 = q / (4 * ntn), rem = q - g4 * 4 * ntn, tn = rem >> 2, tm = xcd * tmx + g4 * 4 + (rem & 3);
            gemm_tile_i8<MT>(A, M, as, Bt, N, bs, K, tm * 128 * MT, tn * 256, epi, lds, tid);
        }
        return;
    }
    for (int t = bid; t < nt; t += nbl) {
        const int tn = t / ntm, tm = t % ntm;
        gemm_tile_i8<MT>(A, M, as, Bt, N, bs, K, tm * 128 * MT, tn * 256, epi, lds, tid);
    }
}

DI void wquant_rows(const bf16_t* __restrict__ src, unsigned char* __restrict__ dst, float* __restrict__ sc, int nrows, int gw, int nw, int lane) {
    for (int n = gw; n < nrows; n += nw) {
        const u32x4 a = *(const u32x4*)(src + (long)n * 1024 + 16 * lane), b = *(const u32x4*)(src + (long)n * 1024 + 16 * lane + 8);
        float v[16];
        v[0] = bflo(a.x); v[1] = bfhi(a.x); v[2] = bflo(a.y); v[3] = bfhi(a.y); v[4] = bflo(a.z); v[5] = bfhi(a.z); v[6] = bflo(a.w); v[7] = bfhi(a.w);
        v[8] = bflo(b.x); v[9] = bfhi(b.x); v[10] = bflo(b.y); v[11] = bfhi(b.y); v[12] = bflo(b.z); v[13] = bfhi(b.z); v[14] = bflo(b.w); v[15] = bfhi(b.w);
        float am = 0.f;
#pragma unroll
        for (int q = 0; q < 16; ++q) am = fmaxf(am, fabsf(v[q]));
        am = wave_max(am);
        const float qs = am > 0.f ? 127.f / am : 1.f;
        u32x4 o;
        o.x = (unsigned)pack_i8x4(v[0] * qs, v[1] * qs, v[2] * qs, v[3] * qs); o.y = (unsigned)pack_i8x4(v[4] * qs, v[5] * qs, v[6] * qs, v[7] * qs);
        o.z = (unsigned)pack_i8x4(v[8] * qs, v[9] * qs, v[10] * qs, v[11] * qs); o.w = (unsigned)pack_i8x4(v[12] * qs, v[13] * qs, v[14] * qs, v[15] * qs);
        *(u32x4*)(dst + (long)n * 1024 + 16 * lane) = o;
        if (lane == 0) sc[n] = am > 0.f ? am * (1.f / 127.f) : 1.f;
    }
}
DI void phase_wquant(unsigned char* ws, int tid) {
    const int lane = tid & 63, gw = blockIdx.x * NWAVES + (tid >> 6), nw = gridDim.x * NWAVES;
    float* sc = (float*)(ws + OFF_W8S);
    wquant_rows((const bf16_t*)(ws + OFF_WT_PEER), ws + OFF_W8_PEER, sc + W8S_PEER, 4096, gw, nw, lane);
    wquant_rows((const bf16_t*)(ws + OFF_WT_DIN), ws + OFF_W8_DIN, sc + W8S_DIN, 3072, gw, nw, lane);
    wquant_rows((const bf16_t*)(ws + OFF_WT_KV), ws + OFF_W8_KV, sc + W8S_KV, 1536, gw, nw, lane);
    wquant_rows((const bf16_t*)(ws + OFF_WT_NIN), ws + OFF_W8_NIN, sc + W8S_NIN, 1088, gw, nw, lane);
}

#define XB_TMO      128
#define XB_XCNT(j)  (256  + 64 * (j))
#define XB_XSUB(j)  (1280 + 64 * (j))
#define XB_XGEN(j)  (2304 + 64 * (j))
#define XB_TOP      3328
#define XB_TOPGEN   3392
#define XCD_BAR_WORDS 3456
#define XB_SPIN_CAP (1u << 22)
DI unsigned xb_ld(unsigned* p) { return __hip_atomic_load(p, __ATOMIC_RELAXED, __HIP_MEMORY_SCOPE_AGENT); }
DI unsigned xb_add(unsigned* p, unsigned v) { return __hip_atomic_fetch_add(p, v, __ATOMIC_RELAXED, __HIP_MEMORY_SCOPE_AGENT); }
DI unsigned xb_xcc_id() { return (unsigned)__builtin_amdgcn_s_getreg((3 << 11) | 20) & 0xFu; }
#define XB_SPIN(cond, bar) do { unsigned _sp = 0; while (cond) { __builtin_amdgcn_s_sleep(1); \
    if ((++_sp & 255u) == 0u) { if (xb_ld(&(bar)[XB_TMO])) break; if (_sp > XB_SPIN_CAP) { atomicAdd(&(bar)[XB_TMO], 1u); break; } } } } while (0)
DI void xcd_barrier_complete(unsigned* bar, unsigned x, unsigned& nloc, unsigned& nx) {
    const unsigned G = gridDim.x;
    unsigned sum, cnt, mine, sp = 0u;
    for (;;) {
        sum = 0u; cnt = 0u; mine = 0u;
#pragma unroll
        for (unsigned j = 0; j < 16; ++j) { const unsigned c = xb_ld(&bar[XB_XCNT(j)]); sum += c; cnt += (c > 0u) ? 1u : 0u; mine = (j == x) ? c : mine; }
        if (sum == G) break;
        __builtin_amdgcn_s_sleep(1);
        if ((++sp & 255u) == 0u) { if (xb_ld(&bar[XB_TMO])) break; if (sp > XB_SPIN_CAP) { atomicAdd(&bar[XB_TMO], 1u); break; } }
    }
    nloc = mine > 0u ? mine : 1u; nx = cnt > 0u ? cnt : 1u;
}
DI void xcd_barrier(unsigned* bar, volatile LAS unsigned* st, int tid) {
    asm volatile("s_waitcnt vmcnt(0)" ::: "memory");
    __syncthreads();
    if (tid == 0) {
        const unsigned x = xb_xcc_id();
        __builtin_amdgcn_s_waitcnt(0);
        unsigned nloc = st[0], nx = st[1];
        if (nloc == 0u) { xcd_barrier_complete(bar, x, nloc, nx); st[0] = nloc; st[1] = nx; }
        const unsigned old = xb_add(&bar[XB_XSUB(x)], 1u);
        const unsigned gen = old / nloc;
        if (old + 1u == (gen + 1u) * nloc) {
            __builtin_amdgcn_fence(__ATOMIC_RELEASE, "agent");
            asm volatile("s_waitcnt vmcnt(0)" ::: "memory");
            const unsigned og = xb_add(&bar[XB_TOP], 1u);
            const unsigned tg = og / nx;
            if (og + 1u == (tg + 1u) * nx) xb_add(&bar[XB_TOPGEN], 1u);
            else XB_SPIN(xb_ld(&bar[XB_TOPGEN]) == tg, bar);
            __builtin_amdgcn_fence(__ATOMIC_ACQUIRE, "agent");
            xb_add(&bar[XB_XGEN(x)], 1u);
            asm volatile("s_waitcnt vmcnt(0)" ::: "memory");
        } else {
            XB_SPIN(xb_ld(&bar[XB_XGEN(x)]) == gen, bar);
            __builtin_amdgcn_fence(__ATOMIC_ACQUIRE, "agent");
            asm volatile("s_waitcnt vmcnt(0)" ::: "memory");
        }
    }
    __syncthreads();
}

#define ftid() ftid_(wave_u)
DI int ftid_(int wave_u) { int t = (wave_u << 6) + (int)__builtin_amdgcn_mbcnt_hi(~0u, __builtin_amdgcn_mbcnt_lo(~0u, 0u)); asm volatile("" : "+v"(t)); return t; }


#if defined(__HIP_DEVICE_COMPILE__)
typedef const __attribute__((address_space(4))) Params* KParamPtr;
DI Params load_params() { KParamPtr kp = (KParamPtr)__builtin_amdgcn_kernarg_segment_ptr(); asm volatile("" : "+s"(kp)); return *kp; }
#else
DI Params load_params() { return Params{}; }
#endif
#define p (load_params())
#define ws (load_params().ws)
#define ada ((const float*)(ws + OFF_ADA))
#define Hb ((bf16_t*)(ws + OFF_H))
#define bar ((unsigned*)(ws + OFF_BAR))
__global__ void __launch_bounds__(NTHREADS) yoco_fwd(Params p_arg) {
    extern __shared__ __attribute__((aligned(16))) unsigned char lds[];
    cg::grid_group grid = cg::this_grid();
    volatile LAS unsigned* bst = (volatile LAS unsigned*)(lds + LDS_BAR);
    const int wave_u = __builtin_amdgcn_readfirstlane((int)(threadIdx.x >> 6));
    { const int t0 = ftid(); if (t0 == 0) { bst[0] = 0u; bst[1] = 0u; }
      if (blockIdx.x == 0) for (int i = t0; i < XCD_BAR_WORDS; i += NTHREADS) bar[i] = 0u; }
    __syncthreads();
    RUN(0) REP(0) phase_prep(p, lds, ftid());
    grid.sync();
    if (ftid() == 0) (void)xb_add(&bar[XB_XCNT(xb_xcc_id())], 1u);
    RUN(1) REP(1) phase_norm_q8<false>(p.in[0], Hb, ws + OFF_H8, (float*)(ws + OFF_HS), p.in[5], ada, 0, 1024, ftid());
    RUN(1) phase_wquant(ws, ftid());
    xcd_barrier(bar, bst, ftid());
    RUN(2) REP(2) {
        EpiQKV0 e{(bf16_t*)(ws + OFF_Q0), (bf16_t*)(ws + OFF_K0), (bf16_t*)(ws + OFF_VT0), p.in[10], p.in[11], (float*)(ws + OFF_MB0), p.in[2]};
        gemm_phase_i8<2>(ws + OFF_H8, NTOK, (const float*)(ws + OFF_HS), ws + OFF_W8_DIN, 3072, (const float*)(ws + OFF_W8S) + W8S_DIN, DM, e, lds, ftid());
    }
    xcd_barrier(bar, bst, ftid());
    RUN(3) REP(3) phase_diff_attn(p, lds, ftid());
    __builtin_amdgcn_s_setprio(0);
    xcd_barrier(bar, bst, ftid());
    RUN(4) REP(4) {
        EpiResid e{p.in[0], opq(p.out), ada + 2 * 1024};
        gemm_phase<2>(Hb, DM, NTOK, (const bf16_t*)(ws + OFF_WT_DOUT), DM, 1024, DM, e, lds, ftid());
    }
    xcd_barrier(bar, bst, ftid());
    if (STOP_AFTER <= 1) return;
    RUN(1) phase_norm_q8<false>(opq(p.out), Hb, ws + OFF_H8, (float*)(ws + OFF_HS), p.in[6], ada, 3 * 1024, 4 * 1024, ftid());
    xcd_barrier(bar, bst, ftid());
    RUN(5) REP(5) {
        EpiPeer e{(int*)(ws + OFF_RIDX), (float*)(ws + OFF_RGATE), 128 * 1024};
        gemm_phase_i8<2>(ws + OFF_H8, NTOK, (const float*)(ws + OFF_HS), ws + OFF_W8_PEER, 2048, (const float*)(ws + OFF_W8S) + W8S_PEER, DM, e, lds, ftid());
    }
    xcd_barrier(bar, bst, ftid());
    if ((REPEAT_MASK >> 6) & 1) phase_peer_u<true>(p, 0, lds, ftid());
    RUN(6) phase_peer_u<false>(p, 0, lds, ftid());
    xcd_barrier(bar, bst, ftid());
    if ((REPEAT_MASK >> 10) & 1) phase_peer_v<true>(p, 0, lds, ftid());
    RUN(6) phase_peer_v<false>(p, 0, lds, ftid());
    xcd_barrier(bar, bst, ftid());
    RUN(1) phase_norm2(opq(p.out), ws + OFF_H8, (float*)(ws + OFF_HS), p.in[13], 12288, 12288 + 1024, ws + OFF_H, (float*)(ws + OFF_HS) + NTOK, p.in[5] + 1024, 6144, 6144 + 1024, ada, ftid());
    xcd_barrier(bar, bst, ftid());
    if (STOP_AFTER <= 2) return;
    RUN(7) REP(7) {
        EpiKV e{(bf16_t*)(ws + OFF_KC), (bf16_t*)(ws + OFF_KS), (bf16_t*)(ws + OFF_VST), (bf16_t*)(ws + OFF_KW), (bf16_t*)(ws + OFF_VWT), p.in[21]};
        gemm_phase_i8<2>(ws + OFF_H8, NTOK, (const float*)(ws + OFF_HS), ws + OFF_W8_KV, 1536, (const float*)(ws + OFF_W8S) + W8S_KV, DM, e, lds, ftid());
    }
    xcd_barrier(bar, bst, ftid());
    RUN(8) REP(8) {
        EpiNsaQ e{(bf16_t*)(ws + OFF_QN), (float*)(ws + OFF_GATES), p.in[25], p.in[23], (float*)(ws + OFF_MB1)};
        gemm_phase_i8<2>(ws + OFF_H, NTOK, (const float*)(ws + OFF_HS) + NTOK, ws + OFF_W8_NIN, 1048, (const float*)(ws + OFF_W8S) + W8S_NIN, DM, e, lds, ftid(),
                         gridDim.x >= 128 ? 64 : 0);
        for (int t = blockIdx.x; t < 64; t += gridDim.x) {
            const int pr = t >> 2, tm = t & 3, kv = pr >> 3, bg = pr & 7;
            const bf16_t* Ap = (const bf16_t*)(ws + OFF_KC) + (long)(kv * 8 + bg) * SEQ * 128;
            bf16_t* hid = (bf16_t*)(ws + OFF_HID) + (long)pr * 512 * 256;
            EpiCmp1 e1{hid, (const float*)(ws + OFF_POSB) + kv * 16 * 256, p.in[19] + kv * 256};
            gemm_tile<1>(Ap, 2048, 511, (const bf16_t*)(ws + OFF_WT_C1) + (long)kv * 256 * 4096, 4096, 256, 4096, tm * 128, 0, e1, lds, ftid());
            __syncthreads();
            bf16_t* dst = kv == 0 ? (bf16_t*)(ws + OFF_KCMP) + (long)bg * 512 * 128 : (bf16_t*)(ws + OFF_VCMPT) + (long)bg * 128 * 512;
            EpiCmp2 e2{dst, p.in[21], kv};
            gemm_tile<1>(hid, 256, 512, (const bf16_t*)(ws + OFF_WT_C2) + (long)kv * 128 * 256, 256, 128, 256, tm * 128, 0, e2, lds, ftid());
        }
    }
    xcd_barrier(bar, bst, ftid());
#ifdef NSA_PROBE
    phase_nsa_attn<NSA_PROBE>(p, lds, ftid());
#endif
    RUN(9) REP(9) phase_nsa_attn<0>(p, lds, ftid());
    xcd_barrier(bar, bst, ftid());
    RUN(4) {
        float* xo = opq(p.out);
        EpiResid e{xo, xo, ada + 6144 + 2 * 1024};
        gemm_phase<2>(Hb, DM, NTOK, (const bf16_t*)(ws + OFF_WT_NOUT), DM, 1024, DM, e, lds, ftid());
    }
    xcd_barrier(bar, bst, ftid());
    if (STOP_AFTER <= 3) return;
    RUN(1) phase_norm_q8<false>(opq(p.out), Hb, ws + OFF_H8, (float*)(ws + OFF_HS), p.in[6] + 1024, ada, 6144 + 3 * 1024, 6144 + 4 * 1024, ftid());
    xcd_barrier(bar, bst, ftid());
    RUN(5) REP(5) {
        EpiPeer e{(int*)(ws + OFF_RIDX), (float*)(ws + OFF_RGATE), 128 * 1024};
        gemm_phase_i8<2>(ws + OFF_H8, NTOK, (const float*)(ws + OFF_HS), ws + OFF_W8_PEER + (long)2048 * 1024, 2048, (const float*)(ws + OFF_W8S) + W8S_PEER + 2048, DM, e, lds, ftid());
    }
    xcd_barrier(bar, bst, ftid());
    if ((REPEAT_MASK >> 6) & 1) phase_peer_u<true>(p, 1, lds, ftid());
    RUN(6) phase_peer_u<false>(p, 1, lds, ftid());
    xcd_barrier(bar, bst, ftid());
    if ((REPEAT_MASK >> 10) & 1) phase_peer_v<true>(p, 1, lds, ftid());
    RUN(6) phase_peer_v<false>(p, 1, lds, ftid());
}
#undef p
#undef ws
#undef ada
#undef Hb
#undef bar

extern "C" void kernel_launch(void* const* d_in, const int* in_sizes, int n_in, void* d_out, int out_size, void* d_ws, size_t ws_size,
                              hipStream_t stream) {
    static int grid_blocks = 0;
    if (grid_blocks == 0) {
        if (n_in != 30 || out_size != NTOK * DM || ws_size < WS_END) {
            fprintf(stderr, "kernel_launch: unexpected shapes (n_in %d out %d ws %zu)\n", n_in, out_size, ws_size);
            grid_blocks = -1; return;
        }
        int dev = 0, cus = 0, per_cu = 0;
        hipGetDevice(&dev);
        hipDeviceGetAttribute(&cus, hipDeviceAttributeMultiprocessorCount, dev);
        hipFuncSetAttribute((const void*)yoco_fwd, hipFuncAttributeMaxDynamicSharedMemorySize, LDS_BYTES);
        hipOccupancyMaxActiveBlocksPerMultiprocessor(&per_cu, (const void*)yoco_fwd, NTHREADS, LDS_BYTES);
        if (per_cu < 1) { fprintf(stderr, "kernel_launch: occupancy query says %d blocks per CU\n", per_cu); grid_blocks = -1; return; }
        grid_blocks = cus;
    }
    if (grid_blocks < 0) return;
    Params p{};
    for (int i = 0; i < 30; ++i) p.in[i] = (const float*)d_in[i];
    p.out = (float*)d_out;
    p.ws = (unsigned char*)d_ws;
    void* args[] = {&p};
    hipError_t e = hipLaunchCooperativeKernel((const void*)yoco_fwd, dim3(grid_blocks), dim3(NTHREADS), args, LDS_BYTES, stream);
    if (e != hipSuccess) fprintf(stderr, "cooperative launch failed: %s (grid %d)\n", hipGetErrorString(e), grid_blocks);
}
```

```cpp
#include <hip/hip_runtime.h>
#include <hip/hip_cooperative_groups.h>
#include <cstdio>
#include <cstdint>
namespace cg = cooperative_groups;

#define DI __device__ __forceinline__
#ifndef STOP_AFTER
#define STOP_AFTER 99
#endif
#ifndef ONLY_PHASE
#define ONLY_PHASE -1
#endif
#define RUN(n) if (ONLY_PHASE < 0 || ONLY_PHASE == (n))
#ifndef REPEAT_MASK
#define REPEAT_MASK 0
#endif
#define REP(n) for (int rep_ = 0; rep_ < (((REPEAT_MASK) >> (n)) & 1) + 1; ++rep_)

typedef unsigned short bf16_t;
typedef short bf16x8 __attribute__((ext_vector_type(8)));
typedef float f32x16 __attribute__((ext_vector_type(16)));
typedef float f32x4 __attribute__((ext_vector_type(4)));
typedef float f32x2 __attribute__((ext_vector_type(2)));
typedef unsigned u32x4 __attribute__((ext_vector_type(4)));
typedef unsigned u32x2 __attribute__((ext_vector_type(2)));
typedef __bf16 bf16x2v __attribute__((ext_vector_type(2)));

#define MFMA32(a, b, c) __builtin_amdgcn_mfma_f32_32x32x16_bf16((a), (b), (c), 0, 0, 0)
typedef int i32x4 __attribute__((ext_vector_type(4)));
typedef int i32x16 __attribute__((ext_vector_type(16)));
#define MFMA32I8(a, b, c) __builtin_amdgcn_mfma_i32_32x32x32_i8((a), (b), (c), 0, 0, 0)

constexpr int NB = 4, SEQ = 8192, DM = 1024, NTOK = NB * SEQ;
constexpr int NTHREADS = 512, NWAVES = 8;
constexpr float EPS = 1e-6f;
constexpr float LOG2E = 1.4426950408889634f;
constexpr int ADA_STRIDE = 14336;

constexpr size_t MB = 1u << 20;
constexpr size_t OFF_ADA = 0;
constexpr size_t OFF_POSB = 256 * 1024;
constexpr size_t OFF_BAR = 320 * 1024;
constexpr size_t OFF_MB0 = 168 * MB;
constexpr size_t OFF_MB1 = 172 * MB;
constexpr size_t OFF_H8 = 104 * MB;
constexpr size_t OFF_HS = 174 * MB;
constexpr size_t OFF_W8 = 176 * MB;
constexpr size_t OFF_W8_DIN = OFF_W8, OFF_W8_KV = OFF_W8 + 3 * MB, OFF_W8_NIN = OFF_W8 + 5 * MB, OFF_W8_PEER = OFF_W8 + 7 * MB;
constexpr size_t OFF_W8S = 188 * MB;
constexpr int W8S_DIN = 0, W8S_KV = 3072, W8S_NIN = 4608, W8S_PEER = 5760, W8S_TOTAL = 9856;
constexpr size_t OFF_USI = 384 * 1024;
constexpr size_t OFF_VSI = 512 * 1024;
constexpr size_t OFF_WT_DIN = 1 * MB;
constexpr size_t OFF_WT_DOUT = 7 * MB;
constexpr size_t OFF_WT_KV = 9 * MB;
constexpr size_t OFF_WT_NIN = 12 * MB;
constexpr size_t OFF_WT_NOUT = 15 * MB;
constexpr size_t OFF_WT_PEER = 17 * MB;
constexpr size_t OFF_WT_C1 = 25 * MB;
constexpr size_t OFF_WT_C2 = 29 * MB;
constexpr size_t OFF_GATES = 30 * MB;
constexpr size_t OFF_KCMP = 34 * MB;
constexpr size_t OFF_VCMPT = 35 * MB;
constexpr size_t OFF_HID = 36 * MB;
constexpr size_t OFF_RIDX = 40 * MB;
constexpr size_t OFF_RGATE = 56 * MB;
constexpr size_t OFF_PU = 72 * MB;
constexpr size_t OFF_PV = 136 * MB;
constexpr size_t OFF_H = 200 * MB;
constexpr size_t OFF_R = 264 * MB;
constexpr size_t WS_END = 456 * MB;
constexpr size_t OFF_Q0 = OFF_R, OFF_K0 = OFF_R + 64 * MB, OFF_VT0 = OFF_R + 128 * MB;
constexpr size_t OFF_QN = OFF_R, OFF_H2 = OFF_R, OFF_KC = OFF_R + 64 * MB, OFF_KS = OFF_R + 96 * MB, OFF_VST = OFF_R + 112 * MB,
                 OFF_KW = OFF_R + 128 * MB, OFF_VWT = OFF_R + 144 * MB;

constexpr int LDS_BAR = 159 * 1024;
constexpr int LDS_BYTES = LDS_BAR + 256;

struct Params {
    const float* in[30];
    float* out;
    unsigned char* ws;
};

template <class T> DI T* opq(T* q) { asm volatile("" : "+s"(q)); return (T*)(__attribute__((address_space(1))) T*)q; }
DI unsigned pk2(float lo, float hi) { f32x2 v = {lo, hi}; return __builtin_bit_cast(unsigned, __builtin_convertvector(v, bf16x2v)); }
DI bf16_t f2bf(float x) { return (bf16_t)(pk2(x, 0.f) & 0xffffu); }
DI float bflo(unsigned u) { return __uint_as_float(u << 16); }
DI float bfhi(unsigned u) { return __uint_as_float(u & 0xffff0000u); }
DI float fexp2(float x) { return __builtin_amdgcn_exp2f(x); }
DI float frcp(float x) { return __builtin_amdgcn_rcpf(x); }
DI int crow(int reg, int h) { return (reg & 3) + 8 * (reg >> 2) + 4 * h; }
template <int CTRL> DI float dpp_f(float v) { return __builtin_bit_cast(float, __builtin_amdgcn_update_dpp(0, __builtin_bit_cast(int, v), CTRL, 0xF, 0xF, true)); }
DI float lx1(float v) { return dpp_f<0xB1>(v); }
DI float lx2(float v) { return dpp_f<0x4E>(v); }
DI float lhm(float v) { return dpp_f<0x141>(v); }
DI float lr8(float v) { return dpp_f<0x128>(v); }
DI float sum_x16(float v) { auto s = __builtin_amdgcn_permlane16_swap(__float_as_uint(v), __float_as_uint(v), false, false); return __uint_as_float(s[0]) + __uint_as_float(s[1]); }
DI float sum_x32(float v) { auto s = __builtin_amdgcn_permlane32_swap(__float_as_uint(v), __float_as_uint(v), false, false); return __uint_as_float(s[0]) + __uint_as_float(s[1]); }
DI float max_x16(float v) { auto s = __builtin_amdgcn_permlane16_swap(__float_as_uint(v), __float_as_uint(v), false, false); return fmaxf(__uint_as_float(s[0]), __uint_as_float(s[1])); }
DI float max_x32(float v) { auto s = __builtin_amdgcn_permlane32_swap(__float_as_uint(v), __float_as_uint(v), false, false); return fmaxf(__uint_as_float(s[0]), __uint_as_float(s[1])); }
DI unsigned get_x32(unsigned v, int h) { auto s = __builtin_amdgcn_permlane32_swap(v, v, false, false); return h ? s[0] : s[1]; }
DI float wave_sum(float v) { v += lx1(v); v += lx2(v); v += lhm(v); v += lr8(v); v = sum_x16(v); return sum_x32(v); }
DI float wave_max(float v) { v = fmaxf(v, lx1(v)); v = fmaxf(v, lx2(v)); v = fmaxf(v, lhm(v)); v = fmaxf(v, lr8(v)); v = max_x16(v); return max_x32(v); }
DI int bperm(int v, int srclane) { return __builtin_amdgcn_ds_bpermute(srclane << 2, v); }
DI float bpermf(float v, int srclane) { return __builtin_bit_cast(float, __builtin_amdgcn_ds_bpermute(srclane << 2, __builtin_bit_cast(int, v))); }
DI float gelu_tanh(float x) {
    const float u = 0.7978845608028654f * (x + 0.044715f * x * x * x);
    return x * frcp(1.f + fexp2(-2.f * LOG2E * u));
}
DI float dot2bf(unsigned a, unsigned b, float c) {
    return __builtin_amdgcn_fdot2_f32_bf16(__builtin_bit_cast(bf16x2v, a), __builtin_bit_cast(bf16x2v, b), c, false);
}
DI int rel_bucket_i(int d) {
    if (d < 16) return d < 0 ? 0 : d;
    int b = 16;
    b += d >= 21; b += d >= 27; b += d >= 35; b += d >= 46; b += d >= 59; b += d >= 77; b += d >= 99; b += d >= 128;
    b += d >= 166; b += d >= 216; b += d >= 280; b += d >= 363; b += d >= 470; b += d >= 609; b += d >= 790;
    return b;
}
DI unsigned f2key(float f) { unsigned u = __float_as_uint(f); return u ^ ((unsigned)((int)u >> 31) | 0x80000000u); }
DI float key2f(unsigned k) { unsigned u = (k & 0x80000000u) ? (k ^ 0x80000000u) : ~k; return __uint_as_float(u); }

constexpr int EPI_LDS = 96 * 1024;

DI int sw2(int row, int chunk) { return (row >> 1) * 256 + (((((row & 1) << 3) | chunk) ^ ((row >> 1) & 15)) << 4); }
DI void sw2_src(int P, int& row, int& chunk) { const int R2 = P >> 4, lc = (P & 15) ^ (R2 & 15); row = 2 * R2 + (lc >> 3); chunk = lc & 7; }

template <class T, class = void> struct epi_stash { static constexpr bool value = false, present = false; };
template <class T> struct epi_stash<T, decltype((void)T::STASH)> { static constexpr bool value = T::STASH, present = true; };

template <int MT, class Epi>
DI void gemm_tile(const bf16_t* __restrict__ A, long lda, int M, const bf16_t* __restrict__ Bt, long ldb, int N, int K,
                  int m0, int n0, const Epi& epi, unsigned char* lds, int tid) {
    constexpr int XS = MT * 128 * 128, WS = 256 * 128, STAGE = XS + WS;
    const int lane = tid & 63, w = tid >> 6, tg = w & 3, fh = w >> 2, r = lane & 31, h = lane >> 5;
    const int wbase = tid & ~63;
    unsigned xo[2 * MT], wo[4];
#pragma unroll
    for (int i = 0; i < 2 * MT; ++i) { int row, c; sw2_src(tid + 512 * i, row, c); int m = m0 + row; m = m < M ? m : M - 1; xo[i] = (unsigned)m * (unsigned)(lda * 2) + c * 16; }
#pragma unroll
    for (int i = 0; i < 4; ++i) { int row, c; sw2_src(tid + 512 * i, row, c); int n = n0 + row; n = n < N ? n : N - 1; wo[i] = (unsigned)n * (unsigned)(ldb * 2) + c * 16; }
    const unsigned char* Ab = (const unsigned char*)A;
    const unsigned char* Bb = (const unsigned char*)Bt;
    auto stage = [&](int kt, unsigned char* st) {
#pragma unroll
        for (int i = 0; i < 2 * MT; ++i)
            __builtin_amdgcn_global_load_lds((const unsigned*)(Ab + kt * 128 + xo[i]), (unsigned*)(st + (wbase + 512 * i) * 16), 16, 0, 0);
#pragma unroll
        for (int i = 0; i < 4; ++i)
            __builtin_amdgcn_global_load_lds((const unsigned*)(Bb + kt * 128 + wo[i]), (unsigned*)(st + XS + (wbase + 512 * i) * 16), 16, 0, 0);
    };
    f32x16 acc[MT][4];
#pragma unroll
    for (int s2 = 0; s2 < MT; ++s2)
#pragma unroll
        for (int i = 0; i < 4; ++i)
#pragma unroll
            for (int j = 0; j < 16; ++j) acc[s2][i][j] = 0.f;
    const int nk = K >> 6;
    stage(0, lds);
    __syncthreads();
    for (int kt = 0; kt < nk; ++kt) {
        unsigned char* cur = lds + (kt & 1) * STAGE;
        if (kt + 1 < nk) stage(kt + 1, lds + ((kt + 1) & 1) * STAGE);
        bf16x8 xfa[MT], wfa[4], xfb[MT], wfb[4];
        auto ldf = [&](bf16x8 (&xf)[MT], bf16x8 (&wf)[4], int ks) {
#pragma unroll
            for (int s2 = 0; s2 < MT; ++s2) xf[s2] = *(const bf16x8*)(cur + sw2(32 * MT * tg + 32 * s2 + r, 2 * ks + h));
#pragma unroll
            for (int mt = 0; mt < 4; ++mt) wf[mt] = *(const bf16x8*)(cur + XS + sw2(128 * fh + 32 * mt + r, 2 * ks + h));
        };
        auto mm = [&](const bf16x8 (&xf)[MT], const bf16x8 (&wf)[4]) {
#pragma unroll
            for (int mt = 0; mt < 4; ++mt)
#pragma unroll
                for (int s2 = 0; s2 < MT; ++s2) acc[s2][mt] = MFMA32(wf[mt], xf[s2], acc[s2][mt]);
        };
        ldf(xfa, wfa, 0);
        ldf(xfb, wfb, 1); __builtin_amdgcn_sched_barrier(0); mm(xfa, wfa); __builtin_amdgcn_sched_barrier(0);
        ldf(xfa, wfa, 2); __builtin_amdgcn_sched_barrier(0); mm(xfb, wfb); __builtin_amdgcn_sched_barrier(0);
        ldf(xfb, wfb, 3); __builtin_amdgcn_sched_barrier(0); mm(xfa, wfa); __builtin_amdgcn_sched_barrier(0);
        mm(xfb, wfb);
        __syncthreads();
    }
    if constexpr (MT == 2 && epi_stash<Epi>::value) {
        float* sp = (float*)lds + w * 4096 + lane;
#pragma unroll
        for (int mt = 0; mt < 4; ++mt)
#pragma unroll
            for (int j = 0; j < 16; ++j) sp[(mt * 16 + j) * 64] = acc[1][mt][j];
        epi(acc[0], m0 + 64 * tg + r, n0 + 128 * fh, h, lds, tid);
        f32x16 a2[4];
        const float* sp2 = sp; asm volatile("" : "+v"(sp2));
#pragma unroll
        for (int mt = 0; mt < 4; ++mt)
#pragma unroll
            for (int j = 0; j < 16; ++j) a2[mt][j] = sp2[(mt * 16 + j) * 64];
        epi(a2, m0 + 64 * tg + 32 + r, n0 + 128 * fh, h, lds, tid);
        __syncthreads();
    } else {
        int ho = h, ro = r, to = tid;
        if constexpr (epi_stash<Epi>::present) asm volatile("" : "+v"(ho), "+v"(ro), "+v"(to));
#pragma unroll
        for (int s2 = 0; s2 < MT; ++s2) epi(acc[s2], m0 + 32 * MT * tg + 32 * s2 + ro, n0 + 128 * fh, ho, lds, to);
    }
}

DI void store_vt_tile(bf16_t* base, long rstride, const f32x16& a, int row0, int h, int lane) {
    const bool odd = lane & 1;
#pragma unroll
    for (int rg = 0; rg < 16; rg += 2) {
        const float xa = lx1(a[rg]), xb = lx1(a[rg + 1]);
        const unsigned wv = odd ? pk2(xb, a[rg + 1]) : pk2(a[rg], xa);
        bf16_t* dp = base + (long)(row0 + crow(odd ? rg + 1 : rg, h)) * rstride - (odd ? 1 : 0);
        *(unsigned*)dp = wv;
    }
}
struct EpiQKV0 {
    bf16_t *Q, *Kk, *VT;
    const float *qg, *kg;
    float* MB; const float* relb;
    DI void operator()(const f32x16 (&acc)[4], int tok, int fbase, int h, unsigned char*, int) const {
        const int sec = fbase >> 10, hd = (fbase & 1023) >> 7, b = tok >> 13, s = tok & (SEQ - 1);
        if (sec < 2) {
            const float* gn = sec == 0 ? qg : kg;
            const float sc = sec == 0 ? 0.125f * LOG2E : 1.f;
            bf16_t* dst = sec == 0 ? Q : Kk;
#pragma unroll
            for (int j = 0; j < 2; ++j) {
                float ss = 0.f;
#pragma unroll
                for (int mt = 0; mt < 2; ++mt)
#pragma unroll
                    for (int rg = 0; rg < 16; ++rg) { const float v = acc[2 * j + mt][rg]; ss += v * v; }
                ss = sum_x32(ss);
                const float rstd = rsqrtf(ss * (1.f / 64.f) + EPS) * sc;
                bf16_t* row = dst + ((long)((b * 8 + hd) * 2 + j) * SEQ + s) * 64;
                float qq = 0.f;
#pragma unroll
                for (int mt = 0; mt < 2; ++mt)
#pragma unroll
                    for (int g4 = 0; g4 < 4; ++g4) {
                        const int d0 = 32 * mt + 8 * g4 + 4 * h;
                        const f32x4 gv = *(const f32x4*)(gn + d0);
                        const float v0 = acc[2 * j + mt][4 * g4 + 0] * rstd * gv.x, v1 = acc[2 * j + mt][4 * g4 + 1] * rstd * gv.y;
                        const float v2 = acc[2 * j + mt][4 * g4 + 2] * rstd * gv.z, v3 = acc[2 * j + mt][4 * g4 + 3] * rstd * gv.w;
                        qq += v0 * v0 + v1 * v1 + v2 * v2 + v3 * v3;
                        u32x2 o;
                        o.x = pk2(v0, v1); o.y = pk2(v2, v3);
                        *(u32x2*)(row + d0) = o;
                    }
                if (sec == 0) {
                    qq = sum_x32(qq);
                    float kmx = 0.f;
                    for (int d = 0; d < 64; ++d) kmx = fmaxf(kmx, fabsf(kg[d]));
                    float bmx = 0.f;
                    for (int bk = 0; bk < 32; ++bk) bmx = fmaxf(bmx, relb[bk * 8 + hd] - relb[31 * 8 + hd]);
                    if (h == 0) MB[(long)((b * 8 + hd) * 2 + j) * SEQ + s] = 1.01f * sqrtf(qq) * 8.f * kmx + bmx * LOG2E;
                }
            }
        } else {
            bf16_t* base = VT + (long)(b * 8 + hd) * 128 * SEQ + s;
#pragma unroll
            for (int mt = 0; mt < 4; ++mt) store_vt_tile(base, SEQ, acc[mt], 32 * mt, h, tok);
        }
    }
};

struct EpiResid {
    const float* xin; float* xout; const float* gate;
    DI void operator()(const f32x16 (&acc)[4], int tok, int fbase, int h, unsigned char* lds, int tid) const {
        const int lane = tid & 63, w = tid >> 6, r = lane & 31, hh = lane >> 5;
        float* T = (float*)(lds + w * 16896);
#pragma unroll
        for (int mt = 0; mt < 4; ++mt)
#pragma unroll
            for (int g4 = 0; g4 < 4; ++g4)
                *(f32x4*)(T + r * 132 + 32 * mt + 8 * g4 + 4 * h) = (f32x4){acc[mt][4 * g4 + 0], acc[mt][4 * g4 + 1], acc[mt][4 * g4 + 2], acc[mt][4 * g4 + 3]};
        const int tok0 = tok - r, b = tok0 >> 13, f = fbase + 4 * r;
        const f32x4 gv = *(const f32x4*)(gate + b * ADA_STRIDE + f);
        __builtin_amdgcn_sched_barrier(0);
        const float* xp = xin + (long)(tok0 + hh) * DM + f;
        float* op = xout + (long)(tok0 + hh) * DM + f;
        const float* tp = T + hh * 132 + 4 * r;
#pragma unroll
        for (int i0 = 0; i0 < 16; i0 += 4) {
            f32x4 xv[4];
#pragma unroll
            for (int i = 0; i < 4; ++i) xv[i] = *(const f32x4*)(xp + (long)(2 * (i0 + i)) * DM);
#pragma unroll
            for (int i = 0; i < 4; ++i) {
                const f32x4 a = *(const f32x4*)(tp + 2 * (i0 + i) * 132);
                f32x4 o;
                o.x = xv[i].x + gv.x * a.x; o.y = xv[i].y + gv.y * a.y; o.z = xv[i].z + gv.z * a.z; o.w = xv[i].w + gv.w * a.w;
                *(f32x4*)(op + (long)(2 * (i0 + i)) * DM) = o;
            }
            __builtin_amdgcn_sched_barrier(0);
        }
        __syncthreads();
    }
};

struct EpiKV {
    bf16_t *KC, *KS, *VST, *KW, *VWT;
    const float* kgain;
    DI void operator()(const f32x16 (&acc)[4], int tok, int fbase, int h, unsigned char*, int) const {
        const int c = fbase >> 7, br = c >> 2, kv = (c >> 1) & 1, g = c & 1, b = tok >> 13, s = tok & (SEQ - 1);
        if (br == 0 || kv == 0) {
            float rstd = 1.f;
            bf16_t* row;
            if (br == 0) row = KC + ((long)((kv * 4 + b) * 2 + g) * SEQ + s) * 128;
            else {
                float ss = 0.f;
#pragma unroll
                for (int mt = 0; mt < 4; ++mt)
#pragma unroll
                    for (int rg = 0; rg < 16; ++rg) ss += acc[mt][rg] * acc[mt][rg];
                ss = sum_x32(ss);
                rstd = rsqrtf(ss * (1.f / 128.f) + EPS);
                row = (br == 1 ? KS : KW) + ((long)(b * 2 + g) * SEQ + s) * 128;
            }
#pragma unroll
            for (int mt = 0; mt < 4; ++mt)
#pragma unroll
                for (int g4 = 0; g4 < 4; ++g4) {
                    const int d0 = 32 * mt + 8 * g4 + 4 * h;
                    f32x4 gv = {1.f, 1.f, 1.f, 1.f};
                    if (br != 0) gv = *(const f32x4*)(kgain + br * 128 + d0);
                    u32x2 o;
                    o.x = pk2(acc[mt][4 * g4 + 0] * rstd * gv.x, acc[mt][4 * g4 + 1] * rstd * gv.y);
                    o.y = pk2(acc[mt][4 * g4 + 2] * rstd * gv.z, acc[mt][4 * g4 + 3] * rstd * gv.w);
                    *(u32x2*)(row + d0) = o;
                }
        } else {
            bf16_t* base = (br == 1 ? VST : VWT) + (long)(b * 2 + g) * 128 * SEQ + s;
#pragma unroll
            for (int mt = 0; mt < 4; ++mt) store_vt_tile(base, SEQ, acc[mt], 32 * mt, h, tok);
        }
    }
};

struct EpiCmp1 {
    bf16_t* hid; const float* posb_part; const float* b1;
    DI void operator()(const f32x16 (&acc)[4], int tok, int fbase, int h, unsigned char*, int) const {
        if (tok >= 512) return;
#pragma unroll
        for (int mt = 0; mt < 4; ++mt)
#pragma unroll
            for (int g4 = 0; g4 < 4; ++g4) {
                const int f = fbase + 32 * mt + 8 * g4 + 4 * h;
                f32x4 pb = *(const f32x4*)(b1 + f);
                for (int c = 0; c < 16; ++c) { const f32x4 t = *(const f32x4*)(posb_part + c * 256 + f); pb.x += t.x; pb.y += t.y; pb.z += t.z; pb.w += t.w; }
                u32x2 o;
                o.x = pk2(gelu_tanh(acc[mt][4 * g4 + 0] + pb.x), gelu_tanh(acc[mt][4 * g4 + 1] + pb.y));
                o.y = pk2(gelu_tanh(acc[mt][4 * g4 + 2] + pb.z), gelu_tanh(acc[mt][4 * g4 + 3] + pb.w));
                *(u32x2*)(hid + (long)tok * 256 + f) = o;
            }
    }
};

struct EpiCmp2 {
    bf16_t* dst; const float* kgain0; int kv;
    DI void operator()(const f32x16 (&acc)[4], int tok, int fbase, int h, unsigned char*, int) const {
        if (fbase != 0 || tok >= 512) return;
        const float valid = tok < 511 ? 1.f : 0.f;
        if (kv == 0) {
            float ss = 0.f;
#pragma unroll
            for (int mt = 0; mt < 4; ++mt)
#pragma unroll
                for (int rg = 0; rg < 16; ++rg) ss += acc[mt][rg] * acc[mt][rg];
            ss = sum_x32(ss);
            const float rstd = rsqrtf(ss * (1.f / 128.f) + EPS) * valid;
#pragma unroll
            for (int mt = 0; mt < 4; ++mt)
#pragma unroll
                for (int g4 = 0; g4 < 4; ++g4) {
                    const int d0 = 32 * mt + 8 * g4 + 4 * h;
                    const f32x4 gv = *(const f32x4*)(kgain0 + d0);
                    u32x2 o;
                    o.x = pk2(acc[mt][4 * g4 + 0] * rstd * gv.x, acc[mt][4 * g4 + 1] * rstd * gv.y);
                    o.y = pk2(acc[mt][4 * g4 + 2] * rstd * gv.z, acc[mt][4 * g4 + 3] * rstd * gv.w);
                    *(u32x2*)(dst + (long)tok * 128 + d0) = o;
                }
        } else {
#pragma unroll
            for (int mt = 0; mt < 4; ++mt)
#pragma unroll
                for (int rg = 0; rg < 16; ++rg) dst[(long)(32 * mt + crow(rg, h)) * 512 + tok] = f2bf(acc[mt][rg] * valid);
        }
    }
};

struct EpiNsaQ {
    bf16_t* QN; float* gates; const float* qgain; const float* bgate; float* qnrm;
    DI void operator()(const f32x16 (&acc)[4], int tok, int fbase, int h, unsigned char*, int) const {
        const int b = tok >> 13, s = tok & (SEQ - 1);
        if (fbase < 1024) {
            const int head = fbase >> 7;
            float ss = 0.f;
#pragma unroll
            for (int mt = 0; mt < 4; ++mt)
#pragma unroll
                for (int rg = 0; rg < 16; ++rg) ss += acc[mt][rg] * acc[mt][rg];
            ss = sum_x32(ss);
            const float rstd = rsqrtf(ss * (1.f / 128.f) + EPS) * (0.08838834764831845f * LOG2E);
            bf16_t* row = QN + ((long)(b * 8 + head) * SEQ + s) * 128;
            float qq = 0.f;
#pragma unroll
            for (int mt = 0; mt < 4; ++mt)
#pragma unroll
                for (int g4 = 0; g4 < 4; ++g4) {
                    const int d0 = 32 * mt + 8 * g4 + 4 * h;
                    const f32x4 gv = *(const f32x4*)(qgain + d0);
                    const float v0 = acc[mt][4 * g4 + 0] * rstd * gv.x, v1 = acc[mt][4 * g4 + 1] * rstd * gv.y;
                    const float v2 = acc[mt][4 * g4 + 2] * rstd * gv.z, v3 = acc[mt][4 * g4 + 3] * rstd * gv.w;
                    qq += v0 * v0 + v1 * v1 + v2 * v2 + v3 * v3;
                    u32x2 o;
                    o.x = pk2(v0, v1); o.y = pk2(v2, v3);
                    *(u32x2*)(row + d0) = o;
                }
            qq = sum_x32(qq);
            if (h == 0) qnrm[(long)tok * 8 + head] = 1.01f * sqrtf(qq);
        } else if (fbase == 1024) {
#pragma unroll
            for (int rg = 0; rg < 16; ++rg) {
                const int f = crow(rg, h);
                if (f < 24) { const float z = acc[0][rg] + bgate[f]; gates[(long)tok * 24 + f] = frcp(1.f + fexp2(-LOG2E * z)); }
            }
        }
    }
};

DI void ce_desc(unsigned& a, unsigned& b) { const unsigned hi = a > b ? a : b, lo = a > b ? b : a; a = hi; b = lo; }
DI void sort16_desc(unsigned (&a)[16]) {
#define CE_(i, j) ce_desc(a[i], a[j]);
    CE_(0,13) CE_(1,12) CE_(2,15) CE_(3,14) CE_(4,8) CE_(5,6) CE_(7,11) CE_(9,10)
    CE_(0,5) CE_(1,7) CE_(2,9) CE_(3,4) CE_(6,13) CE_(8,14) CE_(10,15) CE_(11,12)
    CE_(0,1) CE_(2,3) CE_(4,5) CE_(6,8) CE_(7,9) CE_(10,11) CE_(12,13) CE_(14,15)
    CE_(0,2) CE_(1,3) CE_(4,10) CE_(5,11) CE_(6,7) CE_(8,9) CE_(12,14) CE_(13,15)
    CE_(1,2) CE_(3,12) CE_(4,6) CE_(5,7) CE_(8,10) CE_(9,11) CE_(13,14)
    CE_(1,4) CE_(2,6) CE_(5,8) CE_(7,10) CE_(9,13) CE_(11,14)
    CE_(2,4) CE_(3,6) CE_(9,12) CE_(11,13)
    CE_(3,5) CE_(6,8) CE_(7,9) CE_(10,12)
    CE_(3,4) CE_(5,6) CE_(7,8) CE_(9,10) CE_(11,12)
    CE_(6,7) CE_(8,9)
#undef CE_
}
DI void bitonic_merge16_desc(unsigned (&a)[16]) {
#pragma unroll
    for (int st = 8; st >= 1; st >>= 1)
#pragma unroll
        for (int i = 0; i < 16; ++i)
            if ((i & st) == 0) ce_desc(a[i], a[i + st]);
}
DI void merge_top16(unsigned (&a)[16], const unsigned (&b)[16]) {
#pragma unroll
    for (int i = 0; i < 16; ++i) a[i] = a[i] > b[15 - i] ? a[i] : b[15 - i];
    bitonic_merge16_desc(a);
}

struct EpiPeer {
    static constexpr bool STASH = false;
    int* ridx; float* rgate; int ex_off;
    DI void operator()(const f32x16 (&acc)[4], int tok, int fbase, int h, unsigned char* lds, int tid) const {
        const int lane = tid & 63, w = tid >> 6, tg = w & 3, fh = w >> 2, r = lane & 31;
        const int hd = fbase >> 8;
        unsigned* EX = (unsigned*)(lds + ex_off);
        unsigned L[16];
        {
            unsigned G1[16], G2[16], G3[16];
#pragma unroll
            for (int rg = 0; rg < 16; ++rg) {
                const int c = crow(rg, h);
                L[rg] = (f2key(acc[0][rg]) & ~127u) | (unsigned)(127 - c);
                G1[rg] = (f2key(acc[1][rg]) & ~127u) | (unsigned)(127 - 32 - c);
                G2[rg] = (f2key(acc[2][rg]) & ~127u) | (unsigned)(127 - 64 - c);
                G3[rg] = (f2key(acc[3][rg]) & ~127u) | (unsigned)(127 - 96 - c);
            }
            sort16_desc(L); sort16_desc(G1); merge_top16(L, G1);
            sort16_desc(G2); sort16_desc(G3); merge_top16(G2, G3);
            merge_top16(L, G2);
        }
        {
            unsigned P[16];
#pragma unroll
            for (int i = 0; i < 16; ++i) P[i] = get_x32(L[i], h);
            merge_top16(L, P);
        }
        if (h == 0) {
#pragma unroll
            for (int i = 0; i < 16; i += 4) *(u32x4*)(EX + ((fh * 4 + tg) * 32 + r) * 16 + i) = (u32x4){L[i], L[i + 1], L[i + 2], L[i + 3]};
        }
        __syncthreads();
        float xf[4], ys[16];
        {
            const unsigned* l0 = EX + ((0 * 4 + tg) * 32 + r) * 16;
            const unsigned* l1 = EX + ((1 * 4 + tg) * 32 + r) * 16;
            const unsigned* px = h ? l1 : l0;
            const unsigned* py = h ? l0 : l1;
            const u32x4 a = *(const u32x4*)px;
            xf[0] = key2f(a.x & ~127u); xf[1] = key2f(a.y & ~127u); xf[2] = key2f(a.z & ~127u); xf[3] = key2f(a.w & ~127u);
            unsigned Y[16];
#pragma unroll
            for (int i = 0; i < 16; i += 4) { const u32x4 b2 = *(const u32x4*)(py + i); Y[i] = b2.x; Y[i + 1] = b2.y; Y[i + 2] = b2.z; Y[i + 3] = b2.w; }
#pragma unroll
            for (int k = 0; k < 15; ++k) ys[k] = key2f((h ? Y[k + 1] : Y[k]) & ~127u);
            ys[15] = key2f(Y[15] & ~127u);
        }
        auto pkey = [&](int i, int k) -> unsigned {
            const float fs = xf[i] + ys[k];
            const unsigned code = h ? (unsigned)((((k + 1) & 15) << 4) | i) : (unsigned)((i << 4) | k);
            return (f2key(fs) & ~255u) | (255u - code);
        };
        unsigned T[16], E[16];
#pragma unroll
        for (int k = 0; k < 16; ++k) T[k] = pkey(0, k);
        T[15] = h ? 0u : T[15];
#pragma unroll
        for (int k = 1; k <= 7; ++k) E[k - 1] = pkey(1, k);
#pragma unroll
        for (int k = 2; k <= 4; ++k) E[7 + k - 2] = pkey(2, k);
        E[10] = pkey(3, 3);
#pragma unroll
        for (int k = 11; k < 16; ++k) E[k] = 0u;
        sort16_desc(E);
        merge_top16(T, E);
        {
            unsigned P[16];
#pragma unroll
            for (int i = 0; i < 16; ++i) P[i] = get_x32(T[i], h);
            merge_top16(T, P);
        }
        float sc[16], sum = 0.f;
        const float mx = key2f(T[0] & ~255u);
#pragma unroll
        for (int k = 0; k < 16; ++k) { sc[k] = fexp2((key2f(T[k] & ~255u) - mx) * LOG2E); sum += sc[k]; }
        const float inv = frcp(sum);
        if (h == 0) {
            const unsigned* l0 = EX + ((0 * 4 + tg) * 32 + r) * 16;
            const unsigned* l1 = EX + ((1 * 4 + tg) * 32 + r) * 16;
#pragma unroll
            for (int k = 0; k < 16; ++k) {
                if ((k >> 3) != fh) continue;
                const unsigned code = 255u - (T[k] & 255u);
                const int i1 = 127 - (int)(l0[code >> 4] & 127u), i2 = 127 - (int)(l1[code & 15u] & 127u);
                ridx[(long)tok * 128 + hd * 16 + k] = i1 * 128 + i2;
                rgate[(long)tok * 128 + hd * 16 + k] = sc[k] * inv;
            }
        }
        __syncthreads();
    }
};

DI void p0_transpose_item(const float* __restrict__ W, int K, int N, bf16_t* __restrict__ WT, int item, int ntn, unsigned char* lds, int tid) {
    float* tile = (float*)lds;
    const int kb = item / ntn, nb = item % ntn, k0 = kb * 64, n0 = nb * 64;
    {
        const int nn = tid & 63, kk0 = tid >> 6;
#pragma unroll
        for (int i = 0; i < 8; ++i) { const int kk = kk0 + 8 * i; const int n = n0 + nn; tile[kk * 65 + nn] = n < N ? W[(long)(k0 + kk) * N + n] : 0.f; }
    }
    __syncthreads();
    {
        const int n = tid >> 3, c = tid & 7;
        const float* s = tile + (8 * c) * 65 + n;
        u32x4 o;
        o.x = pk2(s[0], s[65]); o.y = pk2(s[2 * 65], s[3 * 65]); o.z = pk2(s[4 * 65], s[5 * 65]); o.w = pk2(s[6 * 65], s[7 * 65]);
        *(u32x4*)(WT + (long)(n0 + n) * K + k0 + 8 * c) = o;
    }
    __syncthreads();
}

DI int pack_i8x4(float a, float b, float c, float d) {
    const int ia = __float2int_rn(a), ib = __float2int_rn(b), ic = __float2int_rn(c), id = __float2int_rn(d);
    return (ia & 255) | ((ib & 255) << 8) | ((ic & 255) << 16) | (id << 24);
}
DI void p0_fp8_item(const float* __restrict__ src, unsigned char* __restrict__ dst, float* __restrict__ sinv, bool sliced, int item, int tid) {
    const int lane = tid & 63, row = item * 8 + (tid >> 6);
    const float* rp = src + (long)row * 1024;
    f32x4 v[4]; float am = 0.f;
#pragma unroll
    for (int j = 0; j < 4; ++j) {
        v[j] = *(const f32x4*)(rp + 4 * lane + 256 * j);
        am = fmaxf(am, fmaxf(fmaxf(fabsf(v[j].x), fabsf(v[j].y)), fmaxf(fabsf(v[j].z), fabsf(v[j].w))));
    }
    am = wave_max(am);
    const float sc = sliced ? (am > 0.f ? exp2f(floorf(log2f(384.f / am))) : 1.f) : (am > 0.f ? 127.f / am : 1.f);
    if (lane == 0) sinv[row] = 1.f / sc;
#pragma unroll
    for (int j = 0; j < 4; ++j) {
        int pk = 0;
        if (sliced) {
            pk = __builtin_amdgcn_cvt_pk_fp8_f32(v[j].x * sc, v[j].y * sc, pk, false);
            pk = __builtin_amdgcn_cvt_pk_fp8_f32(v[j].z * sc, v[j].w * sc, pk, true);
        } else pk = pack_i8x4(v[j].x * sc, v[j].y * sc, v[j].z * sc, v[j].w * sc);
        const int col = 4 * lane + 256 * j;
        unsigned char* d = sliced ? dst + ((long)(col >> 7) * 16384 + row) * 128 + (col & 127) : dst + (long)row * 1024 + col;
        *(int*)d = pk;
    }
}

DI void p0_weff_item(const float* __restrict__ wq, const float* __restrict__ subk, bf16_t* __restrict__ WT, int item, unsigned char* lds, int tid) {
    const int layer = item >> 8, g = (item >> 4) & 15, ct = item & 15, p = g & 1, c0 = ct * 64;
    float* As = (float*)lds;
    float* Bs = As + 64 * 129;
    const float* wql = wq + (long)layer * 1024 * 2048;
    const float* sk = subk + ((long)layer * 2 + p) * 128 * 128;
    for (int e = tid; e < 64 * 128; e += NTHREADS) { const int c = e >> 7, d = e & 127; As[c * 129 + d] = wql[(long)(c0 + c) * 2048 + g * 128 + d]; }
    for (int e = tid; e < 128 * 128; e += NTHREADS) { const int k = e >> 7, d = e & 127; Bs[k * 129 + d] = sk[k * 128 + d]; }
    __syncthreads();
    const int lane = tid & 63, w = tid >> 6, ti = w & 3, tj = w >> 2, r = lane & 31, h = lane >> 5;
    f32x16 acc;
#pragma unroll
    for (int i = 0; i < 16; ++i) acc[i] = 0.f;
    const float* ap = Bs + (32 * ti + r) * 129 + h;
    const float* bp = As + (32 * tj + r) * 129 + h;
#pragma unroll 8
    for (int d = 0; d < 128; d += 2) acc = __builtin_amdgcn_mfma_f32_32x32x2f32(ap[d], bp[d], acc, 0, 0, 0);
    bf16_t* o = WT + ((long)layer * 2048 + g * 128 + 32 * ti) * 1024 + c0 + 32 * tj + r;
#pragma unroll
    for (int i = 0; i < 16; ++i) o[(long)crow(i, h) * 1024] = f2bf(acc[i]);
    __syncthreads();
}

DI void p0_posb_item(const float* __restrict__ pos, const float* __restrict__ w1, float* __restrict__ part, int item, unsigned char* lds, int tid) {
    const int kv = item >> 4, ch = item & 15;
    float* red = (float*)lds;
    const int j = tid & 255, half = tid >> 8;
    const float* pp = pos + (long)kv * 4096 + ch * 256 + half * 128;
    const float* ww = w1 + ((long)kv * 4096 + ch * 256 + half * 128) * 256 + j;
    float a = 0.f;
    for (int f = 0; f < 128; ++f) a += pp[f] * ww[(long)f * 256];
    red[half * 256 + j] = a;
    __syncthreads();
    if (tid < 256) part[(kv * 16 + ch) * 256 + tid] = red[tid] + red[256 + tid];
    __syncthreads();
}

DI void p0_ada_item(const Params& p, float* __restrict__ ada, int item, unsigned char* lds, int tid) {
    float* cact = (float*)lds;
    float* red = cact + 4096;
    const float* c = p.in[1];
    for (int e = tid; e < 4096; e += NTHREADS) { const float v = c[e]; cact[e] = v * frcp(1.f + fexp2(-LOG2E * v)); }
    __syncthreads();
    const int colg = item * 64;
    const float* W; const float* bias; int N, n0;
    if (colg < 6144) { W = p.in[3]; bias = p.in[4]; N = 6144; n0 = colg; }
    else if (colg < 12288) { W = p.in[3] + (long)1024 * 6144; bias = p.in[4] + 6144; N = 6144; n0 = colg - 6144; }
    else { W = p.in[14]; bias = p.in[15]; N = 2048; n0 = colg - 12288; }
    const int col = tid & 63, kg = tid >> 6;
    float a0 = 0.f, a1 = 0.f, a2 = 0.f, a3 = 0.f;
    const float* wp = W + (long)(kg * 128) * N + n0 + col;
#pragma unroll 8
    for (int k = 0; k < 128; ++k) {
        const float wv = wp[(long)k * N];
        const int kk = kg * 128 + k;
        a0 += cact[kk] * wv; a1 += cact[1024 + kk] * wv; a2 += cact[2048 + kk] * wv; a3 += cact[3072 + kk] * wv;
    }
    red[(kg * 4 + 0) * 64 + col] = a0; red[(kg * 4 + 1) * 64 + col] = a1; red[(kg * 4 + 2) * 64 + col] = a2; red[(kg * 4 + 3) * 64 + col] = a3;
    __syncthreads();
    if (tid < 256) {
        const int b = tid >> 6, cc = tid & 63;
        float s = bias[n0 + cc];
#pragma unroll
        for (int q = 0; q < 8; ++q) s += red[(q * 4 + b) * 64 + cc];
        ada[b * ADA_STRIDE + colg + cc] = s;
    }
    __syncthreads();
}

constexpr int P0_CONV = 8192, P0_TR_DIN = 768, P0_TR_DOUT = 256, P0_TR_KV = 384, P0_TR_NIN = 288, P0_TR_NOUT = 256, P0_TR_C1 = 512, P0_TR_C2 = 16,
              P0_WEFF = 512, P0_POSB = 32, P0_ADA = 224;
constexpr int P0_TOTAL = P0_CONV + P0_TR_DIN + P0_TR_DOUT + P0_TR_KV + P0_TR_NIN + P0_TR_NOUT + P0_TR_C1 + P0_TR_C2 + P0_WEFF + P0_POSB + P0_ADA;

DI void phase_prep(const Params& p, unsigned char* lds, int tid) {
    unsigned char* ws = p.ws;
    for (int it = blockIdx.x; it < P0_TOTAL; it += gridDim.x) {
        int r = it;
        if (r < P0_ADA) { p0_ada_item(p, (float*)(ws + OFF_ADA), r, lds, tid); continue; } r -= P0_ADA;
        if (r < P0_WEFF) { p0_weff_item(p.in[26], p.in[27], (bf16_t*)(ws + OFF_WT_PEER), r, lds, tid); continue; } r -= P0_WEFF;
        if (r < P0_POSB) { p0_posb_item(p.in[17], p.in[18], (float*)(ws + OFF_POSB), r, lds, tid); continue; } r -= P0_POSB;
        if (r < P0_TR_DIN) { p0_transpose_item(p.in[7], 1024, 3072, (bf16_t*)(ws + OFF_WT_DIN), r, 48, lds, tid); continue; } r -= P0_TR_DIN;
        if (r < P0_TR_DOUT) { p0_transpose_item(p.in[8], 1024, 1024, (bf16_t*)(ws + OFF_WT_DOUT), r, 16, lds, tid); continue; } r -= P0_TR_DOUT;
        if (r < P0_TR_KV) { p0_transpose_item(p.in[16], 1024, 1536, (bf16_t*)(ws + OFF_WT_KV), r, 24, lds, tid); continue; } r -= P0_TR_KV;
        if (r < P0_TR_NIN) { p0_transpose_item(p.in[22], 1024, 1048, (bf16_t*)(ws + OFF_WT_NIN), r, 18, lds, tid); continue; } r -= P0_TR_NIN;
        if (r < P0_TR_NOUT) { p0_transpose_item(p.in[24], 1024, 1024, (bf16_t*)(ws + OFF_WT_NOUT), r, 16, lds, tid); continue; } r -= P0_TR_NOUT;
        if (r < P0_TR_C1) { const int kv = r >> 8; p0_transpose_item(p.in[18] + (long)kv * 4096 * 256, 4096, 256, (bf16_t*)(ws + OFF_WT_C1) + (long)kv * 256 * 4096, r & 255, 4, lds, tid); continue; } r -= P0_TR_C1;
        if (r < P0_TR_C2) { const int kv = r >> 3; p0_transpose_item(p.in[20] + (long)kv * 256 * 128, 256, 128, (bf16_t*)(ws + OFF_WT_C2) + (long)kv * 128 * 256, r & 7, 2, lds, tid); continue; } r -= P0_TR_C2;
        {
            const int tbl = r >> 11, sub = r & 2047;
            const int layer = tbl & 1;
            const float* src = (tbl < 2 ? p.in[28] : p.in[29]) + (long)layer * 16384 * 1024;
            unsigned char* dst = ws + (tbl < 2 ? OFF_PU : OFF_PV) + (long)layer * 16384 * 1024;
            float* sinv = (float*)(ws + (tbl < 2 ? OFF_USI : OFF_VSI)) + layer * 16384;
            p0_fp8_item(src, dst, sinv, tbl >= 2, sub, tid);
        }
    }
}

DI void norm_row_write(const f32x4 (&v)[4], float rstd, const float* gain, const float* shift, const float* scale, bf16_t* orow, int lane) {
#pragma unroll
    for (int j = 0; j < 4; ++j) {
        const int c = 4 * lane + 256 * j;
        const f32x4 g = *(const f32x4*)(gain + c), sh = *(const f32x4*)(shift + c), sc = *(const f32x4*)(scale + c);
        u32x2 o;
        o.x = pk2(v[j].x * rstd * g.x * (1.f + sc.x) + sh.x, v[j].y * rstd * g.y * (1.f + sc.y) + sh.y);
        o.y = pk2(v[j].z * rstd * g.z * (1.f + sc.z) + sh.z, v[j].w * rstd * g.w * (1.f + sc.w) + sh.w);
        *(u32x2*)(orow + c) = o;
    }
}
template <bool BF>
DI void phase_norm_q8(const float* __restrict__ x, bf16_t* __restrict__ out, unsigned char* __restrict__ out8, float* __restrict__ outs,
                      const float* gain, const float* ada, int shift_off, int scale_off, int tid) {
    const int lane = tid & 63, gw = blockIdx.x * NWAVES + (tid >> 6), nw = gridDim.x * NWAVES;
    for (int tok = gw; tok < NTOK; tok += nw) {
        const int b = tok >> 13;
        f32x4 v[4]; float ss = 0.f;
#pragma unroll
        for (int j = 0; j < 4; ++j) { v[j] = *(const f32x4*)(x + (long)tok * DM + 4 * lane + 256 * j); ss += v[j].x * v[j].x + v[j].y * v[j].y + v[j].z * v[j].z + v[j].w * v[j].w; }
        const float rstd = rsqrtf(wave_sum(ss) * (1.f / DM) + EPS);
        const float* shift = ada + b * ADA_STRIDE + shift_off; const float* scale = ada + b * ADA_STRIDE + scale_off;
        float am = 0.f;
#pragma unroll
        for (int j = 0; j < 4; ++j) {
            const int c = 4 * lane + 256 * j;
            const f32x4 g = *(const f32x4*)(gain + c), sh = *(const f32x4*)(shift + c), sc = *(const f32x4*)(scale + c);
            v[j].x = v[j].x * rstd * g.x * (1.f + sc.x) + sh.x; v[j].y = v[j].y * rstd * g.y * (1.f + sc.y) + sh.y;
            v[j].z = v[j].z * rstd * g.z * (1.f + sc.z) + sh.z; v[j].w = v[j].w * rstd * g.w * (1.f + sc.w) + sh.w;
            if constexpr (BF) { u32x2 o; o.x = pk2(v[j].x, v[j].y); o.y = pk2(v[j].z, v[j].w); *(u32x2*)(out + (long)tok * DM + c) = o; }
            am = fmaxf(am, fmaxf(fmaxf(fabsf(v[j].x), fabsf(v[j].y)), fmaxf(fabsf(v[j].z), fabsf(v[j].w))));
        }
        am = wave_max(am);
        const float qs = am > 0.f ? 127.f / am : 1.f;
#pragma unroll
        for (int j = 0; j < 4; ++j) *(int*)(out8 + (long)tok * DM + 4 * lane + 256 * j) = pack_i8x4(v[j].x * qs, v[j].y * qs, v[j].z * qs, v[j].w * qs);
        if (lane == 0) outs[tok] = am > 0.f ? am * (1.f / 127.f) : 1.f;
    }
}
DI void phase_norm(const float* __restrict__ x, bf16_t* __restrict__ out, const float* gain, const float* ada, int shift_off, int scale_off, int tid) {
    const int lane = tid & 63, gw = blockIdx.x * NWAVES + (tid >> 6), nw = gridDim.x * NWAVES;
    for (int tok = gw; tok < NTOK; tok += nw) {
        const int b = tok >> 13;
        f32x4 v[4]; float ss = 0.f;
#pragma unroll
        for (int j = 0; j < 4; ++j) { v[j] = *(const f32x4*)(x + (long)tok * DM + 4 * lane + 256 * j); ss += v[j].x * v[j].x + v[j].y * v[j].y + v[j].z * v[j].z + v[j].w * v[j].w; }
        const float rstd = rsqrtf(wave_sum(ss) * (1.f / DM) + EPS);
        norm_row_write(v, rstd, gain, ada + b * ADA_STRIDE + shift_off, ada + b * ADA_STRIDE + scale_off, out + (long)tok * DM, lane);
    }
}

DI int kidx(int mt, int i) { return 32 * mt + 16 * (i >> 3) + (i & 7); }
template <int DQK>
DI void attn_qk32(const unsigned char* Ks, const bf16x8 (&qf)[DQK / 16], f32x16& st, int mt, int r, int h, float init = 0.f) {
    constexpr int RB = DQK * 2, MSK = DQK == 64 ? 7 : 15;
    const int row = 32 * mt + ((r & 0x13) | ((r & 4) << 1) | ((r & 8) >> 1));
#pragma unroll
    for (int i = 0; i < 16; ++i) st[i] = init;
#pragma unroll
    for (int ks = 0; ks < DQK / 16; ++ks) {
        const bf16x8 kf = RB == 128 ? *(const bf16x8*)(Ks + sw2(row, 2 * ks + h)) : *(const bf16x8*)(Ks + row * RB + (((2 * ks + h) ^ (row & MSK)) << 4));
        st = MFMA32(kf, qf[ks], st);
    }
}
DI void attn_pack32(const f32x16& st, bf16x8 (&pf)[2]) {
#pragma unroll
    for (int s = 0; s < 2; ++s) {
        u32x4 t;
        t.x = pk2(st[8 * s + 0], st[8 * s + 1]); t.y = pk2(st[8 * s + 2], st[8 * s + 3]);
        t.z = pk2(st[8 * s + 4], st[8 * s + 5]); t.w = pk2(st[8 * s + 6], st[8 * s + 7]);
        pf[s] = __builtin_bit_cast(bf16x8, t);
    }
}
DI void attn_softmax32(f32x16& st, float& m, float& l, f32x16 (&o)[4]) {
    float mx = st[0];
#pragma unroll
    for (int i = 1; i < 16; ++i) mx = fmaxf(mx, st[i]);
    mx = max_x32(mx);
    const float mn = fmaxf(m, mx);
    if (!__all(mn == m)) {
        const float alpha = fexp2(m - mn);
        l *= alpha;
#pragma unroll
        for (int dt = 0; dt < 4; ++dt)
#pragma unroll
            for (int i = 0; i < 16; ++i) o[dt][i] *= alpha;
        m = mn;
    }
    float sum = 0.f;
#pragma unroll
    for (int i = 0; i < 16; ++i) { const float pv = fexp2(st[i] - m); st[i] = pv; sum += pv; }
    l += sum;
}
DI void attn_softmax32_b(f32x16& st, float& l) {
    float sum = 0.f;
#pragma unroll
    for (int i = 0; i < 16; ++i) { const float pv = fexp2(st[i]); st[i] = pv; sum += pv; }
    l += sum;
}
DI void attn_pv32(const unsigned char* Vs, const bf16x8 (&pf)[2], f32x16 (&o)[4], int mt, int r, int h) {
#pragma unroll
    for (int dt = 0; dt < 4; ++dt)
#pragma unroll
        for (int s2 = 0; s2 < 2; ++s2) {
            const int row = 32 * dt + r;
            const bf16x8 vf = *(const bf16x8*)(Vs + sw2(row, 2 * (2 * mt + s2) + h));
            o[dt] = MFMA32(vf, pf[s2], o[dt]);
        }
}
template <int RB, int NROWS>
DI void dma_offsets(unsigned (&off)[NROWS * RB / 16 / 512], unsigned gstride, int tid) {
    constexpr int CPR = RB / 16;
#pragma unroll
    for (int i = 0; i < NROWS * CPR / 512; ++i) {
        const int idx = tid + 512 * i;
        int row, cp;
        if (RB == 128) sw2_src(idx, row, cp); else { row = idx / CPR; cp = (idx % CPR) ^ (row & (CPR - 1)); }
        off[i] = (unsigned)row * gstride + (cp << 4);
    }
}
template <int N>
DI void dma_issue(unsigned char* dst, const unsigned char* gbase, const unsigned (&off)[N], int tid) {
    const int wbase = tid & ~63;
#pragma unroll
    for (int i = 0; i < N; ++i)
        __builtin_amdgcn_global_load_lds((const unsigned*)(gbase + off[i]), (unsigned*)(dst + (wbase + 512 * i) * 16), 16, 0, 0);
}

constexpr int AT_STAGE = 32 * 1024;
constexpr int AT_LUT = 2 * AT_STAGE;
constexpr int LUT_N = 1280, LUT_OFF = 1100;
constexpr int LUTC_W = 52;
constexpr int AT_LUTC = AT_LUT + 20 * 1024;
constexpr int AT_IMP = AT_LUTC + 13 * 1024;
constexpr int AT_SEL = AT_IMP + 34 * 1024;

DI void phase_diff_attn(const Params& p, unsigned char* lds, int tid) {
    unsigned char* ws = p.ws;
    const bf16_t* Q = (const bf16_t*)(ws + OFF_Q0);
    const bf16_t* Kk = (const bf16_t*)(ws + OFF_K0);
    const bf16_t* VT = (const bf16_t*)(ws + OFF_VT0);
    bf16_t* O = (bf16_t*)(ws + OFF_H);
    const float* relb = p.in[2];
    const float* lam = p.in[9];
    const float* subln = p.in[12];
    const int lane = tid & 63, w = tid >> 6, comp = w & 1, qg = w >> 1, r = lane & 31, h = lane >> 5;
    float* lut = (float*)(lds + 128 * 1024);
    if (w >= 4) __builtin_amdgcn_s_setprio(1);
    float lam_full;
    {
        const float s01 = wave_sum(lam[lane] * lam[64 + lane]), s23 = wave_sum(lam[128 + lane] * lam[192 + lane]);
        lam_full = __expf(s01) - __expf(s23) + 0.2f;
    }
    const int G = gridDim.x, rows_per_it = G >> 5;
    unsigned koff[1], voff[2];
    dma_offsets<128, 64>(koff, 128, tid);
    dma_offsets<128, 128>(voff, SEQ * 2, tid);
    constexpr int ST2 = 64 * 1024;
    for (int it = 0;; ++it) {
        int qb, b, hd;
        if (G == 256) {
            if (it >= 8) break;
            const int xcd = blockIdx.x & 7, lb = blockIdx.x >> 3, pr = xcd * 4 + (it >> 1);
            qb = (it & 1) ? lb : 63 - lb; b = pr >> 3; hd = pr & 7;
        } else {
            int u;
            if ((G & 31) == 0) {
                const int rr = blockIdx.x >> 5, cc = blockIdx.x & 31;
                const int rowi = it * rows_per_it + ((it & 1) ? rows_per_it - 1 - rr : rr);
                u = rowi * 32 + cc;
            } else u = it * G + blockIdx.x;
            if (u >= 2048) break;
            qb = 63 - (u >> 5); b = (u & 31) >> 3; hd = u & 7;
        }
        const int q0 = qb * 128, ntiles = qb + 1;
        const int qpos = q0 + 32 * qg + r, qlo = q0 + 32 * qg, qhi = qlo + 31;
        for (int e = tid; e < LUT_N; e += NTHREADS) { const int d = LUT_OFF - e; lut[e] = d < 0 ? -INFINITY : (d >= 790 ? 0.f : (relb[rel_bucket_i(d) * 8 + hd] - relb[31 * 8 + hd]) * LOG2E); }
        bf16x8 qf[4];
        {
            const bf16_t* qrow = Q + ((long)((b * 8 + hd) * 2 + comp) * SEQ + qpos) * 64;
#pragma unroll
            for (int ks = 0; ks < 4; ++ks) qf[ks] = *(const bf16x8*)(qrow + 16 * ks + 8 * h);
        }
        const unsigned char* k0g = (const unsigned char*)(Kk + (long)((b * 8 + hd) * 2 + 0) * SEQ * 64);
        const unsigned char* k1g = (const unsigned char*)(Kk + (long)((b * 8 + hd) * 2 + 1) * SEQ * 64);
        const unsigned char* vtg = (const unsigned char*)(VT + (long)(b * 8 + hd) * 128 * SEQ);
        f32x16 o[4];
#pragma unroll
        for (int dt = 0; dt < 4; ++dt)
#pragma unroll
            for (int i = 0; i < 16; ++i) o[dt][i] = 0.f;
        float l = 0.f;
        const float nmb = -((const float*)(ws + OFF_MB0))[(long)((b * 8 + hd) * 2 + comp) * SEQ + qpos];
        auto stage = [&](int kt, unsigned char* st) {
#pragma unroll
            for (int sb = 0; sb < 2; ++sb) {
                dma_issue(st + sb * 8192, k0g + (long)(2 * kt + sb) * 8192, koff, tid);
                dma_issue(st + 16384 + sb * 8192, k1g + (long)(2 * kt + sb) * 8192, koff, tid);
                dma_issue(st + 32768 + sb * 16384, vtg + (long)(2 * kt + sb) * 128, voff, tid);
            }
        };
        stage(0, lds);
        __syncthreads();
        for (int kt = 0; kt < ntiles; ++kt) {
            unsigned char* cur = lds + (kt & 1) * ST2;
            if (kt + 1 < ntiles) stage(kt + 1, lds + ((kt + 1) & 1) * ST2);
            const bool nearb = qlo - (kt * 128 + 127) < 790;
            const int dbase0 = qpos - kt * 128 - 8 * h;
            const unsigned char* kb = cur + comp * 16384;
            f32x16 sa, sbv;
            attn_qk32<64>(kb, qf, sa, 0, r, h, nmb);
#pragma unroll
            for (int j = 0; j < 4; ++j) {
                f32x16& sc = (j & 1) ? sbv : sa;
                f32x16& sn = (j & 1) ? sa : sbv;
                if (j < 3) attn_qk32<64>(kb + ((j + 1) >> 1) * 8192, qf, sn, (j + 1) & 1, r, h, nmb);
                if (nearb) {
                    const float* lp = lut + (LUT_OFF - dbase0 + 64 * (j >> 1));
#pragma unroll
                    for (int i = 0; i < 16; ++i) sc[i] += lp[kidx(j & 1, i)];
                }
                attn_softmax32_b(sc, l);
                bf16x8 pf[2];
                attn_pack32(sc, pf);
                attn_pv32(cur + 32768 + (j >> 1) * 16384, pf, o, j & 1, r, h);
            }
            __syncthreads();
        }
        l = sum_x32(l);
        const float inv = l > 0.f ? frcp(l) : 0.f;
        float* xch = (float*)lds + qg * 4096;
        if (comp == 1) {
            const float sc = inv * lam_full;
#pragma unroll
            for (int dt = 0; dt < 4; ++dt)
#pragma unroll
                for (int i = 0; i < 16; ++i) xch[(dt * 16 + i) * 64 + lane] = o[dt][i] * sc;
        }
        __syncthreads();
        if (comp == 0) {
            float ss = 0.f;
#pragma unroll
            for (int dt = 0; dt < 4; ++dt)
#pragma unroll
                for (int i = 0; i < 16; ++i) { const float v = o[dt][i] * inv - xch[(dt * 16 + i) * 64 + lane]; o[dt][i] = v; ss += v * v; }
            ss = sum_x32(ss);
            const float rstd = rsqrtf(ss * (1.f / 128.f) + EPS) * 0.8f;
            bf16_t* orow = O + (long)(b * SEQ + qpos) * DM + hd * 128;
#pragma unroll
            for (int dt = 0; dt < 4; ++dt)
#pragma unroll
                for (int g4 = 0; g4 < 4; ++g4) {
                    const int d0 = 32 * dt + 8 * g4 + 4 * h;
                    const f32x4 gv = *(const f32x4*)(subln + d0);
                    u32x2 ov;
                    ov.x = pk2(o[dt][4 * g4 + 0] * rstd * gv.x, o[dt][4 * g4 + 1] * rstd * gv.y);
                    ov.y = pk2(o[dt][4 * g4 + 2] * rstd * gv.z, o[dt][4 * g4 + 3] * rstd * gv.w);
                    *(u32x2*)(orow + d0) = ov;
                }
        }
        __syncthreads();
    }
}

template <int VAR>
DI void phase_nsa_attn(const Params& p, unsigned char* lds, int tid) {
    unsigned char* ws = p.ws;
    const bf16_t* QN = (const bf16_t*)(ws + OFF_QN);
    const bf16_t* KS = (const bf16_t*)(ws + OFF_KS);
    const bf16_t* VST = (const bf16_t*)(ws + OFF_VST);
    const bf16_t* KW = (const bf16_t*)(ws + OFF_KW);
    const bf16_t* VWT = (const bf16_t*)(ws + OFF_VWT);
    const bf16_t* KCMP = (const bf16_t*)(ws + OFF_KCMP);
    const bf16_t* VCMPT = (const bf16_t*)(ws + OFF_VCMPT);
    const float* gates = (const float*)(ws + OFF_GATES);
    bf16_t* O = VAR ? (bf16_t*)(ws + OFF_PU + 32 * MB) : (bf16_t*)(ws + OFF_H);
    const float* relb = p.in[2];
    const int lane = tid & 63, w = tid >> 6, hg = w >> 1, th = w & 1, r = lane & 31, h = lane >> 5;
    float* lut = (float*)(lds + AT_LUT);
    float* lutc = (float*)(lds + AT_LUTC);
    float* imp = (float*)(lds + AT_IMP);
    unsigned* selw = (unsigned*)(lds + AT_SEL);
    unsigned short* sel16 = (unsigned short*)selw;
    float* bmxs = (float*)(selw + 264);
    const float* qnrm = (const float*)(ws + OFF_MB1);
    float kmx[3];
    for (int br = 0; br < 3; ++br) kmx[br] = wave_max(fmaxf(fabsf(p.in[21][br * 128 + lane]), fabsf(p.in[21][br * 128 + 64 + lane]))) * 11.313708498984761f;
    const int G = gridDim.x, rows_per_it = G >> 3;
    int lut_g = -1;
    for (int it = 0;; ++it) {
        int u;
        if ((G & 7) == 0) {
            const int rr = blockIdx.x >> 3, cc = blockIdx.x & 7;
            const int rowi = it * rows_per_it + ((it & 1) ? rows_per_it - 1 - rr : rr);
            u = rowi * 8 + cc;
        } else u = it * G + blockIdx.x;
        if (u >= 1024) break;
        const int bi = 127 - (u >> 3), b = (u & 7) >> 1, g = u & 1, head = 4 * g + hg;
        const int tq = 64 * bi + 32 * th + r;
        const int tl = 32 * th + r;
        const long tok = (long)b * SEQ + tq;
        if (g != lut_g) {
            lut_g = g;
            if (tid < 128) {
                const int hh = tid >> 5, bk = tid & 31;
                float bm = fmaxf(0.f, relb[bk * 8 + 4 * g + hh] - relb[31 * 8 + 4 * g + hh]);
                bm = fmaxf(bm, lx1(bm)); bm = fmaxf(bm, lx2(bm)); bm = fmaxf(bm, lhm(bm)); bm = fmaxf(bm, lr8(bm)); bm = max_x16(bm);
                if (bk == 0) bmxs[hh] = bm * LOG2E;
            }
            for (int e = tid; e < 4 * LUT_N; e += NTHREADS) { const int hh = e / LUT_N, d = LUT_OFF - (e % LUT_N); lut[e] = d < 0 ? -INFINITY : (d >= 790 ? 0.f : (relb[rel_bucket_i(d) * 8 + 4 * g + hh] - relb[31 * 8 + 4 * g + hh]) * LOG2E); }
            for (int e = tid; e < 4 * 16 * LUTC_W; e += NTHREADS) {
                const int hh = e / (16 * LUTC_W), ph = (e / LUTC_W) & 15, ci = e % LUTC_W, d = 16 * (ci - 1) + ph;
                lutc[e] = ci == 0 ? -INFINITY : (d >= 790 ? 0.f : (relb[rel_bucket_i(d) * 8 + 4 * g + hh] - relb[31 * 8 + 4 * g + hh]) * LOG2E);
            }
        }
        if (tid < 4) selw[256 + tid] = 0u;
        const float* mylut = lut + hg * LUT_N;
        bf16x8 qf[8];
        const bf16_t* qrow = QN + ((long)(b * 8 + head) * SEQ + tq) * 128 + 8 * h;
        auto load_q = [&](const bf16_t* qr) {
#pragma unroll
            for (int ks = 0; ks < 8; ++ks) qf[ks] = *(const bf16x8*)(qr + 16 * ks);
        };
        const float* gp = gates + tok * 24 + head * 3;
        bf16_t* orow = O + (VAR ? (tok & 16383) : tok) * DM + head * 128;
        auto stage = [&](const unsigned char* kg, const unsigned char* vg, unsigned vstride, int kt, unsigned char* st) {
            int t2 = tid; asm volatile("" : "+v"(t2));
            unsigned koff[2], vo[2];
            dma_offsets<256, 64>(koff, 256, t2);
            dma_offsets<128, 128>(vo, vstride, t2);
            dma_issue(st, kg + (long)kt * 16384, koff, t2);
            dma_issue(st + 16384, vg + (long)kt * 128, vo, t2);
        };
        f32x16 o[4];
        float l;
        auto reset = [&]() {
#pragma unroll
            for (int dt = 0; dt < 4; ++dt)
#pragma unroll
                for (int i = 0; i < 16; ++i) o[dt][i] = 0.f;
            l = 0.f;
        };
        const unsigned char* kcg = (const unsigned char*)(KCMP + (long)(b * 2 + g) * 512 * 128);
        const unsigned char* vcg = (const unsigned char*)(VCMPT + (long)(b * 2 + g) * 128 * 512);
        const int nct = ((4 * bi + 2) >> 6) + 1;
        const int hgc = r & 3, tlc = 8 * w + (r >> 2), tqc = 64 * bi + tlc;
        const long tokc = (long)b * SEQ + tqc;
        reset();
        load_q(QN + ((long)(b * 8 + 4 * g + hgc) * SEQ + tqc) * 128 + 8 * h);
        __syncthreads();
        if (VAR != 3) {
            const int cb = (tqc - 31) >> 4;
            const int cfar = ((64 * bi + 8 * w - 31) >> 4) - 8 - 23;
            const float* lc = lutc + (hgc * 16 + ((tqc - 31) & 15)) * LUTC_W + 1;
            const float nmb = -(qnrm[tokc * 8 + 4 * g + hgc] * kmx[0] + bmxs[hgc]);
            stage(kcg, vcg, 1024u, 0, lds);
            __syncthreads();
            for (int kt = 0; kt < nct; ++kt) {
                unsigned char* cur = lds + (kt & 1) * AT_STAGE;
                if (kt + 1 < nct) stage(kcg, vcg, 1024u, kt + 1, lds + ((kt + 1) & 1) * AT_STAGE);
                const int cbase = cb - kt * 64 - 8 * h;
#pragma unroll
                for (int mt = 0; mt < 2; ++mt) {
                    f32x16 st;
                    attn_qk32<128>(cur, qf, st, mt, r, h, nmb);
                    float sum = 0.f;
                    if (cfar - kt * 64 - 32 * mt >= 50) {
#pragma unroll
                        for (int i = 0; i < 16; ++i) sum += fexp2(st[i]);
                    } else {
#pragma unroll
                        for (int i = 0; i < 16; ++i) {
                            const int c = cbase - kidx(mt, i);
                            sum += fexp2(st[i] + lc[c < -1 ? -1 : (c > 50 ? 50 : c)]);
                        }
                    }
                    l += sum;
                }
                __syncthreads();
            }
            const float lt = sum_x32(l);
            const float invl = lt > 0.f ? frcp(lt) : 0.f;
            stage(kcg, vcg, 1024u, 0, lds);
            __syncthreads();
            float carry = 0.f;
            for (int kt = 0; kt < nct; ++kt) {
                unsigned char* cur = lds + (kt & 1) * AT_STAGE;
                if (kt + 1 < nct) stage(kcg, vcg, 1024u, kt + 1, lds + ((kt + 1) & 1) * AT_STAGE);
                const int cbase = cb - kt * 64 - 8 * h;
                float o0[4], o1[4], sp[4];
#pragma unroll
                for (int mt = 0; mt < 2; ++mt) {
                    f32x16 st;
                    attn_qk32<128>(cur, qf, st, mt, r, h, nmb);
                    if (cfar - kt * 64 - 32 * mt >= 50) {
#pragma unroll
                        for (int i = 0; i < 16; ++i) st[i] = fexp2(st[i]) * invl;
                    } else {
#pragma unroll
                        for (int i = 0; i < 16; ++i) {
                            const int c = cbase - kidx(mt, i);
                            st[i] = fexp2(st[i] + lc[c < -1 ? -1 : (c > 50 ? 50 : c)]) * invl;
                        }
                    }
#pragma unroll
                    for (int gq = 0; gq < 2; ++gq) {
                        const int G2 = 2 * mt + gq, q0 = 2 * gq, q1 = 2 * gq + 1;
                        const float c20 = 0.5f * st[4 * q0 + 3];
                        o0[G2] = st[4 * q0] + st[4 * q0 + 1] + st[4 * q0 + 2] + c20;
                        o1[G2] = st[4 * q1] + st[4 * q1 + 1] + st[4 * q1 + 2] + 0.5f * st[4 * q1 + 3] + c20;
                        sp[G2] = 0.5f * st[4 * q1 + 3];
                    }
                    bf16x8 pf[2];
                    attn_pack32(st, pf);
                    attn_pv32(cur + 16384, pf, o, mt, r, h);
                }
                float rc[4];
#pragma unroll
                for (int G2 = 0; G2 < 4; ++G2) rc[G2] = __uint_as_float(get_x32(__float_as_uint(sp[G2]), h));
                if (h) {
#pragma unroll
                    for (int G2 = 0; G2 < 4; ++G2) o0[G2] += rc[G2];
                } else {
                    o0[0] += carry; o0[1] += rc[0]; o0[2] += rc[1]; o0[3] += rc[2];
                    carry = rc[3];
                }
#pragma unroll
                for (int G2 = 0; G2 < 4; ++G2) {
                    float a0 = o0[G2], a1 = o1[G2];
                    a0 += lx1(a0); a0 += lx2(a0); a1 += lx1(a1); a1 += lx2(a1);
                    if (hgc == 0) *(f32x2*)(imp + tlc * 130 + kt * 16 + 4 * G2 + 2 * h) = (f32x2){a0, a1};
                }
                __syncthreads();
            }
        }
        {
            const float g_c = gates[tokc * 24 + (4 * g + hgc) * 3];
            bf16_t* orc = O + (VAR ? (tokc & 16383) : tokc) * DM + (4 * g + hgc) * 128;
#pragma unroll
            for (int dt = 0; dt < 4; ++dt)
#pragma unroll
                for (int g4 = 0; g4 < 4; ++g4) {
                    const int d0 = 32 * dt + 8 * g4 + 4 * h;
                    u32x2 ov;
                    ov.x = pk2(o[dt][4 * g4 + 0] * g_c, o[dt][4 * g4 + 1] * g_c);
                    ov.y = pk2(o[dt][4 * g4 + 2] * g_c, o[dt][4 * g4 + 3] * g_c);
                    *(u32x2*)(orc + d0) = ov;
                }
        }
        if (VAR != 5) {
            const int tkn = tid >> 3, part = tid & 7;
            unsigned key[16];
#pragma unroll
            for (int q = 0; q < 16; ++q) {
                const int j = part * 16 + q;
                float v = imp[tkn * 130 + j];
                const int back = bi - j;
                if (j == 0 || (back >= 0 && back < 2)) v = 1e9f;
                if (back < 0) v = -1e30f;
                key[q] = f2key(v);
            }
            unsigned srt[16];
#pragma unroll
            for (int q = 0; q < 16; ++q) { key[q] = (key[q] & ~127u) | (unsigned)(127 - (part * 16 + q)); srt[q] = key[q]; }
            sort16_desc(srt);
            {
                unsigned pr[16];
#pragma unroll
                for (int q = 0; q < 16; ++q) pr[q] = (unsigned)__builtin_amdgcn_update_dpp(0, (int)srt[q], 0xB1, 0xF, 0xF, true);
                merge_top16(srt, pr);
#pragma unroll
                for (int q = 0; q < 16; ++q) pr[q] = (unsigned)__builtin_amdgcn_update_dpp(0, (int)srt[q], 0x4E, 0xF, 0xF, true);
                merge_top16(srt, pr);
#pragma unroll
                for (int q = 0; q < 16; ++q) pr[q] = (unsigned)__builtin_amdgcn_update_dpp(0, (int)srt[q], 0x141, 0xF, 0xF, true);
                merge_top16(srt, pr);
            }
            const unsigned T16 = srt[15];
            unsigned bits = 0;
#pragma unroll
            for (int q = 0; q < 16; ++q) bits |= (key[q] >= T16 && key[q] >= 0x80000000u) ? (1u << q) : 0u;
            sel16[tkn * 8 + part] = (unsigned short)bits;
            atomicOr(&selw[256 + (part >> 1)], bits << ((part & 1) * 16));
        }
        __syncthreads();
        const unsigned un0 = selw[256], un1 = selw[257], un2 = selw[258], un3 = selw[259];
        const unsigned char* ksg = (const unsigned char*)(KS + (long)(b * 2 + g) * SEQ * 128);
        const unsigned char* vsg = (const unsigned char*)(VST + (long)(b * 2 + g) * 128 * SEQ);
        reset(); load_q(qrow);
        const float qn_main = qnrm[tok * 8 + head];
        {
            const float nmb = -(qn_main * kmx[1] + bmxs[hg]);
            const unsigned long long ulo = ((unsigned long long)(unsigned)__builtin_amdgcn_readfirstlane((int)un1) << 32) | (unsigned)__builtin_amdgcn_readfirstlane((int)un0);
            const unsigned long long uhi = ((unsigned long long)(unsigned)__builtin_amdgcn_readfirstlane((int)un3) << 32) | (unsigned)__builtin_amdgcn_readfirstlane((int)un2);
            auto next_tile = [&](int from) -> int {
                if (from < 64) { const unsigned long long mk = ulo >> from; if (mk) return from + __builtin_ctzll(mk); from = 64; }
                if (from < 128) { const unsigned long long mk = uhi >> (from - 64); if (mk) return from + __builtin_ctzll(mk); }
                return 128;
            };
            int jt = (VAR == 1 || VAR == 4 || VAR == 5) ? 128 : next_tile(0);
            int buf = 0;
            if (jt < 128) stage(ksg, vsg, SEQ * 2u, jt, lds);
            __syncthreads();
            while (jt < 128) {
                unsigned char* cur = lds + buf * AT_STAGE;
                const int jn = next_tile(jt + 1);
                if (jn < 128) stage(ksg, vsg, SEQ * 2u, jn, lds + (buf ^ 1) * AT_STAGE);
                const unsigned wd = selw[tl * 4 + (jt >> 5)];
                const bool mysel = (wd >> (jt & 31)) & 1u;
                if (__any(mysel)) {
                    const int k0 = jt * 64;
                    const bool nearb = (64 * bi + 32 * th) - (k0 + 63) < 790;
                    const int dbase = tq - k0 - 8 * h;
                    const float* lp = mylut + (LUT_OFF - dbase);
#pragma unroll
                    for (int mt = 0; mt < 2; ++mt) {
                        f32x16 st;
                        attn_qk32<128>(cur, qf, st, mt, r, h, mysel ? nmb : -INFINITY);
                        if (nearb) {
#pragma unroll
                            for (int i = 0; i < 16; ++i) st[i] += lp[kidx(mt, i)];
                        }
                        attn_softmax32_b(st, l);
                        bf16x8 pf[2];
                        attn_pack32(st, pf);
                        attn_pv32(cur + 16384, pf, o, mt, r, h);
                    }
                }
                __syncthreads();
                buf ^= 1; jt = jn;
            }
        }
        {
            const float lt = sum_x32(l);
            const float sc = (lt > 0.f ? frcp(lt) : 0.f) * gp[1];
#pragma unroll
            for (int dt = 0; dt < 4; ++dt)
#pragma unroll
                for (int g4 = 0; g4 < 4; ++g4) {
                    const int d0 = 32 * dt + 8 * g4 + 4 * h;
                    const u32x2 pv = *(const u32x2*)(orow + d0);
                    u32x2 ov;
                    ov.x = pk2(bflo(pv.x) + o[dt][4 * g4 + 0] * sc, bfhi(pv.x) + o[dt][4 * g4 + 1] * sc);
                    ov.y = pk2(bflo(pv.y) + o[dt][4 * g4 + 2] * sc, bfhi(pv.y) + o[dt][4 * g4 + 3] * sc);
                    *(u32x2*)(orow + d0) = ov;
                }
        }
        const unsigned char* kwg = (const unsigned char*)(KW + (long)(b * 2 + g) * SEQ * 128);
        const unsigned char* vwg = (const unsigned char*)(VWT + (long)(b * 2 + g) * 128 * SEQ);
        reset(); load_q(qrow);
        {
            const float nmb = -(qn_main * kmx[2] + bmxs[hg]);
            const int j0 = bi >= 8 ? bi - 8 : 0, nt = (VAR == 2 || VAR == 4 || VAR == 5) ? 1 : bi - j0 + 1;
            stage(kwg, vwg, SEQ * 2u, j0, lds);
            __syncthreads();
            for (int kt = 0; kt < nt; ++kt) {
                unsigned char* cur = lds + (kt & 1) * AT_STAGE;
                if (kt + 1 < nt) stage(kwg, vwg, SEQ * 2u, j0 + kt + 1, lds + ((kt + 1) & 1) * AT_STAGE);
                const int k0 = (j0 + kt) * 64;
                const int dbase = tq - k0 - 8 * h;
                const float* lp = mylut + (LUT_OFF - dbase);
#pragma unroll
                for (int mt = 0; mt < 2; ++mt) {
                    f32x16 st;
                    attn_qk32<128>(cur, qf, st, mt, r, h, nmb);
#pragma unroll
                    for (int i = 0; i < 16; ++i) st[i] = kidx(mt, i) <= dbase - 512 ? -INFINITY : st[i] + lp[kidx(mt, i)];
                    attn_softmax32_b(st, l);
                    bf16x8 pf[2];
                    attn_pack32(st, pf);
                    attn_pv32(cur + 16384, pf, o, mt, r, h);
                }
                __syncthreads();
            }
        }
        {
            const float lt = sum_x32(l);
            const float sc = (lt > 0.f ? frcp(lt) : 0.f) * gp[2];
#pragma unroll
            for (int dt = 0; dt < 4; ++dt)
#pragma unroll
                for (int g4 = 0; g4 < 4; ++g4) {
                    const int d0 = 32 * dt + 8 * g4 + 4 * h;
                    const u32x2 pv = *(const u32x2*)(orow + d0);
                    u32x2 ov;
                    ov.x = pk2(bflo(pv.x) + o[dt][4 * g4 + 0] * sc, bfhi(pv.x) + o[dt][4 * g4 + 1] * sc);
                    ov.y = pk2(bflo(pv.y) + o[dt][4 * g4 + 2] * sc, bfhi(pv.y) + o[dt][4 * g4 + 3] * sc);
                    *(u32x2*)(orow + d0) = ov;
                }
        }
        __syncthreads();
    }
}

DI void fp8x16_fma(const u32x4& q, const f32x4& h0, const f32x4& h1, const f32x4& h2, const f32x4& h3, f32x2& a0, f32x2& a1) {
    a0 += __builtin_amdgcn_cvt_pk_f32_fp8((int)q.x, false) * (f32x2){h0.x, h0.y};
    a1 += __builtin_amdgcn_cvt_pk_f32_fp8((int)q.x, true)  * (f32x2){h0.z, h0.w};
    a0 += __builtin_amdgcn_cvt_pk_f32_fp8((int)q.y, false) * (f32x2){h1.x, h1.y};
    a1 += __builtin_amdgcn_cvt_pk_f32_fp8((int)q.y, true)  * (f32x2){h1.z, h1.w};
    a0 += __builtin_amdgcn_cvt_pk_f32_fp8((int)q.z, false) * (f32x2){h2.x, h2.y};
    a1 += __builtin_amdgcn_cvt_pk_f32_fp8((int)q.z, true)  * (f32x2){h2.z, h2.w};
    a0 += __builtin_amdgcn_cvt_pk_f32_fp8((int)q.w, false) * (f32x2){h3.x, h3.y};
    a1 += __builtin_amdgcn_cvt_pk_f32_fp8((int)q.w, true)  * (f32x2){h3.z, h3.w};
}
#ifndef UMASK
#define UMASK 0xffffffffu
#endif
template <bool DRY>
DI void phase_peer_u(const Params& p, int layer, unsigned char* lds, int tid) {
    unsigned char* ws = p.ws;
    const unsigned char* H8 = ws + OFF_H8;
    const float* HS = (const float*)(ws + OFF_HS);
    const int* ridx = (const int*)(ws + OFF_RIDX);
    float* rgate = (float*)(ws + OFF_RGATE);
    const unsigned char* U = ws + OFF_PU + (long)layer * 16384 * 1024;
    const __amdgpu_buffer_rsrc_t urs = __builtin_amdgcn_make_buffer_rsrc((void*)U, (short)0, 16384 * 1024, 0x00020000);
    const float* usi = (const float*)(ws + OFF_USI) + layer * 16384;
    const float* vsi = (const float*)(ws + OFF_VSI) + layer * 16384;
    const int lane = tid & 63, w = __builtin_amdgcn_readfirstlane(tid >> 6), sub = lane & 7, grp = lane >> 3;
    const int xg = blockIdx.x & 7, lb = blockIdx.x >> 3, nwv = (gridDim.x >> 3) * NWAVES, wv = lb * NWAVES + w;
    unsigned* clb = (unsigned*)(lds + w * 12288);
    unsigned char* hbb = lds + w * 12288 + 4096;
    const unsigned long long lt = (1ull << lane) - 1ull;
    if (lb >= (int)(gridDim.x >> 3)) return;
    int i0, i1; unsigned g0, g1; u32x4 h0; float hs0;
    auto ld_tok = [&](int tk) {
        tk = tk < NTOK ? tk : wv;
        i0 = ridx[(long)tk * 128 + lane]; i1 = ridx[(long)tk * 128 + 64 + lane];
        g0 = __float_as_uint(rgate[(long)tk * 128 + lane]); g1 = __float_as_uint(rgate[(long)tk * 128 + 64 + lane]);
        h0 = *(const u32x4*)(H8 + (long)tk * DM + lane * 16); hs0 = HS[tk];
    };
    bool sb0, sb1; int sk0, sk1; float su0, sv0, su1, sv1;
    auto stage_tok = [&](int bi) -> int {
        unsigned* cl = clb + bi * 512; unsigned char* hb = hbb + bi * 4096;
        const bool b0 = (i0 >> 11) == xg, b1 = (i1 >> 11) == xg;
        const unsigned long long m0 = __ballot(b0), m1 = __ballot(b1);
        const int n0 = __popcll(m0), n = n0 + __popcll(m1);
        sb0 = b0; sb1 = b1; sk0 = __popcll(m0 & lt); sk1 = n0 + __popcll(m1 & lt);
        if (b0) { *(u32x4*)(cl + 4 * sk0) = (u32x4){(unsigned)lane, (unsigned)i0, g0, 0u}; su0 = usi[i0]; sv0 = vsi[i0]; }
        if (b1) { *(u32x4*)(cl + 4 * sk1) = (u32x4){(unsigned)(64 + lane), (unsigned)i1, g1, 0u}; su1 = usi[i1]; sv1 = vsi[i1]; }
        if (n == 0 && lane == 0) *(u32x4*)cl = (u32x4){0u, 0u, 0u, 0u};
        *(u32x4*)(hb + lane * 16) = h0;
        if (lane == 0) *(float*)(hb + 1024) = hs0;
        return n;
    };
    auto flush_scales = [&](int bi) {
        float* cs = (float*)(hbb + bi * 4096 + 1536);
        if (sb0) *(f32x2*)(cs + 2 * sk0) = (f32x2){su0, sv0};
        if (sb1) *(f32x2*)(cs + 2 * sk1) = (f32x2){su1, sv1};
    };
    ld_tok(wv);
    int nC = stage_tok(0);
    flush_scales(0);
    ld_tok(wv + nwv);
    int slotC, idC; bool validC; float g_in;
    { validC = grp < nC; const int kk = validC ? grp : 0; const u32x4 e = *(const u32x4*)(clb + 4 * kk); slotC = e.x; idC = e.y; g_in = __uint_as_float(e.z); }
    u32x4 uv[8];
    {
        const unsigned uoff = validC ? (unsigned)idC * 1024u + (unsigned)sub * 16u : 0x40000000u;
#pragma unroll
        for (int t = 0; t < 8; ++t) { uv[t] = __builtin_bit_cast(u32x4, __builtin_amdgcn_raw_buffer_load_b128(urs, (int)(uoff + t * 128), 0, 0)); __builtin_amdgcn_sched_barrier(0); }
    }
    int it = 0;
    for (int tok = wv; tok < NTOK; tok += nwv, ++it) {
        const int cb = it & 1;
        const unsigned* clC = clb + cb * 512; const unsigned* clN = clb + (cb ^ 1) * 512;
        const unsigned char* hbC = hbb + cb * 4096;
        const bool more = tok + nwv < NTOK;
        const int nN = stage_tok(cb ^ 1); ld_tok(tok + 2 * nwv);
        const float shC = *(const float*)(hbC + 1024);
        const int nr = nC > 8 ? (nC + 7) >> 3 : 1;
        u32x4 hq[8];
#pragma unroll
        for (int t = 0; t < 8; ++t) hq[t] = *(const u32x4*)(hbC + (sub + 8 * t) * 16);
        auto do_round = [&](int rd) {
            const f32x2 s2 = *(const f32x2*)(hbC + 1536 + 8 * (validC ? 8 * rd + grp : 0));
            int slotN, idN; bool validN; float g_inN;
            {
                u32x4 e;
                if (rd + 1 < nr) { const int k = 8 * (rd + 1) + grp; validN = k < nC; e = *(const u32x4*)(clC + 4 * (validN ? k : 0)); }
                else if (more) { validN = grp < nN; e = *(const u32x4*)(clN + 4 * (validN ? grp : 0)); }
                else { validN = false; e = *(const u32x4*)clC; }
                slotN = e.x; idN = e.y; g_inN = __uint_as_float(e.z);
            }
            const unsigned uoffN = validN ? ((unsigned)idN & (DRY ? UMASK : 0xffffffffu)) * 1024u + (unsigned)sub * 16u : 0x40000000u;
            __builtin_amdgcn_sched_barrier(0);
            int a0 = 0, a1 = 0, a2 = 0, a3 = 0;
#pragma unroll
            for (int t = 0; t < 8; ++t) {
                const u32x4 q = uv[t];
                a0 = __builtin_amdgcn_sdot4((int)q.x, (int)hq[t].x, a0, false); a1 = __builtin_amdgcn_sdot4((int)q.y, (int)hq[t].y, a1, false);
                a2 = __builtin_amdgcn_sdot4((int)q.z, (int)hq[t].z, a2, false); a3 = __builtin_amdgcn_sdot4((int)q.w, (int)hq[t].w, a3, false);
                uv[t] = __builtin_bit_cast(u32x4, __builtin_amdgcn_raw_buffer_load_b128(urs, (int)(uoffN + t * 128), 0, 0));
                __builtin_amdgcn_sched_barrier(0);
            }
            int di = (a0 + a1) + (a2 + a3);
            di += __builtin_amdgcn_update_dpp(0, di, 0xB1, 0xF, 0xF, true);
            di += __builtin_amdgcn_update_dpp(0, di, 0x4E, 0xF, 0xF, true);
            di += __builtin_amdgcn_update_dpp(0, di, 0x141, 0xF, 0xF, true);
            if (validC && sub == 0) {
                float* gw = DRY ? (float*)(ws + OFF_R) + (long)tok * 128 + slotC : rgate + (long)tok * 128 + slotC;
                *gw = g_in * gelu_tanh((float)di * s2.x * shC) * s2.y;
            }
            slotC = slotN; idC = idN; validC = validN; g_in = g_inN;
        };
        do_round(0);
        for (int rd = 1; rd < nr; ++rd) do_round(rd);
        flush_scales(cb ^ 1);
        nC = nN;
    }
}

#ifndef VMASK
#define VMASK 0xffffffffu
#endif
#ifndef V_MFMA
#define V_MFMA 1
#endif
#define LAS __attribute__((address_space(3)))
typedef int v2i_t __attribute__((ext_vector_type(2)));
template <bool DRY>
DI void phase_peer_v(const Params& p, int layer, unsigned char* lds, int tid) {
    unsigned char* ws = p.ws;
    const int* ridx = (const int*)(ws + OFF_RIDX);
    const float* wact = (const float*)(ws + OFF_RGATE);
    const float* ada = (const float*)(ws + OFF_ADA);
    float* x = opq(p.out);
    const int lane = tid & 63, w = __builtin_amdgcn_readfirstlane(tid >> 6), sub = lane & 7, eg = lane >> 3;
    const int xg = blockIdx.x & 7, lb = blockIdx.x >> 3, nwv = (gridDim.x >> 3) * NWAVES, wv = lb * NWAVES + w;
    if (lb >= (int)(gridDim.x >> 3)) return;
    const unsigned char* Vc = ws + OFF_PV + ((long)(layer * 8 + xg) * 16384) * 128;
    unsigned char* gr = lds + w * 16384;
    unsigned* ring = (unsigned*)(lds + 128 * 1024 + w * 3072);
    int ia, ib; float wa, wb;
    auto ld_tokv = [&](int tk) {
        tk = tk < NTOK ? tk : wv;
        ia = ridx[(long)tk * 128 + lane]; ib = ridx[(long)tk * 128 + 64 + lane];
        wa = wact[(long)tk * 128 + lane]; wb = wact[(long)tk * 128 + 64 + lane];
    };
    auto st_ring = [&](int slot) {
        unsigned* rs = ring + slot * 256;
        rs[lane] = (unsigned)ia; rs[64 + lane] = (unsigned)ib; rs[128 + lane] = __float_as_uint(wa); rs[192 + lane] = __float_as_uint(wb);
    };
    auto rd_ids = [&](int slot, u32x4 (&a)[4]) {
        const u32x4* ip = (const u32x4*)(ring + slot * 256 + eg * 16);
#pragma unroll
        for (int q = 0; q < 4; ++q) a[q] = ip[q];
    };
    auto issue = [&](int j, const u32x4 (&a)[4]) {
#pragma unroll
        for (int i = 0; i < 4; ++i) {
            const int g = 4 * (i & 1) + (eg >> 1);
            const unsigned src = (a[j][i] & (DRY ? VMASK : 0xffffffffu)) * 128u + (unsigned)((sub ^ g) << 4);
            __builtin_amdgcn_global_load_lds((const unsigned*)(Vc + src), (unsigned*)(gr + j * 4096 + i * 1024), 16, 0, 0);
        }
    };
    const int col0 = 128 * xg + 16 * sub;
    ld_tokv(wv); st_ring(0);
    ld_tokv(wv + nwv); st_ring(1);
    ld_tokv(wv + 2 * nwv);
    {
        u32x4 a[4];
        rd_ids(0, a);
#pragma unroll
        for (int j = 0; j < 4; ++j) issue(j, a);
    }
#if V_MFMA
    unsigned char* wb8 = lds + 152 * 1024 + w * 256;
    const int m16 = lane & 15, q4 = lane >> 4;
    int boff[8];
    {
        const int rowL = 8 * q4 + (m16 >> 1), gL = (rowL >> 1) & 7;
#pragma unroll
        for (int nt = 0; nt < 8; ++nt) boff[nt] = rowL * 128 + ((nt ^ gL) << 4) + 8 * (m16 & 1);
    }
    unsigned baddr[8];
    const unsigned gr3 = (unsigned)(unsigned long)(LAS unsigned char*)gr;
#pragma unroll
    for (int nt = 0; nt < 8; ++nt) baddr[nt] = gr3 + (unsigned)boff[nt];
    const unsigned aaddr = (unsigned)(unsigned long)(LAS unsigned char*)wb8 + (unsigned)((m16 & 1) * 128 + 8 * q4);
    float xv[8], gfv[8]; int gb = -1;
    const int colx = 128 * xg + m16;
    if (lane < 16) {
#pragma unroll
        for (int nt = 0; nt < 8; ++nt) xv[nt] = x[(long)wv * DM + colx + 16 * nt];
    }
#else
    f32x4 gfv[4]; int gb = -1;
    f32x4 xv[4];
    if (eg == 0) {
#pragma unroll
        for (int c = 0; c < 4; ++c) xv[c] = *(const f32x4*)(x + (long)wv * DM + col0 + 4 * c);
    }
#endif
    int it = 0, s3 = 0;
    for (int tok = wv; tok < NTOK; tok += nwv, ++it) {
        const int sl0 = s3, sl1 = s3 == 2 ? 0 : s3 + 1, sl2 = s3 == 0 ? 2 : s3 - 1;
        st_ring(sl2);
        ld_tokv(tok + 3 * nwv);
        u32x4 na[4];
        rd_ids(sl1, na);
        {
            const int b = tok >> 13;
            if (b != gb) {
                gb = b;
#if V_MFMA
                if (lane < 16) {
#pragma unroll
                    for (int nt = 0; nt < 8; ++nt) gfv[nt] = ada[b * ADA_STRIDE + layer * 6144 + 5 * 1024 + colx + 16 * nt];
                }
#else
                const float* gf = ada + b * ADA_STRIDE + layer * 6144 + 5 * 1024 + col0;
#pragma unroll
                for (int c = 0; c < 4; ++c) gfv[c] = *(const f32x4*)(gf + 4 * c);
#endif
                asm volatile("s_waitcnt vmcnt(0)" ::: "memory");
            }
        }
#if V_MFMA
        float invS;
        {
            const float w0 = __uint_as_float(ring[sl0 * 256 + 128 + lane]), w1 = __uint_as_float(ring[sl0 * 256 + 192 + lane]);
            const float mx = wave_max(fmaxf(fabsf(w0), fabsf(w1)));
            int ex = (int)((__float_as_uint(mx) >> 23) & 255u) - 127;
            ex = ex < -100 ? -100 : ex;
            const float S = __uint_as_float((unsigned)(127 + 7 - ex) << 23);
            invS = __uint_as_float((unsigned)(127 - 7 + ex) << 23);
            const float a0 = w0 * S, a1 = w1 * S;
            const int hi = __builtin_amdgcn_cvt_pk_fp8_f32(a0, a1, 0, false);
            const f32x2 hf = __builtin_amdgcn_cvt_pk_f32_fp8(hi, false);
            const int lo = __builtin_amdgcn_cvt_pk_fp8_f32(a0 - hf.x, a1 - hf.y, 0, false);
            const int p0 = 8 * (lane & 15) + (lane >> 4);
            wb8[p0] = (unsigned char)(hi & 255); wb8[p0 + 4] = (unsigned char)((hi >> 8) & 255);
            wb8[128 + p0] = (unsigned char)(lo & 255); wb8[128 + p0 + 4] = (unsigned char)((lo >> 8) & 255);
        }
        f32x4 d[8];
#pragma unroll
        for (int nt = 0; nt < 8; ++nt) d[nt] = (f32x4){0.f, 0.f, 0.f, 0.f};
#pragma unroll
        for (int j = 0; j < 4; ++j) {
            asm volatile("s_waitcnt vmcnt(24)" ::: "memory");
            v2i_t aq, b0, b1, b2, b3, b4, b5, b6, b7;
            asm volatile("ds_read_b64 %0, %9 offset:%18\n\t"
                         "ds_read_b64_tr_b8 %1, %10 offset:%19\n\tds_read_b64_tr_b8 %2, %11 offset:%19\n\t"
                         "ds_read_b64_tr_b8 %3, %12 offset:%19\n\tds_read_b64_tr_b8 %4, %13 offset:%19\n\t"
                         "ds_read_b64_tr_b8 %5, %14 offset:%19\n\tds_read_b64_tr_b8 %6, %15 offset:%19\n\t"
                         "ds_read_b64_tr_b8 %7, %16 offset:%19\n\tds_read_b64_tr_b8 %8, %17 offset:%19\n\t"
                         "s_waitcnt lgkmcnt(0)"
                         : "=&v"(aq), "=&v"(b0), "=&v"(b1), "=&v"(b2), "=&v"(b3), "=&v"(b4), "=&v"(b5), "=&v"(b6), "=&v"(b7)
                         : "v"(aaddr), "v"(baddr[0]), "v"(baddr[1]), "v"(baddr[2]), "v"(baddr[3]), "v"(baddr[4]), "v"(baddr[5]), "v"(baddr[6]), "v"(baddr[7]),
                           "i"(32 * j), "i"(4096 * j)
                         : "memory");
            long a8 = ((long)(unsigned)aq.y << 32) | (unsigned)aq.x;
            a8 = m16 < 2 ? a8 : 0l;
            const v2i_t bq[8] = {b0, b1, b2, b3, b4, b5, b6, b7};
#pragma unroll
            for (int nt = 0; nt < 8; ++nt) {
                const long b8 = ((long)(unsigned)bq[nt].y << 32) | (unsigned)bq[nt].x;
                d[nt] = __builtin_amdgcn_mfma_f32_16x16x32_fp8_fp8(a8, b8, d[nt], 0, 0, 0);
            }
            issue(j, na);
        }
        if (lane < 16) {
            float* xr = DRY ? (float*)(ws + OFF_R + 16 * MB) + (long)tok * DM + colx : x + (long)tok * DM + colx;
#pragma unroll
            for (int nt = 0; nt < 8; ++nt) xr[16 * nt] = xv[nt] + gfv[nt] * ((d[nt].x + d[nt].y) * invS);
            const int tn = tok + nwv < NTOK ? tok + nwv : wv;
#pragma unroll
            for (int nt = 0; nt < 8; ++nt) xv[nt] = x[(long)tn * DM + colx + 16 * nt];
        }
#else
        f32x4 cw[4];
        {
            const f32x4* wp = (const f32x4*)(ring + sl0 * 256 + 128 + eg * 16);
#pragma unroll
            for (int q = 0; q < 4; ++q) cw[q] = wp[q];
        }
        f32x2 ap[8];
#pragma unroll
        for (int i = 0; i < 8; ++i) ap[i] = (f32x2){0.f, 0.f};
#pragma unroll
        for (int j = 0; j < 4; ++j) {
            asm volatile("s_waitcnt vmcnt(20)" ::: "memory");
#pragma unroll
            for (int i = 0; i < 4; ++i) {
                const int rs = 8 * i + eg, g = 4 * (i & 1) + (eg >> 1);
                const u32x4 v = *(const u32x4*)(gr + j * 4096 + rs * 128 + ((sub ^ g) << 4));
                const float ws1 = cw[j][i]; const f32x2 ww = {ws1, ws1};
                ap[0] += __builtin_amdgcn_cvt_pk_f32_fp8((int)v.x, false) * ww; ap[1] += __builtin_amdgcn_cvt_pk_f32_fp8((int)v.x, true) * ww;
                ap[2] += __builtin_amdgcn_cvt_pk_f32_fp8((int)v.y, false) * ww; ap[3] += __builtin_amdgcn_cvt_pk_f32_fp8((int)v.y, true) * ww;
                ap[4] += __builtin_amdgcn_cvt_pk_f32_fp8((int)v.z, false) * ww; ap[5] += __builtin_amdgcn_cvt_pk_f32_fp8((int)v.z, true) * ww;
                ap[6] += __builtin_amdgcn_cvt_pk_f32_fp8((int)v.w, false) * ww; ap[7] += __builtin_amdgcn_cvt_pk_f32_fp8((int)v.w, true) * ww;
            }
            asm volatile("s_waitcnt lgkmcnt(0)" ::: "memory");
            issue(j, na);
        }
        float acc[16];
#pragma unroll
        for (int i = 0; i < 8; ++i) { acc[2 * i] = ap[i].x; acc[2 * i + 1] = ap[i].y; }
#pragma unroll
        for (int i = 0; i < 16; ++i) { acc[i] += lr8(acc[i]); acc[i] = sum_x16(acc[i]); acc[i] = sum_x32(acc[i]); }
        if (eg == 0) {
            float* xr = DRY ? (float*)(ws + OFF_R + 16 * MB) + (long)tok * DM + col0 : x + (long)tok * DM + col0;
#pragma unroll
            for (int c = 0; c < 4; ++c) {
                const f32x4 gv = gfv[c];
                f32x4 o;
                o.x = xv[c].x + gv.x * acc[4 * c + 0]; o.y = xv[c].y + gv.y * acc[4 * c + 1];
                o.z = xv[c].z + gv.z * acc[4 * c + 2]; o.w = xv[c].w + gv.w * acc[4 * c + 3];
                *(f32x4*)(xr + 4 * c) = o;
            }
            const int tn = tok + nwv < NTOK ? tok + nwv : wv;
#pragma unroll
            for (int c = 0; c < 4; ++c) xv[c] = *(const f32x4*)(x + (long)tn * DM + col0 + 4 * c);
        }
#endif
        s3 = sl1;
    }
    asm volatile("s_waitcnt vmcnt(0)" ::: "memory");
}

DI void norm_row_q8(const f32x4 (&v)[4], float rstd, const float* gain, const float* shift, const float* scale, unsigned char* orow, float* os, int lane) {
    f32x4 y[4]; float am = 0.f;
#pragma unroll
    for (int j = 0; j < 4; ++j) {
        const int c = 4 * lane + 256 * j;
        const f32x4 g = *(const f32x4*)(gain + c), sh = *(const f32x4*)(shift + c), sc = *(const f32x4*)(scale + c);
        y[j].x = v[j].x * rstd * g.x * (1.f + sc.x) + sh.x; y[j].y = v[j].y * rstd * g.y * (1.f + sc.y) + sh.y;
        y[j].z = v[j].z * rstd * g.z * (1.f + sc.z) + sh.z; y[j].w = v[j].w * rstd * g.w * (1.f + sc.w) + sh.w;
        am = fmaxf(am, fmaxf(fmaxf(fabsf(y[j].x), fabsf(y[j].y)), fmaxf(fabsf(y[j].z), fabsf(y[j].w))));
    }
    am = wave_max(am);
    const float qs = am > 0.f ? 127.f / am : 1.f;
#pragma unroll
    for (int j = 0; j < 4; ++j) *(int*)(orow + 4 * lane + 256 * j) = pack_i8x4(y[j].x * qs, y[j].y * qs, y[j].z * qs, y[j].w * qs);
    if (lane == 0) *os = am > 0.f ? am * (1.f / 127.f) : 1.f;
}
DI void phase_norm2(const float* __restrict__ x, unsigned char* __restrict__ out1, float* __restrict__ os1, const float* gain1, int sh1, int sc1,
                    unsigned char* __restrict__ out2, float* __restrict__ os2, const float* gain2, int sh2, int sc2, const float* ada, int tid) {
    const int lane = tid & 63, gw = blockIdx.x * NWAVES + (tid >> 6), nw = gridDim.x * NWAVES;
    for (int tok = gw; tok < NTOK; tok += nw) {
        const int b = tok >> 13;
        f32x4 v[4]; float ss = 0.f;
#pragma unroll
        for (int j = 0; j < 4; ++j) { v[j] = *(const f32x4*)(x + (long)tok * DM + 4 * lane + 256 * j); ss += v[j].x * v[j].x + v[j].y * v[j].y + v[j].z * v[j].z + v[j].w * v[j].w; }
        const float rstd = rsqrtf(wave_sum(ss) * (1.f / DM) + EPS);
        norm_row_q8(v, rstd, gain1, ada + b * ADA_STRIDE + sh1, ada + b * ADA_STRIDE + sc1, out1 + (long)tok * DM, os1 + tok, lane);
        norm_row_q8(v, rstd, gain2, ada + b * ADA_STRIDE + sh2, ada + b * ADA_STRIDE + sc2, out2 + (long)tok * DM, os2 + tok, lane);
    }
}

template <int MT, class Epi>
DI void gemm_phase(const bf16_t* A, long lda, int M, const bf16_t* Bt, long ldb, int N, int K, const Epi& epi, unsigned char* lds, int tid) {
    const int ntm = (M + 128 * MT - 1) / (128 * MT), ntn = (N + 255) / 256, nt = ntm * ntn;
    if ((gridDim.x & 7) == 0 && (ntm & 31) == 0) {
        const int xcd = blockIdx.x & 7, lb = blockIdx.x >> 3, nlb = gridDim.x >> 3, tmx = ntm >> 3, per = tmx * ntn;
        for (int q = lb; q < per; q += nlb) {
            const int g4 = q / (4 * ntn), rem = q - g4 * 4 * ntn, tn = rem >> 2, tm = xcd * tmx + g4 * 4 + (rem & 3);
            if (tm < (xcd + 1) * tmx) gemm_tile<MT>(A, lda, M, Bt, ldb, N, K, tm * 128 * MT, tn * 256, epi, lds, tid);
        }
        return;
    }
    for (int t = blockIdx.x; t < nt; t += gridDim.x) {
        const int tn = t / ntm, tm = t % ntm;
        gemm_tile<MT>(A, lda, M, Bt, ldb, N, K, tm * 128 * MT, tn * 256, epi, lds, tid);
    }
}

template <int MT, class Epi>
DI void gemm_tile_i8(const unsigned char* __restrict__ A, int M, const float* __restrict__ as, const unsigned char* __restrict__ Bt, int N, const float* __restrict__ bs,
                     int K, int m0, int n0, const Epi& epi, unsigned char* lds, int tid) {
    constexpr int XS = MT * 128 * 128, WS = 256 * 128, STAGE = XS + WS;
    const int lane = tid & 63, w = tid >> 6, tg = w & 3, fh = w >> 2, r = lane & 31, h = lane >> 5;
    const int wbase = tid & ~63;
    unsigned xo[2 * MT], wo[4];
#pragma unroll
    for (int i = 0; i < 2 * MT; ++i) { int row, c; sw2_src(tid + 512 * i, row, c); int m = m0 + row; m = m < M ? m : M - 1; xo[i] = (unsigned)m * (unsigned)K + c * 16; }
#pragma unroll
    for (int i = 0; i < 4; ++i) { int row, c; sw2_src(tid + 512 * i, row, c); int n = n0 + row; n = n < N ? n : N - 1; wo[i] = (unsigned)n * (unsigned)K + c * 16; }
    auto stage = [&](int kt, unsigned char* st) {
#pragma unroll
        for (int i = 0; i < 2 * MT; ++i)
            __builtin_amdgcn_global_load_lds((const unsigned*)(A + kt * 128 + xo[i]), (unsigned*)(st + (wbase + 512 * i) * 16), 16, 0, 0);
#pragma unroll
        for (int i = 0; i < 4; ++i)
            __builtin_amdgcn_global_load_lds((const unsigned*)(Bt + kt * 128 + wo[i]), (unsigned*)(st + XS + (wbase + 512 * i) * 16), 16, 0, 0);
    };
    i32x16 acc[MT][4];
#pragma unroll
    for (int s2 = 0; s2 < MT; ++s2)
#pragma unroll
        for (int i = 0; i < 4; ++i)
#pragma unroll
            for (int j = 0; j < 16; ++j) acc[s2][i][j] = 0;
    const int nk = K >> 7;
    stage(0, lds);
    __syncthreads();
#pragma unroll 2
    for (int kt = 0; kt < nk; ++kt) {
        unsigned char* cur = lds + (kt & 1) * STAGE;
        if (kt + 1 < nk) stage(kt + 1, lds + ((kt + 1) & 1) * STAGE);
        i32x4 xfa[MT], wfa[4], xfb[MT], wfb[4];
        auto ldf = [&](i32x4 (&xf)[MT], i32x4 (&wf)[4], int ks) {
#pragma unroll
            for (int s2 = 0; s2 < MT; ++s2) xf[s2] = *(const i32x4*)(cur + sw2(32 * MT * tg + 32 * s2 + r, 2 * ks + h));
#pragma unroll
            for (int mt = 0; mt < 4; ++mt) wf[mt] = *(const i32x4*)(cur + XS + sw2(128 * fh + 32 * mt + r, 2 * ks + h));
        };
        auto mm = [&](const i32x4 (&xf)[MT], const i32x4 (&wf)[4]) {
#pragma unroll
            for (int mt = 0; mt < 4; ++mt)
#pragma unroll
                for (int s2 = 0; s2 < MT; ++s2) acc[s2][mt] = MFMA32I8(wf[mt], xf[s2], acc[s2][mt]);
        };
        ldf(xfa, wfa, 0);
        ldf(xfb, wfb, 1); __builtin_amdgcn_sched_barrier(0); mm(xfa, wfa); __builtin_amdgcn_sched_barrier(0);
        ldf(xfa, wfa, 2); __builtin_amdgcn_sched_barrier(0); mm(xfb, wfb); __builtin_amdgcn_sched_barrier(0);
        ldf(xfb, wfb, 3); __builtin_amdgcn_sched_barrier(0); mm(xfa, wfa); __builtin_amdgcn_sched_barrier(0);
        mm(xfb, wfb);
        __syncthreads();
    }
    auto fin = [&](const i32x16 (&ai)[4], int s2, int ho, int ro, int to) {
        const int tok = m0 + 32 * MT * tg + 32 * s2 + ro, fbase = n0 + 128 * fh;
        const float sa = as[tok < M ? tok : M - 1];
        f32x16 af[4];
#pragma unroll
        for (int mt = 0; mt < 4; ++mt) {
#pragma unroll
            for (int g4 = 0; g4 < 4; ++g4) {
                int f0 = fbase + 32 * mt + 8 * g4 + 4 * ho; f0 = f0 + 3 < N ? f0 : (N - 4 > 0 ? N - 4 : 0);
                const f32x4 sb = *(const f32x4*)(bs + f0);
                af[mt][4 * g4 + 0] = (float)ai[mt][4 * g4 + 0] * (sa * sb.x); af[mt][4 * g4 + 1] = (float)ai[mt][4 * g4 + 1] * (sa * sb.y);
                af[mt][4 * g4 + 2] = (float)ai[mt][4 * g4 + 2] * (sa * sb.z); af[mt][4 * g4 + 3] = (float)ai[mt][4 * g4 + 3] * (sa * sb.w);
            }
            __builtin_amdgcn_sched_barrier(0);
        }
        epi(af, tok, fbase, ho, lds, to);
        __builtin_amdgcn_sched_barrier(0);
    };
    if constexpr (MT == 2 && epi_stash<Epi>::present) {
        int* sp = (int*)lds + w * 4096 + lane;
#pragma unroll
        for (int mt = 0; mt < 4; ++mt)
#pragma unroll
            for (int j = 0; j < 16; ++j) sp[(mt * 16 + j) * 64] = acc[1][mt][j];
        int ho = h, ro = r, to = tid;
        asm volatile("" : "+v"(ho), "+v"(ro), "+v"(to));
        fin(acc[0], 0, ho, ro, to);
        i32x16 a2[4];
        const int* sp2 = sp; asm volatile("" : "+v"(sp2));
#pragma unroll
        for (int mt = 0; mt < 4; ++mt)
#pragma unroll
            for (int j = 0; j < 16; ++j) a2[mt][j] = sp2[(mt * 16 + j) * 64];
        asm volatile("" : "+v"(ho), "+v"(ro), "+v"(to));
        fin(a2, 1, ho, ro, to);
        __syncthreads();
    } else {
        int ho = h, ro = r, to = tid;
#pragma unroll
        for (int s2 = 0; s2 < MT; ++s2) { asm volatile("" : "+v"(ho), "+v"(ro), "+v"(to)); fin(acc[s2], s2, ho, ro, to); }
    }
}
template <int MT, class Epi>
DI void gemm_phase_i8(const unsigned char* A, int M, const float* as, const unsigned char* Bt, int N, const float* bs, int K, const Epi& epi, unsigned char* lds, int tid,
                      int skip = 0) {
    const int ntm = (M + 128 * MT - 1) / (128 * MT), ntn = (N + 255) / 256, nt = ntm * ntn;
    const int bid = (int)blockIdx.x - skip, nbl = (int)gridDim.x - skip;
    if (bid < 0) return;
    if ((gridDim.x & 7) == 0 && (ntm & 31) == 0) {
        const int xcd = bid & 7, lb = bid >> 3, nlb = nbl >> 3, tmx = ntm >> 3, per = tmx * ntn;
        for (int q = lb; q < per; q += nlb) {
            const int g4 = q / (4 * ntn), rem = q - g4 * 4 * ntn, tn = rem >> 2, tm = xcd * tmx + g4 * 4 + (rem & 3);
            gemm_tile_i8<MT>(A, M, as, Bt, N, bs, K, tm * 128 * MT, tn * 256, epi, lds, tid);
        }
        return;
    }
    for (int t = bid; t < nt; t += nbl) {
        const int tn = t / ntm, tm = t % ntm;
        gemm_tile_i8<MT>(A, M, as, Bt, N, bs, K, tm * 128 * MT, tn * 256, epi, lds, tid);
    }
}

DI void wquant_rows(const bf16_t* __restrict__ src, unsigned char* __restrict__ dst, float* __restrict__ sc, int nrows, int gw, int nw, int lane) {
    for (int n = gw; n < nrows; n += nw) {
        const u32x4 a = *(const u32x4*)(src + (long)n * 1024 + 16 * lane), b = *(const u32x4*)(src + (long)n * 1024 + 16 * lane + 8);
        float v[16];
        v[0] = bflo(a.x); v[1] = bfhi(a.x); v[2] = bflo(a.y); v[3] = bfhi(a.y); v[4] = bflo(a.z); v[5] = bfhi(a.z); v[6] = bflo(a.w); v[7] = bfhi(a.w);
        v[8] = bflo(b.x); v[9] = bfhi(b.x); v[10] = bflo(b.y); v[11] = bfhi(b.y); v[12] = bflo(b.z); v[13] = bfhi(b.z); v[14] = bflo(b.w); v[15] = bfhi(b.w);
        float am = 0.f;
#pragma unroll
        for (int q = 0; q < 16; ++q) am = fmaxf(am, fabsf(v[q]));
        am = wave_max(am);
        const float qs = am > 0.f ? 127.f / am : 1.f;
        u32x4 o;
        o.x = (unsigned)pack_i8x4(v[0] * qs, v[1] * qs, v[2] * qs, v[3] * qs); o.y = (unsigned)pack_i8x4(v[4] * qs, v[5] * qs, v[6] * qs, v[7] * qs);
        o.z = (unsigned)pack_i8x4(v[8] * qs, v[9] * qs, v[10] * qs, v[11] * qs); o.w = (unsigned)pack_i8x4(v[12] * qs, v[13] * qs, v[14] * qs, v[15] * qs);
        *(u32x4*)(dst + (long)n * 1024 + 16 * lane) = o;
        if (lane == 0) sc[n] = am > 0.f ? am * (1.f / 127.f) : 1.f;
    }
}
DI void phase_wquant(unsigned char* ws, int tid) {
    const int lane = tid & 63, gw = blockIdx.x * NWAVES + (tid >> 6), nw = gridDim.x * NWAVES;
    float* sc = (float*)(ws + OFF_W8S);
    wquant_rows((const bf16_t*)(ws + OFF_WT_PEER), ws + OFF_W8_PEER, sc + W8S_PEER, 4096, gw, nw, lane);
    wquant_rows((const bf16_t*)(ws + OFF_WT_DIN), ws + OFF_W8_DIN, sc + W8S_DIN, 3072, gw, nw, lane);
    wquant_rows((const bf16_t*)(ws + OFF_WT_KV), ws + OFF_W8_KV, sc + W8S_KV, 1536, gw, nw, lane);
    wquant_rows((const bf16_t*)(ws + OFF_WT_NIN), ws + OFF_W8_NIN, sc + W8S_NIN, 1088, gw, nw, lane);
}

#define XB_TMO      128
#define XB_XCNT(j)  (256  + 64 * (j))
#define XB_XSUB(j)  (1280 + 64 * (j))
#define XB_XGEN(j)  (2304 + 64 * (j))
#define XB_TOP      3328
#define XB_TOPGEN   3392
#define XCD_BAR_WORDS 3456
#define XB_SPIN_CAP (1u << 22)
DI unsigned xb_ld(unsigned* p) { return __hip_atomic_load(p, __ATOMIC_RELAXED, __HIP_MEMORY_SCOPE_AGENT); }
DI unsigned xb_add(unsigned* p, unsigned v) { return __hip_atomic_fetch_add(p, v, __ATOMIC_RELAXED, __HIP_MEMORY_SCOPE_AGENT); }
DI unsigned xb_xcc_id() { return (unsigned)__builtin_amdgcn_s_getreg((3 << 11) | 20) & 0xFu; }
#define XB_SPIN(cond, bar) do { unsigned _sp = 0; while (cond) { __builtin_amdgcn_s_sleep(1); \
    if ((++_sp & 255u) == 0u) { if (xb_ld(&(bar)[XB_TMO])) break; if (_sp > XB_SPIN_CAP) { atomicAdd(&(bar)[XB_TMO], 1u); break; } } } } while (0)
DI void xcd_barrier_complete(unsigned* bar, unsigned x, unsigned& nloc, unsigned& nx) {
    const unsigned G = gridDim.x;
    unsigned sum, cnt, mine, sp = 0u;
    for (;;) {
        sum = 0u; cnt = 0u; mine = 0u;
#pragma unroll
        for (unsigned j = 0; j < 16; ++j) { const unsigned c = xb_ld(&bar[XB_XCNT(j)]); sum += c; cnt += (c > 0u) ? 1u : 0u; mine = (j == x) ? c : mine; }
        if (sum == G) break;
        __builtin_amdgcn_s_sleep(1);
        if ((++sp & 255u) == 0u) { if (xb_ld(&bar[XB_TMO])) break; if (sp > XB_SPIN_CAP) { atomicAdd(&bar[XB_TMO], 1u); break; } }
    }
    nloc = mine > 0u ? mine : 1u; nx = cnt > 0u ? cnt : 1u;
}
DI void xcd_barrier(unsigned* bar, volatile LAS unsigned* st, int tid) {
    asm volatile("s_waitcnt vmcnt(0)" ::: "memory");
    __syncthreads();
    if (tid == 0) {
        const unsigned x = xb_xcc_id();
        __builtin_amdgcn_s_waitcnt(0);
        unsigned nloc = st[0], nx = st[1];
        if (nloc == 0u) { xcd_barrier_complete(bar, x, nloc, nx); st[0] = nloc; st[1] = nx; }
        const unsigned old = xb_add(&bar[XB_XSUB(x)], 1u);
        const unsigned gen = old / nloc;
        if (old + 1u == (gen + 1u) * nloc) {
            __builtin_amdgcn_fence(__ATOMIC_RELEASE, "agent");
            asm volatile("s_waitcnt vmcnt(0)" ::: "memory");
            const unsigned og = xb_add(&bar[XB_TOP], 1u);
            const unsigned tg = og / nx;
            if (og + 1u == (tg + 1u) * nx) xb_add(&bar[XB_TOPGEN], 1u);
            else XB_SPIN(xb_ld(&bar[XB_TOPGEN]) == tg, bar);
            __builtin_amdgcn_fence(__ATOMIC_ACQUIRE, "agent");
            xb_add(&bar[XB_XGEN(x)], 1u);
            asm volatile("s_waitcnt vmcnt(0)" ::: "memory");
        } else {
            XB_SPIN(xb_ld(&bar[XB_XGEN(x)]) == gen, bar);
            __builtin_amdgcn_fence(__ATOMIC_ACQUIRE, "agent");
            asm volatile("s_waitcnt vmcnt(0)" ::: "memory");
        }
    }
    __syncthreads();
}

#define ftid() ftid_(wave_u)
DI int ftid_(int wave_u) { int t = (wave_u << 6) + (int)__builtin_amdgcn_mbcnt_hi(~0u, __builtin_amdgcn_mbcnt_lo(~0u, 0u)); asm volatile("" : "+v"(t)); return t; }


#if defined(__HIP_DEVICE_COMPILE__)
typedef const __attribute__((address_space(4))) Params* KParamPtr;
DI Params load_params() { KParamPtr kp = (KParamPtr)__builtin_amdgcn_kernarg_segment_ptr(); asm volatile("" : "+s"(kp)); return *kp; }
#else
DI Params load_params() { return Params{}; }
#endif
#define p (load_params())
#define ws (load_params().ws)
#define ada ((const float*)(ws + OFF_ADA))
#define Hb ((bf16_t*)(ws + OFF_H))
#define bar ((unsigned*)(ws + OFF_BAR))
__global__ void __launch_bounds__(NTHREADS) yoco_fwd(Params p_arg) {
    extern __shared__ __attribute__((aligned(16))) unsigned char lds[];
    cg::grid_group grid = cg::this_grid();
    volatile LAS unsigned* bst = (volatile LAS unsigned*)(lds + LDS_BAR);
    const int wave_u = __builtin_amdgcn_readfirstlane((int)(threadIdx.x >> 6));
    { const int t0 = ftid(); if (t0 == 0) { bst[0] = 0u; bst[1] = 0u; }
      if (blockIdx.x == 0) for (int i = t0; i < XCD_BAR_WORDS; i += NTHREADS) bar[i] = 0u; }
    __syncthreads();
    RUN(0) REP(0) phase_prep(p, lds, ftid());
    grid.sync();
    if (ftid() == 0) (void)xb_add(&bar[XB_XCNT(xb_xcc_id())], 1u);
    RUN(1) REP(1) phase_norm_q8<false>(p.in[0], Hb, ws + OFF_H8, (float*)(ws + OFF_HS), p.in[5], ada, 0, 1024, ftid());
    RUN(1) phase_wquant(ws, ftid());
    xcd_barrier(bar, bst, ftid());
    RUN(2) REP(2) {
        EpiQKV0 e{(bf16_t*)(ws + OFF_Q0), (bf16_t*)(ws + OFF_K0), (bf16_t*)(ws + OFF_VT0), p.in[10], p.in[11], (float*)(ws + OFF_MB0), p.in[2]};
        gemm_phase_i8<2>(ws + OFF_H8, NTOK, (const float*)(ws + OFF_HS), ws + OFF_W8_DIN, 3072, (const float*)(ws + OFF_W8S) + W8S_DIN, DM, e, lds, ftid());
    }
    xcd_barrier(bar, bst, ftid());
    RUN(3) REP(3) phase_diff_attn(p, lds, ftid());
    __builtin_amdgcn_s_setprio(0);
    xcd_barrier(bar, bst, ftid());
    RUN(4) REP(4) {
        EpiResid e{p.in[0], opq(p.out), ada + 2 * 1024};
        gemm_phase<2>(Hb, DM, NTOK, (const bf16_t*)(ws + OFF_WT_DOUT), DM, 1024, DM, e, lds, ftid());
    }
    xcd_barrier(bar, bst, ftid());
    if (STOP_AFTER <= 1) return;
    RUN(1) phase_norm_q8<false>(opq(p.out), Hb, ws + OFF_H8, (float*)(ws + OFF_HS), p.in[6], ada, 3 * 1024, 4 * 1024, ftid());
    xcd_barrier(bar, bst, ftid());
    RUN(5) REP(5) {
        EpiPeer e{(int*)(ws + OFF_RIDX), (float*)(ws + OFF_RGATE), 128 * 1024};
        gemm_phase_i8<2>(ws + OFF_H8, NTOK, (const float*)(ws + OFF_HS), ws + OFF_W8_PEER, 2048, (const float*)(ws + OFF_W8S) + W8S_PEER, DM, e, lds, ftid());
    }
    xcd_barrier(bar, bst, ftid());
    if ((REPEAT_MASK >> 6) & 1) phase_peer_u<true>(p, 0, lds, ftid());
    RUN(6) phase_peer_u<false>(p, 0, lds, ftid());
    xcd_barrier(bar, bst, ftid());
    if ((REPEAT_MASK >> 10) & 1) phase_peer_v<true>(p, 0, lds, ftid());
    RUN(6) phase_peer_v<false>(p, 0, lds, ftid());
    xcd_barrier(bar, bst, ftid());
    RUN(1) phase_norm2(opq(p.out), ws + OFF_H8, (float*)(ws + OFF_HS), p.in[13], 12288, 12288 + 1024, ws + OFF_H, (float*)(ws + OFF_HS) + NTOK, p.in[5] + 1024, 6144, 6144 + 1024, ada, ftid());
    xcd_barrier(bar, bst, ftid());
    if (STOP_AFTER <= 2) return;
    RUN(7) REP(7) {
        EpiKV e{(bf16_t*)(ws + OFF_KC), (bf16_t*)(ws + OFF_KS), (bf16_t*)(ws + OFF_VST), (bf16_t*)(ws + OFF_KW), (bf16_t*)(ws + OFF_VWT), p.in[21]};
        gemm_phase_i8<2>(ws + OFF_H8, NTOK, (const float*)(ws + OFF_HS), ws + OFF_W8_KV, 1536, (const float*)(ws + OFF_W8S) + W8S_KV, DM, e, lds, ftid());
    }
    xcd_barrier(bar, bst, ftid());
    RUN(8) REP(8) {
        EpiNsaQ e{(bf16_t*)(ws + OFF_QN), (float*)(ws + OFF_GATES), p.in[25], p.in[23], (float*)(ws + OFF_MB1)};
        gemm_phase_i8<2>(ws + OFF_H, NTOK, (const float*)(ws + OFF_HS) + NTOK, ws + OFF_W8_NIN, 1048, (const float*)(ws + OFF_W8S) + W8S_NIN, DM, e, lds, ftid(),
                         gridDim.x >= 128 ? 64 : 0);
        for (int t = blockIdx.x; t < 64; t += gridDim.x) {
            const int pr = t >> 2, tm = t & 3, kv = pr >> 3, bg = pr & 7;
            const bf16_t* Ap = (const bf16_t*)(ws + OFF_KC) + (long)(kv * 8 + bg) * SEQ * 128;
            bf16_t* hid = (bf16_t*)(ws + OFF_HID) + (long)pr * 512 * 256;
            EpiCmp1 e1{hid, (const float*)(ws + OFF_POSB) + kv * 16 * 256, p.in[19] + kv * 256};
            gemm_tile<1>(Ap, 2048, 511, (const bf16_t*)(ws + OFF_WT_C1) + (long)kv * 256 * 4096, 4096, 256, 4096, tm * 128, 0, e1, lds, ftid());
            __syncthreads();
            bf16_t* dst = kv == 0 ? (bf16_t*)(ws + OFF_KCMP) + (long)bg * 512 * 128 : (bf16_t*)(ws + OFF_VCMPT) + (long)bg * 128 * 512;
            EpiCmp2 e2{dst, p.in[21], kv};
            gemm_tile<1>(hid, 256, 512, (const bf16_t*)(ws + OFF_WT_C2) + (long)kv * 128 * 256, 256, 128, 256, tm * 128, 0, e2, lds, ftid());
        }
    }
    xcd_barrier(bar, bst, ftid());
#ifdef NSA_PROBE
    phase_nsa_attn<NSA_PROBE>(p, lds, ftid());
#endif
    RUN(9) REP(9) phase_nsa_attn<0>(p, lds, ftid());
    xcd_barrier(bar, bst, ftid());
    RUN(4) {
        float* xo = opq(p.out);
        EpiResid e{xo, xo, ada + 6144 + 2 * 1024};
        gemm_phase<2>(Hb, DM, NTOK, (const bf16_t*)(ws + OFF_WT_NOUT), DM, 1024, DM, e, lds, ftid());
    }
    xcd_barrier(bar, bst, ftid());
    if (STOP_AFTER <= 3) return;
    RUN(1) phase_norm_q8<false>(opq(p.out), Hb, ws + OFF_H8, (float*)(ws + OFF_HS), p.in[6] + 1024, ada, 6144 + 3 * 1024, 6144 + 4 * 1024, ftid());
    xcd_barrier(bar, bst, ftid());
    RUN(5) REP(5) {
        EpiPeer e{(int*)(ws + OFF_RIDX), (float*)(ws + OFF_RGATE), 128 * 1024};
        gemm_phase_i8<2>(ws + OFF_H8, NTOK, (const float*)(ws + OFF_HS), ws + OFF_W8_PEER + (long)2048 * 1024, 2048, (const float*)(ws + OFF_W8S) + W8S_PEER + 2048, DM, e, lds, ftid());
    }
    xcd_barrier(bar, bst, ftid());
    if ((REPEAT_MASK >> 6) & 1) phase_peer_u<true>(p, 1, lds, ftid());
    RUN(6) phase_peer_u<false>(p, 1, lds, ftid());
    xcd_barrier(bar, bst, ftid());
    if ((REPEAT_MASK >> 10) & 1) phase_peer_v<true>(p, 1, lds, ftid());
    RUN(6) phase_peer_v<false>(p, 1, lds, ftid());
}
#undef p
#undef ws
#undef ada
#undef Hb
#undef bar

extern "C" void kernel_launch(void* const* d_in, const int* in_sizes, int n_in, void* d_out, int out_size, void* d_ws, size_t ws_size,
                              hipStream_t stream) {
    static int grid_blocks = 0;
    if (grid_blocks == 0) {
        if (n_in != 30 || out_size != NTOK * DM || ws_size < WS_END) {
            fprintf(stderr, "kernel_launch: unexpected shapes (n_in %d out %d ws %zu)\n", n_in, out_size, ws_size);
            grid_blocks = -1; return;
        }
        int dev = 0, cus = 0, per_cu = 0;
        hipGetDevice(&dev);
        hipDeviceGetAttribute(&cus, hipDeviceAttributeMultiprocessorCount, dev);
        hipFuncSetAttribute((const void*)yoco_fwd, hipFuncAttributeMaxDynamicSharedMemorySize, LDS_BYTES);
        hipOccupancyMaxActiveBlocksPerMultiprocessor(&per_cu, (const void*)yoco_fwd, NTHREADS, LDS_BYTES);
        if (per_cu < 1) { fprintf(stderr, "kernel_launch: occupancy query says %d blocks per CU\n", per_cu); grid_blocks = -1; return; }
        grid_blocks = cus;
    }
    if (grid_blocks < 0) return;
    Params p{};
    for (int i = 0; i < 30; ++i) p.in[i] = (const float*)d_in[i];
    p.out = (float*)d_out;
    p.ws = (unsigned char*)d_ws;
    void* args[] = {&p};
    hipError_t e = hipLaunchCooperativeKernel((const void*)yoco_fwd, dim3(grid_blocks), dim3(NTHREADS), args, LDS_BYTES, stream);
    if (e != hipSuccess) fprintf(stderr, "cooperative launch failed: %s (grid %d)\n", hipGetErrorString(e), grid_blocks);
}
```

```cpp
#include <hip/hip_runtime.h>
#include <hip/hip_cooperative_groups.h>
#include <cstdio>
#include <cstdint>
namespace cg = cooperative_groups;

#define DI __device__ __forceinline__
#ifndef STOP_AFTER
#define STOP_AFTER 99
#endif
#ifndef ONLY_PHASE
#define ONLY_PHASE -1
#endif
#define RUN(n) if (ONLY_PHASE < 0 || ONLY_PHASE == (n))
#ifndef REPEAT_MASK
#define REPEAT_MASK 0
#endif
#define REP(n) for (int rep_ = 0; rep_ < (((REPEAT_MASK) >> (n)) & 1) + 1; ++rep_)

typedef unsigned short bf16_t;
typedef short bf16x8 __attribute__((ext_vector_type(8)));
typedef float f32x16 __attribute__((ext_vector_type(16)));
typedef float f32x4 __attribute__((ext_vector_type(4)));
typedef float f32x2 __attribute__((ext_vector_type(2)));
typedef unsigned u32x4 __attribute__((ext_vector_type(4)));
typedef unsigned u32x2 __attribute__((ext_vector_type(2)));
typedef __bf16 bf16x2v __attribute__((ext_vector_type(2)));

#define MFMA32(a, b, c) __builtin_amdgcn_mfma_f32_32x32x16_bf16((a), (b), (c), 0, 0, 0)
typedef int i32x4 __attribute__((ext_vector_type(4)));
typedef int i32x16 __attribute__((ext_vector_type(16)));
#define MFMA32I8(a, b, c) __builtin_amdgcn_mfma_i32_32x32x32_i8((a), (b), (c), 0, 0, 0)

constexpr int NB = 4, SEQ = 8192, DM = 1024, NTOK = NB * SEQ;
constexpr int NTHREADS = 512, NWAVES = 8;
constexpr float EPS = 1e-6f;
constexpr float LOG2E = 1.4426950408889634f;
constexpr int ADA_STRIDE = 14336;

constexpr size_t MB = 1u << 20;
constexpr size_t OFF_ADA = 0;
constexpr size_t OFF_POSB = 256 * 1024;
constexpr size_t OFF_BAR = 320 * 1024;
constexpr size_t OFF_MB0 = 168 * MB;
constexpr size_t OFF_MB1 = 172 * MB;
constexpr size_t OFF_H8 = 104 * MB;
constexpr size_t OFF_HS = 174 * MB;
constexpr size_t OFF_W8 = 176 * MB;
constexpr size_t OFF_W8_DIN = OFF_W8, OFF_W8_KV = OFF_W8 + 3 * MB, OFF_W8_NIN = OFF_W8 + 5 * MB, OFF_W8_PEER = OFF_W8 + 7 * MB;
constexpr size_t OFF_W8S = 188 * MB;
constexpr int W8S_DIN = 0, W8S_KV = 3072, W8S_NIN = 4608, W8S_PEER = 5760, W8S_TOTAL = 9856;
constexpr size_t OFF_USI = 384 * 1024;
constexpr size_t OFF_VSI = 512 * 1024;
constexpr size_t OFF_WT_DIN = 1 * MB;
constexpr size_t OFF_WT_DOUT = 7 * MB;
constexpr size_t OFF_WT_KV = 9 * MB;
constexpr size_t OFF_WT_NIN = 12 * MB;
constexpr size_t OFF_WT_NOUT = 15 * MB;
constexpr size_t OFF_WT_PEER = 17 * MB;
constexpr size_t OFF_WT_C1 = 25 * MB;
constexpr size_t OFF_WT_C2 = 29 * MB;
constexpr size_t OFF_GATES = 30 * MB;
constexpr size_t OFF_KCMP = 34 * MB;
constexpr size_t OFF_VCMPT = 35 * MB;
constexpr size_t OFF_HID = 36 * MB;
constexpr size_t OFF_RIDX = 40 * MB;
constexpr size_t OFF_RGATE = 56 * MB;
constexpr size_t OFF_PU = 72 * MB;
constexpr size_t OFF_PV = 136 * MB;
constexpr size_t OFF_H = 200 * MB;
constexpr size_t OFF_R = 264 * MB;
constexpr size_t WS_END = 456 * MB;
constexpr size_t OFF_Q0 = OFF_R, OFF_K0 = OFF_R + 64 * MB, OFF_VT0 = OFF_R + 128 * MB;
constexpr size_t OFF_QN = OFF_R, OFF_H2 = OFF_R, OFF_KC = OFF_R + 64 * MB, OFF_KS = OFF_R + 96 * MB, OFF_VST = OFF_R + 112 * MB,
                 OFF_KW = OFF_R + 128 * MB, OFF_VWT = OFF_R + 144 * MB;

constexpr int LDS_BAR = 159 * 1024;
constexpr int LDS_BYTES = LDS_BAR + 256;

struct Params {
    const float* in[30];
    float* out;
    unsigned char* ws;
};

template <class T> DI T* opq(T* q) { asm volatile("" : "+s"(q)); return (T*)(__attribute__((address_space(1))) T*)q; }
DI unsigned pk2(float lo, float hi) { f32x2 v = {lo, hi}; return __builtin_bit_cast(unsigned, __builtin_convertvector(v, bf16x2v)); }
DI bf16_t f2bf(float x) { return (bf16_t)(pk2(x, 0.f) & 0xffffu); }
DI float bflo(unsigned u) { return __uint_as_float(u << 16); }
DI float bfhi(unsigned u) { return __uint_as_float(u & 0xffff0000u); }
DI float fexp2(float x) { return __builtin_amdgcn_exp2f(x); }
DI float frcp(float x) { return __builtin_amdgcn_rcpf(x); }
DI int crow(int reg, int h) { return (reg & 3) + 8 * (reg >> 2) + 4 * h; }
template <int CTRL> DI float dpp_f(float v) { return __builtin_bit_cast(float, __builtin_amdgcn_update_dpp(0, __builtin_bit_cast(int, v), CTRL, 0xF, 0xF, true)); }
DI float lx1(float v) { return dpp_f<0xB1>(v); }
DI float lx2(float v) { return dpp_f<0x4E>(v); }
DI float lhm(float v) { return dpp_f<0x141>(v); }
DI float lr8(float v) { return dpp_f<0x128>(v); }
DI float sum_x16(float v) { auto s = __builtin_amdgcn_permlane16_swap(__float_as_uint(v), __float_as_uint(v), false, false); return __uint_as_float(s[0]) + __uint_as_float(s[1]); }
DI float sum_x32(float v) { auto s = __builtin_amdgcn_permlane32_swap(__float_as_uint(v), __float_as_uint(v), false, false); return __uint_as_float(s[0]) + __uint_as_float(s[1]); }
DI float max_x16(float v) { auto s = __builtin_amdgcn_permlane16_swap(__float_as_uint(v), __float_as_uint(v), false, false); return fmaxf(__uint_as_float(s[0]), __uint_as_float(s[1])); }
DI float max_x32(float v) { auto s = __builtin_amdgcn_permlane32_swap(__float_as_uint(v), __float_as_uint(v), false, false); return fmaxf(__uint_as_float(s[0]), __uint_as_float(s[1])); }
DI unsigned get_x32(unsigned v, int h) { auto s = __builtin_amdgcn_permlane32_swap(v, v, false, false); return h ? s[0] : s[1]; }
DI float wave_sum(float v) { v += lx1(v); v += lx2(v); v += lhm(v); v += lr8(v); v = sum_x16(v); return sum_x32(v); }
DI float wave_max(float v) { v = fmaxf(v, lx1(v)); v = fmaxf(v, lx2(v)); v = fmaxf(v, lhm(v)); v = fmaxf(v, lr8(v)); v = max_x16(v); return max_x32(v); }
DI int bperm(int v, int srclane) { return __builtin_amdgcn_ds_bpermute(srclane << 2, v); }
DI float bpermf(float v, int srclane) { return __builtin_bit_cast(float, __builtin_amdgcn_ds_bpermute(srclane << 2, __builtin_bit_cast(int, v))); }
DI float gelu_tanh(float x) {
    const float u = 0.7978845608028654f * (x + 0.044715f * x * x * x);
    return x * frcp(1.f + fexp2(-2.f * LOG2E * u));
}
DI float dot2bf(unsigned a, unsigned b, float c) {
    return __builtin_amdgcn_fdot2_f32_bf16(__builtin_bit_cast(bf16x2v, a), __builtin_bit_cast(bf16x2v, b), c, false);
}
DI int rel_bucket_i(int d) {
    if (d < 16) return d < 0 ? 0 : d;
    int b = 16;
    b += d >= 21; b += d >= 27; b += d >= 35; b += d >= 46; b += d >= 59; b += d >= 77; b += d >= 99; b += d >= 128;
    b += d >= 166; b += d >= 216; b += d >= 280; b += d >= 363; b += d >= 470; b += d >= 609; b += d >= 790;
    return b;
}
DI unsigned f2key(float f) { unsigned u = __float_as_uint(f); return u ^ ((unsigned)((int)u >> 31) | 0x80000000u); }
DI float key2f(unsigned k) { unsigned u = (k & 0x80000000u) ? (k ^ 0x80000000u) : ~k; return __uint_as_float(u); }

constexpr int EPI_LDS = 96 * 1024;

DI int sw2(int row, int chunk) { return (row >> 1) * 256 + (((((row & 1) << 3) | chunk) ^ ((row >> 1) & 15)) << 4); }
DI void sw2_src(int P, int& row, int& chunk) { const int R2 = P >> 4, lc = (P & 15) ^ (R2 & 15); row = 2 * R2 + (lc >> 3); chunk = lc & 7; }

template <class T, class = void> struct epi_stash { static constexpr bool value = false, present = false; };
template <class T> struct epi_stash<T, decltype((void)T::STASH)> { static constexpr bool value = T::STASH, present = true; };

template <int MT, class Epi>
DI void gemm_tile(const bf16_t* __restrict__ A, long lda, int M, const bf16_t* __restrict__ Bt, long ldb, int N, int K,
                  int m0, int n0, const Epi& epi, unsigned char* lds, int tid) {
    constexpr int XS = MT * 128 * 128, WS = 256 * 128, STAGE = XS + WS;
    const int lane = tid & 63, w = tid >> 6, tg = w & 3, fh = w >> 2, r = lane & 31, h = lane >> 5;
    const int wbase = tid & ~63;
    unsigned xo[2 * MT], wo[4];
#pragma unroll
    for (int i = 0; i < 2 * MT; ++i) { int row, c; sw2_src(tid + 512 * i, row, c); int m = m0 + row; m = m < M ? m : M - 1; xo[i] = (unsigned)m * (unsigned)(lda * 2) + c * 16; }
#pragma unroll
    for (int i = 0; i < 4; ++i) { int row, c; sw2_src(tid + 512 * i, row, c); int n = n0 + row; n = n < N ? n : N - 1; wo[i] = (unsigned)n * (unsigned)(ldb * 2) + c * 16; }
    const unsigned char* Ab = (const unsigned char*)A;
    const unsigned char* Bb = (const unsigned char*)Bt;
    auto stage = [&](int kt, unsigned char* st) {
#pragma unroll
        for (int i = 0; i < 2 * MT; ++i)
            __builtin_amdgcn_global_load_lds((const unsigned*)(Ab + kt * 128 + xo[i]), (unsigned*)(st + (wbase + 512 * i) * 16), 16, 0, 0);
#pragma unroll
        for (int i = 0; i < 4; ++i)
            __builtin_amdgcn_global_load_lds((const unsigned*)(Bb + kt * 128 + wo[i]), (unsigned*)(st + XS + (wbase + 512 * i) * 16), 16, 0, 0);
    };
    f32x16 acc[MT][4];
#pragma unroll
    for (int s2 = 0; s2 < MT; ++s2)
#pragma unroll
        for (int i = 0; i < 4; ++i)
#pragma unroll
            for (int j = 0; j < 16; ++j) acc[s2][i][j] = 0.f;
    const int nk = K >> 6;
    stage(0, lds);
    __syncthreads();
    for (int kt = 0; kt < nk; ++kt) {
        unsigned char* cur = lds + (kt & 1) * STAGE;
        if (kt + 1 < nk) stage(kt + 1, lds + ((kt + 1) & 1) * STAGE);
        bf16x8 xfa[MT], wfa[4], xfb[MT], wfb[4];
        auto ldf = [&](bf16x8 (&xf)[MT], bf16x8 (&wf)[4], int ks) {
#pragma unroll
            for (int s2 = 0; s2 < MT; ++s2) xf[s2] = *(const bf16x8*)(cur + sw2(32 * MT * tg + 32 * s2 + r, 2 * ks + h));
#pragma unroll
            for (int mt = 0; mt < 4; ++mt) wf[mt] = *(const bf16x8*)(cur + XS + sw2(128 * fh + 32 * mt + r, 2 * ks + h));
        };
        auto mm = [&](const bf16x8 (&xf)[MT], const bf16x8 (&wf)[4]) {
#pragma unroll
            for (int mt = 0; mt < 4; ++mt)
#pragma unroll
                for (int s2 = 0; s2 < MT; ++s2) acc[s2][mt] = MFMA32(wf[mt], xf[s2], acc[s2][mt]);
        };
        ldf(xfa, wfa, 0);
        ldf(xfb, wfb, 1); __builtin_amdgcn_sched_barrier(0); mm(xfa, wfa); __builtin_amdgcn_sched_barrier(0);
        ldf(xfa, wfa, 2); __builtin_amdgcn_sched_barrier(0); mm(xfb, wfb); __builtin_amdgcn_sched_barrier(0);
        ldf(xfb, wfb, 3); __builtin_amdgcn_sched_barrier(0); mm(xfa, wfa); __builtin_amdgcn_sched_barrier(0);
        mm(xfb, wfb);
        __syncthreads();
    }
    if constexpr (MT == 2 && epi_stash<Epi>::value) {
        float* sp = (float*)lds + w * 4096 + lane;
#pragma unroll
        for (int mt = 0; mt < 4; ++mt)
#pragma unroll
            for (int j = 0; j < 16; ++j) sp[(mt * 16 + j) * 64] = acc[1][mt][j];
        epi(acc[0], m0 + 64 * tg + r, n0 + 128 * fh, h, lds, tid);
        f32x16 a2[4];
        const float* sp2 = sp; asm volatile("" : "+v"(sp2));
#pragma unroll
        for (int mt = 0; mt < 4; ++mt)
#pragma unroll
            for (int j = 0; j < 16; ++j) a2[mt][j] = sp2[(mt * 16 + j) * 64];
        epi(a2, m0 + 64 * tg + 32 + r, n0 + 128 * fh, h, lds, tid);
        __syncthreads();
    } else {
        int ho = h, ro = r, to = tid;
        if constexpr (epi_stash<Epi>::present) asm volatile("" : "+v"(ho), "+v"(ro), "+v"(to));
#pragma unroll
        for (int s2 = 0; s2 < MT; ++s2) epi(acc[s2], m0 + 32 * MT * tg + 32 * s2 + ro, n0 + 128 * fh, ho, lds, to);
    }
}

DI void store_vt_tile(bf16_t* base, long rstride, const f32x16& a, int row0, int h, int lane) {
    const bool odd = lane & 1;
#pragma unroll
    for (int rg = 0; rg < 16; rg += 2) {
        const float xa = lx1(a[rg]), xb = lx1(a[rg + 1]);
        const unsigned wv = odd ? pk2(xb, a[rg + 1]) : pk2(a[rg], xa);
        bf16_t* dp = base + (long)(row0 + crow(odd ? rg + 1 : rg, h)) * rstride - (odd ? 1 : 0);
        *(unsigned*)dp = wv;
    }
}
struct EpiQKV0 {
    bf16_t *Q, *Kk, *VT;
    const float *qg, *kg;
    float* MB; const float* relb;
    DI void operator()(const f32x16 (&acc)[4], int tok, int fbase, int h, unsigned char*, int) const {
        const int sec = fbase >> 10, hd = (fbase & 1023) >> 7, b = tok >> 13, s = tok & (SEQ - 1);
        if (sec < 2) {
            const float* gn = sec == 0 ? qg : kg;
            const float sc = sec == 0 ? 0.125f * LOG2E : 1.f;
            bf16_t* dst = sec == 0 ? Q : Kk;
#pragma unroll
            for (int j = 0; j < 2; ++j) {
                float ss = 0.f;
#pragma unroll
                for (int mt = 0; mt < 2; ++mt)
#pragma unroll
                    for (int rg = 0; rg < 16; ++rg) { const float v = acc[2 * j + mt][rg]; ss += v * v; }
                ss = sum_x32(ss);
                const float rstd = rsqrtf(ss * (1.f / 64.f) + EPS) * sc;
                bf16_t* row = dst + ((long)((b * 8 + hd) * 2 + j) * SEQ + s) * 64;
                float qq = 0.f;
#pragma unroll
                for (int mt = 0; mt < 2; ++mt)
#pragma unroll
                    for (int g4 = 0; g4 < 4; ++g4) {
                        const int d0 = 32 * mt + 8 * g4 + 4 * h;
                        const f32x4 gv = *(const f32x4*)(gn + d0);
                        const float v0 = acc[2 * j + mt][4 * g4 + 0] * rstd * gv.x, v1 = acc[2 * j + mt][4 * g4 + 1] * rstd * gv.y;
                        const float v2 = acc[2 * j + mt][4 * g4 + 2] * rstd * gv.z, v3 = acc[2 * j + mt][4 * g4 + 3] * rstd * gv.w;
                        qq += v0 * v0 + v1 * v1 + v2 * v2 + v3 * v3;
                        u32x2 o;
                        o.x = pk2(v0, v1); o.y = pk2(v2, v3);
                        *(u32x2*)(row + d0) = o;
                    }
                if (sec == 0) {
                    qq = sum_x32(qq);
                    float kmx = 0.f;
                    for (int d = 0; d < 64; ++d) kmx = fmaxf(kmx, fabsf(kg[d]));
                    float bmx = 0.f;
                    for (int bk = 0; bk < 32; ++bk) bmx = fmaxf(bmx, relb[bk * 8 + hd] - relb[31 * 8 + hd]);
                    if (h == 0) MB[(long)((b * 8 + hd) * 2 + j) * SEQ + s] = 1.01f * sqrtf(qq) * 8.f * kmx + bmx * LOG2E;
                }
            }
        } else {
            bf16_t* base = VT + (long)(b * 8 + hd) * 128 * SEQ + s;
#pragma unroll
            for (int mt = 0; mt < 4; ++mt) store_vt_tile(base, SEQ, acc[mt], 32 * mt, h, tok);
        }
    }
};

struct EpiResid {
    const float* xin; float* xout; const float* gate;
    DI void operator()(const f32x16 (&acc)[4], int tok, int fbase, int h, unsigned char* lds, int tid) const {
        const int lane = tid & 63, w = tid >> 6, r = lane & 31, hh = lane >> 5;
        float* T = (float*)(lds + w * 16896);
#pragma unroll
        for (int mt = 0; mt < 4; ++mt)
#pragma unroll
            for (int g4 = 0; g4 < 4; ++g4)
                *(f32x4*)(T + r * 132 + 32 * mt + 8 * g4 + 4 * h) = (f32x4){acc[mt][4 * g4 + 0], acc[mt][4 * g4 + 1], acc[mt][4 * g4 + 2], acc[mt][4 * g4 + 3]};
        const int tok0 = tok - r, b = tok0 >> 13, f = fbase + 4 * r;
        const f32x4 gv = *(const f32x4*)(gate + b * ADA_STRIDE + f);
        __builtin_amdgcn_sched_barrier(0);
        const float* xp = xin + (long)(tok0 + hh) * DM + f;
        float* op = xout + (long)(tok0 + hh) * DM + f;
        const float* tp = T + hh * 132 + 4 * r;
#pragma unroll
        for (int i0 = 0; i0 < 16; i0 += 4) {
            f32x4 xv[4];
#pragma unroll
            for (int i = 0; i < 4; ++i) xv[i] = *(const f32x4*)(xp + (long)(2 * (i0 + i)) * DM);
#pragma unroll
            for (int i = 0; i < 4; ++i) {
                const f32x4 a = *(const f32x4*)(tp + 2 * (i0 + i) * 132);
                f32x4 o;
                o.x = xv[i].x + gv.x * a.x; o.y = xv[i].y + gv.y * a.y; o.z = xv[i].z + gv.z * a.z; o.w = xv[i].w + gv.w * a.w;
                *(f32x4*)(op + (long)(2 * (i0 + i)) * DM) = o;
            }
            __builtin_amdgcn_sched_barrier(0);
        }
        __syncthreads();
    }
};

struct EpiKV {
    bf16_t *KC, *KS, *VST, *KW, *VWT;
    const float* kgain;
    DI void operator()(const f32x16 (&acc)[4], int tok, int fbase, int h, unsigned char*, int) const {
        const int c = fbase >> 7, br = c >> 2, kv = (c >> 1) & 1, g = c & 1, b = tok >> 13, s = tok & (SEQ - 1);
        if (br == 0 || kv == 0) {
            float rstd = 1.f;
            bf16_t* row;
            if (br == 0) row = KC + ((long)((kv * 4 + b) * 2 + g) * SEQ + s) * 128;
            else {
                float ss = 0.f;
#pragma unroll
                for (int mt = 0; mt < 4; ++mt)
#pragma unroll
                    for (int rg = 0; rg < 16; ++rg) ss += acc[mt][rg] * acc[mt][rg];
                ss = sum_x32(ss);
                rstd = rsqrtf(ss * (1.f / 128.f) + EPS);
                row = (br == 1 ? KS : KW) + ((long)(b * 2 + g) * SEQ + s) * 128;
            }
#pragma unroll
            for (int mt = 0; mt < 4; ++mt)
#pragma unroll
                for (int g4 = 0; g4 < 4; ++g4) {
                    const int d0 = 32 * mt + 8 * g4 + 4 * h;
                    f32x4 gv = {1.f, 1.f, 1.f, 1.f};
                    if (br != 0) gv = *(const f32x4*)(kgain + br * 128 + d0);
                    u32x2 o;
                    o.x = pk2(acc[mt][4 * g4 + 0] * rstd * gv.x, acc[mt][4 * g4 + 1] * rstd * gv.y);
                    o.y = pk2(acc[mt][4 * g4 + 2] * rstd * gv.z, acc[mt][4 * g4 + 3] * rstd * gv.w);
                    *(u32x2*)(row + d0) = o;
                }
        } else {
            bf16_t* base = (br == 1 ? VST : VWT) + (long)(b * 2 + g) * 128 * SEQ + s;
#pragma unroll
            for (int mt = 0; mt < 4; ++mt) store_vt_tile(base, SEQ, acc[mt], 32 * mt, h, tok);
        }
    }
};

struct EpiCmp1 {
    bf16_t* hid; const float* posb_part; const float* b1;
    DI void operator()(const f32x16 (&acc)[4], int tok, int fbase, int h, unsigned char*, int) const {
        if (tok >= 512) return;
#pragma unroll
        for (int mt = 0; mt < 4; ++mt)
#pragma unroll
            for (int g4 = 0; g4 < 4; ++g4) {
                const int f = fbase + 32 * mt + 8 * g4 + 4 * h;
                f32x4 pb = *(const f32x4*)(b1 + f);
                for (int c = 0; c < 16; ++c) { const f32x4 t = *(const f32x4*)(posb_part + c * 256 + f); pb.x += t.x; pb.y += t.y; pb.z += t.z; pb.w += t.w; }
                u32x2 o;
                o.x = pk2(gelu_tanh(acc[mt][4 * g4 + 0] + pb.x), gelu_tanh(acc[mt][4 * g4 + 1] + pb.y));
                o.y = pk2(gelu_tanh(acc[mt][4 * g4 + 2] + pb.z), gelu_tanh(acc[mt][4 * g4 + 3] + pb.w));
                *(u32x2*)(hid + (long)tok * 256 + f) = o;
            }
    }
};

struct EpiCmp2 {
    bf16_t* dst; const float* kgain0; int kv;
    DI void operator()(const f32x16 (&acc)[4], int tok, int fbase, int h, unsigned char*, int) const {
        if (fbase != 0 || tok >= 512) return;
        const float valid = tok < 511 ? 1.f : 0.f;
        if (kv == 0) {
            float ss = 0.f;
#pragma unroll
            for (int mt = 0; mt < 4; ++mt)
#pragma unroll
                for (int rg = 0; rg < 16; ++rg) ss += acc[mt][rg] * acc[mt][rg];
            ss = sum_x32(ss);
            const float rstd = rsqrtf(ss * (1.f / 128.f) + EPS) * valid;
#pragma unroll
            for (int mt = 0; mt < 4; ++mt)
#pragma unroll
                for (int g4 = 0; g4 < 4; ++g4) {
                    const int d0 = 32 * mt + 8 * g4 + 4 * h;
                    const f32x4 gv = *(const f32x4*)(kgain0 + d0);
                    u32x2 o;
                    o.x = pk2(acc[mt][4 * g4 + 0] * rstd * gv.x, acc[mt][4 * g4 + 1] * rstd * gv.y);
                    o.y = pk2(acc[mt][4 * g4 + 2] * rstd * gv.z, acc[mt][4 * g4 + 3] * rstd * gv.w);
                    *(u32x2*)(dst + (long)tok * 128 + d0) = o;
                }
        } else {
#pragma unroll
            for (int mt = 0; mt < 4; ++mt)
#pragma unroll
                for (int rg = 0; rg < 16; ++rg) dst[(long)(32 * mt + crow(rg, h)) * 512 + tok] = f2bf(acc[mt][rg] * valid);
        }
    }
};

struct EpiNsaQ {
    bf16_t* QN; float* gates; const float* qgain; const float* bgate; float* qnrm;
    DI void operator()(const f32x16 (&acc)[4], int tok, int fbase, int h, unsigned char*, int) const {
        const int b = tok >> 13, s = tok & (SEQ - 1);
        if (fbase < 1024) {
            const int head = fbase >> 7;
            float ss = 0.f;
#pragma unroll
            for (int mt = 0; mt < 4; ++mt)
#pragma unroll
                for (int rg = 0; rg < 16; ++rg) ss += acc[mt][rg] * acc[mt][rg];
            ss = sum_x32(ss);
            const float rstd = rsqrtf(ss * (1.f / 128.f) + EPS) * (0.08838834764831845f * LOG2E);
            bf16_t* row = QN + ((long)(b * 8 + head) * SEQ + s) * 128;
            float qq = 0.f;
#pragma unroll
            for (int mt = 0; mt < 4; ++mt)
#pragma unroll
                for (int g4 = 0; g4 < 4; ++g4) {
                    const int d0 = 32 * mt + 8 * g4 + 4 * h;
                    const f32x4 gv = *(const f32x4*)(qgain + d0);
                    const float v0 = acc[mt][4 * g4 + 0] * rstd * gv.x, v1 = acc[mt][4 * g4 + 1] * rstd * gv.y;
                    const float v2 = acc[mt][4 * g4 + 2] * rstd * gv.z, v3 = acc[mt][4 * g4 + 3] * rstd * gv.w;
                    qq += v0 * v0 + v1 * v1 + v2 * v2 + v3 * v3;
                    u32x2 o;
                    o.x = pk2(v0, v1); o.y = pk2(v2, v3);
                    *(u32x2*)(row + d0) = o;
                }
            qq = sum_x32(qq);
            if (h == 0) qnrm[(long)tok * 8 + head] = 1.01f * sqrtf(qq);
        } else if (fbase == 1024) {
#pragma unroll
            for (int rg = 0; rg < 16; ++rg) {
                const int f = crow(rg, h);
                if (f < 24) { const float z = acc[0][rg] + bgate[f]; gates[(long)tok * 24 + f] = frcp(1.f + fexp2(-LOG2E * z)); }
            }
        }
    }
};

DI void ce_desc(unsigned& a, unsigned& b) { const unsigned hi = a > b ? a : b, lo = a > b ? b : a; a = hi; b = lo; }
DI void sort16_desc(unsigned (&a)[16]) {
#define CE_(i, j) ce_desc(a[i], a[j]);
    CE_(0,13) CE_(1,12) CE_(2,15) CE_(3,14) CE_(4,8) CE_(5,6) CE_(7,11) CE_(9,10)
    CE_(0,5) CE_(1,7) CE_(2,9) CE_(3,4) CE_(6,13) CE_(8,14) CE_(10,15) CE_(11,12)
    CE_(0,1) CE_(2,3) CE_(4,5) CE_(6,8) CE_(7,9) CE_(10,11) CE_(12,13) CE_(14,15)
    CE_(0,2) CE_(1,3) CE_(4,10) CE_(5,11) CE_(6,7) CE_(8,9) CE_(12,14) CE_(13,15)
    CE_(1,2) CE_(3,12) CE_(4,6) CE_(5,7) CE_(8,10) CE_(9,11) CE_(13,14)
    CE_(1,4) CE_(2,6) CE_(5,8) CE_(7,10) CE_(9,13) CE_(11,14)
    CE_(2,4) CE_(3,6) CE_(9,12) CE_(11,13)
    CE_(3,5) CE_(6,8) CE_(7,9) CE_(10,12)
    CE_(3,4) CE_(5,6) CE_(7,8) CE_(9,10) CE_(11,12)
    CE_(6,7) CE_(8,9)
#undef CE_
}
DI void bitonic_merge16_desc(unsigned (&a)[16]) {
#pragma unroll
    for (int st = 8; st >= 1; st >>= 1)
#pragma unroll
        for (int i = 0; i < 16; ++i)
            if ((i & st) == 0) ce_desc(a[i], a[i + st]);
}
DI void merge_top16(unsigned (&a)[16], const unsigned (&b)[16]) {
#pragma unroll
    for (int i = 0; i < 16; ++i) a[i] = a[i] > b[15 - i] ? a[i] : b[15 - i];
    bitonic_merge16_desc(a);
}

struct EpiPeer {
    static constexpr bool STASH = false;
    int* ridx; float* rgate; int ex_off;
    DI void operator()(const f32x16 (&acc)[4], int tok, int fbase, int h, unsigned char* lds, int tid) const {
        const int lane = tid & 63, w = tid >> 6, tg = w & 3, fh = w >> 2, r = lane & 31;
        const int hd = fbase >> 8;
        unsigned* EX = (unsigned*)(lds + ex_off);
        unsigned L[16];
        {
            unsigned G1[16], G2[16], G3[16];
#pragma unroll
            for (int rg = 0; rg < 16; ++rg) {
                const int c = crow(rg, h);
                L[rg] = (f2key(acc[0][rg]) & ~127u) | (unsigned)(127 - c);
                G1[rg] = (f2key(acc[1][rg]) & ~127u) | (unsigned)(127 - 32 - c);
                G2[rg] = (f2key(acc[2][rg]) & ~127u) | (unsigned)(127 - 64 - c);
                G3[rg] = (f2key(acc[3][rg]) & ~127u) | (unsigned)(127 - 96 - c);
            }
            sort16_desc(L); sort16_desc(G1); merge_top16(L, G1);
            sort16_desc(G2); sort16_desc(G3); merge_top16(G2, G3);
            merge_top16(L, G2);
        }
        {
            unsigned P[16];
#pragma unroll
            for (int i = 0; i < 16; ++i) P[i] = get_x32(L[i], h);
            merge_top16(L, P);
        }
        if (h == 0) {
#pragma unroll
            for (int i = 0; i < 16; i += 4) *(u32x4*)(EX + ((fh * 4 + tg) * 32 + r) * 16 + i) = (u32x4){L[i], L[i + 1], L[i + 2], L[i + 3]};
        }
        __syncthreads();
        float xf[4], ys[16];
        {
            const unsigned* l0 = EX + ((0 * 4 + tg) * 32 + r) * 16;
            const unsigned* l1 = EX + ((1 * 4 + tg) * 32 + r) * 16;
            const unsigned* px = h ? l1 : l0;
            const unsigned* py = h ? l0 : l1;
            const u32x4 a = *(const u32x4*)px;
            xf[0] = key2f(a.x & ~127u); xf[1] = key2f(a.y & ~127u); xf[2] = key2f(a.z & ~127u); xf[3] = key2f(a.w & ~127u);
            unsigned Y[16];
#pragma unroll
            for (int i = 0; i < 16; i += 4) { const u32x4 b2 = *(const u32x4*)(py + i); Y[i] = b2.x; Y[i + 1] = b2.y; Y[i + 2] = b2.z; Y[i + 3] = b2.w; }
#pragma unroll
            for (int k = 0; k < 15; ++k) ys[k] = key2f((h ? Y[k + 1] : Y[k]) & ~127u);
            ys[15] = key2f(Y[15] & ~127u);
        }
        auto pkey = [&](int i, int k) -> unsigned {
            const float fs = xf[i] + ys[k];
            const unsigned code = h ? (unsigned)((((k + 1) & 15) << 4) | i) : (unsigned)((i << 4) | k);
            return (f2key(fs) & ~255u) | (255u - code);
        };
        unsigned T[16], E[16];
#pragma unroll
        for (int k = 0; k < 16; ++k) T[k] = pkey(0, k);
        T[15] = h ? 0u : T[15];
#pragma unroll
        for (int k = 1; k <= 7; ++k) E[k - 1] = pkey(1, k);
#pragma unroll
        for (int k = 2; k <= 4; ++k) E[7 + k - 2] = pkey(2, k);
        E[10] = pkey(3, 3);
#pragma unroll
        for (int k = 11; k < 16; ++k) E[k] = 0u;
        sort16_desc(E);
        merge_top16(T, E);
        {
            unsigned P[16];
#pragma unroll
            for (int i = 0; i < 16; ++i) P[i] = get_x32(T[i], h);
            merge_top16(T, P);
        }
        float sc[16], sum = 0.f;
        const float mx = key2f(T[0] & ~255u);
#pragma unroll
        for (int k = 0; k < 16; ++k) { sc[k] = fexp2((key2f(T[k] & ~255u) - mx) * LOG2E); sum += sc[k]; }
        const float inv = frcp(sum);
        if (h == 0) {
            const unsigned* l0 = EX + ((0 * 4 + tg) * 32 + r) * 16;
            const unsigned* l1 = EX + ((1 * 4 + tg) * 32 + r) * 16;
#pragma unroll
            for (int k = 0; k < 16; ++k) {
                if ((k >> 3) != fh) continue;
                const unsigned code = 255u - (T[k] & 255u);
                const int i1 = 127 - (int)(l0[code >> 4] & 127u), i2 = 127 - (int)(l1[code & 15u] & 127u);
                ridx[(long)tok * 128 + hd * 16 + k] = i1 * 128 + i2;
                rgate[(long)tok * 128 + hd * 16 + k] = sc[k] * inv;
            }
        }
        __syncthreads();
    }
};

DI void p0_transpose_item(const float* __restrict__ W, int K, int N, bf16_t* __restrict__ WT, int item, int ntn, unsigned char* lds, int tid) {
    float* tile = (float*)lds;
    const int kb = item / ntn, nb = item % ntn, k0 = kb * 64, n0 = nb * 64;
    {
        const int nn = tid & 63, kk0 = tid >> 6;
#pragma unroll
        for (int i = 0; i < 8; ++i) { const int kk = kk0 + 8 * i; const int n = n0 + nn; tile[kk * 65 + nn] = n < N ? W[(long)(k0 + kk) * N + n] : 0.f; }
    }
    __syncthreads();
    {
        const int n = tid >> 3, c = tid & 7;
        const float* s = tile + (8 * c) * 65 + n;
        u32x4 o;
        o.x = pk2(s[0], s[65]); o.y = pk2(s[2 * 65], s[3 * 65]); o.z = pk2(s[4 * 65], s[5 * 65]); o.w = pk2(s[6 * 65], s[7 * 65]);
        *(u32x4*)(WT + (long)(n0 + n) * K + k0 + 8 * c) = o;
    }
    __syncthreads();
}

DI int pack_i8x4(float a, float b, float c, float d) {
    const int ia = __float2int_rn(a), ib = __float2int_rn(b), ic = __float2int_rn(c), id = __float2int_rn(d);
    return (ia & 255) | ((ib & 255) << 8) | ((ic & 255) << 16) | (id << 24);
}
DI void p0_fp8_item(const float* __restrict__ src, unsigned char* __restrict__ dst, float* __restrict__ sinv, bool sliced, int item, int tid) {
    const int lane = tid & 63, row = item * 8 + (tid >> 6);
    const float* rp = src + (long)row * 1024;
    f32x4 v[4]; float am = 0.f;
#pragma unroll
    for (int j = 0; j < 4; ++j) {
        v[j] = *(const f32x4*)(rp + 4 * lane + 256 * j);
        am = fmaxf(am, fmaxf(fmaxf(fabsf(v[j].x), fabsf(v[j].y)), fmaxf(fabsf(v[j].z), fabsf(v[j].w))));
    }
    am = wave_max(am);
    const float sc = sliced ? (am > 0.f ? exp2f(floorf(log2f(384.f / am))) : 1.f) : (am > 0.f ? 127.f / am : 1.f);
    if (lane == 0) sinv[row] = 1.f / sc;
#pragma unroll
    for (int j = 0; j < 4; ++j) {
        int pk = 0;
        if (sliced) {
            pk = __builtin_amdgcn_cvt_pk_fp8_f32(v[j].x * sc, v[j].y * sc, pk, false);
            pk = __builtin_amdgcn_cvt_pk_fp8_f32(v[j].z * sc, v[j].w * sc, pk, true);
        } else pk = pack_i8x4(v[j].x * sc, v[j].y * sc, v[j].z * sc, v[j].w * sc);
        const int col = 4 * lane + 256 * j;
        unsigned char* d = sliced ? dst + ((long)(col >> 7) * 16384 + row) * 128 + (col & 127) : dst + (long)row * 1024 + col;
        *(int*)d = pk;
    }
}

DI void p0_weff_item(const float* __restrict__ wq, const float* __restrict__ subk, bf16_t* __restrict__ WT, int item, unsigned char* lds, int tid) {
    const int layer = item >> 8, g = (item >> 4) & 15, ct = item & 15, p = g & 1, c0 = ct * 64;
    float* As = (float*)lds;
    float* Bs = As + 64 * 129;
    const float* wql = wq + (long)layer * 1024 * 2048;
    const float* sk = subk + ((long)layer * 2 + p) * 128 * 128;
    for (int e = tid; e < 64 * 128; e += NTHREADS) { const int c = e >> 7, d = e & 127; As[c * 129 + d] = wql[(long)(c0 + c) * 2048 + g * 128 + d]; }
    for (int e = tid; e < 128 * 128; e += NTHREADS) { const int k = e >> 7, d = e & 127; Bs[k * 129 + d] = sk[k * 128 + d]; }
    __syncthreads();
    const int lane = tid & 63, w = tid >> 6, ti = w & 3, tj = w >> 2, r = lane & 31, h = lane >> 5;
    f32x16 acc;
#pragma unroll
    for (int i = 0; i < 16; ++i) acc[i] = 0.f;
    const float* ap = Bs + (32 * ti + r) * 129 + h;
    const float* bp = As + (32 * tj + r) * 129 + h;
#pragma unroll 8
    for (int d = 0; d < 128; d += 2) acc = __builtin_amdgcn_mfma_f32_32x32x2f32(ap[d], bp[d], acc, 0, 0, 0);
    bf16_t* o = WT + ((long)layer * 2048 + g * 128 + 32 * ti) * 1024 + c0 + 32 * tj + r;
#pragma unroll
    for (int i = 0; i < 16; ++i) o[(long)crow(i, h) * 1024] = f2bf(acc[i]);
    __syncthreads();
}

DI void p0_posb_item(const float* __restrict__ pos, const float* __restrict__ w1, float* __restrict__ part, int item, unsigned char* lds, int tid) {
    const int kv = item >> 4, ch = item & 15;
    float* red = (float*)lds;
    const int j = tid & 255, half = tid >> 8;
    const float* pp = pos + (long)kv * 4096 + ch * 256 + half * 128;
    const float* ww = w1 + ((long)kv * 4096 + ch * 256 + half * 128) * 256 + j;
    float a = 0.f;
    for (int f = 0; f < 128; ++f) a += pp[f] * ww[(long)f * 256];
    red[half * 256 + j] = a;
    __syncthreads();
    if (tid < 256) part[(kv * 16 + ch) * 256 + tid] = red[tid] + red[256 + tid];
    __syncthreads();
}

DI void p0_ada_item(const Params& p, float* __restrict__ ada, int item, unsigned char* lds, int tid) {
    float* cact = (float*)lds;
    float* red = cact + 4096;
    const float* c = p.in[1];
    for (int e = tid; e < 4096; e += NTHREADS) { const float v = c[e]; cact[e] = v * frcp(1.f + fexp2(-LOG2E * v)); }
    __syncthreads();
    const int colg = item * 64;
    const float* W; const float* bias; int N, n0;
    if (colg < 6144) { W = p.in[3]; bias = p.in[4]; N = 6144; n0 = colg; }
    else if (colg < 12288) { W = p.in[3] + (long)1024 * 6144; bias = p.in[4] + 6144; N = 6144; n0 = colg - 6144; }
    else { W = p.in[14]; bias = p.in[15]; N = 2048; n0 = colg - 12288; }
    const int col = tid & 63, kg = tid >> 6;
    float a0 = 0.f, a1 = 0.f, a2 = 0.f, a3 = 0.f;
    const float* wp = W + (long)(kg * 128) * N + n0 + col;
#pragma unroll 8
    for (int k = 0; k < 128; ++k) {
        const float wv = wp[(long)k * N];
        const int kk = kg * 128 + k;
        a0 += cact[kk] * wv; a1 += cact[1024 + kk] * wv; a2 += cact[2048 + kk] * wv; a3 += cact[3072 + kk] * wv;
    }
    red[(kg * 4 + 0) * 64 + col] = a0; red[(kg * 4 + 1) * 64 + col] = a1; red[(kg * 4 + 2) * 64 + col] = a2; red[(kg * 4 + 3) * 64 + col] = a3;
    __syncthreads();
    if (tid < 256) {
        const int b = tid >> 6, cc = tid & 63;
        float s = bias[n0 + cc];
#pragma unroll
        for (int q = 0; q < 8; ++q) s += red[(q * 4 + b) * 64 + cc];
        ada[b * ADA_STRIDE + colg + cc] = s;
    }
    __syncthreads();
}

constexpr int P0_CONV = 8192, P0_TR_DIN = 768, P0_TR_DOUT = 256, P0_TR_KV = 384, P0_TR_NIN = 288, P0_TR_NOUT = 256, P0_TR_C1 = 512, P0_TR_C2 = 16,
              P0_WEFF = 512, P0_POSB = 32, P0_ADA = 224;
constexpr int P0_TOTAL = P0_CONV + P0_TR_DIN + P0_TR_DOUT + P0_TR_KV + P0_TR_NIN + P0_TR_NOUT + P0_TR_C1 + P0_TR_C2 + P0_WEFF + P0_POSB + P0_ADA;

DI void phase_prep(const Params& p, unsigned char* lds, int tid) {
    unsigned char* ws = p.ws;
    for (int it = blockIdx.x; it < P0_TOTAL; it += gridDim.x) {
        int r = it;
        if (r < P0_ADA) { p0_ada_item(p, (float*)(ws + OFF_ADA), r, lds, tid); continue; } r -= P0_ADA;
        if (r < P0_WEFF) { p0_weff_item(p.in[26], p.in[27], (bf16_t*)(ws + OFF_WT_PEER), r, lds, tid); continue; } r -= P0_WEFF;
        if (r < P0_POSB) { p0_posb_item(p.in[17], p.in[18], (float*)(ws + OFF_POSB), r, lds, tid); continue; } r -= P0_POSB;
        if (r < P0_TR_DIN) { p0_transpose_item(p.in[7], 1024, 3072, (bf16_t*)(ws + OFF_WT_DIN), r, 48, lds, tid); continue; } r -= P0_TR_DIN;
        if (r < P0_TR_DOUT) { p0_transpose_item(p.in[8], 1024, 1024, (bf16_t*)(ws + OFF_WT_DOUT), r, 16, lds, tid); continue; } r -= P0_TR_DOUT;
        if (r < P0_TR_KV) { p0_transpose_item(p.in[16], 1024, 1536, (bf16_t*)(ws + OFF_WT_KV), r, 24, lds, tid); continue; } r -= P0_TR_KV;
        if (r < P0_TR_NIN) { p0_transpose_item(p.in[22], 1024, 1048, (bf16_t*)(ws + OFF_WT_NIN), r, 18, lds, tid); continue; } r -= P0_TR_NIN;
        if (r < P0_TR_NOUT) { p0_transpose_item(p.in[24], 1024, 1024, (bf16_t*)(ws + OFF_WT_NOUT), r, 16, lds, tid); continue; } r -= P0_TR_NOUT;
        if (r < P0_TR_C1) { const int kv = r >> 8; p0_transpose_item(p.in[18] + (long)kv * 4096 * 256, 4096, 256, (bf16_t*)(ws + OFF_WT_C1) + (long)kv * 256 * 4096, r & 255, 4, lds, tid); continue; } r -= P0_TR_C1;
        if (r < P0_TR_C2) { const int kv = r >> 3; p0_transpose_item(p.in[20] + (long)kv * 256 * 128, 256, 128, (bf16_t*)(ws + OFF_WT_C2) + (long)kv * 128 * 256, r & 7, 2, lds, tid); continue; } r -= P0_TR_C2;
        {
            const int tbl = r >> 11, sub = r & 2047;
            const int layer = tbl & 1;
            const float* src = (tbl < 2 ? p.in[28] : p.in[29]) + (long)layer * 16384 * 1024;
            unsigned char* dst = ws + (tbl < 2 ? OFF_PU : OFF_PV) + (long)layer * 16384 * 1024;
            float* sinv = (float*)(ws + (tbl < 2 ? OFF_USI : OFF_VSI)) + layer * 16384;
            p0_fp8_item(src, dst, sinv, tbl >= 2, sub, tid);
        }
    }
}

DI void norm_row_write(const f32x4 (&v)[4], float rstd, const float* gain, const float* shift, const float* scale, bf16_t* orow, int lane) {
#pragma unroll
    for (int j = 0; j < 4; ++j) {
        const int c = 4 * lane + 256 * j;
        const f32x4 g = *(const f32x4*)(gain + c), sh = *(const f32x4*)(shift + c), sc = *(const f32x4*)(scale + c);
        u32x2 o;
        o.x = pk2(v[j].x * rstd * g.x * (1.f + sc.x) + sh.x, v[j].y * rstd * g.y * (1.f + sc.y) + sh.y);
        o.y = pk2(v[j].z * rstd * g.z * (1.f + sc.z) + sh.z, v[j].w * rstd * g.w * (1.f + sc.w) + sh.w);
        *(u32x2*)(orow + c) = o;
    }
}
template <bool BF>
DI void phase_norm_q8(const float* __restrict__ x, bf16_t* __restrict__ out, unsigned char* __restrict__ out8, float* __restrict__ outs,
                      const float* gain, const float* ada, int shift_off, int scale_off, int tid) {
    const int lane = tid & 63, gw = blockIdx.x * NWAVES + (tid >> 6), nw = gridDim.x * NWAVES;
    for (int tok = gw; tok < NTOK; tok += nw) {
        const int b = tok >> 13;
        f32x4 v[4]; float ss = 0.f;
#pragma unroll
        for (int j = 0; j < 4; ++j) { v[j] = *(const f32x4*)(x + (long)tok * DM + 4 * lane + 256 * j); ss += v[j].x * v[j].x + v[j].y * v[j].y + v[j].z * v[j].z + v[j].w * v[j].w; }
        const float rstd = rsqrtf(wave_sum(ss) * (1.f / DM) + EPS);
        const float* shift = ada + b * ADA_STRIDE + shift_off; const float* scale = ada + b * ADA_STRIDE + scale_off;
        float am = 0.f;
#pragma unroll
        for (int j = 0; j < 4; ++j) {
            const int c = 4 * lane + 256 * j;
            const f32x4 g = *(const f32x4*)(gain + c), sh = *(const f32x4*)(shift + c), sc = *(const f32x4*)(scale + c);
            v[j].x = v[j].x * rstd * g.x * (1.f + sc.x) + sh.x; v[j].y = v[j].y * rstd * g.y * (1.f + sc.y) + sh.y;
            v[j].z = v[j].z * rstd * g.z * (1.f + sc.z) + sh.z; v[j].w = v[j].w * rstd * g.w * (1.f + sc.w) + sh.w;
            if constexpr (BF) { u32x2 o; o.x = pk2(v[j].x, v[j].y); o.y = pk2(v[j].z, v[j].w); *(u32x2*)(out + (long)tok * DM + c) = o; }
            am = fmaxf(am, fmaxf(fmaxf(fabsf(v[j].x), fabsf(v[j].y)), fmaxf(fabsf(v[j].z), fabsf(v[j].w))));
        }
        am = wave_max(am);
        const float qs = am > 0.f ? 127.f / am : 1.f;
#pragma unroll
        for (int j = 0; j < 4; ++j) *(int*)(out8 + (long)tok * DM + 4 * lane + 256 * j) = pack_i8x4(v[j].x * qs, v[j].y * qs, v[j].z * qs, v[j].w * qs);
        if (lane == 0) outs[tok] = am > 0.f ? am * (1.f / 127.f) : 1.f;
    }
}
DI void phase_norm(const float* __restrict__ x, bf16_t* __restrict__ out, const float* gain, const float* ada, int shift_off, int scale_off, int tid) {
    const int lane = tid & 63, gw = blockIdx.x * NWAVES + (tid >> 6), nw = gridDim.x * NWAVES;
    for (int tok = gw; tok < NTOK; tok += nw) {
        const int b = tok >> 13;
        f32x4 v[4]; float ss = 0.f;
#pragma unroll
        for (int j = 0; j < 4; ++j) { v[j] = *(const f32x4*)(x + (long)tok * DM + 4 * lane + 256 * j); ss += v[j].x * v[j].x + v[j].y * v[j].y + v[j].z * v[j].z + v[j].w * v[j].w; }
        const float rstd = rsqrtf(wave_sum(ss) * (1.f / DM) + EPS);
        norm_row_write(v, rstd, gain, ada + b * ADA_STRIDE + shift_off, ada + b * ADA_STRIDE + scale_off, out + (long)tok * DM, lane);
    }
}

DI int kidx(int mt, int i) { return 32 * mt + 16 * (i >> 3) + (i & 7); }
template <int DQK>
DI void attn_qk32(const unsigned char* Ks, const bf16x8 (&qf)[DQK / 16], f32x16& st, int mt, int r, int h, float init = 0.f) {
    constexpr int RB = DQK * 2, MSK = DQK == 64 ? 7 : 15;
    const int row = 32 * mt + ((r & 0x13) | ((r & 4) << 1) | ((r & 8) >> 1));
#pragma unroll
    for (int i = 0; i < 16; ++i) st[i] = init;
#pragma unroll
    for (int ks = 0; ks < DQK / 16; ++ks) {
        const bf16x8 kf = RB == 128 ? *(const bf16x8*)(Ks + sw2(row, 2 * ks + h)) : *(const bf16x8*)(Ks + row * RB + (((2 * ks + h) ^ (row & MSK)) << 4));
        st = MFMA32(kf, qf[ks], st);
    }
}
DI void attn_pack32(const f32x16& st, bf16x8 (&pf)[2]) {
#pragma unroll
    for (int s = 0; s < 2; ++s) {
        u32x4 t;
        t.x = pk2(st[8 * s + 0], st[8 * s + 1]); t.y = pk2(st[8 * s + 2], st[8 * s + 3]);
        t.z = pk2(st[8 * s + 4], st[8 * s + 5]); t.w = pk2(st[8 * s + 6], st[8 * s + 7]);
        pf[s] = __builtin_bit_cast(bf16x8, t);
    }
}
DI void attn_softmax32(f32x16& st, float& m, float& l, f32x16 (&o)[4]) {
    float mx = st[0];
#pragma unroll
    for (int i = 1; i < 16; ++i) mx = fmaxf(mx, st[i]);
    mx = max_x32(mx);
    const float mn = fmaxf(m, mx);
    if (!__all(mn == m)) {
        const float alpha = fexp2(m - mn);
        l *= alpha;
#pragma unroll
        for (int dt = 0; dt < 4; ++dt)
#pragma unroll
            for (int i = 0; i < 16; ++i) o[dt][i] *= alpha;
        m = mn;
    }
    float sum = 0.f;
#pragma unroll
    for (int i = 0; i < 16; ++i) { const float pv = fexp2(st[i] - m); st[i] = pv; sum += pv; }
    l += sum;
}
DI void attn_softmax32_b(f32x16& st, float& l) {
    float sum = 0.f;
#pragma unroll
    for (int i = 0; i < 16; ++i) { const float pv = fexp2(st[i]); st[i] = pv; sum += pv; }
    l += sum;
}
DI void attn_pv32(const unsigned char* Vs, const bf16x8 (&pf)[2], f32x16 (&o)[4], int mt, int r, int h) {
#pragma unroll
    for (int dt = 0; dt < 4; ++dt)
#pragma unroll
        for (int s2 = 0; s2 < 2; ++s2) {
            const int row = 32 * dt + r;
            const bf16x8 vf = *(const bf16x8*)(Vs + sw2(row, 2 * (2 * mt + s2) + h));
            o[dt] = MFMA32(vf, pf[s2], o[dt]);
        }
}
template <int RB, int NROWS>
DI void dma_offsets(unsigned (&off)[NROWS * RB / 16 / 512], unsigned gstride, int tid) {
    constexpr int CPR = RB / 16;
#pragma unroll
    for (int i = 0; i < NROWS * CPR / 512; ++i) {
        const int idx = tid + 512 * i;
        int row, cp;
        if (RB == 128) sw2_src(idx, row, cp); else { row = idx / CPR; cp = (idx % CPR) ^ (row & (CPR - 1)); }
        off[i] = (unsigned)row * gstride + (cp << 4);
    }
}
template <int N>
DI void dma_issue(unsigned char* dst, const unsigned char* gbase, const unsigned (&off)[N], int tid) {
    const int wbase = tid & ~63;
#pragma unroll
    for (int i = 0; i < N; ++i)
        __builtin_amdgcn_global_load_lds((const unsigned*)(gbase + off[i]), (unsigned*)(dst + (wbase + 512 * i) * 16), 16, 0, 0);
}

constexpr int AT_STAGE = 32 * 1024;
constexpr int AT_LUT = 2 * AT_STAGE;
constexpr int LUT_N = 1280, LUT_OFF = 1100;
constexpr int LUTC_W = 52;
constexpr int AT_LUTC = AT_LUT + 20 * 1024;
constexpr int AT_IMP = AT_LUTC + 13 * 1024;
constexpr int AT_SEL = AT_IMP + 34 * 1024;

DI void phase_diff_attn(const Params& p, unsigned char* lds, int tid) {
    unsigned char* ws = p.ws;
    const bf16_t* Q = (const bf16_t*)(ws + OFF_Q0);
    const bf16_t* Kk = (const bf16_t*)(ws + OFF_K0);
    const bf16_t* VT = (const bf16_t*)(ws + OFF_VT0);
    bf16_t* O = (bf16_t*)(ws + OFF_H);
    const float* relb = p.in[2];
    const float* lam = p.in[9];
    const float* subln = p.in[12];
    const int lane = tid & 63, w = tid >> 6, comp = w & 1, qg = w >> 1, r = lane & 31, h = lane >> 5;
    float* lut = (float*)(lds + 128 * 1024);
    if (w >= 4) __builtin_amdgcn_s_setprio(1);
    float lam_full;
    {
        const float s01 = wave_sum(lam[lane] * lam[64 + lane]), s23 = wave_sum(lam[128 + lane] * lam[192 + lane]);
        lam_full = __expf(s01) - __expf(s23) + 0.2f;
    }
    const int G = gridDim.x, rows_per_it = G >> 5;
    unsigned koff[1], voff[2];
    dma_offsets<128, 64>(koff, 128, tid);
    dma_offsets<128, 128>(voff, SEQ * 2, tid);
    constexpr int ST2 = 64 * 1024;
    for (int it = 0;; ++it) {
        int qb, b, hd;
        if (G == 256) {
            if (it >= 8) break;
            const int xcd = blockIdx.x & 7, lb = blockIdx.x >> 3, pr = xcd * 4 + (it >> 1);
            qb = (it & 1) ? lb : 63 - lb; b = pr >> 3; hd = pr & 7;
        } else {
            int u;
            if ((G & 31) == 0) {
                const int rr = blockIdx.x >> 5, cc = blockIdx.x & 31;
                const int rowi = it * rows_per_it + ((it & 1) ? rows_per_it - 1 - rr : rr);
                u = rowi * 32 + cc;
            } else u = it * G + blockIdx.x;
            if (u >= 2048) break;
            qb = 63 - (u >> 5); b = (u & 31) >> 3; hd = u & 7;
        }
        const int q0 = qb * 128, ntiles = qb + 1;
        const int qpos = q0 + 32 * qg + r, qlo = q0 + 32 * qg, qhi = qlo + 31;
        for (int e = tid; e < LUT_N; e += NTHREADS) { const int d = LUT_OFF - e; lut[e] = d < 0 ? -INFINITY : (d >= 790 ? 0.f : (relb[rel_bucket_i(d) * 8 + hd] - relb[31 * 8 + hd]) * LOG2E); }
        bf16x8 qf[4];
        {
            const bf16_t* qrow = Q + ((long)((b * 8 + hd) * 2 + comp) * SEQ + qpos) * 64;
#pragma unroll
            for (int ks = 0; ks < 4; ++ks) qf[ks] = *(const bf16x8*)(qrow + 16 * ks + 8 * h);
        }
        const unsigned char* k0g = (const unsigned char*)(Kk + (long)((b * 8 + hd) * 2 + 0) * SEQ * 64);
        const unsigned char* k1g = (const unsigned char*)(Kk + (long)((b * 8 + hd) * 2 + 1) * SEQ * 64);
        const unsigned char* vtg = (const unsigned char*)(VT + (long)(b * 8 + hd) * 128 * SEQ);
        f32x16 o[4];
#pragma unroll
        for (int dt = 0; dt < 4; ++dt)
#pragma unroll
            for (int i = 0; i < 16; ++i) o[dt][i] = 0.f;
        float l = 0.f;
        const float nmb = -((const float*)(ws + OFF_MB0))[(long)((b * 8 + hd) * 2 + comp) * SEQ + qpos];
        auto stage = [&](int kt, unsigned char* st) {
#pragma unroll
            for (int sb = 0; sb < 2; ++sb) {
                dma_issue(st + sb * 8192, k0g + (long)(2 * kt + sb) * 8192, koff, tid);
                dma_issue(st + 16384 + sb * 8192, k1g + (long)(2 * kt + sb) * 8192, koff, tid);
                dma_issue(st + 32768 + sb * 16384, vtg + (long)(2 * kt + sb) * 128, voff, tid);
            }
        };
        stage(0, lds);
        __syncthreads();
        for (int kt = 0; kt < ntiles; ++kt) {
            unsigned char* cur = lds + (kt & 1) * ST2;
            if (kt + 1 < ntiles) stage(kt + 1, lds + ((kt + 1) & 1) * ST2);
            const bool nearb = qlo - (kt * 128 + 127) < 790;
            const int dbase0 = qpos - kt * 128 - 8 * h;
            const unsigned char* kb = cur + comp * 16384;
            f32x16 sa, sbv;
            attn_qk32<64>(kb, qf, sa, 0, r, h, nmb);
#pragma unroll
            for (int j = 0; j < 4; ++j) {
                f32x16& sc = (j & 1) ? sbv : sa;
                f32x16& sn = (j & 1) ? sa : sbv;
                if (j < 3) attn_qk32<64>(kb + ((j + 1) >> 1) * 8192, qf, sn, (j + 1) & 1, r, h, nmb);
                if (nearb) {
                    const float* lp = lut + (LUT_OFF - dbase0 + 64 * (j >> 1));
#pragma unroll
                    for (int i = 0; i < 16; ++i) sc[i] += lp[kidx(j & 1, i)];
                }
                attn_softmax32_b(sc, l);
                bf16x8 pf[2];
                attn_pack32(sc, pf);
                attn_pv32(cur + 32768 + (j >> 1) * 16384, pf, o, j & 1, r, h);
            }
            __syncthreads();
        }
        l = sum_x32(l);
        const float inv = l > 0.f ? frcp(l) : 0.f;
        float* xch = (float*)lds + qg * 4096;
        if (comp == 1) {
            const float sc = inv * lam_full;
#pragma unroll
            for (int dt = 0; dt < 4; ++dt)
#pragma unroll
                for (int i = 0; i < 16; ++i) xch[(dt * 16 + i) * 64 + lane] = o[dt][i] * sc;
        }
        __syncthreads();
        if (comp == 0) {
            float ss = 0.f;
#pragma unroll
            for (int dt = 0; dt < 4; ++dt)
#pragma unroll
                for (int i = 0; i < 16; ++i) { const float v = o[dt][i] * inv - xch[(dt * 16 + i) * 64 + lane]; o[dt][i] = v; ss += v * v; }
            ss = sum_x32(ss);
            const float rstd = rsqrtf(ss * (1.f / 128.f) + EPS) * 0.8f;
            bf16_t* orow = O + (long)(b * SEQ + qpos) * DM + hd * 128;
#pragma unroll
            for (int dt = 0; dt < 4; ++dt)
#pragma unroll
                for (int g4 = 0; g4 < 4; ++g4) {
                    const int d0 = 32 * dt + 8 * g4 + 4 * h;
                    const f32x4 gv = *(const f32x4*)(subln + d0);
                    u32x2 ov;
                    ov.x = pk2(o[dt][4 * g4 + 0] * rstd * gv.x, o[dt][4 * g4 + 1] * rstd * gv.y);
                    ov.y = pk2(o[dt][4 * g4 + 2] * rstd * gv.z, o[dt][4 * g4 + 3] * rstd * gv.w);
                    *(u32x2*)(orow + d0) = ov;
                }
        }
        __syncthreads();
    }
}

template <int VAR>
DI void phase_nsa_attn(const Params& p, unsigned char* lds, int tid) {
    unsigned char* ws = p.ws;
    const bf16_t* QN = (const bf16_t*)(ws + OFF_QN);
    const bf16_t* KS = (const bf16_t*)(ws + OFF_KS);
    const bf16_t* VST = (const bf16_t*)(ws + OFF_VST);
    const bf16_t* KW = (const bf16_t*)(ws + OFF_KW);
    const bf16_t* VWT = (const bf16_t*)(ws + OFF_VWT);
    const bf16_t* KCMP = (const bf16_t*)(ws + OFF_KCMP);
    const bf16_t* VCMPT = (const bf16_t*)(ws + OFF_VCMPT);
    const float* gates = (const float*)(ws + OFF_GATES);
    bf16_t* O = VAR ? (bf16_t*)(ws + OFF_PU + 32 * MB) : (bf16_t*)(ws + OFF_H);
    const float* relb = p.in[2];
    const int lane = tid & 63, w = tid >> 6, hg = w >> 1, th = w & 1, r = lane & 31, h = lane >> 5;
    float* lut = (float*)(lds + AT_LUT);
    float* lutc = (float*)(lds + AT_LUTC);
    float* imp = (float*)(lds + AT_IMP);
    unsigned* selw = (unsigned*)(lds + AT_SEL);
    unsigned short* sel16 = (unsigned short*)selw;
    float* bmxs = (float*)(selw + 264);
    const float* qnrm = (const float*)(ws + OFF_MB1);
    float kmx[3];
    for (int br = 0; br < 3; ++br) kmx[br] = wave_max(fmaxf(fabsf(p.in[21][br * 128 + lane]), fabsf(p.in[21][br * 128 + 64 + lane]))) * 11.313708498984761f;
    const int G = gridDim.x, rows_per_it = G >> 3;
    int lut_g = -1;
    for (int it = 0;; ++it) {
        int u;
        if ((G & 7) == 0) {
            const int rr = blockIdx.x >> 3, cc = blockIdx.x & 7;
            const int rowi = it * rows_per_it + ((it & 1) ? rows_per_it - 1 - rr : rr);
            u = rowi * 8 + cc;
        } else u = it * G + blockIdx.x;
        if (u >= 1024) break;
        const int bi = 127 - (u >> 3), b = (u & 7) >> 1, g = u & 1, head = 4 * g + hg;
        const int tq = 64 * bi + 32 * th + r;
        const int tl = 32 * th + r;
        const long tok = (long)b * SEQ + tq;
        if (g != lut_g) {
            lut_g = g;
            if (tid < 128) {
                const int hh = tid >> 5, bk = tid & 31;
                float bm = fmaxf(0.f, relb[bk * 8 + 4 * g + hh] - relb[31 * 8 + 4 * g + hh]);
                bm = fmaxf(bm, lx1(bm)); bm = fmaxf(bm, lx2(bm)); bm = fmaxf(bm, lhm(bm)); bm = fmaxf(bm, lr8(bm)); bm = max_x16(bm);
                if (bk == 0) bmxs[hh] = bm * LOG2E;
            }
            for (int e = tid; e < 4 * LUT_N; e += NTHREADS) { const int hh = e / LUT_N, d = LUT_OFF - (e % LUT_N); lut[e] = d < 0 ? -INFINITY : (d >= 790 ? 0.f : (relb[rel_bucket_i(d) * 8 + 4 * g + hh] - relb[31 * 8 + 4 * g + hh]) * LOG2E); }
            for (int e = tid; e < 4 * 16 * LUTC_W; e += NTHREADS) {
                const int hh = e / (16 * LUTC_W), ph = (e / LUTC_W) & 15, ci = e % LUTC_W, d = 16 * (ci - 1) + ph;
                lutc[e] = ci == 0 ? -INFINITY : (d >= 790 ? 0.f : (relb[rel_bucket_i(d) * 8 + 4 * g + hh] - relb[31 * 8 + 4 * g + hh]) * LOG2E);
            }
        }
        if (tid < 4) selw[256 + tid] = 0u;
        const float* mylut = lut + hg * LUT_N;
        bf16x8 qf[8];
        const bf16_t* qrow = QN + ((long)(b * 8 + head) * SEQ + tq) * 128 + 8 * h;
        auto load_q = [&](const bf16_t* qr) {
#pragma unroll
            for (int ks = 0; ks < 8; ++ks) qf[ks] = *(const bf16x8*)(qr + 16 * ks);
        };
        const float* gp = gates + tok * 24 + head * 3;
        bf16_t* orow = O + (VAR ? (tok & 16383) : tok) * DM + head * 128;
        auto stage = [&](const unsigned char* kg, const unsigned char* vg, unsigned vstride, int kt, unsigned char* st) {
            int t2 = tid; asm volatile("" : "+v"(t2));
            unsigned koff[2], vo[2];
            dma_offsets<256, 64>(koff, 256, t2);
            dma_offsets<128, 128>(vo, vstride, t2);
            dma_issue(st, kg + (long)kt * 16384, koff, t2);
            dma_issue(st + 16384, vg + (long)kt * 128, vo, t2);
        };
        f32x16 o[4];
        float l;
        auto reset = [&]() {
#pragma unroll
            for (int dt = 0; dt < 4; ++dt)
#pragma unroll
                for (int i = 0; i < 16; ++i) o[dt][i] = 0.f;
            l = 0.f;
        };
        const unsigned char* kcg = (const unsigned char*)(KCMP + (long)(b * 2 + g) * 512 * 128);
        const unsigned char* vcg = (const unsigned char*)(VCMPT + (long)(b * 2 + g) * 128 * 512);
        const int nct = ((4 * bi + 2) >> 6) + 1;
        const int hgc = r & 3, tlc = 8 * w + (r >> 2), tqc = 64 * bi + tlc;
        const long tokc = (long)b * SEQ + tqc;
        reset();
        load_q(QN + ((long)(b * 8 + 4 * g + hgc) * SEQ + tqc) * 128 + 8 * h);
        __syncthreads();
        if (VAR != 3) {
            const int cb = (tqc - 31) >> 4;
            const int cfar = ((64 * bi + 8 * w - 31) >> 4) - 8 - 23;
            const float* lc = lutc + (hgc * 16 + ((tqc - 31) & 15)) * LUTC_W + 1;
            const float nmb = -(qnrm[tokc * 8 + 4 * g + hgc] * kmx[0] + bmxs[hgc]);
            stage(kcg, vcg, 1024u, 0, lds);
            __syncthreads();
            for (int kt = 0; kt < nct; ++kt) {
                unsigned char* cur = lds + (kt & 1) * AT_STAGE;
                if (kt + 1 < nct) stage(kcg, vcg, 1024u, kt + 1, lds + ((kt + 1) & 1) * AT_STAGE);
                const int cbase = cb - kt * 64 - 8 * h;
#pragma unroll
                for (int mt = 0; mt < 2; ++mt) {
                    f32x16 st;
                    attn_qk32<128>(cur, qf, st, mt, r, h, nmb);
                    float sum = 0.f;
                    if (cfar - kt * 64 - 32 * mt >= 50) {
#pragma unroll
                        for (int i = 0; i < 16; ++i) sum += fexp2(st[i]);
                    } else {
#pragma unroll
                        for (int i = 0; i < 16; ++i) {
                            const int c = cbase - kidx(mt, i);
                            sum += fexp2(st[i] + lc[c < -1 ? -1 : (c > 50 ? 50 : c)]);
                        }
                    }
                    l += sum;
                }
                __syncthreads();
            }
            const float lt = sum_x32(l);
            const float invl = lt > 0.f ? frcp(lt) : 0.f;
            stage(kcg, vcg, 1024u, 0, lds);
            __syncthreads();
            float carry = 0.f;
            for (int kt = 0; kt < nct; ++kt) {
                unsigned char* cur = lds + (kt & 1) * AT_STAGE;
                if (kt + 1 < nct) stage(kcg, vcg, 1024u, kt + 1, lds + ((kt + 1) & 1) * AT_STAGE);
                const int cbase = cb - kt * 64 - 8 * h;
                float o0[4], o1[4], sp[4];
#pragma unroll
                for (int mt = 0; mt < 2; ++mt) {
                    f32x16 st;
                    attn_qk32<128>(cur, qf, st, mt, r, h, nmb);
                    if (cfar - kt * 64 - 32 * mt >= 50) {
#pragma unroll
                        for (int i = 0; i < 16; ++i) st[i] = fexp2(st[i]) * invl;
                    } else {
#pragma unroll
                        for (int i = 0; i < 16; ++i) {
                            const int c = cbase - kidx(mt, i);
                            st[i] = fexp2(st[i] + lc[c < -1 ? -1 : (c > 50 ? 50 : c)]) * invl;
                        }
                    }
#pragma unroll
                    for (int gq = 0; gq < 2; ++gq) {
                        const int G2 = 2 * mt + gq, q0 = 2 * gq, q1 = 2 * gq + 1;
                        const float c20 = 0.5f * st[4 * q0 + 3];
                        o0[G2] = st[4 * q0] + st[4 * q0 + 1] + st[4 * q0 + 2] + c20;
                        o1[G2] = st[4 * q1] + st[4 * q1 + 1] + st[4 * q1 + 2] + 0.5f * st[4 * q1 + 3] + c20;
                        sp[G2] = 0.5f * st[4 * q1 + 3];
                    }
                    bf16x8 pf[2];
                    attn_pack32(st, pf);
                    attn_pv32(cur + 16384, pf, o, mt, r, h);
                }
                float rc[4];
#pragma unroll
                for (int G2 = 0; G2 < 4; ++G2) rc[G2] = __uint_as_float(get_x32(__float_as_uint(sp[G2]), h));
                if (h) {
#pragma unroll
                    for (int G2 = 0; G2 < 4; ++G2) o0[G2] += rc[G2];
                } else {
                    o0[0] += carry; o0[1] += rc[0]; o0[2] += rc[1]; o0[3] += rc[2];
                    carry = rc[3];
                }
#pragma unroll
                for (int G2 = 0; G2 < 4; ++G2) {
                    float a0 = o0[G2], a1 = o1[G2];
                    a0 += lx1(a0); a0 += lx2(a0); a1 += lx1(a1); a1 += lx2(a1);
                    if (hgc == 0) *(f32x2*)(imp + tlc * 130 + kt * 16 + 4 * G2 + 2 * h) = (f32x2){a0, a1};
                }
                __syncthreads();
            }
        }
        {
            const float g_c = gates[tokc * 24 + (4 * g + hgc) * 3];
            bf16_t* orc = O + (VAR ? (tokc & 16383) : tokc) * DM + (4 * g + hgc) * 128;
#pragma unroll
            for (int dt = 0; dt < 4; ++dt)
#pragma unroll
                for (int g4 = 0; g4 < 4; ++g4) {
                    const int d0 = 32 * dt + 8 * g4 + 4 * h;
                    u32x2 ov;
                    ov.x = pk2(o[dt][4 * g4 + 0] * g_c, o[dt][4 * g4 + 1] * g_c);
                    ov.y = pk2(o[dt][4 * g4 + 2] * g_c, o[dt][4 * g4 + 3] * g_c);
                    *(u32x2*)(orc + d0) = ov;
                }
        }
        if (VAR != 5) {
            const int tkn = tid >> 3, part = tid & 7;
            unsigned key[16];
#pragma unroll
            for (int q = 0; q < 16; ++q) {
                const int j = part * 16 + q;
                float v = imp[tkn * 130 + j];
                const int back = bi - j;
                if (j == 0 || (back >= 0 && back < 2)) v = 1e9f;
                if (back < 0) v = -1e30f;
                key[q] = f2key(v);
            }
            unsigned srt[16];
#pragma unroll
            for (int q = 0; q < 16; ++q) { key[q] = (key[q] & ~127u) | (unsigned)(127 - (part * 16 + q)); srt[q] = key[q]; }
            sort16_desc(srt);
            {
                unsigned pr[16];
#pragma unroll
                for (int q = 0; q < 16; ++q) pr[q] = (unsigned)__builtin_amdgcn_update_dpp(0, (int)srt[q], 0xB1, 0xF, 0xF, true);
                merge_top16(srt, pr);
#pragma unroll
                for (int q = 0; q < 16; ++q) pr[q] = (unsigned)__builtin_amdgcn_update_dpp(0, (int)srt[q], 0x4E, 0xF, 0xF, true);
                merge_top16(srt, pr);
#pragma unroll
                for (int q = 0; q < 16; ++q) pr[q] = (unsigned)__builtin_amdgcn_update_dpp(0, (int)srt[q], 0x141, 0xF, 0xF, true);
                merge_top16(srt, pr);
            }
            const unsigned T16 = srt[15];
            unsigned bits = 0;
#pragma unroll
            for (int q = 0; q < 16; ++q) bits |= (key[q] >= T16 && key[q] >= 0x80000000u) ? (1u << q) : 0u;
            sel16[tkn * 8 + part] = (unsigned short)bits;
            atomicOr(&selw[256 + (part >> 1)], bits << ((part & 1) * 16));
        }
        __syncthreads();
        const unsigned un0 = selw[256], un1 = selw[257], un2 = selw[258], un3 = selw[259];
        const unsigned char* ksg = (const unsigned char*)(KS + (long)(b * 2 + g) * SEQ * 128);
        const unsigned char* vsg = (const unsigned char*)(VST + (long)(b * 2 + g) * 128 * SEQ);
        reset(); load_q(qrow);
        const float qn_main = qnrm[tok * 8 + head];
        {
            const float nmb = -(qn_main * kmx[1] + bmxs[hg]);
            const unsigned long long ulo = ((unsigned long long)(unsigned)__builtin_amdgcn_readfirstlane((int)un1) << 32) | (unsigned)__builtin_amdgcn_readfirstlane((int)un0);
            const unsigned long long uhi = ((unsigned long long)(unsigned)__builtin_amdgcn_readfirstlane((int)un3) << 32) | (unsigned)__builtin_amdgcn_readfirstlane((int)un2);
            auto next_tile = [&](int from) -> int {
                if (from < 64) { const unsigned long long mk = ulo >> from; if (mk) return from + __builtin_ctzll(mk); from = 64; }
                if (from < 128) { const unsigned long long mk = uhi >> (from - 64); if (mk) return from + __builtin_ctzll(mk); }
                return 128;
            };
            int jt = (VAR == 1 || VAR == 4 || VAR == 5) ? 128 : next_tile(0);
            int buf = 0;
            if (jt < 128) stage(ksg, vsg, SEQ * 2u, jt, lds);
            __syncthreads();
            while (jt < 128) {
                unsigned char* cur = lds + buf * AT_STAGE;
                const int jn = next_tile(jt + 1);
                if (jn < 128) stage(ksg, vsg, SEQ * 2u, jn, lds + (buf ^ 1) * AT_STAGE);
                const unsigned wd = selw[tl * 4 + (jt >> 5)];
                const bool mysel = (wd >> (jt & 31)) & 1u;
                if (__any(mysel)) {
                    const int k0 = jt * 64;
                    const bool nearb = (64 * bi + 32 * th) - (k0 + 63) < 790;
                    const int dbase = tq - k0 - 8 * h;
                    const float* lp = mylut + (LUT_OFF - dbase);
#pragma unroll
                    for (int mt = 0; mt < 2; ++mt) {
                        f32x16 st;
                        attn_qk32<128>(cur, qf, st, mt, r, h, mysel ? nmb : -INFINITY);
                        if (nearb) {
#pragma unroll
                            for (int i = 0; i < 16; ++i) st[i] += lp[kidx(mt, i)];
                        }
                        attn_softmax32_b(st, l);
                        bf16x8 pf[2];
                        attn_pack32(st, pf);
                        attn_pv32(cur + 16384, pf, o, mt, r, h);
                    }
                }
                __syncthreads();
                buf ^= 1; jt = jn;
            }
        }
        {
            const float lt = sum_x32(l);
            const float sc = (lt > 0.f ? frcp(lt) : 0.f) * gp[1];
#pragma unroll
            for (int dt = 0; dt < 4; ++dt)
#pragma unroll
                for (int g4 = 0; g4 < 4; ++g4) {
                    const int d0 = 32 * dt + 8 * g4 + 4 * h;
                    const u32x2 pv = *(const u32x2*)(orow + d0);
                    u32x2 ov;
                    ov.x = pk2(bflo(pv.x) + o[dt][4 * g4 + 0] * sc, bfhi(pv.x) + o[dt][4 * g4 + 1] * sc);
                    ov.y = pk2(bflo(pv.y) + o[dt][4 * g4 + 2] * sc, bfhi(pv.y) + o[dt][4 * g4 + 3] * sc);
                    *(u32x2*)(orow + d0) = ov;
                }
        }
        const unsigned char* kwg = (const unsigned char*)(KW + (long)(b * 2 + g) * SEQ * 128);
        const unsigned char* vwg = (const unsigned char*)(VWT + (long)(b * 2 + g) * 128 * SEQ);
        reset(); load_q(qrow);
        {
            const float nmb = -(qn_main * kmx[2] + bmxs[hg]);
            const int j0 = bi >= 8 ? bi - 8 : 0, nt = (VAR == 2 || VAR == 4 || VAR == 5) ? 1 : bi - j0 + 1;
            stage(kwg, vwg, SEQ * 2u, j0, lds);
            __syncthreads();
            for (int kt = 0; kt < nt; ++kt) {
                unsigned char* cur = lds + (kt & 1) * AT_STAGE;
                if (kt + 1 < nt) stage(kwg, vwg, SEQ * 2u, j0 + kt + 1, lds + ((kt + 1) & 1) * AT_STAGE);
                const int k0 = (j0 + kt) * 64;
                const int dbase = tq - k0 - 8 * h;
                const float* lp = mylut + (LUT_OFF - dbase);
#pragma unroll
                for (int mt = 0; mt < 2; ++mt) {
                    f32x16 st;
                    attn_qk32<128>(cur, qf, st, mt, r, h, nmb);
                    if (kt == 0 && bi >= 8) {
#pragma unroll
                        for (int i = 0; i < 16; ++i) st[i] = kidx(mt, i) <= dbase - 512 ? -INFINITY : st[i] + lp[kidx(mt, i)];
                    } else {
#pragma unroll
                        for (int i = 0; i < 16; ++i) st[i] += lp[kidx(mt, i)];
                    }
                    attn_softmax32_b(st, l);
                    bf16x8 pf[2];
                    attn_pack32(st, pf);
                    attn_pv32(cur + 16384, pf, o, mt, r, h);
                }
                __syncthreads();
            }
        }
        {
            const float lt = sum_x32(l);
            const float sc = (lt > 0.f ? frcp(lt) : 0.f) * gp[2];
#pragma unroll
            for (int dt = 0; dt < 4; ++dt)
#pragma unroll
                for (int g4 = 0; g4 < 4; ++g4) {
                    const int d0 = 32 * dt + 8 * g4 + 4 * h;
                    const u32x2 pv = *(const u32x2*)(orow + d0);
                    u32x2 ov;
                    ov.x = pk2(bflo(pv.x) + o[dt][4 * g4 + 0] * sc, bfhi(pv.x) + o[dt][4 * g4 + 1] * sc);
                    ov.y = pk2(bflo(pv.y) + o[dt][4 * g4 + 2] * sc, bfhi(pv.y) + o[dt][4 * g4 + 3] * sc);
                    *(u32x2*)(orow + d0) = ov;
                }
        }
        __syncthreads();
    }
}

DI void fp8x16_fma(const u32x4& q, const f32x4& h0, const f32x4& h1, const f32x4& h2, const f32x4& h3, f32x2& a0, f32x2& a1) {
    a0 += __builtin_amdgcn_cvt_pk_f32_fp8((int)q.x, false) * (f32x2){h0.x, h0.y};
    a1 += __builtin_amdgcn_cvt_pk_f32_fp8((int)q.x, true)  * (f32x2){h0.z, h0.w};
    a0 += __builtin_amdgcn_cvt_pk_f32_fp8((int)q.y, false) * (f32x2){h1.x, h1.y};
    a1 += __builtin_amdgcn_cvt_pk_f32_fp8((int)q.y, true)  * (f32x2){h1.z, h1.w};
    a0 += __builtin_amdgcn_cvt_pk_f32_fp8((int)q.z, false) * (f32x2){h2.x, h2.y};
    a1 += __builtin_amdgcn_cvt_pk_f32_fp8((int)q.z, true)  * (f32x2){h2.z, h2.w};
    a0 += __builtin_amdgcn_cvt_pk_f32_fp8((int)q.w, false) * (f32x2){h3.x, h3.y};
    a1 += __builtin_amdgcn_cvt_pk_f32_fp8((int)q.w, true)  * (f32x2){h3.z, h3.w};
}
#ifndef UMASK
#define UMASK 0xffffffffu
#endif
template <bool DRY>
DI void phase_peer_u(const Params& p, int layer, unsigned char* lds, int tid) {
    unsigned char* ws = p.ws;
    const unsigned char* H8 = ws + OFF_H8;
    const float* HS = (const float*)(ws + OFF_HS);
    const int* ridx = (const int*)(ws + OFF_RIDX);
    float* rgate = (float*)(ws + OFF_RGATE);
    const unsigned char* U = ws + OFF_PU + (long)layer * 16384 * 1024;
    const __amdgpu_buffer_rsrc_t urs = __builtin_amdgcn_make_buffer_rsrc((void*)U, (short)0, 16384 * 1024, 0x00020000);
    const float* usi = (const float*)(ws + OFF_USI) + layer * 16384;
    const float* vsi = (const float*)(ws + OFF_VSI) + layer * 16384;
    const int lane = tid & 63, w = __builtin_amdgcn_readfirstlane(tid >> 6), sub = lane & 7, grp = lane >> 3;
    const int xg = blockIdx.x & 7, lb = blockIdx.x >> 3, nwv = (gridDim.x >> 3) * NWAVES, wv = lb * NWAVES + w;
    unsigned* clb = (unsigned*)(lds + w * 12288);
    unsigned char* hbb = lds + w * 12288 + 4096;
    const unsigned long long lt = (1ull << lane) - 1ull;
    if (lb >= (int)(gridDim.x >> 3)) return;
    int i0, i1; unsigned g0, g1; u32x4 h0; float hs0;
    auto ld_tok = [&](int tk) {
        tk = tk < NTOK ? tk : wv;
        i0 = ridx[(long)tk * 128 + lane]; i1 = ridx[(long)tk * 128 + 64 + lane];
        g0 = __float_as_uint(rgate[(long)tk * 128 + lane]); g1 = __float_as_uint(rgate[(long)tk * 128 + 64 + lane]);
        h0 = *(const u32x4*)(H8 + (long)tk * DM + lane * 16); hs0 = HS[tk];
    };
    bool sb0, sb1; int sk0, sk1; float su0, sv0, su1, sv1;
    auto stage_tok = [&](int bi) -> int {
        unsigned* cl = clb + bi * 512; unsigned char* hb = hbb + bi * 4096;
        const bool b0 = (i0 >> 11) == xg, b1 = (i1 >> 11) == xg;
        const unsigned long long m0 = __ballot(b0), m1 = __ballot(b1);
        const int n0 = __popcll(m0), n = n0 + __popcll(m1);
        sb0 = b0; sb1 = b1; sk0 = __popcll(m0 & lt); sk1 = n0 + __popcll(m1 & lt);
        if (b0) { *(u32x4*)(cl + 4 * sk0) = (u32x4){(unsigned)lane, (unsigned)i0, g0, 0u}; su0 = usi[i0]; sv0 = vsi[i0]; }
        if (b1) { *(u32x4*)(cl + 4 * sk1) = (u32x4){(unsigned)(64 + lane), (unsigned)i1, g1, 0u}; su1 = usi[i1]; sv1 = vsi[i1]; }
        if (n == 0 && lane == 0) *(u32x4*)cl = (u32x4){0u, 0u, 0u, 0u};
        *(u32x4*)(hb + lane * 16) = h0;
        if (lane == 0) *(float*)(hb + 1024) = hs0;
        return n;
    };
    auto flush_scales = [&](int bi) {
        float* cs = (float*)(hbb + bi * 4096 + 1536);
        if (sb0) *(f32x2*)(cs + 2 * sk0) = (f32x2){su0, sv0};
        if (sb1) *(f32x2*)(cs + 2 * sk1) = (f32x2){su1, sv1};
    };
    ld_tok(wv);
    int nC = stage_tok(0);
    flush_scales(0);
    ld_tok(wv + nwv);
    int slotC, idC; bool validC; float g_in;
    { validC = grp < nC; const int kk = validC ? grp : 0; const u32x4 e = *(const u32x4*)(clb + 4 * kk); slotC = e.x; idC = e.y; g_in = __uint_as_float(e.z); }
    u32x4 uv[8];
    {
        const unsigned uoff = validC ? (unsigned)idC * 1024u + (unsigned)sub * 16u : 0x40000000u;
#pragma unroll
        for (int t = 0; t < 8; ++t) { uv[t] = __builtin_bit_cast(u32x4, __builtin_amdgcn_raw_buffer_load_b128(urs, (int)(uoff + t * 128), 0, 0)); __builtin_amdgcn_sched_barrier(0); }
    }
    int it = 0;
    for (int tok = wv; tok < NTOK; tok += nwv, ++it) {
        const int cb = it & 1;
        const unsigned* clC = clb + cb * 512; const unsigned* clN = clb + (cb ^ 1) * 512;
        const unsigned char* hbC = hbb + cb * 4096;
        const bool more = tok + nwv < NTOK;
        const int nN = stage_tok(cb ^ 1); ld_tok(tok + 2 * nwv);
        const float shC = *(const float*)(hbC + 1024);
        const int nr = nC > 8 ? (nC + 7) >> 3 : 1;
        u32x4 hq[8];
#pragma unroll
        for (int t = 0; t < 8; ++t) hq[t] = *(const u32x4*)(hbC + (sub + 8 * t) * 16);
        auto do_round = [&](int rd) {
            const f32x2 s2 = *(const f32x2*)(hbC + 1536 + 8 * (validC ? 8 * rd + grp : 0));
            int slotN, idN; bool validN; float g_inN;
            {
                u32x4 e;
                if (rd + 1 < nr) { const int k = 8 * (rd + 1) + grp; validN = k < nC; e = *(const u32x4*)(clC + 4 * (validN ? k : 0)); }
                else if (more) { validN = grp < nN; e = *(const u32x4*)(clN + 4 * (validN ? grp : 0)); }
                else { validN = false; e = *(const u32x4*)clC; }
                slotN = e.x; idN = e.y; g_inN = __uint_as_float(e.z);
            }
            const unsigned uoffN = validN ? ((unsigned)idN & (DRY ? UMASK : 0xffffffffu)) * 1024u + (unsigned)sub * 16u : 0x40000000u;
            __builtin_amdgcn_sched_barrier(0);
            int a0 = 0, a1 = 0, a2 = 0, a3 = 0;
#pragma unroll
            for (int t = 0; t < 8; ++t) {
                const u32x4 q = uv[t];
                a0 = __builtin_amdgcn_sdot4((int)q.x, (int)hq[t].x, a0, false); a1 = __builtin_amdgcn_sdot4((int)q.y, (int)hq[t].y, a1, false);
                a2 = __builtin_amdgcn_sdot4((int)q.z, (int)hq[t].z, a2, false); a3 = __builtin_amdgcn_sdot4((int)q.w, (int)hq[t].w, a3, false);
                uv[t] = __builtin_bit_cast(u32x4, __builtin_amdgcn_raw_buffer_load_b128(urs, (int)(uoffN + t * 128), 0, 0));
                __builtin_amdgcn_sched_barrier(0);
            }
            int di = (a0 + a1) + (a2 + a3);
            di += __builtin_amdgcn_update_dpp(0, di, 0xB1, 0xF, 0xF, true);
            di += __builtin_amdgcn_update_dpp(0, di, 0x4E, 0xF, 0xF, true);
            di += __builtin_amdgcn_update_dpp(0, di, 0x141, 0xF, 0xF, true);
            if (validC && sub == 0) {
                float* gw = DRY ? (float*)(ws + OFF_R) + (long)tok * 128 + slotC : rgate + (long)tok * 128 + slotC;
                *gw = g_in * gelu_tanh((float)di * s2.x * shC) * s2.y;
            }
            slotC = slotN; idC = idN; validC = validN; g_in = g_inN;
        };
        do_round(0);
        for (int rd = 1; rd < nr; ++rd) do_round(rd);
        flush_scales(cb ^ 1);
        nC = nN;
    }
}

#ifndef VMASK
#define VMASK 0xffffffffu
#endif
#ifndef V_MFMA
#define V_MFMA 1
#endif
#define LAS __attribute__((address_space(3)))
typedef int v2i_t __attribute__((ext_vector_type(2)));
template <bool DRY>
DI void phase_peer_v(const Params& p, int layer, unsigned char* lds, int tid) {
    unsigned char* ws = p.ws;
    const int* ridx = (const int*)(ws + OFF_RIDX);
    const float* wact = (const float*)(ws + OFF_RGATE);
    const float* ada = (const float*)(ws + OFF_ADA);
    float* x = opq(p.out);
    const int lane = tid & 63, w = __builtin_amdgcn_readfirstlane(tid >> 6), sub = lane & 7, eg = lane >> 3;
    const int xg = blockIdx.x & 7, lb = blockIdx.x >> 3, nwv = (gridDim.x >> 3) * NWAVES, wv = lb * NWAVES + w;
    if (lb >= (int)(gridDim.x >> 3)) return;
    const unsigned char* Vc = ws + OFF_PV + ((long)(layer * 8 + xg) * 16384) * 128;
    unsigned char* gr = lds + w * 16384;
    unsigned* ring = (unsigned*)(lds + 128 * 1024 + w * 3072);
    int ia, ib; float wa, wb;
    auto ld_tokv = [&](int tk) {
        tk = tk < NTOK ? tk : wv;
        ia = ridx[(long)tk * 128 + lane]; ib = ridx[(long)tk * 128 + 64 + lane];
        wa = wact[(long)tk * 128 + lane]; wb = wact[(long)tk * 128 + 64 + lane];
    };
    auto st_ring = [&](int slot) {
        unsigned* rs = ring + slot * 256;
        rs[lane] = (unsigned)ia; rs[64 + lane] = (unsigned)ib; rs[128 + lane] = __float_as_uint(wa); rs[192 + lane] = __float_as_uint(wb);
    };
    auto rd_ids = [&](int slot, u32x4 (&a)[4]) {
        const u32x4* ip = (const u32x4*)(ring + slot * 256 + eg * 16);
#pragma unroll
        for (int q = 0; q < 4; ++q) a[q] = ip[q];
    };
    auto issue = [&](int j, const u32x4 (&a)[4]) {
#pragma unroll
        for (int i = 0; i < 4; ++i) {
            const int g = 4 * (i & 1) + (eg >> 1);
            const unsigned src = (a[j][i] & (DRY ? VMASK : 0xffffffffu)) * 128u + (unsigned)((sub ^ g) << 4);
            __builtin_amdgcn_global_load_lds((const unsigned*)(Vc + src), (unsigned*)(gr + j * 4096 + i * 1024), 16, 0, 0);
        }
    };
    const int col0 = 128 * xg + 16 * sub;
    ld_tokv(wv); st_ring(0);
    ld_tokv(wv + nwv); st_ring(1);
    ld_tokv(wv + 2 * nwv);
    {
        u32x4 a[4];
        rd_ids(0, a);
#pragma unroll
        for (int j = 0; j < 4; ++j) issue(j, a);
    }
#if V_MFMA
    unsigned char* wb8 = lds + 152 * 1024 + w * 256;
    const int m16 = lane & 15, q4 = lane >> 4;
    int boff[8];
    {
        const int rowL = 8 * q4 + (m16 >> 1), gL = (rowL >> 1) & 7;
#pragma unroll
        for (int nt = 0; nt < 8; ++nt) boff[nt] = rowL * 128 + ((nt ^ gL) << 4) + 8 * (m16 & 1);
    }
    unsigned baddr[8];
    const unsigned gr3 = (unsigned)(unsigned long)(LAS unsigned char*)gr;
#pragma unroll
    for (int nt = 0; nt < 8; ++nt) baddr[nt] = gr3 + (unsigned)boff[nt];
    const unsigned aaddr = (unsigned)(unsigned long)(LAS unsigned char*)wb8 + (unsigned)((m16 & 1) * 128 + 8 * q4);
    float xv[8], gfv[8]; int gb = -1;
    const int colx = 128 * xg + m16;
    if (lane < 16) {
#pragma unroll
        for (int nt = 0; nt < 8; ++nt) xv[nt] = x[(long)wv * DM + colx + 16 * nt];
    }
#else
    f32x4 gfv[4]; int gb = -1;
    f32x4 xv[4];
    if (eg == 0) {
#pragma unroll
        for (int c = 0; c < 4; ++c) xv[c] = *(const f32x4*)(x + (long)wv * DM + col0 + 4 * c);
    }
#endif
    int it = 0, s3 = 0;
    for (int tok = wv; tok < NTOK; tok += nwv, ++it) {
        const int sl0 = s3, sl1 = s3 == 2 ? 0 : s3 + 1, sl2 = s3 == 0 ? 2 : s3 - 1;
        st_ring(sl2);
        ld_tokv(tok + 3 * nwv);
        u32x4 na[4];
        rd_ids(sl1, na);
        {
            const int b = tok >> 13;
            if (b != gb) {
                gb = b;
#if V_MFMA
                if (lane < 16) {
#pragma unroll
                    for (int nt = 0; nt < 8; ++nt) gfv[nt] = ada[b * ADA_STRIDE + layer * 6144 + 5 * 1024 + colx + 16 * nt];
                }
#else
                const float* gf = ada + b * ADA_STRIDE + layer * 6144 + 5 * 1024 + col0;
#pragma unroll
                for (int c = 0; c < 4; ++c) gfv[c] = *(const f32x4*)(gf + 4 * c);
#endif
                asm volatile("s_waitcnt vmcnt(0)" ::: "memory");
            }
        }
#if V_MFMA
        float invS;
        {
            const float w0 = __uint_as_float(ring[sl0 * 256 + 128 + lane]), w1 = __uint_as_float(ring[sl0 * 256 + 192 + lane]);
            const float mx = wave_max(fmaxf(fabsf(w0), fabsf(w1)));
            int ex = (int)((__float_as_uint(mx) >> 23) & 255u) - 127;
            ex = ex < -100 ? -100 : ex;
            const float S = __uint_as_float((unsigned)(127 + 7 - ex) << 23);
            invS = __uint_as_float((unsigned)(127 - 7 + ex) << 23);
            const float a0 = w0 * S, a1 = w1 * S;
            const int hi = __builtin_amdgcn_cvt_pk_fp8_f32(a0, a1, 0, false);
            const f32x2 hf = __builtin_amdgcn_cvt_pk_f32_fp8(hi, false);
            const int lo = __builtin_amdgcn_cvt_pk_fp8_f32(a0 - hf.x, a1 - hf.y, 0, false);
            const int p0 = 8 * (lane & 15) + (lane >> 4);
            wb8[p0] = (unsigned char)(hi & 255); wb8[p0 + 4] = (unsigned char)((hi >> 8) & 255);
            wb8[128 + p0] = (unsigned char)(lo & 255); wb8[128 + p0 + 4] = (unsigned char)((lo >> 8) & 255);
        }
        f32x4 d[8];
#pragma unroll
        for (int nt = 0; nt < 8; ++nt) d[nt] = (f32x4){0.f, 0.f, 0.f, 0.f};
#pragma unroll
        for (int j = 0; j < 4; ++j) {
            asm volatile("s_waitcnt vmcnt(24)" ::: "memory");
            v2i_t aq, b0, b1, b2, b3, b4, b5, b6, b7;
            asm volatile("ds_read_b64 %0, %9 offset:%18\n\t"
                         "ds_read_b64_tr_b8 %1, %10 offset:%19\n\tds_read_b64_tr_b8 %2, %11 offset:%19\n\t"
                         "ds_read_b64_tr_b8 %3, %12 offset:%19\n\tds_read_b64_tr_b8 %4, %13 offset:%19\n\t"
                         "ds_read_b64_tr_b8 %5, %14 offset:%19\n\tds_read_b64_tr_b8 %6, %15 offset:%19\n\t"
                         "ds_read_b64_tr_b8 %7, %16 offset:%19\n\tds_read_b64_tr_b8 %8, %17 offset:%19\n\t"
                         "s_waitcnt lgkmcnt(0)"
                         : "=&v"(aq), "=&v"(b0), "=&v"(b1), "=&v"(b2), "=&v"(b3), "=&v"(b4), "=&v"(b5), "=&v"(b6), "=&v"(b7)
                         : "v"(aaddr), "v"(baddr[0]), "v"(baddr[1]), "v"(baddr[2]), "v"(baddr[3]), "v"(baddr[4]), "v"(baddr[5]), "v"(baddr[6]), "v"(baddr[7]),
                           "i"(32 * j), "i"(4096 * j)
                         : "memory");
            long a8 = ((long)(unsigned)aq.y << 32) | (unsigned)aq.x;
            a8 = m16 < 2 ? a8 : 0l;
            const v2i_t bq[8] = {b0, b1, b2, b3, b4, b5, b6, b7};
#pragma unroll
            for (int nt = 0; nt < 8; ++nt) {
                const long b8 = ((long)(unsigned)bq[nt].y << 32) | (unsigned)bq[nt].x;
                d[nt] = __builtin_amdgcn_mfma_f32_16x16x32_fp8_fp8(a8, b8, d[nt], 0, 0, 0);
            }
            issue(j, na);
        }
        if (lane < 16) {
            float* xr = DRY ? (float*)(ws + OFF_R + 16 * MB) + (long)tok * DM + colx : x + (long)tok * DM + colx;
#pragma unroll
            for (int nt = 0; nt < 8; ++nt) xr[16 * nt] = xv[nt] + gfv[nt] * ((d[nt].x + d[nt].y) * invS);
            const int tn = tok + nwv < NTOK ? tok + nwv : wv;
#pragma unroll
            for (int nt = 0; nt < 8; ++nt) xv[nt] = x[(long)tn * DM + colx + 16 * nt];
        }
#else
        f32x4 cw[4];
        {
            const f32x4* wp = (const f32x4*)(ring + sl0 * 256 + 128 + eg * 16);
#pragma unroll
            for (int q = 0; q < 4; ++q) cw[q] = wp[q];
        }
        f32x2 ap[8];
#pragma unroll
        for (int i = 0; i < 8; ++i) ap[i] = (f32x2){0.f, 0.f};
#pragma unroll
        for (int j = 0; j < 4; ++j) {
            asm volatile("s_waitcnt vmcnt(20)" ::: "memory");
#pragma unroll
            for (int i = 0; i < 4; ++i) {
                const int rs = 8 * i + eg, g = 4 * (i & 1) + (eg >> 1);
                const u32x4 v = *(const u32x4*)(gr + j * 4096 + rs * 128 + ((sub ^ g) << 4));
                const float ws1 = cw[j][i]; const f32x2 ww = {ws1, ws1};
                ap[0] += __builtin_amdgcn_cvt_pk_f32_fp8((int)v.x, false) * ww; ap[1] += __builtin_amdgcn_cvt_pk_f32_fp8((int)v.x, true) * ww;
                ap[2] += __builtin_amdgcn_cvt_pk_f32_fp8((int)v.y, false) * ww; ap[3] += __builtin_amdgcn_cvt_pk_f32_fp8((int)v.y, true) * ww;
                ap[4] += __builtin_amdgcn_cvt_pk_f32_fp8((int)v.z, false) * ww; ap[5] += __builtin_amdgcn_cvt_pk_f32_fp8((int)v.z, true) * ww;
                ap[6] += __builtin_amdgcn_cvt_pk_f32_fp8((int)v.w, false) * ww; ap[7] += __builtin_amdgcn_cvt_pk_f32_fp8((int)v.w, true) * ww;
            }
            asm volatile("s_waitcnt lgkmcnt(0)" ::: "memory");
            issue(j, na);
        }
        float acc[16];
#pragma unroll
        for (int i = 0; i < 8; ++i) { acc[2 * i] = ap[i].x; acc[2 * i + 1] = ap[i].y; }
#pragma unroll
        for (int i = 0; i < 16; ++i) { acc[i] += lr8(acc[i]); acc[i] = sum_x16(acc[i]); acc[i] = sum_x32(acc[i]); }
        if (eg == 0) {
            float* xr = DRY ? (float*)(ws + OFF_R + 16 * MB) + (long)tok * DM + col0 : x + (long)tok * DM + col0;
#pragma unroll
            for (int c = 0; c < 4; ++c) {
                const f32x4 gv = gfv[c];
                f32x4 o;
                o.x = xv[c].x + gv.x * acc[4 * c + 0]; o.y = xv[c].y + gv.y * acc[4 * c + 1];
                o.z = xv[c].z + gv.z * acc[4 * c + 2]; o.w = xv[c].w + gv.w * acc[4 * c + 3];
                *(f32x4*)(xr + 4 * c) = o;
            }
            const int tn = tok + nwv < NTOK ? tok + nwv : wv;
#pragma unroll
            for (int c = 0; c < 4; ++c) xv[c] = *(const f32x4*)(x + (long)tn * DM + col0 + 4 * c);
        }
#endif
        s3 = sl1;
    }
    asm volatile("s_waitcnt vmcnt(0)" ::: "memory");
}

DI void norm_row_q8(const f32x4 (&v)[4], float rstd, const float* gain, const float* shift, const float* scale, unsigned char* orow, float* os, int lane) {
    f32x4 y[4]; float am = 0.f;
#pragma unroll
    for (int j = 0; j < 4; ++j) {
        const int c = 4 * lane + 256 * j;
        const f32x4 g = *(const f32x4*)(gain + c), sh = *(const f32x4*)(shift + c), sc = *(const f32x4*)(scale + c);
        y[j].x = v[j].x * rstd * g.x * (1.f + sc.x) + sh.x; y[j].y = v[j].y * rstd * g.y * (1.f + sc.y) + sh.y;
        y[j].z = v[j].z * rstd * g.z * (1.f + sc.z) + sh.z; y[j].w = v[j].w * rstd * g.w * (1.f + sc.w) + sh.w;
        am = fmaxf(am, fmaxf(fmaxf(fabsf(y[j].x), fabsf(y[j].y)), fmaxf(fabsf(y[j].z), fabsf(y[j].w))));
    }
    am = wave_max(am);
    const float qs = am > 0.f ? 127.f / am : 1.f;
#pragma unroll
    for (int j = 0; j < 4; ++j) *(int*)(orow + 4 * lane + 256 * j) = pack_i8x4(y[j].x * qs, y[j].y * qs, y[j].z * qs, y[j].w * qs);
    if (lane == 0) *os = am > 0.f ? am * (1.f / 127.f) : 1.f;
}
DI void phase_norm2(const float* __restrict__ x, unsigned char* __restrict__ out1, float* __restrict__ os1, const float* gain1, int sh1, int sc1,
                    unsigned char* __restrict__ out2, float* __restrict__ os2, const float* gain2, int sh2, int sc2, const float* ada, int tid) {
    const int lane = tid & 63, gw = blockIdx.x * NWAVES + (tid >> 6), nw = gridDim.x * NWAVES;
    for (int tok = gw; tok < NTOK; tok += nw) {
        const int b = tok >> 13;
        f32x4 v[4]; float ss = 0.f;
#pragma unroll
        for (int j = 0; j < 4; ++j) { v[j] = *(const f32x4*)(x + (long)tok * DM + 4 * lane + 256 * j); ss += v[j].x * v[j].x + v[j].y * v[j].y + v[j].z * v[j].z + v[j].w * v[j].w; }
        const float rstd = rsqrtf(wave_sum(ss) * (1.f / DM) + EPS);
        norm_row_q8(v, rstd, gain1, ada + b * ADA_STRIDE + sh1, ada + b * ADA_STRIDE + sc1, out1 + (long)tok * DM, os1 + tok, lane);
        norm_row_q8(v, rstd, gain2, ada + b * ADA_STRIDE + sh2, ada + b * ADA_STRIDE + sc2, out2 + (long)tok * DM, os2 + tok, lane);
    }
}

template <int MT, class Epi>
DI void gemm_phase(const bf16_t* A, long lda, int M, const bf16_t* Bt, long ldb, int N, int K, const Epi& epi, unsigned char* lds, int tid) {
    const int ntm = (M + 128 * MT - 1) / (128 * MT), ntn = (N + 255) / 256, nt = ntm * ntn;
    if ((gridDim.x & 7) == 0 && (ntm & 31) == 0) {
        const int xcd = blockIdx.x & 7, lb = blockIdx.x >> 3, nlb = gridDim.x >> 3, tmx = ntm >> 3, per = tmx * ntn;
        for (int q = lb; q < per; q += nlb) {
            const int g4 = q / (4 * ntn), rem = q - g4 * 4 * ntn, tn = rem >> 2, tm = xcd * tmx + g4 * 4 + (rem & 3);
            if (tm < (xcd + 1) * tmx) gemm_tile<MT>(A, lda, M, Bt, ldb, N, K, tm * 128 * MT, tn * 256, epi, lds, tid);
        }
        return;
    }
    for (int t = blockIdx.x; t < nt; t += gridDim.x) {
        const int tn = t / ntm, tm = t % ntm;
        gemm_tile<MT>(A, lda, M, Bt, ldb, N, K, tm * 128 * MT, tn * 256, epi, lds, tid);
    }
}

template <int MT, class Epi>
DI void gemm_tile_i8(const unsigned char* __restrict__ A, int M, const float* __restrict__ as, const unsigned char* __restrict__ Bt, int N, const float* __restrict__ bs,
                     int K, int m0, int n0, const Epi& epi, unsigned char* lds, int tid) {
    constexpr int XS = MT * 128 * 128, WS = 256 * 128, STAGE = XS + WS;
    const int lane = tid & 63, w = tid >> 6, tg = w & 3, fh = w >> 2, r = lane & 31, h = lane >> 5;
    const int wbase = tid & ~63;
    unsigned xo[2 * MT], wo[4];
#pragma unroll
    for (int i = 0; i < 2 * MT; ++i) { int row, c; sw2_src(tid + 512 * i, row, c); int m = m0 + row; m = m < M ? m : M - 1; xo[i] = (unsigned)m * (unsigned)K + c * 16; }
#pragma unroll
    for (int i = 0; i < 4; ++i) { int row, c; sw2_src(tid + 512 * i, row, c); int n = n0 + row; n = n < N ? n : N - 1; wo[i] = (unsigned)n * (unsigned)K + c * 16; }
    auto stage = [&](int kt, unsigned char* st) {
#pragma unroll
        for (int i = 0; i < 2 * MT; ++i)
            __builtin_amdgcn_global_load_lds((const unsigned*)(A + kt * 128 + xo[i]), (unsigned*)(st + (wbase + 512 * i) * 16), 16, 0, 0);
#pragma unroll
        for (int i = 0; i < 4; ++i)
            __builtin_amdgcn_global_load_lds((const unsigned*)(Bt + kt * 128 + wo[i]), (unsigned*)(st + XS + (wbase + 512 * i) * 16), 16, 0, 0);
    };
    i32x16 acc[MT][4];
#pragma unroll
    for (int s2 = 0; s2 < MT; ++s2)
#pragma unroll
        for (int i = 0; i < 4; ++i)
#pragma unroll
            for (int j = 0; j < 16; ++j) acc[s2][i][j] = 0;
    const int nk = K >> 7;
    stage(0, lds);
    __syncthreads();
#pragma unroll 2
    for (int kt = 0; kt < nk; ++kt) {
        unsigned char* cur = lds + (kt & 1) * STAGE;
        if (kt + 1 < nk) stage(kt + 1, lds + ((kt + 1) & 1) * STAGE);
        i32x4 xfa[MT], wfa[4], xfb[MT], wfb[4];
        auto ldf = [&](i32x4 (&xf)[MT], i32x4 (&wf)[4], int ks) {
#pragma unroll
            for (int s2 = 0; s2 < MT; ++s2) xf[s2] = *(const i32x4*)(cur + sw2(32 * MT * tg + 32 * s2 + r, 2 * ks + h));
#pragma unroll
            for (int mt = 0; mt < 4; ++mt) wf[mt] = *(const i32x4*)(cur + XS + sw2(128 * fh + 32 * mt + r, 2 * ks + h));
        };
        auto mm = [&](const i32x4 (&xf)[MT], const i32x4 (&wf)[4]) {
#pragma unroll
            for (int mt = 0; mt < 4; ++mt)
#pragma unroll
                for (int s2 = 0; s2 < MT; ++s2) acc[s2][mt] = MFMA32I8(wf[mt], xf[s2], acc[s2][mt]);
        };
        ldf(xfa, wfa, 0);
        ldf(xfb, wfb, 1); __builtin_amdgcn_sched_barrier(0); mm(xfa, wfa); __builtin_amdgcn_sched_barrier(0);
        ldf(xfa, wfa, 2); __builtin_amdgcn_sched_barrier(0); mm(xfb, wfb); __builtin_amdgcn_sched_barrier(0);
        ldf(xfb, wfb, 3); __builtin_amdgcn_sched_barrier(0); mm(xfa, wfa); __builtin_amdgcn_sched_barrier(0);
        mm(xfb, wfb);
        __syncthreads();
    }
    auto fin = [&](const i32x16 (&ai)[4], int s2, int ho, int ro, int to) {
        const int tok = m0 + 32 * MT * tg + 32 * s2 + ro, fbase = n0 + 128 * fh;
        const float sa = as[tok < M ? tok : M - 1];
        f32x16 af[4];
#pragma unroll
        for (int mt = 0; mt < 4; ++mt) {
#pragma unroll
            for (int g4 = 0; g4 < 4; ++g4) {
                int f0 = fbase + 32 * mt + 8 * g4 + 4 * ho; f0 = f0 + 3 < N ? f0 : (N - 4 > 0 ? N - 4 : 0);
                const f32x4 sb = *(const f32x4*)(bs + f0);
                af[mt][4 * g4 + 0] = (float)ai[mt][4 * g4 + 0] * (sa * sb.x); af[mt][4 * g4 + 1] = (float)ai[mt][4 * g4 + 1] * (sa * sb.y);
                af[mt][4 * g4 + 2] = (float)ai[mt][4 * g4 + 2] * (sa * sb.z); af[mt][4 * g4 + 3] = (float)ai[mt][4 * g4 + 3] * (sa * sb.w);
            }
            __builtin_amdgcn_sched_barrier(0);
        }
        epi(af, tok, fbase, ho, lds, to);
        __builtin_amdgcn_sched_barrier(0);
    };
    if constexpr (MT == 2 && epi_stash<Epi>::present) {
        int* sp = (int*)lds + w * 4096 + lane;
#pragma unroll
        for (int mt = 0; mt < 4; ++mt)
#pragma unroll
            for (int j = 0; j < 16; ++j) sp[(mt * 16 + j) * 64] = acc[1][mt][j];
        int ho = h, ro = r, to = tid;
        asm volatile("" : "+v"(ho), "+v"(ro), "+v"(to));
        fin(acc[0], 0, ho, ro, to);
        i32x16 a2[4];
        const int* sp2 = sp; asm volatile("" : "+v"(sp2));
#pragma unroll
        for (int mt = 0; mt < 4; ++mt)
#pragma unroll
            for (int j = 0; j < 16; ++j) a2[mt][j] = sp2[(mt * 16 + j) * 64];
        asm volatile("" : "+v"(ho), "+v"(ro), "+v"(to));
        fin(a2, 1, ho, ro, to);
        __syncthreads();
    } else {
        int ho = h, ro = r, to = tid;
#pragma unroll
        for (int s2 = 0; s2 < MT; ++s2) { asm volatile("" : "+v"(ho), "+v"(ro), "+v"(to)); fin(acc[s2], s2, ho, ro, to); }
    }
}
template <int MT, class Epi>
DI void gemm_phase_i8(const unsigned char* A, int M, const float* as, const unsigned char* Bt, int N, const float* bs, int K, const Epi& epi, unsigned char* lds, int tid,
                      int skip = 0) {
    const int ntm = (M + 128 * MT - 1) / (128 * MT), ntn = (N + 255) / 256, nt = ntm * ntn;
    const int bid = (int)blockIdx.x - skip, nbl = (int)gridDim.x - skip;
    if (bid < 0) return;
    if ((gridDim.x & 7) == 0 && (ntm & 31) == 0) {
        const int xcd = bid & 7, lb = bid >> 3, nlb = nbl >> 3, tmx = ntm >> 3, per = tmx * ntn;
        for (int q = lb; q < per; q += nlb) {
            const int g4 = q / (4 * ntn), rem = q - g4 * 4 * ntn, tn = rem >> 2, tm = xcd * tmx + g4 * 4 + (rem & 3);
            gemm_tile_i8<MT>(A, M, as, Bt, N, bs, K, tm * 128 * MT, tn * 256, epi, lds, tid);
        }
        return;
    }
    for (int t = bid; t < nt; t += nbl) {
        const int tn = t / ntm, tm = t % ntm;
        gemm_tile_i8<MT>(A, M, as, Bt, N, bs, K, tm * 128 * MT, tn * 256, epi, lds, tid);
    }
}

DI void wquant_rows(const bf16_t* __restrict__ src, unsigned char* __restrict__ dst, float* __restrict__ sc, int nrows, int gw, int nw, int lane) {
    for (int n = gw; n < nrows; n += nw) {
        const u32x4 a = *(const u32x4*)(src + (long)n * 1024 + 16 * lane), b = *(const u32x4*)(src + (long)n * 1024 + 16 * lane + 8);
        float v[16];
        v[0] = bflo(a.x); v[1] = bfhi(a.x); v[2] = bflo(a.y); v[3] = bfhi(a.y); v[4] = bflo(a.z); v[5] = bfhi(a.z); v[6] = bflo(a.w); v[7] = bfhi(a.w);
        v[8] = bflo(b.x); v[9] = bfhi(b.x); v[10] = bflo(b.y); v[11] = bfhi(b.y); v[12] = bflo(b.z); v[13] = bfhi(b.z); v[14] = bflo(b.w); v[15] = bfhi(b.w);
        float am = 0.f;
#pragma unroll
        for (int q = 0; q < 16; ++q) am = fmaxf(am, fabsf(v[q]));
        am = wave_max(am);
        const float qs = am > 0.f ? 127.f / am : 1.f;
        u32x4 o;
        o.x = (unsigned)pack_i8x4(v[0] * qs, v[1] * qs, v[2] * qs, v[3] * qs); o.y = (unsigned)pack_i8x4(v[4] * qs, v[5] * qs, v[6] * qs, v[7] * qs);
        o.z = (unsigned)pack_i8x4(v[8] * qs, v[9] * qs, v[10] * qs, v[11] * qs); o.w = (unsigned)pack_i8x4(v[12] * qs, v[13] * qs, v[14] * qs, v[15] * qs);
        *(u32x4*)(dst + (long)n * 1024 + 16 * lane) = o;
        if (lane == 0) sc[n] = am > 0.f ? am * (1.f / 127.f) : 1.f;
    }
}
DI void phase_wquant(unsigned char* ws, int tid) {
    const int lane = tid & 63, gw = blockIdx.x * NWAVES + (tid >> 6), nw = gridDim.x * NWAVES;
    float* sc = (float*)(ws + OFF_W8S);
    wquant_rows((const bf16_t*)(ws + OFF_WT_PEER), ws + OFF_W8_PEER, sc + W8S_PEER, 4096, gw, nw, lane);
    wquant_rows((const bf16_t*)(ws + OFF_WT_DIN), ws + OFF_W8_DIN, sc + W8S_DIN, 3072, gw, nw, lane);
    wquant_rows((const bf16_t*)(ws + OFF_WT_KV), ws + OFF_W8_KV, sc + W8S_KV, 1536, gw, nw, lane);
    wquant_rows((const bf16_t*)(ws + OFF_WT_NIN), ws + OFF_W8_NIN, sc + W8S_NIN, 1088, gw, nw, lane);
}

#define XB_TMO      128
#define XB_XCNT(j)  (256  + 64 * (j))
#define XB_XSUB(j)  (1280 + 64 * (j))
#define XB_XGEN(j)  (2304 + 64 * (j))
#define XB_TOP      3328
#define XB_TOPGEN   3392
#define XCD_BAR_WORDS 3456
#define XB_SPIN_CAP (1u << 22)
DI unsigned xb_ld(unsigned* p) { return __hip_atomic_load(p, __ATOMIC_RELAXED, __HIP_MEMORY_SCOPE_AGENT); }
DI unsigned xb_add(unsigned* p, unsigned v) { return __hip_atomic_fetch_add(p, v, __ATOMIC_RELAXED, __HIP_MEMORY_SCOPE_AGENT); }
DI unsigned xb_xcc_id() { return (unsigned)__builtin_amdgcn_s_getreg((3 << 11) | 20) & 0xFu; }
#define XB_SPIN(cond, bar) do { unsigned _sp = 0; while (cond) { __builtin_amdgcn_s_sleep(1); \
    if ((++_sp & 255u) == 0u) { if (xb_ld(&(bar)[XB_TMO])) break; if (_sp > XB_SPIN_CAP) { atomicAdd(&(bar)[XB_TMO], 1u); break; } } } } while (0)
DI void xcd_barrier_complete(unsigned* bar, unsigned x, unsigned& nloc, unsigned& nx) {
    const unsigned G = gridDim.x;
    unsigned sum, cnt, mine, sp = 0u;
    for (;;) {
        sum = 0u; cnt = 0u; mine = 0u;
#pragma unroll
        for (unsigned j = 0; j < 16; ++j) { const unsigned c = xb_ld(&bar[XB_XCNT(j)]); sum += c; cnt += (c > 0u) ? 1u : 0u; mine = (j == x) ? c : mine; }
        if (sum == G) break;
        __builtin_amdgcn_s_sleep(1);
        if ((++sp & 255u) == 0u) { if (xb_ld(&bar[XB_TMO])) break; if (sp > XB_SPIN_CAP) { atomicAdd(&bar[XB_TMO], 1u); break; } }
    }
    nloc = mine > 0u ? mine : 1u; nx = cnt > 0u ? cnt : 1u;
}
DI void xcd_barrier(unsigned* bar, volatile LAS unsigned* st, int tid) {
    asm volatile("s_waitcnt vmcnt(0)" ::: "memory");
    __syncthreads();
    if (tid == 0) {
        const unsigned x = xb_xcc_id();
        __builtin_amdgcn_s_waitcnt(0);
        unsigned nloc = st[0], nx = st[1];
        if (nloc == 0u) { xcd_barrier_complete(bar, x, nloc, nx); st[0] = nloc; st[1] = nx; }
        const unsigned old = xb_add(&bar[XB_XSUB(x)], 1u);
        const unsigned gen = old / nloc;
        if (old + 1u == (gen + 1u) * nloc) {
            __builtin_amdgcn_fence(__ATOMIC_RELEASE, "agent");
            asm volatile("s_waitcnt vmcnt(0)" ::: "memory");
            const unsigned og = xb_add(&bar[XB_TOP], 1u);
            const unsigned tg = og / nx;
            if (og + 1u == (tg + 1u) * nx) xb_add(&bar[XB_TOPGEN], 1u);
            else XB_SPIN(xb_ld(&bar[XB_TOPGEN]) == tg, bar);
            __builtin_amdgcn_fence(__ATOMIC_ACQUIRE, "agent");
            xb_add(&bar[XB_XGEN(x)], 1u);
            asm volatile("s_waitcnt vmcnt(0)" ::: "memory");
        } else {
            XB_SPIN(xb_ld(&bar[XB_XGEN(x)]) == gen, bar);
            __builtin_amdgcn_fence(__ATOMIC_ACQUIRE, "agent");
            asm volatile("s_waitcnt vmcnt(0)" ::: "memory");
        }
    }
    __syncthreads();
}

#define ftid() ftid_(wave_u)
DI int ftid_(int wave_u) { int t = (wave_u << 6) + (int)__builtin_amdgcn_mbcnt_hi(~0u, __builtin_amdgcn_mbcnt_lo(~0u, 0u)); asm volatile("" : "+v"(t)); return t; }


#if defined(__HIP_DEVICE_COMPILE__)
typedef const __attribute__((address_space(4))) Params* KParamPtr;
DI Params load_params() { KParamPtr kp = (KParamPtr)__builtin_amdgcn_kernarg_segment_ptr(); asm volatile("" : "+s"(kp)); return *kp; }
#else
DI Params load_params() { return Params{}; }
#endif
#define p (load_params())
#define ws (load_params().ws)
#define ada ((const float*)(ws + OFF_ADA))
#define Hb ((bf16_t*)(ws + OFF_H))
#define bar ((unsigned*)(ws + OFF_BAR))
__global__ void __launch_bounds__(NTHREADS) yoco_fwd(Params p_arg) {
    extern __shared__ __attribute__((aligned(16))) unsigned char lds[];
    cg::grid_group grid = cg::this_grid();
    volatile LAS unsigned* bst = (volatile LAS unsigned*)(lds + LDS_BAR);
    const int wave_u = __builtin_amdgcn_readfirstlane((int)(threadIdx.x >> 6));
    { const int t0 = ftid(); if (t0 == 0) { bst[0] = 0u; bst[1] = 0u; }
      if (blockIdx.x == 0) for (int i = t0; i < XCD_BAR_WORDS; i += NTHREADS) bar[i] = 0u; }
    __syncthreads();
    RUN(0) REP(0) phase_prep(p, lds, ftid());
    grid.sync();
    if (ftid() == 0) (void)xb_add(&bar[XB_XCNT(xb_xcc_id())], 1u);
    RUN(1) REP(1) phase_norm_q8<false>(p.in[0], Hb, ws + OFF_H8, (float*)(ws + OFF_HS), p.in[5], ada, 0, 1024, ftid());
    RUN(1) phase_wquant(ws, ftid());
    xcd_barrier(bar, bst, ftid());
    RUN(2) REP(2) {
        EpiQKV0 e{(bf16_t*)(ws + OFF_Q0), (bf16_t*)(ws + OFF_K0), (bf16_t*)(ws + OFF_VT0), p.in[10], p.in[11], (float*)(ws + OFF_MB0), p.in[2]};
        gemm_phase_i8<2>(ws + OFF_H8, NTOK, (const float*)(ws + OFF_HS), ws + OFF_W8_DIN, 3072, (const float*)(ws + OFF_W8S) + W8S_DIN, DM, e, lds, ftid());
    }
    xcd_barrier(bar, bst, ftid());
    RUN(3) REP(3) phase_diff_attn(p, lds, ftid());
    __builtin_amdgcn_s_setprio(0);
    xcd_barrier(bar, bst, ftid());
    RUN(4) REP(4) {
        EpiResid e{p.in[0], opq(p.out), ada + 2 * 1024};
        gemm_phase<2>(Hb, DM, NTOK, (const bf16_t*)(ws + OFF_WT_DOUT), DM, 1024, DM, e, lds, ftid());
    }
    xcd_barrier(bar, bst, ftid());
    if (STOP_AFTER <= 1) return;
    RUN(1) phase_norm_q8<false>(opq(p.out), Hb, ws + OFF_H8, (float*)(ws + OFF_HS), p.in[6], ada, 3 * 1024, 4 * 1024, ftid());
    xcd_barrier(bar, bst, ftid());
    RUN(5) REP(5) {
        EpiPeer e{(int*)(ws + OFF_RIDX), (float*)(ws + OFF_RGATE), 128 * 1024};
        gemm_phase_i8<2>(ws + OFF_H8, NTOK, (const float*)(ws + OFF_HS), ws + OFF_W8_PEER, 2048, (const float*)(ws + OFF_W8S) + W8S_PEER, DM, e, lds, ftid());
    }
    xcd_barrier(bar, bst, ftid());
    if ((REPEAT_MASK >> 6) & 1) phase_peer_u<true>(p, 0, lds, ftid());
    RUN(6) phase_peer_u<false>(p, 0, lds, ftid());
    xcd_barrier(bar, bst, ftid());
    if ((REPEAT_MASK >> 10) & 1) phase_peer_v<true>(p, 0, lds, ftid());
    RUN(6) phase_peer_v<false>(p, 0, lds, ftid());
    xcd_barrier(bar, bst, ftid());
    RUN(1) phase_norm2(opq(p.out), ws + OFF_H8, (float*)(ws + OFF_HS), p.in[13], 12288, 12288 + 1024, ws + OFF_H, (float*)(ws + OFF_HS) + NTOK, p.in[5] + 1024, 6144, 6144 + 1024, ada, ftid());
    xcd_barrier(bar, bst, ftid());
    if (STOP_AFTER <= 2) return;
    RUN(7) REP(7) {
        EpiKV e{(bf16_t*)(ws + OFF_KC), (bf16_t*)(ws + OFF_KS), (bf16_t*)(ws + OFF_VST), (bf16_t*)(ws + OFF_KW), (bf16_t*)(ws + OFF_VWT), p.in[21]};
        gemm_phase_i8<2>(ws + OFF_H8, NTOK, (const float*)(ws + OFF_HS), ws + OFF_W8_KV, 1536, (const float*)(ws + OFF_W8S) + W8S_KV, DM, e, lds, ftid());
    }
    xcd_barrier(bar, bst, ftid());
    RUN(8) REP(8) {
        EpiNsaQ e{(bf16_t*)(ws + OFF_QN), (float*)(ws + OFF_GATES), p.in[25], p.in[23], (float*)(ws + OFF_MB1)};
        gemm_phase_i8<2>(ws + OFF_H, NTOK, (const float*)(ws + OFF_HS) + NTOK, ws + OFF_W8_NIN, 1048, (const float*)(ws + OFF_W8S) + W8S_NIN, DM, e, lds, ftid(),
                         gridDim.x >= 128 ? 64 : 0);
        for (int t = blockIdx.x; t < 64; t += gridDim.x) {
            const int pr = t >> 2, tm = t & 3, kv = pr >> 3, bg = pr & 7;
            const bf16_t* Ap = (const bf16_t*)(ws + OFF_KC) + (long)(kv * 8 + bg) * SEQ * 128;
            bf16_t* hid = (bf16_t*)(ws + OFF_HID) + (long)pr * 512 * 256;
            EpiCmp1 e1{hid, (const float*)(ws + OFF_POSB) + kv * 16 * 256, p.in[19] + kv * 256};
            gemm_tile<1>(Ap, 2048, 511, (const bf16_t*)(ws + OFF_WT_C1) + (long)kv * 256 * 4096, 4096, 256, 4096, tm * 128, 0, e1, lds, ftid());
            __syncthreads();
            bf16_t* dst = kv == 0 ? (bf16_t*)(ws + OFF_KCMP) + (long)bg * 512 * 128 : (bf16_t*)(ws + OFF_VCMPT) + (long)bg * 128 * 512;
            EpiCmp2 e2{dst, p.in[21], kv};
            gemm_tile<1>(hid, 256, 512, (const bf16_t*)(ws + OFF_WT_C2) + (long)kv * 128 * 256, 256, 128, 256, tm * 128, 0, e2, lds, ftid());
        }
    }
    xcd_barrier(bar, bst, ftid());
#ifdef NSA_PROBE
    phase_nsa_attn<NSA_PROBE>(p, lds, ftid());
#endif
    RUN(9) REP(9) phase_nsa_attn<0>(p, lds, ftid());
    xcd_barrier(bar, bst, ftid());
    RUN(4) {
        float* xo = opq(p.out);
        EpiResid e{xo, xo, ada + 6144 + 2 * 1024};
        gemm_phase<2>(Hb, DM, NTOK, (const bf16_t*)(ws + OFF_WT_NOUT), DM, 1024, DM, e, lds, ftid());
    }
    xcd_barrier(bar, bst, ftid());
    if (STOP_AFTER <= 3) return;
    RUN(1) phase_norm_q8<false>(opq(p.out), Hb, ws + OFF_H8, (float*)(ws + OFF_HS), p.in[6] + 1024, ada, 6144 + 3 * 1024, 6144 + 4 * 1024, ftid());
    xcd_barrier(bar, bst, ftid());
    RUN(5) REP(5) {
        EpiPeer e{(int*)(ws + OFF_RIDX), (float*)(ws + OFF_RGATE), 128 * 1024};
        gemm_phase_i8<2>(ws + OFF_H8, NTOK, (const float*)(ws + OFF_HS), ws + OFF_W8_PEER + (long)2048 * 1024, 2048, (const float*)(ws + OFF_W8S) + W8S_PEER + 2048, DM, e, lds, ftid());
    }
    xcd_barrier(bar, bst, ftid());
    if ((REPEAT_MASK >> 6) & 1) phase_peer_u<true>(p, 1, lds, ftid());
    RUN(6) phase_peer_u<false>(p, 1, lds, ftid());
    xcd_barrier(bar, bst, ftid());
    if ((REPEAT_MASK >> 10) & 1) phase_peer_v<true>(p, 1, lds, ftid());
    RUN(6) phase_peer_v<false>(p, 1, lds, ftid());
}
#undef p
#undef ws
#undef ada
#undef Hb
#undef bar

extern "C" void kernel_launch(void* const* d_in, const int* in_sizes, int n_in, void* d_out, int out_size, void* d_ws, size_t ws_size,
                              hipStream_t stream) {
    static int grid_blocks = 0;
    if (grid_blocks == 0) {
        if (n_in != 30 || out_size != NTOK * DM || ws_size < WS_END) {
            fprintf(stderr, "kernel_launch: unexpected shapes (n_in %d out %d ws %zu)\n", n_in, out_size, ws_size);
            grid_blocks = -1; return;
        }
        int dev = 0, cus = 0, per_cu = 0;
        hipGetDevice(&dev);
        hipDeviceGetAttribute(&cus, hipDeviceAttributeMultiprocessorCount, dev);
        hipFuncSetAttribute((const void*)yoco_fwd, hipFuncAttributeMaxDynamicSharedMemorySize, LDS_BYTES);
        hipOccupancyMaxActiveBlocksPerMultiprocessor(&per_cu, (const void*)yoco_fwd, NTHREADS, LDS_BYTES);
        if (per_cu < 1) { fprintf(stderr, "kernel_launch: occupancy query says %d blocks per CU\n", per_cu); grid_blocks = -1; return; }
        grid_blocks = cus;
    }
    if (grid_blocks < 0) return;
    Params p{};
    for (int i = 0; i < 30; ++i) p.in[i] = (const float*)d_in[i];
    p.out = (float*)d_out;
    p.ws = (unsigned char*)d_ws;
    void* args[] = {&p};
    hipError_t e = hipLaunchCooperativeKernel((const void*)yoco_fwd, dim3(grid_blocks), dim3(NTHREADS), args, LDS_BYTES, stream);
    if (e != hipSuccess) fprintf(stderr, "cooperative launch failed: %s (grid %d)\n", hipGetErrorString(e), grid_blocks);
}
```

```cpp
#include <hip/hip_runtime.h>
#include <hip/hip_cooperative_groups.h>
#include <cstdio>
#include <cstdint>
namespace cg = cooperative_groups;

#define DI __device__ __forceinline__
#ifndef STOP_AFTER
#define STOP_AFTER 99
#endif
#ifndef ONLY_PHASE
#define ONLY_PHASE -1
#endif
#define RUN(n) if (ONLY_PHASE < 0 || ONLY_PHASE == (n))
#ifndef REPEAT_MASK
#define REPEAT_MASK 0
#endif
#define REP(n) for (int rep_ = 0; rep_ < (((REPEAT_MASK) >> (n)) & 1) + 1; ++rep_)

typedef unsigned short bf16_t;
typedef short bf16x8 __attribute__((ext_vector_type(8)));
typedef float f32x16 __attribute__((ext_vector_type(16)));
typedef float f32x4 __attribute__((ext_vector_type(4)));
typedef float f32x2 __attribute__((ext_vector_type(2)));
typedef unsigned u32x4 __attribute__((ext_vector_type(4)));
typedef unsigned u32x2 __attribute__((ext_vector_type(2)));
typedef __bf16 bf16x2v __attribute__((ext_vector_type(2)));

#define MFMA32(a, b, c) __builtin_amdgcn_mfma_f32_32x32x16_bf16((a), (b), (c), 0, 0, 0)
typedef int i32x4 __attribute__((ext_vector_type(4)));
typedef int i32x16 __attribute__((ext_vector_type(16)));
#define MFMA32I8(a, b, c) __builtin_amdgcn_mfma_i32_32x32x32_i8((a), (b), (c), 0, 0, 0)

constexpr int NB = 4, SEQ = 8192, DM = 1024, NTOK = NB * SEQ;
constexpr int NTHREADS = 512, NWAVES = 8;
constexpr float EPS = 1e-6f;
constexpr float LOG2E = 1.4426950408889634f;
constexpr int ADA_STRIDE = 14336;

constexpr size_t MB = 1u << 20;
constexpr size_t OFF_ADA = 0;
constexpr size_t OFF_POSB = 256 * 1024;
constexpr size_t OFF_BAR = 320 * 1024;
constexpr size_t OFF_MB0 = 168 * MB;
constexpr size_t OFF_MB1 = 172 * MB;
constexpr size_t OFF_H8 = 104 * MB;
constexpr size_t OFF_HS = 174 * MB;
constexpr size_t OFF_XB = 448 * MB;
constexpr size_t OFF_W8 = 176 * MB;
constexpr size_t OFF_W8_DIN = OFF_W8, OFF_W8_KV = OFF_W8 + 3 * MB, OFF_W8_NIN = OFF_W8 + 5 * MB, OFF_W8_PEER = OFF_W8 + 7 * MB;
constexpr size_t OFF_W8S = 188 * MB;
constexpr int W8S_DIN = 0, W8S_KV = 3072, W8S_NIN = 4608, W8S_PEER = 5760, W8S_TOTAL = 9856;
constexpr size_t OFF_USI = 384 * 1024;
constexpr size_t OFF_VSI = 512 * 1024;
constexpr size_t OFF_WT_DIN = 1 * MB;
constexpr size_t OFF_WT_DOUT = 7 * MB;
constexpr size_t OFF_WT_KV = 9 * MB;
constexpr size_t OFF_WT_NIN = 12 * MB;
constexpr size_t OFF_WT_NOUT = 15 * MB;
constexpr size_t OFF_WT_PEER = 17 * MB;
constexpr size_t OFF_WT_C1 = 25 * MB;
constexpr size_t OFF_WT_C2 = 29 * MB;
constexpr size_t OFF_GATES = 30 * MB;
constexpr size_t OFF_KCMP = 34 * MB;
constexpr size_t OFF_VCMPT = 35 * MB;
constexpr size_t OFF_HID = 36 * MB;
constexpr size_t OFF_RIDX = 40 * MB;
constexpr size_t OFF_RGATE = 56 * MB;
constexpr size_t OFF_PU = 72 * MB;
constexpr size_t OFF_PV = 136 * MB;
constexpr size_t OFF_H = 200 * MB;
constexpr size_t OFF_R = 264 * MB;
constexpr size_t WS_END = 456 * MB;
constexpr size_t OFF_Q0 = OFF_R, OFF_K0 = OFF_R + 64 * MB, OFF_VT0 = OFF_R + 128 * MB;
constexpr size_t OFF_QN = OFF_R, OFF_H2 = OFF_R, OFF_KC = OFF_R + 64 * MB, OFF_KS = OFF_R + 96 * MB, OFF_VST = OFF_R + 112 * MB,
                 OFF_KW = OFF_R + 128 * MB, OFF_VWT = OFF_R + 144 * MB;

constexpr int LDS_BAR = 159 * 1024;
constexpr int LDS_BYTES = LDS_BAR + 256;

struct Params {
    const float* in[30];
    float* out;
    unsigned char* ws;
};

template <class T> DI T* opq(T* q) { asm volatile("" : "+s"(q)); return (T*)(__attribute__((address_space(1))) T*)q; }
DI unsigned pk2(float lo, float hi) { f32x2 v = {lo, hi}; return __builtin_bit_cast(unsigned, __builtin_convertvector(v, bf16x2v)); }
DI bf16_t f2bf(float x) { return (bf16_t)(pk2(x, 0.f) & 0xffffu); }
DI float bflo(unsigned u) { return __uint_as_float(u << 16); }
DI float bfhi(unsigned u) { return __uint_as_float(u & 0xffff0000u); }
template <bool XB> DI f32x4 ld4(const void* base, long e) {
    if constexpr (XB) { const u32x2 t = *(const u32x2*)((const bf16_t*)base + e); return (f32x4){bflo(t.x), bfhi(t.x), bflo(t.y), bfhi(t.y)}; }
    else return *(const f32x4*)((const float*)base + e);
}
template <bool XB> DI void st4(void* base, long e, const f32x4& v) {
    if constexpr (XB) { u32x2 t; t.x = pk2(v.x, v.y); t.y = pk2(v.z, v.w); *(u32x2*)((bf16_t*)base + e) = t; }
    else *(f32x4*)((float*)base + e) = v;
}
DI float fexp2(float x) { return __builtin_amdgcn_exp2f(x); }
DI float frcp(float x) { return __builtin_amdgcn_rcpf(x); }
DI int crow(int reg, int h) { return (reg & 3) + 8 * (reg >> 2) + 4 * h; }
template <int CTRL> DI float dpp_f(float v) { return __builtin_bit_cast(float, __builtin_amdgcn_update_dpp(0, __builtin_bit_cast(int, v), CTRL, 0xF, 0xF, true)); }
DI float lx1(float v) { return dpp_f<0xB1>(v); }
DI float lx2(float v) { return dpp_f<0x4E>(v); }
DI float lhm(float v) { return dpp_f<0x141>(v); }
DI float lr8(float v) { return dpp_f<0x128>(v); }
DI float sum_x16(float v) { auto s = __builtin_amdgcn_permlane16_swap(__float_as_uint(v), __float_as_uint(v), false, false); return __uint_as_float(s[0]) + __uint_as_float(s[1]); }
DI float sum_x32(float v) { auto s = __builtin_amdgcn_permlane32_swap(__float_as_uint(v), __float_as_uint(v), false, false); return __uint_as_float(s[0]) + __uint_as_float(s[1]); }
DI float max_x16(float v) { auto s = __builtin_amdgcn_permlane16_swap(__float_as_uint(v), __float_as_uint(v), false, false); return fmaxf(__uint_as_float(s[0]), __uint_as_float(s[1])); }
DI float max_x32(float v) { auto s = __builtin_amdgcn_permlane32_swap(__float_as_uint(v), __float_as_uint(v), false, false); return fmaxf(__uint_as_float(s[0]), __uint_as_float(s[1])); }
DI unsigned get_x32(unsigned v, int h) { auto s = __builtin_amdgcn_permlane32_swap(v, v, false, false); return h ? s[0] : s[1]; }
DI float wave_sum(float v) { v += lx1(v); v += lx2(v); v += lhm(v); v += lr8(v); v = sum_x16(v); return sum_x32(v); }
DI float wave_max(float v) { v = fmaxf(v, lx1(v)); v = fmaxf(v, lx2(v)); v = fmaxf(v, lhm(v)); v = fmaxf(v, lr8(v)); v = max_x16(v); return max_x32(v); }
DI int bperm(int v, int srclane) { return __builtin_amdgcn_ds_bpermute(srclane << 2, v); }
DI float bpermf(float v, int srclane) { return __builtin_bit_cast(float, __builtin_amdgcn_ds_bpermute(srclane << 2, __builtin_bit_cast(int, v))); }
DI float gelu_tanh(float x) {
    const float u = 0.7978845608028654f * (x + 0.044715f * x * x * x);
    return x * frcp(1.f + fexp2(-2.f * LOG2E * u));
}
DI float dot2bf(unsigned a, unsigned b, float c) {
    return __builtin_amdgcn_fdot2_f32_bf16(__builtin_bit_cast(bf16x2v, a), __builtin_bit_cast(bf16x2v, b), c, false);
}
DI int rel_bucket_i(int d) {
    if (d < 16) return d < 0 ? 0 : d;
    int b = 16;
    b += d >= 21; b += d >= 27; b += d >= 35; b += d >= 46; b += d >= 59; b += d >= 77; b += d >= 99; b += d >= 128;
    b += d >= 166; b += d >= 216; b += d >= 280; b += d >= 363; b += d >= 470; b += d >= 609; b += d >= 790;
    return b;
}
DI unsigned f2key(float f) { unsigned u = __float_as_uint(f); return u ^ ((unsigned)((int)u >> 31) | 0x80000000u); }
DI float key2f(unsigned k) { unsigned u = (k & 0x80000000u) ? (k ^ 0x80000000u) : ~k; return __uint_as_float(u); }

constexpr int EPI_LDS = 96 * 1024;

DI int sw2(int row, int chunk) { return (row >> 1) * 256 + (((((row & 1) << 3) | chunk) ^ ((row >> 1) & 15)) << 4); }
DI void sw2_src(int P, int& row, int& chunk) { const int R2 = P >> 4, lc = (P & 15) ^ (R2 & 15); row = 2 * R2 + (lc >> 3); chunk = lc & 7; }

template <class T, class = void> struct epi_stash { static constexpr bool value = false, present = false; };
template <class T> struct epi_stash<T, decltype((void)T::STASH)> { static constexpr bool value = T::STASH, present = true; };

template <int MT, class Epi>
DI void gemm_tile(const bf16_t* __restrict__ A, long lda, int M, const bf16_t* __restrict__ Bt, long ldb, int N, int K,
                  int m0, int n0, const Epi& epi, unsigned char* lds, int tid) {
    constexpr int XS = MT * 128 * 128, WS = 256 * 128, STAGE = XS + WS;
    const int lane = tid & 63, w = tid >> 6, tg = w & 3, fh = w >> 2, r = lane & 31, h = lane >> 5;
    const int wbase = tid & ~63;
    unsigned xo[2 * MT], wo[4];
#pragma unroll
    for (int i = 0; i < 2 * MT; ++i) { int row, c; sw2_src(tid + 512 * i, row, c); int m = m0 + row; m = m < M ? m : M - 1; xo[i] = (unsigned)m * (unsigned)(lda * 2) + c * 16; }
#pragma unroll
    for (int i = 0; i < 4; ++i) { int row, c; sw2_src(tid + 512 * i, row, c); int n = n0 + row; n = n < N ? n : N - 1; wo[i] = (unsigned)n * (unsigned)(ldb * 2) + c * 16; }
    const unsigned char* Ab = (const unsigned char*)A;
    const unsigned char* Bb = (const unsigned char*)Bt;
    auto stage = [&](int kt, unsigned char* st) {
#pragma unroll
        for (int i = 0; i < 2 * MT; ++i)
            __builtin_amdgcn_global_load_lds((const unsigned*)(Ab + kt * 128 + xo[i]), (unsigned*)(st + (wbase + 512 * i) * 16), 16, 0, 0);
#pragma unroll
        for (int i = 0; i < 4; ++i)
            __builtin_amdgcn_global_load_lds((const unsigned*)(Bb + kt * 128 + wo[i]), (unsigned*)(st + XS + (wbase + 512 * i) * 16), 16, 0, 0);
    };
    f32x16 acc[MT][4];
#pragma unroll
    for (int s2 = 0; s2 < MT; ++s2)
#pragma unroll
        for (int i = 0; i < 4; ++i)
#pragma unroll
            for (int j = 0; j < 16; ++j) acc[s2][i][j] = 0.f;
    const int nk = K >> 6;
    stage(0, lds);
    __syncthreads();
    for (int kt = 0; kt < nk; ++kt) {
        unsigned char* cur = lds + (kt & 1) * STAGE;
        if (kt + 1 < nk) stage(kt + 1, lds + ((kt + 1) & 1) * STAGE);
        bf16x8 xfa[MT], wfa[4], xfb[MT], wfb[4];
        auto ldf = [&](bf16x8 (&xf)[MT], bf16x8 (&wf)[4], int ks) {
#pragma unroll
            for (int s2 = 0; s2 < MT; ++s2) xf[s2] = *(const bf16x8*)(cur + sw2(32 * MT * tg + 32 * s2 + r, 2 * ks + h));
#pragma unroll
            for (int mt = 0; mt < 4; ++mt) wf[mt] = *(const bf16x8*)(cur + XS + sw2(128 * fh + 32 * mt + r, 2 * ks + h));
        };
        auto mm = [&](const bf16x8 (&xf)[MT], const bf16x8 (&wf)[4]) {
#pragma unroll
            for (int mt = 0; mt < 4; ++mt)
#pragma unroll
                for (int s2 = 0; s2 < MT; ++s2) acc[s2][mt] = MFMA32(wf[mt], xf[s2], acc[s2][mt]);
        };
        ldf(xfa, wfa, 0);
        ldf(xfb, wfb, 1); __builtin_amdgcn_sched_barrier(0); mm(xfa, wfa); __builtin_amdgcn_sched_barrier(0);
        ldf(xfa, wfa, 2); __builtin_amdgcn_sched_barrier(0); mm(xfb, wfb); __builtin_amdgcn_sched_barrier(0);
        ldf(xfb, wfb, 3); __builtin_amdgcn_sched_barrier(0); mm(xfa, wfa); __builtin_amdgcn_sched_barrier(0);
        mm(xfb, wfb);
        __syncthreads();
    }
    if constexpr (MT == 2 && epi_stash<Epi>::value) {
        float* sp = (float*)lds + w * 4096 + lane;
#pragma unroll
        for (int mt = 0; mt < 4; ++mt)
#pragma unroll
            for (int j = 0; j < 16; ++j) sp[(mt * 16 + j) * 64] = acc[1][mt][j];
        epi(acc[0], m0 + 64 * tg + r, n0 + 128 * fh, h, lds, tid);
        f32x16 a2[4];
        const float* sp2 = sp; asm volatile("" : "+v"(sp2));
#pragma unroll
        for (int mt = 0; mt < 4; ++mt)
#pragma unroll
            for (int j = 0; j < 16; ++j) a2[mt][j] = sp2[(mt * 16 + j) * 64];
        epi(a2, m0 + 64 * tg + 32 + r, n0 + 128 * fh, h, lds, tid);
        __syncthreads();
    } else {
        int ho = h, ro = r, to = tid;
        if constexpr (epi_stash<Epi>::present) asm volatile("" : "+v"(ho), "+v"(ro), "+v"(to));
#pragma unroll
        for (int s2 = 0; s2 < MT; ++s2) epi(acc[s2], m0 + 32 * MT * tg + 32 * s2 + ro, n0 + 128 * fh, ho, lds, to);
    }
}

DI void store_vt_tile(bf16_t* base, long rstride, const f32x16& a, int row0, int h, int lane) {
    const bool odd = lane & 1;
#pragma unroll
    for (int rg = 0; rg < 16; rg += 2) {
        const float xa = lx1(a[rg]), xb = lx1(a[rg + 1]);
        const unsigned wv = odd ? pk2(xb, a[rg + 1]) : pk2(a[rg], xa);
        bf16_t* dp = base + (long)(row0 + crow(odd ? rg + 1 : rg, h)) * rstride - (odd ? 1 : 0);
        *(unsigned*)dp = wv;
    }
}
struct EpiQKV0 {
    bf16_t *Q, *Kk, *VT;
    const float *qg, *kg;
    float* MB; const float* relb;
    DI void operator()(const f32x16 (&acc)[4], int tok, int fbase, int h, unsigned char*, int) const {
        const int sec = fbase >> 10, hd = (fbase & 1023) >> 7, b = tok >> 13, s = tok & (SEQ - 1);
        if (sec < 2) {
            const float* gn = sec == 0 ? qg : kg;
            const float sc = sec == 0 ? 0.125f * LOG2E : 1.f;
            bf16_t* dst = sec == 0 ? Q : Kk;
#pragma unroll
            for (int j = 0; j < 2; ++j) {
                float ss = 0.f;
#pragma unroll
                for (int mt = 0; mt < 2; ++mt)
#pragma unroll
                    for (int rg = 0; rg < 16; ++rg) { const float v = acc[2 * j + mt][rg]; ss += v * v; }
                ss = sum_x32(ss);
                const float rstd = rsqrtf(ss * (1.f / 64.f) + EPS) * sc;
                bf16_t* row = dst + ((long)((b * 8 + hd) * 2 + j) * SEQ + s) * 64;
                float qq = 0.f;
#pragma unroll
                for (int mt = 0; mt < 2; ++mt)
#pragma unroll
                    for (int g4 = 0; g4 < 4; ++g4) {
                        const int d0 = 32 * mt + 8 * g4 + 4 * h;
                        const f32x4 gv = *(const f32x4*)(gn + d0);
                        const float v0 = acc[2 * j + mt][4 * g4 + 0] * rstd * gv.x, v1 = acc[2 * j + mt][4 * g4 + 1] * rstd * gv.y;
                        const float v2 = acc[2 * j + mt][4 * g4 + 2] * rstd * gv.z, v3 = acc[2 * j + mt][4 * g4 + 3] * rstd * gv.w;
                        qq += v0 * v0 + v1 * v1 + v2 * v2 + v3 * v3;
                        u32x2 o;
                        o.x = pk2(v0, v1); o.y = pk2(v2, v3);
                        *(u32x2*)(row + d0) = o;
                    }
                if (sec == 0) {
                    qq = sum_x32(qq);
                    float kmx = 0.f;
                    for (int d = 0; d < 64; ++d) kmx = fmaxf(kmx, fabsf(kg[d]));
                    float bmx = 0.f;
                    for (int bk = 0; bk < 32; ++bk) bmx = fmaxf(bmx, relb[bk * 8 + hd] - relb[31 * 8 + hd]);
                    if (h == 0) MB[(long)((b * 8 + hd) * 2 + j) * SEQ + s] = 1.01f * sqrtf(qq) * 8.f * kmx + bmx * LOG2E;
                }
            }
        } else {
            bf16_t* base = VT + (long)(b * 8 + hd) * 128 * SEQ + s;
#pragma unroll
            for (int mt = 0; mt < 4; ++mt) store_vt_tile(base, SEQ, acc[mt], 32 * mt, h, tok);
        }
    }
};

template <bool INB, bool OUTB>
struct EpiResid {
    const void* xin; void* xout; const float* gate;
    DI void operator()(const f32x16 (&acc)[4], int tok, int fbase, int h, unsigned char* lds, int tid) const {
        const int lane = tid & 63, w = tid >> 6, r = lane & 31, hh = lane >> 5;
        float* T = (float*)(lds + w * 16896);
#pragma unroll
        for (int mt = 0; mt < 4; ++mt)
#pragma unroll
            for (int g4 = 0; g4 < 4; ++g4)
                *(f32x4*)(T + r * 132 + 32 * mt + 8 * g4 + 4 * h) = (f32x4){acc[mt][4 * g4 + 0], acc[mt][4 * g4 + 1], acc[mt][4 * g4 + 2], acc[mt][4 * g4 + 3]};
        const int tok0 = tok - r, b = tok0 >> 13, f = fbase + 4 * r;
        const f32x4 gv = *(const f32x4*)(gate + b * ADA_STRIDE + f);
        __builtin_amdgcn_sched_barrier(0);
        const long e0 = (long)(tok0 + hh) * DM + f;
        const float* tp = T + hh * 132 + 4 * r;
#pragma unroll
        for (int i0 = 0; i0 < 16; i0 += 4) {
            f32x4 xv[4];
#pragma unroll
            for (int i = 0; i < 4; ++i) xv[i] = ld4<INB>(xin, e0 + (long)(2 * (i0 + i)) * DM);
#pragma unroll
            for (int i = 0; i < 4; ++i) {
                const f32x4 a = *(const f32x4*)(tp + 2 * (i0 + i) * 132);
                f32x4 o;
                o.x = xv[i].x + gv.x * a.x; o.y = xv[i].y + gv.y * a.y; o.z = xv[i].z + gv.z * a.z; o.w = xv[i].w + gv.w * a.w;
                st4<OUTB>(xout, e0 + (long)(2 * (i0 + i)) * DM, o);
            }
            __builtin_amdgcn_sched_barrier(0);
        }
        __syncthreads();
    }
};

struct EpiKV {
    bf16_t *KC, *KS, *VST, *KW, *VWT;
    const float* kgain;
    DI void operator()(const f32x16 (&acc)[4], int tok, int fbase, int h, unsigned char*, int) const {
        const int c = fbase >> 7, br = c >> 2, kv = (c >> 1) & 1, g = c & 1, b = tok >> 13, s = tok & (SEQ - 1);
        if (br == 0 || kv == 0) {
            float rstd = 1.f;
            bf16_t* row;
            if (br == 0) row = KC + ((long)((kv * 4 + b) * 2 + g) * SEQ + s) * 128;
            else {
                float ss = 0.f;
#pragma unroll
                for (int mt = 0; mt < 4; ++mt)
#pragma unroll
                    for (int rg = 0; rg < 16; ++rg) ss += acc[mt][rg] * acc[mt][rg];
                ss = sum_x32(ss);
                rstd = rsqrtf(ss * (1.f / 128.f) + EPS);
                row = (br == 1 ? KS : KW) + ((long)(b * 2 + g) * SEQ + s) * 128;
            }
#pragma unroll
            for (int mt = 0; mt < 4; ++mt)
#pragma unroll
                for (int g4 = 0; g4 < 4; ++g4) {
                    const int d0 = 32 * mt + 8 * g4 + 4 * h;
                    f32x4 gv = {1.f, 1.f, 1.f, 1.f};
                    if (br != 0) gv = *(const f32x4*)(kgain + br * 128 + d0);
                    u32x2 o;
                    o.x = pk2(acc[mt][4 * g4 + 0] * rstd * gv.x, acc[mt][4 * g4 + 1] * rstd * gv.y);
                    o.y = pk2(acc[mt][4 * g4 + 2] * rstd * gv.z, acc[mt][4 * g4 + 3] * rstd * gv.w);
                    *(u32x2*)(row + d0) = o;
                }
        } else {
            bf16_t* base = (br == 1 ? VST : VWT) + (long)(b * 2 + g) * 128 * SEQ + s;
#pragma unroll
            for (int mt = 0; mt < 4; ++mt) store_vt_tile(base, SEQ, acc[mt], 32 * mt, h, tok);
        }
    }
};

struct EpiCmp1 {
    bf16_t* hid; const float* posb_part; const float* b1;
    DI void operator()(const f32x16 (&acc)[4], int tok, int fbase, int h, unsigned char*, int) const {
        if (tok >= 512) return;
#pragma unroll
        for (int mt = 0; mt < 4; ++mt)
#pragma unroll
            for (int g4 = 0; g4 < 4; ++g4) {
                const int f = fbase + 32 * mt + 8 * g4 + 4 * h;
                f32x4 pb = *(const f32x4*)(b1 + f);
                for (int c = 0; c < 16; ++c) { const f32x4 t = *(const f32x4*)(posb_part + c * 256 + f); pb.x += t.x; pb.y += t.y; pb.z += t.z; pb.w += t.w; }
                u32x2 o;
                o.x = pk2(gelu_tanh(acc[mt][4 * g4 + 0] + pb.x), gelu_tanh(acc[mt][4 * g4 + 1] + pb.y));
                o.y = pk2(gelu_tanh(acc[mt][4 * g4 + 2] + pb.z), gelu_tanh(acc[mt][4 * g4 + 3] + pb.w));
                *(u32x2*)(hid + (long)tok * 256 + f) = o;
            }
    }
};

struct EpiCmp2 {
    bf16_t* dst; const float* kgain0; int kv;
    DI void operator()(const f32x16 (&acc)[4], int tok, int fbase, int h, unsigned char*, int) const {
        if (fbase != 0 || tok >= 512) return;
        const float valid = tok < 511 ? 1.f : 0.f;
        if (kv == 0) {
            float ss = 0.f;
#pragma unroll
            for (int mt = 0; mt < 4; ++mt)
#pragma unroll
                for (int rg = 0; rg < 16; ++rg) ss += acc[mt][rg] * acc[mt][rg];
            ss = sum_x32(ss);
            const float rstd = rsqrtf(ss * (1.f / 128.f) + EPS) * valid;
#pragma unroll
            for (int mt = 0; mt < 4; ++mt)
#pragma unroll
                for (int g4 = 0; g4 < 4; ++g4) {
                    const int d0 = 32 * mt + 8 * g4 + 4 * h;
                    const f32x4 gv = *(const f32x4*)(kgain0 + d0);
                    u32x2 o;
                    o.x = pk2(acc[mt][4 * g4 + 0] * rstd * gv.x, acc[mt][4 * g4 + 1] * rstd * gv.y);
                    o.y = pk2(acc[mt][4 * g4 + 2] * rstd * gv.z, acc[mt][4 * g4 + 3] * rstd * gv.w);
                    *(u32x2*)(dst + (long)tok * 128 + d0) = o;
                }
        } else {
#pragma unroll
            for (int mt = 0; mt < 4; ++mt)
#pragma unroll
                for (int rg = 0; rg < 16; ++rg) dst[(long)(32 * mt + crow(rg, h)) * 512 + tok] = f2bf(acc[mt][rg] * valid);
        }
    }
};

struct EpiNsaQ {
    bf16_t* QN; float* gates; const float* qgain; const float* bgate; float* qnrm;
    DI void operator()(const f32x16 (&acc)[4], int tok, int fbase, int h, unsigned char*, int) const {
        const int b = tok >> 13, s = tok & (SEQ - 1);
        if (fbase < 1024) {
            const int head = fbase >> 7;
            float ss = 0.f;
#pragma unroll
            for (int mt = 0; mt < 4; ++mt)
#pragma unroll
                for (int rg = 0; rg < 16; ++rg) ss += acc[mt][rg] * acc[mt][rg];
            ss = sum_x32(ss);
            const float rstd = rsqrtf(ss * (1.f / 128.f) + EPS) * (0.08838834764831845f * LOG2E);
            bf16_t* row = QN + ((long)(b * 8 + head) * SEQ + s) * 128;
            float qq = 0.f;
#pragma unroll
            for (int mt = 0; mt < 4; ++mt)
#pragma unroll
                for (int g4 = 0; g4 < 4; ++g4) {
                    const int d0 = 32 * mt + 8 * g4 + 4 * h;
                    const f32x4 gv = *(const f32x4*)(qgain + d0);
                    const float v0 = acc[mt][4 * g4 + 0] * rstd * gv.x, v1 = acc[mt][4 * g4 + 1] * rstd * gv.y;
                    const float v2 = acc[mt][4 * g4 + 2] * rstd * gv.z, v3 = acc[mt][4 * g4 + 3] * rstd * gv.w;
                    qq += v0 * v0 + v1 * v1 + v2 * v2 + v3 * v3;
                    u32x2 o;
                    o.x = pk2(v0, v1); o.y = pk2(v2, v3);
                    *(u32x2*)(row + d0) = o;
                }
            qq = sum_x32(qq);
            if (h == 0) qnrm[(long)tok * 8 + head] = 1.01f * sqrtf(qq);
        } else if (fbase == 1024) {
#pragma unroll
            for (int rg = 0; rg < 16; ++rg) {
                const int f = crow(rg, h);
                if (f < 24) { const float z = acc[0][rg] + bgate[f]; gates[(long)tok * 24 + f] = frcp(1.f + fexp2(-LOG2E * z)); }
            }
        }
    }
};

DI void ce_desc(unsigned& a, unsigned& b) { const unsigned hi = a > b ? a : b, lo = a > b ? b : a; a = hi; b = lo; }
DI void sort16_desc(unsigned (&a)[16]) {
#define CE_(i, j) ce_desc(a[i], a[j]);
    CE_(0,13) CE_(1,12) CE_(2,15) CE_(3,14) CE_(4,8) CE_(5,6) CE_(7,11) CE_(9,10)
    CE_(0,5) CE_(1,7) CE_(2,9) CE_(3,4) CE_(6,13) CE_(8,14) CE_(10,15) CE_(11,12)
    CE_(0,1) CE_(2,3) CE_(4,5) CE_(6,8) CE_(7,9) CE_(10,11) CE_(12,13) CE_(14,15)
    CE_(0,2) CE_(1,3) CE_(4,10) CE_(5,11) CE_(6,7) CE_(8,9) CE_(12,14) CE_(13,15)
    CE_(1,2) CE_(3,12) CE_(4,6) CE_(5,7) CE_(8,10) CE_(9,11) CE_(13,14)
    CE_(1,4) CE_(2,6) CE_(5,8) CE_(7,10) CE_(9,13) CE_(11,14)
    CE_(2,4) CE_(3,6) CE_(9,12) CE_(11,13)
    CE_(3,5) CE_(6,8) CE_(7,9) CE_(10,12)
    CE_(3,4) CE_(5,6) CE_(7,8) CE_(9,10) CE_(11,12)
    CE_(6,7) CE_(8,9)
#undef CE_
}
DI void bitonic_merge16_desc(unsigned (&a)[16]) {
#pragma unroll
    for (int st = 8; st >= 1; st >>= 1)
#pragma unroll
        for (int i = 0; i < 16; ++i)
            if ((i & st) == 0) ce_desc(a[i], a[i + st]);
}
DI void merge_top16(unsigned (&a)[16], const unsigned (&b)[16]) {
#pragma unroll
    for (int i = 0; i < 16; ++i) a[i] = a[i] > b[15 - i] ? a[i] : b[15 - i];
    bitonic_merge16_desc(a);
}

struct EpiPeer {
    static constexpr bool STASH = false;
    int* ridx; float* rgate; int ex_off;
    DI void operator()(const f32x16 (&acc)[4], int tok, int fbase, int h, unsigned char* lds, int tid) const {
        const int lane = tid & 63, w = tid >> 6, tg = w & 3, fh = w >> 2, r = lane & 31;
        const int hd = fbase >> 8;
        unsigned* EX = (unsigned*)(lds + ex_off);
        unsigned L[16];
        {
            unsigned G1[16], G2[16], G3[16];
#pragma unroll
            for (int rg = 0; rg < 16; ++rg) {
                const int c = crow(rg, h);
                L[rg] = (f2key(acc[0][rg]) & ~127u) | (unsigned)(127 - c);
                G1[rg] = (f2key(acc[1][rg]) & ~127u) | (unsigned)(127 - 32 - c);
                G2[rg] = (f2key(acc[2][rg]) & ~127u) | (unsigned)(127 - 64 - c);
                G3[rg] = (f2key(acc[3][rg]) & ~127u) | (unsigned)(127 - 96 - c);
            }
            sort16_desc(L); sort16_desc(G1); merge_top16(L, G1);
            sort16_desc(G2); sort16_desc(G3); merge_top16(G2, G3);
            merge_top16(L, G2);
        }
        {
            unsigned P[16];
#pragma unroll
            for (int i = 0; i < 16; ++i) P[i] = get_x32(L[i], h);
            merge_top16(L, P);
        }
        if (h == 0) {
#pragma unroll
            for (int i = 0; i < 16; i += 4) *(u32x4*)(EX + ((fh * 4 + tg) * 32 + r) * 16 + i) = (u32x4){L[i], L[i + 1], L[i + 2], L[i + 3]};
        }
        __syncthreads();
        float xf[4], ys[16];
        {
            const unsigned* l0 = EX + ((0 * 4 + tg) * 32 + r) * 16;
            const unsigned* l1 = EX + ((1 * 4 + tg) * 32 + r) * 16;
            const unsigned* px = h ? l1 : l0;
            const unsigned* py = h ? l0 : l1;
            const u32x4 a = *(const u32x4*)px;
            xf[0] = key2f(a.x & ~127u); xf[1] = key2f(a.y & ~127u); xf[2] = key2f(a.z & ~127u); xf[3] = key2f(a.w & ~127u);
            unsigned Y[16];
#pragma unroll
            for (int i = 0; i < 16; i += 4) { const u32x4 b2 = *(const u32x4*)(py + i); Y[i] = b2.x; Y[i + 1] = b2.y; Y[i + 2] = b2.z; Y[i + 3] = b2.w; }
#pragma unroll
            for (int k = 0; k < 15; ++k) ys[k] = key2f((h ? Y[k + 1] : Y[k]) & ~127u);
            ys[15] = key2f(Y[15] & ~127u);
        }
        auto pkey = [&](int i, int k) -> unsigned {
            const float fs = xf[i] + ys[k];
            const unsigned code = h ? (unsigned)((((k + 1) & 15) << 4) | i) : (unsigned)((i << 4) | k);
            return (f2key(fs) & ~255u) | (255u - code);
        };
        unsigned T[16], E[16];
#pragma unroll
        for (int k = 0; k < 16; ++k) T[k] = pkey(0, k);
        T[15] = h ? 0u : T[15];
#pragma unroll
        for (int k = 1; k <= 7; ++k) E[k - 1] = pkey(1, k);
#pragma unroll
        for (int k = 2; k <= 4; ++k) E[7 + k - 2] = pkey(2, k);
        E[10] = pkey(3, 3);
#pragma unroll
        for (int k = 11; k < 16; ++k) E[k] = 0u;
        sort16_desc(E);
        merge_top16(T, E);
        {
            unsigned P[16];
#pragma unroll
            for (int i = 0; i < 16; ++i) P[i] = get_x32(T[i], h);
            merge_top16(T, P);
        }
        float sc[16], sum = 0.f;
        const float mx = key2f(T[0] & ~255u);
#pragma unroll
        for (int k = 0; k < 16; ++k) { sc[k] = fexp2((key2f(T[k] & ~255u) - mx) * LOG2E); sum += sc[k]; }
        const float inv = frcp(sum);
        if (h == 0) {
            const unsigned* l0 = EX + ((0 * 4 + tg) * 32 + r) * 16;
            const unsigned* l1 = EX + ((1 * 4 + tg) * 32 + r) * 16;
#pragma unroll
            for (int k = 0; k < 16; ++k) {
                if ((k >> 3) != fh) continue;
                const unsigned code = 255u - (T[k] & 255u);
                const int i1 = 127 - (int)(l0[code >> 4] & 127u), i2 = 127 - (int)(l1[code & 15u] & 127u);
                ridx[(long)tok * 128 + hd * 16 + k] = i1 * 128 + i2;
                rgate[(long)tok * 128 + hd * 16 + k] = sc[k] * inv;
            }
        }
        __syncthreads();
    }
};

DI void p0_transpose_item(const float* __restrict__ W, int K, int N, bf16_t* __restrict__ WT, int item, int ntn, unsigned char* lds, int tid) {
    float* tile = (float*)lds;
    const int kb = item / ntn, nb = item % ntn, k0 = kb * 64, n0 = nb * 64;
    {
        const int nn = tid & 63, kk0 = tid >> 6;
#pragma unroll
        for (int i = 0; i < 8; ++i) { const int kk = kk0 + 8 * i; const int n = n0 + nn; tile[kk * 65 + nn] = n < N ? W[(long)(k0 + kk) * N + n] : 0.f; }
    }
    __syncthreads();
    {
        const int n = tid >> 3, c = tid & 7;
        const float* s = tile + (8 * c) * 65 + n;
        u32x4 o;
        o.x = pk2(s[0], s[65]); o.y = pk2(s[2 * 65], s[3 * 65]); o.z = pk2(s[4 * 65], s[5 * 65]); o.w = pk2(s[6 * 65], s[7 * 65]);
        *(u32x4*)(WT + (long)(n0 + n) * K + k0 + 8 * c) = o;
    }
    __syncthreads();
}

DI int pack_i8x4(float a, float b, float c, float d) {
    const int ia = __float2int_rn(a), ib = __float2int_rn(b), ic = __float2int_rn(c), id = __float2int_rn(d);
    return (ia & 255) | ((ib & 255) << 8) | ((ic & 255) << 16) | (id << 24);
}
DI void p0_fp8_item(const float* __restrict__ src, unsigned char* __restrict__ dst, float* __restrict__ sinv, bool sliced, int item, int tid) {
    const int lane = tid & 63, row = item * 8 + (tid >> 6);
    const float* rp = src + (long)row * 1024;
    f32x4 v[4]; float am = 0.f;
#pragma unroll
    for (int j = 0; j < 4; ++j) {
        v[j] = *(const f32x4*)(rp + 4 * lane + 256 * j);
        am = fmaxf(am, fmaxf(fmaxf(fabsf(v[j].x), fabsf(v[j].y)), fmaxf(fabsf(v[j].z), fabsf(v[j].w))));
    }
    am = wave_max(am);
    const float sc = sliced ? (am > 0.f ? exp2f(floorf(log2f(384.f / am))) : 1.f) : (am > 0.f ? 127.f / am : 1.f);
    if (lane == 0) sinv[row] = 1.f / sc;
#pragma unroll
    for (int j = 0; j < 4; ++j) {
        int pk = 0;
        if (sliced) {
            pk = __builtin_amdgcn_cvt_pk_fp8_f32(v[j].x * sc, v[j].y * sc, pk, false);
            pk = __builtin_amdgcn_cvt_pk_fp8_f32(v[j].z * sc, v[j].w * sc, pk, true);
        } else pk = pack_i8x4(v[j].x * sc, v[j].y * sc, v[j].z * sc, v[j].w * sc);
        const int col = 4 * lane + 256 * j;
        unsigned char* d = sliced ? dst + ((long)(col >> 7) * 16384 + row) * 128 + (col & 127) : dst + (long)row * 1024 + col;
        *(int*)d = pk;
    }
}

DI void p0_weff_item(const float* __restrict__ wq, const float* __restrict__ subk, bf16_t* __restrict__ WT, int item, unsigned char* lds, int tid) {
    const int layer = item >> 8, g = (item >> 4) & 15, ct = item & 15, p = g & 1, c0 = ct * 64;
    float* As = (float*)lds;
    float* Bs = As + 64 * 129;
    const float* wql = wq + (long)layer * 1024 * 2048;
    const float* sk = subk + ((long)layer * 2 + p) * 128 * 128;
    for (int e = tid; e < 64 * 128; e += NTHREADS) { const int c = e >> 7, d = e & 127; As[c * 129 + d] = wql[(long)(c0 + c) * 2048 + g * 128 + d]; }
    for (int e = tid; e < 128 * 128; e += NTHREADS) { const int k = e >> 7, d = e & 127; Bs[k * 129 + d] = sk[k * 128 + d]; }
    __syncthreads();
    const int lane = tid & 63, w = tid >> 6, ti = w & 3, tj = w >> 2, r = lane & 31, h = lane >> 5;
    f32x16 acc;
#pragma unroll
    for (int i = 0; i < 16; ++i) acc[i] = 0.f;
    const float* ap = Bs + (32 * ti + r) * 129 + h;
    const float* bp = As + (32 * tj + r) * 129 + h;
#pragma unroll 8
    for (int d = 0; d < 128; d += 2) acc = __builtin_amdgcn_mfma_f32_32x32x2f32(ap[d], bp[d], acc, 0, 0, 0);
    bf16_t* o = WT + ((long)layer * 2048 + g * 128 + 32 * ti) * 1024 + c0 + 32 * tj + r;
#pragma unroll
    for (int i = 0; i < 16; ++i) o[(long)crow(i, h) * 1024] = f2bf(acc[i]);
    __syncthreads();
}

DI void p0_posb_item(const float* __restrict__ pos, const float* __restrict__ w1, float* __restrict__ part, int item, unsigned char* lds, int tid) {
    const int kv = item >> 4, ch = item & 15;
    float* red = (float*)lds;
    const int j = tid & 255, half = tid >> 8;
    const float* pp = pos + (long)kv * 4096 + ch * 256 + half * 128;
    const float* ww = w1 + ((long)kv * 4096 + ch * 256 + half * 128) * 256 + j;
    float a = 0.f;
    for (int f = 0; f < 128; ++f) a += pp[f] * ww[(long)f * 256];
    red[half * 256 + j] = a;
    __syncthreads();
    if (tid < 256) part[(kv * 16 + ch) * 256 + tid] = red[tid] + red[256 + tid];
    __syncthreads();
}

DI void p0_ada_item(const Params& p, float* __restrict__ ada, int item, unsigned char* lds, int tid) {
    float* cact = (float*)lds;
    float* red = cact + 4096;
    const float* c = p.in[1];
    for (int e = tid; e < 4096; e += NTHREADS) { const float v = c[e]; cact[e] = v * frcp(1.f + fexp2(-LOG2E * v)); }
    __syncthreads();
    const int colg = item * 64;
    const float* W; const float* bias; int N, n0;
    if (colg < 6144) { W = p.in[3]; bias = p.in[4]; N = 6144; n0 = colg; }
    else if (colg < 12288) { W = p.in[3] + (long)1024 * 6144; bias = p.in[4] + 6144; N = 6144; n0 = colg - 6144; }
    else { W = p.in[14]; bias = p.in[15]; N = 2048; n0 = colg - 12288; }
    const int col = tid & 63, kg = tid >> 6;
    float a0 = 0.f, a1 = 0.f, a2 = 0.f, a3 = 0.f;
    const float* wp = W + (long)(kg * 128) * N + n0 + col;
#pragma unroll 8
    for (int k = 0; k < 128; ++k) {
        const float wv = wp[(long)k * N];
        const int kk = kg * 128 + k;
        a0 += cact[kk] * wv; a1 += cact[1024 + kk] * wv; a2 += cact[2048 + kk] * wv; a3 += cact[3072 + kk] * wv;
    }
    red[(kg * 4 + 0) * 64 + col] = a0; red[(kg * 4 + 1) * 64 + col] = a1; red[(kg * 4 + 2) * 64 + col] = a2; red[(kg * 4 + 3) * 64 + col] = a3;
    __syncthreads();
    if (tid < 256) {
        const int b = tid >> 6, cc = tid & 63;
        float s = bias[n0 + cc];
#pragma unroll
        for (int q = 0; q < 8; ++q) s += red[(q * 4 + b) * 64 + cc];
        ada[b * ADA_STRIDE + colg + cc] = s;
    }
    __syncthreads();
}

constexpr int P0_CONV = 8192, P0_TR_DIN = 768, P0_TR_DOUT = 256, P0_TR_KV = 384, P0_TR_NIN = 288, P0_TR_NOUT = 256, P0_TR_C1 = 512, P0_TR_C2 = 16,
              P0_WEFF = 512, P0_POSB = 32, P0_ADA = 224;
constexpr int P0_TOTAL = P0_CONV + P0_TR_DIN + P0_TR_DOUT + P0_TR_KV + P0_TR_NIN + P0_TR_NOUT + P0_TR_C1 + P0_TR_C2 + P0_WEFF + P0_POSB + P0_ADA;

DI void phase_prep(const Params& p, unsigned char* lds, int tid) {
    unsigned char* ws = p.ws;
    for (int it = blockIdx.x; it < P0_TOTAL; it += gridDim.x) {
        int r = it;
        if (r < P0_ADA) { p0_ada_item(p, (float*)(ws + OFF_ADA), r, lds, tid); continue; } r -= P0_ADA;
        if (r < P0_WEFF) { p0_weff_item(p.in[26], p.in[27], (bf16_t*)(ws + OFF_WT_PEER), r, lds, tid); continue; } r -= P0_WEFF;
        if (r < P0_POSB) { p0_posb_item(p.in[17], p.in[18], (float*)(ws + OFF_POSB), r, lds, tid); continue; } r -= P0_POSB;
        if (r < P0_TR_DIN) { p0_transpose_item(p.in[7], 1024, 3072, (bf16_t*)(ws + OFF_WT_DIN), r, 48, lds, tid); continue; } r -= P0_TR_DIN;
        if (r < P0_TR_DOUT) { p0_transpose_item(p.in[8], 1024, 1024, (bf16_t*)(ws + OFF_WT_DOUT), r, 16, lds, tid); continue; } r -= P0_TR_DOUT;
        if (r < P0_TR_KV) { p0_transpose_item(p.in[16], 1024, 1536, (bf16_t*)(ws + OFF_WT_KV), r, 24, lds, tid); continue; } r -= P0_TR_KV;
        if (r < P0_TR_NIN) { p0_transpose_item(p.in[22], 1024, 1048, (bf16_t*)(ws + OFF_WT_NIN), r, 18, lds, tid); continue; } r -= P0_TR_NIN;
        if (r < P0_TR_NOUT) { p0_transpose_item(p.in[24], 1024, 1024, (bf16_t*)(ws + OFF_WT_NOUT), r, 16, lds, tid); continue; } r -= P0_TR_NOUT;
        if (r < P0_TR_C1) { const int kv = r >> 8; p0_transpose_item(p.in[18] + (long)kv * 4096 * 256, 4096, 256, (bf16_t*)(ws + OFF_WT_C1) + (long)kv * 256 * 4096, r & 255, 4, lds, tid); continue; } r -= P0_TR_C1;
        if (r < P0_TR_C2) { const int kv = r >> 3; p0_transpose_item(p.in[20] + (long)kv * 256 * 128, 256, 128, (bf16_t*)(ws + OFF_WT_C2) + (long)kv * 128 * 256, r & 7, 2, lds, tid); continue; } r -= P0_TR_C2;
        {
            const int tbl = r >> 11, sub = r & 2047;
            const int layer = tbl & 1;
            const float* src = (tbl < 2 ? p.in[28] : p.in[29]) + (long)layer * 16384 * 1024;
            unsigned char* dst = ws + (tbl < 2 ? OFF_PU : OFF_PV) + (long)layer * 16384 * 1024;
            float* sinv = (float*)(ws + (tbl < 2 ? OFF_USI : OFF_VSI)) + layer * 16384;
            p0_fp8_item(src, dst, sinv, tbl >= 2, sub, tid);
        }
    }
}

DI void norm_row_write(const f32x4 (&v)[4], float rstd, const float* gain, const float* shift, const float* scale, bf16_t* orow, int lane) {
#pragma unroll
    for (int j = 0; j < 4; ++j) {
        const int c = 4 * lane + 256 * j;
        const f32x4 g = *(const f32x4*)(gain + c), sh = *(const f32x4*)(shift + c), sc = *(const f32x4*)(scale + c);
        u32x2 o;
        o.x = pk2(v[j].x * rstd * g.x * (1.f + sc.x) + sh.x, v[j].y * rstd * g.y * (1.f + sc.y) + sh.y);
        o.y = pk2(v[j].z * rstd * g.z * (1.f + sc.z) + sh.z, v[j].w * rstd * g.w * (1.f + sc.w) + sh.w);
        *(u32x2*)(orow + c) = o;
    }
}
template <bool BF, bool XB>
DI void phase_norm_q8(const void* __restrict__ x, bf16_t* __restrict__ out, unsigned char* __restrict__ out8, float* __restrict__ outs,
                      const float* gain, const float* ada, int shift_off, int scale_off, int tid) {
    const int lane = tid & 63, gw = blockIdx.x * NWAVES + (tid >> 6), nw = gridDim.x * NWAVES;
    for (int tok = gw; tok < NTOK; tok += nw) {
        const int b = tok >> 13;
        f32x4 v[4]; float ss = 0.f;
#pragma unroll
        for (int j = 0; j < 4; ++j) { v[j] = ld4<XB>(x, (long)tok * DM + 4 * lane + 256 * j); ss += v[j].x * v[j].x + v[j].y * v[j].y + v[j].z * v[j].z + v[j].w * v[j].w; }
        const float rstd = rsqrtf(wave_sum(ss) * (1.f / DM) + EPS);
        const float* shift = ada + b * ADA_STRIDE + shift_off; const float* scale = ada + b * ADA_STRIDE + scale_off;
        float am = 0.f;
#pragma unroll
        for (int j = 0; j < 4; ++j) {
            const int c = 4 * lane + 256 * j;
            const f32x4 g = *(const f32x4*)(gain + c), sh = *(const f32x4*)(shift + c), sc = *(const f32x4*)(scale + c);
            v[j].x = v[j].x * rstd * g.x * (1.f + sc.x) + sh.x; v[j].y = v[j].y * rstd * g.y * (1.f + sc.y) + sh.y;
            v[j].z = v[j].z * rstd * g.z * (1.f + sc.z) + sh.z; v[j].w = v[j].w * rstd * g.w * (1.f + sc.w) + sh.w;
            if constexpr (BF) { u32x2 o; o.x = pk2(v[j].x, v[j].y); o.y = pk2(v[j].z, v[j].w); *(u32x2*)(out + (long)tok * DM + c) = o; }
            am = fmaxf(am, fmaxf(fmaxf(fabsf(v[j].x), fabsf(v[j].y)), fmaxf(fabsf(v[j].z), fabsf(v[j].w))));
        }
        am = wave_max(am);
        const float qs = am > 0.f ? 127.f / am : 1.f;
#pragma unroll
        for (int j = 0; j < 4; ++j) *(int*)(out8 + (long)tok * DM + 4 * lane + 256 * j) = pack_i8x4(v[j].x * qs, v[j].y * qs, v[j].z * qs, v[j].w * qs);
        if (lane == 0) outs[tok] = am > 0.f ? am * (1.f / 127.f) : 1.f;
    }
}
DI void phase_norm(const float* __restrict__ x, bf16_t* __restrict__ out, const float* gain, const float* ada, int shift_off, int scale_off, int tid) {
    const int lane = tid & 63, gw = blockIdx.x * NWAVES + (tid >> 6), nw = gridDim.x * NWAVES;
    for (int tok = gw; tok < NTOK; tok += nw) {
        const int b = tok >> 13;
        f32x4 v[4]; float ss = 0.f;
#pragma unroll
        for (int j = 0; j < 4; ++j) { v[j] = *(const f32x4*)(x + (long)tok * DM + 4 * lane + 256 * j); ss += v[j].x * v[j].x + v[j].y * v[j].y + v[j].z * v[j].z + v[j].w * v[j].w; }
        const float rstd = rsqrtf(wave_sum(ss) * (1.f / DM) + EPS);
        norm_row_write(v, rstd, gain, ada + b * ADA_STRIDE + shift_off, ada + b * ADA_STRIDE + scale_off, out + (long)tok * DM, lane);
    }
}

DI int kidx(int mt, int i) { return 32 * mt + 16 * (i >> 3) + (i & 7); }
template <int DQK>
DI void attn_qk32(const unsigned char* Ks, const bf16x8 (&qf)[DQK / 16], f32x16& st, int mt, int r, int h, float init = 0.f) {
    constexpr int RB = DQK * 2, MSK = DQK == 64 ? 7 : 15;
    const int row = 32 * mt + ((r & 0x13) | ((r & 4) << 1) | ((r & 8) >> 1));
#pragma unroll
    for (int i = 0; i < 16; ++i) st[i] = init;
#pragma unroll
    for (int ks = 0; ks < DQK / 16; ++ks) {
        const bf16x8 kf = RB == 128 ? *(const bf16x8*)(Ks + sw2(row, 2 * ks + h)) : *(const bf16x8*)(Ks + row * RB + (((2 * ks + h) ^ (row & MSK)) << 4));
        st = MFMA32(kf, qf[ks], st);
    }
}
DI void attn_pack32(const f32x16& st, bf16x8 (&pf)[2]) {
#pragma unroll
    for (int s = 0; s < 2; ++s) {
        u32x4 t;
        t.x = pk2(st[8 * s + 0], st[8 * s + 1]); t.y = pk2(st[8 * s + 2], st[8 * s + 3]);
        t.z = pk2(st[8 * s + 4], st[8 * s + 5]); t.w = pk2(st[8 * s + 6], st[8 * s + 7]);
        pf[s] = __builtin_bit_cast(bf16x8, t);
    }
}
DI void attn_softmax32(f32x16& st, float& m, float& l, f32x16 (&o)[4]) {
    float mx = st[0];
#pragma unroll
    for (int i = 1; i < 16; ++i) mx = fmaxf(mx, st[i]);
    mx = max_x32(mx);
    const float mn = fmaxf(m, mx);
    if (!__all(mn == m)) {
        const float alpha = fexp2(m - mn);
        l *= alpha;
#pragma unroll
        for (int dt = 0; dt < 4; ++dt)
#pragma unroll
            for (int i = 0; i < 16; ++i) o[dt][i] *= alpha;
        m = mn;
    }
    float sum = 0.f;
#pragma unroll
    for (int i = 0; i < 16; ++i) { const float pv = fexp2(st[i] - m); st[i] = pv; sum += pv; }
    l += sum;
}
DI void attn_softmax32_b(f32x16& st, float& l) {
    float sum = 0.f;
#pragma unroll
    for (int i = 0; i < 16; ++i) { const float pv = fexp2(st[i]); st[i] = pv; sum += pv; }
    l += sum;
}
DI void attn_pv32(const unsigned char* Vs, const bf16x8 (&pf)[2], f32x16 (&o)[4], int mt, int r, int h) {
#pragma unroll
    for (int dt = 0; dt < 4; ++dt)
#pragma unroll
        for (int s2 = 0; s2 < 2; ++s2) {
            const int row = 32 * dt + r;
            const bf16x8 vf = *(const bf16x8*)(Vs + sw2(row, 2 * (2 * mt + s2) + h));
            o[dt] = MFMA32(vf, pf[s2], o[dt]);
        }
}
template <int RB, int NROWS>
DI void dma_offsets(unsigned (&off)[NROWS * RB / 16 / 512], unsigned gstride, int tid) {
    constexpr int CPR = RB / 16;
#pragma unroll
    for (int i = 0; i < NROWS * CPR / 512; ++i) {
        const int idx = tid + 512 * i;
        int row, cp;
        if (RB == 128) sw2_src(idx, row, cp); else { row = idx / CPR; cp = (idx % CPR) ^ (row & (CPR - 1)); }
        off[i] = (unsigned)row * gstride + (cp << 4);
    }
}
template <int N>
DI void dma_issue(unsigned char* dst, const unsigned char* gbase, const unsigned (&off)[N], int tid) {
    const int wbase = tid & ~63;
#pragma unroll
    for (int i = 0; i < N; ++i)
        __builtin_amdgcn_global_load_lds((const unsigned*)(gbase + off[i]), (unsigned*)(dst + (wbase + 512 * i) * 16), 16, 0, 0);
}

constexpr int AT_STAGE = 32 * 1024;
constexpr int AT_LUT = 2 * AT_STAGE;
constexpr int LUT_N = 1280, LUT_OFF = 1100;
constexpr int LUTC_W = 52;
constexpr int AT_LUTC = AT_LUT + 20 * 1024;
constexpr int AT_IMP = AT_LUTC + 13 * 1024;
constexpr int AT_SEL = AT_IMP + 34 * 1024;

DI void phase_diff_attn(const Params& p, unsigned char* lds, int tid) {
    unsigned char* ws = p.ws;
    const bf16_t* Q = (const bf16_t*)(ws + OFF_Q0);
    const bf16_t* Kk = (const bf16_t*)(ws + OFF_K0);
    const bf16_t* VT = (const bf16_t*)(ws + OFF_VT0);
    bf16_t* O = (bf16_t*)(ws + OFF_H);
    const float* relb = p.in[2];
    const float* lam = p.in[9];
    const float* subln = p.in[12];
    const int lane = tid & 63, w = tid >> 6, comp = w & 1, qg = w >> 1, r = lane & 31, h = lane >> 5;
    float* lut = (float*)(lds + 128 * 1024);
    if (w >= 4) __builtin_amdgcn_s_setprio(1);
    float lam_full;
    {
        const float s01 = wave_sum(lam[lane] * lam[64 + lane]), s23 = wave_sum(lam[128 + lane] * lam[192 + lane]);
        lam_full = __expf(s01) - __expf(s23) + 0.2f;
    }
    const int G = gridDim.x, rows_per_it = G >> 5;
    unsigned koff[1], voff[2];
    dma_offsets<128, 64>(koff, 128, tid);
    dma_offsets<128, 128>(voff, SEQ * 2, tid);
    constexpr int ST2 = 64 * 1024;
    for (int it = 0;; ++it) {
        int qb, b, hd;
        if (G == 256) {
            if (it >= 8) break;
            const int xcd = blockIdx.x & 7, lb = blockIdx.x >> 3, pr = xcd * 4 + (it >> 1);
            qb = (it & 1) ? lb : 63 - lb; b = pr >> 3; hd = pr & 7;
        } else {
            int u;
            if ((G & 31) == 0) {
                const int rr = blockIdx.x >> 5, cc = blockIdx.x & 31;
                const int rowi = it * rows_per_it + ((it & 1) ? rows_per_it - 1 - rr : rr);
                u = rowi * 32 + cc;
            } else u = it * G + blockIdx.x;
            if (u >= 2048) break;
            qb = 63 - (u >> 5); b = (u & 31) >> 3; hd = u & 7;
        }
        const int q0 = qb * 128, ntiles = qb + 1;
        const int qpos = q0 + 32 * qg + r, qlo = q0 + 32 * qg, qhi = qlo + 31;
        for (int e = tid; e < LUT_N; e += NTHREADS) { const int d = LUT_OFF - e; lut[e] = d < 0 ? -INFINITY : (d >= 790 ? 0.f : (relb[rel_bucket_i(d) * 8 + hd] - relb[31 * 8 + hd]) * LOG2E); }
        bf16x8 qf[4];
        {
            const bf16_t* qrow = Q + ((long)((b * 8 + hd) * 2 + comp) * SEQ + qpos) * 64;
#pragma unroll
            for (int ks = 0; ks < 4; ++ks) qf[ks] = *(const bf16x8*)(qrow + 16 * ks + 8 * h);
        }
        const unsigned char* k0g = (const unsigned char*)(Kk + (long)((b * 8 + hd) * 2 + 0) * SEQ * 64);
        const unsigned char* k1g = (const unsigned char*)(Kk + (long)((b * 8 + hd) * 2 + 1) * SEQ * 64);
        const unsigned char* vtg = (const unsigned char*)(VT + (long)(b * 8 + hd) * 128 * SEQ);
        f32x16 o[4];
#pragma unroll
        for (int dt = 0; dt < 4; ++dt)
#pragma unroll
            for (int i = 0; i < 16; ++i) o[dt][i] = 0.f;
        float l = 0.f;
        const float nmb = -((const float*)(ws + OFF_MB0))[(long)((b * 8 + hd) * 2 + comp) * SEQ + qpos];
        auto stage = [&](int kt, unsigned char* st) {
#pragma unroll
            for (int sb = 0; sb < 2; ++sb) {
                dma_issue(st + sb * 8192, k0g + (long)(2 * kt + sb) * 8192, koff, tid);
                dma_issue(st + 16384 + sb * 8192, k1g + (long)(2 * kt + sb) * 8192, koff, tid);
                dma_issue(st + 32768 + sb * 16384, vtg + (long)(2 * kt + sb) * 128, voff, tid);
            }
        };
        stage(0, lds);
        __syncthreads();
        for (int kt = 0; kt < ntiles; ++kt) {
            unsigned char* cur = lds + (kt & 1) * ST2;
            if (kt + 1 < ntiles) stage(kt + 1, lds + ((kt + 1) & 1) * ST2);
            const bool nearb = qlo - (kt * 128 + 127) < 790;
            const int dbase0 = qpos - kt * 128 - 8 * h;
            const unsigned char* kb = cur + comp * 16384;
            f32x16 sa, sbv;
            attn_qk32<64>(kb, qf, sa, 0, r, h, nmb);
#pragma unroll
            for (int j = 0; j < 4; ++j) {
                f32x16& sc = (j & 1) ? sbv : sa;
                f32x16& sn = (j & 1) ? sa : sbv;
                if (j < 3) attn_qk32<64>(kb + ((j + 1) >> 1) * 8192, qf, sn, (j + 1) & 1, r, h, nmb);
                if (nearb) {
                    const float* lp = lut + (LUT_OFF - dbase0 + 64 * (j >> 1));
#pragma unroll
                    for (int i = 0; i < 16; ++i) sc[i] += lp[kidx(j & 1, i)];
                }
                attn_softmax32_b(sc, l);
                bf16x8 pf[2];
                attn_pack32(sc, pf);
                attn_pv32(cur + 32768 + (j >> 1) * 16384, pf, o, j & 1, r, h);
            }
            __syncthreads();
        }
        l = sum_x32(l);
        const float inv = l > 0.f ? frcp(l) : 0.f;
        float* xch = (float*)lds + qg * 4096;
        if (comp == 1) {
            const float sc = inv * lam_full;
#pragma unroll
            for (int dt = 0; dt < 4; ++dt)
#pragma unroll
                for (int i = 0; i < 16; ++i) xch[(dt * 16 + i) * 64 + lane] = o[dt][i] * sc;
        }
        __syncthreads();
        if (comp == 0) {
            float ss = 0.f;
#pragma unroll
            for (int dt = 0; dt < 4; ++dt)
#pragma unroll
                for (int i = 0; i < 16; ++i) { const float v = o[dt][i] * inv - xch[(dt * 16 + i) * 64 + lane]; o[dt][i] = v; ss += v * v; }
            ss = sum_x32(ss);
            const float rstd = rsqrtf(ss * (1.f / 128.f) + EPS) * 0.8f;
            bf16_t* orow = O + (long)(b * SEQ + qpos) * DM + hd * 128;
#pragma unroll
            for (int dt = 0; dt < 4; ++dt)
#pragma unroll
                for (int g4 = 0; g4 < 4; ++g4) {
                    const int d0 = 32 * dt + 8 * g4 + 4 * h;
                    const f32x4 gv = *(const f32x4*)(subln + d0);
                    u32x2 ov;
                    ov.x = pk2(o[dt][4 * g4 + 0] * rstd * gv.x, o[dt][4 * g4 + 1] * rstd * gv.y);
                    ov.y = pk2(o[dt][4 * g4 + 2] * rstd * gv.z, o[dt][4 * g4 + 3] * rstd * gv.w);
                    *(u32x2*)(orow + d0) = ov;
                }
        }
        __syncthreads();
    }
}

template <int VAR>
DI void phase_nsa_attn(const Params& p, unsigned char* lds, int tid) {
    unsigned char* ws = p.ws;
    const bf16_t* QN = (const bf16_t*)(ws + OFF_QN);
    const bf16_t* KS = (const bf16_t*)(ws + OFF_KS);
    const bf16_t* VST = (const bf16_t*)(ws + OFF_VST);
    const bf16_t* KW = (const bf16_t*)(ws + OFF_KW);
    const bf16_t* VWT = (const bf16_t*)(ws + OFF_VWT);
    const bf16_t* KCMP = (const bf16_t*)(ws + OFF_KCMP);
    const bf16_t* VCMPT = (const bf16_t*)(ws + OFF_VCMPT);
    const float* gates = (const float*)(ws + OFF_GATES);
    bf16_t* O = VAR ? (bf16_t*)(ws + OFF_PU + 32 * MB) : (bf16_t*)(ws + OFF_H);
    const float* relb = p.in[2];
    const int lane = tid & 63, w = tid >> 6, hg = w >> 1, th = w & 1, r = lane & 31, h = lane >> 5;
    float* lut = (float*)(lds + AT_LUT);
    float* lutc = (float*)(lds + AT_LUTC);
    float* imp = (float*)(lds + AT_IMP);
    unsigned* selw = (unsigned*)(lds + AT_SEL);
    unsigned short* sel16 = (unsigned short*)selw;
    float* bmxs = (float*)(selw + 264);
    const float* qnrm = (const float*)(ws + OFF_MB1);
    float kmx[3];
    for (int br = 0; br < 3; ++br) kmx[br] = wave_max(fmaxf(fabsf(p.in[21][br * 128 + lane]), fabsf(p.in[21][br * 128 + 64 + lane]))) * 11.313708498984761f;
    const int G = gridDim.x, rows_per_it = G >> 3;
    int lut_g = -1;
    for (int it = 0;; ++it) {
        int u;
        if ((G & 7) == 0) {
            const int rr = blockIdx.x >> 3, cc = blockIdx.x & 7;
            const int rowi = it * rows_per_it + ((it & 1) ? rows_per_it - 1 - rr : rr);
            u = rowi * 8 + cc;
        } else u = it * G + blockIdx.x;
        if (u >= 1024) break;
        const int bi = 127 - (u >> 3), b = (u & 7) >> 1, g = u & 1, head = 4 * g + hg;
        const int tq = 64 * bi + 32 * th + r;
        const int tl = 32 * th + r;
        const long tok = (long)b * SEQ + tq;
        if (g != lut_g) {
            lut_g = g;
            if (tid < 128) {
                const int hh = tid >> 5, bk = tid & 31;
                float bm = fmaxf(0.f, relb[bk * 8 + 4 * g + hh] - relb[31 * 8 + 4 * g + hh]);
                bm = fmaxf(bm, lx1(bm)); bm = fmaxf(bm, lx2(bm)); bm = fmaxf(bm, lhm(bm)); bm = fmaxf(bm, lr8(bm)); bm = max_x16(bm);
                if (bk == 0) bmxs[hh] = bm * LOG2E;
            }
            for (int e = tid; e < 4 * LUT_N; e += NTHREADS) { const int hh = e / LUT_N, d = LUT_OFF - (e % LUT_N); lut[e] = d < 0 ? -INFINITY : (d >= 790 ? 0.f : (relb[rel_bucket_i(d) * 8 + 4 * g + hh] - relb[31 * 8 + 4 * g + hh]) * LOG2E); }
            for (int e = tid; e < 4 * 16 * LUTC_W; e += NTHREADS) {
                const int hh = e / (16 * LUTC_W), ph = (e / LUTC_W) & 15, ci = e % LUTC_W, d = 16 * (ci - 1) + ph;
                lutc[e] = ci == 0 ? -INFINITY : (d >= 790 ? 0.f : (relb[rel_bucket_i(d) * 8 + 4 * g + hh] - relb[31 * 8 + 4 * g + hh]) * LOG2E);
            }
        }
        if (tid < 4) selw[256 + tid] = 0u;
        const float* mylut = lut + hg * LUT_N;
        bf16x8 qf[8];
        const bf16_t* qrow = QN + ((long)(b * 8 + head) * SEQ + tq) * 128 + 8 * h;
        auto load_q = [&](const bf16_t* qr) {
#pragma unroll
            for (int ks = 0; ks < 8; ++ks) qf[ks] = *(const bf16x8*)(qr + 16 * ks);
        };
        const float* gp = gates + tok * 24 + head * 3;
        bf16_t* orow = O + (VAR ? (tok & 16383) : tok) * DM + head * 128;
        auto stage = [&](const unsigned char* kg, const unsigned char* vg, unsigned vstride, int kt, unsigned char* st) {
            int t2 = tid; asm volatile("" : "+v"(t2));
            unsigned koff[2], vo[2];
            dma_offsets<256, 64>(koff, 256, t2);
            dma_offsets<128, 128>(vo, vstride, t2);
            dma_issue(st, kg + (long)kt * 16384, koff, t2);
            dma_issue(st + 16384, vg + (long)kt * 128, vo, t2);
        };
        f32x16 o[4];
        float l;
        auto reset = [&]() {
#pragma unroll
            for (int dt = 0; dt < 4; ++dt)
#pragma unroll
                for (int i = 0; i < 16; ++i) o[dt][i] = 0.f;
            l = 0.f;
        };
        const unsigned char* kcg = (const unsigned char*)(KCMP + (long)(b * 2 + g) * 512 * 128);
        const unsigned char* vcg = (const unsigned char*)(VCMPT + (long)(b * 2 + g) * 128 * 512);
        const int nct = ((4 * bi + 2) >> 6) + 1;
        const int hgc = r & 3, tlc = 8 * w + (r >> 2), tqc = 64 * bi + tlc;
        const long tokc = (long)b * SEQ + tqc;
        reset();
        load_q(QN + ((long)(b * 8 + 4 * g + hgc) * SEQ + tqc) * 128 + 8 * h);
        __syncthreads();
        if (VAR != 3) {
            const int cb = (tqc - 31) >> 4;
            const int cfar = ((64 * bi + 8 * w - 31) >> 4) - 8 - 23;
            const float* lc = lutc + (hgc * 16 + ((tqc - 31) & 15)) * LUTC_W + 1;
            const float nmb = -(qnrm[tokc * 8 + 4 * g + hgc] * kmx[0] + bmxs[hgc]);
            stage(kcg, vcg, 1024u, 0, lds);
            __syncthreads();
            for (int kt = 0; kt < nct; ++kt) {
                unsigned char* cur = lds + (kt & 1) * AT_STAGE;
                if (kt + 1 < nct) stage(kcg, vcg, 1024u, kt + 1, lds + ((kt + 1) & 1) * AT_STAGE);
                const int cbase = cb - kt * 64 - 8 * h;
#pragma unroll
                for (int mt = 0; mt < 2; ++mt) {
                    f32x16 st;
                    attn_qk32<128>(cur, qf, st, mt, r, h, nmb);
                    float sum = 0.f;
                    if (cfar - kt * 64 - 32 * mt >= 50) {
#pragma unroll
                        for (int i = 0; i < 16; ++i) sum += fexp2(st[i]);
                    } else {
#pragma unroll
                        for (int i = 0; i < 16; ++i) {
                            const int c = cbase - kidx(mt, i);
                            sum += fexp2(st[i] + lc[c < -1 ? -1 : (c > 50 ? 50 : c)]);
                        }
                    }
                    l += sum;
                }
                __syncthreads();
            }
            const float lt = sum_x32(l);
            const float invl = lt > 0.f ? frcp(lt) : 0.f;
            stage(kcg, vcg, 1024u, 0, lds);
            __syncthreads();
            float carry = 0.f;
            for (int kt = 0; kt < nct; ++kt) {
                unsigned char* cur = lds + (kt & 1) * AT_STAGE;
                if (kt + 1 < nct) stage(kcg, vcg, 1024u, kt + 1, lds + ((kt + 1) & 1) * AT_STAGE);
                const int cbase = cb - kt * 64 - 8 * h;
                float o0[4], o1[4], sp[4];
#pragma unroll
                for (int mt = 0; mt < 2; ++mt) {
                    f32x16 st;
                    attn_qk32<128>(cur, qf, st, mt, r, h, nmb);
                    if (cfar - kt * 64 - 32 * mt >= 50) {
#pragma unroll
                        for (int i = 0; i < 16; ++i) st[i] = fexp2(st[i]) * invl;
                    } else {
#pragma unroll
                        for (int i = 0; i < 16; ++i) {
                            const int c = cbase - kidx(mt, i);
                            st[i] = fexp2(st[i] + lc[c < -1 ? -1 : (c > 50 ? 50 : c)]) * invl;
                        }
                    }
#pragma unroll
                    for (int gq = 0; gq < 2; ++gq) {
                        const int G2 = 2 * mt + gq, q0 = 2 * gq, q1 = 2 * gq + 1;
                        const float c20 = 0.5f * st[4 * q0 + 3];
                        o0[G2] = st[4 * q0] + st[4 * q0 + 1] + st[4 * q0 + 2] + c20;
                        o1[G2] = st[4 * q1] + st[4 * q1 + 1] + st[4 * q1 + 2] + 0.5f * st[4 * q1 + 3] + c20;
                        sp[G2] = 0.5f * st[4 * q1 + 3];
                    }
                    bf16x8 pf[2];
                    attn_pack32(st, pf);
                    attn_pv32(cur + 16384, pf, o, mt, r, h);
                }
                float rc[4];
#pragma unroll
                for (int G2 = 0; G2 < 4; ++G2) rc[G2] = __uint_as_float(get_x32(__float_as_uint(sp[G2]), h));
                if (h) {
#pragma unroll
                    for (int G2 = 0; G2 < 4; ++G2) o0[G2] += rc[G2];
                } else {
                    o0[0] += carry; o0[1] += rc[0]; o0[2] += rc[1]; o0[3] += rc[2];
                    carry = rc[3];
                }
#pragma unroll
                for (int G2 = 0; G2 < 4; ++G2) {
                    float a0 = o0[G2], a1 = o1[G2];
                    a0 += lx1(a0); a0 += lx2(a0); a1 += lx1(a1); a1 += lx2(a1);
                    if (hgc == 0) *(f32x2*)(imp + tlc * 130 + kt * 16 + 4 * G2 + 2 * h) = (f32x2){a0, a1};
                }
                __syncthreads();
            }
        }
        {
            const float g_c = gates[tokc * 24 + (4 * g + hgc) * 3];
            bf16_t* orc = O + (VAR ? (tokc & 16383) : tokc) * DM + (4 * g + hgc) * 128;
#pragma unroll
            for (int dt = 0; dt < 4; ++dt)
#pragma unroll
                for (int g4 = 0; g4 < 4; ++g4) {
                    const int d0 = 32 * dt + 8 * g4 + 4 * h;
                    u32x2 ov;
                    ov.x = pk2(o[dt][4 * g4 + 0] * g_c, o[dt][4 * g4 + 1] * g_c);
                    ov.y = pk2(o[dt][4 * g4 + 2] * g_c, o[dt][4 * g4 + 3] * g_c);
                    *(u32x2*)(orc + d0) = ov;
                }
        }
        if (VAR != 5) {
            const int tkn = tid >> 3, part = tid & 7;
            unsigned key[16];
#pragma unroll
            for (int q = 0; q < 16; ++q) {
                const int j = part * 16 + q;
                float v = imp[tkn * 130 + j];
                const int back = bi - j;
                if (j == 0 || (back >= 0 && back < 2)) v = 1e9f;
                if (back < 0) v = -1e30f;
                key[q] = f2key(v);
            }
            unsigned srt[16];
#pragma unroll
            for (int q = 0; q < 16; ++q) { key[q] = (key[q] & ~127u) | (unsigned)(127 - (part * 16 + q)); srt[q] = key[q]; }
            sort16_desc(srt);
            {
                unsigned pr[16];
#pragma unroll
                for (int q = 0; q < 16; ++q) pr[q] = (unsigned)__builtin_amdgcn_update_dpp(0, (int)srt[q], 0xB1, 0xF, 0xF, true);
                merge_top16(srt, pr);
#pragma unroll
                for (int q = 0; q < 16; ++q) pr[q] = (unsigned)__builtin_amdgcn_update_dpp(0, (int)srt[q], 0x4E, 0xF, 0xF, true);
                merge_top16(srt, pr);
#pragma unroll
                for (int q = 0; q < 16; ++q) pr[q] = (unsigned)__builtin_amdgcn_update_dpp(0, (int)srt[q], 0x141, 0xF, 0xF, true);
                merge_top16(srt, pr);
            }
            const unsigned T16 = srt[15];
            unsigned bits = 0;
#pragma unroll
            for (int q = 0; q < 16; ++q) bits |= (key[q] >= T16 && key[q] >= 0x80000000u) ? (1u << q) : 0u;
            sel16[tkn * 8 + part] = (unsigned short)bits;
            atomicOr(&selw[256 + (part >> 1)], bits << ((part & 1) * 16));
        }
        __syncthreads();
        const unsigned un0 = selw[256], un1 = selw[257], un2 = selw[258], un3 = selw[259];
        const unsigned char* ksg = (const unsigned char*)(KS + (long)(b * 2 + g) * SEQ * 128);
        const unsigned char* vsg = (const unsigned char*)(VST + (long)(b * 2 + g) * 128 * SEQ);
        reset(); load_q(qrow);
        const float qn_main = qnrm[tok * 8 + head];
        {
            const float nmb = -(qn_main * kmx[1] + bmxs[hg]);
            const unsigned long long ulo = ((unsigned long long)(unsigned)__builtin_amdgcn_readfirstlane((int)un1) << 32) | (unsigned)__builtin_amdgcn_readfirstlane((int)un0);
            const unsigned long long uhi = ((unsigned long long)(unsigned)__builtin_amdgcn_readfirstlane((int)un3) << 32) | (unsigned)__builtin_amdgcn_readfirstlane((int)un2);
            auto next_tile = [&](int from) -> int {
                if (from < 64) { const unsigned long long mk = ulo >> from; if (mk) return from + __builtin_ctzll(mk); from = 64; }
                if (from < 128) { const unsigned long long mk = uhi >> (from - 64); if (mk) return from + __builtin_ctzll(mk); }
                return 128;
            };
            int jt = (VAR == 1 || VAR == 4 || VAR == 5) ? 128 : next_tile(0);
            int buf = 0;
            if (jt < 128) stage(ksg, vsg, SEQ * 2u, jt, lds);
            __syncthreads();
            while (jt < 128) {
                unsigned char* cur = lds + buf * AT_STAGE;
                const int jn = next_tile(jt + 1);
                if (jn < 128) stage(ksg, vsg, SEQ * 2u, jn, lds + (buf ^ 1) * AT_STAGE);
                const unsigned wd = selw[tl * 4 + (jt >> 5)];
                const bool mysel = (wd >> (jt & 31)) & 1u;
                if (__any(mysel)) {
                    const int k0 = jt * 64;
                    const bool nearb = (64 * bi + 32 * th) - (k0 + 63) < 790;
                    const int dbase = tq - k0 - 8 * h;
                    const float* lp = mylut + (LUT_OFF - dbase);
#pragma unroll
                    for (int mt = 0; mt < 2; ++mt) {
                        f32x16 st;
                        attn_qk32<128>(cur, qf, st, mt, r, h, mysel ? nmb : -INFINITY);
                        if (nearb) {
#pragma unroll
                            for (int i = 0; i < 16; ++i) st[i] += lp[kidx(mt, i)];
                        }
                        attn_softmax32_b(st, l);
                        bf16x8 pf[2];
                        attn_pack32(st, pf);
                        attn_pv32(cur + 16384, pf, o, mt, r, h);
                    }
                }
                __syncthreads();
                buf ^= 1; jt = jn;
            }
        }
        {
            const float lt = sum_x32(l);
            const float sc = (lt > 0.f ? frcp(lt) : 0.f) * gp[1];
#pragma unroll
            for (int dt = 0; dt < 4; ++dt)
#pragma unroll
                for (int g4 = 0; g4 < 4; ++g4) {
                    const int d0 = 32 * dt + 8 * g4 + 4 * h;
                    const u32x2 pv = *(const u32x2*)(orow + d0);
                    u32x2 ov;
                    ov.x = pk2(bflo(pv.x) + o[dt][4 * g4 + 0] * sc, bfhi(pv.x) + o[dt][4 * g4 + 1] * sc);
                    ov.y = pk2(bflo(pv.y) + o[dt][4 * g4 + 2] * sc, bfhi(pv.y) + o[dt][4 * g4 + 3] * sc);
                    *(u32x2*)(orow + d0) = ov;
                }
        }
        const unsigned char* kwg = (const unsigned char*)(KW + (long)(b * 2 + g) * SEQ * 128);
        const unsigned char* vwg = (const unsigned char*)(VWT + (long)(b * 2 + g) * 128 * SEQ);
        reset(); load_q(qrow);
        {
            const float nmb = -(qn_main * kmx[2] + bmxs[hg]);
            const int j0 = bi >= 8 ? bi - 8 : 0, nt = (VAR == 2 || VAR == 4 || VAR == 5) ? 1 : bi - j0 + 1;
            stage(kwg, vwg, SEQ * 2u, j0, lds);
            __syncthreads();
            for (int kt = 0; kt < nt; ++kt) {
                unsigned char* cur = lds + (kt & 1) * AT_STAGE;
                if (kt + 1 < nt) stage(kwg, vwg, SEQ * 2u, j0 + kt + 1, lds + ((kt + 1) & 1) * AT_STAGE);
                const int k0 = (j0 + kt) * 64;
                const int dbase = tq - k0 - 8 * h;
                const float* lp = mylut + (LUT_OFF - dbase);
#pragma unroll
                for (int mt = 0; mt < 2; ++mt) {
                    f32x16 st;
                    attn_qk32<128>(cur, qf, st, mt, r, h, nmb);
                    if (kt == 0 && bi >= 8) {
#pragma unroll
                        for (int i = 0; i < 16; ++i) st[i] = kidx(mt, i) <= dbase - 512 ? -INFINITY : st[i] + lp[kidx(mt, i)];
                    } else {
#pragma unroll
                        for (int i = 0; i < 16; ++i) st[i] += lp[kidx(mt, i)];
                    }
                    attn_softmax32_b(st, l);
                    bf16x8 pf[2];
                    attn_pack32(st, pf);
                    attn_pv32(cur + 16384, pf, o, mt, r, h);
                }
                __syncthreads();
            }
        }
        {
            const float lt = sum_x32(l);
            const float sc = (lt > 0.f ? frcp(lt) : 0.f) * gp[2];
#pragma unroll
            for (int dt = 0; dt < 4; ++dt)
#pragma unroll
                for (int g4 = 0; g4 < 4; ++g4) {
                    const int d0 = 32 * dt + 8 * g4 + 4 * h;
                    const u32x2 pv = *(const u32x2*)(orow + d0);
                    u32x2 ov;
                    ov.x = pk2(bflo(pv.x) + o[dt][4 * g4 + 0] * sc, bfhi(pv.x) + o[dt][4 * g4 + 1] * sc);
                    ov.y = pk2(bflo(pv.y) + o[dt][4 * g4 + 2] * sc, bfhi(pv.y) + o[dt][4 * g4 + 3] * sc);
                    *(u32x2*)(orow + d0) = ov;
                }
        }
        __syncthreads();
    }
}

DI void fp8x16_fma(const u32x4& q, const f32x4& h0, const f32x4& h1, const f32x4& h2, const f32x4& h3, f32x2& a0, f32x2& a1) {
    a0 += __builtin_amdgcn_cvt_pk_f32_fp8((int)q.x, false) * (f32x2){h0.x, h0.y};
    a1 += __builtin_amdgcn_cvt_pk_f32_fp8((int)q.x, true)  * (f32x2){h0.z, h0.w};
    a0 += __builtin_amdgcn_cvt_pk_f32_fp8((int)q.y, false) * (f32x2){h1.x, h1.y};
    a1 += __builtin_amdgcn_cvt_pk_f32_fp8((int)q.y, true)  * (f32x2){h1.z, h1.w};
    a0 += __builtin_amdgcn_cvt_pk_f32_fp8((int)q.z, false) * (f32x2){h2.x, h2.y};
    a1 += __builtin_amdgcn_cvt_pk_f32_fp8((int)q.z, true)  * (f32x2){h2.z, h2.w};
    a0 += __builtin_amdgcn_cvt_pk_f32_fp8((int)q.w, false) * (f32x2){h3.x, h3.y};
    a1 += __builtin_amdgcn_cvt_pk_f32_fp8((int)q.w, true)  * (f32x2){h3.z, h3.w};
}
#ifndef UMASK
#define UMASK 0xffffffffu
#endif
template <bool DRY>
DI void phase_peer_u(const Params& p, int layer, unsigned char* lds, int tid) {
    unsigned char* ws = p.ws;
    const unsigned char* H8 = ws + OFF_H8;
    const float* HS = (const float*)(ws + OFF_HS);
    const int* ridx = (const int*)(ws + OFF_RIDX);
    float* rgate = (float*)(ws + OFF_RGATE);
    const unsigned char* U = ws + OFF_PU + (long)layer * 16384 * 1024;
    const __amdgpu_buffer_rsrc_t urs = __builtin_amdgcn_make_buffer_rsrc((void*)U, (short)0, 16384 * 1024, 0x00020000);
    const float* usi = (const float*)(ws + OFF_USI) + layer * 16384;
    const float* vsi = (const float*)(ws + OFF_VSI) + layer * 16384;
    const int lane = tid & 63, w = __builtin_amdgcn_readfirstlane(tid >> 6), sub = lane & 7, grp = lane >> 3;
    const int xg = blockIdx.x & 7, lb = blockIdx.x >> 3, nwv = (gridDim.x >> 3) * NWAVES, wv = lb * NWAVES + w;
    unsigned* clb = (unsigned*)(lds + w * 12288);
    unsigned char* hbb = lds + w * 12288 + 4096;
    const unsigned long long lt = (1ull << lane) - 1ull;
    if (lb >= (int)(gridDim.x >> 3)) return;
    int i0, i1; unsigned g0, g1; u32x4 h0; float hs0;
    auto ld_tok = [&](int tk) {
        tk = tk < NTOK ? tk : wv;
        i0 = ridx[(long)tk * 128 + lane]; i1 = ridx[(long)tk * 128 + 64 + lane];
        g0 = __float_as_uint(rgate[(long)tk * 128 + lane]); g1 = __float_as_uint(rgate[(long)tk * 128 + 64 + lane]);
        h0 = *(const u32x4*)(H8 + (long)tk * DM + lane * 16); hs0 = HS[tk];
    };
    bool sb0, sb1; int sk0, sk1; float su0, sv0, su1, sv1;
    auto stage_tok = [&](int bi) -> int {
        unsigned* cl = clb + bi * 512; unsigned char* hb = hbb + bi * 4096;
        const bool b0 = (i0 >> 11) == xg, b1 = (i1 >> 11) == xg;
        const unsigned long long m0 = __ballot(b0), m1 = __ballot(b1);
        const int n0 = __popcll(m0), n = n0 + __popcll(m1);
        sb0 = b0; sb1 = b1; sk0 = __popcll(m0 & lt); sk1 = n0 + __popcll(m1 & lt);
        if (b0) { *(u32x4*)(cl + 4 * sk0) = (u32x4){(unsigned)lane, (unsigned)i0, g0, 0u}; su0 = usi[i0]; sv0 = vsi[i0]; }
        if (b1) { *(u32x4*)(cl + 4 * sk1) = (u32x4){(unsigned)(64 + lane), (unsigned)i1, g1, 0u}; su1 = usi[i1]; sv1 = vsi[i1]; }
        if (n == 0 && lane == 0) *(u32x4*)cl = (u32x4){0u, 0u, 0u, 0u};
        *(u32x4*)(hb + lane * 16) = h0;
        if (lane == 0) *(float*)(hb + 1024) = hs0;
        return n;
    };
    auto flush_scales = [&](int bi) {
        float* cs = (float*)(hbb + bi * 4096 + 1536);
        if (sb0) *(f32x2*)(cs + 2 * sk0) = (f32x2){su0, sv0};
        if (sb1) *(f32x2*)(cs + 2 * sk1) = (f32x2){su1, sv1};
    };
    ld_tok(wv);
    int nC = stage_tok(0);
    flush_scales(0);
    ld_tok(wv + nwv);
    int slotC, idC; bool validC; float g_in;
    { validC = grp < nC; const int kk = validC ? grp : 0; const u32x4 e = *(const u32x4*)(clb + 4 * kk); slotC = e.x; idC = e.y; g_in = __uint_as_float(e.z); }
    u32x4 uv[8];
    {
        const unsigned uoff = validC ? (unsigned)idC * 1024u + (unsigned)sub * 16u : 0x40000000u;
#pragma unroll
        for (int t = 0; t < 8; ++t) { uv[t] = __builtin_bit_cast(u32x4, __builtin_amdgcn_raw_buffer_load_b128(urs, (int)(uoff + t * 128), 0, 0)); __builtin_amdgcn_sched_barrier(0); }
    }
    int it = 0;
    for (int tok = wv; tok < NTOK; tok += nwv, ++it) {
        const int cb = it & 1;
        const unsigned* clC = clb + cb * 512; const unsigned* clN = clb + (cb ^ 1) * 512;
        const unsigned char* hbC = hbb + cb * 4096;
        const bool more = tok + nwv < NTOK;
        const int nN = stage_tok(cb ^ 1); ld_tok(tok + 2 * nwv);
        const float shC = *(const float*)(hbC + 1024);
        const int nr = nC > 8 ? (nC + 7) >> 3 : 1;
        u32x4 hq[8];
#pragma unroll
        for (int t = 0; t < 8; ++t) hq[t] = *(const u32x4*)(hbC + (sub + 8 * t) * 16);
        auto do_round = [&](int rd) {
            const f32x2 s2 = *(const f32x2*)(hbC + 1536 + 8 * (validC ? 8 * rd + grp : 0));
            int slotN, idN; bool validN; float g_inN;
            {
                u32x4 e;
                if (rd + 1 < nr) { const int k = 8 * (rd + 1) + grp; validN = k < nC; e = *(const u32x4*)(clC + 4 * (validN ? k : 0)); }
                else if (more) { validN = grp < nN; e = *(const u32x4*)(clN + 4 * (validN ? grp : 0)); }
                else { validN = false; e = *(const u32x4*)clC; }
                slotN = e.x; idN = e.y; g_inN = __uint_as_float(e.z);
            }
            const unsigned uoffN = validN ? ((unsigned)idN & (DRY ? UMASK : 0xffffffffu)) * 1024u + (unsigned)sub * 16u : 0x40000000u;
            __builtin_amdgcn_sched_barrier(0);
            int a0 = 0, a1 = 0, a2 = 0, a3 = 0;
#pragma unroll
            for (int t = 0; t < 8; ++t) {
                const u32x4 q = uv[t];
                a0 = __builtin_amdgcn_sdot4((int)q.x, (int)hq[t].x, a0, false); a1 = __builtin_amdgcn_sdot4((int)q.y, (int)hq[t].y, a1, false);
                a2 = __builtin_amdgcn_sdot4((int)q.z, (int)hq[t].z, a2, false); a3 = __builtin_amdgcn_sdot4((int)q.w, (int)hq[t].w, a3, false);
                uv[t] = __builtin_bit_cast(u32x4, __builtin_amdgcn_raw_buffer_load_b128(urs, (int)(uoffN + t * 128), 0, 0));
                __builtin_amdgcn_sched_barrier(0);
            }
            int di = (a0 + a1) + (a2 + a3);
            di += __builtin_amdgcn_update_dpp(0, di, 0xB1, 0xF, 0xF, true);
            di += __builtin_amdgcn_update_dpp(0, di, 0x4E, 0xF, 0xF, true);
            di += __builtin_amdgcn_update_dpp(0, di, 0x141, 0xF, 0xF, true);
            if (validC && sub == 0) {
                float* gw = DRY ? (float*)(ws + OFF_R) + (long)tok * 128 + slotC : rgate + (long)tok * 128 + slotC;
                *gw = g_in * gelu_tanh((float)di * s2.x * shC) * s2.y;
            }
            slotC = slotN; idC = idN; validC = validN; g_in = g_inN;
        };
        do_round(0);
        for (int rd = 1; rd < nr; ++rd) do_round(rd);
        flush_scales(cb ^ 1);
        nC = nN;
    }
}

#ifndef VMASK
#define VMASK 0xffffffffu
#endif
#ifndef V_MFMA
#define V_MFMA 1
#endif
#define LAS __attribute__((address_space(3)))
typedef int v2i_t __attribute__((ext_vector_type(2)));
template <bool DRY>
DI void phase_peer_v(const Params& p, int layer, unsigned char* lds, int tid) {
    unsigned char* ws = p.ws;
    const int* ridx = (const int*)(ws + OFF_RIDX);
    const float* wact = (const float*)(ws + OFF_RGATE);
    const float* ada = (const float*)(ws + OFF_ADA);
    float* xo = opq(p.out);
    bf16_t* x = (bf16_t*)(ws + OFF_XB);
    const int lane = tid & 63, w = __builtin_amdgcn_readfirstlane(tid >> 6), sub = lane & 7, eg = lane >> 3;
    const int xg = blockIdx.x & 7, lb = blockIdx.x >> 3, nwv = (gridDim.x >> 3) * NWAVES, wv = lb * NWAVES + w;
    if (lb >= (int)(gridDim.x >> 3)) return;
    const unsigned char* Vc = ws + OFF_PV + ((long)(layer * 8 + xg) * 16384) * 128;
    unsigned char* gr = lds + w * 16384;
    unsigned* ring = (unsigned*)(lds + 128 * 1024 + w * 3072);
    int ia, ib; float wa, wb;
    auto ld_tokv = [&](int tk) {
        tk = tk < NTOK ? tk : wv;
        ia = ridx[(long)tk * 128 + lane]; ib = ridx[(long)tk * 128 + 64 + lane];
        wa = wact[(long)tk * 128 + lane]; wb = wact[(long)tk * 128 + 64 + lane];
    };
    auto st_ring = [&](int slot) {
        unsigned* rs = ring + slot * 256;
        rs[lane] = (unsigned)ia; rs[64 + lane] = (unsigned)ib; rs[128 + lane] = __float_as_uint(wa); rs[192 + lane] = __float_as_uint(wb);
    };
    auto rd_ids = [&](int slot, u32x4 (&a)[4]) {
        const u32x4* ip = (const u32x4*)(ring + slot * 256 + eg * 16);
#pragma unroll
        for (int q = 0; q < 4; ++q) a[q] = ip[q];
    };
    auto issue = [&](int j, const u32x4 (&a)[4]) {
#pragma unroll
        for (int i = 0; i < 4; ++i) {
            const int g = 4 * (i & 1) + (eg >> 1);
            const unsigned src = (a[j][i] & (DRY ? VMASK : 0xffffffffu)) * 128u + (unsigned)((sub ^ g) << 4);
            __builtin_amdgcn_global_load_lds((const unsigned*)(Vc + src), (unsigned*)(gr + j * 4096 + i * 1024), 16, 0, 0);
        }
    };
    const int col0 = 128 * xg + 16 * sub;
    ld_tokv(wv); st_ring(0);
    ld_tokv(wv + nwv); st_ring(1);
    ld_tokv(wv + 2 * nwv);
    {
        u32x4 a[4];
        rd_ids(0, a);
#pragma unroll
        for (int j = 0; j < 4; ++j) issue(j, a);
    }
#if V_MFMA
    unsigned char* wb8 = lds + 152 * 1024 + w * 256;
    const int m16 = lane & 15, q4 = lane >> 4;
    int boff[8];
    {
        const int rowL = 8 * q4 + (m16 >> 1), gL = (rowL >> 1) & 7;
#pragma unroll
        for (int nt = 0; nt < 8; ++nt) boff[nt] = rowL * 128 + ((nt ^ gL) << 4) + 8 * (m16 & 1);
    }
    unsigned baddr[8];
    const unsigned gr3 = (unsigned)(unsigned long)(LAS unsigned char*)gr;
#pragma unroll
    for (int nt = 0; nt < 8; ++nt) baddr[nt] = gr3 + (unsigned)boff[nt];
    const unsigned aaddr = (unsigned)(unsigned long)(LAS unsigned char*)wb8 + (unsigned)((m16 & 1) * 128 + 8 * q4);
    float xv[8], gfv[8]; int gb = -1;
    const int colx = 128 * xg + m16;
    if (lane < 16) {
#pragma unroll
        for (int nt = 0; nt < 8; ++nt) xv[nt] = bflo((unsigned)x[(long)wv * DM + colx + 16 * nt]);
    }
#else
    f32x4 gfv[4]; int gb = -1;
    f32x4 xv[4];
    if (eg == 0) {
#pragma unroll
        for (int c = 0; c < 4; ++c) xv[c] = *(const f32x4*)(x + (long)wv * DM + col0 + 4 * c);
    }
#endif
    int it = 0, s3 = 0;
    for (int tok = wv; tok < NTOK; tok += nwv, ++it) {
        const int sl0 = s3, sl1 = s3 == 2 ? 0 : s3 + 1, sl2 = s3 == 0 ? 2 : s3 - 1;
        st_ring(sl2);
        ld_tokv(tok + 3 * nwv);
        u32x4 na[4];
        rd_ids(sl1, na);
        {
            const int b = tok >> 13;
            if (b != gb) {
                gb = b;
#if V_MFMA
                if (lane < 16) {
#pragma unroll
                    for (int nt = 0; nt < 8; ++nt) gfv[nt] = ada[b * ADA_STRIDE + layer * 6144 + 5 * 1024 + colx + 16 * nt];
                }
#else
                const float* gf = ada + b * ADA_STRIDE + layer * 6144 + 5 * 1024 + col0;
#pragma unroll
                for (int c = 0; c < 4; ++c) gfv[c] = *(const f32x4*)(gf + 4 * c);
#endif
                asm volatile("s_waitcnt vmcnt(0)" ::: "memory");
            }
        }
#if V_MFMA
        float invS;
        {
            const float w0 = __uint_as_float(ring[sl0 * 256 + 128 + lane]), w1 = __uint_as_float(ring[sl0 * 256 + 192 + lane]);
            const float mx = wave_max(fmaxf(fabsf(w0), fabsf(w1)));
            int ex = (int)((__float_as_uint(mx) >> 23) & 255u) - 127;
            ex = ex < -100 ? -100 : ex;
            const float S = __uint_as_float((unsigned)(127 + 7 - ex) << 23);
            invS = __uint_as_float((unsigned)(127 - 7 + ex) << 23);
            const float a0 = w0 * S, a1 = w1 * S;
            const int hi = __builtin_amdgcn_cvt_pk_fp8_f32(a0, a1, 0, false);
            const f32x2 hf = __builtin_amdgcn_cvt_pk_f32_fp8(hi, false);
            const int lo = __builtin_amdgcn_cvt_pk_fp8_f32(a0 - hf.x, a1 - hf.y, 0, false);
            const int p0 = 8 * (lane & 15) + (lane >> 4);
            wb8[p0] = (unsigned char)(hi & 255); wb8[p0 + 4] = (unsigned char)((hi >> 8) & 255);
            wb8[128 + p0] = (unsigned char)(lo & 255); wb8[128 + p0 + 4] = (unsigned char)((lo >> 8) & 255);
        }
        f32x4 d[8];
#pragma unroll
        for (int nt = 0; nt < 8; ++nt) d[nt] = (f32x4){0.f, 0.f, 0.f, 0.f};
#pragma unroll
        for (int j = 0; j < 4; ++j) {
            asm volatile("s_waitcnt vmcnt(24)" ::: "memory");
            v2i_t aq, b0, b1, b2, b3, b4, b5, b6, b7;
            asm volatile("ds_read_b64 %0, %9 offset:%18\n\t"
                         "ds_read_b64_tr_b8 %1, %10 offset:%19\n\tds_read_b64_tr_b8 %2, %11 offset:%19\n\t"
                         "ds_read_b64_tr_b8 %3, %12 offset:%19\n\tds_read_b64_tr_b8 %4, %13 offset:%19\n\t"
                         "ds_read_b64_tr_b8 %5, %14 offset:%19\n\tds_read_b64_tr_b8 %6, %15 offset:%19\n\t"
                         "ds_read_b64_tr_b8 %7, %16 offset:%19\n\tds_read_b64_tr_b8 %8, %17 offset:%19\n\t"
                         "s_waitcnt lgkmcnt(0)"
                         : "=&v"(aq), "=&v"(b0), "=&v"(b1), "=&v"(b2), "=&v"(b3), "=&v"(b4), "=&v"(b5), "=&v"(b6), "=&v"(b7)
                         : "v"(aaddr), "v"(baddr[0]), "v"(baddr[1]), "v"(baddr[2]), "v"(baddr[3]), "v"(baddr[4]), "v"(baddr[5]), "v"(baddr[6]), "v"(baddr[7]),
                           "i"(32 * j), "i"(4096 * j)
                         : "memory");
            long a8 = ((long)(unsigned)aq.y << 32) | (unsigned)aq.x;
            a8 = m16 < 2 ? a8 : 0l;
            const v2i_t bq[8] = {b0, b1, b2, b3, b4, b5, b6, b7};
#pragma unroll
            for (int nt = 0; nt < 8; ++nt) {
                const long b8 = ((long)(unsigned)bq[nt].y << 32) | (unsigned)bq[nt].x;
                d[nt] = __builtin_amdgcn_mfma_f32_16x16x32_fp8_fp8(a8, b8, d[nt], 0, 0, 0);
            }
            issue(j, na);
        }
        if (lane < 16) {
            if (layer == 0 && !DRY) {
                bf16_t* xr = x + (long)tok * DM + colx;
#pragma unroll
                for (int nt = 0; nt < 8; ++nt) xr[16 * nt] = f2bf(xv[nt] + gfv[nt] * ((d[nt].x + d[nt].y) * invS));
            } else {
                float* xr = DRY ? (float*)(ws + OFF_R + 16 * MB) + (long)tok * DM + colx : xo + (long)tok * DM + colx;
#pragma unroll
                for (int nt = 0; nt < 8; ++nt) xr[16 * nt] = xv[nt] + gfv[nt] * ((d[nt].x + d[nt].y) * invS);
            }
            const int tn = tok + nwv < NTOK ? tok + nwv : wv;
#pragma unroll
            for (int nt = 0; nt < 8; ++nt) xv[nt] = bflo((unsigned)x[(long)tn * DM + colx + 16 * nt]);
        }
#else
        f32x4 cw[4];
        {
            const f32x4* wp = (const f32x4*)(ring + sl0 * 256 + 128 + eg * 16);
#pragma unroll
            for (int q = 0; q < 4; ++q) cw[q] = wp[q];
        }
        f32x2 ap[8];
#pragma unroll
        for (int i = 0; i < 8; ++i) ap[i] = (f32x2){0.f, 0.f};
#pragma unroll
        for (int j = 0; j < 4; ++j) {
            asm volatile("s_waitcnt vmcnt(20)" ::: "memory");
#pragma unroll
            for (int i = 0; i < 4; ++i) {
                const int rs = 8 * i + eg, g = 4 * (i & 1) + (eg >> 1);
                const u32x4 v = *(const u32x4*)(gr + j * 4096 + rs * 128 + ((sub ^ g) << 4));
                const float ws1 = cw[j][i]; const f32x2 ww = {ws1, ws1};
                ap[0] += __builtin_amdgcn_cvt_pk_f32_fp8((int)v.x, false) * ww; ap[1] += __builtin_amdgcn_cvt_pk_f32_fp8((int)v.x, true) * ww;
                ap[2] += __builtin_amdgcn_cvt_pk_f32_fp8((int)v.y, false) * ww; ap[3] += __builtin_amdgcn_cvt_pk_f32_fp8((int)v.y, true) * ww;
                ap[4] += __builtin_amdgcn_cvt_pk_f32_fp8((int)v.z, false) * ww; ap[5] += __builtin_amdgcn_cvt_pk_f32_fp8((int)v.z, true) * ww;
                ap[6] += __builtin_amdgcn_cvt_pk_f32_fp8((int)v.w, false) * ww; ap[7] += __builtin_amdgcn_cvt_pk_f32_fp8((int)v.w, true) * ww;
            }
            asm volatile("s_waitcnt lgkmcnt(0)" ::: "memory");
            issue(j, na);
        }
        float acc[16];
#pragma unroll
        for (int i = 0; i < 8; ++i) { acc[2 * i] = ap[i].x; acc[2 * i + 1] = ap[i].y; }
#pragma unroll
        for (int i = 0; i < 16; ++i) { acc[i] += lr8(acc[i]); acc[i] = sum_x16(acc[i]); acc[i] = sum_x32(acc[i]); }
        if (eg == 0) {
            float* xr = DRY ? (float*)(ws + OFF_R + 16 * MB) + (long)tok * DM + col0 : x + (long)tok * DM + col0;
#pragma unroll
            for (int c = 0; c < 4; ++c) {
                const f32x4 gv = gfv[c];
                f32x4 o;
                o.x = xv[c].x + gv.x * acc[4 * c + 0]; o.y = xv[c].y + gv.y * acc[4 * c + 1];
                o.z = xv[c].z + gv.z * acc[4 * c + 2]; o.w = xv[c].w + gv.w * acc[4 * c + 3];
                *(f32x4*)(xr + 4 * c) = o;
            }
            const int tn = tok + nwv < NTOK ? tok + nwv : wv;
#pragma unroll
            for (int c = 0; c < 4; ++c) xv[c] = *(const f32x4*)(x + (long)tn * DM + col0 + 4 * c);
        }
#endif
        s3 = sl1;
    }
    asm volatile("s_waitcnt vmcnt(0)" ::: "memory");
}

DI void norm_row_q8(const f32x4 (&v)[4], float rstd, const float* gain, const float* shift, const float* scale, unsigned char* orow, float* os, int lane) {
    f32x4 y[4]; float am = 0.f;
#pragma unroll
    for (int j = 0; j < 4; ++j) {
        const int c = 4 * lane + 256 * j;
        const f32x4 g = *(const f32x4*)(gain + c), sh = *(const f32x4*)(shift + c), sc = *(const f32x4*)(scale + c);
        y[j].x = v[j].x * rstd * g.x * (1.f + sc.x) + sh.x; y[j].y = v[j].y * rstd * g.y * (1.f + sc.y) + sh.y;
        y[j].z = v[j].z * rstd * g.z * (1.f + sc.z) + sh.z; y[j].w = v[j].w * rstd * g.w * (1.f + sc.w) + sh.w;
        am = fmaxf(am, fmaxf(fmaxf(fabsf(y[j].x), fabsf(y[j].y)), fmaxf(fabsf(y[j].z), fabsf(y[j].w))));
    }
    am = wave_max(am);
    const float qs = am > 0.f ? 127.f / am : 1.f;
#pragma unroll
    for (int j = 0; j < 4; ++j) *(int*)(orow + 4 * lane + 256 * j) = pack_i8x4(y[j].x * qs, y[j].y * qs, y[j].z * qs, y[j].w * qs);
    if (lane == 0) *os = am > 0.f ? am * (1.f / 127.f) : 1.f;
}
DI void phase_norm2(const void* __restrict__ x, unsigned char* __restrict__ out1, float* __restrict__ os1, const float* gain1, int sh1, int sc1,
                    unsigned char* __restrict__ out2, float* __restrict__ os2, const float* gain2, int sh2, int sc2, const float* ada, int tid) {
    const int lane = tid & 63, gw = blockIdx.x * NWAVES + (tid >> 6), nw = gridDim.x * NWAVES;
    for (int tok = gw; tok < NTOK; tok += nw) {
        const int b = tok >> 13;
        f32x4 v[4]; float ss = 0.f;
#pragma unroll
        for (int j = 0; j < 4; ++j) { v[j] = ld4<true>(x, (long)tok * DM + 4 * lane + 256 * j); ss += v[j].x * v[j].x + v[j].y * v[j].y + v[j].z * v[j].z + v[j].w * v[j].w; }
        const float rstd = rsqrtf(wave_sum(ss) * (1.f / DM) + EPS);
        norm_row_q8(v, rstd, gain1, ada + b * ADA_STRIDE + sh1, ada + b * ADA_STRIDE + sc1, out1 + (long)tok * DM, os1 + tok, lane);
        norm_row_q8(v, rstd, gain2, ada + b * ADA_STRIDE + sh2, ada + b * ADA_STRIDE + sc2, out2 + (long)tok * DM, os2 + tok, lane);
    }
}

template <int MT, class Epi>
DI void gemm_phase(const bf16_t* A, long lda, int M, const bf16_t* Bt, long ldb, int N, int K, const Epi& epi, unsigned char* lds, int tid) {
    const int ntm = (M + 128 * MT - 1) / (128 * MT), ntn = (N + 255) / 256, nt = ntm * ntn;
    if ((gridDim.x & 7) == 0 && (ntm & 31) == 0) {
        const int xcd = blockIdx.x & 7, lb = blockIdx.x >> 3, nlb = gridDim.x >> 3, tmx = ntm >> 3, per = tmx * ntn;
        for (int q = lb; q < per; q += nlb) {
            const int g4 = q / (4 * ntn), rem = q - g4 * 4 * ntn, tn = rem >> 2, tm = xcd * tmx + g4 * 4 + (rem & 3);
            if (tm < (xcd + 1) * tmx) gemm_tile<MT>(A, lda, M, Bt, ldb, N, K, tm * 128 * MT, tn * 256, epi, lds, tid);
        }
        return;
    }
    for (int t = blockIdx.x; t < nt; t += gridDim.x) {
        const int tn = t / ntm, tm = t % ntm;
        gemm_tile<MT>(A, lda, M, Bt, ldb, N, K, tm * 128 * MT, tn * 256, epi, lds, tid);
    }
}

template <int MT, class Epi>
DI void gemm_tile_i8(const unsigned char* __restrict__ A, int M, const float* __restrict__ as, const unsigned char* __restrict__ Bt, int N, const float* __restrict__ bs,
                     int K, int m0, int n0, const Epi& epi, unsigned char* lds, int tid) {
    constexpr int XS = MT * 128 * 128, WS = 256 * 128, STAGE = XS + WS;
    const int lane = tid & 63, w = tid >> 6, tg = w & 3, fh = w >> 2, r = lane & 31, h = lane >> 5;
    const int wbase = tid & ~63;
    unsigned xo[2 * MT], wo[4];
#pragma unroll
    for (int i = 0; i < 2 * MT; ++i) { int row, c; sw2_src(tid + 512 * i, row, c); int m = m0 + row; m = m < M ? m : M - 1; xo[i] = (unsigned)m * (unsigned)K + c * 16; }
#pragma unroll
    for (int i = 0; i < 4; ++i) { int row, c; sw2_src(tid + 512 * i, row, c); int n = n0 + row; n = n < N ? n : N - 1; wo[i] = (unsigned)n * (unsigned)K + c * 16; }
    auto stage = [&](int kt, unsigned char* st) {
#pragma unroll
        for (int i = 0; i < 2 * MT; ++i)
            __builtin_amdgcn_global_load_lds((const unsigned*)(A + kt * 128 + xo[i]), (unsigned*)(st + (wbase + 512 * i) * 16), 16, 0, 0);
#pragma unroll
        for (int i = 0; i < 4; ++i)
            __builtin_amdgcn_global_load_lds((const unsigned*)(Bt + kt * 128 + wo[i]), (unsigned*)(st + XS + (wbase + 512 * i) * 16), 16, 0, 0);
    };
    i32x16 acc[MT][4];
#pragma unroll
    for (int s2 = 0; s2 < MT; ++s2)
#pragma unroll
        for (int i = 0; i < 4; ++i)
#pragma unroll
            for (int j = 0; j < 16; ++j) acc[s2][i][j] = 0;
    const int nk = K >> 7;
    stage(0, lds);
    __syncthreads();
#pragma unroll 2
    for (int kt = 0; kt < nk; ++kt) {
        unsigned char* cur = lds + (kt & 1) * STAGE;
        if (kt + 1 < nk) stage(kt + 1, lds + ((kt + 1) & 1) * STAGE);
        i32x4 xfa[MT], wfa[4], xfb[MT], wfb[4];
        auto ldf = [&](i32x4 (&xf)[MT], i32x4 (&wf)[4], int ks) {
#pragma unroll
            for (int s2 = 0; s2 < MT; ++s2) xf[s2] = *(const i32x4*)(cur + sw2(32 * MT * tg + 32 * s2 + r, 2 * ks + h));
#pragma unroll
            for (int mt = 0; mt < 4; ++mt) wf[mt] = *(const i32x4*)(cur + XS + sw2(128 * fh + 32 * mt + r, 2 * ks + h));
        };
        auto mm = [&](const i32x4 (&xf)[MT], const i32x4 (&wf)[4]) {
#pragma unroll
            for (int mt = 0; mt < 4; ++mt)
#pragma unroll
                for (int s2 = 0; s2 < MT; ++s2) acc[s2][mt] = MFMA32I8(wf[mt], xf[s2], acc[s2][mt]);
        };
        ldf(xfa, wfa, 0);
        ldf(xfb, wfb, 1); __builtin_amdgcn_sched_barrier(0); mm(xfa, wfa); __builtin_amdgcn_sched_barrier(0);
        ldf(xfa, wfa, 2); __builtin_amdgcn_sched_barrier(0); mm(xfb, wfb); __builtin_amdgcn_sched_barrier(0);
        ldf(xfb, wfb, 3); __builtin_amdgcn_sched_barrier(0); mm(xfa, wfa); __builtin_amdgcn_sched_barrier(0);
        mm(xfb, wfb);
        __syncthreads();
    }
    auto fin = [&](const i32x16 (&ai)[4], int s2, int ho, int ro, int to) {
        const int tok = m0 + 32 * MT * tg + 32 * s2 + ro, fbase = n0 + 128 * fh;
        const float sa = as[tok < M ? tok : M - 1];
        f32x16 af[4];
#pragma unroll
        for (int mt = 0; mt < 4; ++mt) {
#pragma unroll
            for (int g4 = 0; g4 < 4; ++g4) {
                int f0 = fbase + 32 * mt + 8 * g4 + 4 * ho; f0 = f0 + 3 < N ? f0 : (N - 4 > 0 ? N - 4 : 0);
                const f32x4 sb = *(const f32x4*)(bs + f0);
                af[mt][4 * g4 + 0] = (float)ai[mt][4 * g4 + 0] * (sa * sb.x); af[mt][4 * g4 + 1] = (float)ai[mt][4 * g4 + 1] * (sa * sb.y);
                af[mt][4 * g4 + 2] = (float)ai[mt][4 * g4 + 2] * (sa * sb.z); af[mt][4 * g4 + 3] = (float)ai[mt][4 * g4 + 3] * (sa * sb.w);
            }
            __builtin_amdgcn_sched_barrier(0);
        }
        epi(af, tok, fbase, ho, lds, to);
        __builtin_amdgcn_sched_barrier(0);
    };
    if constexpr (MT == 2 && epi_stash<Epi>::present) {
        int* sp = (int*)lds + w * 4096 + lane;
#pragma unroll
        for (int mt = 0; mt < 4; ++mt)
#pragma unroll
            for (int j = 0; j < 16; ++j) sp[(mt * 16 + j) * 64] = acc[1][mt][j];
        int ho = h, ro = r, to = tid;
        asm volatile("" : "+v"(ho), "+v"(ro), "+v"(to));
        fin(acc[0], 0, ho, ro, to);
        i32x16 a2[4];
        const int* sp2 = sp; asm volatile("" : "+v"(sp2));
#pragma unroll
        for (int mt = 0; mt < 4; ++mt)
#pragma unroll
            for (int j = 0; j < 16; ++j) a2[mt][j] = sp2[(mt * 16 + j) * 64];
        asm volatile("" : "+v"(ho), "+v"(ro), "+v"(to));
        fin(a2, 1, ho, ro, to);
        __syncthreads();
    } else {
        int ho = h, ro = r, to = tid;
#pragma unroll
        for (int s2 = 0; s2 < MT; ++s2) { asm volatile("" : "+v"(ho), "+v"(ro), "+v"(to)); fin(acc[s2], s2, ho, ro, to); }
    }
}
template <int MT, class Epi>
DI void gemm_phase_i8(const unsigned char* A, int M, const float* as, const unsigned char* Bt, int N, const float* bs, int K, const Epi& epi, unsigned char* lds, int tid,
                      int skip = 0) {
    const int ntm = (M + 128 * MT - 1) / (128 * MT), ntn = (N + 255) / 256, nt = ntm * ntn;
    const int bid = (int)blockIdx.x - skip, nbl = (int)gridDim.x - skip;
    if (bid < 0) return;
    if ((gridDim.x & 7) == 0 && (ntm & 31) == 0) {
        const int xcd = bid & 7, lb = bid >> 3, nlb = nbl >> 3, tmx = ntm >> 3, per = tmx * ntn;
        for (int q = lb; q < per; q += nlb) {
            const int g4 = q / (4 * ntn), rem = q - g4 * 4 * ntn, tn = rem >> 2, tm = xcd * tmx + g4 * 4 + (rem & 3);
            gemm_tile_i8<MT>(A, M, as, Bt, N, bs, K, tm * 128 * MT, tn * 256, epi, lds, tid);
        }
        return;
    }
    for (int t = bid; t < nt; t += nbl) {
        const int tn = t / ntm, tm = t % ntm;
        gemm_tile_i8<MT>(A, M, as, Bt, N, bs, K, tm * 128 * MT, tn * 256, epi, lds, tid);
    }
}

DI void wquant_rows(const bf16_t* __restrict__ src, unsigned char* __restrict__ dst, float* __restrict__ sc, int nrows, int gw, int nw, int lane) {
    for (int n = gw; n < nrows; n += nw) {
        const u32x4 a = *(const u32x4*)(src + (long)n * 1024 + 16 * lane), b = *(const u32x4*)(src + (long)n * 1024 + 16 * lane + 8);
        float v[16];
        v[0] = bflo(a.x); v[1] = bfhi(a.x); v[2] = bflo(a.y); v[3] = bfhi(a.y); v[4] = bflo(a.z); v[5] = bfhi(a.z); v[6] = bflo(a.w); v[7] = bfhi(a.w);
        v[8] = bflo(b.x); v[9] = bfhi(b.x); v[10] = bflo(b.y); v[11] = bfhi(b.y); v[12] = bflo(b.z); v[13] = bfhi(b.z); v[14] = bflo(b.w); v[15] = bfhi(b.w);
        float am = 0.f;
#pragma unroll
        for (int q = 0; q < 16; ++q) am = fmaxf(am, fabsf(v[q]));
        am = wave_max(am);
        const float qs = am > 0.f ? 127.f / am : 1.f;
        u32x4 o;
        o.x = (unsigned)pack_i8x4(v[0] * qs, v[1] * qs, v[2] * qs, v[3] * qs); o.y = (unsigned)pack_i8x4(v[4] * qs, v[5] * qs, v[6] * qs, v[7] * qs);
        o.z = (unsigned)pack_i8x4(v[8] * qs, v[9] * qs, v[10] * qs, v[11] * qs); o.w = (unsigned)pack_i8x4(v[12] * qs, v[13] * qs, v[14] * qs, v[15] * qs);
        *(u32x4*)(dst + (long)n * 1024 + 16 * lane) = o;
        if (lane == 0) sc[n] = am > 0.f ? am * (1.f / 127.f) : 1.f;
    }
}
DI void phase_wquant(unsigned char* ws, int tid) {
    const int lane = tid & 63, gw = blockIdx.x * NWAVES + (tid >> 6), nw = gridDim.x * NWAVES;
    float* sc = (float*)(ws + OFF_W8S);
    wquant_rows((const bf16_t*)(ws + OFF_WT_PEER), ws + OFF_W8_PEER, sc + W8S_PEER, 4096, gw, nw, lane);
    wquant_rows((const bf16_t*)(ws + OFF_WT_DIN), ws + OFF_W8_DIN, sc + W8S_DIN, 3072, gw, nw, lane);
    wquant_rows((const bf16_t*)(ws + OFF_WT_KV), ws + OFF_W8_KV, sc + W8S_KV, 1536, gw, nw, lane);
    wquant_rows((const bf16_t*)(ws + OFF_WT_NIN), ws + OFF_W8_NIN, sc + W8S_NIN, 1088, gw, nw, lane);
}

#define XB_TMO      128
#define XB_XCNT(j)  (256  + 64 * (j))
#define XB_XSUB(j)  (1280 + 64 * (j))
#define XB_XGEN(j)  (2304 + 64 * (j))
#define XB_TOP      3328
#define XB_TOPGEN   3392
#define XCD_BAR_WORDS 3456
#define XB_SPIN_CAP (1u << 22)
DI unsigned xb_ld(unsigned* p) { return __hip_atomic_load(p, __ATOMIC_RELAXED, __HIP_MEMORY_SCOPE_AGENT); }
DI unsigned xb_add(unsigned* p, unsigned v) { return __hip_atomic_fetch_add(p, v, __ATOMIC_RELAXED, __HIP_MEMORY_SCOPE_AGENT); }
DI unsigned xb_xcc_id() { return (unsigned)__builtin_amdgcn_s_getreg((3 << 11) | 20) & 0xFu; }
#define XB_SPIN(cond, bar) do { unsigned _sp = 0; while (cond) { __builtin_amdgcn_s_sleep(1); \
    if ((++_sp & 255u) == 0u) { if (xb_ld(&(bar)[XB_TMO])) break; if (_sp > XB_SPIN_CAP) { atomicAdd(&(bar)[XB_TMO], 1u); break; } } } } while (0)
DI void xcd_barrier_complete(unsigned* bar, unsigned x, unsigned& nloc, unsigned& nx) {
    const unsigned G = gridDim.x;
    unsigned sum, cnt, mine, sp = 0u;
    for (;;) {
        sum = 0u; cnt = 0u; mine = 0u;
#pragma unroll
        for (unsigned j = 0; j < 16; ++j) { const unsigned c = xb_ld(&bar[XB_XCNT(j)]); sum += c; cnt += (c > 0u) ? 1u : 0u; mine = (j == x) ? c : mine; }
        if (sum == G) break;
        __builtin_amdgcn_s_sleep(1);
        if ((++sp & 255u) == 0u) { if (xb_ld(&bar[XB_TMO])) break; if (sp > XB_SPIN_CAP) { atomicAdd(&bar[XB_TMO], 1u); break; } }
    }
    nloc = mine > 0u ? mine : 1u; nx = cnt > 0u ? cnt : 1u;
}
DI void xcd_barrier(unsigned* bar, volatile LAS unsigned* st, int tid) {
    asm volatile("s_waitcnt vmcnt(0)" ::: "memory");
    __syncthreads();
    if (tid == 0) {
        const unsigned x = xb_xcc_id();
        __builtin_amdgcn_s_waitcnt(0);
        unsigned nloc = st[0], nx = st[1];
        if (nloc == 0u) { xcd_barrier_complete(bar, x, nloc, nx); st[0] = nloc; st[1] = nx; }
        const unsigned old = xb_add(&bar[XB_XSUB(x)], 1u);
        const unsigned gen = old / nloc;
        if (old + 1u == (gen + 1u) * nloc) {
            __builtin_amdgcn_fence(__ATOMIC_RELEASE, "agent");
            asm volatile("s_waitcnt vmcnt(0)" ::: "memory");
            const unsigned og = xb_add(&bar[XB_TOP], 1u);
            const unsigned tg = og / nx;
            if (og + 1u == (tg + 1u) * nx) xb_add(&bar[XB_TOPGEN], 1u);
            else XB_SPIN(xb_ld(&bar[XB_TOPGEN]) == tg, bar);
            __builtin_amdgcn_fence(__ATOMIC_ACQUIRE, "agent");
            xb_add(&bar[XB_XGEN(x)], 1u);
            asm volatile("s_waitcnt vmcnt(0)" ::: "memory");
        } else {
            XB_SPIN(xb_ld(&bar[XB_XGEN(x)]) == gen, bar);
            __builtin_amdgcn_fence(__ATOMIC_ACQUIRE, "agent");
            asm volatile("s_waitcnt vmcnt(0)" ::: "memory");
        }
    }
    __syncthreads();
}

#define ftid() ftid_(wave_u)
DI int ftid_(int wave_u) { int t = (wave_u << 6) + (int)__builtin_amdgcn_mbcnt_hi(~0u, __builtin_amdgcn_mbcnt_lo(~0u, 0u)); asm volatile("" : "+v"(t)); return t; }


#if defined(__HIP_DEVICE_COMPILE__)
typedef const __attribute__((address_space(4))) Params* KParamPtr;
DI Params load_params() { KParamPtr kp = (KParamPtr)__builtin_amdgcn_kernarg_segment_ptr(); asm volatile("" : "+s"(kp)); return *kp; }
#else
DI Params load_params() { return Params{}; }
#endif
#define p (load_params())
#define ws (load_params().ws)
#define ada ((const float*)(ws + OFF_ADA))
#define Hb ((bf16_t*)(ws + OFF_H))
#define bar ((unsigned*)(ws + OFF_BAR))
__global__ void __launch_bounds__(NTHREADS) yoco_fwd(Params p_arg) {
    extern __shared__ __attribute__((aligned(16))) unsigned char lds[];
    cg::grid_group grid = cg::this_grid();
    volatile LAS unsigned* bst = (volatile LAS unsigned*)(lds + LDS_BAR);
    const int wave_u = __builtin_amdgcn_readfirstlane((int)(threadIdx.x >> 6));
    { const int t0 = ftid(); if (t0 == 0) { bst[0] = 0u; bst[1] = 0u; }
      if (blockIdx.x == 0) for (int i = t0; i < XCD_BAR_WORDS; i += NTHREADS) bar[i] = 0u; }
    __syncthreads();
    RUN(0) REP(0) phase_prep(p, lds, ftid());
    grid.sync();
    if (ftid() == 0) (void)xb_add(&bar[XB_XCNT(xb_xcc_id())], 1u);
    RUN(1) REP(1) phase_norm_q8<false, false>(p.in[0], Hb, ws + OFF_H8, (float*)(ws + OFF_HS), p.in[5], ada, 0, 1024, ftid());
    RUN(1) phase_wquant(ws, ftid());
    xcd_barrier(bar, bst, ftid());
    RUN(2) REP(2) {
        EpiQKV0 e{(bf16_t*)(ws + OFF_Q0), (bf16_t*)(ws + OFF_K0), (bf16_t*)(ws + OFF_VT0), p.in[10], p.in[11], (float*)(ws + OFF_MB0), p.in[2]};
        gemm_phase_i8<2>(ws + OFF_H8, NTOK, (const float*)(ws + OFF_HS), ws + OFF_W8_DIN, 3072, (const float*)(ws + OFF_W8S) + W8S_DIN, DM, e, lds, ftid());
    }
    xcd_barrier(bar, bst, ftid());
    RUN(3) REP(3) phase_diff_attn(p, lds, ftid());
    __builtin_amdgcn_s_setprio(0);
    xcd_barrier(bar, bst, ftid());
    RUN(4) REP(4) {
        EpiResid<false, true> e{p.in[0], ws + OFF_XB, ada + 2 * 1024};
        gemm_phase<2>(Hb, DM, NTOK, (const bf16_t*)(ws + OFF_WT_DOUT), DM, 1024, DM, e, lds, ftid());
    }
    xcd_barrier(bar, bst, ftid());
    if (STOP_AFTER <= 1) return;
    RUN(1) phase_norm_q8<false, true>(ws + OFF_XB, Hb, ws + OFF_H8, (float*)(ws + OFF_HS), p.in[6], ada, 3 * 1024, 4 * 1024, ftid());
    xcd_barrier(bar, bst, ftid());
    RUN(5) REP(5) {
        EpiPeer e{(int*)(ws + OFF_RIDX), (float*)(ws + OFF_RGATE), 128 * 1024};
        gemm_phase_i8<2>(ws + OFF_H8, NTOK, (const float*)(ws + OFF_HS), ws + OFF_W8_PEER, 2048, (const float*)(ws + OFF_W8S) + W8S_PEER, DM, e, lds, ftid());
    }
    xcd_barrier(bar, bst, ftid());
    if ((REPEAT_MASK >> 6) & 1) phase_peer_u<true>(p, 0, lds, ftid());
    RUN(6) phase_peer_u<false>(p, 0, lds, ftid());
    xcd_barrier(bar, bst, ftid());
    if ((REPEAT_MASK >> 10) & 1) phase_peer_v<true>(p, 0, lds, ftid());
    RUN(6) phase_peer_v<false>(p, 0, lds, ftid());
    xcd_barrier(bar, bst, ftid());
    RUN(1) phase_norm2(ws + OFF_XB, ws + OFF_H8, (float*)(ws + OFF_HS), p.in[13], 12288, 12288 + 1024, ws + OFF_H, (float*)(ws + OFF_HS) + NTOK, p.in[5] + 1024, 6144, 6144 + 1024, ada, ftid());
    xcd_barrier(bar, bst, ftid());
    if (STOP_AFTER <= 2) return;
    RUN(7) REP(7) {
        EpiKV e{(bf16_t*)(ws + OFF_KC), (bf16_t*)(ws + OFF_KS), (bf16_t*)(ws + OFF_VST), (bf16_t*)(ws + OFF_KW), (bf16_t*)(ws + OFF_VWT), p.in[21]};
        gemm_phase_i8<2>(ws + OFF_H8, NTOK, (const float*)(ws + OFF_HS), ws + OFF_W8_KV, 1536, (const float*)(ws + OFF_W8S) + W8S_KV, DM, e, lds, ftid());
    }
    xcd_barrier(bar, bst, ftid());
    RUN(8) REP(8) {
        EpiNsaQ e{(bf16_t*)(ws + OFF_QN), (float*)(ws + OFF_GATES), p.in[25], p.in[23], (float*)(ws + OFF_MB1)};
        gemm_phase_i8<2>(ws + OFF_H, NTOK, (const float*)(ws + OFF_HS) + NTOK, ws + OFF_W8_NIN, 1048, (const float*)(ws + OFF_W8S) + W8S_NIN, DM, e, lds, ftid(),
                         gridDim.x >= 128 ? 64 : 0);
        for (int t = blockIdx.x; t < 64; t += gridDim.x) {
            const int pr = t >> 2, tm = t & 3, kv = pr >> 3, bg = pr & 7;
            const bf16_t* Ap = (const bf16_t*)(ws + OFF_KC) + (long)(kv * 8 + bg) * SEQ * 128;
            bf16_t* hid = (bf16_t*)(ws + OFF_HID) + (long)pr * 512 * 256;
            EpiCmp1 e1{hid, (const float*)(ws + OFF_POSB) + kv * 16 * 256, p.in[19] + kv * 256};
            gemm_tile<1>(Ap, 2048, 511, (const bf16_t*)(ws + OFF_WT_C1) + (long)kv * 256 * 4096, 4096, 256, 4096, tm * 128, 0, e1, lds, ftid());
            __syncthreads();
            bf16_t* dst = kv == 0 ? (bf16_t*)(ws + OFF_KCMP) + (long)bg * 512 * 128 : (bf16_t*)(ws + OFF_VCMPT) + (long)bg * 128 * 512;
            EpiCmp2 e2{dst, p.in[21], kv};
            gemm_tile<1>(hid, 256, 512, (const bf16_t*)(ws + OFF_WT_C2) + (long)kv * 128 * 256, 256, 128, 256, tm * 128, 0, e2, lds, ftid());
        }
    }
    xcd_barrier(bar, bst, ftid());
#ifdef NSA_PROBE
    phase_nsa_attn<NSA_PROBE>(p, lds, ftid());
#endif
    RUN(9) REP(9) phase_nsa_attn<0>(p, lds, ftid());
    xcd_barrier(bar, bst, ftid());
    RUN(4) {
        EpiResid<true, true> e{ws + OFF_XB, ws + OFF_XB, ada + 6144 + 2 * 1024};
        gemm_phase<2>(Hb, DM, NTOK, (const bf16_t*)(ws + OFF_WT_NOUT), DM, 1024, DM, e, lds, ftid());
    }
    xcd_barrier(bar, bst, ftid());
    if (STOP_AFTER <= 3) return;
    RUN(1) phase_norm_q8<false, true>(ws + OFF_XB, Hb, ws + OFF_H8, (float*)(ws + OFF_HS), p.in[6] + 1024, ada, 6144 + 3 * 1024, 6144 + 4 * 1024, ftid());
    xcd_barrier(bar, bst, ftid());
    RUN(5) REP(5) {
        EpiPeer e{(int*)(ws + OFF_RIDX), (float*)(ws + OFF_RGATE), 128 * 1024};
        gemm_phase_i8<2>(ws + OFF_H8, NTOK, (const float*)(ws + OFF_HS), ws + OFF_W8_PEER + (long)2048 * 1024, 2048, (const float*)(ws + OFF_W8S) + W8S_PEER + 2048, DM, e, lds, ftid());
    }
    xcd_barrier(bar, bst, ftid());
    if ((REPEAT_MASK >> 6) & 1) phase_peer_u<true>(p, 1, lds, ftid());
    RUN(6) phase_peer_u<false>(p, 1, lds, ftid());
    xcd_barrier(bar, bst, ftid());
    if ((REPEAT_MASK >> 10) & 1) phase_peer_v<true>(p, 1, lds, ftid());
    RUN(6) phase_peer_v<false>(p, 1, lds, ftid());
}
#undef p
#undef ws
#undef ada
#undef Hb
#undef bar

extern "C" void kernel_launch(void* const* d_in, const int* in_sizes, int n_in, void* d_out, int out_size, void* d_ws, size_t ws_size,
                              hipStream_t stream) {
    static int grid_blocks = 0;
    if (grid_blocks == 0) {
        if (n_in != 30 || out_size != NTOK * DM || ws_size < WS_END) {
            fprintf(stderr, "kernel_launch: unexpected shapes (n_in %d out %d ws %zu)\n", n_in, out_size, ws_size);
            grid_blocks = -1; return;
        }
        int dev = 0, cus = 0, per_cu = 0;
        hipGetDevice(&dev);
        hipDeviceGetAttribute(&cus, hipDeviceAttributeMultiprocessorCount, dev);
        hipFuncSetAttribute((const void*)yoco_fwd, hipFuncAttributeMaxDynamicSharedMemorySize, LDS_BYTES);
        hipOccupancyMaxActiveBlocksPerMultiprocessor(&per_cu, (const void*)yoco_fwd, NTHREADS, LDS_BYTES);
        if (per_cu < 1) { fprintf(stderr, "kernel_launch: occupancy query says %d blocks per CU\n", per_cu); grid_blocks = -1; return; }
        grid_blocks = cus;
    }
    if (grid_blocks < 0) return;
    Params p{};
    for (int i = 0; i < 30; ++i) p.in[i] = (const float*)d_in[i];
    p.out = (float*)d_out;
    p.ws = (unsigned char*)d_ws;
    void* args[] = {&p};
    hipError_t e = hipLaunchCooperativeKernel((const void*)yoco_fwd, dim3(grid_blocks), dim3(NTHREADS), args, LDS_BYTES, stream);
    if (e != hipSuccess) fprintf(stderr, "cooperative launch failed: %s (grid %d)\n", hipGetErrorString(e), grid_blocks);
}
```
